# Optimizing an MI355X kernel written in HIP

```python
import math
import jax, jax.numpy as jnp
from jax import lax
import numpy as np

D_MODEL = 1024
BATCH = 2
SEQ = 8192
DEPTH = 4

CHUNK = 64
HEAD_DIM = 64
SSM_WIDTH = D_MODEL // 4
ATT_WIDTH = (D_MODEL - SSM_WIDTH) // 2
RET_WIDTH = D_MODEL - SSM_WIDTH - ATT_WIDTH
ATT_HEADS = ATT_WIDTH // HEAD_DIM
RET_HEADS = RET_WIDTH // HEAD_DIM
IN_COLS = 3 * ATT_WIDTH + 4 * RET_WIDTH + SSM_WIDTH
ATT_LEFT_CHUNKS = 8
ATT_BAND = (ATT_LEFT_CHUNKS + 1) * CHUNK
REL_CLIP = 256
ROPE_BASE = 10000.0
SSM_GROUP = 16
SSM_GROUPS = SSM_WIDTH // SSM_GROUP
SSM_STATE = 64
PEER_HEADS = 8
PEER_TOPK = 16
PEER_NKEYS = 128
PEER_QDIM = 256
PEER_N = PEER_NKEYS * PEER_NKEYS
PEER_BLOCK = 128
EPS = 1e-6

kernel_name = 'hybrid_streaming_encoder_block'


def _rms(x):
    xf = x.astype(jnp.float32)
    return xf * lax.rsqrt(jnp.mean(xf * xf, axis=-1, keepdims=True) + EPS)


def rms_norm(x, gain):
    return (_rms(x) * gain.astype(jnp.float32)).astype(x.dtype)


def chunk_attention(q, k, v, rel_bias):
    b, l, h, dh = q.shape
    nc = l // CHUNK
    qc = q.reshape(b, nc, CHUNK, h, dh)
    kc = k.reshape(b, nc, CHUNK, h, dh)
    vc = v.reshape(b, nc, CHUNK, h, dh)
    pad = ((0, 0), (ATT_LEFT_CHUNKS, 0), (0, 0), (0, 0), (0, 0))
    kp = jnp.pad(kc, pad)
    vp = jnp.pad(vc, pad)
    kb = jnp.concatenate([kp[:, j:j + nc] for j in range(ATT_LEFT_CHUNKS + 1)], axis=2)
    vb = jnp.concatenate([vp[:, j:j + nc] for j in range(ATT_LEFT_CHUNKS + 1)], axis=2)
    scores = jnp.einsum('bnqhd,bnkhd->bnhqk', qc, kb).astype(jnp.float32) * (dh ** -0.5)
    qpos = jnp.arange(CHUNK) + ATT_LEFT_CHUNKS * CHUNK
    kpos = jnp.arange(ATT_BAND)
    rel = jnp.clip(qpos[:, None] - kpos[None, :], -REL_CLIP, REL_CLIP) + REL_CLIP
    bias = rel_bias.astype(jnp.float32)[:, rel]
    key_chunk = jnp.arange(nc)[:, None] + (kpos // CHUNK)[None, :] - ATT_LEFT_CHUNKS
    valid = (key_chunk >= 0)[None, :, None, None, :]
    scores = jnp.where(valid, scores + bias[None, None], -1e30)
    p = jax.nn.softmax(scores, axis=-1).astype(v.dtype)
    out = jnp.einsum('bnhqk,bnkhd->bnqhd', p, vb)
    return out.reshape(b, l, h * dh)


def rotary(x, pos):
    d = x.shape[-1]
    half = d // 2
    inv = ROPE_BASE ** (-jnp.arange(half, dtype=jnp.float32) / half)
    ang = pos.astype(jnp.float32)[:, None] * inv[None, :]
    cos = jnp.cos(ang)[None, :, None, :]
    sin = jnp.sin(ang)[None, :, None, :]
    xf = x.astype(jnp.float32)
    x1, x2 = xf[..., :half], xf[..., half:]
    return jnp.concatenate([x1 * cos - x2 * sin, x1 * sin + x2 * cos], axis=-1)


def retention(q, k, v, g):
    b, l, h, d = q.shape
    nc = l // CHUNK
    pos = jnp.arange(l)
    qf = rotary(q, pos)
    kf = rotary(k, pos) * (d ** -0.5)
    vf = v.astype(jnp.float32)
    log_g = jnp.log1p(-jnp.power(2.0, -5.0 - jnp.arange(h, dtype=jnp.float32)))
    idx = jnp.arange(CHUNK, dtype=jnp.float32)
    intra_decay = jnp.exp(log_g[:, None, None] * jnp.abs(idx[:, None] - idx[None, :]))
    k_decay = jnp.exp(log_g[:, None] * (CHUNK - 1 - idx)[None, :])
    q_decay = jnp.exp(log_g[:, None] * (idx + 1.0)[None, :])
    chunk_decay = jnp.exp(log_g * CHUNK)[None, :, None, None]
    qc = qf.reshape(b, nc, CHUNK, h, d)
    kc = kf.reshape(b, nc, CHUNK, h, d)
    vc = vf.reshape(b, nc, CHUNK, h, d)
    s = jnp.einsum('bnqhd,bnkhd->bnhqk', qc, kc) * intra_decay
    y_intra = jnp.einsum('bnhqk,bnkhe->bnqhe', s, vc)
    upd = jnp.einsum('bnkhd,bnkhe,hk->nbhde', kc, vc, k_decay)

    def step(state, u):
        return chunk_decay * state + u, state

    _, s_prev = lax.scan(step, jnp.zeros((b, h, d, d), jnp.float32), upd)
    y_cross = jnp.einsum('bnqhd,nbhde,hq->bnqhe', qc, s_prev, q_decay)
    y = y_intra + y_cross
    mu = jnp.mean(y, axis=-1, keepdims=True)
    var = jnp.mean(jnp.square(y - mu), axis=-1, keepdims=True)
    y = (y - mu) * lax.rsqrt(var + EPS)
    y = y.reshape(b, l, h * d) * jax.nn.silu(g.astype(jnp.float32))
    return y.astype(v.dtype)


def s5_ssm(u, lam_re, lam_im, log_dt, b_re, b_im, c_re, c_im, d_skip, w_glu):
    bsz, l, w = u.shape
    uf = u.astype(jnp.float32).reshape(bsz, l, SSM_GROUPS, SSM_GROUP)
    dt = jnp.exp(log_dt.astype(jnp.float32))[:, None]
    lr = lam_re.astype(jnp.float32)
    li = lam_im.astype(jnp.float32)
    mag = jnp.exp(lr * dt)
    ab_re = mag * jnp.cos(li * dt)
    ab_im = mag * jnp.sin(li * dt)
    den = lr * lr + li * li
    nr, ni = ab_re - 1.0, ab_im
    f_re = (nr * lr + ni * li) / den
    f_im = (ni * lr - nr * li) / den
    br, bi = b_re.astype(jnp.float32), b_im.astype(jnp.float32)
    bb_re = f_re[..., None] * br - f_im[..., None] * bi
    bb_im = f_re[..., None] * bi + f_im[..., None] * br
    bu_re = jnp.einsum('gpc,blgc->blgp', bb_re, uf)
    bu_im = jnp.einsum('gpc,blgc->blgp', bb_im, uf)
    a_re = jnp.broadcast_to(ab_re, bu_re.shape)
    a_im = jnp.broadcast_to(ab_im, bu_im.shape)

    def combine(e1, e2):
        ar1, ai1, br1, bi1 = e1
        ar2, ai2, br2, bi2 = e2
        return (ar2 * ar1 - ai2 * ai1,
                ar2 * ai1 + ai2 * ar1,
                ar2 * br1 - ai2 * bi1 + br2,
                ar2 * bi1 + ai2 * br1 + bi2)

    _, _, x_re, x_im = lax.associative_scan(combine, (a_re, a_im, bu_re, bu_im), axis=1)
    y = (jnp.einsum('gcp,blgp->blgc', c_re.astype(jnp.float32), x_re)
         - jnp.einsum('gcp,blgp->blgc', c_im.astype(jnp.float32), x_im)
         + d_skip.astype(jnp.float32).reshape(SSM_GROUPS, SSM_GROUP) * uf)
    y = jax.nn.gelu(y.reshape(bsz, l, w))
    z = y @ w_glu.astype(jnp.float32)
    out = z[..., :w] * jax.nn.sigmoid(z[..., w:])
    return out.astype(u.dtype)


def peer(h, w_q, subkeys, u_tab, v_tab):
    b, l, dm = h.shape
    t = b * l
    hf = h.reshape(t, dm)
    q = (hf @ w_q).astype(jnp.float32).reshape(t, PEER_HEADS, 2, PEER_QDIM // 2)
    s = jnp.einsum('thsd,hskd->thsk', q, subkeys.astype(jnp.float32))
    top_s, top_i = lax.top_k(s, PEER_TOPK)
    cand_s = top_s[:, :, 0, :, None] + top_s[:, :, 1, None, :]
    cand_i = top_i[:, :, 0, :, None] * PEER_NKEYS + top_i[:, :, 1, None, :]
    best_s, best_pos = lax.top_k(cand_s.reshape(t, PEER_HEADS, PEER_TOPK * PEER_TOPK), PEER_TOPK)
    expert = jnp.take_along_axis(cand_i.reshape(t, PEER_HEADS, PEER_TOPK * PEER_TOPK), best_pos, axis=-1)
    gate = jax.nn.softmax(best_s, axis=-1)
    nblk = t // PEER_BLOCK

    def block(args):
        hb, eb, gb = args
        ub = jnp.take(u_tab, eb, axis=0)
        vb = jnp.take(v_tab, eb, axis=0)
        act = jax.nn.gelu(jnp.einsum('thkd,td->thk', ub, hb).astype(jnp.float32))
        return jnp.einsum('thk,thkd->td', (gb * act).astype(vb.dtype), vb)

    out = lax.map(block, (hf.reshape(nblk, PEER_BLOCK, dm),
                          expert.reshape(nblk, PEER_BLOCK, PEER_HEADS, PEER_TOPK),
                          gate.reshape(nblk, PEER_BLOCK, PEER_HEADS, PEER_TOPK)))
    return out.reshape(b, l, dm).astype(h.dtype)


def setup_inputs(seed: int = 0) -> dict:
    key = jax.random.key(seed)
    ks = jax.random.split(key, 26)
    f32 = jnp.float32
    nrm = lambda k, shape, scale: jax.random.normal(k, shape, f32) * scale
    lam_re = -0.5 + nrm(ks[7], (DEPTH, SSM_GROUPS, SSM_STATE), 0.01)
    lam_im = (jnp.pi * jnp.arange(SSM_STATE, dtype=f32))[None, None, :] + nrm(ks[8], (DEPTH, SSM_GROUPS, SSM_STATE), 0.01)
    log_dt = jax.random.uniform(ks[9], (DEPTH, SSM_GROUPS), f32, math.log(1e-3), math.log(1e-1))
    return {
        'x': nrm(ks[0], (BATCH, SEQ, D_MODEL), 1.0),
        'c': nrm(ks[1], (BATCH, D_MODEL), 1.0),
        'w_ada': nrm(ks[2], (DEPTH, D_MODEL, 6 * D_MODEL), 0.5 * D_MODEL ** -0.5),
        'b_ada': nrm(ks[3], (DEPTH, 6 * D_MODEL), 0.02),
        'norm_mix': 1.0 + nrm(ks[4], (DEPTH, D_MODEL), 0.05),
        'norm_ffn': 1.0 + nrm(ks[5], (DEPTH, D_MODEL), 0.05),
        'w_in': nrm(ks[6], (DEPTH, D_MODEL, IN_COLS), D_MODEL ** -0.5),
        'rel_bias': nrm(ks[10], (DEPTH, ATT_HEADS, 2 * REL_CLIP + 1), 0.2),
        'ssm_lambda_re': lam_re,
        'ssm_lambda_im': lam_im,
        'ssm_log_dt': log_dt,
        'ssm_b_re': nrm(ks[11], (DEPTH, SSM_GROUPS, SSM_STATE, SSM_GROUP), (2 * SSM_GROUP) ** -0.5),
        'ssm_b_im': nrm(ks[12], (DEPTH, SSM_GROUPS, SSM_STATE, SSM_GROUP), (2 * SSM_GROUP) ** -0.5),
        'ssm_c_re': nrm(ks[13], (DEPTH, SSM_GROUPS, SSM_GROUP, SSM_STATE), (2 * SSM_STATE) ** -0.5),
        'ssm_c_im': nrm(ks[14], (DEPTH, SSM_GROUPS, SSM_GROUP, SSM_STATE), (2 * SSM_STATE) ** -0.5),
        'ssm_d': nrm(ks[15], (DEPTH, SSM_WIDTH), 1.0),
        'w_glu': nrm(ks[16], (DEPTH, SSM_WIDTH, 2 * SSM_WIDTH), SSM_WIDTH ** -0.5),
        'merge_gain': 1.0 + nrm(ks[17], (DEPTH, D_MODEL), 0.05),
        'w_out': nrm(ks[18], (DEPTH, D_MODEL, D_MODEL), D_MODEL ** -0.5),
        'peer_w_q': nrm(ks[19], (DEPTH, D_MODEL, PEER_HEADS * PEER_QDIM), D_MODEL ** -0.5),
        'peer_subkeys': nrm(ks[20], (DEPTH, PEER_HEADS, 2, PEER_NKEYS, PEER_QDIM // 2), (PEER_QDIM // 2) ** -0.5),
        'peer_u': nrm(ks[21], (DEPTH, PEER_N, D_MODEL), D_MODEL ** -0.5),
        'peer_v': nrm(ks[22], (DEPTH, PEER_N, D_MODEL), 0.5),
        'final_norm': 1.0 + nrm(ks[23], (D_MODEL,), 0.05),
    }


def reference(x, c, w_ada, b_ada, norm_mix, norm_ffn, w_in, rel_bias, ssm_lambda_re, ssm_lambda_im,
              ssm_log_dt, ssm_b_re, ssm_b_im, ssm_c_re, ssm_c_im, ssm_d, w_glu, merge_gain, w_out,
              peer_w_q, peer_subkeys, peer_u, peer_v, final_norm):
    b, l, dm = x.shape
    sizes = [ATT_WIDTH] * 3 + [RET_WIDTH] * 4 + [SSM_WIDTH]
    splits = [int(v) for v in np.cumsum(sizes)[:-1]]
    cond = jax.nn.silu(c)
    for layer in range(DEPTH):
        mod = (cond @ w_ada[layer] + b_ada[layer])[:, None, :]
        sh1, sc1, g1, sh2, sc2, g2 = jnp.split(mod, 6, axis=-1)
        hmix = rms_norm(x, norm_mix[layer]) * (1.0 + sc1) + sh1
        proj = hmix @ w_in[layer]
        qa, ka, va, qr, kr, vr, gr, us = jnp.split(proj, splits, axis=-1)
        hs = lambda t: t.reshape(b, l, -1, HEAD_DIM)
        att = chunk_attention(hs(qa), hs(ka), hs(va), rel_bias[layer])
        ret = retention(hs(qr), hs(kr), hs(vr), gr)
        ssm = s5_ssm(us, ssm_lambda_re[layer], ssm_lambda_im[layer], ssm_log_dt[layer],
                     ssm_b_re[layer], ssm_b_im[layer], ssm_c_re[layer], ssm_c_im[layer],
                     ssm_d[layer], w_glu[layer])
        merged = jnp.concatenate([_rms(att), ret.astype(jnp.float32), _rms(ssm)], axis=-1)
        merged = (merged * merge_gain[layer].astype(jnp.float32)).astype(x.dtype)
        x = x + g1 * (merged @ w_out[layer])
        hffn = rms_norm(x, norm_ffn[layer]) * (1.0 + sc2) + sh2
        x = x + g2 * peer(hffn, peer_w_q[layer], peer_subkeys[layer], peer_u[layer], peer_v[layer])
    return rms_norm(x, final_norm)
```

```cpp
#include <hip/hip_runtime.h>
#include <hip/hip_cooperative_groups.h>
#include <cstdio>
#include <cstdint>
namespace cg = cooperative_groups;

typedef unsigned short bf16_t;
typedef short bf16x8 __attribute__((ext_vector_type(8)));
typedef float f32x4 __attribute__((ext_vector_type(4)));

constexpr int T_ = 16384, D_ = 1024, L_ = 8192, NBATCH = 2, DEPTH_ = 4;
constexpr int INC = 2944, INCP = 3072;
constexpr int NCH = 128;
constexpr int NT = 512;
constexpr int NW = 8;
constexpr float EPS_ = 1e-6f;
constexpr int C_QA = 0, C_KA = 384, C_VA = 768, C_QR = 1152, C_KR = 1536, C_VR = 1920, C_GR = 2304, C_US = 2688;

constexpr size_t al256(size_t x) { return (x + 255) & ~(size_t)255; }
constexpr size_t WS_MOD   = 0;
constexpr size_t WS_ROTC  = al256(WS_MOD + 4ull * 2 * 6144 * 4);
constexpr size_t WS_ROTS  = al256(WS_ROTC + 8192ull * 32 * 4);
constexpr size_t WS_SA    = al256(WS_ROTS + 8192ull * 32 * 4);
constexpr size_t WS_SBB   = al256(WS_SA + 4ull * 16 * 64 * 2 * 4);
constexpr size_t WS_WIN   = al256(WS_SBB + 4ull * 16 * 64 * 32 * 4);
constexpr size_t WS_WOUT  = al256(WS_WIN + 4ull * INCP * 1024 * 2);
constexpr size_t WS_WQ    = al256(WS_WOUT + 4ull * 1024 * 1024 * 2);
constexpr size_t WS_SUBK  = al256(WS_WQ + 4ull * 2048 * 1024 * 2);
constexpr size_t WS_ABUF  = al256(WS_SUBK + 4ull * 16 * 128 * 128 * 2);
constexpr size_t WS_PROJ  = al256(WS_ABUF + (size_t)T_ * 1024 * 2);
constexpr size_t WS_VTA   = al256(WS_PROJ + (size_t)T_ * INCP * 2);
constexpr size_t WS_ATT   = al256(WS_VTA + 2ull * 6 * 64 * 8192 * 2);
constexpr size_t WS_YINT  = al256(WS_ATT + (size_t)T_ * 384 * 4);
constexpr size_t WS_UPD   = al256(WS_YINT + (size_t)T_ * 384 * 4);
constexpr size_t WS_SPREV = al256(WS_UPD + 256ull * 6 * 4096 * 4);
constexpr size_t WS_SEND  = al256(WS_SPREV + 256ull * 6 * 4096 * 4);
constexpr size_t WS_CARRY = al256(WS_SEND + 256ull * 16 * 64 * 2 * 4);
constexpr size_t WS_X     = al256(WS_CARRY + 256ull * 16 * 64 * 2 * 4);
constexpr size_t WS_Q     = al256(WS_X + (size_t)T_ * 1024 * 4);
constexpr size_t WS_SC    = al256(WS_Q + (size_t)T_ * 2048 * 2);
constexpr size_t WS_EIDX  = al256(WS_SC + (size_t)T_ * 2048 * 4);
constexpr size_t WS_EGATE = al256(WS_EIDX + (size_t)T_ * 128 * 4);
constexpr size_t WS_END   = al256(WS_EGATE + (size_t)T_ * 128 * 4);

constexpr int LDS_BYTES = 135168;

struct Params {
  const float* in[24];
  float* out;
  unsigned char* ws;
};
enum { I_X = 0, I_C, I_WADA, I_BADA, I_NMIX, I_NFFN, I_WIN, I_RELB, I_LRE, I_LIM, I_LOGDT, I_BRE, I_BIM, I_CRE, I_CIM, I_SSMD,
       I_WGLU, I_MGAIN, I_WOUT, I_WQ, I_SUBK, I_PU, I_PV, I_FNORM };

__device__ __forceinline__ float bf2f(bf16_t v) { return __uint_as_float(((unsigned)v) << 16); }
__device__ __forceinline__ bf16_t f2bf(float f) { unsigned u = __float_as_uint(f); u += 0x7fffu + ((u >> 16) & 1u); return (bf16_t)(u >> 16); }
__device__ __forceinline__ unsigned pk2(float a, float b) { return (unsigned)f2bf(a) | ((unsigned)f2bf(b) << 16); }
__device__ __forceinline__ float wave_sum(float v) {
#pragma unroll
  for (int o = 32; o > 0; o >>= 1) v += __shfl_xor(v, o);
  return v;
}
__device__ __forceinline__ float wave_max(float v) {
#pragma unroll
  for (int o = 32; o > 0; o >>= 1) v = fmaxf(v, __shfl_xor(v, o));
  return v;
}
__device__ __forceinline__ float gelu_tanh(float x) { const float u = 0.7978845608028654f * (x + 0.044715f * x * x * x); return 0.5f * x * (1.f + tanhf(u)); }
__device__ __forceinline__ float sigmoid_f(float x) { return 1.f / (1.f + __expf(-x)); }
__device__ __forceinline__ unsigned char* launder_ptr(unsigned char* q) { asm volatile("" : "+s"(q)); return q; }
__device__ __forceinline__ const float* launder_cptr(const float* q) { asm volatile("" : "+s"(q)); return q; }
__device__ __forceinline__ int launder_tid() { int t = threadIdx.x; asm volatile("" : "+v"(t)); return t; }

__device__ void setup_phase(const Params& p, unsigned char* smem) {
  unsigned char* const ws = launder_ptr(p.ws); const int tidx = launder_tid(); (void)ws; (void)tidx;
  const int tid = tidx;
  float* sm = (float*)smem;
  {
    float* cond = sm;
    float* red = sm + 2048;
    float* MOD = (float*)(ws + WS_MOD);
    for (int i = tid; i < 2048; i += NT) { const float c = p.in[I_C][i]; cond[i] = c * sigmoid_f(c); }
    __syncthreads();
    for (int item = blockIdx.x; item < 4 * 96; item += gridDim.x) {
      const int l = item / 96, cb = item % 96, kq = tid >> 6, jj = tid & 63, j = cb * 64 + jj;
      const float* w = p.in[I_WADA] + (size_t)l * 1024 * 6144 + j;
      float a0 = 0.f, a1 = 0.f;
      for (int k = kq * 128; k < kq * 128 + 128; ++k) { const float wv = w[(size_t)k * 6144]; a0 += cond[k] * wv; a1 += cond[1024 + k] * wv; }
      red[(kq * 2 + 0) * 64 + jj] = a0; red[(kq * 2 + 1) * 64 + jj] = a1;
      __syncthreads();
      if (tid < 128) {
        const int b = tid >> 6, j2 = tid & 63; float s = 0.f;
        for (int q = 0; q < 8; ++q) s += red[(q * 2 + b) * 64 + j2];
        MOD[((size_t)l * 2 + b) * 6144 + cb * 64 + j2] = s + p.in[I_BADA][(size_t)l * 6144 + cb * 64 + j2];
      }
      __syncthreads();
    }
  }
  const int gtid = blockIdx.x * NT + tid, gn = gridDim.x * NT;
  {
    float* RC = (float*)(ws + WS_ROTC); float* RS = (float*)(ws + WS_ROTS);
    for (int idx = gtid; idx < 8192 * 32; idx += gn) {
      const int pos = idx >> 5, i = idx & 31;
      const float inv = powf(10000.0f, -(float)i / 32.0f);
      const float ang = (float)pos * inv;
      float s, c; sincosf(ang, &s, &c);
      RC[idx] = c; RS[idx] = s;
    }
  }
  {
    float* SA = (float*)(ws + WS_SA); float* SBB = (float*)(ws + WS_SBB);
    for (int idx = gtid; idx < 4 * 16 * 64; idx += gn) {
      const int l = idx / 1024, g = (idx >> 6) & 15;
      const float dt = expf(p.in[I_LOGDT][l * 16 + g]);
      const float lr = p.in[I_LRE][idx], li = p.in[I_LIM][idx];
      const float mag = expf(lr * dt);
      float sn, cs; sincosf(li * dt, &sn, &cs);
      const float are = mag * cs, aim = mag * sn;
      const float den = lr * lr + li * li, nr = are - 1.f, ni = aim;
      const float fre = (nr * lr + ni * li) / den, fim = (ni * lr - nr * li) / den;
      SA[idx * 2] = are; SA[idx * 2 + 1] = aim;
      for (int c = 0; c < 16; ++c) {
        const float br = p.in[I_BRE][(size_t)idx * 16 + c], bi = p.in[I_BIM][(size_t)idx * 16 + c];
        SBB[(size_t)idx * 32 + c] = fre * br - fim * bi;
        SBB[(size_t)idx * 32 + 16 + c] = fre * bi + fim * br;
      }
    }
  }
  {
    bf16_t* SK = (bf16_t*)(ws + WS_SUBK);
    for (int idx = gtid; idx < 4 * 16 * 128 * 128; idx += gn) SK[idx] = f2bf(p.in[I_SUBK][idx]);
  }
  {
    float* tile = sm;
    constexpr int IT_IN = 4 * 16 * 48, IT_OUT = 4 * 16 * 16, IT_Q = 4 * 16 * 32;
    __syncthreads();
    for (int item = blockIdx.x; item < IT_IN + IT_OUT + IT_Q; item += gridDim.x) {
      const float* W; bf16_t* WT; int N, NP, r = item;
      if (r < IT_IN) { const int l = r / (16 * 48); r %= 16 * 48; W = p.in[I_WIN] + (size_t)l * 1024 * INC; WT = (bf16_t*)(ws + WS_WIN) + (size_t)l * INCP * 1024; N = INC; NP = 48; }
      else if (r < IT_IN + IT_OUT) { r -= IT_IN; const int l = r / 256; r %= 256; W = p.in[I_WOUT] + (size_t)l * 1024 * 1024; WT = (bf16_t*)(ws + WS_WOUT) + (size_t)l * 1024 * 1024; N = 1024; NP = 16; }
      else { r -= IT_IN + IT_OUT; const int l = r / 512; r %= 512; W = p.in[I_WQ] + (size_t)l * 1024 * 2048; WT = (bf16_t*)(ws + WS_WQ) + (size_t)l * 2048 * 1024; N = 2048; NP = 32; }
      const int kb = r / NP, nb = r % NP, k0 = kb * 64, n0 = nb * 64;
      {
        const int col = tid & 63, rr = tid >> 6;
#pragma unroll
        for (int i = 0; i < 8; ++i) { const int kk = rr + 8 * i; const int n = n0 + col; tile[kk * 65 + col] = (n < N) ? W[(size_t)(k0 + kk) * N + n] : 0.f; }
      }
      __syncthreads();
      {
        const int n = tid >> 3, kc = tid & 7; const float* s = tile + (kc * 8) * 65 + n;
        uint4 o; o.x = pk2(s[0], s[65]); o.y = pk2(s[2 * 65], s[3 * 65]); o.z = pk2(s[4 * 65], s[5 * 65]); o.w = pk2(s[6 * 65], s[7 * 65]);
        *(uint4*)(WT + (size_t)(n0 + n) * 1024 + k0 + kc * 8) = o;
      }
      __syncthreads();
    }
  }
}

__device__ void norm_mod_phase(const float* __restrict__ xsrc, const float* __restrict__ gain, const float* __restrict__ mod_sh, const float* __restrict__ mod_sc,
                               bf16_t* __restrict__ outp) {
  const int tidx = launder_tid();
  const int lane = tidx & 63, gw = blockIdx.x * NW + (tidx >> 6), nw = gridDim.x * NW;
  for (int t = gw; t < T_; t += nw) {
    const int b = t >> 13;
    const f32x4* xr = (const f32x4*)(xsrc + (size_t)t * 1024) + lane;
    f32x4 v[4]; float s = 0.f;
#pragma unroll
    for (int j = 0; j < 4; ++j) { v[j] = xr[64 * j]; s += v[j].x * v[j].x + v[j].y * v[j].y + v[j].z * v[j].z + v[j].w * v[j].w; }
    const float rstd = rsqrtf(wave_sum(s) * (1.f / 1024.f) + EPS_);
#pragma unroll
    for (int j = 0; j < 4; ++j) {
      const int c = lane * 4 + 256 * j;
      const f32x4 g = *(const f32x4*)(gain + c), sh = *(const f32x4*)(mod_sh + b * 6144 + c), sc = *(const f32x4*)(mod_sc + b * 6144 + c);
      const float o0 = v[j].x * rstd * g.x * (1.f + sc.x) + sh.x, o1 = v[j].y * rstd * g.y * (1.f + sc.y) + sh.y;
      const float o2 = v[j].z * rstd * g.z * (1.f + sc.z) + sh.z, o3 = v[j].w * rstd * g.w * (1.f + sc.w) + sh.w;
      uint2 o; o.x = pk2(o0, o1); o.y = pk2(o2, o3);
      *(uint2*)(outp + (size_t)t * 1024 + c) = o;
    }
  }
}

__device__ __forceinline__ void gemm_tile_128(const bf16_t* __restrict__ A, int lda, const bf16_t* __restrict__ Bt, int ldb, int K, unsigned char* smem, f32x4 (&acc)[4][2]) {
  const int tid = threadIdx.x, lane = tid & 63, wid = tid >> 6, wm = wid >> 2, wn = wid & 3, fr = lane & 15, fq = lane >> 4;
  bf16_t* As = (bf16_t*)smem; bf16_t* Bs = As + 128 * 72;
  const int r0 = tid >> 3, kc = tid & 7;
  const bf16_t* ap0 = A + (size_t)r0 * lda + kc * 8; const bf16_t* ap1 = ap0 + (size_t)64 * lda;
  const bf16_t* bp0 = Bt + (size_t)r0 * ldb + kc * 8; const bf16_t* bp1 = bp0 + (size_t)64 * ldb;
  uint4 ra0 = *(const uint4*)ap0, ra1 = *(const uint4*)ap1, rb0 = *(const uint4*)bp0, rb1 = *(const uint4*)bp1;
#pragma unroll
  for (int mi = 0; mi < 4; ++mi)
#pragma unroll
    for (int ni = 0; ni < 2; ++ni) acc[mi][ni] = (f32x4){0.f, 0.f, 0.f, 0.f};
  const int nk = K >> 6;
  for (int kt = 0; kt < nk; ++kt) {
    __syncthreads();
    *(uint4*)(As + r0 * 72 + kc * 8) = ra0; *(uint4*)(As + (r0 + 64) * 72 + kc * 8) = ra1;
    *(uint4*)(Bs + r0 * 72 + kc * 8) = rb0; *(uint4*)(Bs + (r0 + 64) * 72 + kc * 8) = rb1;
    __syncthreads();
    if (kt + 1 < nk) { ap0 += 64; ap1 += 64; bp0 += 64; bp1 += 64; ra0 = *(const uint4*)ap0; ra1 = *(const uint4*)ap1; rb0 = *(const uint4*)bp0; rb1 = *(const uint4*)bp1; }
#pragma unroll
    for (int ks = 0; ks < 2; ++ks) {
      bf16x8 af[4], bfr[2];
#pragma unroll
      for (int mi = 0; mi < 4; ++mi) af[mi] = *(const bf16x8*)(As + (wm * 64 + mi * 16 + fr) * 72 + ks * 32 + fq * 8);
#pragma unroll
      for (int ni = 0; ni < 2; ++ni) bfr[ni] = *(const bf16x8*)(Bs + (wn * 32 + ni * 16 + fr) * 72 + ks * 32 + fq * 8);
#pragma unroll
      for (int mi = 0; mi < 4; ++mi)
#pragma unroll
        for (int ni = 0; ni < 2; ++ni) acc[mi][ni] = __builtin_amdgcn_mfma_f32_16x16x32_bf16(bfr[ni], af[mi], acc[mi][ni], 0, 0, 0);
    }
  }
}

__device__ void gemm_proj_phase(const Params& p, int l, unsigned char* smem) {
  unsigned char* const ws = launder_ptr(p.ws); const int tidx = launder_tid(); (void)ws; (void)tidx;
  const bf16_t* A = (const bf16_t*)(ws + WS_ABUF); const bf16_t* Bt = (const bf16_t*)(ws + WS_WIN) + (size_t)l * INCP * 1024;
  bf16_t* PROJ = (bf16_t*)(ws + WS_PROJ); bf16_t* VTA = (bf16_t*)(ws + WS_VTA);
  const int lane = tidx & 63, wid = tidx >> 6, wm = wid >> 2, wn = wid & 3, fr = lane & 15, fq = lane >> 4;
  constexpr int NTL = INCP / 128;
  constexpr int NTU = 23;
  for (int u = blockIdx.x; u < 128 * NTU; u += gridDim.x) {
    const int mt = u / NTU, nt = u % NTU, m0 = mt * 128, n0 = nt * 128;
    f32x4 acc[4][2];
    gemm_tile_128(A + (size_t)m0 * 1024, 1024, Bt + (size_t)n0 * 1024, 1024, 1024, smem, acc);
#pragma unroll
    for (int mi = 0; mi < 4; ++mi)
#pragma unroll
      for (int ni = 0; ni < 2; ++ni) {
        const int t = m0 + wm * 64 + mi * 16 + fr, c = n0 + wn * 32 + ni * 16 + fq * 4;
        const f32x4 v = acc[mi][ni];
        uint2 o; o.x = pk2(v.x, v.y); o.y = pk2(v.z, v.w);
        *(uint2*)(PROJ + (size_t)t * INCP + c) = o;
        if (c >= C_VA && c < C_VA + 384) {
          const int b = t >> 13, lpos = t & 8191, ch = c - C_VA;
          bf16_t* vt = VTA + ((size_t)b * 384 + ch) * 8192 + lpos;
          vt[0] = f2bf(v.x); vt[8192] = f2bf(v.y); vt[2 * 8192] = f2bf(v.z); vt[3 * 8192] = f2bf(v.w);
        }
      }
  }
  (void)NTL;
}

__device__ void gemm_out_phase(const Params& p, int l, const float* __restrict__ xsrc, unsigned char* smem) {
  unsigned char* const ws = launder_ptr(p.ws); const int tidx = launder_tid(); (void)ws; (void)tidx;
  const bf16_t* A = (const bf16_t*)(ws + WS_ABUF); const bf16_t* Bt = (const bf16_t*)(ws + WS_WOUT) + (size_t)l * 1024 * 1024;
  float* X = (float*)(ws + WS_X); const float* g1 = (const float*)(ws + WS_MOD) + (size_t)l * 2 * 6144 + 2048;
  const int lane = tidx & 63, wid = tidx >> 6, wm = wid >> 2, wn = wid & 3, fr = lane & 15, fq = lane >> 4;
  for (int u = blockIdx.x; u < 128 * 8; u += gridDim.x) {
    const int mt = u >> 3, nt = u & 7, m0 = mt * 128, n0 = nt * 128;
    f32x4 acc[4][2];
    gemm_tile_128(A + (size_t)m0 * 1024, 1024, Bt + (size_t)n0 * 1024, 1024, 1024, smem, acc);
#pragma unroll
    for (int mi = 0; mi < 4; ++mi)
#pragma unroll
      for (int ni = 0; ni < 2; ++ni) {
        const int t = m0 + wm * 64 + mi * 16 + fr, c = n0 + wn * 32 + ni * 16 + fq * 4, b = t >> 13;
        const f32x4 xv = *(const f32x4*)(xsrc + (size_t)t * 1024 + c), g = *(const f32x4*)(g1 + b * 6144 + c);
        f32x4 o; o.x = xv.x + g.x * acc[mi][ni].x; o.y = xv.y + g.y * acc[mi][ni].y; o.z = xv.z + g.z * acc[mi][ni].z; o.w = xv.w + g.w * acc[mi][ni].w;
        *(f32x4*)(X + (size_t)t * 1024 + c) = o;
      }
  }
}

__device__ void gemm_q_phase(const Params& p, int l, unsigned char* smem) {
  unsigned char* const ws = launder_ptr(p.ws); const int tidx = launder_tid(); (void)ws; (void)tidx;
  const bf16_t* A = (const bf16_t*)(ws + WS_ABUF); const bf16_t* Bt = (const bf16_t*)(ws + WS_WQ) + (size_t)l * 2048 * 1024;
  bf16_t* Q = (bf16_t*)(ws + WS_Q);
  const int lane = tidx & 63, wid = tidx >> 6, wm = wid >> 2, wn = wid & 3, fr = lane & 15, fq = lane >> 4;
  for (int u = blockIdx.x; u < 128 * 16; u += gridDim.x) {
    const int mt = u >> 4, nt = u & 15, m0 = mt * 128, n0 = nt * 128;
    f32x4 acc[4][2];
    gemm_tile_128(A + (size_t)m0 * 1024, 1024, Bt + (size_t)n0 * 1024, 1024, 1024, smem, acc);
#pragma unroll
    for (int mi = 0; mi < 4; ++mi)
#pragma unroll
      for (int ni = 0; ni < 2; ++ni) {
        const int t = m0 + wm * 64 + mi * 16 + fr, c = n0 + wn * 32 + ni * 16 + fq * 4;
        const f32x4 v = acc[mi][ni];
        uint2 o; o.x = pk2(v.x, v.y); o.y = pk2(v.z, v.w);
        *(uint2*)(Q + (size_t)t * 2048 + c) = o;
      }
  }
}

__device__ void gemm_scores_phase(const Params& p, int l, unsigned char* smem) {
  unsigned char* const ws = launder_ptr(p.ws); const int tidx = launder_tid(); (void)ws; (void)tidx;
  const bf16_t* Q = (const bf16_t*)(ws + WS_Q); const bf16_t* SK = (const bf16_t*)(ws + WS_SUBK) + (size_t)l * 16 * 128 * 128;
  float* SC = (float*)(ws + WS_SC);
  const int lane = tidx & 63, wid = tidx >> 6, wm = wid >> 2, wn = wid & 3, fr = lane & 15, fq = lane >> 4;
  for (int u = blockIdx.x; u < 128 * 16; u += gridDim.x) {
    const int mt = u >> 4, hs = u & 15, m0 = mt * 128;
    f32x4 acc[4][2];
    gemm_tile_128(Q + (size_t)m0 * 2048 + hs * 128, 2048, SK + (size_t)hs * 128 * 128, 128, 128, smem, acc);
#pragma unroll
    for (int mi = 0; mi < 4; ++mi)
#pragma unroll
      for (int ni = 0; ni < 2; ++ni) {
        const int t = m0 + wm * 64 + mi * 16 + fr, c = hs * 128 + wn * 32 + ni * 16 + fq * 4;
        *(f32x4*)(SC + (size_t)t * 2048 + c) = acc[mi][ni];
      }
  }
}

__device__ void attn_phase(const Params& p, int l) {
  unsigned char* const ws = launder_ptr(p.ws); const int tidx = launder_tid(); (void)ws; (void)tidx;
  const bf16_t* PROJ = (const bf16_t*)(ws + WS_PROJ); const bf16_t* VTA = (const bf16_t*)(ws + WS_VTA);
  float* ATT = (float*)(ws + WS_ATT);
  const int lane = tidx & 63, fr = lane & 15, fq = lane >> 4;
  const int gw = blockIdx.x * NW + (tidx >> 6), nw = gridDim.x * NW;
  for (int task = gw; task < 256 * 24; task += nw) {
    const int item = task / 24, rb = task % 24, h = rb >> 2, qb = rb & 3;
    const int b = item >> 7, n = item & 127, t0 = b * 8192 + n * 64;
    const float* rbias = p.in[I_RELB] + ((size_t)l * 6 + h) * 513;
    const int iq = qb * 16 + fr;
    bf16x8 qf[2];
#pragma unroll
    for (int ds = 0; ds < 2; ++ds) qf[ds] = *(const bf16x8*)(PROJ + (size_t)(t0 + iq) * INCP + C_QA + h * 64 + ds * 32 + fq * 8);
    f32x4 o[4];
#pragma unroll
    for (int et = 0; et < 4; ++et) o[et] = (f32x4){0.f, 0.f, 0.f, 0.f};
    float mrun = -1e30f, lrun = 0.f;
    for (int jc = 0; jc < 9; ++jc) {
      const int m = n - 8 + jc;
      if (m < 0) continue;
      const int tk = b * 8192 + m * 64;
      float s[2][2][4];
#pragma unroll
      for (int g = 0; g < 2; ++g)
#pragma unroll
        for (int tt = 0; tt < 2; ++tt) {
          const int key = tk + 32 * g + 8 * (fr >> 2) + (fr & 3) + 4 * tt;
          const bf16_t* kp = PROJ + (size_t)key * INCP + C_KA + h * 64 + fq * 8;
          const bf16x8 k0 = *(const bf16x8*)kp, k1 = *(const bf16x8*)(kp + 32);
          f32x4 st = (f32x4){0.f, 0.f, 0.f, 0.f};
          st = __builtin_amdgcn_mfma_f32_16x16x32_bf16(k0, qf[0], st, 0, 0, 0);
          st = __builtin_amdgcn_mfma_f32_16x16x32_bf16(k1, qf[1], st, 0, 0, 0);
#pragma unroll
          for (int j = 0; j < 4; ++j) {
            const int kk = 32 * g + 8 * fq + 4 * tt + j;
            int diff = 512 + iq - (64 * jc + kk);
            diff = diff > 256 ? 256 : diff;
            s[g][tt][j] = st[j] * 0.125f + rbias[diff + 256];
          }
        }
      float mloc = -1e30f;
#pragma unroll
      for (int g = 0; g < 2; ++g)
#pragma unroll
        for (int tt = 0; tt < 2; ++tt)
#pragma unroll
          for (int j = 0; j < 4; ++j) mloc = fmaxf(mloc, s[g][tt][j]);
      mloc = fmaxf(mloc, __shfl_xor(mloc, 16)); mloc = fmaxf(mloc, __shfl_xor(mloc, 32));
      const float mnew = fmaxf(mrun, mloc), alpha = __expf(mrun - mnew);
      mrun = mnew;
      float ls = 0.f;
#pragma unroll
      for (int g = 0; g < 2; ++g)
#pragma unroll
        for (int tt = 0; tt < 2; ++tt)
#pragma unroll
          for (int j = 0; j < 4; ++j) { const float e = __expf(s[g][tt][j] - mnew); s[g][tt][j] = e; ls += e; }
      lrun = lrun * alpha + ls;
#pragma unroll
      for (int et = 0; et < 4; ++et) { o[et].x *= alpha; o[et].y *= alpha; o[et].z *= alpha; o[et].w *= alpha; }
#pragma unroll
      for (int g = 0; g < 2; ++g) {
        union { bf16x8 v; unsigned u[4]; } pf;
        pf.u[0] = pk2(s[g][0][0], s[g][0][1]); pf.u[1] = pk2(s[g][0][2], s[g][0][3]);
        pf.u[2] = pk2(s[g][1][0], s[g][1][1]); pf.u[3] = pk2(s[g][1][2], s[g][1][3]);
#pragma unroll
        for (int et = 0; et < 4; ++et) {
          const bf16x8 vf = *(const bf16x8*)(VTA + ((size_t)b * 384 + h * 64 + et * 16 + fr) * 8192 + m * 64 + 32 * g + 8 * fq);
          o[et] = __builtin_amdgcn_mfma_f32_16x16x32_bf16(vf, pf.v, o[et], 0, 0, 0);
        }
      }
    }
    lrun += __shfl_xor(lrun, 16); lrun += __shfl_xor(lrun, 32);
    const float inv = 1.f / lrun;
#pragma unroll
    for (int et = 0; et < 4; ++et) {
      f32x4 v = o[et]; v.x *= inv; v.y *= inv; v.z *= inv; v.w *= inv;
      *(f32x4*)(ATT + (size_t)(t0 + iq) * 384 + h * 64 + et * 16 + fq * 4) = v;
    }
  }
}

__device__ void mix_local_phase(const Params& p, int l, unsigned char* smem) {
  unsigned char* const ws = launder_ptr(p.ws); const int tidx = launder_tid(); (void)ws; (void)tidx;
  const bf16_t* PROJ = (const bf16_t*)(ws + WS_PROJ);
  const float* RC = (const float*)(ws + WS_ROTC); const float* RS = (const float*)(ws + WS_ROTS);
  float* YINT = (float*)(ws + WS_YINT); float* UPD = (float*)(ws + WS_UPD);
  const float* SA = (const float*)(ws + WS_SA) + (size_t)l * 16 * 64 * 2; const float* SBB = (const float*)(ws + WS_SBB) + (size_t)l * 16 * 64 * 32;
  float* SEND = (float*)(ws + WS_SEND);
  const int tid = tidx, lane = tid & 63, wid = tid >> 6;
  float* qf = (float*)smem; float* kf = qf + 64 * 65; float* vv = kf + 64 * 65; float* S = vv + 64 * 65; float* kdec = S + 64 * 65;
  float* ussm = kdec + 64;
  for (int item = blockIdx.x; item < 256; item += gridDim.x) {
    const int b = item >> 7, n = item & 127, t0 = b * 8192 + n * 64;
    for (int h = 0; h < 6; ++h) {
      const float lg = log1pf(-exp2f(-5.f - (float)h));
      __syncthreads();
#pragma unroll
      for (int r = 0; r < 4; ++r) {
        const int idx = tid + NT * r, i = idx >> 5, dd = idx & 31;
        const bf16_t* row = PROJ + (size_t)(t0 + i) * INCP;
        const float c = RC[(n * 64 + i) * 32 + dd], s = RS[(n * 64 + i) * 32 + dd];
        const float q1 = bf2f(row[C_QR + h * 64 + dd]), q2 = bf2f(row[C_QR + h * 64 + dd + 32]);
        const float k1 = bf2f(row[C_KR + h * 64 + dd]) * 0.125f, k2 = bf2f(row[C_KR + h * 64 + dd + 32]) * 0.125f;
        qf[i * 65 + dd] = q1 * c - q2 * s; qf[i * 65 + dd + 32] = q1 * s + q2 * c;
        kf[i * 65 + dd] = k1 * c - k2 * s; kf[i * 65 + dd + 32] = k1 * s + k2 * c;
        vv[i * 65 + dd] = bf2f(row[C_VR + h * 64 + dd]); vv[i * 65 + dd + 32] = bf2f(row[C_VR + h * 64 + dd + 32]);
      }
      if (tid < 64) kdec[tid] = __expf(lg * (float)(63 - tid));
      __syncthreads();
#pragma unroll 1
      for (int r = 0; r < 8; ++r) {
        const int idx = tid + NT * r, i = idx >> 6, j = idx & 63;
        float a = 0.f;
#pragma unroll 16
        for (int d = 0; d < 64; ++d) a += qf[i * 65 + d] * kf[j * 65 + d];
        const int dij = i > j ? i - j : j - i;
        S[i * 65 + j] = a * __expf(lg * (float)dij);
      }
      __syncthreads();
#pragma unroll 1
      for (int r = 0; r < 8; ++r) {
        const int idx = tid + NT * r, i = idx >> 6, e = idx & 63;
        float a = 0.f, u = 0.f;
#pragma unroll 16
        for (int j = 0; j < 64; ++j) { a += S[i * 65 + j] * vv[j * 65 + e]; u += kf[j * 65 + i] * kdec[j] * vv[j * 65 + e]; }
        YINT[(size_t)(t0 + i) * 384 + h * 64 + e] = a;
        UPD[((size_t)item * 6 + h) * 4096 + i * 64 + e] = u;
      }
    }
    __syncthreads();
    for (int gi = 0; gi < 2; ++gi) {
      const int g = wid * 2 + gi;
      float* uw = ussm + wid * 1024;
#pragma unroll 4
      for (int r = 0; r < 16; ++r) { const int idx = lane + 64 * r, i = idx >> 4, c = idx & 15; uw[idx] = bf2f(PROJ[(size_t)(t0 + i) * INCP + C_US + g * 16 + c]); }
      float bbr[16], bbi[16];
      const float* bbp = SBB + ((size_t)g * 64 + lane) * 32;
#pragma unroll
      for (int c = 0; c < 16; ++c) { bbr[c] = bbp[c]; bbi[c] = bbp[16 + c]; }
      const float are = SA[(g * 64 + lane) * 2], aim = SA[(g * 64 + lane) * 2 + 1];
      float xr = 0.f, xi = 0.f;
#pragma unroll 2
      for (int i = 0; i < 64; ++i) {
        float br = 0.f, bi = 0.f;
#pragma unroll
        for (int c = 0; c < 16; ++c) { const float u = uw[i * 16 + c]; br += bbr[c] * u; bi += bbi[c] * u; }
        const float nr = are * xr - aim * xi + br, ni = are * xi + aim * xr + bi;
        xr = nr; xi = ni;
      }
      SEND[(((size_t)item * 16 + g) * 64 + lane) * 2] = xr; SEND[(((size_t)item * 16 + g) * 64 + lane) * 2 + 1] = xi;
    }
  }
}

__device__ void scan_phase(const Params& p, int l) {
  unsigned char* const ws = launder_ptr(p.ws); const int tidx = launder_tid(); (void)ws; (void)tidx;
  const float* UPD = (const float*)(ws + WS_UPD); float* SPREV = (float*)(ws + WS_SPREV);
  const float* SEND = (const float*)(ws + WS_SEND); float* CARRY = (float*)(ws + WS_CARRY);
  const float* SA = (const float*)(ws + WS_SA) + (size_t)l * 16 * 64 * 2;
  const int gtid = blockIdx.x * NT + tidx, gn = gridDim.x * NT;
  for (int idx = gtid; idx < 2 * 6 * 4096 + 2 * 1024; idx += gn) {
    if (idx < 2 * 6 * 4096) {
      const int b = idx / (6 * 4096), r = idx % (6 * 4096), h = r >> 12;
      const float cd = __expf(64.f * log1pf(-exp2f(-5.f - (float)h)));
      float s = 0.f;
      for (int n = 0; n < NCH; ++n) {
        const size_t off = ((size_t)(b * NCH + n)) * 6 * 4096 + r;
        SPREV[off] = s;
        s = cd * s + UPD[off];
      }
    } else {
      const int r2 = idx - 2 * 6 * 4096, b = r2 >> 10, gp = r2 & 1023;
      float ar = SA[gp * 2], ai = SA[gp * 2 + 1];
#pragma unroll
      for (int q = 0; q < 6; ++q) { const float nr = ar * ar - ai * ai, ni = 2.f * ar * ai; ar = nr; ai = ni; }
      float xr = 0.f, xi = 0.f;
      for (int n = 0; n < NCH; ++n) {
        const size_t off = (((size_t)(b * NCH + n)) * 1024 + gp) * 2;
        CARRY[off] = xr; CARRY[off + 1] = xi;
        const float sr = SEND[off], si = SEND[off + 1];
        const float nr = ar * xr - ai * xi + sr, ni = ar * xi + ai * xr + si;
        xr = nr; xi = ni;
      }
    }
  }
}

__device__ void mix_final_phase(const Params& p, int l, unsigned char* smem) {
  unsigned char* const ws = launder_ptr(p.ws); const int tidx = launder_tid(); (void)ws; (void)tidx;
  const bf16_t* PROJ = (const bf16_t*)(ws + WS_PROJ);
  const float* RC = (const float*)(ws + WS_ROTC); const float* RS = (const float*)(ws + WS_ROTS);
  const float* YINT = (const float*)(ws + WS_YINT); const float* SPREV = (const float*)(ws + WS_SPREV);
  const float* ATT = (const float*)(ws + WS_ATT);
  const float* SA = (const float*)(ws + WS_SA) + (size_t)l * 16 * 64 * 2; const float* SBB = (const float*)(ws + WS_SBB) + (size_t)l * 16 * 64 * 32;
  const float* CARRY = (const float*)(ws + WS_CARRY);
  const float* cre = p.in[I_CRE] + (size_t)l * 16 * 16 * 64; const float* cim = p.in[I_CIM] + (size_t)l * 16 * 16 * 64;
  const float* dsk = p.in[I_SSMD] + (size_t)l * 256; const float* wglu = p.in[I_WGLU] + (size_t)l * 256 * 512;
  const float* mg = p.in[I_MGAIN] + (size_t)l * 1024;
  bf16_t* MRG = (bf16_t*)(ws + WS_ABUF);
  const int tid = tidx, lane = tid & 63, wid = tid >> 6;
  float* qf = (float*)smem; float* sp = qf + 64 * 65; float* Y = sp + 64 * 64;
  float* YS = (float*)smem;
  float* wv = (float*)(smem + 64 * 257 * 4);
  for (int item = blockIdx.x; item < 256; item += gridDim.x) {
    const int b = item >> 7, n = item & 127, t0 = b * 8192 + n * 64;
    for (int ii = 0; ii < 8; ++ii) {
      const int t = t0 + wid * 8 + ii;
      float v[6]; float s = 0.f;
#pragma unroll
      for (int j = 0; j < 6; ++j) { v[j] = ATT[(size_t)t * 384 + lane + 64 * j]; s += v[j] * v[j]; }
      const float rstd = rsqrtf(wave_sum(s) * (1.f / 384.f) + EPS_);
#pragma unroll
      for (int j = 0; j < 6; ++j) MRG[(size_t)t * 1024 + lane + 64 * j] = f2bf(v[j] * rstd * mg[lane + 64 * j]);
    }
    for (int h = 0; h < 6; ++h) {
      const float lg = log1pf(-exp2f(-5.f - (float)h));
      __syncthreads();
#pragma unroll
      for (int r = 0; r < 4; ++r) {
        const int idx = tid + NT * r, i = idx >> 5, dd = idx & 31;
        const bf16_t* row = PROJ + (size_t)(t0 + i) * INCP;
        const float c = RC[(n * 64 + i) * 32 + dd], s = RS[(n * 64 + i) * 32 + dd];
        const float q1 = bf2f(row[C_QR + h * 64 + dd]), q2 = bf2f(row[C_QR + h * 64 + dd + 32]);
        qf[i * 65 + dd] = q1 * c - q2 * s; qf[i * 65 + dd + 32] = q1 * s + q2 * c;
      }
#pragma unroll
      for (int r = 0; r < 8; ++r) { const int idx = tid + NT * r; sp[idx] = SPREV[((size_t)item * 6 + h) * 4096 + idx]; }
      __syncthreads();
#pragma unroll 1
      for (int r = 0; r < 8; ++r) {
        const int idx = tid + NT * r, i = idx >> 6, e = idx & 63;
        float a = 0.f;
#pragma unroll 16
        for (int d = 0; d < 64; ++d) a += qf[i * 65 + d] * sp[d * 64 + e];
        Y[i * 65 + e] = YINT[(size_t)(t0 + i) * 384 + h * 64 + e] + __expf(lg * (float)(i + 1)) * a;
      }
      __syncthreads();
      for (int ii = 0; ii < 8; ++ii) {
        const int i = wid * 8 + ii, t = t0 + i;
        const float v = Y[i * 65 + lane];
        const float mu = wave_sum(v) * (1.f / 64.f);
        const float dv = v - mu;
        const float var = wave_sum(dv * dv) * (1.f / 64.f);
        const float gte = bf2f(PROJ[(size_t)t * INCP + C_GR + h * 64 + lane]);
        const float o = dv * rsqrtf(var + EPS_) * (gte * sigmoid_f(gte));
        MRG[(size_t)t * 1024 + 384 + h * 64 + lane] = f2bf(o * mg[384 + h * 64 + lane]);
      }
    }
    __syncthreads();
    for (int gi = 0; gi < 2; ++gi) {
      const int g = wid * 2 + gi;
      float* uw = wv + wid * 2048; float* xre = uw + 1024; float* xim = xre + 512;
#pragma unroll 4
      for (int r = 0; r < 16; ++r) { const int idx = lane + 64 * r, i = idx >> 4, c = idx & 15; uw[idx] = bf2f(PROJ[(size_t)(t0 + i) * INCP + C_US + g * 16 + c]); }
      float bbr[16], bbi[16];
      const float* bbp = SBB + ((size_t)g * 64 + lane) * 32;
#pragma unroll
      for (int c = 0; c < 16; ++c) { bbr[c] = bbp[c]; bbi[c] = bbp[16 + c]; }
      const float are = SA[(g * 64 + lane) * 2], aim = SA[(g * 64 + lane) * 2 + 1];
      float xr = CARRY[(((size_t)item * 16 + g) * 64 + lane) * 2], xi = CARRY[(((size_t)item * 16 + g) * 64 + lane) * 2 + 1];
      const int i8 = lane >> 3, c0 = (lane & 7) * 2;
      const float* cr0 = cre + ((size_t)g * 16 + c0) * 64; const float* ci0 = cim + ((size_t)g * 16 + c0) * 64;
#pragma unroll 1
      for (int blk = 0; blk < 8; ++blk) {
#pragma unroll 2
        for (int ii = 0; ii < 8; ++ii) {
          const int i = blk * 8 + ii;
          float br = 0.f, bi = 0.f;
#pragma unroll
          for (int c = 0; c < 16; ++c) { const float u = uw[i * 16 + c]; br += bbr[c] * u; bi += bbi[c] * u; }
          const float nr = are * xr - aim * xi + br, ni = are * xi + aim * xr + bi;
          xr = nr; xi = ni;
          xre[ii * 64 + lane] = xr; xim[ii * 64 + lane] = xi;
        }
        float a0 = 0.f, a1 = 0.f;
#pragma unroll 4
        for (int pp = 0; pp < 64; ++pp) {
          const float vr = xre[i8 * 64 + pp], vi = xim[i8 * 64 + pp];
          a0 += cr0[pp] * vr - ci0[pp] * vi;
          a1 += cr0[64 + pp] * vr - ci0[64 + pp] * vi;
        }
        const int i = blk * 8 + i8;
        const float y0 = a0 + dsk[g * 16 + c0] * uw[i * 16 + c0], y1 = a1 + dsk[g * 16 + c0 + 1] * uw[i * 16 + c0 + 1];
        YS[i * 257 + g * 16 + c0] = gelu_tanh(y0); YS[i * 257 + g * 16 + c0 + 1] = gelu_tanh(y1);
      }
    }
    __syncthreads();
    {
      const int nn = tid & 255, half = tid >> 8;
      float* OUTS = wv;
#pragma unroll 1
      for (int ps = 0; ps < 2; ++ps) {
        const int ib = half * 32 + ps * 16;
        float z1[16], z2[16];
#pragma unroll
        for (int i = 0; i < 16; ++i) { z1[i] = 0.f; z2[i] = 0.f; }
#pragma unroll 2
        for (int k = 0; k < 256; ++k) {
          const float w1 = wglu[(size_t)k * 512 + nn], w2 = wglu[(size_t)k * 512 + 256 + nn];
#pragma unroll
          for (int i = 0; i < 16; ++i) { const float yv = YS[(ib + i) * 257 + k]; z1[i] += yv * w1; z2[i] += yv * w2; }
        }
#pragma unroll
        for (int i = 0; i < 16; ++i) OUTS[(ib + i) * 256 + nn] = z1[i] * sigmoid_f(z2[i]);
      }
      __syncthreads();
      for (int ii = 0; ii < 8; ++ii) {
        const int i = wid * 8 + ii, t = t0 + i;
        float v[4]; float s = 0.f;
#pragma unroll
        for (int j = 0; j < 4; ++j) { v[j] = OUTS[i * 256 + lane + 64 * j]; s += v[j] * v[j]; }
        const float rstd = rsqrtf(wave_sum(s) * (1.f / 256.f) + EPS_);
#pragma unroll
        for (int j = 0; j < 4; ++j) MRG[(size_t)t * 1024 + 768 + lane + 64 * j] = f2bf(v[j] * rstd * mg[768 + lane + 64 * j]);
      }
    }
    __syncthreads();
  }
}

__device__ void topk_phase(const Params& p, unsigned char* smem) {
  unsigned char* const ws = launder_ptr(p.ws); const int tidx = launder_tid(); (void)ws; (void)tidx;
  const float* SC = (const float*)(ws + WS_SC); int* EIDX = (int*)(ws + WS_EIDX); float* EGATE = (float*)(ws + WS_EGATE);
  const int lane = tidx & 63, wid = tidx >> 6;
  const int gw = blockIdx.x * NW + wid, nw = gridDim.x * NW;
  float* tops = (float*)smem + wid * 512; int* topi = (int*)(tops + 256);
  for (int t = gw; t < T_; t += nw) {
    const float* sc = SC + (size_t)t * 2048;
    for (int hs = 0; hs < 16; ++hs) {
      float v0 = sc[hs * 128 + lane], v1 = sc[hs * 128 + 64 + lane];
      float ms = 0.f; int mi = 0;
      for (int it = 0; it < 16; ++it) {
        const float m = fmaxf(v0, v1);
        const float wmx = wave_max(m);
        const unsigned long long bal = __ballot(m == wmx);
        const int src = __ffsll((long long)bal) - 1;
        const int slot = (v0 == wmx) ? 0 : 1;
        const int sslot = __shfl(slot, src);
        if (lane == src) { if (sslot == 0) v0 = -3.0e38f; else v1 = -3.0e38f; }
        if (lane == it) { ms = wmx; mi = src + 64 * sslot; }
      }
      if (lane < 16) { tops[hs * 16 + lane] = ms; topi[hs * 16 + lane] = mi; }
    }
    for (int h = 0; h < 8; ++h) {
      const float a = tops[(2 * h) * 16 + (lane >> 2)];
      float c0 = a + tops[(2 * h + 1) * 16 + (lane & 3) * 4 + 0], c1 = a + tops[(2 * h + 1) * 16 + (lane & 3) * 4 + 1];
      float c2 = a + tops[(2 * h + 1) * 16 + (lane & 3) * 4 + 2], c3 = a + tops[(2 * h + 1) * 16 + (lane & 3) * 4 + 3];
      float bs = 0.f; int bc = 0;
      for (int it = 0; it < 16; ++it) {
        const float m = fmaxf(fmaxf(c0, c1), fmaxf(c2, c3));
        const float wmx = wave_max(m);
        const unsigned long long bal = __ballot(m == wmx);
        const int src = __ffsll((long long)bal) - 1;
        const int slot = (c0 == wmx) ? 0 : ((c1 == wmx) ? 1 : ((c2 == wmx) ? 2 : 3));
        const int sslot = __shfl(slot, src);
        if (lane == src) { if (sslot == 0) c0 = -3.0e38f; else if (sslot == 1) c1 = -3.0e38f; else if (sslot == 2) c2 = -3.0e38f; else c3 = -3.0e38f; }
        if (lane == it) { bs = wmx; bc = src * 4 + sslot; }
      }
      const float mx = __shfl(bs, 0);
      const float e = (lane < 16) ? __expf(bs - mx) : 0.f;
      const float sum = wave_sum(e);
      if (lane < 16) {
        const int i = bc >> 4, j = bc & 15;
        EIDX[(size_t)t * 128 + h * 16 + lane] = topi[(2 * h) * 16 + i] * 128 + topi[(2 * h + 1) * 16 + j];
        EGATE[(size_t)t * 128 + h * 16 + lane] = e / sum;
      }
    }
  }
}

__device__ void peer_phase(const Params& p, int l, bool last) {
  unsigned char* const ws = launder_ptr(p.ws); const int tidx = launder_tid(); (void)ws; (void)tidx;
  const bf16_t* HF = (const bf16_t*)(ws + WS_ABUF); float* X = (float*)(ws + WS_X);
  const int* EIDX = (const int*)(ws + WS_EIDX); const float* EGATE = (const float*)(ws + WS_EGATE);
  const float* U = p.in[I_PU] + (size_t)l * 16384 * 1024; const float* V = p.in[I_PV] + (size_t)l * 16384 * 1024;
  const float* g2 = (const float*)(ws + WS_MOD) + (size_t)l * 2 * 6144 + 5120;
  const int lane = tidx & 63, gw = blockIdx.x * NW + (tidx >> 6), nw = gridDim.x * NW;
  for (int t = gw; t < T_; t += nw) {
    const int b = t >> 13;
    float hv[16];
#pragma unroll
    for (int j = 0; j < 4; ++j) {
      const uint2 r = *(const uint2*)(HF + (size_t)t * 1024 + lane * 4 + 256 * j);
      hv[4 * j] = __uint_as_float(r.x << 16); hv[4 * j + 1] = __uint_as_float(r.x & 0xffff0000u);
      hv[4 * j + 2] = __uint_as_float(r.y << 16); hv[4 * j + 3] = __uint_as_float(r.y & 0xffff0000u);
    }
    const int e0 = EIDX[(size_t)t * 128 + lane], e1 = EIDX[(size_t)t * 128 + 64 + lane];
    const float g0 = EGATE[(size_t)t * 128 + lane], g1 = EGATE[(size_t)t * 128 + 64 + lane];
    float acc[16];
#pragma unroll
    for (int j = 0; j < 16; ++j) acc[j] = 0.f;
#pragma unroll 2
    for (int k = 0; k < 128; ++k) {
      const int idx = __shfl((k < 64) ? e0 : e1, k & 63);
      const float gt = __shfl((k < 64) ? g0 : g1, k & 63);
      const f32x4* ur = (const f32x4*)(U + (size_t)idx * 1024) + lane;
      const f32x4* vr = (const f32x4*)(V + (size_t)idx * 1024) + lane;
      f32x4 uu[4], vq[4];
#pragma unroll
      for (int j = 0; j < 4; ++j) { uu[j] = ur[64 * j]; vq[j] = vr[64 * j]; }
      float d = 0.f;
#pragma unroll
      for (int j = 0; j < 4; ++j) d += uu[j].x * hv[4 * j] + uu[j].y * hv[4 * j + 1] + uu[j].z * hv[4 * j + 2] + uu[j].w * hv[4 * j + 3];
      d = wave_sum(d);
      const float w = gt * gelu_tanh(d);
#pragma unroll
      for (int j = 0; j < 4; ++j) { acc[4 * j] += w * vq[j].x; acc[4 * j + 1] += w * vq[j].y; acc[4 * j + 2] += w * vq[j].z; acc[4 * j + 3] += w * vq[j].w; }
    }
    float xn[16]; float ss = 0.f;
#pragma unroll
    for (int j = 0; j < 4; ++j) {
      const int c = lane * 4 + 256 * j;
      const f32x4 xv = *(const f32x4*)(X + (size_t)t * 1024 + c), g = *(const f32x4*)(g2 + b * 6144 + c);
      xn[4 * j] = xv.x + g.x * acc[4 * j]; xn[4 * j + 1] = xv.y + g.y * acc[4 * j + 1]; xn[4 * j + 2] = xv.z + g.z * acc[4 * j + 2]; xn[4 * j + 3] = xv.w + g.w * acc[4 * j + 3];
      ss += xn[4 * j] * xn[4 * j] + xn[4 * j + 1] * xn[4 * j + 1] + xn[4 * j + 2] * xn[4 * j + 2] + xn[4 * j + 3] * xn[4 * j + 3];
    }
    if (!last) {
#pragma unroll
      for (int j = 0; j < 4; ++j) *(f32x4*)(X + (size_t)t * 1024 + lane * 4 + 256 * j) = (f32x4){xn[4 * j], xn[4 * j + 1], xn[4 * j + 2], xn[4 * j + 3]};
    } else {
      const float rstd = rsqrtf(wave_sum(ss) * (1.f / 1024.f) + EPS_);
#pragma unroll
      for (int j = 0; j < 4; ++j) {
        const int c = lane * 4 + 256 * j;
        const f32x4 fn = *(const f32x4*)(p.in[I_FNORM] + c);
        *(f32x4*)(p.out + (size_t)t * 1024 + c) = (f32x4){xn[4 * j] * rstd * fn.x, xn[4 * j + 1] * rstd * fn.y, xn[4 * j + 2] * rstd * fn.z, xn[4 * j + 3] * rstd * fn.w};
      }
    }
  }
}

__global__ void __launch_bounds__(NT) fwd_megakernel(Params p) {
  extern __shared__ __attribute__((aligned(16))) unsigned char smem[];
  cg::grid_group grid = cg::this_grid();
  setup_phase(p, smem);
  grid.sync();
  const float* MOD = (const float*)(p.ws + WS_MOD);
  for (int l = 0; l < DEPTH_; ++l) {
    const float* xsrc = (l == 0) ? p.in[I_X] : (const float*)(p.ws + WS_X);
    const float* modl = MOD + (size_t)l * 2 * 6144;
    norm_mod_phase(xsrc, p.in[I_NMIX] + (size_t)l * 1024, modl + 0, modl + 1024, (bf16_t*)(p.ws + WS_ABUF));
    grid.sync();
    gemm_proj_phase(p, l, smem);
    grid.sync();
    attn_phase(p, l);
    mix_local_phase(p, l, smem);
    grid.sync();
    scan_phase(p, l);
    grid.sync();
    mix_final_phase(p, l, smem);
    grid.sync();
    gemm_out_phase(p, l, xsrc, smem);
    grid.sync();
    norm_mod_phase((const float*)(p.ws + WS_X), p.in[I_NFFN] + (size_t)l * 1024, modl + 3072, modl + 4096, (bf16_t*)(p.ws + WS_ABUF));
    grid.sync();
    gemm_q_phase(p, l, smem);
    grid.sync();
    gemm_scores_phase(p, l, smem);
    grid.sync();
    topk_phase(p, smem);
    grid.sync();
    peer_phase(p, l, l == DEPTH_ - 1);
    grid.sync();
  }
}

extern "C" void kernel_launch(void* const* d_in, const int* in_sizes, int n_in,
                              void* d_out, int out_size, void* d_ws, size_t ws_size,
                              hipStream_t stream) {
  static int grid_blocks = 0;
  if (grid_blocks == 0) {
    if (n_in != 24 || ws_size < WS_END) { fprintf(stderr, "kernel_launch: unexpected n_in %d / ws_size %zu (need %zu)\n", n_in, ws_size, (size_t)WS_END); grid_blocks = -1; return; }
    int dev = 0, cus = 0, per_cu = 0;
    if (hipGetDevice(&dev) != hipSuccess || hipDeviceGetAttribute(&cus, hipDeviceAttributeMultiprocessorCount, dev) != hipSuccess) { grid_blocks = -1; return; }
    if (hipFuncSetAttribute((const void*)fwd_megakernel, hipFuncAttributeMaxDynamicSharedMemorySize, LDS_BYTES) != hipSuccess) { fprintf(stderr, "hipFuncSetAttribute failed\n"); grid_blocks = -1; return; }
    if (hipOccupancyMaxActiveBlocksPerMultiprocessor(&per_cu, (const void*)fwd_megakernel, NT, LDS_BYTES) != hipSuccess || per_cu < 1) { fprintf(stderr, "occupancy query: %d\n", per_cu); grid_blocks = -1; return; }
    grid_blocks = cus;
  }
  if (grid_blocks < 0) return;
  Params p{};
  for (int i = 0; i < 24; ++i) p.in[i] = (const float*)d_in[i];
  p.out = (float*)d_out; p.ws = (unsigned char*)d_ws;
  void* args[] = {&p};
  hipError_t e = hipLaunchCooperativeKernel((void*)fwd_megakernel, dim3(grid_blocks), dim3(NT), args, LDS_BYTES, stream);
  if (e != hipSuccess) fprintf(stderr, "cooperative launch failed: %s (grid %d)\n", hipGetErrorString(e), grid_blocks);
}
```

```cpp
#include <hip/hip_runtime.h>
#include <hip/hip_cooperative_groups.h>
#include <cstdio>
#include <cstdint>
namespace cg = cooperative_groups;

typedef unsigned short bf16_t;
typedef short bf16x8 __attribute__((ext_vector_type(8)));
typedef float f32x4 __attribute__((ext_vector_type(4)));

constexpr int T_ = 16384, D_ = 1024, L_ = 8192, NBATCH = 2, DEPTH_ = 4;
constexpr int INC = 2944, INCP = 3072;
constexpr int NCH = 128;
constexpr int NT = 512;
constexpr int NW = 8;
constexpr float EPS_ = 1e-6f;
constexpr int C_QA = 0, C_KA = 384, C_VA = 768, C_QR = 1152, C_KR = 1536, C_VR = 1920, C_GR = 2304, C_US = 2688;

constexpr size_t al256(size_t x) { return (x + 255) & ~(size_t)255; }
constexpr size_t WS_MOD   = 0;
constexpr size_t WS_ROTC  = al256(WS_MOD + 4ull * 2 * 6144 * 4);
constexpr size_t WS_ROTS  = al256(WS_ROTC + 8192ull * 32 * 4);
constexpr size_t WS_SA    = al256(WS_ROTS + 8192ull * 32 * 4);
constexpr size_t WS_SBB   = al256(WS_SA + 4ull * 16 * 64 * 2 * 4);
constexpr size_t WS_WIN   = al256(WS_SBB + 4ull * 16 * 64 * 32 * 4);
constexpr size_t WS_WOUT  = al256(WS_WIN + 4ull * INCP * 1024 * 2);
constexpr size_t WS_WQ    = al256(WS_WOUT + 4ull * 1024 * 1024 * 2);
constexpr size_t WS_SUBK  = al256(WS_WQ + 4ull * 2048 * 1024 * 2);
constexpr size_t WS_ABUF  = al256(WS_SUBK + 4ull * 16 * 128 * 128 * 2);
constexpr size_t WS_PROJ  = al256(WS_ABUF + (size_t)T_ * 1024 * 2);
constexpr size_t WS_VTA   = al256(WS_PROJ + (size_t)T_ * INCP * 2);
constexpr size_t WS_ATT   = al256(WS_VTA + 2ull * 6 * 64 * 8192 * 2);
constexpr size_t WS_YINT  = al256(WS_ATT + (size_t)T_ * 384 * 4);
constexpr size_t WS_UPD   = al256(WS_YINT + (size_t)T_ * 384 * 4);
constexpr size_t WS_SPREV = al256(WS_UPD + 256ull * 6 * 4096 * 4);
constexpr size_t WS_SEND  = al256(WS_SPREV + 256ull * 6 * 4096 * 4);
constexpr size_t WS_CARRY = al256(WS_SEND + 256ull * 16 * 64 * 2 * 4);
constexpr size_t WS_X     = al256(WS_CARRY + 256ull * 16 * 64 * 2 * 4);
constexpr size_t WS_Q     = al256(WS_X + (size_t)T_ * 1024 * 4);
constexpr size_t WS_SC    = al256(WS_Q + (size_t)T_ * 2048 * 2);
constexpr size_t WS_EIDX  = al256(WS_SC + (size_t)T_ * 2048 * 4);
constexpr size_t WS_EGATE = al256(WS_EIDX + (size_t)T_ * 128 * 4);
constexpr size_t WS_PU8   = al256(WS_EGATE + (size_t)T_ * 128 * 4);
constexpr size_t WS_PV8   = al256(WS_PU8 + 4ull * 16384 * 1024);
constexpr size_t WS_BAR   = al256(WS_PV8 + 4ull * 16384 * 1024);
constexpr size_t WS_END   = al256(WS_BAR + 3456ull * 4);

constexpr int LDS_BYTES = 135168;

struct Params {
  const float* in[24];
  float* out;
  unsigned char* ws;
};
enum { I_X = 0, I_C, I_WADA, I_BADA, I_NMIX, I_NFFN, I_WIN, I_RELB, I_LRE, I_LIM, I_LOGDT, I_BRE, I_BIM, I_CRE, I_CIM, I_SSMD,
       I_WGLU, I_MGAIN, I_WOUT, I_WQ, I_SUBK, I_PU, I_PV, I_FNORM };

__device__ __forceinline__ float bf2f(bf16_t v) { return __uint_as_float(((unsigned)v) << 16); }
__device__ __forceinline__ bf16_t f2bf(float f) { unsigned u = __float_as_uint(f); u += 0x7fffu + ((u >> 16) & 1u); return (bf16_t)(u >> 16); }
__device__ __forceinline__ unsigned pk2(float a, float b) { return (unsigned)f2bf(a) | ((unsigned)f2bf(b) << 16); }
__device__ __forceinline__ float wave_sum(float v) {
#pragma unroll
  for (int o = 32; o > 0; o >>= 1) v += __shfl_xor(v, o);
  return v;
}
__device__ __forceinline__ float wave_max(float v) {
#pragma unroll
  for (int o = 32; o > 0; o >>= 1) v = fmaxf(v, __shfl_xor(v, o));
  return v;
}
__device__ __forceinline__ float gelu_tanh(float x) { const float u = 0.7978845608028654f * (x + 0.044715f * x * x * x); return 0.5f * x * (1.f + tanhf(u)); }
__device__ __forceinline__ float sigmoid_f(float x) { return 1.f / (1.f + __expf(-x)); }
__device__ __forceinline__ unsigned char* launder_ptr(unsigned char* q) { asm volatile("" : "+s"(q)); return q; }
__device__ __forceinline__ const float* launder_cptr(const float* q) { asm volatile("" : "+s"(q)); return q; }
__device__ __forceinline__ int launder_tid() { int t = threadIdx.x; asm volatile("" : "+v"(t)); return t; }

__device__ void setup_phase(const Params& p, unsigned char* smem) {
  unsigned char* const ws = launder_ptr(p.ws); const int tidx = launder_tid(); (void)ws; (void)tidx;
  const int tid = tidx;
  float* sm = (float*)smem;
  {
    float* cond = sm;
    float* red = sm + 2048;
    float* MOD = (float*)(ws + WS_MOD);
    for (int i = tid; i < 2048; i += NT) { const float c = p.in[I_C][i]; cond[i] = c * sigmoid_f(c); }
    __syncthreads();
    for (int item = blockIdx.x; item < 4 * 96; item += gridDim.x) {
      const int l = item / 96, cb = item % 96, kq = tid >> 6, jj = tid & 63, j = cb * 64 + jj;
      const float* w = p.in[I_WADA] + (size_t)l * 1024 * 6144 + j;
      float a0 = 0.f, a1 = 0.f;
      for (int k = kq * 128; k < kq * 128 + 128; ++k) { const float wv = w[(size_t)k * 6144]; a0 += cond[k] * wv; a1 += cond[1024 + k] * wv; }
      red[(kq * 2 + 0) * 64 + jj] = a0; red[(kq * 2 + 1) * 64 + jj] = a1;
      __syncthreads();
      if (tid < 128) {
        const int b = tid >> 6, j2 = tid & 63; float s = 0.f;
        for (int q = 0; q < 8; ++q) s += red[(q * 2 + b) * 64 + j2];
        MOD[((size_t)l * 2 + b) * 6144 + cb * 64 + j2] = s + p.in[I_BADA][(size_t)l * 6144 + cb * 64 + j2];
      }
      __syncthreads();
    }
  }
  const int gtid = blockIdx.x * NT + tid, gn = gridDim.x * NT;
  {
    float* RC = (float*)(ws + WS_ROTC); float* RS = (float*)(ws + WS_ROTS);
    for (int idx = gtid; idx < 8192 * 32; idx += gn) {
      const int pos = idx >> 5, i = idx & 31;
      const float inv = powf(10000.0f, -(float)i / 32.0f);
      const float ang = (float)pos * inv;
      float s, c; sincosf(ang, &s, &c);
      RC[idx] = c; RS[idx] = s;
    }
  }
  {
    float* SA = (float*)(ws + WS_SA); float* SBB = (float*)(ws + WS_SBB);
    for (int idx = gtid; idx < 4 * 16 * 64; idx += gn) {
      const int l = idx / 1024, g = (idx >> 6) & 15;
      const float dt = expf(p.in[I_LOGDT][l * 16 + g]);
      const float lr = p.in[I_LRE][idx], li = p.in[I_LIM][idx];
      const float mag = expf(lr * dt);
      float sn, cs; sincosf(li * dt, &sn, &cs);
      const float are = mag * cs, aim = mag * sn;
      const float den = lr * lr + li * li, nr = are - 1.f, ni = aim;
      const float fre = (nr * lr + ni * li) / den, fim = (ni * lr - nr * li) / den;
      SA[idx * 2] = are; SA[idx * 2 + 1] = aim;
      for (int c = 0; c < 16; ++c) {
        const float br = p.in[I_BRE][(size_t)idx * 16 + c], bi = p.in[I_BIM][(size_t)idx * 16 + c];
        SBB[(size_t)idx * 32 + c] = fre * br - fim * bi;
        SBB[(size_t)idx * 32 + 16 + c] = fre * bi + fim * br;
      }
    }
  }
  {
    bf16_t* SK = (bf16_t*)(ws + WS_SUBK);
    for (int idx = gtid; idx < 4 * 16 * 128 * 128; idx += gn) SK[idx] = f2bf(p.in[I_SUBK][idx]);
  }
  {
    constexpr size_t NIT = 4ull * 16384 * 1024 / 16;
    for (size_t it = gtid; it < 2 * NIT; it += gn) {
      const int tb = it >= NIT ? 1 : 0; const size_t r = it - (size_t)tb * NIT;
      const f32x4* src = (const f32x4*)((tb ? p.in[I_PV] : p.in[I_PU]) + r * 16);
      const float sc = tb ? 64.f : 1024.f;
      unsigned o[4];
#pragma unroll
      for (int q = 0; q < 4; ++q) {
        const f32x4 a = src[q];
        const float x0 = fminf(fmaxf(a.x * sc, -448.f), 448.f), x1 = fminf(fmaxf(a.y * sc, -448.f), 448.f);
        const float x2 = fminf(fmaxf(a.z * sc, -448.f), 448.f), x3 = fminf(fmaxf(a.w * sc, -448.f), 448.f);
        int pk = __builtin_amdgcn_cvt_pk_fp8_f32(x0, x1, 0, false);
        pk = __builtin_amdgcn_cvt_pk_fp8_f32(x2, x3, pk, true);
        o[q] = (unsigned)pk;
      }
      *(uint4*)(ws + (tb ? WS_PV8 : WS_PU8) + r * 16) = make_uint4(o[0], o[1], o[2], o[3]);
    }
  }
  {
    float* tile = sm;
    constexpr int IT_IN = 4 * 16 * 48, IT_OUT = 4 * 16 * 16, IT_Q = 4 * 16 * 32;
    __syncthreads();
    for (int item = blockIdx.x; item < IT_IN + IT_OUT + IT_Q; item += gridDim.x) {
      const float* W; bf16_t* WT; int N, NP, r = item;
      if (r < IT_IN) { const int l = r / (16 * 48); r %= 16 * 48; W = p.in[I_WIN] + (size_t)l * 1024 * INC; WT = (bf16_t*)(ws + WS_WIN) + (size_t)l * INCP * 1024; N = INC; NP = 48; }
      else if (r < IT_IN + IT_OUT) { r -= IT_IN; const int l = r / 256; r %= 256; W = p.in[I_WOUT] + (size_t)l * 1024 * 1024; WT = (bf16_t*)(ws + WS_WOUT) + (size_t)l * 1024 * 1024; N = 1024; NP = 16; }
      else { r -= IT_IN + IT_OUT; const int l = r / 512; r %= 512; W = p.in[I_WQ] + (size_t)l * 1024 * 2048; WT = (bf16_t*)(ws + WS_WQ) + (size_t)l * 2048 * 1024; N = 2048; NP = 32; }
      const int kb = r / NP, nb = r % NP, k0 = kb * 64, n0 = nb * 64;
      {
        const int col = tid & 63, rr = tid >> 6;
#pragma unroll
        for (int i = 0; i < 8; ++i) { const int kk = rr + 8 * i; const int n = n0 + col; tile[kk * 65 + col] = (n < N) ? W[(size_t)(k0 + kk) * N + n] : 0.f; }
      }
      __syncthreads();
      {
        const int n = tid >> 3, kc = tid & 7; const float* s = tile + (kc * 8) * 65 + n;
        uint4 o; o.x = pk2(s[0], s[65]); o.y = pk2(s[2 * 65], s[3 * 65]); o.z = pk2(s[4 * 65], s[5 * 65]); o.w = pk2(s[6 * 65], s[7 * 65]);
        *(uint4*)(WT + (size_t)(n0 + n) * 1024 + k0 + kc * 8) = o;
      }
      __syncthreads();
    }
  }
}

__device__ void norm_mod_phase(const float* __restrict__ xsrc, const float* __restrict__ gain, const float* __restrict__ mod_sh, const float* __restrict__ mod_sc,
                               bf16_t* __restrict__ outp) {
  const int tidx = launder_tid();
  const int lane = tidx & 63, gw = blockIdx.x * NW + (tidx >> 6), nw = gridDim.x * NW;
  for (int t = gw; t < T_; t += nw) {
    const int b = t >> 13;
    const f32x4* xr = (const f32x4*)(xsrc + (size_t)t * 1024) + lane;
    f32x4 v[4]; float s = 0.f;
#pragma unroll
    for (int j = 0; j < 4; ++j) { v[j] = xr[64 * j]; s += v[j].x * v[j].x + v[j].y * v[j].y + v[j].z * v[j].z + v[j].w * v[j].w; }
    const float rstd = rsqrtf(wave_sum(s) * (1.f / 1024.f) + EPS_);
#pragma unroll
    for (int j = 0; j < 4; ++j) {
      const int c = lane * 4 + 256 * j;
      const f32x4 g = *(const f32x4*)(gain + c), sh = *(const f32x4*)(mod_sh + b * 6144 + c), sc = *(const f32x4*)(mod_sc + b * 6144 + c);
      const float o0 = v[j].x * rstd * g.x * (1.f + sc.x) + sh.x, o1 = v[j].y * rstd * g.y * (1.f + sc.y) + sh.y;
      const float o2 = v[j].z * rstd * g.z * (1.f + sc.z) + sh.z, o3 = v[j].w * rstd * g.w * (1.f + sc.w) + sh.w;
      uint2 o; o.x = pk2(o0, o1); o.y = pk2(o2, o3);
      *(uint2*)(outp + (size_t)t * 1024 + c) = o;
    }
  }
}

__device__ __forceinline__ void gemm_tile_128(const bf16_t* __restrict__ A, int lda, const bf16_t* __restrict__ Bt, int ldb, int K, unsigned char* smem, f32x4 (&acc)[4][2]) {
  const int tid = threadIdx.x, lane = tid & 63, wid = tid >> 6, wm = wid >> 2, wn = wid & 3, fr = lane & 15, fq = lane >> 4;
  bf16_t* As = (bf16_t*)smem; bf16_t* Bs = As + 128 * 72;
  const int r0 = tid >> 3, kc = tid & 7;
  const bf16_t* ap0 = A + (size_t)r0 * lda + kc * 8; const bf16_t* ap1 = ap0 + (size_t)64 * lda;
  const bf16_t* bp0 = Bt + (size_t)r0 * ldb + kc * 8; const bf16_t* bp1 = bp0 + (size_t)64 * ldb;
  uint4 ra0 = *(const uint4*)ap0, ra1 = *(const uint4*)ap1, rb0 = *(const uint4*)bp0, rb1 = *(const uint4*)bp1;
#pragma unroll
  for (int mi = 0; mi < 4; ++mi)
#pragma unroll
    for (int ni = 0; ni < 2; ++ni) acc[mi][ni] = (f32x4){0.f, 0.f, 0.f, 0.f};
  const int nk = K >> 6;
  for (int kt = 0; kt < nk; ++kt) {
    __syncthreads();
    *(uint4*)(As + r0 * 72 + kc * 8) = ra0; *(uint4*)(As + (r0 + 64) * 72 + kc * 8) = ra1;
    *(uint4*)(Bs + r0 * 72 + kc * 8) = rb0; *(uint4*)(Bs + (r0 + 64) * 72 + kc * 8) = rb1;
    __syncthreads();
    if (kt + 1 < nk) { ap0 += 64; ap1 += 64; bp0 += 64; bp1 += 64; ra0 = *(const uint4*)ap0; ra1 = *(const uint4*)ap1; rb0 = *(const uint4*)bp0; rb1 = *(const uint4*)bp1; }
#pragma unroll
    for (int ks = 0; ks < 2; ++ks) {
      bf16x8 af[4], bfr[2];
#pragma unroll
      for (int mi = 0; mi < 4; ++mi) af[mi] = *(const bf16x8*)(As + (wm * 64 + mi * 16 + fr) * 72 + ks * 32 + fq * 8);
#pragma unroll
      for (int ni = 0; ni < 2; ++ni) bfr[ni] = *(const bf16x8*)(Bs + (wn * 32 + ni * 16 + fr) * 72 + ks * 32 + fq * 8);
#pragma unroll
      for (int mi = 0; mi < 4; ++mi)
#pragma unroll
        for (int ni = 0; ni < 2; ++ni) acc[mi][ni] = __builtin_amdgcn_mfma_f32_16x16x32_bf16(bfr[ni], af[mi], acc[mi][ni], 0, 0, 0);
    }
  }
}

__device__ void gemm_proj_phase(const Params& p, int l, unsigned char* smem) {
  unsigned char* const ws = launder_ptr(p.ws); const int tidx = launder_tid(); (void)ws; (void)tidx;
  const bf16_t* A = (const bf16_t*)(ws + WS_ABUF); const bf16_t* Bt = (const bf16_t*)(ws + WS_WIN) + (size_t)l * INCP * 1024;
  bf16_t* PROJ = (bf16_t*)(ws + WS_PROJ); bf16_t* VTA = (bf16_t*)(ws + WS_VTA);
  const int lane = tidx & 63, wid = tidx >> 6, wm = wid >> 2, wn = wid & 3, fr = lane & 15, fq = lane >> 4;
  constexpr int NTL = INCP / 128;
  constexpr int NTU = 23;
  for (int u = blockIdx.x; u < 128 * NTU; u += gridDim.x) {
    const int mt = u / NTU, nt = u % NTU, m0 = mt * 128, n0 = nt * 128;
    f32x4 acc[4][2];
    gemm_tile_128(A + (size_t)m0 * 1024, 1024, Bt + (size_t)n0 * 1024, 1024, 1024, smem, acc);
#pragma unroll
    for (int mi = 0; mi < 4; ++mi)
#pragma unroll
      for (int ni = 0; ni < 2; ++ni) {
        const int t = m0 + wm * 64 + mi * 16 + fr, c = n0 + wn * 32 + ni * 16 + fq * 4;
        const f32x4 v = acc[mi][ni];
        uint2 o; o.x = pk2(v.x, v.y); o.y = pk2(v.z, v.w);
        *(uint2*)(PROJ + (size_t)t * INCP + c) = o;
        if (c >= C_VA && c < C_VA + 384) {
          const int b = t >> 13, lpos = t & 8191, ch = c - C_VA;
          bf16_t* vt = VTA + ((size_t)b * 384 + ch) * 8192 + lpos;
          vt[0] = f2bf(v.x); vt[8192] = f2bf(v.y); vt[2 * 8192] = f2bf(v.z); vt[3 * 8192] = f2bf(v.w);
        }
      }
  }
  (void)NTL;
}

__device__ void gemm_out_phase(const Params& p, int l, const float* __restrict__ xsrc, unsigned char* smem) {
  unsigned char* const ws = launder_ptr(p.ws); const int tidx = launder_tid(); (void)ws; (void)tidx;
  const bf16_t* A = (const bf16_t*)(ws + WS_ABUF); const bf16_t* Bt = (const bf16_t*)(ws + WS_WOUT) + (size_t)l * 1024 * 1024;
  float* X = (float*)(ws + WS_X); const float* g1 = (const float*)(ws + WS_MOD) + (size_t)l * 2 * 6144 + 2048;
  const int lane = tidx & 63, wid = tidx >> 6, wm = wid >> 2, wn = wid & 3, fr = lane & 15, fq = lane >> 4;
  for (int u = blockIdx.x; u < 128 * 8; u += gridDim.x) {
    const int mt = u >> 3, nt = u & 7, m0 = mt * 128, n0 = nt * 128;
    f32x4 acc[4][2];
    gemm_tile_128(A + (size_t)m0 * 1024, 1024, Bt + (size_t)n0 * 1024, 1024, 1024, smem, acc);
#pragma unroll
    for (int mi = 0; mi < 4; ++mi)
#pragma unroll
      for (int ni = 0; ni < 2; ++ni) {
        const int t = m0 + wm * 64 + mi * 16 + fr, c = n0 + wn * 32 + ni * 16 + fq * 4, b = t >> 13;
        const f32x4 xv = *(const f32x4*)(xsrc + (size_t)t * 1024 + c), g = *(const f32x4*)(g1 + b * 6144 + c);
        f32x4 o; o.x = xv.x + g.x * acc[mi][ni].x; o.y = xv.y + g.y * acc[mi][ni].y; o.z = xv.z + g.z * acc[mi][ni].z; o.w = xv.w + g.w * acc[mi][ni].w;
        *(f32x4*)(X + (size_t)t * 1024 + c) = o;
      }
  }
}

__device__ void gemm_q_phase(const Params& p, int l, unsigned char* smem) {
  unsigned char* const ws = launder_ptr(p.ws); const int tidx = launder_tid(); (void)ws; (void)tidx;
  const bf16_t* A = (const bf16_t*)(ws + WS_ABUF); const bf16_t* Bt = (const bf16_t*)(ws + WS_WQ) + (size_t)l * 2048 * 1024;
  bf16_t* Q = (bf16_t*)(ws + WS_Q);
  const int lane = tidx & 63, wid = tidx >> 6, wm = wid >> 2, wn = wid & 3, fr = lane & 15, fq = lane >> 4;
  for (int u = blockIdx.x; u < 128 * 16; u += gridDim.x) {
    const int mt = u >> 4, nt = u & 15, m0 = mt * 128, n0 = nt * 128;
    f32x4 acc[4][2];
    gemm_tile_128(A + (size_t)m0 * 1024, 1024, Bt + (size_t)n0 * 1024, 1024, 1024, smem, acc);
#pragma unroll
    for (int mi = 0; mi < 4; ++mi)
#pragma unroll
      for (int ni = 0; ni < 2; ++ni) {
        const int t = m0 + wm * 64 + mi * 16 + fr, c = n0 + wn * 32 + ni * 16 + fq * 4;
        const f32x4 v = acc[mi][ni];
        uint2 o; o.x = pk2(v.x, v.y); o.y = pk2(v.z, v.w);
        *(uint2*)(Q + (size_t)t * 2048 + c) = o;
      }
  }
}

__device__ void gemm_scores_phase(const Params& p, int l, unsigned char* smem) {
  unsigned char* const ws = launder_ptr(p.ws); const int tidx = launder_tid(); (void)ws; (void)tidx;
  const bf16_t* Q = (const bf16_t*)(ws + WS_Q); const bf16_t* SK = (const bf16_t*)(ws + WS_SUBK) + (size_t)l * 16 * 128 * 128;
  float* SC = (float*)(ws + WS_SC);
  const int lane = tidx & 63, wid = tidx >> 6, wm = wid >> 2, wn = wid & 3, fr = lane & 15, fq = lane >> 4;
  for (int u = blockIdx.x; u < 128 * 16; u += gridDim.x) {
    const int mt = u >> 4, hs = u & 15, m0 = mt * 128;
    f32x4 acc[4][2];
    gemm_tile_128(Q + (size_t)m0 * 2048 + hs * 128, 2048, SK + (size_t)hs * 128 * 128, 128, 128, smem, acc);
#pragma unroll
    for (int mi = 0; mi < 4; ++mi)
#pragma unroll
      for (int ni = 0; ni < 2; ++ni) {
        const int t = m0 + wm * 64 + mi * 16 + fr, c = hs * 128 + wn * 32 + ni * 16 + fq * 4;
        *(f32x4*)(SC + (size_t)t * 2048 + c) = acc[mi][ni];
      }
  }
}

__device__ void attn_phase(const Params& p, int l) {
  unsigned char* const ws = launder_ptr(p.ws); const int tidx = launder_tid(); (void)ws; (void)tidx;
  const bf16_t* PROJ = (const bf16_t*)(ws + WS_PROJ); const bf16_t* VTA = (const bf16_t*)(ws + WS_VTA);
  float* ATT = (float*)(ws + WS_ATT);
  const int lane = tidx & 63, fr = lane & 15, fq = lane >> 4;
  const int gw = blockIdx.x * NW + (tidx >> 6), nw = gridDim.x * NW;
  for (int task = gw; task < 256 * 24; task += nw) {
    const int item = task / 24, rb = task % 24, h = rb >> 2, qb = rb & 3;
    const int b = item >> 7, n = item & 127, t0 = b * 8192 + n * 64;
    const float* rbias = p.in[I_RELB] + ((size_t)l * 6 + h) * 513;
    const int iq = qb * 16 + fr;
    bf16x8 qf[2];
#pragma unroll
    for (int ds = 0; ds < 2; ++ds) qf[ds] = *(const bf16x8*)(PROJ + (size_t)(t0 + iq) * INCP + C_QA + h * 64 + ds * 32 + fq * 8);
    f32x4 o[4];
#pragma unroll
    for (int et = 0; et < 4; ++et) o[et] = (f32x4){0.f, 0.f, 0.f, 0.f};
    float mrun = -1e30f, lrun = 0.f;
    for (int jc = 0; jc < 9; ++jc) {
      const int m = n - 8 + jc;
      if (m < 0) continue;
      const int tk = b * 8192 + m * 64;
      float s[2][2][4];
#pragma unroll
      for (int g = 0; g < 2; ++g)
#pragma unroll
        for (int tt = 0; tt < 2; ++tt) {
          const int key = tk + 32 * g + 8 * (fr >> 2) + (fr & 3) + 4 * tt;
          const bf16_t* kp = PROJ + (size_t)key * INCP + C_KA + h * 64 + fq * 8;
          const bf16x8 k0 = *(const bf16x8*)kp, k1 = *(const bf16x8*)(kp + 32);
          f32x4 st = (f32x4){0.f, 0.f, 0.f, 0.f};
          st = __builtin_amdgcn_mfma_f32_16x16x32_bf16(k0, qf[0], st, 0, 0, 0);
          st = __builtin_amdgcn_mfma_f32_16x16x32_bf16(k1, qf[1], st, 0, 0, 0);
#pragma unroll
          for (int j = 0; j < 4; ++j) {
            const int kk = 32 * g + 8 * fq + 4 * tt + j;
            int diff = 512 + iq - (64 * jc + kk);
            diff = diff > 256 ? 256 : diff;
            s[g][tt][j] = st[j] * 0.125f + rbias[diff + 256];
          }
        }
      float mloc = -1e30f;
#pragma unroll
      for (int g = 0; g < 2; ++g)
#pragma unroll
        for (int tt = 0; tt < 2; ++tt)
#pragma unroll
          for (int j = 0; j < 4; ++j) mloc = fmaxf(mloc, s[g][tt][j]);
      mloc = fmaxf(mloc, __shfl_xor(mloc, 16)); mloc = fmaxf(mloc, __shfl_xor(mloc, 32));
      const float mnew = fmaxf(mrun, mloc), alpha = __expf(mrun - mnew);
      mrun = mnew;
      float ls = 0.f;
#pragma unroll
      for (int g = 0; g < 2; ++g)
#pragma unroll
        for (int tt = 0; tt < 2; ++tt)
#pragma unroll
          for (int j = 0; j < 4; ++j) { const float e = __expf(s[g][tt][j] - mnew); s[g][tt][j] = e; ls += e; }
      lrun = lrun * alpha + ls;
#pragma unroll
      for (int et = 0; et < 4; ++et) { o[et].x *= alpha; o[et].y *= alpha; o[et].z *= alpha; o[et].w *= alpha; }
#pragma unroll
      for (int g = 0; g < 2; ++g) {
        union { bf16x8 v; unsigned u[4]; } pf;
        pf.u[0] = pk2(s[g][0][0], s[g][0][1]); pf.u[1] = pk2(s[g][0][2], s[g][0][3]);
        pf.u[2] = pk2(s[g][1][0], s[g][1][1]); pf.u[3] = pk2(s[g][1][2], s[g][1][3]);
#pragma unroll
        for (int et = 0; et < 4; ++et) {
          const bf16x8 vf = *(const bf16x8*)(VTA + ((size_t)b * 384 + h * 64 + et * 16 + fr) * 8192 + m * 64 + 32 * g + 8 * fq);
          o[et] = __builtin_amdgcn_mfma_f32_16x16x32_bf16(vf, pf.v, o[et], 0, 0, 0);
        }
      }
    }
    lrun += __shfl_xor(lrun, 16); lrun += __shfl_xor(lrun, 32);
    const float inv = 1.f / lrun;
#pragma unroll
    for (int et = 0; et < 4; ++et) {
      f32x4 v = o[et]; v.x *= inv; v.y *= inv; v.z *= inv; v.w *= inv;
      *(f32x4*)(ATT + (size_t)(t0 + iq) * 384 + h * 64 + et * 16 + fq * 4) = v;
    }
  }
}

__device__ void mix_local_phase(const Params& p, int l, unsigned char* smem) {
  unsigned char* const ws = launder_ptr(p.ws); const int tidx = launder_tid(); (void)ws; (void)tidx;
  const bf16_t* PROJ = (const bf16_t*)(ws + WS_PROJ);
  const float* RC = (const float*)(ws + WS_ROTC); const float* RS = (const float*)(ws + WS_ROTS);
  float* YINT = (float*)(ws + WS_YINT); float* UPD = (float*)(ws + WS_UPD);
  const float* SA = (const float*)(ws + WS_SA) + (size_t)l * 16 * 64 * 2; const float* SBB = (const float*)(ws + WS_SBB) + (size_t)l * 16 * 64 * 32;
  float* SEND = (float*)(ws + WS_SEND);
  const int tid = tidx, lane = tid & 63, wid = tid >> 6;
  float* qf = (float*)smem; float* kf = qf + 64 * 65; float* vv = kf + 64 * 65; float* S = vv + 64 * 65; float* kdec = S + 64 * 65;
  float* ussm = kdec + 64;
  for (int item = blockIdx.x; item < 256; item += gridDim.x) {
    const int b = item >> 7, n = item & 127, t0 = b * 8192 + n * 64;
    for (int h = 0; h < 6; ++h) {
      const float lg = log1pf(-exp2f(-5.f - (float)h));
      __syncthreads();
#pragma unroll
      for (int r = 0; r < 4; ++r) {
        const int idx = tid + NT * r, i = idx >> 5, dd = idx & 31;
        const bf16_t* row = PROJ + (size_t)(t0 + i) * INCP;
        const float c = RC[(n * 64 + i) * 32 + dd], s = RS[(n * 64 + i) * 32 + dd];
        const float q1 = bf2f(row[C_QR + h * 64 + dd]), q2 = bf2f(row[C_QR + h * 64 + dd + 32]);
        const float k1 = bf2f(row[C_KR + h * 64 + dd]) * 0.125f, k2 = bf2f(row[C_KR + h * 64 + dd + 32]) * 0.125f;
        qf[i * 65 + dd] = q1 * c - q2 * s; qf[i * 65 + dd + 32] = q1 * s + q2 * c;
        kf[i * 65 + dd] = k1 * c - k2 * s; kf[i * 65 + dd + 32] = k1 * s + k2 * c;
        vv[i * 65 + dd] = bf2f(row[C_VR + h * 64 + dd]); vv[i * 65 + dd + 32] = bf2f(row[C_VR + h * 64 + dd + 32]);
      }
      if (tid < 64) kdec[tid] = __expf(lg * (float)(63 - tid));
      __syncthreads();
#pragma unroll 1
      for (int r = 0; r < 8; ++r) {
        const int idx = tid + NT * r, i = idx >> 6, j = idx & 63;
        float a = 0.f;
#pragma unroll 16
        for (int d = 0; d < 64; ++d) a += qf[i * 65 + d] * kf[j * 65 + d];
        const int dij = i > j ? i - j : j - i;
        S[i * 65 + j] = a * __expf(lg * (float)dij);
      }
      __syncthreads();
#pragma unroll 1
      for (int r = 0; r < 8; ++r) {
        const int idx = tid + NT * r, i = idx >> 6, e = idx & 63;
        float a = 0.f, u = 0.f;
#pragma unroll 16
        for (int j = 0; j < 64; ++j) { a += S[i * 65 + j] * vv[j * 65 + e]; u += kf[j * 65 + i] * kdec[j] * vv[j * 65 + e]; }
        YINT[(size_t)(t0 + i) * 384 + h * 64 + e] = a;
        UPD[((size_t)item * 6 + h) * 4096 + i * 64 + e] = u;
      }
    }
    __syncthreads();
    for (int gi = 0; gi < 2; ++gi) {
      const int g = wid * 2 + gi;
      float* uw = ussm + wid * 1024;
#pragma unroll 4
      for (int r = 0; r < 16; ++r) { const int idx = lane + 64 * r, i = idx >> 4, c = idx & 15; uw[idx] = bf2f(PROJ[(size_t)(t0 + i) * INCP + C_US + g * 16 + c]); }
      float bbr[16], bbi[16];
      const float* bbp = SBB + ((size_t)g * 64 + lane) * 32;
#pragma unroll
      for (int c = 0; c < 16; ++c) { bbr[c] = bbp[c]; bbi[c] = bbp[16 + c]; }
      const float are = SA[(g * 64 + lane) * 2], aim = SA[(g * 64 + lane) * 2 + 1];
      float xr = 0.f, xi = 0.f;
#pragma unroll 2
      for (int i = 0; i < 64; ++i) {
        float br = 0.f, bi = 0.f;
#pragma unroll
        for (int c = 0; c < 16; ++c) { const float u = uw[i * 16 + c]; br += bbr[c] * u; bi += bbi[c] * u; }
        const float nr = are * xr - aim * xi + br, ni = are * xi + aim * xr + bi;
        xr = nr; xi = ni;
      }
      SEND[(((size_t)item * 16 + g) * 64 + lane) * 2] = xr; SEND[(((size_t)item * 16 + g) * 64 + lane) * 2 + 1] = xi;
    }
  }
}

__device__ void scan_phase(const Params& p, int l) {
  unsigned char* const ws = launder_ptr(p.ws); const int tidx = launder_tid(); (void)ws; (void)tidx;
  const float* UPD = (const float*)(ws + WS_UPD); float* SPREV = (float*)(ws + WS_SPREV);
  const float* SEND = (const float*)(ws + WS_SEND); float* CARRY = (float*)(ws + WS_CARRY);
  const float* SA = (const float*)(ws + WS_SA) + (size_t)l * 16 * 64 * 2;
  const int gtid = blockIdx.x * NT + tidx, gn = gridDim.x * NT;
  for (int idx = gtid; idx < 2 * 6 * 4096 + 2 * 1024; idx += gn) {
    if (idx < 2 * 6 * 4096) {
      const int b = idx / (6 * 4096), r = idx % (6 * 4096), h = r >> 12;
      const float cd = __expf(64.f * log1pf(-exp2f(-5.f - (float)h)));
      float s = 0.f;
      for (int n = 0; n < NCH; ++n) {
        const size_t off = ((size_t)(b * NCH + n)) * 6 * 4096 + r;
        SPREV[off] = s;
        s = cd * s + UPD[off];
      }
    } else {
      const int r2 = idx - 2 * 6 * 4096, b = r2 >> 10, gp = r2 & 1023;
      float ar = SA[gp * 2], ai = SA[gp * 2 + 1];
#pragma unroll
      for (int q = 0; q < 6; ++q) { const float nr = ar * ar - ai * ai, ni = 2.f * ar * ai; ar = nr; ai = ni; }
      float xr = 0.f, xi = 0.f;
      for (int n = 0; n < NCH; ++n) {
        const size_t off = (((size_t)(b * NCH + n)) * 1024 + gp) * 2;
        CARRY[off] = xr; CARRY[off + 1] = xi;
        const float sr = SEND[off], si = SEND[off + 1];
        const float nr = ar * xr - ai * xi + sr, ni = ar * xi + ai * xr + si;
        xr = nr; xi = ni;
      }
    }
  }
}

__device__ void mix_final_phase(const Params& p, int l, unsigned char* smem) {
  unsigned char* const ws = launder_ptr(p.ws); const int tidx = launder_tid(); (void)ws; (void)tidx;
  const bf16_t* PROJ = (const bf16_t*)(ws + WS_PROJ);
  const float* RC = (const float*)(ws + WS_ROTC); const float* RS = (const float*)(ws + WS_ROTS);
  const float* YINT = (const float*)(ws + WS_YINT); const float* SPREV = (const float*)(ws + WS_SPREV);
  const float* ATT = (const float*)(ws + WS_ATT);
  const float* SA = (const float*)(ws + WS_SA) + (size_t)l * 16 * 64 * 2; const float* SBB = (const float*)(ws + WS_SBB) + (size_t)l * 16 * 64 * 32;
  const float* CARRY = (const float*)(ws + WS_CARRY);
  const float* cre = p.in[I_CRE] + (size_t)l * 16 * 16 * 64; const float* cim = p.in[I_CIM] + (size_t)l * 16 * 16 * 64;
  const float* dsk = p.in[I_SSMD] + (size_t)l * 256; const float* wglu = p.in[I_WGLU] + (size_t)l * 256 * 512;
  const float* mg = p.in[I_MGAIN] + (size_t)l * 1024;
  bf16_t* MRG = (bf16_t*)(ws + WS_ABUF);
  const int tid = tidx, lane = tid & 63, wid = tid >> 6;
  float* qf = (float*)smem; float* sp = qf + 64 * 65; float* Y = sp + 64 * 64;
  float* YS = (float*)smem;
  float* wv = (float*)(smem + 64 * 257 * 4);
  for (int item = blockIdx.x; item < 256; item += gridDim.x) {
    const int b = item >> 7, n = item & 127, t0 = b * 8192 + n * 64;
    for (int ii = 0; ii < 8; ++ii) {
      const int t = t0 + wid * 8 + ii;
      float v[6]; float s = 0.f;
#pragma unroll
      for (int j = 0; j < 6; ++j) { v[j] = ATT[(size_t)t * 384 + lane + 64 * j]; s += v[j] * v[j]; }
      const float rstd = rsqrtf(wave_sum(s) * (1.f / 384.f) + EPS_);
#pragma unroll
      for (int j = 0; j < 6; ++j) MRG[(size_t)t * 1024 + lane + 64 * j] = f2bf(v[j] * rstd * mg[lane + 64 * j]);
    }
    for (int h = 0; h < 6; ++h) {
      const float lg = log1pf(-exp2f(-5.f - (float)h));
      __syncthreads();
#pragma unroll
      for (int r = 0; r < 4; ++r) {
        const int idx = tid + NT * r, i = idx >> 5, dd = idx & 31;
        const bf16_t* row = PROJ + (size_t)(t0 + i) * INCP;
        const float c = RC[(n * 64 + i) * 32 + dd], s = RS[(n * 64 + i) * 32 + dd];
        const float q1 = bf2f(row[C_QR + h * 64 + dd]), q2 = bf2f(row[C_QR + h * 64 + dd + 32]);
        qf[i * 65 + dd] = q1 * c - q2 * s; qf[i * 65 + dd + 32] = q1 * s + q2 * c;
      }
#pragma unroll
      for (int r = 0; r < 8; ++r) { const int idx = tid + NT * r; sp[idx] = SPREV[((size_t)item * 6 + h) * 4096 + idx]; }
      __syncthreads();
#pragma unroll 1
      for (int r = 0; r < 8; ++r) {
        const int idx = tid + NT * r, i = idx >> 6, e = idx & 63;
        float a = 0.f;
#pragma unroll 16
        for (int d = 0; d < 64; ++d) a += qf[i * 65 + d] * sp[d * 64 + e];
        Y[i * 65 + e] = YINT[(size_t)(t0 + i) * 384 + h * 64 + e] + __expf(lg * (float)(i + 1)) * a;
      }
      __syncthreads();
      for (int ii = 0; ii < 8; ++ii) {
        const int i = wid * 8 + ii, t = t0 + i;
        const float v = Y[i * 65 + lane];
        const float mu = wave_sum(v) * (1.f / 64.f);
        const float dv = v - mu;
        const float var = wave_sum(dv * dv) * (1.f / 64.f);
        const float gte = bf2f(PROJ[(size_t)t * INCP + C_GR + h * 64 + lane]);
        const float o = dv * rsqrtf(var + EPS_) * (gte * sigmoid_f(gte));
        MRG[(size_t)t * 1024 + 384 + h * 64 + lane] = f2bf(o * mg[384 + h * 64 + lane]);
      }
    }
    __syncthreads();
    for (int gi = 0; gi < 2; ++gi) {
      const int g = wid * 2 + gi;
      float* uw = wv + wid * 2048; float* xre = uw + 1024; float* xim = xre + 512;
#pragma unroll 4
      for (int r = 0; r < 16; ++r) { const int idx = lane + 64 * r, i = idx >> 4, c = idx & 15; uw[idx] = bf2f(PROJ[(size_t)(t0 + i) * INCP + C_US + g * 16 + c]); }
      float bbr[16], bbi[16];
      const float* bbp = SBB + ((size_t)g * 64 + lane) * 32;
#pragma unroll
      for (int c = 0; c < 16; ++c) { bbr[c] = bbp[c]; bbi[c] = bbp[16 + c]; }
      const float are = SA[(g * 64 + lane) * 2], aim = SA[(g * 64 + lane) * 2 + 1];
      float xr = CARRY[(((size_t)item * 16 + g) * 64 + lane) * 2], xi = CARRY[(((size_t)item * 16 + g) * 64 + lane) * 2 + 1];
      const int i8 = lane >> 3, c0 = (lane & 7) * 2;
      const float* cr0 = cre + ((size_t)g * 16 + c0) * 64; const float* ci0 = cim + ((size_t)g * 16 + c0) * 64;
#pragma unroll 1
      for (int blk = 0; blk < 8; ++blk) {
#pragma unroll 2
        for (int ii = 0; ii < 8; ++ii) {
          const int i = blk * 8 + ii;
          float br = 0.f, bi = 0.f;
#pragma unroll
          for (int c = 0; c < 16; ++c) { const float u = uw[i * 16 + c]; br += bbr[c] * u; bi += bbi[c] * u; }
          const float nr = are * xr - aim * xi + br, ni = are * xi + aim * xr + bi;
          xr = nr; xi = ni;
          xre[ii * 64 + lane] = xr; xim[ii * 64 + lane] = xi;
        }
        float a0 = 0.f, a1 = 0.f;
#pragma unroll 4
        for (int pp = 0; pp < 64; ++pp) {
          const float vr = xre[i8 * 64 + pp], vi = xim[i8 * 64 + pp];
          a0 += cr0[pp] * vr - ci0[pp] * vi;
          a1 += cr0[64 + pp] * vr - ci0[64 + pp] * vi;
        }
        const int i = blk * 8 + i8;
        const float y0 = a0 + dsk[g * 16 + c0] * uw[i * 16 + c0], y1 = a1 + dsk[g * 16 + c0 + 1] * uw[i * 16 + c0 + 1];
        YS[i * 257 + g * 16 + c0] = gelu_tanh(y0); YS[i * 257 + g * 16 + c0 + 1] = gelu_tanh(y1);
      }
    }
    __syncthreads();
    {
      const int nn = tid & 255, half = tid >> 8;
      float* OUTS = wv;
#pragma unroll 1
      for (int ps = 0; ps < 2; ++ps) {
        const int ib = half * 32 + ps * 16;
        float z1[16], z2[16];
#pragma unroll
        for (int i = 0; i < 16; ++i) { z1[i] = 0.f; z2[i] = 0.f; }
#pragma unroll 2
        for (int k = 0; k < 256; ++k) {
          const float w1 = wglu[(size_t)k * 512 + nn], w2 = wglu[(size_t)k * 512 + 256 + nn];
#pragma unroll
          for (int i = 0; i < 16; ++i) { const float yv = YS[(ib + i) * 257 + k]; z1[i] += yv * w1; z2[i] += yv * w2; }
        }
#pragma unroll
        for (int i = 0; i < 16; ++i) OUTS[(ib + i) * 256 + nn] = z1[i] * sigmoid_f(z2[i]);
      }
      __syncthreads();
      for (int ii = 0; ii < 8; ++ii) {
        const int i = wid * 8 + ii, t = t0 + i;
        float v[4]; float s = 0.f;
#pragma unroll
        for (int j = 0; j < 4; ++j) { v[j] = OUTS[i * 256 + lane + 64 * j]; s += v[j] * v[j]; }
        const float rstd = rsqrtf(wave_sum(s) * (1.f / 256.f) + EPS_);
#pragma unroll
        for (int j = 0; j < 4; ++j) MRG[(size_t)t * 1024 + 768 + lane + 64 * j] = f2bf(v[j] * rstd * mg[768 + lane + 64 * j]);
      }
    }
    __syncthreads();
  }
}

__device__ void topk_phase(const Params& p, unsigned char* smem) {
  unsigned char* const ws = launder_ptr(p.ws); const int tidx = launder_tid(); (void)ws; (void)tidx;
  const float* SC = (const float*)(ws + WS_SC); int* EIDX = (int*)(ws + WS_EIDX); float* EGATE = (float*)(ws + WS_EGATE);
  const int lane = tidx & 63, wid = tidx >> 6;
  const int gw = blockIdx.x * NW + wid, nw = gridDim.x * NW;
  float* tops = (float*)smem + wid * 512; int* topi = (int*)(tops + 256);
  for (int t = gw; t < T_; t += nw) {
    const float* sc = SC + (size_t)t * 2048;
    for (int hs = 0; hs < 16; ++hs) {
      float v0 = sc[hs * 128 + lane], v1 = sc[hs * 128 + 64 + lane];
      float ms = 0.f; int mi = 0;
      for (int it = 0; it < 16; ++it) {
        const float m = fmaxf(v0, v1);
        const float wmx = wave_max(m);
        const unsigned long long bal = __ballot(m == wmx);
        const int src = __ffsll((long long)bal) - 1;
        const int slot = (v0 == wmx) ? 0 : 1;
        const int sslot = __shfl(slot, src);
        if (lane == src) { if (sslot == 0) v0 = -3.0e38f; else v1 = -3.0e38f; }
        if (lane == it) { ms = wmx; mi = src + 64 * sslot; }
      }
      if (lane < 16) { tops[hs * 16 + lane] = ms; topi[hs * 16 + lane] = mi; }
    }
    for (int h = 0; h < 8; ++h) {
      const float a = tops[(2 * h) * 16 + (lane >> 2)];
      float c0 = a + tops[(2 * h + 1) * 16 + (lane & 3) * 4 + 0], c1 = a + tops[(2 * h + 1) * 16 + (lane & 3) * 4 + 1];
      float c2 = a + tops[(2 * h + 1) * 16 + (lane & 3) * 4 + 2], c3 = a + tops[(2 * h + 1) * 16 + (lane & 3) * 4 + 3];
      float bs = 0.f; int bc = 0;
      for (int it = 0; it < 16; ++it) {
        const float m = fmaxf(fmaxf(c0, c1), fmaxf(c2, c3));
        const float wmx = wave_max(m);
        const unsigned long long bal = __ballot(m == wmx);
        const int src = __ffsll((long long)bal) - 1;
        const int slot = (c0 == wmx) ? 0 : ((c1 == wmx) ? 1 : ((c2 == wmx) ? 2 : 3));
        const int sslot = __shfl(slot, src);
        if (lane == src) { if (sslot == 0) c0 = -3.0e38f; else if (sslot == 1) c1 = -3.0e38f; else if (sslot == 2) c2 = -3.0e38f; else c3 = -3.0e38f; }
        if (lane == it) { bs = wmx; bc = src * 4 + sslot; }
      }
      const float mx = __shfl(bs, 0);
      const float e = (lane < 16) ? __expf(bs - mx) : 0.f;
      const float sum = wave_sum(e);
      if (lane < 16) {
        const int i = bc >> 4, j = bc & 15;
        EIDX[(size_t)t * 128 + h * 16 + lane] = topi[(2 * h) * 16 + i] * 128 + topi[(2 * h + 1) * 16 + j];
        EGATE[(size_t)t * 128 + h * 16 + lane] = e / sum;
      }
    }
  }
}

typedef float f32x2 __attribute__((ext_vector_type(2)));
__device__ __forceinline__ float dot16_fp8(const uint4 u, const float (&hv)[16]) {
  f32x2 c; float d;
  c = __builtin_amdgcn_cvt_pk_f32_fp8((int)u.x, false); d = c.x * hv[0] + c.y * hv[1];
  c = __builtin_amdgcn_cvt_pk_f32_fp8((int)u.x, true);  d += c.x * hv[2] + c.y * hv[3];
  c = __builtin_amdgcn_cvt_pk_f32_fp8((int)u.y, false); d += c.x * hv[4] + c.y * hv[5];
  c = __builtin_amdgcn_cvt_pk_f32_fp8((int)u.y, true);  d += c.x * hv[6] + c.y * hv[7];
  c = __builtin_amdgcn_cvt_pk_f32_fp8((int)u.z, false); d += c.x * hv[8] + c.y * hv[9];
  c = __builtin_amdgcn_cvt_pk_f32_fp8((int)u.z, true);  d += c.x * hv[10] + c.y * hv[11];
  c = __builtin_amdgcn_cvt_pk_f32_fp8((int)u.w, false); d += c.x * hv[12] + c.y * hv[13];
  c = __builtin_amdgcn_cvt_pk_f32_fp8((int)u.w, true);  d += c.x * hv[14] + c.y * hv[15];
  return d;
}
__device__ __forceinline__ void axpy16_fp8(const uint4 v, const float w, float (&acc)[16]) {
  f32x2 c;
  c = __builtin_amdgcn_cvt_pk_f32_fp8((int)v.x, false); acc[0] += w * c.x; acc[1] += w * c.y;
  c = __builtin_amdgcn_cvt_pk_f32_fp8((int)v.x, true);  acc[2] += w * c.x; acc[3] += w * c.y;
  c = __builtin_amdgcn_cvt_pk_f32_fp8((int)v.y, false); acc[4] += w * c.x; acc[5] += w * c.y;
  c = __builtin_amdgcn_cvt_pk_f32_fp8((int)v.y, true);  acc[6] += w * c.x; acc[7] += w * c.y;
  c = __builtin_amdgcn_cvt_pk_f32_fp8((int)v.z, false); acc[8] += w * c.x; acc[9] += w * c.y;
  c = __builtin_amdgcn_cvt_pk_f32_fp8((int)v.z, true);  acc[10] += w * c.x; acc[11] += w * c.y;
  c = __builtin_amdgcn_cvt_pk_f32_fp8((int)v.w, false); acc[12] += w * c.x; acc[13] += w * c.y;
  c = __builtin_amdgcn_cvt_pk_f32_fp8((int)v.w, true);  acc[14] += w * c.x; acc[15] += w * c.y;
}
__device__ void peer_phase(const Params& p, int l, bool last) {
  unsigned char* const ws = launder_ptr(p.ws); const int tidx = launder_tid();
  bf16_t* HF = (bf16_t*)(ws + WS_ABUF); float* X = (float*)(ws + WS_X);
  const int* EIDX = (const int*)(ws + WS_EIDX); const float* EGATE = (const float*)(ws + WS_EGATE);
  const uint4* U8 = (const uint4*)(ws + WS_PU8) + (size_t)l * 16384 * 64; const uint4* V8 = (const uint4*)(ws + WS_PV8) + (size_t)l * 16384 * 64;
  const float* g2 = (const float*)(ws + WS_MOD) + (size_t)l * 2 * 6144 + 5120;
  const int ln = last ? l : l + 1;
  const float* nsh = (const float*)(ws + WS_MOD) + (size_t)ln * 2 * 6144; const float* nsc = nsh + 1024;
  const float* ngain = p.in[I_NMIX] + (size_t)ln * 1024;
  const int lane = tidx & 63, gw = blockIdx.x * NW + (tidx >> 6), nw = gridDim.x * NW;
  const int rL = ((lane >> 5) & 1) * 4 + ((lane >> 4) & 1) * 2 + ((lane >> 3) & 1);
  const bool hi5 = (lane & 32) != 0, hi4 = (lane & 16) != 0, hi3 = (lane & 8) != 0;
  for (int t = gw; t < T_; t += nw) {
    const int b = t >> 13;
    float hv[16];
    {
      const uint4 h0 = *(const uint4*)(HF + (size_t)t * 1024 + lane * 16), h1 = *(const uint4*)(HF + (size_t)t * 1024 + lane * 16 + 8);
      const unsigned hw[8] = {h0.x, h0.y, h0.z, h0.w, h1.x, h1.y, h1.z, h1.w};
#pragma unroll
      for (int q = 0; q < 8; ++q) { hv[2 * q] = __uint_as_float(hw[q] << 16); hv[2 * q + 1] = __uint_as_float(hw[q] & 0xffff0000u); }
    }
    const int e0 = EIDX[(size_t)t * 128 + lane], e1 = EIDX[(size_t)t * 128 + 64 + lane];
    const float g0 = EGATE[(size_t)t * 128 + lane], g1 = EGATE[(size_t)t * 128 + 64 + lane];
    float acc[16];
#pragma unroll
    for (int j = 0; j < 16; ++j) acc[j] = 0.f;
#pragma unroll 1
    for (int bt = 0; bt < 16; ++bt) {
      const int esrc = (bt < 8) ? e0 : e1; const float gsrc = (bt < 8) ? g0 : g1; const int lb = (bt & 7) * 8;
      uint4 ur[8], vr[8];
#pragma unroll
      for (int r = 0; r < 8; ++r) {
        const int idx = __builtin_amdgcn_readlane(esrc, lb + r);
        ur[r] = U8[(size_t)idx * 64 + lane]; vr[r] = V8[(size_t)idx * 64 + lane];
      }
      float d[8];
#pragma unroll
      for (int r = 0; r < 8; ++r) d[r] = dot16_fp8(ur[r], hv);
      float r4[4], r2[2];
#pragma unroll
      for (int i = 0; i < 4; ++i) { const float keep = hi5 ? d[i + 4] : d[i], send = hi5 ? d[i] : d[i + 4]; r4[i] = keep + __shfl_xor(send, 32); }
#pragma unroll
      for (int i = 0; i < 2; ++i) { const float keep = hi4 ? r4[i + 2] : r4[i], send = hi4 ? r4[i] : r4[i + 2]; r2[i] = keep + __shfl_xor(send, 16); }
      float r1;
      { const float keep = hi3 ? r2[1] : r2[0], send = hi3 ? r2[0] : r2[1]; r1 = keep + __shfl_xor(send, 8); }
      r1 += __shfl_xor(r1, 4); r1 += __shfl_xor(r1, 2); r1 += __shfl_xor(r1, 1);
      const float gl = __shfl(gsrc, lb + rL);
      const float w = gl * gelu_tanh(r1 * (1.f / 1024.f));
#pragma unroll
      for (int r = 0; r < 8; ++r) {
        const int Lk = ((r >> 2) & 1) * 32 + ((r >> 1) & 1) * 16 + (r & 1) * 8;
        const float wr = __int_as_float(__builtin_amdgcn_readlane(__float_as_int(w), Lk));
        axpy16_fp8(vr[r], wr, acc);
      }
    }
    float xn[16]; float ss = 0.f;
#pragma unroll
    for (int q = 0; q < 4; ++q) {
      const int c = lane * 16 + 4 * q;
      const f32x4 xv = *(const f32x4*)(X + (size_t)t * 1024 + c), g = *(const f32x4*)(g2 + b * 6144 + c);
      xn[4 * q] = xv.x + g.x * acc[4 * q] * (1.f / 64.f); xn[4 * q + 1] = xv.y + g.y * acc[4 * q + 1] * (1.f / 64.f);
      xn[4 * q + 2] = xv.z + g.z * acc[4 * q + 2] * (1.f / 64.f); xn[4 * q + 3] = xv.w + g.w * acc[4 * q + 3] * (1.f / 64.f);
      ss += xn[4 * q] * xn[4 * q] + xn[4 * q + 1] * xn[4 * q + 1] + xn[4 * q + 2] * xn[4 * q + 2] + xn[4 * q + 3] * xn[4 * q + 3];
    }
    const float rstd = rsqrtf(wave_sum(ss) * (1.f / 1024.f) + EPS_);
    if (!last) {
      unsigned hb[8];
#pragma unroll
      for (int q = 0; q < 4; ++q) {
        const int c = lane * 16 + 4 * q;
        *(f32x4*)(X + (size_t)t * 1024 + c) = (f32x4){xn[4 * q], xn[4 * q + 1], xn[4 * q + 2], xn[4 * q + 3]};
        const f32x4 gn = *(const f32x4*)(ngain + c), sh = *(const f32x4*)(nsh + b * 6144 + c), sc = *(const f32x4*)(nsc + b * 6144 + c);
        hb[2 * q] = pk2(xn[4 * q] * rstd * gn.x * (1.f + sc.x) + sh.x, xn[4 * q + 1] * rstd * gn.y * (1.f + sc.y) + sh.y);
        hb[2 * q + 1] = pk2(xn[4 * q + 2] * rstd * gn.z * (1.f + sc.z) + sh.z, xn[4 * q + 3] * rstd * gn.w * (1.f + sc.w) + sh.w);
      }
      *(uint4*)(HF + (size_t)t * 1024 + lane * 16) = make_uint4(hb[0], hb[1], hb[2], hb[3]);
      *(uint4*)(HF + (size_t)t * 1024 + lane * 16 + 8) = make_uint4(hb[4], hb[5], hb[6], hb[7]);
    } else {
#pragma unroll
      for (int q = 0; q < 4; ++q) {
        const int c = lane * 16 + 4 * q;
        const f32x4 fn = *(const f32x4*)(p.in[I_FNORM] + c);
        *(f32x4*)(p.out + (size_t)t * 1024 + c) = (f32x4){xn[4 * q] * rstd * fn.x, xn[4 * q + 1] * rstd * fn.y, xn[4 * q + 2] * rstd * fn.z, xn[4 * q + 3] * rstd * fn.w};
      }
    }
  }
}


#define XB_TMO      128
#define XB_XCNT(j)  (256  + 64 * (j))
#define XB_XSUB(j)  (1280 + 64 * (j))
#define XB_XGEN(j)  (2304 + 64 * (j))
#define XB_TOP      3328
#define XB_TOPGEN   3392
#define XCD_BAR_WORDS 3456
#define XB_SPIN_CAP (1u << 20)
#define LAS __attribute__((address_space(3)))
__device__ __forceinline__ unsigned xb_ld(unsigned* q)              { return __hip_atomic_load(q, __ATOMIC_RELAXED, __HIP_MEMORY_SCOPE_AGENT); }
__device__ __forceinline__ unsigned xb_add(unsigned* q, unsigned v) { return __hip_atomic_fetch_add(q, v, __ATOMIC_RELAXED, __HIP_MEMORY_SCOPE_AGENT); }
__device__ __forceinline__ unsigned xb_xcc_id() { return (unsigned)__builtin_amdgcn_s_getreg((3 << 11) | 20) & 0xFu; }
#define XB_SPIN(cond, bar) do { unsigned _sp = 0; while (cond) { __builtin_amdgcn_s_sleep(1); \
    if ((++_sp & 255u) == 0u) { if (xb_ld(&(bar)[XB_TMO])) break; if (_sp > XB_SPIN_CAP) { atomicAdd(&(bar)[XB_TMO], 1u); break; } } } } while (0)
struct XcdBarrier { unsigned* bar; unsigned x; volatile LAS unsigned* st; };
__device__ __forceinline__ XcdBarrier xcd_barrier_post(unsigned* bar, volatile LAS unsigned* st) {
    XcdBarrier b; b.bar = bar; b.x = xb_xcc_id(); b.st = st;
    if (threadIdx.x == 0) (void)xb_add(&bar[XB_XCNT(b.x)], 1u);
    return b;
}
__device__ __forceinline__ void xcd_barrier_complete(unsigned* bar, unsigned x, unsigned& nloc, unsigned& nx) {
    const unsigned G = gridDim.x * gridDim.y * gridDim.z;
    unsigned sum, cnt, mine, sp = 0u;
    for (;;) {
        sum = 0u; cnt = 0u; mine = 0u;
#pragma unroll
        for (unsigned j = 0; j < 16; ++j) { const unsigned c = xb_ld(&bar[XB_XCNT(j)]); sum += c; cnt += (c > 0u) ? 1u : 0u; mine = (j == x) ? c : mine; }
        if (sum == G) break;
        __builtin_amdgcn_s_sleep(1);
        if ((++sp & 255u) == 0u) { if (xb_ld(&bar[XB_TMO])) break; if (sp > XB_SPIN_CAP) { atomicAdd(&bar[XB_TMO], 1u); break; } }
    }
    nloc = mine > 0u ? mine : 1u; nx = cnt > 0u ? cnt : 1u;
}
__device__ __forceinline__ void xcd_barrier(const XcdBarrier& b) {
    asm volatile("s_waitcnt vmcnt(0)" ::: "memory");
    __syncthreads();
    if (threadIdx.x == 0) {
        unsigned* bar = b.bar;
        __builtin_amdgcn_s_waitcnt(0);
        unsigned nloc = b.st[0], nx = b.st[1];
        if (nloc == 0u) { xcd_barrier_complete(bar, b.x, nloc, nx); b.st[0] = nloc; b.st[1] = nx; }
        const unsigned old = xb_add(&bar[XB_XSUB(b.x)], 1u);
        const unsigned gen = old / nloc;
        if (old + 1u == (gen + 1u) * nloc) {
            __builtin_amdgcn_fence(__ATOMIC_RELEASE, "agent");
            asm volatile("s_waitcnt vmcnt(0)" ::: "memory");
            const unsigned og = xb_add(&bar[XB_TOP], 1u);
            const unsigned tg = og / nx;
            if (og + 1u == (tg + 1u) * nx) xb_add(&bar[XB_TOPGEN], 1u);
            else XB_SPIN(xb_ld(&bar[XB_TOPGEN]) == tg, bar);
            __builtin_amdgcn_fence(__ATOMIC_ACQUIRE, "agent");
            xb_add(&bar[XB_XGEN(b.x)], 1u);
            asm volatile("s_waitcnt vmcnt(0)" ::: "memory");
        } else {
            XB_SPIN(xb_ld(&bar[XB_XGEN(b.x)]) == gen, bar);
            __builtin_amdgcn_fence(__ATOMIC_ACQUIRE, "agent");
            asm volatile("s_waitcnt vmcnt(0)" ::: "memory");
        }
    }
    __syncthreads();
}

__global__ void __launch_bounds__(NT) fwd_megakernel(Params p) {
  extern __shared__ __attribute__((aligned(16))) unsigned char smem[];
  cg::grid_group grid = cg::this_grid();
  volatile LAS unsigned* xbst = (volatile LAS unsigned*)(smem + LDS_BYTES - 16);
  if (threadIdx.x == 0) { xbst[0] = 0u; xbst[1] = 0u; }
  if (blockIdx.x == 0) { unsigned* bw = (unsigned*)(p.ws + WS_BAR); for (int i = threadIdx.x; i < XCD_BAR_WORDS; i += NT) bw[i] = 0u; }
  setup_phase(p, smem);
  grid.sync();
  const XcdBarrier xb = xcd_barrier_post((unsigned*)(p.ws + WS_BAR), xbst);
  const float* MOD = (const float*)(p.ws + WS_MOD);
  for (int l = 0; l < DEPTH_; ++l) {
    const float* xsrc = (l == 0) ? p.in[I_X] : (const float*)(p.ws + WS_X);
    const float* modl = MOD + (size_t)l * 2 * 6144;
    if (l == 0) {
      norm_mod_phase(xsrc, p.in[I_NMIX], modl + 0, modl + 1024, (bf16_t*)(p.ws + WS_ABUF));
      xcd_barrier(xb);
    }
    gemm_proj_phase(p, l, smem);
    xcd_barrier(xb);
    attn_phase(p, l);
    mix_local_phase(p, l, smem);
    xcd_barrier(xb);
    scan_phase(p, l);
    xcd_barrier(xb);
    mix_final_phase(p, l, smem);
    xcd_barrier(xb);
    gemm_out_phase(p, l, xsrc, smem);
    xcd_barrier(xb);
    norm_mod_phase((const float*)(p.ws + WS_X), p.in[I_NFFN] + (size_t)l * 1024, modl + 3072, modl + 4096, (bf16_t*)(p.ws + WS_ABUF));
    xcd_barrier(xb);
    gemm_q_phase(p, l, smem);
    xcd_barrier(xb);
    gemm_scores_phase(p, l, smem);
    xcd_barrier(xb);
    topk_phase(p, smem);
    xcd_barrier(xb);
    peer_phase(p, l, l == DEPTH_ - 1);
    xcd_barrier(xb);
  }
}

extern "C" void kernel_launch(void* const* d_in, const int* in_sizes, int n_in,
                              void* d_out, int out_size, void* d_ws, size_t ws_size,
                              hipStream_t stream) {
  static int grid_blocks = 0;
  if (grid_blocks == 0) {
    if (n_in != 24 || ws_size < WS_END) { fprintf(stderr, "kernel_launch: unexpected n_in %d / ws_size %zu (need %zu)\n", n_in, ws_size, (size_t)WS_END); grid_blocks = -1; return; }
    int dev = 0, cus = 0, per_cu = 0;
    if (hipGetDevice(&dev) != hipSuccess || hipDeviceGetAttribute(&cus, hipDeviceAttributeMultiprocessorCount, dev) != hipSuccess) { grid_blocks = -1; return; }
    if (hipFuncSetAttribute((const void*)fwd_megakernel, hipFuncAttributeMaxDynamicSharedMemorySize, LDS_BYTES) != hipSuccess) { fprintf(stderr, "hipFuncSetAttribute failed\n"); grid_blocks = -1; return; }
    if (hipOccupancyMaxActiveBlocksPerMultiprocessor(&per_cu, (const void*)fwd_megakernel, NT, LDS_BYTES) != hipSuccess || per_cu < 1) { fprintf(stderr, "occupancy query: %d\n", per_cu); grid_blocks = -1; return; }
    grid_blocks = cus;
  }
  if (grid_blocks < 0) return;
  Params p{};
  for (int i = 0; i < 24; ++i) p.in[i] = (const float*)d_in[i];
  p.out = (float*)d_out; p.ws = (unsigned char*)d_ws;
  void* args[] = {&p};
  hipError_t e = hipLaunchCooperativeKernel((void*)fwd_megakernel, dim3(grid_blocks), dim3(NT), args, LDS_BYTES, stream);
  if (e != hipSuccess) fprintf(stderr, "cooperative launch failed: %s (grid %d)\n", hipGetErrorString(e), grid_blocks);
}
```

```cpp
#include <hip/hip_runtime.h>
#include <hip/hip_cooperative_groups.h>
#include <cstdio>
#include <cstdint>
namespace cg = cooperative_groups;

typedef unsigned short bf16_t;
typedef short bf16x8 __attribute__((ext_vector_type(8)));
typedef float f32x4 __attribute__((ext_vector_type(4)));

constexpr int T_ = 16384, D_ = 1024, L_ = 8192, NBATCH = 2, DEPTH_ = 4;
constexpr int INC = 2944, INCP = 3072;
constexpr int NCH = 128;
constexpr int NT = 512;
constexpr int NW = 8;
constexpr float EPS_ = 1e-6f;
constexpr int C_QA = 0, C_KA = 384, C_VA = 768, C_QR = 1152, C_KR = 1536, C_VR = 1920, C_GR = 2304, C_US = 2688;

constexpr size_t al256(size_t x) { return (x + 255) & ~(size_t)255; }
constexpr size_t WS_MOD   = 0;
constexpr size_t WS_ROTC  = al256(WS_MOD + 4ull * 2 * 6144 * 4);
constexpr size_t WS_ROTS  = al256(WS_ROTC + 8192ull * 32 * 4);
constexpr size_t WS_SA    = al256(WS_ROTS + 8192ull * 32 * 4);
constexpr size_t WS_SBB   = al256(WS_SA + 4ull * 16 * 64 * 2 * 4);
constexpr size_t WS_WIN   = al256(WS_SBB + 4ull * 16 * 64 * 32 * 4);
constexpr size_t WS_WOUT  = al256(WS_WIN + 4ull * INCP * 1024 * 2);
constexpr size_t WS_WQ    = al256(WS_WOUT + 4ull * 1024 * 1024 * 2);
constexpr size_t WS_SUBK  = al256(WS_WQ + 4ull * 2048 * 1024 * 2);
constexpr size_t WS_ABUF  = al256(WS_SUBK + 4ull * 16 * 128 * 128 * 2);
constexpr size_t WS_PROJ  = al256(WS_ABUF + (size_t)T_ * 1024 * 2);
constexpr size_t WS_VTA   = al256(WS_PROJ + (size_t)T_ * INCP * 2);
constexpr size_t WS_ATT   = al256(WS_VTA + 2ull * 6 * 64 * 8192 * 2);
constexpr size_t WS_YINT  = al256(WS_ATT + (size_t)T_ * 384 * 4);
constexpr size_t WS_UPD   = al256(WS_YINT + (size_t)T_ * 384 * 4);
constexpr size_t WS_SPREV = al256(WS_UPD + 256ull * 6 * 4096 * 4);
constexpr size_t WS_SEND  = al256(WS_SPREV + 256ull * 6 * 4096 * 4);
constexpr size_t WS_CARRY = al256(WS_SEND + 256ull * 16 * 64 * 2 * 4);
constexpr size_t WS_X     = al256(WS_CARRY + 256ull * 16 * 64 * 2 * 4);
constexpr size_t WS_Q     = al256(WS_X + (size_t)T_ * 1024 * 4);
constexpr size_t WS_SC    = al256(WS_Q + (size_t)T_ * 2048 * 2);
constexpr size_t WS_EIDX  = al256(WS_SC + (size_t)T_ * 2048 * 4);
constexpr size_t WS_EGATE = al256(WS_EIDX + (size_t)T_ * 128 * 4);
constexpr size_t WS_PU8   = al256(WS_EGATE + (size_t)T_ * 128 * 4);
constexpr size_t WS_PV8   = al256(WS_PU8 + 4ull * 16384 * 1024);
constexpr size_t WS_BAR   = al256(WS_PV8 + 4ull * 16384 * 1024);
constexpr size_t WS_END   = al256(WS_BAR + 3456ull * 4);

constexpr int LDS_BYTES = 135168;

struct Params {
  const float* in[24];
  float* out;
  unsigned char* ws;
};
enum { I_X = 0, I_C, I_WADA, I_BADA, I_NMIX, I_NFFN, I_WIN, I_RELB, I_LRE, I_LIM, I_LOGDT, I_BRE, I_BIM, I_CRE, I_CIM, I_SSMD,
       I_WGLU, I_MGAIN, I_WOUT, I_WQ, I_SUBK, I_PU, I_PV, I_FNORM };

__device__ __forceinline__ float bf2f(bf16_t v) { return __uint_as_float(((unsigned)v) << 16); }
__device__ __forceinline__ bf16_t f2bf(float f) { unsigned u = __float_as_uint(f); u += 0x7fffu + ((u >> 16) & 1u); return (bf16_t)(u >> 16); }
__device__ __forceinline__ unsigned pk2(float a, float b) { return (unsigned)f2bf(a) | ((unsigned)f2bf(b) << 16); }
__device__ __forceinline__ float wave_sum(float v) {
#pragma unroll
  for (int o = 32; o > 0; o >>= 1) v += __shfl_xor(v, o);
  return v;
}
__device__ __forceinline__ float wave_max(float v) {
#pragma unroll
  for (int o = 32; o > 0; o >>= 1) v = fmaxf(v, __shfl_xor(v, o));
  return v;
}
__device__ __forceinline__ float gelu_tanh(float x) { const float u = 0.7978845608028654f * (x + 0.044715f * x * x * x); return 0.5f * x * (1.f + tanhf(u)); }
__device__ __forceinline__ float sigmoid_f(float x) { return 1.f / (1.f + __expf(-x)); }
__device__ __forceinline__ unsigned char* launder_ptr(unsigned char* q) { asm volatile("" : "+s"(q)); return q; }
__device__ __forceinline__ const float* launder_cptr(const float* q) { asm volatile("" : "+s"(q)); return q; }
__device__ __forceinline__ int launder_tid() { int t = threadIdx.x; asm volatile("" : "+v"(t)); return t; }

__device__ void setup_phase(const Params& p, unsigned char* smem) {
  unsigned char* const ws = launder_ptr(p.ws); const int tidx = launder_tid(); (void)ws; (void)tidx;
  const int tid = tidx;
  float* sm = (float*)smem;
  {
    float* cond = sm;
    float* red = sm + 2048;
    float* MOD = (float*)(ws + WS_MOD);
    for (int i = tid; i < 2048; i += NT) { const float c = p.in[I_C][i]; cond[i] = c * sigmoid_f(c); }
    __syncthreads();
    for (int item = blockIdx.x; item < 4 * 96; item += gridDim.x) {
      const int l = item / 96, cb = item % 96, kq = tid >> 6, jj = tid & 63, j = cb * 64 + jj;
      const float* w = p.in[I_WADA] + (size_t)l * 1024 * 6144 + j;
      float a0 = 0.f, a1 = 0.f;
      for (int k = kq * 128; k < kq * 128 + 128; ++k) { const float wv = w[(size_t)k * 6144]; a0 += cond[k] * wv; a1 += cond[1024 + k] * wv; }
      red[(kq * 2 + 0) * 64 + jj] = a0; red[(kq * 2 + 1) * 64 + jj] = a1;
      __syncthreads();
      if (tid < 128) {
        const int b = tid >> 6, j2 = tid & 63; float s = 0.f;
        for (int q = 0; q < 8; ++q) s += red[(q * 2 + b) * 64 + j2];
        MOD[((size_t)l * 2 + b) * 6144 + cb * 64 + j2] = s + p.in[I_BADA][(size_t)l * 6144 + cb * 64 + j2];
      }
      __syncthreads();
    }
  }
  const int gtid = blockIdx.x * NT + tid, gn = gridDim.x * NT;
  {
    float* RC = (float*)(ws + WS_ROTC); float* RS = (float*)(ws + WS_ROTS);
    for (int idx = gtid; idx < 8192 * 32; idx += gn) {
      const int pos = idx >> 5, i = idx & 31;
      const float inv = powf(10000.0f, -(float)i / 32.0f);
      const float ang = (float)pos * inv;
      float s, c; sincosf(ang, &s, &c);
      RC[idx] = c; RS[idx] = s;
    }
  }
  {
    float* SA = (float*)(ws + WS_SA); float* SBB = (float*)(ws + WS_SBB);
    for (int idx = gtid; idx < 4 * 16 * 64; idx += gn) {
      const int l = idx / 1024, g = (idx >> 6) & 15;
      const float dt = expf(p.in[I_LOGDT][l * 16 + g]);
      const float lr = p.in[I_LRE][idx], li = p.in[I_LIM][idx];
      const float mag = expf(lr * dt);
      float sn, cs; sincosf(li * dt, &sn, &cs);
      const float are = mag * cs, aim = mag * sn;
      const float den = lr * lr + li * li, nr = are - 1.f, ni = aim;
      const float fre = (nr * lr + ni * li) / den, fim = (ni * lr - nr * li) / den;
      SA[idx * 2] = are; SA[idx * 2 + 1] = aim;
      for (int c = 0; c < 16; ++c) {
        const float br = p.in[I_BRE][(size_t)idx * 16 + c], bi = p.in[I_BIM][(size_t)idx * 16 + c];
        SBB[(size_t)idx * 32 + c] = fre * br - fim * bi;
        SBB[(size_t)idx * 32 + 16 + c] = fre * bi + fim * br;
      }
    }
  }
  {
    bf16_t* SK = (bf16_t*)(ws + WS_SUBK);
    for (int idx = gtid; idx < 4 * 16 * 128 * 128; idx += gn) SK[idx] = f2bf(p.in[I_SUBK][idx]);
  }
  {
    constexpr size_t NIT = 4ull * 16384 * 1024 / 16;
    for (size_t it = gtid; it < 2 * NIT; it += gn) {
      const int tb = it >= NIT ? 1 : 0; const size_t r = it - (size_t)tb * NIT;
      const f32x4* src = (const f32x4*)((tb ? p.in[I_PV] : p.in[I_PU]) + r * 16);
      const float sc = tb ? 64.f : 1024.f;
      unsigned o[4];
#pragma unroll
      for (int q = 0; q < 4; ++q) {
        const f32x4 a = src[q];
        const float x0 = fminf(fmaxf(a.x * sc, -448.f), 448.f), x1 = fminf(fmaxf(a.y * sc, -448.f), 448.f);
        const float x2 = fminf(fmaxf(a.z * sc, -448.f), 448.f), x3 = fminf(fmaxf(a.w * sc, -448.f), 448.f);
        int pk = __builtin_amdgcn_cvt_pk_fp8_f32(x0, x1, 0, false);
        pk = __builtin_amdgcn_cvt_pk_fp8_f32(x2, x3, pk, true);
        o[q] = (unsigned)pk;
      }
      *(uint4*)(ws + (tb ? WS_PV8 : WS_PU8) + r * 16) = make_uint4(o[0], o[1], o[2], o[3]);
    }
  }
  {
    float* tile = sm;
    constexpr int IT_IN = 4 * 16 * 48, IT_OUT = 4 * 16 * 16, IT_Q = 4 * 16 * 32;
    __syncthreads();
    for (int item = blockIdx.x; item < IT_IN + IT_OUT + IT_Q; item += gridDim.x) {
      const float* W; bf16_t* WT; int N, NP, r = item;
      if (r < IT_IN) { const int l = r / (16 * 48); r %= 16 * 48; W = p.in[I_WIN] + (size_t)l * 1024 * INC; WT = (bf16_t*)(ws + WS_WIN) + (size_t)l * INCP * 1024; N = INC; NP = 48; }
      else if (r < IT_IN + IT_OUT) { r -= IT_IN; const int l = r / 256; r %= 256; W = p.in[I_WOUT] + (size_t)l * 1024 * 1024; WT = (bf16_t*)(ws + WS_WOUT) + (size_t)l * 1024 * 1024; N = 1024; NP = 16; }
      else { r -= IT_IN + IT_OUT; const int l = r / 512; r %= 512; W = p.in[I_WQ] + (size_t)l * 1024 * 2048; WT = (bf16_t*)(ws + WS_WQ) + (size_t)l * 2048 * 1024; N = 2048; NP = 32; }
      const int kb = r / NP, nb = r % NP, k0 = kb * 64, n0 = nb * 64;
      {
        const int col = tid & 63, rr = tid >> 6;
#pragma unroll
        for (int i = 0; i < 8; ++i) { const int kk = rr + 8 * i; const int n = n0 + col; tile[kk * 65 + col] = (n < N) ? W[(size_t)(k0 + kk) * N + n] : 0.f; }
      }
      __syncthreads();
      {
        const int n = tid >> 3, kc = tid & 7; const float* s = tile + (kc * 8) * 65 + n;
        uint4 o; o.x = pk2(s[0], s[65]); o.y = pk2(s[2 * 65], s[3 * 65]); o.z = pk2(s[4 * 65], s[5 * 65]); o.w = pk2(s[6 * 65], s[7 * 65]);
        *(uint4*)(WT + (size_t)(n0 + n) * 1024 + k0 + kc * 8) = o;
      }
      __syncthreads();
    }
  }
}

__device__ void norm_mod_phase(const float* __restrict__ xsrc, const float* __restrict__ gain, const float* __restrict__ mod_sh, const float* __restrict__ mod_sc,
                               bf16_t* __restrict__ outp) {
  const int tidx = launder_tid();
  const int lane = tidx & 63, gw = blockIdx.x * NW + (tidx >> 6), nw = gridDim.x * NW;
  for (int t = gw; t < T_; t += nw) {
    const int b = t >> 13;
    const f32x4* xr = (const f32x4*)(xsrc + (size_t)t * 1024) + lane;
    f32x4 v[4]; float s = 0.f;
#pragma unroll
    for (int j = 0; j < 4; ++j) { v[j] = xr[64 * j]; s += v[j].x * v[j].x + v[j].y * v[j].y + v[j].z * v[j].z + v[j].w * v[j].w; }
    const float rstd = rsqrtf(wave_sum(s) * (1.f / 1024.f) + EPS_);
#pragma unroll
    for (int j = 0; j < 4; ++j) {
      const int c = lane * 4 + 256 * j;
      const f32x4 g = *(const f32x4*)(gain + c), sh = *(const f32x4*)(mod_sh + b * 6144 + c), sc = *(const f32x4*)(mod_sc + b * 6144 + c);
      const float o0 = v[j].x * rstd * g.x * (1.f + sc.x) + sh.x, o1 = v[j].y * rstd * g.y * (1.f + sc.y) + sh.y;
      const float o2 = v[j].z * rstd * g.z * (1.f + sc.z) + sh.z, o3 = v[j].w * rstd * g.w * (1.f + sc.w) + sh.w;
      uint2 o; o.x = pk2(o0, o1); o.y = pk2(o2, o3);
      *(uint2*)(outp + (size_t)t * 1024 + c) = o;
    }
  }
}

__device__ __forceinline__ void gemm_tile_128(const bf16_t* __restrict__ A, int lda, const bf16_t* __restrict__ Bt, int ldb, int K, unsigned char* smem, f32x4 (&acc)[4][2]) {
  const int tid = threadIdx.x, lane = tid & 63, wid = tid >> 6, wm = wid >> 2, wn = wid & 3, fr = lane & 15, fq = lane >> 4;
  bf16_t* As = (bf16_t*)smem; bf16_t* Bs = As + 128 * 72;
  const int r0 = tid >> 3, kc = tid & 7;
  const bf16_t* ap0 = A + (size_t)r0 * lda + kc * 8; const bf16_t* ap1 = ap0 + (size_t)64 * lda;
  const bf16_t* bp0 = Bt + (size_t)r0 * ldb + kc * 8; const bf16_t* bp1 = bp0 + (size_t)64 * ldb;
  uint4 ra0 = *(const uint4*)ap0, ra1 = *(const uint4*)ap1, rb0 = *(const uint4*)bp0, rb1 = *(const uint4*)bp1;
#pragma unroll
  for (int mi = 0; mi < 4; ++mi)
#pragma unroll
    for (int ni = 0; ni < 2; ++ni) acc[mi][ni] = (f32x4){0.f, 0.f, 0.f, 0.f};
  const int nk = K >> 6;
  for (int kt = 0; kt < nk; ++kt) {
    __syncthreads();
    *(uint4*)(As + r0 * 72 + kc * 8) = ra0; *(uint4*)(As + (r0 + 64) * 72 + kc * 8) = ra1;
    *(uint4*)(Bs + r0 * 72 + kc * 8) = rb0; *(uint4*)(Bs + (r0 + 64) * 72 + kc * 8) = rb1;
    __syncthreads();
    if (kt + 1 < nk) { ap0 += 64; ap1 += 64; bp0 += 64; bp1 += 64; ra0 = *(const uint4*)ap0; ra1 = *(const uint4*)ap1; rb0 = *(const uint4*)bp0; rb1 = *(const uint4*)bp1; }
#pragma unroll
    for (int ks = 0; ks < 2; ++ks) {
      bf16x8 af[4], bfr[2];
#pragma unroll
      for (int mi = 0; mi < 4; ++mi) af[mi] = *(const bf16x8*)(As + (wm * 64 + mi * 16 + fr) * 72 + ks * 32 + fq * 8);
#pragma unroll
      for (int ni = 0; ni < 2; ++ni) bfr[ni] = *(const bf16x8*)(Bs + (wn * 32 + ni * 16 + fr) * 72 + ks * 32 + fq * 8);
#pragma unroll
      for (int mi = 0; mi < 4; ++mi)
#pragma unroll
        for (int ni = 0; ni < 2; ++ni) acc[mi][ni] = __builtin_amdgcn_mfma_f32_16x16x32_bf16(bfr[ni], af[mi], acc[mi][ni], 0, 0, 0);
    }
  }
}

__device__ void gemm_proj_phase(const Params& p, int l, unsigned char* smem) {
  unsigned char* const ws = launder_ptr(p.ws); const int tidx = launder_tid(); (void)ws; (void)tidx;
  const bf16_t* A = (const bf16_t*)(ws + WS_ABUF); const bf16_t* Bt = (const bf16_t*)(ws + WS_WIN) + (size_t)l * INCP * 1024;
  bf16_t* PROJ = (bf16_t*)(ws + WS_PROJ); bf16_t* VTA = (bf16_t*)(ws + WS_VTA);
  const int lane = tidx & 63, wid = tidx >> 6, wm = wid >> 2, wn = wid & 3, fr = lane & 15, fq = lane >> 4;
  constexpr int NTL = INCP / 128;
  constexpr int NTU = 23;
  for (int u = blockIdx.x; u < 128 * NTU; u += gridDim.x) {
    const int mt = u / NTU, nt = u % NTU, m0 = mt * 128, n0 = nt * 128;
    f32x4 acc[4][2];
    gemm_tile_128(A + (size_t)m0 * 1024, 1024, Bt + (size_t)n0 * 1024, 1024, 1024, smem, acc);
#pragma unroll
    for (int mi = 0; mi < 4; ++mi)
#pragma unroll
      for (int ni = 0; ni < 2; ++ni) {
        const int t = m0 + wm * 64 + mi * 16 + fr, c = n0 + wn * 32 + ni * 16 + fq * 4;
        const f32x4 v = acc[mi][ni];
        uint2 o; o.x = pk2(v.x, v.y); o.y = pk2(v.z, v.w);
        *(uint2*)(PROJ + (size_t)t * INCP + c) = o;
        if (c >= C_VA && c < C_VA + 384) {
          const int b = t >> 13, lpos = t & 8191, ch = c - C_VA;
          bf16_t* vt = VTA + ((size_t)b * 384 + ch) * 8192 + lpos;
          vt[0] = f2bf(v.x); vt[8192] = f2bf(v.y); vt[2 * 8192] = f2bf(v.z); vt[3 * 8192] = f2bf(v.w);
        }
      }
  }
  (void)NTL;
}

__device__ void gemm_out_phase(const Params& p, int l, const float* __restrict__ xsrc, unsigned char* smem) {
  unsigned char* const ws = launder_ptr(p.ws); const int tidx = launder_tid(); (void)ws; (void)tidx;
  const bf16_t* A = (const bf16_t*)(ws + WS_ABUF); const bf16_t* Bt = (const bf16_t*)(ws + WS_WOUT) + (size_t)l * 1024 * 1024;
  float* X = (float*)(ws + WS_X); const float* g1 = (const float*)(ws + WS_MOD) + (size_t)l * 2 * 6144 + 2048;
  const int lane = tidx & 63, wid = tidx >> 6, wm = wid >> 2, wn = wid & 3, fr = lane & 15, fq = lane >> 4;
  for (int u = blockIdx.x; u < 128 * 8; u += gridDim.x) {
    const int mt = u >> 3, nt = u & 7, m0 = mt * 128, n0 = nt * 128;
    f32x4 acc[4][2];
    gemm_tile_128(A + (size_t)m0 * 1024, 1024, Bt + (size_t)n0 * 1024, 1024, 1024, smem, acc);
#pragma unroll
    for (int mi = 0; mi < 4; ++mi)
#pragma unroll
      for (int ni = 0; ni < 2; ++ni) {
        const int t = m0 + wm * 64 + mi * 16 + fr, c = n0 + wn * 32 + ni * 16 + fq * 4, b = t >> 13;
        const f32x4 xv = *(const f32x4*)(xsrc + (size_t)t * 1024 + c), g = *(const f32x4*)(g1 + b * 6144 + c);
        f32x4 o; o.x = xv.x + g.x * acc[mi][ni].x; o.y = xv.y + g.y * acc[mi][ni].y; o.z = xv.z + g.z * acc[mi][ni].z; o.w = xv.w + g.w * acc[mi][ni].w;
        *(f32x4*)(X + (size_t)t * 1024 + c) = o;
      }
  }
}

__device__ void gemm_q_phase(const Params& p, int l, unsigned char* smem) {
  unsigned char* const ws = launder_ptr(p.ws); const int tidx = launder_tid(); (void)ws; (void)tidx;
  const bf16_t* A = (const bf16_t*)(ws + WS_ABUF); const bf16_t* Bt = (const bf16_t*)(ws + WS_WQ) + (size_t)l * 2048 * 1024;
  bf16_t* Q = (bf16_t*)(ws + WS_Q);
  const int lane = tidx & 63, wid = tidx >> 6, wm = wid >> 2, wn = wid & 3, fr = lane & 15, fq = lane >> 4;
  for (int u = blockIdx.x; u < 128 * 16; u += gridDim.x) {
    const int mt = u >> 4, nt = u & 15, m0 = mt * 128, n0 = nt * 128;
    f32x4 acc[4][2];
    gemm_tile_128(A + (size_t)m0 * 1024, 1024, Bt + (size_t)n0 * 1024, 1024, 1024, smem, acc);
#pragma unroll
    for (int mi = 0; mi < 4; ++mi)
#pragma unroll
      for (int ni = 0; ni < 2; ++ni) {
        const int t = m0 + wm * 64 + mi * 16 + fr, c = n0 + wn * 32 + ni * 16 + fq * 4;
        const f32x4 v = acc[mi][ni];
        uint2 o; o.x = pk2(v.x, v.y); o.y = pk2(v.z, v.w);
        *(uint2*)(Q + (size_t)t * 2048 + c) = o;
      }
  }
}

__device__ void attn_phase(const Params& p, int l) {
  unsigned char* const ws = launder_ptr(p.ws); const int tidx = launder_tid(); (void)ws; (void)tidx;
  const bf16_t* PROJ = (const bf16_t*)(ws + WS_PROJ); const bf16_t* VTA = (const bf16_t*)(ws + WS_VTA);
  float* ATT = (float*)(ws + WS_ATT);
  const int lane = tidx & 63, fr = lane & 15, fq = lane >> 4;
  const int gw = blockIdx.x * NW + (tidx >> 6), nw = gridDim.x * NW;
  for (int task = gw; task < 256 * 24; task += nw) {
    const int item = task / 24, rb = task % 24, h = rb >> 2, qb = rb & 3;
    const int b = item >> 7, n = item & 127, t0 = b * 8192 + n * 64;
    const float* rbias = p.in[I_RELB] + ((size_t)l * 6 + h) * 513;
    const int iq = qb * 16 + fr;
    bf16x8 qf[2];
#pragma unroll
    for (int ds = 0; ds < 2; ++ds) qf[ds] = *(const bf16x8*)(PROJ + (size_t)(t0 + iq) * INCP + C_QA + h * 64 + ds * 32 + fq * 8);
    f32x4 o[4];
#pragma unroll
    for (int et = 0; et < 4; ++et) o[et] = (f32x4){0.f, 0.f, 0.f, 0.f};
    float mrun = -1e30f, lrun = 0.f;
    for (int jc = 0; jc < 9; ++jc) {
      const int m = n - 8 + jc;
      if (m < 0) continue;
      const int tk = b * 8192 + m * 64;
      float s[2][2][4];
#pragma unroll
      for (int g = 0; g < 2; ++g)
#pragma unroll
        for (int tt = 0; tt < 2; ++tt) {
          const int key = tk + 32 * g + 8 * (fr >> 2) + (fr & 3) + 4 * tt;
          const bf16_t* kp = PROJ + (size_t)key * INCP + C_KA + h * 64 + fq * 8;
          const bf16x8 k0 = *(const bf16x8*)kp, k1 = *(const bf16x8*)(kp + 32);
          f32x4 st = (f32x4){0.f, 0.f, 0.f, 0.f};
          st = __builtin_amdgcn_mfma_f32_16x16x32_bf16(k0, qf[0], st, 0, 0, 0);
          st = __builtin_amdgcn_mfma_f32_16x16x32_bf16(k1, qf[1], st, 0, 0, 0);
#pragma unroll
          for (int j = 0; j < 4; ++j) {
            const int kk = 32 * g + 8 * fq + 4 * tt + j;
            int diff = 512 + iq - (64 * jc + kk);
            diff = diff > 256 ? 256 : diff;
            s[g][tt][j] = st[j] * 0.125f + rbias[diff + 256];
          }
        }
      float mloc = -1e30f;
#pragma unroll
      for (int g = 0; g < 2; ++g)
#pragma unroll
        for (int tt = 0; tt < 2; ++tt)
#pragma unroll
          for (int j = 0; j < 4; ++j) mloc = fmaxf(mloc, s[g][tt][j]);
      mloc = fmaxf(mloc, __shfl_xor(mloc, 16)); mloc = fmaxf(mloc, __shfl_xor(mloc, 32));
      const float mnew = fmaxf(mrun, mloc), alpha = __expf(mrun - mnew);
      mrun = mnew;
      float ls = 0.f;
#pragma unroll
      for (int g = 0; g < 2; ++g)
#pragma unroll
        for (int tt = 0; tt < 2; ++tt)
#pragma unroll
          for (int j = 0; j < 4; ++j) { const float e = __expf(s[g][tt][j] - mnew); s[g][tt][j] = e; ls += e; }
      lrun = lrun * alpha + ls;
#pragma unroll
      for (int et = 0; et < 4; ++et) { o[et].x *= alpha; o[et].y *= alpha; o[et].z *= alpha; o[et].w *= alpha; }
#pragma unroll
      for (int g = 0; g < 2; ++g) {
        union { bf16x8 v; unsigned u[4]; } pf;
        pf.u[0] = pk2(s[g][0][0], s[g][0][1]); pf.u[1] = pk2(s[g][0][2], s[g][0][3]);
        pf.u[2] = pk2(s[g][1][0], s[g][1][1]); pf.u[3] = pk2(s[g][1][2], s[g][1][3]);
#pragma unroll
        for (int et = 0; et < 4; ++et) {
          const bf16x8 vf = *(const bf16x8*)(VTA + ((size_t)b * 384 + h * 64 + et * 16 + fr) * 8192 + m * 64 + 32 * g + 8 * fq);
          o[et] = __builtin_amdgcn_mfma_f32_16x16x32_bf16(vf, pf.v, o[et], 0, 0, 0);
        }
      }
    }
    lrun += __shfl_xor(lrun, 16); lrun += __shfl_xor(lrun, 32);
    const float inv = 1.f / lrun;
#pragma unroll
    for (int et = 0; et < 4; ++et) {
      f32x4 v = o[et]; v.x *= inv; v.y *= inv; v.z *= inv; v.w *= inv;
      *(f32x4*)(ATT + (size_t)(t0 + iq) * 384 + h * 64 + et * 16 + fq * 4) = v;
    }
  }
}

__device__ void mix_local_phase(const Params& p, int l, unsigned char* smem) {
  unsigned char* const ws = launder_ptr(p.ws); const int tidx = launder_tid(); (void)ws; (void)tidx;
  const bf16_t* PROJ = (const bf16_t*)(ws + WS_PROJ);
  const float* RC = (const float*)(ws + WS_ROTC); const float* RS = (const float*)(ws + WS_ROTS);
  float* YINT = (float*)(ws + WS_YINT); float* UPD = (float*)(ws + WS_UPD);
  const float* SA = (const float*)(ws + WS_SA) + (size_t)l * 16 * 64 * 2; const float* SBB = (const float*)(ws + WS_SBB) + (size_t)l * 16 * 64 * 32;
  float* SEND = (float*)(ws + WS_SEND);
  const int tid = tidx, lane = tid & 63, wid = tid >> 6;
  float* qf = (float*)smem; float* kf = qf + 64 * 65; float* vv = kf + 64 * 65; float* S = vv + 64 * 65; float* kdec = S + 64 * 65;
  float* ussm = kdec + 64;
  for (int item = blockIdx.x; item < 256; item += gridDim.x) {
    const int b = item >> 7, n = item & 127, t0 = b * 8192 + n * 64;
    for (int h = 0; h < 6; ++h) {
      const float lg = log1pf(-exp2f(-5.f - (float)h));
      __syncthreads();
#pragma unroll
      for (int r = 0; r < 4; ++r) {
        const int idx = tid + NT * r, i = idx >> 5, dd = idx & 31;
        const bf16_t* row = PROJ + (size_t)(t0 + i) * INCP;
        const float c = RC[(n * 64 + i) * 32 + dd], s = RS[(n * 64 + i) * 32 + dd];
        const float q1 = bf2f(row[C_QR + h * 64 + dd]), q2 = bf2f(row[C_QR + h * 64 + dd + 32]);
        const float k1 = bf2f(row[C_KR + h * 64 + dd]) * 0.125f, k2 = bf2f(row[C_KR + h * 64 + dd + 32]) * 0.125f;
        qf[i * 65 + dd] = q1 * c - q2 * s; qf[i * 65 + dd + 32] = q1 * s + q2 * c;
        kf[i * 65 + dd] = k1 * c - k2 * s; kf[i * 65 + dd + 32] = k1 * s + k2 * c;
        vv[i * 65 + dd] = bf2f(row[C_VR + h * 64 + dd]); vv[i * 65 + dd + 32] = bf2f(row[C_VR + h * 64 + dd + 32]);
      }
      if (tid < 64) kdec[tid] = __expf(lg * (float)(63 - tid));
      __syncthreads();
#pragma unroll 1
      for (int r = 0; r < 8; ++r) {
        const int idx = tid + NT * r, i = idx >> 6, j = idx & 63;
        float a = 0.f;
#pragma unroll 16
        for (int d = 0; d < 64; ++d) a += qf[i * 65 + d] * kf[j * 65 + d];
        const int dij = i > j ? i - j : j - i;
        S[i * 65 + j] = a * __expf(lg * (float)dij);
      }
      __syncthreads();
#pragma unroll 1
      for (int r = 0; r < 8; ++r) {
        const int idx = tid + NT * r, i = idx >> 6, e = idx & 63;
        float a = 0.f, u = 0.f;
#pragma unroll 16
        for (int j = 0; j < 64; ++j) { a += S[i * 65 + j] * vv[j * 65 + e]; u += kf[j * 65 + i] * kdec[j] * vv[j * 65 + e]; }
        YINT[(size_t)(t0 + i) * 384 + h * 64 + e] = a;
        UPD[((size_t)item * 6 + h) * 4096 + i * 64 + e] = u;
      }
    }
    __syncthreads();
    for (int gi = 0; gi < 2; ++gi) {
      const int g = wid * 2 + gi;
      float* uw = ussm + wid * 1024;
#pragma unroll 4
      for (int r = 0; r < 16; ++r) { const int idx = lane + 64 * r, i = idx >> 4, c = idx & 15; uw[idx] = bf2f(PROJ[(size_t)(t0 + i) * INCP + C_US + g * 16 + c]); }
      float bbr[16], bbi[16];
      const float* bbp = SBB + ((size_t)g * 64 + lane) * 32;
#pragma unroll
      for (int c = 0; c < 16; ++c) { bbr[c] = bbp[c]; bbi[c] = bbp[16 + c]; }
      const float are = SA[(g * 64 + lane) * 2], aim = SA[(g * 64 + lane) * 2 + 1];
      float xr = 0.f, xi = 0.f;
#pragma unroll 2
      for (int i = 0; i < 64; ++i) {
        float br = 0.f, bi = 0.f;
#pragma unroll
        for (int c = 0; c < 16; ++c) { const float u = uw[i * 16 + c]; br += bbr[c] * u; bi += bbi[c] * u; }
        const float nr = are * xr - aim * xi + br, ni = are * xi + aim * xr + bi;
        xr = nr; xi = ni;
      }
      SEND[(((size_t)item * 16 + g) * 64 + lane) * 2] = xr; SEND[(((size_t)item * 16 + g) * 64 + lane) * 2 + 1] = xi;
    }
  }
}

__device__ void scan_phase(const Params& p, int l) {
  unsigned char* const ws = launder_ptr(p.ws); const int tidx = launder_tid(); (void)ws; (void)tidx;
  const float* UPD = (const float*)(ws + WS_UPD); float* SPREV = (float*)(ws + WS_SPREV);
  const float* SEND = (const float*)(ws + WS_SEND); float* CARRY = (float*)(ws + WS_CARRY);
  const float* SA = (const float*)(ws + WS_SA) + (size_t)l * 16 * 64 * 2;
  const int gtid = blockIdx.x * NT + tidx, gn = gridDim.x * NT;
  for (int idx = gtid; idx < 2 * 6 * 4096 + 2 * 1024; idx += gn) {
    if (idx < 2 * 6 * 4096) {
      const int b = idx / (6 * 4096), r = idx % (6 * 4096), h = r >> 12;
      const float cd = __expf(64.f * log1pf(-exp2f(-5.f - (float)h)));
      float s = 0.f;
      for (int n = 0; n < NCH; ++n) {
        const size_t off = ((size_t)(b * NCH + n)) * 6 * 4096 + r;
        SPREV[off] = s;
        s = cd * s + UPD[off];
      }
    } else {
      const int r2 = idx - 2 * 6 * 4096, b = r2 >> 10, gp = r2 & 1023;
      float ar = SA[gp * 2], ai = SA[gp * 2 + 1];
#pragma unroll
      for (int q = 0; q < 6; ++q) { const float nr = ar * ar - ai * ai, ni = 2.f * ar * ai; ar = nr; ai = ni; }
      float xr = 0.f, xi = 0.f;
      for (int n = 0; n < NCH; ++n) {
        const size_t off = (((size_t)(b * NCH + n)) * 1024 + gp) * 2;
        CARRY[off] = xr; CARRY[off + 1] = xi;
        const float sr = SEND[off], si = SEND[off + 1];
        const float nr = ar * xr - ai * xi + sr, ni = ar * xi + ai * xr + si;
        xr = nr; xi = ni;
      }
    }
  }
}

__device__ void mix_final_phase(const Params& p, int l, unsigned char* smem) {
  unsigned char* const ws = launder_ptr(p.ws); const int tidx = launder_tid(); (void)ws; (void)tidx;
  const bf16_t* PROJ = (const bf16_t*)(ws + WS_PROJ);
  const float* RC = (const float*)(ws + WS_ROTC); const float* RS = (const float*)(ws + WS_ROTS);
  const float* YINT = (const float*)(ws + WS_YINT); const float* SPREV = (const float*)(ws + WS_SPREV);
  const float* ATT = (const float*)(ws + WS_ATT);
  const float* SA = (const float*)(ws + WS_SA) + (size_t)l * 16 * 64 * 2; const float* SBB = (const float*)(ws + WS_SBB) + (size_t)l * 16 * 64 * 32;
  const float* CARRY = (const float*)(ws + WS_CARRY);
  const float* cre = p.in[I_CRE] + (size_t)l * 16 * 16 * 64; const float* cim = p.in[I_CIM] + (size_t)l * 16 * 16 * 64;
  const float* dsk = p.in[I_SSMD] + (size_t)l * 256; const float* wglu = p.in[I_WGLU] + (size_t)l * 256 * 512;
  const float* mg = p.in[I_MGAIN] + (size_t)l * 1024;
  bf16_t* MRG = (bf16_t*)(ws + WS_ABUF);
  const int tid = tidx, lane = tid & 63, wid = tid >> 6;
  float* qf = (float*)smem; float* sp = qf + 64 * 65; float* Y = sp + 64 * 64;
  float* YS = (float*)smem;
  float* wv = (float*)(smem + 64 * 257 * 4);
  for (int item = blockIdx.x; item < 256; item += gridDim.x) {
    const int b = item >> 7, n = item & 127, t0 = b * 8192 + n * 64;
    for (int ii = 0; ii < 8; ++ii) {
      const int t = t0 + wid * 8 + ii;
      float v[6]; float s = 0.f;
#pragma unroll
      for (int j = 0; j < 6; ++j) { v[j] = ATT[(size_t)t * 384 + lane + 64 * j]; s += v[j] * v[j]; }
      const float rstd = rsqrtf(wave_sum(s) * (1.f / 384.f) + EPS_);
#pragma unroll
      for (int j = 0; j < 6; ++j) MRG[(size_t)t * 1024 + lane + 64 * j] = f2bf(v[j] * rstd * mg[lane + 64 * j]);
    }
    for (int h = 0; h < 6; ++h) {
      const float lg = log1pf(-exp2f(-5.f - (float)h));
      __syncthreads();
#pragma unroll
      for (int r = 0; r < 4; ++r) {
        const int idx = tid + NT * r, i = idx >> 5, dd = idx & 31;
        const bf16_t* row = PROJ + (size_t)(t0 + i) * INCP;
        const float c = RC[(n * 64 + i) * 32 + dd], s = RS[(n * 64 + i) * 32 + dd];
        const float q1 = bf2f(row[C_QR + h * 64 + dd]), q2 = bf2f(row[C_QR + h * 64 + dd + 32]);
        qf[i * 65 + dd] = q1 * c - q2 * s; qf[i * 65 + dd + 32] = q1 * s + q2 * c;
      }
#pragma unroll
      for (int r = 0; r < 8; ++r) { const int idx = tid + NT * r; sp[idx] = SPREV[((size_t)item * 6 + h) * 4096 + idx]; }
      __syncthreads();
#pragma unroll 1
      for (int r = 0; r < 8; ++r) {
        const int idx = tid + NT * r, i = idx >> 6, e = idx & 63;
        float a = 0.f;
#pragma unroll 16
        for (int d = 0; d < 64; ++d) a += qf[i * 65 + d] * sp[d * 64 + e];
        Y[i * 65 + e] = YINT[(size_t)(t0 + i) * 384 + h * 64 + e] + __expf(lg * (float)(i + 1)) * a;
      }
      __syncthreads();
      for (int ii = 0; ii < 8; ++ii) {
        const int i = wid * 8 + ii, t = t0 + i;
        const float v = Y[i * 65 + lane];
        const float mu = wave_sum(v) * (1.f / 64.f);
        const float dv = v - mu;
        const float var = wave_sum(dv * dv) * (1.f / 64.f);
        const float gte = bf2f(PROJ[(size_t)t * INCP + C_GR + h * 64 + lane]);
        const float o = dv * rsqrtf(var + EPS_) * (gte * sigmoid_f(gte));
        MRG[(size_t)t * 1024 + 384 + h * 64 + lane] = f2bf(o * mg[384 + h * 64 + lane]);
      }
    }
    __syncthreads();
    for (int gi = 0; gi < 2; ++gi) {
      const int g = wid * 2 + gi;
      float* uw = wv + wid * 2048; float* xre = uw + 1024; float* xim = xre + 512;
#pragma unroll 4
      for (int r = 0; r < 16; ++r) { const int idx = lane + 64 * r, i = idx >> 4, c = idx & 15; uw[idx] = bf2f(PROJ[(size_t)(t0 + i) * INCP + C_US + g * 16 + c]); }
      float bbr[16], bbi[16];
      const float* bbp = SBB + ((size_t)g * 64 + lane) * 32;
#pragma unroll
      for (int c = 0; c < 16; ++c) { bbr[c] = bbp[c]; bbi[c] = bbp[16 + c]; }
      const float are = SA[(g * 64 + lane) * 2], aim = SA[(g * 64 + lane) * 2 + 1];
      float xr = CARRY[(((size_t)item * 16 + g) * 64 + lane) * 2], xi = CARRY[(((size_t)item * 16 + g) * 64 + lane) * 2 + 1];
      const int i8 = lane >> 3, c0 = (lane & 7) * 2;
      const float* cr0 = cre + ((size_t)g * 16 + c0) * 64; const float* ci0 = cim + ((size_t)g * 16 + c0) * 64;
#pragma unroll 1
      for (int blk = 0; blk < 8; ++blk) {
#pragma unroll 2
        for (int ii = 0; ii < 8; ++ii) {
          const int i = blk * 8 + ii;
          float br = 0.f, bi = 0.f;
#pragma unroll
          for (int c = 0; c < 16; ++c) { const float u = uw[i * 16 + c]; br += bbr[c] * u; bi += bbi[c] * u; }
          const float nr = are * xr - aim * xi + br, ni = are * xi + aim * xr + bi;
          xr = nr; xi = ni;
          xre[ii * 64 + lane] = xr; xim[ii * 64 + lane] = xi;
        }
        float a0 = 0.f, a1 = 0.f;
#pragma unroll 4
        for (int pp = 0; pp < 64; ++pp) {
          const float vr = xre[i8 * 64 + pp], vi = xim[i8 * 64 + pp];
          a0 += cr0[pp] * vr - ci0[pp] * vi;
          a1 += cr0[64 + pp] * vr - ci0[64 + pp] * vi;
        }
        const int i = blk * 8 + i8;
        const float y0 = a0 + dsk[g * 16 + c0] * uw[i * 16 + c0], y1 = a1 + dsk[g * 16 + c0 + 1] * uw[i * 16 + c0 + 1];
        YS[i * 257 + g * 16 + c0] = gelu_tanh(y0); YS[i * 257 + g * 16 + c0 + 1] = gelu_tanh(y1);
      }
    }
    __syncthreads();
    {
      const int nn = tid & 255, half = tid >> 8;
      float* OUTS = wv;
#pragma unroll 1
      for (int ps = 0; ps < 2; ++ps) {
        const int ib = half * 32 + ps * 16;
        float z1[16], z2[16];
#pragma unroll
        for (int i = 0; i < 16; ++i) { z1[i] = 0.f; z2[i] = 0.f; }
#pragma unroll 2
        for (int k = 0; k < 256; ++k) {
          const float w1 = wglu[(size_t)k * 512 + nn], w2 = wglu[(size_t)k * 512 + 256 + nn];
#pragma unroll
          for (int i = 0; i < 16; ++i) { const float yv = YS[(ib + i) * 257 + k]; z1[i] += yv * w1; z2[i] += yv * w2; }
        }
#pragma unroll
        for (int i = 0; i < 16; ++i) OUTS[(ib + i) * 256 + nn] = z1[i] * sigmoid_f(z2[i]);
      }
      __syncthreads();
      for (int ii = 0; ii < 8; ++ii) {
        const int i = wid * 8 + ii, t = t0 + i;
        float v[4]; float s = 0.f;
#pragma unroll
        for (int j = 0; j < 4; ++j) { v[j] = OUTS[i * 256 + lane + 64 * j]; s += v[j] * v[j]; }
        const float rstd = rsqrtf(wave_sum(s) * (1.f / 256.f) + EPS_);
#pragma unroll
        for (int j = 0; j < 4; ++j) MRG[(size_t)t * 1024 + 768 + lane + 64 * j] = f2bf(v[j] * rstd * mg[768 + lane + 64 * j]);
      }
    }
    __syncthreads();
  }
}

typedef float f32x2 __attribute__((ext_vector_type(2)));
__device__ __forceinline__ float dot16_fp8(const uint4 u, const float (&hv)[16]) {
  f32x2 c; float d;
  c = __builtin_amdgcn_cvt_pk_f32_fp8((int)u.x, false); d = c.x * hv[0] + c.y * hv[1];
  c = __builtin_amdgcn_cvt_pk_f32_fp8((int)u.x, true);  d += c.x * hv[2] + c.y * hv[3];
  c = __builtin_amdgcn_cvt_pk_f32_fp8((int)u.y, false); d += c.x * hv[4] + c.y * hv[5];
  c = __builtin_amdgcn_cvt_pk_f32_fp8((int)u.y, true);  d += c.x * hv[6] + c.y * hv[7];
  c = __builtin_amdgcn_cvt_pk_f32_fp8((int)u.z, false); d += c.x * hv[8] + c.y * hv[9];
  c = __builtin_amdgcn_cvt_pk_f32_fp8((int)u.z, true);  d += c.x * hv[10] + c.y * hv[11];
  c = __builtin_amdgcn_cvt_pk_f32_fp8((int)u.w, false); d += c.x * hv[12] + c.y * hv[13];
  c = __builtin_amdgcn_cvt_pk_f32_fp8((int)u.w, true);  d += c.x * hv[14] + c.y * hv[15];
  return d;
}
__device__ __forceinline__ void axpy16_fp8(const uint4 v, const float w, float (&acc)[16]) {
  f32x2 c;
  c = __builtin_amdgcn_cvt_pk_f32_fp8((int)v.x, false); acc[0] += w * c.x; acc[1] += w * c.y;
  c = __builtin_amdgcn_cvt_pk_f32_fp8((int)v.x, true);  acc[2] += w * c.x; acc[3] += w * c.y;
  c = __builtin_amdgcn_cvt_pk_f32_fp8((int)v.y, false); acc[4] += w * c.x; acc[5] += w * c.y;
  c = __builtin_amdgcn_cvt_pk_f32_fp8((int)v.y, true);  acc[6] += w * c.x; acc[7] += w * c.y;
  c = __builtin_amdgcn_cvt_pk_f32_fp8((int)v.z, false); acc[8] += w * c.x; acc[9] += w * c.y;
  c = __builtin_amdgcn_cvt_pk_f32_fp8((int)v.z, true);  acc[10] += w * c.x; acc[11] += w * c.y;
  c = __builtin_amdgcn_cvt_pk_f32_fp8((int)v.w, false); acc[12] += w * c.x; acc[13] += w * c.y;
  c = __builtin_amdgcn_cvt_pk_f32_fp8((int)v.w, true);  acc[14] += w * c.x; acc[15] += w * c.y;
}
typedef float f32x16 __attribute__((ext_vector_type(16)));
__device__ __forceinline__ float vmaxf(float a, float b) { float r; asm("v_max_f32 %0, %1, %2" : "=v"(r) : "v"(a), "v"(b)); return r; }
__device__ __forceinline__ float vminf(float a, float b) { float r; asm("v_min_f32 %0, %1, %2" : "=v"(r) : "v"(a), "v"(b)); return r; }
__device__ __forceinline__ void cx(float& hi, float& lo) { const float a = hi, b = lo; hi = vmaxf(a, b); lo = vminf(a, b); }
__device__ __forceinline__ void cx2(float& kh, int& ph, float& kl, int& pl) {
  const float a = kh, b = kl; const int pa = ph, pb = pl; const bool c = a >= b;
  kh = vmaxf(a, b); kl = vminf(a, b); ph = c ? pa : pb; pl = c ? pb : pa;
}
__device__ __forceinline__ void bitonic_sort16_desc(float (&v)[16]) {
#pragma unroll
  for (int k = 2; k <= 16; k <<= 1)
#pragma unroll
    for (int j = k >> 1; j > 0; j >>= 1)
#pragma unroll
      for (int i = 0; i < 16; ++i) {
        const int l = i ^ j;
        if (l > i) { if ((i & k) == 0) cx(v[i], v[l]); else cx(v[l], v[i]); }
      }
}
__device__ __forceinline__ void bitonic_merge16_desc(float (&v)[16]) {
#pragma unroll
  for (int j = 8; j > 0; j >>= 1)
#pragma unroll
    for (int i = 0; i < 16; ++i) { const int l = i ^ j; if (l > i) cx(v[i], v[l]); }
}
__device__ __forceinline__ void top16_merge(float (&a)[16], const float (&b)[16]) {
#pragma unroll
  for (int i = 0; i < 16; ++i) a[i] = vmaxf(a[i], b[15 - i]);
  bitonic_merge16_desc(a);
}
template <int M> __device__ __forceinline__ void top16_merge_chain(float (&k)[16], int (&q)[16], const float (&xk)[M], const int (&xq)[M]) {
#pragma unroll
  for (int i = 16 - M; i < 16; ++i) { const float a = k[i], b = xk[15 - i]; const bool c = a >= b; k[i] = vmaxf(a, b); q[i] = c ? q[i] : xq[15 - i]; }
#pragma unroll
  for (int j = 8; j > 0; j >>= 1)
#pragma unroll
    for (int i = 0; i < 16; ++i) { const int l = i ^ j; if (l > i) cx2(k[i], q[i], k[l], q[l]); }
}

__device__ void peer_phase(const Params& p, int l, bool last, unsigned char* smem) {
  unsigned char* const ws = launder_ptr(p.ws); const int tidx = launder_tid();
  bf16_t* HF = (bf16_t*)(ws + WS_ABUF); float* X = (float*)(ws + WS_X);
  const bf16_t* Q = (const bf16_t*)(ws + WS_Q); const bf16_t* SK = (const bf16_t*)(ws + WS_SUBK) + (size_t)l * 16 * 128 * 128;
  const uint4* U8 = (const uint4*)(ws + WS_PU8) + (size_t)l * 16384 * 64; const uint4* V8 = (const uint4*)(ws + WS_PV8) + (size_t)l * 16384 * 64;
  const float* g2 = (const float*)(ws + WS_MOD) + (size_t)l * 2 * 6144 + 5120;
  const int ln = last ? l : l + 1;
  const float* nsh = (const float*)(ws + WS_MOD) + (size_t)ln * 2 * 6144; const float* nsc = nsh + 1024;
  const float* ngain = p.in[I_NMIX] + (size_t)ln * 1024;
  const int lane = tidx & 63, wid = tidx >> 6;
  const int rL = ((lane >> 5) & 1) * 4 + ((lane >> 4) & 1) * 2 + ((lane >> 3) & 1);
  const bool hi5 = (lane & 32) != 0, hi4 = (lane & 16) != 0, hi3 = (lane & 8) != 0;
  int* idxL = (int*)smem; float* gateL = (float*)(smem + 64 * 132 * 4);
  for (int item = blockIdx.x; item < T_ / 64; item += gridDim.x) {
    const int t0 = item * 64;
    __syncthreads();
    {
      int lane_o = lane; asm volatile("" : "+v"(lane_o));
      const int tg = wid & 1, hp = wid >> 1, hf = lane_o >> 5, tl = 32 * tg + (lane_o & 31);
      const bf16_t* qrow = Q + (size_t)(t0 + tl) * 2048;
      float F[2][16];
#pragma unroll
      for (int sd = 0; sd < 2; ++sd) {
        float Lh[2][16];
#pragma unroll
        for (int hh = 0; hh < 2; ++hh) {
          const int hs = 2 * (2 * hp + hh) + sd;
          float top[16];
          const bf16_t* skb = SK + ((size_t)hs * 128 + (lane & 31)) * 128 + 8 * hf;
#pragma unroll
          for (int kp = 0; kp < 2; ++kp) {
            f32x16 acc[2];
#pragma unroll
            for (int kt = 0; kt < 2; ++kt)
#pragma unroll
              for (int r = 0; r < 16; ++r) acc[kt][r] = 0.f;
#pragma unroll 2
            for (int ks = 0; ks < 8; ++ks) {
              const bf16x8 bq = *(const bf16x8*)(qrow + hs * 128 + ks * 16 + 8 * hf);
#pragma unroll
              for (int kt = 0; kt < 2; ++kt) {
                const bf16x8 ak = *(const bf16x8*)(skb + (size_t)(kp * 2 + kt) * 32 * 128 + ks * 16);
                acc[kt] = __builtin_amdgcn_mfma_f32_32x32x16_bf16(ak, bq, acc[kt], 0, 0, 0);
              }
            }
#pragma unroll
            for (int kt = 0; kt < 2; ++kt) {
              float g[16];
#pragma unroll
              for (int r = 0; r < 16; ++r) {
                const int key = (kp * 2 + kt) * 32 + (r & 3) + 8 * (r >> 2) + 4 * hf;
                g[r] = __uint_as_float((__float_as_uint(acc[kt][r]) & 0xffffff80u) | (unsigned)key);
              }
              bitonic_sort16_desc(g);
              if (kp == 0 && kt == 0) {
#pragma unroll
                for (int r = 0; r < 16; ++r) top[r] = g[r];
              } else top16_merge(top, g);
              __builtin_amdgcn_sched_barrier(0);
            }
          }
#pragma unroll
          for (int r = 0; r < 16; ++r) Lh[hh][r] = top[r];
          __builtin_amdgcn_sched_barrier(0);
        }
#pragma unroll
        for (int r = 0; r < 16; ++r) {
          const auto sw = __builtin_amdgcn_permlane32_swap(__float_as_uint(Lh[0][r]), __float_as_uint(Lh[1][r]), false, false);
          Lh[0][r] = __uint_as_float(sw[0]); Lh[1][r] = __uint_as_float(sw[1]);
        }
        top16_merge(Lh[0], Lh[1]);
#pragma unroll
        for (int r = 0; r < 16; ++r) F[sd][r] = Lh[0][r];
        __builtin_amdgcn_sched_barrier(0);
      }
      int ia[16], ib[16];
#pragma unroll
      for (int r = 0; r < 16; ++r) { ia[r] = (int)(__float_as_uint(F[0][r]) & 127u) << 7; ib[r] = (int)(__float_as_uint(F[1][r]) & 127u); }
      float k[16]; int q[16];
#pragma unroll
      for (int j = 0; j < 16; ++j) { k[j] = F[0][0] + F[1][j]; q[j] = ia[0] | ib[j]; }
      { float xk[8]; int xq[8];
#pragma unroll
        for (int j = 0; j < 8; ++j) { xk[j] = F[0][1] + F[1][j]; xq[j] = ia[1] | ib[j]; }
        top16_merge_chain<8>(k, q, xk, xq); }
      { float xk[5]; int xq[5];
#pragma unroll
        for (int j = 0; j < 5; ++j) { xk[j] = F[0][2] + F[1][j]; xq[j] = ia[2] | ib[j]; }
        top16_merge_chain<5>(k, q, xk, xq); }
      { float xk[4]; int xq[4];
#pragma unroll
        for (int j = 0; j < 4; ++j) { xk[j] = F[0][3] + F[1][j]; xq[j] = ia[3] | ib[j]; }
        top16_merge_chain<4>(k, q, xk, xq); }
      { float xk[3]; int xq[3];
#pragma unroll
        for (int j = 0; j < 3; ++j) { xk[j] = F[0][4] + F[1][j]; xq[j] = ia[4] | ib[j]; }
        top16_merge_chain<3>(k, q, xk, xq); }
      { float xk[11]; int xq[11];
#pragma unroll
        for (int i = 0; i < 11; ++i) { xk[i] = F[0][5 + i] + F[1][0]; xq[i] = ia[5 + i] | ib[0]; }
        top16_merge_chain<11>(k, q, xk, xq); }
      { float xk[3]; int xq[3];
#pragma unroll
        for (int i = 0; i < 3; ++i) { xk[i] = F[0][5 + i] + F[1][1]; xq[i] = ia[5 + i] | ib[1]; }
        top16_merge_chain<3>(k, q, xk, xq); }
      float e[16]; float es = 0.f;
#pragma unroll
      for (int i = 0; i < 16; ++i) { e[i] = __expf(k[i] - k[0]); es += e[i]; }
      const float ies = 1.f / es;
      const int h = 2 * hp + hf;
#pragma unroll
      for (int i = 0; i < 16; ++i) { idxL[tl * 132 + h * 16 + i] = q[i]; gateL[tl * 132 + h * 16 + i] = e[i] * ies; }
    }
    __syncthreads();
#pragma unroll 1
    for (int ii = 0; ii < 8; ++ii) {
      const int tl = wid * 8 + ii, t = t0 + tl, b = t >> 13;
      float hv[16];
      {
        const uint4 h0 = *(const uint4*)(HF + (size_t)t * 1024 + lane * 16), h1 = *(const uint4*)(HF + (size_t)t * 1024 + lane * 16 + 8);
        const unsigned hw[8] = {h0.x, h0.y, h0.z, h0.w, h1.x, h1.y, h1.z, h1.w};
#pragma unroll
        for (int qq = 0; qq < 8; ++qq) { hv[2 * qq] = __uint_as_float(hw[qq] << 16); hv[2 * qq + 1] = __uint_as_float(hw[qq] & 0xffff0000u); }
      }
      const int e0 = idxL[tl * 132 + lane], e1 = idxL[tl * 132 + 64 + lane];
      const float g0 = gateL[tl * 132 + lane], g1 = gateL[tl * 132 + 64 + lane];
      float acc[16];
#pragma unroll
      for (int j = 0; j < 16; ++j) acc[j] = 0.f;
#pragma unroll 1
      for (int bt = 0; bt < 16; ++bt) {
        const int esrc = (bt < 8) ? e0 : e1; const float gsrc = (bt < 8) ? g0 : g1; const int lb = (bt & 7) * 8;
        uint4 ur[8], vr[8];
        int eidx[8];
#pragma unroll
        for (int r = 0; r < 8; ++r) eidx[r] = __builtin_amdgcn_readlane(esrc, lb + r);
#pragma unroll
        for (int r = 0; r < 8; ++r) ur[r] = U8[(size_t)eidx[r] * 64 + lane];
#pragma unroll
        for (int r = 0; r < 8; ++r) vr[r] = V8[(size_t)eidx[r] * 64 + lane];
        float d[8];
#pragma unroll
        for (int r = 0; r < 8; ++r) { d[r] = dot16_fp8(ur[r], hv); asm volatile("" : "+v"(d[r])); }
        float r4[4], r2[2];
#pragma unroll
        for (int i = 0; i < 4; ++i) { const float keep = hi5 ? d[i + 4] : d[i], send = hi5 ? d[i] : d[i + 4]; r4[i] = keep + __shfl_xor(send, 32); }
#pragma unroll
        for (int i = 0; i < 2; ++i) { const float keep = hi4 ? r4[i + 2] : r4[i], send = hi4 ? r4[i] : r4[i + 2]; r2[i] = keep + __shfl_xor(send, 16); }
        float r1;
        { const float keep = hi3 ? r2[1] : r2[0], send = hi3 ? r2[0] : r2[1]; r1 = keep + __shfl_xor(send, 8); }
        r1 += __shfl_xor(r1, 4); r1 += __shfl_xor(r1, 2); r1 += __shfl_xor(r1, 1);
        const float gl = __shfl(gsrc, lb + rL);
        const float w = gl * gelu_tanh(r1 * (1.f / 1024.f));
#pragma unroll
        for (int r = 0; r < 8; ++r) {
          const int Lk = ((r >> 2) & 1) * 32 + ((r >> 1) & 1) * 16 + (r & 1) * 8;
          const float wr = __int_as_float(__builtin_amdgcn_readlane(__float_as_int(w), Lk));
          axpy16_fp8(vr[r], wr, acc);
          __builtin_amdgcn_sched_barrier(0);
        }
      }
      float xn[16]; float ss = 0.f;
#pragma unroll
      for (int qq = 0; qq < 4; ++qq) {
        const int c = lane * 16 + 4 * qq;
        const f32x4 xv = *(const f32x4*)(X + (size_t)t * 1024 + c), g = *(const f32x4*)(g2 + b * 6144 + c);
        xn[4 * qq] = xv.x + g.x * acc[4 * qq] * (1.f / 64.f); xn[4 * qq + 1] = xv.y + g.y * acc[4 * qq + 1] * (1.f / 64.f);
        xn[4 * qq + 2] = xv.z + g.z * acc[4 * qq + 2] * (1.f / 64.f); xn[4 * qq + 3] = xv.w + g.w * acc[4 * qq + 3] * (1.f / 64.f);
        ss += xn[4 * qq] * xn[4 * qq] + xn[4 * qq + 1] * xn[4 * qq + 1] + xn[4 * qq + 2] * xn[4 * qq + 2] + xn[4 * qq + 3] * xn[4 * qq + 3];
      }
      const float rstd = rsqrtf(wave_sum(ss) * (1.f / 1024.f) + EPS_);
      if (!last) {
        unsigned hb[8];
#pragma unroll
        for (int qq = 0; qq < 4; ++qq) {
          const int c = lane * 16 + 4 * qq;
          *(f32x4*)(X + (size_t)t * 1024 + c) = (f32x4){xn[4 * qq], xn[4 * qq + 1], xn[4 * qq + 2], xn[4 * qq + 3]};
          const f32x4 gn = *(const f32x4*)(ngain + c), sh = *(const f32x4*)(nsh + b * 6144 + c), sc = *(const f32x4*)(nsc + b * 6144 + c);
          hb[2 * qq] = pk2(xn[4 * qq] * rstd * gn.x * (1.f + sc.x) + sh.x, xn[4 * qq + 1] * rstd * gn.y * (1.f + sc.y) + sh.y);
          hb[2 * qq + 1] = pk2(xn[4 * qq + 2] * rstd * gn.z * (1.f + sc.z) + sh.z, xn[4 * qq + 3] * rstd * gn.w * (1.f + sc.w) + sh.w);
        }
        *(uint4*)(HF + (size_t)t * 1024 + lane * 16) = make_uint4(hb[0], hb[1], hb[2], hb[3]);
        *(uint4*)(HF + (size_t)t * 1024 + lane * 16 + 8) = make_uint4(hb[4], hb[5], hb[6], hb[7]);
      } else {
#pragma unroll
        for (int qq = 0; qq < 4; ++qq) {
          const int c = lane * 16 + 4 * qq;
          const f32x4 fn = *(const f32x4*)(p.in[I_FNORM] + c);
          *(f32x4*)(p.out + (size_t)t * 1024 + c) = (f32x4){xn[4 * qq] * rstd * fn.x, xn[4 * qq + 1] * rstd * fn.y, xn[4 * qq + 2] * rstd * fn.z, xn[4 * qq + 3] * rstd * fn.w};
        }
      }
    }
  }
}

#define XB_TMO      128
#define XB_XCNT(j)  (256  + 64 * (j))
#define XB_XSUB(j)  (1280 + 64 * (j))
#define XB_XGEN(j)  (2304 + 64 * (j))
#define XB_TOP      3328
#define XB_TOPGEN   3392
#define XCD_BAR_WORDS 3456
#define XB_SPIN_CAP (1u << 20)
#define LAS __attribute__((address_space(3)))
__device__ __forceinline__ unsigned xb_ld(unsigned* q)              { return __hip_atomic_load(q, __ATOMIC_RELAXED, __HIP_MEMORY_SCOPE_AGENT); }
__device__ __forceinline__ unsigned xb_add(unsigned* q, unsigned v) { return __hip_atomic_fetch_add(q, v, __ATOMIC_RELAXED, __HIP_MEMORY_SCOPE_AGENT); }
__device__ __forceinline__ unsigned xb_xcc_id() { return (unsigned)__builtin_amdgcn_s_getreg((3 << 11) | 20) & 0xFu; }
#define XB_SPIN(cond, bar) do { unsigned _sp = 0; while (cond) { __builtin_amdgcn_s_sleep(1); \
    if ((++_sp & 255u) == 0u) { if (xb_ld(&(bar)[XB_TMO])) break; if (_sp > XB_SPIN_CAP) { atomicAdd(&(bar)[XB_TMO], 1u); break; } } } } while (0)
struct XcdBarrier { unsigned* bar; unsigned x; volatile LAS unsigned* st; };
__device__ __forceinline__ XcdBarrier xcd_barrier_post(unsigned* bar, volatile LAS unsigned* st) {
    XcdBarrier b; b.bar = bar; b.x = xb_xcc_id(); b.st = st;
    if (threadIdx.x == 0) (void)xb_add(&bar[XB_XCNT(b.x)], 1u);
    return b;
}
__device__ __forceinline__ void xcd_barrier_complete(unsigned* bar, unsigned x, unsigned& nloc, unsigned& nx) {
    const unsigned G = gridDim.x * gridDim.y * gridDim.z;
    unsigned sum, cnt, mine, sp = 0u;
    for (;;) {
        sum = 0u; cnt = 0u; mine = 0u;
#pragma unroll
        for (unsigned j = 0; j < 16; ++j) { const unsigned c = xb_ld(&bar[XB_XCNT(j)]); sum += c; cnt += (c > 0u) ? 1u : 0u; mine = (j == x) ? c : mine; }
        if (sum == G) break;
        __builtin_amdgcn_s_sleep(1);
        if ((++sp & 255u) == 0u) { if (xb_ld(&bar[XB_TMO])) break; if (sp > XB_SPIN_CAP) { atomicAdd(&bar[XB_TMO], 1u); break; } }
    }
    nloc = mine > 0u ? mine : 1u; nx = cnt > 0u ? cnt : 1u;
}
__device__ __forceinline__ void xcd_barrier(const XcdBarrier& b) {
    asm volatile("s_waitcnt vmcnt(0)" ::: "memory");
    __syncthreads();
    if (threadIdx.x == 0) {
        unsigned* bar = b.bar;
        __builtin_amdgcn_s_waitcnt(0);
        unsigned nloc = b.st[0], nx = b.st[1];
        if (nloc == 0u) { xcd_barrier_complete(bar, b.x, nloc, nx); b.st[0] = nloc; b.st[1] = nx; }
        const unsigned old = xb_add(&bar[XB_XSUB(b.x)], 1u);
        const unsigned gen = old / nloc;
        if (old + 1u == (gen + 1u) * nloc) {
            __builtin_amdgcn_fence(__ATOMIC_RELEASE, "agent");
            asm volatile("s_waitcnt vmcnt(0)" ::: "memory");
            const unsigned og = xb_add(&bar[XB_TOP], 1u);
            const unsigned tg = og / nx;
            if (og + 1u == (tg + 1u) * nx) xb_add(&bar[XB_TOPGEN], 1u);
            else XB_SPIN(xb_ld(&bar[XB_TOPGEN]) == tg, bar);
            __builtin_amdgcn_fence(__ATOMIC_ACQUIRE, "agent");
            xb_add(&bar[XB_XGEN(b.x)], 1u);
            asm volatile("s_waitcnt vmcnt(0)" ::: "memory");
        } else {
            XB_SPIN(xb_ld(&bar[XB_XGEN(b.x)]) == gen, bar);
            __builtin_amdgcn_fence(__ATOMIC_ACQUIRE, "agent");
            asm volatile("s_waitcnt vmcnt(0)" ::: "memory");
        }
    }
    __syncthreads();
}

__global__ void __launch_bounds__(NT) fwd_megakernel(Params p) {
  extern __shared__ __attribute__((aligned(16))) unsigned char smem[];
  cg::grid_group grid = cg::this_grid();
  volatile LAS unsigned* xbst = (volatile LAS unsigned*)(smem + LDS_BYTES - 16);
  if (threadIdx.x == 0) { xbst[0] = 0u; xbst[1] = 0u; }
  if (blockIdx.x == 0) { unsigned* bw = (unsigned*)(p.ws + WS_BAR); for (int i = threadIdx.x; i < XCD_BAR_WORDS; i += NT) bw[i] = 0u; }
  setup_phase(p, smem);
  grid.sync();
  const XcdBarrier xb = xcd_barrier_post((unsigned*)(p.ws + WS_BAR), xbst);
  const float* MOD = (const float*)(p.ws + WS_MOD);
  for (int l = 0; l < DEPTH_; ++l) {
    const float* xsrc = (l == 0) ? p.in[I_X] : (const float*)(p.ws + WS_X);
    const float* modl = MOD + (size_t)l * 2 * 6144;
    if (l == 0) {
      norm_mod_phase(xsrc, p.in[I_NMIX], modl + 0, modl + 1024, (bf16_t*)(p.ws + WS_ABUF));
      xcd_barrier(xb);
    }
    gemm_proj_phase(p, l, smem);
    xcd_barrier(xb);
    attn_phase(p, l);
    mix_local_phase(p, l, smem);
    xcd_barrier(xb);
    scan_phase(p, l);
    xcd_barrier(xb);
    mix_final_phase(p, l, smem);
    xcd_barrier(xb);
    gemm_out_phase(p, l, xsrc, smem);
    xcd_barrier(xb);
    norm_mod_phase((const float*)(p.ws + WS_X), p.in[I_NFFN] + (size_t)l * 1024, modl + 3072, modl + 4096, (bf16_t*)(p.ws + WS_ABUF));
    xcd_barrier(xb);
    gemm_q_phase(p, l, smem);
    xcd_barrier(xb);
    peer_phase(p, l, l == DEPTH_ - 1, smem);
    xcd_barrier(xb);
  }
}

extern "C" void kernel_launch(void* const* d_in, const int* in_sizes, int n_in,
                              void* d_out, int out_size, void* d_ws, size_t ws_size,
                              hipStream_t stream) {
  static int grid_blocks = 0;
  if (grid_blocks == 0) {
    if (n_in != 24 || ws_size < WS_END) { fprintf(stderr, "kernel_launch: unexpected n_in %d / ws_size %zu (need %zu)\n", n_in, ws_size, (size_t)WS_END); grid_blocks = -1; return; }
    int dev = 0, cus = 0, per_cu = 0;
    if (hipGetDevice(&dev) != hipSuccess || hipDeviceGetAttribute(&cus, hipDeviceAttributeMultiprocessorCount, dev) != hipSuccess) { grid_blocks = -1; return; }
    if (hipFuncSetAttribute((const void*)fwd_megakernel, hipFuncAttributeMaxDynamicSharedMemorySize, LDS_BYTES) != hipSuccess) { fprintf(stderr, "hipFuncSetAttribute failed\n"); grid_blocks = -1; return; }
    if (hipOccupancyMaxActiveBlocksPerMultiprocessor(&per_cu, (const void*)fwd_megakernel, NT, LDS_BYTES) != hipSuccess || per_cu < 1) { fprintf(stderr, "occupancy query: %d\n", per_cu); grid_blocks = -1; return; }
    grid_blocks = cus;
  }
  if (grid_blocks < 0) return;
  Params p{};
  for (int i = 0; i < 24; ++i) p.in[i] = (const float*)d_in[i];
  p.out = (float*)d_out; p.ws = (unsigned char*)d_ws;
  void* args[] = {&p};
  hipError_t e = hipLaunchCooperativeKernel((void*)fwd_megakernel, dim3(grid_blocks), dim3(NT), args, LDS_BYTES, stream);
  if (e != hipSuccess) fprintf(stderr, "cooperative launch failed: %s (grid %d)\n", hipGetErrorString(e), grid_blocks);
}
```

```cpp
#include <hip/hip_runtime.h>
#include <hip/hip_cooperative_groups.h>
#include <cstdio>
#include <cstdint>
namespace cg = cooperative_groups;

typedef unsigned short bf16_t;
typedef short bf16x8 __attribute__((ext_vector_type(8)));
typedef float f32x4 __attribute__((ext_vector_type(4)));

constexpr int T_ = 16384, D_ = 1024, L_ = 8192, NBATCH = 2, DEPTH_ = 4;
constexpr int INC = 2944, INCP = 3072;
constexpr int NCH = 128;
constexpr int NT = 512;
constexpr int NW = 8;
constexpr float EPS_ = 1e-6f;
constexpr int C_QA = 0, C_KA = 384, C_VA = 768, C_QR = 1152, C_KR = 1536, C_VR = 1920, C_GR = 2304, C_US = 2688;

constexpr size_t al256(size_t x) { return (x + 255) & ~(size_t)255; }
constexpr size_t WS_MOD   = 0;
constexpr size_t WS_ROTC  = al256(WS_MOD + 4ull * 2 * 6144 * 4);
constexpr size_t WS_ROTS  = al256(WS_ROTC + 8192ull * 32 * 4);
constexpr size_t WS_SA    = al256(WS_ROTS + 8192ull * 32 * 4);
constexpr size_t WS_SBB   = al256(WS_SA + 4ull * 16 * 64 * 2 * 4);
constexpr size_t WS_WIN   = al256(WS_SBB + 4ull * 16 * 64 * 32 * 4);
constexpr size_t WS_WOUT  = al256(WS_WIN + 4ull * INCP * 1024 * 2);
constexpr size_t WS_WQ    = al256(WS_WOUT + 4ull * 1024 * 1024 * 2);
constexpr size_t WS_SUBK  = al256(WS_WQ + 4ull * 2048 * 1024 * 2);
constexpr size_t WS_ABUF  = al256(WS_SUBK + 4ull * 16 * 128 * 128 * 2);
constexpr size_t WS_PROJ  = al256(WS_ABUF + (size_t)T_ * 1024 * 2);
constexpr size_t WS_VTA   = al256(WS_PROJ + (size_t)T_ * INCP * 2);
constexpr size_t WS_ATT   = al256(WS_VTA + 2ull * 6 * 64 * 8192 * 2);
constexpr size_t WS_YINT  = al256(WS_ATT + (size_t)T_ * 384 * 4);
constexpr size_t WS_UPD   = al256(WS_YINT + (size_t)T_ * 384 * 4);
constexpr size_t WS_SPREV = al256(WS_UPD + 256ull * 6 * 4096 * 4);
constexpr size_t WS_SEND  = al256(WS_SPREV + 256ull * 6 * 4096 * 4);
constexpr size_t WS_CARRY = al256(WS_SEND + 256ull * 16 * 64 * 2 * 4);
constexpr size_t WS_X     = al256(WS_CARRY + 256ull * 16 * 64 * 2 * 4);
constexpr size_t WS_Q     = al256(WS_X + (size_t)T_ * 1024 * 4);
constexpr size_t WS_SC    = al256(WS_Q + (size_t)T_ * 2048 * 2);
constexpr size_t WS_EIDX  = al256(WS_SC + (size_t)T_ * 2048 * 4);
constexpr size_t WS_EGATE = al256(WS_EIDX + (size_t)T_ * 128 * 4);
constexpr size_t WS_PU8   = al256(WS_EGATE + (size_t)T_ * 128 * 4);
constexpr size_t WS_PV8   = al256(WS_PU8 + 4ull * 16384 * 1024);
constexpr size_t WS_BAR   = al256(WS_PV8 + 4ull * 16384 * 1024);
constexpr size_t WS_SPT   = al256(WS_BAR + 3456ull * 4);
constexpr size_t WS_CB    = al256(WS_SPT + 256ull * 6 * 4096 * 2);
constexpr size_t WS_WGLUT = al256(WS_CB + 4ull * 16 * 16 * 128 * 2);
constexpr size_t WS_VTR   = al256(WS_WGLUT + 4ull * 512 * 256 * 2);
constexpr size_t WS_END   = al256(WS_VTR + 2ull * 384 * 8192 * 2);

constexpr int LDS_BYTES = 135168;

struct Params {
  const float* in[24];
  float* out;
  unsigned char* ws;
};
enum { I_X = 0, I_C, I_WADA, I_BADA, I_NMIX, I_NFFN, I_WIN, I_RELB, I_LRE, I_LIM, I_LOGDT, I_BRE, I_BIM, I_CRE, I_CIM, I_SSMD,
       I_WGLU, I_MGAIN, I_WOUT, I_WQ, I_SUBK, I_PU, I_PV, I_FNORM };

__device__ __forceinline__ float bf2f(bf16_t v) { return __uint_as_float(((unsigned)v) << 16); }
__device__ __forceinline__ bf16_t f2bf(float f) { unsigned u = __float_as_uint(f); u += 0x7fffu + ((u >> 16) & 1u); return (bf16_t)(u >> 16); }
__device__ __forceinline__ unsigned pk2(float a, float b) { return (unsigned)f2bf(a) | ((unsigned)f2bf(b) << 16); }
__device__ __forceinline__ float wave_sum(float v) {
#pragma unroll
  for (int o = 32; o > 0; o >>= 1) v += __shfl_xor(v, o);
  return v;
}
__device__ __forceinline__ float wave_max(float v) {
#pragma unroll
  for (int o = 32; o > 0; o >>= 1) v = fmaxf(v, __shfl_xor(v, o));
  return v;
}
__device__ __forceinline__ float gelu_tanh(float x) { const float u = 0.7978845608028654f * (x + 0.044715f * x * x * x); return 0.5f * x * (1.f + tanhf(u)); }
__device__ __forceinline__ float sigmoid_f(float x) { return 1.f / (1.f + __expf(-x)); }
__device__ __forceinline__ unsigned char* launder_ptr(unsigned char* q) { asm volatile("" : "+s"(q)); return q; }
__device__ __forceinline__ const float* launder_cptr(const float* q) { asm volatile("" : "+s"(q)); return q; }
__device__ __forceinline__ int launder_tid() { int t = threadIdx.x; asm volatile("" : "+v"(t)); return t; }
typedef const Params __attribute__((address_space(4)))* CParamsP;
__device__ __forceinline__ CParamsP launder_kargs() { CParamsP q = (CParamsP)__builtin_amdgcn_kernarg_segment_ptr(); asm volatile("" : "+s"(q)); return q; }

__device__ void setup_phase(const Params& p, unsigned char* smem) {
  const CParamsP pp = launder_kargs();
  unsigned char* const ws = launder_ptr(pp->ws); const int tidx = launder_tid(); (void)ws; (void)tidx;
  const int tid = tidx;
  float* sm = (float*)smem;
  {
    float* cond = sm;
    float* red = sm + 2048;
    float* MOD = (float*)(ws + WS_MOD);
    for (int i = tid; i < 2048; i += NT) { const float c = pp->in[I_C][i]; cond[i] = c * sigmoid_f(c); }
    __syncthreads();
    for (int item = blockIdx.x; item < 4 * 96; item += gridDim.x) {
      const int l = item / 96, cb = item % 96, kq = tid >> 6, jj = tid & 63, j = cb * 64 + jj;
      const float* w = pp->in[I_WADA] + (size_t)l * 1024 * 6144 + j;
      float a0 = 0.f, a1 = 0.f;
      for (int k = kq * 128; k < kq * 128 + 128; ++k) { const float wv = w[(size_t)k * 6144]; a0 += cond[k] * wv; a1 += cond[1024 + k] * wv; }
      red[(kq * 2 + 0) * 64 + jj] = a0; red[(kq * 2 + 1) * 64 + jj] = a1;
      __syncthreads();
      if (tid < 128) {
        const int b = tid >> 6, j2 = tid & 63; float s = 0.f;
        for (int q = 0; q < 8; ++q) s += red[(q * 2 + b) * 64 + j2];
        MOD[((size_t)l * 2 + b) * 6144 + cb * 64 + j2] = s + pp->in[I_BADA][(size_t)l * 6144 + cb * 64 + j2];
      }
      __syncthreads();
    }
  }
  const int gtid = blockIdx.x * NT + tid, gn = gridDim.x * NT;
  {
    float* RC = (float*)(ws + WS_ROTC); float* RS = (float*)(ws + WS_ROTS);
    for (int idx = gtid; idx < 8192 * 32; idx += gn) {
      const int pos = idx >> 5, i = idx & 31;
      const float inv = powf(10000.0f, -(float)i / 32.0f);
      const float ang = (float)pos * inv;
      float s, c; sincosf(ang, &s, &c);
      RC[idx] = c; RS[idx] = s;
    }
  }
  {
    float* SA = (float*)(ws + WS_SA); float* SBB = (float*)(ws + WS_SBB);
    for (int idx = gtid; idx < 4 * 16 * 64; idx += gn) {
      const int l = idx / 1024, g = (idx >> 6) & 15;
      const float dt = expf(pp->in[I_LOGDT][l * 16 + g]);
      const float lr = pp->in[I_LRE][idx], li = pp->in[I_LIM][idx];
      const float mag = expf(lr * dt);
      float sn, cs; sincosf(li * dt, &sn, &cs);
      const float are = mag * cs, aim = mag * sn;
      const float den = lr * lr + li * li, nr = are - 1.f, ni = aim;
      const float fre = (nr * lr + ni * li) / den, fim = (ni * lr - nr * li) / den;
      SA[idx * 2] = are; SA[idx * 2 + 1] = aim;
      for (int c = 0; c < 16; ++c) {
        const float br = pp->in[I_BRE][(size_t)idx * 16 + c], bi = pp->in[I_BIM][(size_t)idx * 16 + c];
        SBB[(size_t)idx * 32 + c] = fre * br - fim * bi;
        SBB[(size_t)idx * 32 + 16 + c] = fre * bi + fim * br;
      }
    }
  }
  {
    bf16_t* SK = (bf16_t*)(ws + WS_SUBK);
    for (int idx = gtid; idx < 4 * 16 * 128 * 128; idx += gn) SK[idx] = f2bf(pp->in[I_SUBK][idx]);
  }
  {
    bf16_t* CB = (bf16_t*)(ws + WS_CB);
    for (int idx = gtid; idx < 4 * 16 * 16 * 128; idx += gn) {
      const int k = idx & 127, lgc = idx >> 7;
      CB[idx] = (k < 64) ? f2bf(pp->in[I_CRE][(size_t)lgc * 64 + k]) : f2bf(-pp->in[I_CIM][(size_t)lgc * 64 + (k - 64)]);
    }
    bf16_t* WG = (bf16_t*)(ws + WS_WGLUT);
    for (int idx = gtid; idx < 4 * 512 * 256; idx += gn) {
      const int k = idx & 255, nn = (idx >> 8) & 511, l2 = idx >> 17;
      WG[idx] = f2bf(pp->in[I_WGLU][((size_t)l2 * 256 + k) * 512 + nn]);
    }
  }
  {
    constexpr size_t NIT = 4ull * 16384 * 1024 / 16;
    for (size_t it = gtid; it < 2 * NIT; it += gn) {
      const int tb = it >= NIT ? 1 : 0; const size_t r = it - (size_t)tb * NIT;
      const f32x4* src = (const f32x4*)((tb ? pp->in[I_PV] : pp->in[I_PU]) + r * 16);
      const float sc = tb ? 64.f : 1024.f;
      unsigned o[4];
#pragma unroll
      for (int q = 0; q < 4; ++q) {
        const f32x4 a = src[q];
        const float x0 = fminf(fmaxf(a.x * sc, -448.f), 448.f), x1 = fminf(fmaxf(a.y * sc, -448.f), 448.f);
        const float x2 = fminf(fmaxf(a.z * sc, -448.f), 448.f), x3 = fminf(fmaxf(a.w * sc, -448.f), 448.f);
        int pk = __builtin_amdgcn_cvt_pk_fp8_f32(x0, x1, 0, false);
        pk = __builtin_amdgcn_cvt_pk_fp8_f32(x2, x3, pk, true);
        o[q] = (unsigned)pk;
      }
      *(uint4*)(ws + (tb ? WS_PV8 : WS_PU8) + r * 16) = make_uint4(o[0], o[1], o[2], o[3]);
    }
  }
  {
    float* tile = sm;
    constexpr int IT_IN = 4 * 16 * 48, IT_OUT = 4 * 16 * 16, IT_Q = 4 * 16 * 32;
    __syncthreads();
    for (int item = blockIdx.x; item < IT_IN + IT_OUT + IT_Q; item += gridDim.x) {
      const float* W; bf16_t* WT; int N, NP, r = item;
      if (r < IT_IN) { const int l = r / (16 * 48); r %= 16 * 48; W = pp->in[I_WIN] + (size_t)l * 1024 * INC; WT = (bf16_t*)(ws + WS_WIN) + (size_t)l * INCP * 1024; N = INC; NP = 48; }
      else if (r < IT_IN + IT_OUT) { r -= IT_IN; const int l = r / 256; r %= 256; W = pp->in[I_WOUT] + (size_t)l * 1024 * 1024; WT = (bf16_t*)(ws + WS_WOUT) + (size_t)l * 1024 * 1024; N = 1024; NP = 16; }
      else { r -= IT_IN + IT_OUT; const int l = r / 512; r %= 512; W = pp->in[I_WQ] + (size_t)l * 1024 * 2048; WT = (bf16_t*)(ws + WS_WQ) + (size_t)l * 2048 * 1024; N = 2048; NP = 32; }
      const int kb = r / NP, nb = r % NP, k0 = kb * 64, n0 = nb * 64;
      {
        const int col = tid & 63, rr = tid >> 6;
#pragma unroll
        for (int i = 0; i < 8; ++i) { const int kk = rr + 8 * i; const int n = n0 + col; tile[kk * 65 + col] = (n < N) ? W[(size_t)(k0 + kk) * N + n] : 0.f; }
      }
      __syncthreads();
      {
        const int n = tid >> 3, kc = tid & 7; const float* s = tile + (kc * 8) * 65 + n;
        uint4 o; o.x = pk2(s[0], s[65]); o.y = pk2(s[2 * 65], s[3 * 65]); o.z = pk2(s[4 * 65], s[5 * 65]); o.w = pk2(s[6 * 65], s[7 * 65]);
        *(uint4*)(WT + (size_t)(n0 + n) * 1024 + k0 + kc * 8) = o;
      }
      __syncthreads();
    }
  }
}

__device__ void norm_mod_phase(const float* __restrict__ xsrc, const float* __restrict__ gain, const float* __restrict__ mod_sh, const float* __restrict__ mod_sc,
                               bf16_t* __restrict__ outp) {
  const int tidx = launder_tid();
  const int lane = tidx & 63, gw = blockIdx.x * NW + (tidx >> 6), nw = gridDim.x * NW;
  for (int t = gw; t < T_; t += nw) {
    const int b = t >> 13;
    const f32x4* xr = (const f32x4*)(xsrc + (size_t)t * 1024) + lane;
    f32x4 v[4]; float s = 0.f;
#pragma unroll
    for (int j = 0; j < 4; ++j) { v[j] = xr[64 * j]; s += v[j].x * v[j].x + v[j].y * v[j].y + v[j].z * v[j].z + v[j].w * v[j].w; }
    const float rstd = rsqrtf(wave_sum(s) * (1.f / 1024.f) + EPS_);
#pragma unroll
    for (int j = 0; j < 4; ++j) {
      const int c = lane * 4 + 256 * j;
      const f32x4 g = *(const f32x4*)(gain + c), sh = *(const f32x4*)(mod_sh + b * 6144 + c), sc = *(const f32x4*)(mod_sc + b * 6144 + c);
      const float o0 = v[j].x * rstd * g.x * (1.f + sc.x) + sh.x, o1 = v[j].y * rstd * g.y * (1.f + sc.y) + sh.y;
      const float o2 = v[j].z * rstd * g.z * (1.f + sc.z) + sh.z, o3 = v[j].w * rstd * g.w * (1.f + sc.w) + sh.w;
      uint2 o; o.x = pk2(o0, o1); o.y = pk2(o2, o3);
      *(uint2*)(outp + (size_t)t * 1024 + c) = o;
    }
  }
}


namespace pg8 {
#define PG8_LAS __attribute__((address_space(3)))
typedef unsigned u32x4 __attribute__((ext_vector_type(4)));
constexpr int BM = 256, BK = 64, HALF = 128, HTB = HALF * BK * 2, STAGE_BYTES = 8 * HTB, NXCD = 8, WGM = 8;
__host__ __device__ __forceinline__ int lds_byte(int r, int c) { const int st = (r >> 4) * 2 + (c >> 5), rr = r & 15, cc = c & 31, ob = rr * 64 + cc * 2; return st * 1024 + (ob ^ (((ob >> 9) & 1) << 5)); }
__host__ __device__ __forceinline__ void stage_rc(int b, int& R, int& C) { const int st = b / 1024, sb = b % 1024, swz = sb ^ (((sb >> 9) & 1) << 5); R = (st >> 1) * 16 + swz / 64; C = (st & 1) * 32 + (swz % 64) / 2; }
__host__ __device__ __forceinline__ int perm32(int rho) { const int n = rho >> 4, i = rho & 15; return 8 * (i >> 2) + 4 * n + (i & 3); }
struct Unit { int pm, pn; };
struct Gemm { const bf16_t* A; const bf16_t* Bt; int M, N, K; };
struct StaticOrder {
    int nM, nN, nwg, G, c;
    __host__ __device__ void init(int M, int N, int G_, int c_) { nM = M / BM; nN = N / BM; nwg = nM * nN; G = G_; c = c_; }
    __host__ __device__ bool next(int i, Unit& u) const {
        const long L = (long)i * G + c; if (L >= nwg) return false;
        int wgid = (int)L; { const int q = nwg / NXCD, r = nwg % NXCD, xcd = wgid % NXCD, off = wgid / NXCD; wgid = (xcd < r ? xcd * (q + 1) : r * (q + 1) + (xcd - r) * q) + off; }
        const int nig = WGM * nN, gid = wgid / nig, fm = gid * WGM, gsz = (nM - fm) < WGM ? (nM - fm) : WGM;
        u.pm = fm + ((wgid % nig) % gsz); u.pn = (wgid % nig) / gsz; return true;
    }
    __device__ __forceinline__ void a_ready(const Unit&) const {}
    __device__ __forceinline__ void done(const Unit&) const {}
};
__device__ __forceinline__ unsigned cvt_pk_bf16(float lo, float hi) { unsigned r; asm volatile("v_cvt_pk_bf16_f32 %0, %1, %2" : "=v"(r) : "v"(lo), "v"(hi)); return r; }
template <class Epi, class Sched>
__device__ __forceinline__ void gemm_phase(PG8_LAS unsigned char* lds, const Gemm g, const Sched& S, const Epi& E) {
    const int tid = threadIdx.x, wid = __builtin_amdgcn_readfirstlane(tid >> 6), lane = tid & 63, wr = wid >> 2, wc = wid & 3, fr = lane & 15, fq = lane >> 4;
    const int K = g.K, nt = K / BK;
    unsigned voffA[2], voffB[2];
#pragma unroll
    for (int i = 0; i < 2; ++i) { int R, C; stage_rc(tid * 16 + i * 8192, R, C); const int Rb = Epi::PERM ? ((R & ~31) + perm32(R & 31)) : R;
        voffA[i] = (unsigned)(R * K + C) * 2u; voffB[i] = (unsigned)(Rb * K + C) * 2u; }
    const size_t kstep = (size_t)(BK * 2);
    const size_t hstep = (size_t)HALF * K * 2;
    const size_t tstep = 2 * hstep;
    const unsigned ldsw = (unsigned)wid * 1024u;
    const int aoff = lds_byte(wr * 64 + fr, fq * 8), boff = lds_byte(wc * 32 + fr, fq * 8);
#define PG8_SA(b, h) (((b) * 2 + (h)) * HTB)
#define PG8_SB(b, h) ((4 + (b) * 2 + (h)) * HTB)
#define PG8_STAGE(bufoff, gbase, voff) do { _Pragma("unroll") for (int _i = 0; _i < 2; ++_i) \
        __builtin_amdgcn_global_load_lds((const unsigned*)((const char*)(gbase) + (voff)[_i]), (PG8_LAS unsigned*)(lds + (bufoff) + ldsw + _i * 8192), 16, 0, 0); } while (0)
#define PG8_LDA(dst, b, h) do { _Pragma("unroll") for (int m = 0; m < 4; ++m) _Pragma("unroll") for (int k = 0; k < 2; ++k) dst[m][k] = *(const PG8_LAS bf16x8*)(lds + PG8_SA(b, h) + aoff + m * 2048 + k * 1024); } while (0)
#define PG8_LDB(dst, b, h) do { _Pragma("unroll") for (int n = 0; n < 2; ++n) _Pragma("unroll") for (int k = 0; k < 2; ++k) dst[n][k] = *(const PG8_LAS bf16x8*)(lds + PG8_SB(b, h) + boff + n * 2048 + k * 1024); } while (0)
#define PG8_MMA(ai, bj, At, Bt) do { __builtin_amdgcn_s_setprio(1); _Pragma("unroll") for (int m = 0; m < 4; ++m) _Pragma("unroll") for (int n = 0; n < 2; ++n) _Pragma("unroll") for (int k = 0; k < 2; ++k) \
        acc[ai][bj][m][n] = __builtin_amdgcn_mfma_f32_16x16x32_bf16(Bt[n][k], At[m][k], acc[ai][bj][m][n], 0, 0, 0); __builtin_amdgcn_s_setprio(0); } while (0)
#define PG8_WAIT_V(n) asm volatile("s_waitcnt vmcnt(" #n ")" ::: "memory")
#define PG8_WAIT_L(n) asm volatile("s_waitcnt lgkmcnt(" #n ")" ::: "memory")
#define PG8_BAR __builtin_amdgcn_s_barrier()
#define PG8_SCHED __builtin_amdgcn_sched_barrier(0)
    Unit cur, nxt; int ui = 0;
    if (!S.next(0, cur)) return;
    f32x4 acc[2][2][4][2];
#pragma unroll
    for (int a = 0; a < 2; ++a)
#pragma unroll
        for (int b = 0; b < 2; ++b)
#pragma unroll
            for (int m = 0; m < 4; ++m)
#pragma unroll
                for (int n = 0; n < 2; ++n) acc[a][b][m][n] = (f32x4){0.f, 0.f, 0.f, 0.f};
    bf16x8 At[4][2], B0[2][2], B1[2][2];
    const char* cA = (const char*)g.A + (size_t)cur.pm * tstep; const char* cB = (const char*)g.Bt + (size_t)cur.pn * tstep;
    S.a_ready(cur);
    PG8_STAGE(PG8_SB(0, 0), cB, voffB); PG8_STAGE(PG8_SA(0, 0), cA, voffA); PG8_STAGE(PG8_SB(0, 1), cB + hstep, voffB); PG8_STAGE(PG8_SA(0, 1), cA + hstep, voffA);
    if (wr == 1) PG8_BAR;
    PG8_WAIT_V(4); PG8_BAR;
    PG8_STAGE(PG8_SB(1, 0), cB + kstep, voffB); PG8_STAGE(PG8_SA(1, 0), cA + kstep, voffA); PG8_STAGE(PG8_SB(1, 1), cB + hstep + kstep, voffB);
    PG8_WAIT_V(6); PG8_BAR;
    for (;;) {
        const bool has_next = S.next(ui + 1, nxt);
        const char* nA = has_next ? (const char*)g.A + (size_t)nxt.pm * tstep : cA; const char* nB = has_next ? (const char*)g.Bt + (size_t)nxt.pn * tstep : cB;
        for (int t = 0; t < nt; t += 2) {
            const bool last = (t == nt - 2);
            const char* a1 = cA + (size_t)(t + 1) * kstep;
            const char* a2 = last ? nA : cA + (size_t)(t + 2) * kstep; const char* b2 = last ? nB : cB + (size_t)(t + 2) * kstep;
            const char* a3 = a2 + kstep; const char* b3 = b2 + kstep;
            if (last && has_next) S.a_ready(nxt);
            PG8_LDB(B0, 0, 0); PG8_SCHED; PG8_LDA(At, 0, 0); PG8_STAGE(PG8_SA(1, 1), a1 + hstep, voffA);
            PG8_WAIT_L(8); PG8_BAR; PG8_WAIT_L(0); PG8_MMA(0, 0, At, B0); PG8_BAR; PG8_SCHED;
            PG8_LDB(B1, 0, 1); PG8_STAGE(PG8_SB(0, 0), b2, voffB);
            PG8_BAR; PG8_WAIT_L(0); PG8_MMA(0, 1, At, B1); PG8_BAR;
            PG8_LDA(At, 0, 1); PG8_STAGE(PG8_SA(0, 0), a2, voffA);
            PG8_BAR; PG8_WAIT_L(0); PG8_MMA(1, 0, At, B0); PG8_BAR; PG8_SCHED;
            PG8_STAGE(PG8_SB(0, 1), b2 + hstep, voffB);
            PG8_WAIT_V(6); PG8_BAR; PG8_MMA(1, 1, At, B1); PG8_BAR;
            PG8_LDB(B0, 1, 0); PG8_SCHED; PG8_LDA(At, 1, 0); PG8_STAGE(PG8_SA(0, 1), a2 + hstep, voffA);
            PG8_WAIT_L(8); PG8_BAR; PG8_WAIT_L(0); PG8_MMA(0, 0, At, B0); PG8_BAR; PG8_SCHED;
            PG8_LDB(B1, 1, 1); PG8_STAGE(PG8_SB(1, 0), b3, voffB);
            PG8_BAR; PG8_WAIT_L(0); PG8_MMA(0, 1, At, B1); PG8_BAR;
            PG8_LDA(At, 1, 1); PG8_STAGE(PG8_SA(1, 0), a3, voffA);
            PG8_BAR; PG8_WAIT_L(0); PG8_MMA(1, 0, At, B0); PG8_BAR; PG8_SCHED;
            PG8_STAGE(PG8_SB(1, 1), b3 + hstep, voffB);
            PG8_WAIT_V(6); PG8_BAR; PG8_MMA(1, 1, At, B1); PG8_BAR;
        }
        if constexpr (!Epi::AFTER_DRAIN) { E(acc, cur, wr, wc, fr, fq); S.done(cur); }
        if (!has_next) break;
#pragma unroll
        for (int a = 0; a < 2; ++a)
#pragma unroll
            for (int b = 0; b < 2; ++b)
#pragma unroll
                for (int m = 0; m < 4; ++m)
#pragma unroll
                    for (int n = 0; n < 2; ++n) acc[a][b][m][n] = (f32x4){0.f, 0.f, 0.f, 0.f};
        cur = nxt; cA = nA; cB = nB; ++ui;
    }
    PG8_WAIT_V(0);
    if (wr == 0) PG8_BAR;
    PG8_BAR;
    if constexpr (Epi::AFTER_DRAIN) { E.fused(acc, cur, wr, wc, fr, fq, lds, wid, lane); S.done(cur); }
#undef PG8_SA
#undef PG8_SB
#undef PG8_STAGE
#undef PG8_LDA
#undef PG8_LDB
#undef PG8_MMA
#undef PG8_WAIT_V
#undef PG8_WAIT_L
#undef PG8_BAR
#undef PG8_SCHED
}
}

struct EpiProj {
  static constexpr bool PERM = true, AFTER_DRAIN = false;
  bf16_t* PROJ; bf16_t* VTA;
  __device__ __forceinline__ void operator()(const f32x4 (&acc)[2][2][4][2], const pg8::Unit& u, int wr, int wc, int fr, int fq) const {
    const int row0 = u.pm * 256 + wr * 64 + fr, col0 = u.pn * 256 + wc * 32 + 8 * fq;
#pragma unroll
    for (int ai = 0; ai < 2; ++ai)
#pragma unroll
      for (int m = 0; m < 4; ++m) {
        const int t = row0 + ai * 128 + m * 16;
#pragma unroll
        for (int bj = 0; bj < 2; ++bj) {
          const int c = col0 + bj * 128;
          const f32x4 v0 = acc[ai][bj][m][0], v1 = acc[ai][bj][m][1];
          pg8::u32x4 w; w.x = pg8::cvt_pk_bf16(v0[0], v0[1]); w.y = pg8::cvt_pk_bf16(v0[2], v0[3]); w.z = pg8::cvt_pk_bf16(v1[0], v1[1]); w.w = pg8::cvt_pk_bf16(v1[2], v1[3]);
          *(pg8::u32x4*)(PROJ + (size_t)t * INCP + c) = w;
          if (c >= C_VA && c < C_VA + 384) {
            bf16_t* vt = VTA + ((size_t)(t >> 13) * 384 + (c - C_VA)) * 8192 + (t & 8191);
            vt[0] = (bf16_t)(w.x & 0xffffu); vt[8192] = (bf16_t)(w.x >> 16); vt[2 * 8192] = (bf16_t)(w.y & 0xffffu); vt[3 * 8192] = (bf16_t)(w.y >> 16);
            vt[4 * 8192] = (bf16_t)(w.z & 0xffffu); vt[5 * 8192] = (bf16_t)(w.z >> 16); vt[6 * 8192] = (bf16_t)(w.w & 0xffffu); vt[7 * 8192] = (bf16_t)(w.w >> 16);
          }
        }
      }
  }
};
struct EpiOut {
  static constexpr bool PERM = false, AFTER_DRAIN = false;
  const float* xsrc; float* X; const float* g1;
  __device__ __forceinline__ void operator()(const f32x4 (&acc)[2][2][4][2], const pg8::Unit& u, int wr, int wc, int fr, int fq) const {
    const int row0 = u.pm * 256 + wr * 64 + fr, col0 = u.pn * 256 + wc * 32 + 4 * fq;
#pragma unroll
    for (int ai = 0; ai < 2; ++ai)
#pragma unroll
      for (int m = 0; m < 4; ++m) {
        const int t = row0 + ai * 128 + m * 16, b = t >> 13;
#pragma unroll
        for (int bj = 0; bj < 2; ++bj)
#pragma unroll
          for (int n = 0; n < 2; ++n) {
            const int c = col0 + bj * 128 + n * 16;
            const f32x4 xv = *(const f32x4*)(xsrc + (size_t)t * 1024 + c), g = *(const f32x4*)(g1 + b * 6144 + c);
            *(f32x4*)(X + (size_t)t * 1024 + c) = xv + g * acc[ai][bj][m][n];
          }
      }
  }
};
struct EpiQ {
  static constexpr bool PERM = true, AFTER_DRAIN = false;
  bf16_t* Q;
  __device__ __forceinline__ void operator()(const f32x4 (&acc)[2][2][4][2], const pg8::Unit& u, int wr, int wc, int fr, int fq) const {
    const int row0 = u.pm * 256 + wr * 64 + fr, col0 = u.pn * 256 + wc * 32 + 8 * fq;
#pragma unroll
    for (int ai = 0; ai < 2; ++ai)
#pragma unroll
      for (int m = 0; m < 4; ++m) {
        const int t = row0 + ai * 128 + m * 16;
#pragma unroll
        for (int bj = 0; bj < 2; ++bj) {
          const f32x4 v0 = acc[ai][bj][m][0], v1 = acc[ai][bj][m][1];
          pg8::u32x4 w; w.x = pg8::cvt_pk_bf16(v0[0], v0[1]); w.y = pg8::cvt_pk_bf16(v0[2], v0[3]); w.z = pg8::cvt_pk_bf16(v1[0], v1[1]); w.w = pg8::cvt_pk_bf16(v1[2], v1[3]);
          *(pg8::u32x4*)(Q + (size_t)t * 2048 + col0 + bj * 128) = w;
        }
      }
  }
};

__device__ void gemm_proj_phase(const Params& p, int l, unsigned char* smem) {
  const CParamsP pp = launder_kargs();
  unsigned char* const ws = launder_ptr(pp->ws);
  pg8::Gemm g; g.A = (const bf16_t*)(ws + WS_ABUF); g.Bt = (const bf16_t*)(ws + WS_WIN) + (size_t)l * INCP * 1024; g.M = T_; g.N = INCP; g.K = 1024;
  pg8::StaticOrder S; S.init(T_, INCP, gridDim.x, blockIdx.x);
  EpiProj E; E.PROJ = (bf16_t*)(ws + WS_PROJ); E.VTA = (bf16_t*)(ws + WS_VTA);
  pg8::gemm_phase<EpiProj, pg8::StaticOrder>((PG8_LAS unsigned char*)smem, g, S, E);
}
__device__ void gemm_out_phase(const Params& p, int l, const float* __restrict__ xsrc, unsigned char* smem) {
  const CParamsP pp = launder_kargs();
  unsigned char* const ws = launder_ptr(pp->ws);
  pg8::Gemm g; g.A = (const bf16_t*)(ws + WS_ABUF); g.Bt = (const bf16_t*)(ws + WS_WOUT) + (size_t)l * 1024 * 1024; g.M = T_; g.N = 1024; g.K = 1024;
  pg8::StaticOrder S; S.init(T_, 1024, gridDim.x, blockIdx.x);
  EpiOut E; E.xsrc = xsrc; E.X = (float*)(ws + WS_X); E.g1 = (const float*)(ws + WS_MOD) + (size_t)l * 2 * 6144 + 2048;
  pg8::gemm_phase<EpiOut, pg8::StaticOrder>((PG8_LAS unsigned char*)smem, g, S, E);
}
__device__ void gemm_q_phase(const Params& p, int l, unsigned char* smem) {
  const CParamsP pp = launder_kargs();
  unsigned char* const ws = launder_ptr(pp->ws);
  pg8::Gemm g; g.A = (const bf16_t*)(ws + WS_ABUF); g.Bt = (const bf16_t*)(ws + WS_WQ) + (size_t)l * 2048 * 1024; g.M = T_; g.N = 2048; g.K = 1024;
  pg8::StaticOrder S; S.init(T_, 2048, gridDim.x, blockIdx.x);
  EpiQ E; E.Q = (bf16_t*)(ws + WS_Q);
  pg8::gemm_phase<EpiQ, pg8::StaticOrder>((PG8_LAS unsigned char*)smem, g, S, E);
}

__device__ void attn_phase(const Params& p, int l) {
  const CParamsP pp = launder_kargs();
  unsigned char* const ws = launder_ptr(pp->ws); const int tidx = launder_tid(); (void)ws; (void)tidx;
  const bf16_t* PROJ = (const bf16_t*)(ws + WS_PROJ); const bf16_t* VTA = (const bf16_t*)(ws + WS_VTA);
  float* ATT = (float*)(ws + WS_ATT);
  const int lane = tidx & 63, fr = lane & 15, fq = lane >> 4;
  const int gw = blockIdx.x * NW + (tidx >> 6), nw = gridDim.x * NW;
  for (int task = gw; task < 256 * 24; task += nw) {
    const int item = task / 24, rb = task % 24, h = rb >> 2, qb = rb & 3;
    const int b = item >> 7, n = item & 127, t0 = b * 8192 + n * 64;
    const float* rbias = pp->in[I_RELB] + ((size_t)l * 6 + h) * 513;
    const int iq = qb * 16 + fr;
    bf16x8 qf[2];
#pragma unroll
    for (int ds = 0; ds < 2; ++ds) qf[ds] = *(const bf16x8*)(PROJ + (size_t)(t0 + iq) * INCP + C_QA + h * 64 + ds * 32 + fq * 8);
    f32x4 o[4];
#pragma unroll
    for (int et = 0; et < 4; ++et) o[et] = (f32x4){0.f, 0.f, 0.f, 0.f};
    float mrun = -1e30f, lrun = 0.f;
    for (int jc = 0; jc < 9; ++jc) {
      const int m = n - 8 + jc;
      if (m < 0) continue;
      const int tk = b * 8192 + m * 64;
      float s[2][2][4];
#pragma unroll
      for (int g = 0; g < 2; ++g)
#pragma unroll
        for (int tt = 0; tt < 2; ++tt) {
          const int key = tk + 32 * g + 8 * (fr >> 2) + (fr & 3) + 4 * tt;
          const bf16_t* kp = PROJ + (size_t)key * INCP + C_KA + h * 64 + fq * 8;
          const bf16x8 k0 = *(const bf16x8*)kp, k1 = *(const bf16x8*)(kp + 32);
          f32x4 st = (f32x4){0.f, 0.f, 0.f, 0.f};
          st = __builtin_amdgcn_mfma_f32_16x16x32_bf16(k0, qf[0], st, 0, 0, 0);
          st = __builtin_amdgcn_mfma_f32_16x16x32_bf16(k1, qf[1], st, 0, 0, 0);
#pragma unroll
          for (int j = 0; j < 4; ++j) {
            const int kk = 32 * g + 8 * fq + 4 * tt + j;
            int diff = 512 + iq - (64 * jc + kk);
            diff = diff > 256 ? 256 : diff;
            s[g][tt][j] = st[j] * 0.125f + rbias[diff + 256];
          }
        }
      float mloc = -1e30f;
#pragma unroll
      for (int g = 0; g < 2; ++g)
#pragma unroll
        for (int tt = 0; tt < 2; ++tt)
#pragma unroll
          for (int j = 0; j < 4; ++j) mloc = fmaxf(mloc, s[g][tt][j]);
      mloc = fmaxf(mloc, __shfl_xor(mloc, 16)); mloc = fmaxf(mloc, __shfl_xor(mloc, 32));
      const float mnew = fmaxf(mrun, mloc), alpha = __expf(mrun - mnew);
      mrun = mnew;
      float ls = 0.f;
#pragma unroll
      for (int g = 0; g < 2; ++g)
#pragma unroll
        for (int tt = 0; tt < 2; ++tt)
#pragma unroll
          for (int j = 0; j < 4; ++j) { const float e = __expf(s[g][tt][j] - mnew); s[g][tt][j] = e; ls += e; }
      lrun = lrun * alpha + ls;
#pragma unroll
      for (int et = 0; et < 4; ++et) { o[et].x *= alpha; o[et].y *= alpha; o[et].z *= alpha; o[et].w *= alpha; }
#pragma unroll
      for (int g = 0; g < 2; ++g) {
        union { bf16x8 v; unsigned u[4]; } pf;
        pf.u[0] = pk2(s[g][0][0], s[g][0][1]); pf.u[1] = pk2(s[g][0][2], s[g][0][3]);
        pf.u[2] = pk2(s[g][1][0], s[g][1][1]); pf.u[3] = pk2(s[g][1][2], s[g][1][3]);
#pragma unroll
        for (int et = 0; et < 4; ++et) {
          const bf16x8 vf = *(const bf16x8*)(VTA + ((size_t)b * 384 + h * 64 + et * 16 + fr) * 8192 + m * 64 + 32 * g + 8 * fq);
          o[et] = __builtin_amdgcn_mfma_f32_16x16x32_bf16(vf, pf.v, o[et], 0, 0, 0);
        }
      }
    }
    lrun += __shfl_xor(lrun, 16); lrun += __shfl_xor(lrun, 32);
    const float inv = 1.f / lrun;
#pragma unroll
    for (int et = 0; et < 4; ++et) {
      f32x4 v = o[et]; v.x *= inv; v.y *= inv; v.z *= inv; v.w *= inv;
      *(f32x4*)(ATT + (size_t)(t0 + iq) * 384 + h * 64 + et * 16 + fq * 4) = v;
    }
  }
}

__device__ void mix_local_phase(const Params& p, int l, unsigned char* smem) {
  const CParamsP pp = launder_kargs();
  unsigned char* const ws = launder_ptr(pp->ws); const int tidx = launder_tid(); (void)ws; (void)tidx;
  const bf16_t* PROJ = (const bf16_t*)(ws + WS_PROJ);
  const float* RC = (const float*)(ws + WS_ROTC); const float* RS = (const float*)(ws + WS_ROTS);
  float* YINT = (float*)(ws + WS_YINT); float* UPD = (float*)(ws + WS_UPD);
  const float* SA = (const float*)(ws + WS_SA) + (size_t)l * 16 * 64 * 2; const float* SBB = (const float*)(ws + WS_SBB) + (size_t)l * 16 * 64 * 32;
  float* SEND = (float*)(ws + WS_SEND);
  const int tid = tidx, lane = tid & 63, wid = tid >> 6;
  float* qf = (float*)smem; float* kf = qf + 64 * 65; float* vv = kf + 64 * 65; float* S = vv + 64 * 65; float* kdec = S + 64 * 65;
  float* ussm = kdec + 64;
  for (int item = blockIdx.x; item < 256; item += gridDim.x) {
    const int b = item >> 7, n = item & 127, t0 = b * 8192 + n * 64;
    for (int h = 0; h < 6; ++h) {
      const float lg = log1pf(-exp2f(-5.f - (float)h));
      __syncthreads();
#pragma unroll
      for (int r = 0; r < 4; ++r) {
        const int idx = tid + NT * r, i = idx >> 5, dd = idx & 31;
        const bf16_t* row = PROJ + (size_t)(t0 + i) * INCP;
        const float c = RC[(n * 64 + i) * 32 + dd], s = RS[(n * 64 + i) * 32 + dd];
        const float q1 = bf2f(row[C_QR + h * 64 + dd]), q2 = bf2f(row[C_QR + h * 64 + dd + 32]);
        const float k1 = bf2f(row[C_KR + h * 64 + dd]) * 0.125f, k2 = bf2f(row[C_KR + h * 64 + dd + 32]) * 0.125f;
        qf[i * 65 + dd] = q1 * c - q2 * s; qf[i * 65 + dd + 32] = q1 * s + q2 * c;
        kf[i * 65 + dd] = k1 * c - k2 * s; kf[i * 65 + dd + 32] = k1 * s + k2 * c;
        vv[i * 65 + dd] = bf2f(row[C_VR + h * 64 + dd]); vv[i * 65 + dd + 32] = bf2f(row[C_VR + h * 64 + dd + 32]);
      }
      if (tid < 64) kdec[tid] = __expf(lg * (float)(63 - tid));
      __syncthreads();
#pragma unroll 1
      for (int r = 0; r < 8; ++r) {
        const int idx = tid + NT * r, i = idx >> 6, j = idx & 63;
        float a = 0.f;
#pragma unroll 16
        for (int d = 0; d < 64; ++d) a += qf[i * 65 + d] * kf[j * 65 + d];
        const int dij = i > j ? i - j : j - i;
        S[i * 65 + j] = a * __expf(lg * (float)dij);
      }
      __syncthreads();
#pragma unroll 1
      for (int r = 0; r < 8; ++r) {
        const int idx = tid + NT * r, i = idx >> 6, e = idx & 63;
        float a = 0.f, u = 0.f;
#pragma unroll 16
        for (int j = 0; j < 64; ++j) { a += S[i * 65 + j] * vv[j * 65 + e]; u += kf[j * 65 + i] * kdec[j] * vv[j * 65 + e]; }
        YINT[(size_t)(t0 + i) * 384 + h * 64 + e] = a;
        UPD[((size_t)item * 6 + h) * 4096 + i * 64 + e] = u;
      }
    }
    __syncthreads();
    for (int gi = 0; gi < 2; ++gi) {
      const int g = wid * 2 + gi;
      float* uw = ussm + wid * 1024;
#pragma unroll 4
      for (int r = 0; r < 16; ++r) { const int idx = lane + 64 * r, i = idx >> 4, c = idx & 15; uw[idx] = bf2f(PROJ[(size_t)(t0 + i) * INCP + C_US + g * 16 + c]); }
      float bbr[16], bbi[16];
      const float* bbp = SBB + ((size_t)g * 64 + lane) * 32;
#pragma unroll
      for (int c = 0; c < 16; ++c) { bbr[c] = bbp[c]; bbi[c] = bbp[16 + c]; }
      const float are = SA[(g * 64 + lane) * 2], aim = SA[(g * 64 + lane) * 2 + 1];
      float xr = 0.f, xi = 0.f;
#pragma unroll 2
      for (int i = 0; i < 64; ++i) {
        float br = 0.f, bi = 0.f;
#pragma unroll
        for (int c = 0; c < 16; ++c) { const float u = uw[i * 16 + c]; br += bbr[c] * u; bi += bbi[c] * u; }
        const float nr = are * xr - aim * xi + br, ni = are * xi + aim * xr + bi;
        xr = nr; xi = ni;
      }
      SEND[(((size_t)item * 16 + g) * 64 + lane) * 2] = xr; SEND[(((size_t)item * 16 + g) * 64 + lane) * 2 + 1] = xi;
    }
  }
}

__device__ void scan_phase(const Params& p, int l) {
  const CParamsP pp = launder_kargs();
  unsigned char* const ws = launder_ptr(pp->ws); const int tidx = launder_tid(); (void)ws; (void)tidx;
  const float* UPD = (const float*)(ws + WS_UPD); float* SPREV = (float*)(ws + WS_SPREV); bf16_t* SPT = (bf16_t*)(ws + WS_SPT);
  const float* SEND = (const float*)(ws + WS_SEND); float* CARRY = (float*)(ws + WS_CARRY);
  const float* SA = (const float*)(ws + WS_SA) + (size_t)l * 16 * 64 * 2;
  const int gtid = blockIdx.x * NT + tidx, gn = gridDim.x * NT;
  for (int idx = gtid; idx < 2 * 6 * 4096 + 2 * 1024; idx += gn) {
    if (idx < 2 * 6 * 4096) {
      const int b = idx / (6 * 4096), r = idx % (6 * 4096), h = r >> 12;
      const float cd = __expf(64.f * log1pf(-exp2f(-5.f - (float)h)));
      float s = 0.f;
      for (int n = 0; n < NCH; ++n) {
        const size_t off = ((size_t)(b * NCH + n)) * 6 * 4096 + r;
        SPREV[off] = s;
        SPT[((size_t)(b * NCH + n) * 6 + h) * 4096 + (r & 63) * 64 + ((r >> 6) & 63)] = f2bf(s);
        s = cd * s + UPD[off];
      }
    } else {
      const int r2 = idx - 2 * 6 * 4096, b = r2 >> 10, gp = r2 & 1023;
      float ar = SA[gp * 2], ai = SA[gp * 2 + 1];
#pragma unroll
      for (int q = 0; q < 6; ++q) { const float nr = ar * ar - ai * ai, ni = 2.f * ar * ai; ar = nr; ai = ni; }
      float xr = 0.f, xi = 0.f;
      for (int n = 0; n < NCH; ++n) {
        const size_t off = (((size_t)(b * NCH + n)) * 1024 + gp) * 2;
        CARRY[off] = xr; CARRY[off + 1] = xi;
        const float sr = SEND[off], si = SEND[off + 1];
        const float nr = ar * xr - ai * xi + sr, ni = ar * xi + ai * xr + si;
        xr = nr; xi = ni;
      }
    }
  }
}

__device__ __forceinline__ void rotary_frag(const bf16x8 x0, const bf16x8 x1, const float* __restrict__ RC, const float* __restrict__ RS, int pos, int fq, float scale, bf16x8& o0, bf16x8& o1) {
  const f32x4 c0 = *(const f32x4*)(RC + pos * 32 + 8 * fq), c1 = *(const f32x4*)(RC + pos * 32 + 8 * fq + 4);
  const f32x4 s0 = *(const f32x4*)(RS + pos * 32 + 8 * fq), s1 = *(const f32x4*)(RS + pos * 32 + 8 * fq + 4);
  const float cc[8] = {c0.x, c0.y, c0.z, c0.w, c1.x, c1.y, c1.z, c1.w}, sn[8] = {s0.x, s0.y, s0.z, s0.w, s1.x, s1.y, s1.z, s1.w};
  union { bf16x8 v; unsigned u[4]; } r0, r1;
#pragma unroll
  for (int q = 0; q < 4; ++q) {
    const float a0 = bf2f((bf16_t)x0[2 * q]) * scale, a1 = bf2f((bf16_t)x0[2 * q + 1]) * scale, b0 = bf2f((bf16_t)x1[2 * q]) * scale, b1 = bf2f((bf16_t)x1[2 * q + 1]) * scale;
    r0.u[q] = pk2(a0 * cc[2 * q] - b0 * sn[2 * q], a1 * cc[2 * q + 1] - b1 * sn[2 * q + 1]);
    r1.u[q] = pk2(a0 * sn[2 * q] + b0 * cc[2 * q], a1 * sn[2 * q + 1] + b1 * cc[2 * q + 1]);
  }
  o0 = r0.v; o1 = r1.v;
}
__device__ void mix_final_phase(const Params& p, int l, unsigned char* smem) {
  const CParamsP pp = launder_kargs();
  unsigned char* const ws = launder_ptr(pp->ws); const int tidx = launder_tid();
  const bf16_t* PROJ = (const bf16_t*)(ws + WS_PROJ);
  const float* RC = (const float*)(ws + WS_ROTC); const float* RS = (const float*)(ws + WS_ROTS);
  const float* YINT = (const float*)(ws + WS_YINT); const bf16_t* SPT = (const bf16_t*)(ws + WS_SPT);
  const float* ATT = (const float*)(ws + WS_ATT);
  const float* SA = (const float*)(ws + WS_SA) + (size_t)l * 16 * 64 * 2; const float* SBB = (const float*)(ws + WS_SBB) + (size_t)l * 16 * 64 * 32;
  const float* CARRY = (const float*)(ws + WS_CARRY);
  const bf16_t* CB = (const bf16_t*)(ws + WS_CB) + (size_t)l * 16 * 16 * 128; const bf16_t* WG = (const bf16_t*)(ws + WS_WGLUT) + (size_t)l * 512 * 256;
  const float* dsk = pp->in[I_SSMD] + (size_t)l * 256;
  const float* mg = pp->in[I_MGAIN] + (size_t)l * 1024;
  bf16_t* MRG = (bf16_t*)(ws + WS_ABUF);
  const int tid = tidx, lane = tid & 63, wid = tid >> 6, fr = lane & 15, fq = lane >> 4;
  bf16_t* YS = (bf16_t*)smem;
  float* red = (float*)(smem + 33792);
  float* uw = (float*)(smem + 36864 + wid * 8448);
  bf16_t* XB = (bf16_t*)(smem + 36864 + wid * 8448 + 4096);
  for (int item = blockIdx.x; item < 256; item += gridDim.x) {
    const int b = item >> 7, n = item & 127, t0 = b * 8192 + n * 64;
    __syncthreads();
    for (int ii = 0; ii < 8; ++ii) {
      const int t = t0 + wid * 8 + ii;
      float v[6]; float sq = 0.f;
#pragma unroll
      for (int j = 0; j < 6; ++j) { v[j] = ATT[(size_t)t * 384 + lane + 64 * j]; sq += v[j] * v[j]; }
      const float rstd = rsqrtf(wave_sum(sq) * (1.f / 384.f) + EPS_);
#pragma unroll
      for (int j = 0; j < 6; ++j) MRG[(size_t)t * 1024 + lane + 64 * j] = f2bf(v[j] * rstd * mg[lane + 64 * j]);
    }
#pragma unroll 1
    for (int k3 = 0; k3 < 3; ++k3) {
      const int task = wid * 3 + k3, h = task >> 2, tb = task & 3;
      const int i = 16 * tb + fr, t = t0 + i;
      const float lg2 = log2f(1.f - exp2f(-5.f - (float)h));
      bf16x8 qf0, qf1;
      {
        const bf16_t* qp = PROJ + (size_t)t * INCP + C_QR + h * 64 + 8 * fq;
        rotary_frag(*(const bf16x8*)qp, *(const bf16x8*)(qp + 32), RC, RS, n * 64 + i, fq, 1.f, qf0, qf1);
      }
      f32x4 o[4];
#pragma unroll
      for (int et = 0; et < 4; ++et) {
        const bf16_t* sp = SPT + (((size_t)item * 6 + h) * 64 + 16 * et + fr) * 64 + 8 * fq;
        const bf16x8 a0 = *(const bf16x8*)sp, a1 = *(const bf16x8*)(sp + 32);
        o[et] = __builtin_amdgcn_mfma_f32_16x16x32_bf16(a0, qf0, (f32x4){0.f, 0.f, 0.f, 0.f}, 0, 0, 0);
        o[et] = __builtin_amdgcn_mfma_f32_16x16x32_bf16(a1, qf1, o[et], 0, 0, 0);
      }
      const float qd = exp2f(lg2 * (float)(i + 1));
      float y[16]; float s1 = 0.f;
#pragma unroll
      for (int et = 0; et < 4; ++et) {
        const f32x4 yi = *(const f32x4*)(YINT + (size_t)t * 384 + h * 64 + 16 * et + 4 * fq);
        y[4 * et] = yi.x + qd * o[et].x; y[4 * et + 1] = yi.y + qd * o[et].y; y[4 * et + 2] = yi.z + qd * o[et].z; y[4 * et + 3] = yi.w + qd * o[et].w;
        s1 += (y[4 * et] + y[4 * et + 1]) + (y[4 * et + 2] + y[4 * et + 3]);
      }
      s1 += __shfl_xor(s1, 16); s1 += __shfl_xor(s1, 32);
      const float mu = s1 * (1.f / 64.f);
      float s2 = 0.f;
#pragma unroll
      for (int q = 0; q < 16; ++q) { y[q] -= mu; s2 += y[q] * y[q]; }
      s2 += __shfl_xor(s2, 16); s2 += __shfl_xor(s2, 32);
      const float rstd = rsqrtf(s2 * (1.f / 64.f) + EPS_);
#pragma unroll
      for (int et = 0; et < 4; ++et) {
        const int c = h * 64 + 16 * et + 4 * fq;
        const uint2 gr = *(const uint2*)(PROJ + (size_t)t * INCP + C_GR + c);
        const float g0 = __uint_as_float(gr.x << 16), g1 = __uint_as_float(gr.x & 0xffff0000u), g2 = __uint_as_float(gr.y << 16), g3 = __uint_as_float(gr.y & 0xffff0000u);
        const f32x4 mgv = *(const f32x4*)(mg + 384 + c);
        uint2 ov;
        ov.x = pk2(y[4 * et] * rstd * (g0 * sigmoid_f(g0)) * mgv.x, y[4 * et + 1] * rstd * (g1 * sigmoid_f(g1)) * mgv.y);
        ov.y = pk2(y[4 * et + 2] * rstd * (g2 * sigmoid_f(g2)) * mgv.z, y[4 * et + 3] * rstd * (g3 * sigmoid_f(g3)) * mgv.w);
        *(uint2*)(MRG + (size_t)t * 1024 + 384 + c) = ov;
      }
    }
#pragma unroll 1
    for (int gi = 0; gi < 2; ++gi) {
      const int g = wid * 2 + gi;
#pragma unroll 4
      for (int r = 0; r < 16; ++r) { const int idx = lane + 64 * r, i = idx >> 4, c = idx & 15; uw[idx] = bf2f(PROJ[(size_t)(t0 + i) * INCP + C_US + g * 16 + c]); }
      float bbr[16], bbi[16];
      const float* bbp = SBB + ((size_t)g * 64 + lane) * 32;
#pragma unroll
      for (int c = 0; c < 16; ++c) { bbr[c] = bbp[c]; bbi[c] = bbp[16 + c]; }
      const float are = SA[(g * 64 + lane) * 2], aim = SA[(g * 64 + lane) * 2 + 1];
      float xr = CARRY[(((size_t)item * 16 + g) * 64 + lane) * 2], xi = CARRY[(((size_t)item * 16 + g) * 64 + lane) * 2 + 1];
      bf16x8 cb[4];
#pragma unroll
      for (int ks = 0; ks < 4; ++ks) cb[ks] = *(const bf16x8*)(CB + ((size_t)g * 16 + fr) * 128 + 32 * ks + 8 * fq);
      const float dv = dsk[g * 16 + fr];
#pragma unroll 1
      for (int tb = 0; tb < 4; ++tb) {
#pragma unroll 2
        for (int ii = 0; ii < 16; ++ii) {
          const int i = tb * 16 + ii;
          float br = 0.f, bi = 0.f;
#pragma unroll
          for (int c = 0; c < 16; ++c) { const float u = uw[i * 16 + c]; br += bbr[c] * u; bi += bbi[c] * u; }
          const float nr = are * xr - aim * xi + br, ni = are * xi + aim * xr + bi;
          xr = nr; xi = ni;
          XB[ii * 136 + lane] = f2bf(xr); XB[ii * 136 + 64 + lane] = f2bf(xi);
        }
        f32x4 acc = (f32x4){0.f, 0.f, 0.f, 0.f};
#pragma unroll
        for (int ks = 0; ks < 4; ++ks) {
          const bf16x8 af = *(const bf16x8*)(XB + fr * 136 + 32 * ks + 8 * fq);
          acc = __builtin_amdgcn_mfma_f32_16x16x32_bf16(af, cb[ks], acc, 0, 0, 0);
        }
#pragma unroll
        for (int j = 0; j < 4; ++j) {
          const int i = tb * 16 + 4 * fq + j;
          const float yv = acc[j] + dv * uw[i * 16 + fr];
          YS[i * 264 + g * 16 + fr] = f2bf(gelu_tanh(yv));
        }
      }
    }
    __syncthreads();
    {
      const int n0 = 32 * wid;
      f32x4 a1[4][2], a2[4][2];
#pragma unroll
      for (int mt = 0; mt < 4; ++mt)
#pragma unroll
        for (int nt = 0; nt < 2; ++nt) { a1[mt][nt] = (f32x4){0.f, 0.f, 0.f, 0.f}; a2[mt][nt] = (f32x4){0.f, 0.f, 0.f, 0.f}; }
#pragma unroll 2
      for (int ks = 0; ks < 8; ++ks) {
        bf16x8 w1[2], w2[2], yb[4];
#pragma unroll
        for (int nt = 0; nt < 2; ++nt) {
          w1[nt] = *(const bf16x8*)(WG + (size_t)(n0 + 16 * nt + fr) * 256 + 32 * ks + 8 * fq);
          w2[nt] = *(const bf16x8*)(WG + (size_t)(256 + n0 + 16 * nt + fr) * 256 + 32 * ks + 8 * fq);
        }
#pragma unroll
        for (int mt = 0; mt < 4; ++mt) yb[mt] = *(const bf16x8*)(YS + (16 * mt + fr) * 264 + 32 * ks + 8 * fq);
#pragma unroll
        for (int mt = 0; mt < 4; ++mt)
#pragma unroll
          for (int nt = 0; nt < 2; ++nt) {
            a1[mt][nt] = __builtin_amdgcn_mfma_f32_16x16x32_bf16(w1[nt], yb[mt], a1[mt][nt], 0, 0, 0);
            a2[mt][nt] = __builtin_amdgcn_mfma_f32_16x16x32_bf16(w2[nt], yb[mt], a2[mt][nt], 0, 0, 0);
          }
      }
#pragma unroll
      for (int mt = 0; mt < 4; ++mt) {
        float sq = 0.f;
#pragma unroll
        for (int nt = 0; nt < 2; ++nt) {
          f32x4 z = a1[mt][nt]; const f32x4 zg = a2[mt][nt];
          z.x *= sigmoid_f(zg.x); z.y *= sigmoid_f(zg.y); z.z *= sigmoid_f(zg.z); z.w *= sigmoid_f(zg.w);
          a1[mt][nt] = z; sq += z.x * z.x + z.y * z.y + z.z * z.z + z.w * z.w;
        }
        sq += __shfl_xor(sq, 16); sq += __shfl_xor(sq, 32);
        if (fq == 0) red[wid * 64 + 16 * mt + fr] = sq;
      }
      __syncthreads();
#pragma unroll
      for (int mt = 0; mt < 4; ++mt) {
        const int i = 16 * mt + fr, t = t0 + i;
        float tot = 0.f;
#pragma unroll
        for (int w8 = 0; w8 < 8; ++w8) tot += red[w8 * 64 + i];
        const float rstd = rsqrtf(tot * (1.f / 256.f) + EPS_);
#pragma unroll
        for (int nt = 0; nt < 2; ++nt) {
          const int c = n0 + 16 * nt + 4 * fq;
          const f32x4 mgv = *(const f32x4*)(mg + 768 + c); const f32x4 z = a1[mt][nt];
          uint2 ov; ov.x = pk2(z.x * rstd * mgv.x, z.y * rstd * mgv.y); ov.y = pk2(z.z * rstd * mgv.z, z.w * rstd * mgv.w);
          *(uint2*)(MRG + (size_t)t * 1024 + 768 + c) = ov;
        }
      }
    }
  }
}

typedef float f32x2 __attribute__((ext_vector_type(2)));
__device__ __forceinline__ float dot16_fp8(const uint4 u, const float (&hv)[16]) {
  f32x2 c; float d;
  c = __builtin_amdgcn_cvt_pk_f32_fp8((int)u.x, false); d = c.x * hv[0] + c.y * hv[1];
  c = __builtin_amdgcn_cvt_pk_f32_fp8((int)u.x, true);  d += c.x * hv[2] + c.y * hv[3];
  c = __builtin_amdgcn_cvt_pk_f32_fp8((int)u.y, false); d += c.x * hv[4] + c.y * hv[5];
  c = __builtin_amdgcn_cvt_pk_f32_fp8((int)u.y, true);  d += c.x * hv[6] + c.y * hv[7];
  c = __builtin_amdgcn_cvt_pk_f32_fp8((int)u.z, false); d += c.x * hv[8] + c.y * hv[9];
  c = __builtin_amdgcn_cvt_pk_f32_fp8((int)u.z, true);  d += c.x * hv[10] + c.y * hv[11];
  c = __builtin_amdgcn_cvt_pk_f32_fp8((int)u.w, false); d += c.x * hv[12] + c.y * hv[13];
  c = __builtin_amdgcn_cvt_pk_f32_fp8((int)u.w, true);  d += c.x * hv[14] + c.y * hv[15];
  return d;
}
__device__ __forceinline__ void axpy16_fp8(const uint4 v, const float w, float (&acc)[16]) {
  f32x2 c;
  c = __builtin_amdgcn_cvt_pk_f32_fp8((int)v.x, false); acc[0] += w * c.x; acc[1] += w * c.y;
  c = __builtin_amdgcn_cvt_pk_f32_fp8((int)v.x, true);  acc[2] += w * c.x; acc[3] += w * c.y;
  c = __builtin_amdgcn_cvt_pk_f32_fp8((int)v.y, false); acc[4] += w * c.x; acc[5] += w * c.y;
  c = __builtin_amdgcn_cvt_pk_f32_fp8((int)v.y, true);  acc[6] += w * c.x; acc[7] += w * c.y;
  c = __builtin_amdgcn_cvt_pk_f32_fp8((int)v.z, false); acc[8] += w * c.x; acc[9] += w * c.y;
  c = __builtin_amdgcn_cvt_pk_f32_fp8((int)v.z, true);  acc[10] += w * c.x; acc[11] += w * c.y;
  c = __builtin_amdgcn_cvt_pk_f32_fp8((int)v.w, false); acc[12] += w * c.x; acc[13] += w * c.y;
  c = __builtin_amdgcn_cvt_pk_f32_fp8((int)v.w, true);  acc[14] += w * c.x; acc[15] += w * c.y;
}
typedef float f32x16 __attribute__((ext_vector_type(16)));
__device__ __forceinline__ float vmaxf(float a, float b) { float r; asm("v_max_f32 %0, %1, %2" : "=v"(r) : "v"(a), "v"(b)); return r; }
__device__ __forceinline__ float vminf(float a, float b) { float r; asm("v_min_f32 %0, %1, %2" : "=v"(r) : "v"(a), "v"(b)); return r; }
__device__ __forceinline__ void cx(float& hi, float& lo) { const float a = hi, b = lo; hi = vmaxf(a, b); lo = vminf(a, b); }
__device__ __forceinline__ void cx2(float& kh, int& ph, float& kl, int& pl) {
  const float a = kh, b = kl; const int pa = ph, pb = pl; const bool c = a >= b;
  kh = vmaxf(a, b); kl = vminf(a, b); ph = c ? pa : pb; pl = c ? pb : pa;
}
__device__ __forceinline__ void bitonic_sort16_desc(float (&v)[16]) {
#pragma unroll
  for (int k = 2; k <= 16; k <<= 1)
#pragma unroll
    for (int j = k >> 1; j > 0; j >>= 1)
#pragma unroll
      for (int i = 0; i < 16; ++i) {
        const int l = i ^ j;
        if (l > i) { if ((i & k) == 0) cx(v[i], v[l]); else cx(v[l], v[i]); }
      }
}
__device__ __forceinline__ void bitonic_merge16_desc(float (&v)[16]) {
#pragma unroll
  for (int j = 8; j > 0; j >>= 1)
#pragma unroll
    for (int i = 0; i < 16; ++i) { const int l = i ^ j; if (l > i) cx(v[i], v[l]); }
}
__device__ __forceinline__ void top16_merge(float (&a)[16], const float (&b)[16]) {
#pragma unroll
  for (int i = 0; i < 16; ++i) a[i] = vmaxf(a[i], b[15 - i]);
  bitonic_merge16_desc(a);
}
template <int M> __device__ __forceinline__ void top16_merge_chain(float (&k)[16], int (&q)[16], const float (&xk)[M], const int (&xq)[M]) {
#pragma unroll
  for (int i = 16 - M; i < 16; ++i) { const float a = k[i], b = xk[15 - i]; const bool c = a >= b; k[i] = vmaxf(a, b); q[i] = c ? q[i] : xq[15 - i]; }
#pragma unroll
  for (int j = 8; j > 0; j >>= 1)
#pragma unroll
    for (int i = 0; i < 16; ++i) { const int l = i ^ j; if (l > i) cx2(k[i], q[i], k[l], q[l]); }
}

__device__ void peer_phase(const Params& p, int l, bool last, unsigned char* smem) {
  const CParamsP pp = launder_kargs();
  unsigned char* const ws = launder_ptr(pp->ws); const int tidx = launder_tid();
  bf16_t* HF = (bf16_t*)(ws + WS_ABUF); float* X = (float*)(ws + WS_X);
  const bf16_t* Q = (const bf16_t*)(ws + WS_Q); const bf16_t* SK = (const bf16_t*)(ws + WS_SUBK) + (size_t)l * 16 * 128 * 128;
  const uint4* U8 = (const uint4*)(ws + WS_PU8) + (size_t)l * 16384 * 64; const uint4* V8 = (const uint4*)(ws + WS_PV8) + (size_t)l * 16384 * 64;
  const float* g2 = (const float*)(ws + WS_MOD) + (size_t)l * 2 * 6144 + 5120;
  const int ln = last ? l : l + 1;
  const float* nsh = (const float*)(ws + WS_MOD) + (size_t)ln * 2 * 6144; const float* nsc = nsh + 1024;
  const float* ngain = pp->in[I_NMIX] + (size_t)ln * 1024;
  const int lane = tidx & 63, wid = tidx >> 6;
  const int rL = ((lane >> 5) & 1) * 4 + ((lane >> 4) & 1) * 2 + ((lane >> 3) & 1);
  const bool hi5 = (lane & 32) != 0, hi4 = (lane & 16) != 0, hi3 = (lane & 8) != 0;
  int* idxL = (int*)smem; float* gateL = (float*)(smem + 64 * 132 * 4);
  for (int item = blockIdx.x; item < T_ / 64; item += gridDim.x) {
    const int t0 = item * 64;
    __syncthreads();
    {
      int lane_o = lane; asm volatile("" : "+v"(lane_o));
      const int tg = wid & 1, hp = wid >> 1, hf = lane_o >> 5, tl = 32 * tg + (lane_o & 31);
      const bf16_t* qrow = Q + (size_t)(t0 + tl) * 2048;
      float F[2][16];
#pragma unroll
      for (int sd = 0; sd < 2; ++sd) {
        float Lh[2][16];
#pragma unroll
        for (int hh = 0; hh < 2; ++hh) {
          const int hs = 2 * (2 * hp + hh) + sd;
          float top[16];
          const bf16_t* skb = SK + ((size_t)hs * 128 + (lane & 31)) * 128 + 8 * hf;
#pragma unroll
          for (int kp = 0; kp < 2; ++kp) {
            f32x16 acc[2];
#pragma unroll
            for (int kt = 0; kt < 2; ++kt)
#pragma unroll
              for (int r = 0; r < 16; ++r) acc[kt][r] = 0.f;
#pragma unroll 2
            for (int ks = 0; ks < 8; ++ks) {
              const bf16x8 bq = *(const bf16x8*)(qrow + hs * 128 + ks * 16 + 8 * hf);
#pragma unroll
              for (int kt = 0; kt < 2; ++kt) {
                const bf16x8 ak = *(const bf16x8*)(skb + (size_t)(kp * 2 + kt) * 32 * 128 + ks * 16);
                acc[kt] = __builtin_amdgcn_mfma_f32_32x32x16_bf16(ak, bq, acc[kt], 0, 0, 0);
              }
            }
#pragma unroll
            for (int kt = 0; kt < 2; ++kt) {
              float g[16];
#pragma unroll
              for (int r = 0; r < 16; ++r) {
                const int key = (kp * 2 + kt) * 32 + (r & 3) + 8 * (r >> 2) + 4 * hf;
                g[r] = __uint_as_float((__float_as_uint(acc[kt][r]) & 0xffffff80u) | (unsigned)key);
              }
              bitonic_sort16_desc(g);
              if (kp == 0 && kt == 0) {
#pragma unroll
                for (int r = 0; r < 16; ++r) top[r] = g[r];
              } else top16_merge(top, g);
              __builtin_amdgcn_sched_barrier(0);
            }
          }
#pragma unroll
          for (int r = 0; r < 16; ++r) Lh[hh][r] = top[r];
          __builtin_amdgcn_sched_barrier(0);
        }
#pragma unroll
        for (int r = 0; r < 16; ++r) {
          const auto sw = __builtin_amdgcn_permlane32_swap(__float_as_uint(Lh[0][r]), __float_as_uint(Lh[1][r]), false, false);
          Lh[0][r] = __uint_as_float(sw[0]); Lh[1][r] = __uint_as_float(sw[1]);
        }
        top16_merge(Lh[0], Lh[1]);
#pragma unroll
        for (int r = 0; r < 16; ++r) F[sd][r] = Lh[0][r];
        __builtin_amdgcn_sched_barrier(0);
      }
      int ia[16], ib[16];
#pragma unroll
      for (int r = 0; r < 16; ++r) { ia[r] = (int)(__float_as_uint(F[0][r]) & 127u) << 7; ib[r] = (int)(__float_as_uint(F[1][r]) & 127u); }
      float k[16]; int q[16];
#pragma unroll
      for (int j = 0; j < 16; ++j) { k[j] = F[0][0] + F[1][j]; q[j] = ia[0] | ib[j]; }
      { float xk[8]; int xq[8];
#pragma unroll
        for (int j = 0; j < 8; ++j) { xk[j] = F[0][1] + F[1][j]; xq[j] = ia[1] | ib[j]; }
        top16_merge_chain<8>(k, q, xk, xq); }
      { float xk[5]; int xq[5];
#pragma unroll
        for (int j = 0; j < 5; ++j) { xk[j] = F[0][2] + F[1][j]; xq[j] = ia[2] | ib[j]; }
        top16_merge_chain<5>(k, q, xk, xq); }
      { float xk[4]; int xq[4];
#pragma unroll
        for (int j = 0; j < 4; ++j) { xk[j] = F[0][3] + F[1][j]; xq[j] = ia[3] | ib[j]; }
        top16_merge_chain<4>(k, q, xk, xq); }
      { float xk[3]; int xq[3];
#pragma unroll
        for (int j = 0; j < 3; ++j) { xk[j] = F[0][4] + F[1][j]; xq[j] = ia[4] | ib[j]; }
        top16_merge_chain<3>(k, q, xk, xq); }
      { float xk[11]; int xq[11];
#pragma unroll
        for (int i = 0; i < 11; ++i) { xk[i] = F[0][5 + i] + F[1][0]; xq[i] = ia[5 + i] | ib[0]; }
        top16_merge_chain<11>(k, q, xk, xq); }
      { float xk[3]; int xq[3];
#pragma unroll
        for (int i = 0; i < 3; ++i) { xk[i] = F[0][5 + i] + F[1][1]; xq[i] = ia[5 + i] | ib[1]; }
        top16_merge_chain<3>(k, q, xk, xq); }
      float e[16]; float es = 0.f;
#pragma unroll
      for (int i = 0; i < 16; ++i) { e[i] = __expf(k[i] - k[0]); es += e[i]; }
      const float ies = 1.f / es;
      const int h = 2 * hp + hf;
#pragma unroll
      for (int i = 0; i < 16; ++i) { idxL[tl * 132 + h * 16 + i] = q[i]; gateL[tl * 132 + h * 16 + i] = e[i] * ies; }
    }
    __syncthreads();
#pragma unroll 1
    for (int ii = 0; ii < 8; ++ii) {
      const int tl = wid * 8 + ii, t = t0 + tl, b = t >> 13;
      float hv[16];
      {
        const uint4 h0 = *(const uint4*)(HF + (size_t)t * 1024 + lane * 16), h1 = *(const uint4*)(HF + (size_t)t * 1024 + lane * 16 + 8);
        const unsigned hw[8] = {h0.x, h0.y, h0.z, h0.w, h1.x, h1.y, h1.z, h1.w};
#pragma unroll
        for (int qq = 0; qq < 8; ++qq) { hv[2 * qq] = __uint_as_float(hw[qq] << 16); hv[2 * qq + 1] = __uint_as_float(hw[qq] & 0xffff0000u); }
      }
      const int e0 = idxL[tl * 132 + lane], e1 = idxL[tl * 132 + 64 + lane];
      const float g0 = gateL[tl * 132 + lane], g1 = gateL[tl * 132 + 64 + lane];
      float acc[16];
#pragma unroll
      for (int j = 0; j < 16; ++j) acc[j] = 0.f;
#pragma unroll 1
      for (int bt = 0; bt < 16; ++bt) {
        const int esrc = (bt < 8) ? e0 : e1; const float gsrc = (bt < 8) ? g0 : g1; const int lb = (bt & 7) * 8;
        uint4 ur[8], vr[8];
        int eidx[8];
#pragma unroll
        for (int r = 0; r < 8; ++r) eidx[r] = __builtin_amdgcn_readlane(esrc, lb + r);
#pragma unroll
        for (int r = 0; r < 8; ++r) ur[r] = U8[(size_t)eidx[r] * 64 + lane];
#pragma unroll
        for (int r = 0; r < 8; ++r) vr[r] = V8[(size_t)eidx[r] * 64 + lane];
        float d[8];
#pragma unroll
        for (int r = 0; r < 8; ++r) { d[r] = dot16_fp8(ur[r], hv); asm volatile("" : "+v"(d[r])); }
        float r4[4], r2[2];
#pragma unroll
        for (int i = 0; i < 4; ++i) { const float keep = hi5 ? d[i + 4] : d[i], send = hi5 ? d[i] : d[i + 4]; r4[i] = keep + __shfl_xor(send, 32); }
#pragma unroll
        for (int i = 0; i < 2; ++i) { const float keep = hi4 ? r4[i + 2] : r4[i], send = hi4 ? r4[i] : r4[i + 2]; r2[i] = keep + __shfl_xor(send, 16); }
        float r1;
        { const float keep = hi3 ? r2[1] : r2[0], send = hi3 ? r2[0] : r2[1]; r1 = keep + __shfl_xor(send, 8); }
        r1 += __shfl_xor(r1, 4); r1 += __shfl_xor(r1, 2); r1 += __shfl_xor(r1, 1);
        const float gl = __shfl(gsrc, lb + rL);
        const float w = gl * gelu_tanh(r1 * (1.f / 1024.f));
#pragma unroll
        for (int r = 0; r < 8; ++r) {
          const int Lk = ((r >> 2) & 1) * 32 + ((r >> 1) & 1) * 16 + (r & 1) * 8;
          const float wr = __int_as_float(__builtin_amdgcn_readlane(__float_as_int(w), Lk));
          axpy16_fp8(vr[r], wr, acc);
          __builtin_amdgcn_sched_barrier(0);
        }
      }
      float xn[16]; float ss = 0.f;
#pragma unroll
      for (int qq = 0; qq < 4; ++qq) {
        const int c = lane * 16 + 4 * qq;
        const f32x4 xv = *(const f32x4*)(X + (size_t)t * 1024 + c), g = *(const f32x4*)(g2 + b * 6144 + c);
        xn[4 * qq] = xv.x + g.x * acc[4 * qq] * (1.f / 64.f); xn[4 * qq + 1] = xv.y + g.y * acc[4 * qq + 1] * (1.f / 64.f);
        xn[4 * qq + 2] = xv.z + g.z * acc[4 * qq + 2] * (1.f / 64.f); xn[4 * qq + 3] = xv.w + g.w * acc[4 * qq + 3] * (1.f / 64.f);
        ss += xn[4 * qq] * xn[4 * qq] + xn[4 * qq + 1] * xn[4 * qq + 1] + xn[4 * qq + 2] * xn[4 * qq + 2] + xn[4 * qq + 3] * xn[4 * qq + 3];
      }
      const float rstd = rsqrtf(wave_sum(ss) * (1.f / 1024.f) + EPS_);
      if (!last) {
        unsigned hb[8];
#pragma unroll
        for (int qq = 0; qq < 4; ++qq) {
          const int c = lane * 16 + 4 * qq;
          *(f32x4*)(X + (size_t)t * 1024 + c) = (f32x4){xn[4 * qq], xn[4 * qq + 1], xn[4 * qq + 2], xn[4 * qq + 3]};
          const f32x4 gn = *(const f32x4*)(ngain + c), sh = *(const f32x4*)(nsh + b * 6144 + c), sc = *(const f32x4*)(nsc + b * 6144 + c);
          hb[2 * qq] = pk2(xn[4 * qq] * rstd * gn.x * (1.f + sc.x) + sh.x, xn[4 * qq + 1] * rstd * gn.y * (1.f + sc.y) + sh.y);
          hb[2 * qq + 1] = pk2(xn[4 * qq + 2] * rstd * gn.z * (1.f + sc.z) + sh.z, xn[4 * qq + 3] * rstd * gn.w * (1.f + sc.w) + sh.w);
        }
        *(uint4*)(HF + (size_t)t * 1024 + lane * 16) = make_uint4(hb[0], hb[1], hb[2], hb[3]);
        *(uint4*)(HF + (size_t)t * 1024 + lane * 16 + 8) = make_uint4(hb[4], hb[5], hb[6], hb[7]);
      } else {
#pragma unroll
        for (int qq = 0; qq < 4; ++qq) {
          const int c = lane * 16 + 4 * qq;
          const f32x4 fn = *(const f32x4*)(pp->in[I_FNORM] + c);
          *(f32x4*)(pp->out + (size_t)t * 1024 + c) = (f32x4){xn[4 * qq] * rstd * fn.x, xn[4 * qq + 1] * rstd * fn.y, xn[4 * qq + 2] * rstd * fn.z, xn[4 * qq + 3] * rstd * fn.w};
        }
      }
    }
  }
}

#define XB_TMO      128
#define XB_XCNT(j)  (256  + 64 * (j))
#define XB_XSUB(j)  (1280 + 64 * (j))
#define XB_XGEN(j)  (2304 + 64 * (j))
#define XB_TOP      3328
#define XB_TOPGEN   3392
#define XCD_BAR_WORDS 3456
#define XB_SPIN_CAP (1u << 20)
#define LAS __attribute__((address_space(3)))
__device__ __forceinline__ unsigned xb_ld(unsigned* q)              { return __hip_atomic_load(q, __ATOMIC_RELAXED, __HIP_MEMORY_SCOPE_AGENT); }
__device__ __forceinline__ unsigned xb_add(unsigned* q, unsigned v) { return __hip_atomic_fetch_add(q, v, __ATOMIC_RELAXED, __HIP_MEMORY_SCOPE_AGENT); }
__device__ __forceinline__ unsigned xb_xcc_id() { return (unsigned)__builtin_amdgcn_s_getreg((3 << 11) | 20) & 0xFu; }
#define XB_SPIN(cond, bar) do { unsigned _sp = 0; while (cond) { __builtin_amdgcn_s_sleep(1); \
    if ((++_sp & 255u) == 0u) { if (xb_ld(&(bar)[XB_TMO])) break; if (_sp > XB_SPIN_CAP) { atomicAdd(&(bar)[XB_TMO], 1u); break; } } } } while (0)
struct XcdBarrier { unsigned* bar; unsigned x; volatile LAS unsigned* st; };
__device__ __forceinline__ XcdBarrier xcd_barrier_post(unsigned* bar, volatile LAS unsigned* st) {
    XcdBarrier b; b.bar = bar; b.x = xb_xcc_id(); b.st = st;
    if (threadIdx.x == 0) (void)xb_add(&bar[XB_XCNT(b.x)], 1u);
    return b;
}
__device__ __forceinline__ void xcd_barrier_complete(unsigned* bar, unsigned x, unsigned& nloc, unsigned& nx) {
    const unsigned G = gridDim.x * gridDim.y * gridDim.z;
    unsigned sum, cnt, mine, sp = 0u;
    for (;;) {
        sum = 0u; cnt = 0u; mine = 0u;
#pragma unroll
        for (unsigned j = 0; j < 16; ++j) { const unsigned c = xb_ld(&bar[XB_XCNT(j)]); sum += c; cnt += (c > 0u) ? 1u : 0u; mine = (j == x) ? c : mine; }
        if (sum == G) break;
        __builtin_amdgcn_s_sleep(1);
        if ((++sp & 255u) == 0u) { if (xb_ld(&bar[XB_TMO])) break; if (sp > XB_SPIN_CAP) { atomicAdd(&bar[XB_TMO], 1u); break; } }
    }
    nloc = mine > 0u ? mine : 1u; nx = cnt > 0u ? cnt : 1u;
}
__device__ __forceinline__ void xcd_barrier(const XcdBarrier& b) {
    asm volatile("s_waitcnt vmcnt(0)" ::: "memory");
    __syncthreads();
    if (threadIdx.x == 0) {
        unsigned* bar = b.bar;
        __builtin_amdgcn_s_waitcnt(0);
        unsigned nloc = b.st[0], nx = b.st[1];
        if (nloc == 0u) { xcd_barrier_complete(bar, b.x, nloc, nx); b.st[0] = nloc; b.st[1] = nx; }
        const unsigned old = xb_add(&bar[XB_XSUB(b.x)], 1u);
        const unsigned gen = old / nloc;
        if (old + 1u == (gen + 1u) * nloc) {
            __builtin_amdgcn_fence(__ATOMIC_RELEASE, "agent");
            asm volatile("s_waitcnt vmcnt(0)" ::: "memory");
            const unsigned og = xb_add(&bar[XB_TOP], 1u);
            const unsigned tg = og / nx;
            if (og + 1u == (tg + 1u) * nx) xb_add(&bar[XB_TOPGEN], 1u);
            else XB_SPIN(xb_ld(&bar[XB_TOPGEN]) == tg, bar);
            __builtin_amdgcn_fence(__ATOMIC_ACQUIRE, "agent");
            xb_add(&bar[XB_XGEN(b.x)], 1u);
            asm volatile("s_waitcnt vmcnt(0)" ::: "memory");
        } else {
            XB_SPIN(xb_ld(&bar[XB_XGEN(b.x)]) == gen, bar);
            __builtin_amdgcn_fence(__ATOMIC_ACQUIRE, "agent");
            asm volatile("s_waitcnt vmcnt(0)" ::: "memory");
        }
    }
    __syncthreads();
}

__global__ void __launch_bounds__(NT) fwd_megakernel(Params p) {
  extern __shared__ __attribute__((aligned(16))) unsigned char smem[];
  const CParamsP pp = launder_kargs();
  cg::grid_group grid = cg::this_grid();
  volatile LAS unsigned* xbst = (volatile LAS unsigned*)(smem + LDS_BYTES - 16);
  if (threadIdx.x == 0) { xbst[0] = 0u; xbst[1] = 0u; }
  if (blockIdx.x == 0) { unsigned* bw = (unsigned*)(pp->ws + WS_BAR); for (int i = threadIdx.x; i < XCD_BAR_WORDS; i += NT) bw[i] = 0u; }
  setup_phase(p, smem);
  grid.sync();
  const XcdBarrier xb = xcd_barrier_post((unsigned*)(pp->ws + WS_BAR), xbst);
  const float* MOD = (const float*)(pp->ws + WS_MOD);
  for (int l = 0; l < DEPTH_; ++l) {
    const float* xsrc = (l == 0) ? pp->in[I_X] : (const float*)(pp->ws + WS_X);
    const float* modl = MOD + (size_t)l * 2 * 6144;
    if (l == 0) {
      norm_mod_phase(xsrc, pp->in[I_NMIX], modl + 0, modl + 1024, (bf16_t*)(pp->ws + WS_ABUF));
      xcd_barrier(xb);
    }
    gemm_proj_phase(p, l, smem);
    xcd_barrier(xb);
    attn_phase(p, l);
    mix_local_phase(p, l, smem);
    xcd_barrier(xb);
    scan_phase(p, l);
    xcd_barrier(xb);
    mix_final_phase(p, l, smem);
    xcd_barrier(xb);
    gemm_out_phase(p, l, xsrc, smem);
    xcd_barrier(xb);
    norm_mod_phase((const float*)(pp->ws + WS_X), pp->in[I_NFFN] + (size_t)l * 1024, modl + 3072, modl + 4096, (bf16_t*)(pp->ws + WS_ABUF));
    xcd_barrier(xb);
    gemm_q_phase(p, l, smem);
    xcd_barrier(xb);
    peer_phase(p, l, l == DEPTH_ - 1, smem);
    xcd_barrier(xb);
  }
}

extern "C" void kernel_launch(void* const* d_in, const int* in_sizes, int n_in,
                              void* d_out, int out_size, void* d_ws, size_t ws_size,
                              hipStream_t stream) {
  static int grid_blocks = 0;
  if (grid_blocks == 0) {
    if (n_in != 24 || ws_size < WS_END) { fprintf(stderr, "kernel_launch: unexpected n_in %d / ws_size %zu (need %zu)\n", n_in, ws_size, (size_t)WS_END); grid_blocks = -1; return; }
    int dev = 0, cus = 0, per_cu = 0;
    if (hipGetDevice(&dev) != hipSuccess || hipDeviceGetAttribute(&cus, hipDeviceAttributeMultiprocessorCount, dev) != hipSuccess) { grid_blocks = -1; return; }
    if (hipFuncSetAttribute((const void*)fwd_megakernel, hipFuncAttributeMaxDynamicSharedMemorySize, LDS_BYTES) != hipSuccess) { fprintf(stderr, "hipFuncSetAttribute failed\n"); grid_blocks = -1; return; }
    if (hipOccupancyMaxActiveBlocksPerMultiprocessor(&per_cu, (const void*)fwd_megakernel, NT, LDS_BYTES) != hipSuccess || per_cu < 1) { fprintf(stderr, "occupancy query: %d\n", per_cu); grid_blocks = -1; return; }
    grid_blocks = cus;
  }
  if (grid_blocks < 0) return;
  Params p{};
  for (int i = 0; i < 24; ++i) p.in[i] = (const float*)d_in[i];
  p.out = (float*)d_out; p.ws = (unsigned char*)d_ws;
  void* args[] = {&p};
  hipError_t e = hipLaunchCooperativeKernel((void*)fwd_megakernel, dim3(grid_blocks), dim3(NT), args, LDS_BYTES, stream);
  if (e != hipSuccess) fprintf(stderr, "cooperative launch failed: %s (grid %d)\n", hipGetErrorString(e), grid_blocks);
}
```

```cpp
#include <hip/hip_runtime.h>
#include <hip/hip_cooperative_groups.h>
#include <cstdio>
#include <cstdint>
namespace cg = cooperative_groups;

typedef unsigned short bf16_t;
typedef short bf16x8 __attribute__((ext_vector_type(8)));
typedef float f32x4 __attribute__((ext_vector_type(4)));

constexpr int T_ = 16384, D_ = 1024, L_ = 8192, NBATCH = 2, DEPTH_ = 4;
constexpr int INC = 2944, INCP = 3072;
constexpr int NCH = 128;
constexpr int NT = 512;
constexpr int NW = 8;
constexpr float EPS_ = 1e-6f;
constexpr int C_QA = 0, C_KA = 384, C_VA = 768, C_QR = 1152, C_KR = 1536, C_VR = 1920, C_GR = 2304, C_US = 2688;

constexpr size_t al256(size_t x) { return (x + 255) & ~(size_t)255; }
constexpr size_t WS_MOD   = 0;
constexpr size_t WS_ROTC  = al256(WS_MOD + 4ull * 2 * 6144 * 4);
constexpr size_t WS_ROTS  = al256(WS_ROTC + 8192ull * 32 * 4);
constexpr size_t WS_SA    = al256(WS_ROTS + 8192ull * 32 * 4);
constexpr size_t WS_SBB   = al256(WS_SA + 4ull * 16 * 64 * 2 * 4);
constexpr size_t WS_WIN   = al256(WS_SBB + 4ull * 16 * 64 * 32 * 4);
constexpr size_t WS_WOUT  = al256(WS_WIN + 4ull * INCP * 1024 * 2);
constexpr size_t WS_WQ    = al256(WS_WOUT + 4ull * 1024 * 1024 * 2);
constexpr size_t WS_SUBK  = al256(WS_WQ + 4ull * 2048 * 1024 * 2);
constexpr size_t WS_ABUF  = al256(WS_SUBK + 4ull * 16 * 128 * 128 * 2);
constexpr size_t WS_PROJ  = al256(WS_ABUF + (size_t)T_ * 1024 * 2);
constexpr size_t WS_VTA   = al256(WS_PROJ + (size_t)T_ * INCP * 2);
constexpr size_t WS_ATT   = al256(WS_VTA + 2ull * 6 * 64 * 8192 * 2);
constexpr size_t WS_YINT  = al256(WS_ATT + (size_t)T_ * 384 * 4);
constexpr size_t WS_UPD   = al256(WS_YINT + (size_t)T_ * 384 * 4);
constexpr size_t WS_SPREV = al256(WS_UPD + 256ull * 6 * 4096 * 4);
constexpr size_t WS_SEND  = al256(WS_SPREV + 256ull * 6 * 4096 * 4);
constexpr size_t WS_CARRY = al256(WS_SEND + 256ull * 16 * 64 * 2 * 4);
constexpr size_t WS_X     = al256(WS_CARRY + 256ull * 16 * 64 * 2 * 4);
constexpr size_t WS_Q     = al256(WS_X + (size_t)T_ * 1024 * 4);
constexpr size_t WS_SC    = al256(WS_Q + (size_t)T_ * 2048 * 2);
constexpr size_t WS_EIDX  = al256(WS_SC + (size_t)T_ * 2048 * 4);
constexpr size_t WS_EGATE = al256(WS_EIDX + (size_t)T_ * 128 * 4);
constexpr size_t WS_PU8   = al256(WS_EGATE + (size_t)T_ * 128 * 4);
constexpr size_t WS_PV8   = al256(WS_PU8 + 4ull * 16384 * 1024);
constexpr size_t WS_BAR   = al256(WS_PV8 + 4ull * 16384 * 1024);
constexpr size_t WS_SPT   = al256(WS_BAR + 3456ull * 4);
constexpr size_t WS_CB    = al256(WS_SPT + 256ull * 6 * 4096 * 2);
constexpr size_t WS_WGLUT = al256(WS_CB + 4ull * 16 * 16 * 128 * 2);
constexpr size_t WS_VTR   = al256(WS_WGLUT + 4ull * 512 * 256 * 2);
constexpr size_t WS_END   = al256(WS_VTR + 2ull * 384 * 8192 * 2);

constexpr int LDS_BYTES = 135168;

struct Params {
  const float* in[24];
  float* out;
  unsigned char* ws;
};
enum { I_X = 0, I_C, I_WADA, I_BADA, I_NMIX, I_NFFN, I_WIN, I_RELB, I_LRE, I_LIM, I_LOGDT, I_BRE, I_BIM, I_CRE, I_CIM, I_SSMD,
       I_WGLU, I_MGAIN, I_WOUT, I_WQ, I_SUBK, I_PU, I_PV, I_FNORM };

__device__ __forceinline__ float bf2f(bf16_t v) { return __uint_as_float(((unsigned)v) << 16); }
__device__ __forceinline__ bf16_t f2bf(float f) { unsigned u = __float_as_uint(f); u += 0x7fffu + ((u >> 16) & 1u); return (bf16_t)(u >> 16); }
__device__ __forceinline__ unsigned pk2(float a, float b) { return (unsigned)f2bf(a) | ((unsigned)f2bf(b) << 16); }
__device__ __forceinline__ float wave_sum(float v) {
#pragma unroll
  for (int o = 32; o > 0; o >>= 1) v += __shfl_xor(v, o);
  return v;
}
__device__ __forceinline__ float wave_max(float v) {
#pragma unroll
  for (int o = 32; o > 0; o >>= 1) v = fmaxf(v, __shfl_xor(v, o));
  return v;
}
__device__ __forceinline__ float gelu_tanh(float x) { const float u = 0.7978845608028654f * (x + 0.044715f * x * x * x); return 0.5f * x * (1.f + tanhf(u)); }
__device__ __forceinline__ float sigmoid_f(float x) { return 1.f / (1.f + __expf(-x)); }
__device__ __forceinline__ unsigned char* launder_ptr(unsigned char* q) { asm volatile("" : "+s"(q)); return q; }
__device__ __forceinline__ const float* launder_cptr(const float* q) { asm volatile("" : "+s"(q)); return q; }
__device__ __forceinline__ int launder_tid() { int t = threadIdx.x; asm volatile("" : "+v"(t)); return t; }
typedef const Params __attribute__((address_space(4)))* CParamsP;
__device__ __forceinline__ CParamsP launder_kargs() { CParamsP q = (CParamsP)__builtin_amdgcn_kernarg_segment_ptr(); asm volatile("" : "+s"(q)); return q; }

__device__ void setup_phase(const Params& p, unsigned char* smem) {
  const CParamsP pp = launder_kargs();
  unsigned char* const ws = launder_ptr(pp->ws); const int tidx = launder_tid(); (void)ws; (void)tidx;
  const int tid = tidx;
  float* sm = (float*)smem;
  {
    float* cond = sm;
    float* red = sm + 2048;
    float* MOD = (float*)(ws + WS_MOD);
    for (int i = tid; i < 2048; i += NT) { const float c = pp->in[I_C][i]; cond[i] = c * sigmoid_f(c); }
    __syncthreads();
    for (int item = blockIdx.x; item < 4 * 96; item += gridDim.x) {
      const int l = item / 96, cb = item % 96, kq = tid >> 6, jj = tid & 63, j = cb * 64 + jj;
      const float* w = pp->in[I_WADA] + (size_t)l * 1024 * 6144 + j;
      float a0 = 0.f, a1 = 0.f;
      for (int k = kq * 128; k < kq * 128 + 128; ++k) { const float wv = w[(size_t)k * 6144]; a0 += cond[k] * wv; a1 += cond[1024 + k] * wv; }
      red[(kq * 2 + 0) * 64 + jj] = a0; red[(kq * 2 + 1) * 64 + jj] = a1;
      __syncthreads();
      if (tid < 128) {
        const int b = tid >> 6, j2 = tid & 63; float s = 0.f;
        for (int q = 0; q < 8; ++q) s += red[(q * 2 + b) * 64 + j2];
        MOD[((size_t)l * 2 + b) * 6144 + cb * 64 + j2] = s + pp->in[I_BADA][(size_t)l * 6144 + cb * 64 + j2];
      }
      __syncthreads();
    }
  }
  const int gtid = blockIdx.x * NT + tid, gn = gridDim.x * NT;
  {
    float* RC = (float*)(ws + WS_ROTC); float* RS = (float*)(ws + WS_ROTS);
    for (int idx = gtid; idx < 8192 * 32; idx += gn) {
      const int pos = idx >> 5, i = idx & 31;
      const float inv = powf(10000.0f, -(float)i / 32.0f);
      const float ang = (float)pos * inv;
      float s, c; sincosf(ang, &s, &c);
      RC[idx] = c; RS[idx] = s;
    }
  }
  {
    float* SA = (float*)(ws + WS_SA); float* SBB = (float*)(ws + WS_SBB);
    for (int idx = gtid; idx < 4 * 16 * 64; idx += gn) {
      const int l = idx / 1024, g = (idx >> 6) & 15;
      const float dt = expf(pp->in[I_LOGDT][l * 16 + g]);
      const float lr = pp->in[I_LRE][idx], li = pp->in[I_LIM][idx];
      const float mag = expf(lr * dt);
      float sn, cs; sincosf(li * dt, &sn, &cs);
      const float are = mag * cs, aim = mag * sn;
      const float den = lr * lr + li * li, nr = are - 1.f, ni = aim;
      const float fre = (nr * lr + ni * li) / den, fim = (ni * lr - nr * li) / den;
      SA[idx * 2] = are; SA[idx * 2 + 1] = aim;
      for (int c = 0; c < 16; ++c) {
        const float br = pp->in[I_BRE][(size_t)idx * 16 + c], bi = pp->in[I_BIM][(size_t)idx * 16 + c];
        SBB[(size_t)idx * 32 + c] = fre * br - fim * bi;
        SBB[(size_t)idx * 32 + 16 + c] = fre * bi + fim * br;
      }
    }
  }
  {
    bf16_t* SK = (bf16_t*)(ws + WS_SUBK);
    for (int idx = gtid; idx < 4 * 16 * 128 * 128; idx += gn) SK[idx] = f2bf(pp->in[I_SUBK][idx]);
  }
  {
    bf16_t* CB = (bf16_t*)(ws + WS_CB);
    for (int idx = gtid; idx < 4 * 16 * 16 * 128; idx += gn) {
      const int k = idx & 127, lgc = idx >> 7;
      CB[idx] = (k < 64) ? f2bf(pp->in[I_CRE][(size_t)lgc * 64 + k]) : f2bf(-pp->in[I_CIM][(size_t)lgc * 64 + (k - 64)]);
    }
    bf16_t* WG = (bf16_t*)(ws + WS_WGLUT);
    for (int idx = gtid; idx < 4 * 512 * 256; idx += gn) {
      const int k = idx & 255, nn = (idx >> 8) & 511, l2 = idx >> 17;
      WG[idx] = f2bf(pp->in[I_WGLU][((size_t)l2 * 256 + k) * 512 + nn]);
    }
  }
  {
    constexpr size_t NIT = 4ull * 16384 * 1024 / 16;
    for (size_t it = gtid; it < 2 * NIT; it += gn) {
      const int tb = it >= NIT ? 1 : 0; const size_t r = it - (size_t)tb * NIT;
      const f32x4* src = (const f32x4*)((tb ? pp->in[I_PV] : pp->in[I_PU]) + r * 16);
      const float sc = tb ? 64.f : 1024.f;
      unsigned o[4];
#pragma unroll
      for (int q = 0; q < 4; ++q) {
        const f32x4 a = src[q];
        const float x0 = fminf(fmaxf(a.x * sc, -448.f), 448.f), x1 = fminf(fmaxf(a.y * sc, -448.f), 448.f);
        const float x2 = fminf(fmaxf(a.z * sc, -448.f), 448.f), x3 = fminf(fmaxf(a.w * sc, -448.f), 448.f);
        int pk = __builtin_amdgcn_cvt_pk_fp8_f32(x0, x1, 0, false);
        pk = __builtin_amdgcn_cvt_pk_fp8_f32(x2, x3, pk, true);
        o[q] = (unsigned)pk;
      }
      *(uint4*)(ws + (tb ? WS_PV8 : WS_PU8) + r * 16) = make_uint4(o[0], o[1], o[2], o[3]);
    }
  }
  {
    float* tile = sm;
    constexpr int IT_IN = 4 * 16 * 48, IT_OUT = 4 * 16 * 16, IT_Q = 4 * 16 * 32;
    __syncthreads();
    for (int item = blockIdx.x; item < IT_IN + IT_OUT + IT_Q; item += gridDim.x) {
      const float* W; bf16_t* WT; int N, NP, r = item;
      if (r < IT_IN) { const int l = r / (16 * 48); r %= 16 * 48; W = pp->in[I_WIN] + (size_t)l * 1024 * INC; WT = (bf16_t*)(ws + WS_WIN) + (size_t)l * INCP * 1024; N = INC; NP = 48; }
      else if (r < IT_IN + IT_OUT) { r -= IT_IN; const int l = r / 256; r %= 256; W = pp->in[I_WOUT] + (size_t)l * 1024 * 1024; WT = (bf16_t*)(ws + WS_WOUT) + (size_t)l * 1024 * 1024; N = 1024; NP = 16; }
      else { r -= IT_IN + IT_OUT; const int l = r / 512; r %= 512; W = pp->in[I_WQ] + (size_t)l * 1024 * 2048; WT = (bf16_t*)(ws + WS_WQ) + (size_t)l * 2048 * 1024; N = 2048; NP = 32; }
      const int kb = r / NP, nb = r % NP, k0 = kb * 64, n0 = nb * 64;
      {
        const int col = tid & 63, rr = tid >> 6;
#pragma unroll
        for (int i = 0; i < 8; ++i) { const int kk = rr + 8 * i; const int n = n0 + col; tile[kk * 65 + col] = (n < N) ? W[(size_t)(k0 + kk) * N + n] : 0.f; }
      }
      __syncthreads();
      {
        const int n = tid >> 3, kc = tid & 7; const float* s = tile + (kc * 8) * 65 + n;
        uint4 o; o.x = pk2(s[0], s[65]); o.y = pk2(s[2 * 65], s[3 * 65]); o.z = pk2(s[4 * 65], s[5 * 65]); o.w = pk2(s[6 * 65], s[7 * 65]);
        *(uint4*)(WT + (size_t)(n0 + n) * 1024 + k0 + kc * 8) = o;
      }
      __syncthreads();
    }
  }
}

__device__ void norm_mod_phase(const float* __restrict__ xsrc, const float* __restrict__ gain, const float* __restrict__ mod_sh, const float* __restrict__ mod_sc,
                               bf16_t* __restrict__ outp) {
  const int tidx = launder_tid();
  const int lane = tidx & 63, gw = blockIdx.x * NW + (tidx >> 6), nw = gridDim.x * NW;
  for (int t = gw; t < T_; t += nw) {
    const int b = t >> 13;
    const f32x4* xr = (const f32x4*)(xsrc + (size_t)t * 1024) + lane;
    f32x4 v[4]; float s = 0.f;
#pragma unroll
    for (int j = 0; j < 4; ++j) { v[j] = xr[64 * j]; s += v[j].x * v[j].x + v[j].y * v[j].y + v[j].z * v[j].z + v[j].w * v[j].w; }
    const float rstd = rsqrtf(wave_sum(s) * (1.f / 1024.f) + EPS_);
#pragma unroll
    for (int j = 0; j < 4; ++j) {
      const int c = lane * 4 + 256 * j;
      const f32x4 g = *(const f32x4*)(gain + c), sh = *(const f32x4*)(mod_sh + b * 6144 + c), sc = *(const f32x4*)(mod_sc + b * 6144 + c);
      const float o0 = v[j].x * rstd * g.x * (1.f + sc.x) + sh.x, o1 = v[j].y * rstd * g.y * (1.f + sc.y) + sh.y;
      const float o2 = v[j].z * rstd * g.z * (1.f + sc.z) + sh.z, o3 = v[j].w * rstd * g.w * (1.f + sc.w) + sh.w;
      uint2 o; o.x = pk2(o0, o1); o.y = pk2(o2, o3);
      *(uint2*)(outp + (size_t)t * 1024 + c) = o;
    }
  }
}


namespace pg8 {
#define PG8_LAS __attribute__((address_space(3)))
typedef unsigned u32x4 __attribute__((ext_vector_type(4)));
constexpr int BM = 256, BK = 64, HALF = 128, HTB = HALF * BK * 2, STAGE_BYTES = 8 * HTB, NXCD = 8, WGM = 8;
__host__ __device__ __forceinline__ int lds_byte(int r, int c) { const int st = (r >> 4) * 2 + (c >> 5), rr = r & 15, cc = c & 31, ob = rr * 64 + cc * 2; return st * 1024 + (ob ^ (((ob >> 9) & 1) << 5)); }
__host__ __device__ __forceinline__ void stage_rc(int b, int& R, int& C) { const int st = b / 1024, sb = b % 1024, swz = sb ^ (((sb >> 9) & 1) << 5); R = (st >> 1) * 16 + swz / 64; C = (st & 1) * 32 + (swz % 64) / 2; }
__host__ __device__ __forceinline__ int perm32(int rho) { const int n = rho >> 4, i = rho & 15; return 8 * (i >> 2) + 4 * n + (i & 3); }
struct Unit { int pm, pn; };
struct Gemm { const bf16_t* A; const bf16_t* Bt; int M, N, K; };
struct StaticOrder {
    int nM, nN, nwg, G, c;
    __host__ __device__ void init(int M, int N, int G_, int c_) { nM = M / BM; nN = N / BM; nwg = nM * nN; G = G_; c = c_; }
    __host__ __device__ bool next(int i, Unit& u) const {
        const long L = (long)i * G + c; if (L >= nwg) return false;
        int wgid = (int)L; { const int q = nwg / NXCD, r = nwg % NXCD, xcd = wgid % NXCD, off = wgid / NXCD; wgid = (xcd < r ? xcd * (q + 1) : r * (q + 1) + (xcd - r) * q) + off; }
        const int nig = WGM * nN, gid = wgid / nig, fm = gid * WGM, gsz = (nM - fm) < WGM ? (nM - fm) : WGM;
        u.pm = fm + ((wgid % nig) % gsz); u.pn = (wgid % nig) / gsz; return true;
    }
    __device__ __forceinline__ void a_ready(const Unit&) const {}
    __device__ __forceinline__ void done(const Unit&) const {}
};
__device__ __forceinline__ unsigned cvt_pk_bf16(float lo, float hi) { unsigned r; asm volatile("v_cvt_pk_bf16_f32 %0, %1, %2" : "=v"(r) : "v"(lo), "v"(hi)); return r; }
template <class Epi, class Sched>
__device__ __forceinline__ void gemm_phase(PG8_LAS unsigned char* lds, const Gemm g, const Sched& S, const Epi& E) {
    const int tid = threadIdx.x, wid = __builtin_amdgcn_readfirstlane(tid >> 6), lane = tid & 63, wr = wid >> 2, wc = wid & 3, fr = lane & 15, fq = lane >> 4;
    const int K = g.K, nt = K / BK;
    unsigned voffA[2], voffB[2];
#pragma unroll
    for (int i = 0; i < 2; ++i) { int R, C; stage_rc(tid * 16 + i * 8192, R, C); const int Rb = Epi::PERM ? ((R & ~31) + perm32(R & 31)) : R;
        voffA[i] = (unsigned)(R * K + C) * 2u; voffB[i] = (unsigned)(Rb * K + C) * 2u; }
    const size_t kstep = (size_t)(BK * 2);
    const size_t hstep = (size_t)HALF * K * 2;
    const size_t tstep = 2 * hstep;
    const unsigned ldsw = (unsigned)wid * 1024u;
    const int aoff = lds_byte(wr * 64 + fr, fq * 8), boff = lds_byte(wc * 32 + fr, fq * 8);
#define PG8_SA(b, h) (((b) * 2 + (h)) * HTB)
#define PG8_SB(b, h) ((4 + (b) * 2 + (h)) * HTB)
#define PG8_STAGE(bufoff, gbase, voff) do { _Pragma("unroll") for (int _i = 0; _i < 2; ++_i) \
        __builtin_amdgcn_global_load_lds((const unsigned*)((const char*)(gbase) + (voff)[_i]), (PG8_LAS unsigned*)(lds + (bufoff) + ldsw + _i * 8192), 16, 0, 0); } while (0)
#define PG8_LDA(dst, b, h) do { _Pragma("unroll") for (int m = 0; m < 4; ++m) _Pragma("unroll") for (int k = 0; k < 2; ++k) dst[m][k] = *(const PG8_LAS bf16x8*)(lds + PG8_SA(b, h) + aoff + m * 2048 + k * 1024); } while (0)
#define PG8_LDB(dst, b, h) do { _Pragma("unroll") for (int n = 0; n < 2; ++n) _Pragma("unroll") for (int k = 0; k < 2; ++k) dst[n][k] = *(const PG8_LAS bf16x8*)(lds + PG8_SB(b, h) + boff + n * 2048 + k * 1024); } while (0)
#define PG8_MMA(ai, bj, At, Bt) do { __builtin_amdgcn_s_setprio(1); _Pragma("unroll") for (int m = 0; m < 4; ++m) _Pragma("unroll") for (int n = 0; n < 2; ++n) _Pragma("unroll") for (int k = 0; k < 2; ++k) \
        acc[ai][bj][m][n] = __builtin_amdgcn_mfma_f32_16x16x32_bf16(Bt[n][k], At[m][k], acc[ai][bj][m][n], 0, 0, 0); __builtin_amdgcn_s_setprio(0); } while (0)
#define PG8_WAIT_V(n) asm volatile("s_waitcnt vmcnt(" #n ")" ::: "memory")
#define PG8_WAIT_L(n) asm volatile("s_waitcnt lgkmcnt(" #n ")" ::: "memory")
#define PG8_BAR __builtin_amdgcn_s_barrier()
#define PG8_SCHED __builtin_amdgcn_sched_barrier(0)
    Unit cur, nxt; int ui = 0;
    if (!S.next(0, cur)) return;
    f32x4 acc[2][2][4][2];
#pragma unroll
    for (int a = 0; a < 2; ++a)
#pragma unroll
        for (int b = 0; b < 2; ++b)
#pragma unroll
            for (int m = 0; m < 4; ++m)
#pragma unroll
                for (int n = 0; n < 2; ++n) acc[a][b][m][n] = (f32x4){0.f, 0.f, 0.f, 0.f};
    bf16x8 At[4][2], B0[2][2], B1[2][2];
    const char* cA = (const char*)g.A + (size_t)cur.pm * tstep; const char* cB = (const char*)g.Bt + (size_t)cur.pn * tstep;
    S.a_ready(cur);
    PG8_STAGE(PG8_SB(0, 0), cB, voffB); PG8_STAGE(PG8_SA(0, 0), cA, voffA); PG8_STAGE(PG8_SB(0, 1), cB + hstep, voffB); PG8_STAGE(PG8_SA(0, 1), cA + hstep, voffA);
    if (wr == 1) PG8_BAR;
    PG8_WAIT_V(4); PG8_BAR;
    PG8_STAGE(PG8_SB(1, 0), cB + kstep, voffB); PG8_STAGE(PG8_SA(1, 0), cA + kstep, voffA); PG8_STAGE(PG8_SB(1, 1), cB + hstep + kstep, voffB);
    PG8_WAIT_V(6); PG8_BAR;
    for (;;) {
        const bool has_next = S.next(ui + 1, nxt);
        const char* nA = has_next ? (const char*)g.A + (size_t)nxt.pm * tstep : cA; const char* nB = has_next ? (const char*)g.Bt + (size_t)nxt.pn * tstep : cB;
        for (int t = 0; t < nt; t += 2) {
            const bool last = (t == nt - 2);
            const char* a1 = cA + (size_t)(t + 1) * kstep;
            const char* a2 = last ? nA : cA + (size_t)(t + 2) * kstep; const char* b2 = last ? nB : cB + (size_t)(t + 2) * kstep;
            const char* a3 = a2 + kstep; const char* b3 = b2 + kstep;
            if (last && has_next) S.a_ready(nxt);
            PG8_LDB(B0, 0, 0); PG8_SCHED; PG8_LDA(At, 0, 0); PG8_STAGE(PG8_SA(1, 1), a1 + hstep, voffA);
            PG8_WAIT_L(8); PG8_BAR; PG8_WAIT_L(0); PG8_MMA(0, 0, At, B0); PG8_BAR; PG8_SCHED;
            PG8_LDB(B1, 0, 1); PG8_STAGE(PG8_SB(0, 0), b2, voffB);
            PG8_BAR; PG8_WAIT_L(0); PG8_MMA(0, 1, At, B1); PG8_BAR;
            PG8_LDA(At, 0, 1); PG8_STAGE(PG8_SA(0, 0), a2, voffA);
            PG8_BAR; PG8_WAIT_L(0); PG8_MMA(1, 0, At, B0); PG8_BAR; PG8_SCHED;
            PG8_STAGE(PG8_SB(0, 1), b2 + hstep, voffB);
            PG8_WAIT_V(6); PG8_BAR; PG8_MMA(1, 1, At, B1); PG8_BAR;
            PG8_LDB(B0, 1, 0); PG8_SCHED; PG8_LDA(At, 1, 0); PG8_STAGE(PG8_SA(0, 1), a2 + hstep, voffA);
            PG8_WAIT_L(8); PG8_BAR; PG8_WAIT_L(0); PG8_MMA(0, 0, At, B0); PG8_BAR; PG8_SCHED;
            PG8_LDB(B1, 1, 1); PG8_STAGE(PG8_SB(1, 0), b3, voffB);
            PG8_BAR; PG8_WAIT_L(0); PG8_MMA(0, 1, At, B1); PG8_BAR;
            PG8_LDA(At, 1, 1); PG8_STAGE(PG8_SA(1, 0), a3, voffA);
            PG8_BAR; PG8_WAIT_L(0); PG8_MMA(1, 0, At, B0); PG8_BAR; PG8_SCHED;
            PG8_STAGE(PG8_SB(1, 1), b3 + hstep, voffB);
            PG8_WAIT_V(6); PG8_BAR; PG8_MMA(1, 1, At, B1); PG8_BAR;
        }
        if constexpr (!Epi::AFTER_DRAIN) { E(acc, cur, wr, wc, fr, fq); S.done(cur); }
        if (!has_next) break;
#pragma unroll
        for (int a = 0; a < 2; ++a)
#pragma unroll
            for (int b = 0; b < 2; ++b)
#pragma unroll
                for (int m = 0; m < 4; ++m)
#pragma unroll
                    for (int n = 0; n < 2; ++n) acc[a][b][m][n] = (f32x4){0.f, 0.f, 0.f, 0.f};
        cur = nxt; cA = nA; cB = nB; ++ui;
    }
    PG8_WAIT_V(0);
    if (wr == 0) PG8_BAR;
    PG8_BAR;
    if constexpr (Epi::AFTER_DRAIN) { E.fused(acc, cur, wr, wc, fr, fq, lds, wid, lane); S.done(cur); }
#undef PG8_SA
#undef PG8_SB
#undef PG8_STAGE
#undef PG8_LDA
#undef PG8_LDB
#undef PG8_MMA
#undef PG8_WAIT_V
#undef PG8_WAIT_L
#undef PG8_BAR
#undef PG8_SCHED
}
}

struct EpiProj {
  static constexpr bool PERM = true, AFTER_DRAIN = false;
  bf16_t* PROJ; bf16_t* VTA; bf16_t* VTR;
  __device__ __forceinline__ void operator()(const f32x4 (&acc)[2][2][4][2], const pg8::Unit& u, int wr, int wc, int fr, int fq) const {
    const int row0 = u.pm * 256 + wr * 64 + fr, col0 = u.pn * 256 + wc * 32 + 8 * fq;
#pragma unroll
    for (int ai = 0; ai < 2; ++ai)
#pragma unroll
      for (int m = 0; m < 4; ++m) {
        const int t = row0 + ai * 128 + m * 16;
#pragma unroll
        for (int bj = 0; bj < 2; ++bj) {
          const int c = col0 + bj * 128;
          const f32x4 v0 = acc[ai][bj][m][0], v1 = acc[ai][bj][m][1];
          pg8::u32x4 w; w.x = pg8::cvt_pk_bf16(v0[0], v0[1]); w.y = pg8::cvt_pk_bf16(v0[2], v0[3]); w.z = pg8::cvt_pk_bf16(v1[0], v1[1]); w.w = pg8::cvt_pk_bf16(v1[2], v1[3]);
          *(pg8::u32x4*)(PROJ + (size_t)t * INCP + c) = w;
          const bool isva = (c >= C_VA && c < C_VA + 384), isvr = (c >= C_VR && c < C_VR + 384);
          if (isva || isvr) {
            bf16_t* vt = (isva ? VTA : VTR) + ((size_t)(t >> 13) * 384 + (c - (isva ? C_VA : C_VR))) * 8192 + (t & 8191);
            vt[0] = (bf16_t)(w.x & 0xffffu); vt[8192] = (bf16_t)(w.x >> 16); vt[2 * 8192] = (bf16_t)(w.y & 0xffffu); vt[3 * 8192] = (bf16_t)(w.y >> 16);
            vt[4 * 8192] = (bf16_t)(w.z & 0xffffu); vt[5 * 8192] = (bf16_t)(w.z >> 16); vt[6 * 8192] = (bf16_t)(w.w & 0xffffu); vt[7 * 8192] = (bf16_t)(w.w >> 16);
          }
        }
      }
  }
};
struct EpiOut {
  static constexpr bool PERM = false, AFTER_DRAIN = false;
  const float* xsrc; float* X; const float* g1;
  __device__ __forceinline__ void operator()(const f32x4 (&acc)[2][2][4][2], const pg8::Unit& u, int wr, int wc, int fr, int fq) const {
    const int row0 = u.pm * 256 + wr * 64 + fr, col0 = u.pn * 256 + wc * 32 + 4 * fq;
#pragma unroll
    for (int ai = 0; ai < 2; ++ai)
#pragma unroll
      for (int m = 0; m < 4; ++m) {
        const int t = row0 + ai * 128 + m * 16, b = t >> 13;
#pragma unroll
        for (int bj = 0; bj < 2; ++bj)
#pragma unroll
          for (int n = 0; n < 2; ++n) {
            const int c = col0 + bj * 128 + n * 16;
            const f32x4 xv = *(const f32x4*)(xsrc + (size_t)t * 1024 + c), g = *(const f32x4*)(g1 + b * 6144 + c);
            *(f32x4*)(X + (size_t)t * 1024 + c) = xv + g * acc[ai][bj][m][n];
          }
      }
  }
};
struct EpiQ {
  static constexpr bool PERM = true, AFTER_DRAIN = false;
  bf16_t* Q;
  __device__ __forceinline__ void operator()(const f32x4 (&acc)[2][2][4][2], const pg8::Unit& u, int wr, int wc, int fr, int fq) const {
    const int row0 = u.pm * 256 + wr * 64 + fr, col0 = u.pn * 256 + wc * 32 + 8 * fq;
#pragma unroll
    for (int ai = 0; ai < 2; ++ai)
#pragma unroll
      for (int m = 0; m < 4; ++m) {
        const int t = row0 + ai * 128 + m * 16;
#pragma unroll
        for (int bj = 0; bj < 2; ++bj) {
          const f32x4 v0 = acc[ai][bj][m][0], v1 = acc[ai][bj][m][1];
          pg8::u32x4 w; w.x = pg8::cvt_pk_bf16(v0[0], v0[1]); w.y = pg8::cvt_pk_bf16(v0[2], v0[3]); w.z = pg8::cvt_pk_bf16(v1[0], v1[1]); w.w = pg8::cvt_pk_bf16(v1[2], v1[3]);
          *(pg8::u32x4*)(Q + (size_t)t * 2048 + col0 + bj * 128) = w;
        }
      }
  }
};

__device__ void gemm_proj_phase(const Params& p, int l, unsigned char* smem) {
  const CParamsP pp = launder_kargs();
  unsigned char* const ws = launder_ptr(pp->ws);
  pg8::Gemm g; g.A = (const bf16_t*)(ws + WS_ABUF); g.Bt = (const bf16_t*)(ws + WS_WIN) + (size_t)l * INCP * 1024; g.M = T_; g.N = INCP; g.K = 1024;
  pg8::StaticOrder S; S.init(T_, INCP, gridDim.x, blockIdx.x);
  EpiProj E; E.PROJ = (bf16_t*)(ws + WS_PROJ); E.VTA = (bf16_t*)(ws + WS_VTA); E.VTR = (bf16_t*)(ws + WS_VTR);
  pg8::gemm_phase<EpiProj, pg8::StaticOrder>((PG8_LAS unsigned char*)smem, g, S, E);
}
__device__ void gemm_out_phase(const Params& p, int l, const float* __restrict__ xsrc, unsigned char* smem) {
  const CParamsP pp = launder_kargs();
  unsigned char* const ws = launder_ptr(pp->ws);
  pg8::Gemm g; g.A = (const bf16_t*)(ws + WS_ABUF); g.Bt = (const bf16_t*)(ws + WS_WOUT) + (size_t)l * 1024 * 1024; g.M = T_; g.N = 1024; g.K = 1024;
  pg8::StaticOrder S; S.init(T_, 1024, gridDim.x, blockIdx.x);
  EpiOut E; E.xsrc = xsrc; E.X = (float*)(ws + WS_X); E.g1 = (const float*)(ws + WS_MOD) + (size_t)l * 2 * 6144 + 2048;
  pg8::gemm_phase<EpiOut, pg8::StaticOrder>((PG8_LAS unsigned char*)smem, g, S, E);
}
__device__ void gemm_q_phase(const Params& p, int l, unsigned char* smem) {
  const CParamsP pp = launder_kargs();
  unsigned char* const ws = launder_ptr(pp->ws);
  pg8::Gemm g; g.A = (const bf16_t*)(ws + WS_ABUF); g.Bt = (const bf16_t*)(ws + WS_WQ) + (size_t)l * 2048 * 1024; g.M = T_; g.N = 2048; g.K = 1024;
  pg8::StaticOrder S; S.init(T_, 2048, gridDim.x, blockIdx.x);
  EpiQ E; E.Q = (bf16_t*)(ws + WS_Q);
  pg8::gemm_phase<EpiQ, pg8::StaticOrder>((PG8_LAS unsigned char*)smem, g, S, E);
}

__device__ void attn_phase(const Params& p, int l) {
  const CParamsP pp = launder_kargs();
  unsigned char* const ws = launder_ptr(pp->ws); const int tidx = launder_tid(); (void)ws; (void)tidx;
  const bf16_t* PROJ = (const bf16_t*)(ws + WS_PROJ); const bf16_t* VTA = (const bf16_t*)(ws + WS_VTA);
  float* ATT = (float*)(ws + WS_ATT);
  const int lane = tidx & 63, fr = lane & 15, fq = lane >> 4;
  const int gw = blockIdx.x * NW + (tidx >> 6), nw = gridDim.x * NW;
  for (int task = gw; task < 256 * 24; task += nw) {
    const int item = task / 24, rb = task % 24, h = rb >> 2, qb = rb & 3;
    const int b = item >> 7, n = item & 127, t0 = b * 8192 + n * 64;
    const float* rbias = pp->in[I_RELB] + ((size_t)l * 6 + h) * 513;
    const int iq = qb * 16 + fr;
    bf16x8 qf[2];
#pragma unroll
    for (int ds = 0; ds < 2; ++ds) qf[ds] = *(const bf16x8*)(PROJ + (size_t)(t0 + iq) * INCP + C_QA + h * 64 + ds * 32 + fq * 8);
    f32x4 o[4];
#pragma unroll
    for (int et = 0; et < 4; ++et) o[et] = (f32x4){0.f, 0.f, 0.f, 0.f};
    float mrun = -1e30f, lrun = 0.f;
    for (int jc = 0; jc < 9; ++jc) {
      const int m = n - 8 + jc;
      if (m < 0) continue;
      const int tk = b * 8192 + m * 64;
      float s[2][2][4];
#pragma unroll
      for (int g = 0; g < 2; ++g)
#pragma unroll
        for (int tt = 0; tt < 2; ++tt) {
          const int key = tk + 32 * g + 8 * (fr >> 2) + (fr & 3) + 4 * tt;
          const bf16_t* kp = PROJ + (size_t)key * INCP + C_KA + h * 64 + fq * 8;
          const bf16x8 k0 = *(const bf16x8*)kp, k1 = *(const bf16x8*)(kp + 32);
          f32x4 st = (f32x4){0.f, 0.f, 0.f, 0.f};
          st = __builtin_amdgcn_mfma_f32_16x16x32_bf16(k0, qf[0], st, 0, 0, 0);
          st = __builtin_amdgcn_mfma_f32_16x16x32_bf16(k1, qf[1], st, 0, 0, 0);
#pragma unroll
          for (int j = 0; j < 4; ++j) {
            const int kk = 32 * g + 8 * fq + 4 * tt + j;
            int diff = 512 + iq - (64 * jc + kk);
            diff = diff > 256 ? 256 : diff;
            s[g][tt][j] = st[j] * 0.125f + rbias[diff + 256];
          }
        }
      float mloc = -1e30f;
#pragma unroll
      for (int g = 0; g < 2; ++g)
#pragma unroll
        for (int tt = 0; tt < 2; ++tt)
#pragma unroll
          for (int j = 0; j < 4; ++j) mloc = fmaxf(mloc, s[g][tt][j]);
      mloc = fmaxf(mloc, __shfl_xor(mloc, 16)); mloc = fmaxf(mloc, __shfl_xor(mloc, 32));
      const float mnew = fmaxf(mrun, mloc), alpha = __expf(mrun - mnew);
      mrun = mnew;
      float ls = 0.f;
#pragma unroll
      for (int g = 0; g < 2; ++g)
#pragma unroll
        for (int tt = 0; tt < 2; ++tt)
#pragma unroll
          for (int j = 0; j < 4; ++j) { const float e = __expf(s[g][tt][j] - mnew); s[g][tt][j] = e; ls += e; }
      lrun = lrun * alpha + ls;
#pragma unroll
      for (int et = 0; et < 4; ++et) { o[et].x *= alpha; o[et].y *= alpha; o[et].z *= alpha; o[et].w *= alpha; }
#pragma unroll
      for (int g = 0; g < 2; ++g) {
        union { bf16x8 v; unsigned u[4]; } pf;
        pf.u[0] = pk2(s[g][0][0], s[g][0][1]); pf.u[1] = pk2(s[g][0][2], s[g][0][3]);
        pf.u[2] = pk2(s[g][1][0], s[g][1][1]); pf.u[3] = pk2(s[g][1][2], s[g][1][3]);
#pragma unroll
        for (int et = 0; et < 4; ++et) {
          const bf16x8 vf = *(const bf16x8*)(VTA + ((size_t)b * 384 + h * 64 + et * 16 + fr) * 8192 + m * 64 + 32 * g + 8 * fq);
          o[et] = __builtin_amdgcn_mfma_f32_16x16x32_bf16(vf, pf.v, o[et], 0, 0, 0);
        }
      }
    }
    lrun += __shfl_xor(lrun, 16); lrun += __shfl_xor(lrun, 32);
    const float inv = 1.f / lrun;
#pragma unroll
    for (int et = 0; et < 4; ++et) {
      f32x4 v = o[et]; v.x *= inv; v.y *= inv; v.z *= inv; v.w *= inv;
      *(f32x4*)(ATT + (size_t)(t0 + iq) * 384 + h * 64 + et * 16 + fq * 4) = v;
    }
  }
}

__device__ __forceinline__ void rotary_frag(const bf16x8 x0, const bf16x8 x1, const float* __restrict__ RC, const float* __restrict__ RS, int pos, int fq, float scale, bf16x8& o0, bf16x8& o1) {
  const f32x4 c0 = *(const f32x4*)(RC + pos * 32 + 8 * fq), c1 = *(const f32x4*)(RC + pos * 32 + 8 * fq + 4);
  const f32x4 s0 = *(const f32x4*)(RS + pos * 32 + 8 * fq), s1 = *(const f32x4*)(RS + pos * 32 + 8 * fq + 4);
  const float cc[8] = {c0.x, c0.y, c0.z, c0.w, c1.x, c1.y, c1.z, c1.w}, sn[8] = {s0.x, s0.y, s0.z, s0.w, s1.x, s1.y, s1.z, s1.w};
  union { bf16x8 v; unsigned u[4]; } r0, r1;
#pragma unroll
  for (int q = 0; q < 4; ++q) {
    const float a0 = bf2f((bf16_t)x0[2 * q]) * scale, a1 = bf2f((bf16_t)x0[2 * q + 1]) * scale, b0 = bf2f((bf16_t)x1[2 * q]) * scale, b1 = bf2f((bf16_t)x1[2 * q + 1]) * scale;
    r0.u[q] = pk2(a0 * cc[2 * q] - b0 * sn[2 * q], a1 * cc[2 * q + 1] - b1 * sn[2 * q + 1]);
    r1.u[q] = pk2(a0 * sn[2 * q] + b0 * cc[2 * q], a1 * sn[2 * q + 1] + b1 * cc[2 * q + 1]);
  }
  o0 = r0.v; o1 = r1.v;
}
__device__ void mix_local_phase(const Params& p, int l, unsigned char* smem) {
  const CParamsP pp = launder_kargs();
  unsigned char* const ws = launder_ptr(pp->ws); const int tidx = launder_tid();
  const bf16_t* PROJ = (const bf16_t*)(ws + WS_PROJ); const bf16_t* VTR = (const bf16_t*)(ws + WS_VTR);
  const float* RC = (const float*)(ws + WS_ROTC); const float* RS = (const float*)(ws + WS_ROTS);
  float* YINT = (float*)(ws + WS_YINT); float* UPDT = (float*)(ws + WS_UPD);
  const float* SA = (const float*)(ws + WS_SA) + (size_t)l * 16 * 64 * 2; const float* SBB = (const float*)(ws + WS_SBB) + (size_t)l * 16 * 64 * 32;
  float* SEND = (float*)(ws + WS_SEND);
  const int tid = tidx, lane = tid & 63, wid = tid >> 6, fr = lane & 15, fq = lane >> 4;
  bf16_t* KT = (bf16_t*)smem;
  float* uw = (float*)(smem + 55296 + wid * 4096);
  for (int item = blockIdx.x; item < 256; item += gridDim.x) {
    const int b = item >> 7, n = item & 127, t0 = b * 8192 + n * 64;
    __syncthreads();
#pragma unroll 1
    for (int k3 = 0; k3 < 3; ++k3) {
      const int task = wid * 3 + k3, h = task >> 2, tb = task & 3;
      const int i = 16 * tb + fr;
      const float lg2 = log2f(1.f - exp2f(-5.f - (float)h));
      bf16x8 qf0, qf1;
      {
        const bf16_t* qp = PROJ + (size_t)(t0 + i) * INCP + C_QR + h * 64 + 8 * fq;
        rotary_frag(*(const bf16x8*)qp, *(const bf16x8*)(qp + 32), RC, RS, n * 64 + i, fq, 1.f, qf0, qf1);
      }
      f32x4 o[4];
#pragma unroll
      for (int et = 0; et < 4; ++et) o[et] = (f32x4){0.f, 0.f, 0.f, 0.f};
#pragma unroll
      for (int g = 0; g < 2; ++g) {
        float st[2][4];
#pragma unroll
        for (int tt = 0; tt < 2; ++tt) {
          const int key = 32 * g + 8 * (fr >> 2) + (fr & 3) + 4 * tt;
          const bf16_t* kp = PROJ + (size_t)(t0 + key) * INCP + C_KR + h * 64 + 8 * fq;
          bf16x8 kf0, kf1;
          rotary_frag(*(const bf16x8*)kp, *(const bf16x8*)(kp + 32), RC, RS, n * 64 + key, fq, 0.125f, kf0, kf1);
          f32x4 s4 = __builtin_amdgcn_mfma_f32_16x16x32_bf16(kf0, qf0, (f32x4){0.f, 0.f, 0.f, 0.f}, 0, 0, 0);
          s4 = __builtin_amdgcn_mfma_f32_16x16x32_bf16(kf1, qf1, s4, 0, 0, 0);
#pragma unroll
          for (int j = 0; j < 4; ++j) {
            const int kk = 32 * g + 8 * fq + 4 * tt + j;
            const int dij = i > kk ? i - kk : kk - i;
            st[tt][j] = s4[j] * exp2f(lg2 * (float)dij);
          }
          if (tb == 0) {
            const float kd = exp2f(lg2 * (float)(63 - key));
#pragma unroll
            for (int jj = 0; jj < 8; ++jj) {
              KT[(h * 64 + 8 * fq + jj) * 72 + key] = f2bf(bf2f((bf16_t)kf0[jj]) * kd);
              KT[(h * 64 + 32 + 8 * fq + jj) * 72 + key] = f2bf(bf2f((bf16_t)kf1[jj]) * kd);
            }
          }
        }
        union { bf16x8 v; unsigned u[4]; } pf;
        pf.u[0] = pk2(st[0][0], st[0][1]); pf.u[1] = pk2(st[0][2], st[0][3]); pf.u[2] = pk2(st[1][0], st[1][1]); pf.u[3] = pk2(st[1][2], st[1][3]);
#pragma unroll
        for (int et = 0; et < 4; ++et) {
          const bf16x8 vf = *(const bf16x8*)(VTR + ((size_t)b * 384 + h * 64 + et * 16 + fr) * 8192 + n * 64 + 32 * g + 8 * fq);
          o[et] = __builtin_amdgcn_mfma_f32_16x16x32_bf16(vf, pf.v, o[et], 0, 0, 0);
        }
      }
#pragma unroll
      for (int et = 0; et < 4; ++et) *(f32x4*)(YINT + (size_t)(t0 + i) * 384 + h * 64 + et * 16 + fq * 4) = o[et];
    }
    __syncthreads();
#pragma unroll 1
    for (int k3 = 0; k3 < 3; ++k3) {
      const int task = wid * 3 + k3, h = task >> 2, et = task & 3;
      f32x4 acc[4];
#pragma unroll
      for (int dt = 0; dt < 4; ++dt) acc[dt] = (f32x4){0.f, 0.f, 0.f, 0.f};
#pragma unroll
      for (int g = 0; g < 2; ++g) {
        const bf16x8 vf = *(const bf16x8*)(VTR + ((size_t)b * 384 + h * 64 + et * 16 + fr) * 8192 + n * 64 + 32 * g + 8 * fq);
#pragma unroll
        for (int dt = 0; dt < 4; ++dt) {
          const bf16x8 kt = *(const bf16x8*)(KT + (h * 64 + 16 * dt + fr) * 72 + 32 * g + 8 * fq);
          acc[dt] = __builtin_amdgcn_mfma_f32_16x16x32_bf16(kt, vf, acc[dt], 0, 0, 0);
        }
      }
#pragma unroll
      for (int dt = 0; dt < 4; ++dt) *(f32x4*)(UPDT + (((size_t)item * 6 + h) * 64 + 16 * et + fr) * 64 + 16 * dt + 4 * fq) = acc[dt];
    }
#pragma unroll 1
    for (int gi = 0; gi < 2; ++gi) {
      const int g = wid * 2 + gi;
#pragma unroll 4
      for (int r = 0; r < 16; ++r) { const int idx = lane + 64 * r, i = idx >> 4, c = idx & 15; uw[idx] = bf2f(PROJ[(size_t)(t0 + i) * INCP + C_US + g * 16 + c]); }
      float bbr[16], bbi[16];
      const float* bbp = SBB + ((size_t)g * 64 + lane) * 32;
#pragma unroll
      for (int c = 0; c < 16; ++c) { bbr[c] = bbp[c]; bbi[c] = bbp[16 + c]; }
      const float are = SA[(g * 64 + lane) * 2], aim = SA[(g * 64 + lane) * 2 + 1];
      float xr = 0.f, xi = 0.f;
#pragma unroll 2
      for (int i = 0; i < 64; ++i) {
        float br = 0.f, bi = 0.f;
#pragma unroll
        for (int c = 0; c < 16; ++c) { const float u = uw[i * 16 + c]; br += bbr[c] * u; bi += bbi[c] * u; }
        const float nr = are * xr - aim * xi + br, ni = are * xi + aim * xr + bi;
        xr = nr; xi = ni;
      }
      SEND[(((size_t)item * 16 + g) * 64 + lane) * 2] = xr; SEND[(((size_t)item * 16 + g) * 64 + lane) * 2 + 1] = xi;
    }
  }
}

__device__ void scan_phase(const Params& p, int l) {
  const CParamsP pp = launder_kargs();
  unsigned char* const ws = launder_ptr(pp->ws); const int tidx = launder_tid();
  const float* __restrict__ UPDT = (const float*)(ws + WS_UPD); bf16_t* __restrict__ SPT = (bf16_t*)(ws + WS_SPT);
  const float* __restrict__ SEND = (const float*)(ws + WS_SEND); float* __restrict__ CARRY = (float*)(ws + WS_CARRY);
  const float* SA = (const float*)(ws + WS_SA) + (size_t)l * 16 * 64 * 2;
  const int gtid = blockIdx.x * NT + tidx, gn = gridDim.x * NT;
  for (int idx = gtid; idx < 2 * 6 * 4096 + 2 * 1024; idx += gn) {
    if (idx < 2 * 6 * 4096) {
      const int b = idx / (6 * 4096), r = idx % (6 * 4096), h = r >> 12;
      const float cd = exp2f(64.f * log2f(1.f - exp2f(-5.f - (float)h)));
      float s = 0.f;
#pragma unroll 1
      for (int nb = 0; nb < NCH; nb += 16) {
        float v[16];
#pragma unroll
        for (int j = 0; j < 16; ++j) v[j] = UPDT[((size_t)(b * NCH + nb + j)) * 6 * 4096 + r];
#pragma unroll
        for (int j = 0; j < 16; ++j) { SPT[((size_t)(b * NCH + nb + j)) * 6 * 4096 + r] = f2bf(s); s = cd * s + v[j]; }
      }
    } else {
      const int r2 = idx - 2 * 6 * 4096, b = r2 >> 10, gp = r2 & 1023;
      float ar = SA[gp * 2], ai = SA[gp * 2 + 1];
#pragma unroll
      for (int q = 0; q < 6; ++q) { const float nr = ar * ar - ai * ai, ni = 2.f * ar * ai; ar = nr; ai = ni; }
      float xr = 0.f, xi = 0.f;
#pragma unroll 1
      for (int nb = 0; nb < NCH; nb += 16) {
        float2 v[16];
#pragma unroll
        for (int j = 0; j < 16; ++j) v[j] = *(const float2*)(SEND + (((size_t)(b * NCH + nb + j)) * 1024 + gp) * 2);
#pragma unroll
        for (int j = 0; j < 16; ++j) {
          *(float2*)(CARRY + (((size_t)(b * NCH + nb + j)) * 1024 + gp) * 2) = make_float2(xr, xi);
          const float nr = ar * xr - ai * xi + v[j].x, ni = ar * xi + ai * xr + v[j].y;
          xr = nr; xi = ni;
        }
      }
    }
  }
}

__device__ void mix_final_phase(const Params& p, int l, unsigned char* smem) {
  const CParamsP pp = launder_kargs();
  unsigned char* const ws = launder_ptr(pp->ws); const int tidx = launder_tid();
  const bf16_t* PROJ = (const bf16_t*)(ws + WS_PROJ);
  const float* RC = (const float*)(ws + WS_ROTC); const float* RS = (const float*)(ws + WS_ROTS);
  const float* YINT = (const float*)(ws + WS_YINT); const bf16_t* SPT = (const bf16_t*)(ws + WS_SPT);
  const float* ATT = (const float*)(ws + WS_ATT);
  const float* SA = (const float*)(ws + WS_SA) + (size_t)l * 16 * 64 * 2; const float* SBB = (const float*)(ws + WS_SBB) + (size_t)l * 16 * 64 * 32;
  const float* CARRY = (const float*)(ws + WS_CARRY);
  const bf16_t* CB = (const bf16_t*)(ws + WS_CB) + (size_t)l * 16 * 16 * 128; const bf16_t* WG = (const bf16_t*)(ws + WS_WGLUT) + (size_t)l * 512 * 256;
  const float* dsk = pp->in[I_SSMD] + (size_t)l * 256;
  const float* mg = pp->in[I_MGAIN] + (size_t)l * 1024;
  bf16_t* MRG = (bf16_t*)(ws + WS_ABUF);
  const int tid = tidx, lane = tid & 63, wid = tid >> 6, fr = lane & 15, fq = lane >> 4;
  bf16_t* YS = (bf16_t*)smem;
  float* red = (float*)(smem + 33792);
  float* uw = (float*)(smem + 36864 + wid * 8448);
  bf16_t* XB = (bf16_t*)(smem + 36864 + wid * 8448 + 4096);
  for (int item = blockIdx.x; item < 256; item += gridDim.x) {
    const int b = item >> 7, n = item & 127, t0 = b * 8192 + n * 64;
    __syncthreads();
    for (int ii = 0; ii < 8; ++ii) {
      const int t = t0 + wid * 8 + ii;
      float v[6]; float sq = 0.f;
#pragma unroll
      for (int j = 0; j < 6; ++j) { v[j] = ATT[(size_t)t * 384 + lane + 64 * j]; sq += v[j] * v[j]; }
      const float rstd = rsqrtf(wave_sum(sq) * (1.f / 384.f) + EPS_);
#pragma unroll
      for (int j = 0; j < 6; ++j) MRG[(size_t)t * 1024 + lane + 64 * j] = f2bf(v[j] * rstd * mg[lane + 64 * j]);
    }
#pragma unroll 1
    for (int k3 = 0; k3 < 3; ++k3) {
      const int task = wid * 3 + k3, h = task >> 2, tb = task & 3;
      const int i = 16 * tb + fr, t = t0 + i;
      const float lg2 = log2f(1.f - exp2f(-5.f - (float)h));
      bf16x8 qf0, qf1;
      {
        const bf16_t* qp = PROJ + (size_t)t * INCP + C_QR + h * 64 + 8 * fq;
        rotary_frag(*(const bf16x8*)qp, *(const bf16x8*)(qp + 32), RC, RS, n * 64 + i, fq, 1.f, qf0, qf1);
      }
      f32x4 o[4];
#pragma unroll
      for (int et = 0; et < 4; ++et) {
        const bf16_t* sp = SPT + (((size_t)item * 6 + h) * 64 + 16 * et + fr) * 64 + 8 * fq;
        const bf16x8 a0 = *(const bf16x8*)sp, a1 = *(const bf16x8*)(sp + 32);
        o[et] = __builtin_amdgcn_mfma_f32_16x16x32_bf16(a0, qf0, (f32x4){0.f, 0.f, 0.f, 0.f}, 0, 0, 0);
        o[et] = __builtin_amdgcn_mfma_f32_16x16x32_bf16(a1, qf1, o[et], 0, 0, 0);
      }
      const float qd = exp2f(lg2 * (float)(i + 1));
      float y[16]; float s1 = 0.f;
#pragma unroll
      for (int et = 0; et < 4; ++et) {
        const f32x4 yi = *(const f32x4*)(YINT + (size_t)t * 384 + h * 64 + 16 * et + 4 * fq);
        y[4 * et] = yi.x + qd * o[et].x; y[4 * et + 1] = yi.y + qd * o[et].y; y[4 * et + 2] = yi.z + qd * o[et].z; y[4 * et + 3] = yi.w + qd * o[et].w;
        s1 += (y[4 * et] + y[4 * et + 1]) + (y[4 * et + 2] + y[4 * et + 3]);
      }
      s1 += __shfl_xor(s1, 16); s1 += __shfl_xor(s1, 32);
      const float mu = s1 * (1.f / 64.f);
      float s2 = 0.f;
#pragma unroll
      for (int q = 0; q < 16; ++q) { y[q] -= mu; s2 += y[q] * y[q]; }
      s2 += __shfl_xor(s2, 16); s2 += __shfl_xor(s2, 32);
      const float rstd = rsqrtf(s2 * (1.f / 64.f) + EPS_);
#pragma unroll
      for (int et = 0; et < 4; ++et) {
        const int c = h * 64 + 16 * et + 4 * fq;
        const uint2 gr = *(const uint2*)(PROJ + (size_t)t * INCP + C_GR + c);
        const float g0 = __uint_as_float(gr.x << 16), g1 = __uint_as_float(gr.x & 0xffff0000u), g2 = __uint_as_float(gr.y << 16), g3 = __uint_as_float(gr.y & 0xffff0000u);
        const f32x4 mgv = *(const f32x4*)(mg + 384 + c);
        uint2 ov;
        ov.x = pk2(y[4 * et] * rstd * (g0 * sigmoid_f(g0)) * mgv.x, y[4 * et + 1] * rstd * (g1 * sigmoid_f(g1)) * mgv.y);
        ov.y = pk2(y[4 * et + 2] * rstd * (g2 * sigmoid_f(g2)) * mgv.z, y[4 * et + 3] * rstd * (g3 * sigmoid_f(g3)) * mgv.w);
        *(uint2*)(MRG + (size_t)t * 1024 + 384 + c) = ov;
      }
    }
#pragma unroll 1
    for (int gi = 0; gi < 2; ++gi) {
      const int g = wid * 2 + gi;
#pragma unroll 4
      for (int r = 0; r < 16; ++r) { const int idx = lane + 64 * r, i = idx >> 4, c = idx & 15; uw[idx] = bf2f(PROJ[(size_t)(t0 + i) * INCP + C_US + g * 16 + c]); }
      float bbr[16], bbi[16];
      const float* bbp = SBB + ((size_t)g * 64 + lane) * 32;
#pragma unroll
      for (int c = 0; c < 16; ++c) { bbr[c] = bbp[c]; bbi[c] = bbp[16 + c]; }
      const float are = SA[(g * 64 + lane) * 2], aim = SA[(g * 64 + lane) * 2 + 1];
      float xr = CARRY[(((size_t)item * 16 + g) * 64 + lane) * 2], xi = CARRY[(((size_t)item * 16 + g) * 64 + lane) * 2 + 1];
      bf16x8 cb[4];
#pragma unroll
      for (int ks = 0; ks < 4; ++ks) cb[ks] = *(const bf16x8*)(CB + ((size_t)g * 16 + fr) * 128 + 32 * ks + 8 * fq);
      const float dv = dsk[g * 16 + fr];
#pragma unroll 1
      for (int tb = 0; tb < 4; ++tb) {
#pragma unroll 2
        for (int ii = 0; ii < 16; ++ii) {
          const int i = tb * 16 + ii;
          float br = 0.f, bi = 0.f;
#pragma unroll
          for (int c = 0; c < 16; ++c) { const float u = uw[i * 16 + c]; br += bbr[c] * u; bi += bbi[c] * u; }
          const float nr = are * xr - aim * xi + br, ni = are * xi + aim * xr + bi;
          xr = nr; xi = ni;
          XB[ii * 136 + lane] = f2bf(xr); XB[ii * 136 + 64 + lane] = f2bf(xi);
        }
        f32x4 acc = (f32x4){0.f, 0.f, 0.f, 0.f};
#pragma unroll
        for (int ks = 0; ks < 4; ++ks) {
          const bf16x8 af = *(const bf16x8*)(XB + fr * 136 + 32 * ks + 8 * fq);
          acc = __builtin_amdgcn_mfma_f32_16x16x32_bf16(af, cb[ks], acc, 0, 0, 0);
        }
#pragma unroll
        for (int j = 0; j < 4; ++j) {
          const int i = tb * 16 + 4 * fq + j;
          const float yv = acc[j] + dv * uw[i * 16 + fr];
          YS[i * 264 + g * 16 + fr] = f2bf(gelu_tanh(yv));
        }
      }
    }
    __syncthreads();
    {
      const int n0 = 32 * wid;
      f32x4 a1[4][2], a2[4][2];
#pragma unroll
      for (int mt = 0; mt < 4; ++mt)
#pragma unroll
        for (int nt = 0; nt < 2; ++nt) { a1[mt][nt] = (f32x4){0.f, 0.f, 0.f, 0.f}; a2[mt][nt] = (f32x4){0.f, 0.f, 0.f, 0.f}; }
#pragma unroll 2
      for (int ks = 0; ks < 8; ++ks) {
        bf16x8 w1[2], w2[2], yb[4];
#pragma unroll
        for (int nt = 0; nt < 2; ++nt) {
          w1[nt] = *(const bf16x8*)(WG + (size_t)(n0 + 16 * nt + fr) * 256 + 32 * ks + 8 * fq);
          w2[nt] = *(const bf16x8*)(WG + (size_t)(256 + n0 + 16 * nt + fr) * 256 + 32 * ks + 8 * fq);
        }
#pragma unroll
        for (int mt = 0; mt < 4; ++mt) yb[mt] = *(const bf16x8*)(YS + (16 * mt + fr) * 264 + 32 * ks + 8 * fq);
#pragma unroll
        for (int mt = 0; mt < 4; ++mt)
#pragma unroll
          for (int nt = 0; nt < 2; ++nt) {
            a1[mt][nt] = __builtin_amdgcn_mfma_f32_16x16x32_bf16(w1[nt], yb[mt], a1[mt][nt], 0, 0, 0);
            a2[mt][nt] = __builtin_amdgcn_mfma_f32_16x16x32_bf16(w2[nt], yb[mt], a2[mt][nt], 0, 0, 0);
          }
      }
#pragma unroll
      for (int mt = 0; mt < 4; ++mt) {
        float sq = 0.f;
#pragma unroll
        for (int nt = 0; nt < 2; ++nt) {
          f32x4 z = a1[mt][nt]; const f32x4 zg = a2[mt][nt];
          z.x *= sigmoid_f(zg.x); z.y *= sigmoid_f(zg.y); z.z *= sigmoid_f(zg.z); z.w *= sigmoid_f(zg.w);
          a1[mt][nt] = z; sq += z.x * z.x + z.y * z.y + z.z * z.z + z.w * z.w;
        }
        sq += __shfl_xor(sq, 16); sq += __shfl_xor(sq, 32);
        if (fq == 0) red[wid * 64 + 16 * mt + fr] = sq;
      }
      __syncthreads();
#pragma unroll
      for (int mt = 0; mt < 4; ++mt) {
        const int i = 16 * mt + fr, t = t0 + i;
        float tot = 0.f;
#pragma unroll
        for (int w8 = 0; w8 < 8; ++w8) tot += red[w8 * 64 + i];
        const float rstd = rsqrtf(tot * (1.f / 256.f) + EPS_);
#pragma unroll
        for (int nt = 0; nt < 2; ++nt) {
          const int c = n0 + 16 * nt + 4 * fq;
          const f32x4 mgv = *(const f32x4*)(mg + 768 + c); const f32x4 z = a1[mt][nt];
          uint2 ov; ov.x = pk2(z.x * rstd * mgv.x, z.y * rstd * mgv.y); ov.y = pk2(z.z * rstd * mgv.z, z.w * rstd * mgv.w);
          *(uint2*)(MRG + (size_t)t * 1024 + 768 + c) = ov;
        }
      }
    }
  }
}

typedef float f32x2 __attribute__((ext_vector_type(2)));
__device__ __forceinline__ float dot16_fp8(const uint4 u, const float (&hv)[16]) {
  f32x2 c; float d;
  c = __builtin_amdgcn_cvt_pk_f32_fp8((int)u.x, false); d = c.x * hv[0] + c.y * hv[1];
  c = __builtin_amdgcn_cvt_pk_f32_fp8((int)u.x, true);  d += c.x * hv[2] + c.y * hv[3];
  c = __builtin_amdgcn_cvt_pk_f32_fp8((int)u.y, false); d += c.x * hv[4] + c.y * hv[5];
  c = __builtin_amdgcn_cvt_pk_f32_fp8((int)u.y, true);  d += c.x * hv[6] + c.y * hv[7];
  c = __builtin_amdgcn_cvt_pk_f32_fp8((int)u.z, false); d += c.x * hv[8] + c.y * hv[9];
  c = __builtin_amdgcn_cvt_pk_f32_fp8((int)u.z, true);  d += c.x * hv[10] + c.y * hv[11];
  c = __builtin_amdgcn_cvt_pk_f32_fp8((int)u.w, false); d += c.x * hv[12] + c.y * hv[13];
  c = __builtin_amdgcn_cvt_pk_f32_fp8((int)u.w, true);  d += c.x * hv[14] + c.y * hv[15];
  return d;
}
__device__ __forceinline__ void axpy16_fp8(const uint4 v, const float w, float (&acc)[16]) {
  f32x2 c;
  c = __builtin_amdgcn_cvt_pk_f32_fp8((int)v.x, false); acc[0] += w * c.x; acc[1] += w * c.y;
  c = __builtin_amdgcn_cvt_pk_f32_fp8((int)v.x, true);  acc[2] += w * c.x; acc[3] += w * c.y;
  c = __builtin_amdgcn_cvt_pk_f32_fp8((int)v.y, false); acc[4] += w * c.x; acc[5] += w * c.y;
  c = __builtin_amdgcn_cvt_pk_f32_fp8((int)v.y, true);  acc[6] += w * c.x; acc[7] += w * c.y;
  c = __builtin_amdgcn_cvt_pk_f32_fp8((int)v.z, false); acc[8] += w * c.x; acc[9] += w * c.y;
  c = __builtin_amdgcn_cvt_pk_f32_fp8((int)v.z, true);  acc[10] += w * c.x; acc[11] += w * c.y;
  c = __builtin_amdgcn_cvt_pk_f32_fp8((int)v.w, false); acc[12] += w * c.x; acc[13] += w * c.y;
  c = __builtin_amdgcn_cvt_pk_f32_fp8((int)v.w, true);  acc[14] += w * c.x; acc[15] += w * c.y;
}
typedef float f32x16 __attribute__((ext_vector_type(16)));
__device__ __forceinline__ float vmaxf(float a, float b) { float r; asm("v_max_f32 %0, %1, %2" : "=v"(r) : "v"(a), "v"(b)); return r; }
__device__ __forceinline__ float vminf(float a, float b) { float r; asm("v_min_f32 %0, %1, %2" : "=v"(r) : "v"(a), "v"(b)); return r; }
__device__ __forceinline__ void cx(float& hi, float& lo) { const float a = hi, b = lo; hi = vmaxf(a, b); lo = vminf(a, b); }
__device__ __forceinline__ void cx2(float& kh, int& ph, float& kl, int& pl) {
  const float a = kh, b = kl; const int pa = ph, pb = pl; const bool c = a >= b;
  kh = vmaxf(a, b); kl = vminf(a, b); ph = c ? pa : pb; pl = c ? pb : pa;
}
__device__ __forceinline__ void bitonic_sort16_desc(float (&v)[16]) {
#pragma unroll
  for (int k = 2; k <= 16; k <<= 1)
#pragma unroll
    for (int j = k >> 1; j > 0; j >>= 1)
#pragma unroll
      for (int i = 0; i < 16; ++i) {
        const int l = i ^ j;
        if (l > i) { if ((i & k) == 0) cx(v[i], v[l]); else cx(v[l], v[i]); }
      }
}
__device__ __forceinline__ void bitonic_merge16_desc(float (&v)[16]) {
#pragma unroll
  for (int j = 8; j > 0; j >>= 1)
#pragma unroll
    for (int i = 0; i < 16; ++i) { const int l = i ^ j; if (l > i) cx(v[i], v[l]); }
}
__device__ __forceinline__ void top16_merge(float (&a)[16], const float (&b)[16]) {
#pragma unroll
  for (int i = 0; i < 16; ++i) a[i] = vmaxf(a[i], b[15 - i]);
  bitonic_merge16_desc(a);
}
template <int M> __device__ __forceinline__ void top16_merge_chain(float (&k)[16], int (&q)[16], const float (&xk)[M], const int (&xq)[M]) {
#pragma unroll
  for (int i = 16 - M; i < 16; ++i) { const float a = k[i], b = xk[15 - i]; const bool c = a >= b; k[i] = vmaxf(a, b); q[i] = c ? q[i] : xq[15 - i]; }
#pragma unroll
  for (int j = 8; j > 0; j >>= 1)
#pragma unroll
    for (int i = 0; i < 16; ++i) { const int l = i ^ j; if (l > i) cx2(k[i], q[i], k[l], q[l]); }
}

__device__ void peer_phase(const Params& p, int l, bool last, unsigned char* smem) {
  const CParamsP pp = launder_kargs();
  unsigned char* const ws = launder_ptr(pp->ws); const int tidx = launder_tid();
  bf16_t* HF = (bf16_t*)(ws + WS_ABUF); float* X = (float*)(ws + WS_X);
  const bf16_t* Q = (const bf16_t*)(ws + WS_Q); const bf16_t* SK = (const bf16_t*)(ws + WS_SUBK) + (size_t)l * 16 * 128 * 128;
  const uint4* U8 = (const uint4*)(ws + WS_PU8) + (size_t)l * 16384 * 64; const uint4* V8 = (const uint4*)(ws + WS_PV8) + (size_t)l * 16384 * 64;
  const float* g2 = (const float*)(ws + WS_MOD) + (size_t)l * 2 * 6144 + 5120;
  const int ln = last ? l : l + 1;
  const float* nsh = (const float*)(ws + WS_MOD) + (size_t)ln * 2 * 6144; const float* nsc = nsh + 1024;
  const float* ngain = pp->in[I_NMIX] + (size_t)ln * 1024;
  const int lane = tidx & 63, wid = tidx >> 6;
  const int rL = ((lane >> 5) & 1) * 4 + ((lane >> 4) & 1) * 2 + ((lane >> 3) & 1);
  const bool hi5 = (lane & 32) != 0, hi4 = (lane & 16) != 0, hi3 = (lane & 8) != 0;
  int* idxL = (int*)smem; float* gateL = (float*)(smem + 64 * 132 * 4);
  for (int item = blockIdx.x; item < T_ / 64; item += gridDim.x) {
    const int t0 = item * 64;
    __syncthreads();
    {
      int lane_o = lane; asm volatile("" : "+v"(lane_o));
      const int tg = wid & 1, hp = wid >> 1, hf = lane_o >> 5, tl = 32 * tg + (lane_o & 31);
      const bf16_t* qrow = Q + (size_t)(t0 + tl) * 2048;
      float F[2][16];
#pragma unroll
      for (int sd = 0; sd < 2; ++sd) {
        float Lh[2][16];
#pragma unroll
        for (int hh = 0; hh < 2; ++hh) {
          const int hs = 2 * (2 * hp + hh) + sd;
          float top[16];
          const bf16_t* skb = SK + ((size_t)hs * 128 + (lane & 31)) * 128 + 8 * hf;
#pragma unroll
          for (int kp = 0; kp < 2; ++kp) {
            f32x16 acc[2];
#pragma unroll
            for (int kt = 0; kt < 2; ++kt)
#pragma unroll
              for (int r = 0; r < 16; ++r) acc[kt][r] = 0.f;
#pragma unroll 2
            for (int ks = 0; ks < 8; ++ks) {
              const bf16x8 bq = *(const bf16x8*)(qrow + hs * 128 + ks * 16 + 8 * hf);
#pragma unroll
              for (int kt = 0; kt < 2; ++kt) {
                const bf16x8 ak = *(const bf16x8*)(skb + (size_t)(kp * 2 + kt) * 32 * 128 + ks * 16);
                acc[kt] = __builtin_amdgcn_mfma_f32_32x32x16_bf16(ak, bq, acc[kt], 0, 0, 0);
              }
            }
#pragma unroll
            for (int kt = 0; kt < 2; ++kt) {
              float g[16];
#pragma unroll
              for (int r = 0; r < 16; ++r) {
                const int key = (kp * 2 + kt) * 32 + (r & 3) + 8 * (r >> 2) + 4 * hf;
                g[r] = __uint_as_float((__float_as_uint(acc[kt][r]) & 0xffffff80u) | (unsigned)key);
              }
              bitonic_sort16_desc(g);
              if (kp == 0 && kt == 0) {
#pragma unroll
                for (int r = 0; r < 16; ++r) top[r] = g[r];
              } else top16_merge(top, g);
              __builtin_amdgcn_sched_barrier(0);
            }
          }
#pragma unroll
          for (int r = 0; r < 16; ++r) Lh[hh][r] = top[r];
          __builtin_amdgcn_sched_barrier(0);
        }
#pragma unroll
        for (int r = 0; r < 16; ++r) {
          const auto sw = __builtin_amdgcn_permlane32_swap(__float_as_uint(Lh[0][r]), __float_as_uint(Lh[1][r]), false, false);
          Lh[0][r] = __uint_as_float(sw[0]); Lh[1][r] = __uint_as_float(sw[1]);
        }
        top16_merge(Lh[0], Lh[1]);
#pragma unroll
        for (int r = 0; r < 16; ++r) F[sd][r] = Lh[0][r];
        __builtin_amdgcn_sched_barrier(0);
      }
      int ia[16], ib[16];
#pragma unroll
      for (int r = 0; r < 16; ++r) { ia[r] = (int)(__float_as_uint(F[0][r]) & 127u) << 7; ib[r] = (int)(__float_as_uint(F[1][r]) & 127u); }
      float k[16]; int q[16];
#pragma unroll
      for (int j = 0; j < 16; ++j) { k[j] = F[0][0] + F[1][j]; q[j] = ia[0] | ib[j]; }
      { float xk[8]; int xq[8];
#pragma unroll
        for (int j = 0; j < 8; ++j) { xk[j] = F[0][1] + F[1][j]; xq[j] = ia[1] | ib[j]; }
        top16_merge_chain<8>(k, q, xk, xq); }
      { float xk[5]; int xq[5];
#pragma unroll
        for (int j = 0; j < 5; ++j) { xk[j] = F[0][2] + F[1][j]; xq[j] = ia[2] | ib[j]; }
        top16_merge_chain<5>(k, q, xk, xq); }
      { float xk[4]; int xq[4];
#pragma unroll
        for (int j = 0; j < 4; ++j) { xk[j] = F[0][3] + F[1][j]; xq[j] = ia[3] | ib[j]; }
        top16_merge_chain<4>(k, q, xk, xq); }
      { float xk[3]; int xq[3];
#pragma unroll
        for (int j = 0; j < 3; ++j) { xk[j] = F[0][4] + F[1][j]; xq[j] = ia[4] | ib[j]; }
        top16_merge_chain<3>(k, q, xk, xq); }
      { float xk[11]; int xq[11];
#pragma unroll
        for (int i = 0; i < 11; ++i) { xk[i] = F[0][5 + i] + F[1][0]; xq[i] = ia[5 + i] | ib[0]; }
        top16_merge_chain<11>(k, q, xk, xq); }
      { float xk[3]; int xq[3];
#pragma unroll
        for (int i = 0; i < 3; ++i) { xk[i] = F[0][5 + i] + F[1][1]; xq[i] = ia[5 + i] | ib[1]; }
        top16_merge_chain<3>(k, q, xk, xq); }
      float e[16]; float es = 0.f;
#pragma unroll
      for (int i = 0; i < 16; ++i) { e[i] = __expf(k[i] - k[0]); es += e[i]; }
      const float ies = 1.f / es;
      const int h = 2 * hp + hf;
#pragma unroll
      for (int i = 0; i < 16; ++i) { idxL[tl * 132 + h * 16 + i] = q[i]; gateL[tl * 132 + h * 16 + i] = e[i] * ies; }
    }
    __syncthreads();
#pragma unroll 1
    for (int ii = 0; ii < 8; ++ii) {
      const int tl = wid * 8 + ii, t = t0 + tl, b = t >> 13;
      float hv[16];
      {
        const uint4 h0 = *(const uint4*)(HF + (size_t)t * 1024 + lane * 16), h1 = *(const uint4*)(HF + (size_t)t * 1024 + lane * 16 + 8);
        const unsigned hw[8] = {h0.x, h0.y, h0.z, h0.w, h1.x, h1.y, h1.z, h1.w};
#pragma unroll
        for (int qq = 0; qq < 8; ++qq) { hv[2 * qq] = __uint_as_float(hw[qq] << 16); hv[2 * qq + 1] = __uint_as_float(hw[qq] & 0xffff0000u); }
      }
      const int e0 = idxL[tl * 132 + lane], e1 = idxL[tl * 132 + 64 + lane];
      const float g0 = gateL[tl * 132 + lane], g1 = gateL[tl * 132 + 64 + lane];
      float acc[16];
#pragma unroll
      for (int j = 0; j < 16; ++j) acc[j] = 0.f;
#pragma unroll 1
      for (int bt = 0; bt < 16; ++bt) {
        const int esrc = (bt < 8) ? e0 : e1; const float gsrc = (bt < 8) ? g0 : g1; const int lb = (bt & 7) * 8;
        uint4 ur[8], vr[8];
        int eidx[8];
#pragma unroll
        for (int r = 0; r < 8; ++r) eidx[r] = __builtin_amdgcn_readlane(esrc, lb + r);
#pragma unroll
        for (int r = 0; r < 8; ++r) ur[r] = U8[(size_t)eidx[r] * 64 + lane];
#pragma unroll
        for (int r = 0; r < 8; ++r) vr[r] = V8[(size_t)eidx[r] * 64 + lane];
        float d[8];
#pragma unroll
        for (int r = 0; r < 8; ++r) { d[r] = dot16_fp8(ur[r], hv); asm volatile("" : "+v"(d[r])); }
        float r4[4], r2[2];
#pragma unroll
        for (int i = 0; i < 4; ++i) { const float keep = hi5 ? d[i + 4] : d[i], send = hi5 ? d[i] : d[i + 4]; r4[i] = keep + __shfl_xor(send, 32); }
#pragma unroll
        for (int i = 0; i < 2; ++i) { const float keep = hi4 ? r4[i + 2] : r4[i], send = hi4 ? r4[i] : r4[i + 2]; r2[i] = keep + __shfl_xor(send, 16); }
        float r1;
        { const float keep = hi3 ? r2[1] : r2[0], send = hi3 ? r2[0] : r2[1]; r1 = keep + __shfl_xor(send, 8); }
        r1 += __shfl_xor(r1, 4); r1 += __shfl_xor(r1, 2); r1 += __shfl_xor(r1, 1);
        const float gl = __shfl(gsrc, lb + rL);
        const float w = gl * gelu_tanh(r1 * (1.f / 1024.f));
#pragma unroll
        for (int r = 0; r < 8; ++r) {
          const int Lk = ((r >> 2) & 1) * 32 + ((r >> 1) & 1) * 16 + (r & 1) * 8;
          const float wr = __int_as_float(__builtin_amdgcn_readlane(__float_as_int(w), Lk));
          axpy16_fp8(vr[r], wr, acc);
          __builtin_amdgcn_sched_barrier(0);
        }
      }
      float xn[16]; float ss = 0.f;
#pragma unroll
      for (int qq = 0; qq < 4; ++qq) {
        const int c = lane * 16 + 4 * qq;
        const f32x4 xv = *(const f32x4*)(X + (size_t)t * 1024 + c), g = *(const f32x4*)(g2 + b * 6144 + c);
        xn[4 * qq] = xv.x + g.x * acc[4 * qq] * (1.f / 64.f); xn[4 * qq + 1] = xv.y + g.y * acc[4 * qq + 1] * (1.f / 64.f);
        xn[4 * qq + 2] = xv.z + g.z * acc[4 * qq + 2] * (1.f / 64.f); xn[4 * qq + 3] = xv.w + g.w * acc[4 * qq + 3] * (1.f / 64.f);
        ss += xn[4 * qq] * xn[4 * qq] + xn[4 * qq + 1] * xn[4 * qq + 1] + xn[4 * qq + 2] * xn[4 * qq + 2] + xn[4 * qq + 3] * xn[4 * qq + 3];
      }
      const float rstd = rsqrtf(wave_sum(ss) * (1.f / 1024.f) + EPS_);
      if (!last) {
        unsigned hb[8];
#pragma unroll
        for (int qq = 0; qq < 4; ++qq) {
          const int c = lane * 16 + 4 * qq;
          *(f32x4*)(X + (size_t)t * 1024 + c) = (f32x4){xn[4 * qq], xn[4 * qq + 1], xn[4 * qq + 2], xn[4 * qq + 3]};
          const f32x4 gn = *(const f32x4*)(ngain + c), sh = *(const f32x4*)(nsh + b * 6144 + c), sc = *(const f32x4*)(nsc + b * 6144 + c);
          hb[2 * qq] = pk2(xn[4 * qq] * rstd * gn.x * (1.f + sc.x) + sh.x, xn[4 * qq + 1] * rstd * gn.y * (1.f + sc.y) + sh.y);
          hb[2 * qq + 1] = pk2(xn[4 * qq + 2] * rstd * gn.z * (1.f + sc.z) + sh.z, xn[4 * qq + 3] * rstd * gn.w * (1.f + sc.w) + sh.w);
        }
        *(uint4*)(HF + (size_t)t * 1024 + lane * 16) = make_uint4(hb[0], hb[1], hb[2], hb[3]);
        *(uint4*)(HF + (size_t)t * 1024 + lane * 16 + 8) = make_uint4(hb[4], hb[5], hb[6], hb[7]);
      } else {
#pragma unroll
        for (int qq = 0; qq < 4; ++qq) {
          const int c = lane * 16 + 4 * qq;
          const f32x4 fn = *(const f32x4*)(pp->in[I_FNORM] + c);
          *(f32x4*)(pp->out + (size_t)t * 1024 + c) = (f32x4){xn[4 * qq] * rstd * fn.x, xn[4 * qq + 1] * rstd * fn.y, xn[4 * qq + 2] * rstd * fn.z, xn[4 * qq + 3] * rstd * fn.w};
        }
      }
    }
  }
}

#define XB_TMO      128
#define XB_XCNT(j)  (256  + 64 * (j))
#define XB_XSUB(j)  (1280 + 64 * (j))
#define XB_XGEN(j)  (2304 + 64 * (j))
#define XB_TOP      3328
#define XB_TOPGEN   3392
#define XCD_BAR_WORDS 3456
#define XB_SPIN_CAP (1u << 20)
#define LAS __attribute__((address_space(3)))
__device__ __forceinline__ unsigned xb_ld(unsigned* q)              { return __hip_atomic_load(q, __ATOMIC_RELAXED, __HIP_MEMORY_SCOPE_AGENT); }
__device__ __forceinline__ unsigned xb_add(unsigned* q, unsigned v) { return __hip_atomic_fetch_add(q, v, __ATOMIC_RELAXED, __HIP_MEMORY_SCOPE_AGENT); }
__device__ __forceinline__ unsigned xb_xcc_id() { return (unsigned)__builtin_amdgcn_s_getreg((3 << 11) | 20) & 0xFu; }
#define XB_SPIN(cond, bar) do { unsigned _sp = 0; while (cond) { __builtin_amdgcn_s_sleep(1); \
    if ((++_sp & 255u) == 0u) { if (xb_ld(&(bar)[XB_TMO])) break; if (_sp > XB_SPIN_CAP) { atomicAdd(&(bar)[XB_TMO], 1u); break; } } } } while (0)
struct XcdBarrier { unsigned* bar; unsigned x; volatile LAS unsigned* st; };
__device__ __forceinline__ XcdBarrier xcd_barrier_post(unsigned* bar, volatile LAS unsigned* st) {
    XcdBarrier b; b.bar = bar; b.x = xb_xcc_id(); b.st = st;
    if (threadIdx.x == 0) (void)xb_add(&bar[XB_XCNT(b.x)], 1u);
    return b;
}
__device__ __forceinline__ void xcd_barrier_complete(unsigned* bar, unsigned x, unsigned& nloc, unsigned& nx) {
    const unsigned G = gridDim.x * gridDim.y * gridDim.z;
    unsigned sum, cnt, mine, sp = 0u;
    for (;;) {
        sum = 0u; cnt = 0u; mine = 0u;
#pragma unroll
        for (unsigned j = 0; j < 16; ++j) { const unsigned c = xb_ld(&bar[XB_XCNT(j)]); sum += c; cnt += (c > 0u) ? 1u : 0u; mine = (j == x) ? c : mine; }
        if (sum == G) break;
        __builtin_amdgcn_s_sleep(1);
        if ((++sp & 255u) == 0u) { if (xb_ld(&bar[XB_TMO])) break; if (sp > XB_SPIN_CAP) { atomicAdd(&bar[XB_TMO], 1u); break; } }
    }
    nloc = mine > 0u ? mine : 1u; nx = cnt > 0u ? cnt : 1u;
}
__device__ __forceinline__ void xcd_barrier(const XcdBarrier& b) {
    asm volatile("s_waitcnt vmcnt(0)" ::: "memory");
    __syncthreads();
    if (threadIdx.x == 0) {
        unsigned* bar = b.bar;
        __builtin_amdgcn_s_waitcnt(0);
        unsigned nloc = b.st[0], nx = b.st[1];
        if (nloc == 0u) { xcd_barrier_complete(bar, b.x, nloc, nx); b.st[0] = nloc; b.st[1] = nx; }
        const unsigned old = xb_add(&bar[XB_XSUB(b.x)], 1u);
        const unsigned gen = old / nloc;
        if (old + 1u == (gen + 1u) * nloc) {
            __builtin_amdgcn_fence(__ATOMIC_RELEASE, "agent");
            asm volatile("s_waitcnt vmcnt(0)" ::: "memory");
            const unsigned og = xb_add(&bar[XB_TOP], 1u);
            const unsigned tg = og / nx;
            if (og + 1u == (tg + 1u) * nx) xb_add(&bar[XB_TOPGEN], 1u);
            else XB_SPIN(xb_ld(&bar[XB_TOPGEN]) == tg, bar);
            __builtin_amdgcn_fence(__ATOMIC_ACQUIRE, "agent");
            xb_add(&bar[XB_XGEN(b.x)], 1u);
            asm volatile("s_waitcnt vmcnt(0)" ::: "memory");
        } else {
            XB_SPIN(xb_ld(&bar[XB_XGEN(b.x)]) == gen, bar);
            __builtin_amdgcn_fence(__ATOMIC_ACQUIRE, "agent");
            asm volatile("s_waitcnt vmcnt(0)" ::: "memory");
        }
    }
    __syncthreads();
}

__global__ void __launch_bounds__(NT) fwd_megakernel(Params p) {
  extern __shared__ __attribute__((aligned(16))) unsigned char smem[];
  const CParamsP pp = launder_kargs();
  cg::grid_group grid = cg::this_grid();
  volatile LAS unsigned* xbst = (volatile LAS unsigned*)(smem + LDS_BYTES - 16);
  if (threadIdx.x == 0) { xbst[0] = 0u; xbst[1] = 0u; }
  if (blockIdx.x == 0) { unsigned* bw = (unsigned*)(pp->ws + WS_BAR); for (int i = threadIdx.x; i < XCD_BAR_WORDS; i += NT) bw[i] = 0u; }
  setup_phase(p, smem);
  grid.sync();
  const XcdBarrier xb = xcd_barrier_post((unsigned*)(pp->ws + WS_BAR), xbst);
  const float* MOD = (const float*)(pp->ws + WS_MOD);
  for (int l = 0; l < DEPTH_; ++l) {
    const float* xsrc = (l == 0) ? pp->in[I_X] : (const float*)(pp->ws + WS_X);
    const float* modl = MOD + (size_t)l * 2 * 6144;
    if (l == 0) {
      norm_mod_phase(xsrc, pp->in[I_NMIX], modl + 0, modl + 1024, (bf16_t*)(pp->ws + WS_ABUF));
      xcd_barrier(xb);
    }
    gemm_proj_phase(p, l, smem);
    xcd_barrier(xb);
    attn_phase(p, l);
    mix_local_phase(p, l, smem);
    xcd_barrier(xb);
    scan_phase(p, l);
    xcd_barrier(xb);
    mix_final_phase(p, l, smem);
    xcd_barrier(xb);
    gemm_out_phase(p, l, xsrc, smem);
    xcd_barrier(xb);
    norm_mod_phase((const float*)(pp->ws + WS_X), pp->in[I_NFFN] + (size_t)l * 1024, modl + 3072, modl + 4096, (bf16_t*)(pp->ws + WS_ABUF));
    xcd_barrier(xb);
    gemm_q_phase(p, l, smem);
    xcd_barrier(xb);
    peer_phase(p, l, l == DEPTH_ - 1, smem);
    xcd_barrier(xb);
  }
}

extern "C" void kernel_launch(void* const* d_in, const int* in_sizes, int n_in,
                              void* d_out, int out_size, void* d_ws, size_t ws_size,
                              hipStream_t stream) {
  static int grid_blocks = 0;
  if (grid_blocks == 0) {
    if (n_in != 24 || ws_size < WS_END) { fprintf(stderr, "kernel_launch: unexpected n_in %d / ws_size %zu (need %zu)\n", n_in, ws_size, (size_t)WS_END); grid_blocks = -1; return; }
    int dev = 0, cus = 0, per_cu = 0;
    if (hipGetDevice(&dev) != hipSuccess || hipDeviceGetAttribute(&cus, hipDeviceAttributeMultiprocessorCount, dev) != hipSuccess) { grid_blocks = -1; return; }
    if (hipFuncSetAttribute((const void*)fwd_megakernel, hipFuncAttributeMaxDynamicSharedMemorySize, LDS_BYTES) != hipSuccess) { fprintf(stderr, "hipFuncSetAttribute failed\n"); grid_blocks = -1; return; }
    if (hipOccupancyMaxActiveBlocksPerMultiprocessor(&per_cu, (const void*)fwd_megakernel, NT, LDS_BYTES) != hipSuccess || per_cu < 1) { fprintf(stderr, "occupancy query: %d\n", per_cu); grid_blocks = -1; return; }
    grid_blocks = cus;
  }
  if (grid_blocks < 0) return;
  Params p{};
  for (int i = 0; i < 24; ++i) p.in[i] = (const float*)d_in[i];
  p.out = (float*)d_out; p.ws = (unsigned char*)d_ws;
  void* args[] = {&p};
  hipError_t e = hipLaunchCooperativeKernel((void*)fwd_megakernel, dim3(grid_blocks), dim3(NT), args, LDS_BYTES, stream);
  if (e != hipSuccess) fprintf(stderr, "cooperative launch failed: %s (grid %d)\n", hipGetErrorString(e), grid_blocks);
}
```

```cpp
#include <hip/hip_runtime.h>
#include <hip/hip_cooperative_groups.h>
#include <cstdio>
#include <cstdint>
namespace cg = cooperative_groups;

typedef unsigned short bf16_t;
typedef short bf16x8 __attribute__((ext_vector_type(8)));
typedef float f32x4 __attribute__((ext_vector_type(4)));

constexpr int T_ = 16384, D_ = 1024, L_ = 8192, NBATCH = 2, DEPTH_ = 4;
constexpr int INC = 2944, INCP = 3072;
constexpr int NCH = 128;
constexpr int NT = 512;
constexpr int NW = 8;
constexpr float EPS_ = 1e-6f;
constexpr int C_QA = 0, C_KA = 384, C_VA = 768, C_QR = 1152, C_KR = 1536, C_VR = 1920, C_GR = 2304, C_US = 2688;

constexpr size_t al256(size_t x) { return (x + 255) & ~(size_t)255; }
constexpr size_t WS_MOD   = 0;
constexpr size_t WS_ROTC  = al256(WS_MOD + 4ull * 2 * 6144 * 4);
constexpr size_t WS_ROTS  = al256(WS_ROTC + 8192ull * 32 * 4);
constexpr size_t WS_SA    = al256(WS_ROTS + 8192ull * 32 * 4);
constexpr size_t WS_SBB   = al256(WS_SA + 4ull * 16 * 64 * 2 * 4);
constexpr size_t WS_WIN   = al256(WS_SBB + 4ull * 16 * 64 * 32 * 4);
constexpr size_t WS_WOUT  = al256(WS_WIN + 4ull * INCP * 1024 * 2);
constexpr size_t WS_WQ    = al256(WS_WOUT + 4ull * 1024 * 1024 * 2);
constexpr size_t WS_SUBK  = al256(WS_WQ + 4ull * 2048 * 1024 * 2);
constexpr size_t WS_ABUF  = al256(WS_SUBK + 4ull * 16 * 128 * 128 * 2);
constexpr size_t WS_PROJ  = al256(WS_ABUF + (size_t)T_ * 1024 * 2);
constexpr size_t WS_VTA   = al256(WS_PROJ + (size_t)T_ * INCP * 2);
constexpr size_t WS_ATT   = al256(WS_VTA + 2ull * 6 * 64 * 8192 * 2);
constexpr size_t WS_YINT  = al256(WS_ATT + (size_t)T_ * 384 * 4);
constexpr size_t WS_UPD   = al256(WS_YINT + (size_t)T_ * 384 * 4);
constexpr size_t WS_SPREV = al256(WS_UPD + 256ull * 6 * 4096 * 4);
constexpr size_t WS_SEND  = al256(WS_SPREV + 256ull * 6 * 4096 * 4);
constexpr size_t WS_CARRY = al256(WS_SEND + 256ull * 16 * 64 * 2 * 4);
constexpr size_t WS_X     = al256(WS_CARRY + 256ull * 16 * 64 * 2 * 4);
constexpr size_t WS_Q     = al256(WS_X + (size_t)T_ * 1024 * 4);
constexpr size_t WS_SC    = al256(WS_Q + (size_t)T_ * 2048 * 2);
constexpr size_t WS_EIDX  = al256(WS_SC + (size_t)T_ * 2048 * 4);
constexpr size_t WS_EGATE = al256(WS_EIDX + (size_t)T_ * 128 * 4);
constexpr size_t WS_PU8   = al256(WS_EGATE + (size_t)T_ * 128 * 4);
constexpr size_t WS_PV8   = al256(WS_PU8 + 4ull * 16384 * 1024);
constexpr size_t WS_BAR   = al256(WS_PV8 + 4ull * 16384 * 1024);
constexpr size_t WS_SPT   = al256(WS_BAR + 3456ull * 4);
constexpr size_t WS_CB    = al256(WS_SPT + 256ull * 6 * 4096 * 2);
constexpr size_t WS_WGLUT = al256(WS_CB + 4ull * 16 * 16 * 128 * 2);
constexpr size_t WS_VTR   = al256(WS_WGLUT + 4ull * 512 * 256 * 2);
constexpr size_t WS_END   = al256(WS_VTR + 2ull * 384 * 8192 * 2);

constexpr int LDS_BYTES = 135168;

struct Params {
  const float* in[24];
  float* out;
  unsigned char* ws;
};
enum { I_X = 0, I_C, I_WADA, I_BADA, I_NMIX, I_NFFN, I_WIN, I_RELB, I_LRE, I_LIM, I_LOGDT, I_BRE, I_BIM, I_CRE, I_CIM, I_SSMD,
       I_WGLU, I_MGAIN, I_WOUT, I_WQ, I_SUBK, I_PU, I_PV, I_FNORM };

__device__ __forceinline__ float bf2f(bf16_t v) { return __uint_as_float(((unsigned)v) << 16); }
__device__ __forceinline__ bf16_t f2bf(float f) { unsigned u = __float_as_uint(f); u += 0x7fffu + ((u >> 16) & 1u); return (bf16_t)(u >> 16); }
__device__ __forceinline__ unsigned pk2(float a, float b) { return (unsigned)f2bf(a) | ((unsigned)f2bf(b) << 16); }
__device__ __forceinline__ float wave_sum(float v) {
#pragma unroll
  for (int o = 32; o > 0; o >>= 1) v += __shfl_xor(v, o);
  return v;
}
__device__ __forceinline__ float wave_max(float v) {
#pragma unroll
  for (int o = 32; o > 0; o >>= 1) v = fmaxf(v, __shfl_xor(v, o));
  return v;
}
__device__ __forceinline__ float gelu_tanh(float x) { const float u = 0.7978845608028654f * (x + 0.044715f * x * x * x); return 0.5f * x * (1.f + tanhf(u)); }
__device__ __forceinline__ float sigmoid_f(float x) { return 1.f / (1.f + __expf(-x)); }
__device__ __forceinline__ unsigned char* launder_ptr(unsigned char* q) { asm volatile("" : "+s"(q)); return q; }
__device__ __forceinline__ const float* launder_cptr(const float* q) { asm volatile("" : "+s"(q)); return q; }
__device__ __forceinline__ int launder_tid() { int t = threadIdx.x; asm volatile("" : "+v"(t)); return t; }
typedef const Params __attribute__((address_space(4)))* CParamsP;
__device__ __forceinline__ CParamsP launder_kargs() { CParamsP q = (CParamsP)__builtin_amdgcn_kernarg_segment_ptr(); asm volatile("" : "+s"(q)); return q; }

__device__ void setup_phase(const Params& p, unsigned char* smem) {
  const CParamsP pp = launder_kargs();
  unsigned char* const ws = launder_ptr(pp->ws); const int tidx = launder_tid(); (void)ws; (void)tidx;
  const int tid = tidx;
  float* sm = (float*)smem;
  {
    float* cond = sm;
    float* red = sm + 2048;
    float* MOD = (float*)(ws + WS_MOD);
    for (int i = tid; i < 2048; i += NT) { const float c = pp->in[I_C][i]; cond[i] = c * sigmoid_f(c); }
    __syncthreads();
    for (int item = blockIdx.x; item < 4 * 96; item += gridDim.x) {
      const int l = item / 96, cb = item % 96, kq = tid >> 6, jj = tid & 63, j = cb * 64 + jj;
      const float* w = pp->in[I_WADA] + (size_t)l * 1024 * 6144 + j;
      float a0 = 0.f, a1 = 0.f;
      for (int k = kq * 128; k < kq * 128 + 128; ++k) { const float wv = w[(size_t)k * 6144]; a0 += cond[k] * wv; a1 += cond[1024 + k] * wv; }
      red[(kq * 2 + 0) * 64 + jj] = a0; red[(kq * 2 + 1) * 64 + jj] = a1;
      __syncthreads();
      if (tid < 128) {
        const int b = tid >> 6, j2 = tid & 63; float s = 0.f;
        for (int q = 0; q < 8; ++q) s += red[(q * 2 + b) * 64 + j2];
        MOD[((size_t)l * 2 + b) * 6144 + cb * 64 + j2] = s + pp->in[I_BADA][(size_t)l * 6144 + cb * 64 + j2];
      }
      __syncthreads();
    }
  }
  const int gtid = blockIdx.x * NT + tid, gn = gridDim.x * NT;
  {
    float* RC = (float*)(ws + WS_ROTC); float* RS = (float*)(ws + WS_ROTS);
    for (int idx = gtid; idx < 8192 * 32; idx += gn) {
      const int pos = idx >> 5, i = idx & 31;
      const float inv = powf(10000.0f, -(float)i / 32.0f);
      const float ang = (float)pos * inv;
      float s, c; sincosf(ang, &s, &c);
      RC[idx] = c; RS[idx] = s;
    }
  }
  {
    float* SA = (float*)(ws + WS_SA); float* SBB = (float*)(ws + WS_SBB);
    for (int idx = gtid; idx < 4 * 16 * 64; idx += gn) {
      const int l = idx / 1024, g = (idx >> 6) & 15;
      const float dt = expf(pp->in[I_LOGDT][l * 16 + g]);
      const float lr = pp->in[I_LRE][idx], li = pp->in[I_LIM][idx];
      const float mag = expf(lr * dt);
      float sn, cs; sincosf(li * dt, &sn, &cs);
      const float are = mag * cs, aim = mag * sn;
      const float den = lr * lr + li * li, nr = are - 1.f, ni = aim;
      const float fre = (nr * lr + ni * li) / den, fim = (ni * lr - nr * li) / den;
      SA[idx * 2] = are; SA[idx * 2 + 1] = aim;
      for (int c = 0; c < 16; ++c) {
        const float br = pp->in[I_BRE][(size_t)idx * 16 + c], bi = pp->in[I_BIM][(size_t)idx * 16 + c];
        SBB[(size_t)idx * 32 + c] = fre * br - fim * bi;
        SBB[(size_t)idx * 32 + 16 + c] = fre * bi + fim * br;
      }
    }
  }
  {
    bf16_t* SK = (bf16_t*)(ws + WS_SUBK);
    for (int idx = gtid; idx < 4 * 16 * 128 * 128; idx += gn) SK[idx] = f2bf(pp->in[I_SUBK][idx]);
  }
  {
    bf16_t* CB = (bf16_t*)(ws + WS_CB);
    for (int idx = gtid; idx < 4 * 16 * 16 * 128; idx += gn) {
      const int k = idx & 127, lgc = idx >> 7;
      CB[idx] = (k < 64) ? f2bf(pp->in[I_CRE][(size_t)lgc * 64 + k]) : f2bf(-pp->in[I_CIM][(size_t)lgc * 64 + (k - 64)]);
    }
    bf16_t* WG = (bf16_t*)(ws + WS_WGLUT);
    for (int idx = gtid; idx < 4 * 512 * 256; idx += gn) {
      const int k = idx & 255, nn = (idx >> 8) & 511, l2 = idx >> 17;
      WG[idx] = f2bf(pp->in[I_WGLU][((size_t)l2 * 256 + k) * 512 + nn]);
    }
  }
  {
    constexpr size_t NIT = 4ull * 16384 * 1024 / 16;
    for (size_t it = gtid; it < 2 * NIT; it += gn) {
      const int tb = it >= NIT ? 1 : 0; const size_t r = it - (size_t)tb * NIT;
      const f32x4* src = (const f32x4*)((tb ? pp->in[I_PV] : pp->in[I_PU]) + r * 16);
      const float sc = tb ? 4.f : 64.f;
      unsigned o[2] = {0u, 0u};
#pragma unroll
      for (int q = 0; q < 4; ++q) {
        const f32x4 a = src[q];
        const float x0 = fminf(fmaxf(a.x * sc, -6.f), 6.f), x1 = fminf(fmaxf(a.y * sc, -6.f), 6.f);
        const float x2 = fminf(fmaxf(a.z * sc, -6.f), 6.f), x3 = fminf(fmaxf(a.w * sc, -6.f), 6.f);
        if (q == 0)      { o[0] = __builtin_amdgcn_cvt_scalef32_pk_fp4_f32(o[0], x0, x1, 1.0f, 0); o[0] = __builtin_amdgcn_cvt_scalef32_pk_fp4_f32(o[0], x2, x3, 1.0f, 1); }
        else if (q == 1) { o[0] = __builtin_amdgcn_cvt_scalef32_pk_fp4_f32(o[0], x0, x1, 1.0f, 2); o[0] = __builtin_amdgcn_cvt_scalef32_pk_fp4_f32(o[0], x2, x3, 1.0f, 3); }
        else if (q == 2) { o[1] = __builtin_amdgcn_cvt_scalef32_pk_fp4_f32(o[1], x0, x1, 1.0f, 0); o[1] = __builtin_amdgcn_cvt_scalef32_pk_fp4_f32(o[1], x2, x3, 1.0f, 1); }
        else             { o[1] = __builtin_amdgcn_cvt_scalef32_pk_fp4_f32(o[1], x0, x1, 1.0f, 2); o[1] = __builtin_amdgcn_cvt_scalef32_pk_fp4_f32(o[1], x2, x3, 1.0f, 3); }
      }
      *(uint2*)(ws + (tb ? WS_PV8 : WS_PU8) + r * 8) = make_uint2(o[0], o[1]);
    }
  }
  {
    float* tile = sm;
    constexpr int IT_IN = 4 * 16 * 48, IT_OUT = 4 * 16 * 16, IT_Q = 4 * 16 * 32;
    __syncthreads();
    for (int item = blockIdx.x; item < IT_IN + IT_OUT + IT_Q; item += gridDim.x) {
      const float* W; bf16_t* WT; int N, NP, r = item;
      if (r < IT_IN) { const int l = r / (16 * 48); r %= 16 * 48; W = pp->in[I_WIN] + (size_t)l * 1024 * INC; WT = (bf16_t*)(ws + WS_WIN) + (size_t)l * INCP * 1024; N = INC; NP = 48; }
      else if (r < IT_IN + IT_OUT) { r -= IT_IN; const int l = r / 256; r %= 256; W = pp->in[I_WOUT] + (size_t)l * 1024 * 1024; WT = (bf16_t*)(ws + WS_WOUT) + (size_t)l * 1024 * 1024; N = 1024; NP = 16; }
      else { r -= IT_IN + IT_OUT; const int l = r / 512; r %= 512; W = pp->in[I_WQ] + (size_t)l * 1024 * 2048; WT = (bf16_t*)(ws + WS_WQ) + (size_t)l * 2048 * 1024; N = 2048; NP = 32; }
      const int kb = r / NP, nb = r % NP, k0 = kb * 64, n0 = nb * 64;
      {
        const int col = tid & 63, rr = tid >> 6;
#pragma unroll
        for (int i = 0; i < 8; ++i) { const int kk = rr + 8 * i; const int n = n0 + col; tile[kk * 65 + col] = (n < N) ? W[(size_t)(k0 + kk) * N + n] : 0.f; }
      }
      __syncthreads();
      {
        const int n = tid >> 3, kc = tid & 7; const float* s = tile + (kc * 8) * 65 + n;
        uint4 o; o.x = pk2(s[0], s[65]); o.y = pk2(s[2 * 65], s[3 * 65]); o.z = pk2(s[4 * 65], s[5 * 65]); o.w = pk2(s[6 * 65], s[7 * 65]);
        *(uint4*)(WT + (size_t)(n0 + n) * 1024 + k0 + kc * 8) = o;
      }
      __syncthreads();
    }
  }
}

__device__ void norm_mod_phase(const float* __restrict__ xsrc, const float* __restrict__ gain, const float* __restrict__ mod_sh, const float* __restrict__ mod_sc,
                               bf16_t* __restrict__ outp) {
  const int tidx = launder_tid();
  const int lane = tidx & 63, gw = blockIdx.x * NW + (tidx >> 6), nw = gridDim.x * NW;
  for (int t = gw; t < T_; t += nw) {
    const int b = t >> 13;
    const f32x4* xr = (const f32x4*)(xsrc + (size_t)t * 1024) + lane;
    f32x4 v[4]; float s = 0.f;
#pragma unroll
    for (int j = 0; j < 4; ++j) { v[j] = xr[64 * j]; s += v[j].x * v[j].x + v[j].y * v[j].y + v[j].z * v[j].z + v[j].w * v[j].w; }
    const float rstd = rsqrtf(wave_sum(s) * (1.f / 1024.f) + EPS_);
#pragma unroll
    for (int j = 0; j < 4; ++j) {
      const int c = lane * 4 + 256 * j;
      const f32x4 g = *(const f32x4*)(gain + c), sh = *(const f32x4*)(mod_sh + b * 6144 + c), sc = *(const f32x4*)(mod_sc + b * 6144 + c);
      const float o0 = v[j].x * rstd * g.x * (1.f + sc.x) + sh.x, o1 = v[j].y * rstd * g.y * (1.f + sc.y) + sh.y;
      const float o2 = v[j].z * rstd * g.z * (1.f + sc.z) + sh.z, o3 = v[j].w * rstd * g.w * (1.f + sc.w) + sh.w;
      uint2 o; o.x = pk2(o0, o1); o.y = pk2(o2, o3);
      *(uint2*)(outp + (size_t)t * 1024 + c) = o;
    }
  }
}


namespace pg8 {
#define PG8_LAS __attribute__((address_space(3)))
typedef unsigned u32x4 __attribute__((ext_vector_type(4)));
constexpr int BM = 256, BK = 64, HALF = 128, HTB = HALF * BK * 2, STAGE_BYTES = 8 * HTB, NXCD = 8, WGM = 8;
__host__ __device__ __forceinline__ int lds_byte(int r, int c) { const int st = (r >> 4) * 2 + (c >> 5), rr = r & 15, cc = c & 31, ob = rr * 64 + cc * 2; return st * 1024 + (ob ^ (((ob >> 9) & 1) << 5)); }
__host__ __device__ __forceinline__ void stage_rc(int b, int& R, int& C) { const int st = b / 1024, sb = b % 1024, swz = sb ^ (((sb >> 9) & 1) << 5); R = (st >> 1) * 16 + swz / 64; C = (st & 1) * 32 + (swz % 64) / 2; }
__host__ __device__ __forceinline__ int perm32(int rho) { const int n = rho >> 4, i = rho & 15; return 8 * (i >> 2) + 4 * n + (i & 3); }
struct Unit { int pm, pn; };
struct Gemm { const bf16_t* A; const bf16_t* Bt; int M, N, K; };
struct StaticOrder {
    int nM, nN, nwg, G, c;
    __host__ __device__ void init(int M, int N, int G_, int c_) { nM = M / BM; nN = N / BM; nwg = nM * nN; G = G_; c = c_; }
    __host__ __device__ bool next(int i, Unit& u) const {
        const long L = (long)i * G + c; if (L >= nwg) return false;
        int wgid = (int)L; { const int q = nwg / NXCD, r = nwg % NXCD, xcd = wgid % NXCD, off = wgid / NXCD; wgid = (xcd < r ? xcd * (q + 1) : r * (q + 1) + (xcd - r) * q) + off; }
        const int nig = WGM * nN, gid = wgid / nig, fm = gid * WGM, gsz = (nM - fm) < WGM ? (nM - fm) : WGM;
        u.pm = fm + ((wgid % nig) % gsz); u.pn = (wgid % nig) / gsz; return true;
    }
    __device__ __forceinline__ void a_ready(const Unit&) const {}
    __device__ __forceinline__ void done(const Unit&) const {}
};
__device__ __forceinline__ unsigned cvt_pk_bf16(float lo, float hi) { unsigned r; asm volatile("v_cvt_pk_bf16_f32 %0, %1, %2" : "=v"(r) : "v"(lo), "v"(hi)); return r; }
template <class Epi, class Sched>
__device__ __forceinline__ void gemm_phase(PG8_LAS unsigned char* lds, const Gemm g, const Sched& S, const Epi& E) {
    const int tid = launder_tid(), wid = __builtin_amdgcn_readfirstlane(tid >> 6), lane = tid & 63, wr = wid >> 2, wc = wid & 3, fr = lane & 15, fq = lane >> 4;
    const int K = g.K, nt = K / BK;
    unsigned voffA[2], voffB[2];
#pragma unroll
    for (int i = 0; i < 2; ++i) { int R, C; stage_rc(tid * 16 + i * 8192, R, C); const int Rb = Epi::PERM ? ((R & ~31) + perm32(R & 31)) : R;
        voffA[i] = (unsigned)(R * K + C) * 2u; voffB[i] = (unsigned)(Rb * K + C) * 2u; }
    const size_t kstep = (size_t)(BK * 2);
    const size_t hstep = (size_t)HALF * K * 2;
    const size_t tstep = 2 * hstep;
    const unsigned ldsw = (unsigned)wid * 1024u;
    const int aoff = lds_byte(wr * 64 + fr, fq * 8), boff = lds_byte(wc * 32 + fr, fq * 8);
#define PG8_SA(b, h) (((b) * 2 + (h)) * HTB)
#define PG8_SB(b, h) ((4 + (b) * 2 + (h)) * HTB)
#define PG8_STAGE(bufoff, gbase, voff) do { _Pragma("unroll") for (int _i = 0; _i < 2; ++_i) \
        __builtin_amdgcn_global_load_lds((const unsigned*)((const char*)(gbase) + (voff)[_i]), (PG8_LAS unsigned*)(lds + (bufoff) + ldsw + _i * 8192), 16, 0, 0); } while (0)
#define PG8_LDA(dst, b, h) do { _Pragma("unroll") for (int m = 0; m < 4; ++m) _Pragma("unroll") for (int k = 0; k < 2; ++k) dst[m][k] = *(const PG8_LAS bf16x8*)(lds + PG8_SA(b, h) + aoff + m * 2048 + k * 1024); } while (0)
#define PG8_LDB(dst, b, h) do { _Pragma("unroll") for (int n = 0; n < 2; ++n) _Pragma("unroll") for (int k = 0; k < 2; ++k) dst[n][k] = *(const PG8_LAS bf16x8*)(lds + PG8_SB(b, h) + boff + n * 2048 + k * 1024); } while (0)
#define PG8_MMA(ai, bj, At, Bt) do { __builtin_amdgcn_s_setprio(1); _Pragma("unroll") for (int m = 0; m < 4; ++m) _Pragma("unroll") for (int n = 0; n < 2; ++n) _Pragma("unroll") for (int k = 0; k < 2; ++k) \
        acc[ai][bj][m][n] = __builtin_amdgcn_mfma_f32_16x16x32_bf16(Bt[n][k], At[m][k], acc[ai][bj][m][n], 0, 0, 0); __builtin_amdgcn_s_setprio(0); } while (0)
#define PG8_WAIT_V(n) asm volatile("s_waitcnt vmcnt(" #n ")" ::: "memory")
#define PG8_WAIT_L(n) asm volatile("s_waitcnt lgkmcnt(" #n ")" ::: "memory")
#define PG8_BAR __builtin_amdgcn_s_barrier()
#define PG8_SCHED __builtin_amdgcn_sched_barrier(0)
    Unit cur, nxt; int ui = 0;
    if (!S.next(0, cur)) return;
    f32x4 acc[2][2][4][2];
#pragma unroll
    for (int a = 0; a < 2; ++a)
#pragma unroll
        for (int b = 0; b < 2; ++b)
#pragma unroll
            for (int m = 0; m < 4; ++m)
#pragma unroll
                for (int n = 0; n < 2; ++n) acc[a][b][m][n] = (f32x4){0.f, 0.f, 0.f, 0.f};
    bf16x8 At[4][2], B0[2][2], B1[2][2];
    const char* cA = (const char*)g.A + (size_t)cur.pm * tstep; const char* cB = (const char*)g.Bt + (size_t)cur.pn * tstep;
    S.a_ready(cur);
    PG8_STAGE(PG8_SB(0, 0), cB, voffB); PG8_STAGE(PG8_SA(0, 0), cA, voffA); PG8_STAGE(PG8_SB(0, 1), cB + hstep, voffB); PG8_STAGE(PG8_SA(0, 1), cA + hstep, voffA);
    if (wr == 1) PG8_BAR;
    PG8_WAIT_V(4); PG8_BAR;
    PG8_STAGE(PG8_SB(1, 0), cB + kstep, voffB); PG8_STAGE(PG8_SA(1, 0), cA + kstep, voffA); PG8_STAGE(PG8_SB(1, 1), cB + hstep + kstep, voffB);
    PG8_WAIT_V(6); PG8_BAR;
    for (;;) {
        const bool has_next = S.next(ui + 1, nxt);
        const char* nA = has_next ? (const char*)g.A + (size_t)nxt.pm * tstep : cA; const char* nB = has_next ? (const char*)g.Bt + (size_t)nxt.pn * tstep : cB;
        for (int t = 0; t < nt; t += 2) {
            const bool last = (t == nt - 2);
            const char* a1 = cA + (size_t)(t + 1) * kstep;
            const char* a2 = last ? nA : cA + (size_t)(t + 2) * kstep; const char* b2 = last ? nB : cB + (size_t)(t + 2) * kstep;
            const char* a3 = a2 + kstep; const char* b3 = b2 + kstep;
            if (last && has_next) S.a_ready(nxt);
            PG8_LDB(B0, 0, 0); PG8_SCHED; PG8_LDA(At, 0, 0); PG8_STAGE(PG8_SA(1, 1), a1 + hstep, voffA);
            PG8_WAIT_L(8); PG8_BAR; PG8_WAIT_L(0); PG8_MMA(0, 0, At, B0); PG8_BAR; PG8_SCHED;
            PG8_LDB(B1, 0, 1); PG8_STAGE(PG8_SB(0, 0), b2, voffB);
            PG8_BAR; PG8_WAIT_L(0); PG8_MMA(0, 1, At, B1); PG8_BAR;
            PG8_LDA(At, 0, 1); PG8_STAGE(PG8_SA(0, 0), a2, voffA);
            PG8_BAR; PG8_WAIT_L(0); PG8_MMA(1, 0, At, B0); PG8_BAR; PG8_SCHED;
            PG8_STAGE(PG8_SB(0, 1), b2 + hstep, voffB);
            PG8_WAIT_V(6); PG8_BAR; PG8_MMA(1, 1, At, B1); PG8_BAR;
            PG8_LDB(B0, 1, 0); PG8_SCHED; PG8_LDA(At, 1, 0); PG8_STAGE(PG8_SA(0, 1), a2 + hstep, voffA);
            PG8_WAIT_L(8); PG8_BAR; PG8_WAIT_L(0); PG8_MMA(0, 0, At, B0); PG8_BAR; PG8_SCHED;
            PG8_LDB(B1, 1, 1); PG8_STAGE(PG8_SB(1, 0), b3, voffB);
            PG8_BAR; PG8_WAIT_L(0); PG8_MMA(0, 1, At, B1); PG8_BAR;
            PG8_LDA(At, 1, 1); PG8_STAGE(PG8_SA(1, 0), a3, voffA);
            PG8_BAR; PG8_WAIT_L(0); PG8_MMA(1, 0, At, B0); PG8_BAR; PG8_SCHED;
            PG8_STAGE(PG8_SB(1, 1), b3 + hstep, voffB);
            PG8_WAIT_V(6); PG8_BAR; PG8_MMA(1, 1, At, B1); PG8_BAR;
        }
        if constexpr (!Epi::AFTER_DRAIN) { E(acc, cur, wr, wc, fr, fq); S.done(cur); }
        if (!has_next) break;
#pragma unroll
        for (int a = 0; a < 2; ++a)
#pragma unroll
            for (int b = 0; b < 2; ++b)
#pragma unroll
                for (int m = 0; m < 4; ++m)
#pragma unroll
                    for (int n = 0; n < 2; ++n) acc[a][b][m][n] = (f32x4){0.f, 0.f, 0.f, 0.f};
        cur = nxt; cA = nA; cB = nB; ++ui;
    }
    PG8_WAIT_V(0);
    if (wr == 0) PG8_BAR;
    PG8_BAR;
    if constexpr (Epi::AFTER_DRAIN) { E.fused(acc, cur, wr, wc, fr, fq, lds, wid, lane); S.done(cur); }
#undef PG8_SA
#undef PG8_SB
#undef PG8_STAGE
#undef PG8_LDA
#undef PG8_LDB
#undef PG8_MMA
#undef PG8_WAIT_V
#undef PG8_WAIT_L
#undef PG8_BAR
#undef PG8_SCHED
}
}

struct EpiProj {
  static constexpr bool PERM = true, AFTER_DRAIN = false;
  bf16_t* PROJ; bf16_t* VTA; bf16_t* VTR;
  __device__ __forceinline__ void operator()(const f32x4 (&acc)[2][2][4][2], const pg8::Unit& u, int wr, int wc, int fr, int fq) const {
    const int row0 = u.pm * 256 + wr * 64 + fr, col0 = u.pn * 256 + wc * 32 + 8 * fq;
#pragma unroll
    for (int ai = 0; ai < 2; ++ai)
#pragma unroll
      for (int m = 0; m < 4; ++m) {
        const int t = row0 + ai * 128 + m * 16;
#pragma unroll
        for (int bj = 0; bj < 2; ++bj) {
          const int c = col0 + bj * 128;
          const f32x4 v0 = acc[ai][bj][m][0], v1 = acc[ai][bj][m][1];
          pg8::u32x4 w; w.x = pg8::cvt_pk_bf16(v0[0], v0[1]); w.y = pg8::cvt_pk_bf16(v0[2], v0[3]); w.z = pg8::cvt_pk_bf16(v1[0], v1[1]); w.w = pg8::cvt_pk_bf16(v1[2], v1[3]);
          *(pg8::u32x4*)(PROJ + (size_t)t * INCP + c) = w;
          const bool isva = (c >= C_VA && c < C_VA + 384), isvr = (c >= C_VR && c < C_VR + 384);
          if (isva || isvr) {
            bf16_t* vt = (isva ? VTA : VTR) + ((size_t)(t >> 13) * 384 + (c - (isva ? C_VA : C_VR))) * 8192 + (t & 8191);
            vt[0] = (bf16_t)(w.x & 0xffffu); vt[8192] = (bf16_t)(w.x >> 16); vt[2 * 8192] = (bf16_t)(w.y & 0xffffu); vt[3 * 8192] = (bf16_t)(w.y >> 16);
            vt[4 * 8192] = (bf16_t)(w.z & 0xffffu); vt[5 * 8192] = (bf16_t)(w.z >> 16); vt[6 * 8192] = (bf16_t)(w.w & 0xffffu); vt[7 * 8192] = (bf16_t)(w.w >> 16);
          }
        }
      }
  }
};
struct EpiOut {
  static constexpr bool PERM = false, AFTER_DRAIN = false;
  const float* xsrc; float* X; const float* g1;
  __device__ __forceinline__ void operator()(const f32x4 (&acc)[2][2][4][2], const pg8::Unit& u, int wr, int wc, int fr, int fq) const {
    const int row0 = u.pm * 256 + wr * 64 + fr, col0 = u.pn * 256 + wc * 32 + 4 * fq;
#pragma unroll
    for (int ai = 0; ai < 2; ++ai)
#pragma unroll
      for (int m = 0; m < 4; ++m) {
        const int t = row0 + ai * 128 + m * 16, b = t >> 13;
#pragma unroll
        for (int bj = 0; bj < 2; ++bj)
#pragma unroll
          for (int n = 0; n < 2; ++n) {
            const int c = col0 + bj * 128 + n * 16;
            const f32x4 xv = *(const f32x4*)(xsrc + (size_t)t * 1024 + c), g = *(const f32x4*)(g1 + b * 6144 + c);
            *(f32x4*)(X + (size_t)t * 1024 + c) = xv + g * acc[ai][bj][m][n];
          }
      }
  }
};
struct EpiQ {
  static constexpr bool PERM = true, AFTER_DRAIN = false;
  bf16_t* Q;
  __device__ __forceinline__ void operator()(const f32x4 (&acc)[2][2][4][2], const pg8::Unit& u, int wr, int wc, int fr, int fq) const {
    const int row0 = u.pm * 256 + wr * 64 + fr, col0 = u.pn * 256 + wc * 32 + 8 * fq;
#pragma unroll
    for (int ai = 0; ai < 2; ++ai)
#pragma unroll
      for (int m = 0; m < 4; ++m) {
        const int t = row0 + ai * 128 + m * 16;
#pragma unroll
        for (int bj = 0; bj < 2; ++bj) {
          const f32x4 v0 = acc[ai][bj][m][0], v1 = acc[ai][bj][m][1];
          pg8::u32x4 w; w.x = pg8::cvt_pk_bf16(v0[0], v0[1]); w.y = pg8::cvt_pk_bf16(v0[2], v0[3]); w.z = pg8::cvt_pk_bf16(v1[0], v1[1]); w.w = pg8::cvt_pk_bf16(v1[2], v1[3]);
          *(pg8::u32x4*)(Q + (size_t)t * 2048 + col0 + bj * 128) = w;
        }
      }
  }
};

__device__ void gemm_proj_phase(const Params& p, int l, unsigned char* smem) {
  const CParamsP pp = launder_kargs();
  unsigned char* const ws = launder_ptr(pp->ws);
  pg8::Gemm g; g.A = (const bf16_t*)(ws + WS_ABUF); g.Bt = (const bf16_t*)(ws + WS_WIN) + (size_t)l * INCP * 1024; g.M = T_; g.N = INCP; g.K = 1024;
  pg8::StaticOrder S; S.init(T_, INCP, gridDim.x, blockIdx.x);
  EpiProj E; E.PROJ = (bf16_t*)(ws + WS_PROJ); E.VTA = (bf16_t*)(ws + WS_VTA); E.VTR = (bf16_t*)(ws + WS_VTR);
  pg8::gemm_phase<EpiProj, pg8::StaticOrder>((PG8_LAS unsigned char*)smem, g, S, E);
}
__device__ void gemm_out_phase(const Params& p, int l, const float* __restrict__ xsrc, unsigned char* smem) {
  const CParamsP pp = launder_kargs();
  unsigned char* const ws = launder_ptr(pp->ws);
  pg8::Gemm g; g.A = (const bf16_t*)(ws + WS_ABUF); g.Bt = (const bf16_t*)(ws + WS_WOUT) + (size_t)l * 1024 * 1024; g.M = T_; g.N = 1024; g.K = 1024;
  pg8::StaticOrder S; S.init(T_, 1024, gridDim.x, blockIdx.x);
  EpiOut E; E.xsrc = xsrc; E.X = (float*)(ws + WS_X); E.g1 = (const float*)(ws + WS_MOD) + (size_t)l * 2 * 6144 + 2048;
  pg8::gemm_phase<EpiOut, pg8::StaticOrder>((PG8_LAS unsigned char*)smem, g, S, E);
}
__device__ void gemm_q_phase(const Params& p, int l, unsigned char* smem) {
  const CParamsP pp = launder_kargs();
  unsigned char* const ws = launder_ptr(pp->ws);
  pg8::Gemm g; g.A = (const bf16_t*)(ws + WS_ABUF); g.Bt = (const bf16_t*)(ws + WS_WQ) + (size_t)l * 2048 * 1024; g.M = T_; g.N = 2048; g.K = 1024;
  pg8::StaticOrder S; S.init(T_, 2048, gridDim.x, blockIdx.x);
  EpiQ E; E.Q = (bf16_t*)(ws + WS_Q);
  pg8::gemm_phase<EpiQ, pg8::StaticOrder>((PG8_LAS unsigned char*)smem, g, S, E);
}

struct AttnFrags { bf16x8 k[2][2][2]; bf16x8 v[2][4]; };
__device__ __forceinline__ void attn_load(AttnFrags& f, const bf16_t* __restrict__ PROJ, const bf16_t* __restrict__ VTA, int tk, int b, int h, int lk, int fr, int fq) {
#pragma unroll
  for (int g = 0; g < 2; ++g) {
#pragma unroll
    for (int tt = 0; tt < 2; ++tt) {
      const int key = tk + 32 * g + 8 * (fr >> 2) + (fr & 3) + 4 * tt;
      const bf16_t* kp = PROJ + (size_t)key * INCP + C_KA + h * 64 + fq * 8;
      f.k[g][tt][0] = *(const bf16x8*)kp; f.k[g][tt][1] = *(const bf16x8*)(kp + 32);
    }
#pragma unroll
    for (int et = 0; et < 4; ++et) f.v[g][et] = *(const bf16x8*)(VTA + ((size_t)b * 384 + h * 64 + et * 16 + fr) * 8192 + lk + 32 * g + 8 * fq);
  }
}
__device__ void attn_phase(const Params& p, int l, unsigned char* smem) {
  const CParamsP pp = launder_kargs();
  unsigned char* const ws = launder_ptr(pp->ws); const int tidx = launder_tid();
  const bf16_t* PROJ = (const bf16_t*)(ws + WS_PROJ); const bf16_t* VTA = (const bf16_t*)(ws + WS_VTA);
  float* ATT = (float*)(ws + WS_ATT);
  const int lane = tidx & 63, wid = tidx >> 6, fr = lane & 15, fq = lane >> 4;
  float* ext = (float*)smem;
  constexpr float LOG2E = 1.4426950408889634f;
  __syncthreads();
  for (int idx = tidx; idx < 6 * 640; idx += NT) {
    const int h = idx / 640, e = idx - h * 640; int d = e - 63; d = d > 256 ? 256 : d;
    ext[idx] = pp->in[I_RELB][((size_t)l * 6 + h) * 513 + d + 256] * LOG2E;
  }
  __syncthreads();
  for (int item = blockIdx.x; item < 256; item += gridDim.x) {
    const int b = item >> 7, n = item & 127, t0 = b * 8192 + n * 64;
    const int jc0 = n >= 8 ? 0 : 8 - n;
#pragma unroll 1
    for (int k3 = 0; k3 < 3; ++k3) {
      const int task = k3 * 8 + wid, h = task >> 2, qb = task & 3;
      const int iq = qb * 16 + fr;
      const float* exth = ext + h * 640 + 63 + 512 + iq - 8 * fq;
      bf16x8 qf[2];
#pragma unroll
      for (int ds = 0; ds < 2; ++ds) qf[ds] = *(const bf16x8*)(PROJ + (size_t)(t0 + iq) * INCP + C_QA + h * 64 + ds * 32 + fq * 8);
      f32x4 o[4];
#pragma unroll
      for (int et = 0; et < 4; ++et) o[et] = (f32x4){0.f, 0.f, 0.f, 0.f};
      float mrun = -1e30f, lrun = 0.f;
      AttnFrags cur, nxt;
      attn_load(cur, PROJ, VTA, b * 8192 + (n - 8 + jc0) * 64, b, h, (n - 8 + jc0) * 64, fr, fq);
#pragma unroll 1
      for (int jc = jc0; jc < 9; ++jc) {
        if (jc < 8) attn_load(nxt, PROJ, VTA, b * 8192 + (n - 7 + jc) * 64, b, h, (n - 7 + jc) * 64, fr, fq);
        float sc[2][2][4];
#pragma unroll
        for (int g = 0; g < 2; ++g)
#pragma unroll
          for (int tt = 0; tt < 2; ++tt) {
            f32x4 st = __builtin_amdgcn_mfma_f32_16x16x32_bf16(cur.k[g][tt][0], qf[0], (f32x4){0.f, 0.f, 0.f, 0.f}, 0, 0, 0);
            st = __builtin_amdgcn_mfma_f32_16x16x32_bf16(cur.k[g][tt][1], qf[1], st, 0, 0, 0);
#pragma unroll
            for (int j = 0; j < 4; ++j) sc[g][tt][j] = st[j] * (0.125f * LOG2E) + exth[-(64 * jc + 32 * g + 4 * tt + j)];
          }
        float mloc = -1e30f;
#pragma unroll
        for (int g = 0; g < 2; ++g)
#pragma unroll
          for (int tt = 0; tt < 2; ++tt)
#pragma unroll
            for (int j = 0; j < 4; ++j) mloc = fmaxf(mloc, sc[g][tt][j]);
        mloc = fmaxf(mloc, __shfl_xor(mloc, 16)); mloc = fmaxf(mloc, __shfl_xor(mloc, 32));
        const float mnew = fmaxf(mrun, mloc), alpha = __builtin_amdgcn_exp2f(mrun - mnew);
        mrun = mnew;
        float ls = 0.f;
#pragma unroll
        for (int g = 0; g < 2; ++g)
#pragma unroll
          for (int tt = 0; tt < 2; ++tt)
#pragma unroll
            for (int j = 0; j < 4; ++j) { const float e = __builtin_amdgcn_exp2f(sc[g][tt][j] - mnew); sc[g][tt][j] = e; ls += e; }
        lrun = lrun * alpha + ls;
#pragma unroll
        for (int et = 0; et < 4; ++et) { o[et].x *= alpha; o[et].y *= alpha; o[et].z *= alpha; o[et].w *= alpha; }
#pragma unroll
        for (int g = 0; g < 2; ++g) {
          union { bf16x8 v; unsigned u[4]; } pf;
          pf.u[0] = pk2(sc[g][0][0], sc[g][0][1]); pf.u[1] = pk2(sc[g][0][2], sc[g][0][3]);
          pf.u[2] = pk2(sc[g][1][0], sc[g][1][1]); pf.u[3] = pk2(sc[g][1][2], sc[g][1][3]);
#pragma unroll
          for (int et = 0; et < 4; ++et) o[et] = __builtin_amdgcn_mfma_f32_16x16x32_bf16(cur.v[g][et], pf.v, o[et], 0, 0, 0);
        }
        cur = nxt;
      }
      lrun += __shfl_xor(lrun, 16); lrun += __shfl_xor(lrun, 32);
      const float inv = 1.f / lrun;
#pragma unroll
      for (int et = 0; et < 4; ++et) {
        f32x4 v = o[et]; v.x *= inv; v.y *= inv; v.z *= inv; v.w *= inv;
        *(f32x4*)(ATT + (size_t)(t0 + iq) * 384 + h * 64 + et * 16 + fq * 4) = v;
      }
    }
  }
  __syncthreads();
}

__device__ __forceinline__ void rotary_frag(const bf16x8 x0, const bf16x8 x1, const float* __restrict__ RC, const float* __restrict__ RS, int pos, int fq, float scale, bf16x8& o0, bf16x8& o1) {
  const f32x4 c0 = *(const f32x4*)(RC + pos * 32 + 8 * fq), c1 = *(const f32x4*)(RC + pos * 32 + 8 * fq + 4);
  const f32x4 s0 = *(const f32x4*)(RS + pos * 32 + 8 * fq), s1 = *(const f32x4*)(RS + pos * 32 + 8 * fq + 4);
  const float cc[8] = {c0.x, c0.y, c0.z, c0.w, c1.x, c1.y, c1.z, c1.w}, sn[8] = {s0.x, s0.y, s0.z, s0.w, s1.x, s1.y, s1.z, s1.w};
  union { bf16x8 v; unsigned u[4]; } r0, r1;
#pragma unroll
  for (int q = 0; q < 4; ++q) {
    const float a0 = bf2f((bf16_t)x0[2 * q]) * scale, a1 = bf2f((bf16_t)x0[2 * q + 1]) * scale, b0 = bf2f((bf16_t)x1[2 * q]) * scale, b1 = bf2f((bf16_t)x1[2 * q + 1]) * scale;
    r0.u[q] = pk2(a0 * cc[2 * q] - b0 * sn[2 * q], a1 * cc[2 * q + 1] - b1 * sn[2 * q + 1]);
    r1.u[q] = pk2(a0 * sn[2 * q] + b0 * cc[2 * q], a1 * sn[2 * q + 1] + b1 * cc[2 * q + 1]);
  }
  o0 = r0.v; o1 = r1.v;
}
__device__ void mix_local_phase(const Params& p, int l, unsigned char* smem) {
  const CParamsP pp = launder_kargs();
  unsigned char* const ws = launder_ptr(pp->ws); const int tidx = launder_tid();
  const bf16_t* PROJ = (const bf16_t*)(ws + WS_PROJ); const bf16_t* VTR = (const bf16_t*)(ws + WS_VTR);
  const float* RC = (const float*)(ws + WS_ROTC); const float* RS = (const float*)(ws + WS_ROTS);
  float* YINT = (float*)(ws + WS_YINT); float* UPDT = (float*)(ws + WS_UPD);
  const float* SA = (const float*)(ws + WS_SA) + (size_t)l * 16 * 64 * 2; const float* SBB = (const float*)(ws + WS_SBB) + (size_t)l * 16 * 64 * 32;
  float* SEND = (float*)(ws + WS_SEND);
  const int tid = tidx, lane = tid & 63, wid = tid >> 6, fr = lane & 15, fq = lane >> 4;
  bf16_t* KT = (bf16_t*)smem;
  float* uw = (float*)(smem + 55296 + wid * 4096);
  for (int item = blockIdx.x; item < 256; item += gridDim.x) {
    const int b = item >> 7, n = item & 127, t0 = b * 8192 + n * 64;
    __syncthreads();
#pragma unroll 1
    for (int k3 = 0; k3 < 3; ++k3) {
      const int task = wid * 3 + k3, h = task >> 2, tb = task & 3;
      const int i = 16 * tb + fr;
      const float lg2 = log2f(1.f - exp2f(-5.f - (float)h));
      bf16x8 qf0, qf1;
      {
        const bf16_t* qp = PROJ + (size_t)(t0 + i) * INCP + C_QR + h * 64 + 8 * fq;
        rotary_frag(*(const bf16x8*)qp, *(const bf16x8*)(qp + 32), RC, RS, n * 64 + i, fq, 1.f, qf0, qf1);
      }
      f32x4 o[4];
#pragma unroll
      for (int et = 0; et < 4; ++et) o[et] = (f32x4){0.f, 0.f, 0.f, 0.f};
#pragma unroll
      for (int g = 0; g < 2; ++g) {
        float st[2][4];
#pragma unroll
        for (int tt = 0; tt < 2; ++tt) {
          const int key = 32 * g + 8 * (fr >> 2) + (fr & 3) + 4 * tt;
          const bf16_t* kp = PROJ + (size_t)(t0 + key) * INCP + C_KR + h * 64 + 8 * fq;
          bf16x8 kf0, kf1;
          rotary_frag(*(const bf16x8*)kp, *(const bf16x8*)(kp + 32), RC, RS, n * 64 + key, fq, 0.125f, kf0, kf1);
          f32x4 s4 = __builtin_amdgcn_mfma_f32_16x16x32_bf16(kf0, qf0, (f32x4){0.f, 0.f, 0.f, 0.f}, 0, 0, 0);
          s4 = __builtin_amdgcn_mfma_f32_16x16x32_bf16(kf1, qf1, s4, 0, 0, 0);
#pragma unroll
          for (int j = 0; j < 4; ++j) {
            const int kk = 32 * g + 8 * fq + 4 * tt + j;
            const int dij = i > kk ? i - kk : kk - i;
            st[tt][j] = s4[j] * exp2f(lg2 * (float)dij);
          }
          if (tb == 0) {
            const float kd = exp2f(lg2 * (float)(63 - key));
#pragma unroll
            for (int jj = 0; jj < 8; ++jj) {
              KT[(h * 64 + 8 * fq + jj) * 72 + key] = f2bf(bf2f((bf16_t)kf0[jj]) * kd);
              KT[(h * 64 + 32 + 8 * fq + jj) * 72 + key] = f2bf(bf2f((bf16_t)kf1[jj]) * kd);
            }
          }
        }
        union { bf16x8 v; unsigned u[4]; } pf;
        pf.u[0] = pk2(st[0][0], st[0][1]); pf.u[1] = pk2(st[0][2], st[0][3]); pf.u[2] = pk2(st[1][0], st[1][1]); pf.u[3] = pk2(st[1][2], st[1][3]);
#pragma unroll
        for (int et = 0; et < 4; ++et) {
          const bf16x8 vf = *(const bf16x8*)(VTR + ((size_t)b * 384 + h * 64 + et * 16 + fr) * 8192 + n * 64 + 32 * g + 8 * fq);
          o[et] = __builtin_amdgcn_mfma_f32_16x16x32_bf16(vf, pf.v, o[et], 0, 0, 0);
        }
      }
#pragma unroll
      for (int et = 0; et < 4; ++et) *(f32x4*)(YINT + (size_t)(t0 + i) * 384 + h * 64 + et * 16 + fq * 4) = o[et];
    }
    __syncthreads();
#pragma unroll 1
    for (int k3 = 0; k3 < 3; ++k3) {
      const int task = wid * 3 + k3, h = task >> 2, et = task & 3;
      f32x4 acc[4];
#pragma unroll
      for (int dt = 0; dt < 4; ++dt) acc[dt] = (f32x4){0.f, 0.f, 0.f, 0.f};
#pragma unroll
      for (int g = 0; g < 2; ++g) {
        const bf16x8 vf = *(const bf16x8*)(VTR + ((size_t)b * 384 + h * 64 + et * 16 + fr) * 8192 + n * 64 + 32 * g + 8 * fq);
#pragma unroll
        for (int dt = 0; dt < 4; ++dt) {
          const bf16x8 kt = *(const bf16x8*)(KT + (h * 64 + 16 * dt + fr) * 72 + 32 * g + 8 * fq);
          acc[dt] = __builtin_amdgcn_mfma_f32_16x16x32_bf16(kt, vf, acc[dt], 0, 0, 0);
        }
      }
#pragma unroll
      for (int dt = 0; dt < 4; ++dt) *(f32x4*)(UPDT + (((size_t)item * 6 + h) * 64 + 16 * et + fr) * 64 + 16 * dt + 4 * fq) = acc[dt];
    }
#pragma unroll 1
    for (int gi = 0; gi < 2; ++gi) {
      const int g = wid * 2 + gi;
#pragma unroll 4
      for (int r = 0; r < 16; ++r) { const int idx = lane + 64 * r, i = idx >> 4, c = idx & 15; uw[idx] = bf2f(PROJ[(size_t)(t0 + i) * INCP + C_US + g * 16 + c]); }
      float bbr[16], bbi[16];
      const float* bbp = SBB + ((size_t)g * 64 + lane) * 32;
#pragma unroll
      for (int c = 0; c < 16; ++c) { bbr[c] = bbp[c]; bbi[c] = bbp[16 + c]; }
      const float are = SA[(g * 64 + lane) * 2], aim = SA[(g * 64 + lane) * 2 + 1];
      float xr = 0.f, xi = 0.f;
#pragma unroll 2
      for (int i = 0; i < 64; ++i) {
        float br = 0.f, bi = 0.f;
#pragma unroll
        for (int c = 0; c < 16; ++c) { const float u = uw[i * 16 + c]; br += bbr[c] * u; bi += bbi[c] * u; }
        const float nr = are * xr - aim * xi + br, ni = are * xi + aim * xr + bi;
        xr = nr; xi = ni;
      }
      SEND[(((size_t)item * 16 + g) * 64 + lane) * 2] = xr; SEND[(((size_t)item * 16 + g) * 64 + lane) * 2 + 1] = xi;
    }
  }
}

__device__ void scan_phase(const Params& p, int l) {
  const CParamsP pp = launder_kargs();
  unsigned char* const ws = launder_ptr(pp->ws); const int tidx = launder_tid();
  const float* __restrict__ UPDT = (const float*)(ws + WS_UPD); bf16_t* __restrict__ SPT = (bf16_t*)(ws + WS_SPT);
  const float* __restrict__ SEND = (const float*)(ws + WS_SEND); float* __restrict__ CARRY = (float*)(ws + WS_CARRY);
  const float* SA = (const float*)(ws + WS_SA) + (size_t)l * 16 * 64 * 2;
  const int gtid = blockIdx.x * NT + tidx, gn = gridDim.x * NT;
  for (int idx = gtid; idx < 2 * 6 * 4096 + 2 * 1024; idx += gn) {
    if (idx < 2 * 6 * 4096) {
      const int b = idx / (6 * 4096), r = idx % (6 * 4096), h = r >> 12;
      const float cd = exp2f(64.f * log2f(1.f - exp2f(-5.f - (float)h)));
      float s = 0.f;
#pragma unroll 1
      for (int nb = 0; nb < NCH; nb += 16) {
        float v[16];
#pragma unroll
        for (int j = 0; j < 16; ++j) v[j] = UPDT[((size_t)(b * NCH + nb + j)) * 6 * 4096 + r];
#pragma unroll
        for (int j = 0; j < 16; ++j) { SPT[((size_t)(b * NCH + nb + j)) * 6 * 4096 + r] = f2bf(s); s = cd * s + v[j]; }
      }
    } else {
      const int r2 = idx - 2 * 6 * 4096, b = r2 >> 10, gp = r2 & 1023;
      float ar = SA[gp * 2], ai = SA[gp * 2 + 1];
#pragma unroll
      for (int q = 0; q < 6; ++q) { const float nr = ar * ar - ai * ai, ni = 2.f * ar * ai; ar = nr; ai = ni; }
      float xr = 0.f, xi = 0.f;
#pragma unroll 1
      for (int nb = 0; nb < NCH; nb += 16) {
        float2 v[16];
#pragma unroll
        for (int j = 0; j < 16; ++j) v[j] = *(const float2*)(SEND + (((size_t)(b * NCH + nb + j)) * 1024 + gp) * 2);
#pragma unroll
        for (int j = 0; j < 16; ++j) {
          *(float2*)(CARRY + (((size_t)(b * NCH + nb + j)) * 1024 + gp) * 2) = make_float2(xr, xi);
          const float nr = ar * xr - ai * xi + v[j].x, ni = ar * xi + ai * xr + v[j].y;
          xr = nr; xi = ni;
        }
      }
    }
  }
}

__device__ void mix_final_phase(const Params& p, int l, unsigned char* smem) {
  const CParamsP pp = launder_kargs();
  unsigned char* const ws = launder_ptr(pp->ws); const int tidx = launder_tid();
  const bf16_t* PROJ = (const bf16_t*)(ws + WS_PROJ);
  const float* RC = (const float*)(ws + WS_ROTC); const float* RS = (const float*)(ws + WS_ROTS);
  const float* YINT = (const float*)(ws + WS_YINT); const bf16_t* SPT = (const bf16_t*)(ws + WS_SPT);
  const float* ATT = (const float*)(ws + WS_ATT);
  const float* SA = (const float*)(ws + WS_SA) + (size_t)l * 16 * 64 * 2; const float* SBB = (const float*)(ws + WS_SBB) + (size_t)l * 16 * 64 * 32;
  const float* CARRY = (const float*)(ws + WS_CARRY);
  const bf16_t* CB = (const bf16_t*)(ws + WS_CB) + (size_t)l * 16 * 16 * 128; const bf16_t* WG = (const bf16_t*)(ws + WS_WGLUT) + (size_t)l * 512 * 256;
  const float* dsk = pp->in[I_SSMD] + (size_t)l * 256;
  const float* mg = pp->in[I_MGAIN] + (size_t)l * 1024;
  bf16_t* MRG = (bf16_t*)(ws + WS_ABUF);
  const int tid = tidx, lane = tid & 63, wid = tid >> 6, fr = lane & 15, fq = lane >> 4;
  bf16_t* YS = (bf16_t*)smem;
  float* red = (float*)(smem + 33792);
  float* uw = (float*)(smem + 36864 + wid * 8448);
  bf16_t* XB = (bf16_t*)(smem + 36864 + wid * 8448 + 4096);
  for (int item = blockIdx.x; item < 256; item += gridDim.x) {
    const int b = item >> 7, n = item & 127, t0 = b * 8192 + n * 64;
    __syncthreads();
    for (int ii = 0; ii < 8; ++ii) {
      const int t = t0 + wid * 8 + ii;
      float v[6]; float sq = 0.f;
#pragma unroll
      for (int j = 0; j < 6; ++j) { v[j] = ATT[(size_t)t * 384 + lane + 64 * j]; sq += v[j] * v[j]; }
      const float rstd = rsqrtf(wave_sum(sq) * (1.f / 384.f) + EPS_);
#pragma unroll
      for (int j = 0; j < 6; ++j) MRG[(size_t)t * 1024 + lane + 64 * j] = f2bf(v[j] * rstd * mg[lane + 64 * j]);
    }
#pragma unroll 1
    for (int k3 = 0; k3 < 3; ++k3) {
      const int task = wid * 3 + k3, h = task >> 2, tb = task & 3;
      const int i = 16 * tb + fr, t = t0 + i;
      const float lg2 = log2f(1.f - exp2f(-5.f - (float)h));
      bf16x8 qf0, qf1;
      {
        const bf16_t* qp = PROJ + (size_t)t * INCP + C_QR + h * 64 + 8 * fq;
        rotary_frag(*(const bf16x8*)qp, *(const bf16x8*)(qp + 32), RC, RS, n * 64 + i, fq, 1.f, qf0, qf1);
      }
      f32x4 o[4];
#pragma unroll
      for (int et = 0; et < 4; ++et) {
        const bf16_t* sp = SPT + (((size_t)item * 6 + h) * 64 + 16 * et + fr) * 64 + 8 * fq;
        const bf16x8 a0 = *(const bf16x8*)sp, a1 = *(const bf16x8*)(sp + 32);
        o[et] = __builtin_amdgcn_mfma_f32_16x16x32_bf16(a0, qf0, (f32x4){0.f, 0.f, 0.f, 0.f}, 0, 0, 0);
        o[et] = __builtin_amdgcn_mfma_f32_16x16x32_bf16(a1, qf1, o[et], 0, 0, 0);
      }
      const float qd = exp2f(lg2 * (float)(i + 1));
      float y[16]; float s1 = 0.f;
#pragma unroll
      for (int et = 0; et < 4; ++et) {
        const f32x4 yi = *(const f32x4*)(YINT + (size_t)t * 384 + h * 64 + 16 * et + 4 * fq);
        y[4 * et] = yi.x + qd * o[et].x; y[4 * et + 1] = yi.y + qd * o[et].y; y[4 * et + 2] = yi.z + qd * o[et].z; y[4 * et + 3] = yi.w + qd * o[et].w;
        s1 += (y[4 * et] + y[4 * et + 1]) + (y[4 * et + 2] + y[4 * et + 3]);
      }
      s1 += __shfl_xor(s1, 16); s1 += __shfl_xor(s1, 32);
      const float mu = s1 * (1.f / 64.f);
      float s2 = 0.f;
#pragma unroll
      for (int q = 0; q < 16; ++q) { y[q] -= mu; s2 += y[q] * y[q]; }
      s2 += __shfl_xor(s2, 16); s2 += __shfl_xor(s2, 32);
      const float rstd = rsqrtf(s2 * (1.f / 64.f) + EPS_);
#pragma unroll
      for (int et = 0; et < 4; ++et) {
        const int c = h * 64 + 16 * et + 4 * fq;
        const uint2 gr = *(const uint2*)(PROJ + (size_t)t * INCP + C_GR + c);
        const float g0 = __uint_as_float(gr.x << 16), g1 = __uint_as_float(gr.x & 0xffff0000u), g2 = __uint_as_float(gr.y << 16), g3 = __uint_as_float(gr.y & 0xffff0000u);
        const f32x4 mgv = *(const f32x4*)(mg + 384 + c);
        uint2 ov;
        ov.x = pk2(y[4 * et] * rstd * (g0 * sigmoid_f(g0)) * mgv.x, y[4 * et + 1] * rstd * (g1 * sigmoid_f(g1)) * mgv.y);
        ov.y = pk2(y[4 * et + 2] * rstd * (g2 * sigmoid_f(g2)) * mgv.z, y[4 * et + 3] * rstd * (g3 * sigmoid_f(g3)) * mgv.w);
        *(uint2*)(MRG + (size_t)t * 1024 + 384 + c) = ov;
      }
    }
#pragma unroll 1
    for (int gi = 0; gi < 2; ++gi) {
      const int g = wid * 2 + gi;
#pragma unroll 4
      for (int r = 0; r < 16; ++r) { const int idx = lane + 64 * r, i = idx >> 4, c = idx & 15; uw[idx] = bf2f(PROJ[(size_t)(t0 + i) * INCP + C_US + g * 16 + c]); }
      float bbr[16], bbi[16];
      const float* bbp = SBB + ((size_t)g * 64 + lane) * 32;
#pragma unroll
      for (int c = 0; c < 16; ++c) { bbr[c] = bbp[c]; bbi[c] = bbp[16 + c]; }
      const float are = SA[(g * 64 + lane) * 2], aim = SA[(g * 64 + lane) * 2 + 1];
      float xr = CARRY[(((size_t)item * 16 + g) * 64 + lane) * 2], xi = CARRY[(((size_t)item * 16 + g) * 64 + lane) * 2 + 1];
      bf16x8 cb[4];
#pragma unroll
      for (int ks = 0; ks < 4; ++ks) cb[ks] = *(const bf16x8*)(CB + ((size_t)g * 16 + fr) * 128 + 32 * ks + 8 * fq);
      const float dv = dsk[g * 16 + fr];
#pragma unroll 1
      for (int tb = 0; tb < 4; ++tb) {
#pragma unroll 2
        for (int ii = 0; ii < 16; ++ii) {
          const int i = tb * 16 + ii;
          float br = 0.f, bi = 0.f;
#pragma unroll
          for (int c = 0; c < 16; ++c) { const float u = uw[i * 16 + c]; br += bbr[c] * u; bi += bbi[c] * u; }
          const float nr = are * xr - aim * xi + br, ni = are * xi + aim * xr + bi;
          xr = nr; xi = ni;
          XB[ii * 136 + lane] = f2bf(xr); XB[ii * 136 + 64 + lane] = f2bf(xi);
        }
        f32x4 acc = (f32x4){0.f, 0.f, 0.f, 0.f};
#pragma unroll
        for (int ks = 0; ks < 4; ++ks) {
          const bf16x8 af = *(const bf16x8*)(XB + fr * 136 + 32 * ks + 8 * fq);
          acc = __builtin_amdgcn_mfma_f32_16x16x32_bf16(af, cb[ks], acc, 0, 0, 0);
        }
#pragma unroll
        for (int j = 0; j < 4; ++j) {
          const int i = tb * 16 + 4 * fq + j;
          const float yv = acc[j] + dv * uw[i * 16 + fr];
          YS[i * 264 + g * 16 + fr] = f2bf(gelu_tanh(yv));
        }
      }
    }
    __syncthreads();
    {
      const int n0 = 32 * wid;
      f32x4 a1[4][2], a2[4][2];
#pragma unroll
      for (int mt = 0; mt < 4; ++mt)
#pragma unroll
        for (int nt = 0; nt < 2; ++nt) { a1[mt][nt] = (f32x4){0.f, 0.f, 0.f, 0.f}; a2[mt][nt] = (f32x4){0.f, 0.f, 0.f, 0.f}; }
#pragma unroll 2
      for (int ks = 0; ks < 8; ++ks) {
        bf16x8 w1[2], w2[2], yb[4];
#pragma unroll
        for (int nt = 0; nt < 2; ++nt) {
          w1[nt] = *(const bf16x8*)(WG + (size_t)(n0 + 16 * nt + fr) * 256 + 32 * ks + 8 * fq);
          w2[nt] = *(const bf16x8*)(WG + (size_t)(256 + n0 + 16 * nt + fr) * 256 + 32 * ks + 8 * fq);
        }
#pragma unroll
        for (int mt = 0; mt < 4; ++mt) yb[mt] = *(const bf16x8*)(YS + (16 * mt + fr) * 264 + 32 * ks + 8 * fq);
#pragma unroll
        for (int mt = 0; mt < 4; ++mt)
#pragma unroll
          for (int nt = 0; nt < 2; ++nt) {
            a1[mt][nt] = __builtin_amdgcn_mfma_f32_16x16x32_bf16(w1[nt], yb[mt], a1[mt][nt], 0, 0, 0);
            a2[mt][nt] = __builtin_amdgcn_mfma_f32_16x16x32_bf16(w2[nt], yb[mt], a2[mt][nt], 0, 0, 0);
          }
      }
#pragma unroll
      for (int mt = 0; mt < 4; ++mt) {
        float sq = 0.f;
#pragma unroll
        for (int nt = 0; nt < 2; ++nt) {
          f32x4 z = a1[mt][nt]; const f32x4 zg = a2[mt][nt];
          z.x *= sigmoid_f(zg.x); z.y *= sigmoid_f(zg.y); z.z *= sigmoid_f(zg.z); z.w *= sigmoid_f(zg.w);
          a1[mt][nt] = z; sq += z.x * z.x + z.y * z.y + z.z * z.z + z.w * z.w;
        }
        sq += __shfl_xor(sq, 16); sq += __shfl_xor(sq, 32);
        if (fq == 0) red[wid * 64 + 16 * mt + fr] = sq;
      }
      __syncthreads();
#pragma unroll
      for (int mt = 0; mt < 4; ++mt) {
        const int i = 16 * mt + fr, t = t0 + i;
        float tot = 0.f;
#pragma unroll
        for (int w8 = 0; w8 < 8; ++w8) tot += red[w8 * 64 + i];
        const float rstd = rsqrtf(tot * (1.f / 256.f) + EPS_);
#pragma unroll
        for (int nt = 0; nt < 2; ++nt) {
          const int c = n0 + 16 * nt + 4 * fq;
          const f32x4 mgv = *(const f32x4*)(mg + 768 + c); const f32x4 z = a1[mt][nt];
          uint2 ov; ov.x = pk2(z.x * rstd * mgv.x, z.y * rstd * mgv.y); ov.y = pk2(z.z * rstd * mgv.z, z.w * rstd * mgv.w);
          *(uint2*)(MRG + (size_t)t * 1024 + 768 + c) = ov;
        }
      }
    }
  }
}

typedef float f32x2 __attribute__((ext_vector_type(2)));
__device__ __forceinline__ float dot16_fp4(const uint2 u, const float (&hv)[16]) {
  f32x2 c; float d;
  c = __builtin_amdgcn_cvt_scalef32_pk_f32_fp4(u.x, 1.0f, 0); d = c.x * hv[0] + c.y * hv[1];
  c = __builtin_amdgcn_cvt_scalef32_pk_f32_fp4(u.x, 1.0f, 1); d += c.x * hv[2] + c.y * hv[3];
  c = __builtin_amdgcn_cvt_scalef32_pk_f32_fp4(u.x, 1.0f, 2); d += c.x * hv[4] + c.y * hv[5];
  c = __builtin_amdgcn_cvt_scalef32_pk_f32_fp4(u.x, 1.0f, 3); d += c.x * hv[6] + c.y * hv[7];
  c = __builtin_amdgcn_cvt_scalef32_pk_f32_fp4(u.y, 1.0f, 0); d += c.x * hv[8] + c.y * hv[9];
  c = __builtin_amdgcn_cvt_scalef32_pk_f32_fp4(u.y, 1.0f, 1); d += c.x * hv[10] + c.y * hv[11];
  c = __builtin_amdgcn_cvt_scalef32_pk_f32_fp4(u.y, 1.0f, 2); d += c.x * hv[12] + c.y * hv[13];
  c = __builtin_amdgcn_cvt_scalef32_pk_f32_fp4(u.y, 1.0f, 3); d += c.x * hv[14] + c.y * hv[15];
  return d;
}
__device__ __forceinline__ void axpy16_fp4(const uint2 v, const float w, float (&acc)[16]) {
  f32x2 c;
  c = __builtin_amdgcn_cvt_scalef32_pk_f32_fp4(v.x, 1.0f, 0); acc[0] += w * c.x; acc[1] += w * c.y;
  c = __builtin_amdgcn_cvt_scalef32_pk_f32_fp4(v.x, 1.0f, 1); acc[2] += w * c.x; acc[3] += w * c.y;
  c = __builtin_amdgcn_cvt_scalef32_pk_f32_fp4(v.x, 1.0f, 2); acc[4] += w * c.x; acc[5] += w * c.y;
  c = __builtin_amdgcn_cvt_scalef32_pk_f32_fp4(v.x, 1.0f, 3); acc[6] += w * c.x; acc[7] += w * c.y;
  c = __builtin_amdgcn_cvt_scalef32_pk_f32_fp4(v.y, 1.0f, 0); acc[8] += w * c.x; acc[9] += w * c.y;
  c = __builtin_amdgcn_cvt_scalef32_pk_f32_fp4(v.y, 1.0f, 1); acc[10] += w * c.x; acc[11] += w * c.y;
  c = __builtin_amdgcn_cvt_scalef32_pk_f32_fp4(v.y, 1.0f, 2); acc[12] += w * c.x; acc[13] += w * c.y;
  c = __builtin_amdgcn_cvt_scalef32_pk_f32_fp4(v.y, 1.0f, 3); acc[14] += w * c.x; acc[15] += w * c.y;
}
typedef float f32x16 __attribute__((ext_vector_type(16)));
__device__ __forceinline__ float vmaxf(float a, float b) { float r; asm("v_max_f32 %0, %1, %2" : "=v"(r) : "v"(a), "v"(b)); return r; }
__device__ __forceinline__ float vminf(float a, float b) { float r; asm("v_min_f32 %0, %1, %2" : "=v"(r) : "v"(a), "v"(b)); return r; }
__device__ __forceinline__ void cx(float& hi, float& lo) { const float a = hi, b = lo; hi = vmaxf(a, b); lo = vminf(a, b); }
__device__ __forceinline__ void cx2(float& kh, int& ph, float& kl, int& pl) {
  const float a = kh, b = kl; const int pa = ph, pb = pl; const bool c = a >= b;
  kh = vmaxf(a, b); kl = vminf(a, b); ph = c ? pa : pb; pl = c ? pb : pa;
}
__device__ __forceinline__ void bitonic_sort16_desc(float (&v)[16]) {
#pragma unroll
  for (int k = 2; k <= 16; k <<= 1)
#pragma unroll
    for (int j = k >> 1; j > 0; j >>= 1)
#pragma unroll
      for (int i = 0; i < 16; ++i) {
        const int l = i ^ j;
        if (l > i) { if ((i & k) == 0) cx(v[i], v[l]); else cx(v[l], v[i]); }
      }
}
__device__ __forceinline__ void bitonic_merge16_desc(float (&v)[16]) {
#pragma unroll
  for (int j = 8; j > 0; j >>= 1)
#pragma unroll
    for (int i = 0; i < 16; ++i) { const int l = i ^ j; if (l > i) cx(v[i], v[l]); }
}
__device__ __forceinline__ void top16_merge(float (&a)[16], const float (&b)[16]) {
#pragma unroll
  for (int i = 0; i < 16; ++i) a[i] = vmaxf(a[i], b[15 - i]);
  bitonic_merge16_desc(a);
}
template <int M> __device__ __forceinline__ void top16_merge_chain(float (&k)[16], int (&q)[16], const float (&xk)[M], const int (&xq)[M]) {
#pragma unroll
  for (int i = 16 - M; i < 16; ++i) { const float a = k[i], b = xk[15 - i]; const bool c = a >= b; k[i] = vmaxf(a, b); q[i] = c ? q[i] : xq[15 - i]; }
#pragma unroll
  for (int j = 8; j > 0; j >>= 1)
#pragma unroll
    for (int i = 0; i < 16; ++i) { const int l = i ^ j; if (l > i) cx2(k[i], q[i], k[l], q[l]); }
}

__device__ void peer_phase(const Params& p, int l, bool last, unsigned char* smem) {
  const CParamsP pp = launder_kargs();
  unsigned char* const ws = launder_ptr(pp->ws); const int tidx = launder_tid();
  bf16_t* HF = (bf16_t*)(ws + WS_ABUF); float* X = (float*)(ws + WS_X);
  const bf16_t* Q = (const bf16_t*)(ws + WS_Q); const bf16_t* SK = (const bf16_t*)(ws + WS_SUBK) + (size_t)l * 16 * 128 * 128;
  const uint2* U4 = (const uint2*)(ws + WS_PU8) + (size_t)l * 16384 * 64; const uint2* V4 = (const uint2*)(ws + WS_PV8) + (size_t)l * 16384 * 64;
  const float* g2 = (const float*)(ws + WS_MOD) + (size_t)l * 2 * 6144 + 5120;
  const int ln = last ? l : l + 1;
  const float* nsh = (const float*)(ws + WS_MOD) + (size_t)ln * 2 * 6144; const float* nsc = nsh + 1024;
  const float* ngain = pp->in[I_NMIX] + (size_t)ln * 1024;
  const int lane = tidx & 63, wid = tidx >> 6;
  const int rL = ((lane >> 5) & 1) * 8 + ((lane >> 4) & 1) * 4 + ((lane >> 3) & 1) * 2 + ((lane >> 2) & 1);
  const bool hi5 = (lane & 32) != 0, hi4 = (lane & 16) != 0, hi3 = (lane & 8) != 0, hi2 = (lane & 4) != 0;
  int* idxL = (int*)smem; float* gateL = (float*)(smem + 64 * 132 * 4);
  for (int item = blockIdx.x; item < T_ / 64; item += gridDim.x) {
    const int t0 = item * 64;
    __syncthreads();
    {
      int lane_o = lane; asm volatile("" : "+v"(lane_o));
      const int tg = wid & 1, hp = wid >> 1, hf = lane_o >> 5, tl = 32 * tg + (lane_o & 31);
      const bf16_t* qrow = Q + (size_t)(t0 + tl) * 2048;
      float F[2][16];
#pragma unroll
      for (int sd = 0; sd < 2; ++sd) {
        float Lh[2][16];
#pragma unroll
        for (int hh = 0; hh < 2; ++hh) {
          const int hs = 2 * (2 * hp + hh) + sd;
          float top[16];
          const bf16_t* skb = SK + ((size_t)hs * 128 + (lane & 31)) * 128 + 8 * hf;
#pragma unroll
          for (int kp = 0; kp < 2; ++kp) {
            f32x16 acc[2];
#pragma unroll
            for (int kt = 0; kt < 2; ++kt)
#pragma unroll
              for (int r = 0; r < 16; ++r) acc[kt][r] = 0.f;
#pragma unroll 2
            for (int ks = 0; ks < 8; ++ks) {
              const bf16x8 bq = *(const bf16x8*)(qrow + hs * 128 + ks * 16 + 8 * hf);
#pragma unroll
              for (int kt = 0; kt < 2; ++kt) {
                const bf16x8 ak = *(const bf16x8*)(skb + (size_t)(kp * 2 + kt) * 32 * 128 + ks * 16);
                acc[kt] = __builtin_amdgcn_mfma_f32_32x32x16_bf16(ak, bq, acc[kt], 0, 0, 0);
              }
            }
#pragma unroll
            for (int kt = 0; kt < 2; ++kt) {
              float g[16];
#pragma unroll
              for (int r = 0; r < 16; ++r) {
                const int key = (kp * 2 + kt) * 32 + (r & 3) + 8 * (r >> 2) + 4 * hf;
                g[r] = __uint_as_float((__float_as_uint(acc[kt][r]) & 0xffffff80u) | (unsigned)key);
              }
              bitonic_sort16_desc(g);
              if (kp == 0 && kt == 0) {
#pragma unroll
                for (int r = 0; r < 16; ++r) top[r] = g[r];
              } else top16_merge(top, g);
              __builtin_amdgcn_sched_barrier(0);
            }
          }
#pragma unroll
          for (int r = 0; r < 16; ++r) Lh[hh][r] = top[r];
          __builtin_amdgcn_sched_barrier(0);
        }
#pragma unroll
        for (int r = 0; r < 16; ++r) {
          const auto sw = __builtin_amdgcn_permlane32_swap(__float_as_uint(Lh[0][r]), __float_as_uint(Lh[1][r]), false, false);
          Lh[0][r] = __uint_as_float(sw[0]); Lh[1][r] = __uint_as_float(sw[1]);
        }
        top16_merge(Lh[0], Lh[1]);
#pragma unroll
        for (int r = 0; r < 16; ++r) F[sd][r] = Lh[0][r];
        __builtin_amdgcn_sched_barrier(0);
      }
      int ia[16], ib[16];
#pragma unroll
      for (int r = 0; r < 16; ++r) { ia[r] = (int)(__float_as_uint(F[0][r]) & 127u) << 7; ib[r] = (int)(__float_as_uint(F[1][r]) & 127u); }
      float k[16]; int q[16];
#pragma unroll
      for (int j = 0; j < 16; ++j) { k[j] = F[0][0] + F[1][j]; q[j] = ia[0] | ib[j]; }
      { float xk[8]; int xq[8];
#pragma unroll
        for (int j = 0; j < 8; ++j) { xk[j] = F[0][1] + F[1][j]; xq[j] = ia[1] | ib[j]; }
        top16_merge_chain<8>(k, q, xk, xq); }
      { float xk[5]; int xq[5];
#pragma unroll
        for (int j = 0; j < 5; ++j) { xk[j] = F[0][2] + F[1][j]; xq[j] = ia[2] | ib[j]; }
        top16_merge_chain<5>(k, q, xk, xq); }
      { float xk[4]; int xq[4];
#pragma unroll
        for (int j = 0; j < 4; ++j) { xk[j] = F[0][3] + F[1][j]; xq[j] = ia[3] | ib[j]; }
        top16_merge_chain<4>(k, q, xk, xq); }
      { float xk[3]; int xq[3];
#pragma unroll
        for (int j = 0; j < 3; ++j) { xk[j] = F[0][4] + F[1][j]; xq[j] = ia[4] | ib[j]; }
        top16_merge_chain<3>(k, q, xk, xq); }
      { float xk[11]; int xq[11];
#pragma unroll
        for (int i = 0; i < 11; ++i) { xk[i] = F[0][5 + i] + F[1][0]; xq[i] = ia[5 + i] | ib[0]; }
        top16_merge_chain<11>(k, q, xk, xq); }
      { float xk[3]; int xq[3];
#pragma unroll
        for (int i = 0; i < 3; ++i) { xk[i] = F[0][5 + i] + F[1][1]; xq[i] = ia[5 + i] | ib[1]; }
        top16_merge_chain<3>(k, q, xk, xq); }
      float e[16]; float es = 0.f;
#pragma unroll
      for (int i = 0; i < 16; ++i) { e[i] = __expf(k[i] - k[0]); es += e[i]; }
      const float ies = 1.f / es;
      const int h = 2 * hp + hf;
#pragma unroll
      for (int i = 0; i < 16; ++i) { idxL[tl * 132 + h * 16 + i] = q[i]; gateL[tl * 132 + h * 16 + i] = e[i] * ies; }
    }
    __syncthreads();
#pragma unroll 1
    for (int ii = 0; ii < 8; ++ii) {
      const int tl = wid * 8 + ii, t = t0 + tl, b = t >> 13;
      float hv[16];
      {
        const uint4 h0 = *(const uint4*)(HF + (size_t)t * 1024 + lane * 16), h1 = *(const uint4*)(HF + (size_t)t * 1024 + lane * 16 + 8);
        const unsigned hw[8] = {h0.x, h0.y, h0.z, h0.w, h1.x, h1.y, h1.z, h1.w};
#pragma unroll
        for (int qq = 0; qq < 8; ++qq) { hv[2 * qq] = __uint_as_float(hw[qq] << 16); hv[2 * qq + 1] = __uint_as_float(hw[qq] & 0xffff0000u); }
      }
      const int e0 = idxL[tl * 132 + lane], e1 = idxL[tl * 132 + 64 + lane];
      const float g0 = gateL[tl * 132 + lane], g1 = gateL[tl * 132 + 64 + lane];
      float acc[16];
#pragma unroll
      for (int j = 0; j < 16; ++j) acc[j] = 0.f;
#pragma unroll 1
      for (int bt = 0; bt < 8; ++bt) {
        const int esrc = (bt < 4) ? e0 : e1; const float gsrc = (bt < 4) ? g0 : g1; const int lb = (bt & 3) * 16;
        uint2 ur[16], vr[16];
        int eidx[16];
#pragma unroll
        for (int r = 0; r < 16; ++r) eidx[r] = __builtin_amdgcn_readlane(esrc, lb + r);
#pragma unroll
        for (int r = 0; r < 16; ++r) { const uint2* rowp = U4 + (size_t)eidx[r] * 64; ur[r] = rowp[lane]; }
#pragma unroll
        for (int r = 0; r < 16; ++r) { const uint2* rowp = V4 + (size_t)eidx[r] * 64; vr[r] = rowp[lane]; }
        float d[16];
#pragma unroll
        for (int r = 0; r < 16; ++r) { d[r] = dot16_fp4(ur[r], hv); asm volatile("" : "+v"(d[r])); }
        float r8[8], r4[4], r2[2];
#pragma unroll
        for (int i = 0; i < 8; ++i) { const float keep = hi5 ? d[i + 8] : d[i], send = hi5 ? d[i] : d[i + 8]; r8[i] = keep + __shfl_xor(send, 32); }
#pragma unroll
        for (int i = 0; i < 4; ++i) { const float keep = hi4 ? r8[i + 4] : r8[i], send = hi4 ? r8[i] : r8[i + 4]; r4[i] = keep + __shfl_xor(send, 16); }
#pragma unroll
        for (int i = 0; i < 2; ++i) { const float keep = hi3 ? r4[i + 2] : r4[i], send = hi3 ? r4[i] : r4[i + 2]; r2[i] = keep + __shfl_xor(send, 8); }
        float r1;
        { const float keep = hi2 ? r2[1] : r2[0], send = hi2 ? r2[0] : r2[1]; r1 = keep + __shfl_xor(send, 4); }
        r1 += __shfl_xor(r1, 2); r1 += __shfl_xor(r1, 1);
        const float gl = __shfl(gsrc, lb + rL);
        const float w = gl * gelu_tanh(r1 * (1.f / 64.f));
#pragma unroll
        for (int r = 0; r < 16; ++r) {
          const int Lk = ((r >> 3) & 1) * 32 + ((r >> 2) & 1) * 16 + ((r >> 1) & 1) * 8 + (r & 1) * 4;
          const float wr = __int_as_float(__builtin_amdgcn_readlane(__float_as_int(w), Lk));
          axpy16_fp4(vr[r], wr, acc);
          __builtin_amdgcn_sched_barrier(0);
        }
      }
      float xn[16]; float ss = 0.f;
#pragma unroll
      for (int qq = 0; qq < 4; ++qq) {
        const int c = lane * 16 + 4 * qq;
        const f32x4 xv = *(const f32x4*)(X + (size_t)t * 1024 + c), g = *(const f32x4*)(g2 + b * 6144 + c);
        xn[4 * qq] = xv.x + g.x * acc[4 * qq] * 0.25f; xn[4 * qq + 1] = xv.y + g.y * acc[4 * qq + 1] * 0.25f;
        xn[4 * qq + 2] = xv.z + g.z * acc[4 * qq + 2] * 0.25f; xn[4 * qq + 3] = xv.w + g.w * acc[4 * qq + 3] * 0.25f;
        ss += xn[4 * qq] * xn[4 * qq] + xn[4 * qq + 1] * xn[4 * qq + 1] + xn[4 * qq + 2] * xn[4 * qq + 2] + xn[4 * qq + 3] * xn[4 * qq + 3];
      }
      const float rstd = rsqrtf(wave_sum(ss) * (1.f / 1024.f) + EPS_);
      if (!last) {
        unsigned hb[8];
#pragma unroll
        for (int qq = 0; qq < 4; ++qq) {
          const int c = lane * 16 + 4 * qq;
          *(f32x4*)(X + (size_t)t * 1024 + c) = (f32x4){xn[4 * qq], xn[4 * qq + 1], xn[4 * qq + 2], xn[4 * qq + 3]};
          const f32x4 gn = *(const f32x4*)(ngain + c), sh = *(const f32x4*)(nsh + b * 6144 + c), sc = *(const f32x4*)(nsc + b * 6144 + c);
          hb[2 * qq] = pk2(xn[4 * qq] * rstd * gn.x * (1.f + sc.x) + sh.x, xn[4 * qq + 1] * rstd * gn.y * (1.f + sc.y) + sh.y);
          hb[2 * qq + 1] = pk2(xn[4 * qq + 2] * rstd * gn.z * (1.f + sc.z) + sh.z, xn[4 * qq + 3] * rstd * gn.w * (1.f + sc.w) + sh.w);
        }
        *(uint4*)(HF + (size_t)t * 1024 + lane * 16) = make_uint4(hb[0], hb[1], hb[2], hb[3]);
        *(uint4*)(HF + (size_t)t * 1024 + lane * 16 + 8) = make_uint4(hb[4], hb[5], hb[6], hb[7]);
      } else {
#pragma unroll
        for (int qq = 0; qq < 4; ++qq) {
          const int c = lane * 16 + 4 * qq;
          const f32x4 fn = *(const f32x4*)(pp->in[I_FNORM] + c);
          *(f32x4*)(pp->out + (size_t)t * 1024 + c) = (f32x4){xn[4 * qq] * rstd * fn.x, xn[4 * qq + 1] * rstd * fn.y, xn[4 * qq + 2] * rstd * fn.z, xn[4 * qq + 3] * rstd * fn.w};
        }
      }
    }
  }
}

#define XB_TMO      128
#define XB_XCNT(j)  (256  + 64 * (j))
#define XB_XSUB(j)  (1280 + 64 * (j))
#define XB_XGEN(j)  (2304 + 64 * (j))
#define XB_TOP      3328
#define XB_TOPGEN   3392
#define XCD_BAR_WORDS 3456
#define XB_SPIN_CAP (1u << 20)
#define LAS __attribute__((address_space(3)))
__device__ __forceinline__ unsigned xb_ld(unsigned* q)              { return __hip_atomic_load(q, __ATOMIC_RELAXED, __HIP_MEMORY_SCOPE_AGENT); }
__device__ __forceinline__ unsigned xb_add(unsigned* q, unsigned v) { return __hip_atomic_fetch_add(q, v, __ATOMIC_RELAXED, __HIP_MEMORY_SCOPE_AGENT); }
__device__ __forceinline__ unsigned xb_xcc_id() { return (unsigned)__builtin_amdgcn_s_getreg((3 << 11) | 20) & 0xFu; }
#define XB_SPIN(cond, bar) do { unsigned _sp = 0; while (cond) { __builtin_amdgcn_s_sleep(1); \
    if ((++_sp & 255u) == 0u) { if (xb_ld(&(bar)[XB_TMO])) break; if (_sp > XB_SPIN_CAP) { atomicAdd(&(bar)[XB_TMO], 1u); break; } } } } while (0)
struct XcdBarrier { unsigned* bar; unsigned x; volatile LAS unsigned* st; };
__device__ __forceinline__ XcdBarrier xcd_barrier_post(unsigned* bar, volatile LAS unsigned* st) {
    XcdBarrier b; b.bar = bar; b.x = xb_xcc_id(); b.st = st;
    if (threadIdx.x == 0) (void)xb_add(&bar[XB_XCNT(b.x)], 1u);
    return b;
}
__device__ __forceinline__ void xcd_barrier_complete(unsigned* bar, unsigned x, unsigned& nloc, unsigned& nx) {
    const unsigned G = gridDim.x * gridDim.y * gridDim.z;
    unsigned sum, cnt, mine, sp = 0u;
    for (;;) {
        sum = 0u; cnt = 0u; mine = 0u;
#pragma unroll
        for (unsigned j = 0; j < 16; ++j) { const unsigned c = xb_ld(&bar[XB_XCNT(j)]); sum += c; cnt += (c > 0u) ? 1u : 0u; mine = (j == x) ? c : mine; }
        if (sum == G) break;
        __builtin_amdgcn_s_sleep(1);
        if ((++sp & 255u) == 0u) { if (xb_ld(&bar[XB_TMO])) break; if (sp > XB_SPIN_CAP) { atomicAdd(&bar[XB_TMO], 1u); break; } }
    }
    nloc = mine > 0u ? mine : 1u; nx = cnt > 0u ? cnt : 1u;
}
__device__ __forceinline__ void xcd_barrier(const XcdBarrier& b) {
    asm volatile("s_waitcnt vmcnt(0)" ::: "memory");
    __syncthreads();
    if (threadIdx.x == 0) {
        unsigned* bar = b.bar;
        __builtin_amdgcn_s_waitcnt(0);
        unsigned nloc = b.st[0], nx = b.st[1];
        if (nloc == 0u) { xcd_barrier_complete(bar, b.x, nloc, nx); b.st[0] = nloc; b.st[1] = nx; }
        const unsigned old = xb_add(&bar[XB_XSUB(b.x)], 1u);
        const unsigned gen = old / nloc;
        if (old + 1u == (gen + 1u) * nloc) {
            __builtin_amdgcn_fence(__ATOMIC_RELEASE, "agent");
            asm volatile("s_waitcnt vmcnt(0)" ::: "memory");
            const unsigned og = xb_add(&bar[XB_TOP], 1u);
            const unsigned tg = og / nx;
            if (og + 1u == (tg + 1u) * nx) xb_add(&bar[XB_TOPGEN], 1u);
            else XB_SPIN(xb_ld(&bar[XB_TOPGEN]) == tg, bar);
            __builtin_amdgcn_fence(__ATOMIC_ACQUIRE, "agent");
            xb_add(&bar[XB_XGEN(b.x)], 1u);
            asm volatile("s_waitcnt vmcnt(0)" ::: "memory");
        } else {
            XB_SPIN(xb_ld(&bar[XB_XGEN(b.x)]) == gen, bar);
            __builtin_amdgcn_fence(__ATOMIC_ACQUIRE, "agent");
            asm volatile("s_waitcnt vmcnt(0)" ::: "memory");
        }
    }
    __syncthreads();
}

__global__ void __launch_bounds__(NT) fwd_megakernel(Params p) {
  extern __shared__ __attribute__((aligned(16))) unsigned char smem[];
  const CParamsP pp = launder_kargs();
  cg::grid_group grid = cg::this_grid();
  volatile LAS unsigned* xbst = (volatile LAS unsigned*)(smem + LDS_BYTES - 16);
  if (threadIdx.x == 0) { xbst[0] = 0u; xbst[1] = 0u; }
  if (blockIdx.x == 0) { unsigned* bw = (unsigned*)(pp->ws + WS_BAR); for (int i = threadIdx.x; i < XCD_BAR_WORDS; i += NT) bw[i] = 0u; }
  setup_phase(p, smem);
  grid.sync();
  const XcdBarrier xb = xcd_barrier_post((unsigned*)(pp->ws + WS_BAR), xbst);
  const float* MOD = (const float*)(pp->ws + WS_MOD);
  for (int l = 0; l < DEPTH_; ++l) {
    const float* xsrc = (l == 0) ? pp->in[I_X] : (const float*)(pp->ws + WS_X);
    const float* modl = MOD + (size_t)l * 2 * 6144;
    if (l == 0) {
      norm_mod_phase(xsrc, pp->in[I_NMIX], modl + 0, modl + 1024, (bf16_t*)(pp->ws + WS_ABUF));
      xcd_barrier(xb);
    }
    gemm_proj_phase(p, l, smem);
    xcd_barrier(xb);
    attn_phase(p, l, smem);
    mix_local_phase(p, l, smem);
    xcd_barrier(xb);
    scan_phase(p, l);
    xcd_barrier(xb);
    mix_final_phase(p, l, smem);
    xcd_barrier(xb);
    gemm_out_phase(p, l, xsrc, smem);
    xcd_barrier(xb);
    norm_mod_phase((const float*)(pp->ws + WS_X), pp->in[I_NFFN] + (size_t)l * 1024, modl + 3072, modl + 4096, (bf16_t*)(pp->ws + WS_ABUF));
    xcd_barrier(xb);
    gemm_q_phase(p, l, smem);
    xcd_barrier(xb);
    peer_phase(p, l, l == DEPTH_ - 1, smem);
    xcd_barrier(xb);
  }
}

extern "C" void kernel_launch(void* const* d_in, const int* in_sizes, int n_in,
                              void* d_out, int out_size, void* d_ws, size_t ws_size,
                              hipStream_t stream) {
  static int grid_blocks = 0;
  if (grid_blocks == 0) {
    if (n_in != 24 || ws_size < WS_END) { fprintf(stderr, "kernel_launch: unexpected n_in %d / ws_size %zu (need %zu)\n", n_in, ws_size, (size_t)WS_END); grid_blocks = -1; return; }
    int dev = 0, cus = 0, per_cu = 0;
    if (hipGetDevice(&dev) != hipSuccess || hipDeviceGetAttribute(&cus, hipDeviceAttributeMultiprocessorCount, dev) != hipSuccess) { grid_blocks = -1; return; }
    if (hipFuncSetAttribute((const void*)fwd_megakernel, hipFuncAttributeMaxDynamicSharedMemorySize, LDS_BYTES) != hipSuccess) { fprintf(stderr, "hipFuncSetAttribute failed\n"); grid_blocks = -1; return; }
    if (hipOccupancyMaxActiveBlocksPerMultiprocessor(&per_cu, (const void*)fwd_megakernel, NT, LDS_BYTES) != hipSuccess || per_cu < 1) { fprintf(stderr, "occupancy query: %d\n", per_cu); grid_blocks = -1; return; }
    grid_blocks = cus;
  }
  if (grid_blocks < 0) return;
  Params p{};
  for (int i = 0; i < 24; ++i) p.in[i] = (const float*)d_in[i];
  p.out = (float*)d_out; p.ws = (unsigned char*)d_ws;
  void* args[] = {&p};
  hipError_t e = hipLaunchCooperativeKernel((void*)fwd_megakernel, dim3(grid_blocks), dim3(NT), args, LDS_BYTES, stream);
  if (e != hipSuccess) fprintf(stderr, "cooperative launch failed: %s (grid %d)\n", hipGetErrorString(e), grid_blocks);
}
```

```cpp
#include <hip/hip_runtime.h>
#include <hip/hip_cooperative_groups.h>
#include <cstdio>
#include <cstdint>
namespace cg = cooperative_groups;

typedef unsigned short bf16_t;
typedef short bf16x8 __attribute__((ext_vector_type(8)));
typedef float f32x4 __attribute__((ext_vector_type(4)));

constexpr int T_ = 16384, D_ = 1024, L_ = 8192, NBATCH = 2, DEPTH_ = 4;
constexpr int INC = 2944, INCP = 3072;
constexpr int NCH = 128;
constexpr int NT = 512;
constexpr int NW = 8;
constexpr float EPS_ = 1e-6f;
constexpr int C_QA = 0, C_KA = 384, C_VA = 768, C_QR = 1152, C_KR = 1536, C_VR = 1920, C_GR = 2304, C_US = 2688;

constexpr size_t al256(size_t x) { return (x + 255) & ~(size_t)255; }
constexpr size_t WS_MOD   = 0;
constexpr size_t WS_ROTC  = al256(WS_MOD + 4ull * 2 * 6144 * 4);
constexpr size_t WS_ROTS  = al256(WS_ROTC + 8192ull * 32 * 4);
constexpr size_t WS_SA    = al256(WS_ROTS + 8192ull * 32 * 4);
constexpr size_t WS_SBB   = al256(WS_SA + 4ull * 16 * 64 * 2 * 4);
constexpr size_t WS_WIN   = al256(WS_SBB + 4ull * 16 * 64 * 32 * 4);
constexpr size_t WS_WOUT  = al256(WS_WIN + 4ull * INCP * 1024 * 2);
constexpr size_t WS_WQ    = al256(WS_WOUT + 4ull * 1024 * 1024 * 2);
constexpr size_t WS_SUBK  = al256(WS_WQ + 4ull * 2048 * 1024 * 2);
constexpr size_t WS_ABUF  = al256(WS_SUBK + 4ull * 16 * 128 * 128 * 2);
constexpr size_t WS_PROJ  = al256(WS_ABUF + (size_t)T_ * 1024 * 2);
constexpr size_t WS_VTA   = al256(WS_PROJ + (size_t)T_ * INCP * 2);
constexpr size_t WS_ATT   = al256(WS_VTA + 2ull * 6 * 64 * 8192 * 2);
constexpr size_t WS_YINT  = al256(WS_ATT + (size_t)T_ * 384 * 4);
constexpr size_t WS_UPD   = al256(WS_YINT + (size_t)T_ * 384 * 4);
constexpr size_t WS_SPREV = al256(WS_UPD + 256ull * 6 * 4096 * 4);
constexpr size_t WS_SEND  = al256(WS_SPREV + 256ull * 6 * 4096 * 4);
constexpr size_t WS_CARRY = al256(WS_SEND + 256ull * 16 * 64 * 2 * 4);
constexpr size_t WS_X     = al256(WS_CARRY + 256ull * 16 * 64 * 2 * 4);
constexpr size_t WS_Q     = al256(WS_X + (size_t)T_ * 1024 * 4);
constexpr size_t WS_SC    = al256(WS_Q + (size_t)T_ * 2048 * 2);
constexpr size_t WS_EIDX  = al256(WS_SC + (size_t)T_ * 2048 * 4);
constexpr size_t WS_EGATE = al256(WS_EIDX + (size_t)T_ * 128 * 4);
constexpr size_t WS_PU8   = al256(WS_EGATE + (size_t)T_ * 128 * 4);
constexpr size_t WS_PV8   = al256(WS_PU8 + 4ull * 16384 * 1024);
constexpr size_t WS_BAR   = al256(WS_PV8 + 4ull * 16384 * 1024);
constexpr size_t WS_SPT   = al256(WS_BAR + 3456ull * 4);
constexpr size_t WS_CB    = al256(WS_SPT + 256ull * 6 * 4096 * 2);
constexpr size_t WS_WGLUT = al256(WS_CB + 4ull * 16 * 16 * 128 * 2);
constexpr size_t WS_VTR   = al256(WS_WGLUT + 4ull * 512 * 256 * 2);
constexpr size_t WS_END   = al256(WS_VTR + 2ull * 384 * 8192 * 2);

constexpr int LDS_BYTES = 135168;

#define GAS __attribute__((address_space(1)))
struct Params {
  const GAS float* in[24];
  GAS float* out;
  GAS unsigned char* ws;
};
enum { I_X = 0, I_C, I_WADA, I_BADA, I_NMIX, I_NFFN, I_WIN, I_RELB, I_LRE, I_LIM, I_LOGDT, I_BRE, I_BIM, I_CRE, I_CIM, I_SSMD,
       I_WGLU, I_MGAIN, I_WOUT, I_WQ, I_SUBK, I_PU, I_PV, I_FNORM };

__device__ __forceinline__ float bf2f(bf16_t v) { return __uint_as_float(((unsigned)v) << 16); }
__device__ __forceinline__ bf16_t f2bf(float f) { unsigned u = __float_as_uint(f); u += 0x7fffu + ((u >> 16) & 1u); return (bf16_t)(u >> 16); }
__device__ __forceinline__ unsigned pk2(float a, float b) { return (unsigned)f2bf(a) | ((unsigned)f2bf(b) << 16); }
__device__ __forceinline__ float wave_sum(float v) {
#pragma unroll
  for (int o = 32; o > 0; o >>= 1) v += __shfl_xor(v, o);
  return v;
}
__device__ __forceinline__ float wave_max(float v) {
#pragma unroll
  for (int o = 32; o > 0; o >>= 1) v = fmaxf(v, __shfl_xor(v, o));
  return v;
}
__device__ __forceinline__ float gelu_tanh(float x) { const float u = 0.7978845608028654f * (x + 0.044715f * x * x * x); return 0.5f * x * (1.f + tanhf(u)); }
__device__ __forceinline__ float sigmoid_f(float x) { return 1.f / (1.f + __expf(-x)); }
__device__ __forceinline__ GAS unsigned char* launder_ptr(GAS unsigned char* q) { asm volatile("" : "+s"(q)); return q; }
__device__ __forceinline__ const float* gin(const GAS float* q) { return (const float*)q; }
__device__ __forceinline__ const float* launder_cptr(const float* q) { asm volatile("" : "+s"(q)); return q; }
__device__ __forceinline__ int launder_tid() { int t = threadIdx.x; asm volatile("" : "+v"(t)); return t; }
typedef const Params __attribute__((address_space(4)))* CParamsP;
__device__ __forceinline__ CParamsP launder_kargs() { CParamsP q = (CParamsP)__builtin_amdgcn_kernarg_segment_ptr(); asm volatile("" : "+s"(q)); return q; }

__device__ void setup_phase(const Params& p, unsigned char* smem) {
  const CParamsP pp = launder_kargs();
  GAS unsigned char* const ws = launder_ptr(pp->ws); const int tidx = launder_tid(); (void)ws; (void)tidx;
  const int tid = tidx;
  float* sm = (float*)smem;
  {
    float* cond = sm;
    float* red = sm + 2048;
    float* MOD = (float*)(ws + WS_MOD);
    for (int i = tid; i < 2048; i += NT) { const float c = gin(pp->in[I_C])[i]; cond[i] = c * sigmoid_f(c); }
    __syncthreads();
    for (int item = blockIdx.x; item < 4 * 96; item += gridDim.x) {
      const int l = item / 96, cb = item % 96, kq = tid >> 6, jj = tid & 63, j = cb * 64 + jj;
      const float* w = gin(pp->in[I_WADA]) + (size_t)l * 1024 * 6144 + j;
      float a0 = 0.f, a1 = 0.f;
      for (int k = kq * 128; k < kq * 128 + 128; ++k) { const float wv = w[(size_t)k * 6144]; a0 += cond[k] * wv; a1 += cond[1024 + k] * wv; }
      red[(kq * 2 + 0) * 64 + jj] = a0; red[(kq * 2 + 1) * 64 + jj] = a1;
      __syncthreads();
      if (tid < 128) {
        const int b = tid >> 6, j2 = tid & 63; float s = 0.f;
        for (int q = 0; q < 8; ++q) s += red[(q * 2 + b) * 64 + j2];
        MOD[((size_t)l * 2 + b) * 6144 + cb * 64 + j2] = s + gin(pp->in[I_BADA])[(size_t)l * 6144 + cb * 64 + j2];
      }
      __syncthreads();
    }
  }
  const int gtid = blockIdx.x * NT + tid, gn = gridDim.x * NT;
  {
    float* RC = (float*)(ws + WS_ROTC); float* RS = (float*)(ws + WS_ROTS);
    for (int idx = gtid; idx < 8192 * 32; idx += gn) {
      const int pos = idx >> 5, i = idx & 31;
      const float inv = powf(10000.0f, -(float)i / 32.0f);
      const float ang = (float)pos * inv;
      float s, c; sincosf(ang, &s, &c);
      RC[idx] = c; RS[idx] = s;
    }
  }
  {
    float* SA = (float*)(ws + WS_SA); float* SBB = (float*)(ws + WS_SBB);
    for (int idx = gtid; idx < 4 * 16 * 64; idx += gn) {
      const int l = idx / 1024, g = (idx >> 6) & 15;
      const float dt = expf(gin(pp->in[I_LOGDT])[l * 16 + g]);
      const float lr = gin(pp->in[I_LRE])[idx], li = gin(pp->in[I_LIM])[idx];
      const float mag = expf(lr * dt);
      float sn, cs; sincosf(li * dt, &sn, &cs);
      const float are = mag * cs, aim = mag * sn;
      const float den = lr * lr + li * li, nr = are - 1.f, ni = aim;
      const float fre = (nr * lr + ni * li) / den, fim = (ni * lr - nr * li) / den;
      SA[idx * 2] = are; SA[idx * 2 + 1] = aim;
      for (int c = 0; c < 16; ++c) {
        const float br = gin(pp->in[I_BRE])[(size_t)idx * 16 + c], bi = gin(pp->in[I_BIM])[(size_t)idx * 16 + c];
        SBB[(size_t)idx * 32 + c] = fre * br - fim * bi;
        SBB[(size_t)idx * 32 + 16 + c] = fre * bi + fim * br;
      }
    }
  }
  {
    bf16_t* SK = (bf16_t*)(ws + WS_SUBK);
    for (int idx = gtid; idx < 4 * 16 * 128 * 128; idx += gn) SK[idx] = f2bf(gin(pp->in[I_SUBK])[idx]);
  }
  {
    bf16_t* CB = (bf16_t*)(ws + WS_CB);
    for (int idx = gtid; idx < 4 * 16 * 16 * 128; idx += gn) {
      const int k = idx & 127, lgc = idx >> 7;
      CB[idx] = (k < 64) ? f2bf(gin(pp->in[I_CRE])[(size_t)lgc * 64 + k]) : f2bf(-gin(pp->in[I_CIM])[(size_t)lgc * 64 + (k - 64)]);
    }
    bf16_t* WG = (bf16_t*)(ws + WS_WGLUT);
    for (int idx = gtid; idx < 4 * 512 * 256; idx += gn) {
      const int k = idx & 255, nn = (idx >> 8) & 511, l2 = idx >> 17;
      WG[idx] = f2bf(gin(pp->in[I_WGLU])[((size_t)l2 * 256 + k) * 512 + nn]);
    }
  }
  {
    constexpr size_t NIT = 4ull * 16384 * 1024 / 16;
    for (size_t it = gtid; it < 2 * NIT; it += gn) {
      const int tb = it >= NIT ? 1 : 0; const size_t r = it - (size_t)tb * NIT;
      const f32x4* src = (const f32x4*)((tb ? gin(pp->in[I_PV]) : gin(pp->in[I_PU])) + r * 16);
      const float sc = tb ? 4.f : 64.f;
      unsigned o[2] = {0u, 0u};
#pragma unroll
      for (int q = 0; q < 4; ++q) {
        const f32x4 a = src[q];
        const float x0 = fminf(fmaxf(a.x * sc, -6.f), 6.f), x1 = fminf(fmaxf(a.y * sc, -6.f), 6.f);
        const float x2 = fminf(fmaxf(a.z * sc, -6.f), 6.f), x3 = fminf(fmaxf(a.w * sc, -6.f), 6.f);
        if (q == 0)      { o[0] = __builtin_amdgcn_cvt_scalef32_pk_fp4_f32(o[0], x0, x1, 1.0f, 0); o[0] = __builtin_amdgcn_cvt_scalef32_pk_fp4_f32(o[0], x2, x3, 1.0f, 1); }
        else if (q == 1) { o[0] = __builtin_amdgcn_cvt_scalef32_pk_fp4_f32(o[0], x0, x1, 1.0f, 2); o[0] = __builtin_amdgcn_cvt_scalef32_pk_fp4_f32(o[0], x2, x3, 1.0f, 3); }
        else if (q == 2) { o[1] = __builtin_amdgcn_cvt_scalef32_pk_fp4_f32(o[1], x0, x1, 1.0f, 0); o[1] = __builtin_amdgcn_cvt_scalef32_pk_fp4_f32(o[1], x2, x3, 1.0f, 1); }
        else             { o[1] = __builtin_amdgcn_cvt_scalef32_pk_fp4_f32(o[1], x0, x1, 1.0f, 2); o[1] = __builtin_amdgcn_cvt_scalef32_pk_fp4_f32(o[1], x2, x3, 1.0f, 3); }
      }
      *(uint2*)(ws + (tb ? WS_PV8 : WS_PU8) + r * 8) = make_uint2(o[0], o[1]);
    }
  }
  {
    float* tile = sm;
    constexpr int IT_IN = 4 * 16 * 48, IT_OUT = 4 * 16 * 16, IT_Q = 4 * 16 * 32;
    __syncthreads();
    for (int item = blockIdx.x; item < IT_IN + IT_OUT + IT_Q; item += gridDim.x) {
      const float* W; bf16_t* WT; int N, NP, r = item;
      if (r < IT_IN) { const int l = r / (16 * 48); r %= 16 * 48; W = gin(pp->in[I_WIN]) + (size_t)l * 1024 * INC; WT = (bf16_t*)(ws + WS_WIN) + (size_t)l * INCP * 1024; N = INC; NP = 48; }
      else if (r < IT_IN + IT_OUT) { r -= IT_IN; const int l = r / 256; r %= 256; W = gin(pp->in[I_WOUT]) + (size_t)l * 1024 * 1024; WT = (bf16_t*)(ws + WS_WOUT) + (size_t)l * 1024 * 1024; N = 1024; NP = 16; }
      else { r -= IT_IN + IT_OUT; const int l = r / 512; r %= 512; W = gin(pp->in[I_WQ]) + (size_t)l * 1024 * 2048; WT = (bf16_t*)(ws + WS_WQ) + (size_t)l * 2048 * 1024; N = 2048; NP = 32; }
      const int kb = r / NP, nb = r % NP, k0 = kb * 64, n0 = nb * 64;
      {
        const int col = tid & 63, rr = tid >> 6;
#pragma unroll
        for (int i = 0; i < 8; ++i) { const int kk = rr + 8 * i; const int n = n0 + col; tile[kk * 65 + col] = (n < N) ? W[(size_t)(k0 + kk) * N + n] : 0.f; }
      }
      __syncthreads();
      {
        const int n = tid >> 3, kc = tid & 7; const float* s = tile + (kc * 8) * 65 + n;
        uint4 o; o.x = pk2(s[0], s[65]); o.y = pk2(s[2 * 65], s[3 * 65]); o.z = pk2(s[4 * 65], s[5 * 65]); o.w = pk2(s[6 * 65], s[7 * 65]);
        *(uint4*)(WT + (size_t)(n0 + n) * 1024 + k0 + kc * 8) = o;
      }
      __syncthreads();
    }
  }
}

__device__ void norm_mod_phase(const float* __restrict__ xsrc, const float* __restrict__ gain, const float* __restrict__ mod_sh, const float* __restrict__ mod_sc,
                               bf16_t* __restrict__ outp) {
  const int tidx = launder_tid();
  const int lane = tidx & 63, gw = blockIdx.x * NW + (tidx >> 6), nw = gridDim.x * NW;
  for (int t = gw; t < T_; t += nw) {
    const int b = t >> 13;
    const f32x4* xr = (const f32x4*)(xsrc + (size_t)t * 1024) + lane;
    f32x4 v[4]; float s = 0.f;
#pragma unroll
    for (int j = 0; j < 4; ++j) { v[j] = xr[64 * j]; s += v[j].x * v[j].x + v[j].y * v[j].y + v[j].z * v[j].z + v[j].w * v[j].w; }
    const float rstd = rsqrtf(wave_sum(s) * (1.f / 1024.f) + EPS_);
#pragma unroll
    for (int j = 0; j < 4; ++j) {
      const int c = lane * 4 + 256 * j;
      const f32x4 g = *(const f32x4*)(gain + c), sh = *(const f32x4*)(mod_sh + b * 6144 + c), sc = *(const f32x4*)(mod_sc + b * 6144 + c);
      const float o0 = v[j].x * rstd * g.x * (1.f + sc.x) + sh.x, o1 = v[j].y * rstd * g.y * (1.f + sc.y) + sh.y;
      const float o2 = v[j].z * rstd * g.z * (1.f + sc.z) + sh.z, o3 = v[j].w * rstd * g.w * (1.f + sc.w) + sh.w;
      uint2 o; o.x = pk2(o0, o1); o.y = pk2(o2, o3);
      *(uint2*)(outp + (size_t)t * 1024 + c) = o;
    }
  }
}


namespace pg8 {
#define PG8_LAS __attribute__((address_space(3)))
typedef unsigned u32x4 __attribute__((ext_vector_type(4)));
constexpr int BM = 256, BK = 64, HALF = 128, HTB = HALF * BK * 2, STAGE_BYTES = 8 * HTB, NXCD = 8, WGM = 8;
__host__ __device__ __forceinline__ int lds_byte(int r, int c) { const int st = (r >> 4) * 2 + (c >> 5), rr = r & 15, cc = c & 31, ob = rr * 64 + cc * 2; return st * 1024 + (ob ^ (((ob >> 9) & 1) << 5)); }
__host__ __device__ __forceinline__ void stage_rc(int b, int& R, int& C) { const int st = b / 1024, sb = b % 1024, swz = sb ^ (((sb >> 9) & 1) << 5); R = (st >> 1) * 16 + swz / 64; C = (st & 1) * 32 + (swz % 64) / 2; }
__host__ __device__ __forceinline__ int perm32(int rho) { const int n = rho >> 4, i = rho & 15; return 8 * (i >> 2) + 4 * n + (i & 3); }
struct Unit { int pm, pn; };
struct Gemm { const bf16_t* A; const bf16_t* Bt; int M, N, K; };
struct StaticOrder {
    int nM, nN, nwg, G, c;
    __host__ __device__ void init(int M, int N, int G_, int c_) { nM = M / BM; nN = N / BM; nwg = nM * nN; G = G_; c = c_; }
    __host__ __device__ bool next(int i, Unit& u) const {
        const long L = (long)i * G + c; if (L >= nwg) return false;
        int wgid = (int)L; { const int q = nwg / NXCD, r = nwg % NXCD, xcd = wgid % NXCD, off = wgid / NXCD; wgid = (xcd < r ? xcd * (q + 1) : r * (q + 1) + (xcd - r) * q) + off; }
        const int nig = WGM * nN, gid = wgid / nig, fm = gid * WGM, gsz = (nM - fm) < WGM ? (nM - fm) : WGM;
        u.pm = fm + ((wgid % nig) % gsz); u.pn = (wgid % nig) / gsz; return true;
    }
    __device__ __forceinline__ void a_ready(const Unit&) const {}
    __device__ __forceinline__ void done(const Unit&) const {}
};
__device__ __forceinline__ unsigned cvt_pk_bf16(float lo, float hi) { unsigned r; asm volatile("v_cvt_pk_bf16_f32 %0, %1, %2" : "=v"(r) : "v"(lo), "v"(hi)); return r; }
template <class Epi, class Sched>
__device__ __forceinline__ void gemm_phase(PG8_LAS unsigned char* lds, const Gemm g, const Sched& S, const Epi& E) {
    const int tid = launder_tid(), wid = __builtin_amdgcn_readfirstlane(tid >> 6), lane = tid & 63, wr = wid >> 2, wc = wid & 3, fr = lane & 15, fq = lane >> 4;
    const int K = g.K, nt = K / BK;
    unsigned voffA[2], voffB[2];
#pragma unroll
    for (int i = 0; i < 2; ++i) { int R, C; stage_rc(tid * 16 + i * 8192, R, C); const int Rb = Epi::PERM ? ((R & ~31) + perm32(R & 31)) : R;
        voffA[i] = (unsigned)(R * K + C) * 2u; voffB[i] = (unsigned)(Rb * K + C) * 2u; }
    const size_t kstep = (size_t)(BK * 2);
    const size_t hstep = (size_t)HALF * K * 2;
    const size_t tstep = 2 * hstep;
    const unsigned ldsw = (unsigned)wid * 1024u;
    const int aoff = lds_byte(wr * 64 + fr, fq * 8), boff = lds_byte(wc * 32 + fr, fq * 8);
#define PG8_SA(b, h) (((b) * 2 + (h)) * HTB)
#define PG8_SB(b, h) ((4 + (b) * 2 + (h)) * HTB)
#define PG8_STAGE(bufoff, gbase, voff) do { _Pragma("unroll") for (int _i = 0; _i < 2; ++_i) \
        __builtin_amdgcn_global_load_lds((const unsigned*)((const char*)(gbase) + (voff)[_i]), (PG8_LAS unsigned*)(lds + (bufoff) + ldsw + _i * 8192), 16, 0, 0); } while (0)
#define PG8_LDA(dst, b, h) do { _Pragma("unroll") for (int m = 0; m < 4; ++m) _Pragma("unroll") for (int k = 0; k < 2; ++k) dst[m][k] = *(const PG8_LAS bf16x8*)(lds + PG8_SA(b, h) + aoff + m * 2048 + k * 1024); } while (0)
#define PG8_LDB(dst, b, h) do { _Pragma("unroll") for (int n = 0; n < 2; ++n) _Pragma("unroll") for (int k = 0; k < 2; ++k) dst[n][k] = *(const PG8_LAS bf16x8*)(lds + PG8_SB(b, h) + boff + n * 2048 + k * 1024); } while (0)
#define PG8_MMA(ai, bj, At, Bt) do { __builtin_amdgcn_s_setprio(1); _Pragma("unroll") for (int m = 0; m < 4; ++m) _Pragma("unroll") for (int n = 0; n < 2; ++n) _Pragma("unroll") for (int k = 0; k < 2; ++k) \
        acc[ai][bj][m][n] = __builtin_amdgcn_mfma_f32_16x16x32_bf16(Bt[n][k], At[m][k], acc[ai][bj][m][n], 0, 0, 0); __builtin_amdgcn_s_setprio(0); } while (0)
#define PG8_WAIT_V(n) asm volatile("s_waitcnt vmcnt(" #n ")" ::: "memory")
#define PG8_WAIT_L(n) asm volatile("s_waitcnt lgkmcnt(" #n ")" ::: "memory")
#define PG8_BAR __builtin_amdgcn_s_barrier()
#define PG8_SCHED __builtin_amdgcn_sched_barrier(0)
    Unit cur, nxt; int ui = 0;
    if (!S.next(0, cur)) return;
    f32x4 acc[2][2][4][2];
#pragma unroll
    for (int a = 0; a < 2; ++a)
#pragma unroll
        for (int b = 0; b < 2; ++b)
#pragma unroll
            for (int m = 0; m < 4; ++m)
#pragma unroll
                for (int n = 0; n < 2; ++n) acc[a][b][m][n] = (f32x4){0.f, 0.f, 0.f, 0.f};
    bf16x8 At[4][2], B0[2][2], B1[2][2];
    const char* cA = (const char*)g.A + (size_t)cur.pm * tstep; const char* cB = (const char*)g.Bt + (size_t)cur.pn * tstep;
    S.a_ready(cur);
    PG8_STAGE(PG8_SB(0, 0), cB, voffB); PG8_STAGE(PG8_SA(0, 0), cA, voffA); PG8_STAGE(PG8_SB(0, 1), cB + hstep, voffB); PG8_STAGE(PG8_SA(0, 1), cA + hstep, voffA);
    if (wr == 1) PG8_BAR;
    PG8_WAIT_V(4); PG8_BAR;
    PG8_STAGE(PG8_SB(1, 0), cB + kstep, voffB); PG8_STAGE(PG8_SA(1, 0), cA + kstep, voffA); PG8_STAGE(PG8_SB(1, 1), cB + hstep + kstep, voffB);
    PG8_WAIT_V(6); PG8_BAR;
    for (;;) {
        const bool has_next = S.next(ui + 1, nxt);
        const char* nA = has_next ? (const char*)g.A + (size_t)nxt.pm * tstep : cA; const char* nB = has_next ? (const char*)g.Bt + (size_t)nxt.pn * tstep : cB;
        for (int t = 0; t < nt; t += 2) {
            const bool last = (t == nt - 2);
            const char* a1 = cA + (size_t)(t + 1) * kstep;
            const char* a2 = last ? nA : cA + (size_t)(t + 2) * kstep; const char* b2 = last ? nB : cB + (size_t)(t + 2) * kstep;
            const char* a3 = a2 + kstep; const char* b3 = b2 + kstep;
            if (last && has_next) S.a_ready(nxt);
            PG8_LDB(B0, 0, 0); PG8_SCHED; PG8_LDA(At, 0, 0); PG8_STAGE(PG8_SA(1, 1), a1 + hstep, voffA);
            PG8_WAIT_L(8); PG8_BAR; PG8_WAIT_L(0); PG8_MMA(0, 0, At, B0); PG8_BAR; PG8_SCHED;
            PG8_LDB(B1, 0, 1); PG8_STAGE(PG8_SB(0, 0), b2, voffB);
            PG8_BAR; PG8_WAIT_L(0); PG8_MMA(0, 1, At, B1); PG8_BAR;
            PG8_LDA(At, 0, 1); PG8_STAGE(PG8_SA(0, 0), a2, voffA);
            PG8_BAR; PG8_WAIT_L(0); PG8_MMA(1, 0, At, B0); PG8_BAR; PG8_SCHED;
            PG8_STAGE(PG8_SB(0, 1), b2 + hstep, voffB);
            PG8_WAIT_V(6); PG8_BAR; PG8_MMA(1, 1, At, B1); PG8_BAR;
            PG8_LDB(B0, 1, 0); PG8_SCHED; PG8_LDA(At, 1, 0); PG8_STAGE(PG8_SA(0, 1), a2 + hstep, voffA);
            PG8_WAIT_L(8); PG8_BAR; PG8_WAIT_L(0); PG8_MMA(0, 0, At, B0); PG8_BAR; PG8_SCHED;
            PG8_LDB(B1, 1, 1); PG8_STAGE(PG8_SB(1, 0), b3, voffB);
            PG8_BAR; PG8_WAIT_L(0); PG8_MMA(0, 1, At, B1); PG8_BAR;
            PG8_LDA(At, 1, 1); PG8_STAGE(PG8_SA(1, 0), a3, voffA);
            PG8_BAR; PG8_WAIT_L(0); PG8_MMA(1, 0, At, B0); PG8_BAR; PG8_SCHED;
            PG8_STAGE(PG8_SB(1, 1), b3 + hstep, voffB);
            PG8_WAIT_V(6); PG8_BAR; PG8_MMA(1, 1, At, B1); PG8_BAR;
        }
        if constexpr (!Epi::AFTER_DRAIN) { E(acc, cur, wr, wc, fr, fq); S.done(cur); }
        if (!has_next) break;
#pragma unroll
        for (int a = 0; a < 2; ++a)
#pragma unroll
            for (int b = 0; b < 2; ++b)
#pragma unroll
                for (int m = 0; m < 4; ++m)
#pragma unroll
                    for (int n = 0; n < 2; ++n) acc[a][b][m][n] = (f32x4){0.f, 0.f, 0.f, 0.f};
        cur = nxt; cA = nA; cB = nB; ++ui;
    }
    PG8_WAIT_V(0);
    if (wr == 0) PG8_BAR;
    PG8_BAR;
    if constexpr (Epi::AFTER_DRAIN) { E.fused(acc, cur, wr, wc, fr, fq, lds, wid, lane); S.done(cur); }
#undef PG8_SA
#undef PG8_SB
#undef PG8_STAGE
#undef PG8_LDA
#undef PG8_LDB
#undef PG8_MMA
#undef PG8_WAIT_V
#undef PG8_WAIT_L
#undef PG8_BAR
#undef PG8_SCHED
}
}

struct EpiProj {
  static constexpr bool PERM = true, AFTER_DRAIN = false;
  bf16_t* PROJ; bf16_t* VTA; bf16_t* VTR;
  __device__ __forceinline__ void operator()(const f32x4 (&acc)[2][2][4][2], const pg8::Unit& u, int wr, int wc, int fr, int fq) const {
    const int row0 = u.pm * 256 + wr * 64 + fr, col0 = u.pn * 256 + wc * 32 + 8 * fq;
#pragma unroll
    for (int ai = 0; ai < 2; ++ai)
#pragma unroll
      for (int m = 0; m < 4; ++m) {
        const int t = row0 + ai * 128 + m * 16;
#pragma unroll
        for (int bj = 0; bj < 2; ++bj) {
          const int c = col0 + bj * 128;
          const f32x4 v0 = acc[ai][bj][m][0], v1 = acc[ai][bj][m][1];
          pg8::u32x4 w; w.x = pg8::cvt_pk_bf16(v0[0], v0[1]); w.y = pg8::cvt_pk_bf16(v0[2], v0[3]); w.z = pg8::cvt_pk_bf16(v1[0], v1[1]); w.w = pg8::cvt_pk_bf16(v1[2], v1[3]);
          *(pg8::u32x4*)(PROJ + (size_t)t * INCP + c) = w;
          const bool isva = (c >= C_VA && c < C_VA + 384), isvr = (c >= C_VR && c < C_VR + 384);
          if (isva || isvr) {
            bf16_t* vt = (isva ? VTA : VTR) + ((size_t)(t >> 13) * 384 + (c - (isva ? C_VA : C_VR))) * 8192 + (t & 8191);
            vt[0] = (bf16_t)(w.x & 0xffffu); vt[8192] = (bf16_t)(w.x >> 16); vt[2 * 8192] = (bf16_t)(w.y & 0xffffu); vt[3 * 8192] = (bf16_t)(w.y >> 16);
            vt[4 * 8192] = (bf16_t)(w.z & 0xffffu); vt[5 * 8192] = (bf16_t)(w.z >> 16); vt[6 * 8192] = (bf16_t)(w.w & 0xffffu); vt[7 * 8192] = (bf16_t)(w.w >> 16);
          }
        }
      }
  }
};
struct EpiOut {
  static constexpr bool PERM = false, AFTER_DRAIN = false;
  const float* xsrc; float* X; const float* g1;
  __device__ __forceinline__ void operator()(const f32x4 (&acc)[2][2][4][2], const pg8::Unit& u, int wr, int wc, int fr, int fq) const {
    const int row0 = u.pm * 256 + wr * 64 + fr, col0 = u.pn * 256 + wc * 32 + 4 * fq;
#pragma unroll
    for (int ai = 0; ai < 2; ++ai)
#pragma unroll
      for (int m = 0; m < 4; ++m) {
        const int t = row0 + ai * 128 + m * 16, b = t >> 13;
#pragma unroll
        for (int bj = 0; bj < 2; ++bj)
#pragma unroll
          for (int n = 0; n < 2; ++n) {
            const int c = col0 + bj * 128 + n * 16;
            const f32x4 xv = *(const f32x4*)(xsrc + (size_t)t * 1024 + c), g = *(const f32x4*)(g1 + b * 6144 + c);
            *(f32x4*)(X + (size_t)t * 1024 + c) = xv + g * acc[ai][bj][m][n];
          }
      }
  }
};
struct EpiQ {
  static constexpr bool PERM = true, AFTER_DRAIN = false;
  bf16_t* Q;
  __device__ __forceinline__ void operator()(const f32x4 (&acc)[2][2][4][2], const pg8::Unit& u, int wr, int wc, int fr, int fq) const {
    const int row0 = u.pm * 256 + wr * 64 + fr, col0 = u.pn * 256 + wc * 32 + 8 * fq;
#pragma unroll
    for (int ai = 0; ai < 2; ++ai)
#pragma unroll
      for (int m = 0; m < 4; ++m) {
        const int t = row0 + ai * 128 + m * 16;
#pragma unroll
        for (int bj = 0; bj < 2; ++bj) {
          const f32x4 v0 = acc[ai][bj][m][0], v1 = acc[ai][bj][m][1];
          pg8::u32x4 w; w.x = pg8::cvt_pk_bf16(v0[0], v0[1]); w.y = pg8::cvt_pk_bf16(v0[2], v0[3]); w.z = pg8::cvt_pk_bf16(v1[0], v1[1]); w.w = pg8::cvt_pk_bf16(v1[2], v1[3]);
          *(pg8::u32x4*)(Q + (size_t)t * 2048 + col0 + bj * 128) = w;
        }
      }
  }
};

__device__ void gemm_proj_phase(const Params& p, int l, unsigned char* smem) {
  const CParamsP pp = launder_kargs();
  GAS unsigned char* const ws = launder_ptr(pp->ws);
  pg8::Gemm g; g.A = (const bf16_t*)(ws + WS_ABUF); g.Bt = (const bf16_t*)(ws + WS_WIN) + (size_t)l * INCP * 1024; g.M = T_; g.N = INCP; g.K = 1024;
  pg8::StaticOrder S; S.init(T_, INCP, gridDim.x, blockIdx.x);
  EpiProj E; E.PROJ = (bf16_t*)(ws + WS_PROJ); E.VTA = (bf16_t*)(ws + WS_VTA); E.VTR = (bf16_t*)(ws + WS_VTR);
  pg8::gemm_phase<EpiProj, pg8::StaticOrder>((PG8_LAS unsigned char*)smem, g, S, E);
}
__device__ void gemm_out_phase(const Params& p, int l, const float* __restrict__ xsrc, unsigned char* smem) {
  const CParamsP pp = launder_kargs();
  GAS unsigned char* const ws = launder_ptr(pp->ws);
  pg8::Gemm g; g.A = (const bf16_t*)(ws + WS_ABUF); g.Bt = (const bf16_t*)(ws + WS_WOUT) + (size_t)l * 1024 * 1024; g.M = T_; g.N = 1024; g.K = 1024;
  pg8::StaticOrder S; S.init(T_, 1024, gridDim.x, blockIdx.x);
  EpiOut E; E.xsrc = xsrc; E.X = (float*)(ws + WS_X); E.g1 = (const float*)(ws + WS_MOD) + (size_t)l * 2 * 6144 + 2048;
  pg8::gemm_phase<EpiOut, pg8::StaticOrder>((PG8_LAS unsigned char*)smem, g, S, E);
}
__device__ void gemm_q_phase(const Params& p, int l, unsigned char* smem) {
  const CParamsP pp = launder_kargs();
  GAS unsigned char* const ws = launder_ptr(pp->ws);
  pg8::Gemm g; g.A = (const bf16_t*)(ws + WS_ABUF); g.Bt = (const bf16_t*)(ws + WS_WQ) + (size_t)l * 2048 * 1024; g.M = T_; g.N = 2048; g.K = 1024;
  pg8::StaticOrder S; S.init(T_, 2048, gridDim.x, blockIdx.x);
  EpiQ E; E.Q = (bf16_t*)(ws + WS_Q);
  pg8::gemm_phase<EpiQ, pg8::StaticOrder>((PG8_LAS unsigned char*)smem, g, S, E);
}

struct AttnFrags { bf16x8 k[2][2][2]; bf16x8 v[2][4]; };
__device__ __forceinline__ void attn_load(AttnFrags& f, const bf16_t* __restrict__ PROJ, const bf16_t* __restrict__ VTA, int tk, int b, int h, int lk, int fr, int fq) {
#pragma unroll
  for (int g = 0; g < 2; ++g) {
#pragma unroll
    for (int tt = 0; tt < 2; ++tt) {
      const int key = tk + 32 * g + 8 * (fr >> 2) + (fr & 3) + 4 * tt;
      const bf16_t* kp = PROJ + (size_t)key * INCP + C_KA + h * 64 + fq * 8;
      f.k[g][tt][0] = *(const bf16x8*)kp; f.k[g][tt][1] = *(const bf16x8*)(kp + 32);
    }
#pragma unroll
    for (int et = 0; et < 4; ++et) f.v[g][et] = *(const bf16x8*)(VTA + ((size_t)b * 384 + h * 64 + et * 16 + fr) * 8192 + lk + 32 * g + 8 * fq);
  }
}
__device__ void attn_phase(const Params& p, int l, unsigned char* smem) {
  const CParamsP pp = launder_kargs();
  GAS unsigned char* const ws = launder_ptr(pp->ws); const int tidx = launder_tid();
  const bf16_t* PROJ = (const bf16_t*)(ws + WS_PROJ); const bf16_t* VTA = (const bf16_t*)(ws + WS_VTA);
  float* ATT = (float*)(ws + WS_ATT);
  const int lane = tidx & 63, wid = tidx >> 6, fr = lane & 15, fq = lane >> 4;
  float* ext = (float*)smem;
  constexpr float LOG2E = 1.4426950408889634f;
  __syncthreads();
  for (int idx = tidx; idx < 6 * 640; idx += NT) {
    const int h = idx / 640, e = idx - h * 640; int d = e - 63; d = d > 256 ? 256 : d;
    ext[idx] = gin(pp->in[I_RELB])[((size_t)l * 6 + h) * 513 + d + 256] * LOG2E;
  }
  __syncthreads();
  for (int item = blockIdx.x; item < 256; item += gridDim.x) {
    const int b = item >> 7, n = item & 127, t0 = b * 8192 + n * 64;
    const int jc0 = n >= 8 ? 0 : 8 - n;
#pragma unroll 1
    for (int k3 = 0; k3 < 3; ++k3) {
      const int task = k3 * 8 + wid, h = task >> 2, qb = task & 3;
      const int iq = qb * 16 + fr;
      const float* exth = ext + h * 640 + 63 + 512 + iq - 8 * fq;
      bf16x8 qf[2];
#pragma unroll
      for (int ds = 0; ds < 2; ++ds) qf[ds] = *(const bf16x8*)(PROJ + (size_t)(t0 + iq) * INCP + C_QA + h * 64 + ds * 32 + fq * 8);
      f32x4 o[4];
#pragma unroll
      for (int et = 0; et < 4; ++et) o[et] = (f32x4){0.f, 0.f, 0.f, 0.f};
      float mrun = -1e30f, lrun = 0.f;
      AttnFrags cur, nxt;
      attn_load(cur, PROJ, VTA, b * 8192 + (n - 8 + jc0) * 64, b, h, (n - 8 + jc0) * 64, fr, fq);
#pragma unroll 1
      for (int jc = jc0; jc < 9; ++jc) {
        if (jc < 8) attn_load(nxt, PROJ, VTA, b * 8192 + (n - 7 + jc) * 64, b, h, (n - 7 + jc) * 64, fr, fq);
        float sc[2][2][4];
#pragma unroll
        for (int g = 0; g < 2; ++g)
#pragma unroll
          for (int tt = 0; tt < 2; ++tt) {
            f32x4 st = __builtin_amdgcn_mfma_f32_16x16x32_bf16(cur.k[g][tt][0], qf[0], (f32x4){0.f, 0.f, 0.f, 0.f}, 0, 0, 0);
            st = __builtin_amdgcn_mfma_f32_16x16x32_bf16(cur.k[g][tt][1], qf[1], st, 0, 0, 0);
#pragma unroll
            for (int j = 0; j < 4; ++j) sc[g][tt][j] = st[j] * (0.125f * LOG2E) + exth[-(64 * jc + 32 * g + 4 * tt + j)];
          }
        float mloc = -1e30f;
#pragma unroll
        for (int g = 0; g < 2; ++g)
#pragma unroll
          for (int tt = 0; tt < 2; ++tt)
#pragma unroll
            for (int j = 0; j < 4; ++j) mloc = fmaxf(mloc, sc[g][tt][j]);
        mloc = fmaxf(mloc, __shfl_xor(mloc, 16)); mloc = fmaxf(mloc, __shfl_xor(mloc, 32));
        const float mnew = fmaxf(mrun, mloc), alpha = __builtin_amdgcn_exp2f(mrun - mnew);
        mrun = mnew;
        float ls = 0.f;
#pragma unroll
        for (int g = 0; g < 2; ++g)
#pragma unroll
          for (int tt = 0; tt < 2; ++tt)
#pragma unroll
            for (int j = 0; j < 4; ++j) { const float e = __builtin_amdgcn_exp2f(sc[g][tt][j] - mnew); sc[g][tt][j] = e; ls += e; }
        lrun = lrun * alpha + ls;
#pragma unroll
        for (int et = 0; et < 4; ++et) { o[et].x *= alpha; o[et].y *= alpha; o[et].z *= alpha; o[et].w *= alpha; }
#pragma unroll
        for (int g = 0; g < 2; ++g) {
          union { bf16x8 v; unsigned u[4]; } pf;
          pf.u[0] = pk2(sc[g][0][0], sc[g][0][1]); pf.u[1] = pk2(sc[g][0][2], sc[g][0][3]);
          pf.u[2] = pk2(sc[g][1][0], sc[g][1][1]); pf.u[3] = pk2(sc[g][1][2], sc[g][1][3]);
#pragma unroll
          for (int et = 0; et < 4; ++et) o[et] = __builtin_amdgcn_mfma_f32_16x16x32_bf16(cur.v[g][et], pf.v, o[et], 0, 0, 0);
        }
        cur = nxt;
      }
      lrun += __shfl_xor(lrun, 16); lrun += __shfl_xor(lrun, 32);
      const float inv = 1.f / lrun;
#pragma unroll
      for (int et = 0; et < 4; ++et) {
        f32x4 v = o[et]; v.x *= inv; v.y *= inv; v.z *= inv; v.w *= inv;
        *(f32x4*)(ATT + (size_t)(t0 + iq) * 384 + h * 64 + et * 16 + fq * 4) = v;
      }
    }
  }
  __syncthreads();
}

__device__ __forceinline__ void rotary_frag(const bf16x8 x0, const bf16x8 x1, const float* __restrict__ RC, const float* __restrict__ RS, int pos, int fq, float scale, bf16x8& o0, bf16x8& o1) {
  const f32x4 c0 = *(const f32x4*)(RC + pos * 32 + 8 * fq), c1 = *(const f32x4*)(RC + pos * 32 + 8 * fq + 4);
  const f32x4 s0 = *(const f32x4*)(RS + pos * 32 + 8 * fq), s1 = *(const f32x4*)(RS + pos * 32 + 8 * fq + 4);
  const float cc[8] = {c0.x, c0.y, c0.z, c0.w, c1.x, c1.y, c1.z, c1.w}, sn[8] = {s0.x, s0.y, s0.z, s0.w, s1.x, s1.y, s1.z, s1.w};
  union { bf16x8 v; unsigned u[4]; } r0, r1;
#pragma unroll
  for (int q = 0; q < 4; ++q) {
    const float a0 = bf2f((bf16_t)x0[2 * q]) * scale, a1 = bf2f((bf16_t)x0[2 * q + 1]) * scale, b0 = bf2f((bf16_t)x1[2 * q]) * scale, b1 = bf2f((bf16_t)x1[2 * q + 1]) * scale;
    r0.u[q] = pk2(a0 * cc[2 * q] - b0 * sn[2 * q], a1 * cc[2 * q + 1] - b1 * sn[2 * q + 1]);
    r1.u[q] = pk2(a0 * sn[2 * q] + b0 * cc[2 * q], a1 * sn[2 * q + 1] + b1 * cc[2 * q + 1]);
  }
  o0 = r0.v; o1 = r1.v;
}
__device__ void mix_local_phase(const Params& p, int l, unsigned char* smem) {
  const CParamsP pp = launder_kargs();
  GAS unsigned char* const ws = launder_ptr(pp->ws); const int tidx = launder_tid();
  const bf16_t* PROJ = (const bf16_t*)(ws + WS_PROJ); const bf16_t* VTR = (const bf16_t*)(ws + WS_VTR);
  const float* RC = (const float*)(ws + WS_ROTC); const float* RS = (const float*)(ws + WS_ROTS);
  float* YINT = (float*)(ws + WS_YINT); float* UPDT = (float*)(ws + WS_UPD);
  const float* SA = (const float*)(ws + WS_SA) + (size_t)l * 16 * 64 * 2; const float* SBB = (const float*)(ws + WS_SBB) + (size_t)l * 16 * 64 * 32;
  float* SEND = (float*)(ws + WS_SEND);
  const int tid = tidx, lane = tid & 63, wid = tid >> 6, fr = lane & 15, fq = lane >> 4;
  bf16_t* KT = (bf16_t*)smem;
  float* uw = (float*)(smem + 55296 + wid * 4096);
  for (int item = blockIdx.x; item < 256; item += gridDim.x) {
    const int b = item >> 7, n = item & 127, t0 = b * 8192 + n * 64;
    __syncthreads();
#pragma unroll 1
    for (int k3 = 0; k3 < 3; ++k3) {
      const int task = wid * 3 + k3, h = task >> 2, tb = task & 3;
      const int i = 16 * tb + fr;
      const float lg2 = log2f(1.f - exp2f(-5.f - (float)h));
      bf16x8 qf0, qf1;
      {
        const bf16_t* qp = PROJ + (size_t)(t0 + i) * INCP + C_QR + h * 64 + 8 * fq;
        rotary_frag(*(const bf16x8*)qp, *(const bf16x8*)(qp + 32), RC, RS, n * 64 + i, fq, 1.f, qf0, qf1);
      }
      f32x4 o[4];
#pragma unroll
      for (int et = 0; et < 4; ++et) o[et] = (f32x4){0.f, 0.f, 0.f, 0.f};
#pragma unroll
      for (int g = 0; g < 2; ++g) {
        float st[2][4];
#pragma unroll
        for (int tt = 0; tt < 2; ++tt) {
          const int key = 32 * g + 8 * (fr >> 2) + (fr & 3) + 4 * tt;
          const bf16_t* kp = PROJ + (size_t)(t0 + key) * INCP + C_KR + h * 64 + 8 * fq;
          bf16x8 kf0, kf1;
          rotary_frag(*(const bf16x8*)kp, *(const bf16x8*)(kp + 32), RC, RS, n * 64 + key, fq, 0.125f, kf0, kf1);
          f32x4 s4 = __builtin_amdgcn_mfma_f32_16x16x32_bf16(kf0, qf0, (f32x4){0.f, 0.f, 0.f, 0.f}, 0, 0, 0);
          s4 = __builtin_amdgcn_mfma_f32_16x16x32_bf16(kf1, qf1, s4, 0, 0, 0);
#pragma unroll
          for (int j = 0; j < 4; ++j) {
            const int kk = 32 * g + 8 * fq + 4 * tt + j;
            const int dij = i > kk ? i - kk : kk - i;
            st[tt][j] = s4[j] * exp2f(lg2 * (float)dij);
          }
          if (tb == 0) {
            const float kd = exp2f(lg2 * (float)(63 - key));
#pragma unroll
            for (int jj = 0; jj < 8; ++jj) {
              KT[(h * 64 + 8 * fq + jj) * 72 + key] = f2bf(bf2f((bf16_t)kf0[jj]) * kd);
              KT[(h * 64 + 32 + 8 * fq + jj) * 72 + key] = f2bf(bf2f((bf16_t)kf1[jj]) * kd);
            }
          }
        }
        union { bf16x8 v; unsigned u[4]; } pf;
        pf.u[0] = pk2(st[0][0], st[0][1]); pf.u[1] = pk2(st[0][2], st[0][3]); pf.u[2] = pk2(st[1][0], st[1][1]); pf.u[3] = pk2(st[1][2], st[1][3]);
#pragma unroll
        for (int et = 0; et < 4; ++et) {
          const bf16x8 vf = *(const bf16x8*)(VTR + ((size_t)b * 384 + h * 64 + et * 16 + fr) * 8192 + n * 64 + 32 * g + 8 * fq);
          o[et] = __builtin_amdgcn_mfma_f32_16x16x32_bf16(vf, pf.v, o[et], 0, 0, 0);
        }
      }
#pragma unroll
      for (int et = 0; et < 4; ++et) *(f32x4*)(YINT + (size_t)(t0 + i) * 384 + h * 64 + et * 16 + fq * 4) = o[et];
    }
    __syncthreads();
#pragma unroll 1
    for (int k3 = 0; k3 < 3; ++k3) {
      const int task = wid * 3 + k3, h = task >> 2, et = task & 3;
      f32x4 acc[4];
#pragma unroll
      for (int dt = 0; dt < 4; ++dt) acc[dt] = (f32x4){0.f, 0.f, 0.f, 0.f};
#pragma unroll
      for (int g = 0; g < 2; ++g) {
        const bf16x8 vf = *(const bf16x8*)(VTR + ((size_t)b * 384 + h * 64 + et * 16 + fr) * 8192 + n * 64 + 32 * g + 8 * fq);
#pragma unroll
        for (int dt = 0; dt < 4; ++dt) {
          const bf16x8 kt = *(const bf16x8*)(KT + (h * 64 + 16 * dt + fr) * 72 + 32 * g + 8 * fq);
          acc[dt] = __builtin_amdgcn_mfma_f32_16x16x32_bf16(kt, vf, acc[dt], 0, 0, 0);
        }
      }
#pragma unroll
      for (int dt = 0; dt < 4; ++dt) *(f32x4*)(UPDT + (((size_t)item * 6 + h) * 64 + 16 * et + fr) * 64 + 16 * dt + 4 * fq) = acc[dt];
    }
#pragma unroll 1
    for (int gi = 0; gi < 2; ++gi) {
      const int g = wid * 2 + gi;
#pragma unroll 4
      for (int r = 0; r < 16; ++r) { const int idx = lane + 64 * r, i = idx >> 4, c = idx & 15; uw[idx] = bf2f(PROJ[(size_t)(t0 + i) * INCP + C_US + g * 16 + c]); }
      float bbr[16], bbi[16];
      const float* bbp = SBB + ((size_t)g * 64 + lane) * 32;
#pragma unroll
      for (int c = 0; c < 16; ++c) { bbr[c] = bbp[c]; bbi[c] = bbp[16 + c]; }
      const float are = SA[(g * 64 + lane) * 2], aim = SA[(g * 64 + lane) * 2 + 1];
      float xr = 0.f, xi = 0.f;
#pragma unroll 2
      for (int i = 0; i < 64; ++i) {
        float br = 0.f, bi = 0.f;
#pragma unroll
        for (int c = 0; c < 16; ++c) { const float u = uw[i * 16 + c]; br += bbr[c] * u; bi += bbi[c] * u; }
        const float nr = are * xr - aim * xi + br, ni = are * xi + aim * xr + bi;
        xr = nr; xi = ni;
      }
      SEND[(((size_t)item * 16 + g) * 64 + lane) * 2] = xr; SEND[(((size_t)item * 16 + g) * 64 + lane) * 2 + 1] = xi;
    }
  }
}

__device__ void scan_phase(const Params& p, int l) {
  const CParamsP pp = launder_kargs();
  GAS unsigned char* const ws = launder_ptr(pp->ws); const int tidx = launder_tid();
  const float* __restrict__ UPDT = (const float*)(ws + WS_UPD); bf16_t* __restrict__ SPT = (bf16_t*)(ws + WS_SPT);
  const float* __restrict__ SEND = (const float*)(ws + WS_SEND); float* __restrict__ CARRY = (float*)(ws + WS_CARRY);
  const float* SA = (const float*)(ws + WS_SA) + (size_t)l * 16 * 64 * 2;
  const int gtid = blockIdx.x * NT + tidx, gn = gridDim.x * NT;
  for (int idx = gtid; idx < 2 * 6 * 4096 + 2 * 1024; idx += gn) {
    if (idx < 2 * 6 * 4096) {
      const int b = idx / (6 * 4096), r = idx % (6 * 4096), h = r >> 12;
      const float cd = exp2f(64.f * log2f(1.f - exp2f(-5.f - (float)h)));
      float s = 0.f;
#pragma unroll 1
      for (int nb = 0; nb < NCH; nb += 16) {
        float v[16];
#pragma unroll
        for (int j = 0; j < 16; ++j) v[j] = UPDT[((size_t)(b * NCH + nb + j)) * 6 * 4096 + r];
#pragma unroll
        for (int j = 0; j < 16; ++j) { SPT[((size_t)(b * NCH + nb + j)) * 6 * 4096 + r] = f2bf(s); s = cd * s + v[j]; }
      }
    } else {
      const int r2 = idx - 2 * 6 * 4096, b = r2 >> 10, gp = r2 & 1023;
      float ar = SA[gp * 2], ai = SA[gp * 2 + 1];
#pragma unroll
      for (int q = 0; q < 6; ++q) { const float nr = ar * ar - ai * ai, ni = 2.f * ar * ai; ar = nr; ai = ni; }
      float xr = 0.f, xi = 0.f;
#pragma unroll 1
      for (int nb = 0; nb < NCH; nb += 16) {
        float2 v[16];
#pragma unroll
        for (int j = 0; j < 16; ++j) v[j] = *(const float2*)(SEND + (((size_t)(b * NCH + nb + j)) * 1024 + gp) * 2);
#pragma unroll
        for (int j = 0; j < 16; ++j) {
          *(float2*)(CARRY + (((size_t)(b * NCH + nb + j)) * 1024 + gp) * 2) = make_float2(xr, xi);
          const float nr = ar * xr - ai * xi + v[j].x, ni = ar * xi + ai * xr + v[j].y;
          xr = nr; xi = ni;
        }
      }
    }
  }
}

__device__ void mix_final_phase(const Params& p, int l, unsigned char* smem) {
  const CParamsP pp = launder_kargs();
  GAS unsigned char* const ws = launder_ptr(pp->ws); const int tidx = launder_tid();
  const bf16_t* PROJ = (const bf16_t*)(ws + WS_PROJ);
  const float* RC = (const float*)(ws + WS_ROTC); const float* RS = (const float*)(ws + WS_ROTS);
  const float* YINT = (const float*)(ws + WS_YINT); const bf16_t* SPT = (const bf16_t*)(ws + WS_SPT);
  const float* ATT = (const float*)(ws + WS_ATT);
  const float* SA = (const float*)(ws + WS_SA) + (size_t)l * 16 * 64 * 2; const float* SBB = (const float*)(ws + WS_SBB) + (size_t)l * 16 * 64 * 32;
  const float* CARRY = (const float*)(ws + WS_CARRY);
  const bf16_t* CB = (const bf16_t*)(ws + WS_CB) + (size_t)l * 16 * 16 * 128; const bf16_t* WG = (const bf16_t*)(ws + WS_WGLUT) + (size_t)l * 512 * 256;
  const float* dsk = gin(pp->in[I_SSMD]) + (size_t)l * 256;
  const float* mg = gin(pp->in[I_MGAIN]) + (size_t)l * 1024;
  bf16_t* MRG = (bf16_t*)(ws + WS_ABUF);
  const int tid = tidx, lane = tid & 63, wid = tid >> 6, fr = lane & 15, fq = lane >> 4;
  bf16_t* YS = (bf16_t*)smem;
  float* red = (float*)(smem + 33792);
  float* uw = (float*)(smem + 36864 + wid * 8448);
  bf16_t* XB = (bf16_t*)(smem + 36864 + wid * 8448 + 4096);
  for (int item = blockIdx.x; item < 256; item += gridDim.x) {
    const int b = item >> 7, n = item & 127, t0 = b * 8192 + n * 64;
    __syncthreads();
    for (int ii = 0; ii < 8; ++ii) {
      const int t = t0 + wid * 8 + ii;
      float v[6]; float sq = 0.f;
#pragma unroll
      for (int j = 0; j < 6; ++j) { v[j] = ATT[(size_t)t * 384 + lane + 64 * j]; sq += v[j] * v[j]; }
      const float rstd = rsqrtf(wave_sum(sq) * (1.f / 384.f) + EPS_);
#pragma unroll
      for (int j = 0; j < 6; ++j) MRG[(size_t)t * 1024 + lane + 64 * j] = f2bf(v[j] * rstd * mg[lane + 64 * j]);
    }
#pragma unroll 1
    for (int k3 = 0; k3 < 3; ++k3) {
      const int task = wid * 3 + k3, h = task >> 2, tb = task & 3;
      const int i = 16 * tb + fr, t = t0 + i;
      const float lg2 = log2f(1.f - exp2f(-5.f - (float)h));
      bf16x8 qf0, qf1;
      {
        const bf16_t* qp = PROJ + (size_t)t * INCP + C_QR + h * 64 + 8 * fq;
        rotary_frag(*(const bf16x8*)qp, *(const bf16x8*)(qp + 32), RC, RS, n * 64 + i, fq, 1.f, qf0, qf1);
      }
      f32x4 o[4];
#pragma unroll
      for (int et = 0; et < 4; ++et) {
        const bf16_t* sp = SPT + (((size_t)item * 6 + h) * 64 + 16 * et + fr) * 64 + 8 * fq;
        const bf16x8 a0 = *(const bf16x8*)sp, a1 = *(const bf16x8*)(sp + 32);
        o[et] = __builtin_amdgcn_mfma_f32_16x16x32_bf16(a0, qf0, (f32x4){0.f, 0.f, 0.f, 0.f}, 0, 0, 0);
        o[et] = __builtin_amdgcn_mfma_f32_16x16x32_bf16(a1, qf1, o[et], 0, 0, 0);
      }
      const float qd = exp2f(lg2 * (float)(i + 1));
      float y[16]; float s1 = 0.f;
#pragma unroll
      for (int et = 0; et < 4; ++et) {
        const f32x4 yi = *(const f32x4*)(YINT + (size_t)t * 384 + h * 64 + 16 * et + 4 * fq);
        y[4 * et] = yi.x + qd * o[et].x; y[4 * et + 1] = yi.y + qd * o[et].y; y[4 * et + 2] = yi.z + qd * o[et].z; y[4 * et + 3] = yi.w + qd * o[et].w;
        s1 += (y[4 * et] + y[4 * et + 1]) + (y[4 * et + 2] + y[4 * et + 3]);
      }
      s1 += __shfl_xor(s1, 16); s1 += __shfl_xor(s1, 32);
      const float mu = s1 * (1.f / 64.f);
      float s2 = 0.f;
#pragma unroll
      for (int q = 0; q < 16; ++q) { y[q] -= mu; s2 += y[q] * y[q]; }
      s2 += __shfl_xor(s2, 16); s2 += __shfl_xor(s2, 32);
      const float rstd = rsqrtf(s2 * (1.f / 64.f) + EPS_);
#pragma unroll
      for (int et = 0; et < 4; ++et) {
        const int c = h * 64 + 16 * et + 4 * fq;
        const uint2 gr = *(const uint2*)(PROJ + (size_t)t * INCP + C_GR + c);
        const float g0 = __uint_as_float(gr.x << 16), g1 = __uint_as_float(gr.x & 0xffff0000u), g2 = __uint_as_float(gr.y << 16), g3 = __uint_as_float(gr.y & 0xffff0000u);
        const f32x4 mgv = *(const f32x4*)(mg + 384 + c);
        uint2 ov;
        ov.x = pk2(y[4 * et] * rstd * (g0 * sigmoid_f(g0)) * mgv.x, y[4 * et + 1] * rstd * (g1 * sigmoid_f(g1)) * mgv.y);
        ov.y = pk2(y[4 * et + 2] * rstd * (g2 * sigmoid_f(g2)) * mgv.z, y[4 * et + 3] * rstd * (g3 * sigmoid_f(g3)) * mgv.w);
        *(uint2*)(MRG + (size_t)t * 1024 + 384 + c) = ov;
      }
    }
#pragma unroll 1
    for (int gi = 0; gi < 2; ++gi) {
      const int g = wid * 2 + gi;
#pragma unroll 4
      for (int r = 0; r < 16; ++r) { const int idx = lane + 64 * r, i = idx >> 4, c = idx & 15; uw[idx] = bf2f(PROJ[(size_t)(t0 + i) * INCP + C_US + g * 16 + c]); }
      float bbr[16], bbi[16];
      const float* bbp = SBB + ((size_t)g * 64 + lane) * 32;
#pragma unroll
      for (int c = 0; c < 16; ++c) { bbr[c] = bbp[c]; bbi[c] = bbp[16 + c]; }
      const float are = SA[(g * 64 + lane) * 2], aim = SA[(g * 64 + lane) * 2 + 1];
      float xr = CARRY[(((size_t)item * 16 + g) * 64 + lane) * 2], xi = CARRY[(((size_t)item * 16 + g) * 64 + lane) * 2 + 1];
      bf16x8 cb[4];
#pragma unroll
      for (int ks = 0; ks < 4; ++ks) cb[ks] = *(const bf16x8*)(CB + ((size_t)g * 16 + fr) * 128 + 32 * ks + 8 * fq);
      const float dv = dsk[g * 16 + fr];
#pragma unroll 1
      for (int tb = 0; tb < 4; ++tb) {
#pragma unroll 2
        for (int ii = 0; ii < 16; ++ii) {
          const int i = tb * 16 + ii;
          float br = 0.f, bi = 0.f;
#pragma unroll
          for (int c = 0; c < 16; ++c) { const float u = uw[i * 16 + c]; br += bbr[c] * u; bi += bbi[c] * u; }
          const float nr = are * xr - aim * xi + br, ni = are * xi + aim * xr + bi;
          xr = nr; xi = ni;
          XB[ii * 136 + lane] = f2bf(xr); XB[ii * 136 + 64 + lane] = f2bf(xi);
        }
        f32x4 acc = (f32x4){0.f, 0.f, 0.f, 0.f};
#pragma unroll
        for (int ks = 0; ks < 4; ++ks) {
          const bf16x8 af = *(const bf16x8*)(XB + fr * 136 + 32 * ks + 8 * fq);
          acc = __builtin_amdgcn_mfma_f32_16x16x32_bf16(af, cb[ks], acc, 0, 0, 0);
        }
#pragma unroll
        for (int j = 0; j < 4; ++j) {
          const int i = tb * 16 + 4 * fq + j;
          const float yv = acc[j] + dv * uw[i * 16 + fr];
          YS[i * 264 + g * 16 + fr] = f2bf(gelu_tanh(yv));
        }
      }
    }
    __syncthreads();
    {
      const int n0 = 32 * wid;
      f32x4 a1[4][2], a2[4][2];
#pragma unroll
      for (int mt = 0; mt < 4; ++mt)
#pragma unroll
        for (int nt = 0; nt < 2; ++nt) { a1[mt][nt] = (f32x4){0.f, 0.f, 0.f, 0.f}; a2[mt][nt] = (f32x4){0.f, 0.f, 0.f, 0.f}; }
#pragma unroll 2
      for (int ks = 0; ks < 8; ++ks) {
        bf16x8 w1[2], w2[2], yb[4];
#pragma unroll
        for (int nt = 0; nt < 2; ++nt) {
          w1[nt] = *(const bf16x8*)(WG + (size_t)(n0 + 16 * nt + fr) * 256 + 32 * ks + 8 * fq);
          w2[nt] = *(const bf16x8*)(WG + (size_t)(256 + n0 + 16 * nt + fr) * 256 + 32 * ks + 8 * fq);
        }
#pragma unroll
        for (int mt = 0; mt < 4; ++mt) yb[mt] = *(const bf16x8*)(YS + (16 * mt + fr) * 264 + 32 * ks + 8 * fq);
#pragma unroll
        for (int mt = 0; mt < 4; ++mt)
#pragma unroll
          for (int nt = 0; nt < 2; ++nt) {
            a1[mt][nt] = __builtin_amdgcn_mfma_f32_16x16x32_bf16(w1[nt], yb[mt], a1[mt][nt], 0, 0, 0);
            a2[mt][nt] = __builtin_amdgcn_mfma_f32_16x16x32_bf16(w2[nt], yb[mt], a2[mt][nt], 0, 0, 0);
          }
      }
#pragma unroll
      for (int mt = 0; mt < 4; ++mt) {
        float sq = 0.f;
#pragma unroll
        for (int nt = 0; nt < 2; ++nt) {
          f32x4 z = a1[mt][nt]; const f32x4 zg = a2[mt][nt];
          z.x *= sigmoid_f(zg.x); z.y *= sigmoid_f(zg.y); z.z *= sigmoid_f(zg.z); z.w *= sigmoid_f(zg.w);
          a1[mt][nt] = z; sq += z.x * z.x + z.y * z.y + z.z * z.z + z.w * z.w;
        }
        sq += __shfl_xor(sq, 16); sq += __shfl_xor(sq, 32);
        if (fq == 0) red[wid * 64 + 16 * mt + fr] = sq;
      }
      __syncthreads();
#pragma unroll
      for (int mt = 0; mt < 4; ++mt) {
        const int i = 16 * mt + fr, t = t0 + i;
        float tot = 0.f;
#pragma unroll
        for (int w8 = 0; w8 < 8; ++w8) tot += red[w8 * 64 + i];
        const float rstd = rsqrtf(tot * (1.f / 256.f) + EPS_);
#pragma unroll
        for (int nt = 0; nt < 2; ++nt) {
          const int c = n0 + 16 * nt + 4 * fq;
          const f32x4 mgv = *(const f32x4*)(mg + 768 + c); const f32x4 z = a1[mt][nt];
          uint2 ov; ov.x = pk2(z.x * rstd * mgv.x, z.y * rstd * mgv.y); ov.y = pk2(z.z * rstd * mgv.z, z.w * rstd * mgv.w);
          *(uint2*)(MRG + (size_t)t * 1024 + 768 + c) = ov;
        }
      }
    }
  }
}

typedef float f32x2 __attribute__((ext_vector_type(2)));
__device__ __forceinline__ float dot16_fp4(const uint2 u, const f32x2 (&hv)[8]) {
  f32x2 d = __builtin_amdgcn_cvt_scalef32_pk_f32_fp4(u.x, 1.0f, 0) * hv[0];
  d += __builtin_amdgcn_cvt_scalef32_pk_f32_fp4(u.x, 1.0f, 1) * hv[1];
  d += __builtin_amdgcn_cvt_scalef32_pk_f32_fp4(u.x, 1.0f, 2) * hv[2];
  d += __builtin_amdgcn_cvt_scalef32_pk_f32_fp4(u.x, 1.0f, 3) * hv[3];
  d += __builtin_amdgcn_cvt_scalef32_pk_f32_fp4(u.y, 1.0f, 0) * hv[4];
  d += __builtin_amdgcn_cvt_scalef32_pk_f32_fp4(u.y, 1.0f, 1) * hv[5];
  d += __builtin_amdgcn_cvt_scalef32_pk_f32_fp4(u.y, 1.0f, 2) * hv[6];
  d += __builtin_amdgcn_cvt_scalef32_pk_f32_fp4(u.y, 1.0f, 3) * hv[7];
  return d.x + d.y;
}
__device__ __forceinline__ void axpy16_fp4(const uint2 v, const float w, f32x2 (&acc)[8]) {
  const f32x2 w2 = (f32x2){w, w};
  acc[0] += w2 * __builtin_amdgcn_cvt_scalef32_pk_f32_fp4(v.x, 1.0f, 0);
  acc[1] += w2 * __builtin_amdgcn_cvt_scalef32_pk_f32_fp4(v.x, 1.0f, 1);
  acc[2] += w2 * __builtin_amdgcn_cvt_scalef32_pk_f32_fp4(v.x, 1.0f, 2);
  acc[3] += w2 * __builtin_amdgcn_cvt_scalef32_pk_f32_fp4(v.x, 1.0f, 3);
  acc[4] += w2 * __builtin_amdgcn_cvt_scalef32_pk_f32_fp4(v.y, 1.0f, 0);
  acc[5] += w2 * __builtin_amdgcn_cvt_scalef32_pk_f32_fp4(v.y, 1.0f, 1);
  acc[6] += w2 * __builtin_amdgcn_cvt_scalef32_pk_f32_fp4(v.y, 1.0f, 2);
  acc[7] += w2 * __builtin_amdgcn_cvt_scalef32_pk_f32_fp4(v.y, 1.0f, 3);
}
typedef float f32x16 __attribute__((ext_vector_type(16)));
__device__ __forceinline__ float vmaxf(float a, float b) { float r; asm("v_max_f32 %0, %1, %2" : "=v"(r) : "v"(a), "v"(b)); return r; }
__device__ __forceinline__ float vminf(float a, float b) { float r; asm("v_min_f32 %0, %1, %2" : "=v"(r) : "v"(a), "v"(b)); return r; }
__device__ __forceinline__ void cx(float& hi, float& lo) { const float a = hi, b = lo; hi = vmaxf(a, b); lo = vminf(a, b); }
__device__ __forceinline__ void cx2(float& kh, int& ph, float& kl, int& pl) {
  const float a = kh, b = kl; const int pa = ph, pb = pl; const bool c = a >= b;
  kh = vmaxf(a, b); kl = vminf(a, b); ph = c ? pa : pb; pl = c ? pb : pa;
}
__device__ __forceinline__ void bitonic_sort16_desc(float (&v)[16]) {
#pragma unroll
  for (int k = 2; k <= 16; k <<= 1)
#pragma unroll
    for (int j = k >> 1; j > 0; j >>= 1)
#pragma unroll
      for (int i = 0; i < 16; ++i) {
        const int l = i ^ j;
        if (l > i) { if ((i & k) == 0) cx(v[i], v[l]); else cx(v[l], v[i]); }
      }
}
__device__ __forceinline__ void bitonic_merge16_desc(float (&v)[16]) {
#pragma unroll
  for (int j = 8; j > 0; j >>= 1)
#pragma unroll
    for (int i = 0; i < 16; ++i) { const int l = i ^ j; if (l > i) cx(v[i], v[l]); }
}
__device__ __forceinline__ void top16_merge(float (&a)[16], const float (&b)[16]) {
#pragma unroll
  for (int i = 0; i < 16; ++i) a[i] = vmaxf(a[i], b[15 - i]);
  bitonic_merge16_desc(a);
}
template <int M> __device__ __forceinline__ void top16_merge_chain(float (&k)[16], int (&q)[16], const float (&xk)[M], const int (&xq)[M]) {
#pragma unroll
  for (int i = 16 - M; i < 16; ++i) { const float a = k[i], b = xk[15 - i]; const bool c = a >= b; k[i] = vmaxf(a, b); q[i] = c ? q[i] : xq[15 - i]; }
#pragma unroll
  for (int j = 8; j > 0; j >>= 1)
#pragma unroll
    for (int i = 0; i < 16; ++i) { const int l = i ^ j; if (l > i) cx2(k[i], q[i], k[l], q[l]); }
}

__device__ void peer_phase(const Params& p, int l, bool last, unsigned char* smem) {
  const CParamsP pp = launder_kargs();
  GAS unsigned char* const ws = launder_ptr(pp->ws); const int tidx = launder_tid();
  bf16_t* HF = (bf16_t*)(ws + WS_ABUF); float* X = (float*)(ws + WS_X);
  const bf16_t* Q = (const bf16_t*)(ws + WS_Q); const bf16_t* SK = (const bf16_t*)(ws + WS_SUBK) + (size_t)l * 16 * 128 * 128;
  const uint2* U4 = (const uint2*)(ws + WS_PU8) + (size_t)l * 16384 * 64; const uint2* V4 = (const uint2*)(ws + WS_PV8) + (size_t)l * 16384 * 64;
  const float* g2 = (const float*)(ws + WS_MOD) + (size_t)l * 2 * 6144 + 5120;
  const int ln = last ? l : l + 1;
  const float* nsh = (const float*)(ws + WS_MOD) + (size_t)ln * 2 * 6144; const float* nsc = nsh + 1024;
  const float* ngain = gin(pp->in[I_NMIX]) + (size_t)ln * 1024;
  const int lane = tidx & 63, wid = tidx >> 6;
  const int rL = ((lane >> 5) & 1) * 8 + ((lane >> 4) & 1) * 4 + ((lane >> 3) & 1) * 2 + ((lane >> 2) & 1);
  const bool hi5 = (lane & 32) != 0, hi4 = (lane & 16) != 0, hi3 = (lane & 8) != 0, hi2 = (lane & 4) != 0;
  int* idxL = (int*)smem; float* gateL = (float*)(smem + 64 * 132 * 4);
  for (int item = blockIdx.x; item < T_ / 64; item += gridDim.x) {
    const int t0 = item * 64;
    __syncthreads();
    {
      int lane_o = lane; asm volatile("" : "+v"(lane_o));
      const int tg = wid & 1, hp = wid >> 1, hf = lane_o >> 5, tl = 32 * tg + (lane_o & 31);
      const bf16_t* qrow = Q + (size_t)(t0 + tl) * 2048;
      float F[2][16];
#pragma unroll
      for (int sd = 0; sd < 2; ++sd) {
        float Lh[2][16];
#pragma unroll
        for (int hh = 0; hh < 2; ++hh) {
          const int hs = 2 * (2 * hp + hh) + sd;
          float top[16];
          const bf16_t* skb = SK + ((size_t)hs * 128 + (lane & 31)) * 128 + 8 * hf;
#pragma unroll
          for (int kp = 0; kp < 2; ++kp) {
            f32x16 acc[2];
#pragma unroll
            for (int kt = 0; kt < 2; ++kt)
#pragma unroll
              for (int r = 0; r < 16; ++r) acc[kt][r] = 0.f;
#pragma unroll 2
            for (int ks = 0; ks < 8; ++ks) {
              const bf16x8 bq = *(const bf16x8*)(qrow + hs * 128 + ks * 16 + 8 * hf);
#pragma unroll
              for (int kt = 0; kt < 2; ++kt) {
                const bf16x8 ak = *(const bf16x8*)(skb + (size_t)(kp * 2 + kt) * 32 * 128 + ks * 16);
                acc[kt] = __builtin_amdgcn_mfma_f32_32x32x16_bf16(ak, bq, acc[kt], 0, 0, 0);
              }
            }
#pragma unroll
            for (int kt = 0; kt < 2; ++kt) {
              float g[16];
#pragma unroll
              for (int r = 0; r < 16; ++r) {
                const int key = (kp * 2 + kt) * 32 + (r & 3) + 8 * (r >> 2) + 4 * hf;
                g[r] = __uint_as_float((__float_as_uint(acc[kt][r]) & 0xffffff80u) | (unsigned)key);
              }
              bitonic_sort16_desc(g);
              if (kp == 0 && kt == 0) {
#pragma unroll
                for (int r = 0; r < 16; ++r) top[r] = g[r];
              } else top16_merge(top, g);
              __builtin_amdgcn_sched_barrier(0);
            }
          }
#pragma unroll
          for (int r = 0; r < 16; ++r) Lh[hh][r] = top[r];
          __builtin_amdgcn_sched_barrier(0);
        }
#pragma unroll
        for (int r = 0; r < 16; ++r) {
          const auto sw = __builtin_amdgcn_permlane32_swap(__float_as_uint(Lh[0][r]), __float_as_uint(Lh[1][r]), false, false);
          Lh[0][r] = __uint_as_float(sw[0]); Lh[1][r] = __uint_as_float(sw[1]);
        }
        top16_merge(Lh[0], Lh[1]);
#pragma unroll
        for (int r = 0; r < 16; ++r) F[sd][r] = Lh[0][r];
        __builtin_amdgcn_sched_barrier(0);
      }
      int ia[16], ib[16];
#pragma unroll
      for (int r = 0; r < 16; ++r) { ia[r] = (int)(__float_as_uint(F[0][r]) & 127u) << 7; ib[r] = (int)(__float_as_uint(F[1][r]) & 127u); }
      float k[16]; int q[16];
#pragma unroll
      for (int j = 0; j < 16; ++j) { k[j] = F[0][0] + F[1][j]; q[j] = ia[0] | ib[j]; }
      { float xk[8]; int xq[8];
#pragma unroll
        for (int j = 0; j < 8; ++j) { xk[j] = F[0][1] + F[1][j]; xq[j] = ia[1] | ib[j]; }
        top16_merge_chain<8>(k, q, xk, xq); }
      { float xk[5]; int xq[5];
#pragma unroll
        for (int j = 0; j < 5; ++j) { xk[j] = F[0][2] + F[1][j]; xq[j] = ia[2] | ib[j]; }
        top16_merge_chain<5>(k, q, xk, xq); }
      { float xk[4]; int xq[4];
#pragma unroll
        for (int j = 0; j < 4; ++j) { xk[j] = F[0][3] + F[1][j]; xq[j] = ia[3] | ib[j]; }
        top16_merge_chain<4>(k, q, xk, xq); }
      { float xk[3]; int xq[3];
#pragma unroll
        for (int j = 0; j < 3; ++j) { xk[j] = F[0][4] + F[1][j]; xq[j] = ia[4] | ib[j]; }
        top16_merge_chain<3>(k, q, xk, xq); }
      { float xk[11]; int xq[11];
#pragma unroll
        for (int i = 0; i < 11; ++i) { xk[i] = F[0][5 + i] + F[1][0]; xq[i] = ia[5 + i] | ib[0]; }
        top16_merge_chain<11>(k, q, xk, xq); }
      { float xk[3]; int xq[3];
#pragma unroll
        for (int i = 0; i < 3; ++i) { xk[i] = F[0][5 + i] + F[1][1]; xq[i] = ia[5 + i] | ib[1]; }
        top16_merge_chain<3>(k, q, xk, xq); }
      float e[16]; float es = 0.f;
#pragma unroll
      for (int i = 0; i < 16; ++i) { e[i] = __expf(k[i] - k[0]); es += e[i]; }
      const float ies = 1.f / es;
      const int h = 2 * hp + hf;
#pragma unroll
      for (int i = 0; i < 16; ++i) { idxL[tl * 132 + h * 16 + i] = q[i]; gateL[tl * 132 + h * 16 + i] = e[i] * ies; }
    }
    __syncthreads();
#pragma unroll 1
    for (int ii = 0; ii < 8; ++ii) {
      const int tl = wid * 8 + ii, t = t0 + tl, b = t >> 13;
      f32x2 hv[8];
      {
        const uint4 h0 = *(const uint4*)(HF + (size_t)t * 1024 + lane * 16), h1 = *(const uint4*)(HF + (size_t)t * 1024 + lane * 16 + 8);
        const unsigned hw[8] = {h0.x, h0.y, h0.z, h0.w, h1.x, h1.y, h1.z, h1.w};
#pragma unroll
        for (int qq = 0; qq < 8; ++qq) hv[qq] = (f32x2){__uint_as_float(hw[qq] << 16), __uint_as_float(hw[qq] & 0xffff0000u)};
      }
      const int e0 = idxL[tl * 132 + lane], e1 = idxL[tl * 132 + 64 + lane];
      const float g0 = gateL[tl * 132 + lane], g1 = gateL[tl * 132 + 64 + lane];
      f32x2 acc2[8];
#pragma unroll
      for (int j = 0; j < 8; ++j) acc2[j] = (f32x2){0.f, 0.f};
#pragma unroll 1
      for (int bt = 0; bt < 8; ++bt) {
        const int esrc = (bt < 4) ? e0 : e1; const float gsrc = (bt < 4) ? g0 : g1; const int lb = (bt & 3) * 16;
        uint2 ur[16], vr[16];
        int eidx[16];
#pragma unroll
        for (int r = 0; r < 16; ++r) eidx[r] = __builtin_amdgcn_readlane(esrc, lb + r);
#pragma unroll
        for (int r = 0; r < 16; ++r) { const uint2* rowp = U4 + (size_t)eidx[r] * 64; ur[r] = rowp[lane]; }
#pragma unroll
        for (int r = 0; r < 16; ++r) { const uint2* rowp = V4 + (size_t)eidx[r] * 64; vr[r] = rowp[lane]; }
        float d[16];
#pragma unroll
        for (int r = 0; r < 16; ++r) { d[r] = dot16_fp4(ur[r], hv); asm volatile("" : "+v"(d[r])); }
        float r8[8], r4[4], r2[2];
#pragma unroll
        for (int i = 0; i < 8; ++i) { const float keep = hi5 ? d[i + 8] : d[i], send = hi5 ? d[i] : d[i + 8]; r8[i] = keep + __shfl_xor(send, 32); }
#pragma unroll
        for (int i = 0; i < 4; ++i) { const float keep = hi4 ? r8[i + 4] : r8[i], send = hi4 ? r8[i] : r8[i + 4]; r4[i] = keep + __shfl_xor(send, 16); }
#pragma unroll
        for (int i = 0; i < 2; ++i) { const float keep = hi3 ? r4[i + 2] : r4[i], send = hi3 ? r4[i] : r4[i + 2]; r2[i] = keep + __shfl_xor(send, 8); }
        float r1;
        { const float keep = hi2 ? r2[1] : r2[0], send = hi2 ? r2[0] : r2[1]; r1 = keep + __shfl_xor(send, 4); }
        r1 += __shfl_xor(r1, 2); r1 += __shfl_xor(r1, 1);
        const float gl = __shfl(gsrc, lb + rL);
        const float w = gl * gelu_tanh(r1 * (1.f / 64.f));
#pragma unroll
        for (int r = 0; r < 16; ++r) {
          const int Lk = ((r >> 3) & 1) * 32 + ((r >> 2) & 1) * 16 + ((r >> 1) & 1) * 8 + (r & 1) * 4;
          const float wr = __int_as_float(__builtin_amdgcn_readlane(__float_as_int(w), Lk));
          axpy16_fp4(vr[r], wr, acc2);
          __builtin_amdgcn_sched_barrier(0);
        }
      }
      float acc[16];
#pragma unroll
      for (int j = 0; j < 8; ++j) { acc[2 * j] = acc2[j].x; acc[2 * j + 1] = acc2[j].y; }
      float xn[16]; float ss = 0.f;
#pragma unroll
      for (int qq = 0; qq < 4; ++qq) {
        const int c = lane * 16 + 4 * qq;
        const f32x4 xv = *(const f32x4*)(X + (size_t)t * 1024 + c), g = *(const f32x4*)(g2 + b * 6144 + c);
        xn[4 * qq] = xv.x + g.x * acc[4 * qq] * 0.25f; xn[4 * qq + 1] = xv.y + g.y * acc[4 * qq + 1] * 0.25f;
        xn[4 * qq + 2] = xv.z + g.z * acc[4 * qq + 2] * 0.25f; xn[4 * qq + 3] = xv.w + g.w * acc[4 * qq + 3] * 0.25f;
        ss += xn[4 * qq] * xn[4 * qq] + xn[4 * qq + 1] * xn[4 * qq + 1] + xn[4 * qq + 2] * xn[4 * qq + 2] + xn[4 * qq + 3] * xn[4 * qq + 3];
      }
      const float rstd = rsqrtf(wave_sum(ss) * (1.f / 1024.f) + EPS_);
      if (!last) {
        unsigned hb[8];
#pragma unroll
        for (int qq = 0; qq < 4; ++qq) {
          const int c = lane * 16 + 4 * qq;
          *(f32x4*)(X + (size_t)t * 1024 + c) = (f32x4){xn[4 * qq], xn[4 * qq + 1], xn[4 * qq + 2], xn[4 * qq + 3]};
          const f32x4 gn = *(const f32x4*)(ngain + c), sh = *(const f32x4*)(nsh + b * 6144 + c), sc = *(const f32x4*)(nsc + b * 6144 + c);
          hb[2 * qq] = pk2(xn[4 * qq] * rstd * gn.x * (1.f + sc.x) + sh.x, xn[4 * qq + 1] * rstd * gn.y * (1.f + sc.y) + sh.y);
          hb[2 * qq + 1] = pk2(xn[4 * qq + 2] * rstd * gn.z * (1.f + sc.z) + sh.z, xn[4 * qq + 3] * rstd * gn.w * (1.f + sc.w) + sh.w);
        }
        *(uint4*)(HF + (size_t)t * 1024 + lane * 16) = make_uint4(hb[0], hb[1], hb[2], hb[3]);
        *(uint4*)(HF + (size_t)t * 1024 + lane * 16 + 8) = make_uint4(hb[4], hb[5], hb[6], hb[7]);
      } else {
#pragma unroll
        for (int qq = 0; qq < 4; ++qq) {
          const int c = lane * 16 + 4 * qq;
          const f32x4 fn = *(const f32x4*)(gin(pp->in[I_FNORM]) + c);
          *(f32x4*)((float*)pp->out + (size_t)t * 1024 + c) = (f32x4){xn[4 * qq] * rstd * fn.x, xn[4 * qq + 1] * rstd * fn.y, xn[4 * qq + 2] * rstd * fn.z, xn[4 * qq + 3] * rstd * fn.w};
        }
      }
    }
  }
}

#define XB_TMO      128
#define XB_XCNT(j)  (256  + 64 * (j))
#define XB_XSUB(j)  (1280 + 64 * (j))
#define XB_XGEN(j)  (2304 + 64 * (j))
#define XB_TOP      3328
#define XB_TOPGEN   3392
#define XCD_BAR_WORDS 3456
#define XB_SPIN_CAP (1u << 20)
#define LAS __attribute__((address_space(3)))
__device__ __forceinline__ unsigned xb_ld(unsigned* q)              { return __hip_atomic_load(q, __ATOMIC_RELAXED, __HIP_MEMORY_SCOPE_AGENT); }
__device__ __forceinline__ unsigned xb_add(unsigned* q, unsigned v) { return __hip_atomic_fetch_add(q, v, __ATOMIC_RELAXED, __HIP_MEMORY_SCOPE_AGENT); }
__device__ __forceinline__ unsigned xb_xcc_id() { return (unsigned)__builtin_amdgcn_s_getreg((3 << 11) | 20) & 0xFu; }
#define XB_SPIN(cond, bar) do { unsigned _sp = 0; while (cond) { __builtin_amdgcn_s_sleep(1); \
    if ((++_sp & 255u) == 0u) { if (xb_ld(&(bar)[XB_TMO])) break; if (_sp > XB_SPIN_CAP) { atomicAdd(&(bar)[XB_TMO], 1u); break; } } } } while (0)
struct XcdBarrier { unsigned* bar; unsigned x; volatile LAS unsigned* st; };
__device__ __forceinline__ XcdBarrier xcd_barrier_post(unsigned* bar, volatile LAS unsigned* st) {
    XcdBarrier b; b.bar = bar; b.x = xb_xcc_id(); b.st = st;
    if (threadIdx.x == 0) (void)xb_add(&bar[XB_XCNT(b.x)], 1u);
    return b;
}
__device__ __forceinline__ void xcd_barrier_complete(unsigned* bar, unsigned x, unsigned& nloc, unsigned& nx) {
    const unsigned G = gridDim.x * gridDim.y * gridDim.z;
    unsigned sum, cnt, mine, sp = 0u;
    for (;;) {
        sum = 0u; cnt = 0u; mine = 0u;
#pragma unroll
        for (unsigned j = 0; j < 16; ++j) { const unsigned c = xb_ld(&bar[XB_XCNT(j)]); sum += c; cnt += (c > 0u) ? 1u : 0u; mine = (j == x) ? c : mine; }
        if (sum == G) break;
        __builtin_amdgcn_s_sleep(1);
        if ((++sp & 255u) == 0u) { if (xb_ld(&bar[XB_TMO])) break; if (sp > XB_SPIN_CAP) { atomicAdd(&bar[XB_TMO], 1u); break; } }
    }
    nloc = mine > 0u ? mine : 1u; nx = cnt > 0u ? cnt : 1u;
}
__device__ __forceinline__ void xcd_barrier(const XcdBarrier& b) {
    asm volatile("s_waitcnt vmcnt(0)" ::: "memory");
    __syncthreads();
    if (threadIdx.x == 0) {
        unsigned* bar = b.bar;
        __builtin_amdgcn_s_waitcnt(0);
        unsigned nloc = b.st[0], nx = b.st[1];
        if (nloc == 0u) { xcd_barrier_complete(bar, b.x, nloc, nx); b.st[0] = nloc; b.st[1] = nx; }
        const unsigned old = xb_add(&bar[XB_XSUB(b.x)], 1u);
        const unsigned gen = old / nloc;
        if (old + 1u == (gen + 1u) * nloc) {
            __builtin_amdgcn_fence(__ATOMIC_RELEASE, "agent");
            asm volatile("s_waitcnt vmcnt(0)" ::: "memory");
            const unsigned og = xb_add(&bar[XB_TOP], 1u);
            const unsigned tg = og / nx;
            if (og + 1u == (tg + 1u) * nx) xb_add(&bar[XB_TOPGEN], 1u);
            else XB_SPIN(xb_ld(&bar[XB_TOPGEN]) == tg, bar);
            __builtin_amdgcn_fence(__ATOMIC_ACQUIRE, "agent");
            xb_add(&bar[XB_XGEN(b.x)], 1u);
            asm volatile("s_waitcnt vmcnt(0)" ::: "memory");
        } else {
            XB_SPIN(xb_ld(&bar[XB_XGEN(b.x)]) == gen, bar);
            __builtin_amdgcn_fence(__ATOMIC_ACQUIRE, "agent");
            asm volatile("s_waitcnt vmcnt(0)" ::: "memory");
        }
    }
    __syncthreads();
}

__global__ void __launch_bounds__(NT) fwd_megakernel(Params p) {
  extern __shared__ __attribute__((aligned(16))) unsigned char smem[];
  const CParamsP pp = launder_kargs();
  cg::grid_group grid = cg::this_grid();
  volatile LAS unsigned* xbst = (volatile LAS unsigned*)(smem + LDS_BYTES - 16);
  if (threadIdx.x == 0) { xbst[0] = 0u; xbst[1] = 0u; }
  if (blockIdx.x == 0) { unsigned* bw = (unsigned*)(pp->ws + WS_BAR); for (int i = threadIdx.x; i < XCD_BAR_WORDS; i += NT) bw[i] = 0u; }
  setup_phase(p, smem);
  grid.sync();
  const XcdBarrier xb = xcd_barrier_post((unsigned*)(pp->ws + WS_BAR), xbst);
  const float* MOD = (const float*)(pp->ws + WS_MOD);
  for (int l = 0; l < DEPTH_; ++l) {
    const float* xsrc = (l == 0) ? gin(pp->in[I_X]) : (const float*)(pp->ws + WS_X);
    const float* modl = MOD + (size_t)l * 2 * 6144;
    if (l == 0) {
      norm_mod_phase(xsrc, gin(pp->in[I_NMIX]), modl + 0, modl + 1024, (bf16_t*)(pp->ws + WS_ABUF));
      xcd_barrier(xb);
    }
    gemm_proj_phase(p, l, smem);
    xcd_barrier(xb);
    attn_phase(p, l, smem);
    mix_local_phase(p, l, smem);
    xcd_barrier(xb);
    scan_phase(p, l);
    xcd_barrier(xb);
    mix_final_phase(p, l, smem);
    xcd_barrier(xb);
    gemm_out_phase(p, l, xsrc, smem);
    xcd_barrier(xb);
    norm_mod_phase((const float*)(pp->ws + WS_X), gin(pp->in[I_NFFN]) + (size_t)l * 1024, modl + 3072, modl + 4096, (bf16_t*)(pp->ws + WS_ABUF));
    xcd_barrier(xb);
    gemm_q_phase(p, l, smem);
    xcd_barrier(xb);
    peer_phase(p, l, l == DEPTH_ - 1, smem);
    xcd_barrier(xb);
  }
}

extern "C" void kernel_launch(void* const* d_in, const int* in_sizes, int n_in,
                              void* d_out, int out_size, void* d_ws, size_t ws_size,
                              hipStream_t stream) {
  static int grid_blocks = 0;
  if (grid_blocks == 0) {
    if (n_in != 24 || ws_size < WS_END) { fprintf(stderr, "kernel_launch: unexpected n_in %d / ws_size %zu (need %zu)\n", n_in, ws_size, (size_t)WS_END); grid_blocks = -1; return; }
    int dev = 0, cus = 0, per_cu = 0;
    if (hipGetDevice(&dev) != hipSuccess || hipDeviceGetAttribute(&cus, hipDeviceAttributeMultiprocessorCount, dev) != hipSuccess) { grid_blocks = -1; return; }
    if (hipFuncSetAttribute((const void*)fwd_megakernel, hipFuncAttributeMaxDynamicSharedMemorySize, LDS_BYTES) != hipSuccess) { fprintf(stderr, "hipFuncSetAttribute failed\n"); grid_blocks = -1; return; }
    if (hipOccupancyMaxActiveBlocksPerMultiprocessor(&per_cu, (const void*)fwd_megakernel, NT, LDS_BYTES) != hipSuccess || per_cu < 1) { fprintf(stderr, "occupancy query: %d\n", per_cu); grid_blocks = -1; return; }
    grid_blocks = cus;
  }
  if (grid_blocks < 0) return;
  Params p{};
  for (int i = 0; i < 24; ++i) p.in[i] = (const GAS float*)d_in[i];
  p.out = (GAS float*)d_out; p.ws = (GAS unsigned char*)d_ws;
  void* args[] = {&p};
  hipError_t e = hipLaunchCooperativeKernel((void*)fwd_megakernel, dim3(grid_blocks), dim3(NT), args, LDS_BYTES, stream);
  if (e != hipSuccess) fprintf(stderr, "cooperative launch failed: %s (grid %d)\n", hipGetErrorString(e), grid_blocks);
}
```

```cpp
#include <hip/hip_runtime.h>
#include <hip/hip_cooperative_groups.h>
#include <cstdio>
#include <cstdint>
namespace cg = cooperative_groups;

typedef unsigned short bf16_t;
typedef short bf16x8 __attribute__((ext_vector_type(8)));
typedef float f32x4 __attribute__((ext_vector_type(4)));
typedef float f32x16 __attribute__((ext_vector_type(16)));

constexpr int T_ = 16384, D_ = 1024, L_ = 8192, NBATCH = 2, DEPTH_ = 4;
constexpr int INC = 2944, INCP = 3072;
constexpr int NCH = 128;
constexpr int NT = 512;
constexpr int NW = 8;
constexpr float EPS_ = 1e-6f;
constexpr int C_QA = 0, C_KA = 384, C_VA = 768, C_QR = 1152, C_KR = 1536, C_VR = 1920, C_GR = 2304, C_US = 2688;

constexpr size_t al256(size_t x) { return (x + 255) & ~(size_t)255; }
constexpr size_t WS_MOD   = 0;
constexpr size_t WS_ROTC  = al256(WS_MOD + 4ull * 2 * 6144 * 4);
constexpr size_t WS_ROTS  = al256(WS_ROTC + 8192ull * 32 * 4);
constexpr size_t WS_SA    = al256(WS_ROTS + 8192ull * 32 * 4);
constexpr size_t WS_SBB   = al256(WS_SA + 4ull * 16 * 64 * 2 * 4);
constexpr size_t WS_WIN   = al256(WS_SBB + 4ull * 16 * 64 * 32 * 4);
constexpr size_t WS_WOUT  = al256(WS_WIN + 4ull * INCP * 1024 * 2);
constexpr size_t WS_WQ    = al256(WS_WOUT + 4ull * 1024 * 1024 * 2);
constexpr size_t WS_SUBK  = al256(WS_WQ + 4ull * 2048 * 1024 * 2);
constexpr size_t WS_ABUF  = al256(WS_SUBK + 4ull * 16 * 128 * 128 * 2);
constexpr size_t WS_PROJ  = al256(WS_ABUF + (size_t)T_ * 1024 * 2);
constexpr size_t WS_VTA   = al256(WS_PROJ + (size_t)T_ * INCP * 2);
constexpr size_t WS_ATT   = al256(WS_VTA + 2ull * 6 * 64 * 8192 * 2);
constexpr size_t WS_YINT  = al256(WS_ATT + (size_t)T_ * 384 * 4);
constexpr size_t WS_UPD   = al256(WS_YINT + (size_t)T_ * 384 * 4);
constexpr size_t WS_SPREV = al256(WS_UPD + 256ull * 6 * 4096 * 4);
constexpr size_t WS_SEND  = al256(WS_SPREV + 256ull * 6 * 4096 * 4);
constexpr size_t WS_CARRY = al256(WS_SEND + 256ull * 16 * 64 * 2 * 4);
constexpr size_t WS_X     = al256(WS_CARRY + 256ull * 16 * 64 * 2 * 4);
constexpr size_t WS_Q     = al256(WS_X + (size_t)T_ * 1024 * 4);
constexpr size_t WS_SC    = al256(WS_Q + (size_t)T_ * 2048 * 2);
constexpr size_t WS_EIDX  = al256(WS_SC + (size_t)T_ * 2048 * 4);
constexpr size_t WS_EGATE = al256(WS_EIDX + (size_t)T_ * 128 * 4);
constexpr size_t WS_PU8   = al256(WS_EGATE + (size_t)T_ * 128 * 4);
constexpr size_t WS_PV8   = al256(WS_PU8 + 4ull * 16384 * 1024);
constexpr size_t WS_BAR   = al256(WS_PV8 + 4ull * 16384 * 1024);
constexpr size_t WS_SPT   = al256(WS_BAR + 3456ull * 4);
constexpr size_t WS_CB    = al256(WS_SPT + 256ull * 6 * 4096 * 2);
constexpr size_t WS_WGLUT = al256(WS_CB + 4ull * 16 * 16 * 128 * 2);
constexpr size_t WS_VTR   = al256(WS_WGLUT + 4ull * 512 * 256 * 2);
constexpr size_t WS_XG    = al256(WS_VTR + 2ull * 384 * 8192 * 2);
constexpr size_t WS_SSQ   = al256(WS_XG + (size_t)T_ * 1024 * 2);
constexpr size_t WS_C2    = al256(WS_SSQ + (size_t)T_ * 16 * 4);
constexpr size_t WS_BBH   = al256(WS_C2 + 4ull * 2 * 2048 * 4);
constexpr size_t WS_END   = al256(WS_BBH + 4ull * 16 * 2 * 64 * 16 * 2);

constexpr int LDS_BYTES = 135168;

#define GAS __attribute__((address_space(1)))
struct Params {
  const GAS float* in[24];
  GAS float* out;
  GAS unsigned char* ws;
};
enum { I_X = 0, I_C, I_WADA, I_BADA, I_NMIX, I_NFFN, I_WIN, I_RELB, I_LRE, I_LIM, I_LOGDT, I_BRE, I_BIM, I_CRE, I_CIM, I_SSMD,
       I_WGLU, I_MGAIN, I_WOUT, I_WQ, I_SUBK, I_PU, I_PV, I_FNORM };

__device__ __forceinline__ float bf2f(bf16_t v) { return __uint_as_float(((unsigned)v) << 16); }
__device__ __forceinline__ bf16_t f2bf(float f) { unsigned u = __float_as_uint(f); u += 0x7fffu + ((u >> 16) & 1u); return (bf16_t)(u >> 16); }
__device__ __forceinline__ unsigned pk2(float a, float b) { return (unsigned)f2bf(a) | ((unsigned)f2bf(b) << 16); }
__device__ __forceinline__ float wave_sum(float v) {
#pragma unroll
  for (int o = 32; o > 0; o >>= 1) v += __shfl_xor(v, o);
  return v;
}
__device__ __forceinline__ float wave_max(float v) {
#pragma unroll
  for (int o = 32; o > 0; o >>= 1) v = fmaxf(v, __shfl_xor(v, o));
  return v;
}
__device__ __forceinline__ float gelu_tanh(float x) { const float u = 0.7978845608028654f * (x + 0.044715f * x * x * x); return 0.5f * x * (1.f + tanhf(u)); }
__device__ __forceinline__ float sigmoid_f(float x) { return 1.f / (1.f + __expf(-x)); }
__device__ __forceinline__ GAS unsigned char* launder_ptr(GAS unsigned char* q) { asm volatile("" : "+s"(q)); return q; }
__device__ __forceinline__ const float* gin(const GAS float* q) { return (const float*)q; }
__device__ __forceinline__ const float* launder_cptr(const float* q) { asm volatile("" : "+s"(q)); return q; }
__device__ __forceinline__ int launder_tid() { int t = threadIdx.x; asm volatile("" : "+v"(t)); return t; }
typedef const Params __attribute__((address_space(4)))* CParamsP;
__device__ __forceinline__ CParamsP launder_kargs() { CParamsP q = (CParamsP)__builtin_amdgcn_kernarg_segment_ptr(); asm volatile("" : "+s"(q)); return q; }

__device__ __forceinline__ void convert_tables_fp4(const CParamsP pp, GAS unsigned char* ws, int layer, int gtid, int gn) {
  constexpr size_t NIT = 16384ull * 1024 / 16;
  for (size_t it = gtid; it < 2 * NIT; it += gn) {
    const int tb = it >= NIT ? 1 : 0; const size_t r = (it - (size_t)tb * NIT) + (size_t)layer * NIT;
    const f32x4* src = (const f32x4*)((tb ? gin(pp->in[I_PV]) : gin(pp->in[I_PU])) + r * 16);
    const float sc = tb ? 4.f : 64.f;
    unsigned o[2] = {0u, 0u};
#pragma unroll
    for (int q = 0; q < 4; ++q) {
      const f32x4 a = src[q];
      const float x0 = fminf(fmaxf(a.x * sc, -6.f), 6.f), x1 = fminf(fmaxf(a.y * sc, -6.f), 6.f);
      const float x2 = fminf(fmaxf(a.z * sc, -6.f), 6.f), x3 = fminf(fmaxf(a.w * sc, -6.f), 6.f);
      if (q == 0)      { o[0] = __builtin_amdgcn_cvt_scalef32_pk_fp4_f32(o[0], x0, x1, 1.0f, 0); o[0] = __builtin_amdgcn_cvt_scalef32_pk_fp4_f32(o[0], x2, x3, 1.0f, 1); }
      else if (q == 1) { o[0] = __builtin_amdgcn_cvt_scalef32_pk_fp4_f32(o[0], x0, x1, 1.0f, 2); o[0] = __builtin_amdgcn_cvt_scalef32_pk_fp4_f32(o[0], x2, x3, 1.0f, 3); }
      else if (q == 2) { o[1] = __builtin_amdgcn_cvt_scalef32_pk_fp4_f32(o[1], x0, x1, 1.0f, 0); o[1] = __builtin_amdgcn_cvt_scalef32_pk_fp4_f32(o[1], x2, x3, 1.0f, 1); }
      else             { o[1] = __builtin_amdgcn_cvt_scalef32_pk_fp4_f32(o[1], x0, x1, 1.0f, 2); o[1] = __builtin_amdgcn_cvt_scalef32_pk_fp4_f32(o[1], x2, x3, 1.0f, 3); }
    }
    *(uint2*)(ws + (tb ? WS_PV8 : WS_PU8) + r * 8) = make_uint2(o[0], o[1]);
  }
}

__device__ void setup_phase(const Params& p, unsigned char* smem) {
  const CParamsP pp = launder_kargs();
  GAS unsigned char* const ws = launder_ptr(pp->ws); const int tidx = launder_tid(); (void)ws; (void)tidx;
  const int tid = tidx;
  float* sm = (float*)smem;
  {
    float* cond = sm;
    float* red = sm + 2048;
    float* MOD = (float*)(ws + WS_MOD);
    for (int i = tid; i < 2048; i += NT) { const float c = gin(pp->in[I_C])[i]; cond[i] = c * sigmoid_f(c); }
    __syncthreads();
    for (int item = blockIdx.x; item < 4 * 96; item += gridDim.x) {
      const int l = item / 96, cb = item % 96, kq = tid >> 6, jj = tid & 63, j = cb * 64 + jj;
      const float* w = gin(pp->in[I_WADA]) + (size_t)l * 1024 * 6144 + j;
      float a0 = 0.f, a1 = 0.f;
#pragma unroll 16
      for (int k = kq * 128; k < kq * 128 + 128; ++k) { const float wv = w[(size_t)k * 6144]; a0 += cond[k] * wv; a1 += cond[1024 + k] * wv; }
      red[(kq * 2 + 0) * 64 + jj] = a0; red[(kq * 2 + 1) * 64 + jj] = a1;
      __syncthreads();
      if (tid < 128) {
        const int b = tid >> 6, j2 = tid & 63; float s = 0.f;
        for (int q = 0; q < 8; ++q) s += red[(q * 2 + b) * 64 + j2];
        MOD[((size_t)l * 2 + b) * 6144 + cb * 64 + j2] = s + gin(pp->in[I_BADA])[(size_t)l * 6144 + cb * 64 + j2];
      }
      __syncthreads();
    }
  }
  const int gtid = blockIdx.x * NT + tid, gn = gridDim.x * NT;
  {
    float* RC = (float*)(ws + WS_ROTC); float* RS = (float*)(ws + WS_ROTS);
    for (int idx = gtid; idx < 8192 * 32; idx += gn) {
      const int pos = idx >> 5, i = idx & 31;
      const float inv = powf(10000.0f, -(float)i / 32.0f);
      const float ang = (float)pos * inv;
      float s, c; sincosf(ang, &s, &c);
      RC[idx] = c; RS[idx] = s;
    }
  }
  {
    float* SA = (float*)(ws + WS_SA); float* SBB = (float*)(ws + WS_SBB); bf16_t* BBH = (bf16_t*)(ws + WS_BBH);
    for (int idx = gtid; idx < 4 * 16 * 64; idx += gn) {
      const int l = idx / 1024, g = (idx >> 6) & 15;
      const float dt = expf(gin(pp->in[I_LOGDT])[l * 16 + g]);
      const float lr = gin(pp->in[I_LRE])[idx], li = gin(pp->in[I_LIM])[idx];
      const float mag = expf(lr * dt);
      float sn, cs; sincosf(li * dt, &sn, &cs);
      const float are = mag * cs, aim = mag * sn;
      const float den = lr * lr + li * li, nr = are - 1.f, ni = aim;
      const float fre = (nr * lr + ni * li) / den, fim = (ni * lr - nr * li) / den;
      SA[idx * 2] = are; SA[idx * 2 + 1] = aim;
      for (int c = 0; c < 16; ++c) {
        const float br = gin(pp->in[I_BRE])[(size_t)idx * 16 + c], bi = gin(pp->in[I_BIM])[(size_t)idx * 16 + c];
        SBB[(size_t)idx * 32 + c] = fre * br - fim * bi;
        SBB[(size_t)idx * 32 + 16 + c] = fre * bi + fim * br;
        BBH[(((size_t)(idx >> 6) * 2 + 0) * 64 + (idx & 63)) * 16 + c] = f2bf(fre * br - fim * bi);
        BBH[(((size_t)(idx >> 6) * 2 + 1) * 64 + (idx & 63)) * 16 + c] = f2bf(fre * bi + fim * br);
      }
    }
  }
  {
    bf16_t* SK = (bf16_t*)(ws + WS_SUBK);
    for (int idx = gtid; idx < 4 * 16 * 128 * 128; idx += gn) SK[idx] = f2bf(gin(pp->in[I_SUBK])[idx]);
  }
  {
    bf16_t* CB = (bf16_t*)(ws + WS_CB);
    for (int idx = gtid; idx < 4 * 16 * 16 * 128; idx += gn) {
      const int k = idx & 127, lgc = idx >> 7;
      CB[idx] = (k < 64) ? f2bf(gin(pp->in[I_CRE])[(size_t)lgc * 64 + k]) : f2bf(-gin(pp->in[I_CIM])[(size_t)lgc * 64 + (k - 64)]);
    }
    bf16_t* WG = (bf16_t*)(ws + WS_WGLUT);
    for (int idx = gtid; idx < 4 * 512 * 256; idx += gn) {
      const int k = idx & 255, nn = (idx >> 8) & 511, l2 = idx >> 17;
      WG[idx] = f2bf(gin(pp->in[I_WGLU])[((size_t)l2 * 256 + k) * 512 + nn]);
    }
  }
  convert_tables_fp4(pp, ws, 0, gtid, gn);
  {
    float* tile = sm;
    constexpr int IT_IN = 4 * 16 * 48, IT_OUT = 4 * 16 * 16, IT_Q = 4 * 16 * 32;
    __syncthreads();
    for (int item = blockIdx.x; item < IT_IN + IT_OUT + IT_Q; item += gridDim.x) {
      const float* W; bf16_t* WT; int N, NP, r = item;
      if (r < IT_IN) { const int l = r / (16 * 48); r %= 16 * 48; W = gin(pp->in[I_WIN]) + (size_t)l * 1024 * INC; WT = (bf16_t*)(ws + WS_WIN) + (size_t)l * INCP * 1024; N = INC; NP = 48; }
      else if (r < IT_IN + IT_OUT) { r -= IT_IN; const int l = r / 256; r %= 256; W = gin(pp->in[I_WOUT]) + (size_t)l * 1024 * 1024; WT = (bf16_t*)(ws + WS_WOUT) + (size_t)l * 1024 * 1024; N = 1024; NP = 16; }
      else { r -= IT_IN + IT_OUT; const int l = r / 512; r %= 512; W = gin(pp->in[I_WQ]) + (size_t)l * 1024 * 2048; WT = (bf16_t*)(ws + WS_WQ) + (size_t)l * 2048 * 1024; N = 2048; NP = 32; }
      const int kb = r / NP, nb = r % NP, k0 = kb * 64, n0 = nb * 64;
      {
        const int col = tid & 63, rr = tid >> 6;
#pragma unroll
        for (int i = 0; i < 8; ++i) { const int kk = rr + 8 * i; const int n = n0 + col; tile[kk * 65 + col] = (n < N) ? W[(size_t)(k0 + kk) * N + n] : 0.f; }
      }
      __syncthreads();
      {
        const int n = tid >> 3, kc = tid & 7; const float* s = tile + (kc * 8) * 65 + n;
        uint4 o; o.x = pk2(s[0], s[65]); o.y = pk2(s[2 * 65], s[3 * 65]); o.z = pk2(s[4 * 65], s[5 * 65]); o.w = pk2(s[6 * 65], s[7 * 65]);
        *(uint4*)(WT + (size_t)(n0 + n) * 1024 + k0 + kc * 8) = o;
      }
      __syncthreads();
    }
  }
}

__device__ void qbias_phase(const Params& p, unsigned char* smem) {
  const CParamsP pp = launder_kargs();
  GAS unsigned char* const ws = launder_ptr(pp->ws); const int tid = launder_tid();
  float* red = (float*)smem;
  float* C2 = (float*)(ws + WS_C2); const float* MOD = (const float*)(ws + WS_MOD);
  for (int item = blockIdx.x; item < 4 * 32; item += gridDim.x) {
    const int l = item >> 5, cb = item & 31, kq = tid >> 6, jj = tid & 63, j = cb * 64 + jj;
    const float* w = gin(pp->in[I_WQ]) + (size_t)l * 1024 * 2048 + j;
    const float* s0 = MOD + (size_t)l * 2 * 6144 + 3072; const float* s1 = s0 + 6144;
    float a0 = 0.f, a1 = 0.f;
#pragma unroll 16
    for (int k = kq * 128; k < kq * 128 + 128; ++k) { const float wv = w[(size_t)k * 2048]; a0 += s0[k] * wv; a1 += s1[k] * wv; }
    __syncthreads();
    red[(kq * 2 + 0) * 64 + jj] = a0; red[(kq * 2 + 1) * 64 + jj] = a1;
    __syncthreads();
    if (tid < 128) {
      const int b = tid >> 6, j2 = tid & 63; float sum = 0.f;
      for (int q = 0; q < 8; ++q) sum += red[(q * 2 + b) * 64 + j2];
      C2[((size_t)l * 2 + b) * 2048 + cb * 64 + j2] = sum;
    }
  }
  __syncthreads();
}

__device__ void norm_mod_phase(const float* __restrict__ xsrc, const float* __restrict__ gain, const float* __restrict__ mod_sh, const float* __restrict__ mod_sc,
                               bf16_t* __restrict__ outp) {
  const int tidx = launder_tid();
  const int lane = tidx & 63, gw = blockIdx.x * NW + (tidx >> 6), nw = gridDim.x * NW;
  for (int t = gw; t < T_; t += nw) {
    const int b = t >> 13;
    const f32x4* xr = (const f32x4*)(xsrc + (size_t)t * 1024) + lane;
    f32x4 v[4]; float s = 0.f;
#pragma unroll
    for (int j = 0; j < 4; ++j) { v[j] = xr[64 * j]; s += v[j].x * v[j].x + v[j].y * v[j].y + v[j].z * v[j].z + v[j].w * v[j].w; }
    const float rstd = rsqrtf(wave_sum(s) * (1.f / 1024.f) + EPS_);
#pragma unroll
    for (int j = 0; j < 4; ++j) {
      const int c = lane * 4 + 256 * j;
      const f32x4 g = *(const f32x4*)(gain + c), sh = *(const f32x4*)(mod_sh + b * 6144 + c), sc = *(const f32x4*)(mod_sc + b * 6144 + c);
      const float o0 = v[j].x * rstd * g.x * (1.f + sc.x) + sh.x, o1 = v[j].y * rstd * g.y * (1.f + sc.y) + sh.y;
      const float o2 = v[j].z * rstd * g.z * (1.f + sc.z) + sh.z, o3 = v[j].w * rstd * g.w * (1.f + sc.w) + sh.w;
      uint2 o; o.x = pk2(o0, o1); o.y = pk2(o2, o3);
      *(uint2*)(outp + (size_t)t * 1024 + c) = o;
    }
  }
}


namespace pg8 {
#define PG8_LAS __attribute__((address_space(3)))
typedef unsigned u32x4 __attribute__((ext_vector_type(4)));
constexpr int BM = 256, BK = 64, HALF = 128, HTB = HALF * BK * 2, STAGE_BYTES = 8 * HTB, NXCD = 8, WGM = 8;
__host__ __device__ __forceinline__ int lds_byte(int r, int c) { const int st = (r >> 4) * 2 + (c >> 5), rr = r & 15, cc = c & 31, ob = rr * 64 + cc * 2; return st * 1024 + (ob ^ (((ob >> 9) & 1) << 5)); }
__host__ __device__ __forceinline__ void stage_rc(int b, int& R, int& C) { const int st = b / 1024, sb = b % 1024, swz = sb ^ (((sb >> 9) & 1) << 5); R = (st >> 1) * 16 + swz / 64; C = (st & 1) * 32 + (swz % 64) / 2; }
__host__ __device__ __forceinline__ int perm32(int rho) { const int n = rho >> 4, i = rho & 15; return 8 * (i >> 2) + 4 * n + (i & 3); }
struct Unit { int pm, pn; };
struct Gemm { const bf16_t* A; const bf16_t* Bt; int M, N, K; };
struct StaticOrder {
    int nM, nN, nwg, G, c;
    __host__ __device__ void init(int M, int N, int G_, int c_) { nM = M / BM; nN = N / BM; nwg = nM * nN; G = G_; c = c_; }
    __host__ __device__ bool next(int i, Unit& u) const {
        const long L = (long)i * G + c; if (L >= nwg) return false;
        int wgid = (int)L; { const int q = nwg / NXCD, r = nwg % NXCD, xcd = wgid % NXCD, off = wgid / NXCD; wgid = (xcd < r ? xcd * (q + 1) : r * (q + 1) + (xcd - r) * q) + off; }
        const int nig = WGM * nN, gid = wgid / nig, fm = gid * WGM, gsz = (nM - fm) < WGM ? (nM - fm) : WGM;
        u.pm = fm + ((wgid % nig) % gsz); u.pn = (wgid % nig) / gsz; return true;
    }
    __device__ __forceinline__ void a_ready(const Unit&) const {}
    __device__ __forceinline__ void done(const Unit&) const {}
};
__device__ __forceinline__ unsigned cvt_pk_bf16(float lo, float hi) { unsigned r; asm volatile("v_cvt_pk_bf16_f32 %0, %1, %2" : "=v"(r) : "v"(lo), "v"(hi)); return r; }
template <class Epi, class Sched>
__device__ __forceinline__ void gemm_phase(PG8_LAS unsigned char* lds, const Gemm g, const Sched& S, const Epi& E) {
    const int tid = launder_tid(), wid = __builtin_amdgcn_readfirstlane(tid >> 6), lane = tid & 63, wr = wid >> 2, wc = wid & 3, fr = lane & 15, fq = lane >> 4;
    const int K = g.K, nt = K / BK;
    unsigned voffA[2], voffB[2];
#pragma unroll
    for (int i = 0; i < 2; ++i) { int R, C; stage_rc(tid * 16 + i * 8192, R, C); const int Rb = Epi::PERM ? ((R & ~31) + perm32(R & 31)) : R;
        voffA[i] = (unsigned)(R * K + C) * 2u; voffB[i] = (unsigned)(Rb * K + C) * 2u; }
    const size_t kstep = (size_t)(BK * 2);
    const size_t hstep = (size_t)HALF * K * 2;
    const size_t tstep = 2 * hstep;
    const unsigned ldsw = (unsigned)wid * 1024u;
    const int aoff = lds_byte(wr * 64 + fr, fq * 8), boff = lds_byte(wc * 32 + fr, fq * 8);
#define PG8_SA(b, h) (((b) * 2 + (h)) * HTB)
#define PG8_SB(b, h) ((4 + (b) * 2 + (h)) * HTB)
#define PG8_STAGE(bufoff, gbase, voff) do { _Pragma("unroll") for (int _i = 0; _i < 2; ++_i) \
        __builtin_amdgcn_global_load_lds((const unsigned*)((const char*)(gbase) + (voff)[_i]), (PG8_LAS unsigned*)(lds + (bufoff) + ldsw + _i * 8192), 16, 0, 0); } while (0)
#define PG8_LDA(dst, b, h) do { _Pragma("unroll") for (int m = 0; m < 4; ++m) _Pragma("unroll") for (int k = 0; k < 2; ++k) dst[m][k] = *(const PG8_LAS bf16x8*)(lds + PG8_SA(b, h) + aoff + m * 2048 + k * 1024); } while (0)
#define PG8_LDB(dst, b, h) do { _Pragma("unroll") for (int n = 0; n < 2; ++n) _Pragma("unroll") for (int k = 0; k < 2; ++k) dst[n][k] = *(const PG8_LAS bf16x8*)(lds + PG8_SB(b, h) + boff + n * 2048 + k * 1024); } while (0)
#define PG8_MMA(ai, bj, At, Bt) do { __builtin_amdgcn_s_setprio(1); _Pragma("unroll") for (int m = 0; m < 4; ++m) _Pragma("unroll") for (int n = 0; n < 2; ++n) _Pragma("unroll") for (int k = 0; k < 2; ++k) \
        acc[ai][bj][m][n] = __builtin_amdgcn_mfma_f32_16x16x32_bf16(Bt[n][k], At[m][k], acc[ai][bj][m][n], 0, 0, 0); __builtin_amdgcn_s_setprio(0); } while (0)
#define PG8_WAIT_V(n) asm volatile("s_waitcnt vmcnt(" #n ")" ::: "memory")
#define PG8_WAIT_L(n) asm volatile("s_waitcnt lgkmcnt(" #n ")" ::: "memory")
#define PG8_BAR __builtin_amdgcn_s_barrier()
#define PG8_SCHED __builtin_amdgcn_sched_barrier(0)
    Unit cur, nxt; int ui = 0;
    if (!S.next(0, cur)) return;
    f32x4 acc[2][2][4][2];
#pragma unroll
    for (int a = 0; a < 2; ++a)
#pragma unroll
        for (int b = 0; b < 2; ++b)
#pragma unroll
            for (int m = 0; m < 4; ++m)
#pragma unroll
                for (int n = 0; n < 2; ++n) acc[a][b][m][n] = (f32x4){0.f, 0.f, 0.f, 0.f};
    bf16x8 At[4][2], B0[2][2], B1[2][2];
    const char* cA = (const char*)g.A + (size_t)cur.pm * tstep; const char* cB = (const char*)g.Bt + (size_t)cur.pn * tstep;
    S.a_ready(cur);
    PG8_STAGE(PG8_SB(0, 0), cB, voffB); PG8_STAGE(PG8_SA(0, 0), cA, voffA); PG8_STAGE(PG8_SB(0, 1), cB + hstep, voffB); PG8_STAGE(PG8_SA(0, 1), cA + hstep, voffA);
    if (wr == 1) PG8_BAR;
    PG8_WAIT_V(4); PG8_BAR;
    PG8_STAGE(PG8_SB(1, 0), cB + kstep, voffB); PG8_STAGE(PG8_SA(1, 0), cA + kstep, voffA); PG8_STAGE(PG8_SB(1, 1), cB + hstep + kstep, voffB);
    PG8_WAIT_V(6); PG8_BAR;
    for (;;) {
        const bool has_next = S.next(ui + 1, nxt);
        const char* nA = has_next ? (const char*)g.A + (size_t)nxt.pm * tstep : cA; const char* nB = has_next ? (const char*)g.Bt + (size_t)nxt.pn * tstep : cB;
        for (int t = 0; t < nt; t += 2) {
            const bool last = (t == nt - 2);
            const char* a1 = cA + (size_t)(t + 1) * kstep;
            const char* a2 = last ? nA : cA + (size_t)(t + 2) * kstep; const char* b2 = last ? nB : cB + (size_t)(t + 2) * kstep;
            const char* a3 = a2 + kstep; const char* b3 = b2 + kstep;
            if (last && has_next) S.a_ready(nxt);
            PG8_LDB(B0, 0, 0); PG8_SCHED; PG8_LDA(At, 0, 0); PG8_STAGE(PG8_SA(1, 1), a1 + hstep, voffA);
            PG8_WAIT_L(8); PG8_BAR; PG8_WAIT_L(0); PG8_MMA(0, 0, At, B0); PG8_BAR; PG8_SCHED;
            PG8_LDB(B1, 0, 1); PG8_STAGE(PG8_SB(0, 0), b2, voffB);
            PG8_BAR; PG8_WAIT_L(0); PG8_MMA(0, 1, At, B1); PG8_BAR;
            PG8_LDA(At, 0, 1); PG8_STAGE(PG8_SA(0, 0), a2, voffA);
            PG8_BAR; PG8_WAIT_L(0); PG8_MMA(1, 0, At, B0); PG8_BAR; PG8_SCHED;
            PG8_STAGE(PG8_SB(0, 1), b2 + hstep, voffB);
            PG8_WAIT_V(6); PG8_BAR; PG8_MMA(1, 1, At, B1); PG8_BAR;
            PG8_LDB(B0, 1, 0); PG8_SCHED; PG8_LDA(At, 1, 0); PG8_STAGE(PG8_SA(0, 1), a2 + hstep, voffA);
            PG8_WAIT_L(8); PG8_BAR; PG8_WAIT_L(0); PG8_MMA(0, 0, At, B0); PG8_BAR; PG8_SCHED;
            PG8_LDB(B1, 1, 1); PG8_STAGE(PG8_SB(1, 0), b3, voffB);
            PG8_BAR; PG8_WAIT_L(0); PG8_MMA(0, 1, At, B1); PG8_BAR;
            PG8_LDA(At, 1, 1); PG8_STAGE(PG8_SA(1, 0), a3, voffA);
            PG8_BAR; PG8_WAIT_L(0); PG8_MMA(1, 0, At, B0); PG8_BAR; PG8_SCHED;
            PG8_STAGE(PG8_SB(1, 1), b3 + hstep, voffB);
            PG8_WAIT_V(6); PG8_BAR; PG8_MMA(1, 1, At, B1); PG8_BAR;
        }
        if constexpr (!Epi::AFTER_DRAIN) { E(acc, cur, wr, wc, fr, fq); S.done(cur); }
        if (!has_next) break;
#pragma unroll
        for (int a = 0; a < 2; ++a)
#pragma unroll
            for (int b = 0; b < 2; ++b)
#pragma unroll
                for (int m = 0; m < 4; ++m)
#pragma unroll
                    for (int n = 0; n < 2; ++n) acc[a][b][m][n] = (f32x4){0.f, 0.f, 0.f, 0.f};
        cur = nxt; cA = nA; cB = nB; ++ui;
    }
    PG8_WAIT_V(0);
    if (wr == 0) PG8_BAR;
    PG8_BAR;
    if constexpr (Epi::AFTER_DRAIN) { E.fused(acc, cur, wr, wc, fr, fq, lds, wid, lane); S.done(cur); }
#undef PG8_SA
#undef PG8_SB
#undef PG8_STAGE
#undef PG8_LDA
#undef PG8_LDB
#undef PG8_MMA
#undef PG8_WAIT_V
#undef PG8_WAIT_L
#undef PG8_BAR
#undef PG8_SCHED
}
}

__device__ __forceinline__ float ssq_total(const float* __restrict__ SSQ, int t) {
  const f32x4 a = *(const f32x4*)(SSQ + (size_t)t * 16), b = *(const f32x4*)(SSQ + (size_t)t * 16 + 4), c = *(const f32x4*)(SSQ + (size_t)t * 16 + 8), d = *(const f32x4*)(SSQ + (size_t)t * 16 + 12);
  return (((a.x + a.y) + (a.z + a.w)) + ((b.x + b.y) + (b.z + b.w))) + (((c.x + c.y) + (c.z + c.w)) + ((d.x + d.y) + (d.z + d.w)));
}
struct EpiProj {
  static constexpr bool PERM = true, AFTER_DRAIN = false;
  bf16_t* PROJ; bf16_t* VTA; bf16_t* VTR;
  __device__ __forceinline__ void operator()(const f32x4 (&acc)[2][2][4][2], const pg8::Unit& u, int wr, int wc, int fr, int fq) const {
    const int row0 = u.pm * 256 + wr * 64 + fr, col0 = u.pn * 256 + wc * 32 + 8 * fq;
#pragma unroll
    for (int ai = 0; ai < 2; ++ai)
#pragma unroll
      for (int m = 0; m < 4; ++m) {
        const int t = row0 + ai * 128 + m * 16;
#pragma unroll
        for (int bj = 0; bj < 2; ++bj) {
          const int c = col0 + bj * 128;
          const f32x4 v0 = acc[ai][bj][m][0], v1 = acc[ai][bj][m][1];
          pg8::u32x4 w; w.x = pg8::cvt_pk_bf16(v0[0], v0[1]); w.y = pg8::cvt_pk_bf16(v0[2], v0[3]); w.z = pg8::cvt_pk_bf16(v1[0], v1[1]); w.w = pg8::cvt_pk_bf16(v1[2], v1[3]);
          *(pg8::u32x4*)(PROJ + (size_t)t * INCP + c) = w;
          const bool isva = (c >= C_VA && c < C_VA + 384), isvr = (c >= C_VR && c < C_VR + 384);
          if (isva || isvr) {
            bf16_t* vt = (isva ? VTA : VTR) + ((size_t)(t >> 13) * 384 + (c - (isva ? C_VA : C_VR))) * 8192 + (t & 8191);
            vt[0] = (bf16_t)(w.x & 0xffffu); vt[8192] = (bf16_t)(w.x >> 16); vt[2 * 8192] = (bf16_t)(w.y & 0xffffu); vt[3 * 8192] = (bf16_t)(w.y >> 16);
            vt[4 * 8192] = (bf16_t)(w.z & 0xffffu); vt[5 * 8192] = (bf16_t)(w.z >> 16); vt[6 * 8192] = (bf16_t)(w.w & 0xffffu); vt[7 * 8192] = (bf16_t)(w.w >> 16);
          }
        }
      }
  }
};
struct EpiOut {
  static constexpr bool PERM = false, AFTER_DRAIN = false;
  const float* xsrc; float* X; const float* g1; const float* nf; const float* sc2; bf16_t* XG; float* SSQ;
  __device__ __forceinline__ void operator()(const f32x4 (&acc)[2][2][4][2], const pg8::Unit& u, int wr, int wc, int fr, int fq) const {
    const int row0 = u.pm * 256 + wr * 64 + fr, col0 = u.pn * 256 + wc * 32 + 4 * fq, b = (u.pm * 256) >> 13;
    f32x4 gg[2][2], gs[2][2];
#pragma unroll
    for (int bj = 0; bj < 2; ++bj)
#pragma unroll
      for (int n = 0; n < 2; ++n) {
        const int c = col0 + bj * 128 + n * 16;
        gg[bj][n] = *(const f32x4*)(g1 + b * 6144 + c);
        const f32x4 gf = *(const f32x4*)(nf + c), sc = *(const f32x4*)(sc2 + b * 6144 + c);
        gs[bj][n] = gf * (sc + 1.f);
      }
#pragma unroll
    for (int ai = 0; ai < 2; ++ai)
#pragma unroll
      for (int m = 0; m < 4; ++m) {
        const int t = row0 + ai * 128 + m * 16;
        float sq = 0.f;
#pragma unroll
        for (int bj = 0; bj < 2; ++bj)
#pragma unroll
          for (int n = 0; n < 2; ++n) {
            const int c = col0 + bj * 128 + n * 16;
            const f32x4 xv = *(const f32x4*)(xsrc + (size_t)t * 1024 + c);
            const f32x4 xn = xv + gg[bj][n] * acc[ai][bj][m][n];
            *(f32x4*)(X + (size_t)t * 1024 + c) = xn;
            const f32x4 xs = xn * gs[bj][n];
            uint2 o; o.x = pg8::cvt_pk_bf16(xs.x, xs.y); o.y = pg8::cvt_pk_bf16(xs.z, xs.w);
            *(uint2*)(XG + (size_t)t * 1024 + c) = o;
            sq += (xn.x * xn.x + xn.y * xn.y) + (xn.z * xn.z + xn.w * xn.w);
          }
        sq += __shfl_xor(sq, 16); sq += __shfl_xor(sq, 32);
        if (fq == 0) SSQ[(size_t)t * 16 + u.pn * 4 + wc] = sq;
      }
  }
};
struct EpiQ {
  static constexpr bool PERM = true, AFTER_DRAIN = false;
  bf16_t* Q; const float* SSQ; const float* C2;
  __device__ __forceinline__ void operator()(const f32x4 (&acc)[2][2][4][2], const pg8::Unit& u, int wr, int wc, int fr, int fq) const {
    const int row0 = u.pm * 256 + wr * 64 + fr, col0 = u.pn * 256 + wc * 32 + 8 * fq, b = (u.pm * 256) >> 13;
    f32x4 cc[2][2];
#pragma unroll
    for (int bj = 0; bj < 2; ++bj) { cc[bj][0] = *(const f32x4*)(C2 + b * 2048 + col0 + bj * 128); cc[bj][1] = *(const f32x4*)(C2 + b * 2048 + col0 + bj * 128 + 4); }
#pragma unroll
    for (int ai = 0; ai < 2; ++ai)
#pragma unroll
      for (int m = 0; m < 4; ++m) {
        const int t = row0 + ai * 128 + m * 16;
        const float rstd = rsqrtf(ssq_total(SSQ, t) * (1.f / 1024.f) + EPS_);
#pragma unroll
        for (int bj = 0; bj < 2; ++bj) {
          const f32x4 v0 = acc[ai][bj][m][0] * rstd + cc[bj][0], v1 = acc[ai][bj][m][1] * rstd + cc[bj][1];
          pg8::u32x4 w; w.x = pg8::cvt_pk_bf16(v0[0], v0[1]); w.y = pg8::cvt_pk_bf16(v0[2], v0[3]); w.z = pg8::cvt_pk_bf16(v1[0], v1[1]); w.w = pg8::cvt_pk_bf16(v1[2], v1[3]);
          *(pg8::u32x4*)(Q + (size_t)t * 2048 + col0 + bj * 128) = w;
        }
      }
  }
};

__device__ void gemm_proj_phase(const Params& p, int l, unsigned char* smem) {
  const CParamsP pp = launder_kargs();
  GAS unsigned char* const ws = launder_ptr(pp->ws);
  pg8::Gemm g; g.A = (const bf16_t*)(ws + WS_ABUF); g.Bt = (const bf16_t*)(ws + WS_WIN) + (size_t)l * INCP * 1024; g.M = T_; g.N = INCP; g.K = 1024;
  pg8::StaticOrder S; S.init(T_, INCP, gridDim.x, blockIdx.x);
  EpiProj E; E.PROJ = (bf16_t*)(ws + WS_PROJ); E.VTA = (bf16_t*)(ws + WS_VTA); E.VTR = (bf16_t*)(ws + WS_VTR);
  pg8::gemm_phase<EpiProj, pg8::StaticOrder>((PG8_LAS unsigned char*)smem, g, S, E);
}
__device__ void gemm_out_phase(const Params& p, int l, const float* __restrict__ xsrc, unsigned char* smem) {
  const CParamsP pp = launder_kargs();
  GAS unsigned char* const ws = launder_ptr(pp->ws);
  pg8::Gemm g; g.A = (const bf16_t*)(ws + WS_ABUF); g.Bt = (const bf16_t*)(ws + WS_WOUT) + (size_t)l * 1024 * 1024; g.M = T_; g.N = 1024; g.K = 1024;
  pg8::StaticOrder S; S.init(T_, 1024, gridDim.x, blockIdx.x);
  EpiOut E; E.xsrc = xsrc; E.X = (float*)(ws + WS_X); E.g1 = (const float*)(ws + WS_MOD) + (size_t)l * 2 * 6144 + 2048;
  E.nf = gin(pp->in[I_NFFN]) + (size_t)l * 1024; E.sc2 = (const float*)(ws + WS_MOD) + (size_t)l * 2 * 6144 + 4096; E.XG = (bf16_t*)(ws + WS_XG); E.SSQ = (float*)(ws + WS_SSQ);
  pg8::gemm_phase<EpiOut, pg8::StaticOrder>((PG8_LAS unsigned char*)smem, g, S, E);
}
__device__ void gemm_q_phase(const Params& p, int l, unsigned char* smem) {
  const CParamsP pp = launder_kargs();
  GAS unsigned char* const ws = launder_ptr(pp->ws);
  pg8::Gemm g; g.A = (const bf16_t*)(ws + WS_XG); g.Bt = (const bf16_t*)(ws + WS_WQ) + (size_t)l * 2048 * 1024; g.M = T_; g.N = 2048; g.K = 1024;
  pg8::StaticOrder S; S.init(T_, 2048, gridDim.x, blockIdx.x);
  EpiQ E; E.Q = (bf16_t*)(ws + WS_Q); E.SSQ = (const float*)(ws + WS_SSQ); E.C2 = (const float*)(ws + WS_C2) + (size_t)l * 2 * 2048;
  pg8::gemm_phase<EpiQ, pg8::StaticOrder>((PG8_LAS unsigned char*)smem, g, S, E);
}

__device__ __forceinline__ int attn_fk(int r) { return ((r >> 3) & 3) | (((r >> 1) & 1) << 2); }
__device__ __forceinline__ int attn_fv(int r) { return (r >> 1) & 7; }
__device__ void attn_phase(const Params& p, int l, unsigned char* smem) {
  const CParamsP pp = launder_kargs();
  GAS unsigned char* const ws = launder_ptr(pp->ws); const int tidx = launder_tid();
  const bf16_t* PROJ = (const bf16_t*)(ws + WS_PROJ); const bf16_t* VTA = (const bf16_t*)(ws + WS_VTA);
  float* ATT = (float*)(ws + WS_ATT);
  const int lane = tidx & 63, wid = tidx >> 6, fr = lane & 15, fq = lane >> 4;
  float* ext = (float*)smem;
  unsigned char* stg = smem + 15360;
  constexpr float LOG2E = 1.4426950408889634f;
  __syncthreads();
  for (int idx = tidx; idx < 6 * 640; idx += NT) {
    const int h = idx / 640, e = idx - h * 640; int d = e - 63; d = d > 256 ? 256 : d;
    ext[idx] = gin(pp->in[I_RELB])[((size_t)l * 6 + h) * 513 + d + 256] * LOG2E;
  }
  const int hh = wid >> 2, qb = wid & 3, iq = qb * 16 + fr;
  const int srow = tidx >> 3, sch = tidx & 7;
  for (int item = blockIdx.x; item < 256; item += gridDim.x) {
    const int b = item >> 7, n = item & 127, t0 = b * 8192 + n * 64;
    const int jc0 = n >= 8 ? 0 : 8 - n, nch = 9 - jc0, nst = 3 * nch;
    uint4 sr0, sr1, sr2, sr3;
#define ATTN_LOAD(st) do { const int _rd = (st) / nch, _jc = jc0 + (st) - _rd * nch, _m = n - 8 + _jc; \
      sr0 = *(const uint4*)(PROJ + (size_t)(b * 8192 + _m * 64 + srow) * INCP + C_KA + (2 * _rd) * 64 + sch * 8); \
      sr1 = *(const uint4*)(PROJ + (size_t)(b * 8192 + _m * 64 + srow) * INCP + C_KA + (2 * _rd + 1) * 64 + sch * 8); \
      sr2 = *(const uint4*)(VTA + ((size_t)b * 384 + (2 * _rd) * 64 + srow) * 8192 + _m * 64 + sch * 8); \
      sr3 = *(const uint4*)(VTA + ((size_t)b * 384 + (2 * _rd + 1) * 64 + srow) * 8192 + _m * 64 + sch * 8); } while (0)
#define ATTN_WRITE(buf) do { unsigned char* _bp = stg + (buf) * 32768; \
      *(uint4*)(_bp + srow * 128 + ((sch ^ attn_fk(srow)) << 4)) = sr0; \
      *(uint4*)(_bp + 8192 + srow * 128 + ((sch ^ attn_fk(srow)) << 4)) = sr1; \
      *(uint4*)(_bp + 16384 + srow * 128 + ((sch ^ attn_fv(srow)) << 4)) = sr2; \
      *(uint4*)(_bp + 24576 + srow * 128 + ((sch ^ attn_fv(srow)) << 4)) = sr3; } while (0)
    __syncthreads();
    ATTN_LOAD(0);
    ATTN_WRITE(0);
    __syncthreads();
    bf16x8 qf[2];
    f32x4 o[4];
    float mrun = -1e30f, lrun = 0.f;
    const float* exth = ext;
#pragma unroll 1
    for (int st = 0; st < nst; ++st) {
      const int rd = st / nch, jc = jc0 + st - rd * nch, h = 2 * rd + hh;
      if (st + 1 < nst) ATTN_LOAD(st + 1);
      if (jc == jc0) {
#pragma unroll
        for (int ds = 0; ds < 2; ++ds) qf[ds] = *(const bf16x8*)(PROJ + (size_t)(t0 + iq) * INCP + C_QA + h * 64 + ds * 32 + fq * 8);
#pragma unroll
        for (int et = 0; et < 4; ++et) o[et] = (f32x4){0.f, 0.f, 0.f, 0.f};
        mrun = -1e30f; lrun = 0.f;
        exth = ext + h * 640 + 63 + 512 + iq - 8 * fq;
      }
      const unsigned char* kb = stg + (st & 1) * 32768 + hh * 8192;
      const unsigned char* vb = stg + (st & 1) * 32768 + (2 + hh) * 8192;
      float sc[2][2][4];
#pragma unroll
      for (int g = 0; g < 2; ++g)
#pragma unroll
        for (int tt = 0; tt < 2; ++tt) {
          const int key = 32 * g + 8 * (fr >> 2) + (fr & 3) + 4 * tt, fk = attn_fk(key);
          const bf16x8 k0 = *(const bf16x8*)(kb + key * 128 + ((fq ^ fk) << 4));
          const bf16x8 k1 = *(const bf16x8*)(kb + key * 128 + (((4 + fq) ^ fk) << 4));
          f32x4 s4 = __builtin_amdgcn_mfma_f32_16x16x32_bf16(k0, qf[0], (f32x4){0.f, 0.f, 0.f, 0.f}, 0, 0, 0);
          s4 = __builtin_amdgcn_mfma_f32_16x16x32_bf16(k1, qf[1], s4, 0, 0, 0);
#pragma unroll
          for (int j = 0; j < 4; ++j) sc[g][tt][j] = s4[j] * (0.125f * LOG2E) + exth[-(64 * jc + 32 * g + 4 * tt + j)];
        }
      float mloc = -1e30f;
#pragma unroll
      for (int g = 0; g < 2; ++g)
#pragma unroll
        for (int tt = 0; tt < 2; ++tt)
#pragma unroll
          for (int j = 0; j < 4; ++j) mloc = fmaxf(mloc, sc[g][tt][j]);
      mloc = fmaxf(mloc, __shfl_xor(mloc, 16)); mloc = fmaxf(mloc, __shfl_xor(mloc, 32));
      const float mnew = fmaxf(mrun, mloc), alpha = __builtin_amdgcn_exp2f(mrun - mnew);
      mrun = mnew;
      float ls = 0.f;
#pragma unroll
      for (int g = 0; g < 2; ++g)
#pragma unroll
        for (int tt = 0; tt < 2; ++tt)
#pragma unroll
          for (int j = 0; j < 4; ++j) { const float e = __builtin_amdgcn_exp2f(sc[g][tt][j] - mnew); sc[g][tt][j] = e; ls += e; }
      lrun = lrun * alpha + ls;
#pragma unroll
      for (int et = 0; et < 4; ++et) { o[et].x *= alpha; o[et].y *= alpha; o[et].z *= alpha; o[et].w *= alpha; }
#pragma unroll
      for (int g = 0; g < 2; ++g) {
        union { bf16x8 v; unsigned u[4]; } pf;
        pf.u[0] = pk2(sc[g][0][0], sc[g][0][1]); pf.u[1] = pk2(sc[g][0][2], sc[g][0][3]);
        pf.u[2] = pk2(sc[g][1][0], sc[g][1][1]); pf.u[3] = pk2(sc[g][1][2], sc[g][1][3]);
#pragma unroll
        for (int et = 0; et < 4; ++et) {
          const int er = 16 * et + fr;
          const bf16x8 vf = *(const bf16x8*)(vb + er * 128 + (((4 * g + fq) ^ attn_fv(er)) << 4));
          o[et] = __builtin_amdgcn_mfma_f32_16x16x32_bf16(vf, pf.v, o[et], 0, 0, 0);
        }
      }
      if (jc == 8) {
        float lt = lrun + __shfl_xor(lrun, 16); lt += __shfl_xor(lt, 32);
        const float inv = 1.f / lt;
#pragma unroll
        for (int et = 0; et < 4; ++et) {
          f32x4 v = o[et]; v.x *= inv; v.y *= inv; v.z *= inv; v.w *= inv;
          *(f32x4*)(ATT + (size_t)(t0 + iq) * 384 + h * 64 + et * 16 + fq * 4) = v;
        }
      }
      if (st + 1 < nst) ATTN_WRITE((st + 1) & 1);
      __syncthreads();
    }
#undef ATTN_LOAD
#undef ATTN_WRITE
  }
  __syncthreads();
}

__device__ __forceinline__ void ssm_bu32(const bf16_t* __restrict__ bbh_g, const bf16_t* __restrict__ urow, int lane,
                                         f32x16& lo_re, f32x16& hi_re, f32x16& lo_im, f32x16& hi_im) {
  const int hf = lane >> 5, pl = lane & 31;
  const bf16x8 ub = *(const bf16x8*)(urow + 8 * hf);
  f32x16 z;
#pragma unroll
  for (int r = 0; r < 16; ++r) z[r] = 0.f;
  const bf16x8 a0r = *(const bf16x8*)(bbh_g + (size_t)(0 * 64 + pl) * 16 + 8 * hf), a1r = *(const bf16x8*)(bbh_g + (size_t)(0 * 64 + 32 + pl) * 16 + 8 * hf);
  const bf16x8 a0i = *(const bf16x8*)(bbh_g + (size_t)(1 * 64 + pl) * 16 + 8 * hf), a1i = *(const bf16x8*)(bbh_g + (size_t)(1 * 64 + 32 + pl) * 16 + 8 * hf);
  lo_re = __builtin_amdgcn_mfma_f32_32x32x16_bf16(ub, a0r, z, 0, 0, 0); hi_re = __builtin_amdgcn_mfma_f32_32x32x16_bf16(ub, a1r, z, 0, 0, 0);
  lo_im = __builtin_amdgcn_mfma_f32_32x32x16_bf16(ub, a0i, z, 0, 0, 0); hi_im = __builtin_amdgcn_mfma_f32_32x32x16_bf16(ub, a1i, z, 0, 0, 0);
#pragma unroll
  for (int r = 0; r < 16; ++r) {
    const auto s1 = __builtin_amdgcn_permlane32_swap(__float_as_uint(lo_re[r]), __float_as_uint(hi_re[r]), false, false);
    lo_re[r] = __uint_as_float(s1[0]); hi_re[r] = __uint_as_float(s1[1]);
    const auto s2 = __builtin_amdgcn_permlane32_swap(__float_as_uint(lo_im[r]), __float_as_uint(hi_im[r]), false, false);
    lo_im[r] = __uint_as_float(s2[0]); hi_im[r] = __uint_as_float(s2[1]);
  }
}
__device__ __forceinline__ void rotary_frag(const bf16x8 x0, const bf16x8 x1, const float* __restrict__ RC, const float* __restrict__ RS, int pos, int fq, float scale, bf16x8& o0, bf16x8& o1) {
  const f32x4 c0 = *(const f32x4*)(RC + pos * 32 + 8 * fq), c1 = *(const f32x4*)(RC + pos * 32 + 8 * fq + 4);
  const f32x4 s0 = *(const f32x4*)(RS + pos * 32 + 8 * fq), s1 = *(const f32x4*)(RS + pos * 32 + 8 * fq + 4);
  const float cc[8] = {c0.x, c0.y, c0.z, c0.w, c1.x, c1.y, c1.z, c1.w}, sn[8] = {s0.x, s0.y, s0.z, s0.w, s1.x, s1.y, s1.z, s1.w};
  union { bf16x8 v; unsigned u[4]; } r0, r1;
#pragma unroll
  for (int q = 0; q < 4; ++q) {
    const float a0 = bf2f((bf16_t)x0[2 * q]) * scale, a1 = bf2f((bf16_t)x0[2 * q + 1]) * scale, b0 = bf2f((bf16_t)x1[2 * q]) * scale, b1 = bf2f((bf16_t)x1[2 * q + 1]) * scale;
    r0.u[q] = pk2(a0 * cc[2 * q] - b0 * sn[2 * q], a1 * cc[2 * q + 1] - b1 * sn[2 * q + 1]);
    r1.u[q] = pk2(a0 * sn[2 * q] + b0 * cc[2 * q], a1 * sn[2 * q + 1] + b1 * cc[2 * q + 1]);
  }
  o0 = r0.v; o1 = r1.v;
}
__device__ void mix_local_phase(const Params& p, int l, unsigned char* smem) {
  const CParamsP pp = launder_kargs();
  GAS unsigned char* const ws = launder_ptr(pp->ws); const int tidx = launder_tid();
  const bf16_t* PROJ = (const bf16_t*)(ws + WS_PROJ); const bf16_t* VTR = (const bf16_t*)(ws + WS_VTR);
  const float* RC = (const float*)(ws + WS_ROTC); const float* RS = (const float*)(ws + WS_ROTS);
  float* YINT = (float*)(ws + WS_YINT); float* UPDT = (float*)(ws + WS_UPD);
  const float* SA = (const float*)(ws + WS_SA) + (size_t)l * 16 * 64 * 2; const bf16_t* BBH = (const bf16_t*)(ws + WS_BBH) + (size_t)l * 16 * 2 * 64 * 16;
  float* SEND = (float*)(ws + WS_SEND);
  const int tid = tidx, lane = tid & 63, wid = tid >> 6, fr = lane & 15, fq = lane >> 4;
  bf16_t* KT = (bf16_t*)smem;
  for (int item = blockIdx.x; item < 256; item += gridDim.x) {
    const int b = item >> 7, n = item & 127, t0 = b * 8192 + n * 64;
    __syncthreads();
#pragma unroll 1
    for (int k3 = 0; k3 < 3; ++k3) {
      const int task = wid * 3 + k3, h = task >> 2, tb = task & 3;
      const int i = 16 * tb + fr;
      const float lg2 = log2f(1.f - exp2f(-5.f - (float)h));
      bf16x8 qf0, qf1;
      {
        const bf16_t* qp = PROJ + (size_t)(t0 + i) * INCP + C_QR + h * 64 + 8 * fq;
        rotary_frag(*(const bf16x8*)qp, *(const bf16x8*)(qp + 32), RC, RS, n * 64 + i, fq, 1.f, qf0, qf1);
      }
      f32x4 o[4];
#pragma unroll
      for (int et = 0; et < 4; ++et) o[et] = (f32x4){0.f, 0.f, 0.f, 0.f};
#pragma unroll
      for (int g = 0; g < 2; ++g) {
        float st[2][4];
#pragma unroll
        for (int tt = 0; tt < 2; ++tt) {
          const int key = 32 * g + 8 * (fr >> 2) + (fr & 3) + 4 * tt;
          const bf16_t* kp = PROJ + (size_t)(t0 + key) * INCP + C_KR + h * 64 + 8 * fq;
          bf16x8 kf0, kf1;
          rotary_frag(*(const bf16x8*)kp, *(const bf16x8*)(kp + 32), RC, RS, n * 64 + key, fq, 0.125f, kf0, kf1);
          f32x4 s4 = __builtin_amdgcn_mfma_f32_16x16x32_bf16(kf0, qf0, (f32x4){0.f, 0.f, 0.f, 0.f}, 0, 0, 0);
          s4 = __builtin_amdgcn_mfma_f32_16x16x32_bf16(kf1, qf1, s4, 0, 0, 0);
#pragma unroll
          for (int j = 0; j < 4; ++j) {
            const int kk = 32 * g + 8 * fq + 4 * tt + j;
            const int dij = i > kk ? i - kk : kk - i;
            st[tt][j] = s4[j] * exp2f(lg2 * (float)dij);
          }
          if (tb == 0) {
            const float kd = exp2f(lg2 * (float)(63 - key));
#pragma unroll
            for (int jj = 0; jj < 8; ++jj) {
              KT[(h * 64 + 8 * fq + jj) * 72 + key] = f2bf(bf2f((bf16_t)kf0[jj]) * kd);
              KT[(h * 64 + 32 + 8 * fq + jj) * 72 + key] = f2bf(bf2f((bf16_t)kf1[jj]) * kd);
            }
          }
        }
        union { bf16x8 v; unsigned u[4]; } pf;
        pf.u[0] = pk2(st[0][0], st[0][1]); pf.u[1] = pk2(st[0][2], st[0][3]); pf.u[2] = pk2(st[1][0], st[1][1]); pf.u[3] = pk2(st[1][2], st[1][3]);
#pragma unroll
        for (int et = 0; et < 4; ++et) {
          const bf16x8 vf = *(const bf16x8*)(VTR + ((size_t)b * 384 + h * 64 + et * 16 + fr) * 8192 + n * 64 + 32 * g + 8 * fq);
          o[et] = __builtin_amdgcn_mfma_f32_16x16x32_bf16(vf, pf.v, o[et], 0, 0, 0);
        }
      }
#pragma unroll
      for (int et = 0; et < 4; ++et) *(f32x4*)(YINT + (size_t)(t0 + i) * 384 + h * 64 + et * 16 + fq * 4) = o[et];
    }
    __syncthreads();
#pragma unroll 1
    for (int k3 = 0; k3 < 3; ++k3) {
      const int task = wid * 3 + k3, h = task >> 2, et = task & 3;
      f32x4 acc[4];
#pragma unroll
      for (int dt = 0; dt < 4; ++dt) acc[dt] = (f32x4){0.f, 0.f, 0.f, 0.f};
#pragma unroll
      for (int g = 0; g < 2; ++g) {
        const bf16x8 vf = *(const bf16x8*)(VTR + ((size_t)b * 384 + h * 64 + et * 16 + fr) * 8192 + n * 64 + 32 * g + 8 * fq);
#pragma unroll
        for (int dt = 0; dt < 4; ++dt) {
          const bf16x8 kt = *(const bf16x8*)(KT + (h * 64 + 16 * dt + fr) * 72 + 32 * g + 8 * fq);
          acc[dt] = __builtin_amdgcn_mfma_f32_16x16x32_bf16(kt, vf, acc[dt], 0, 0, 0);
        }
      }
#pragma unroll
      for (int dt = 0; dt < 4; ++dt) *(f32x4*)(UPDT + (((size_t)item * 6 + h) * 64 + 16 * et + fr) * 64 + 16 * dt + 4 * fq) = acc[dt];
    }
#pragma unroll 1
    for (int gi = 0; gi < 2; ++gi) {
      const int g = wid * 2 + gi;
      const float are = SA[(g * 64 + lane) * 2], aim = SA[(g * 64 + lane) * 2 + 1];
      float xr = 0.f, xi = 0.f;
#pragma unroll 1
      for (int blk = 0; blk < 2; ++blk) {
        f32x16 lr, hr, li, hi;
        ssm_bu32(BBH + (size_t)g * 2 * 64 * 16, PROJ + (size_t)(t0 + 32 * blk + (lane & 31)) * INCP + C_US + g * 16, lane, lr, hr, li, hi);
#pragma unroll
        for (int a4 = 0; a4 < 4; ++a4) {
#pragma unroll
          for (int bq = 0; bq < 4; ++bq) { const float nr = are * xr - aim * xi + lr[4 * a4 + bq], ni = are * xi + aim * xr + li[4 * a4 + bq]; xr = nr; xi = ni; }
#pragma unroll
          for (int bq = 0; bq < 4; ++bq) { const float nr = are * xr - aim * xi + hr[4 * a4 + bq], ni = are * xi + aim * xr + hi[4 * a4 + bq]; xr = nr; xi = ni; }
        }
      }
      SEND[(((size_t)item * 16 + g) * 64 + lane) * 2] = xr; SEND[(((size_t)item * 16 + g) * 64 + lane) * 2 + 1] = xi;
    }
  }
}

__device__ void scan_phase(const Params& p, int l) {
  const CParamsP pp = launder_kargs();
  GAS unsigned char* const ws = launder_ptr(pp->ws); const int tidx = launder_tid();
  const float* __restrict__ UPDT = (const float*)(ws + WS_UPD); bf16_t* __restrict__ SPT = (bf16_t*)(ws + WS_SPT);
  const float* __restrict__ SEND = (const float*)(ws + WS_SEND); float* __restrict__ CARRY = (float*)(ws + WS_CARRY);
  const float* SA = (const float*)(ws + WS_SA) + (size_t)l * 16 * 64 * 2;
  const int gtid = blockIdx.x * NT + tidx, gn = gridDim.x * NT;
  for (int idx = gtid; idx < 2 * 6 * 4096 + 2 * 1024; idx += gn) {
    if (idx < 2 * 6 * 4096) {
      const int b = idx / (6 * 4096), r = idx % (6 * 4096), h = r >> 12;
      const float cd = exp2f(64.f * log2f(1.f - exp2f(-5.f - (float)h)));
      float s = 0.f;
#pragma unroll 1
      for (int nb = 0; nb < NCH; nb += 16) {
        float v[16];
#pragma unroll
        for (int j = 0; j < 16; ++j) v[j] = UPDT[((size_t)(b * NCH + nb + j)) * 6 * 4096 + r];
#pragma unroll
        for (int j = 0; j < 16; ++j) { SPT[((size_t)(b * NCH + nb + j)) * 6 * 4096 + r] = f2bf(s); s = cd * s + v[j]; }
      }
    } else {
      const int r2 = idx - 2 * 6 * 4096, b = r2 >> 10, gp = r2 & 1023;
      float ar = SA[gp * 2], ai = SA[gp * 2 + 1];
#pragma unroll
      for (int q = 0; q < 6; ++q) { const float nr = ar * ar - ai * ai, ni = 2.f * ar * ai; ar = nr; ai = ni; }
      float xr = 0.f, xi = 0.f;
#pragma unroll 1
      for (int nb = 0; nb < NCH; nb += 16) {
        float2 v[16];
#pragma unroll
        for (int j = 0; j < 16; ++j) v[j] = *(const float2*)(SEND + (((size_t)(b * NCH + nb + j)) * 1024 + gp) * 2);
#pragma unroll
        for (int j = 0; j < 16; ++j) {
          *(float2*)(CARRY + (((size_t)(b * NCH + nb + j)) * 1024 + gp) * 2) = make_float2(xr, xi);
          const float nr = ar * xr - ai * xi + v[j].x, ni = ar * xi + ai * xr + v[j].y;
          xr = nr; xi = ni;
        }
      }
    }
  }
  if (l + 1 < DEPTH_) convert_tables_fp4(pp, ws, l + 1, gtid, gn);
}

__device__ void mix_final_phase(const Params& p, int l, unsigned char* smem) {
  const CParamsP pp = launder_kargs();
  GAS unsigned char* const ws = launder_ptr(pp->ws); const int tidx = launder_tid();
  const bf16_t* PROJ = (const bf16_t*)(ws + WS_PROJ);
  const float* RC = (const float*)(ws + WS_ROTC); const float* RS = (const float*)(ws + WS_ROTS);
  const float* YINT = (const float*)(ws + WS_YINT); const bf16_t* SPT = (const bf16_t*)(ws + WS_SPT);
  const float* ATT = (const float*)(ws + WS_ATT);
  const float* SA = (const float*)(ws + WS_SA) + (size_t)l * 16 * 64 * 2; const bf16_t* BBH = (const bf16_t*)(ws + WS_BBH) + (size_t)l * 16 * 2 * 64 * 16;
  const float* CARRY = (const float*)(ws + WS_CARRY);
  const bf16_t* CB = (const bf16_t*)(ws + WS_CB) + (size_t)l * 16 * 16 * 128; const bf16_t* WG = (const bf16_t*)(ws + WS_WGLUT) + (size_t)l * 512 * 256;
  const float* dsk = gin(pp->in[I_SSMD]) + (size_t)l * 256;
  const float* mg = gin(pp->in[I_MGAIN]) + (size_t)l * 1024;
  bf16_t* MRG = (bf16_t*)(ws + WS_ABUF);
  const int tid = tidx, lane = tid & 63, wid = tid >> 6, fr = lane & 15, fq = lane >> 4;
  bf16_t* YS = (bf16_t*)smem;
  float* red = (float*)(smem + 33792);
  bf16_t* XB = (bf16_t*)(smem + 36864 + wid * 8448 + 4096);
  for (int item = blockIdx.x; item < 256; item += gridDim.x) {
    const int b = item >> 7, n = item & 127, t0 = b * 8192 + n * 64;
    __syncthreads();
    for (int ii = 0; ii < 8; ++ii) {
      const int t = t0 + wid * 8 + ii;
      float v[6]; float sq = 0.f;
#pragma unroll
      for (int j = 0; j < 6; ++j) { v[j] = ATT[(size_t)t * 384 + lane + 64 * j]; sq += v[j] * v[j]; }
      const float rstd = rsqrtf(wave_sum(sq) * (1.f / 384.f) + EPS_);
#pragma unroll
      for (int j = 0; j < 6; ++j) MRG[(size_t)t * 1024 + lane + 64 * j] = f2bf(v[j] * rstd * mg[lane + 64 * j]);
    }
#pragma unroll 1
    for (int k3 = 0; k3 < 3; ++k3) {
      const int task = wid * 3 + k3, h = task >> 2, tb = task & 3;
      const int i = 16 * tb + fr, t = t0 + i;
      const float lg2 = log2f(1.f - exp2f(-5.f - (float)h));
      bf16x8 qf0, qf1;
      {
        const bf16_t* qp = PROJ + (size_t)t * INCP + C_QR + h * 64 + 8 * fq;
        rotary_frag(*(const bf16x8*)qp, *(const bf16x8*)(qp + 32), RC, RS, n * 64 + i, fq, 1.f, qf0, qf1);
      }
      f32x4 o[4];
#pragma unroll
      for (int et = 0; et < 4; ++et) {
        const bf16_t* sp = SPT + (((size_t)item * 6 + h) * 64 + 16 * et + fr) * 64 + 8 * fq;
        const bf16x8 a0 = *(const bf16x8*)sp, a1 = *(const bf16x8*)(sp + 32);
        o[et] = __builtin_amdgcn_mfma_f32_16x16x32_bf16(a0, qf0, (f32x4){0.f, 0.f, 0.f, 0.f}, 0, 0, 0);
        o[et] = __builtin_amdgcn_mfma_f32_16x16x32_bf16(a1, qf1, o[et], 0, 0, 0);
      }
      const float qd = exp2f(lg2 * (float)(i + 1));
      float y[16]; float s1 = 0.f;
#pragma unroll
      for (int et = 0; et < 4; ++et) {
        const f32x4 yi = *(const f32x4*)(YINT + (size_t)t * 384 + h * 64 + 16 * et + 4 * fq);
        y[4 * et] = yi.x + qd * o[et].x; y[4 * et + 1] = yi.y + qd * o[et].y; y[4 * et + 2] = yi.z + qd * o[et].z; y[4 * et + 3] = yi.w + qd * o[et].w;
        s1 += (y[4 * et] + y[4 * et + 1]) + (y[4 * et + 2] + y[4 * et + 3]);
      }
      s1 += __shfl_xor(s1, 16); s1 += __shfl_xor(s1, 32);
      const float mu = s1 * (1.f / 64.f);
      float s2 = 0.f;
#pragma unroll
      for (int q = 0; q < 16; ++q) { y[q] -= mu; s2 += y[q] * y[q]; }
      s2 += __shfl_xor(s2, 16); s2 += __shfl_xor(s2, 32);
      const float rstd = rsqrtf(s2 * (1.f / 64.f) + EPS_);
#pragma unroll
      for (int et = 0; et < 4; ++et) {
        const int c = h * 64 + 16 * et + 4 * fq;
        const uint2 gr = *(const uint2*)(PROJ + (size_t)t * INCP + C_GR + c);
        const float g0 = __uint_as_float(gr.x << 16), g1 = __uint_as_float(gr.x & 0xffff0000u), g2 = __uint_as_float(gr.y << 16), g3 = __uint_as_float(gr.y & 0xffff0000u);
        const f32x4 mgv = *(const f32x4*)(mg + 384 + c);
        uint2 ov;
        ov.x = pk2(y[4 * et] * rstd * (g0 * sigmoid_f(g0)) * mgv.x, y[4 * et + 1] * rstd * (g1 * sigmoid_f(g1)) * mgv.y);
        ov.y = pk2(y[4 * et + 2] * rstd * (g2 * sigmoid_f(g2)) * mgv.z, y[4 * et + 3] * rstd * (g3 * sigmoid_f(g3)) * mgv.w);
        *(uint2*)(MRG + (size_t)t * 1024 + 384 + c) = ov;
      }
    }
#pragma unroll 1
    for (int gi = 0; gi < 2; ++gi) {
      const int g = wid * 2 + gi;
      const float are = SA[(g * 64 + lane) * 2], aim = SA[(g * 64 + lane) * 2 + 1];
      float xr = CARRY[(((size_t)item * 16 + g) * 64 + lane) * 2], xi = CARRY[(((size_t)item * 16 + g) * 64 + lane) * 2 + 1];
      bf16x8 cb[4];
#pragma unroll
      for (int ks = 0; ks < 4; ++ks) cb[ks] = *(const bf16x8*)(CB + ((size_t)g * 16 + fr) * 128 + 32 * ks + 8 * fq);
      const float dv = dsk[g * 16 + fr];
#pragma unroll 1
      for (int blk = 0; blk < 2; ++blk) {
        f32x16 lr, hr, li, hi;
        ssm_bu32(BBH + (size_t)g * 2 * 64 * 16, PROJ + (size_t)(t0 + 32 * blk + (lane & 31)) * INCP + C_US + g * 16, lane, lr, hr, li, hi);
#pragma unroll
        for (int half = 0; half < 2; ++half) {
#pragma unroll
          for (int a2 = 0; a2 < 2; ++a2) {
            const int a4 = 2 * half + a2;
#pragma unroll
            for (int bq = 0; bq < 4; ++bq) {
              const float nr = are * xr - aim * xi + lr[4 * a4 + bq], ni = are * xi + aim * xr + li[4 * a4 + bq]; xr = nr; xi = ni;
              XB[(8 * a2 + bq) * 136 + lane] = f2bf(xr); XB[(8 * a2 + bq) * 136 + 64 + lane] = f2bf(xi);
            }
#pragma unroll
            for (int bq = 0; bq < 4; ++bq) {
              const float nr = are * xr - aim * xi + hr[4 * a4 + bq], ni = are * xi + aim * xr + hi[4 * a4 + bq]; xr = nr; xi = ni;
              XB[(8 * a2 + 4 + bq) * 136 + lane] = f2bf(xr); XB[(8 * a2 + 4 + bq) * 136 + 64 + lane] = f2bf(xi);
            }
          }
          f32x4 acc = (f32x4){0.f, 0.f, 0.f, 0.f};
#pragma unroll
          for (int ks = 0; ks < 4; ++ks) {
            const bf16x8 af = *(const bf16x8*)(XB + fr * 136 + 32 * ks + 8 * fq);
            acc = __builtin_amdgcn_mfma_f32_16x16x32_bf16(af, cb[ks], acc, 0, 0, 0);
          }
#pragma unroll
          for (int j = 0; j < 4; ++j) {
            const int i = 32 * blk + 16 * half + 4 * fq + j;
            const float yv = acc[j] + dv * bf2f(PROJ[(size_t)(t0 + i) * INCP + C_US + g * 16 + fr]);
            YS[i * 264 + g * 16 + fr] = f2bf(gelu_tanh(yv));
          }
        }
      }
    }
    __syncthreads();
    {
      const int n0 = 32 * wid;
      f32x4 a1[4][2], a2[4][2];
#pragma unroll
      for (int mt = 0; mt < 4; ++mt)
#pragma unroll
        for (int nt = 0; nt < 2; ++nt) { a1[mt][nt] = (f32x4){0.f, 0.f, 0.f, 0.f}; a2[mt][nt] = (f32x4){0.f, 0.f, 0.f, 0.f}; }
#pragma unroll 2
      for (int ks = 0; ks < 8; ++ks) {
        bf16x8 w1[2], w2[2], yb[4];
#pragma unroll
        for (int nt = 0; nt < 2; ++nt) {
          w1[nt] = *(const bf16x8*)(WG + (size_t)(n0 + 16 * nt + fr) * 256 + 32 * ks + 8 * fq);
          w2[nt] = *(const bf16x8*)(WG + (size_t)(256 + n0 + 16 * nt + fr) * 256 + 32 * ks + 8 * fq);
        }
#pragma unroll
        for (int mt = 0; mt < 4; ++mt) yb[mt] = *(const bf16x8*)(YS + (16 * mt + fr) * 264 + 32 * ks + 8 * fq);
#pragma unroll
        for (int mt = 0; mt < 4; ++mt)
#pragma unroll
          for (int nt = 0; nt < 2; ++nt) {
            a1[mt][nt] = __builtin_amdgcn_mfma_f32_16x16x32_bf16(w1[nt], yb[mt], a1[mt][nt], 0, 0, 0);
            a2[mt][nt] = __builtin_amdgcn_mfma_f32_16x16x32_bf16(w2[nt], yb[mt], a2[mt][nt], 0, 0, 0);
          }
      }
#pragma unroll
      for (int mt = 0; mt < 4; ++mt) {
        float sq = 0.f;
#pragma unroll
        for (int nt = 0; nt < 2; ++nt) {
          f32x4 z = a1[mt][nt]; const f32x4 zg = a2[mt][nt];
          z.x *= sigmoid_f(zg.x); z.y *= sigmoid_f(zg.y); z.z *= sigmoid_f(zg.z); z.w *= sigmoid_f(zg.w);
          a1[mt][nt] = z; sq += z.x * z.x + z.y * z.y + z.z * z.z + z.w * z.w;
        }
        sq += __shfl_xor(sq, 16); sq += __shfl_xor(sq, 32);
        if (fq == 0) red[wid * 64 + 16 * mt + fr] = sq;
      }
      __syncthreads();
#pragma unroll
      for (int mt = 0; mt < 4; ++mt) {
        const int i = 16 * mt + fr, t = t0 + i;
        float tot = 0.f;
#pragma unroll
        for (int w8 = 0; w8 < 8; ++w8) tot += red[w8 * 64 + i];
        const float rstd = rsqrtf(tot * (1.f / 256.f) + EPS_);
#pragma unroll
        for (int nt = 0; nt < 2; ++nt) {
          const int c = n0 + 16 * nt + 4 * fq;
          const f32x4 mgv = *(const f32x4*)(mg + 768 + c); const f32x4 z = a1[mt][nt];
          uint2 ov; ov.x = pk2(z.x * rstd * mgv.x, z.y * rstd * mgv.y); ov.y = pk2(z.z * rstd * mgv.z, z.w * rstd * mgv.w);
          *(uint2*)(MRG + (size_t)t * 1024 + 768 + c) = ov;
        }
      }
    }
  }
}

typedef float f32x2 __attribute__((ext_vector_type(2)));
__device__ __forceinline__ float dot16_fp4(const uint2 u, const f32x2 (&hv)[8]) {
  f32x2 d = __builtin_amdgcn_cvt_scalef32_pk_f32_fp4(u.x, 1.0f, 0) * hv[0];
  d += __builtin_amdgcn_cvt_scalef32_pk_f32_fp4(u.x, 1.0f, 1) * hv[1];
  d += __builtin_amdgcn_cvt_scalef32_pk_f32_fp4(u.x, 1.0f, 2) * hv[2];
  d += __builtin_amdgcn_cvt_scalef32_pk_f32_fp4(u.x, 1.0f, 3) * hv[3];
  d += __builtin_amdgcn_cvt_scalef32_pk_f32_fp4(u.y, 1.0f, 0) * hv[4];
  d += __builtin_amdgcn_cvt_scalef32_pk_f32_fp4(u.y, 1.0f, 1) * hv[5];
  d += __builtin_amdgcn_cvt_scalef32_pk_f32_fp4(u.y, 1.0f, 2) * hv[6];
  d += __builtin_amdgcn_cvt_scalef32_pk_f32_fp4(u.y, 1.0f, 3) * hv[7];
  return d.x + d.y;
}
__device__ __forceinline__ void axpy16_fp4(const uint2 v, const float w, f32x2 (&acc)[8]) {
  const f32x2 w2 = (f32x2){w, w};
  acc[0] += w2 * __builtin_amdgcn_cvt_scalef32_pk_f32_fp4(v.x, 1.0f, 0);
  acc[1] += w2 * __builtin_amdgcn_cvt_scalef32_pk_f32_fp4(v.x, 1.0f, 1);
  acc[2] += w2 * __builtin_amdgcn_cvt_scalef32_pk_f32_fp4(v.x, 1.0f, 2);
  acc[3] += w2 * __builtin_amdgcn_cvt_scalef32_pk_f32_fp4(v.x, 1.0f, 3);
  acc[4] += w2 * __builtin_amdgcn_cvt_scalef32_pk_f32_fp4(v.y, 1.0f, 0);
  acc[5] += w2 * __builtin_amdgcn_cvt_scalef32_pk_f32_fp4(v.y, 1.0f, 1);
  acc[6] += w2 * __builtin_amdgcn_cvt_scalef32_pk_f32_fp4(v.y, 1.0f, 2);
  acc[7] += w2 * __builtin_amdgcn_cvt_scalef32_pk_f32_fp4(v.y, 1.0f, 3);
}
__device__ __forceinline__ float vmaxf(float a, float b) { float r; asm("v_max_f32 %0, %1, %2" : "=v"(r) : "v"(a), "v"(b)); return r; }
__device__ __forceinline__ float vminf(float a, float b) { float r; asm("v_min_f32 %0, %1, %2" : "=v"(r) : "v"(a), "v"(b)); return r; }
__device__ __forceinline__ void cx(float& hi, float& lo) { const float a = hi, b = lo; hi = vmaxf(a, b); lo = vminf(a, b); }
__device__ __forceinline__ void cx2(float& kh, int& ph, float& kl, int& pl) {
  const float a = kh, b = kl; const int pa = ph, pb = pl; const bool c = a >= b;
  kh = vmaxf(a, b); kl = vminf(a, b); ph = c ? pa : pb; pl = c ? pb : pa;
}
__device__ __forceinline__ void bitonic_sort16_desc(float (&v)[16]) {
#pragma unroll
  for (int k = 2; k <= 16; k <<= 1)
#pragma unroll
    for (int j = k >> 1; j > 0; j >>= 1)
#pragma unroll
      for (int i = 0; i < 16; ++i) {
        const int l = i ^ j;
        if (l > i) { if ((i & k) == 0) cx(v[i], v[l]); else cx(v[l], v[i]); }
      }
}
__device__ __forceinline__ void bitonic_merge16_desc(float (&v)[16]) {
#pragma unroll
  for (int j = 8; j > 0; j >>= 1)
#pragma unroll
    for (int i = 0; i < 16; ++i) { const int l = i ^ j; if (l > i) cx(v[i], v[l]); }
}
__device__ __forceinline__ void top16_merge(float (&a)[16], const float (&b)[16]) {
#pragma unroll
  for (int i = 0; i < 16; ++i) a[i] = vmaxf(a[i], b[15 - i]);
  bitonic_merge16_desc(a);
}
template <int M> __device__ __forceinline__ void top16_merge_chain(float (&k)[16], int (&q)[16], const float (&xk)[M], const int (&xq)[M]) {
#pragma unroll
  for (int i = 16 - M; i < 16; ++i) { const float a = k[i], b = xk[15 - i]; const bool c = a >= b; k[i] = vmaxf(a, b); q[i] = c ? q[i] : xq[15 - i]; }
#pragma unroll
  for (int j = 8; j > 0; j >>= 1)
#pragma unroll
    for (int i = 0; i < 16; ++i) { const int l = i ^ j; if (l > i) cx2(k[i], q[i], k[l], q[l]); }
}

__device__ void peer_phase(const Params& p, int l, bool last, unsigned char* smem) {
  const CParamsP pp = launder_kargs();
  GAS unsigned char* const ws = launder_ptr(pp->ws); const int tidx = launder_tid();
  bf16_t* HF = (bf16_t*)(ws + WS_ABUF); float* X = (float*)(ws + WS_X);
  const bf16_t* Q = (const bf16_t*)(ws + WS_Q); const bf16_t* SK = (const bf16_t*)(ws + WS_SUBK) + (size_t)l * 16 * 128 * 128;
  const uint2* U4 = (const uint2*)(ws + WS_PU8) + (size_t)l * 16384 * 64; const uint2* V4 = (const uint2*)(ws + WS_PV8) + (size_t)l * 16384 * 64;
  const float* g2 = (const float*)(ws + WS_MOD) + (size_t)l * 2 * 6144 + 5120;
  const bf16_t* XG = (const bf16_t*)(ws + WS_XG); const float* SSQ = (const float*)(ws + WS_SSQ); const float* sh2 = (const float*)(ws + WS_MOD) + (size_t)l * 2 * 6144 + 3072;
  const int ln = last ? l : l + 1;
  const float* nsh = (const float*)(ws + WS_MOD) + (size_t)ln * 2 * 6144; const float* nsc = nsh + 1024;
  const float* ngain = gin(pp->in[I_NMIX]) + (size_t)ln * 1024;
  const int lane = tidx & 63, wid = tidx >> 6;
  const int rL = ((lane >> 5) & 1) * 8 + ((lane >> 4) & 1) * 4 + ((lane >> 3) & 1) * 2 + ((lane >> 2) & 1);
  const bool hi5 = (lane & 32) != 0, hi4 = (lane & 16) != 0, hi3 = (lane & 8) != 0, hi2 = (lane & 4) != 0;
  int* idxL = (int*)smem; float* gateL = (float*)(smem + 64 * 132 * 4);
  for (int item = blockIdx.x; item < T_ / 64; item += gridDim.x) {
    const int t0 = item * 64;
    __syncthreads();
    {
      int lane_o = lane; asm volatile("" : "+v"(lane_o));
      const int tg = wid & 1, hp = wid >> 1, hf = lane_o >> 5, tl = 32 * tg + (lane_o & 31);
      const bf16_t* qrow = Q + (size_t)(t0 + tl) * 2048;
      float F[2][16];
#pragma unroll
      for (int sd = 0; sd < 2; ++sd) {
        float Lh[2][16];
#pragma unroll
        for (int hh = 0; hh < 2; ++hh) {
          const int hs = 2 * (2 * hp + hh) + sd;
          float top[16];
          const bf16_t* skb = SK + ((size_t)hs * 128 + (lane & 31)) * 128 + 8 * hf;
#pragma unroll
          for (int kp = 0; kp < 2; ++kp) {
            f32x16 acc[2];
#pragma unroll
            for (int kt = 0; kt < 2; ++kt)
#pragma unroll
              for (int r = 0; r < 16; ++r) acc[kt][r] = 0.f;
#pragma unroll 2
            for (int ks = 0; ks < 8; ++ks) {
              const bf16x8 bq = *(const bf16x8*)(qrow + hs * 128 + ks * 16 + 8 * hf);
#pragma unroll
              for (int kt = 0; kt < 2; ++kt) {
                const bf16x8 ak = *(const bf16x8*)(skb + (size_t)(kp * 2 + kt) * 32 * 128 + ks * 16);
                acc[kt] = __builtin_amdgcn_mfma_f32_32x32x16_bf16(ak, bq, acc[kt], 0, 0, 0);
              }
            }
#pragma unroll
            for (int kt = 0; kt < 2; ++kt) {
              float g[16];
#pragma unroll
              for (int r = 0; r < 16; ++r) {
                const int key = (kp * 2 + kt) * 32 + (r & 3) + 8 * (r >> 2) + 4 * hf;
                g[r] = __uint_as_float((__float_as_uint(acc[kt][r]) & 0xffffff80u) | (unsigned)key);
              }
              bitonic_sort16_desc(g);
              if (kp == 0 && kt == 0) {
#pragma unroll
                for (int r = 0; r < 16; ++r) top[r] = g[r];
              } else top16_merge(top, g);
              __builtin_amdgcn_sched_barrier(0);
            }
          }
#pragma unroll
          for (int r = 0; r < 16; ++r) Lh[hh][r] = top[r];
          __builtin_amdgcn_sched_barrier(0);
        }
#pragma unroll
        for (int r = 0; r < 16; ++r) {
          const auto sw = __builtin_amdgcn_permlane32_swap(__float_as_uint(Lh[0][r]), __float_as_uint(Lh[1][r]), false, false);
          Lh[0][r] = __uint_as_float(sw[0]); Lh[1][r] = __uint_as_float(sw[1]);
        }
        top16_merge(Lh[0], Lh[1]);
#pragma unroll
        for (int r = 0; r < 16; ++r) F[sd][r] = Lh[0][r];
        __builtin_amdgcn_sched_barrier(0);
      }
      int ia[16], ib[16];
#pragma unroll
      for (int r = 0; r < 16; ++r) { ia[r] = (int)(__float_as_uint(F[0][r]) & 127u) << 7; ib[r] = (int)(__float_as_uint(F[1][r]) & 127u); }
      float k[16]; int q[16];
#pragma unroll
      for (int j = 0; j < 16; ++j) { k[j] = F[0][0] + F[1][j]; q[j] = ia[0] | ib[j]; }
      { float xk[8]; int xq[8];
#pragma unroll
        for (int j = 0; j < 8; ++j) { xk[j] = F[0][1] + F[1][j]; xq[j] = ia[1] | ib[j]; }
        top16_merge_chain<8>(k, q, xk, xq); }
      { float xk[5]; int xq[5];
#pragma unroll
        for (int j = 0; j < 5; ++j) { xk[j] = F[0][2] + F[1][j]; xq[j] = ia[2] | ib[j]; }
        top16_merge_chain<5>(k, q, xk, xq); }
      { float xk[4]; int xq[4];
#pragma unroll
        for (int j = 0; j < 4; ++j) { xk[j] = F[0][3] + F[1][j]; xq[j] = ia[3] | ib[j]; }
        top16_merge_chain<4>(k, q, xk, xq); }
      { float xk[3]; int xq[3];
#pragma unroll
        for (int j = 0; j < 3; ++j) { xk[j] = F[0][4] + F[1][j]; xq[j] = ia[4] | ib[j]; }
        top16_merge_chain<3>(k, q, xk, xq); }
      { float xk[11]; int xq[11];
#pragma unroll
        for (int i = 0; i < 11; ++i) { xk[i] = F[0][5 + i] + F[1][0]; xq[i] = ia[5 + i] | ib[0]; }
        top16_merge_chain<11>(k, q, xk, xq); }
      { float xk[3]; int xq[3];
#pragma unroll
        for (int i = 0; i < 3; ++i) { xk[i] = F[0][5 + i] + F[1][1]; xq[i] = ia[5 + i] | ib[1]; }
        top16_merge_chain<3>(k, q, xk, xq); }
      float e[16]; float es = 0.f;
#pragma unroll
      for (int i = 0; i < 16; ++i) { e[i] = __expf(k[i] - k[0]); es += e[i]; }
      const float ies = 1.f / es;
      const int h = 2 * hp + hf;
#pragma unroll
      for (int i = 0; i < 16; ++i) { idxL[tl * 132 + h * 16 + i] = q[i]; gateL[tl * 132 + h * 16 + i] = e[i] * ies; }
    }
    __syncthreads();
#pragma unroll 1
    for (int ii = 0; ii < 8; ++ii) {
      const int tl = wid * 8 + ii, t = t0 + tl, b = t >> 13;
      f32x2 hv[8];
      {
        const uint4 h0 = *(const uint4*)(XG + (size_t)t * 1024 + lane * 16), h1 = *(const uint4*)(XG + (size_t)t * 1024 + lane * 16 + 8);
        const unsigned hw[8] = {h0.x, h0.y, h0.z, h0.w, h1.x, h1.y, h1.z, h1.w};
        const float rs = rsqrtf(ssq_total(SSQ, t) * (1.f / 1024.f) + EPS_);
#pragma unroll
        for (int qq = 0; qq < 4; ++qq) {
          const f32x4 sh = *(const f32x4*)(sh2 + b * 6144 + lane * 16 + 4 * qq);
          hv[2 * qq] = (f32x2){__uint_as_float(hw[2 * qq] << 16) * rs + sh.x, __uint_as_float(hw[2 * qq] & 0xffff0000u) * rs + sh.y};
          hv[2 * qq + 1] = (f32x2){__uint_as_float(hw[2 * qq + 1] << 16) * rs + sh.z, __uint_as_float(hw[2 * qq + 1] & 0xffff0000u) * rs + sh.w};
        }
      }
      const int e0 = idxL[tl * 132 + lane], e1 = idxL[tl * 132 + 64 + lane];
      const float g0 = gateL[tl * 132 + lane], g1 = gateL[tl * 132 + 64 + lane];
      f32x2 acc2[8];
#pragma unroll
      for (int j = 0; j < 8; ++j) acc2[j] = (f32x2){0.f, 0.f};
#pragma unroll 1
      for (int bt = 0; bt < 8; ++bt) {
        const int esrc = (bt < 4) ? e0 : e1; const float gsrc = (bt < 4) ? g0 : g1; const int lb = (bt & 3) * 16;
        uint2 ur[16], vr[16];
        int eidx[16];
#pragma unroll
        for (int r = 0; r < 16; ++r) eidx[r] = __builtin_amdgcn_readlane(esrc, lb + r);
#pragma unroll
        for (int r = 0; r < 16; ++r) { const uint2* rowp = U4 + (size_t)eidx[r] * 64; ur[r] = rowp[lane]; }
#pragma unroll
        for (int r = 0; r < 16; ++r) { const uint2* rowp = V4 + (size_t)eidx[r] * 64; vr[r] = rowp[lane]; }
        float d[16];
#pragma unroll
        for (int r = 0; r < 16; ++r) { d[r] = dot16_fp4(ur[r], hv); asm volatile("" : "+v"(d[r])); }
        float r8[8], r4[4], r2[2];
#pragma unroll
        for (int i = 0; i < 8; ++i) { const float keep = hi5 ? d[i + 8] : d[i], send = hi5 ? d[i] : d[i + 8]; r8[i] = keep + __shfl_xor(send, 32); }
#pragma unroll
        for (int i = 0; i < 4; ++i) { const float keep = hi4 ? r8[i + 4] : r8[i], send = hi4 ? r8[i] : r8[i + 4]; r4[i] = keep + __shfl_xor(send, 16); }
#pragma unroll
        for (int i = 0; i < 2; ++i) { const float keep = hi3 ? r4[i + 2] : r4[i], send = hi3 ? r4[i] : r4[i + 2]; r2[i] = keep + __shfl_xor(send, 8); }
        float r1;
        { const float keep = hi2 ? r2[1] : r2[0], send = hi2 ? r2[0] : r2[1]; r1 = keep + __shfl_xor(send, 4); }
        r1 += __shfl_xor(r1, 2); r1 += __shfl_xor(r1, 1);
        const float gl = __shfl(gsrc, lb + rL);
        const float w = gl * gelu_tanh(r1 * (1.f / 64.f));
#pragma unroll
        for (int r = 0; r < 16; ++r) {
          const int Lk = ((r >> 3) & 1) * 32 + ((r >> 2) & 1) * 16 + ((r >> 1) & 1) * 8 + (r & 1) * 4;
          const float wr = __int_as_float(__builtin_amdgcn_readlane(__float_as_int(w), Lk));
          axpy16_fp4(vr[r], wr, acc2);
          __builtin_amdgcn_sched_barrier(0);
        }
      }
      float acc[16];
#pragma unroll
      for (int j = 0; j < 8; ++j) { acc[2 * j] = acc2[j].x; acc[2 * j + 1] = acc2[j].y; }
      float xn[16]; float ss = 0.f;
#pragma unroll
      for (int qq = 0; qq < 4; ++qq) {
        const int c = lane * 16 + 4 * qq;
        const f32x4 xv = *(const f32x4*)(X + (size_t)t * 1024 + c), g = *(const f32x4*)(g2 + b * 6144 + c);
        xn[4 * qq] = xv.x + g.x * acc[4 * qq] * 0.25f; xn[4 * qq + 1] = xv.y + g.y * acc[4 * qq + 1] * 0.25f;
        xn[4 * qq + 2] = xv.z + g.z * acc[4 * qq + 2] * 0.25f; xn[4 * qq + 3] = xv.w + g.w * acc[4 * qq + 3] * 0.25f;
        ss += xn[4 * qq] * xn[4 * qq] + xn[4 * qq + 1] * xn[4 * qq + 1] + xn[4 * qq + 2] * xn[4 * qq + 2] + xn[4 * qq + 3] * xn[4 * qq + 3];
      }
      const float rstd = rsqrtf(wave_sum(ss) * (1.f / 1024.f) + EPS_);
      if (!last) {
        unsigned hb[8];
#pragma unroll
        for (int qq = 0; qq < 4; ++qq) {
          const int c = lane * 16 + 4 * qq;
          *(f32x4*)(X + (size_t)t * 1024 + c) = (f32x4){xn[4 * qq], xn[4 * qq + 1], xn[4 * qq + 2], xn[4 * qq + 3]};
          const f32x4 gn = *(const f32x4*)(ngain + c), sh = *(const f32x4*)(nsh + b * 6144 + c), sc = *(const f32x4*)(nsc + b * 6144 + c);
          hb[2 * qq] = pk2(xn[4 * qq] * rstd * gn.x * (1.f + sc.x) + sh.x, xn[4 * qq + 1] * rstd * gn.y * (1.f + sc.y) + sh.y);
          hb[2 * qq + 1] = pk2(xn[4 * qq + 2] * rstd * gn.z * (1.f + sc.z) + sh.z, xn[4 * qq + 3] * rstd * gn.w * (1.f + sc.w) + sh.w);
        }
        *(uint4*)(HF + (size_t)t * 1024 + lane * 16) = make_uint4(hb[0], hb[1], hb[2], hb[3]);
        *(uint4*)(HF + (size_t)t * 1024 + lane * 16 + 8) = make_uint4(hb[4], hb[5], hb[6], hb[7]);
      } else {
#pragma unroll
        for (int qq = 0; qq < 4; ++qq) {
          const int c = lane * 16 + 4 * qq;
          const f32x4 fn = *(const f32x4*)(gin(pp->in[I_FNORM]) + c);
          *(f32x4*)((float*)pp->out + (size_t)t * 1024 + c) = (f32x4){xn[4 * qq] * rstd * fn.x, xn[4 * qq + 1] * rstd * fn.y, xn[4 * qq + 2] * rstd * fn.z, xn[4 * qq + 3] * rstd * fn.w};
        }
      }
    }
  }
}

#define XB_TMO      128
#define XB_XCNT(j)  (256  + 64 * (j))
#define XB_XSUB(j)  (1280 + 64 * (j))
#define XB_XGEN(j)  (2304 + 64 * (j))
#define XB_TOP      3328
#define XB_TOPGEN   3392
#define XCD_BAR_WORDS 3456
#define XB_SPIN_CAP (1u << 20)
#define LAS __attribute__((address_space(3)))
__device__ __forceinline__ unsigned xb_ld(unsigned* q)              { return __hip_atomic_load(q, __ATOMIC_RELAXED, __HIP_MEMORY_SCOPE_AGENT); }
__device__ __forceinline__ unsigned xb_add(unsigned* q, unsigned v) { return __hip_atomic_fetch_add(q, v, __ATOMIC_RELAXED, __HIP_MEMORY_SCOPE_AGENT); }
__device__ __forceinline__ unsigned xb_xcc_id() { return (unsigned)__builtin_amdgcn_s_getreg((3 << 11) | 20) & 0xFu; }
#define XB_SPIN(cond, bar) do { unsigned _sp = 0; while (cond) { __builtin_amdgcn_s_sleep(1); \
    if ((++_sp & 255u) == 0u) { if (xb_ld(&(bar)[XB_TMO])) break; if (_sp > XB_SPIN_CAP) { atomicAdd(&(bar)[XB_TMO], 1u); break; } } } } while (0)
struct XcdBarrier { unsigned* bar; unsigned x; volatile LAS unsigned* st; };
__device__ __forceinline__ XcdBarrier xcd_barrier_post(unsigned* bar, volatile LAS unsigned* st) {
    XcdBarrier b; b.bar = bar; b.x = xb_xcc_id(); b.st = st;
    if (threadIdx.x == 0) (void)xb_add(&bar[XB_XCNT(b.x)], 1u);
    return b;
}
__device__ __forceinline__ void xcd_barrier_complete(unsigned* bar, unsigned x, unsigned& nloc, unsigned& nx) {
    const unsigned G = gridDim.x * gridDim.y * gridDim.z;
    unsigned sum, cnt, mine, sp = 0u;
    for (;;) {
        sum = 0u; cnt = 0u; mine = 0u;
#pragma unroll
        for (unsigned j = 0; j < 16; ++j) { const unsigned c = xb_ld(&bar[XB_XCNT(j)]); sum += c; cnt += (c > 0u) ? 1u : 0u; mine = (j == x) ? c : mine; }
        if (sum == G) break;
        __builtin_amdgcn_s_sleep(1);
        if ((++sp & 255u) == 0u) { if (xb_ld(&bar[XB_TMO])) break; if (sp > XB_SPIN_CAP) { atomicAdd(&bar[XB_TMO], 1u); break; } }
    }
    nloc = mine > 0u ? mine : 1u; nx = cnt > 0u ? cnt : 1u;
}
__device__ __forceinline__ void xcd_barrier(const XcdBarrier& b) {
    asm volatile("s_waitcnt vmcnt(0)" ::: "memory");
    __syncthreads();
    if (threadIdx.x == 0) {
        unsigned* bar = b.bar;
        __builtin_amdgcn_s_waitcnt(0);
        unsigned nloc = b.st[0], nx = b.st[1];
        if (nloc == 0u) { xcd_barrier_complete(bar, b.x, nloc, nx); b.st[0] = nloc; b.st[1] = nx; }
        const unsigned old = xb_add(&bar[XB_XSUB(b.x)], 1u);
        const unsigned gen = old / nloc;
        if (old + 1u == (gen + 1u) * nloc) {
            __builtin_amdgcn_fence(__ATOMIC_RELEASE, "agent");
            asm volatile("s_waitcnt vmcnt(0)" ::: "memory");
            const unsigned og = xb_add(&bar[XB_TOP], 1u);
            const unsigned tg = og / nx;
            if (og + 1u == (tg + 1u) * nx) xb_add(&bar[XB_TOPGEN], 1u);
            else XB_SPIN(xb_ld(&bar[XB_TOPGEN]) == tg, bar);
            __builtin_amdgcn_fence(__ATOMIC_ACQUIRE, "agent");
            xb_add(&bar[XB_XGEN(b.x)], 1u);
            asm volatile("s_waitcnt vmcnt(0)" ::: "memory");
        } else {
            XB_SPIN(xb_ld(&bar[XB_XGEN(b.x)]) == gen, bar);
            __builtin_amdgcn_fence(__ATOMIC_ACQUIRE, "agent");
            asm volatile("s_waitcnt vmcnt(0)" ::: "memory");
        }
    }
    __syncthreads();
}

__global__ void __launch_bounds__(NT) fwd_megakernel(Params p) {
  extern __shared__ __attribute__((aligned(16))) unsigned char smem[];
  const CParamsP pp = launder_kargs();
  cg::grid_group grid = cg::this_grid();
  volatile LAS unsigned* xbst = (volatile LAS unsigned*)(smem + LDS_BYTES - 16);
  if (threadIdx.x == 0) { xbst[0] = 0u; xbst[1] = 0u; }
  if (blockIdx.x == 0) { unsigned* bw = (unsigned*)(pp->ws + WS_BAR); for (int i = threadIdx.x; i < XCD_BAR_WORDS; i += NT) bw[i] = 0u; }
  setup_phase(p, smem);
  grid.sync();
  const XcdBarrier xb = xcd_barrier_post((unsigned*)(pp->ws + WS_BAR), xbst);
  const float* MOD = (const float*)(pp->ws + WS_MOD);
  for (int l = 0; l < DEPTH_; ++l) {
    const float* xsrc = (l == 0) ? gin(pp->in[I_X]) : (const float*)(pp->ws + WS_X);
    const float* modl = MOD + (size_t)l * 2 * 6144;
    if (l == 0) {
      norm_mod_phase(xsrc, gin(pp->in[I_NMIX]), modl + 0, modl + 1024, (bf16_t*)(pp->ws + WS_ABUF));
      qbias_phase(p, smem);
      xcd_barrier(xb);
    }
    gemm_proj_phase(p, l, smem);
    xcd_barrier(xb);
    attn_phase(p, l, smem);
    mix_local_phase(p, l, smem);
    xcd_barrier(xb);
    scan_phase(p, l);
    xcd_barrier(xb);
    mix_final_phase(p, l, smem);
    xcd_barrier(xb);
    gemm_out_phase(p, l, xsrc, smem);
    xcd_barrier(xb);
    gemm_q_phase(p, l, smem);
    xcd_barrier(xb);
    peer_phase(p, l, l == DEPTH_ - 1, smem);
    xcd_barrier(xb);
  }
}

extern "C" void kernel_launch(void* const* d_in, const int* in_sizes, int n_in,
                              void* d_out, int out_size, void* d_ws, size_t ws_size,
                              hipStream_t stream) {
  static int grid_blocks = 0;
  if (grid_blocks == 0) {
    if (n_in != 24 || ws_size < WS_END) { fprintf(stderr, "kernel_launch: unexpected n_in %d / ws_size %zu (need %zu)\n", n_in, ws_size, (size_t)WS_END); grid_blocks = -1; return; }
    int dev = 0, cus = 0, per_cu = 0;
    if (hipGetDevice(&dev) != hipSuccess || hipDeviceGetAttribute(&cus, hipDeviceAttributeMultiprocessorCount, dev) != hipSuccess) { grid_blocks = -1; return; }
    if (hipFuncSetAttribute((const void*)fwd_megakernel, hipFuncAttributeMaxDynamicSharedMemorySize, LDS_BYTES) != hipSuccess) { fprintf(stderr, "hipFuncSetAttribute failed\n"); grid_blocks = -1; return; }
    if (hipOccupancyMaxActiveBlocksPerMultiprocessor(&per_cu, (const void*)fwd_megakernel, NT, LDS_BYTES) != hipSuccess || per_cu < 1) { fprintf(stderr, "occupancy query: %d\n", per_cu); grid_blocks = -1; return; }
    grid_blocks = cus;
  }
  if (grid_blocks < 0) return;
  Params p{};
  for (int i = 0; i < 24; ++i) p.in[i] = (const GAS float*)d_in[i];
  p.out = (GAS float*)d_out; p.ws = (GAS unsigned char*)d_ws;
  void* args[] = {&p};
  hipError_t e = hipLaunchCooperativeKernel((void*)fwd_megakernel, dim3(grid_blocks), dim3(NT), args, LDS_BYTES, stream);
  if (e != hipSuccess) fprintf(stderr, "cooperative launch failed: %s (grid %d)\n", hipGetErrorString(e), grid_blocks);
}
```

```cpp
#include <hip/hip_runtime.h>
#include <hip/hip_cooperative_groups.h>
#include <cstdio>
#include <cstdint>
namespace cg = cooperative_groups;

typedef unsigned short bf16_t;
typedef short bf16x8 __attribute__((ext_vector_type(8)));
typedef float f32x4 __attribute__((ext_vector_type(4)));
typedef float f32x16 __attribute__((ext_vector_type(16)));
typedef int i32x8 __attribute__((ext_vector_type(8)));

constexpr int T_ = 16384, D_ = 1024, L_ = 8192, NBATCH = 2, DEPTH_ = 4;
constexpr int INC = 2944, INCP = 3072;
constexpr int NCH = 128;
constexpr int NT = 512;
constexpr int NW = 8;
constexpr float EPS_ = 1e-6f;
constexpr int C_QA = 0, C_KA = 384, C_VA = 768, C_QR = 1152, C_KR = 1536, C_VR = 1920, C_GR = 2304, C_US = 2688;

constexpr size_t al256(size_t x) { return (x + 255) & ~(size_t)255; }
constexpr size_t WS_MOD   = 0;
constexpr size_t WS_ROTC  = al256(WS_MOD + 4ull * 2 * 6144 * 4);
constexpr size_t WS_ROTS  = al256(WS_ROTC + 8192ull * 32 * 4);
constexpr size_t WS_SA    = al256(WS_ROTS + 8192ull * 32 * 4);
constexpr size_t WS_SBB   = al256(WS_SA + 4ull * 16 * 64 * 2 * 4);
constexpr size_t WS_WIN   = al256(WS_SBB + 4ull * 16 * 64 * 32 * 4);
constexpr size_t WS_WOUT  = al256(WS_WIN + 4ull * INCP * 1024 * 2);
constexpr size_t WS_WQ    = al256(WS_WOUT + 4ull * 1024 * 1024 * 2);
constexpr size_t WS_SUBK  = al256(WS_WQ + 4ull * 2048 * 1024 * 2);
constexpr size_t WS_ABUF  = al256(WS_SUBK + 4ull * 16 * 128 * 128 * 2);
constexpr size_t WS_PROJ  = al256(WS_ABUF + (size_t)T_ * 1024 * 2);
constexpr size_t WS_VTA   = al256(WS_PROJ + (size_t)T_ * INCP * 2);
constexpr size_t WS_ATT   = al256(WS_VTA + 2ull * 6 * 64 * 8192 * 2);
constexpr size_t WS_YINT  = al256(WS_ATT + (size_t)T_ * 384 * 4);
constexpr size_t WS_UPD   = al256(WS_YINT + (size_t)T_ * 384 * 4);
constexpr size_t WS_SPREV = al256(WS_UPD + 256ull * 6 * 4096 * 4);
constexpr size_t WS_SEND  = al256(WS_SPREV + 256ull * 6 * 4096 * 4);
constexpr size_t WS_CARRY = al256(WS_SEND + 256ull * 16 * 64 * 2 * 4);
constexpr size_t WS_X     = al256(WS_CARRY + 256ull * 16 * 64 * 2 * 4);
constexpr size_t WS_Q     = al256(WS_X + (size_t)T_ * 1024 * 4);
constexpr size_t WS_SC    = al256(WS_Q + (size_t)T_ * 2048 * 2);
constexpr size_t WS_EIDX  = al256(WS_SC + (size_t)T_ * 2048 * 4);
constexpr size_t WS_EGATE = al256(WS_EIDX + (size_t)T_ * 128 * 4);
constexpr size_t WS_PU8   = al256(WS_EGATE + (size_t)T_ * 128 * 4);
constexpr size_t WS_PV8   = al256(WS_PU8 + 4ull * 16384 * 1024);
constexpr size_t WS_BAR   = al256(WS_PV8 + 4ull * 16384 * 1024);
constexpr size_t WS_SPT   = al256(WS_BAR + 3456ull * 4);
constexpr size_t WS_CB    = al256(WS_SPT + 256ull * 6 * 4096 * 2);
constexpr size_t WS_WGLUT = al256(WS_CB + 4ull * 16 * 16 * 128 * 2);
constexpr size_t WS_VTR   = al256(WS_WGLUT + 4ull * 512 * 256 * 2);
constexpr size_t WS_XG    = al256(WS_VTR + 2ull * 384 * 8192 * 2);
constexpr size_t WS_SSQ   = al256(WS_XG + (size_t)T_ * 1024 * 2);
constexpr size_t WS_C2    = al256(WS_SSQ + (size_t)T_ * 16 * 4);
constexpr size_t WS_BBH   = al256(WS_C2 + 4ull * 2 * 2048 * 4);
constexpr size_t WS_END   = al256(WS_BBH + 4ull * 16 * 2 * 64 * 16 * 2);

constexpr int LDS_BYTES = 135168;

#define GAS __attribute__((address_space(1)))
struct Params {
  const GAS float* in[24];
  GAS float* out;
  GAS unsigned char* ws;
};
enum { I_X = 0, I_C, I_WADA, I_BADA, I_NMIX, I_NFFN, I_WIN, I_RELB, I_LRE, I_LIM, I_LOGDT, I_BRE, I_BIM, I_CRE, I_CIM, I_SSMD,
       I_WGLU, I_MGAIN, I_WOUT, I_WQ, I_SUBK, I_PU, I_PV, I_FNORM };

__device__ __forceinline__ float bf2f(bf16_t v) { return __uint_as_float(((unsigned)v) << 16); }
__device__ __forceinline__ bf16_t f2bf(float f) { unsigned u = __float_as_uint(f); u += 0x7fffu + ((u >> 16) & 1u); return (bf16_t)(u >> 16); }
__device__ __forceinline__ unsigned pk2(float a, float b) { return (unsigned)f2bf(a) | ((unsigned)f2bf(b) << 16); }
__device__ __forceinline__ float wave_sum(float v) {
#pragma unroll
  for (int o = 32; o > 0; o >>= 1) v += __shfl_xor(v, o);
  return v;
}
__device__ __forceinline__ float wave_max(float v) {
#pragma unroll
  for (int o = 32; o > 0; o >>= 1) v = fmaxf(v, __shfl_xor(v, o));
  return v;
}
__device__ __forceinline__ float gelu_tanh(float x) { const float u = 0.7978845608028654f * (x + 0.044715f * x * x * x); return 0.5f * x * (1.f + tanhf(u)); }
__device__ __forceinline__ float sigmoid_f(float x) { return 1.f / (1.f + __expf(-x)); }
__device__ __forceinline__ GAS unsigned char* launder_ptr(GAS unsigned char* q) { asm volatile("" : "+s"(q)); return q; }
__device__ __forceinline__ const float* gin(const GAS float* q) { return (const float*)q; }
__device__ __forceinline__ const float* launder_cptr(const float* q) { asm volatile("" : "+s"(q)); return q; }
__device__ __forceinline__ int launder_tid() { int t = threadIdx.x; asm volatile("" : "+v"(t)); return t; }
typedef const Params __attribute__((address_space(4)))* CParamsP;
__device__ __forceinline__ CParamsP launder_kargs() { CParamsP q = (CParamsP)__builtin_amdgcn_kernarg_segment_ptr(); asm volatile("" : "+s"(q)); return q; }

__device__ __forceinline__ void convert_tables_fp4(const CParamsP pp, GAS unsigned char* ws, int layer, int gtid, int gn) {
  constexpr size_t NIT = 16384ull * 1024 / 16;
  for (size_t it = gtid; it < 2 * NIT; it += gn) {
    const int tb = it >= NIT ? 1 : 0; const size_t r = (it - (size_t)tb * NIT) + (size_t)layer * NIT;
    const f32x4* src = (const f32x4*)((tb ? gin(pp->in[I_PV]) : gin(pp->in[I_PU])) + r * 16);
    const float sc = tb ? 4.f : 64.f;
    unsigned o[2] = {0u, 0u};
#pragma unroll
    for (int q = 0; q < 4; ++q) {
      const f32x4 a = src[q];
      const float x0 = fminf(fmaxf(a.x * sc, -6.f), 6.f), x1 = fminf(fmaxf(a.y * sc, -6.f), 6.f);
      const float x2 = fminf(fmaxf(a.z * sc, -6.f), 6.f), x3 = fminf(fmaxf(a.w * sc, -6.f), 6.f);
      if (q == 0)      { o[0] = __builtin_amdgcn_cvt_scalef32_pk_fp4_f32(o[0], x0, x1, 1.0f, 0); o[0] = __builtin_amdgcn_cvt_scalef32_pk_fp4_f32(o[0], x2, x3, 1.0f, 1); }
      else if (q == 1) { o[0] = __builtin_amdgcn_cvt_scalef32_pk_fp4_f32(o[0], x0, x1, 1.0f, 2); o[0] = __builtin_amdgcn_cvt_scalef32_pk_fp4_f32(o[0], x2, x3, 1.0f, 3); }
      else if (q == 2) { o[1] = __builtin_amdgcn_cvt_scalef32_pk_fp4_f32(o[1], x0, x1, 1.0f, 0); o[1] = __builtin_amdgcn_cvt_scalef32_pk_fp4_f32(o[1], x2, x3, 1.0f, 1); }
      else             { o[1] = __builtin_amdgcn_cvt_scalef32_pk_fp4_f32(o[1], x0, x1, 1.0f, 2); o[1] = __builtin_amdgcn_cvt_scalef32_pk_fp4_f32(o[1], x2, x3, 1.0f, 3); }
    }
    *(uint2*)(ws + (tb ? WS_PV8 : WS_PU8) + r * 8) = make_uint2(o[0], o[1]);
  }
}

__device__ void setup_phase(const Params& p, unsigned char* smem) {
  const CParamsP pp = launder_kargs();
  GAS unsigned char* const ws = launder_ptr(pp->ws); const int tidx = launder_tid(); (void)ws; (void)tidx;
  const int tid = tidx;
  float* sm = (float*)smem;
  {
    float* cond = sm;
    float* red = sm + 2048;
    float* MOD = (float*)(ws + WS_MOD);
    for (int i = tid; i < 2048; i += NT) { const float c = gin(pp->in[I_C])[i]; cond[i] = c * sigmoid_f(c); }
    __syncthreads();
    for (int item = blockIdx.x; item < 4 * 96; item += gridDim.x) {
      const int l = item / 96, cb = item % 96, kq = tid >> 6, jj = tid & 63, j = cb * 64 + jj;
      const float* w = gin(pp->in[I_WADA]) + (size_t)l * 1024 * 6144 + j;
      float a0 = 0.f, a1 = 0.f;
#pragma unroll 16
      for (int k = kq * 128; k < kq * 128 + 128; ++k) { const float wv = w[(size_t)k * 6144]; a0 += cond[k] * wv; a1 += cond[1024 + k] * wv; }
      red[(kq * 2 + 0) * 64 + jj] = a0; red[(kq * 2 + 1) * 64 + jj] = a1;
      __syncthreads();
      if (tid < 128) {
        const int b = tid >> 6, j2 = tid & 63; float s = 0.f;
        for (int q = 0; q < 8; ++q) s += red[(q * 2 + b) * 64 + j2];
        MOD[((size_t)l * 2 + b) * 6144 + cb * 64 + j2] = s + gin(pp->in[I_BADA])[(size_t)l * 6144 + cb * 64 + j2];
      }
      __syncthreads();
    }
  }
  const int gtid = blockIdx.x * NT + tid, gn = gridDim.x * NT;
  {
    float* RC = (float*)(ws + WS_ROTC); float* RS = (float*)(ws + WS_ROTS);
    for (int idx = gtid; idx < 8192 * 32; idx += gn) {
      const int pos = idx >> 5, i = idx & 31;
      const float inv = powf(10000.0f, -(float)i / 32.0f);
      const float ang = (float)pos * inv;
      float s, c; sincosf(ang, &s, &c);
      RC[idx] = c; RS[idx] = s;
    }
  }
  {
    float* SA = (float*)(ws + WS_SA); float* SBB = (float*)(ws + WS_SBB); bf16_t* BBH = (bf16_t*)(ws + WS_BBH);
    for (int idx = gtid; idx < 4 * 16 * 64; idx += gn) {
      const int l = idx / 1024, g = (idx >> 6) & 15;
      const float dt = expf(gin(pp->in[I_LOGDT])[l * 16 + g]);
      const float lr = gin(pp->in[I_LRE])[idx], li = gin(pp->in[I_LIM])[idx];
      const float mag = expf(lr * dt);
      float sn, cs; sincosf(li * dt, &sn, &cs);
      const float are = mag * cs, aim = mag * sn;
      const float den = lr * lr + li * li, nr = are - 1.f, ni = aim;
      const float fre = (nr * lr + ni * li) / den, fim = (ni * lr - nr * li) / den;
      SA[idx * 2] = are; SA[idx * 2 + 1] = aim;
      for (int c = 0; c < 16; ++c) {
        const float br = gin(pp->in[I_BRE])[(size_t)idx * 16 + c], bi = gin(pp->in[I_BIM])[(size_t)idx * 16 + c];
        SBB[(size_t)idx * 32 + c] = fre * br - fim * bi;
        SBB[(size_t)idx * 32 + 16 + c] = fre * bi + fim * br;
        BBH[(((size_t)(idx >> 6) * 2 + 0) * 64 + (idx & 63)) * 16 + c] = f2bf(fre * br - fim * bi);
        BBH[(((size_t)(idx >> 6) * 2 + 1) * 64 + (idx & 63)) * 16 + c] = f2bf(fre * bi + fim * br);
      }
    }
  }
  {
    bf16_t* SK = (bf16_t*)(ws + WS_SUBK);
    for (int idx = gtid; idx < 4 * 16 * 128 * 128; idx += gn) SK[idx] = f2bf(gin(pp->in[I_SUBK])[idx]);
  }
  {
    bf16_t* CB = (bf16_t*)(ws + WS_CB);
    for (int idx = gtid; idx < 4 * 16 * 16 * 128; idx += gn) {
      const int k = idx & 127, lgc = idx >> 7;
      CB[idx] = (k < 64) ? f2bf(gin(pp->in[I_CRE])[(size_t)lgc * 64 + k]) : f2bf(-gin(pp->in[I_CIM])[(size_t)lgc * 64 + (k - 64)]);
    }
    bf16_t* WG = (bf16_t*)(ws + WS_WGLUT);
    for (int idx = gtid; idx < 4 * 512 * 256; idx += gn) {
      const int k = idx & 255, nn = (idx >> 8) & 511, l2 = idx >> 17;
      WG[idx] = f2bf(gin(pp->in[I_WGLU])[((size_t)l2 * 256 + k) * 512 + nn]);
    }
  }
  convert_tables_fp4(pp, ws, 0, gtid, gn);
  {
    __syncthreads();
    const int lane = tid & 63, wid = tid >> 6;
    float* scr = sm + wid * (64 * 33);
    constexpr int IT_IN = 16 * 96, IT_OUT = 16 * 32, IT_Q = 16 * 64, IT_L = IT_IN + IT_OUT + IT_Q;
    for (int item = blockIdx.x * NW + wid; item < 4 * IT_L; item += gridDim.x * NW) {
      const int l = item / IT_L; int r = item - l * IT_L;
      const float* W; bf16_t* WT; int N, NP;
      if (r < IT_IN) { W = gin(pp->in[I_WIN]) + (size_t)l * 1024 * INC; WT = (bf16_t*)(ws + WS_WIN) + (size_t)l * INCP * 1024; N = INC; NP = 96; }
      else if (r < IT_IN + IT_OUT) { r -= IT_IN; W = gin(pp->in[I_WOUT]) + (size_t)l * 1024 * 1024; WT = (bf16_t*)(ws + WS_WOUT) + (size_t)l * 1024 * 1024; N = 1024; NP = 32; }
      else { r -= IT_IN + IT_OUT; W = gin(pp->in[I_WQ]) + (size_t)l * 1024 * 2048; WT = (bf16_t*)(ws + WS_WQ) + (size_t)l * 2048 * 1024; N = 2048; NP = 64; }
      const int kb = r / NP, nb = r - kb * NP, k0 = kb * 64, n0 = nb * 32;
      const int nn = n0 + (lane & 31); const bool inb = nn < N;
      float v[32];
#pragma unroll
      for (int i = 0; i < 32; ++i) { const int kk = 2 * i + (lane >> 5); v[i] = inb ? W[(size_t)(k0 + kk) * N + nn] : 0.f; }
#pragma unroll
      for (int i = 0; i < 32; ++i) { const int kk = 2 * i + (lane >> 5); scr[kk * 33 + (lane & 31)] = v[i]; }
      const int c = lane & 7;
#pragma unroll
      for (int j = 0; j < 4; ++j) {
        const int n = (lane >> 3) + 8 * j; const float* sp = scr + (8 * c) * 33 + n;
        uint4 o; o.x = pk2(sp[0], sp[33]); o.y = pk2(sp[2 * 33], sp[3 * 33]); o.z = pk2(sp[4 * 33], sp[5 * 33]); o.w = pk2(sp[6 * 33], sp[7 * 33]);
        *(uint4*)(WT + (size_t)(n0 + n) * 1024 + k0 + 8 * c) = o;
      }
    }
    __syncthreads();
  }
}

__device__ void qbias_phase(const Params& p, unsigned char* smem) {
  const CParamsP pp = launder_kargs();
  GAS unsigned char* const ws = launder_ptr(pp->ws); const int tid = launder_tid();
  float* red = (float*)smem;
  float* C2 = (float*)(ws + WS_C2); const float* MOD = (const float*)(ws + WS_MOD);
  for (int item = blockIdx.x; item < 4 * 32; item += gridDim.x) {
    const int l = item >> 5, cb = item & 31, kq = tid >> 6, jj = tid & 63, j = cb * 64 + jj;
    const float* w = gin(pp->in[I_WQ]) + (size_t)l * 1024 * 2048 + j;
    const float* s0 = MOD + (size_t)l * 2 * 6144 + 3072; const float* s1 = s0 + 6144;
    float a0 = 0.f, a1 = 0.f;
#pragma unroll 16
    for (int k = kq * 128; k < kq * 128 + 128; ++k) { const float wv = w[(size_t)k * 2048]; a0 += s0[k] * wv; a1 += s1[k] * wv; }
    __syncthreads();
    red[(kq * 2 + 0) * 64 + jj] = a0; red[(kq * 2 + 1) * 64 + jj] = a1;
    __syncthreads();
    if (tid < 128) {
      const int b = tid >> 6, j2 = tid & 63; float sum = 0.f;
      for (int q = 0; q < 8; ++q) sum += red[(q * 2 + b) * 64 + j2];
      C2[((size_t)l * 2 + b) * 2048 + cb * 64 + j2] = sum;
    }
  }
  __syncthreads();
}

__device__ void norm_mod_phase(const float* __restrict__ xsrc, const float* __restrict__ gain, const float* __restrict__ mod_sh, const float* __restrict__ mod_sc,
                               bf16_t* __restrict__ outp) {
  const int tidx = launder_tid();
  const int lane = tidx & 63, gw = blockIdx.x * NW + (tidx >> 6), nw = gridDim.x * NW;
  for (int t = gw; t < T_; t += nw) {
    const int b = t >> 13;
    const f32x4* xr = (const f32x4*)(xsrc + (size_t)t * 1024) + lane;
    f32x4 v[4]; float s = 0.f;
#pragma unroll
    for (int j = 0; j < 4; ++j) { v[j] = xr[64 * j]; s += v[j].x * v[j].x + v[j].y * v[j].y + v[j].z * v[j].z + v[j].w * v[j].w; }
    const float rstd = rsqrtf(wave_sum(s) * (1.f / 1024.f) + EPS_);
#pragma unroll
    for (int j = 0; j < 4; ++j) {
      const int c = lane * 4 + 256 * j;
      const f32x4 g = *(const f32x4*)(gain + c), sh = *(const f32x4*)(mod_sh + b * 6144 + c), sc = *(const f32x4*)(mod_sc + b * 6144 + c);
      const float o0 = v[j].x * rstd * g.x * (1.f + sc.x) + sh.x, o1 = v[j].y * rstd * g.y * (1.f + sc.y) + sh.y;
      const float o2 = v[j].z * rstd * g.z * (1.f + sc.z) + sh.z, o3 = v[j].w * rstd * g.w * (1.f + sc.w) + sh.w;
      uint2 o; o.x = pk2(o0, o1); o.y = pk2(o2, o3);
      *(uint2*)(outp + (size_t)t * 1024 + c) = o;
    }
  }
}


namespace pg8 {
#define PG8_LAS __attribute__((address_space(3)))
typedef unsigned u32x4 __attribute__((ext_vector_type(4)));
constexpr int BM = 256, BK = 64, HALF = 128, HTB = HALF * BK * 2, STAGE_BYTES = 8 * HTB, NXCD = 8, WGM = 8;
__host__ __device__ __forceinline__ int lds_byte(int r, int c) { const int st = (r >> 4) * 2 + (c >> 5), rr = r & 15, cc = c & 31, ob = rr * 64 + cc * 2; return st * 1024 + (ob ^ (((ob >> 9) & 1) << 5)); }
__host__ __device__ __forceinline__ void stage_rc(int b, int& R, int& C) { const int st = b / 1024, sb = b % 1024, swz = sb ^ (((sb >> 9) & 1) << 5); R = (st >> 1) * 16 + swz / 64; C = (st & 1) * 32 + (swz % 64) / 2; }
__host__ __device__ __forceinline__ int perm32(int rho) { const int n = rho >> 4, i = rho & 15; return 8 * (i >> 2) + 4 * n + (i & 3); }
struct Unit { int pm, pn; };
struct Gemm { const bf16_t* A; const bf16_t* Bt; int M, N, K; };
struct StaticOrder {
    int nM, nN, nwg, G, c;
    __host__ __device__ void init(int M, int N, int G_, int c_) { nM = M / BM; nN = N / BM; nwg = nM * nN; G = G_; c = c_; }
    __host__ __device__ bool next(int i, Unit& u) const {
        const long L = (long)i * G + c; if (L >= nwg) return false;
        int wgid = (int)L; { const int q = nwg / NXCD, r = nwg % NXCD, xcd = wgid % NXCD, off = wgid / NXCD; wgid = (xcd < r ? xcd * (q + 1) : r * (q + 1) + (xcd - r) * q) + off; }
        const int nig = WGM * nN, gid = wgid / nig, fm = gid * WGM, gsz = (nM - fm) < WGM ? (nM - fm) : WGM;
        u.pm = fm + ((wgid % nig) % gsz); u.pn = (wgid % nig) / gsz; return true;
    }
    __device__ __forceinline__ void a_ready(const Unit&) const {}
    __device__ __forceinline__ void done(const Unit&) const {}
};
__device__ __forceinline__ unsigned cvt_pk_bf16(float lo, float hi) { unsigned r; asm volatile("v_cvt_pk_bf16_f32 %0, %1, %2" : "=v"(r) : "v"(lo), "v"(hi)); return r; }
template <class Epi, class Sched>
__device__ __forceinline__ void gemm_phase(PG8_LAS unsigned char* lds, const Gemm g, const Sched& S, const Epi& E) {
    const int tid = launder_tid(), wid = __builtin_amdgcn_readfirstlane(tid >> 6), lane = tid & 63, wr = wid >> 2, wc = wid & 3, fr = lane & 15, fq = lane >> 4;
    const int K = g.K, nt = K / BK;
    unsigned voffA[2], voffB[2];
#pragma unroll
    for (int i = 0; i < 2; ++i) { int R, C; stage_rc(tid * 16 + i * 8192, R, C); const int Rb = Epi::PERM ? ((R & ~31) + perm32(R & 31)) : R;
        voffA[i] = (unsigned)(R * K + C) * 2u; voffB[i] = (unsigned)(Rb * K + C) * 2u; }
    const size_t kstep = (size_t)(BK * 2);
    const size_t hstep = (size_t)HALF * K * 2;
    const size_t tstep = 2 * hstep;
    const unsigned ldsw = (unsigned)wid * 1024u;
    const int aoff = lds_byte(wr * 64 + fr, fq * 8), boff = lds_byte(wc * 32 + fr, fq * 8);
#define PG8_SA(b, h) (((b) * 2 + (h)) * HTB)
#define PG8_SB(b, h) ((4 + (b) * 2 + (h)) * HTB)
#define PG8_STAGE(bufoff, gbase, voff) do { _Pragma("unroll") for (int _i = 0; _i < 2; ++_i) \
        __builtin_amdgcn_global_load_lds((const unsigned*)((const char*)(gbase) + (voff)[_i]), (PG8_LAS unsigned*)(lds + (bufoff) + ldsw + _i * 8192), 16, 0, 0); } while (0)
#define PG8_LDA(dst, b, h) do { _Pragma("unroll") for (int m = 0; m < 4; ++m) _Pragma("unroll") for (int k = 0; k < 2; ++k) dst[m][k] = *(const PG8_LAS bf16x8*)(lds + PG8_SA(b, h) + aoff + m * 2048 + k * 1024); } while (0)
#define PG8_LDB(dst, b, h) do { _Pragma("unroll") for (int n = 0; n < 2; ++n) _Pragma("unroll") for (int k = 0; k < 2; ++k) dst[n][k] = *(const PG8_LAS bf16x8*)(lds + PG8_SB(b, h) + boff + n * 2048 + k * 1024); } while (0)
#define PG8_MMA(ai, bj, At, Bt) do { __builtin_amdgcn_s_setprio(1); _Pragma("unroll") for (int m = 0; m < 4; ++m) _Pragma("unroll") for (int n = 0; n < 2; ++n) _Pragma("unroll") for (int k = 0; k < 2; ++k) \
        acc[ai][bj][m][n] = __builtin_amdgcn_mfma_f32_16x16x32_bf16(Bt[n][k], At[m][k], acc[ai][bj][m][n], 0, 0, 0); __builtin_amdgcn_s_setprio(0); } while (0)
#define PG8_WAIT_V(n) asm volatile("s_waitcnt vmcnt(" #n ")" ::: "memory")
#define PG8_WAIT_L(n) asm volatile("s_waitcnt lgkmcnt(" #n ")" ::: "memory")
#define PG8_BAR __builtin_amdgcn_s_barrier()
#define PG8_SCHED __builtin_amdgcn_sched_barrier(0)
    Unit cur, nxt; int ui = 0;
    if (!S.next(0, cur)) return;
    f32x4 acc[2][2][4][2];
#pragma unroll
    for (int a = 0; a < 2; ++a)
#pragma unroll
        for (int b = 0; b < 2; ++b)
#pragma unroll
            for (int m = 0; m < 4; ++m)
#pragma unroll
                for (int n = 0; n < 2; ++n) acc[a][b][m][n] = (f32x4){0.f, 0.f, 0.f, 0.f};
    bf16x8 At[4][2], B0[2][2], B1[2][2];
    const char* cA = (const char*)g.A + (size_t)cur.pm * tstep; const char* cB = (const char*)g.Bt + (size_t)cur.pn * tstep;
    S.a_ready(cur);
    PG8_STAGE(PG8_SB(0, 0), cB, voffB); PG8_STAGE(PG8_SA(0, 0), cA, voffA); PG8_STAGE(PG8_SB(0, 1), cB + hstep, voffB); PG8_STAGE(PG8_SA(0, 1), cA + hstep, voffA);
    if (wr == 1) PG8_BAR;
    PG8_WAIT_V(4); PG8_BAR;
    PG8_STAGE(PG8_SB(1, 0), cB + kstep, voffB); PG8_STAGE(PG8_SA(1, 0), cA + kstep, voffA); PG8_STAGE(PG8_SB(1, 1), cB + hstep + kstep, voffB);
    PG8_WAIT_V(6); PG8_BAR;
    for (;;) {
        const bool has_next = S.next(ui + 1, nxt);
        const char* nA = has_next ? (const char*)g.A + (size_t)nxt.pm * tstep : cA; const char* nB = has_next ? (const char*)g.Bt + (size_t)nxt.pn * tstep : cB;
        for (int t = 0; t < nt; t += 2) {
            const bool last = (t == nt - 2);
            const char* a1 = cA + (size_t)(t + 1) * kstep;
            const char* a2 = last ? nA : cA + (size_t)(t + 2) * kstep; const char* b2 = last ? nB : cB + (size_t)(t + 2) * kstep;
            const char* a3 = a2 + kstep; const char* b3 = b2 + kstep;
            if (last && has_next) S.a_ready(nxt);
            PG8_LDB(B0, 0, 0); PG8_SCHED; PG8_LDA(At, 0, 0); PG8_STAGE(PG8_SA(1, 1), a1 + hstep, voffA);
            PG8_WAIT_L(8); PG8_BAR; PG8_WAIT_L(0); PG8_MMA(0, 0, At, B0); PG8_BAR; PG8_SCHED;
            PG8_LDB(B1, 0, 1); PG8_STAGE(PG8_SB(0, 0), b2, voffB);
            PG8_BAR; PG8_WAIT_L(0); PG8_MMA(0, 1, At, B1); PG8_BAR;
            PG8_LDA(At, 0, 1); PG8_STAGE(PG8_SA(0, 0), a2, voffA);
            PG8_BAR; PG8_WAIT_L(0); PG8_MMA(1, 0, At, B0); PG8_BAR; PG8_SCHED;
            PG8_STAGE(PG8_SB(0, 1), b2 + hstep, voffB);
            PG8_WAIT_V(6); PG8_BAR; PG8_MMA(1, 1, At, B1); PG8_BAR;
            PG8_LDB(B0, 1, 0); PG8_SCHED; PG8_LDA(At, 1, 0); PG8_STAGE(PG8_SA(0, 1), a2 + hstep, voffA);
            PG8_WAIT_L(8); PG8_BAR; PG8_WAIT_L(0); PG8_MMA(0, 0, At, B0); PG8_BAR; PG8_SCHED;
            PG8_LDB(B1, 1, 1); PG8_STAGE(PG8_SB(1, 0), b3, voffB);
            PG8_BAR; PG8_WAIT_L(0); PG8_MMA(0, 1, At, B1); PG8_BAR;
            PG8_LDA(At, 1, 1); PG8_STAGE(PG8_SA(1, 0), a3, voffA);
            PG8_BAR; PG8_WAIT_L(0); PG8_MMA(1, 0, At, B0); PG8_BAR; PG8_SCHED;
            PG8_STAGE(PG8_SB(1, 1), b3 + hstep, voffB);
            PG8_WAIT_V(6); PG8_BAR; PG8_MMA(1, 1, At, B1); PG8_BAR;
        }
        if constexpr (!Epi::AFTER_DRAIN) { E(acc, cur, wr, wc, fr, fq); S.done(cur); }
        if (!has_next) break;
#pragma unroll
        for (int a = 0; a < 2; ++a)
#pragma unroll
            for (int b = 0; b < 2; ++b)
#pragma unroll
                for (int m = 0; m < 4; ++m)
#pragma unroll
                    for (int n = 0; n < 2; ++n) acc[a][b][m][n] = (f32x4){0.f, 0.f, 0.f, 0.f};
        cur = nxt; cA = nA; cB = nB; ++ui;
    }
    PG8_WAIT_V(0);
    if (wr == 0) PG8_BAR;
    PG8_BAR;
    if constexpr (Epi::AFTER_DRAIN) { E.fused(acc, cur, wr, wc, fr, fq, lds, wid, lane); S.done(cur); }
#undef PG8_SA
#undef PG8_SB
#undef PG8_STAGE
#undef PG8_LDA
#undef PG8_LDB
#undef PG8_MMA
#undef PG8_WAIT_V
#undef PG8_WAIT_L
#undef PG8_BAR
#undef PG8_SCHED
}
}

__device__ __forceinline__ float ssq_total(const float* __restrict__ SSQ, int t) {
  const f32x4 a = *(const f32x4*)(SSQ + (size_t)t * 16), b = *(const f32x4*)(SSQ + (size_t)t * 16 + 4), c = *(const f32x4*)(SSQ + (size_t)t * 16 + 8), d = *(const f32x4*)(SSQ + (size_t)t * 16 + 12);
  return (((a.x + a.y) + (a.z + a.w)) + ((b.x + b.y) + (b.z + b.w))) + (((c.x + c.y) + (c.z + c.w)) + ((d.x + d.y) + (d.z + d.w)));
}
struct EpiProj {
  static constexpr bool PERM = true, AFTER_DRAIN = false;
  bf16_t* PROJ; bf16_t* VTA; bf16_t* VTR;
  __device__ __forceinline__ void operator()(const f32x4 (&acc)[2][2][4][2], const pg8::Unit& u, int wr, int wc, int fr, int fq) const {
    const int row0 = u.pm * 256 + wr * 64 + fr, col0 = u.pn * 256 + wc * 32 + 8 * fq;
#pragma unroll
    for (int ai = 0; ai < 2; ++ai)
#pragma unroll
      for (int m = 0; m < 4; ++m) {
        const int t = row0 + ai * 128 + m * 16;
#pragma unroll
        for (int bj = 0; bj < 2; ++bj) {
          const int c = col0 + bj * 128;
          const f32x4 v0 = acc[ai][bj][m][0], v1 = acc[ai][bj][m][1];
          pg8::u32x4 w; w.x = pg8::cvt_pk_bf16(v0[0], v0[1]); w.y = pg8::cvt_pk_bf16(v0[2], v0[3]); w.z = pg8::cvt_pk_bf16(v1[0], v1[1]); w.w = pg8::cvt_pk_bf16(v1[2], v1[3]);
          *(pg8::u32x4*)(PROJ + (size_t)t * INCP + c) = w;
          const bool isva = (c >= C_VA && c < C_VA + 384), isvr = (c >= C_VR && c < C_VR + 384);
          if (isva || isvr) {
            bf16_t* vt = (isva ? VTA : VTR) + ((size_t)(t >> 13) * 384 + (c - (isva ? C_VA : C_VR))) * 8192 + (t & 8191);
            vt[0] = (bf16_t)(w.x & 0xffffu); vt[8192] = (bf16_t)(w.x >> 16); vt[2 * 8192] = (bf16_t)(w.y & 0xffffu); vt[3 * 8192] = (bf16_t)(w.y >> 16);
            vt[4 * 8192] = (bf16_t)(w.z & 0xffffu); vt[5 * 8192] = (bf16_t)(w.z >> 16); vt[6 * 8192] = (bf16_t)(w.w & 0xffffu); vt[7 * 8192] = (bf16_t)(w.w >> 16);
          }
        }
      }
  }
};
struct EpiOut {
  static constexpr bool PERM = false, AFTER_DRAIN = false;
  const float* xsrc; float* X; const float* g1; const float* nf; const float* sc2; bf16_t* XG; float* SSQ;
  __device__ __forceinline__ void operator()(const f32x4 (&acc)[2][2][4][2], const pg8::Unit& u, int wr, int wc, int fr, int fq) const {
    const int row0 = u.pm * 256 + wr * 64 + fr, col0 = u.pn * 256 + wc * 32 + 4 * fq, b = (u.pm * 256) >> 13;
    f32x4 gg[2][2], gs[2][2];
#pragma unroll
    for (int bj = 0; bj < 2; ++bj)
#pragma unroll
      for (int n = 0; n < 2; ++n) {
        const int c = col0 + bj * 128 + n * 16;
        gg[bj][n] = *(const f32x4*)(g1 + b * 6144 + c);
        const f32x4 gf = *(const f32x4*)(nf + c), sc = *(const f32x4*)(sc2 + b * 6144 + c);
        gs[bj][n] = gf * (sc + 1.f);
      }
#pragma unroll
    for (int ai = 0; ai < 2; ++ai)
#pragma unroll
      for (int m = 0; m < 4; ++m) {
        const int t = row0 + ai * 128 + m * 16;
        float sq = 0.f;
#pragma unroll
        for (int bj = 0; bj < 2; ++bj)
#pragma unroll
          for (int n = 0; n < 2; ++n) {
            const int c = col0 + bj * 128 + n * 16;
            const f32x4 xv = *(const f32x4*)(xsrc + (size_t)t * 1024 + c);
            const f32x4 xn = xv + gg[bj][n] * acc[ai][bj][m][n];
            *(f32x4*)(X + (size_t)t * 1024 + c) = xn;
            const f32x4 xs = xn * gs[bj][n];
            uint2 o; o.x = pg8::cvt_pk_bf16(xs.x, xs.y); o.y = pg8::cvt_pk_bf16(xs.z, xs.w);
            *(uint2*)(XG + (size_t)t * 1024 + c) = o;
            sq += (xn.x * xn.x + xn.y * xn.y) + (xn.z * xn.z + xn.w * xn.w);
          }
        sq += __shfl_xor(sq, 16); sq += __shfl_xor(sq, 32);
        if (fq == 0) SSQ[(size_t)t * 16 + u.pn * 4 + wc] = sq;
      }
  }
};
struct EpiQ {
  static constexpr bool PERM = true, AFTER_DRAIN = false;
  bf16_t* Q; const float* SSQ; const float* C2;
  __device__ __forceinline__ void operator()(const f32x4 (&acc)[2][2][4][2], const pg8::Unit& u, int wr, int wc, int fr, int fq) const {
    const int row0 = u.pm * 256 + wr * 64 + fr, col0 = u.pn * 256 + wc * 32 + 8 * fq, b = (u.pm * 256) >> 13;
    f32x4 cc[2][2];
#pragma unroll
    for (int bj = 0; bj < 2; ++bj) { cc[bj][0] = *(const f32x4*)(C2 + b * 2048 + col0 + bj * 128); cc[bj][1] = *(const f32x4*)(C2 + b * 2048 + col0 + bj * 128 + 4); }
#pragma unroll
    for (int ai = 0; ai < 2; ++ai)
#pragma unroll
      for (int m = 0; m < 4; ++m) {
        const int t = row0 + ai * 128 + m * 16;
        const float rstd = rsqrtf(ssq_total(SSQ, t) * (1.f / 1024.f) + EPS_);
#pragma unroll
        for (int bj = 0; bj < 2; ++bj) {
          const f32x4 v0 = acc[ai][bj][m][0] * rstd + cc[bj][0], v1 = acc[ai][bj][m][1] * rstd + cc[bj][1];
          pg8::u32x4 w; w.x = pg8::cvt_pk_bf16(v0[0], v0[1]); w.y = pg8::cvt_pk_bf16(v0[2], v0[3]); w.z = pg8::cvt_pk_bf16(v1[0], v1[1]); w.w = pg8::cvt_pk_bf16(v1[2], v1[3]);
          *(pg8::u32x4*)(Q + (size_t)t * 2048 + col0 + bj * 128) = w;
        }
      }
  }
};

__device__ void gemm_proj_phase(const Params& p, int l, unsigned char* smem) {
  const CParamsP pp = launder_kargs();
  GAS unsigned char* const ws = launder_ptr(pp->ws);
  pg8::Gemm g; g.A = (const bf16_t*)(ws + WS_ABUF); g.Bt = (const bf16_t*)(ws + WS_WIN) + (size_t)l * INCP * 1024; g.M = T_; g.N = INCP; g.K = 1024;
  pg8::StaticOrder S; S.init(T_, INCP, gridDim.x, blockIdx.x);
  EpiProj E; E.PROJ = (bf16_t*)(ws + WS_PROJ); E.VTA = (bf16_t*)(ws + WS_VTA); E.VTR = (bf16_t*)(ws + WS_VTR);
  pg8::gemm_phase<EpiProj, pg8::StaticOrder>((PG8_LAS unsigned char*)smem, g, S, E);
}
__device__ void gemm_out_phase(const Params& p, int l, const float* __restrict__ xsrc, unsigned char* smem) {
  const CParamsP pp = launder_kargs();
  GAS unsigned char* const ws = launder_ptr(pp->ws);
  pg8::Gemm g; g.A = (const bf16_t*)(ws + WS_ABUF); g.Bt = (const bf16_t*)(ws + WS_WOUT) + (size_t)l * 1024 * 1024; g.M = T_; g.N = 1024; g.K = 1024;
  pg8::StaticOrder S; S.init(T_, 1024, gridDim.x, blockIdx.x);
  EpiOut E; E.xsrc = xsrc; E.X = (float*)(ws + WS_X); E.g1 = (const float*)(ws + WS_MOD) + (size_t)l * 2 * 6144 + 2048;
  E.nf = gin(pp->in[I_NFFN]) + (size_t)l * 1024; E.sc2 = (const float*)(ws + WS_MOD) + (size_t)l * 2 * 6144 + 4096; E.XG = (bf16_t*)(ws + WS_XG); E.SSQ = (float*)(ws + WS_SSQ);
  pg8::gemm_phase<EpiOut, pg8::StaticOrder>((PG8_LAS unsigned char*)smem, g, S, E);
}
__device__ void gemm_q_phase(const Params& p, int l, unsigned char* smem) {
  const CParamsP pp = launder_kargs();
  GAS unsigned char* const ws = launder_ptr(pp->ws);
  pg8::Gemm g; g.A = (const bf16_t*)(ws + WS_XG); g.Bt = (const bf16_t*)(ws + WS_WQ) + (size_t)l * 2048 * 1024; g.M = T_; g.N = 2048; g.K = 1024;
  pg8::StaticOrder S; S.init(T_, 2048, gridDim.x, blockIdx.x);
  EpiQ E; E.Q = (bf16_t*)(ws + WS_Q); E.SSQ = (const float*)(ws + WS_SSQ); E.C2 = (const float*)(ws + WS_C2) + (size_t)l * 2 * 2048;
  pg8::gemm_phase<EpiQ, pg8::StaticOrder>((PG8_LAS unsigned char*)smem, g, S, E);
}

__device__ __forceinline__ int attn_fk(int r) { return ((r >> 3) & 3) | (((r >> 1) & 1) << 2); }
__device__ __forceinline__ int attn_fv(int r) { return (r >> 1) & 7; }
__device__ void attn_phase(const Params& p, int l, unsigned char* smem) {
  const CParamsP pp = launder_kargs();
  GAS unsigned char* const ws = launder_ptr(pp->ws); const int tidx = launder_tid();
  const bf16_t* PROJ = (const bf16_t*)(ws + WS_PROJ); const bf16_t* VTA = (const bf16_t*)(ws + WS_VTA);
  float* ATT = (float*)(ws + WS_ATT);
  const int lane = tidx & 63, wid = tidx >> 6, fr = lane & 15, fq = lane >> 4;
  float* ext = (float*)smem;
  unsigned char* stg = smem + 15360;
  constexpr float LOG2E = 1.4426950408889634f;
  __syncthreads();
  for (int idx = tidx; idx < 6 * 640; idx += NT) {
    const int h = idx / 640, e = idx - h * 640; int d = e - 63; d = d > 256 ? 256 : d;
    ext[idx] = gin(pp->in[I_RELB])[((size_t)l * 6 + h) * 513 + d + 256] * LOG2E;
  }
  const int hh = wid >> 2, qb = wid & 3, iq = qb * 16 + fr;
  const int srow = tidx >> 3, sch = tidx & 7;
  for (int item = blockIdx.x; item < 256; item += gridDim.x) {
    const int b = item >> 7, n = item & 127, t0 = b * 8192 + n * 64;
    const int jc0 = n >= 8 ? 0 : 8 - n, nch = 9 - jc0, nst = 3 * nch;
    uint4 sr0, sr1, sr2, sr3;
#define ATTN_LOAD(st) do { const int _rd = (st) / nch, _jc = jc0 + (st) - _rd * nch, _m = n - 8 + _jc; \
      sr0 = *(const uint4*)(PROJ + (size_t)(b * 8192 + _m * 64 + srow) * INCP + C_KA + (2 * _rd) * 64 + sch * 8); \
      sr1 = *(const uint4*)(PROJ + (size_t)(b * 8192 + _m * 64 + srow) * INCP + C_KA + (2 * _rd + 1) * 64 + sch * 8); \
      sr2 = *(const uint4*)(VTA + ((size_t)b * 384 + (2 * _rd) * 64 + srow) * 8192 + _m * 64 + sch * 8); \
      sr3 = *(const uint4*)(VTA + ((size_t)b * 384 + (2 * _rd + 1) * 64 + srow) * 8192 + _m * 64 + sch * 8); } while (0)
#define ATTN_WRITE(buf) do { unsigned char* _bp = stg + (buf) * 32768; \
      *(uint4*)(_bp + srow * 128 + ((sch ^ attn_fk(srow)) << 4)) = sr0; \
      *(uint4*)(_bp + 8192 + srow * 128 + ((sch ^ attn_fk(srow)) << 4)) = sr1; \
      *(uint4*)(_bp + 16384 + srow * 128 + ((sch ^ attn_fv(srow)) << 4)) = sr2; \
      *(uint4*)(_bp + 24576 + srow * 128 + ((sch ^ attn_fv(srow)) << 4)) = sr3; } while (0)
    __syncthreads();
    ATTN_LOAD(0);
    ATTN_WRITE(0);
    __syncthreads();
    bf16x8 qf[2];
    f32x4 o[4];
    float mrun = -1e30f, lrun = 0.f;
    const float* exth = ext;
#pragma unroll 1
    for (int st = 0; st < nst; ++st) {
      const int rd = st / nch, jc = jc0 + st - rd * nch, h = 2 * rd + hh;
      if (st + 1 < nst) ATTN_LOAD(st + 1);
      if (jc == jc0) {
#pragma unroll
        for (int ds = 0; ds < 2; ++ds) qf[ds] = *(const bf16x8*)(PROJ + (size_t)(t0 + iq) * INCP + C_QA + h * 64 + ds * 32 + fq * 8);
#pragma unroll
        for (int et = 0; et < 4; ++et) o[et] = (f32x4){0.f, 0.f, 0.f, 0.f};
        mrun = -1e30f; lrun = 0.f;
        exth = ext + h * 640 + 63 + 512 + iq - 8 * fq;
      }
      const unsigned char* kb = stg + (st & 1) * 32768 + hh * 8192;
      const unsigned char* vb = stg + (st & 1) * 32768 + (2 + hh) * 8192;
      float sc[2][2][4];
#pragma unroll
      for (int g = 0; g < 2; ++g)
#pragma unroll
        for (int tt = 0; tt < 2; ++tt) {
          const int key = 32 * g + 8 * (fr >> 2) + (fr & 3) + 4 * tt, fk = attn_fk(key);
          const bf16x8 k0 = *(const bf16x8*)(kb + key * 128 + ((fq ^ fk) << 4));
          const bf16x8 k1 = *(const bf16x8*)(kb + key * 128 + (((4 + fq) ^ fk) << 4));
          f32x4 s4 = __builtin_amdgcn_mfma_f32_16x16x32_bf16(k0, qf[0], (f32x4){0.f, 0.f, 0.f, 0.f}, 0, 0, 0);
          s4 = __builtin_amdgcn_mfma_f32_16x16x32_bf16(k1, qf[1], s4, 0, 0, 0);
#pragma unroll
          for (int j = 0; j < 4; ++j) sc[g][tt][j] = s4[j] * (0.125f * LOG2E) + exth[-(64 * jc + 32 * g + 4 * tt + j)];
        }
      float mloc = -1e30f;
#pragma unroll
      for (int g = 0; g < 2; ++g)
#pragma unroll
        for (int tt = 0; tt < 2; ++tt)
#pragma unroll
          for (int j = 0; j < 4; ++j) mloc = fmaxf(mloc, sc[g][tt][j]);
      mloc = fmaxf(mloc, __shfl_xor(mloc, 16)); mloc = fmaxf(mloc, __shfl_xor(mloc, 32));
      const float mnew = fmaxf(mrun, mloc), alpha = __builtin_amdgcn_exp2f(mrun - mnew);
      mrun = mnew;
      float ls = 0.f;
#pragma unroll
      for (int g = 0; g < 2; ++g)
#pragma unroll
        for (int tt = 0; tt < 2; ++tt)
#pragma unroll
          for (int j = 0; j < 4; ++j) { const float e = __builtin_amdgcn_exp2f(sc[g][tt][j] - mnew); sc[g][tt][j] = e; ls += e; }
      lrun = lrun * alpha + ls;
#pragma unroll
      for (int et = 0; et < 4; ++et) { o[et].x *= alpha; o[et].y *= alpha; o[et].z *= alpha; o[et].w *= alpha; }
#pragma unroll
      for (int g = 0; g < 2; ++g) {
        union { bf16x8 v; unsigned u[4]; } pf;
        pf.u[0] = pk2(sc[g][0][0], sc[g][0][1]); pf.u[1] = pk2(sc[g][0][2], sc[g][0][3]);
        pf.u[2] = pk2(sc[g][1][0], sc[g][1][1]); pf.u[3] = pk2(sc[g][1][2], sc[g][1][3]);
#pragma unroll
        for (int et = 0; et < 4; ++et) {
          const int er = 16 * et + fr;
          const bf16x8 vf = *(const bf16x8*)(vb + er * 128 + (((4 * g + fq) ^ attn_fv(er)) << 4));
          o[et] = __builtin_amdgcn_mfma_f32_16x16x32_bf16(vf, pf.v, o[et], 0, 0, 0);
        }
      }
      if (jc == 8) {
        float lt = lrun + __shfl_xor(lrun, 16); lt += __shfl_xor(lt, 32);
        const float inv = 1.f / lt;
#pragma unroll
        for (int et = 0; et < 4; ++et) {
          f32x4 v = o[et]; v.x *= inv; v.y *= inv; v.z *= inv; v.w *= inv;
          *(f32x4*)(ATT + (size_t)(t0 + iq) * 384 + h * 64 + et * 16 + fq * 4) = v;
        }
      }
      if (st + 1 < nst) ATTN_WRITE((st + 1) & 1);
      __syncthreads();
    }
#undef ATTN_LOAD
#undef ATTN_WRITE
  }
  __syncthreads();
}

__device__ __forceinline__ void ssm_bu32(const bf16_t* __restrict__ bbh_g, const bf16_t* __restrict__ urow, int lane,
                                         f32x16& lo_re, f32x16& hi_re, f32x16& lo_im, f32x16& hi_im) {
  const int hf = lane >> 5, pl = lane & 31;
  const bf16x8 ub = *(const bf16x8*)(urow + 8 * hf);
  f32x16 z;
#pragma unroll
  for (int r = 0; r < 16; ++r) z[r] = 0.f;
  const bf16x8 a0r = *(const bf16x8*)(bbh_g + (size_t)(0 * 64 + pl) * 16 + 8 * hf), a1r = *(const bf16x8*)(bbh_g + (size_t)(0 * 64 + 32 + pl) * 16 + 8 * hf);
  const bf16x8 a0i = *(const bf16x8*)(bbh_g + (size_t)(1 * 64 + pl) * 16 + 8 * hf), a1i = *(const bf16x8*)(bbh_g + (size_t)(1 * 64 + 32 + pl) * 16 + 8 * hf);
  lo_re = __builtin_amdgcn_mfma_f32_32x32x16_bf16(ub, a0r, z, 0, 0, 0); hi_re = __builtin_amdgcn_mfma_f32_32x32x16_bf16(ub, a1r, z, 0, 0, 0);
  lo_im = __builtin_amdgcn_mfma_f32_32x32x16_bf16(ub, a0i, z, 0, 0, 0); hi_im = __builtin_amdgcn_mfma_f32_32x32x16_bf16(ub, a1i, z, 0, 0, 0);
#pragma unroll
  for (int r = 0; r < 16; ++r) {
    const auto s1 = __builtin_amdgcn_permlane32_swap(__float_as_uint(lo_re[r]), __float_as_uint(hi_re[r]), false, false);
    lo_re[r] = __uint_as_float(s1[0]); hi_re[r] = __uint_as_float(s1[1]);
    const auto s2 = __builtin_amdgcn_permlane32_swap(__float_as_uint(lo_im[r]), __float_as_uint(hi_im[r]), false, false);
    lo_im[r] = __uint_as_float(s2[0]); hi_im[r] = __uint_as_float(s2[1]);
  }
}
__device__ __forceinline__ void rotary_frag(const bf16x8 x0, const bf16x8 x1, const float* __restrict__ RC, const float* __restrict__ RS, int pos, int fq, float scale, bf16x8& o0, bf16x8& o1) {
  const f32x4 c0 = *(const f32x4*)(RC + pos * 32 + 8 * fq), c1 = *(const f32x4*)(RC + pos * 32 + 8 * fq + 4);
  const f32x4 s0 = *(const f32x4*)(RS + pos * 32 + 8 * fq), s1 = *(const f32x4*)(RS + pos * 32 + 8 * fq + 4);
  const float cc[8] = {c0.x, c0.y, c0.z, c0.w, c1.x, c1.y, c1.z, c1.w}, sn[8] = {s0.x, s0.y, s0.z, s0.w, s1.x, s1.y, s1.z, s1.w};
  union { bf16x8 v; unsigned u[4]; } r0, r1;
#pragma unroll
  for (int q = 0; q < 4; ++q) {
    const float a0 = bf2f((bf16_t)x0[2 * q]) * scale, a1 = bf2f((bf16_t)x0[2 * q + 1]) * scale, b0 = bf2f((bf16_t)x1[2 * q]) * scale, b1 = bf2f((bf16_t)x1[2 * q + 1]) * scale;
    r0.u[q] = pk2(a0 * cc[2 * q] - b0 * sn[2 * q], a1 * cc[2 * q + 1] - b1 * sn[2 * q + 1]);
    r1.u[q] = pk2(a0 * sn[2 * q] + b0 * cc[2 * q], a1 * sn[2 * q + 1] + b1 * cc[2 * q + 1]);
  }
  o0 = r0.v; o1 = r1.v;
}
__device__ void mix_local_phase(const Params& p, int l, unsigned char* smem) {
  const CParamsP pp = launder_kargs();
  GAS unsigned char* const ws = launder_ptr(pp->ws); const int tidx = launder_tid();
  const bf16_t* PROJ = (const bf16_t*)(ws + WS_PROJ); const bf16_t* VTR = (const bf16_t*)(ws + WS_VTR);
  const float* RC = (const float*)(ws + WS_ROTC); const float* RS = (const float*)(ws + WS_ROTS);
  float* YINT = (float*)(ws + WS_YINT); float* UPDT = (float*)(ws + WS_UPD);
  const float* SA = (const float*)(ws + WS_SA) + (size_t)l * 16 * 64 * 2; const bf16_t* BBH = (const bf16_t*)(ws + WS_BBH) + (size_t)l * 16 * 2 * 64 * 16;
  float* SEND = (float*)(ws + WS_SEND);
  const int tid = tidx, lane = tid & 63, wid = tid >> 6, fr = lane & 15, fq = lane >> 4;
  bf16_t* KT = (bf16_t*)smem;
  for (int item = blockIdx.x; item < 256; item += gridDim.x) {
    const int b = item >> 7, n = item & 127, t0 = b * 8192 + n * 64;
    __syncthreads();
#pragma unroll 1
    for (int k3 = 0; k3 < 3; ++k3) {
      const int task = wid * 3 + k3, h = task >> 2, tb = task & 3;
      const int i = 16 * tb + fr;
      const float lg2 = log2f(1.f - exp2f(-5.f - (float)h));
      bf16x8 qf0, qf1;
      {
        const bf16_t* qp = PROJ + (size_t)(t0 + i) * INCP + C_QR + h * 64 + 8 * fq;
        rotary_frag(*(const bf16x8*)qp, *(const bf16x8*)(qp + 32), RC, RS, n * 64 + i, fq, 1.f, qf0, qf1);
      }
      f32x4 o[4];
#pragma unroll
      for (int et = 0; et < 4; ++et) o[et] = (f32x4){0.f, 0.f, 0.f, 0.f};
#pragma unroll
      for (int g = 0; g < 2; ++g) {
        float st[2][4];
#pragma unroll
        for (int tt = 0; tt < 2; ++tt) {
          const int key = 32 * g + 8 * (fr >> 2) + (fr & 3) + 4 * tt;
          const bf16_t* kp = PROJ + (size_t)(t0 + key) * INCP + C_KR + h * 64 + 8 * fq;
          bf16x8 kf0, kf1;
          rotary_frag(*(const bf16x8*)kp, *(const bf16x8*)(kp + 32), RC, RS, n * 64 + key, fq, 0.125f, kf0, kf1);
          f32x4 s4 = __builtin_amdgcn_mfma_f32_16x16x32_bf16(kf0, qf0, (f32x4){0.f, 0.f, 0.f, 0.f}, 0, 0, 0);
          s4 = __builtin_amdgcn_mfma_f32_16x16x32_bf16(kf1, qf1, s4, 0, 0, 0);
#pragma unroll
          for (int j = 0; j < 4; ++j) {
            const int kk = 32 * g + 8 * fq + 4 * tt + j;
            const int dij = i > kk ? i - kk : kk - i;
            st[tt][j] = s4[j] * exp2f(lg2 * (float)dij);
          }
          if (tb == 0) {
            const float kd = exp2f(lg2 * (float)(63 - key));
#pragma unroll
            for (int jj = 0; jj < 8; ++jj) {
              KT[(h * 64 + 8 * fq + jj) * 72 + key] = f2bf(bf2f((bf16_t)kf0[jj]) * kd);
              KT[(h * 64 + 32 + 8 * fq + jj) * 72 + key] = f2bf(bf2f((bf16_t)kf1[jj]) * kd);
            }
          }
        }
        union { bf16x8 v; unsigned u[4]; } pf;
        pf.u[0] = pk2(st[0][0], st[0][1]); pf.u[1] = pk2(st[0][2], st[0][3]); pf.u[2] = pk2(st[1][0], st[1][1]); pf.u[3] = pk2(st[1][2], st[1][3]);
#pragma unroll
        for (int et = 0; et < 4; ++et) {
          const bf16x8 vf = *(const bf16x8*)(VTR + ((size_t)b * 384 + h * 64 + et * 16 + fr) * 8192 + n * 64 + 32 * g + 8 * fq);
          o[et] = __builtin_amdgcn_mfma_f32_16x16x32_bf16(vf, pf.v, o[et], 0, 0, 0);
        }
      }
#pragma unroll
      for (int et = 0; et < 4; ++et) *(f32x4*)(YINT + (size_t)(t0 + i) * 384 + h * 64 + et * 16 + fq * 4) = o[et];
    }
    __syncthreads();
#pragma unroll 1
    for (int k3 = 0; k3 < 3; ++k3) {
      const int task = wid * 3 + k3, h = task >> 2, et = task & 3;
      f32x4 acc[4];
#pragma unroll
      for (int dt = 0; dt < 4; ++dt) acc[dt] = (f32x4){0.f, 0.f, 0.f, 0.f};
#pragma unroll
      for (int g = 0; g < 2; ++g) {
        const bf16x8 vf = *(const bf16x8*)(VTR + ((size_t)b * 384 + h * 64 + et * 16 + fr) * 8192 + n * 64 + 32 * g + 8 * fq);
#pragma unroll
        for (int dt = 0; dt < 4; ++dt) {
          const bf16x8 kt = *(const bf16x8*)(KT + (h * 64 + 16 * dt + fr) * 72 + 32 * g + 8 * fq);
          acc[dt] = __builtin_amdgcn_mfma_f32_16x16x32_bf16(kt, vf, acc[dt], 0, 0, 0);
        }
      }
#pragma unroll
      for (int dt = 0; dt < 4; ++dt) *(f32x4*)(UPDT + (((size_t)item * 6 + h) * 64 + 16 * et + fr) * 64 + 16 * dt + 4 * fq) = acc[dt];
    }
#pragma unroll 1
    for (int gi = 0; gi < 2; ++gi) {
      const int g = wid * 2 + gi;
      const float are = SA[(g * 64 + lane) * 2], aim = SA[(g * 64 + lane) * 2 + 1];
      float xr = 0.f, xi = 0.f;
#pragma unroll 1
      for (int blk = 0; blk < 2; ++blk) {
        f32x16 lr, hr, li, hi;
        ssm_bu32(BBH + (size_t)g * 2 * 64 * 16, PROJ + (size_t)(t0 + 32 * blk + (lane & 31)) * INCP + C_US + g * 16, lane, lr, hr, li, hi);
#pragma unroll
        for (int a4 = 0; a4 < 4; ++a4) {
#pragma unroll
          for (int bq = 0; bq < 4; ++bq) { const float nr = are * xr - aim * xi + lr[4 * a4 + bq], ni = are * xi + aim * xr + li[4 * a4 + bq]; xr = nr; xi = ni; }
#pragma unroll
          for (int bq = 0; bq < 4; ++bq) { const float nr = are * xr - aim * xi + hr[4 * a4 + bq], ni = are * xi + aim * xr + hi[4 * a4 + bq]; xr = nr; xi = ni; }
        }
      }
      SEND[(((size_t)item * 16 + g) * 64 + lane) * 2] = xr; SEND[(((size_t)item * 16 + g) * 64 + lane) * 2 + 1] = xi;
    }
  }
}

__device__ void scan_phase(const Params& p, int l) {
  const CParamsP pp = launder_kargs();
  GAS unsigned char* const ws = launder_ptr(pp->ws); const int tidx = launder_tid();
  const float* __restrict__ UPDT = (const float*)(ws + WS_UPD); bf16_t* __restrict__ SPT = (bf16_t*)(ws + WS_SPT);
  const float* __restrict__ SEND = (const float*)(ws + WS_SEND); float* __restrict__ CARRY = (float*)(ws + WS_CARRY);
  const float* SA = (const float*)(ws + WS_SA) + (size_t)l * 16 * 64 * 2;
  const int gtid = blockIdx.x * NT + tidx, gn = gridDim.x * NT;
  for (int idx = gtid; idx < 2 * 6 * 4096 + 2 * 1024; idx += gn) {
    if (idx < 2 * 6 * 4096) {
      const int b = idx / (6 * 4096), r = idx % (6 * 4096), h = r >> 12;
      const float cd = exp2f(64.f * log2f(1.f - exp2f(-5.f - (float)h)));
      float s = 0.f;
#pragma unroll 1
      for (int nb = 0; nb < NCH; nb += 16) {
        float v[16];
#pragma unroll
        for (int j = 0; j < 16; ++j) v[j] = UPDT[((size_t)(b * NCH + nb + j)) * 6 * 4096 + r];
#pragma unroll
        for (int j = 0; j < 16; ++j) { SPT[((size_t)(b * NCH + nb + j)) * 6 * 4096 + r] = f2bf(s); s = cd * s + v[j]; }
      }
    } else {
      const int r2 = idx - 2 * 6 * 4096, b = r2 >> 10, gp = r2 & 1023;
      float ar = SA[gp * 2], ai = SA[gp * 2 + 1];
#pragma unroll
      for (int q = 0; q < 6; ++q) { const float nr = ar * ar - ai * ai, ni = 2.f * ar * ai; ar = nr; ai = ni; }
      float xr = 0.f, xi = 0.f;
#pragma unroll 1
      for (int nb = 0; nb < NCH; nb += 16) {
        float2 v[16];
#pragma unroll
        for (int j = 0; j < 16; ++j) v[j] = *(const float2*)(SEND + (((size_t)(b * NCH + nb + j)) * 1024 + gp) * 2);
#pragma unroll
        for (int j = 0; j < 16; ++j) {
          *(float2*)(CARRY + (((size_t)(b * NCH + nb + j)) * 1024 + gp) * 2) = make_float2(xr, xi);
          const float nr = ar * xr - ai * xi + v[j].x, ni = ar * xi + ai * xr + v[j].y;
          xr = nr; xi = ni;
        }
      }
    }
  }
  if (l + 1 < DEPTH_) convert_tables_fp4(pp, ws, l + 1, gtid, gn);
}

__device__ void mix_final_phase(const Params& p, int l, unsigned char* smem) {
  const CParamsP pp = launder_kargs();
  GAS unsigned char* const ws = launder_ptr(pp->ws); const int tidx = launder_tid();
  const bf16_t* PROJ = (const bf16_t*)(ws + WS_PROJ);
  const float* RC = (const float*)(ws + WS_ROTC); const float* RS = (const float*)(ws + WS_ROTS);
  const float* YINT = (const float*)(ws + WS_YINT); const bf16_t* SPT = (const bf16_t*)(ws + WS_SPT);
  const float* ATT = (const float*)(ws + WS_ATT);
  const float* SA = (const float*)(ws + WS_SA) + (size_t)l * 16 * 64 * 2; const bf16_t* BBH = (const bf16_t*)(ws + WS_BBH) + (size_t)l * 16 * 2 * 64 * 16;
  const float* CARRY = (const float*)(ws + WS_CARRY);
  const bf16_t* CB = (const bf16_t*)(ws + WS_CB) + (size_t)l * 16 * 16 * 128; const bf16_t* WG = (const bf16_t*)(ws + WS_WGLUT) + (size_t)l * 512 * 256;
  const float* dsk = gin(pp->in[I_SSMD]) + (size_t)l * 256;
  const float* mg = gin(pp->in[I_MGAIN]) + (size_t)l * 1024;
  bf16_t* MRG = (bf16_t*)(ws + WS_ABUF);
  const int tid = tidx, lane = tid & 63, wid = tid >> 6, fr = lane & 15, fq = lane >> 4;
  bf16_t* YS = (bf16_t*)smem;
  float* red = (float*)(smem + 33792);
  bf16_t* XB = (bf16_t*)(smem + 36864 + wid * 8448 + 4096);
  for (int item = blockIdx.x; item < 256; item += gridDim.x) {
    const int b = item >> 7, n = item & 127, t0 = b * 8192 + n * 64;
    __syncthreads();
    for (int ii = 0; ii < 8; ++ii) {
      const int t = t0 + wid * 8 + ii;
      float v[6]; float sq = 0.f;
#pragma unroll
      for (int j = 0; j < 6; ++j) { v[j] = ATT[(size_t)t * 384 + lane + 64 * j]; sq += v[j] * v[j]; }
      const float rstd = rsqrtf(wave_sum(sq) * (1.f / 384.f) + EPS_);
#pragma unroll
      for (int j = 0; j < 6; ++j) MRG[(size_t)t * 1024 + lane + 64 * j] = f2bf(v[j] * rstd * mg[lane + 64 * j]);
    }
#pragma unroll 1
    for (int k3 = 0; k3 < 3; ++k3) {
      const int task = wid * 3 + k3, h = task >> 2, tb = task & 3;
      const int i = 16 * tb + fr, t = t0 + i;
      const float lg2 = log2f(1.f - exp2f(-5.f - (float)h));
      bf16x8 qf0, qf1;
      {
        const bf16_t* qp = PROJ + (size_t)t * INCP + C_QR + h * 64 + 8 * fq;
        rotary_frag(*(const bf16x8*)qp, *(const bf16x8*)(qp + 32), RC, RS, n * 64 + i, fq, 1.f, qf0, qf1);
      }
      f32x4 o[4];
#pragma unroll
      for (int et = 0; et < 4; ++et) {
        const bf16_t* sp = SPT + (((size_t)item * 6 + h) * 64 + 16 * et + fr) * 64 + 8 * fq;
        const bf16x8 a0 = *(const bf16x8*)sp, a1 = *(const bf16x8*)(sp + 32);
        o[et] = __builtin_amdgcn_mfma_f32_16x16x32_bf16(a0, qf0, (f32x4){0.f, 0.f, 0.f, 0.f}, 0, 0, 0);
        o[et] = __builtin_amdgcn_mfma_f32_16x16x32_bf16(a1, qf1, o[et], 0, 0, 0);
      }
      const float qd = exp2f(lg2 * (float)(i + 1));
      float y[16]; float s1 = 0.f;
#pragma unroll
      for (int et = 0; et < 4; ++et) {
        const f32x4 yi = *(const f32x4*)(YINT + (size_t)t * 384 + h * 64 + 16 * et + 4 * fq);
        y[4 * et] = yi.x + qd * o[et].x; y[4 * et + 1] = yi.y + qd * o[et].y; y[4 * et + 2] = yi.z + qd * o[et].z; y[4 * et + 3] = yi.w + qd * o[et].w;
        s1 += (y[4 * et] + y[4 * et + 1]) + (y[4 * et + 2] + y[4 * et + 3]);
      }
      s1 += __shfl_xor(s1, 16); s1 += __shfl_xor(s1, 32);
      const float mu = s1 * (1.f / 64.f);
      float s2 = 0.f;
#pragma unroll
      for (int q = 0; q < 16; ++q) { y[q] -= mu; s2 += y[q] * y[q]; }
      s2 += __shfl_xor(s2, 16); s2 += __shfl_xor(s2, 32);
      const float rstd = rsqrtf(s2 * (1.f / 64.f) + EPS_);
#pragma unroll
      for (int et = 0; et < 4; ++et) {
        const int c = h * 64 + 16 * et + 4 * fq;
        const uint2 gr = *(const uint2*)(PROJ + (size_t)t * INCP + C_GR + c);
        const float g0 = __uint_as_float(gr.x << 16), g1 = __uint_as_float(gr.x & 0xffff0000u), g2 = __uint_as_float(gr.y << 16), g3 = __uint_as_float(gr.y & 0xffff0000u);
        const f32x4 mgv = *(const f32x4*)(mg + 384 + c);
        uint2 ov;
        ov.x = pk2(y[4 * et] * rstd * (g0 * sigmoid_f(g0)) * mgv.x, y[4 * et + 1] * rstd * (g1 * sigmoid_f(g1)) * mgv.y);
        ov.y = pk2(y[4 * et + 2] * rstd * (g2 * sigmoid_f(g2)) * mgv.z, y[4 * et + 3] * rstd * (g3 * sigmoid_f(g3)) * mgv.w);
        *(uint2*)(MRG + (size_t)t * 1024 + 384 + c) = ov;
      }
    }
#pragma unroll 1
    for (int gi = 0; gi < 2; ++gi) {
      const int g = wid * 2 + gi;
      const float are = SA[(g * 64 + lane) * 2], aim = SA[(g * 64 + lane) * 2 + 1];
      float xr = CARRY[(((size_t)item * 16 + g) * 64 + lane) * 2], xi = CARRY[(((size_t)item * 16 + g) * 64 + lane) * 2 + 1];
      bf16x8 cb[4];
#pragma unroll
      for (int ks = 0; ks < 4; ++ks) cb[ks] = *(const bf16x8*)(CB + ((size_t)g * 16 + fr) * 128 + 32 * ks + 8 * fq);
      const float dv = dsk[g * 16 + fr];
#pragma unroll 1
      for (int blk = 0; blk < 2; ++blk) {
        f32x16 lr, hr, li, hi;
        ssm_bu32(BBH + (size_t)g * 2 * 64 * 16, PROJ + (size_t)(t0 + 32 * blk + (lane & 31)) * INCP + C_US + g * 16, lane, lr, hr, li, hi);
#pragma unroll
        for (int half = 0; half < 2; ++half) {
#pragma unroll
          for (int a2 = 0; a2 < 2; ++a2) {
            const int a4 = 2 * half + a2;
#pragma unroll
            for (int bq = 0; bq < 4; ++bq) {
              const float nr = are * xr - aim * xi + lr[4 * a4 + bq], ni = are * xi + aim * xr + li[4 * a4 + bq]; xr = nr; xi = ni;
              XB[(8 * a2 + bq) * 136 + lane] = f2bf(xr); XB[(8 * a2 + bq) * 136 + 64 + lane] = f2bf(xi);
            }
#pragma unroll
            for (int bq = 0; bq < 4; ++bq) {
              const float nr = are * xr - aim * xi + hr[4 * a4 + bq], ni = are * xi + aim * xr + hi[4 * a4 + bq]; xr = nr; xi = ni;
              XB[(8 * a2 + 4 + bq) * 136 + lane] = f2bf(xr); XB[(8 * a2 + 4 + bq) * 136 + 64 + lane] = f2bf(xi);
            }
          }
          f32x4 acc = (f32x4){0.f, 0.f, 0.f, 0.f};
#pragma unroll
          for (int ks = 0; ks < 4; ++ks) {
            const bf16x8 af = *(const bf16x8*)(XB + fr * 136 + 32 * ks + 8 * fq);
            acc = __builtin_amdgcn_mfma_f32_16x16x32_bf16(af, cb[ks], acc, 0, 0, 0);
          }
#pragma unroll
          for (int j = 0; j < 4; ++j) {
            const int i = 32 * blk + 16 * half + 4 * fq + j;
            const float yv = acc[j] + dv * bf2f(PROJ[(size_t)(t0 + i) * INCP + C_US + g * 16 + fr]);
            YS[i * 264 + g * 16 + fr] = f2bf(gelu_tanh(yv));
          }
        }
      }
    }
    __syncthreads();
    {
      const int n0 = 32 * wid;
      f32x4 a1[4][2], a2[4][2];
#pragma unroll
      for (int mt = 0; mt < 4; ++mt)
#pragma unroll
        for (int nt = 0; nt < 2; ++nt) { a1[mt][nt] = (f32x4){0.f, 0.f, 0.f, 0.f}; a2[mt][nt] = (f32x4){0.f, 0.f, 0.f, 0.f}; }
#pragma unroll 2
      for (int ks = 0; ks < 8; ++ks) {
        bf16x8 w1[2], w2[2], yb[4];
#pragma unroll
        for (int nt = 0; nt < 2; ++nt) {
          w1[nt] = *(const bf16x8*)(WG + (size_t)(n0 + 16 * nt + fr) * 256 + 32 * ks + 8 * fq);
          w2[nt] = *(const bf16x8*)(WG + (size_t)(256 + n0 + 16 * nt + fr) * 256 + 32 * ks + 8 * fq);
        }
#pragma unroll
        for (int mt = 0; mt < 4; ++mt) yb[mt] = *(const bf16x8*)(YS + (16 * mt + fr) * 264 + 32 * ks + 8 * fq);
#pragma unroll
        for (int mt = 0; mt < 4; ++mt)
#pragma unroll
          for (int nt = 0; nt < 2; ++nt) {
            a1[mt][nt] = __builtin_amdgcn_mfma_f32_16x16x32_bf16(w1[nt], yb[mt], a1[mt][nt], 0, 0, 0);
            a2[mt][nt] = __builtin_amdgcn_mfma_f32_16x16x32_bf16(w2[nt], yb[mt], a2[mt][nt], 0, 0, 0);
          }
      }
#pragma unroll
      for (int mt = 0; mt < 4; ++mt) {
        float sq = 0.f;
#pragma unroll
        for (int nt = 0; nt < 2; ++nt) {
          f32x4 z = a1[mt][nt]; const f32x4 zg = a2[mt][nt];
          z.x *= sigmoid_f(zg.x); z.y *= sigmoid_f(zg.y); z.z *= sigmoid_f(zg.z); z.w *= sigmoid_f(zg.w);
          a1[mt][nt] = z; sq += z.x * z.x + z.y * z.y + z.z * z.z + z.w * z.w;
        }
        sq += __shfl_xor(sq, 16); sq += __shfl_xor(sq, 32);
        if (fq == 0) red[wid * 64 + 16 * mt + fr] = sq;
      }
      __syncthreads();
#pragma unroll
      for (int mt = 0; mt < 4; ++mt) {
        const int i = 16 * mt + fr, t = t0 + i;
        float tot = 0.f;
#pragma unroll
        for (int w8 = 0; w8 < 8; ++w8) tot += red[w8 * 64 + i];
        const float rstd = rsqrtf(tot * (1.f / 256.f) + EPS_);
#pragma unroll
        for (int nt = 0; nt < 2; ++nt) {
          const int c = n0 + 16 * nt + 4 * fq;
          const f32x4 mgv = *(const f32x4*)(mg + 768 + c); const f32x4 z = a1[mt][nt];
          uint2 ov; ov.x = pk2(z.x * rstd * mgv.x, z.y * rstd * mgv.y); ov.y = pk2(z.z * rstd * mgv.z, z.w * rstd * mgv.w);
          *(uint2*)(MRG + (size_t)t * 1024 + 768 + c) = ov;
        }
      }
    }
  }
}

typedef float f32x2 __attribute__((ext_vector_type(2)));
__device__ __forceinline__ float dot16_fp4(const uint2 u, const f32x2 (&hv)[8]) {
  f32x2 d = __builtin_amdgcn_cvt_scalef32_pk_f32_fp4(u.x, 1.0f, 0) * hv[0];
  d += __builtin_amdgcn_cvt_scalef32_pk_f32_fp4(u.x, 1.0f, 1) * hv[1];
  d += __builtin_amdgcn_cvt_scalef32_pk_f32_fp4(u.x, 1.0f, 2) * hv[2];
  d += __builtin_amdgcn_cvt_scalef32_pk_f32_fp4(u.x, 1.0f, 3) * hv[3];
  d += __builtin_amdgcn_cvt_scalef32_pk_f32_fp4(u.y, 1.0f, 0) * hv[4];
  d += __builtin_amdgcn_cvt_scalef32_pk_f32_fp4(u.y, 1.0f, 1) * hv[5];
  d += __builtin_amdgcn_cvt_scalef32_pk_f32_fp4(u.y, 1.0f, 2) * hv[6];
  d += __builtin_amdgcn_cvt_scalef32_pk_f32_fp4(u.y, 1.0f, 3) * hv[7];
  return d.x + d.y;
}
__device__ __forceinline__ void axpy16_fp4(const uint2 v, const float w, f32x2 (&acc)[8]) {
  const f32x2 w2 = (f32x2){w, w};
  acc[0] += w2 * __builtin_amdgcn_cvt_scalef32_pk_f32_fp4(v.x, 1.0f, 0);
  acc[1] += w2 * __builtin_amdgcn_cvt_scalef32_pk_f32_fp4(v.x, 1.0f, 1);
  acc[2] += w2 * __builtin_amdgcn_cvt_scalef32_pk_f32_fp4(v.x, 1.0f, 2);
  acc[3] += w2 * __builtin_amdgcn_cvt_scalef32_pk_f32_fp4(v.x, 1.0f, 3);
  acc[4] += w2 * __builtin_amdgcn_cvt_scalef32_pk_f32_fp4(v.y, 1.0f, 0);
  acc[5] += w2 * __builtin_amdgcn_cvt_scalef32_pk_f32_fp4(v.y, 1.0f, 1);
  acc[6] += w2 * __builtin_amdgcn_cvt_scalef32_pk_f32_fp4(v.y, 1.0f, 2);
  acc[7] += w2 * __builtin_amdgcn_cvt_scalef32_pk_f32_fp4(v.y, 1.0f, 3);
}
__device__ __forceinline__ float vmaxf(float a, float b) { float r; asm("v_max_f32 %0, %1, %2" : "=v"(r) : "v"(a), "v"(b)); return r; }
__device__ __forceinline__ float vminf(float a, float b) { float r; asm("v_min_f32 %0, %1, %2" : "=v"(r) : "v"(a), "v"(b)); return r; }
__device__ __forceinline__ void cx(float& hi, float& lo) { const float a = hi, b = lo; hi = vmaxf(a, b); lo = vminf(a, b); }
__device__ __forceinline__ void cx2(float& kh, int& ph, float& kl, int& pl) {
  const float a = kh, b = kl; const int pa = ph, pb = pl; const bool c = a >= b;
  kh = vmaxf(a, b); kl = vminf(a, b); ph = c ? pa : pb; pl = c ? pb : pa;
}
__device__ __forceinline__ void bitonic_sort16_desc(float (&v)[16]) {
#pragma unroll
  for (int k = 2; k <= 16; k <<= 1)
#pragma unroll
    for (int j = k >> 1; j > 0; j >>= 1)
#pragma unroll
      for (int i = 0; i < 16; ++i) {
        const int l = i ^ j;
        if (l > i) { if ((i & k) == 0) cx(v[i], v[l]); else cx(v[l], v[i]); }
      }
}
__device__ __forceinline__ void bitonic_merge16_desc(float (&v)[16]) {
#pragma unroll
  for (int j = 8; j > 0; j >>= 1)
#pragma unroll
    for (int i = 0; i < 16; ++i) { const int l = i ^ j; if (l > i) cx(v[i], v[l]); }
}
__device__ __forceinline__ void top16_merge(float (&a)[16], const float (&b)[16]) {
#pragma unroll
  for (int i = 0; i < 16; ++i) a[i] = vmaxf(a[i], b[15 - i]);
  bitonic_merge16_desc(a);
}
template <int M> __device__ __forceinline__ void top16_merge_chain(float (&k)[16], int (&q)[16], const float (&xk)[M], const int (&xq)[M]) {
#pragma unroll
  for (int i = 16 - M; i < 16; ++i) { const float a = k[i], b = xk[15 - i]; const bool c = a >= b; k[i] = vmaxf(a, b); q[i] = c ? q[i] : xq[15 - i]; }
#pragma unroll
  for (int j = 8; j > 0; j >>= 1)
#pragma unroll
    for (int i = 0; i < 16; ++i) { const int l = i ^ j; if (l > i) cx2(k[i], q[i], k[l], q[l]); }
}

__device__ void peer_phase(const Params& p, int l, bool last, unsigned char* smem) {
  const CParamsP pp = launder_kargs();
  GAS unsigned char* const ws = launder_ptr(pp->ws); const int tidx = launder_tid();
  bf16_t* HF = (bf16_t*)(ws + WS_ABUF); float* X = (float*)(ws + WS_X);
  const bf16_t* Q = (const bf16_t*)(ws + WS_Q); const bf16_t* SK = (const bf16_t*)(ws + WS_SUBK) + (size_t)l * 16 * 128 * 128;
  const uint2* U4 = (const uint2*)(ws + WS_PU8) + (size_t)l * 16384 * 64; const uint2* V4 = (const uint2*)(ws + WS_PV8) + (size_t)l * 16384 * 64;
  const float* g2 = (const float*)(ws + WS_MOD) + (size_t)l * 2 * 6144 + 5120;
  const bf16_t* XG = (const bf16_t*)(ws + WS_XG); const float* SSQ = (const float*)(ws + WS_SSQ); const float* sh2 = (const float*)(ws + WS_MOD) + (size_t)l * 2 * 6144 + 3072;
  const int ln = last ? l : l + 1;
  const float* nsh = (const float*)(ws + WS_MOD) + (size_t)ln * 2 * 6144; const float* nsc = nsh + 1024;
  const float* ngain = gin(pp->in[I_NMIX]) + (size_t)ln * 1024;
  const int lane = tidx & 63, wid = tidx >> 6;
  const int rL = ((lane >> 5) & 1) * 8 + ((lane >> 4) & 1) * 4 + ((lane >> 3) & 1) * 2 + ((lane >> 2) & 1);
  const bool hi5 = (lane & 32) != 0, hi4 = (lane & 16) != 0, hi3 = (lane & 8) != 0, hi2 = (lane & 4) != 0;
  int* idxL = (int*)smem; float* gateL = (float*)(smem + 64 * 132 * 4);
  for (int item = blockIdx.x; item < T_ / 64; item += gridDim.x) {
    const int t0 = item * 64;
    __syncthreads();
    {
      int lane_o = lane; asm volatile("" : "+v"(lane_o));
      const int tg = wid & 1, hp = wid >> 1, hf = lane_o >> 5, tl = 32 * tg + (lane_o & 31);
      const bf16_t* qrow = Q + (size_t)(t0 + tl) * 2048;
      float F[2][16];
#pragma unroll
      for (int sd = 0; sd < 2; ++sd) {
        float Lh[2][16];
#pragma unroll
        for (int hh = 0; hh < 2; ++hh) {
          const int hs = 2 * (2 * hp + hh) + sd;
          float top[16];
          const bf16_t* skb = SK + ((size_t)hs * 128 + (lane & 31)) * 128 + 8 * hf;
#pragma unroll
          for (int kp = 0; kp < 2; ++kp) {
            f32x16 acc[2];
#pragma unroll
            for (int kt = 0; kt < 2; ++kt)
#pragma unroll
              for (int r = 0; r < 16; ++r) acc[kt][r] = 0.f;
#pragma unroll 2
            for (int ks = 0; ks < 8; ++ks) {
              const bf16x8 bq = *(const bf16x8*)(qrow + hs * 128 + ks * 16 + 8 * hf);
#pragma unroll
              for (int kt = 0; kt < 2; ++kt) {
                const bf16x8 ak = *(const bf16x8*)(skb + (size_t)(kp * 2 + kt) * 32 * 128 + ks * 16);
                acc[kt] = __builtin_amdgcn_mfma_f32_32x32x16_bf16(ak, bq, acc[kt], 0, 0, 0);
              }
            }
#pragma unroll
            for (int kt = 0; kt < 2; ++kt) {
              float g[16];
#pragma unroll
              for (int r = 0; r < 16; ++r) {
                const int key = (kp * 2 + kt) * 32 + (r & 3) + 8 * (r >> 2) + 4 * hf;
                g[r] = __uint_as_float((__float_as_uint(acc[kt][r]) & 0xffffff80u) | (unsigned)key);
              }
              bitonic_sort16_desc(g);
              if (kp == 0 && kt == 0) {
#pragma unroll
                for (int r = 0; r < 16; ++r) top[r] = g[r];
              } else top16_merge(top, g);
              __builtin_amdgcn_sched_barrier(0);
            }
          }
#pragma unroll
          for (int r = 0; r < 16; ++r) Lh[hh][r] = top[r];
          __builtin_amdgcn_sched_barrier(0);
        }
#pragma unroll
        for (int r = 0; r < 16; ++r) {
          const auto sw = __builtin_amdgcn_permlane32_swap(__float_as_uint(Lh[0][r]), __float_as_uint(Lh[1][r]), false, false);
          Lh[0][r] = __uint_as_float(sw[0]); Lh[1][r] = __uint_as_float(sw[1]);
        }
        top16_merge(Lh[0], Lh[1]);
#pragma unroll
        for (int r = 0; r < 16; ++r) F[sd][r] = Lh[0][r];
        __builtin_amdgcn_sched_barrier(0);
      }
      int ia[16], ib[16];
#pragma unroll
      for (int r = 0; r < 16; ++r) { ia[r] = (int)(__float_as_uint(F[0][r]) & 127u) << 7; ib[r] = (int)(__float_as_uint(F[1][r]) & 127u); }
      float k[16]; int q[16];
#pragma unroll
      for (int j = 0; j < 16; ++j) { k[j] = F[0][0] + F[1][j]; q[j] = ia[0] | ib[j]; }
      { float xk[8]; int xq[8];
#pragma unroll
        for (int j = 0; j < 8; ++j) { xk[j] = F[0][1] + F[1][j]; xq[j] = ia[1] | ib[j]; }
        top16_merge_chain<8>(k, q, xk, xq); }
      { float xk[5]; int xq[5];
#pragma unroll
        for (int j = 0; j < 5; ++j) { xk[j] = F[0][2] + F[1][j]; xq[j] = ia[2] | ib[j]; }
        top16_merge_chain<5>(k, q, xk, xq); }
      { float xk[4]; int xq[4];
#pragma unroll
        for (int j = 0; j < 4; ++j) { xk[j] = F[0][3] + F[1][j]; xq[j] = ia[3] | ib[j]; }
        top16_merge_chain<4>(k, q, xk, xq); }
      { float xk[3]; int xq[3];
#pragma unroll
        for (int j = 0; j < 3; ++j) { xk[j] = F[0][4] + F[1][j]; xq[j] = ia[4] | ib[j]; }
        top16_merge_chain<3>(k, q, xk, xq); }
      { float xk[11]; int xq[11];
#pragma unroll
        for (int i = 0; i < 11; ++i) { xk[i] = F[0][5 + i] + F[1][0]; xq[i] = ia[5 + i] | ib[0]; }
        top16_merge_chain<11>(k, q, xk, xq); }
      { float xk[3]; int xq[3];
#pragma unroll
        for (int i = 0; i < 3; ++i) { xk[i] = F[0][5 + i] + F[1][1]; xq[i] = ia[5 + i] | ib[1]; }
        top16_merge_chain<3>(k, q, xk, xq); }
      float e[16]; float es = 0.f;
#pragma unroll
      for (int i = 0; i < 16; ++i) { e[i] = __expf(k[i] - k[0]); es += e[i]; }
      const float ies = 1.f / es;
      const int h = 2 * hp + hf;
#pragma unroll
      for (int i = 0; i < 16; ++i) { idxL[tl * 132 + h * 16 + i] = q[i]; gateL[tl * 132 + h * 16 + i] = e[i] * ies; }
    }
    __syncthreads();
#pragma unroll 1
    for (int ii = 0; ii < 8; ++ii) {
      const int tl = wid * 8 + ii, t = t0 + tl, b = t >> 13;
      const int fr = lane & 15, fq = lane >> 4;
      uint4 hB1[8], hB2[8];
      {
        const uint4 h0 = *(const uint4*)(XG + (size_t)t * 1024 + lane * 16), h1 = *(const uint4*)(XG + (size_t)t * 1024 + lane * 16 + 8);
        const unsigned hw[8] = {h0.x, h0.y, h0.z, h0.w, h1.x, h1.y, h1.z, h1.w};
        const float rs = rsqrtf(ssq_total(SSQ, t) * (1.f / 1024.f) + EPS_);
        unsigned q1[2] = {0u, 0u}, q2[2] = {0u, 0u};
#pragma unroll
        for (int qq = 0; qq < 4; ++qq) {
          const f32x4 sh = *(const f32x4*)(sh2 + b * 6144 + lane * 16 + 4 * qq);
          float hvv[4];
          hvv[0] = __uint_as_float(hw[2 * qq] << 16) * rs + sh.x; hvv[1] = __uint_as_float(hw[2 * qq] & 0xffff0000u) * rs + sh.y;
          hvv[2] = __uint_as_float(hw[2 * qq + 1] << 16) * rs + sh.z; hvv[3] = __uint_as_float(hw[2 * qq + 1] & 0xffff0000u) * rs + sh.w;
#pragma unroll
          for (int pr = 0; pr < 2; ++pr) {
            const int byte_sel = (2 * qq + pr) & 3, wd = (2 * qq + pr) >> 2;
            const float x0 = fminf(fmaxf(hvv[2 * pr], -6.f), 6.f), x1 = fminf(fmaxf(hvv[2 * pr + 1], -6.f), 6.f);
            unsigned t1 = 0u;
            if (byte_sel == 0) t1 = __builtin_amdgcn_cvt_scalef32_pk_fp4_f32(0u, x0, x1, 1.0f, 0);
            else if (byte_sel == 1) t1 = __builtin_amdgcn_cvt_scalef32_pk_fp4_f32(0u, x0, x1, 1.0f, 1);
            else if (byte_sel == 2) t1 = __builtin_amdgcn_cvt_scalef32_pk_fp4_f32(0u, x0, x1, 1.0f, 2);
            else t1 = __builtin_amdgcn_cvt_scalef32_pk_fp4_f32(0u, x0, x1, 1.0f, 3);
            f32x2 back;
            if (byte_sel == 0) back = __builtin_amdgcn_cvt_scalef32_pk_f32_fp4(t1, 1.0f, 0);
            else if (byte_sel == 1) back = __builtin_amdgcn_cvt_scalef32_pk_f32_fp4(t1, 1.0f, 1);
            else if (byte_sel == 2) back = __builtin_amdgcn_cvt_scalef32_pk_f32_fp4(t1, 1.0f, 2);
            else back = __builtin_amdgcn_cvt_scalef32_pk_f32_fp4(t1, 1.0f, 3);
            const float r0 = fminf(fmaxf((hvv[2 * pr] - back.x) * 8.f, -6.f), 6.f), r1 = fminf(fmaxf((hvv[2 * pr + 1] - back.y) * 8.f, -6.f), 6.f);
            unsigned t2 = 0u;
            if (byte_sel == 0) t2 = __builtin_amdgcn_cvt_scalef32_pk_fp4_f32(0u, r0, r1, 1.0f, 0);
            else if (byte_sel == 1) t2 = __builtin_amdgcn_cvt_scalef32_pk_fp4_f32(0u, r0, r1, 1.0f, 1);
            else if (byte_sel == 2) t2 = __builtin_amdgcn_cvt_scalef32_pk_fp4_f32(0u, r0, r1, 1.0f, 2);
            else t2 = __builtin_amdgcn_cvt_scalef32_pk_fp4_f32(0u, r0, r1, 1.0f, 3);
            q1[wd] |= t1; q2[wd] |= t2;
          }
        }
        unsigned char* hq4 = smem + 67584 + wid * 1024;
        *(uint2*)(hq4 + lane * 8) = make_uint2(q1[0], q1[1]);
        *(uint2*)(hq4 + 512 + lane * 8) = make_uint2(q2[0], q2[1]);
#pragma unroll
        for (int kc = 0; kc < 8; ++kc) { hB1[kc] = *(const uint4*)(hq4 + 64 * kc + 16 * fq); hB2[kc] = *(const uint4*)(hq4 + 512 + 64 * kc + 16 * fq); }
      }
      f32x2 acc2[8];
#pragma unroll
      for (int j = 0; j < 8; ++j) acc2[j] = (f32x2){0.f, 0.f};
#pragma unroll 1
      for (int bt = 0; bt < 8; ++bt) {
        const int myidx = idxL[tl * 132 + 16 * bt + fr];
        const unsigned char* urow = (const unsigned char*)U4 + (size_t)myidx * 512 + 16 * fq;
        uint4 ua[8];
#pragma unroll
        for (int kc = 0; kc < 8; ++kc) ua[kc] = *(const uint4*)(urow + 64 * kc);
        uint2 vr[16];
#pragma unroll
        for (int r = 0; r < 16; ++r) { const int er = __builtin_amdgcn_readlane(myidx, r); const uint2* rowp = V4 + (size_t)er * 64; vr[r] = rowp[lane]; }
        f32x4 sc4 = (f32x4){0.f, 0.f, 0.f, 0.f}, sc4b = (f32x4){0.f, 0.f, 0.f, 0.f};
#pragma unroll
        for (int kc = 0; kc < 8; ++kc) {
          const i32x8 av = (i32x8){(int)ua[kc].x, (int)ua[kc].y, (int)ua[kc].z, (int)ua[kc].w, 0, 0, 0, 0};
          const i32x8 b1 = (i32x8){(int)hB1[kc].x, (int)hB1[kc].y, (int)hB1[kc].z, (int)hB1[kc].w, 0, 0, 0, 0};
          const i32x8 b2 = (i32x8){(int)hB2[kc].x, (int)hB2[kc].y, (int)hB2[kc].z, (int)hB2[kc].w, 0, 0, 0, 0};
          sc4 = __builtin_amdgcn_mfma_scale_f32_16x16x128_f8f6f4(av, b1, sc4, 4  , 4  , 0, 0x7F7F7F7F, 0, 0x7F7F7F7F);
          sc4b = __builtin_amdgcn_mfma_scale_f32_16x16x128_f8f6f4(av, b2, sc4b, 4, 4, 0, 0x7F7F7F7F, 0, 0x7F7F7F7F);
        }
        sc4 = sc4 + sc4b * 0.125f;
        const int jsel = lane & 3;
        const float dsel = jsel == 0 ? sc4[0] : (jsel == 1 ? sc4[1] : (jsel == 2 ? sc4[2] : sc4[3]));
        const float gl = gateL[tl * 132 + 16 * bt + 4 * fq + jsel];
        const float w = gl * gelu_tanh(dsel * (1.f / 64.f));
#pragma unroll
        for (int r = 0; r < 16; ++r) {
          const float wr = __int_as_float(__builtin_amdgcn_readlane(__float_as_int(w), 16 * (r >> 2) + (r & 3)));
          axpy16_fp4(vr[r], wr, acc2);
          __builtin_amdgcn_sched_barrier(0);
        }
      }
      float acc[16];
#pragma unroll
      for (int j = 0; j < 8; ++j) { acc[2 * j] = acc2[j].x; acc[2 * j + 1] = acc2[j].y; }
      float xn[16]; float ss = 0.f;
#pragma unroll
      for (int qq = 0; qq < 4; ++qq) {
        const int c = lane * 16 + 4 * qq;
        const f32x4 xv = *(const f32x4*)(X + (size_t)t * 1024 + c), g = *(const f32x4*)(g2 + b * 6144 + c);
        xn[4 * qq] = xv.x + g.x * acc[4 * qq] * 0.25f; xn[4 * qq + 1] = xv.y + g.y * acc[4 * qq + 1] * 0.25f;
        xn[4 * qq + 2] = xv.z + g.z * acc[4 * qq + 2] * 0.25f; xn[4 * qq + 3] = xv.w + g.w * acc[4 * qq + 3] * 0.25f;
        ss += xn[4 * qq] * xn[4 * qq] + xn[4 * qq + 1] * xn[4 * qq + 1] + xn[4 * qq + 2] * xn[4 * qq + 2] + xn[4 * qq + 3] * xn[4 * qq + 3];
      }
      const float rstd = rsqrtf(wave_sum(ss) * (1.f / 1024.f) + EPS_);
      if (!last) {
        unsigned hb[8];
#pragma unroll
        for (int qq = 0; qq < 4; ++qq) {
          const int c = lane * 16 + 4 * qq;
          *(f32x4*)(X + (size_t)t * 1024 + c) = (f32x4){xn[4 * qq], xn[4 * qq + 1], xn[4 * qq + 2], xn[4 * qq + 3]};
          const f32x4 gn = *(const f32x4*)(ngain + c), sh = *(const f32x4*)(nsh + b * 6144 + c), sc = *(const f32x4*)(nsc + b * 6144 + c);
          hb[2 * qq] = pk2(xn[4 * qq] * rstd * gn.x * (1.f + sc.x) + sh.x, xn[4 * qq + 1] * rstd * gn.y * (1.f + sc.y) + sh.y);
          hb[2 * qq + 1] = pk2(xn[4 * qq + 2] * rstd * gn.z * (1.f + sc.z) + sh.z, xn[4 * qq + 3] * rstd * gn.w * (1.f + sc.w) + sh.w);
        }
        *(uint4*)(HF + (size_t)t * 1024 + lane * 16) = make_uint4(hb[0], hb[1], hb[2], hb[3]);
        *(uint4*)(HF + (size_t)t * 1024 + lane * 16 + 8) = make_uint4(hb[4], hb[5], hb[6], hb[7]);
      } else {
#pragma unroll
        for (int qq = 0; qq < 4; ++qq) {
          const int c = lane * 16 + 4 * qq;
          const f32x4 fn = *(const f32x4*)(gin(pp->in[I_FNORM]) + c);
          *(f32x4*)((float*)pp->out + (size_t)t * 1024 + c) = (f32x4){xn[4 * qq] * rstd * fn.x, xn[4 * qq + 1] * rstd * fn.y, xn[4 * qq + 2] * rstd * fn.z, xn[4 * qq + 3] * rstd * fn.w};
        }
      }
    }
  }
}

#define XB_TMO      128
#define XB_XCNT(j)  (256  + 64 * (j))
#define XB_XSUB(j)  (1280 + 64 * (j))
#define XB_XGEN(j)  (2304 + 64 * (j))
#define XB_TOP      3328
#define XB_TOPGEN   3392
#define XCD_BAR_WORDS 3456
#define XB_SPIN_CAP (1u << 20)
#define LAS __attribute__((address_space(3)))
__device__ __forceinline__ unsigned xb_ld(unsigned* q)              { return __hip_atomic_load(q, __ATOMIC_RELAXED, __HIP_MEMORY_SCOPE_AGENT); }
__device__ __forceinline__ unsigned xb_add(unsigned* q, unsigned v) { return __hip_atomic_fetch_add(q, v, __ATOMIC_RELAXED, __HIP_MEMORY_SCOPE_AGENT); }
__device__ __forceinline__ unsigned xb_xcc_id() { return (unsigned)__builtin_amdgcn_s_getreg((3 << 11) | 20) & 0xFu; }
#define XB_SPIN(cond, bar) do { unsigned _sp = 0; while (cond) { __builtin_amdgcn_s_sleep(1); \
    if ((++_sp & 255u) == 0u) { if (xb_ld(&(bar)[XB_TMO])) break; if (_sp > XB_SPIN_CAP) { atomicAdd(&(bar)[XB_TMO], 1u); break; } } } } while (0)
struct XcdBarrier { unsigned* bar; unsigned x; volatile LAS unsigned* st; };
__device__ __forceinline__ XcdBarrier xcd_barrier_post(unsigned* bar, volatile LAS unsigned* st) {
    XcdBarrier b; b.bar = bar; b.x = xb_xcc_id(); b.st = st;
    if (threadIdx.x == 0) (void)xb_add(&bar[XB_XCNT(b.x)], 1u);
    return b;
}
__device__ __forceinline__ void xcd_barrier_complete(unsigned* bar, unsigned x, unsigned& nloc, unsigned& nx) {
    const unsigned G = gridDim.x * gridDim.y * gridDim.z;
    unsigned sum, cnt, mine, sp = 0u;
    for (;;) {
        sum = 0u; cnt = 0u; mine = 0u;
#pragma unroll
        for (unsigned j = 0; j < 16; ++j) { const unsigned c = xb_ld(&bar[XB_XCNT(j)]); sum += c; cnt += (c > 0u) ? 1u : 0u; mine = (j == x) ? c : mine; }
        if (sum == G) break;
        __builtin_amdgcn_s_sleep(1);
        if ((++sp & 255u) == 0u) { if (xb_ld(&bar[XB_TMO])) break; if (sp > XB_SPIN_CAP) { atomicAdd(&bar[XB_TMO], 1u); break; } }
    }
    nloc = mine > 0u ? mine : 1u; nx = cnt > 0u ? cnt : 1u;
}
__device__ __forceinline__ void xcd_barrier(const XcdBarrier& b) {
    asm volatile("s_waitcnt vmcnt(0)" ::: "memory");
    __syncthreads();
    if (threadIdx.x == 0) {
        unsigned* bar = b.bar;
        __builtin_amdgcn_s_waitcnt(0);
        unsigned nloc = b.st[0], nx = b.st[1];
        if (nloc == 0u) { xcd_barrier_complete(bar, b.x, nloc, nx); b.st[0] = nloc; b.st[1] = nx; }
        const unsigned old = xb_add(&bar[XB_XSUB(b.x)], 1u);
        const unsigned gen = old / nloc;
        if (old + 1u == (gen + 1u) * nloc) {
            __builtin_amdgcn_fence(__ATOMIC_RELEASE, "agent");
            asm volatile("s_waitcnt vmcnt(0)" ::: "memory");
            const unsigned og = xb_add(&bar[XB_TOP], 1u);
            const unsigned tg = og / nx;
            if (og + 1u == (tg + 1u) * nx) xb_add(&bar[XB_TOPGEN], 1u);
            else XB_SPIN(xb_ld(&bar[XB_TOPGEN]) == tg, bar);
            __builtin_amdgcn_fence(__ATOMIC_ACQUIRE, "agent");
            xb_add(&bar[XB_XGEN(b.x)], 1u);
            asm volatile("s_waitcnt vmcnt(0)" ::: "memory");
        } else {
            XB_SPIN(xb_ld(&bar[XB_XGEN(b.x)]) == gen, bar);
            __builtin_amdgcn_fence(__ATOMIC_ACQUIRE, "agent");
            asm volatile("s_waitcnt vmcnt(0)" ::: "memory");
        }
    }
    __syncthreads();
}

__global__ void __launch_bounds__(NT) fwd_megakernel(Params p) {
  extern __shared__ __attribute__((aligned(16))) unsigned char smem[];
  const CParamsP pp = launder_kargs();
  cg::grid_group grid = cg::this_grid();
  volatile LAS unsigned* xbst = (volatile LAS unsigned*)(smem + LDS_BYTES - 16);
  if (threadIdx.x == 0) { xbst[0] = 0u; xbst[1] = 0u; }
  if (blockIdx.x == 0) { unsigned* bw = (unsigned*)(pp->ws + WS_BAR); for (int i = threadIdx.x; i < XCD_BAR_WORDS; i += NT) bw[i] = 0u; }
  setup_phase(p, smem);
  grid.sync();
  const XcdBarrier xb = xcd_barrier_post((unsigned*)(pp->ws + WS_BAR), xbst);
  const float* MOD = (const float*)(pp->ws + WS_MOD);
  for (int l = 0; l < DEPTH_; ++l) {
    const float* xsrc = (l == 0) ? gin(pp->in[I_X]) : (const float*)(pp->ws + WS_X);
    const float* modl = MOD + (size_t)l * 2 * 6144;
    if (l == 0) {
      norm_mod_phase(xsrc, gin(pp->in[I_NMIX]), modl + 0, modl + 1024, (bf16_t*)(pp->ws + WS_ABUF));
      qbias_phase(p, smem);
      xcd_barrier(xb);
    }
    gemm_proj_phase(p, l, smem);
    xcd_barrier(xb);
    attn_phase(p, l, smem);
    mix_local_phase(p, l, smem);
    xcd_barrier(xb);
    scan_phase(p, l);
    xcd_barrier(xb);
    mix_final_phase(p, l, smem);
    xcd_barrier(xb);
    gemm_out_phase(p, l, xsrc, smem);
    xcd_barrier(xb);
    gemm_q_phase(p, l, smem);
    xcd_barrier(xb);
    peer_phase(p, l, l == DEPTH_ - 1, smem);
    xcd_barrier(xb);
  }
}

extern "C" void kernel_launch(void* const* d_in, const int* in_sizes, int n_in,
                              void* d_out, int out_size, void* d_ws, size_t ws_size,
                              hipStream_t stream) {
  static int grid_blocks = 0;
  if (grid_blocks == 0) {
    if (n_in != 24 || ws_size < WS_END) { fprintf(stderr, "kernel_launch: unexpected n_in %d / ws_size %zu (need %zu)\n", n_in, ws_size, (size_t)WS_END); grid_blocks = -1; return; }
    int dev = 0, cus = 0, per_cu = 0;
    if (hipGetDevice(&dev) != hipSuccess || hipDeviceGetAttribute(&cus, hipDeviceAttributeMultiprocessorCount, dev) != hipSuccess) { grid_blocks = -1; return; }
    if (hipFuncSetAttribute((const void*)fwd_megakernel, hipFuncAttributeMaxDynamicSharedMemorySize, LDS_BYTES) != hipSuccess) { fprintf(stderr, "hipFuncSetAttribute failed\n"); grid_blocks = -1; return; }
    if (hipOccupancyMaxActiveBlocksPerMultiprocessor(&per_cu, (const void*)fwd_megakernel, NT, LDS_BYTES) != hipSuccess || per_cu < 1) { fprintf(stderr, "occupancy query: %d\n", per_cu); grid_blocks = -1; return; }
    grid_blocks = cus;
  }
  if (grid_blocks < 0) return;
  Params p{};
  for (int i = 0; i < 24; ++i) p.in[i] = (const GAS float*)d_in[i];
  p.out = (GAS float*)d_out; p.ws = (GAS unsigned char*)d_ws;
  void* args[] = {&p};
  hipError_t e = hipLaunchCooperativeKernel((void*)fwd_megakernel, dim3(grid_blocks), dim3(NT), args, LDS_BYTES, stream);
  if (e != hipSuccess) fprintf(stderr, "cooperative launch failed: %s (grid %d)\n", hipGetErrorString(e), grid_blocks);
}
```

```cpp
#include <hip/hip_runtime.h>
#include <hip/hip_cooperative_groups.h>
#include <cstdio>
#include <cstdint>
namespace cg = cooperative_groups;

typedef unsigned short bf16_t;
typedef short bf16x8 __attribute__((ext_vector_type(8)));
typedef float f32x4 __attribute__((ext_vector_type(4)));
typedef float f32x16 __attribute__((ext_vector_type(16)));
typedef int i32x8 __attribute__((ext_vector_type(8)));

constexpr int T_ = 16384, D_ = 1024, L_ = 8192, NBATCH = 2, DEPTH_ = 4;
constexpr int INC = 2944, INCP = 3072;
constexpr int NCH = 128;
constexpr int NT = 512;
constexpr int NW = 8;
constexpr float EPS_ = 1e-6f;
constexpr int C_QA = 0, C_KA = 384, C_VA = 768, C_QR = 1152, C_KR = 1536, C_VR = 1920, C_GR = 2304, C_US = 2688;

constexpr size_t al256(size_t x) { return (x + 255) & ~(size_t)255; }
constexpr size_t WS_MOD   = 0;
constexpr size_t WS_ROTC  = al256(WS_MOD + 4ull * 2 * 6144 * 4);
constexpr size_t WS_ROTS  = al256(WS_ROTC + 8192ull * 32 * 4);
constexpr size_t WS_SA    = al256(WS_ROTS + 8192ull * 32 * 4);
constexpr size_t WS_SBB   = al256(WS_SA + 4ull * 16 * 64 * 2 * 4);
constexpr size_t WS_WIN   = al256(WS_SBB + 4ull * 16 * 64 * 32 * 4);
constexpr size_t WS_WOUT  = al256(WS_WIN + 4ull * INCP * 1024 * 2);
constexpr size_t WS_WQ    = al256(WS_WOUT + 4ull * 1024 * 1024 * 2);
constexpr size_t WS_SUBK  = al256(WS_WQ + 4ull * 2048 * 1024 * 2);
constexpr size_t WS_ABUF  = al256(WS_SUBK + 4ull * 16 * 128 * 128 * 2);
constexpr size_t WS_PROJ  = al256(WS_ABUF + (size_t)T_ * 1024 * 2);
constexpr size_t WS_VTA   = al256(WS_PROJ + (size_t)T_ * INCP * 2);
constexpr size_t WS_ATT   = al256(WS_VTA + 2ull * 6 * 64 * 8192 * 2);
constexpr size_t WS_YINT  = al256(WS_ATT + (size_t)T_ * 384 * 4);
constexpr size_t WS_UPD   = al256(WS_YINT + (size_t)T_ * 384 * 4);
constexpr size_t WS_SPREV = al256(WS_UPD + 256ull * 6 * 4096 * 4);
constexpr size_t WS_SEND  = al256(WS_SPREV + 256ull * 6 * 4096 * 4);
constexpr size_t WS_CARRY = al256(WS_SEND + 256ull * 16 * 64 * 2 * 4);
constexpr size_t WS_X     = al256(WS_CARRY + 256ull * 16 * 64 * 2 * 4);
constexpr size_t WS_Q     = al256(WS_X + (size_t)T_ * 1024 * 4);
constexpr size_t WS_SC    = al256(WS_Q + (size_t)T_ * 2048 * 2);
constexpr size_t WS_EIDX  = al256(WS_SC + (size_t)T_ * 2048 * 4);
constexpr size_t WS_EGATE = al256(WS_EIDX + (size_t)T_ * 128 * 4);
constexpr size_t WS_PU8   = al256(WS_EGATE + (size_t)T_ * 128 * 4);
constexpr size_t WS_PV8   = al256(WS_PU8 + 4ull * 16384 * 1024);
constexpr size_t WS_BAR   = al256(WS_PV8 + 4ull * 16384 * 1024);
constexpr size_t WS_SPT   = al256(WS_BAR + 3456ull * 4);
constexpr size_t WS_CB    = al256(WS_SPT + 256ull * 6 * 4096 * 2);
constexpr size_t WS_WGLUT = al256(WS_CB + 4ull * 16 * 16 * 128 * 2);
constexpr size_t WS_VTR   = al256(WS_WGLUT + 4ull * 512 * 256 * 2);
constexpr size_t WS_XG    = al256(WS_VTR + 2ull * 384 * 8192 * 2);
constexpr size_t WS_SSQ   = al256(WS_XG + (size_t)T_ * 1024 * 2);
constexpr size_t WS_C2    = al256(WS_SSQ + (size_t)T_ * 16 * 4);
constexpr size_t WS_BBH   = al256(WS_C2 + 4ull * 2 * 2048 * 4);
constexpr size_t WS_END   = al256(WS_BBH + 4ull * 16 * 2 * 64 * 16 * 2);

constexpr int LDS_BYTES = 135168;

#define GAS __attribute__((address_space(1)))
struct Params {
  const GAS float* in[24];
  GAS float* out;
  GAS unsigned char* ws;
};
enum { I_X = 0, I_C, I_WADA, I_BADA, I_NMIX, I_NFFN, I_WIN, I_RELB, I_LRE, I_LIM, I_LOGDT, I_BRE, I_BIM, I_CRE, I_CIM, I_SSMD,
       I_WGLU, I_MGAIN, I_WOUT, I_WQ, I_SUBK, I_PU, I_PV, I_FNORM };

__device__ __forceinline__ float bf2f(bf16_t v) { return __uint_as_float(((unsigned)v) << 16); }
__device__ __forceinline__ bf16_t f2bf(float f) { unsigned u = __float_as_uint(f); u += 0x7fffu + ((u >> 16) & 1u); return (bf16_t)(u >> 16); }
__device__ __forceinline__ unsigned pk2(float a, float b) { return (unsigned)f2bf(a) | ((unsigned)f2bf(b) << 16); }
__device__ __forceinline__ float wave_sum(float v) {
#pragma unroll
  for (int o = 32; o > 0; o >>= 1) v += __shfl_xor(v, o);
  return v;
}
__device__ __forceinline__ float wave_max(float v) {
#pragma unroll
  for (int o = 32; o > 0; o >>= 1) v = fmaxf(v, __shfl_xor(v, o));
  return v;
}
__device__ __forceinline__ float gelu_tanh(float x) { const float u = 0.7978845608028654f * (x + 0.044715f * x * x * x); return 0.5f * x * (1.f + tanhf(u)); }
__device__ __forceinline__ float sigmoid_f(float x) { return 1.f / (1.f + __expf(-x)); }
__device__ __forceinline__ float gelu_tanh_fast(float x) {
  const float u2 = 2.f * 0.7978845608028654f * 1.4426950408889634f * (x + 0.044715f * x * x * x);
  const float e = __builtin_amdgcn_exp2f(fminf(u2, 80.f));
  return x - x * __builtin_amdgcn_rcpf(1.f + e);
}
__device__ __forceinline__ GAS unsigned char* launder_ptr(GAS unsigned char* q) { asm volatile("" : "+s"(q)); return q; }
__device__ __forceinline__ const float* gin(const GAS float* q) { return (const float*)q; }
__device__ __forceinline__ const float* launder_cptr(const float* q) { asm volatile("" : "+s"(q)); return q; }
__device__ __forceinline__ int launder_tid() { int t = threadIdx.x; asm volatile("" : "+v"(t)); return t; }
typedef const Params __attribute__((address_space(4)))* CParamsP;
__device__ __forceinline__ CParamsP launder_kargs() { CParamsP q = (CParamsP)__builtin_amdgcn_kernarg_segment_ptr(); asm volatile("" : "+s"(q)); return q; }

__device__ __forceinline__ void convert_tables_fp4(const CParamsP pp, GAS unsigned char* ws, int layer, int gtid, int gn) {
  constexpr size_t NIT = 16384ull * 1024 / 16;
  for (size_t it = gtid; it < 2 * NIT; it += gn) {
    const int tb = it >= NIT ? 1 : 0; const size_t r = (it - (size_t)tb * NIT) + (size_t)layer * NIT;
    const f32x4* src = (const f32x4*)((tb ? gin(pp->in[I_PV]) : gin(pp->in[I_PU])) + r * 16);
    const float sc = tb ? 4.f : 64.f;
    unsigned o[2] = {0u, 0u};
#pragma unroll
    for (int q = 0; q < 4; ++q) {
      const f32x4 a = src[q];
      const float x0 = fminf(fmaxf(a.x * sc, -6.f), 6.f), x1 = fminf(fmaxf(a.y * sc, -6.f), 6.f);
      const float x2 = fminf(fmaxf(a.z * sc, -6.f), 6.f), x3 = fminf(fmaxf(a.w * sc, -6.f), 6.f);
      if (q == 0)      { o[0] = __builtin_amdgcn_cvt_scalef32_pk_fp4_f32(o[0], x0, x1, 1.0f, 0); o[0] = __builtin_amdgcn_cvt_scalef32_pk_fp4_f32(o[0], x2, x3, 1.0f, 1); }
      else if (q == 1) { o[0] = __builtin_amdgcn_cvt_scalef32_pk_fp4_f32(o[0], x0, x1, 1.0f, 2); o[0] = __builtin_amdgcn_cvt_scalef32_pk_fp4_f32(o[0], x2, x3, 1.0f, 3); }
      else if (q == 2) { o[1] = __builtin_amdgcn_cvt_scalef32_pk_fp4_f32(o[1], x0, x1, 1.0f, 0); o[1] = __builtin_amdgcn_cvt_scalef32_pk_fp4_f32(o[1], x2, x3, 1.0f, 1); }
      else             { o[1] = __builtin_amdgcn_cvt_scalef32_pk_fp4_f32(o[1], x0, x1, 1.0f, 2); o[1] = __builtin_amdgcn_cvt_scalef32_pk_fp4_f32(o[1], x2, x3, 1.0f, 3); }
    }
    *(uint2*)(ws + (tb ? WS_PV8 : WS_PU8) + r * 8) = make_uint2(o[0], o[1]);
  }
}

__device__ void setup_phase(const Params& p, unsigned char* smem) {
  const CParamsP pp = launder_kargs();
  GAS unsigned char* const ws = launder_ptr(pp->ws); const int tidx = launder_tid(); (void)ws; (void)tidx;
  const int tid = tidx;
  float* sm = (float*)smem;
  {
    float* cond = sm;
    float* red = sm + 2048;
    float* MOD = (float*)(ws + WS_MOD);
    for (int i = tid; i < 2048; i += NT) { const float c = gin(pp->in[I_C])[i]; cond[i] = c * sigmoid_f(c); }
    __syncthreads();
    for (int item = blockIdx.x; item < 4 * 96; item += gridDim.x) {
      const int l = item / 96, cb = item % 96, kq = tid >> 6, jj = tid & 63, j = cb * 64 + jj;
      const float* w = gin(pp->in[I_WADA]) + (size_t)l * 1024 * 6144 + j;
      float a0 = 0.f, a1 = 0.f;
#pragma unroll 16
      for (int k = kq * 128; k < kq * 128 + 128; ++k) { const float wv = w[(size_t)k * 6144]; a0 += cond[k] * wv; a1 += cond[1024 + k] * wv; }
      red[(kq * 2 + 0) * 64 + jj] = a0; red[(kq * 2 + 1) * 64 + jj] = a1;
      __syncthreads();
      if (tid < 128) {
        const int b = tid >> 6, j2 = tid & 63; float s = 0.f;
        for (int q = 0; q < 8; ++q) s += red[(q * 2 + b) * 64 + j2];
        MOD[((size_t)l * 2 + b) * 6144 + cb * 64 + j2] = s + gin(pp->in[I_BADA])[(size_t)l * 6144 + cb * 64 + j2];
      }
      __syncthreads();
    }
  }
  const int gtid = blockIdx.x * NT + tid, gn = gridDim.x * NT;
  {
    float* RC = (float*)(ws + WS_ROTC); float* RS = (float*)(ws + WS_ROTS);
    for (int idx = gtid; idx < 8192 * 32; idx += gn) {
      const int pos = idx >> 5, i = idx & 31;
      const float inv = powf(10000.0f, -(float)i / 32.0f);
      const float ang = (float)pos * inv;
      float s, c; sincosf(ang, &s, &c);
      RC[idx] = c; RS[idx] = s;
    }
  }
  {
    float* SA = (float*)(ws + WS_SA); float* SBB = (float*)(ws + WS_SBB); bf16_t* BBH = (bf16_t*)(ws + WS_BBH);
    for (int idx = gtid; idx < 4 * 16 * 64; idx += gn) {
      const int l = idx / 1024, g = (idx >> 6) & 15;
      const float dt = expf(gin(pp->in[I_LOGDT])[l * 16 + g]);
      const float lr = gin(pp->in[I_LRE])[idx], li = gin(pp->in[I_LIM])[idx];
      const float mag = expf(lr * dt);
      float sn, cs; sincosf(li * dt, &sn, &cs);
      const float are = mag * cs, aim = mag * sn;
      const float den = lr * lr + li * li, nr = are - 1.f, ni = aim;
      const float fre = (nr * lr + ni * li) / den, fim = (ni * lr - nr * li) / den;
      SA[idx * 2] = are; SA[idx * 2 + 1] = aim;
      for (int c = 0; c < 16; ++c) {
        const float br = gin(pp->in[I_BRE])[(size_t)idx * 16 + c], bi = gin(pp->in[I_BIM])[(size_t)idx * 16 + c];
        SBB[(size_t)idx * 32 + c] = fre * br - fim * bi;
        SBB[(size_t)idx * 32 + 16 + c] = fre * bi + fim * br;
        BBH[(((size_t)(idx >> 6) * 2 + 0) * 64 + (idx & 63)) * 16 + c] = f2bf(fre * br - fim * bi);
        BBH[(((size_t)(idx >> 6) * 2 + 1) * 64 + (idx & 63)) * 16 + c] = f2bf(fre * bi + fim * br);
      }
    }
  }
  {
    bf16_t* CB = (bf16_t*)(ws + WS_CB);
    for (int idx = gtid; idx < 4 * 16 * 16 * 128; idx += gn) {
      const int k = idx & 127, lgc = idx >> 7;
      CB[idx] = (k < 64) ? f2bf(gin(pp->in[I_CRE])[(size_t)lgc * 64 + k]) : f2bf(-gin(pp->in[I_CIM])[(size_t)lgc * 64 + (k - 64)]);
    }
    bf16_t* WG = (bf16_t*)(ws + WS_WGLUT);
    for (int idx = gtid; idx < 4 * 512 * 256; idx += gn) {
      const int k = idx & 255, nn = (idx >> 8) & 511, l2 = idx >> 17;
      WG[idx] = f2bf(gin(pp->in[I_WGLU])[((size_t)l2 * 256 + k) * 512 + nn]);
    }
  }
  convert_tables_fp4(pp, ws, 0, gtid, gn);
  {
    __syncthreads();
    const int lane = tid & 63, wid = tid >> 6;
    float* scr = sm + wid * (64 * 33);
    constexpr int IT_IN = 16 * 96, IT_OUT = 16 * 32, IT_L = IT_IN + IT_OUT;
    for (int item = blockIdx.x * NW + wid; item < 4 * IT_L; item += gridDim.x * NW) {
      const int l = item / IT_L; int r = item - l * IT_L;
      const float* W; bf16_t* WT; int N, NP;
      if (r < IT_IN) { W = gin(pp->in[I_WIN]) + (size_t)l * 1024 * INC; WT = (bf16_t*)(ws + WS_WIN) + (size_t)l * INCP * 1024; N = INC; NP = 96; }
      else { r -= IT_IN; W = gin(pp->in[I_WOUT]) + (size_t)l * 1024 * 1024; WT = (bf16_t*)(ws + WS_WOUT) + (size_t)l * 1024 * 1024; N = 1024; NP = 32; }
      const int kb = r / NP, nb = r - kb * NP, k0 = kb * 64, n0 = nb * 32;
      const int nn = n0 + (lane & 31); const bool inb = nn < N;
      float v[32];
#pragma unroll
      for (int i = 0; i < 32; ++i) { const int kk = 2 * i + (lane >> 5); v[i] = inb ? W[(size_t)(k0 + kk) * N + nn] : 0.f; }
#pragma unroll
      for (int i = 0; i < 32; ++i) { const int kk = 2 * i + (lane >> 5); scr[kk * 33 + (lane & 31)] = v[i]; }
      const int c = lane & 7;
#pragma unroll
      for (int j = 0; j < 4; ++j) {
        const int n = (lane >> 3) + 8 * j; const float* sp = scr + (8 * c) * 33 + n;
        uint4 o; o.x = pk2(sp[0], sp[33]); o.y = pk2(sp[2 * 33], sp[3 * 33]); o.z = pk2(sp[4 * 33], sp[5 * 33]); o.w = pk2(sp[6 * 33], sp[7 * 33]);
        *(uint4*)(WT + (size_t)(n0 + n) * 1024 + k0 + 8 * c) = o;
      }
    }
    __syncthreads();
  }
  {
    float* WtT = sm;
    float* SKs = sm + 128 * 65;
    bf16_t* WP = (bf16_t*)(ws + WS_WQ);
    for (int item = blockIdx.x; item < 4 * 16 * 16; item += gridDim.x) {
      const int l = item >> 8, hs = (item >> 4) & 15, kb = item & 15, k0 = kb * 64;
      const float* Wq = gin(pp->in[I_WQ]) + (size_t)l * 1024 * 2048 + hs * 128;
      const float* SKg = gin(pp->in[I_SUBK]) + ((size_t)l * 16 + hs) * 128 * 128;
      __syncthreads();
#pragma unroll
      for (int i = 0; i < 16; ++i) { const int idx = tid + NT * i, kk = idx >> 7, d = idx & 127; WtT[d * 65 + kk] = Wq[(size_t)(k0 + kk) * 2048 + d]; }
#pragma unroll
      for (int i = 0; i < 32; ++i) { const int idx = tid + NT * i, key = idx >> 7, d = idx & 127; SKs[key * 129 + d] = SKg[idx]; }
      __syncthreads();
      const int key = tid & 127, kg = tid >> 7;
      float acc[16];
#pragma unroll
      for (int i = 0; i < 16; ++i) acc[i] = 0.f;
#pragma unroll 4
      for (int d = 0; d < 128; ++d) {
        const float sv = SKs[key * 129 + d];
#pragma unroll
        for (int i = 0; i < 16; ++i) acc[i] += sv * WtT[d * 65 + kg * 16 + i];
      }
      uint4 o0, o1;
      o0.x = pk2(acc[0], acc[1]); o0.y = pk2(acc[2], acc[3]); o0.z = pk2(acc[4], acc[5]); o0.w = pk2(acc[6], acc[7]);
      o1.x = pk2(acc[8], acc[9]); o1.y = pk2(acc[10], acc[11]); o1.z = pk2(acc[12], acc[13]); o1.w = pk2(acc[14], acc[15]);
      bf16_t* dst = WP + ((size_t)l * 2048 + hs * 128 + key) * 1024 + k0 + kg * 16;
      *(uint4*)dst = o0; *(uint4*)(dst + 8) = o1;
    }
    __syncthreads();
  }
}

__device__ void qbias_phase(const Params& p, unsigned char* smem) {
  const CParamsP pp = launder_kargs();
  GAS unsigned char* const ws = launder_ptr(pp->ws); const int tid = launder_tid();
  float* C2 = (float*)(ws + WS_C2); const float* MOD = (const float*)(ws + WS_MOD); const bf16_t* WP = (const bf16_t*)(ws + WS_WQ);
  const int lane = tid & 63, gw = blockIdx.x * NW + (tid >> 6), nw = gridDim.x * NW;
  for (int o = gw; o < 4 * 2048; o += nw) {
    const int l = o >> 11;
    const uint4 w0 = *(const uint4*)(WP + (size_t)o * 1024 + lane * 16), w1 = *(const uint4*)(WP + (size_t)o * 1024 + lane * 16 + 8);
    const unsigned ww[8] = {w0.x, w0.y, w0.z, w0.w, w1.x, w1.y, w1.z, w1.w};
    const float* s0 = MOD + (size_t)l * 2 * 6144 + 3072 + lane * 16; const float* s1 = s0 + 6144;
    float a0 = 0.f, a1 = 0.f;
#pragma unroll
    for (int q = 0; q < 8; ++q) {
      const float wl = __uint_as_float(ww[q] << 16), wh = __uint_as_float(ww[q] & 0xffff0000u);
      a0 += s0[2 * q] * wl + s0[2 * q + 1] * wh; a1 += s1[2 * q] * wl + s1[2 * q + 1] * wh;
    }
    a0 = wave_sum(a0); a1 = wave_sum(a1);
    if (lane == 0) { C2[((size_t)l * 2 + 0) * 2048 + (o & 2047)] = a0; C2[((size_t)l * 2 + 1) * 2048 + (o & 2047)] = a1; }
  }
  (void)smem;
}

__device__ void norm_mod_phase(const float* __restrict__ xsrc, const float* __restrict__ gain, const float* __restrict__ mod_sh, const float* __restrict__ mod_sc,
                               bf16_t* __restrict__ outp) {
  const int tidx = launder_tid();
  const int lane = tidx & 63, gw = blockIdx.x * NW + (tidx >> 6), nw = gridDim.x * NW;
  for (int t = gw; t < T_; t += nw) {
    const int b = t >> 13;
    const f32x4* xr = (const f32x4*)(xsrc + (size_t)t * 1024) + lane;
    f32x4 v[4]; float s = 0.f;
#pragma unroll
    for (int j = 0; j < 4; ++j) { v[j] = xr[64 * j]; s += v[j].x * v[j].x + v[j].y * v[j].y + v[j].z * v[j].z + v[j].w * v[j].w; }
    const float rstd = rsqrtf(wave_sum(s) * (1.f / 1024.f) + EPS_);
#pragma unroll
    for (int j = 0; j < 4; ++j) {
      const int c = lane * 4 + 256 * j;
      const f32x4 g = *(const f32x4*)(gain + c), sh = *(const f32x4*)(mod_sh + b * 6144 + c), sc = *(const f32x4*)(mod_sc + b * 6144 + c);
      const float o0 = v[j].x * rstd * g.x * (1.f + sc.x) + sh.x, o1 = v[j].y * rstd * g.y * (1.f + sc.y) + sh.y;
      const float o2 = v[j].z * rstd * g.z * (1.f + sc.z) + sh.z, o3 = v[j].w * rstd * g.w * (1.f + sc.w) + sh.w;
      uint2 o; o.x = pk2(o0, o1); o.y = pk2(o2, o3);
      *(uint2*)(outp + (size_t)t * 1024 + c) = o;
    }
  }
}


namespace pg8 {
#define PG8_LAS __attribute__((address_space(3)))
typedef unsigned u32x4 __attribute__((ext_vector_type(4)));
constexpr int BM = 256, BK = 64, HALF = 128, HTB = HALF * BK * 2, STAGE_BYTES = 8 * HTB, NXCD = 8, WGM = 8;
__host__ __device__ __forceinline__ int lds_byte(int r, int c) { const int st = (r >> 4) * 2 + (c >> 5), rr = r & 15, cc = c & 31, ob = rr * 64 + cc * 2; return st * 1024 + (ob ^ (((ob >> 9) & 1) << 5)); }
__host__ __device__ __forceinline__ void stage_rc(int b, int& R, int& C) { const int st = b / 1024, sb = b % 1024, swz = sb ^ (((sb >> 9) & 1) << 5); R = (st >> 1) * 16 + swz / 64; C = (st & 1) * 32 + (swz % 64) / 2; }
__host__ __device__ __forceinline__ int perm32(int rho) { const int n = rho >> 4, i = rho & 15; return 8 * (i >> 2) + 4 * n + (i & 3); }
struct Unit { int pm, pn; };
struct Gemm { const bf16_t* A; const bf16_t* Bt; int M, N, K; };
struct StaticOrder {
    int nM, nN, nwg, G, c;
    __host__ __device__ void init(int M, int N, int G_, int c_) { nM = M / BM; nN = N / BM; nwg = nM * nN; G = G_; c = c_; }
    __host__ __device__ bool next(int i, Unit& u) const {
        const long L = (long)i * G + c; if (L >= nwg) return false;
        int wgid = (int)L; { const int q = nwg / NXCD, r = nwg % NXCD, xcd = wgid % NXCD, off = wgid / NXCD; wgid = (xcd < r ? xcd * (q + 1) : r * (q + 1) + (xcd - r) * q) + off; }
        const int nig = WGM * nN, gid = wgid / nig, fm = gid * WGM, gsz = (nM - fm) < WGM ? (nM - fm) : WGM;
        u.pm = fm + ((wgid % nig) % gsz); u.pn = (wgid % nig) / gsz; return true;
    }
    __device__ __forceinline__ void a_ready(const Unit&) const {}
    __device__ __forceinline__ void done(const Unit&) const {}
};
__device__ __forceinline__ unsigned cvt_pk_bf16(float lo, float hi) { unsigned r; asm volatile("v_cvt_pk_bf16_f32 %0, %1, %2" : "=v"(r) : "v"(lo), "v"(hi)); return r; }
template <class Epi, class Sched>
__device__ __forceinline__ void gemm_phase(PG8_LAS unsigned char* lds, const Gemm g, const Sched& S, const Epi& E) {
    const int tid = launder_tid(), wid = __builtin_amdgcn_readfirstlane(tid >> 6), lane = tid & 63, wr = wid >> 2, wc = wid & 3, fr = lane & 15, fq = lane >> 4;
    const int K = g.K, nt = K / BK;
    unsigned voffA[2], voffB[2];
#pragma unroll
    for (int i = 0; i < 2; ++i) { int R, C; stage_rc(tid * 16 + i * 8192, R, C); const int Rb = Epi::PERM ? ((R & ~31) + perm32(R & 31)) : R;
        voffA[i] = (unsigned)(R * K + C) * 2u; voffB[i] = (unsigned)(Rb * K + C) * 2u; }
    const size_t kstep = (size_t)(BK * 2);
    const size_t hstep = (size_t)HALF * K * 2;
    const size_t tstep = 2 * hstep;
    const unsigned ldsw = (unsigned)wid * 1024u;
    const int aoff = lds_byte(wr * 64 + fr, fq * 8), boff = lds_byte(wc * 32 + fr, fq * 8);
#define PG8_SA(b, h) (((b) * 2 + (h)) * HTB)
#define PG8_SB(b, h) ((4 + (b) * 2 + (h)) * HTB)
#define PG8_STAGE(bufoff, gbase, voff) do { _Pragma("unroll") for (int _i = 0; _i < 2; ++_i) \
        __builtin_amdgcn_global_load_lds((const unsigned*)((const char*)(gbase) + (voff)[_i]), (PG8_LAS unsigned*)(lds + (bufoff) + ldsw + _i * 8192), 16, 0, 0); } while (0)
#define PG8_LDA(dst, b, h) do { _Pragma("unroll") for (int m = 0; m < 4; ++m) _Pragma("unroll") for (int k = 0; k < 2; ++k) dst[m][k] = *(const PG8_LAS bf16x8*)(lds + PG8_SA(b, h) + aoff + m * 2048 + k * 1024); } while (0)
#define PG8_LDB(dst, b, h) do { _Pragma("unroll") for (int n = 0; n < 2; ++n) _Pragma("unroll") for (int k = 0; k < 2; ++k) dst[n][k] = *(const PG8_LAS bf16x8*)(lds + PG8_SB(b, h) + boff + n * 2048 + k * 1024); } while (0)
#define PG8_MMA(ai, bj, At, Bt) do { __builtin_amdgcn_s_setprio(1); _Pragma("unroll") for (int m = 0; m < 4; ++m) _Pragma("unroll") for (int n = 0; n < 2; ++n) _Pragma("unroll") for (int k = 0; k < 2; ++k) \
        acc[ai][bj][m][n] = __builtin_amdgcn_mfma_f32_16x16x32_bf16(Bt[n][k], At[m][k], acc[ai][bj][m][n], 0, 0, 0); __builtin_amdgcn_s_setprio(0); } while (0)
#define PG8_WAIT_V(n) asm volatile("s_waitcnt vmcnt(" #n ")" ::: "memory")
#define PG8_WAIT_L(n) asm volatile("s_waitcnt lgkmcnt(" #n ")" ::: "memory")
#define PG8_BAR __builtin_amdgcn_s_barrier()
#define PG8_SCHED __builtin_amdgcn_sched_barrier(0)
    Unit cur, nxt; int ui = 0;
    if (!S.next(0, cur)) return;
    f32x4 acc[2][2][4][2];
#pragma unroll
    for (int a = 0; a < 2; ++a)
#pragma unroll
        for (int b = 0; b < 2; ++b)
#pragma unroll
            for (int m = 0; m < 4; ++m)
#pragma unroll
                for (int n = 0; n < 2; ++n) acc[a][b][m][n] = (f32x4){0.f, 0.f, 0.f, 0.f};
    bf16x8 At[4][2], B0[2][2], B1[2][2];
    const char* cA = (const char*)g.A + (size_t)cur.pm * tstep; const char* cB = (const char*)g.Bt + (size_t)cur.pn * tstep;
    S.a_ready(cur);
    PG8_STAGE(PG8_SB(0, 0), cB, voffB); PG8_STAGE(PG8_SA(0, 0), cA, voffA); PG8_STAGE(PG8_SB(0, 1), cB + hstep, voffB); PG8_STAGE(PG8_SA(0, 1), cA + hstep, voffA);
    if (wr == 1) PG8_BAR;
    PG8_WAIT_V(4); PG8_BAR;
    PG8_STAGE(PG8_SB(1, 0), cB + kstep, voffB); PG8_STAGE(PG8_SA(1, 0), cA + kstep, voffA); PG8_STAGE(PG8_SB(1, 1), cB + hstep + kstep, voffB);
    PG8_WAIT_V(6); PG8_BAR;
    for (;;) {
        const bool has_next = S.next(ui + 1, nxt);
        const char* nA = has_next ? (const char*)g.A + (size_t)nxt.pm * tstep : cA; const char* nB = has_next ? (const char*)g.Bt + (size_t)nxt.pn * tstep : cB;
        for (int t = 0; t < nt; t += 2) {
            const bool last = (t == nt - 2);
            const char* a1 = cA + (size_t)(t + 1) * kstep;
            const char* a2 = last ? nA : cA + (size_t)(t + 2) * kstep; const char* b2 = last ? nB : cB + (size_t)(t + 2) * kstep;
            const char* a3 = a2 + kstep; const char* b3 = b2 + kstep;
            if (last && has_next) S.a_ready(nxt);
            PG8_LDB(B0, 0, 0); PG8_SCHED; PG8_LDA(At, 0, 0); PG8_STAGE(PG8_SA(1, 1), a1 + hstep, voffA);
            PG8_WAIT_L(8); PG8_BAR; PG8_WAIT_L(0); PG8_MMA(0, 0, At, B0); PG8_BAR; PG8_SCHED;
            PG8_LDB(B1, 0, 1); PG8_STAGE(PG8_SB(0, 0), b2, voffB);
            PG8_BAR; PG8_WAIT_L(0); PG8_MMA(0, 1, At, B1); PG8_BAR;
            PG8_LDA(At, 0, 1); PG8_STAGE(PG8_SA(0, 0), a2, voffA);
            PG8_BAR; PG8_WAIT_L(0); PG8_MMA(1, 0, At, B0); PG8_BAR; PG8_SCHED;
            PG8_STAGE(PG8_SB(0, 1), b2 + hstep, voffB);
            PG8_WAIT_V(6); PG8_BAR; PG8_MMA(1, 1, At, B1); PG8_BAR;
            PG8_LDB(B0, 1, 0); PG8_SCHED; PG8_LDA(At, 1, 0); PG8_STAGE(PG8_SA(0, 1), a2 + hstep, voffA);
            PG8_WAIT_L(8); PG8_BAR; PG8_WAIT_L(0); PG8_MMA(0, 0, At, B0); PG8_BAR; PG8_SCHED;
            PG8_LDB(B1, 1, 1); PG8_STAGE(PG8_SB(1, 0), b3, voffB);
            PG8_BAR; PG8_WAIT_L(0); PG8_MMA(0, 1, At, B1); PG8_BAR;
            PG8_LDA(At, 1, 1); PG8_STAGE(PG8_SA(1, 0), a3, voffA);
            PG8_BAR; PG8_WAIT_L(0); PG8_MMA(1, 0, At, B0); PG8_BAR; PG8_SCHED;
            PG8_STAGE(PG8_SB(1, 1), b3 + hstep, voffB);
            PG8_WAIT_V(6); PG8_BAR; PG8_MMA(1, 1, At, B1); PG8_BAR;
        }
        if constexpr (!Epi::AFTER_DRAIN) { E(acc, cur, wr, wc, fr, fq); S.done(cur); }
        if (!has_next) break;
#pragma unroll
        for (int a = 0; a < 2; ++a)
#pragma unroll
            for (int b = 0; b < 2; ++b)
#pragma unroll
                for (int m = 0; m < 4; ++m)
#pragma unroll
                    for (int n = 0; n < 2; ++n) acc[a][b][m][n] = (f32x4){0.f, 0.f, 0.f, 0.f};
        cur = nxt; cA = nA; cB = nB; ++ui;
    }
    PG8_WAIT_V(0);
    if (wr == 0) PG8_BAR;
    PG8_BAR;
    if constexpr (Epi::AFTER_DRAIN) { E.fused(acc, cur, wr, wc, fr, fq, lds, wid, lane); S.done(cur); }
#undef PG8_SA
#undef PG8_SB
#undef PG8_STAGE
#undef PG8_LDA
#undef PG8_LDB
#undef PG8_MMA
#undef PG8_WAIT_V
#undef PG8_WAIT_L
#undef PG8_BAR
#undef PG8_SCHED
}
}

__device__ __forceinline__ float ssq_total(const float* __restrict__ SSQ, int t) {
  const f32x4 a = *(const f32x4*)(SSQ + (size_t)t * 16), b = *(const f32x4*)(SSQ + (size_t)t * 16 + 4), c = *(const f32x4*)(SSQ + (size_t)t * 16 + 8), d = *(const f32x4*)(SSQ + (size_t)t * 16 + 12);
  return (((a.x + a.y) + (a.z + a.w)) + ((b.x + b.y) + (b.z + b.w))) + (((c.x + c.y) + (c.z + c.w)) + ((d.x + d.y) + (d.z + d.w)));
}
struct EpiProj {
  static constexpr bool PERM = true, AFTER_DRAIN = false;
  bf16_t* PROJ; bf16_t* VTA; bf16_t* VTR;
  __device__ __forceinline__ void operator()(const f32x4 (&acc)[2][2][4][2], const pg8::Unit& u, int wr, int wc, int fr, int fq) const {
    const int row0 = u.pm * 256 + wr * 64 + fr, col0 = u.pn * 256 + wc * 32 + 8 * fq;
#pragma unroll
    for (int ai = 0; ai < 2; ++ai)
#pragma unroll
      for (int m = 0; m < 4; ++m) {
        const int t = row0 + ai * 128 + m * 16;
#pragma unroll
        for (int bj = 0; bj < 2; ++bj) {
          const int c = col0 + bj * 128;
          const f32x4 v0 = acc[ai][bj][m][0], v1 = acc[ai][bj][m][1];
          pg8::u32x4 w; w.x = pg8::cvt_pk_bf16(v0[0], v0[1]); w.y = pg8::cvt_pk_bf16(v0[2], v0[3]); w.z = pg8::cvt_pk_bf16(v1[0], v1[1]); w.w = pg8::cvt_pk_bf16(v1[2], v1[3]);
          *(pg8::u32x4*)(PROJ + (size_t)t * INCP + c) = w;
          const bool isva = (c >= C_VA && c < C_VA + 384), isvr = (c >= C_VR && c < C_VR + 384);
          if (isva || isvr) {
            bf16_t* vt = (isva ? VTA : VTR) + ((size_t)(t >> 13) * 384 + (c - (isva ? C_VA : C_VR))) * 8192 + (t & 8191);
            vt[0] = (bf16_t)(w.x & 0xffffu); vt[8192] = (bf16_t)(w.x >> 16); vt[2 * 8192] = (bf16_t)(w.y & 0xffffu); vt[3 * 8192] = (bf16_t)(w.y >> 16);
            vt[4 * 8192] = (bf16_t)(w.z & 0xffffu); vt[5 * 8192] = (bf16_t)(w.z >> 16); vt[6 * 8192] = (bf16_t)(w.w & 0xffffu); vt[7 * 8192] = (bf16_t)(w.w >> 16);
          }
        }
      }
  }
};
struct EpiOut {
  static constexpr bool PERM = false, AFTER_DRAIN = false;
  const float* xsrc; float* X; const float* g1; const float* nf; const float* sc2; bf16_t* XG; float* SSQ;
  __device__ __forceinline__ void operator()(const f32x4 (&acc)[2][2][4][2], const pg8::Unit& u, int wr, int wc, int fr, int fq) const {
    const int row0 = u.pm * 256 + wr * 64 + fr, col0 = u.pn * 256 + wc * 32 + 4 * fq, b = (u.pm * 256) >> 13;
    f32x4 gg[2][2], gs[2][2];
#pragma unroll
    for (int bj = 0; bj < 2; ++bj)
#pragma unroll
      for (int n = 0; n < 2; ++n) {
        const int c = col0 + bj * 128 + n * 16;
        gg[bj][n] = *(const f32x4*)(g1 + b * 6144 + c);
        const f32x4 gf = *(const f32x4*)(nf + c), sc = *(const f32x4*)(sc2 + b * 6144 + c);
        gs[bj][n] = gf * (sc + 1.f);
      }
#pragma unroll
    for (int ai = 0; ai < 2; ++ai)
#pragma unroll
      for (int m = 0; m < 4; ++m) {
        const int t = row0 + ai * 128 + m * 16;
        float sq = 0.f;
#pragma unroll
        for (int bj = 0; bj < 2; ++bj)
#pragma unroll
          for (int n = 0; n < 2; ++n) {
            const int c = col0 + bj * 128 + n * 16;
            const f32x4 xv = *(const f32x4*)(xsrc + (size_t)t * 1024 + c);
            const f32x4 xn = xv + gg[bj][n] * acc[ai][bj][m][n];
            *(f32x4*)(X + (size_t)t * 1024 + c) = xn;
            const f32x4 xs = xn * gs[bj][n];
            uint2 o; o.x = pg8::cvt_pk_bf16(xs.x, xs.y); o.y = pg8::cvt_pk_bf16(xs.z, xs.w);
            *(uint2*)(XG + (size_t)t * 1024 + c) = o;
            sq += (xn.x * xn.x + xn.y * xn.y) + (xn.z * xn.z + xn.w * xn.w);
          }
        sq += __shfl_xor(sq, 16); sq += __shfl_xor(sq, 32);
        if (fq == 0) SSQ[(size_t)t * 16 + u.pn * 4 + wc] = sq;
      }
  }
};
struct EpiQ {
  static constexpr bool PERM = false, AFTER_DRAIN = false;
  float* SC4; const float* SSQ; const float* C2;
  __device__ __forceinline__ void operator()(const f32x4 (&acc)[2][2][4][2], const pg8::Unit& u, int wr, int wc, int fr, int fq) const {
    const int row0 = u.pm * 256 + wr * 64 + fr, col0 = u.pn * 256 + wc * 32 + 4 * fq, b = (u.pm * 256) >> 13;
    f32x4 cc[2][2];
#pragma unroll
    for (int bj = 0; bj < 2; ++bj)
#pragma unroll
      for (int n = 0; n < 2; ++n) cc[bj][n] = *(const f32x4*)(C2 + b * 2048 + col0 + bj * 128 + n * 16);
#pragma unroll
    for (int ai = 0; ai < 2; ++ai)
#pragma unroll
      for (int m = 0; m < 4; ++m) {
        const int t = row0 + ai * 128 + m * 16;
        const float rstd = rsqrtf(ssq_total(SSQ, t) * (1.f / 1024.f) + EPS_);
#pragma unroll
        for (int bj = 0; bj < 2; ++bj)
#pragma unroll
          for (int n = 0; n < 2; ++n) {
            const int c = col0 + bj * 128 + n * 16;
            *(f32x4*)(SC4 + ((size_t)(c >> 2) * T_ + t) * 4) = acc[ai][bj][m][n] * rstd + cc[bj][n];
          }
      }
  }
};

__device__ void gemm_proj_phase(const Params& p, int l, unsigned char* smem) {
  const CParamsP pp = launder_kargs();
  GAS unsigned char* const ws = launder_ptr(pp->ws);
  pg8::Gemm g; g.A = (const bf16_t*)(ws + WS_ABUF); g.Bt = (const bf16_t*)(ws + WS_WIN) + (size_t)l * INCP * 1024; g.M = T_; g.N = INCP; g.K = 1024;
  pg8::StaticOrder S; S.init(T_, INCP, gridDim.x, blockIdx.x);
  EpiProj E; E.PROJ = (bf16_t*)(ws + WS_PROJ); E.VTA = (bf16_t*)(ws + WS_VTA); E.VTR = (bf16_t*)(ws + WS_VTR);
  pg8::gemm_phase<EpiProj, pg8::StaticOrder>((PG8_LAS unsigned char*)smem, g, S, E);
}
__device__ void gemm_out_phase(const Params& p, int l, const float* __restrict__ xsrc, unsigned char* smem) {
  const CParamsP pp = launder_kargs();
  GAS unsigned char* const ws = launder_ptr(pp->ws);
  pg8::Gemm g; g.A = (const bf16_t*)(ws + WS_ABUF); g.Bt = (const bf16_t*)(ws + WS_WOUT) + (size_t)l * 1024 * 1024; g.M = T_; g.N = 1024; g.K = 1024;
  pg8::StaticOrder S; S.init(T_, 1024, gridDim.x, blockIdx.x);
  EpiOut E; E.xsrc = xsrc; E.X = (float*)(ws + WS_X); E.g1 = (const float*)(ws + WS_MOD) + (size_t)l * 2 * 6144 + 2048;
  E.nf = gin(pp->in[I_NFFN]) + (size_t)l * 1024; E.sc2 = (const float*)(ws + WS_MOD) + (size_t)l * 2 * 6144 + 4096; E.XG = (bf16_t*)(ws + WS_XG); E.SSQ = (float*)(ws + WS_SSQ);
  pg8::gemm_phase<EpiOut, pg8::StaticOrder>((PG8_LAS unsigned char*)smem, g, S, E);
}
__device__ void gemm_q_phase(const Params& p, int l, unsigned char* smem) {
  const CParamsP pp = launder_kargs();
  GAS unsigned char* const ws = launder_ptr(pp->ws);
  pg8::Gemm g; g.A = (const bf16_t*)(ws + WS_XG); g.Bt = (const bf16_t*)(ws + WS_WQ) + (size_t)l * 2048 * 1024; g.M = T_; g.N = 2048; g.K = 1024;
  pg8::StaticOrder S; S.init(T_, 2048, gridDim.x, blockIdx.x);
  EpiQ E; E.SC4 = (float*)(ws + WS_SC); E.SSQ = (const float*)(ws + WS_SSQ); E.C2 = (const float*)(ws + WS_C2) + (size_t)l * 2 * 2048;
  pg8::gemm_phase<EpiQ, pg8::StaticOrder>((PG8_LAS unsigned char*)smem, g, S, E);
}

__device__ __forceinline__ int attn_fk(int r) { return ((r >> 3) & 3) | (((r >> 1) & 1) << 2); }
__device__ __forceinline__ int attn_fv(int r) { return (r >> 1) & 7; }
__device__ void attn_phase(const Params& p, int l, unsigned char* smem) {
  const CParamsP pp = launder_kargs();
  GAS unsigned char* const ws = launder_ptr(pp->ws); const int tidx = launder_tid();
  const bf16_t* PROJ = (const bf16_t*)(ws + WS_PROJ); const bf16_t* VTA = (const bf16_t*)(ws + WS_VTA);
  float* ATT = (float*)(ws + WS_ATT);
  const int lane = tidx & 63, wid = tidx >> 6, fr = lane & 15, fq = lane >> 4;
  float* ext = (float*)smem;
  unsigned char* stg = smem + 15360;
  constexpr float LOG2E = 1.4426950408889634f;
  __syncthreads();
  for (int idx = tidx; idx < 6 * 640; idx += NT) {
    const int h = idx / 640, e = idx - h * 640; int d = e - 63; d = d > 256 ? 256 : d;
    ext[idx] = gin(pp->in[I_RELB])[((size_t)l * 6 + h) * 513 + d + 256] * LOG2E;
  }
  const int hh = wid >> 2, qb = wid & 3, iq = qb * 16 + fr;
  const int srow = tidx >> 3, sch = tidx & 7;
  for (int item = blockIdx.x; item < 256; item += gridDim.x) {
    const int b = item >> 7, n = item & 127, t0 = b * 8192 + n * 64;
    const int jc0 = n >= 8 ? 0 : 8 - n, nch = 9 - jc0, nst = 3 * nch;
    uint4 sa0, sa1, sa2, sa3, sb0, sb1, sb2, sb3;
#define ATTN_LOAD(S, st) do { const int _rd = (st) / nch, _jc = jc0 + (st) - _rd * nch, _m = n - 8 + _jc; \
      S##0 = *(const uint4*)(PROJ + (size_t)(b * 8192 + _m * 64 + srow) * INCP + C_KA + (2 * _rd) * 64 + sch * 8); \
      S##1 = *(const uint4*)(PROJ + (size_t)(b * 8192 + _m * 64 + srow) * INCP + C_KA + (2 * _rd + 1) * 64 + sch * 8); \
      S##2 = *(const uint4*)(VTA + ((size_t)b * 384 + (2 * _rd) * 64 + srow) * 8192 + _m * 64 + sch * 8); \
      S##3 = *(const uint4*)(VTA + ((size_t)b * 384 + (2 * _rd + 1) * 64 + srow) * 8192 + _m * 64 + sch * 8); } while (0)
#define ATTN_WRITE(S, buf) do { unsigned char* _bp = stg + (buf) * 32768; \
      *(uint4*)(_bp + srow * 128 + ((sch ^ attn_fk(srow)) << 4)) = S##0; \
      *(uint4*)(_bp + 8192 + srow * 128 + ((sch ^ attn_fk(srow)) << 4)) = S##1; \
      *(uint4*)(_bp + 16384 + srow * 128 + ((sch ^ attn_fv(srow)) << 4)) = S##2; \
      *(uint4*)(_bp + 24576 + srow * 128 + ((sch ^ attn_fv(srow)) << 4)) = S##3; } while (0)
    __syncthreads();
    ATTN_LOAD(sa, 0);
    ATTN_WRITE(sa, 0);
    if (1 < nst) ATTN_LOAD(sb, 1);
    __syncthreads();
    bf16x8 qf[2];
    f32x4 o[4];
    float mrun = -1e30f, lrun = 0.f;
    const float* exth = ext;
    auto attn_compute = [&](const int st) {
      const int rd = st / nch, jc = jc0 + st - rd * nch, h = 2 * rd + hh;
      if (jc == jc0) {
#pragma unroll
        for (int ds = 0; ds < 2; ++ds) qf[ds] = *(const bf16x8*)(PROJ + (size_t)(t0 + iq) * INCP + C_QA + h * 64 + ds * 32 + fq * 8);
#pragma unroll
        for (int et = 0; et < 4; ++et) o[et] = (f32x4){0.f, 0.f, 0.f, 0.f};
        mrun = -1e30f; lrun = 0.f;
        exth = ext + h * 640 + 63 + 512 + iq - 8 * fq;
      }
      const unsigned char* kb = stg + (st & 1) * 32768 + hh * 8192;
      const unsigned char* vb = stg + (st & 1) * 32768 + (2 + hh) * 8192;
      float sc[2][2][4];
#pragma unroll
      for (int g = 0; g < 2; ++g)
#pragma unroll
        for (int tt = 0; tt < 2; ++tt) {
          const int key = 32 * g + 8 * (fr >> 2) + (fr & 3) + 4 * tt, fk = attn_fk(key);
          const bf16x8 k0 = *(const bf16x8*)(kb + key * 128 + ((fq ^ fk) << 4));
          const bf16x8 k1 = *(const bf16x8*)(kb + key * 128 + (((4 + fq) ^ fk) << 4));
          f32x4 s4 = __builtin_amdgcn_mfma_f32_16x16x32_bf16(k0, qf[0], (f32x4){0.f, 0.f, 0.f, 0.f}, 0, 0, 0);
          s4 = __builtin_amdgcn_mfma_f32_16x16x32_bf16(k1, qf[1], s4, 0, 0, 0);
#pragma unroll
          for (int j = 0; j < 4; ++j) sc[g][tt][j] = s4[j] * (0.125f * LOG2E) + exth[-(64 * jc + 32 * g + 4 * tt + j)];
        }
      float mloc = -1e30f;
#pragma unroll
      for (int g = 0; g < 2; ++g)
#pragma unroll
        for (int tt = 0; tt < 2; ++tt)
#pragma unroll
          for (int j = 0; j < 4; ++j) mloc = fmaxf(mloc, sc[g][tt][j]);
      mloc = fmaxf(mloc, __shfl_xor(mloc, 16)); mloc = fmaxf(mloc, __shfl_xor(mloc, 32));
      const float mnew = fmaxf(mrun, mloc), alpha = __builtin_amdgcn_exp2f(mrun - mnew);
      mrun = mnew;
      float ls = 0.f;
#pragma unroll
      for (int g = 0; g < 2; ++g)
#pragma unroll
        for (int tt = 0; tt < 2; ++tt)
#pragma unroll
          for (int j = 0; j < 4; ++j) { const float e = __builtin_amdgcn_exp2f(sc[g][tt][j] - mnew); sc[g][tt][j] = e; ls += e; }
      lrun = lrun * alpha + ls;
#pragma unroll
      for (int et = 0; et < 4; ++et) { o[et].x *= alpha; o[et].y *= alpha; o[et].z *= alpha; o[et].w *= alpha; }
#pragma unroll
      for (int g = 0; g < 2; ++g) {
        union { bf16x8 v; unsigned u[4]; } pf;
        pf.u[0] = pk2(sc[g][0][0], sc[g][0][1]); pf.u[1] = pk2(sc[g][0][2], sc[g][0][3]);
        pf.u[2] = pk2(sc[g][1][0], sc[g][1][1]); pf.u[3] = pk2(sc[g][1][2], sc[g][1][3]);
#pragma unroll
        for (int et = 0; et < 4; ++et) {
          const int er = 16 * et + fr;
          const bf16x8 vf = *(const bf16x8*)(vb + er * 128 + (((4 * g + fq) ^ attn_fv(er)) << 4));
          o[et] = __builtin_amdgcn_mfma_f32_16x16x32_bf16(vf, pf.v, o[et], 0, 0, 0);
        }
      }
      if (jc == 8) {
        float lt = lrun + __shfl_xor(lrun, 16); lt += __shfl_xor(lt, 32);
        const float inv = 1.f / lt;
#pragma unroll
        for (int et = 0; et < 4; ++et) {
          f32x4 v = o[et]; v.x *= inv; v.y *= inv; v.z *= inv; v.w *= inv;
          *(f32x4*)(ATT + (size_t)(t0 + iq) * 384 + h * 64 + et * 16 + fq * 4) = v;
        }
      }
    };
#pragma unroll 1
    for (int st0 = 0; st0 < nst; st0 += 2) {
      { const int st = st0;
        if (st + 2 < nst) ATTN_LOAD(sa, st + 2);
        attn_compute(st);
        if (st + 1 < nst) ATTN_WRITE(sb, (st + 1) & 1);
        __syncthreads(); }
      if (st0 + 1 < nst) { const int st = st0 + 1;
        if (st + 2 < nst) ATTN_LOAD(sb, st + 2);
        attn_compute(st);
        if (st + 1 < nst) ATTN_WRITE(sa, (st + 1) & 1);
        __syncthreads(); }
    }
#undef ATTN_LOAD
#undef ATTN_WRITE
  }
  __syncthreads();
}

__device__ __forceinline__ void ssm_bu32(const bf16_t* __restrict__ bbh_g, const bf16_t* __restrict__ urow, int lane,
                                         f32x16& lo_re, f32x16& hi_re, f32x16& lo_im, f32x16& hi_im) {
  const int hf = lane >> 5, pl = lane & 31;
  const bf16x8 ub = *(const bf16x8*)(urow + 8 * hf);
  f32x16 z;
#pragma unroll
  for (int r = 0; r < 16; ++r) z[r] = 0.f;
  const bf16x8 a0r = *(const bf16x8*)(bbh_g + (size_t)(0 * 64 + pl) * 16 + 8 * hf), a1r = *(const bf16x8*)(bbh_g + (size_t)(0 * 64 + 32 + pl) * 16 + 8 * hf);
  const bf16x8 a0i = *(const bf16x8*)(bbh_g + (size_t)(1 * 64 + pl) * 16 + 8 * hf), a1i = *(const bf16x8*)(bbh_g + (size_t)(1 * 64 + 32 + pl) * 16 + 8 * hf);
  lo_re = __builtin_amdgcn_mfma_f32_32x32x16_bf16(ub, a0r, z, 0, 0, 0); hi_re = __builtin_amdgcn_mfma_f32_32x32x16_bf16(ub, a1r, z, 0, 0, 0);
  lo_im = __builtin_amdgcn_mfma_f32_32x32x16_bf16(ub, a0i, z, 0, 0, 0); hi_im = __builtin_amdgcn_mfma_f32_32x32x16_bf16(ub, a1i, z, 0, 0, 0);
#pragma unroll
  for (int r = 0; r < 16; ++r) {
    const auto s1 = __builtin_amdgcn_permlane32_swap(__float_as_uint(lo_re[r]), __float_as_uint(hi_re[r]), false, false);
    lo_re[r] = __uint_as_float(s1[0]); hi_re[r] = __uint_as_float(s1[1]);
    const auto s2 = __builtin_amdgcn_permlane32_swap(__float_as_uint(lo_im[r]), __float_as_uint(hi_im[r]), false, false);
    lo_im[r] = __uint_as_float(s2[0]); hi_im[r] = __uint_as_float(s2[1]);
  }
}
__device__ __forceinline__ void rotary_frag(const bf16x8 x0, const bf16x8 x1, const float* __restrict__ RC, const float* __restrict__ RS, int pos, int fq, float scale, bf16x8& o0, bf16x8& o1) {
  const f32x4 c0 = *(const f32x4*)(RC + pos * 32 + 8 * fq), c1 = *(const f32x4*)(RC + pos * 32 + 8 * fq + 4);
  const f32x4 s0 = *(const f32x4*)(RS + pos * 32 + 8 * fq), s1 = *(const f32x4*)(RS + pos * 32 + 8 * fq + 4);
  const float cc[8] = {c0.x, c0.y, c0.z, c0.w, c1.x, c1.y, c1.z, c1.w}, sn[8] = {s0.x, s0.y, s0.z, s0.w, s1.x, s1.y, s1.z, s1.w};
  union { bf16x8 v; unsigned u[4]; } r0, r1;
#pragma unroll
  for (int q = 0; q < 4; ++q) {
    const float a0 = bf2f((bf16_t)x0[2 * q]) * scale, a1 = bf2f((bf16_t)x0[2 * q + 1]) * scale, b0 = bf2f((bf16_t)x1[2 * q]) * scale, b1 = bf2f((bf16_t)x1[2 * q + 1]) * scale;
    r0.u[q] = pk2(a0 * cc[2 * q] - b0 * sn[2 * q], a1 * cc[2 * q + 1] - b1 * sn[2 * q + 1]);
    r1.u[q] = pk2(a0 * sn[2 * q] + b0 * cc[2 * q], a1 * sn[2 * q + 1] + b1 * cc[2 * q + 1]);
  }
  o0 = r0.v; o1 = r1.v;
}
__device__ void mix_local_phase(const Params& p, int l, unsigned char* smem) {
  const CParamsP pp = launder_kargs();
  GAS unsigned char* const ws = launder_ptr(pp->ws); const int tidx = launder_tid();
  const bf16_t* PROJ = (const bf16_t*)(ws + WS_PROJ); const bf16_t* VTR = (const bf16_t*)(ws + WS_VTR);
  const float* RC = (const float*)(ws + WS_ROTC); const float* RS = (const float*)(ws + WS_ROTS);
  float* YINT = (float*)(ws + WS_YINT); float* UPDT = (float*)(ws + WS_UPD);
  const float* SA = (const float*)(ws + WS_SA) + (size_t)l * 16 * 64 * 2; const bf16_t* BBH = (const bf16_t*)(ws + WS_BBH) + (size_t)l * 16 * 2 * 64 * 16;
  float* SEND = (float*)(ws + WS_SEND);
  const int tid = tidx, lane = tid & 63, wid = tid >> 6, fr = lane & 15, fq = lane >> 4;
  bf16_t* KT = (bf16_t*)smem;
  for (int item = blockIdx.x; item < 256; item += gridDim.x) {
    const int b = item >> 7, n = item & 127, t0 = b * 8192 + n * 64;
    __syncthreads();
#pragma unroll 1
    for (int k3 = 0; k3 < 3; ++k3) {
      const int task = wid * 3 + k3, h = task >> 2, tb = task & 3;
      const int i = 16 * tb + fr;
      const float lg2 = log2f(1.f - exp2f(-5.f - (float)h));
      bf16x8 qf0, qf1;
      {
        const bf16_t* qp = PROJ + (size_t)(t0 + i) * INCP + C_QR + h * 64 + 8 * fq;
        rotary_frag(*(const bf16x8*)qp, *(const bf16x8*)(qp + 32), RC, RS, n * 64 + i, fq, 1.f, qf0, qf1);
      }
      f32x4 o[4];
#pragma unroll
      for (int et = 0; et < 4; ++et) o[et] = (f32x4){0.f, 0.f, 0.f, 0.f};
#pragma unroll
      for (int g = 0; g < 2; ++g) {
        float st[2][4];
#pragma unroll
        for (int tt = 0; tt < 2; ++tt) {
          const int key = 32 * g + 8 * (fr >> 2) + (fr & 3) + 4 * tt;
          const bf16_t* kp = PROJ + (size_t)(t0 + key) * INCP + C_KR + h * 64 + 8 * fq;
          bf16x8 kf0, kf1;
          rotary_frag(*(const bf16x8*)kp, *(const bf16x8*)(kp + 32), RC, RS, n * 64 + key, fq, 0.125f, kf0, kf1);
          f32x4 s4 = __builtin_amdgcn_mfma_f32_16x16x32_bf16(kf0, qf0, (f32x4){0.f, 0.f, 0.f, 0.f}, 0, 0, 0);
          s4 = __builtin_amdgcn_mfma_f32_16x16x32_bf16(kf1, qf1, s4, 0, 0, 0);
#pragma unroll
          for (int j = 0; j < 4; ++j) {
            const int kk = 32 * g + 8 * fq + 4 * tt + j;
            const int dij = i > kk ? i - kk : kk - i;
            st[tt][j] = s4[j] * exp2f(lg2 * (float)dij);
          }
          if (tb == 0) {
            const float kd = exp2f(lg2 * (float)(63 - key));
#pragma unroll
            for (int jj = 0; jj < 8; ++jj) {
              KT[(h * 64 + 8 * fq + jj) * 72 + key] = f2bf(bf2f((bf16_t)kf0[jj]) * kd);
              KT[(h * 64 + 32 + 8 * fq + jj) * 72 + key] = f2bf(bf2f((bf16_t)kf1[jj]) * kd);
            }
          }
        }
        union { bf16x8 v; unsigned u[4]; } pf;
        pf.u[0] = pk2(st[0][0], st[0][1]); pf.u[1] = pk2(st[0][2], st[0][3]); pf.u[2] = pk2(st[1][0], st[1][1]); pf.u[3] = pk2(st[1][2], st[1][3]);
#pragma unroll
        for (int et = 0; et < 4; ++et) {
          const bf16x8 vf = *(const bf16x8*)(VTR + ((size_t)b * 384 + h * 64 + et * 16 + fr) * 8192 + n * 64 + 32 * g + 8 * fq);
          o[et] = __builtin_amdgcn_mfma_f32_16x16x32_bf16(vf, pf.v, o[et], 0, 0, 0);
        }
      }
#pragma unroll
      for (int et = 0; et < 4; ++et) *(f32x4*)(YINT + (size_t)(t0 + i) * 384 + h * 64 + et * 16 + fq * 4) = o[et];
    }
    __syncthreads();
#pragma unroll 1
    for (int k3 = 0; k3 < 3; ++k3) {
      const int task = wid * 3 + k3, h = task >> 2, et = task & 3;
      f32x4 acc[4];
#pragma unroll
      for (int dt = 0; dt < 4; ++dt) acc[dt] = (f32x4){0.f, 0.f, 0.f, 0.f};
#pragma unroll
      for (int g = 0; g < 2; ++g) {
        const bf16x8 vf = *(const bf16x8*)(VTR + ((size_t)b * 384 + h * 64 + et * 16 + fr) * 8192 + n * 64 + 32 * g + 8 * fq);
#pragma unroll
        for (int dt = 0; dt < 4; ++dt) {
          const bf16x8 kt = *(const bf16x8*)(KT + (h * 64 + 16 * dt + fr) * 72 + 32 * g + 8 * fq);
          acc[dt] = __builtin_amdgcn_mfma_f32_16x16x32_bf16(kt, vf, acc[dt], 0, 0, 0);
        }
      }
#pragma unroll
      for (int dt = 0; dt < 4; ++dt) *(f32x4*)(UPDT + (((size_t)item * 6 + h) * 64 + 16 * et + fr) * 64 + 16 * dt + 4 * fq) = acc[dt];
    }
#pragma unroll 1
    for (int gi = 0; gi < 2; ++gi) {
      const int g = wid * 2 + gi;
      const float are = SA[(g * 64 + lane) * 2], aim = SA[(g * 64 + lane) * 2 + 1];
      float xr = 0.f, xi = 0.f;
#pragma unroll 1
      for (int blk = 0; blk < 2; ++blk) {
        f32x16 lr, hr, li, hi;
        ssm_bu32(BBH + (size_t)g * 2 * 64 * 16, PROJ + (size_t)(t0 + 32 * blk + (lane & 31)) * INCP + C_US + g * 16, lane, lr, hr, li, hi);
#pragma unroll
        for (int a4 = 0; a4 < 4; ++a4) {
#pragma unroll
          for (int bq = 0; bq < 4; ++bq) { const float nr = are * xr - aim * xi + lr[4 * a4 + bq], ni = are * xi + aim * xr + li[4 * a4 + bq]; xr = nr; xi = ni; }
#pragma unroll
          for (int bq = 0; bq < 4; ++bq) { const float nr = are * xr - aim * xi + hr[4 * a4 + bq], ni = are * xi + aim * xr + hi[4 * a4 + bq]; xr = nr; xi = ni; }
        }
      }
      SEND[(((size_t)item * 16 + g) * 64 + lane) * 2] = xr; SEND[(((size_t)item * 16 + g) * 64 + lane) * 2 + 1] = xi;
    }
  }
}

__device__ void scan_phase(const Params& p, int l) {
  const CParamsP pp = launder_kargs();
  GAS unsigned char* const ws = launder_ptr(pp->ws); const int tidx = launder_tid();
  const float* __restrict__ UPDT = (const float*)(ws + WS_UPD); bf16_t* __restrict__ SPT = (bf16_t*)(ws + WS_SPT);
  const float* __restrict__ SEND = (const float*)(ws + WS_SEND); float* __restrict__ CARRY = (float*)(ws + WS_CARRY);
  const float* SA = (const float*)(ws + WS_SA) + (size_t)l * 16 * 64 * 2;
  const int gtid = blockIdx.x * NT + tidx, gn = gridDim.x * NT;
  for (int idx = gtid; idx < 2 * 6 * 4096 + 2 * 1024; idx += gn) {
    if (idx < 2 * 6 * 4096) {
      const int b = idx / (6 * 4096), r = idx % (6 * 4096), h = r >> 12;
      const float cd = exp2f(64.f * log2f(1.f - exp2f(-5.f - (float)h)));
      float s = 0.f;
#pragma unroll 1
      for (int nb = 0; nb < NCH; nb += 16) {
        float v[16];
#pragma unroll
        for (int j = 0; j < 16; ++j) v[j] = UPDT[((size_t)(b * NCH + nb + j)) * 6 * 4096 + r];
#pragma unroll
        for (int j = 0; j < 16; ++j) { SPT[((size_t)(b * NCH + nb + j)) * 6 * 4096 + r] = f2bf(s); s = cd * s + v[j]; }
      }
    } else {
      const int r2 = idx - 2 * 6 * 4096, b = r2 >> 10, gp = r2 & 1023;
      float ar = SA[gp * 2], ai = SA[gp * 2 + 1];
#pragma unroll
      for (int q = 0; q < 6; ++q) { const float nr = ar * ar - ai * ai, ni = 2.f * ar * ai; ar = nr; ai = ni; }
      float xr = 0.f, xi = 0.f;
#pragma unroll 1
      for (int nb = 0; nb < NCH; nb += 16) {
        float2 v[16];
#pragma unroll
        for (int j = 0; j < 16; ++j) v[j] = *(const float2*)(SEND + (((size_t)(b * NCH + nb + j)) * 1024 + gp) * 2);
#pragma unroll
        for (int j = 0; j < 16; ++j) {
          *(float2*)(CARRY + (((size_t)(b * NCH + nb + j)) * 1024 + gp) * 2) = make_float2(xr, xi);
          const float nr = ar * xr - ai * xi + v[j].x, ni = ar * xi + ai * xr + v[j].y;
          xr = nr; xi = ni;
        }
      }
    }
  }
  if (l + 1 < DEPTH_) convert_tables_fp4(pp, ws, l + 1, gtid, gn);
}

__device__ void mix_final_phase(const Params& p, int l, unsigned char* smem) {
  const CParamsP pp = launder_kargs();
  GAS unsigned char* const ws = launder_ptr(pp->ws); const int tidx = launder_tid();
  const bf16_t* PROJ = (const bf16_t*)(ws + WS_PROJ);
  const float* RC = (const float*)(ws + WS_ROTC); const float* RS = (const float*)(ws + WS_ROTS);
  const float* YINT = (const float*)(ws + WS_YINT); const bf16_t* SPT = (const bf16_t*)(ws + WS_SPT);
  const float* ATT = (const float*)(ws + WS_ATT);
  const float* SA = (const float*)(ws + WS_SA) + (size_t)l * 16 * 64 * 2; const bf16_t* BBH = (const bf16_t*)(ws + WS_BBH) + (size_t)l * 16 * 2 * 64 * 16;
  const float* CARRY = (const float*)(ws + WS_CARRY);
  const bf16_t* CB = (const bf16_t*)(ws + WS_CB) + (size_t)l * 16 * 16 * 128; const bf16_t* WG = (const bf16_t*)(ws + WS_WGLUT) + (size_t)l * 512 * 256;
  const float* dsk = gin(pp->in[I_SSMD]) + (size_t)l * 256;
  const float* mg = gin(pp->in[I_MGAIN]) + (size_t)l * 1024;
  bf16_t* MRG = (bf16_t*)(ws + WS_ABUF);
  const int tid = tidx, lane = tid & 63, wid = tid >> 6, fr = lane & 15, fq = lane >> 4;
  bf16_t* YS = (bf16_t*)smem;
  float* red = (float*)(smem + 33792);
  bf16_t* XB = (bf16_t*)(smem + 36864 + wid * 8448 + 4096);
  for (int item = blockIdx.x; item < 256; item += gridDim.x) {
    const int b = item >> 7, n = item & 127, t0 = b * 8192 + n * 64;
    __syncthreads();
    for (int ii = 0; ii < 8; ++ii) {
      const int t = t0 + wid * 8 + ii;
      float v[6]; float sq = 0.f;
#pragma unroll
      for (int j = 0; j < 6; ++j) { v[j] = ATT[(size_t)t * 384 + lane + 64 * j]; sq += v[j] * v[j]; }
      const float rstd = rsqrtf(wave_sum(sq) * (1.f / 384.f) + EPS_);
#pragma unroll
      for (int j = 0; j < 6; ++j) MRG[(size_t)t * 1024 + lane + 64 * j] = f2bf(v[j] * rstd * mg[lane + 64 * j]);
    }
#pragma unroll 1
    for (int k3 = 0; k3 < 3; ++k3) {
      const int task = wid * 3 + k3, h = task >> 2, tb = task & 3;
      const int i = 16 * tb + fr, t = t0 + i;
      const float lg2 = log2f(1.f - exp2f(-5.f - (float)h));
      bf16x8 qf0, qf1;
      {
        const bf16_t* qp = PROJ + (size_t)t * INCP + C_QR + h * 64 + 8 * fq;
        rotary_frag(*(const bf16x8*)qp, *(const bf16x8*)(qp + 32), RC, RS, n * 64 + i, fq, 1.f, qf0, qf1);
      }
      f32x4 o[4];
#pragma unroll
      for (int et = 0; et < 4; ++et) {
        const bf16_t* sp = SPT + (((size_t)item * 6 + h) * 64 + 16 * et + fr) * 64 + 8 * fq;
        const bf16x8 a0 = *(const bf16x8*)sp, a1 = *(const bf16x8*)(sp + 32);
        o[et] = __builtin_amdgcn_mfma_f32_16x16x32_bf16(a0, qf0, (f32x4){0.f, 0.f, 0.f, 0.f}, 0, 0, 0);
        o[et] = __builtin_amdgcn_mfma_f32_16x16x32_bf16(a1, qf1, o[et], 0, 0, 0);
      }
      const float qd = exp2f(lg2 * (float)(i + 1));
      float y[16]; float s1 = 0.f;
#pragma unroll
      for (int et = 0; et < 4; ++et) {
        const f32x4 yi = *(const f32x4*)(YINT + (size_t)t * 384 + h * 64 + 16 * et + 4 * fq);
        y[4 * et] = yi.x + qd * o[et].x; y[4 * et + 1] = yi.y + qd * o[et].y; y[4 * et + 2] = yi.z + qd * o[et].z; y[4 * et + 3] = yi.w + qd * o[et].w;
        s1 += (y[4 * et] + y[4 * et + 1]) + (y[4 * et + 2] + y[4 * et + 3]);
      }
      s1 += __shfl_xor(s1, 16); s1 += __shfl_xor(s1, 32);
      const float mu = s1 * (1.f / 64.f);
      float s2 = 0.f;
#pragma unroll
      for (int q = 0; q < 16; ++q) { y[q] -= mu; s2 += y[q] * y[q]; }
      s2 += __shfl_xor(s2, 16); s2 += __shfl_xor(s2, 32);
      const float rstd = rsqrtf(s2 * (1.f / 64.f) + EPS_);
#pragma unroll
      for (int et = 0; et < 4; ++et) {
        const int c = h * 64 + 16 * et + 4 * fq;
        const uint2 gr = *(const uint2*)(PROJ + (size_t)t * INCP + C_GR + c);
        const float g0 = __uint_as_float(gr.x << 16), g1 = __uint_as_float(gr.x & 0xffff0000u), g2 = __uint_as_float(gr.y << 16), g3 = __uint_as_float(gr.y & 0xffff0000u);
        const f32x4 mgv = *(const f32x4*)(mg + 384 + c);
        uint2 ov;
        ov.x = pk2(y[4 * et] * rstd * (g0 * sigmoid_f(g0)) * mgv.x, y[4 * et + 1] * rstd * (g1 * sigmoid_f(g1)) * mgv.y);
        ov.y = pk2(y[4 * et + 2] * rstd * (g2 * sigmoid_f(g2)) * mgv.z, y[4 * et + 3] * rstd * (g3 * sigmoid_f(g3)) * mgv.w);
        *(uint2*)(MRG + (size_t)t * 1024 + 384 + c) = ov;
      }
    }
#pragma unroll 1
    for (int gi = 0; gi < 2; ++gi) {
      const int g = wid * 2 + gi;
      const float are = SA[(g * 64 + lane) * 2], aim = SA[(g * 64 + lane) * 2 + 1];
      float xr = CARRY[(((size_t)item * 16 + g) * 64 + lane) * 2], xi = CARRY[(((size_t)item * 16 + g) * 64 + lane) * 2 + 1];
      bf16x8 cb[4];
#pragma unroll
      for (int ks = 0; ks < 4; ++ks) cb[ks] = *(const bf16x8*)(CB + ((size_t)g * 16 + fr) * 128 + 32 * ks + 8 * fq);
      const float dv = dsk[g * 16 + fr];
#pragma unroll 1
      for (int blk = 0; blk < 2; ++blk) {
        f32x16 lr, hr, li, hi;
        ssm_bu32(BBH + (size_t)g * 2 * 64 * 16, PROJ + (size_t)(t0 + 32 * blk + (lane & 31)) * INCP + C_US + g * 16, lane, lr, hr, li, hi);
#pragma unroll
        for (int half = 0; half < 2; ++half) {
#pragma unroll
          for (int a2 = 0; a2 < 2; ++a2) {
            const int a4 = 2 * half + a2;
#pragma unroll
            for (int bq = 0; bq < 4; ++bq) {
              const float nr = are * xr - aim * xi + lr[4 * a4 + bq], ni = are * xi + aim * xr + li[4 * a4 + bq]; xr = nr; xi = ni;
              XB[(8 * a2 + bq) * 136 + lane] = f2bf(xr); XB[(8 * a2 + bq) * 136 + 64 + lane] = f2bf(xi);
            }
#pragma unroll
            for (int bq = 0; bq < 4; ++bq) {
              const float nr = are * xr - aim * xi + hr[4 * a4 + bq], ni = are * xi + aim * xr + hi[4 * a4 + bq]; xr = nr; xi = ni;
              XB[(8 * a2 + 4 + bq) * 136 + lane] = f2bf(xr); XB[(8 * a2 + 4 + bq) * 136 + 64 + lane] = f2bf(xi);
            }
          }
          f32x4 acc = (f32x4){0.f, 0.f, 0.f, 0.f};
#pragma unroll
          for (int ks = 0; ks < 4; ++ks) {
            const bf16x8 af = *(const bf16x8*)(XB + fr * 136 + 32 * ks + 8 * fq);
            acc = __builtin_amdgcn_mfma_f32_16x16x32_bf16(af, cb[ks], acc, 0, 0, 0);
          }
#pragma unroll
          for (int j = 0; j < 4; ++j) {
            const int i = 32 * blk + 16 * half + 4 * fq + j;
            const float yv = acc[j] + dv * bf2f(PROJ[(size_t)(t0 + i) * INCP + C_US + g * 16 + fr]);
            YS[i * 264 + g * 16 + fr] = f2bf(gelu_tanh(yv));
          }
        }
      }
    }
    __syncthreads();
    {
      const int n0 = 32 * wid;
      f32x4 a1[4][2], a2[4][2];
#pragma unroll
      for (int mt = 0; mt < 4; ++mt)
#pragma unroll
        for (int nt = 0; nt < 2; ++nt) { a1[mt][nt] = (f32x4){0.f, 0.f, 0.f, 0.f}; a2[mt][nt] = (f32x4){0.f, 0.f, 0.f, 0.f}; }
#pragma unroll 2
      for (int ks = 0; ks < 8; ++ks) {
        bf16x8 w1[2], w2[2], yb[4];
#pragma unroll
        for (int nt = 0; nt < 2; ++nt) {
          w1[nt] = *(const bf16x8*)(WG + (size_t)(n0 + 16 * nt + fr) * 256 + 32 * ks + 8 * fq);
          w2[nt] = *(const bf16x8*)(WG + (size_t)(256 + n0 + 16 * nt + fr) * 256 + 32 * ks + 8 * fq);
        }
#pragma unroll
        for (int mt = 0; mt < 4; ++mt) yb[mt] = *(const bf16x8*)(YS + (16 * mt + fr) * 264 + 32 * ks + 8 * fq);
#pragma unroll
        for (int mt = 0; mt < 4; ++mt)
#pragma unroll
          for (int nt = 0; nt < 2; ++nt) {
            a1[mt][nt] = __builtin_amdgcn_mfma_f32_16x16x32_bf16(w1[nt], yb[mt], a1[mt][nt], 0, 0, 0);
            a2[mt][nt] = __builtin_amdgcn_mfma_f32_16x16x32_bf16(w2[nt], yb[mt], a2[mt][nt], 0, 0, 0);
          }
      }
#pragma unroll
      for (int mt = 0; mt < 4; ++mt) {
        float sq = 0.f;
#pragma unroll
        for (int nt = 0; nt < 2; ++nt) {
          f32x4 z = a1[mt][nt]; const f32x4 zg = a2[mt][nt];
          z.x *= sigmoid_f(zg.x); z.y *= sigmoid_f(zg.y); z.z *= sigmoid_f(zg.z); z.w *= sigmoid_f(zg.w);
          a1[mt][nt] = z; sq += z.x * z.x + z.y * z.y + z.z * z.z + z.w * z.w;
        }
        sq += __shfl_xor(sq, 16); sq += __shfl_xor(sq, 32);
        if (fq == 0) red[wid * 64 + 16 * mt + fr] = sq;
      }
      __syncthreads();
#pragma unroll
      for (int mt = 0; mt < 4; ++mt) {
        const int i = 16 * mt + fr, t = t0 + i;
        float tot = 0.f;
#pragma unroll
        for (int w8 = 0; w8 < 8; ++w8) tot += red[w8 * 64 + i];
        const float rstd = rsqrtf(tot * (1.f / 256.f) + EPS_);
#pragma unroll
        for (int nt = 0; nt < 2; ++nt) {
          const int c = n0 + 16 * nt + 4 * fq;
          const f32x4 mgv = *(const f32x4*)(mg + 768 + c); const f32x4 z = a1[mt][nt];
          uint2 ov; ov.x = pk2(z.x * rstd * mgv.x, z.y * rstd * mgv.y); ov.y = pk2(z.z * rstd * mgv.z, z.w * rstd * mgv.w);
          *(uint2*)(MRG + (size_t)t * 1024 + 768 + c) = ov;
        }
      }
    }
  }
}

typedef float f32x2 __attribute__((ext_vector_type(2)));
__device__ __forceinline__ float dot16_fp4(const uint2 u, const f32x2 (&hv)[8]) {
  f32x2 d = __builtin_amdgcn_cvt_scalef32_pk_f32_fp4(u.x, 1.0f, 0) * hv[0];
  d += __builtin_amdgcn_cvt_scalef32_pk_f32_fp4(u.x, 1.0f, 1) * hv[1];
  d += __builtin_amdgcn_cvt_scalef32_pk_f32_fp4(u.x, 1.0f, 2) * hv[2];
  d += __builtin_amdgcn_cvt_scalef32_pk_f32_fp4(u.x, 1.0f, 3) * hv[3];
  d += __builtin_amdgcn_cvt_scalef32_pk_f32_fp4(u.y, 1.0f, 0) * hv[4];
  d += __builtin_amdgcn_cvt_scalef32_pk_f32_fp4(u.y, 1.0f, 1) * hv[5];
  d += __builtin_amdgcn_cvt_scalef32_pk_f32_fp4(u.y, 1.0f, 2) * hv[6];
  d += __builtin_amdgcn_cvt_scalef32_pk_f32_fp4(u.y, 1.0f, 3) * hv[7];
  return d.x + d.y;
}
__device__ __forceinline__ void axpy16_fp4(const uint2 v, const float w, f32x2 (&acc)[8]) {
  const f32x2 w2 = (f32x2){w, w};
  acc[0] += w2 * __builtin_amdgcn_cvt_scalef32_pk_f32_fp4(v.x, 1.0f, 0);
  acc[1] += w2 * __builtin_amdgcn_cvt_scalef32_pk_f32_fp4(v.x, 1.0f, 1);
  acc[2] += w2 * __builtin_amdgcn_cvt_scalef32_pk_f32_fp4(v.x, 1.0f, 2);
  acc[3] += w2 * __builtin_amdgcn_cvt_scalef32_pk_f32_fp4(v.x, 1.0f, 3);
  acc[4] += w2 * __builtin_amdgcn_cvt_scalef32_pk_f32_fp4(v.y, 1.0f, 0);
  acc[5] += w2 * __builtin_amdgcn_cvt_scalef32_pk_f32_fp4(v.y, 1.0f, 1);
  acc[6] += w2 * __builtin_amdgcn_cvt_scalef32_pk_f32_fp4(v.y, 1.0f, 2);
  acc[7] += w2 * __builtin_amdgcn_cvt_scalef32_pk_f32_fp4(v.y, 1.0f, 3);
}
__device__ __forceinline__ float vmaxf(float a, float b) { float r; asm("v_max_f32 %0, %1, %2" : "=v"(r) : "v"(a), "v"(b)); return r; }
__device__ __forceinline__ float vminf(float a, float b) { float r; asm("v_min_f32 %0, %1, %2" : "=v"(r) : "v"(a), "v"(b)); return r; }
__device__ __forceinline__ void cx(float& hi, float& lo) { const float a = hi, b = lo; hi = vmaxf(a, b); lo = vminf(a, b); }
__device__ __forceinline__ void cx2(float& kh, int& ph, float& kl, int& pl) {
  const float a = kh, b = kl; const int pa = ph, pb = pl; const bool c = a >= b;
  kh = vmaxf(a, b); kl = vminf(a, b); ph = c ? pa : pb; pl = c ? pb : pa;
}
__device__ __forceinline__ void bitonic_sort16_desc(float (&v)[16]) {
#pragma unroll
  for (int k = 2; k <= 16; k <<= 1)
#pragma unroll
    for (int j = k >> 1; j > 0; j >>= 1)
#pragma unroll
      for (int i = 0; i < 16; ++i) {
        const int l = i ^ j;
        if (l > i) { if ((i & k) == 0) cx(v[i], v[l]); else cx(v[l], v[i]); }
      }
}
__device__ __forceinline__ void bitonic_merge16_desc(float (&v)[16]) {
#pragma unroll
  for (int j = 8; j > 0; j >>= 1)
#pragma unroll
    for (int i = 0; i < 16; ++i) { const int l = i ^ j; if (l > i) cx(v[i], v[l]); }
}
__device__ __forceinline__ void top16_merge(float (&a)[16], const float (&b)[16]) {
#pragma unroll
  for (int i = 0; i < 16; ++i) a[i] = vmaxf(a[i], b[15 - i]);
  bitonic_merge16_desc(a);
}
template <int M> __device__ __forceinline__ void top16_merge_chain(float (&k)[16], int (&q)[16], const float (&xk)[M], const int (&xq)[M]) {
#pragma unroll
  for (int i = 16 - M; i < 16; ++i) { const float a = k[i], b = xk[15 - i]; const bool c = a >= b; k[i] = vmaxf(a, b); q[i] = c ? q[i] : xq[15 - i]; }
#pragma unroll
  for (int j = 8; j > 0; j >>= 1)
#pragma unroll
    for (int i = 0; i < 16; ++i) { const int l = i ^ j; if (l > i) cx2(k[i], q[i], k[l], q[l]); }
}

__device__ void peer_phase(const Params& p, int l, bool last, unsigned char* smem) {
  const CParamsP pp = launder_kargs();
  GAS unsigned char* const ws = launder_ptr(pp->ws); const int tidx = launder_tid();
  bf16_t* HF = (bf16_t*)(ws + WS_ABUF); float* X = (float*)(ws + WS_X);
  const float* SC4 = (const float*)(ws + WS_SC);
  const uint2* U4 = (const uint2*)(ws + WS_PU8) + (size_t)l * 16384 * 64; const uint2* V4 = (const uint2*)(ws + WS_PV8) + (size_t)l * 16384 * 64;
  const float* g2 = (const float*)(ws + WS_MOD) + (size_t)l * 2 * 6144 + 5120;
  const bf16_t* XG = (const bf16_t*)(ws + WS_XG); const float* SSQ = (const float*)(ws + WS_SSQ); const float* sh2 = (const float*)(ws + WS_MOD) + (size_t)l * 2 * 6144 + 3072;
  const int ln = last ? l : l + 1;
  const float* nsh = (const float*)(ws + WS_MOD) + (size_t)ln * 2 * 6144; const float* nsc = nsh + 1024;
  const float* ngain = gin(pp->in[I_NMIX]) + (size_t)ln * 1024;
  const int lane = tidx & 63, wid = tidx >> 6;
  const int rL = ((lane >> 5) & 1) * 8 + ((lane >> 4) & 1) * 4 + ((lane >> 3) & 1) * 2 + ((lane >> 2) & 1);
  const bool hi5 = (lane & 32) != 0, hi4 = (lane & 16) != 0, hi3 = (lane & 8) != 0, hi2 = (lane & 4) != 0;
  int* idxL = (int*)smem;
  for (int item = blockIdx.x; item < T_ / 64; item += gridDim.x) {
    const int t0 = item * 64;
    __syncthreads();
    {
      int lane_o = lane; asm volatile("" : "+v"(lane_o));
      const int tg = wid & 1, hp = wid >> 1, hf = lane_o >> 5, tl = 32 * tg + (lane_o & 31);
      float F[2][16];
#pragma unroll
      for (int sd = 0; sd < 2; ++sd) {
        float Lh[2][16];
#pragma unroll
        for (int hh = 0; hh < 2; ++hh) {
          const int hs = 2 * (2 * hp + hh) + sd;
          float top[16];
          const float* scp = SC4 + (((size_t)(hs * 32 + 16 * hf)) * T_ + (t0 + tl)) * 4;
#pragma unroll
          for (int kt = 0; kt < 4; ++kt) {
            float g[16];
#pragma unroll
            for (int kq = 0; kq < 4; ++kq) {
              const f32x4 v4 = *(const f32x4*)(scp + (size_t)(4 * kt + kq) * T_ * 4);
#pragma unroll
              for (int j = 0; j < 4; ++j) {
                const int key = 64 * hf + 16 * kt + 4 * kq + j;
                g[4 * kq + j] = __uint_as_float((__float_as_uint(v4[j]) & 0xffffff80u) | (unsigned)key);
              }
            }
            bitonic_sort16_desc(g);
            if (kt == 0) {
#pragma unroll
              for (int r = 0; r < 16; ++r) top[r] = g[r];
            } else top16_merge(top, g);
            __builtin_amdgcn_sched_barrier(0);
          }
#pragma unroll
          for (int r = 0; r < 16; ++r) Lh[hh][r] = top[r];
          __builtin_amdgcn_sched_barrier(0);
        }
#pragma unroll
        for (int r = 0; r < 16; ++r) {
          const auto sw = __builtin_amdgcn_permlane32_swap(__float_as_uint(Lh[0][r]), __float_as_uint(Lh[1][r]), false, false);
          Lh[0][r] = __uint_as_float(sw[0]); Lh[1][r] = __uint_as_float(sw[1]);
        }
        top16_merge(Lh[0], Lh[1]);
#pragma unroll
        for (int r = 0; r < 16; ++r) F[sd][r] = Lh[0][r];
        __builtin_amdgcn_sched_barrier(0);
      }
      int ia[16], ib[16];
#pragma unroll
      for (int r = 0; r < 16; ++r) { ia[r] = (int)(__float_as_uint(F[0][r]) & 127u) << 7; ib[r] = (int)(__float_as_uint(F[1][r]) & 127u); }
      float k[16]; int q[16];
#pragma unroll
      for (int j = 0; j < 16; ++j) { k[j] = F[0][0] + F[1][j]; q[j] = ia[0] | ib[j]; }
      { float xk[8]; int xq[8];
#pragma unroll
        for (int j = 0; j < 8; ++j) { xk[j] = F[0][1] + F[1][j]; xq[j] = ia[1] | ib[j]; }
        top16_merge_chain<8>(k, q, xk, xq); }
      { float xk[5]; int xq[5];
#pragma unroll
        for (int j = 0; j < 5; ++j) { xk[j] = F[0][2] + F[1][j]; xq[j] = ia[2] | ib[j]; }
        top16_merge_chain<5>(k, q, xk, xq); }
      { float xk[4]; int xq[4];
#pragma unroll
        for (int j = 0; j < 4; ++j) { xk[j] = F[0][3] + F[1][j]; xq[j] = ia[3] | ib[j]; }
        top16_merge_chain<4>(k, q, xk, xq); }
      { float xk[3]; int xq[3];
#pragma unroll
        for (int j = 0; j < 3; ++j) { xk[j] = F[0][4] + F[1][j]; xq[j] = ia[4] | ib[j]; }
        top16_merge_chain<3>(k, q, xk, xq); }
      { float xk[11]; int xq[11];
#pragma unroll
        for (int i = 0; i < 11; ++i) { xk[i] = F[0][5 + i] + F[1][0]; xq[i] = ia[5 + i] | ib[0]; }
        top16_merge_chain<11>(k, q, xk, xq); }
      { float xk[3]; int xq[3];
#pragma unroll
        for (int i = 0; i < 3; ++i) { xk[i] = F[0][5 + i] + F[1][1]; xq[i] = ia[5 + i] | ib[1]; }
        top16_merge_chain<3>(k, q, xk, xq); }
      float e[16]; float es = 0.f;
#pragma unroll
      for (int i = 0; i < 16; ++i) { e[i] = __expf(k[i] - k[0]); es += e[i]; }
      const float ies = 1.f / es;
      const int h = 2 * hp + hf;
#pragma unroll
      for (int i = 0; i < 16; ++i) idxL[tl * 132 + h * 16 + i] = (int)(((unsigned)f2bf(e[i] * ies) << 16) | (unsigned)q[i]);
    }
    __syncthreads();
#pragma unroll 1
    for (int ii = 0; ii < 8; ++ii) {
      const int tl = wid * 8 + ii, t = t0 + tl, b = t >> 13;
      const int fr = lane & 15, fq = lane >> 4;
      uint4 hB1[8], hB2[8];
      {
        const uint4 h0 = *(const uint4*)(XG + (size_t)t * 1024 + lane * 16), h1 = *(const uint4*)(XG + (size_t)t * 1024 + lane * 16 + 8);
        const unsigned hw[8] = {h0.x, h0.y, h0.z, h0.w, h1.x, h1.y, h1.z, h1.w};
        const float rs = rsqrtf(ssq_total(SSQ, t) * (1.f / 1024.f) + EPS_);
        unsigned q1[2] = {0u, 0u}, q2[2] = {0u, 0u};
#pragma unroll
        for (int qq = 0; qq < 4; ++qq) {
          const f32x4 sh = *(const f32x4*)(sh2 + b * 6144 + lane * 16 + 4 * qq);
          float hvv[4];
          hvv[0] = __uint_as_float(hw[2 * qq] << 16) * rs + sh.x; hvv[1] = __uint_as_float(hw[2 * qq] & 0xffff0000u) * rs + sh.y;
          hvv[2] = __uint_as_float(hw[2 * qq + 1] << 16) * rs + sh.z; hvv[3] = __uint_as_float(hw[2 * qq + 1] & 0xffff0000u) * rs + sh.w;
#pragma unroll
          for (int pr = 0; pr < 2; ++pr) {
            const int byte_sel = (2 * qq + pr) & 3, wd = (2 * qq + pr) >> 2;
            const float x0 = fminf(fmaxf(hvv[2 * pr], -6.f), 6.f), x1 = fminf(fmaxf(hvv[2 * pr + 1], -6.f), 6.f);
            unsigned t1 = 0u;
            if (byte_sel == 0) t1 = __builtin_amdgcn_cvt_scalef32_pk_fp4_f32(0u, x0, x1, 1.0f, 0);
            else if (byte_sel == 1) t1 = __builtin_amdgcn_cvt_scalef32_pk_fp4_f32(0u, x0, x1, 1.0f, 1);
            else if (byte_sel == 2) t1 = __builtin_amdgcn_cvt_scalef32_pk_fp4_f32(0u, x0, x1, 1.0f, 2);
            else t1 = __builtin_amdgcn_cvt_scalef32_pk_fp4_f32(0u, x0, x1, 1.0f, 3);
            f32x2 back;
            if (byte_sel == 0) back = __builtin_amdgcn_cvt_scalef32_pk_f32_fp4(t1, 1.0f, 0);
            else if (byte_sel == 1) back = __builtin_amdgcn_cvt_scalef32_pk_f32_fp4(t1, 1.0f, 1);
            else if (byte_sel == 2) back = __builtin_amdgcn_cvt_scalef32_pk_f32_fp4(t1, 1.0f, 2);
            else back = __builtin_amdgcn_cvt_scalef32_pk_f32_fp4(t1, 1.0f, 3);
            const float r0 = fminf(fmaxf((hvv[2 * pr] - back.x) * 8.f, -6.f), 6.f), r1 = fminf(fmaxf((hvv[2 * pr + 1] - back.y) * 8.f, -6.f), 6.f);
            unsigned t2 = 0u;
            if (byte_sel == 0) t2 = __builtin_amdgcn_cvt_scalef32_pk_fp4_f32(0u, r0, r1, 1.0f, 0);
            else if (byte_sel == 1) t2 = __builtin_amdgcn_cvt_scalef32_pk_fp4_f32(0u, r0, r1, 1.0f, 1);
            else if (byte_sel == 2) t2 = __builtin_amdgcn_cvt_scalef32_pk_fp4_f32(0u, r0, r1, 1.0f, 2);
            else t2 = __builtin_amdgcn_cvt_scalef32_pk_fp4_f32(0u, r0, r1, 1.0f, 3);
            q1[wd] |= t1; q2[wd] |= t2;
          }
        }
        unsigned char* hq4 = smem + 33792 + wid * 1024;
        *(uint2*)(hq4 + lane * 8) = make_uint2(q1[0], q1[1]);
        *(uint2*)(hq4 + 512 + lane * 8) = make_uint2(q2[0], q2[1]);
#pragma unroll
        for (int kc = 0; kc < 8; ++kc) { hB1[kc] = *(const uint4*)(hq4 + 64 * kc + 16 * fq); hB2[kc] = *(const uint4*)(hq4 + 512 + 64 * kc + 16 * fq); }
      }
      f32x2 acc2[8];
#pragma unroll
      for (int j = 0; j < 8; ++j) acc2[j] = (f32x2){0.f, 0.f};
#pragma unroll 1
      for (int bt = 0; bt < 8; ++bt) {
        const int myidx = idxL[tl * 132 + 16 * bt + fr] & 0xffff;
        unsigned char* ust = smem + 41984 + wid * 8448;
        uint2 ul[16], vr[16];
#pragma unroll
        for (int r = 0; r < 16; ++r) { const int er = __builtin_amdgcn_readlane(myidx, r); const uint2* up = U4 + (size_t)er * 64; ul[r] = up[lane]; const uint2* vp = V4 + (size_t)er * 64; vr[r] = vp[lane]; }
#pragma unroll
        for (int r = 0; r < 16; ++r) *(uint2*)(ust + r * 528 + lane * 8) = ul[r];
        uint4 ua[8];
#pragma unroll
        for (int kc = 0; kc < 8; ++kc) ua[kc] = *(const uint4*)(ust + fr * 528 + 64 * kc + 16 * fq);
        f32x4 sa[2] = {(f32x4){0.f, 0.f, 0.f, 0.f}, (f32x4){0.f, 0.f, 0.f, 0.f}}, sb[2] = {(f32x4){0.f, 0.f, 0.f, 0.f}, (f32x4){0.f, 0.f, 0.f, 0.f}};
#pragma unroll
        for (int kc = 0; kc < 8; ++kc) {
          const i32x8 av = (i32x8){(int)ua[kc].x, (int)ua[kc].y, (int)ua[kc].z, (int)ua[kc].w, 0, 0, 0, 0};
          const i32x8 b1 = (i32x8){(int)hB1[kc].x, (int)hB1[kc].y, (int)hB1[kc].z, (int)hB1[kc].w, 0, 0, 0, 0};
          const i32x8 b2 = (i32x8){(int)hB2[kc].x, (int)hB2[kc].y, (int)hB2[kc].z, (int)hB2[kc].w, 0, 0, 0, 0};
          sa[kc & 1] = __builtin_amdgcn_mfma_scale_f32_16x16x128_f8f6f4(av, b1, sa[kc & 1], 4  , 4  , 0, 0x7F7F7F7F, 0, 0x7F7F7F7F);
          sb[kc & 1] = __builtin_amdgcn_mfma_scale_f32_16x16x128_f8f6f4(av, b2, sb[kc & 1], 4, 4, 0, 0x7F7F7F7F, 0, 0x7F7F7F7F);
        }
        f32x4 sc4 = (sa[0] + sa[1]) + (sb[0] + sb[1]) * 0.125f;
        const int jsel = lane & 3;
        const float dsel = jsel == 0 ? sc4[0] : (jsel == 1 ? sc4[1] : (jsel == 2 ? sc4[2] : sc4[3]));
        const float gl = __uint_as_float((unsigned)idxL[tl * 132 + 16 * bt + 4 * fq + jsel] & 0xffff0000u);
        const float w = gl * gelu_tanh_fast(dsel * (1.f / 64.f));
#pragma unroll
        for (int r = 0; r < 16; ++r) {
          const float wr = __int_as_float(__builtin_amdgcn_readlane(__float_as_int(w), 16 * (r >> 2) + (r & 3)));
          axpy16_fp4(vr[r], wr, acc2);
          if ((r & 3) == 3) __builtin_amdgcn_sched_barrier(0);
        }
      }
      float acc[16];
#pragma unroll
      for (int j = 0; j < 8; ++j) { acc[2 * j] = acc2[j].x; acc[2 * j + 1] = acc2[j].y; }
      float xn[16]; float ss = 0.f;
#pragma unroll
      for (int qq = 0; qq < 4; ++qq) {
        const int c = lane * 16 + 4 * qq;
        const f32x4 xv = *(const f32x4*)(X + (size_t)t * 1024 + c), g = *(const f32x4*)(g2 + b * 6144 + c);
        xn[4 * qq] = xv.x + g.x * acc[4 * qq] * 0.25f; xn[4 * qq + 1] = xv.y + g.y * acc[4 * qq + 1] * 0.25f;
        xn[4 * qq + 2] = xv.z + g.z * acc[4 * qq + 2] * 0.25f; xn[4 * qq + 3] = xv.w + g.w * acc[4 * qq + 3] * 0.25f;
        ss += xn[4 * qq] * xn[4 * qq] + xn[4 * qq + 1] * xn[4 * qq + 1] + xn[4 * qq + 2] * xn[4 * qq + 2] + xn[4 * qq + 3] * xn[4 * qq + 3];
      }
      const float rstd = rsqrtf(wave_sum(ss) * (1.f / 1024.f) + EPS_);
      if (!last) {
        unsigned hb[8];
#pragma unroll
        for (int qq = 0; qq < 4; ++qq) {
          const int c = lane * 16 + 4 * qq;
          *(f32x4*)(X + (size_t)t * 1024 + c) = (f32x4){xn[4 * qq], xn[4 * qq + 1], xn[4 * qq + 2], xn[4 * qq + 3]};
          const f32x4 gn = *(const f32x4*)(ngain + c), sh = *(const f32x4*)(nsh + b * 6144 + c), sc = *(const f32x4*)(nsc + b * 6144 + c);
          hb[2 * qq] = pk2(xn[4 * qq] * rstd * gn.x * (1.f + sc.x) + sh.x, xn[4 * qq + 1] * rstd * gn.y * (1.f + sc.y) + sh.y);
          hb[2 * qq + 1] = pk2(xn[4 * qq + 2] * rstd * gn.z * (1.f + sc.z) + sh.z, xn[4 * qq + 3] * rstd * gn.w * (1.f + sc.w) + sh.w);
        }
        *(uint4*)(HF + (size_t)t * 1024 + lane * 16) = make_uint4(hb[0], hb[1], hb[2], hb[3]);
        *(uint4*)(HF + (size_t)t * 1024 + lane * 16 + 8) = make_uint4(hb[4], hb[5], hb[6], hb[7]);
      } else {
#pragma unroll
        for (int qq = 0; qq < 4; ++qq) {
          const int c = lane * 16 + 4 * qq;
          const f32x4 fn = *(const f32x4*)(gin(pp->in[I_FNORM]) + c);
          *(f32x4*)((float*)pp->out + (size_t)t * 1024 + c) = (f32x4){xn[4 * qq] * rstd * fn.x, xn[4 * qq + 1] * rstd * fn.y, xn[4 * qq + 2] * rstd * fn.z, xn[4 * qq + 3] * rstd * fn.w};
        }
      }
    }
  }
}

#define XB_TMO      128
#define XB_XCNT(j)  (256  + 64 * (j))
#define XB_XSUB(j)  (1280 + 64 * (j))
#define XB_XGEN(j)  (2304 + 64 * (j))
#define XB_TOP      3328
#define XB_TOPGEN   3392
#define XCD_BAR_WORDS 3456
#define XB_SPIN_CAP (1u << 20)
#define LAS __attribute__((address_space(3)))
__device__ __forceinline__ unsigned xb_ld(unsigned* q)              { return __hip_atomic_load(q, __ATOMIC_RELAXED, __HIP_MEMORY_SCOPE_AGENT); }
__device__ __forceinline__ unsigned xb_add(unsigned* q, unsigned v) { return __hip_atomic_fetch_add(q, v, __ATOMIC_RELAXED, __HIP_MEMORY_SCOPE_AGENT); }
__device__ __forceinline__ unsigned xb_xcc_id() { return (unsigned)__builtin_amdgcn_s_getreg((3 << 11) | 20) & 0xFu; }
#define XB_SPIN(cond, bar) do { unsigned _sp = 0; while (cond) { __builtin_amdgcn_s_sleep(1); \
    if ((++_sp & 255u) == 0u) { if (xb_ld(&(bar)[XB_TMO])) break; if (_sp > XB_SPIN_CAP) { atomicAdd(&(bar)[XB_TMO], 1u); break; } } } } while (0)
struct XcdBarrier { unsigned* bar; unsigned x; volatile LAS unsigned* st; };
__device__ __forceinline__ XcdBarrier xcd_barrier_post(unsigned* bar, volatile LAS unsigned* st) {
    XcdBarrier b; b.bar = bar; b.x = xb_xcc_id(); b.st = st;
    if (threadIdx.x == 0) (void)xb_add(&bar[XB_XCNT(b.x)], 1u);
    return b;
}
__device__ __forceinline__ void xcd_barrier_complete(unsigned* bar, unsigned x, unsigned& nloc, unsigned& nx) {
    const unsigned G = gridDim.x * gridDim.y * gridDim.z;
    unsigned sum, cnt, mine, sp = 0u;
    for (;;) {
        sum = 0u; cnt = 0u; mine = 0u;
#pragma unroll
        for (unsigned j = 0; j < 16; ++j) { const unsigned c = xb_ld(&bar[XB_XCNT(j)]); sum += c; cnt += (c > 0u) ? 1u : 0u; mine = (j == x) ? c : mine; }
        if (sum == G) break;
        __builtin_amdgcn_s_sleep(1);
        if ((++sp & 255u) == 0u) { if (xb_ld(&bar[XB_TMO])) break; if (sp > XB_SPIN_CAP) { atomicAdd(&bar[XB_TMO], 1u); break; } }
    }
    nloc = mine > 0u ? mine : 1u; nx = cnt > 0u ? cnt : 1u;
}
__device__ __forceinline__ void xcd_barrier(const XcdBarrier& b) {
    asm volatile("s_waitcnt vmcnt(0)" ::: "memory");
    __syncthreads();
    if (threadIdx.x == 0) {
        unsigned* bar = b.bar;
        __builtin_amdgcn_s_waitcnt(0);
        unsigned nloc = b.st[0], nx = b.st[1];
        if (nloc == 0u) { xcd_barrier_complete(bar, b.x, nloc, nx); b.st[0] = nloc; b.st[1] = nx; }
        const unsigned old = xb_add(&bar[XB_XSUB(b.x)], 1u);
        const unsigned gen = old / nloc;
        if (old + 1u == (gen + 1u) * nloc) {
            __builtin_amdgcn_fence(__ATOMIC_RELEASE, "agent");
            asm volatile("s_waitcnt vmcnt(0)" ::: "memory");
            const unsigned og = xb_add(&bar[XB_TOP], 1u);
            const unsigned tg = og / nx;
            if (og + 1u == (tg + 1u) * nx) xb_add(&bar[XB_TOPGEN], 1u);
            else XB_SPIN(xb_ld(&bar[XB_TOPGEN]) == tg, bar);
            __builtin_amdgcn_fence(__ATOMIC_ACQUIRE, "agent");
            xb_add(&bar[XB_XGEN(b.x)], 1u);
            asm volatile("s_waitcnt vmcnt(0)" ::: "memory");
        } else {
            XB_SPIN(xb_ld(&bar[XB_XGEN(b.x)]) == gen, bar);
            __builtin_amdgcn_fence(__ATOMIC_ACQUIRE, "agent");
            asm volatile("s_waitcnt vmcnt(0)" ::: "memory");
        }
    }
    __syncthreads();
}

__global__ void __launch_bounds__(NT) fwd_megakernel(Params p) {
  extern __shared__ __attribute__((aligned(16))) unsigned char smem[];
  const CParamsP pp = launder_kargs();
  cg::grid_group grid = cg::this_grid();
  volatile LAS unsigned* xbst = (volatile LAS unsigned*)(smem + LDS_BYTES - 16);
  if (threadIdx.x == 0) { xbst[0] = 0u; xbst[1] = 0u; }
  if (blockIdx.x == 0) { unsigned* bw = (unsigned*)(pp->ws + WS_BAR); for (int i = threadIdx.x; i < XCD_BAR_WORDS; i += NT) bw[i] = 0u; }
  setup_phase(p, smem);
  grid.sync();
  const XcdBarrier xb = xcd_barrier_post((unsigned*)(pp->ws + WS_BAR), xbst);
  const float* MOD = (const float*)(pp->ws + WS_MOD);
  for (int l = 0; l < DEPTH_; ++l) {
    const float* xsrc = (l == 0) ? gin(pp->in[I_X]) : (const float*)(pp->ws + WS_X);
    const float* modl = MOD + (size_t)l * 2 * 6144;
    if (l == 0) {
      norm_mod_phase(xsrc, gin(pp->in[I_NMIX]), modl + 0, modl + 1024, (bf16_t*)(pp->ws + WS_ABUF));
      qbias_phase(p, smem);
      xcd_barrier(xb);
    }
    gemm_proj_phase(p, l, smem);
    xcd_barrier(xb);
    attn_phase(p, l, smem);
    mix_local_phase(p, l, smem);
    xcd_barrier(xb);
    scan_phase(p, l);
    xcd_barrier(xb);
    mix_final_phase(p, l, smem);
    xcd_barrier(xb);
    gemm_out_phase(p, l, xsrc, smem);
    xcd_barrier(xb);
    gemm_q_phase(p, l, smem);
    xcd_barrier(xb);
    peer_phase(p, l, l == DEPTH_ - 1, smem);
    xcd_barrier(xb);
  }
}

extern "C" void kernel_launch(void* const* d_in, const int* in_sizes, int n_in,
                              void* d_out, int out_size, void* d_ws, size_t ws_size,
                              hipStream_t stream) {
  static int grid_blocks = 0;
  if (grid_blocks == 0) {
    if (n_in != 24 || ws_size < WS_END) { fprintf(stderr, "kernel_launch: unexpected n_in %d / ws_size %zu (need %zu)\n", n_in, ws_size, (size_t)WS_END); grid_blocks = -1; return; }
    int dev = 0, cus = 0, per_cu = 0;
    if (hipGetDevice(&dev) != hipSuccess || hipDeviceGetAttribute(&cus, hipDeviceAttributeMultiprocessorCount, dev) != hipSuccess) { grid_blocks = -1; return; }
    if (hipFuncSetAttribute((const void*)fwd_megakernel, hipFuncAttributeMaxDynamicSharedMemorySize, LDS_BYTES) != hipSuccess) { fprintf(stderr, "hipFuncSetAttribute failed\n"); grid_blocks = -1; return; }
    if (hipOccupancyMaxActiveBlocksPerMultiprocessor(&per_cu, (const void*)fwd_megakernel, NT, LDS_BYTES) != hipSuccess || per_cu < 1) { fprintf(stderr, "occupancy query: %d\n", per_cu); grid_blocks = -1; return; }
    grid_blocks = cus;
  }
  if (grid_blocks < 0) return;
  Params p{};
  for (int i = 0; i < 24; ++i) p.in[i] = (const GAS float*)d_in[i];
  p.out = (GAS float*)d_out; p.ws = (GAS unsigned char*)d_ws;
  void* args[] = {&p};
  hipError_t e = hipLaunchCooperativeKernel((void*)fwd_megakernel, dim3(grid_blocks), dim3(NT), args, LDS_BYTES, stream);
  if (e != hipSuccess) fprintf(stderr, "cooperative launch failed: %s (grid %d)\n", hipGetErrorString(e), grid_blocks);
}
```

```cpp
#include <hip/hip_runtime.h>
#include <hip/hip_cooperative_groups.h>
#include <cstdio>
#include <cstdint>
namespace cg = cooperative_groups;

typedef unsigned short bf16_t;
typedef short bf16x8 __attribute__((ext_vector_type(8)));
typedef float f32x4 __attribute__((ext_vector_type(4)));
typedef float f32x16 __attribute__((ext_vector_type(16)));
typedef int i32x8 __attribute__((ext_vector_type(8)));

constexpr int T_ = 16384, D_ = 1024, L_ = 8192, NBATCH = 2, DEPTH_ = 4;
constexpr int INC = 2944, INCP = 3072;
constexpr int NCH = 128;
constexpr int NT = 512;
constexpr int NW = 8;
constexpr float EPS_ = 1e-6f;
constexpr int C_QA = 0, C_KA = 384, C_VA = 768, C_QR = 1152, C_KR = 1536, C_VR = 1920, C_GR = 2304, C_US = 2688;

constexpr size_t al256(size_t x) { return (x + 255) & ~(size_t)255; }
constexpr size_t WS_MOD   = 0;
constexpr size_t WS_ROTC  = al256(WS_MOD + 4ull * 2 * 6144 * 4);
constexpr size_t WS_ROTS  = al256(WS_ROTC + 8192ull * 32 * 4);
constexpr size_t WS_SA    = al256(WS_ROTS + 8192ull * 32 * 4);
constexpr size_t WS_SBB   = al256(WS_SA + 4ull * 16 * 64 * 2 * 4);
constexpr size_t WS_WIN   = al256(WS_SBB + 4ull * 16 * 64 * 32 * 4);
constexpr size_t WS_WOUT  = al256(WS_WIN + 4ull * INCP * 1024 * 2);
constexpr size_t WS_WQ    = al256(WS_WOUT + 4ull * 1024 * 1024 * 2);
constexpr size_t WS_SUBK  = al256(WS_WQ + 4ull * 2048 * 1024 * 2);
constexpr size_t WS_ABUF  = al256(WS_SUBK + 4ull * 16 * 128 * 128 * 2);
constexpr size_t WS_PROJ  = al256(WS_ABUF + (size_t)T_ * 1024 * 2);
constexpr size_t WS_VTA   = al256(WS_PROJ + (size_t)T_ * INCP * 2);
constexpr size_t WS_ATT   = al256(WS_VTA + 2ull * 6 * 64 * 8192 * 2);
constexpr size_t WS_YINT  = al256(WS_ATT + (size_t)T_ * 384 * 4);
constexpr size_t WS_UPD   = al256(WS_YINT + (size_t)T_ * 384 * 4);
constexpr size_t WS_SPREV = al256(WS_UPD + 256ull * 6 * 4096 * 4);
constexpr size_t WS_SEND  = al256(WS_SPREV + 256ull * 6 * 4096 * 4);
constexpr size_t WS_CARRY = al256(WS_SEND + 256ull * 16 * 64 * 2 * 4);
constexpr size_t WS_X     = al256(WS_CARRY + 256ull * 16 * 64 * 2 * 4);
constexpr size_t WS_Q     = al256(WS_X + (size_t)T_ * 1024 * 4);
constexpr size_t WS_SC    = al256(WS_Q + (size_t)T_ * 2048 * 2);
constexpr size_t WS_EIDX  = al256(WS_SC + (size_t)T_ * 2048 * 4);
constexpr size_t WS_EGATE = al256(WS_EIDX + (size_t)T_ * 128 * 4);
constexpr size_t WS_PU8   = al256(WS_EGATE + (size_t)T_ * 128 * 4);
constexpr size_t WS_PV8   = al256(WS_PU8 + 4ull * 16384 * 1024);
constexpr size_t WS_BAR   = al256(WS_PV8 + 4ull * 16384 * 1024);
constexpr size_t WS_SPT   = al256(WS_BAR + 3456ull * 4);
constexpr size_t WS_CB    = al256(WS_SPT + 256ull * 6 * 4096 * 2);
constexpr size_t WS_WGLUT = al256(WS_CB + 4ull * 16 * 16 * 128 * 2);
constexpr size_t WS_VTR   = al256(WS_WGLUT + 4ull * 512 * 256 * 2);
constexpr size_t WS_XG    = al256(WS_VTR + 2ull * 384 * 8192 * 2);
constexpr size_t WS_SSQ   = al256(WS_XG + (size_t)T_ * 1024 * 2);
constexpr size_t WS_C2    = al256(WS_SSQ + (size_t)T_ * 16 * 4);
constexpr size_t WS_BBH   = al256(WS_C2 + 4ull * 2 * 2048 * 4);
constexpr size_t WS_END   = al256(WS_BBH + 4ull * 16 * 2 * 64 * 16 * 2);

constexpr int LDS_BYTES = 135168;

#define GAS __attribute__((address_space(1)))
struct Params {
  const GAS float* in[24];
  GAS float* out;
  GAS unsigned char* ws;
};
enum { I_X = 0, I_C, I_WADA, I_BADA, I_NMIX, I_NFFN, I_WIN, I_RELB, I_LRE, I_LIM, I_LOGDT, I_BRE, I_BIM, I_CRE, I_CIM, I_SSMD,
       I_WGLU, I_MGAIN, I_WOUT, I_WQ, I_SUBK, I_PU, I_PV, I_FNORM };

__device__ __forceinline__ float bf2f(bf16_t v) { return __uint_as_float(((unsigned)v) << 16); }
__device__ __forceinline__ bf16_t f2bf(float f) { unsigned u = __float_as_uint(f); u += 0x7fffu + ((u >> 16) & 1u); return (bf16_t)(u >> 16); }
__device__ __forceinline__ unsigned pk2(float a, float b) { return (unsigned)f2bf(a) | ((unsigned)f2bf(b) << 16); }
__device__ __forceinline__ float wave_sum(float v) {
#pragma unroll
  for (int o = 32; o > 0; o >>= 1) v += __shfl_xor(v, o);
  return v;
}
__device__ __forceinline__ float wave_max(float v) {
#pragma unroll
  for (int o = 32; o > 0; o >>= 1) v = fmaxf(v, __shfl_xor(v, o));
  return v;
}
__device__ __forceinline__ float gelu_tanh(float x) { const float u = 0.7978845608028654f * (x + 0.044715f * x * x * x); return 0.5f * x * (1.f + tanhf(u)); }
__device__ __forceinline__ float sigmoid_f(float x) { return 1.f / (1.f + __expf(-x)); }
__device__ __forceinline__ float gelu_tanh_fast(float x) {
  const float u2 = 2.f * 0.7978845608028654f * 1.4426950408889634f * (x + 0.044715f * x * x * x);
  const float e = __builtin_amdgcn_exp2f(fminf(u2, 80.f));
  return x - x * __builtin_amdgcn_rcpf(1.f + e);
}
__device__ __forceinline__ GAS unsigned char* launder_ptr(GAS unsigned char* q) { asm volatile("" : "+s"(q)); return q; }
__device__ __forceinline__ const float* gin(const GAS float* q) { return (const float*)q; }
__device__ __forceinline__ const float* launder_cptr(const float* q) { asm volatile("" : "+s"(q)); return q; }
__device__ __forceinline__ int launder_tid() { int t = threadIdx.x; asm volatile("" : "+v"(t)); return t; }
typedef const Params __attribute__((address_space(4)))* CParamsP;
__device__ __forceinline__ CParamsP launder_kargs() { CParamsP q = (CParamsP)__builtin_amdgcn_kernarg_segment_ptr(); asm volatile("" : "+s"(q)); return q; }

__device__ __forceinline__ void convert_tables_fp4(const CParamsP pp, GAS unsigned char* ws, int layer, int gtid, int gn) {
  constexpr size_t NIT = 16384ull * 1024 / 16;
  for (size_t it = gtid; it < 2 * NIT; it += gn) {
    const int tb = it >= NIT ? 1 : 0; const size_t r = (it - (size_t)tb * NIT) + (size_t)layer * NIT;
    const f32x4* src = (const f32x4*)((tb ? gin(pp->in[I_PV]) : gin(pp->in[I_PU])) + r * 16);
    const float sc = tb ? 4.f : 64.f;
    unsigned o[2] = {0u, 0u};
#pragma unroll
    for (int q = 0; q < 4; ++q) {
      const f32x4 a = src[q];
      const float x0 = fminf(fmaxf(a.x * sc, -6.f), 6.f), x1 = fminf(fmaxf(a.y * sc, -6.f), 6.f);
      const float x2 = fminf(fmaxf(a.z * sc, -6.f), 6.f), x3 = fminf(fmaxf(a.w * sc, -6.f), 6.f);
      if (q == 0)      { o[0] = __builtin_amdgcn_cvt_scalef32_pk_fp4_f32(o[0], x0, x1, 1.0f, 0); o[0] = __builtin_amdgcn_cvt_scalef32_pk_fp4_f32(o[0], x2, x3, 1.0f, 1); }
      else if (q == 1) { o[0] = __builtin_amdgcn_cvt_scalef32_pk_fp4_f32(o[0], x0, x1, 1.0f, 2); o[0] = __builtin_amdgcn_cvt_scalef32_pk_fp4_f32(o[0], x2, x3, 1.0f, 3); }
      else if (q == 2) { o[1] = __builtin_amdgcn_cvt_scalef32_pk_fp4_f32(o[1], x0, x1, 1.0f, 0); o[1] = __builtin_amdgcn_cvt_scalef32_pk_fp4_f32(o[1], x2, x3, 1.0f, 1); }
      else             { o[1] = __builtin_amdgcn_cvt_scalef32_pk_fp4_f32(o[1], x0, x1, 1.0f, 2); o[1] = __builtin_amdgcn_cvt_scalef32_pk_fp4_f32(o[1], x2, x3, 1.0f, 3); }
    }
    *(uint2*)(ws + (tb ? WS_PV8 : WS_PU8) + r * 8) = make_uint2(o[0], o[1]);
  }
}

__device__ void setup_phase(const Params& p, unsigned char* smem) {
  const CParamsP pp = launder_kargs();
  GAS unsigned char* const ws = launder_ptr(pp->ws); const int tidx = launder_tid(); (void)ws; (void)tidx;
  const int tid = tidx;
  float* sm = (float*)smem;
  {
    float* cond = sm;
    float* red = sm + 2048;
    float* MOD = (float*)(ws + WS_MOD);
    for (int i = tid; i < 2048; i += NT) { const float c = gin(pp->in[I_C])[i]; cond[i] = c * sigmoid_f(c); }
    __syncthreads();
    for (int item = blockIdx.x; item < 4 * 96; item += gridDim.x) {
      const int l = item / 96, cb = item % 96, kq = tid >> 6, jj = tid & 63, j = cb * 64 + jj;
      const float* w = gin(pp->in[I_WADA]) + (size_t)l * 1024 * 6144 + j;
      float a0 = 0.f, a1 = 0.f;
#pragma unroll 16
      for (int k = kq * 128; k < kq * 128 + 128; ++k) { const float wv = w[(size_t)k * 6144]; a0 += cond[k] * wv; a1 += cond[1024 + k] * wv; }
      red[(kq * 2 + 0) * 64 + jj] = a0; red[(kq * 2 + 1) * 64 + jj] = a1;
      __syncthreads();
      if (tid < 128) {
        const int b = tid >> 6, j2 = tid & 63; float s = 0.f;
        for (int q = 0; q < 8; ++q) s += red[(q * 2 + b) * 64 + j2];
        MOD[((size_t)l * 2 + b) * 6144 + cb * 64 + j2] = s + gin(pp->in[I_BADA])[(size_t)l * 6144 + cb * 64 + j2];
      }
      __syncthreads();
    }
  }
  const int gtid = blockIdx.x * NT + tid, gn = gridDim.x * NT;
  {
    float* RC = (float*)(ws + WS_ROTC); float* RS = (float*)(ws + WS_ROTS);
    for (int idx = gtid; idx < 8192 * 32; idx += gn) {
      const int pos = idx >> 5, i = idx & 31;
      const float inv = powf(10000.0f, -(float)i / 32.0f);
      const float ang = (float)pos * inv;
      float s, c; sincosf(ang, &s, &c);
      RC[idx] = c; RS[idx] = s;
    }
  }
  {
    float* SA = (float*)(ws + WS_SA); float* SBB = (float*)(ws + WS_SBB); bf16_t* BBH = (bf16_t*)(ws + WS_BBH);
    for (int idx = gtid; idx < 4 * 16 * 64; idx += gn) {
      const int l = idx / 1024, g = (idx >> 6) & 15;
      const float dt = expf(gin(pp->in[I_LOGDT])[l * 16 + g]);
      const float lr = gin(pp->in[I_LRE])[idx], li = gin(pp->in[I_LIM])[idx];
      const float mag = expf(lr * dt);
      float sn, cs; sincosf(li * dt, &sn, &cs);
      const float are = mag * cs, aim = mag * sn;
      const float den = lr * lr + li * li, nr = are - 1.f, ni = aim;
      const float fre = (nr * lr + ni * li) / den, fim = (ni * lr - nr * li) / den;
      SA[idx * 2] = are; SA[idx * 2 + 1] = aim;
      for (int c = 0; c < 16; ++c) {
        const float br = gin(pp->in[I_BRE])[(size_t)idx * 16 + c], bi = gin(pp->in[I_BIM])[(size_t)idx * 16 + c];
        SBB[(size_t)idx * 32 + c] = fre * br - fim * bi;
        SBB[(size_t)idx * 32 + 16 + c] = fre * bi + fim * br;
        {
          const int pq = idx & 63; const size_t fb = (size_t)(idx >> 6) * 2;
          BBH[(((fb + 0) * 2 + (pq >> 5)) * 64 + 32 * (c >> 3) + (pq & 31)) * 8 + (c & 7)] = f2bf(fre * br - fim * bi);
          BBH[(((fb + 1) * 2 + (pq >> 5)) * 64 + 32 * (c >> 3) + (pq & 31)) * 8 + (c & 7)] = f2bf(fre * bi + fim * br);
        }
      }
    }
  }
  {
    bf16_t* CB = (bf16_t*)(ws + WS_CB);
    for (int idx = gtid; idx < 4 * 16 * 16 * 128; idx += gn) {
      const int k = idx & 127, lgc = idx >> 7;
      const bf16_t cv = (k < 64) ? f2bf(gin(pp->in[I_CRE])[(size_t)lgc * 64 + k]) : f2bf(-gin(pp->in[I_CIM])[(size_t)lgc * 64 + (k - 64)]);
      const int cc = lgc & 15, lg = lgc >> 4;
      CB[(((size_t)lg * 4 + (k >> 5)) * 64 + ((k >> 3) & 3) * 16 + cc) * 8 + (k & 7)] = cv;
    }
    bf16_t* WG = (bf16_t*)(ws + WS_WGLUT);
    for (int idx = gtid; idx < 4 * 512 * 256; idx += gn) {
      const int k = idx & 255, nn = (idx >> 8) & 511, l2 = idx >> 17;
      {
        const int which = nn >> 8, w8 = (nn >> 5) & 7, nt = (nn >> 4) & 1, frr = nn & 15, ks = k >> 5, fqq = (k >> 3) & 3, j = k & 7;
        WG[(((((size_t)l2 * 8 + w8) * 8 + ks) * 2 + which) * 2 + nt) * 512 + (fqq * 16 + frr) * 8 + j] = f2bf(gin(pp->in[I_WGLU])[((size_t)l2 * 256 + k) * 512 + nn]);
      }
    }
  }
  convert_tables_fp4(pp, ws, 0, gtid, gn);
  {
    __syncthreads();
    const int lane = tid & 63, wid = tid >> 6;
    float* scr = sm + wid * (64 * 33);
    constexpr int IT_IN = 16 * 96, IT_OUT = 16 * 32, IT_L = IT_IN + IT_OUT;
    for (int item = blockIdx.x * NW + wid; item < 4 * IT_L; item += gridDim.x * NW) {
      const int l = item / IT_L; int r = item - l * IT_L;
      const float* W; bf16_t* WT; int N, NP;
      if (r < IT_IN) { W = gin(pp->in[I_WIN]) + (size_t)l * 1024 * INC; WT = (bf16_t*)(ws + WS_WIN) + (size_t)l * INCP * 1024; N = INC; NP = 96; }
      else { r -= IT_IN; W = gin(pp->in[I_WOUT]) + (size_t)l * 1024 * 1024; WT = (bf16_t*)(ws + WS_WOUT) + (size_t)l * 1024 * 1024; N = 1024; NP = 32; }
      const int kb = r / NP, nb = r - kb * NP, k0 = kb * 64, n0 = nb * 32;
      const int nn = n0 + (lane & 31); const bool inb = nn < N;
      float v[32];
#pragma unroll
      for (int i = 0; i < 32; ++i) { const int kk = 2 * i + (lane >> 5); v[i] = inb ? W[(size_t)(k0 + kk) * N + nn] : 0.f; }
#pragma unroll
      for (int i = 0; i < 32; ++i) { const int kk = 2 * i + (lane >> 5); scr[kk * 33 + (lane & 31)] = v[i]; }
      const int c = lane & 7;
#pragma unroll
      for (int j = 0; j < 4; ++j) {
        const int n = (lane >> 3) + 8 * j; const float* sp = scr + (8 * c) * 33 + n;
        uint4 o; o.x = pk2(sp[0], sp[33]); o.y = pk2(sp[2 * 33], sp[3 * 33]); o.z = pk2(sp[4 * 33], sp[5 * 33]); o.w = pk2(sp[6 * 33], sp[7 * 33]);
        *(uint4*)(WT + (size_t)(n0 + n) * 1024 + k0 + 8 * c) = o;
      }
    }
    __syncthreads();
  }
  {
    float* WtT = sm;
    float* SKs = sm + 128 * 65;
    bf16_t* WP = (bf16_t*)(ws + WS_WQ);
    for (int item = blockIdx.x; item < 4 * 16 * 16; item += gridDim.x) {
      const int l = item >> 8, hs = (item >> 4) & 15, kb = item & 15, k0 = kb * 64;
      const float* Wq = gin(pp->in[I_WQ]) + (size_t)l * 1024 * 2048 + hs * 128;
      const float* SKg = gin(pp->in[I_SUBK]) + ((size_t)l * 16 + hs) * 128 * 128;
      __syncthreads();
#pragma unroll
      for (int i = 0; i < 16; ++i) { const int idx = tid + NT * i, kk = idx >> 7, d = idx & 127; WtT[d * 65 + kk] = Wq[(size_t)(k0 + kk) * 2048 + d]; }
#pragma unroll
      for (int i = 0; i < 32; ++i) { const int idx = tid + NT * i, key = idx >> 7, d = idx & 127; SKs[key * 129 + d] = SKg[idx]; }
      __syncthreads();
      const int key = tid & 127, kg = tid >> 7;
      float acc[16];
#pragma unroll
      for (int i = 0; i < 16; ++i) acc[i] = 0.f;
#pragma unroll 4
      for (int d = 0; d < 128; ++d) {
        const float sv = SKs[key * 129 + d];
#pragma unroll
        for (int i = 0; i < 16; ++i) acc[i] += sv * WtT[d * 65 + kg * 16 + i];
      }
      uint4 o0, o1;
      o0.x = pk2(acc[0], acc[1]); o0.y = pk2(acc[2], acc[3]); o0.z = pk2(acc[4], acc[5]); o0.w = pk2(acc[6], acc[7]);
      o1.x = pk2(acc[8], acc[9]); o1.y = pk2(acc[10], acc[11]); o1.z = pk2(acc[12], acc[13]); o1.w = pk2(acc[14], acc[15]);
      bf16_t* dst = WP + ((size_t)l * 2048 + hs * 128 + key) * 1024 + k0 + kg * 16;
      *(uint4*)dst = o0; *(uint4*)(dst + 8) = o1;
    }
    __syncthreads();
  }
}

__device__ void qbias_phase(const Params& p, unsigned char* smem) {
  const CParamsP pp = launder_kargs();
  GAS unsigned char* const ws = launder_ptr(pp->ws); const int tid = launder_tid();
  float* C2 = (float*)(ws + WS_C2); const float* MOD = (const float*)(ws + WS_MOD); const bf16_t* WP = (const bf16_t*)(ws + WS_WQ);
  const int lane = tid & 63, gw = blockIdx.x * NW + (tid >> 6), nw = gridDim.x * NW;
  for (int o = gw; o < 4 * 2048; o += nw) {
    const int l = o >> 11;
    const uint4 w0 = *(const uint4*)(WP + (size_t)o * 1024 + lane * 16), w1 = *(const uint4*)(WP + (size_t)o * 1024 + lane * 16 + 8);
    const unsigned ww[8] = {w0.x, w0.y, w0.z, w0.w, w1.x, w1.y, w1.z, w1.w};
    const float* s0 = MOD + (size_t)l * 2 * 6144 + 3072 + lane * 16; const float* s1 = s0 + 6144;
    float a0 = 0.f, a1 = 0.f;
#pragma unroll
    for (int q = 0; q < 8; ++q) {
      const float wl = __uint_as_float(ww[q] << 16), wh = __uint_as_float(ww[q] & 0xffff0000u);
      a0 += s0[2 * q] * wl + s0[2 * q + 1] * wh; a1 += s1[2 * q] * wl + s1[2 * q + 1] * wh;
    }
    a0 = wave_sum(a0); a1 = wave_sum(a1);
    if (lane == 0) { C2[((size_t)l * 2 + 0) * 2048 + (o & 2047)] = a0; C2[((size_t)l * 2 + 1) * 2048 + (o & 2047)] = a1; }
  }
  (void)smem;
}

__device__ void norm_mod_phase(const float* __restrict__ xsrc, const float* __restrict__ gain, const float* __restrict__ mod_sh, const float* __restrict__ mod_sc,
                               bf16_t* __restrict__ outp) {
  const int tidx = launder_tid();
  const int lane = tidx & 63, gw = blockIdx.x * NW + (tidx >> 6), nw = gridDim.x * NW;
  for (int t = gw; t < T_; t += nw) {
    const int b = t >> 13;
    const f32x4* xr = (const f32x4*)(xsrc + (size_t)t * 1024) + lane;
    f32x4 v[4]; float s = 0.f;
#pragma unroll
    for (int j = 0; j < 4; ++j) { v[j] = xr[64 * j]; s += v[j].x * v[j].x + v[j].y * v[j].y + v[j].z * v[j].z + v[j].w * v[j].w; }
    const float rstd = rsqrtf(wave_sum(s) * (1.f / 1024.f) + EPS_);
#pragma unroll
    for (int j = 0; j < 4; ++j) {
      const int c = lane * 4 + 256 * j;
      const f32x4 g = *(const f32x4*)(gain + c), sh = *(const f32x4*)(mod_sh + b * 6144 + c), sc = *(const f32x4*)(mod_sc + b * 6144 + c);
      const float o0 = v[j].x * rstd * g.x * (1.f + sc.x) + sh.x, o1 = v[j].y * rstd * g.y * (1.f + sc.y) + sh.y;
      const float o2 = v[j].z * rstd * g.z * (1.f + sc.z) + sh.z, o3 = v[j].w * rstd * g.w * (1.f + sc.w) + sh.w;
      uint2 o; o.x = pk2(o0, o1); o.y = pk2(o2, o3);
      *(uint2*)(outp + (size_t)t * 1024 + c) = o;
    }
  }
}


namespace pg8 {
#define PG8_LAS __attribute__((address_space(3)))
typedef unsigned u32x4 __attribute__((ext_vector_type(4)));
constexpr int BM = 256, BK = 64, HALF = 128, HTB = HALF * BK * 2, STAGE_BYTES = 8 * HTB, NXCD = 8, WGM = 8;
__host__ __device__ __forceinline__ int lds_byte(int r, int c) { const int st = (r >> 4) * 2 + (c >> 5), rr = r & 15, cc = c & 31, ob = rr * 64 + cc * 2; return st * 1024 + (ob ^ (((ob >> 9) & 1) << 5)); }
__host__ __device__ __forceinline__ void stage_rc(int b, int& R, int& C) { const int st = b / 1024, sb = b % 1024, swz = sb ^ (((sb >> 9) & 1) << 5); R = (st >> 1) * 16 + swz / 64; C = (st & 1) * 32 + (swz % 64) / 2; }
__host__ __device__ __forceinline__ int perm32(int rho) { const int n = rho >> 4, i = rho & 15; return 8 * (i >> 2) + 4 * n + (i & 3); }
struct Unit { int pm, pn; };
struct Gemm { const bf16_t* A; const bf16_t* Bt; int M, N, K; };
struct StaticOrder {
    int nM, nN, nwg, G, c;
    __host__ __device__ void init(int M, int N, int G_, int c_) { nM = M / BM; nN = N / BM; nwg = nM * nN; G = G_; c = c_; }
    __host__ __device__ bool next(int i, Unit& u) const {
        const long L = (long)i * G + c; if (L >= nwg) return false;
        int wgid = (int)L; { const int q = nwg / NXCD, r = nwg % NXCD, xcd = wgid % NXCD, off = wgid / NXCD; wgid = (xcd < r ? xcd * (q + 1) : r * (q + 1) + (xcd - r) * q) + off; }
        const int nig = WGM * nN, gid = wgid / nig, fm = gid * WGM, gsz = (nM - fm) < WGM ? (nM - fm) : WGM;
        u.pm = fm + ((wgid % nig) % gsz); u.pn = (wgid % nig) / gsz; return true;
    }
    __device__ __forceinline__ void a_ready(const Unit&) const {}
    __device__ __forceinline__ void done(const Unit&) const {}
};
__device__ __forceinline__ unsigned cvt_pk_bf16(float lo, float hi) { unsigned r; asm volatile("v_cvt_pk_bf16_f32 %0, %1, %2" : "=v"(r) : "v"(lo), "v"(hi)); return r; }
template <class Epi, class Sched>
__device__ __forceinline__ void gemm_phase(PG8_LAS unsigned char* lds, const Gemm g, const Sched& S, const Epi& E) {
    const int tid = launder_tid(), wid = __builtin_amdgcn_readfirstlane(tid >> 6), lane = tid & 63, wr = wid >> 2, wc = wid & 3, fr = lane & 15, fq = lane >> 4;
    const int K = g.K, nt = K / BK;
    unsigned voffA[2], voffB[2];
#pragma unroll
    for (int i = 0; i < 2; ++i) { int R, C; stage_rc(tid * 16 + i * 8192, R, C); const int Rb = Epi::PERM ? ((R & ~31) + perm32(R & 31)) : R;
        voffA[i] = (unsigned)(R * K + C) * 2u; voffB[i] = (unsigned)(Rb * K + C) * 2u; }
    const size_t kstep = (size_t)(BK * 2);
    const size_t hstep = (size_t)HALF * K * 2;
    const size_t tstep = 2 * hstep;
    const unsigned ldsw = (unsigned)wid * 1024u;
    const int aoff = lds_byte(wr * 64 + fr, fq * 8), boff = lds_byte(wc * 32 + fr, fq * 8);
#define PG8_SA(b, h) (((b) * 2 + (h)) * HTB)
#define PG8_SB(b, h) ((4 + (b) * 2 + (h)) * HTB)
#define PG8_STAGE(bufoff, gbase, voff) do { _Pragma("unroll") for (int _i = 0; _i < 2; ++_i) \
        __builtin_amdgcn_global_load_lds((const unsigned*)((const char*)(gbase) + (voff)[_i]), (PG8_LAS unsigned*)(lds + (bufoff) + ldsw + _i * 8192), 16, 0, 0); } while (0)
#define PG8_LDA(dst, b, h) do { _Pragma("unroll") for (int m = 0; m < 4; ++m) _Pragma("unroll") for (int k = 0; k < 2; ++k) dst[m][k] = *(const PG8_LAS bf16x8*)(lds + PG8_SA(b, h) + aoff + m * 2048 + k * 1024); } while (0)
#define PG8_LDB(dst, b, h) do { _Pragma("unroll") for (int n = 0; n < 2; ++n) _Pragma("unroll") for (int k = 0; k < 2; ++k) dst[n][k] = *(const PG8_LAS bf16x8*)(lds + PG8_SB(b, h) + boff + n * 2048 + k * 1024); } while (0)
#define PG8_MMA(ai, bj, At, Bt) do { __builtin_amdgcn_s_setprio(1); _Pragma("unroll") for (int m = 0; m < 4; ++m) _Pragma("unroll") for (int n = 0; n < 2; ++n) _Pragma("unroll") for (int k = 0; k < 2; ++k) \
        acc[ai][bj][m][n] = __builtin_amdgcn_mfma_f32_16x16x32_bf16(Bt[n][k], At[m][k], acc[ai][bj][m][n], 0, 0, 0); __builtin_amdgcn_s_setprio(0); } while (0)
#define PG8_WAIT_V(n) asm volatile("s_waitcnt vmcnt(" #n ")" ::: "memory")
#define PG8_WAIT_L(n) asm volatile("s_waitcnt lgkmcnt(" #n ")" ::: "memory")
#define PG8_BAR __builtin_amdgcn_s_barrier()
#define PG8_SCHED __builtin_amdgcn_sched_barrier(0)
    Unit cur, nxt; int ui = 0;
    if (!S.next(0, cur)) return;
    f32x4 acc[2][2][4][2];
#pragma unroll
    for (int a = 0; a < 2; ++a)
#pragma unroll
        for (int b = 0; b < 2; ++b)
#pragma unroll
            for (int m = 0; m < 4; ++m)
#pragma unroll
                for (int n = 0; n < 2; ++n) acc[a][b][m][n] = (f32x4){0.f, 0.f, 0.f, 0.f};
    bf16x8 At[4][2], B0[2][2], B1[2][2];
    const char* cA = (const char*)g.A + (size_t)cur.pm * tstep; const char* cB = (const char*)g.Bt + (size_t)cur.pn * tstep;
    S.a_ready(cur);
    PG8_STAGE(PG8_SB(0, 0), cB, voffB); PG8_STAGE(PG8_SA(0, 0), cA, voffA); PG8_STAGE(PG8_SB(0, 1), cB + hstep, voffB); PG8_STAGE(PG8_SA(0, 1), cA + hstep, voffA);
    if (wr == 1) PG8_BAR;
    PG8_WAIT_V(4); PG8_BAR;
    PG8_STAGE(PG8_SB(1, 0), cB + kstep, voffB); PG8_STAGE(PG8_SA(1, 0), cA + kstep, voffA); PG8_STAGE(PG8_SB(1, 1), cB + hstep + kstep, voffB);
    PG8_WAIT_V(6); PG8_BAR;
    for (;;) {
        const bool has_next = S.next(ui + 1, nxt);
        const char* nA = has_next ? (const char*)g.A + (size_t)nxt.pm * tstep : cA; const char* nB = has_next ? (const char*)g.Bt + (size_t)nxt.pn * tstep : cB;
        for (int t = 0; t < nt; t += 2) {
            const bool last = (t == nt - 2);
            const char* a1 = cA + (size_t)(t + 1) * kstep;
            const char* a2 = last ? nA : cA + (size_t)(t + 2) * kstep; const char* b2 = last ? nB : cB + (size_t)(t + 2) * kstep;
            const char* a3 = a2 + kstep; const char* b3 = b2 + kstep;
            if (last && has_next) S.a_ready(nxt);
            PG8_LDB(B0, 0, 0); PG8_SCHED; PG8_LDA(At, 0, 0); PG8_STAGE(PG8_SA(1, 1), a1 + hstep, voffA);
            PG8_WAIT_L(8); PG8_BAR; PG8_WAIT_L(0); PG8_MMA(0, 0, At, B0); PG8_BAR; PG8_SCHED;
            PG8_LDB(B1, 0, 1); PG8_STAGE(PG8_SB(0, 0), b2, voffB);
            PG8_BAR; PG8_WAIT_L(0); PG8_MMA(0, 1, At, B1); PG8_BAR;
            PG8_LDA(At, 0, 1); PG8_STAGE(PG8_SA(0, 0), a2, voffA);
            PG8_BAR; PG8_WAIT_L(0); PG8_MMA(1, 0, At, B0); PG8_BAR; PG8_SCHED;
            PG8_STAGE(PG8_SB(0, 1), b2 + hstep, voffB);
            PG8_WAIT_V(6); PG8_BAR; PG8_MMA(1, 1, At, B1); PG8_BAR;
            PG8_LDB(B0, 1, 0); PG8_SCHED; PG8_LDA(At, 1, 0); PG8_STAGE(PG8_SA(0, 1), a2 + hstep, voffA);
            PG8_WAIT_L(8); PG8_BAR; PG8_WAIT_L(0); PG8_MMA(0, 0, At, B0); PG8_BAR; PG8_SCHED;
            PG8_LDB(B1, 1, 1); PG8_STAGE(PG8_SB(1, 0), b3, voffB);
            PG8_BAR; PG8_WAIT_L(0); PG8_MMA(0, 1, At, B1); PG8_BAR;
            PG8_LDA(At, 1, 1); PG8_STAGE(PG8_SA(1, 0), a3, voffA);
            PG8_BAR; PG8_WAIT_L(0); PG8_MMA(1, 0, At, B0); PG8_BAR; PG8_SCHED;
            PG8_STAGE(PG8_SB(1, 1), b3 + hstep, voffB);
            PG8_WAIT_V(6); PG8_BAR; PG8_MMA(1, 1, At, B1); PG8_BAR;
        }
        if constexpr (!Epi::AFTER_DRAIN) { E(acc, cur, wr, wc, fr, fq); S.done(cur); }
        if (!has_next) break;
#pragma unroll
        for (int a = 0; a < 2; ++a)
#pragma unroll
            for (int b = 0; b < 2; ++b)
#pragma unroll
                for (int m = 0; m < 4; ++m)
#pragma unroll
                    for (int n = 0; n < 2; ++n) acc[a][b][m][n] = (f32x4){0.f, 0.f, 0.f, 0.f};
        cur = nxt; cA = nA; cB = nB; ++ui;
    }
    PG8_WAIT_V(0);
    if (wr == 0) PG8_BAR;
    PG8_BAR;
    if constexpr (Epi::AFTER_DRAIN) { E.fused(acc, cur, wr, wc, fr, fq, lds, wid, lane); S.done(cur); }
#undef PG8_SA
#undef PG8_SB
#undef PG8_STAGE
#undef PG8_LDA
#undef PG8_LDB
#undef PG8_MMA
#undef PG8_WAIT_V
#undef PG8_WAIT_L
#undef PG8_BAR
#undef PG8_SCHED
}
}

__device__ __forceinline__ float ssq_total(const float* __restrict__ SSQ, int t) {
  const f32x4 a = *(const f32x4*)(SSQ + (size_t)t * 16), b = *(const f32x4*)(SSQ + (size_t)t * 16 + 4), c = *(const f32x4*)(SSQ + (size_t)t * 16 + 8), d = *(const f32x4*)(SSQ + (size_t)t * 16 + 12);
  return (((a.x + a.y) + (a.z + a.w)) + ((b.x + b.y) + (b.z + b.w))) + (((c.x + c.y) + (c.z + c.w)) + ((d.x + d.y) + (d.z + d.w)));
}
struct EpiProj {
  static constexpr bool PERM = true, AFTER_DRAIN = false;
  bf16_t* PROJ; bf16_t* VTA; bf16_t* VTR;
  __device__ __forceinline__ void operator()(const f32x4 (&acc)[2][2][4][2], const pg8::Unit& u, int wr, int wc, int fr, int fq) const {
    const int row0 = u.pm * 256 + wr * 64 + fr, col0 = u.pn * 256 + wc * 32 + 8 * fq;
#pragma unroll
    for (int ai = 0; ai < 2; ++ai)
#pragma unroll
      for (int m = 0; m < 4; ++m) {
        const int t = row0 + ai * 128 + m * 16;
#pragma unroll
        for (int bj = 0; bj < 2; ++bj) {
          const int c = col0 + bj * 128;
          const f32x4 v0 = acc[ai][bj][m][0], v1 = acc[ai][bj][m][1];
          pg8::u32x4 w; w.x = pg8::cvt_pk_bf16(v0[0], v0[1]); w.y = pg8::cvt_pk_bf16(v0[2], v0[3]); w.z = pg8::cvt_pk_bf16(v1[0], v1[1]); w.w = pg8::cvt_pk_bf16(v1[2], v1[3]);
          *(pg8::u32x4*)(PROJ + (size_t)t * INCP + c) = w;
          const bool isva = (c >= C_VA && c < C_VA + 384), isvr = (c >= C_VR && c < C_VR + 384);
          if (isva || isvr) {
            bf16_t* vt = (isva ? VTA : VTR) + ((size_t)(t >> 13) * 384 + (c - (isva ? C_VA : C_VR))) * 8192 + (t & 8191);
            vt[0] = (bf16_t)(w.x & 0xffffu); vt[8192] = (bf16_t)(w.x >> 16); vt[2 * 8192] = (bf16_t)(w.y & 0xffffu); vt[3 * 8192] = (bf16_t)(w.y >> 16);
            vt[4 * 8192] = (bf16_t)(w.z & 0xffffu); vt[5 * 8192] = (bf16_t)(w.z >> 16); vt[6 * 8192] = (bf16_t)(w.w & 0xffffu); vt[7 * 8192] = (bf16_t)(w.w >> 16);
          }
        }
      }
  }
};
struct EpiOut {
  static constexpr bool PERM = false, AFTER_DRAIN = false;
  const float* xsrc; float* X; const float* g1; const float* nf; const float* sc2; bf16_t* XG; float* SSQ;
  __device__ __forceinline__ void operator()(const f32x4 (&acc)[2][2][4][2], const pg8::Unit& u, int wr, int wc, int fr, int fq) const {
    const int row0 = u.pm * 256 + wr * 64 + fr, col0 = u.pn * 256 + wc * 32 + 4 * fq, b = (u.pm * 256) >> 13;
    f32x4 gg[2][2], gs[2][2];
#pragma unroll
    for (int bj = 0; bj < 2; ++bj)
#pragma unroll
      for (int n = 0; n < 2; ++n) {
        const int c = col0 + bj * 128 + n * 16;
        gg[bj][n] = *(const f32x4*)(g1 + b * 6144 + c);
        const f32x4 gf = *(const f32x4*)(nf + c), sc = *(const f32x4*)(sc2 + b * 6144 + c);
        gs[bj][n] = gf * (sc + 1.f);
      }
#pragma unroll
    for (int ai = 0; ai < 2; ++ai)
#pragma unroll
      for (int m = 0; m < 4; ++m) {
        const int t = row0 + ai * 128 + m * 16;
        float sq = 0.f;
#pragma unroll
        for (int bj = 0; bj < 2; ++bj)
#pragma unroll
          for (int n = 0; n < 2; ++n) {
            const int c = col0 + bj * 128 + n * 16;
            const f32x4 xv = *(const f32x4*)(xsrc + (size_t)t * 1024 + c);
            const f32x4 xn = xv + gg[bj][n] * acc[ai][bj][m][n];
            *(f32x4*)(X + (size_t)t * 1024 + c) = xn;
            const f32x4 xs = xn * gs[bj][n];
            uint2 o; o.x = pg8::cvt_pk_bf16(xs.x, xs.y); o.y = pg8::cvt_pk_bf16(xs.z, xs.w);
            *(uint2*)(XG + (size_t)t * 1024 + c) = o;
            sq += (xn.x * xn.x + xn.y * xn.y) + (xn.z * xn.z + xn.w * xn.w);
          }
        sq += __shfl_xor(sq, 16); sq += __shfl_xor(sq, 32);
        if (fq == 0) SSQ[(size_t)t * 16 + u.pn * 4 + wc] = sq;
      }
  }
};
struct EpiQ {
  static constexpr bool PERM = false, AFTER_DRAIN = false;
  float* SC4; const float* SSQ; const float* C2;
  __device__ __forceinline__ void operator()(const f32x4 (&acc)[2][2][4][2], const pg8::Unit& u, int wr, int wc, int fr, int fq) const {
    const int row0 = u.pm * 256 + wr * 64 + fr, col0 = u.pn * 256 + wc * 32 + 4 * fq, b = (u.pm * 256) >> 13;
    f32x4 cc[2][2];
#pragma unroll
    for (int bj = 0; bj < 2; ++bj)
#pragma unroll
      for (int n = 0; n < 2; ++n) cc[bj][n] = *(const f32x4*)(C2 + b * 2048 + col0 + bj * 128 + n * 16);
#pragma unroll
    for (int ai = 0; ai < 2; ++ai)
#pragma unroll
      for (int m = 0; m < 4; ++m) {
        const int t = row0 + ai * 128 + m * 16;
        const float rstd = rsqrtf(ssq_total(SSQ, t) * (1.f / 1024.f) + EPS_);
#pragma unroll
        for (int bj = 0; bj < 2; ++bj)
#pragma unroll
          for (int n = 0; n < 2; ++n) {
            const int c = col0 + bj * 128 + n * 16;
            *(f32x4*)(SC4 + ((size_t)(c >> 2) * T_ + t) * 4) = acc[ai][bj][m][n] * rstd + cc[bj][n];
          }
      }
  }
};

__device__ void gemm_proj_phase(const Params& p, int l, unsigned char* smem) {
  const CParamsP pp = launder_kargs();
  GAS unsigned char* const ws = launder_ptr(pp->ws);
  pg8::Gemm g; g.A = (const bf16_t*)(ws + WS_ABUF); g.Bt = (const bf16_t*)(ws + WS_WIN) + (size_t)l * INCP * 1024; g.M = T_; g.N = INCP; g.K = 1024;
  pg8::StaticOrder S; S.init(T_, INCP, gridDim.x, blockIdx.x);
  EpiProj E; E.PROJ = (bf16_t*)(ws + WS_PROJ); E.VTA = (bf16_t*)(ws + WS_VTA); E.VTR = (bf16_t*)(ws + WS_VTR);
  pg8::gemm_phase<EpiProj, pg8::StaticOrder>((PG8_LAS unsigned char*)smem, g, S, E);
}
__device__ void gemm_out_phase(const Params& p, int l, const float* __restrict__ xsrc, unsigned char* smem) {
  const CParamsP pp = launder_kargs();
  GAS unsigned char* const ws = launder_ptr(pp->ws);
  pg8::Gemm g; g.A = (const bf16_t*)(ws + WS_ABUF); g.Bt = (const bf16_t*)(ws + WS_WOUT) + (size_t)l * 1024 * 1024; g.M = T_; g.N = 1024; g.K = 1024;
  pg8::StaticOrder S; S.init(T_, 1024, gridDim.x, blockIdx.x);
  EpiOut E; E.xsrc = xsrc; E.X = (float*)(ws + WS_X); E.g1 = (const float*)(ws + WS_MOD) + (size_t)l * 2 * 6144 + 2048;
  E.nf = gin(pp->in[I_NFFN]) + (size_t)l * 1024; E.sc2 = (const float*)(ws + WS_MOD) + (size_t)l * 2 * 6144 + 4096; E.XG = (bf16_t*)(ws + WS_XG); E.SSQ = (float*)(ws + WS_SSQ);
  pg8::gemm_phase<EpiOut, pg8::StaticOrder>((PG8_LAS unsigned char*)smem, g, S, E);
}
__device__ void gemm_q_phase(const Params& p, int l, unsigned char* smem) {
  const CParamsP pp = launder_kargs();
  GAS unsigned char* const ws = launder_ptr(pp->ws);
  pg8::Gemm g; g.A = (const bf16_t*)(ws + WS_XG); g.Bt = (const bf16_t*)(ws + WS_WQ) + (size_t)l * 2048 * 1024; g.M = T_; g.N = 2048; g.K = 1024;
  pg8::StaticOrder S; S.init(T_, 2048, gridDim.x, blockIdx.x);
  EpiQ E; E.SC4 = (float*)(ws + WS_SC); E.SSQ = (const float*)(ws + WS_SSQ); E.C2 = (const float*)(ws + WS_C2) + (size_t)l * 2 * 2048;
  pg8::gemm_phase<EpiQ, pg8::StaticOrder>((PG8_LAS unsigned char*)smem, g, S, E);
}

__device__ __forceinline__ int attn_fk(int r) { return ((r >> 3) & 3) | (((r >> 1) & 1) << 2); }
__device__ __forceinline__ int attn_fv(int r) { return (r >> 1) & 7; }
__device__ void attn_phase(const Params& p, int l, unsigned char* smem) {
  const CParamsP pp = launder_kargs();
  GAS unsigned char* const ws = launder_ptr(pp->ws); const int tidx = launder_tid();
  const bf16_t* PROJ = (const bf16_t*)(ws + WS_PROJ); const bf16_t* VTA = (const bf16_t*)(ws + WS_VTA);
  float* ATT = (float*)(ws + WS_ATT);
  const int lane = tidx & 63, wid = tidx >> 6, fr = lane & 15, fq = lane >> 4;
  float* ext = (float*)smem;
  unsigned char* stg = smem + 15360;
  constexpr float LOG2E = 1.4426950408889634f;
  __syncthreads();
  for (int idx = tidx; idx < 6 * 640; idx += NT) {
    const int h = idx / 640, e = idx - h * 640; int d = e - 63; d = d > 256 ? 256 : d;
    ext[idx] = gin(pp->in[I_RELB])[((size_t)l * 6 + h) * 513 + d + 256] * LOG2E;
  }
  const int hh = wid >> 2, qb = wid & 3, iq = qb * 16 + fr;
  const int srow = tidx >> 3, sch = tidx & 7;
  for (int item = blockIdx.x; item < 256; item += gridDim.x) {
    const int b = item >> 7, n = item & 127, t0 = b * 8192 + n * 64;
    const int jc0 = n >= 8 ? 0 : 8 - n, nch = 9 - jc0, nst = 3 * nch;
    uint4 sa0, sa1, sa2, sa3, sb0, sb1, sb2, sb3;
#define ATTN_LOAD(S, st) do { const int _rd = (st) / nch, _jc = jc0 + (st) - _rd * nch, _m = n - 8 + _jc; \
      S##0 = *(const uint4*)(PROJ + (size_t)(b * 8192 + _m * 64 + srow) * INCP + C_KA + (2 * _rd) * 64 + sch * 8); \
      S##1 = *(const uint4*)(PROJ + (size_t)(b * 8192 + _m * 64 + srow) * INCP + C_KA + (2 * _rd + 1) * 64 + sch * 8); \
      S##2 = *(const uint4*)(VTA + ((size_t)b * 384 + (2 * _rd) * 64 + srow) * 8192 + _m * 64 + sch * 8); \
      S##3 = *(const uint4*)(VTA + ((size_t)b * 384 + (2 * _rd + 1) * 64 + srow) * 8192 + _m * 64 + sch * 8); } while (0)
#define ATTN_WRITE(S, buf) do { unsigned char* _bp = stg + (buf) * 32768; \
      *(uint4*)(_bp + srow * 128 + ((sch ^ attn_fk(srow)) << 4)) = S##0; \
      *(uint4*)(_bp + 8192 + srow * 128 + ((sch ^ attn_fk(srow)) << 4)) = S##1; \
      *(uint4*)(_bp + 16384 + srow * 128 + ((sch ^ attn_fv(srow)) << 4)) = S##2; \
      *(uint4*)(_bp + 24576 + srow * 128 + ((sch ^ attn_fv(srow)) << 4)) = S##3; } while (0)
    __syncthreads();
    ATTN_LOAD(sa, 0);
    ATTN_WRITE(sa, 0);
    if (1 < nst) ATTN_LOAD(sb, 1);
    __syncthreads();
    bf16x8 qf[2];
    f32x4 o[4];
    float mrun = -1e30f, lrun = 0.f;
    const float* exth = ext;
    auto attn_compute = [&](const int st) {
      const int rd = st / nch, jc = jc0 + st - rd * nch, h = 2 * rd + hh;
      if (jc == jc0) {
#pragma unroll
        for (int ds = 0; ds < 2; ++ds) qf[ds] = *(const bf16x8*)(PROJ + (size_t)(t0 + iq) * INCP + C_QA + h * 64 + ds * 32 + fq * 8);
#pragma unroll
        for (int et = 0; et < 4; ++et) o[et] = (f32x4){0.f, 0.f, 0.f, 0.f};
        mrun = -1e30f; lrun = 0.f;
        exth = ext + h * 640 + 63 + 512 + iq - 8 * fq;
      }
      const unsigned char* kb = stg + (st & 1) * 32768 + hh * 8192;
      const unsigned char* vb = stg + (st & 1) * 32768 + (2 + hh) * 8192;
      float sc[2][2][4];
      bf16x8 kfr[2][2][2], vfr[2][4]; float bia[2][2][4];
#pragma unroll
      for (int g = 0; g < 2; ++g)
#pragma unroll
        for (int tt = 0; tt < 2; ++tt) {
          const int key = 32 * g + 8 * (fr >> 2) + (fr & 3) + 4 * tt, fk = attn_fk(key);
          kfr[g][tt][0] = *(const bf16x8*)(kb + key * 128 + ((fq ^ fk) << 4));
          kfr[g][tt][1] = *(const bf16x8*)(kb + key * 128 + (((4 + fq) ^ fk) << 4));
        }
#pragma unroll
      for (int g = 0; g < 2; ++g)
#pragma unroll
        for (int tt = 0; tt < 2; ++tt)
#pragma unroll
          for (int j = 0; j < 4; ++j) bia[g][tt][j] = exth[-(64 * jc + 32 * g + 4 * tt + j)];
#pragma unroll
      for (int g = 0; g < 2; ++g)
#pragma unroll
        for (int et = 0; et < 4; ++et) { const int er = 16 * et + fr; vfr[g][et] = *(const bf16x8*)(vb + er * 128 + (((4 * g + fq) ^ attn_fv(er)) << 4)); }
      __builtin_amdgcn_sched_barrier(0);
#pragma unroll
      for (int g = 0; g < 2; ++g)
#pragma unroll
        for (int tt = 0; tt < 2; ++tt) {
          f32x4 s4 = __builtin_amdgcn_mfma_f32_16x16x32_bf16(kfr[g][tt][0], qf[0], (f32x4){0.f, 0.f, 0.f, 0.f}, 0, 0, 0);
          s4 = __builtin_amdgcn_mfma_f32_16x16x32_bf16(kfr[g][tt][1], qf[1], s4, 0, 0, 0);
#pragma unroll
          for (int j = 0; j < 4; ++j) sc[g][tt][j] = s4[j] * (0.125f * LOG2E) + bia[g][tt][j];
        }
      float mloc = -1e30f;
#pragma unroll
      for (int g = 0; g < 2; ++g)
#pragma unroll
        for (int tt = 0; tt < 2; ++tt)
#pragma unroll
          for (int j = 0; j < 4; ++j) mloc = fmaxf(mloc, sc[g][tt][j]);
      mloc = fmaxf(mloc, __shfl_xor(mloc, 16)); mloc = fmaxf(mloc, __shfl_xor(mloc, 32));
      const float mnew = fmaxf(mrun, mloc), alpha = __builtin_amdgcn_exp2f(mrun - mnew);
      mrun = mnew;
      float ls = 0.f;
#pragma unroll
      for (int g = 0; g < 2; ++g)
#pragma unroll
        for (int tt = 0; tt < 2; ++tt)
#pragma unroll
          for (int j = 0; j < 4; ++j) { const float e = __builtin_amdgcn_exp2f(sc[g][tt][j] - mnew); sc[g][tt][j] = e; ls += e; }
      lrun = lrun * alpha + ls;
#pragma unroll
      for (int et = 0; et < 4; ++et) { o[et].x *= alpha; o[et].y *= alpha; o[et].z *= alpha; o[et].w *= alpha; }
#pragma unroll
      for (int g = 0; g < 2; ++g) {
        union { bf16x8 v; unsigned u[4]; } pf;
        pf.u[0] = pk2(sc[g][0][0], sc[g][0][1]); pf.u[1] = pk2(sc[g][0][2], sc[g][0][3]);
        pf.u[2] = pk2(sc[g][1][0], sc[g][1][1]); pf.u[3] = pk2(sc[g][1][2], sc[g][1][3]);
#pragma unroll
        for (int et = 0; et < 4; ++et) o[et] = __builtin_amdgcn_mfma_f32_16x16x32_bf16(vfr[g][et], pf.v, o[et], 0, 0, 0);
      }
      if (jc == 8) {
        float lt = lrun + __shfl_xor(lrun, 16); lt += __shfl_xor(lt, 32);
        const float inv = 1.f / lt;
#pragma unroll
        for (int et = 0; et < 4; ++et) {
          f32x4 v = o[et]; v.x *= inv; v.y *= inv; v.z *= inv; v.w *= inv;
          *(f32x4*)(ATT + (size_t)(t0 + iq) * 384 + h * 64 + et * 16 + fq * 4) = v;
        }
      }
    };
#pragma unroll 1
    for (int st0 = 0; st0 < nst; st0 += 2) {
      { const int st = st0;
        if (st + 2 < nst) ATTN_LOAD(sa, st + 2);
        attn_compute(st);
        if (st + 1 < nst) ATTN_WRITE(sb, (st + 1) & 1);
        __syncthreads(); }
      if (st0 + 1 < nst) { const int st = st0 + 1;
        if (st + 2 < nst) ATTN_LOAD(sb, st + 2);
        attn_compute(st);
        if (st + 1 < nst) ATTN_WRITE(sa, (st + 1) & 1);
        __syncthreads(); }
    }
#undef ATTN_LOAD
#undef ATTN_WRITE
  }
  __syncthreads();
}

__device__ __forceinline__ void ssm_bu32(const bf16_t* __restrict__ bbh_g, const bf16_t* __restrict__ urow, int lane,
                                         f32x16& lo_re, f32x16& hi_re, f32x16& lo_im, f32x16& hi_im) {
  const int hf = lane >> 5;
  const bf16x8 ub = *(const bf16x8*)(urow + 8 * hf);
  f32x16 z;
#pragma unroll
  for (int r = 0; r < 16; ++r) z[r] = 0.f;
  const bf16x8 a0r = *(const bf16x8*)(bbh_g + (size_t)(0 * 64 + lane) * 8), a1r = *(const bf16x8*)(bbh_g + (size_t)(1 * 64 + lane) * 8);
  const bf16x8 a0i = *(const bf16x8*)(bbh_g + (size_t)(2 * 64 + lane) * 8), a1i = *(const bf16x8*)(bbh_g + (size_t)(3 * 64 + lane) * 8);
  lo_re = __builtin_amdgcn_mfma_f32_32x32x16_bf16(ub, a0r, z, 0, 0, 0); hi_re = __builtin_amdgcn_mfma_f32_32x32x16_bf16(ub, a1r, z, 0, 0, 0);
  lo_im = __builtin_amdgcn_mfma_f32_32x32x16_bf16(ub, a0i, z, 0, 0, 0); hi_im = __builtin_amdgcn_mfma_f32_32x32x16_bf16(ub, a1i, z, 0, 0, 0);
#pragma unroll
  for (int r = 0; r < 16; ++r) {
    const auto s1 = __builtin_amdgcn_permlane32_swap(__float_as_uint(lo_re[r]), __float_as_uint(hi_re[r]), false, false);
    lo_re[r] = __uint_as_float(s1[0]); hi_re[r] = __uint_as_float(s1[1]);
    const auto s2 = __builtin_amdgcn_permlane32_swap(__float_as_uint(lo_im[r]), __float_as_uint(hi_im[r]), false, false);
    lo_im[r] = __uint_as_float(s2[0]); hi_im[r] = __uint_as_float(s2[1]);
  }
}
__device__ __forceinline__ void rotary_frag(const bf16x8 x0, const bf16x8 x1, const float* RC, const float* RS, int pos, int fq, float scale, bf16x8& o0, bf16x8& o1) {
  const f32x4 c0 = *(const f32x4*)(RC + pos * 32 + 8 * fq), c1 = *(const f32x4*)(RC + pos * 32 + 8 * fq + 4);
  const f32x4 s0 = *(const f32x4*)(RS + pos * 32 + 8 * fq), s1 = *(const f32x4*)(RS + pos * 32 + 8 * fq + 4);
  const float cc[8] = {c0.x, c0.y, c0.z, c0.w, c1.x, c1.y, c1.z, c1.w}, sn[8] = {s0.x, s0.y, s0.z, s0.w, s1.x, s1.y, s1.z, s1.w};
  union { bf16x8 v; unsigned u[4]; } r0, r1;
#pragma unroll
  for (int q = 0; q < 4; ++q) {
    const float a0 = bf2f((bf16_t)x0[2 * q]) * scale, a1 = bf2f((bf16_t)x0[2 * q + 1]) * scale, b0 = bf2f((bf16_t)x1[2 * q]) * scale, b1 = bf2f((bf16_t)x1[2 * q + 1]) * scale;
    r0.u[q] = pk2(a0 * cc[2 * q] - b0 * sn[2 * q], a1 * cc[2 * q + 1] - b1 * sn[2 * q + 1]);
    r1.u[q] = pk2(a0 * sn[2 * q] + b0 * cc[2 * q], a1 * sn[2 * q + 1] + b1 * cc[2 * q + 1]);
  }
  o0 = r0.v; o1 = r1.v;
}
__device__ void mix_local_phase(const Params& p, int l, unsigned char* smem) {
  const CParamsP pp = launder_kargs();
  GAS unsigned char* const ws = launder_ptr(pp->ws); const int tidx = launder_tid();
  const bf16_t* PROJ = (const bf16_t*)(ws + WS_PROJ); const bf16_t* VTR = (const bf16_t*)(ws + WS_VTR);
  const float* RC = (const float*)(ws + WS_ROTC); const float* RS = (const float*)(ws + WS_ROTS);
  float* YINT = (float*)(ws + WS_YINT); float* UPDT = (float*)(ws + WS_UPD);
  const float* SA = (const float*)(ws + WS_SA) + (size_t)l * 16 * 64 * 2; const bf16_t* BBH = (const bf16_t*)(ws + WS_BBH) + (size_t)l * 16 * 2 * 64 * 16;
  float* SEND = (float*)(ws + WS_SEND);
  const int tid = tidx, lane = tid & 63, wid = tid >> 6, fr = lane & 15, fq = lane >> 4;
  bf16_t* KT = (bf16_t*)smem;
  float* rcL = (float*)(smem + 55296); float* rsL = rcL + 2048;
  for (int item = blockIdx.x; item < 256; item += gridDim.x) {
    const int b = item >> 7, n = item & 127, t0 = b * 8192 + n * 64;
    __syncthreads();
#pragma unroll
    for (int i = 0; i < 4; ++i) { rcL[tid + NT * i] = RC[n * 2048 + tid + NT * i]; rsL[tid + NT * i] = RS[n * 2048 + tid + NT * i]; }
    __syncthreads();
#pragma unroll 1
    for (int k3 = 0; k3 < 3; ++k3) {
      const int task = wid * 3 + k3, h = task >> 2, tb = task & 3;
      const int i = 16 * tb + fr;
      const float lg2 = log2f(1.f - exp2f(-5.f - (float)h));
      bf16x8 qraw[2], kraw[2][2][2], vraw[2][4];
      {
        const bf16_t* qp = PROJ + (size_t)(t0 + i) * INCP + C_QR + h * 64 + 8 * fq;
        qraw[0] = *(const bf16x8*)qp; qraw[1] = *(const bf16x8*)(qp + 32);
#pragma unroll
        for (int g = 0; g < 2; ++g) {
#pragma unroll
          for (int tt = 0; tt < 2; ++tt) {
            const int key = 32 * g + 8 * (fr >> 2) + (fr & 3) + 4 * tt;
            const bf16_t* kp = PROJ + (size_t)(t0 + key) * INCP + C_KR + h * 64 + 8 * fq;
            kraw[g][tt][0] = *(const bf16x8*)kp; kraw[g][tt][1] = *(const bf16x8*)(kp + 32);
          }
#pragma unroll
          for (int et = 0; et < 4; ++et) vraw[g][et] = *(const bf16x8*)(VTR + ((size_t)b * 384 + h * 64 + et * 16 + fr) * 8192 + n * 64 + 32 * g + 8 * fq);
        }
      }
      __builtin_amdgcn_sched_barrier(0);
      bf16x8 qf0, qf1;
      rotary_frag(qraw[0], qraw[1], rcL, rsL, i, fq, 1.f, qf0, qf1);
      f32x4 o[4];
#pragma unroll
      for (int et = 0; et < 4; ++et) o[et] = (f32x4){0.f, 0.f, 0.f, 0.f};
#pragma unroll
      for (int g = 0; g < 2; ++g) {
        float st[2][4];
#pragma unroll
        for (int tt = 0; tt < 2; ++tt) {
          const int key = 32 * g + 8 * (fr >> 2) + (fr & 3) + 4 * tt;
          bf16x8 kf0, kf1;
          rotary_frag(kraw[g][tt][0], kraw[g][tt][1], rcL, rsL, key, fq, 0.125f, kf0, kf1);
          f32x4 s4 = __builtin_amdgcn_mfma_f32_16x16x32_bf16(kf0, qf0, (f32x4){0.f, 0.f, 0.f, 0.f}, 0, 0, 0);
          s4 = __builtin_amdgcn_mfma_f32_16x16x32_bf16(kf1, qf1, s4, 0, 0, 0);
#pragma unroll
          for (int j = 0; j < 4; ++j) {
            const int kk = 32 * g + 8 * fq + 4 * tt + j;
            const int dij = i > kk ? i - kk : kk - i;
            st[tt][j] = s4[j] * exp2f(lg2 * (float)dij);
          }
          if (tb == 0) {
            const float kd = exp2f(lg2 * (float)(63 - key));
#pragma unroll
            for (int jj = 0; jj < 8; ++jj) {
              KT[(h * 64 + 8 * fq + jj) * 72 + key] = f2bf(bf2f((bf16_t)kf0[jj]) * kd);
              KT[(h * 64 + 32 + 8 * fq + jj) * 72 + key] = f2bf(bf2f((bf16_t)kf1[jj]) * kd);
            }
          }
        }
        union { bf16x8 v; unsigned u[4]; } pf;
        pf.u[0] = pk2(st[0][0], st[0][1]); pf.u[1] = pk2(st[0][2], st[0][3]); pf.u[2] = pk2(st[1][0], st[1][1]); pf.u[3] = pk2(st[1][2], st[1][3]);
#pragma unroll
        for (int et = 0; et < 4; ++et) o[et] = __builtin_amdgcn_mfma_f32_16x16x32_bf16(vraw[g][et], pf.v, o[et], 0, 0, 0);
      }
#pragma unroll
      for (int et = 0; et < 4; ++et) *(f32x4*)(YINT + (((((size_t)item * 6 + h) * 4 + tb) * 4 + et) * 64 + lane) * 4) = o[et];
    }
    __syncthreads();
#pragma unroll 1
    for (int k3 = 0; k3 < 3; ++k3) {
      const int task = wid * 3 + k3, h = task >> 2, et = task & 3;
      f32x4 acc[4];
#pragma unroll
      for (int dt = 0; dt < 4; ++dt) acc[dt] = (f32x4){0.f, 0.f, 0.f, 0.f};
#pragma unroll
      for (int g = 0; g < 2; ++g) {
        const bf16x8 vf = *(const bf16x8*)(VTR + ((size_t)b * 384 + h * 64 + et * 16 + fr) * 8192 + n * 64 + 32 * g + 8 * fq);
#pragma unroll
        for (int dt = 0; dt < 4; ++dt) {
          const bf16x8 kt = *(const bf16x8*)(KT + (h * 64 + 16 * dt + fr) * 72 + 32 * g + 8 * fq);
          acc[dt] = __builtin_amdgcn_mfma_f32_16x16x32_bf16(kt, vf, acc[dt], 0, 0, 0);
        }
      }
#pragma unroll
      for (int dt = 0; dt < 4; ++dt) *(f32x4*)(UPDT + (((size_t)item * 6 + h) * 64 + 16 * et + fr) * 64 + 16 * dt + 4 * fq) = acc[dt];
    }
#pragma unroll 1
    for (int gi = 0; gi < 2; ++gi) {
      const int g = wid * 2 + gi;
      const float are = SA[(g * 64 + lane) * 2], aim = SA[(g * 64 + lane) * 2 + 1];
      float xr = 0.f, xi = 0.f;
#pragma unroll 1
      for (int blk = 0; blk < 2; ++blk) {
        f32x16 lr, hr, li, hi;
        ssm_bu32(BBH + (size_t)g * 2 * 64 * 16, PROJ + (size_t)(t0 + 32 * blk + (lane & 31)) * INCP + C_US + g * 16, lane, lr, hr, li, hi);
#pragma unroll
        for (int a4 = 0; a4 < 4; ++a4) {
#pragma unroll
          for (int bq = 0; bq < 4; ++bq) { const float nr = are * xr - aim * xi + lr[4 * a4 + bq], ni = are * xi + aim * xr + li[4 * a4 + bq]; xr = nr; xi = ni; }
#pragma unroll
          for (int bq = 0; bq < 4; ++bq) { const float nr = are * xr - aim * xi + hr[4 * a4 + bq], ni = are * xi + aim * xr + hi[4 * a4 + bq]; xr = nr; xi = ni; }
        }
      }
      SEND[(((size_t)item * 16 + g) * 64 + lane) * 2] = xr; SEND[(((size_t)item * 16 + g) * 64 + lane) * 2 + 1] = xi;
    }
  }
}

__device__ void scan_phase(const Params& p, int l) {
  const CParamsP pp = launder_kargs();
  GAS unsigned char* const ws = launder_ptr(pp->ws); const int tidx = launder_tid();
  const float* __restrict__ UPDT = (const float*)(ws + WS_UPD); bf16_t* __restrict__ SPT = (bf16_t*)(ws + WS_SPT);
  const float* __restrict__ SEND = (const float*)(ws + WS_SEND); float* __restrict__ CARRY = (float*)(ws + WS_CARRY);
  const float* SA = (const float*)(ws + WS_SA) + (size_t)l * 16 * 64 * 2;
  const int gtid = blockIdx.x * NT + tidx, gn = gridDim.x * NT;
  for (int idx = gtid; idx < 2 * 6 * 4096 + 2 * 1024; idx += gn) {
    if (idx < 2 * 6 * 4096) {
      const int b = idx / (6 * 4096), r = idx % (6 * 4096), h = r >> 12;
      const float cd = exp2f(64.f * log2f(1.f - exp2f(-5.f - (float)h)));
      const int e_ = (r >> 6) & 63, d_ = r & 63;
      const int spoff = h * 4096 + ((((e_ >> 4) * 2 + (d_ >> 5)) * 64 + ((d_ >> 3) & 3) * 16 + (e_ & 15)) * 8 + (d_ & 7));
      float s = 0.f;
#pragma unroll 1
      for (int nb = 0; nb < NCH; nb += 16) {
        float v[16];
#pragma unroll
        for (int j = 0; j < 16; ++j) v[j] = UPDT[((size_t)(b * NCH + nb + j)) * 6 * 4096 + r];
#pragma unroll
        for (int j = 0; j < 16; ++j) { SPT[((size_t)(b * NCH + nb + j)) * 6 * 4096 + spoff] = f2bf(s); s = cd * s + v[j]; }
      }
    } else {
      const int r2 = idx - 2 * 6 * 4096, b = r2 >> 10, gp = r2 & 1023;
      float ar = SA[gp * 2], ai = SA[gp * 2 + 1];
#pragma unroll
      for (int q = 0; q < 6; ++q) { const float nr = ar * ar - ai * ai, ni = 2.f * ar * ai; ar = nr; ai = ni; }
      float xr = 0.f, xi = 0.f;
#pragma unroll 1
      for (int nb = 0; nb < NCH; nb += 16) {
        float2 v[16];
#pragma unroll
        for (int j = 0; j < 16; ++j) v[j] = *(const float2*)(SEND + (((size_t)(b * NCH + nb + j)) * 1024 + gp) * 2);
#pragma unroll
        for (int j = 0; j < 16; ++j) {
          *(float2*)(CARRY + (((size_t)(b * NCH + nb + j)) * 1024 + gp) * 2) = make_float2(xr, xi);
          const float nr = ar * xr - ai * xi + v[j].x, ni = ar * xi + ai * xr + v[j].y;
          xr = nr; xi = ni;
        }
      }
    }
  }
  if (l + 1 < DEPTH_) convert_tables_fp4(pp, ws, l + 1, gtid, gn);
}

__device__ void mix_final_phase(const Params& p, int l, unsigned char* smem) {
  const CParamsP pp = launder_kargs();
  GAS unsigned char* const ws = launder_ptr(pp->ws); const int tidx = launder_tid();
  const bf16_t* PROJ = (const bf16_t*)(ws + WS_PROJ);
  const float* RC = (const float*)(ws + WS_ROTC); const float* RS = (const float*)(ws + WS_ROTS);
  const float* YINT = (const float*)(ws + WS_YINT); const bf16_t* SPT = (const bf16_t*)(ws + WS_SPT);
  const float* ATT = (const float*)(ws + WS_ATT);
  const float* SA = (const float*)(ws + WS_SA) + (size_t)l * 16 * 64 * 2; const bf16_t* BBH = (const bf16_t*)(ws + WS_BBH) + (size_t)l * 16 * 2 * 64 * 16;
  const float* CARRY = (const float*)(ws + WS_CARRY);
  const bf16_t* CB = (const bf16_t*)(ws + WS_CB) + (size_t)l * 16 * 16 * 128; const bf16_t* WG = (const bf16_t*)(ws + WS_WGLUT) + (size_t)l * 512 * 256;
  const float* dsk = gin(pp->in[I_SSMD]) + (size_t)l * 256;
  const float* mg = gin(pp->in[I_MGAIN]) + (size_t)l * 1024;
  bf16_t* MRG = (bf16_t*)(ws + WS_ABUF);
  const int tid = tidx, lane = tid & 63, wid = tid >> 6, fr = lane & 15, fq = lane >> 4;
  bf16_t* YS = (bf16_t*)smem;
  float* red = (float*)(smem + 33792);
  bf16_t* XB = (bf16_t*)(smem + 36864 + wid * 8448 + 4096);
  float* rcL = (float*)(smem + 104448); float* rsL = rcL + 2048;
  for (int item = blockIdx.x; item < 256; item += gridDim.x) {
    const int b = item >> 7, n = item & 127, t0 = b * 8192 + n * 64;
    __syncthreads();
#pragma unroll
    for (int i = 0; i < 4; ++i) { rcL[tid + NT * i] = RC[n * 2048 + tid + NT * i]; rsL[tid + NT * i] = RS[n * 2048 + tid + NT * i]; }
    __syncthreads();
    {
      float av[8][6], mgl[6];
#pragma unroll
      for (int ii = 0; ii < 8; ++ii)
#pragma unroll
        for (int j = 0; j < 6; ++j) av[ii][j] = ATT[(size_t)(t0 + wid * 8 + ii) * 384 + lane + 64 * j];
#pragma unroll
      for (int j = 0; j < 6; ++j) mgl[j] = mg[lane + 64 * j];
      __builtin_amdgcn_sched_barrier(0);
#pragma unroll
      for (int ii = 0; ii < 8; ++ii) {
        const int t = t0 + wid * 8 + ii;
        float sq = 0.f;
#pragma unroll
        for (int j = 0; j < 6; ++j) sq += av[ii][j] * av[ii][j];
        const float rstd = rsqrtf(wave_sum(sq) * (1.f / 384.f) + EPS_);
#pragma unroll
        for (int j = 0; j < 6; ++j) MRG[(size_t)t * 1024 + lane + 64 * j] = f2bf(av[ii][j] * rstd * mgl[j]);
      }
    }
#pragma unroll 1
    for (int k3 = 0; k3 < 3; ++k3) {
      const int task = wid * 3 + k3, h = task >> 2, tb = task & 3;
      const int i = 16 * tb + fr, t = t0 + i;
      const float lg2 = log2f(1.f - exp2f(-5.f - (float)h));
      bf16x8 qraw[2], spf[4][2]; f32x4 yiv[4], mgq[4]; uint2 grv[4];
      {
        const bf16_t* qp = PROJ + (size_t)t * INCP + C_QR + h * 64 + 8 * fq;
        qraw[0] = *(const bf16x8*)qp; qraw[1] = *(const bf16x8*)(qp + 32);
#pragma unroll
        for (int et = 0; et < 4; ++et) {
          const bf16_t* sp = SPT + ((size_t)item * 6 + h) * 4096 + (size_t)(et * 2) * 512 + lane * 8;
          spf[et][0] = *(const bf16x8*)sp; spf[et][1] = *(const bf16x8*)(sp + 512);
          yiv[et] = *(const f32x4*)(YINT + (((((size_t)item * 6 + h) * 4 + tb) * 4 + et) * 64 + lane) * 4);
          grv[et] = *(const uint2*)(PROJ + (size_t)t * INCP + C_GR + h * 64 + 16 * et + 4 * fq);
          mgq[et] = *(const f32x4*)(mg + 384 + h * 64 + 16 * et + 4 * fq);
        }
      }
      __builtin_amdgcn_sched_barrier(0);
      bf16x8 qf0, qf1;
      rotary_frag(qraw[0], qraw[1], rcL, rsL, i, fq, 1.f, qf0, qf1);
      f32x4 o[4];
#pragma unroll
      for (int et = 0; et < 4; ++et) {
        o[et] = __builtin_amdgcn_mfma_f32_16x16x32_bf16(spf[et][0], qf0, (f32x4){0.f, 0.f, 0.f, 0.f}, 0, 0, 0);
        o[et] = __builtin_amdgcn_mfma_f32_16x16x32_bf16(spf[et][1], qf1, o[et], 0, 0, 0);
      }
      const float qd = exp2f(lg2 * (float)(i + 1));
      float y[16]; float s1 = 0.f;
#pragma unroll
      for (int et = 0; et < 4; ++et) {
        const f32x4 yi = yiv[et];
        y[4 * et] = yi.x + qd * o[et].x; y[4 * et + 1] = yi.y + qd * o[et].y; y[4 * et + 2] = yi.z + qd * o[et].z; y[4 * et + 3] = yi.w + qd * o[et].w;
        s1 += (y[4 * et] + y[4 * et + 1]) + (y[4 * et + 2] + y[4 * et + 3]);
      }
      s1 += __shfl_xor(s1, 16); s1 += __shfl_xor(s1, 32);
      const float mu = s1 * (1.f / 64.f);
      float s2 = 0.f;
#pragma unroll
      for (int q = 0; q < 16; ++q) { y[q] -= mu; s2 += y[q] * y[q]; }
      s2 += __shfl_xor(s2, 16); s2 += __shfl_xor(s2, 32);
      const float rstd = rsqrtf(s2 * (1.f / 64.f) + EPS_);
#pragma unroll
      for (int et = 0; et < 4; ++et) {
        const int c = h * 64 + 16 * et + 4 * fq;
        const uint2 gr = grv[et];
        const float g0 = __uint_as_float(gr.x << 16), g1 = __uint_as_float(gr.x & 0xffff0000u), g2 = __uint_as_float(gr.y << 16), g3 = __uint_as_float(gr.y & 0xffff0000u);
        const f32x4 mgv = mgq[et];
        uint2 ov;
        ov.x = pk2(y[4 * et] * rstd * (g0 * sigmoid_f(g0)) * mgv.x, y[4 * et + 1] * rstd * (g1 * sigmoid_f(g1)) * mgv.y);
        ov.y = pk2(y[4 * et + 2] * rstd * (g2 * sigmoid_f(g2)) * mgv.z, y[4 * et + 3] * rstd * (g3 * sigmoid_f(g3)) * mgv.w);
        *(uint2*)(MRG + (size_t)t * 1024 + 384 + c) = ov;
      }
    }
#pragma unroll 1
    for (int gi = 0; gi < 2; ++gi) {
      const int g = wid * 2 + gi;
      const float are = SA[(g * 64 + lane) * 2], aim = SA[(g * 64 + lane) * 2 + 1];
      float xr = CARRY[(((size_t)item * 16 + g) * 64 + lane) * 2], xi = CARRY[(((size_t)item * 16 + g) * 64 + lane) * 2 + 1];
      bf16x8 cb[4];
#pragma unroll
      for (int ks = 0; ks < 4; ++ks) cb[ks] = *(const bf16x8*)(CB + (((size_t)g * 4 + ks) * 64 + lane) * 8);
      const float dv = dsk[g * 16 + fr];
#pragma unroll 1
      for (int blk = 0; blk < 2; ++blk) {
        f32x16 lr, hr, li, hi;
        bf16_t uraw[2][4];
#pragma unroll
        for (int half = 0; half < 2; ++half)
#pragma unroll
          for (int j = 0; j < 4; ++j) uraw[half][j] = PROJ[(size_t)(t0 + 32 * blk + 16 * half + 4 * fq + j) * INCP + C_US + g * 16 + fr];
        ssm_bu32(BBH + (size_t)g * 2 * 64 * 16, PROJ + (size_t)(t0 + 32 * blk + (lane & 31)) * INCP + C_US + g * 16, lane, lr, hr, li, hi);
#pragma unroll
        for (int half = 0; half < 2; ++half) {
#pragma unroll
          for (int a2 = 0; a2 < 2; ++a2) {
            const int a4 = 2 * half + a2;
#pragma unroll
            for (int bq = 0; bq < 4; ++bq) {
              const float nr = are * xr - aim * xi + lr[4 * a4 + bq], ni = are * xi + aim * xr + li[4 * a4 + bq]; xr = nr; xi = ni;
              XB[(8 * a2 + bq) * 136 + lane] = f2bf(xr); XB[(8 * a2 + bq) * 136 + 64 + lane] = f2bf(xi);
            }
#pragma unroll
            for (int bq = 0; bq < 4; ++bq) {
              const float nr = are * xr - aim * xi + hr[4 * a4 + bq], ni = are * xi + aim * xr + hi[4 * a4 + bq]; xr = nr; xi = ni;
              XB[(8 * a2 + 4 + bq) * 136 + lane] = f2bf(xr); XB[(8 * a2 + 4 + bq) * 136 + 64 + lane] = f2bf(xi);
            }
          }
          f32x4 acc = (f32x4){0.f, 0.f, 0.f, 0.f};
#pragma unroll
          for (int ks = 0; ks < 4; ++ks) {
            const bf16x8 af = *(const bf16x8*)(XB + fr * 136 + 32 * ks + 8 * fq);
            acc = __builtin_amdgcn_mfma_f32_16x16x32_bf16(af, cb[ks], acc, 0, 0, 0);
          }
#pragma unroll
          for (int j = 0; j < 4; ++j) {
            const int i = 32 * blk + 16 * half + 4 * fq + j;
            const float yv = acc[j] + dv * bf2f(uraw[half][j]);
            YS[i * 264 + g * 16 + fr] = f2bf(gelu_tanh(yv));
          }
        }
      }
    }
    __syncthreads();
    {
      const int n0 = 32 * wid;
      f32x4 a1[4][2], a2[4][2];
#pragma unroll
      for (int mt = 0; mt < 4; ++mt)
#pragma unroll
        for (int nt = 0; nt < 2; ++nt) { a1[mt][nt] = (f32x4){0.f, 0.f, 0.f, 0.f}; a2[mt][nt] = (f32x4){0.f, 0.f, 0.f, 0.f}; }
#pragma unroll 1
      for (int kh = 0; kh < 2; ++kh) {
        bf16x8 w1[4][2], w2[4][2];
#pragma unroll
        for (int k4 = 0; k4 < 4; ++k4)
#pragma unroll
          for (int nt = 0; nt < 2; ++nt) {
            w1[k4][nt] = *(const bf16x8*)(WG + ((((size_t)wid * 8 + 4 * kh + k4) * 2 + 0) * 2 + nt) * 512 + lane * 8);
            w2[k4][nt] = *(const bf16x8*)(WG + ((((size_t)wid * 8 + 4 * kh + k4) * 2 + 1) * 2 + nt) * 512 + lane * 8);
          }
        __builtin_amdgcn_sched_barrier(0);
#pragma unroll
        for (int k4 = 0; k4 < 4; ++k4) {
          const int ks = 4 * kh + k4;
          bf16x8 yb[4];
#pragma unroll
          for (int mt = 0; mt < 4; ++mt) yb[mt] = *(const bf16x8*)(YS + (16 * mt + fr) * 264 + 32 * ks + 8 * fq);
#pragma unroll
          for (int mt = 0; mt < 4; ++mt)
#pragma unroll
            for (int nt = 0; nt < 2; ++nt) {
              a1[mt][nt] = __builtin_amdgcn_mfma_f32_16x16x32_bf16(w1[k4][nt], yb[mt], a1[mt][nt], 0, 0, 0);
              a2[mt][nt] = __builtin_amdgcn_mfma_f32_16x16x32_bf16(w2[k4][nt], yb[mt], a2[mt][nt], 0, 0, 0);
            }
        }
      }
#pragma unroll
      for (int mt = 0; mt < 4; ++mt) {
        float sq = 0.f;
#pragma unroll
        for (int nt = 0; nt < 2; ++nt) {
          f32x4 z = a1[mt][nt]; const f32x4 zg = a2[mt][nt];
          z.x *= sigmoid_f(zg.x); z.y *= sigmoid_f(zg.y); z.z *= sigmoid_f(zg.z); z.w *= sigmoid_f(zg.w);
          a1[mt][nt] = z; sq += z.x * z.x + z.y * z.y + z.z * z.z + z.w * z.w;
        }
        sq += __shfl_xor(sq, 16); sq += __shfl_xor(sq, 32);
        if (fq == 0) red[wid * 64 + 16 * mt + fr] = sq;
      }
      __syncthreads();
#pragma unroll
      for (int mt = 0; mt < 4; ++mt) {
        const int i = 16 * mt + fr, t = t0 + i;
        float tot = 0.f;
#pragma unroll
        for (int w8 = 0; w8 < 8; ++w8) tot += red[w8 * 64 + i];
        const float rstd = rsqrtf(tot * (1.f / 256.f) + EPS_);
#pragma unroll
        for (int nt = 0; nt < 2; ++nt) {
          const int c = n0 + 16 * nt + 4 * fq;
          const f32x4 mgv = *(const f32x4*)(mg + 768 + c); const f32x4 z = a1[mt][nt];
          uint2 ov; ov.x = pk2(z.x * rstd * mgv.x, z.y * rstd * mgv.y); ov.y = pk2(z.z * rstd * mgv.z, z.w * rstd * mgv.w);
          *(uint2*)(MRG + (size_t)t * 1024 + 768 + c) = ov;
        }
      }
    }
  }
}

typedef float f32x2 __attribute__((ext_vector_type(2)));
__device__ __forceinline__ float dot16_fp4(const uint2 u, const f32x2 (&hv)[8]) {
  f32x2 d = __builtin_amdgcn_cvt_scalef32_pk_f32_fp4(u.x, 1.0f, 0) * hv[0];
  d += __builtin_amdgcn_cvt_scalef32_pk_f32_fp4(u.x, 1.0f, 1) * hv[1];
  d += __builtin_amdgcn_cvt_scalef32_pk_f32_fp4(u.x, 1.0f, 2) * hv[2];
  d += __builtin_amdgcn_cvt_scalef32_pk_f32_fp4(u.x, 1.0f, 3) * hv[3];
  d += __builtin_amdgcn_cvt_scalef32_pk_f32_fp4(u.y, 1.0f, 0) * hv[4];
  d += __builtin_amdgcn_cvt_scalef32_pk_f32_fp4(u.y, 1.0f, 1) * hv[5];
  d += __builtin_amdgcn_cvt_scalef32_pk_f32_fp4(u.y, 1.0f, 2) * hv[6];
  d += __builtin_amdgcn_cvt_scalef32_pk_f32_fp4(u.y, 1.0f, 3) * hv[7];
  return d.x + d.y;
}
__device__ __forceinline__ void axpy16_fp4(const uint2 v, const float w, f32x2 (&acc)[8]) {
  const f32x2 w2 = (f32x2){w, w};
  acc[0] += w2 * __builtin_amdgcn_cvt_scalef32_pk_f32_fp4(v.x, 1.0f, 0);
  acc[1] += w2 * __builtin_amdgcn_cvt_scalef32_pk_f32_fp4(v.x, 1.0f, 1);
  acc[2] += w2 * __builtin_amdgcn_cvt_scalef32_pk_f32_fp4(v.x, 1.0f, 2);
  acc[3] += w2 * __builtin_amdgcn_cvt_scalef32_pk_f32_fp4(v.x, 1.0f, 3);
  acc[4] += w2 * __builtin_amdgcn_cvt_scalef32_pk_f32_fp4(v.y, 1.0f, 0);
  acc[5] += w2 * __builtin_amdgcn_cvt_scalef32_pk_f32_fp4(v.y, 1.0f, 1);
  acc[6] += w2 * __builtin_amdgcn_cvt_scalef32_pk_f32_fp4(v.y, 1.0f, 2);
  acc[7] += w2 * __builtin_amdgcn_cvt_scalef32_pk_f32_fp4(v.y, 1.0f, 3);
}
__device__ __forceinline__ float vmaxf(float a, float b) { float r; asm("v_max_f32 %0, %1, %2" : "=v"(r) : "v"(a), "v"(b)); return r; }
__device__ __forceinline__ float vminf(float a, float b) { float r; asm("v_min_f32 %0, %1, %2" : "=v"(r) : "v"(a), "v"(b)); return r; }
__device__ __forceinline__ void cx(float& hi, float& lo) { const float a = hi, b = lo; hi = vmaxf(a, b); lo = vminf(a, b); }
__device__ __forceinline__ void cx2(float& kh, int& ph, float& kl, int& pl) {
  const float a = kh, b = kl; const int pa = ph, pb = pl; const bool c = a >= b;
  kh = vmaxf(a, b); kl = vminf(a, b); ph = c ? pa : pb; pl = c ? pb : pa;
}
__device__ __forceinline__ void bitonic_sort16_desc(float (&v)[16]) {
#pragma unroll
  for (int k = 2; k <= 16; k <<= 1)
#pragma unroll
    for (int j = k >> 1; j > 0; j >>= 1)
#pragma unroll
      for (int i = 0; i < 16; ++i) {
        const int l = i ^ j;
        if (l > i) { if ((i & k) == 0) cx(v[i], v[l]); else cx(v[l], v[i]); }
      }
}
__device__ __forceinline__ void bitonic_merge16_desc(float (&v)[16]) {
#pragma unroll
  for (int j = 8; j > 0; j >>= 1)
#pragma unroll
    for (int i = 0; i < 16; ++i) { const int l = i ^ j; if (l > i) cx(v[i], v[l]); }
}
__device__ __forceinline__ void top16_merge(float (&a)[16], const float (&b)[16]) {
#pragma unroll
  for (int i = 0; i < 16; ++i) a[i] = vmaxf(a[i], b[15 - i]);
  bitonic_merge16_desc(a);
}
template <int M> __device__ __forceinline__ void top16_merge_chain(float (&k)[16], int (&q)[16], const float (&xk)[M], const int (&xq)[M]) {
#pragma unroll
  for (int i = 16 - M; i < 16; ++i) { const float a = k[i], b = xk[15 - i]; const bool c = a >= b; k[i] = vmaxf(a, b); q[i] = c ? q[i] : xq[15 - i]; }
#pragma unroll
  for (int j = 8; j > 0; j >>= 1)
#pragma unroll
    for (int i = 0; i < 16; ++i) { const int l = i ^ j; if (l > i) cx2(k[i], q[i], k[l], q[l]); }
}

__device__ void peer_phase(const Params& p, int l, bool last, unsigned char* smem) {
  const CParamsP pp = launder_kargs();
  GAS unsigned char* const ws = launder_ptr(pp->ws); const int tidx = launder_tid();
  bf16_t* HF = (bf16_t*)(ws + WS_ABUF); float* X = (float*)(ws + WS_X);
  const float* SC4 = (const float*)(ws + WS_SC);
  const uint2* U4 = (const uint2*)(ws + WS_PU8) + (size_t)l * 16384 * 64; const uint2* V4 = (const uint2*)(ws + WS_PV8) + (size_t)l * 16384 * 64;
  const float* g2 = (const float*)(ws + WS_MOD) + (size_t)l * 2 * 6144 + 5120;
  const bf16_t* XG = (const bf16_t*)(ws + WS_XG); const float* SSQ = (const float*)(ws + WS_SSQ); const float* sh2 = (const float*)(ws + WS_MOD) + (size_t)l * 2 * 6144 + 3072;
  const int ln = last ? l : l + 1;
  const float* nsh = (const float*)(ws + WS_MOD) + (size_t)ln * 2 * 6144; const float* nsc = nsh + 1024;
  const float* ngain = gin(pp->in[I_NMIX]) + (size_t)ln * 1024;
  const int lane = tidx & 63, wid = tidx >> 6;
  const int rL = ((lane >> 5) & 1) * 8 + ((lane >> 4) & 1) * 4 + ((lane >> 3) & 1) * 2 + ((lane >> 2) & 1);
  const bool hi5 = (lane & 32) != 0, hi4 = (lane & 16) != 0, hi3 = (lane & 8) != 0, hi2 = (lane & 4) != 0;
  int* idxL = (int*)smem;
  for (int item = blockIdx.x; item < T_ / 64; item += gridDim.x) {
    const int t0 = item * 64;
    __syncthreads();
    {
      int lane_o = lane; asm volatile("" : "+v"(lane_o));
      const int tg = wid & 1, hp = wid >> 1, hf = lane_o >> 5, tl = 32 * tg + (lane_o & 31);
      float F[2][16];
#pragma unroll
      for (int sd = 0; sd < 2; ++sd) {
        float Lh[2][16];
#pragma unroll
        for (int hh = 0; hh < 2; ++hh) {
          const int hs = 2 * (2 * hp + hh) + sd;
          float top[16];
          const float* scp = SC4 + (((size_t)(hs * 32 + 16 * hf)) * T_ + (t0 + tl)) * 4;
          f32x4 sv[16];
#pragma unroll
          for (int kq = 0; kq < 16; ++kq) sv[kq] = *(const f32x4*)(scp + (size_t)kq * T_ * 4);
          __builtin_amdgcn_sched_barrier(0);
#pragma unroll
          for (int kt = 0; kt < 4; ++kt) {
            float g[16];
#pragma unroll
            for (int kq = 0; kq < 4; ++kq) {
              const f32x4 v4 = sv[4 * kt + kq];
#pragma unroll
              for (int j = 0; j < 4; ++j) {
                const int key = 64 * hf + 16 * kt + 4 * kq + j;
                g[4 * kq + j] = __uint_as_float((__float_as_uint(v4[j]) & 0xffffff80u) | (unsigned)key);
              }
            }
            bitonic_sort16_desc(g);
            if (kt == 0) {
#pragma unroll
              for (int r = 0; r < 16; ++r) top[r] = g[r];
            } else top16_merge(top, g);
            __builtin_amdgcn_sched_barrier(0);
          }
#pragma unroll
          for (int r = 0; r < 16; ++r) Lh[hh][r] = top[r];
          __builtin_amdgcn_sched_barrier(0);
        }
#pragma unroll
        for (int r = 0; r < 16; ++r) {
          const auto sw = __builtin_amdgcn_permlane32_swap(__float_as_uint(Lh[0][r]), __float_as_uint(Lh[1][r]), false, false);
          Lh[0][r] = __uint_as_float(sw[0]); Lh[1][r] = __uint_as_float(sw[1]);
        }
        top16_merge(Lh[0], Lh[1]);
#pragma unroll
        for (int r = 0; r < 16; ++r) F[sd][r] = Lh[0][r];
        __builtin_amdgcn_sched_barrier(0);
      }
      int ia[16], ib[16];
#pragma unroll
      for (int r = 0; r < 16; ++r) { ia[r] = (int)(__float_as_uint(F[0][r]) & 127u) << 7; ib[r] = (int)(__float_as_uint(F[1][r]) & 127u); }
      float k[16]; int q[16];
#pragma unroll
      for (int j = 0; j < 16; ++j) { k[j] = F[0][0] + F[1][j]; q[j] = ia[0] | ib[j]; }
      { float xk[8]; int xq[8];
#pragma unroll
        for (int j = 0; j < 8; ++j) { xk[j] = F[0][1] + F[1][j]; xq[j] = ia[1] | ib[j]; }
        top16_merge_chain<8>(k, q, xk, xq); }
      { float xk[5]; int xq[5];
#pragma unroll
        for (int j = 0; j < 5; ++j) { xk[j] = F[0][2] + F[1][j]; xq[j] = ia[2] | ib[j]; }
        top16_merge_chain<5>(k, q, xk, xq); }
      { float xk[4]; int xq[4];
#pragma unroll
        for (int j = 0; j < 4; ++j) { xk[j] = F[0][3] + F[1][j]; xq[j] = ia[3] | ib[j]; }
        top16_merge_chain<4>(k, q, xk, xq); }
      { float xk[3]; int xq[3];
#pragma unroll
        for (int j = 0; j < 3; ++j) { xk[j] = F[0][4] + F[1][j]; xq[j] = ia[4] | ib[j]; }
        top16_merge_chain<3>(k, q, xk, xq); }
      { float xk[11]; int xq[11];
#pragma unroll
        for (int i = 0; i < 11; ++i) { xk[i] = F[0][5 + i] + F[1][0]; xq[i] = ia[5 + i] | ib[0]; }
        top16_merge_chain<11>(k, q, xk, xq); }
      { float xk[3]; int xq[3];
#pragma unroll
        for (int i = 0; i < 3; ++i) { xk[i] = F[0][5 + i] + F[1][1]; xq[i] = ia[5 + i] | ib[1]; }
        top16_merge_chain<3>(k, q, xk, xq); }
      float e[16]; float es = 0.f;
#pragma unroll
      for (int i = 0; i < 16; ++i) { e[i] = __expf(k[i] - k[0]); es += e[i]; }
      const float ies = 1.f / es;
      const int h = 2 * hp + hf;
#pragma unroll
      for (int i = 0; i < 16; ++i) idxL[tl * 132 + h * 16 + i] = (int)(((unsigned)f2bf(e[i] * ies) << 16) | (unsigned)q[i]);
    }
    __syncthreads();
    f32x4 sh2v[4];
#pragma unroll
    for (int qq = 0; qq < 4; ++qq) sh2v[qq] = *(const f32x4*)(sh2 + (t0 >> 13) * 6144 + lane * 16 + 4 * qq);
    const float rs_lane = rsqrtf(ssq_total(SSQ, t0 + wid * 8 + (lane & 7)) * (1.f / 1024.f) + EPS_);
    uint4 nh0 = *(const uint4*)(XG + (size_t)(t0 + wid * 8) * 1024 + lane * 16), nh1 = *(const uint4*)(XG + (size_t)(t0 + wid * 8) * 1024 + lane * 16 + 8);
#pragma unroll 1
    for (int ii = 0; ii < 8; ++ii) {
      const int tl = wid * 8 + ii, t = t0 + tl, b = t >> 13;
      const int fr = lane & 15, fq = lane >> 4;
      uint4 hB1[8], hB2[8];
      {
        const uint4 h0 = nh0, h1 = nh1;
        if (ii < 7) { nh0 = *(const uint4*)(XG + (size_t)(t + 1) * 1024 + lane * 16); nh1 = *(const uint4*)(XG + (size_t)(t + 1) * 1024 + lane * 16 + 8); }
        const unsigned hw[8] = {h0.x, h0.y, h0.z, h0.w, h1.x, h1.y, h1.z, h1.w};
        const float rs = __int_as_float(__builtin_amdgcn_readlane(__float_as_int(rs_lane), ii));
        unsigned q1[2] = {0u, 0u}, q2[2] = {0u, 0u};
#pragma unroll
        for (int qq = 0; qq < 4; ++qq) {
          const f32x4 sh = sh2v[qq];
          float hvv[4];
          hvv[0] = __uint_as_float(hw[2 * qq] << 16) * rs + sh.x; hvv[1] = __uint_as_float(hw[2 * qq] & 0xffff0000u) * rs + sh.y;
          hvv[2] = __uint_as_float(hw[2 * qq + 1] << 16) * rs + sh.z; hvv[3] = __uint_as_float(hw[2 * qq + 1] & 0xffff0000u) * rs + sh.w;
#pragma unroll
          for (int pr = 0; pr < 2; ++pr) {
            const int byte_sel = (2 * qq + pr) & 3, wd = (2 * qq + pr) >> 2;
            const float x0 = fminf(fmaxf(hvv[2 * pr], -6.f), 6.f), x1 = fminf(fmaxf(hvv[2 * pr + 1], -6.f), 6.f);
            unsigned t1 = 0u;
            if (byte_sel == 0) t1 = __builtin_amdgcn_cvt_scalef32_pk_fp4_f32(0u, x0, x1, 1.0f, 0);
            else if (byte_sel == 1) t1 = __builtin_amdgcn_cvt_scalef32_pk_fp4_f32(0u, x0, x1, 1.0f, 1);
            else if (byte_sel == 2) t1 = __builtin_amdgcn_cvt_scalef32_pk_fp4_f32(0u, x0, x1, 1.0f, 2);
            else t1 = __builtin_amdgcn_cvt_scalef32_pk_fp4_f32(0u, x0, x1, 1.0f, 3);
            f32x2 back;
            if (byte_sel == 0) back = __builtin_amdgcn_cvt_scalef32_pk_f32_fp4(t1, 1.0f, 0);
            else if (byte_sel == 1) back = __builtin_amdgcn_cvt_scalef32_pk_f32_fp4(t1, 1.0f, 1);
            else if (byte_sel == 2) back = __builtin_amdgcn_cvt_scalef32_pk_f32_fp4(t1, 1.0f, 2);
            else back = __builtin_amdgcn_cvt_scalef32_pk_f32_fp4(t1, 1.0f, 3);
            const float r0 = fminf(fmaxf((hvv[2 * pr] - back.x) * 8.f, -6.f), 6.f), r1 = fminf(fmaxf((hvv[2 * pr + 1] - back.y) * 8.f, -6.f), 6.f);
            unsigned t2 = 0u;
            if (byte_sel == 0) t2 = __builtin_amdgcn_cvt_scalef32_pk_fp4_f32(0u, r0, r1, 1.0f, 0);
            else if (byte_sel == 1) t2 = __builtin_amdgcn_cvt_scalef32_pk_fp4_f32(0u, r0, r1, 1.0f, 1);
            else if (byte_sel == 2) t2 = __builtin_amdgcn_cvt_scalef32_pk_fp4_f32(0u, r0, r1, 1.0f, 2);
            else t2 = __builtin_amdgcn_cvt_scalef32_pk_fp4_f32(0u, r0, r1, 1.0f, 3);
            q1[wd] |= t1; q2[wd] |= t2;
          }
        }
        unsigned char* hq4 = smem + 33792 + wid * 1024;
        *(uint2*)(hq4 + lane * 8) = make_uint2(q1[0], q1[1]);
        *(uint2*)(hq4 + 512 + lane * 8) = make_uint2(q2[0], q2[1]);
#pragma unroll
        for (int kc = 0; kc < 8; ++kc) { hB1[kc] = *(const uint4*)(hq4 + 64 * kc + 16 * fq); hB2[kc] = *(const uint4*)(hq4 + 512 + 64 * kc + 16 * fq); }
      }
      f32x2 acc2[8];
#pragma unroll
      for (int j = 0; j < 8; ++j) acc2[j] = (f32x2){0.f, 0.f};
#pragma unroll 1
      for (int bt = 0; bt < 8; ++bt) {
        const int myidx = idxL[tl * 132 + 16 * bt + fr] & 0xffff;
        unsigned char* ust = smem + 41984 + wid * 8448;
        uint2 ul[16], vr[16];
#pragma unroll
        for (int r = 0; r < 16; ++r) { const int er = __builtin_amdgcn_readlane(myidx, r); const uint2* up = U4 + (size_t)er * 64; ul[r] = up[lane]; }
        __builtin_amdgcn_sched_barrier(0);
#pragma unroll
        for (int r = 0; r < 16; ++r) { const int er = __builtin_amdgcn_readlane(myidx, r); const uint2* vp = V4 + (size_t)er * 64; vr[r] = vp[lane]; }
        __builtin_amdgcn_sched_barrier(0);
#pragma unroll
        for (int r = 0; r < 16; ++r) *(uint2*)(ust + r * 528 + lane * 8) = ul[r];
        uint4 ua[8];
#pragma unroll
        for (int kc = 0; kc < 8; ++kc) ua[kc] = *(const uint4*)(ust + fr * 528 + 64 * kc + 16 * fq);
        f32x4 sa[2] = {(f32x4){0.f, 0.f, 0.f, 0.f}, (f32x4){0.f, 0.f, 0.f, 0.f}}, sb[2] = {(f32x4){0.f, 0.f, 0.f, 0.f}, (f32x4){0.f, 0.f, 0.f, 0.f}};
#pragma unroll
        for (int kc = 0; kc < 8; ++kc) {
          const i32x8 av = (i32x8){(int)ua[kc].x, (int)ua[kc].y, (int)ua[kc].z, (int)ua[kc].w, 0, 0, 0, 0};
          const i32x8 b1 = (i32x8){(int)hB1[kc].x, (int)hB1[kc].y, (int)hB1[kc].z, (int)hB1[kc].w, 0, 0, 0, 0};
          const i32x8 b2 = (i32x8){(int)hB2[kc].x, (int)hB2[kc].y, (int)hB2[kc].z, (int)hB2[kc].w, 0, 0, 0, 0};
          sa[kc & 1] = __builtin_amdgcn_mfma_scale_f32_16x16x128_f8f6f4(av, b1, sa[kc & 1], 4  , 4  , 0, 0x7F7F7F7F, 0, 0x7F7F7F7F);
          sb[kc & 1] = __builtin_amdgcn_mfma_scale_f32_16x16x128_f8f6f4(av, b2, sb[kc & 1], 4, 4, 0, 0x7F7F7F7F, 0, 0x7F7F7F7F);
        }
        f32x4 sc4 = (sa[0] + sa[1]) + (sb[0] + sb[1]) * 0.125f;
        const int jsel = lane & 3;
        const float dsel = jsel == 0 ? sc4[0] : (jsel == 1 ? sc4[1] : (jsel == 2 ? sc4[2] : sc4[3]));
        const float gl = __uint_as_float((unsigned)idxL[tl * 132 + 16 * bt + 4 * fq + jsel] & 0xffff0000u);
        const float w = gl * gelu_tanh_fast(dsel * (1.f / 64.f));
#pragma unroll
        for (int r = 0; r < 16; ++r) {
          const float wr = __int_as_float(__builtin_amdgcn_readlane(__float_as_int(w), 16 * (r >> 2) + (r & 3)));
          axpy16_fp4(vr[r], wr, acc2);
          if ((r & 3) == 3) __builtin_amdgcn_sched_barrier(0);
        }
      }
      float acc[16];
#pragma unroll
      for (int j = 0; j < 8; ++j) { acc[2 * j] = acc2[j].x; acc[2 * j + 1] = acc2[j].y; }
      float xn[16]; float ss = 0.f;
#pragma unroll
      for (int qq = 0; qq < 4; ++qq) {
        const int c = lane * 16 + 4 * qq;
        const f32x4 xv = *(const f32x4*)(X + (size_t)t * 1024 + c), g = *(const f32x4*)(g2 + b * 6144 + c);
        xn[4 * qq] = xv.x + g.x * acc[4 * qq] * 0.25f; xn[4 * qq + 1] = xv.y + g.y * acc[4 * qq + 1] * 0.25f;
        xn[4 * qq + 2] = xv.z + g.z * acc[4 * qq + 2] * 0.25f; xn[4 * qq + 3] = xv.w + g.w * acc[4 * qq + 3] * 0.25f;
        ss += xn[4 * qq] * xn[4 * qq] + xn[4 * qq + 1] * xn[4 * qq + 1] + xn[4 * qq + 2] * xn[4 * qq + 2] + xn[4 * qq + 3] * xn[4 * qq + 3];
      }
      const float rstd = rsqrtf(wave_sum(ss) * (1.f / 1024.f) + EPS_);
      if (!last) {
        unsigned hb[8];
#pragma unroll
        for (int qq = 0; qq < 4; ++qq) {
          const int c = lane * 16 + 4 * qq;
          *(f32x4*)(X + (size_t)t * 1024 + c) = (f32x4){xn[4 * qq], xn[4 * qq + 1], xn[4 * qq + 2], xn[4 * qq + 3]};
          const f32x4 gn = *(const f32x4*)(ngain + c), sh = *(const f32x4*)(nsh + b * 6144 + c), sc = *(const f32x4*)(nsc + b * 6144 + c);
          hb[2 * qq] = pk2(xn[4 * qq] * rstd * gn.x * (1.f + sc.x) + sh.x, xn[4 * qq + 1] * rstd * gn.y * (1.f + sc.y) + sh.y);
          hb[2 * qq + 1] = pk2(xn[4 * qq + 2] * rstd * gn.z * (1.f + sc.z) + sh.z, xn[4 * qq + 3] * rstd * gn.w * (1.f + sc.w) + sh.w);
        }
        *(uint4*)(HF + (size_t)t * 1024 + lane * 16) = make_uint4(hb[0], hb[1], hb[2], hb[3]);
        *(uint4*)(HF + (size_t)t * 1024 + lane * 16 + 8) = make_uint4(hb[4], hb[5], hb[6], hb[7]);
      } else {
#pragma unroll
        for (int qq = 0; qq < 4; ++qq) {
          const int c = lane * 16 + 4 * qq;
          const f32x4 fn = *(const f32x4*)(gin(pp->in[I_FNORM]) + c);
          *(f32x4*)((float*)pp->out + (size_t)t * 1024 + c) = (f32x4){xn[4 * qq] * rstd * fn.x, xn[4 * qq + 1] * rstd * fn.y, xn[4 * qq + 2] * rstd * fn.z, xn[4 * qq + 3] * rstd * fn.w};
        }
      }
    }
  }
}

#define XB_TMO      128
#define XB_XCNT(j)  (256  + 64 * (j))
#define XB_XSUB(j)  (1280 + 64 * (j))
#define XB_XGEN(j)  (2304 + 64 * (j))
#define XB_TOP      3328
#define XB_TOPGEN   3392
#define XCD_BAR_WORDS 3456
#define XB_SPIN_CAP (1u << 20)
#define LAS __attribute__((address_space(3)))
__device__ __forceinline__ unsigned xb_ld(unsigned* q)              { return __hip_atomic_load(q, __ATOMIC_RELAXED, __HIP_MEMORY_SCOPE_AGENT); }
__device__ __forceinline__ unsigned xb_add(unsigned* q, unsigned v) { return __hip_atomic_fetch_add(q, v, __ATOMIC_RELAXED, __HIP_MEMORY_SCOPE_AGENT); }
__device__ __forceinline__ unsigned xb_xcc_id() { return (unsigned)__builtin_amdgcn_s_getreg((3 << 11) | 20) & 0xFu; }
#define XB_SPIN(cond, bar) do { unsigned _sp = 0; while (cond) { __builtin_amdgcn_s_sleep(1); \
    if ((++_sp & 255u) == 0u) { if (xb_ld(&(bar)[XB_TMO])) break; if (_sp > XB_SPIN_CAP) { atomicAdd(&(bar)[XB_TMO], 1u); break; } } } } while (0)
struct XcdBarrier { unsigned* bar; unsigned x; volatile LAS unsigned* st; };
__device__ __forceinline__ XcdBarrier xcd_barrier_post(unsigned* bar, volatile LAS unsigned* st) {
    XcdBarrier b; b.bar = bar; b.x = xb_xcc_id(); b.st = st;
    if (threadIdx.x == 0) (void)xb_add(&bar[XB_XCNT(b.x)], 1u);
    return b;
}
__device__ __forceinline__ void xcd_barrier_complete(unsigned* bar, unsigned x, unsigned& nloc, unsigned& nx) {
    const unsigned G = gridDim.x * gridDim.y * gridDim.z;
    unsigned sum, cnt, mine, sp = 0u;
    for (;;) {
        sum = 0u; cnt = 0u; mine = 0u;
#pragma unroll
        for (unsigned j = 0; j < 16; ++j) { const unsigned c = xb_ld(&bar[XB_XCNT(j)]); sum += c; cnt += (c > 0u) ? 1u : 0u; mine = (j == x) ? c : mine; }
        if (sum == G) break;
        __builtin_amdgcn_s_sleep(1);
        if ((++sp & 255u) == 0u) { if (xb_ld(&bar[XB_TMO])) break; if (sp > XB_SPIN_CAP) { atomicAdd(&bar[XB_TMO], 1u); break; } }
    }
    nloc = mine > 0u ? mine : 1u; nx = cnt > 0u ? cnt : 1u;
}
__device__ __forceinline__ void xcd_barrier(const XcdBarrier& b) {
    asm volatile("s_waitcnt vmcnt(0)" ::: "memory");
    __syncthreads();
    if (threadIdx.x == 0) {
        unsigned* bar = b.bar;
        __builtin_amdgcn_s_waitcnt(0);
        unsigned nloc = b.st[0], nx = b.st[1];
        if (nloc == 0u) { xcd_barrier_complete(bar, b.x, nloc, nx); b.st[0] = nloc; b.st[1] = nx; }
        const unsigned old = xb_add(&bar[XB_XSUB(b.x)], 1u);
        const unsigned gen = old / nloc;
        if (old + 1u == (gen + 1u) * nloc) {
            __builtin_amdgcn_fence(__ATOMIC_RELEASE, "agent");
            asm volatile("s_waitcnt vmcnt(0)" ::: "memory");
            const unsigned og = xb_add(&bar[XB_TOP], 1u);
            const unsigned tg = og / nx;
            if (og + 1u == (tg + 1u) * nx) xb_add(&bar[XB_TOPGEN], 1u);
            else XB_SPIN(xb_ld(&bar[XB_TOPGEN]) == tg, bar);
            __builtin_amdgcn_fence(__ATOMIC_ACQUIRE, "agent");
            xb_add(&bar[XB_XGEN(b.x)], 1u);
            asm volatile("s_waitcnt vmcnt(0)" ::: "memory");
        } else {
            XB_SPIN(xb_ld(&bar[XB_XGEN(b.x)]) == gen, bar);
            __builtin_amdgcn_fence(__ATOMIC_ACQUIRE, "agent");
            asm volatile("s_waitcnt vmcnt(0)" ::: "memory");
        }
    }
    __syncthreads();
}

__global__ void __launch_bounds__(NT) fwd_megakernel(Params p) {
  extern __shared__ __attribute__((aligned(16))) unsigned char smem[];
  const CParamsP pp = launder_kargs();
  cg::grid_group grid = cg::this_grid();
  volatile LAS unsigned* xbst = (volatile LAS unsigned*)(smem + LDS_BYTES - 16);
  if (threadIdx.x == 0) { xbst[0] = 0u; xbst[1] = 0u; }
  if (blockIdx.x == 0) { unsigned* bw = (unsigned*)(pp->ws + WS_BAR); for (int i = threadIdx.x; i < XCD_BAR_WORDS; i += NT) bw[i] = 0u; }
  setup_phase(p, smem);
  grid.sync();
  const XcdBarrier xb = xcd_barrier_post((unsigned*)(pp->ws + WS_BAR), xbst);
  const float* MOD = (const float*)(pp->ws + WS_MOD);
  for (int l = 0; l < DEPTH_; ++l) {
    const float* xsrc = (l == 0) ? gin(pp->in[I_X]) : (const float*)(pp->ws + WS_X);
    const float* modl = MOD + (size_t)l * 2 * 6144;
    if (l == 0) {
      norm_mod_phase(xsrc, gin(pp->in[I_NMIX]), modl + 0, modl + 1024, (bf16_t*)(pp->ws + WS_ABUF));
      qbias_phase(p, smem);
      xcd_barrier(xb);
    }
    gemm_proj_phase(p, l, smem);
    xcd_barrier(xb);
    attn_phase(p, l, smem);
    mix_local_phase(p, l, smem);
    xcd_barrier(xb);
    scan_phase(p, l);
    xcd_barrier(xb);
    mix_final_phase(p, l, smem);
    xcd_barrier(xb);
    gemm_out_phase(p, l, xsrc, smem);
    xcd_barrier(xb);
    gemm_q_phase(p, l, smem);
    xcd_barrier(xb);
    peer_phase(p, l, l == DEPTH_ - 1, smem);
    xcd_barrier(xb);
  }
}

extern "C" void kernel_launch(void* const* d_in, const int* in_sizes, int n_in,
                              void* d_out, int out_size, void* d_ws, size_t ws_size,
                              hipStream_t stream) {
  static int grid_blocks = 0;
  if (grid_blocks == 0) {
    if (n_in != 24 || ws_size < WS_END) { fprintf(stderr, "kernel_launch: unexpected n_in %d / ws_size %zu (need %zu)\n", n_in, ws_size, (size_t)WS_END); grid_blocks = -1; return; }
    int dev = 0, cus = 0, per_cu = 0;
    if (hipGetDevice(&dev) != hipSuccess || hipDeviceGetAttribute(&cus, hipDeviceAttributeMultiprocessorCount, dev) != hipSuccess) { grid_blocks = -1; return; }
    if (hipFuncSetAttribute((const void*)fwd_megakernel, hipFuncAttributeMaxDynamicSharedMemorySize, LDS_BYTES) != hipSuccess) { fprintf(stderr, "hipFuncSetAttribute failed\n"); grid_blocks = -1; return; }
    if (hipOccupancyMaxActiveBlocksPerMultiprocessor(&per_cu, (const void*)fwd_megakernel, NT, LDS_BYTES) != hipSuccess || per_cu < 1) { fprintf(stderr, "occupancy query: %d\n", per_cu); grid_blocks = -1; return; }
    grid_blocks = cus;
  }
  if (grid_blocks < 0) return;
  Params p{};
  for (int i = 0; i < 24; ++i) p.in[i] = (const GAS float*)d_in[i];
  p.out = (GAS float*)d_out; p.ws = (GAS unsigned char*)d_ws;
  void* args[] = {&p};
  hipError_t e = hipLaunchCooperativeKernel((void*)fwd_megakernel, dim3(grid_blocks), dim3(NT), args, LDS_BYTES, stream);
  if (e != hipSuccess) fprintf(stderr, "cooperative launch failed: %s (grid %d)\n", hipGetErrorString(e), grid_blocks);
}
```

```cpp
#include <hip/hip_runtime.h>
#include <hip/hip_cooperative_groups.h>
#include <cstdio>
#include <cstdint>
namespace cg = cooperative_groups;

typedef unsigned short bf16_t;
typedef short bf16x8 __attribute__((ext_vector_type(8)));
typedef float f32x4 __attribute__((ext_vector_type(4)));
typedef float f32x16 __attribute__((ext_vector_type(16)));
typedef int i32x8 __attribute__((ext_vector_type(8)));

constexpr int T_ = 16384, D_ = 1024, L_ = 8192, NBATCH = 2, DEPTH_ = 4;
constexpr int INC = 2944, INCP = 3072;
constexpr int NCH = 128;
constexpr int NT = 512;
constexpr int NW = 8;
constexpr float EPS_ = 1e-6f;
constexpr int C_QA = 0, C_KA = 384, C_VA = 768, C_QR = 1152, C_KR = 1536, C_VR = 1920, C_GR = 2304, C_US = 2688;

constexpr size_t al256(size_t x) { return (x + 255) & ~(size_t)255; }
constexpr size_t WS_MOD   = 0;
constexpr size_t WS_ROTC  = al256(WS_MOD + 4ull * 2 * 6144 * 4);
constexpr size_t WS_ROTS  = al256(WS_ROTC + 8192ull * 32 * 4);
constexpr size_t WS_SA    = al256(WS_ROTS + 8192ull * 32 * 4);
constexpr size_t WS_SBB   = al256(WS_SA + 4ull * 16 * 64 * 2 * 4);
constexpr size_t WS_WIN   = al256(WS_SBB + 4ull * 16 * 64 * 32 * 4);
constexpr size_t WS_WOUT  = al256(WS_WIN + 4ull * INCP * 1024 * 2);
constexpr size_t WS_WQ    = al256(WS_WOUT + 4ull * 1024 * 1024 * 2);
constexpr size_t WS_SUBK  = al256(WS_WQ + 4ull * 2048 * 1024 * 2);
constexpr size_t WS_ABUF  = al256(WS_SUBK + 4ull * 16 * 128 * 128 * 2);
constexpr size_t WS_PROJ  = al256(WS_ABUF + (size_t)T_ * 1024 * 2);
constexpr size_t WS_VTA   = al256(WS_PROJ + (size_t)T_ * INCP * 2);
constexpr size_t WS_ATT   = al256(WS_VTA + 2ull * 6 * 64 * 8192 * 2);
constexpr size_t WS_YINT  = al256(WS_ATT + (size_t)T_ * 384 * 4);
constexpr size_t WS_UPD   = al256(WS_YINT + (size_t)T_ * 384 * 4);
constexpr size_t WS_SPREV = al256(WS_UPD + 256ull * 6 * 4096 * 4);
constexpr size_t WS_SEND  = al256(WS_SPREV + 256ull * 6 * 4096 * 4);
constexpr size_t WS_CARRY = al256(WS_SEND + 256ull * 16 * 64 * 2 * 4);
constexpr size_t WS_X     = al256(WS_CARRY + 256ull * 16 * 64 * 2 * 4);
constexpr size_t WS_Q     = al256(WS_X + (size_t)T_ * 1024 * 4);
constexpr size_t WS_SC    = al256(WS_Q + (size_t)T_ * 2048 * 2);
constexpr size_t WS_EIDX  = al256(WS_SC + (size_t)T_ * 2048 * 4);
constexpr size_t WS_EGATE = al256(WS_EIDX + (size_t)T_ * 128 * 4);
constexpr size_t WS_PU8   = al256(WS_EGATE + (size_t)T_ * 128 * 4);
constexpr size_t WS_PV8   = al256(WS_PU8 + 4ull * 16384 * 1024);
constexpr size_t WS_BAR   = al256(WS_PV8 + 4ull * 16384 * 1024);
constexpr size_t WS_SPT   = al256(WS_BAR + 3456ull * 4);
constexpr size_t WS_CB    = al256(WS_SPT + 256ull * 6 * 4096 * 2);
constexpr size_t WS_WGLUT = al256(WS_CB + 4ull * 16 * 16 * 128 * 2);
constexpr size_t WS_VTR   = al256(WS_WGLUT + 4ull * 512 * 256 * 2);
constexpr size_t WS_XG    = al256(WS_VTR + 2ull * 384 * 8192 * 2);
constexpr size_t WS_SSQ   = al256(WS_XG + (size_t)T_ * 1024 * 2);
constexpr size_t WS_C2    = al256(WS_SSQ + (size_t)T_ * 16 * 4);
constexpr size_t WS_BBH   = al256(WS_C2 + 4ull * 2 * 2048 * 4);
constexpr size_t WS_END   = al256(WS_BBH + 4ull * 16 * 2 * 64 * 16 * 2);

constexpr int LDS_BYTES = 135168;

#define GAS __attribute__((address_space(1)))
struct Params {
  const GAS float* in[24];
  GAS float* out;
  GAS unsigned char* ws;
};
enum { I_X = 0, I_C, I_WADA, I_BADA, I_NMIX, I_NFFN, I_WIN, I_RELB, I_LRE, I_LIM, I_LOGDT, I_BRE, I_BIM, I_CRE, I_CIM, I_SSMD,
       I_WGLU, I_MGAIN, I_WOUT, I_WQ, I_SUBK, I_PU, I_PV, I_FNORM };

__device__ __forceinline__ float bf2f(bf16_t v) { return __uint_as_float(((unsigned)v) << 16); }
__device__ __forceinline__ bf16_t f2bf(float f) { unsigned u = __float_as_uint(f); u += 0x7fffu + ((u >> 16) & 1u); return (bf16_t)(u >> 16); }
__device__ __forceinline__ unsigned pk2(float a, float b) { return (unsigned)f2bf(a) | ((unsigned)f2bf(b) << 16); }
__device__ __forceinline__ float wave_sum(float v) {
#pragma unroll
  for (int o = 32; o > 0; o >>= 1) v += __shfl_xor(v, o);
  return v;
}
__device__ __forceinline__ float wave_max(float v) {
#pragma unroll
  for (int o = 32; o > 0; o >>= 1) v = fmaxf(v, __shfl_xor(v, o));
  return v;
}
__device__ __forceinline__ float gelu_tanh(float x) { const float u = 0.7978845608028654f * (x + 0.044715f * x * x * x); return 0.5f * x * (1.f + tanhf(u)); }
__device__ __forceinline__ float sigmoid_f(float x) { return 1.f / (1.f + __expf(-x)); }
__device__ __forceinline__ float gelu_tanh_fast(float x) {
  const float u2 = 2.f * 0.7978845608028654f * 1.4426950408889634f * (x + 0.044715f * x * x * x);
  const float e = __builtin_amdgcn_exp2f(fminf(u2, 80.f));
  return x - x * __builtin_amdgcn_rcpf(1.f + e);
}
__device__ __forceinline__ GAS unsigned char* launder_ptr(GAS unsigned char* q) { asm volatile("" : "+s"(q)); return q; }
__device__ __forceinline__ const float* gin(const GAS float* q) { return (const float*)q; }
__device__ __forceinline__ const float* launder_cptr(const float* q) { asm volatile("" : "+s"(q)); return q; }
__device__ __forceinline__ int launder_tid() { int t = threadIdx.x; asm volatile("" : "+v"(t)); return t; }
typedef const Params __attribute__((address_space(4)))* CParamsP;
__device__ __forceinline__ CParamsP launder_kargs() { CParamsP q = (CParamsP)__builtin_amdgcn_kernarg_segment_ptr(); asm volatile("" : "+s"(q)); return q; }

__device__ __forceinline__ void convert_tables_fp4(const CParamsP pp, GAS unsigned char* ws, int layer, int gtid, int gn) {
  constexpr size_t NIT = 16384ull * 1024 / 16;
  for (size_t it = gtid; it < 2 * NIT; it += gn) {
    const int tb = it >= NIT ? 1 : 0; const size_t r = (it - (size_t)tb * NIT) + (size_t)layer * NIT;
    const f32x4* src = (const f32x4*)((tb ? gin(pp->in[I_PV]) : gin(pp->in[I_PU])) + r * 16);
    const float sc = tb ? 4.f : 64.f;
    unsigned o[2] = {0u, 0u};
#pragma unroll
    for (int q = 0; q < 4; ++q) {
      const f32x4 a = src[q];
      const float x0 = fminf(fmaxf(a.x * sc, -6.f), 6.f), x1 = fminf(fmaxf(a.y * sc, -6.f), 6.f);
      const float x2 = fminf(fmaxf(a.z * sc, -6.f), 6.f), x3 = fminf(fmaxf(a.w * sc, -6.f), 6.f);
      if (q == 0)      { o[0] = __builtin_amdgcn_cvt_scalef32_pk_fp4_f32(o[0], x0, x1, 1.0f, 0); o[0] = __builtin_amdgcn_cvt_scalef32_pk_fp4_f32(o[0], x2, x3, 1.0f, 1); }
      else if (q == 1) { o[0] = __builtin_amdgcn_cvt_scalef32_pk_fp4_f32(o[0], x0, x1, 1.0f, 2); o[0] = __builtin_amdgcn_cvt_scalef32_pk_fp4_f32(o[0], x2, x3, 1.0f, 3); }
      else if (q == 2) { o[1] = __builtin_amdgcn_cvt_scalef32_pk_fp4_f32(o[1], x0, x1, 1.0f, 0); o[1] = __builtin_amdgcn_cvt_scalef32_pk_fp4_f32(o[1], x2, x3, 1.0f, 1); }
      else             { o[1] = __builtin_amdgcn_cvt_scalef32_pk_fp4_f32(o[1], x0, x1, 1.0f, 2); o[1] = __builtin_amdgcn_cvt_scalef32_pk_fp4_f32(o[1], x2, x3, 1.0f, 3); }
    }
    *(uint2*)(ws + (tb ? WS_PV8 : WS_PU8) + r * 8) = make_uint2(o[0], o[1]);
  }
}

__device__ void setup_phase(const Params& p, unsigned char* smem) {
  const CParamsP pp = launder_kargs();
  GAS unsigned char* const ws = launder_ptr(pp->ws); const int tidx = launder_tid(); (void)ws; (void)tidx;
  const int tid = tidx;
  float* sm = (float*)smem;
  {
    float* cond = sm;
    float* red = sm + 2048;
    float* MOD = (float*)(ws + WS_MOD);
    for (int i = tid; i < 2048; i += NT) { const float c = gin(pp->in[I_C])[i]; cond[i] = c * sigmoid_f(c); }
    __syncthreads();
    for (int item = blockIdx.x; item < 4 * 96; item += gridDim.x) {
      const int l = item / 96, cb = item % 96, kq = tid >> 6, jj = tid & 63, j = cb * 64 + jj;
      const float* w = gin(pp->in[I_WADA]) + (size_t)l * 1024 * 6144 + j;
      float a0 = 0.f, a1 = 0.f;
#pragma unroll 16
      for (int k = kq * 128; k < kq * 128 + 128; ++k) { const float wv = w[(size_t)k * 6144]; a0 += cond[k] * wv; a1 += cond[1024 + k] * wv; }
      red[(kq * 2 + 0) * 64 + jj] = a0; red[(kq * 2 + 1) * 64 + jj] = a1;
      __syncthreads();
      if (tid < 128) {
        const int b = tid >> 6, j2 = tid & 63; float s = 0.f;
        for (int q = 0; q < 8; ++q) s += red[(q * 2 + b) * 64 + j2];
        MOD[((size_t)l * 2 + b) * 6144 + cb * 64 + j2] = s + gin(pp->in[I_BADA])[(size_t)l * 6144 + cb * 64 + j2];
      }
      __syncthreads();
    }
  }
  const int gtid = blockIdx.x * NT + tid, gn = gridDim.x * NT;
  {
    float* RC = (float*)(ws + WS_ROTC); float* RS = (float*)(ws + WS_ROTS);
    for (int idx = gtid; idx < 8192 * 32; idx += gn) {
      const int pos = idx >> 5, i = idx & 31;
      const float inv = powf(10000.0f, -(float)i / 32.0f);
      const float ang = (float)pos * inv;
      float s, c; sincosf(ang, &s, &c);
      RC[idx] = c; RS[idx] = s;
    }
  }
  {
    float* SA = (float*)(ws + WS_SA); float* SBB = (float*)(ws + WS_SBB); bf16_t* BBH = (bf16_t*)(ws + WS_BBH);
    for (int idx = gtid; idx < 4 * 16 * 64; idx += gn) {
      const int l = idx / 1024, g = (idx >> 6) & 15;
      const float dt = expf(gin(pp->in[I_LOGDT])[l * 16 + g]);
      const float lr = gin(pp->in[I_LRE])[idx], li = gin(pp->in[I_LIM])[idx];
      const float mag = expf(lr * dt);
      float sn, cs; sincosf(li * dt, &sn, &cs);
      const float are = mag * cs, aim = mag * sn;
      const float den = lr * lr + li * li, nr = are - 1.f, ni = aim;
      const float fre = (nr * lr + ni * li) / den, fim = (ni * lr - nr * li) / den;
      SA[idx * 2] = are; SA[idx * 2 + 1] = aim;
      for (int c = 0; c < 16; ++c) {
        const float br = gin(pp->in[I_BRE])[(size_t)idx * 16 + c], bi = gin(pp->in[I_BIM])[(size_t)idx * 16 + c];
        SBB[(size_t)idx * 32 + c] = fre * br - fim * bi;
        SBB[(size_t)idx * 32 + 16 + c] = fre * bi + fim * br;
        {
          const int pq = idx & 63; const size_t fb = (size_t)(idx >> 6) * 2;
          BBH[(((fb + 0) * 2 + (pq >> 5)) * 64 + 32 * (c >> 3) + (pq & 31)) * 8 + (c & 7)] = f2bf(fre * br - fim * bi);
          BBH[(((fb + 1) * 2 + (pq >> 5)) * 64 + 32 * (c >> 3) + (pq & 31)) * 8 + (c & 7)] = f2bf(fre * bi + fim * br);
        }
      }
    }
  }
  {
    bf16_t* CB = (bf16_t*)(ws + WS_CB);
    for (int idx = gtid; idx < 4 * 16 * 16 * 128; idx += gn) {
      const int k = idx & 127, lgc = idx >> 7;
      const bf16_t cv = (k < 64) ? f2bf(gin(pp->in[I_CRE])[(size_t)lgc * 64 + k]) : f2bf(-gin(pp->in[I_CIM])[(size_t)lgc * 64 + (k - 64)]);
      const int cc = lgc & 15, lg = lgc >> 4;
      CB[(((size_t)lg * 4 + (k >> 5)) * 64 + ((k >> 3) & 3) * 16 + cc) * 8 + (k & 7)] = cv;
    }
    bf16_t* WG = (bf16_t*)(ws + WS_WGLUT);
    for (int idx = gtid; idx < 4 * 512 * 256; idx += gn) {
      const int k = idx & 255, nn = (idx >> 8) & 511, l2 = idx >> 17;
      {
        const int which = nn >> 8, w8 = (nn >> 5) & 7, nt = (nn >> 4) & 1, frr = nn & 15, ks = k >> 5, fqq = (k >> 3) & 3, j = k & 7;
        WG[(((((size_t)l2 * 8 + w8) * 8 + ks) * 2 + which) * 2 + nt) * 512 + (fqq * 16 + frr) * 8 + j] = f2bf(gin(pp->in[I_WGLU])[((size_t)l2 * 256 + k) * 512 + nn]);
      }
    }
  }
  convert_tables_fp4(pp, ws, 0, gtid, gn);
  {
    __syncthreads();
    const int lane = tid & 63, wid = tid >> 6;
    float* scr = sm + wid * (64 * 33);
    constexpr int IT_IN = 16 * 96, IT_OUT = 16 * 32, IT_L = IT_IN + IT_OUT;
    for (int item = blockIdx.x * NW + wid; item < 4 * IT_L; item += gridDim.x * NW) {
      const int l = item / IT_L; int r = item - l * IT_L;
      const float* W; bf16_t* WT; int N, NP;
      if (r < IT_IN) { W = gin(pp->in[I_WIN]) + (size_t)l * 1024 * INC; WT = (bf16_t*)(ws + WS_WIN) + (size_t)l * INCP * 1024; N = INC; NP = 96; }
      else { r -= IT_IN; W = gin(pp->in[I_WOUT]) + (size_t)l * 1024 * 1024; WT = (bf16_t*)(ws + WS_WOUT) + (size_t)l * 1024 * 1024; N = 1024; NP = 32; }
      const int kb = r / NP, nb = r - kb * NP, k0 = kb * 64, n0 = nb * 32;
      const int nn = n0 + (lane & 31); const bool inb = nn < N;
      float v[32];
#pragma unroll
      for (int i = 0; i < 32; ++i) { const int kk = 2 * i + (lane >> 5); v[i] = inb ? W[(size_t)(k0 + kk) * N + nn] : 0.f; }
#pragma unroll
      for (int i = 0; i < 32; ++i) { const int kk = 2 * i + (lane >> 5); scr[kk * 33 + (lane & 31)] = v[i]; }
      const int c = lane & 7;
#pragma unroll
      for (int j = 0; j < 4; ++j) {
        const int n = (lane >> 3) + 8 * j; const float* sp = scr + (8 * c) * 33 + n;
        uint4 o; o.x = pk2(sp[0], sp[33]); o.y = pk2(sp[2 * 33], sp[3 * 33]); o.z = pk2(sp[4 * 33], sp[5 * 33]); o.w = pk2(sp[6 * 33], sp[7 * 33]);
        *(uint4*)(WT + (size_t)(n0 + n) * 1024 + k0 + 8 * c) = o;
      }
    }
    __syncthreads();
  }
  {
    float* WtT = sm;
    float* SKs = sm + 128 * 65;
    bf16_t* WP = (bf16_t*)(ws + WS_WQ);
    for (int item = blockIdx.x; item < 4 * 16 * 16; item += gridDim.x) {
      const int l = item >> 8, hs = (item >> 4) & 15, kb = item & 15, k0 = kb * 64;
      const float* Wq = gin(pp->in[I_WQ]) + (size_t)l * 1024 * 2048 + hs * 128;
      const float* SKg = gin(pp->in[I_SUBK]) + ((size_t)l * 16 + hs) * 128 * 128;
      __syncthreads();
#pragma unroll
      for (int i = 0; i < 16; ++i) { const int idx = tid + NT * i, kk = idx >> 7, d = idx & 127; WtT[d * 65 + kk] = Wq[(size_t)(k0 + kk) * 2048 + d]; }
#pragma unroll
      for (int i = 0; i < 32; ++i) { const int idx = tid + NT * i, key = idx >> 7, d = idx & 127; SKs[key * 129 + d] = SKg[idx]; }
      __syncthreads();
      const int key = tid & 127, kg = tid >> 7;
      float acc[16];
#pragma unroll
      for (int i = 0; i < 16; ++i) acc[i] = 0.f;
#pragma unroll 4
      for (int d = 0; d < 128; ++d) {
        const float sv = SKs[key * 129 + d];
#pragma unroll
        for (int i = 0; i < 16; ++i) acc[i] += sv * WtT[d * 65 + kg * 16 + i];
      }
      uint4 o0, o1;
      o0.x = pk2(acc[0], acc[1]); o0.y = pk2(acc[2], acc[3]); o0.z = pk2(acc[4], acc[5]); o0.w = pk2(acc[6], acc[7]);
      o1.x = pk2(acc[8], acc[9]); o1.y = pk2(acc[10], acc[11]); o1.z = pk2(acc[12], acc[13]); o1.w = pk2(acc[14], acc[15]);
      bf16_t* dst = WP + ((size_t)l * 2048 + hs * 128 + key) * 1024 + k0 + kg * 16;
      *(uint4*)dst = o0; *(uint4*)(dst + 8) = o1;
    }
    __syncthreads();
  }
}

__device__ void qbias_phase(const Params& p, unsigned char* smem) {
  const CParamsP pp = launder_kargs();
  GAS unsigned char* const ws = launder_ptr(pp->ws); const int tid = launder_tid();
  float* C2 = (float*)(ws + WS_C2); const float* MOD = (const float*)(ws + WS_MOD); const bf16_t* WP = (const bf16_t*)(ws + WS_WQ);
  const int lane = tid & 63, gw = blockIdx.x * NW + (tid >> 6), nw = gridDim.x * NW;
  for (int o = gw; o < 4 * 2048; o += nw) {
    const int l = o >> 11;
    const uint4 w0 = *(const uint4*)(WP + (size_t)o * 1024 + lane * 16), w1 = *(const uint4*)(WP + (size_t)o * 1024 + lane * 16 + 8);
    const unsigned ww[8] = {w0.x, w0.y, w0.z, w0.w, w1.x, w1.y, w1.z, w1.w};
    const float* s0 = MOD + (size_t)l * 2 * 6144 + 3072 + lane * 16; const float* s1 = s0 + 6144;
    float a0 = 0.f, a1 = 0.f;
#pragma unroll
    for (int q = 0; q < 8; ++q) {
      const float wl = __uint_as_float(ww[q] << 16), wh = __uint_as_float(ww[q] & 0xffff0000u);
      a0 += s0[2 * q] * wl + s0[2 * q + 1] * wh; a1 += s1[2 * q] * wl + s1[2 * q + 1] * wh;
    }
    a0 = wave_sum(a0); a1 = wave_sum(a1);
    if (lane == 0) { C2[((size_t)l * 2 + 0) * 2048 + (o & 2047)] = a0; C2[((size_t)l * 2 + 1) * 2048 + (o & 2047)] = a1; }
  }
  (void)smem;
}

__device__ void norm_mod_phase(const float* __restrict__ xsrc, const float* __restrict__ gain, const float* __restrict__ mod_sh, const float* __restrict__ mod_sc,
                               bf16_t* __restrict__ outp) {
  const int tidx = launder_tid();
  const int lane = tidx & 63, gw = blockIdx.x * NW + (tidx >> 6), nw = gridDim.x * NW;
  for (int t = gw; t < T_; t += nw) {
    const int b = t >> 13;
    const f32x4* xr = (const f32x4*)(xsrc + (size_t)t * 1024) + lane;
    f32x4 v[4]; float s = 0.f;
#pragma unroll
    for (int j = 0; j < 4; ++j) { v[j] = xr[64 * j]; s += v[j].x * v[j].x + v[j].y * v[j].y + v[j].z * v[j].z + v[j].w * v[j].w; }
    const float rstd = rsqrtf(wave_sum(s) * (1.f / 1024.f) + EPS_);
#pragma unroll
    for (int j = 0; j < 4; ++j) {
      const int c = lane * 4 + 256 * j;
      const f32x4 g = *(const f32x4*)(gain + c), sh = *(const f32x4*)(mod_sh + b * 6144 + c), sc = *(const f32x4*)(mod_sc + b * 6144 + c);
      const float o0 = v[j].x * rstd * g.x * (1.f + sc.x) + sh.x, o1 = v[j].y * rstd * g.y * (1.f + sc.y) + sh.y;
      const float o2 = v[j].z * rstd * g.z * (1.f + sc.z) + sh.z, o3 = v[j].w * rstd * g.w * (1.f + sc.w) + sh.w;
      uint2 o; o.x = pk2(o0, o1); o.y = pk2(o2, o3);
      *(uint2*)(outp + (size_t)t * 1024 + c) = o;
    }
  }
}


namespace pg8 {
#define PG8_LAS __attribute__((address_space(3)))
typedef unsigned u32x4 __attribute__((ext_vector_type(4)));
constexpr int BM = 256, BK = 64, HALF = 128, HTB = HALF * BK * 2, STAGE_BYTES = 8 * HTB, NXCD = 8, WGM = 8;
__host__ __device__ __forceinline__ int lds_byte(int r, int c) { const int st = (r >> 4) * 2 + (c >> 5), rr = r & 15, cc = c & 31, ob = rr * 64 + cc * 2; return st * 1024 + (ob ^ (((ob >> 9) & 1) << 5)); }
__host__ __device__ __forceinline__ void stage_rc(int b, int& R, int& C) { const int st = b / 1024, sb = b % 1024, swz = sb ^ (((sb >> 9) & 1) << 5); R = (st >> 1) * 16 + swz / 64; C = (st & 1) * 32 + (swz % 64) / 2; }
__host__ __device__ __forceinline__ int perm32(int rho) { const int n = rho >> 4, i = rho & 15; return 8 * (i >> 2) + 4 * n + (i & 3); }
struct Unit { int pm, pn; };
struct Gemm { const bf16_t* A; const bf16_t* Bt; int M, N, K; };
struct StaticOrder {
    int nM, nN, nwg, G, c;
    __host__ __device__ void init(int M, int N, int G_, int c_) { nM = M / BM; nN = N / BM; nwg = nM * nN; G = G_; c = c_; }
    __host__ __device__ bool next(int i, Unit& u) const {
        const long L = (long)i * G + c; if (L >= nwg) return false;
        int wgid = (int)L; { const int q = nwg / NXCD, r = nwg % NXCD, xcd = wgid % NXCD, off = wgid / NXCD; wgid = (xcd < r ? xcd * (q + 1) : r * (q + 1) + (xcd - r) * q) + off; }
        const int nig = WGM * nN, gid = wgid / nig, fm = gid * WGM, gsz = (nM - fm) < WGM ? (nM - fm) : WGM;
        u.pm = fm + ((wgid % nig) % gsz); u.pn = (wgid % nig) / gsz; return true;
    }
    __device__ __forceinline__ void a_ready(const Unit&) const {}
    __device__ __forceinline__ void done(const Unit&) const {}
};
__device__ __forceinline__ unsigned cvt_pk_bf16(float lo, float hi) { unsigned r; asm volatile("v_cvt_pk_bf16_f32 %0, %1, %2" : "=v"(r) : "v"(lo), "v"(hi)); return r; }
template <class Epi, class Sched>
__device__ __forceinline__ void gemm_phase(PG8_LAS unsigned char* lds, const Gemm g, const Sched& S, const Epi& E) {
    const int tid = launder_tid(), wid = __builtin_amdgcn_readfirstlane(tid >> 6), lane = tid & 63, wr = wid >> 2, wc = wid & 3, fr = lane & 15, fq = lane >> 4;
    const int K = g.K, nt = K / BK;
    unsigned voffA[2], voffB[2];
#pragma unroll
    for (int i = 0; i < 2; ++i) { int R, C; stage_rc(tid * 16 + i * 8192, R, C); const int Rb = Epi::PERM ? ((R & ~31) + perm32(R & 31)) : R;
        voffA[i] = (unsigned)(R * K + C) * 2u; voffB[i] = (unsigned)(Rb * K + C) * 2u; }
    const size_t kstep = (size_t)(BK * 2);
    const size_t hstep = (size_t)HALF * K * 2;
    const size_t tstep = 2 * hstep;
    const unsigned ldsw = (unsigned)wid * 1024u;
    const int aoff = lds_byte(wr * 64 + fr, fq * 8), boff = lds_byte(wc * 32 + fr, fq * 8);
#define PG8_SA(b, h) (((b) * 2 + (h)) * HTB)
#define PG8_SB(b, h) ((4 + (b) * 2 + (h)) * HTB)
#define PG8_STAGE(bufoff, gbase, voff) do { _Pragma("unroll") for (int _i = 0; _i < 2; ++_i) \
        __builtin_amdgcn_global_load_lds((const unsigned*)((const char*)(gbase) + (voff)[_i]), (PG8_LAS unsigned*)(lds + (bufoff) + ldsw + _i * 8192), 16, 0, 0); } while (0)
#define PG8_LDA(dst, b, h) do { _Pragma("unroll") for (int m = 0; m < 4; ++m) _Pragma("unroll") for (int k = 0; k < 2; ++k) dst[m][k] = *(const PG8_LAS bf16x8*)(lds + PG8_SA(b, h) + aoff + m * 2048 + k * 1024); } while (0)
#define PG8_LDB(dst, b, h) do { _Pragma("unroll") for (int n = 0; n < 2; ++n) _Pragma("unroll") for (int k = 0; k < 2; ++k) dst[n][k] = *(const PG8_LAS bf16x8*)(lds + PG8_SB(b, h) + boff + n * 2048 + k * 1024); } while (0)
#define PG8_MMA(ai, bj, At, Bt) do { __builtin_amdgcn_s_setprio(1); _Pragma("unroll") for (int m = 0; m < 4; ++m) _Pragma("unroll") for (int n = 0; n < 2; ++n) _Pragma("unroll") for (int k = 0; k < 2; ++k) \
        acc[ai][bj][m][n] = __builtin_amdgcn_mfma_f32_16x16x32_bf16(Bt[n][k], At[m][k], acc[ai][bj][m][n], 0, 0, 0); __builtin_amdgcn_s_setprio(0); } while (0)
#define PG8_WAIT_V(n) asm volatile("s_waitcnt vmcnt(" #n ")" ::: "memory")
#define PG8_WAIT_L(n) asm volatile("s_waitcnt lgkmcnt(" #n ")" ::: "memory")
#define PG8_BAR __builtin_amdgcn_s_barrier()
#define PG8_SCHED __builtin_amdgcn_sched_barrier(0)
    Unit cur, nxt; int ui = 0;
    if (!S.next(0, cur)) return;
    f32x4 acc[2][2][4][2];
#pragma unroll
    for (int a = 0; a < 2; ++a)
#pragma unroll
        for (int b = 0; b < 2; ++b)
#pragma unroll
            for (int m = 0; m < 4; ++m)
#pragma unroll
                for (int n = 0; n < 2; ++n) acc[a][b][m][n] = (f32x4){0.f, 0.f, 0.f, 0.f};
    bf16x8 At[4][2], B0[2][2], B1[2][2];
    const char* cA = (const char*)g.A + (size_t)cur.pm * tstep; const char* cB = (const char*)g.Bt + (size_t)cur.pn * tstep;
    S.a_ready(cur);
    PG8_STAGE(PG8_SB(0, 0), cB, voffB); PG8_STAGE(PG8_SA(0, 0), cA, voffA); PG8_STAGE(PG8_SB(0, 1), cB + hstep, voffB); PG8_STAGE(PG8_SA(0, 1), cA + hstep, voffA);
    if (wr == 1) PG8_BAR;
    PG8_WAIT_V(4); PG8_BAR;
    PG8_STAGE(PG8_SB(1, 0), cB + kstep, voffB); PG8_STAGE(PG8_SA(1, 0), cA + kstep, voffA); PG8_STAGE(PG8_SB(1, 1), cB + hstep + kstep, voffB);
    PG8_WAIT_V(6); PG8_BAR;
    for (;;) {
        const bool has_next = S.next(ui + 1, nxt);
        const char* nA = has_next ? (const char*)g.A + (size_t)nxt.pm * tstep : cA; const char* nB = has_next ? (const char*)g.Bt + (size_t)nxt.pn * tstep : cB;
        for (int t = 0; t < nt; t += 2) {
            const bool last = (t == nt - 2);
            const char* a1 = cA + (size_t)(t + 1) * kstep;
            const char* a2 = last ? nA : cA + (size_t)(t + 2) * kstep; const char* b2 = last ? nB : cB + (size_t)(t + 2) * kstep;
            const char* a3 = a2 + kstep; const char* b3 = b2 + kstep;
            if (last && has_next) S.a_ready(nxt);
            PG8_LDB(B0, 0, 0); PG8_SCHED; PG8_LDA(At, 0, 0); PG8_STAGE(PG8_SA(1, 1), a1 + hstep, voffA);
            PG8_WAIT_L(8); PG8_BAR; PG8_WAIT_L(0); PG8_MMA(0, 0, At, B0); PG8_BAR; PG8_SCHED;
            PG8_LDB(B1, 0, 1); PG8_STAGE(PG8_SB(0, 0), b2, voffB);
            PG8_BAR; PG8_WAIT_L(0); PG8_MMA(0, 1, At, B1); PG8_BAR;
            PG8_LDA(At, 0, 1); PG8_STAGE(PG8_SA(0, 0), a2, voffA);
            PG8_BAR; PG8_WAIT_L(0); PG8_MMA(1, 0, At, B0); PG8_BAR; PG8_SCHED;
            PG8_STAGE(PG8_SB(0, 1), b2 + hstep, voffB);
            PG8_WAIT_V(6); PG8_BAR; PG8_MMA(1, 1, At, B1); PG8_BAR;
            PG8_LDB(B0, 1, 0); PG8_SCHED; PG8_LDA(At, 1, 0); PG8_STAGE(PG8_SA(0, 1), a2 + hstep, voffA);
            PG8_WAIT_L(8); PG8_BAR; PG8_WAIT_L(0); PG8_MMA(0, 0, At, B0); PG8_BAR; PG8_SCHED;
            PG8_LDB(B1, 1, 1); PG8_STAGE(PG8_SB(1, 0), b3, voffB);
            PG8_BAR; PG8_WAIT_L(0); PG8_MMA(0, 1, At, B1); PG8_BAR;
            PG8_LDA(At, 1, 1); PG8_STAGE(PG8_SA(1, 0), a3, voffA);
            PG8_BAR; PG8_WAIT_L(0); PG8_MMA(1, 0, At, B0); PG8_BAR; PG8_SCHED;
            PG8_STAGE(PG8_SB(1, 1), b3 + hstep, voffB);
            PG8_WAIT_V(6); PG8_BAR; PG8_MMA(1, 1, At, B1); PG8_BAR;
        }
        if constexpr (!Epi::AFTER_DRAIN) { E(acc, cur, wr, wc, fr, fq); S.done(cur); }
        if (!has_next) break;
#pragma unroll
        for (int a = 0; a < 2; ++a)
#pragma unroll
            for (int b = 0; b < 2; ++b)
#pragma unroll
                for (int m = 0; m < 4; ++m)
#pragma unroll
                    for (int n = 0; n < 2; ++n) acc[a][b][m][n] = (f32x4){0.f, 0.f, 0.f, 0.f};
        cur = nxt; cA = nA; cB = nB; ++ui;
    }
    PG8_WAIT_V(0);
    if (wr == 0) PG8_BAR;
    PG8_BAR;
    if constexpr (Epi::AFTER_DRAIN) { E.fused(acc, cur, wr, wc, fr, fq, lds, wid, lane); S.done(cur); }
#undef PG8_SA
#undef PG8_SB
#undef PG8_STAGE
#undef PG8_LDA
#undef PG8_LDB
#undef PG8_MMA
#undef PG8_WAIT_V
#undef PG8_WAIT_L
#undef PG8_BAR
#undef PG8_SCHED
}
}

__device__ __forceinline__ float ssq_total(const float* __restrict__ SSQ, int t) {
  const f32x4 a = *(const f32x4*)(SSQ + (size_t)t * 16), b = *(const f32x4*)(SSQ + (size_t)t * 16 + 4), c = *(const f32x4*)(SSQ + (size_t)t * 16 + 8), d = *(const f32x4*)(SSQ + (size_t)t * 16 + 12);
  return (((a.x + a.y) + (a.z + a.w)) + ((b.x + b.y) + (b.z + b.w))) + (((c.x + c.y) + (c.z + c.w)) + ((d.x + d.y) + (d.z + d.w)));
}
struct EpiProj {
  static constexpr bool PERM = true, AFTER_DRAIN = false;
  bf16_t* PROJ; bf16_t* VTA; bf16_t* VTR;
  __device__ __forceinline__ void operator()(const f32x4 (&acc)[2][2][4][2], const pg8::Unit& u, int wr, int wc, int fr, int fq) const {
    const int row0 = u.pm * 256 + wr * 64 + fr, col0 = u.pn * 256 + wc * 32 + 8 * fq;
#pragma unroll
    for (int ai = 0; ai < 2; ++ai)
#pragma unroll
      for (int m = 0; m < 4; ++m) {
        const int t = row0 + ai * 128 + m * 16;
#pragma unroll
        for (int bj = 0; bj < 2; ++bj) {
          const int c = col0 + bj * 128;
          const f32x4 v0 = acc[ai][bj][m][0], v1 = acc[ai][bj][m][1];
          pg8::u32x4 w; w.x = pg8::cvt_pk_bf16(v0[0], v0[1]); w.y = pg8::cvt_pk_bf16(v0[2], v0[3]); w.z = pg8::cvt_pk_bf16(v1[0], v1[1]); w.w = pg8::cvt_pk_bf16(v1[2], v1[3]);
          *(pg8::u32x4*)(PROJ + (size_t)t * INCP + c) = w;
          const bool isva = (c >= C_VA && c < C_VA + 384), isvr = (c >= C_VR && c < C_VR + 384);
          if (isva || isvr) {
            bf16_t* vt = (isva ? VTA : VTR) + ((size_t)(t >> 13) * 384 + (c - (isva ? C_VA : C_VR))) * 8192 + (t & 8191);
            vt[0] = (bf16_t)(w.x & 0xffffu); vt[8192] = (bf16_t)(w.x >> 16); vt[2 * 8192] = (bf16_t)(w.y & 0xffffu); vt[3 * 8192] = (bf16_t)(w.y >> 16);
            vt[4 * 8192] = (bf16_t)(w.z & 0xffffu); vt[5 * 8192] = (bf16_t)(w.z >> 16); vt[6 * 8192] = (bf16_t)(w.w & 0xffffu); vt[7 * 8192] = (bf16_t)(w.w >> 16);
          }
        }
      }
  }
};
struct EpiOut {
  static constexpr bool PERM = false, AFTER_DRAIN = false;
  const float* xin; int first; bf16_t* X; const float* g1; const float* nf; const float* sc2; bf16_t* XG; float* SSQ;
  __device__ __forceinline__ void operator()(const f32x4 (&acc)[2][2][4][2], const pg8::Unit& u, int wr, int wc, int fr, int fq) const {
    const int row0 = u.pm * 256 + wr * 64 + fr, col0 = u.pn * 256 + wc * 32 + 4 * fq, b = (u.pm * 256) >> 13;
    f32x4 gg[2][2], gs[2][2];
#pragma unroll
    for (int bj = 0; bj < 2; ++bj)
#pragma unroll
      for (int n = 0; n < 2; ++n) {
        const int c = col0 + bj * 128 + n * 16;
        gg[bj][n] = *(const f32x4*)(g1 + b * 6144 + c);
        const f32x4 gf = *(const f32x4*)(nf + c), sc = *(const f32x4*)(sc2 + b * 6144 + c);
        gs[bj][n] = gf * (sc + 1.f);
      }
#pragma unroll
    for (int ai = 0; ai < 2; ++ai)
#pragma unroll
      for (int m = 0; m < 4; ++m) {
        const int t = row0 + ai * 128 + m * 16;
        float sq = 0.f;
#pragma unroll
        for (int bj = 0; bj < 2; ++bj)
#pragma unroll
          for (int n = 0; n < 2; ++n) {
            const int c = col0 + bj * 128 + n * 16;
            f32x4 xv;
            if (first) xv = *(const f32x4*)(xin + (size_t)t * 1024 + c);
            else { const uint2 xr = *(const uint2*)(X + (size_t)t * 1024 + c); xv = (f32x4){__uint_as_float(xr.x << 16), __uint_as_float(xr.x & 0xffff0000u), __uint_as_float(xr.y << 16), __uint_as_float(xr.y & 0xffff0000u)}; }
            const f32x4 xn = xv + gg[bj][n] * acc[ai][bj][m][n];
            { uint2 xo; xo.x = pg8::cvt_pk_bf16(xn.x, xn.y); xo.y = pg8::cvt_pk_bf16(xn.z, xn.w); *(uint2*)(X + (size_t)t * 1024 + c) = xo; }
            const f32x4 xs = xn * gs[bj][n];
            uint2 o; o.x = pg8::cvt_pk_bf16(xs.x, xs.y); o.y = pg8::cvt_pk_bf16(xs.z, xs.w);
            *(uint2*)(XG + (size_t)t * 1024 + c) = o;
            sq += (xn.x * xn.x + xn.y * xn.y) + (xn.z * xn.z + xn.w * xn.w);
          }
        sq += __shfl_xor(sq, 16); sq += __shfl_xor(sq, 32);
        if (fq == 0) SSQ[(size_t)t * 16 + u.pn * 4 + wc] = sq;
      }
  }
};
struct EpiQ {
  static constexpr bool PERM = true, AFTER_DRAIN = false;
  bf16_t* SC8; const float* SSQ; const float* C2;
  __device__ __forceinline__ void operator()(const f32x4 (&acc)[2][2][4][2], const pg8::Unit& u, int wr, int wc, int fr, int fq) const {
    const int row0 = u.pm * 256 + wr * 64 + fr, col0 = u.pn * 256 + wc * 32 + 8 * fq, b = (u.pm * 256) >> 13;
    f32x4 cc[2][2];
#pragma unroll
    for (int bj = 0; bj < 2; ++bj) { cc[bj][0] = *(const f32x4*)(C2 + b * 2048 + col0 + bj * 128); cc[bj][1] = *(const f32x4*)(C2 + b * 2048 + col0 + bj * 128 + 4); }
#pragma unroll
    for (int ai = 0; ai < 2; ++ai)
#pragma unroll
      for (int m = 0; m < 4; ++m) {
        const int t = row0 + ai * 128 + m * 16;
        const float rstd = rsqrtf(ssq_total(SSQ, t) * (1.f / 1024.f) + EPS_);
#pragma unroll
        for (int bj = 0; bj < 2; ++bj) {
          const f32x4 v0 = acc[ai][bj][m][0] * rstd + cc[bj][0], v1 = acc[ai][bj][m][1] * rstd + cc[bj][1];
          pg8::u32x4 w; w.x = pg8::cvt_pk_bf16(v0[0], v0[1]); w.y = pg8::cvt_pk_bf16(v0[2], v0[3]); w.z = pg8::cvt_pk_bf16(v1[0], v1[1]); w.w = pg8::cvt_pk_bf16(v1[2], v1[3]);
          *(pg8::u32x4*)(SC8 + ((size_t)((col0 + bj * 128) >> 3) * T_ + t) * 8) = w;
        }
      }
  }
};

__device__ void gemm_proj_phase(const Params& p, int l, unsigned char* smem) {
  const CParamsP pp = launder_kargs();
  GAS unsigned char* const ws = launder_ptr(pp->ws);
  pg8::Gemm g; g.A = (const bf16_t*)(ws + WS_ABUF); g.Bt = (const bf16_t*)(ws + WS_WIN) + (size_t)l * INCP * 1024; g.M = T_; g.N = INCP; g.K = 1024;
  pg8::StaticOrder S; S.init(T_, INCP, gridDim.x, blockIdx.x);
  EpiProj E; E.PROJ = (bf16_t*)(ws + WS_PROJ); E.VTA = (bf16_t*)(ws + WS_VTA); E.VTR = (bf16_t*)(ws + WS_VTR);
  pg8::gemm_phase<EpiProj, pg8::StaticOrder>((PG8_LAS unsigned char*)smem, g, S, E);
}
__device__ void gemm_out_phase(const Params& p, int l, unsigned char* smem) {
  const CParamsP pp = launder_kargs();
  GAS unsigned char* const ws = launder_ptr(pp->ws);
  pg8::Gemm g; g.A = (const bf16_t*)(ws + WS_ABUF); g.Bt = (const bf16_t*)(ws + WS_WOUT) + (size_t)l * 1024 * 1024; g.M = T_; g.N = 1024; g.K = 1024;
  pg8::StaticOrder S; S.init(T_, 1024, gridDim.x, blockIdx.x);
  EpiOut E; E.xin = gin(pp->in[I_X]); E.first = (l == 0) ? 1 : 0; E.X = (bf16_t*)(ws + WS_X); E.g1 = (const float*)(ws + WS_MOD) + (size_t)l * 2 * 6144 + 2048;
  E.nf = gin(pp->in[I_NFFN]) + (size_t)l * 1024; E.sc2 = (const float*)(ws + WS_MOD) + (size_t)l * 2 * 6144 + 4096; E.XG = (bf16_t*)(ws + WS_XG); E.SSQ = (float*)(ws + WS_SSQ);
  pg8::gemm_phase<EpiOut, pg8::StaticOrder>((PG8_LAS unsigned char*)smem, g, S, E);
}
__device__ void gemm_q_phase(const Params& p, int l, unsigned char* smem) {
  const CParamsP pp = launder_kargs();
  GAS unsigned char* const ws = launder_ptr(pp->ws);
  pg8::Gemm g; g.A = (const bf16_t*)(ws + WS_XG); g.Bt = (const bf16_t*)(ws + WS_WQ) + (size_t)l * 2048 * 1024; g.M = T_; g.N = 2048; g.K = 1024;
  pg8::StaticOrder S; S.init(T_, 2048, gridDim.x, blockIdx.x);
  EpiQ E; E.SC8 = (bf16_t*)(ws + WS_SC); E.SSQ = (const float*)(ws + WS_SSQ); E.C2 = (const float*)(ws + WS_C2) + (size_t)l * 2 * 2048;
  pg8::gemm_phase<EpiQ, pg8::StaticOrder>((PG8_LAS unsigned char*)smem, g, S, E);
}

__device__ __forceinline__ int attn_fk(int r) { return ((r >> 3) & 3) | (((r >> 1) & 1) << 2); }
__device__ __forceinline__ int attn_fv(int r) { return (r >> 1) & 7; }
__device__ void attn_phase(const Params& p, int l, unsigned char* smem) {
  const CParamsP pp = launder_kargs();
  GAS unsigned char* const ws = launder_ptr(pp->ws); const int tidx = launder_tid();
  const bf16_t* PROJ = (const bf16_t*)(ws + WS_PROJ); const bf16_t* VTA = (const bf16_t*)(ws + WS_VTA);
  bf16_t* ATT = (bf16_t*)(ws + WS_ATT);
  const int lane = tidx & 63, wid = tidx >> 6, fr = lane & 15, fq = lane >> 4;
  float* ext = (float*)smem;
  unsigned char* stg = smem + 15360;
  constexpr float LOG2E = 1.4426950408889634f;
  __syncthreads();
  for (int idx = tidx; idx < 6 * 640; idx += NT) {
    const int h = idx / 640, e = idx - h * 640; int d = e - 63; d = d > 256 ? 256 : d;
    ext[idx] = gin(pp->in[I_RELB])[((size_t)l * 6 + h) * 513 + d + 256] * LOG2E;
  }
  const int hh = wid >> 2, qb = wid & 3, iq = qb * 16 + fr;
  const int srow = tidx >> 3, sch = tidx & 7;
  for (int item = blockIdx.x; item < 256; item += gridDim.x) {
    const int b = item >> 7, n = item & 127, t0 = b * 8192 + n * 64;
    const int jc0 = n >= 8 ? 0 : 8 - n, nch = 9 - jc0, nst = 3 * nch;
    uint4 sa0, sa1, sa2, sa3, sb0, sb1, sb2, sb3;
#define ATTN_LOAD(S, st) do { const int _rd = (st) / nch, _jc = jc0 + (st) - _rd * nch, _m = n - 8 + _jc; \
      S##0 = *(const uint4*)(PROJ + (size_t)(b * 8192 + _m * 64 + srow) * INCP + C_KA + (2 * _rd) * 64 + sch * 8); \
      S##1 = *(const uint4*)(PROJ + (size_t)(b * 8192 + _m * 64 + srow) * INCP + C_KA + (2 * _rd + 1) * 64 + sch * 8); \
      S##2 = *(const uint4*)(VTA + ((size_t)b * 384 + (2 * _rd) * 64 + srow) * 8192 + _m * 64 + sch * 8); \
      S##3 = *(const uint4*)(VTA + ((size_t)b * 384 + (2 * _rd + 1) * 64 + srow) * 8192 + _m * 64 + sch * 8); } while (0)
#define ATTN_WRITE(S, buf) do { unsigned char* _bp = stg + (buf) * 32768; \
      *(uint4*)(_bp + srow * 128 + ((sch ^ attn_fk(srow)) << 4)) = S##0; \
      *(uint4*)(_bp + 8192 + srow * 128 + ((sch ^ attn_fk(srow)) << 4)) = S##1; \
      *(uint4*)(_bp + 16384 + srow * 128 + ((sch ^ attn_fv(srow)) << 4)) = S##2; \
      *(uint4*)(_bp + 24576 + srow * 128 + ((sch ^ attn_fv(srow)) << 4)) = S##3; } while (0)
    __syncthreads();
    ATTN_LOAD(sa, 0);
    ATTN_WRITE(sa, 0);
    if (1 < nst) ATTN_LOAD(sb, 1);
    __syncthreads();
    bf16x8 qf[2];
    f32x4 o[4];
    float mrun = -1e30f, lrun = 0.f;
    const float* exth = ext;
    auto attn_compute = [&](const int st) {
      const int rd = st / nch, jc = jc0 + st - rd * nch, h = 2 * rd + hh;
      if (jc == jc0) {
#pragma unroll
        for (int ds = 0; ds < 2; ++ds) qf[ds] = *(const bf16x8*)(PROJ + (size_t)(t0 + iq) * INCP + C_QA + h * 64 + ds * 32 + fq * 8);
#pragma unroll
        for (int et = 0; et < 4; ++et) o[et] = (f32x4){0.f, 0.f, 0.f, 0.f};
        mrun = -1e30f; lrun = 0.f;
        exth = ext + h * 640 + 63 + 512 + iq - 8 * fq;
      }
      const unsigned char* kb = stg + (st & 1) * 32768 + hh * 8192;
      const unsigned char* vb = stg + (st & 1) * 32768 + (2 + hh) * 8192;
      float sc[2][2][4];
      bf16x8 kfr[2][2][2], vfr[2][4]; float bia[2][2][4];
#pragma unroll
      for (int g = 0; g < 2; ++g)
#pragma unroll
        for (int tt = 0; tt < 2; ++tt) {
          const int key = 32 * g + 8 * (fr >> 2) + (fr & 3) + 4 * tt, fk = attn_fk(key);
          kfr[g][tt][0] = *(const bf16x8*)(kb + key * 128 + ((fq ^ fk) << 4));
          kfr[g][tt][1] = *(const bf16x8*)(kb + key * 128 + (((4 + fq) ^ fk) << 4));
        }
#pragma unroll
      for (int g = 0; g < 2; ++g)
#pragma unroll
        for (int tt = 0; tt < 2; ++tt)
#pragma unroll
          for (int j = 0; j < 4; ++j) bia[g][tt][j] = exth[-(64 * jc + 32 * g + 4 * tt + j)];
#pragma unroll
      for (int g = 0; g < 2; ++g)
#pragma unroll
        for (int et = 0; et < 4; ++et) { const int er = 16 * et + fr; vfr[g][et] = *(const bf16x8*)(vb + er * 128 + (((4 * g + fq) ^ attn_fv(er)) << 4)); }
      __builtin_amdgcn_sched_barrier(0);
#pragma unroll
      for (int g = 0; g < 2; ++g)
#pragma unroll
        for (int tt = 0; tt < 2; ++tt) {
          f32x4 s4 = __builtin_amdgcn_mfma_f32_16x16x32_bf16(kfr[g][tt][0], qf[0], (f32x4){0.f, 0.f, 0.f, 0.f}, 0, 0, 0);
          s4 = __builtin_amdgcn_mfma_f32_16x16x32_bf16(kfr[g][tt][1], qf[1], s4, 0, 0, 0);
#pragma unroll
          for (int j = 0; j < 4; ++j) sc[g][tt][j] = s4[j] * (0.125f * LOG2E) + bia[g][tt][j];
        }
      float mloc = -1e30f;
#pragma unroll
      for (int g = 0; g < 2; ++g)
#pragma unroll
        for (int tt = 0; tt < 2; ++tt)
#pragma unroll
          for (int j = 0; j < 4; ++j) mloc = fmaxf(mloc, sc[g][tt][j]);
      mloc = fmaxf(mloc, __shfl_xor(mloc, 16)); mloc = fmaxf(mloc, __shfl_xor(mloc, 32));
      const float mnew = fmaxf(mrun, mloc), alpha = __builtin_amdgcn_exp2f(mrun - mnew);
      mrun = mnew;
      float ls = 0.f;
#pragma unroll
      for (int g = 0; g < 2; ++g)
#pragma unroll
        for (int tt = 0; tt < 2; ++tt)
#pragma unroll
          for (int j = 0; j < 4; ++j) { const float e = __builtin_amdgcn_exp2f(sc[g][tt][j] - mnew); sc[g][tt][j] = e; ls += e; }
      lrun = lrun * alpha + ls;
#pragma unroll
      for (int et = 0; et < 4; ++et) { o[et].x *= alpha; o[et].y *= alpha; o[et].z *= alpha; o[et].w *= alpha; }
#pragma unroll
      for (int g = 0; g < 2; ++g) {
        union { bf16x8 v; unsigned u[4]; } pf;
        pf.u[0] = pk2(sc[g][0][0], sc[g][0][1]); pf.u[1] = pk2(sc[g][0][2], sc[g][0][3]);
        pf.u[2] = pk2(sc[g][1][0], sc[g][1][1]); pf.u[3] = pk2(sc[g][1][2], sc[g][1][3]);
#pragma unroll
        for (int et = 0; et < 4; ++et) o[et] = __builtin_amdgcn_mfma_f32_16x16x32_bf16(vfr[g][et], pf.v, o[et], 0, 0, 0);
      }
      if (jc == 8) {
        float lt = lrun + __shfl_xor(lrun, 16); lt += __shfl_xor(lt, 32);
        const float inv = 1.f / lt;
#pragma unroll
        for (int et = 0; et < 4; ++et) {
          f32x4 v = o[et]; v.x *= inv; v.y *= inv; v.z *= inv; v.w *= inv;
          { uint2 ov; ov.x = pk2(v.x, v.y); ov.y = pk2(v.z, v.w); *(uint2*)(ATT + (size_t)(t0 + iq) * 384 + h * 64 + et * 16 + fq * 4) = ov; }
        }
      }
    };
#pragma unroll 1
    for (int st0 = 0; st0 < nst; st0 += 2) {
      { const int st = st0;
        if (st + 2 < nst) ATTN_LOAD(sa, st + 2);
        attn_compute(st);
        if (st + 1 < nst) ATTN_WRITE(sb, (st + 1) & 1);
        __syncthreads(); }
      if (st0 + 1 < nst) { const int st = st0 + 1;
        if (st + 2 < nst) ATTN_LOAD(sb, st + 2);
        attn_compute(st);
        if (st + 1 < nst) ATTN_WRITE(sa, (st + 1) & 1);
        __syncthreads(); }
    }
#undef ATTN_LOAD
#undef ATTN_WRITE
  }
  __syncthreads();
}

__device__ __forceinline__ void ssm_bu32(const bf16_t* __restrict__ bbh_g, const bf16_t* __restrict__ urow, int lane,
                                         f32x16& lo_re, f32x16& hi_re, f32x16& lo_im, f32x16& hi_im) {
  const int hf = lane >> 5;
  const bf16x8 ub = *(const bf16x8*)(urow + 8 * hf);
  f32x16 z;
#pragma unroll
  for (int r = 0; r < 16; ++r) z[r] = 0.f;
  const bf16x8 a0r = *(const bf16x8*)(bbh_g + (size_t)(0 * 64 + lane) * 8), a1r = *(const bf16x8*)(bbh_g + (size_t)(1 * 64 + lane) * 8);
  const bf16x8 a0i = *(const bf16x8*)(bbh_g + (size_t)(2 * 64 + lane) * 8), a1i = *(const bf16x8*)(bbh_g + (size_t)(3 * 64 + lane) * 8);
  lo_re = __builtin_amdgcn_mfma_f32_32x32x16_bf16(ub, a0r, z, 0, 0, 0); hi_re = __builtin_amdgcn_mfma_f32_32x32x16_bf16(ub, a1r, z, 0, 0, 0);
  lo_im = __builtin_amdgcn_mfma_f32_32x32x16_bf16(ub, a0i, z, 0, 0, 0); hi_im = __builtin_amdgcn_mfma_f32_32x32x16_bf16(ub, a1i, z, 0, 0, 0);
#pragma unroll
  for (int r = 0; r < 16; ++r) {
    const auto s1 = __builtin_amdgcn_permlane32_swap(__float_as_uint(lo_re[r]), __float_as_uint(hi_re[r]), false, false);
    lo_re[r] = __uint_as_float(s1[0]); hi_re[r] = __uint_as_float(s1[1]);
    const auto s2 = __builtin_amdgcn_permlane32_swap(__float_as_uint(lo_im[r]), __float_as_uint(hi_im[r]), false, false);
    lo_im[r] = __uint_as_float(s2[0]); hi_im[r] = __uint_as_float(s2[1]);
  }
}
__device__ __forceinline__ void rotary_frag(const bf16x8 x0, const bf16x8 x1, const float* RC, const float* RS, int pos, int fq, float scale, bf16x8& o0, bf16x8& o1) {
  const f32x4 c0 = *(const f32x4*)(RC + pos * 32 + 8 * fq), c1 = *(const f32x4*)(RC + pos * 32 + 8 * fq + 4);
  const f32x4 s0 = *(const f32x4*)(RS + pos * 32 + 8 * fq), s1 = *(const f32x4*)(RS + pos * 32 + 8 * fq + 4);
  const float cc[8] = {c0.x, c0.y, c0.z, c0.w, c1.x, c1.y, c1.z, c1.w}, sn[8] = {s0.x, s0.y, s0.z, s0.w, s1.x, s1.y, s1.z, s1.w};
  union { bf16x8 v; unsigned u[4]; } r0, r1;
#pragma unroll
  for (int q = 0; q < 4; ++q) {
    const float a0 = bf2f((bf16_t)x0[2 * q]) * scale, a1 = bf2f((bf16_t)x0[2 * q + 1]) * scale, b0 = bf2f((bf16_t)x1[2 * q]) * scale, b1 = bf2f((bf16_t)x1[2 * q + 1]) * scale;
    r0.u[q] = pk2(a0 * cc[2 * q] - b0 * sn[2 * q], a1 * cc[2 * q + 1] - b1 * sn[2 * q + 1]);
    r1.u[q] = pk2(a0 * sn[2 * q] + b0 * cc[2 * q], a1 * sn[2 * q + 1] + b1 * cc[2 * q + 1]);
  }
  o0 = r0.v; o1 = r1.v;
}
__device__ void mix_local_phase(const Params& p, int l, unsigned char* smem) {
  const CParamsP pp = launder_kargs();
  GAS unsigned char* const ws = launder_ptr(pp->ws); const int tidx = launder_tid();
  const bf16_t* PROJ = (const bf16_t*)(ws + WS_PROJ); const bf16_t* VTR = (const bf16_t*)(ws + WS_VTR);
  const float* RC = (const float*)(ws + WS_ROTC); const float* RS = (const float*)(ws + WS_ROTS);
  bf16_t* YINT = (bf16_t*)(ws + WS_YINT); float* UPDT = (float*)(ws + WS_UPD);
  const float* SA = (const float*)(ws + WS_SA) + (size_t)l * 16 * 64 * 2; const bf16_t* BBH = (const bf16_t*)(ws + WS_BBH) + (size_t)l * 16 * 2 * 64 * 16;
  float* SEND = (float*)(ws + WS_SEND);
  const int tid = tidx, lane = tid & 63, wid = tid >> 6, fr = lane & 15, fq = lane >> 4;
  bf16_t* KT = (bf16_t*)smem;
  float* rcL = (float*)(smem + 55296); float* rsL = rcL + 2048;
  for (int item = blockIdx.x; item < 256; item += gridDim.x) {
    const int b = item >> 7, n = item & 127, t0 = b * 8192 + n * 64;
    __syncthreads();
#pragma unroll
    for (int i = 0; i < 4; ++i) { rcL[tid + NT * i] = RC[n * 2048 + tid + NT * i]; rsL[tid + NT * i] = RS[n * 2048 + tid + NT * i]; }
    __syncthreads();
#pragma unroll 1
    for (int k3 = 0; k3 < 3; ++k3) {
      const int task = wid * 3 + k3, h = task >> 2, tb = task & 3;
      const int i = 16 * tb + fr;
      const float lg2 = log2f(1.f - exp2f(-5.f - (float)h));
      bf16x8 qraw[2], kraw[2][2][2], vraw[2][4];
      {
        const bf16_t* qp = PROJ + (size_t)(t0 + i) * INCP + C_QR + h * 64 + 8 * fq;
        qraw[0] = *(const bf16x8*)qp; qraw[1] = *(const bf16x8*)(qp + 32);
#pragma unroll
        for (int g = 0; g < 2; ++g) {
#pragma unroll
          for (int tt = 0; tt < 2; ++tt) {
            const int key = 32 * g + 8 * (fr >> 2) + (fr & 3) + 4 * tt;
            const bf16_t* kp = PROJ + (size_t)(t0 + key) * INCP + C_KR + h * 64 + 8 * fq;
            kraw[g][tt][0] = *(const bf16x8*)kp; kraw[g][tt][1] = *(const bf16x8*)(kp + 32);
          }
#pragma unroll
          for (int et = 0; et < 4; ++et) vraw[g][et] = *(const bf16x8*)(VTR + ((size_t)b * 384 + h * 64 + et * 16 + fr) * 8192 + n * 64 + 32 * g + 8 * fq);
        }
      }
      __builtin_amdgcn_sched_barrier(0);
      bf16x8 qf0, qf1;
      rotary_frag(qraw[0], qraw[1], rcL, rsL, i, fq, 1.f, qf0, qf1);
      f32x4 o[4];
#pragma unroll
      for (int et = 0; et < 4; ++et) o[et] = (f32x4){0.f, 0.f, 0.f, 0.f};
#pragma unroll
      for (int g = 0; g < 2; ++g) {
        float st[2][4];
#pragma unroll
        for (int tt = 0; tt < 2; ++tt) {
          const int key = 32 * g + 8 * (fr >> 2) + (fr & 3) + 4 * tt;
          bf16x8 kf0, kf1;
          rotary_frag(kraw[g][tt][0], kraw[g][tt][1], rcL, rsL, key, fq, 0.125f, kf0, kf1);
          f32x4 s4 = __builtin_amdgcn_mfma_f32_16x16x32_bf16(kf0, qf0, (f32x4){0.f, 0.f, 0.f, 0.f}, 0, 0, 0);
          s4 = __builtin_amdgcn_mfma_f32_16x16x32_bf16(kf1, qf1, s4, 0, 0, 0);
#pragma unroll
          for (int j = 0; j < 4; ++j) {
            const int kk = 32 * g + 8 * fq + 4 * tt + j;
            const int dij = i > kk ? i - kk : kk - i;
            st[tt][j] = s4[j] * exp2f(lg2 * (float)dij);
          }
          if (tb == 0) {
            const float kd = exp2f(lg2 * (float)(63 - key));
#pragma unroll
            for (int jj = 0; jj < 8; ++jj) {
              KT[(h * 64 + 8 * fq + jj) * 72 + key] = f2bf(bf2f((bf16_t)kf0[jj]) * kd);
              KT[(h * 64 + 32 + 8 * fq + jj) * 72 + key] = f2bf(bf2f((bf16_t)kf1[jj]) * kd);
            }
          }
        }
        union { bf16x8 v; unsigned u[4]; } pf;
        pf.u[0] = pk2(st[0][0], st[0][1]); pf.u[1] = pk2(st[0][2], st[0][3]); pf.u[2] = pk2(st[1][0], st[1][1]); pf.u[3] = pk2(st[1][2], st[1][3]);
#pragma unroll
        for (int et = 0; et < 4; ++et) o[et] = __builtin_amdgcn_mfma_f32_16x16x32_bf16(vraw[g][et], pf.v, o[et], 0, 0, 0);
      }
#pragma unroll
      for (int et = 0; et < 4; ++et) { uint2 ov; ov.x = pk2(o[et].x, o[et].y); ov.y = pk2(o[et].z, o[et].w); *(uint2*)(YINT + (((((size_t)item * 6 + h) * 4 + tb) * 4 + et) * 64 + lane) * 4) = ov; }
    }
    __syncthreads();
#pragma unroll 1
    for (int k3 = 0; k3 < 3; ++k3) {
      const int task = wid * 3 + k3, h = task >> 2, et = task & 3;
      f32x4 acc[4];
#pragma unroll
      for (int dt = 0; dt < 4; ++dt) acc[dt] = (f32x4){0.f, 0.f, 0.f, 0.f};
#pragma unroll
      for (int g = 0; g < 2; ++g) {
        const bf16x8 vf = *(const bf16x8*)(VTR + ((size_t)b * 384 + h * 64 + et * 16 + fr) * 8192 + n * 64 + 32 * g + 8 * fq);
#pragma unroll
        for (int dt = 0; dt < 4; ++dt) {
          const bf16x8 kt = *(const bf16x8*)(KT + (h * 64 + 16 * dt + fr) * 72 + 32 * g + 8 * fq);
          acc[dt] = __builtin_amdgcn_mfma_f32_16x16x32_bf16(kt, vf, acc[dt], 0, 0, 0);
        }
      }
#pragma unroll
      for (int dt = 0; dt < 4; ++dt) *(f32x4*)(UPDT + (((size_t)item * 6 + h) * 64 + 16 * et + fr) * 64 + 16 * dt + 4 * fq) = acc[dt];
    }
#pragma unroll 1
    for (int gi = 0; gi < 2; ++gi) {
      const int g = wid * 2 + gi;
      const float are = SA[(g * 64 + lane) * 2], aim = SA[(g * 64 + lane) * 2 + 1];
      float xr = 0.f, xi = 0.f;
#pragma unroll 1
      for (int blk = 0; blk < 2; ++blk) {
        f32x16 lr, hr, li, hi;
        ssm_bu32(BBH + (size_t)g * 2 * 64 * 16, PROJ + (size_t)(t0 + 32 * blk + (lane & 31)) * INCP + C_US + g * 16, lane, lr, hr, li, hi);
#pragma unroll
        for (int a4 = 0; a4 < 4; ++a4) {
#pragma unroll
          for (int bq = 0; bq < 4; ++bq) { const float nr = are * xr - aim * xi + lr[4 * a4 + bq], ni = are * xi + aim * xr + li[4 * a4 + bq]; xr = nr; xi = ni; }
#pragma unroll
          for (int bq = 0; bq < 4; ++bq) { const float nr = are * xr - aim * xi + hr[4 * a4 + bq], ni = are * xi + aim * xr + hi[4 * a4 + bq]; xr = nr; xi = ni; }
        }
      }
      SEND[(((size_t)item * 16 + g) * 64 + lane) * 2] = xr; SEND[(((size_t)item * 16 + g) * 64 + lane) * 2 + 1] = xi;
    }
  }
}

__device__ void scan_phase(const Params& p, int l) {
  const CParamsP pp = launder_kargs();
  GAS unsigned char* const ws = launder_ptr(pp->ws); const int tidx = launder_tid();
  const float* __restrict__ UPDT = (const float*)(ws + WS_UPD); bf16_t* __restrict__ SPT = (bf16_t*)(ws + WS_SPT);
  const float* __restrict__ SEND = (const float*)(ws + WS_SEND); float* __restrict__ CARRY = (float*)(ws + WS_CARRY);
  const float* SA = (const float*)(ws + WS_SA) + (size_t)l * 16 * 64 * 2;
  const int gtid = blockIdx.x * NT + tidx, gn = gridDim.x * NT;
  for (int idx = gtid; idx < 2 * 6 * 4096 + 2 * 1024; idx += gn) {
    if (idx < 2 * 6 * 4096) {
      const int b = idx / (6 * 4096), r = idx % (6 * 4096), h = r >> 12;
      const float cd = exp2f(64.f * log2f(1.f - exp2f(-5.f - (float)h)));
      const int e_ = (r >> 6) & 63, d_ = r & 63;
      const int spoff = h * 4096 + ((((e_ >> 4) * 2 + (d_ >> 5)) * 64 + ((d_ >> 3) & 3) * 16 + (e_ & 15)) * 8 + (d_ & 7));
      float s = 0.f;
#pragma unroll 1
      for (int nb = 0; nb < NCH; nb += 16) {
        float v[16];
#pragma unroll
        for (int j = 0; j < 16; ++j) v[j] = UPDT[((size_t)(b * NCH + nb + j)) * 6 * 4096 + r];
#pragma unroll
        for (int j = 0; j < 16; ++j) { SPT[((size_t)(b * NCH + nb + j)) * 6 * 4096 + spoff] = f2bf(s); s = cd * s + v[j]; }
      }
    } else {
      const int r2 = idx - 2 * 6 * 4096, b = r2 >> 10, gp = r2 & 1023;
      float ar = SA[gp * 2], ai = SA[gp * 2 + 1];
#pragma unroll
      for (int q = 0; q < 6; ++q) { const float nr = ar * ar - ai * ai, ni = 2.f * ar * ai; ar = nr; ai = ni; }
      float xr = 0.f, xi = 0.f;
#pragma unroll 1
      for (int nb = 0; nb < NCH; nb += 16) {
        float2 v[16];
#pragma unroll
        for (int j = 0; j < 16; ++j) v[j] = *(const float2*)(SEND + (((size_t)(b * NCH + nb + j)) * 1024 + gp) * 2);
#pragma unroll
        for (int j = 0; j < 16; ++j) {
          *(float2*)(CARRY + (((size_t)(b * NCH + nb + j)) * 1024 + gp) * 2) = make_float2(xr, xi);
          const float nr = ar * xr - ai * xi + v[j].x, ni = ar * xi + ai * xr + v[j].y;
          xr = nr; xi = ni;
        }
      }
    }
  }
  if (l + 1 < DEPTH_) convert_tables_fp4(pp, ws, l + 1, gtid, gn);
}

__device__ void mix_final_phase(const Params& p, int l, unsigned char* smem) {
  const CParamsP pp = launder_kargs();
  GAS unsigned char* const ws = launder_ptr(pp->ws); const int tidx = launder_tid();
  const bf16_t* PROJ = (const bf16_t*)(ws + WS_PROJ);
  const float* RC = (const float*)(ws + WS_ROTC); const float* RS = (const float*)(ws + WS_ROTS);
  const bf16_t* YINT = (const bf16_t*)(ws + WS_YINT); const bf16_t* SPT = (const bf16_t*)(ws + WS_SPT);
  const bf16_t* ATT = (const bf16_t*)(ws + WS_ATT);
  const float* SA = (const float*)(ws + WS_SA) + (size_t)l * 16 * 64 * 2; const bf16_t* BBH = (const bf16_t*)(ws + WS_BBH) + (size_t)l * 16 * 2 * 64 * 16;
  const float* CARRY = (const float*)(ws + WS_CARRY);
  const bf16_t* CB = (const bf16_t*)(ws + WS_CB) + (size_t)l * 16 * 16 * 128; const bf16_t* WG = (const bf16_t*)(ws + WS_WGLUT) + (size_t)l * 512 * 256;
  const float* dsk = gin(pp->in[I_SSMD]) + (size_t)l * 256;
  const float* mg = gin(pp->in[I_MGAIN]) + (size_t)l * 1024;
  bf16_t* MRG = (bf16_t*)(ws + WS_ABUF);
  const int tid = tidx, lane = tid & 63, wid = tid >> 6, fr = lane & 15, fq = lane >> 4;
  bf16_t* YS = (bf16_t*)smem;
  float* red = (float*)(smem + 33792);
  bf16_t* XB = (bf16_t*)(smem + 36864 + wid * 8448 + 4096);
  float* rcL = (float*)(smem + 104448); float* rsL = rcL + 2048;
  for (int item = blockIdx.x; item < 256; item += gridDim.x) {
    const int b = item >> 7, n = item & 127, t0 = b * 8192 + n * 64;
    __syncthreads();
#pragma unroll
    for (int i = 0; i < 4; ++i) { rcL[tid + NT * i] = RC[n * 2048 + tid + NT * i]; rsL[tid + NT * i] = RS[n * 2048 + tid + NT * i]; }
    __syncthreads();
    {
      float av[8][6], mgl[6];
#pragma unroll
      for (int ii = 0; ii < 8; ++ii)
#pragma unroll
        for (int j = 0; j < 6; ++j) av[ii][j] = bf2f(ATT[(size_t)(t0 + wid * 8 + ii) * 384 + lane + 64 * j]);
#pragma unroll
      for (int j = 0; j < 6; ++j) mgl[j] = mg[lane + 64 * j];
      __builtin_amdgcn_sched_barrier(0);
#pragma unroll
      for (int ii = 0; ii < 8; ++ii) {
        const int t = t0 + wid * 8 + ii;
        float sq = 0.f;
#pragma unroll
        for (int j = 0; j < 6; ++j) sq += av[ii][j] * av[ii][j];
        const float rstd = rsqrtf(wave_sum(sq) * (1.f / 384.f) + EPS_);
#pragma unroll
        for (int j = 0; j < 6; ++j) MRG[(size_t)t * 1024 + lane + 64 * j] = f2bf(av[ii][j] * rstd * mgl[j]);
      }
    }
#pragma unroll 1
    for (int k3 = 0; k3 < 3; ++k3) {
      const int task = wid * 3 + k3, h = task >> 2, tb = task & 3;
      const int i = 16 * tb + fr, t = t0 + i;
      const float lg2 = log2f(1.f - exp2f(-5.f - (float)h));
      bf16x8 qraw[2], spf[4][2]; f32x4 yiv[4], mgq[4]; uint2 grv[4];
      {
        const bf16_t* qp = PROJ + (size_t)t * INCP + C_QR + h * 64 + 8 * fq;
        qraw[0] = *(const bf16x8*)qp; qraw[1] = *(const bf16x8*)(qp + 32);
#pragma unroll
        for (int et = 0; et < 4; ++et) {
          const bf16_t* sp = SPT + ((size_t)item * 6 + h) * 4096 + (size_t)(et * 2) * 512 + lane * 8;
          spf[et][0] = *(const bf16x8*)sp; spf[et][1] = *(const bf16x8*)(sp + 512);
          { const uint2 yr = *(const uint2*)(YINT + (((((size_t)item * 6 + h) * 4 + tb) * 4 + et) * 64 + lane) * 4); yiv[et] = (f32x4){__uint_as_float(yr.x << 16), __uint_as_float(yr.x & 0xffff0000u), __uint_as_float(yr.y << 16), __uint_as_float(yr.y & 0xffff0000u)}; }
          grv[et] = *(const uint2*)(PROJ + (size_t)t * INCP + C_GR + h * 64 + 16 * et + 4 * fq);
          mgq[et] = *(const f32x4*)(mg + 384 + h * 64 + 16 * et + 4 * fq);
        }
      }
      __builtin_amdgcn_sched_barrier(0);
      bf16x8 qf0, qf1;
      rotary_frag(qraw[0], qraw[1], rcL, rsL, i, fq, 1.f, qf0, qf1);
      f32x4 o[4];
#pragma unroll
      for (int et = 0; et < 4; ++et) {
        o[et] = __builtin_amdgcn_mfma_f32_16x16x32_bf16(spf[et][0], qf0, (f32x4){0.f, 0.f, 0.f, 0.f}, 0, 0, 0);
        o[et] = __builtin_amdgcn_mfma_f32_16x16x32_bf16(spf[et][1], qf1, o[et], 0, 0, 0);
      }
      const float qd = exp2f(lg2 * (float)(i + 1));
      float y[16]; float s1 = 0.f;
#pragma unroll
      for (int et = 0; et < 4; ++et) {
        const f32x4 yi = yiv[et];
        y[4 * et] = yi.x + qd * o[et].x; y[4 * et + 1] = yi.y + qd * o[et].y; y[4 * et + 2] = yi.z + qd * o[et].z; y[4 * et + 3] = yi.w + qd * o[et].w;
        s1 += (y[4 * et] + y[4 * et + 1]) + (y[4 * et + 2] + y[4 * et + 3]);
      }
      s1 += __shfl_xor(s1, 16); s1 += __shfl_xor(s1, 32);
      const float mu = s1 * (1.f / 64.f);
      float s2 = 0.f;
#pragma unroll
      for (int q = 0; q < 16; ++q) { y[q] -= mu; s2 += y[q] * y[q]; }
      s2 += __shfl_xor(s2, 16); s2 += __shfl_xor(s2, 32);
      const float rstd = rsqrtf(s2 * (1.f / 64.f) + EPS_);
#pragma unroll
      for (int et = 0; et < 4; ++et) {
        const int c = h * 64 + 16 * et + 4 * fq;
        const uint2 gr = grv[et];
        const float g0 = __uint_as_float(gr.x << 16), g1 = __uint_as_float(gr.x & 0xffff0000u), g2 = __uint_as_float(gr.y << 16), g3 = __uint_as_float(gr.y & 0xffff0000u);
        const f32x4 mgv = mgq[et];
        uint2 ov;
        ov.x = pk2(y[4 * et] * rstd * (g0 * sigmoid_f(g0)) * mgv.x, y[4 * et + 1] * rstd * (g1 * sigmoid_f(g1)) * mgv.y);
        ov.y = pk2(y[4 * et + 2] * rstd * (g2 * sigmoid_f(g2)) * mgv.z, y[4 * et + 3] * rstd * (g3 * sigmoid_f(g3)) * mgv.w);
        *(uint2*)(MRG + (size_t)t * 1024 + 384 + c) = ov;
      }
    }
#pragma unroll 1
    for (int gi = 0; gi < 2; ++gi) {
      const int g = wid * 2 + gi;
      const float are = SA[(g * 64 + lane) * 2], aim = SA[(g * 64 + lane) * 2 + 1];
      float xr = CARRY[(((size_t)item * 16 + g) * 64 + lane) * 2], xi = CARRY[(((size_t)item * 16 + g) * 64 + lane) * 2 + 1];
      bf16x8 cb[4];
#pragma unroll
      for (int ks = 0; ks < 4; ++ks) cb[ks] = *(const bf16x8*)(CB + (((size_t)g * 4 + ks) * 64 + lane) * 8);
      const float dv = dsk[g * 16 + fr];
#pragma unroll 1
      for (int blk = 0; blk < 2; ++blk) {
        f32x16 lr, hr, li, hi;
        bf16_t uraw[2][4];
#pragma unroll
        for (int half = 0; half < 2; ++half)
#pragma unroll
          for (int j = 0; j < 4; ++j) uraw[half][j] = PROJ[(size_t)(t0 + 32 * blk + 16 * half + 4 * fq + j) * INCP + C_US + g * 16 + fr];
        ssm_bu32(BBH + (size_t)g * 2 * 64 * 16, PROJ + (size_t)(t0 + 32 * blk + (lane & 31)) * INCP + C_US + g * 16, lane, lr, hr, li, hi);
#pragma unroll
        for (int half = 0; half < 2; ++half) {
#pragma unroll
          for (int a2 = 0; a2 < 2; ++a2) {
            const int a4 = 2 * half + a2;
#pragma unroll
            for (int bq = 0; bq < 4; ++bq) {
              const float nr = are * xr - aim * xi + lr[4 * a4 + bq], ni = are * xi + aim * xr + li[4 * a4 + bq]; xr = nr; xi = ni;
              XB[(8 * a2 + bq) * 136 + lane] = f2bf(xr); XB[(8 * a2 + bq) * 136 + 64 + lane] = f2bf(xi);
            }
#pragma unroll
            for (int bq = 0; bq < 4; ++bq) {
              const float nr = are * xr - aim * xi + hr[4 * a4 + bq], ni = are * xi + aim * xr + hi[4 * a4 + bq]; xr = nr; xi = ni;
              XB[(8 * a2 + 4 + bq) * 136 + lane] = f2bf(xr); XB[(8 * a2 + 4 + bq) * 136 + 64 + lane] = f2bf(xi);
            }
          }
          f32x4 acc = (f32x4){0.f, 0.f, 0.f, 0.f};
#pragma unroll
          for (int ks = 0; ks < 4; ++ks) {
            const bf16x8 af = *(const bf16x8*)(XB + fr * 136 + 32 * ks + 8 * fq);
            acc = __builtin_amdgcn_mfma_f32_16x16x32_bf16(af, cb[ks], acc, 0, 0, 0);
          }
#pragma unroll
          for (int j = 0; j < 4; ++j) {
            const int i = 32 * blk + 16 * half + 4 * fq + j;
            const float yv = acc[j] + dv * bf2f(uraw[half][j]);
            YS[i * 264 + g * 16 + fr] = f2bf(gelu_tanh(yv));
          }
        }
      }
    }
    __syncthreads();
    {
      const int n0 = 32 * wid;
      f32x4 a1[4][2], a2[4][2];
#pragma unroll
      for (int mt = 0; mt < 4; ++mt)
#pragma unroll
        for (int nt = 0; nt < 2; ++nt) { a1[mt][nt] = (f32x4){0.f, 0.f, 0.f, 0.f}; a2[mt][nt] = (f32x4){0.f, 0.f, 0.f, 0.f}; }
#pragma unroll 1
      for (int kh = 0; kh < 2; ++kh) {
        bf16x8 w1[4][2], w2[4][2];
#pragma unroll
        for (int k4 = 0; k4 < 4; ++k4)
#pragma unroll
          for (int nt = 0; nt < 2; ++nt) {
            w1[k4][nt] = *(const bf16x8*)(WG + ((((size_t)wid * 8 + 4 * kh + k4) * 2 + 0) * 2 + nt) * 512 + lane * 8);
            w2[k4][nt] = *(const bf16x8*)(WG + ((((size_t)wid * 8 + 4 * kh + k4) * 2 + 1) * 2 + nt) * 512 + lane * 8);
          }
        __builtin_amdgcn_sched_barrier(0);
#pragma unroll
        for (int k4 = 0; k4 < 4; ++k4) {
          const int ks = 4 * kh + k4;
          bf16x8 yb[4];
#pragma unroll
          for (int mt = 0; mt < 4; ++mt) yb[mt] = *(const bf16x8*)(YS + (16 * mt + fr) * 264 + 32 * ks + 8 * fq);
#pragma unroll
          for (int mt = 0; mt < 4; ++mt)
#pragma unroll
            for (int nt = 0; nt < 2; ++nt) {
              a1[mt][nt] = __builtin_amdgcn_mfma_f32_16x16x32_bf16(w1[k4][nt], yb[mt], a1[mt][nt], 0, 0, 0);
              a2[mt][nt] = __builtin_amdgcn_mfma_f32_16x16x32_bf16(w2[k4][nt], yb[mt], a2[mt][nt], 0, 0, 0);
            }
        }
      }
#pragma unroll
      for (int mt = 0; mt < 4; ++mt) {
        float sq = 0.f;
#pragma unroll
        for (int nt = 0; nt < 2; ++nt) {
          f32x4 z = a1[mt][nt]; const f32x4 zg = a2[mt][nt];
          z.x *= sigmoid_f(zg.x); z.y *= sigmoid_f(zg.y); z.z *= sigmoid_f(zg.z); z.w *= sigmoid_f(zg.w);
          a1[mt][nt] = z; sq += z.x * z.x + z.y * z.y + z.z * z.z + z.w * z.w;
        }
        sq += __shfl_xor(sq, 16); sq += __shfl_xor(sq, 32);
        if (fq == 0) red[wid * 64 + 16 * mt + fr] = sq;
      }
      __syncthreads();
#pragma unroll
      for (int mt = 0; mt < 4; ++mt) {
        const int i = 16 * mt + fr, t = t0 + i;
        float tot = 0.f;
#pragma unroll
        for (int w8 = 0; w8 < 8; ++w8) tot += red[w8 * 64 + i];
        const float rstd = rsqrtf(tot * (1.f / 256.f) + EPS_);
#pragma unroll
        for (int nt = 0; nt < 2; ++nt) {
          const int c = n0 + 16 * nt + 4 * fq;
          const f32x4 mgv = *(const f32x4*)(mg + 768 + c); const f32x4 z = a1[mt][nt];
          uint2 ov; ov.x = pk2(z.x * rstd * mgv.x, z.y * rstd * mgv.y); ov.y = pk2(z.z * rstd * mgv.z, z.w * rstd * mgv.w);
          *(uint2*)(MRG + (size_t)t * 1024 + 768 + c) = ov;
        }
      }
    }
  }
}

typedef float f32x2 __attribute__((ext_vector_type(2)));
__device__ __forceinline__ float dot16_fp4(const uint2 u, const f32x2 (&hv)[8]) {
  f32x2 d = __builtin_amdgcn_cvt_scalef32_pk_f32_fp4(u.x, 1.0f, 0) * hv[0];
  d += __builtin_amdgcn_cvt_scalef32_pk_f32_fp4(u.x, 1.0f, 1) * hv[1];
  d += __builtin_amdgcn_cvt_scalef32_pk_f32_fp4(u.x, 1.0f, 2) * hv[2];
  d += __builtin_amdgcn_cvt_scalef32_pk_f32_fp4(u.x, 1.0f, 3) * hv[3];
  d += __builtin_amdgcn_cvt_scalef32_pk_f32_fp4(u.y, 1.0f, 0) * hv[4];
  d += __builtin_amdgcn_cvt_scalef32_pk_f32_fp4(u.y, 1.0f, 1) * hv[5];
  d += __builtin_amdgcn_cvt_scalef32_pk_f32_fp4(u.y, 1.0f, 2) * hv[6];
  d += __builtin_amdgcn_cvt_scalef32_pk_f32_fp4(u.y, 1.0f, 3) * hv[7];
  return d.x + d.y;
}
__device__ __forceinline__ void axpy16_fp4(const uint2 v, const float w, f32x2 (&acc)[8]) {
  const f32x2 w2 = (f32x2){w, w};
  acc[0] += w2 * __builtin_amdgcn_cvt_scalef32_pk_f32_fp4(v.x, 1.0f, 0);
  acc[1] += w2 * __builtin_amdgcn_cvt_scalef32_pk_f32_fp4(v.x, 1.0f, 1);
  acc[2] += w2 * __builtin_amdgcn_cvt_scalef32_pk_f32_fp4(v.x, 1.0f, 2);
  acc[3] += w2 * __builtin_amdgcn_cvt_scalef32_pk_f32_fp4(v.x, 1.0f, 3);
  acc[4] += w2 * __builtin_amdgcn_cvt_scalef32_pk_f32_fp4(v.y, 1.0f, 0);
  acc[5] += w2 * __builtin_amdgcn_cvt_scalef32_pk_f32_fp4(v.y, 1.0f, 1);
  acc[6] += w2 * __builtin_amdgcn_cvt_scalef32_pk_f32_fp4(v.y, 1.0f, 2);
  acc[7] += w2 * __builtin_amdgcn_cvt_scalef32_pk_f32_fp4(v.y, 1.0f, 3);
}
__device__ __forceinline__ float vmaxf(float a, float b) { float r; asm("v_max_f32 %0, %1, %2" : "=v"(r) : "v"(a), "v"(b)); return r; }
__device__ __forceinline__ float vminf(float a, float b) { float r; asm("v_min_f32 %0, %1, %2" : "=v"(r) : "v"(a), "v"(b)); return r; }
__device__ __forceinline__ void cx(float& hi, float& lo) { const float a = hi, b = lo; hi = vmaxf(a, b); lo = vminf(a, b); }
__device__ __forceinline__ void cx2(float& kh, int& ph, float& kl, int& pl) {
  const float a = kh, b = kl; const int pa = ph, pb = pl; const bool c = a >= b;
  kh = vmaxf(a, b); kl = vminf(a, b); ph = c ? pa : pb; pl = c ? pb : pa;
}
__device__ __forceinline__ void bitonic_sort16_desc(float (&v)[16]) {
#pragma unroll
  for (int k = 2; k <= 16; k <<= 1)
#pragma unroll
    for (int j = k >> 1; j > 0; j >>= 1)
#pragma unroll
      for (int i = 0; i < 16; ++i) {
        const int l = i ^ j;
        if (l > i) { if ((i & k) == 0) cx(v[i], v[l]); else cx(v[l], v[i]); }
      }
}
__device__ __forceinline__ void bitonic_merge16_desc(float (&v)[16]) {
#pragma unroll
  for (int j = 8; j > 0; j >>= 1)
#pragma unroll
    for (int i = 0; i < 16; ++i) { const int l = i ^ j; if (l > i) cx(v[i], v[l]); }
}
__device__ __forceinline__ void top16_merge(float (&a)[16], const float (&b)[16]) {
#pragma unroll
  for (int i = 0; i < 16; ++i) a[i] = vmaxf(a[i], b[15 - i]);
  bitonic_merge16_desc(a);
}
template <int M> __device__ __forceinline__ void top16_merge_chain(float (&k)[16], int (&q)[16], const float (&xk)[M], const int (&xq)[M]) {
#pragma unroll
  for (int i = 16 - M; i < 16; ++i) { const float a = k[i], b = xk[15 - i]; const bool c = a >= b; k[i] = vmaxf(a, b); q[i] = c ? q[i] : xq[15 - i]; }
#pragma unroll
  for (int j = 8; j > 0; j >>= 1)
#pragma unroll
    for (int i = 0; i < 16; ++i) { const int l = i ^ j; if (l > i) cx2(k[i], q[i], k[l], q[l]); }
}

__device__ void peer_phase(const Params& p, int l, bool last, unsigned char* smem) {
  const CParamsP pp = launder_kargs();
  GAS unsigned char* const ws = launder_ptr(pp->ws); const int tidx = launder_tid();
  bf16_t* HF = (bf16_t*)(ws + WS_ABUF); bf16_t* X = (bf16_t*)(ws + WS_X);
  const bf16_t* SC8 = (const bf16_t*)(ws + WS_SC);
  const uint2* U4 = (const uint2*)(ws + WS_PU8) + (size_t)l * 16384 * 64; const uint2* V4 = (const uint2*)(ws + WS_PV8) + (size_t)l * 16384 * 64;
  const float* g2 = (const float*)(ws + WS_MOD) + (size_t)l * 2 * 6144 + 5120;
  const bf16_t* XG = (const bf16_t*)(ws + WS_XG); const float* SSQ = (const float*)(ws + WS_SSQ); const float* sh2 = (const float*)(ws + WS_MOD) + (size_t)l * 2 * 6144 + 3072;
  const int ln = last ? l : l + 1;
  const float* nsh = (const float*)(ws + WS_MOD) + (size_t)ln * 2 * 6144; const float* nsc = nsh + 1024;
  const float* ngain = gin(pp->in[I_NMIX]) + (size_t)ln * 1024;
  const int lane = tidx & 63, wid = tidx >> 6;
  const int rL = ((lane >> 5) & 1) * 8 + ((lane >> 4) & 1) * 4 + ((lane >> 3) & 1) * 2 + ((lane >> 2) & 1);
  const bool hi5 = (lane & 32) != 0, hi4 = (lane & 16) != 0, hi3 = (lane & 8) != 0, hi2 = (lane & 4) != 0;
  int* idxL = (int*)smem;
  for (int item = blockIdx.x; item < T_ / 64; item += gridDim.x) {
    const int t0 = item * 64;
    __syncthreads();
    {
      int lane_o = lane; asm volatile("" : "+v"(lane_o));
      const int tg = wid & 1, hp = wid >> 1, hf = lane_o >> 5, tl = 32 * tg + (lane_o & 31);
      float F[2][16];
#pragma unroll
      for (int sd = 0; sd < 2; ++sd) {
        float Lh[2][16];
#pragma unroll
        for (int hh = 0; hh < 2; ++hh) {
          const int hs = 2 * (2 * hp + hh) + sd;
          float top[16];
          const bf16_t* scp = SC8 + (((size_t)(hs * 16 + 8 * hf)) * T_ + (t0 + tl)) * 8;
          uint4 sv[8];
#pragma unroll
          for (int kq = 0; kq < 8; ++kq) sv[kq] = *(const uint4*)(scp + (size_t)kq * T_ * 8);
          __builtin_amdgcn_sched_barrier(0);
#pragma unroll
          for (int kt = 0; kt < 4; ++kt) {
            float g[16];
#pragma unroll
            for (int kq = 0; kq < 2; ++kq) {
              const uint4 v8 = sv[2 * kt + kq];
              const unsigned wv[4] = {v8.x, v8.y, v8.z, v8.w};
#pragma unroll
              for (int j = 0; j < 4; ++j) {
                const int key = 64 * hf + 16 * kt + 8 * kq + 2 * j;
                g[8 * kq + 2 * j] = __uint_as_float((wv[j] << 16) | (unsigned)key);
                g[8 * kq + 2 * j + 1] = __uint_as_float((wv[j] & 0xffff0000u) | (unsigned)(key + 1));
              }
            }
            bitonic_sort16_desc(g);
            if (kt == 0) {
#pragma unroll
              for (int r = 0; r < 16; ++r) top[r] = g[r];
            } else top16_merge(top, g);
            __builtin_amdgcn_sched_barrier(0);
          }
#pragma unroll
          for (int r = 0; r < 16; ++r) Lh[hh][r] = top[r];
          __builtin_amdgcn_sched_barrier(0);
        }
#pragma unroll
        for (int r = 0; r < 16; ++r) {
          const auto sw = __builtin_amdgcn_permlane32_swap(__float_as_uint(Lh[0][r]), __float_as_uint(Lh[1][r]), false, false);
          Lh[0][r] = __uint_as_float(sw[0]); Lh[1][r] = __uint_as_float(sw[1]);
        }
        top16_merge(Lh[0], Lh[1]);
#pragma unroll
        for (int r = 0; r < 16; ++r) F[sd][r] = Lh[0][r];
        __builtin_amdgcn_sched_barrier(0);
      }
      int ia[16], ib[16];
#pragma unroll
      for (int r = 0; r < 16; ++r) { ia[r] = (int)(__float_as_uint(F[0][r]) & 127u) << 7; ib[r] = (int)(__float_as_uint(F[1][r]) & 127u); }
      float k[16]; int q[16];
#pragma unroll
      for (int j = 0; j < 16; ++j) { k[j] = F[0][0] + F[1][j]; q[j] = ia[0] | ib[j]; }
      { float xk[8]; int xq[8];
#pragma unroll
        for (int j = 0; j < 8; ++j) { xk[j] = F[0][1] + F[1][j]; xq[j] = ia[1] | ib[j]; }
        top16_merge_chain<8>(k, q, xk, xq); }
      { float xk[5]; int xq[5];
#pragma unroll
        for (int j = 0; j < 5; ++j) { xk[j] = F[0][2] + F[1][j]; xq[j] = ia[2] | ib[j]; }
        top16_merge_chain<5>(k, q, xk, xq); }
      { float xk[4]; int xq[4];
#pragma unroll
        for (int j = 0; j < 4; ++j) { xk[j] = F[0][3] + F[1][j]; xq[j] = ia[3] | ib[j]; }
        top16_merge_chain<4>(k, q, xk, xq); }
      { float xk[3]; int xq[3];
#pragma unroll
        for (int j = 0; j < 3; ++j) { xk[j] = F[0][4] + F[1][j]; xq[j] = ia[4] | ib[j]; }
        top16_merge_chain<3>(k, q, xk, xq); }
      { float xk[11]; int xq[11];
#pragma unroll
        for (int i = 0; i < 11; ++i) { xk[i] = F[0][5 + i] + F[1][0]; xq[i] = ia[5 + i] | ib[0]; }
        top16_merge_chain<11>(k, q, xk, xq); }
      { float xk[3]; int xq[3];
#pragma unroll
        for (int i = 0; i < 3; ++i) { xk[i] = F[0][5 + i] + F[1][1]; xq[i] = ia[5 + i] | ib[1]; }
        top16_merge_chain<3>(k, q, xk, xq); }
      float e[16]; float es = 0.f;
#pragma unroll
      for (int i = 0; i < 16; ++i) { e[i] = __expf(k[i] - k[0]); es += e[i]; }
      const float ies = 1.f / es;
      const int h = 2 * hp + hf;
#pragma unroll
      for (int i = 0; i < 16; ++i) idxL[tl * 132 + h * 16 + i] = (int)(((unsigned)f2bf(e[i] * ies) << 16) | (unsigned)q[i]);
    }
    __syncthreads();
    f32x4 sh2v[4];
#pragma unroll
    for (int qq = 0; qq < 4; ++qq) sh2v[qq] = *(const f32x4*)(sh2 + (t0 >> 13) * 6144 + lane * 16 + 4 * qq);
    const float rs_lane = rsqrtf(ssq_total(SSQ, t0 + wid * 8 + (lane & 7)) * (1.f / 1024.f) + EPS_);
    uint4 nh0 = *(const uint4*)(XG + (size_t)(t0 + wid * 8) * 1024 + lane * 16), nh1 = *(const uint4*)(XG + (size_t)(t0 + wid * 8) * 1024 + lane * 16 + 8);
#pragma unroll 1
    for (int ii = 0; ii < 8; ++ii) {
      const int tl = wid * 8 + ii, t = t0 + tl, b = t >> 13;
      const int fr = lane & 15, fq = lane >> 4;
      uint4 hB1[8], hB2[8];
      {
        const uint4 h0 = nh0, h1 = nh1;
        if (ii < 7) { nh0 = *(const uint4*)(XG + (size_t)(t + 1) * 1024 + lane * 16); nh1 = *(const uint4*)(XG + (size_t)(t + 1) * 1024 + lane * 16 + 8); }
        const unsigned hw[8] = {h0.x, h0.y, h0.z, h0.w, h1.x, h1.y, h1.z, h1.w};
        const float rs = __int_as_float(__builtin_amdgcn_readlane(__float_as_int(rs_lane), ii));
        unsigned q1[2] = {0u, 0u}, q2[2] = {0u, 0u};
#pragma unroll
        for (int qq = 0; qq < 4; ++qq) {
          const f32x4 sh = sh2v[qq];
          float hvv[4];
          hvv[0] = __uint_as_float(hw[2 * qq] << 16) * rs + sh.x; hvv[1] = __uint_as_float(hw[2 * qq] & 0xffff0000u) * rs + sh.y;
          hvv[2] = __uint_as_float(hw[2 * qq + 1] << 16) * rs + sh.z; hvv[3] = __uint_as_float(hw[2 * qq + 1] & 0xffff0000u) * rs + sh.w;
#pragma unroll
          for (int pr = 0; pr < 2; ++pr) {
            const int byte_sel = (2 * qq + pr) & 3, wd = (2 * qq + pr) >> 2;
            const float x0 = fminf(fmaxf(hvv[2 * pr], -6.f), 6.f), x1 = fminf(fmaxf(hvv[2 * pr + 1], -6.f), 6.f);
            unsigned t1 = 0u;
            if (byte_sel == 0) t1 = __builtin_amdgcn_cvt_scalef32_pk_fp4_f32(0u, x0, x1, 1.0f, 0);
            else if (byte_sel == 1) t1 = __builtin_amdgcn_cvt_scalef32_pk_fp4_f32(0u, x0, x1, 1.0f, 1);
            else if (byte_sel == 2) t1 = __builtin_amdgcn_cvt_scalef32_pk_fp4_f32(0u, x0, x1, 1.0f, 2);
            else t1 = __builtin_amdgcn_cvt_scalef32_pk_fp4_f32(0u, x0, x1, 1.0f, 3);
            f32x2 back;
            if (byte_sel == 0) back = __builtin_amdgcn_cvt_scalef32_pk_f32_fp4(t1, 1.0f, 0);
            else if (byte_sel == 1) back = __builtin_amdgcn_cvt_scalef32_pk_f32_fp4(t1, 1.0f, 1);
            else if (byte_sel == 2) back = __builtin_amdgcn_cvt_scalef32_pk_f32_fp4(t1, 1.0f, 2);
            else back = __builtin_amdgcn_cvt_scalef32_pk_f32_fp4(t1, 1.0f, 3);
            const float r0 = fminf(fmaxf((hvv[2 * pr] - back.x) * 8.f, -6.f), 6.f), r1 = fminf(fmaxf((hvv[2 * pr + 1] - back.y) * 8.f, -6.f), 6.f);
            unsigned t2 = 0u;
            if (byte_sel == 0) t2 = __builtin_amdgcn_cvt_scalef32_pk_fp4_f32(0u, r0, r1, 1.0f, 0);
            else if (byte_sel == 1) t2 = __builtin_amdgcn_cvt_scalef32_pk_fp4_f32(0u, r0, r1, 1.0f, 1);
            else if (byte_sel == 2) t2 = __builtin_amdgcn_cvt_scalef32_pk_fp4_f32(0u, r0, r1, 1.0f, 2);
            else t2 = __builtin_amdgcn_cvt_scalef32_pk_fp4_f32(0u, r0, r1, 1.0f, 3);
            q1[wd] |= t1; q2[wd] |= t2;
          }
        }
        unsigned char* hq4 = smem + 33792 + wid * 1024;
        *(uint2*)(hq4 + lane * 8) = make_uint2(q1[0], q1[1]);
        *(uint2*)(hq4 + 512 + lane * 8) = make_uint2(q2[0], q2[1]);
#pragma unroll
        for (int kc = 0; kc < 8; ++kc) { hB1[kc] = *(const uint4*)(hq4 + 64 * kc + 16 * fq); hB2[kc] = *(const uint4*)(hq4 + 512 + 64 * kc + 16 * fq); }
      }
      f32x2 acc2[8];
#pragma unroll
      for (int j = 0; j < 8; ++j) acc2[j] = (f32x2){0.f, 0.f};
#pragma unroll 1
      for (int bt = 0; bt < 8; ++bt) {
        const int myidx = idxL[tl * 132 + 16 * bt + fr] & 0xffff;
        unsigned char* ust = smem + 41984 + wid * 8448;
        uint2 ul[16], vr[16];
#pragma unroll
        for (int r = 0; r < 16; ++r) { const unsigned off = (unsigned)__builtin_amdgcn_readlane(myidx, r) * 512u + (unsigned)lane * 8u; ul[r] = *(const uint2*)((const unsigned char*)U4 + off); }
        __builtin_amdgcn_sched_barrier(0);
#pragma unroll
        for (int r = 0; r < 16; ++r) { const unsigned off = (unsigned)__builtin_amdgcn_readlane(myidx, r) * 512u + (unsigned)lane * 8u; vr[r] = *(const uint2*)((const unsigned char*)V4 + off); }
        __builtin_amdgcn_sched_barrier(0);
#pragma unroll
        for (int r = 0; r < 16; ++r) *(uint2*)(ust + r * 528 + lane * 8) = ul[r];
        uint4 ua[8];
#pragma unroll
        for (int kc = 0; kc < 8; ++kc) ua[kc] = *(const uint4*)(ust + fr * 528 + 64 * kc + 16 * fq);
        f32x4 sa[2] = {(f32x4){0.f, 0.f, 0.f, 0.f}, (f32x4){0.f, 0.f, 0.f, 0.f}}, sb[2] = {(f32x4){0.f, 0.f, 0.f, 0.f}, (f32x4){0.f, 0.f, 0.f, 0.f}};
#pragma unroll
        for (int kc = 0; kc < 8; ++kc) {
          const i32x8 av = (i32x8){(int)ua[kc].x, (int)ua[kc].y, (int)ua[kc].z, (int)ua[kc].w, 0, 0, 0, 0};
          const i32x8 b1 = (i32x8){(int)hB1[kc].x, (int)hB1[kc].y, (int)hB1[kc].z, (int)hB1[kc].w, 0, 0, 0, 0};
          const i32x8 b2 = (i32x8){(int)hB2[kc].x, (int)hB2[kc].y, (int)hB2[kc].z, (int)hB2[kc].w, 0, 0, 0, 0};
          sa[kc & 1] = __builtin_amdgcn_mfma_scale_f32_16x16x128_f8f6f4(av, b1, sa[kc & 1], 4  , 4  , 0, 0x7F7F7F7F, 0, 0x7F7F7F7F);
          sb[kc & 1] = __builtin_amdgcn_mfma_scale_f32_16x16x128_f8f6f4(av, b2, sb[kc & 1], 4, 4, 0, 0x7F7F7F7F, 0, 0x7F7F7F7F);
        }
        f32x4 sc4 = (sa[0] + sa[1]) + (sb[0] + sb[1]) * 0.125f;
        const int jsel = lane & 3;
        const float dsel = jsel == 0 ? sc4[0] : (jsel == 1 ? sc4[1] : (jsel == 2 ? sc4[2] : sc4[3]));
        const float gl = __uint_as_float((unsigned)idxL[tl * 132 + 16 * bt + 4 * fq + jsel] & 0xffff0000u);
        const float w = gl * gelu_tanh_fast(dsel * (1.f / 64.f));
#pragma unroll
        for (int r = 0; r < 16; ++r) {
          const float wr = __int_as_float(__builtin_amdgcn_readlane(__float_as_int(w), 16 * (r >> 2) + (r & 3)));
          axpy16_fp4(vr[r], wr, acc2);
          if ((r & 3) == 3) __builtin_amdgcn_sched_barrier(0);
        }
      }
      float acc[16];
#pragma unroll
      for (int j = 0; j < 8; ++j) { acc[2 * j] = acc2[j].x; acc[2 * j + 1] = acc2[j].y; }
      float xn[16]; float ss = 0.f;
      const uint4 xr0 = *(const uint4*)(X + (size_t)t * 1024 + lane * 16), xr1 = *(const uint4*)(X + (size_t)t * 1024 + lane * 16 + 8);
      const unsigned xw[8] = {xr0.x, xr0.y, xr0.z, xr0.w, xr1.x, xr1.y, xr1.z, xr1.w};
#pragma unroll
      for (int qq = 0; qq < 4; ++qq) {
        const int c = lane * 16 + 4 * qq;
        const f32x4 xv = (f32x4){__uint_as_float(xw[2 * qq] << 16), __uint_as_float(xw[2 * qq] & 0xffff0000u), __uint_as_float(xw[2 * qq + 1] << 16), __uint_as_float(xw[2 * qq + 1] & 0xffff0000u)};
        const f32x4 g = *(const f32x4*)(g2 + b * 6144 + c);
        xn[4 * qq] = xv.x + g.x * acc[4 * qq] * 0.25f; xn[4 * qq + 1] = xv.y + g.y * acc[4 * qq + 1] * 0.25f;
        xn[4 * qq + 2] = xv.z + g.z * acc[4 * qq + 2] * 0.25f; xn[4 * qq + 3] = xv.w + g.w * acc[4 * qq + 3] * 0.25f;
        ss += xn[4 * qq] * xn[4 * qq] + xn[4 * qq + 1] * xn[4 * qq + 1] + xn[4 * qq + 2] * xn[4 * qq + 2] + xn[4 * qq + 3] * xn[4 * qq + 3];
      }
      const float rstd = rsqrtf(wave_sum(ss) * (1.f / 1024.f) + EPS_);
      if (!last) {
        unsigned hb[8], xb[8];
#pragma unroll
        for (int qq = 0; qq < 4; ++qq) {
          const int c = lane * 16 + 4 * qq;
          xb[2 * qq] = pk2(xn[4 * qq], xn[4 * qq + 1]); xb[2 * qq + 1] = pk2(xn[4 * qq + 2], xn[4 * qq + 3]);
          const f32x4 gn = *(const f32x4*)(ngain + c), sh = *(const f32x4*)(nsh + b * 6144 + c), sc = *(const f32x4*)(nsc + b * 6144 + c);
          hb[2 * qq] = pk2(xn[4 * qq] * rstd * gn.x * (1.f + sc.x) + sh.x, xn[4 * qq + 1] * rstd * gn.y * (1.f + sc.y) + sh.y);
          hb[2 * qq + 1] = pk2(xn[4 * qq + 2] * rstd * gn.z * (1.f + sc.z) + sh.z, xn[4 * qq + 3] * rstd * gn.w * (1.f + sc.w) + sh.w);
        }
        *(uint4*)(X + (size_t)t * 1024 + lane * 16) = make_uint4(xb[0], xb[1], xb[2], xb[3]);
        *(uint4*)(X + (size_t)t * 1024 + lane * 16 + 8) = make_uint4(xb[4], xb[5], xb[6], xb[7]);
        *(uint4*)(HF + (size_t)t * 1024 + lane * 16) = make_uint4(hb[0], hb[1], hb[2], hb[3]);
        *(uint4*)(HF + (size_t)t * 1024 + lane * 16 + 8) = make_uint4(hb[4], hb[5], hb[6], hb[7]);
      } else {
#pragma unroll
        for (int qq = 0; qq < 4; ++qq) {
          const int c = lane * 16 + 4 * qq;
          const f32x4 fn = *(const f32x4*)(gin(pp->in[I_FNORM]) + c);
          *(f32x4*)((float*)pp->out + (size_t)t * 1024 + c) = (f32x4){xn[4 * qq] * rstd * fn.x, xn[4 * qq + 1] * rstd * fn.y, xn[4 * qq + 2] * rstd * fn.z, xn[4 * qq + 3] * rstd * fn.w};
        }
      }
    }
  }
}

#define XB_TMO      128
#define XB_XCNT(j)  (256  + 64 * (j))
#define XB_XSUB(j)  (1280 + 64 * (j))
#define XB_XGEN(j)  (2304 + 64 * (j))
#define XB_TOP      3328
#define XB_TOPGEN   3392
#define XCD_BAR_WORDS 3456
#define XB_SPIN_CAP (1u << 20)
#define LAS __attribute__((address_space(3)))
__device__ __forceinline__ unsigned xb_ld(unsigned* q)              { return __hip_atomic_load(q, __ATOMIC_RELAXED, __HIP_MEMORY_SCOPE_AGENT); }
__device__ __forceinline__ unsigned xb_add(unsigned* q, unsigned v) { return __hip_atomic_fetch_add(q, v, __ATOMIC_RELAXED, __HIP_MEMORY_SCOPE_AGENT); }
__device__ __forceinline__ unsigned xb_xcc_id() { return (unsigned)__builtin_amdgcn_s_getreg((3 << 11) | 20) & 0xFu; }
#define XB_SPIN(cond, bar) do { unsigned _sp = 0; while (cond) { __builtin_amdgcn_s_sleep(1); \
    if ((++_sp & 255u) == 0u) { if (xb_ld(&(bar)[XB_TMO])) break; if (_sp > XB_SPIN_CAP) { atomicAdd(&(bar)[XB_TMO], 1u); break; } } } } while (0)
struct XcdBarrier { unsigned* bar; unsigned x; volatile LAS unsigned* st; };
__device__ __forceinline__ XcdBarrier xcd_barrier_post(unsigned* bar, volatile LAS unsigned* st) {
    XcdBarrier b; b.bar = bar; b.x = xb_xcc_id(); b.st = st;
    if (threadIdx.x == 0) (void)xb_add(&bar[XB_XCNT(b.x)], 1u);
    return b;
}
__device__ __forceinline__ void xcd_barrier_complete(unsigned* bar, unsigned x, unsigned& nloc, unsigned& nx) {
    const unsigned G = gridDim.x * gridDim.y * gridDim.z;
    unsigned sum, cnt, mine, sp = 0u;
    for (;;) {
        sum = 0u; cnt = 0u; mine = 0u;
#pragma unroll
        for (unsigned j = 0; j < 16; ++j) { const unsigned c = xb_ld(&bar[XB_XCNT(j)]); sum += c; cnt += (c > 0u) ? 1u : 0u; mine = (j == x) ? c : mine; }
        if (sum == G) break;
        __builtin_amdgcn_s_sleep(1);
        if ((++sp & 255u) == 0u) { if (xb_ld(&bar[XB_TMO])) break; if (sp > XB_SPIN_CAP) { atomicAdd(&bar[XB_TMO], 1u); break; } }
    }
    nloc = mine > 0u ? mine : 1u; nx = cnt > 0u ? cnt : 1u;
}
__device__ __forceinline__ void xcd_barrier(const XcdBarrier& b) {
    asm volatile("s_waitcnt vmcnt(0)" ::: "memory");
    __syncthreads();
    if (threadIdx.x == 0) {
        unsigned* bar = b.bar;
        __builtin_amdgcn_s_waitcnt(0);
        unsigned nloc = b.st[0], nx = b.st[1];
        if (nloc == 0u) { xcd_barrier_complete(bar, b.x, nloc, nx); b.st[0] = nloc; b.st[1] = nx; }
        const unsigned old = xb_add(&bar[XB_XSUB(b.x)], 1u);
        const unsigned gen = old / nloc;
        if (old + 1u == (gen + 1u) * nloc) {
            __builtin_amdgcn_fence(__ATOMIC_RELEASE, "agent");
            asm volatile("s_waitcnt vmcnt(0)" ::: "memory");
            const unsigned og = xb_add(&bar[XB_TOP], 1u);
            const unsigned tg = og / nx;
            if (og + 1u == (tg + 1u) * nx) xb_add(&bar[XB_TOPGEN], 1u);
            else XB_SPIN(xb_ld(&bar[XB_TOPGEN]) == tg, bar);
            __builtin_amdgcn_fence(__ATOMIC_ACQUIRE, "agent");
            xb_add(&bar[XB_XGEN(b.x)], 1u);
            asm volatile("s_waitcnt vmcnt(0)" ::: "memory");
        } else {
            XB_SPIN(xb_ld(&bar[XB_XGEN(b.x)]) == gen, bar);
            __builtin_amdgcn_fence(__ATOMIC_ACQUIRE, "agent");
            asm volatile("s_waitcnt vmcnt(0)" ::: "memory");
        }
    }
    __syncthreads();
}

__global__ void __launch_bounds__(NT) fwd_megakernel(Params p) {
  extern __shared__ __attribute__((aligned(16))) unsigned char smem[];
  const CParamsP pp = launder_kargs();
  cg::grid_group grid = cg::this_grid();
  volatile LAS unsigned* xbst = (volatile LAS unsigned*)(smem + LDS_BYTES - 16);
  if (threadIdx.x == 0) { xbst[0] = 0u; xbst[1] = 0u; }
  if (blockIdx.x == 0) { unsigned* bw = (unsigned*)(pp->ws + WS_BAR); for (int i = threadIdx.x; i < XCD_BAR_WORDS; i += NT) bw[i] = 0u; }
  setup_phase(p, smem);
  grid.sync();
  const XcdBarrier xb = xcd_barrier_post((unsigned*)(pp->ws + WS_BAR), xbst);
  const float* MOD = (const float*)(pp->ws + WS_MOD);
  for (int l = 0; l < DEPTH_; ++l) {
    const float* xsrc = (l == 0) ? gin(pp->in[I_X]) : (const float*)(pp->ws + WS_X);
    const float* modl = MOD + (size_t)l * 2 * 6144;
    if (l == 0) {
      norm_mod_phase(xsrc, gin(pp->in[I_NMIX]), modl + 0, modl + 1024, (bf16_t*)(pp->ws + WS_ABUF));
      qbias_phase(p, smem);
      xcd_barrier(xb);
    }
    gemm_proj_phase(p, l, smem);
    xcd_barrier(xb);
    attn_phase(p, l, smem);
    mix_local_phase(p, l, smem);
    xcd_barrier(xb);
    scan_phase(p, l);
    xcd_barrier(xb);
    mix_final_phase(p, l, smem);
    xcd_barrier(xb);
    gemm_out_phase(p, l, smem);
    xcd_barrier(xb);
    gemm_q_phase(p, l, smem);
    xcd_barrier(xb);
    peer_phase(p, l, l == DEPTH_ - 1, smem);
    xcd_barrier(xb);
  }
}

extern "C" void kernel_launch(void* const* d_in, const int* in_sizes, int n_in,
                              void* d_out, int out_size, void* d_ws, size_t ws_size,
                              hipStream_t stream) {
  static int grid_blocks = 0;
  if (grid_blocks == 0) {
    if (n_in != 24 || ws_size < WS_END) { fprintf(stderr, "kernel_launch: unexpected n_in %d / ws_size %zu (need %zu)\n", n_in, ws_size, (size_t)WS_END); grid_blocks = -1; return; }
    int dev = 0, cus = 0, per_cu = 0;
    if (hipGetDevice(&dev) != hipSuccess || hipDeviceGetAttribute(&cus, hipDeviceAttributeMultiprocessorCount, dev) != hipSuccess) { grid_blocks = -1; return; }
    if (hipFuncSetAttribute((const void*)fwd_megakernel, hipFuncAttributeMaxDynamicSharedMemorySize, LDS_BYTES) != hipSuccess) { fprintf(stderr, "hipFuncSetAttribute failed\n"); grid_blocks = -1; return; }
    if (hipOccupancyMaxActiveBlocksPerMultiprocessor(&per_cu, (const void*)fwd_megakernel, NT, LDS_BYTES) != hipSuccess || per_cu < 1) { fprintf(stderr, "occupancy query: %d\n", per_cu); grid_blocks = -1; return; }
    grid_blocks = cus;
  }
  if (grid_blocks < 0) return;
  Params p{};
  for (int i = 0; i < 24; ++i) p.in[i] = (const GAS float*)d_in[i];
  p.out = (GAS float*)d_out; p.ws = (GAS unsigned char*)d_ws;
  void* args[] = {&p};
  hipError_t e = hipLaunchCooperativeKernel((void*)fwd_megakernel, dim3(grid_blocks), dim3(NT), args, LDS_BYTES, stream);
  if (e != hipSuccess) fprintf(stderr, "cooperative launch failed: %s (grid %d)\n", hipGetErrorString(e), grid_blocks);
}
```

```cpp
#include <hip/hip_runtime.h>
#include <hip/hip_cooperative_groups.h>
#include <cstdio>
#include <cstdint>
namespace cg = cooperative_groups;

typedef unsigned short bf16_t;
typedef short bf16x8 __attribute__((ext_vector_type(8)));
typedef float f32x4 __attribute__((ext_vector_type(4)));
typedef float f32x16 __attribute__((ext_vector_type(16)));
typedef int i32x8 __attribute__((ext_vector_type(8)));

constexpr int T_ = 16384, D_ = 1024, L_ = 8192, NBATCH = 2, DEPTH_ = 4;
constexpr int INC = 2944, INCP = 3072;
constexpr int NCH = 128;
constexpr int NT = 512;
constexpr int NW = 8;
constexpr float EPS_ = 1e-6f;
constexpr int C_QA = 0, C_KA = 384, C_VA = 768, C_QR = 1152, C_KR = 1536, C_VR = 1920, C_GR = 2304, C_US = 2688;

constexpr size_t al256(size_t x) { return (x + 255) & ~(size_t)255; }
constexpr size_t WS_MOD   = 0;
constexpr size_t WS_ROTC  = al256(WS_MOD + 4ull * 2 * 6144 * 4);
constexpr size_t WS_ROTS  = al256(WS_ROTC + 8192ull * 32 * 4);
constexpr size_t WS_SA    = al256(WS_ROTS + 8192ull * 32 * 4);
constexpr size_t WS_SBB   = al256(WS_SA + 4ull * 16 * 64 * 2 * 4);
constexpr size_t WS_WIN   = al256(WS_SBB + 4ull * 16 * 64 * 32 * 4);
constexpr size_t WS_WOUT  = al256(WS_WIN + 4ull * INCP * 1024 * 2);
constexpr size_t WS_WQ    = al256(WS_WOUT + 4ull * 1024 * 1024 * 2);
constexpr size_t WS_SUBK  = al256(WS_WQ + 4ull * 2048 * 1024 * 2);
constexpr size_t WS_ABUF  = al256(WS_SUBK + 4ull * 16 * 128 * 128 * 2);
constexpr size_t WS_PROJ  = al256(WS_ABUF + (size_t)T_ * 1024 * 2);
constexpr size_t WS_VTA   = al256(WS_PROJ + (size_t)T_ * INCP * 2);
constexpr size_t WS_ATT   = al256(WS_VTA + 2ull * 6 * 64 * 8192 * 2);
constexpr size_t WS_YINT  = al256(WS_ATT + (size_t)T_ * 384 * 4);
constexpr size_t WS_UPD   = al256(WS_YINT + (size_t)T_ * 384 * 4);
constexpr size_t WS_SPREV = al256(WS_UPD + 256ull * 6 * 4096 * 4);
constexpr size_t WS_SEND  = al256(WS_SPREV + 256ull * 6 * 4096 * 4);
constexpr size_t WS_CARRY = al256(WS_SEND + 256ull * 16 * 64 * 2 * 4);
constexpr size_t WS_X     = al256(WS_CARRY + 256ull * 16 * 64 * 2 * 4);
constexpr size_t WS_Q     = al256(WS_X + (size_t)T_ * 1024 * 4);
constexpr size_t WS_SC    = al256(WS_Q + (size_t)T_ * 2048 * 2);
constexpr size_t WS_EIDX  = al256(WS_SC + (size_t)T_ * 2048 * 4);
constexpr size_t WS_EGATE = al256(WS_EIDX + (size_t)T_ * 128 * 4);
constexpr size_t WS_PU8   = al256(WS_EGATE + (size_t)T_ * 128 * 4);
constexpr size_t WS_PV8   = al256(WS_PU8 + 4ull * 16384 * 1024);
constexpr size_t WS_BAR   = al256(WS_PV8 + 4ull * 16384 * 1024);
constexpr size_t WS_SPT   = al256(WS_BAR + 3456ull * 4);
constexpr size_t WS_CB    = al256(WS_SPT + 256ull * 6 * 4096 * 2);
constexpr size_t WS_WGLUT = al256(WS_CB + 4ull * 16 * 16 * 128 * 2);
constexpr size_t WS_VTR   = al256(WS_WGLUT + 4ull * 512 * 256 * 2);
constexpr size_t WS_XG    = al256(WS_VTR + 2ull * 384 * 8192 * 2);
constexpr size_t WS_SSQ   = al256(WS_XG + (size_t)T_ * 1024 * 2);
constexpr size_t WS_C2    = al256(WS_SSQ + (size_t)T_ * 16 * 4);
constexpr size_t WS_BBH   = al256(WS_C2 + 4ull * 2 * 2048 * 4);
constexpr size_t WS_END   = al256(WS_BBH + 4ull * 16 * 2 * 64 * 16 * 2);

constexpr int LDS_BYTES = 135168;

#define GAS __attribute__((address_space(1)))
struct Params {
  const GAS float* in[24];
  GAS float* out;
  GAS unsigned char* ws;
};
enum { I_X = 0, I_C, I_WADA, I_BADA, I_NMIX, I_NFFN, I_WIN, I_RELB, I_LRE, I_LIM, I_LOGDT, I_BRE, I_BIM, I_CRE, I_CIM, I_SSMD,
       I_WGLU, I_MGAIN, I_WOUT, I_WQ, I_SUBK, I_PU, I_PV, I_FNORM };

__device__ __forceinline__ float bf2f(bf16_t v) { return __uint_as_float(((unsigned)v) << 16); }
__device__ __forceinline__ bf16_t f2bf(float f) { unsigned u = __float_as_uint(f); u += 0x7fffu + ((u >> 16) & 1u); return (bf16_t)(u >> 16); }
__device__ __forceinline__ unsigned pk2(float a, float b) { return (unsigned)f2bf(a) | ((unsigned)f2bf(b) << 16); }
__device__ __forceinline__ float wave_sum(float v) {
#pragma unroll
  for (int o = 32; o > 0; o >>= 1) v += __shfl_xor(v, o);
  return v;
}
__device__ __forceinline__ float wave_max(float v) {
#pragma unroll
  for (int o = 32; o > 0; o >>= 1) v = fmaxf(v, __shfl_xor(v, o));
  return v;
}
__device__ __forceinline__ float gelu_tanh(float x) { const float u = 0.7978845608028654f * (x + 0.044715f * x * x * x); return 0.5f * x * (1.f + tanhf(u)); }
__device__ __forceinline__ float sigmoid_f(float x) { return 1.f / (1.f + __expf(-x)); }
__device__ __forceinline__ float gelu_tanh_fast(float x) {
  const float u2 = 2.f * 0.7978845608028654f * 1.4426950408889634f * (x + 0.044715f * x * x * x);
  const float e = __builtin_amdgcn_exp2f(fminf(u2, 80.f));
  return x - x * __builtin_amdgcn_rcpf(1.f + e);
}
__device__ __forceinline__ GAS unsigned char* launder_ptr(GAS unsigned char* q) { asm volatile("" : "+s"(q)); return q; }
__device__ __forceinline__ const float* gin(const GAS float* q) { return (const float*)q; }
__device__ __forceinline__ const float* launder_cptr(const float* q) { asm volatile("" : "+s"(q)); return q; }
__device__ __forceinline__ int launder_tid() { int t = threadIdx.x; asm volatile("" : "+v"(t)); return t; }
typedef const Params __attribute__((address_space(4)))* CParamsP;
__device__ __forceinline__ CParamsP launder_kargs() { CParamsP q = (CParamsP)__builtin_amdgcn_kernarg_segment_ptr(); asm volatile("" : "+s"(q)); return q; }

__device__ __forceinline__ void convert_tables_fp4(const CParamsP pp, GAS unsigned char* ws, int layer, int gtid, int gn) {
  constexpr size_t NIT = 16384ull * 1024 / 16;
  for (size_t it = gtid; it < 2 * NIT; it += gn) {
    const int tb = it >= NIT ? 1 : 0; const size_t r = (it - (size_t)tb * NIT) + (size_t)layer * NIT;
    const f32x4* src = (const f32x4*)((tb ? gin(pp->in[I_PV]) : gin(pp->in[I_PU])) + r * 16);
    const float sc = tb ? 4.f : 64.f;
    unsigned o[2] = {0u, 0u};
#pragma unroll
    for (int q = 0; q < 4; ++q) {
      const f32x4 a = src[q];
      const float x0 = fminf(fmaxf(a.x * sc, -6.f), 6.f), x1 = fminf(fmaxf(a.y * sc, -6.f), 6.f);
      const float x2 = fminf(fmaxf(a.z * sc, -6.f), 6.f), x3 = fminf(fmaxf(a.w * sc, -6.f), 6.f);
      if (q == 0)      { o[0] = __builtin_amdgcn_cvt_scalef32_pk_fp4_f32(o[0], x0, x1, 1.0f, 0); o[0] = __builtin_amdgcn_cvt_scalef32_pk_fp4_f32(o[0], x2, x3, 1.0f, 1); }
      else if (q == 1) { o[0] = __builtin_amdgcn_cvt_scalef32_pk_fp4_f32(o[0], x0, x1, 1.0f, 2); o[0] = __builtin_amdgcn_cvt_scalef32_pk_fp4_f32(o[0], x2, x3, 1.0f, 3); }
      else if (q == 2) { o[1] = __builtin_amdgcn_cvt_scalef32_pk_fp4_f32(o[1], x0, x1, 1.0f, 0); o[1] = __builtin_amdgcn_cvt_scalef32_pk_fp4_f32(o[1], x2, x3, 1.0f, 1); }
      else             { o[1] = __builtin_amdgcn_cvt_scalef32_pk_fp4_f32(o[1], x0, x1, 1.0f, 2); o[1] = __builtin_amdgcn_cvt_scalef32_pk_fp4_f32(o[1], x2, x3, 1.0f, 3); }
    }
    *(uint2*)(ws + (tb ? WS_PV8 : WS_PU8) + r * 8) = make_uint2(o[0], o[1]);
  }
}

__device__ void setup_phase(const Params& p, unsigned char* smem) {
  const CParamsP pp = launder_kargs();
  GAS unsigned char* const ws = launder_ptr(pp->ws); const int tidx = launder_tid(); (void)ws; (void)tidx;
  const int tid = tidx;
  float* sm = (float*)smem;
  {
    float* cond = sm;
    float* red = sm + 2048;
    float* MOD = (float*)(ws + WS_MOD);
    for (int i = tid; i < 2048; i += NT) { const float c = gin(pp->in[I_C])[i]; cond[i] = c * sigmoid_f(c); }
    __syncthreads();
    for (int item = blockIdx.x; item < 4 * 96; item += gridDim.x) {
      const int l = item / 96, cb = item % 96, kq = tid >> 6, jj = tid & 63, j = cb * 64 + jj;
      const float* w = gin(pp->in[I_WADA]) + (size_t)l * 1024 * 6144 + j;
      float a0 = 0.f, a1 = 0.f;
#pragma unroll 16
      for (int k = kq * 128; k < kq * 128 + 128; ++k) { const float wv = w[(size_t)k * 6144]; a0 += cond[k] * wv; a1 += cond[1024 + k] * wv; }
      red[(kq * 2 + 0) * 64 + jj] = a0; red[(kq * 2 + 1) * 64 + jj] = a1;
      __syncthreads();
      if (tid < 128) {
        const int b = tid >> 6, j2 = tid & 63; float s = 0.f;
        for (int q = 0; q < 8; ++q) s += red[(q * 2 + b) * 64 + j2];
        MOD[((size_t)l * 2 + b) * 6144 + cb * 64 + j2] = s + gin(pp->in[I_BADA])[(size_t)l * 6144 + cb * 64 + j2];
      }
      __syncthreads();
    }
  }
  const int gtid = blockIdx.x * NT + tid, gn = gridDim.x * NT;
  {
    float* RC = (float*)(ws + WS_ROTC); float* RS = (float*)(ws + WS_ROTS);
    for (int idx = gtid; idx < 8192 * 32; idx += gn) {
      const int pos = idx >> 5, i = idx & 31;
      const float inv = powf(10000.0f, -(float)i / 32.0f);
      const float ang = (float)pos * inv;
      float s, c; sincosf(ang, &s, &c);
      RC[idx] = c; RS[idx] = s;
    }
  }
  {
    float* SA = (float*)(ws + WS_SA); float* SBB = (float*)(ws + WS_SBB); bf16_t* BBH = (bf16_t*)(ws + WS_BBH);
    for (int idx = gtid; idx < 4 * 16 * 64; idx += gn) {
      const int l = idx / 1024, g = (idx >> 6) & 15;
      const float dt = expf(gin(pp->in[I_LOGDT])[l * 16 + g]);
      const float lr = gin(pp->in[I_LRE])[idx], li = gin(pp->in[I_LIM])[idx];
      const float mag = expf(lr * dt);
      float sn, cs; sincosf(li * dt, &sn, &cs);
      const float are = mag * cs, aim = mag * sn;
      const float den = lr * lr + li * li, nr = are - 1.f, ni = aim;
      const float fre = (nr * lr + ni * li) / den, fim = (ni * lr - nr * li) / den;
      SA[idx * 2] = are; SA[idx * 2 + 1] = aim;
      for (int c = 0; c < 16; ++c) {
        const float br = gin(pp->in[I_BRE])[(size_t)idx * 16 + c], bi = gin(pp->in[I_BIM])[(size_t)idx * 16 + c];
        SBB[(size_t)idx * 32 + c] = fre * br - fim * bi;
        SBB[(size_t)idx * 32 + 16 + c] = fre * bi + fim * br;
        {
          const int pq = idx & 63; const size_t fb = (size_t)(idx >> 6) * 2;
          BBH[(((fb + 0) * 2 + (pq >> 5)) * 64 + 32 * (c >> 3) + (pq & 31)) * 8 + (c & 7)] = f2bf(fre * br - fim * bi);
          BBH[(((fb + 1) * 2 + (pq >> 5)) * 64 + 32 * (c >> 3) + (pq & 31)) * 8 + (c & 7)] = f2bf(fre * bi + fim * br);
        }
      }
    }
  }
  {
    bf16_t* CB = (bf16_t*)(ws + WS_CB);
    for (int idx = gtid; idx < 4 * 16 * 16 * 128; idx += gn) {
      const int k = idx & 127, lgc = idx >> 7;
      const bf16_t cv = (k < 64) ? f2bf(gin(pp->in[I_CRE])[(size_t)lgc * 64 + k]) : f2bf(-gin(pp->in[I_CIM])[(size_t)lgc * 64 + (k - 64)]);
      const int cc = lgc & 15, lg = lgc >> 4;
      CB[(((size_t)lg * 4 + (k >> 5)) * 64 + ((k >> 3) & 3) * 16 + cc) * 8 + (k & 7)] = cv;
    }
    bf16_t* WG = (bf16_t*)(ws + WS_WGLUT);
    for (int idx = gtid; idx < 4 * 512 * 256; idx += gn) {
      const int k = idx & 255, nn = (idx >> 8) & 511, l2 = idx >> 17;
      {
        const int which = nn >> 8, w8 = (nn >> 5) & 7, nt = (nn >> 4) & 1, frr = nn & 15, ks = k >> 5, fqq = (k >> 3) & 3, j = k & 7;
        WG[(((((size_t)l2 * 8 + w8) * 8 + ks) * 2 + which) * 2 + nt) * 512 + (fqq * 16 + frr) * 8 + j] = f2bf(gin(pp->in[I_WGLU])[((size_t)l2 * 256 + k) * 512 + nn]);
      }
    }
  }
  convert_tables_fp4(pp, ws, 0, gtid, gn);
  {
    __syncthreads();
    const int lane = tid & 63, wid = tid >> 6;
    float* scr = sm + wid * (64 * 33);
    constexpr int IT_IN = 16 * 96, IT_OUT = 16 * 32, IT_L = IT_IN + IT_OUT;
    for (int item = blockIdx.x * NW + wid; item < 4 * IT_L; item += gridDim.x * NW) {
      const int l = item / IT_L; int r = item - l * IT_L;
      const float* W; bf16_t* WT; int N, NP;
      if (r < IT_IN) { W = gin(pp->in[I_WIN]) + (size_t)l * 1024 * INC; WT = (bf16_t*)(ws + WS_WIN) + (size_t)l * INCP * 1024; N = INC; NP = 96; }
      else { r -= IT_IN; W = gin(pp->in[I_WOUT]) + (size_t)l * 1024 * 1024; WT = (bf16_t*)(ws + WS_WOUT) + (size_t)l * 1024 * 1024; N = 1024; NP = 32; }
      const int kb = r / NP, nb = r - kb * NP, k0 = kb * 64, n0 = nb * 32;
      const int nn = n0 + (lane & 31); const bool inb = nn < N;
      float v[32];
#pragma unroll
      for (int i = 0; i < 32; ++i) { const int kk = 2 * i + (lane >> 5); v[i] = inb ? W[(size_t)(k0 + kk) * N + nn] : 0.f; }
#pragma unroll
      for (int i = 0; i < 32; ++i) { const int kk = 2 * i + (lane >> 5); scr[kk * 33 + (lane & 31)] = v[i]; }
      const int c = lane & 7;
#pragma unroll
      for (int j = 0; j < 4; ++j) {
        const int n = (lane >> 3) + 8 * j; const float* sp = scr + (8 * c) * 33 + n;
        uint4 o; o.x = pk2(sp[0], sp[33]); o.y = pk2(sp[2 * 33], sp[3 * 33]); o.z = pk2(sp[4 * 33], sp[5 * 33]); o.w = pk2(sp[6 * 33], sp[7 * 33]);
        *(uint4*)(WT + (size_t)(n0 + n) * 1024 + k0 + 8 * c) = o;
      }
    }
    __syncthreads();
  }
  {
    float* WtT = sm;
    float* SKs = sm + 128 * 65;
    bf16_t* WP = (bf16_t*)(ws + WS_WQ);
    for (int item = blockIdx.x; item < 4 * 16 * 16; item += gridDim.x) {
      const int l = item >> 8, hs = (item >> 4) & 15, kb = item & 15, k0 = kb * 64;
      const float* Wq = gin(pp->in[I_WQ]) + (size_t)l * 1024 * 2048 + hs * 128;
      const float* SKg = gin(pp->in[I_SUBK]) + ((size_t)l * 16 + hs) * 128 * 128;
      __syncthreads();
#pragma unroll
      for (int i = 0; i < 16; ++i) { const int idx = tid + NT * i, kk = idx >> 7, d = idx & 127; WtT[d * 65 + kk] = Wq[(size_t)(k0 + kk) * 2048 + d]; }
#pragma unroll
      for (int i = 0; i < 32; ++i) { const int idx = tid + NT * i, key = idx >> 7, d = idx & 127; SKs[key * 129 + d] = SKg[idx]; }
      __syncthreads();
      const int key = tid & 127, kg = tid >> 7;
      float acc[16];
#pragma unroll
      for (int i = 0; i < 16; ++i) acc[i] = 0.f;
#pragma unroll 4
      for (int d = 0; d < 128; ++d) {
        const float sv = SKs[key * 129 + d];
#pragma unroll
        for (int i = 0; i < 16; ++i) acc[i] += sv * WtT[d * 65 + kg * 16 + i];
      }
      uint4 o0, o1;
      o0.x = pk2(acc[0], acc[1]); o0.y = pk2(acc[2], acc[3]); o0.z = pk2(acc[4], acc[5]); o0.w = pk2(acc[6], acc[7]);
      o1.x = pk2(acc[8], acc[9]); o1.y = pk2(acc[10], acc[11]); o1.z = pk2(acc[12], acc[13]); o1.w = pk2(acc[14], acc[15]);
      bf16_t* dst = WP + ((size_t)l * 2048 + hs * 128 + key) * 1024 + k0 + kg * 16;
      *(uint4*)dst = o0; *(uint4*)(dst + 8) = o1;
    }
    __syncthreads();
  }
}

__device__ void qbias_phase(const Params& p, unsigned char* smem) {
  const CParamsP pp = launder_kargs();
  GAS unsigned char* const ws = launder_ptr(pp->ws); const int tid = launder_tid();
  float* C2 = (float*)(ws + WS_C2); const float* MOD = (const float*)(ws + WS_MOD); const bf16_t* WP = (const bf16_t*)(ws + WS_WQ);
  const int lane = tid & 63, gw = blockIdx.x * NW + (tid >> 6), nw = gridDim.x * NW;
  for (int o = gw; o < 4 * 2048; o += nw) {
    const int l = o >> 11;
    const uint4 w0 = *(const uint4*)(WP + (size_t)o * 1024 + lane * 16), w1 = *(const uint4*)(WP + (size_t)o * 1024 + lane * 16 + 8);
    const unsigned ww[8] = {w0.x, w0.y, w0.z, w0.w, w1.x, w1.y, w1.z, w1.w};
    const float* s0 = MOD + (size_t)l * 2 * 6144 + 3072 + lane * 16; const float* s1 = s0 + 6144;
    float a0 = 0.f, a1 = 0.f;
#pragma unroll
    for (int q = 0; q < 8; ++q) {
      const float wl = __uint_as_float(ww[q] << 16), wh = __uint_as_float(ww[q] & 0xffff0000u);
      a0 += s0[2 * q] * wl + s0[2 * q + 1] * wh; a1 += s1[2 * q] * wl + s1[2 * q + 1] * wh;
    }
    a0 = wave_sum(a0); a1 = wave_sum(a1);
    if (lane == 0) { C2[((size_t)l * 2 + 0) * 2048 + (o & 2047)] = a0; C2[((size_t)l * 2 + 1) * 2048 + (o & 2047)] = a1; }
  }
  (void)smem;
}

__device__ void norm_mod_phase(const float* __restrict__ xsrc, const float* __restrict__ gain, const float* __restrict__ mod_sh, const float* __restrict__ mod_sc,
                               bf16_t* __restrict__ outp) {
  const int tidx = launder_tid();
  const int lane = tidx & 63, gw = blockIdx.x * NW + (tidx >> 6), nw = gridDim.x * NW;
  for (int t = gw; t < T_; t += nw) {
    const int b = t >> 13;
    const f32x4* xr = (const f32x4*)(xsrc + (size_t)t * 1024) + lane;
    f32x4 v[4]; float s = 0.f;
#pragma unroll
    for (int j = 0; j < 4; ++j) { v[j] = xr[64 * j]; s += v[j].x * v[j].x + v[j].y * v[j].y + v[j].z * v[j].z + v[j].w * v[j].w; }
    const float rstd = rsqrtf(wave_sum(s) * (1.f / 1024.f) + EPS_);
#pragma unroll
    for (int j = 0; j < 4; ++j) {
      const int c = lane * 4 + 256 * j;
      const f32x4 g = *(const f32x4*)(gain + c), sh = *(const f32x4*)(mod_sh + b * 6144 + c), sc = *(const f32x4*)(mod_sc + b * 6144 + c);
      const float o0 = v[j].x * rstd * g.x * (1.f + sc.x) + sh.x, o1 = v[j].y * rstd * g.y * (1.f + sc.y) + sh.y;
      const float o2 = v[j].z * rstd * g.z * (1.f + sc.z) + sh.z, o3 = v[j].w * rstd * g.w * (1.f + sc.w) + sh.w;
      uint2 o; o.x = pk2(o0, o1); o.y = pk2(o2, o3);
      *(uint2*)(outp + (size_t)t * 1024 + c) = o;
    }
  }
}


namespace pg8 {
#define PG8_LAS __attribute__((address_space(3)))
typedef unsigned u32x4 __attribute__((ext_vector_type(4)));
constexpr int BM = 256, BK = 64, HALF = 128, HTB = HALF * BK * 2, STAGE_BYTES = 8 * HTB, NXCD = 8, WGM = 8;
__host__ __device__ __forceinline__ int lds_byte(int r, int c) { const int st = (r >> 4) * 2 + (c >> 5), rr = r & 15, cc = c & 31, ob = rr * 64 + cc * 2; return st * 1024 + (ob ^ (((ob >> 9) & 1) << 5)); }
__host__ __device__ __forceinline__ void stage_rc(int b, int& R, int& C) { const int st = b / 1024, sb = b % 1024, swz = sb ^ (((sb >> 9) & 1) << 5); R = (st >> 1) * 16 + swz / 64; C = (st & 1) * 32 + (swz % 64) / 2; }
__host__ __device__ __forceinline__ int perm32(int rho) { const int n = rho >> 4, i = rho & 15; return 8 * (i >> 2) + 4 * n + (i & 3); }
struct Unit { int pm, pn; };
struct Gemm { const bf16_t* A; const bf16_t* Bt; int M, N, K; };
struct StaticOrder {
    int nM, nN, nwg, G, c;
    __host__ __device__ void init(int M, int N, int G_, int c_) { nM = M / BM; nN = N / BM; nwg = nM * nN; G = G_; c = c_; }
    __host__ __device__ bool next(int i, Unit& u) const {
        const long L = (long)i * G + c; if (L >= nwg) return false;
        int wgid = (int)L; { const int q = nwg / NXCD, r = nwg % NXCD, xcd = wgid % NXCD, off = wgid / NXCD; wgid = (xcd < r ? xcd * (q + 1) : r * (q + 1) + (xcd - r) * q) + off; }
        const int nig = WGM * nN, gid = wgid / nig, fm = gid * WGM, gsz = (nM - fm) < WGM ? (nM - fm) : WGM;
        u.pm = fm + ((wgid % nig) % gsz); u.pn = (wgid % nig) / gsz; return true;
    }
    __device__ __forceinline__ void a_ready(const Unit&) const {}
    __device__ __forceinline__ void done(const Unit&) const {}
};
__device__ __forceinline__ unsigned cvt_pk_bf16(float lo, float hi) { unsigned r; asm volatile("v_cvt_pk_bf16_f32 %0, %1, %2" : "=v"(r) : "v"(lo), "v"(hi)); return r; }
template <class Epi, class Sched>
__device__ __forceinline__ void gemm_phase(PG8_LAS unsigned char* lds, const Gemm g, const Sched& S, const Epi& E) {
    const int tid = launder_tid(), wid = __builtin_amdgcn_readfirstlane(tid >> 6), lane = tid & 63, wr = wid >> 2, wc = wid & 3, fr = lane & 15, fq = lane >> 4;
    const int K = g.K, nt = K / BK;
    unsigned voffA[2], voffB[2];
#pragma unroll
    for (int i = 0; i < 2; ++i) { int R, C; stage_rc(tid * 16 + i * 8192, R, C); const int Rb = Epi::PERM ? ((R & ~31) + perm32(R & 31)) : R;
        voffA[i] = (unsigned)(R * K + C) * 2u; voffB[i] = (unsigned)(Rb * K + C) * 2u; }
    const size_t kstep = (size_t)(BK * 2);
    const size_t hstep = (size_t)HALF * K * 2;
    const size_t tstep = 2 * hstep;
    const unsigned ldsw = (unsigned)wid * 1024u;
    const int aoff = lds_byte(wr * 64 + fr, fq * 8), boff = lds_byte(wc * 32 + fr, fq * 8);
#define PG8_SA(b, h) (((b) * 2 + (h)) * HTB)
#define PG8_SB(b, h) ((4 + (b) * 2 + (h)) * HTB)
#define PG8_STAGE(bufoff, gbase, voff) do { _Pragma("unroll") for (int _i = 0; _i < 2; ++_i) \
        __builtin_amdgcn_global_load_lds((const unsigned*)((const char*)(gbase) + (voff)[_i]), (PG8_LAS unsigned*)(lds + (bufoff) + ldsw + _i * 8192), 16, 0, 0); } while (0)
#define PG8_LDA(dst, b, h) do { _Pragma("unroll") for (int m = 0; m < 4; ++m) _Pragma("unroll") for (int k = 0; k < 2; ++k) dst[m][k] = *(const PG8_LAS bf16x8*)(lds + PG8_SA(b, h) + aoff + m * 2048 + k * 1024); } while (0)
#define PG8_LDB(dst, b, h) do { _Pragma("unroll") for (int n = 0; n < 2; ++n) _Pragma("unroll") for (int k = 0; k < 2; ++k) dst[n][k] = *(const PG8_LAS bf16x8*)(lds + PG8_SB(b, h) + boff + n * 2048 + k * 1024); } while (0)
#define PG8_MMA(ai, bj, At, Bt) do { __builtin_amdgcn_s_setprio(1); _Pragma("unroll") for (int m = 0; m < 4; ++m) _Pragma("unroll") for (int n = 0; n < 2; ++n) _Pragma("unroll") for (int k = 0; k < 2; ++k) \
        acc[ai][bj][m][n] = __builtin_amdgcn_mfma_f32_16x16x32_bf16(Bt[n][k], At[m][k], acc[ai][bj][m][n], 0, 0, 0); __builtin_amdgcn_s_setprio(0); } while (0)
#define PG8_WAIT_V(n) asm volatile("s_waitcnt vmcnt(" #n ")" ::: "memory")
#define PG8_WAIT_L(n) asm volatile("s_waitcnt lgkmcnt(" #n ")" ::: "memory")
#define PG8_BAR __builtin_amdgcn_s_barrier()
#define PG8_SCHED __builtin_amdgcn_sched_barrier(0)
    Unit cur, nxt; int ui = 0;
    if (!S.next(0, cur)) return;
    f32x4 acc[2][2][4][2];
#pragma unroll
    for (int a = 0; a < 2; ++a)
#pragma unroll
        for (int b = 0; b < 2; ++b)
#pragma unroll
            for (int m = 0; m < 4; ++m)
#pragma unroll
                for (int n = 0; n < 2; ++n) acc[a][b][m][n] = (f32x4){0.f, 0.f, 0.f, 0.f};
    bf16x8 At[4][2], B0[2][2], B1[2][2];
    const char* cA = (const char*)g.A + (size_t)cur.pm * tstep; const char* cB = (const char*)g.Bt + (size_t)cur.pn * tstep;
    S.a_ready(cur);
    PG8_STAGE(PG8_SB(0, 0), cB, voffB); PG8_STAGE(PG8_SA(0, 0), cA, voffA); PG8_STAGE(PG8_SB(0, 1), cB + hstep, voffB); PG8_STAGE(PG8_SA(0, 1), cA + hstep, voffA);
    if (wr == 1) PG8_BAR;
    PG8_WAIT_V(4); PG8_BAR;
    PG8_STAGE(PG8_SB(1, 0), cB + kstep, voffB); PG8_STAGE(PG8_SA(1, 0), cA + kstep, voffA); PG8_STAGE(PG8_SB(1, 1), cB + hstep + kstep, voffB);
    PG8_WAIT_V(6); PG8_BAR;
    for (;;) {
        const bool has_next = S.next(ui + 1, nxt);
        const char* nA = has_next ? (const char*)g.A + (size_t)nxt.pm * tstep : cA; const char* nB = has_next ? (const char*)g.Bt + (size_t)nxt.pn * tstep : cB;
        for (int t = 0; t < nt; t += 2) {
            const bool last = (t == nt - 2);
            const char* a1 = cA + (size_t)(t + 1) * kstep;
            const char* a2 = last ? nA : cA + (size_t)(t + 2) * kstep; const char* b2 = last ? nB : cB + (size_t)(t + 2) * kstep;
            const char* a3 = a2 + kstep; const char* b3 = b2 + kstep;
            if (last && has_next) S.a_ready(nxt);
            PG8_LDB(B0, 0, 0); PG8_SCHED; PG8_LDA(At, 0, 0); PG8_STAGE(PG8_SA(1, 1), a1 + hstep, voffA);
            PG8_WAIT_L(8); PG8_BAR; PG8_WAIT_L(0); PG8_MMA(0, 0, At, B0); PG8_BAR; PG8_SCHED;
            PG8_LDB(B1, 0, 1); PG8_STAGE(PG8_SB(0, 0), b2, voffB);
            PG8_BAR; PG8_WAIT_L(0); PG8_MMA(0, 1, At, B1); PG8_BAR;
            PG8_LDA(At, 0, 1); PG8_STAGE(PG8_SA(0, 0), a2, voffA);
            PG8_BAR; PG8_WAIT_L(0); PG8_MMA(1, 0, At, B0); PG8_BAR; PG8_SCHED;
            PG8_STAGE(PG8_SB(0, 1), b2 + hstep, voffB);
            PG8_WAIT_V(6); PG8_BAR; PG8_MMA(1, 1, At, B1); PG8_BAR;
            PG8_LDB(B0, 1, 0); PG8_SCHED; PG8_LDA(At, 1, 0); PG8_STAGE(PG8_SA(0, 1), a2 + hstep, voffA);
            PG8_WAIT_L(8); PG8_BAR; PG8_WAIT_L(0); PG8_MMA(0, 0, At, B0); PG8_BAR; PG8_SCHED;
            PG8_LDB(B1, 1, 1); PG8_STAGE(PG8_SB(1, 0), b3, voffB);
            PG8_BAR; PG8_WAIT_L(0); PG8_MMA(0, 1, At, B1); PG8_BAR;
            PG8_LDA(At, 1, 1); PG8_STAGE(PG8_SA(1, 0), a3, voffA);
            PG8_BAR; PG8_WAIT_L(0); PG8_MMA(1, 0, At, B0); PG8_BAR; PG8_SCHED;
            PG8_STAGE(PG8_SB(1, 1), b3 + hstep, voffB);
            PG8_WAIT_V(6); PG8_BAR; PG8_MMA(1, 1, At, B1); PG8_BAR;
        }
        if constexpr (!Epi::AFTER_DRAIN) { E(acc, cur, wr, wc, fr, fq); S.done(cur); }
        if (!has_next) break;
#pragma unroll
        for (int a = 0; a < 2; ++a)
#pragma unroll
            for (int b = 0; b < 2; ++b)
#pragma unroll
                for (int m = 0; m < 4; ++m)
#pragma unroll
                    for (int n = 0; n < 2; ++n) acc[a][b][m][n] = (f32x4){0.f, 0.f, 0.f, 0.f};
        cur = nxt; cA = nA; cB = nB; ++ui;
    }
    PG8_WAIT_V(0);
    if (wr == 0) PG8_BAR;
    PG8_BAR;
    if constexpr (Epi::AFTER_DRAIN) { E.fused(acc, cur, wr, wc, fr, fq, lds, wid, lane); S.done(cur); }
#undef PG8_SA
#undef PG8_SB
#undef PG8_STAGE
#undef PG8_LDA
#undef PG8_LDB
#undef PG8_MMA
#undef PG8_WAIT_V
#undef PG8_WAIT_L
#undef PG8_BAR
#undef PG8_SCHED
}
}

__device__ __forceinline__ float ssq_total(const float* __restrict__ SSQ, int t) {
  const f32x4 a = *(const f32x4*)(SSQ + (size_t)t * 16), b = *(const f32x4*)(SSQ + (size_t)t * 16 + 4), c = *(const f32x4*)(SSQ + (size_t)t * 16 + 8), d = *(const f32x4*)(SSQ + (size_t)t * 16 + 12);
  return (((a.x + a.y) + (a.z + a.w)) + ((b.x + b.y) + (b.z + b.w))) + (((c.x + c.y) + (c.z + c.w)) + ((d.x + d.y) + (d.z + d.w)));
}
struct EpiProj {
  static constexpr bool PERM = true, AFTER_DRAIN = false;
  bf16_t* PROJ; bf16_t* VTA; bf16_t* VTR;
  __device__ __forceinline__ void operator()(const f32x4 (&acc)[2][2][4][2], const pg8::Unit& u, int wr, int wc, int fr, int fq) const {
    const int row0 = u.pm * 256 + wr * 64 + fr, col0 = u.pn * 256 + wc * 32 + 8 * fq;
#pragma unroll
    for (int ai = 0; ai < 2; ++ai)
#pragma unroll
      for (int m = 0; m < 4; ++m) {
        const int t = row0 + ai * 128 + m * 16;
#pragma unroll
        for (int bj = 0; bj < 2; ++bj) {
          const int c = col0 + bj * 128;
          const f32x4 v0 = acc[ai][bj][m][0], v1 = acc[ai][bj][m][1];
          pg8::u32x4 w; w.x = pg8::cvt_pk_bf16(v0[0], v0[1]); w.y = pg8::cvt_pk_bf16(v0[2], v0[3]); w.z = pg8::cvt_pk_bf16(v1[0], v1[1]); w.w = pg8::cvt_pk_bf16(v1[2], v1[3]);
          *(pg8::u32x4*)(PROJ + (size_t)t * INCP + c) = w;
          const bool isva = (c >= C_VA && c < C_VA + 384), isvr = (c >= C_VR && c < C_VR + 384);
          if (isva || isvr) {
            bf16_t* vt = (isva ? VTA : VTR) + ((size_t)(t >> 13) * 384 + (c - (isva ? C_VA : C_VR))) * 8192 + (t & 8191);
            vt[0] = (bf16_t)(w.x & 0xffffu); vt[8192] = (bf16_t)(w.x >> 16); vt[2 * 8192] = (bf16_t)(w.y & 0xffffu); vt[3 * 8192] = (bf16_t)(w.y >> 16);
            vt[4 * 8192] = (bf16_t)(w.z & 0xffffu); vt[5 * 8192] = (bf16_t)(w.z >> 16); vt[6 * 8192] = (bf16_t)(w.w & 0xffffu); vt[7 * 8192] = (bf16_t)(w.w >> 16);
          }
        }
      }
  }
};
struct EpiOut {
  static constexpr bool PERM = true, AFTER_DRAIN = false;
  const float* xin; int first; bf16_t* X; const float* g1; const float* nf; const float* sc2; bf16_t* XG; float* SSQ;
  __device__ __forceinline__ void operator()(const f32x4 (&acc)[2][2][4][2], const pg8::Unit& u, int wr, int wc, int fr, int fq) const {
    const int row0 = u.pm * 256 + wr * 64 + fr, col0 = u.pn * 256 + wc * 32 + 8 * fq, b = (u.pm * 256) >> 13;
    f32x4 gg[2][2], gs[2][2];
#pragma unroll
    for (int bj = 0; bj < 2; ++bj)
#pragma unroll
      for (int n = 0; n < 2; ++n) {
        const int c = col0 + bj * 128 + n * 4;
        gg[bj][n] = *(const f32x4*)(g1 + b * 6144 + c);
        const f32x4 gf = *(const f32x4*)(nf + c), sc = *(const f32x4*)(sc2 + b * 6144 + c);
        gs[bj][n] = gf * (sc + 1.f);
      }
#pragma unroll
    for (int ai = 0; ai < 2; ++ai)
#pragma unroll
      for (int m = 0; m < 4; ++m) {
        const int t = row0 + ai * 128 + m * 16;
        float sq = 0.f;
#pragma unroll
        for (int bj = 0; bj < 2; ++bj) {
          const int c = col0 + bj * 128;
          f32x4 x0, x1;
          if (first) { x0 = *(const f32x4*)(xin + (size_t)t * 1024 + c); x1 = *(const f32x4*)(xin + (size_t)t * 1024 + c + 4); }
          else {
            const pg8::u32x4 xr = *(const pg8::u32x4*)(X + (size_t)t * 1024 + c);
            x0 = (f32x4){__uint_as_float(xr.x << 16), __uint_as_float(xr.x & 0xffff0000u), __uint_as_float(xr.y << 16), __uint_as_float(xr.y & 0xffff0000u)};
            x1 = (f32x4){__uint_as_float(xr.z << 16), __uint_as_float(xr.z & 0xffff0000u), __uint_as_float(xr.w << 16), __uint_as_float(xr.w & 0xffff0000u)};
          }
          const f32x4 n0 = x0 + gg[bj][0] * acc[ai][bj][m][0], n1 = x1 + gg[bj][1] * acc[ai][bj][m][1];
          pg8::u32x4 xo; xo.x = pg8::cvt_pk_bf16(n0.x, n0.y); xo.y = pg8::cvt_pk_bf16(n0.z, n0.w); xo.z = pg8::cvt_pk_bf16(n1.x, n1.y); xo.w = pg8::cvt_pk_bf16(n1.z, n1.w);
          *(pg8::u32x4*)(X + (size_t)t * 1024 + c) = xo;
          const f32x4 s0 = n0 * gs[bj][0], s1 = n1 * gs[bj][1];
          pg8::u32x4 go; go.x = pg8::cvt_pk_bf16(s0.x, s0.y); go.y = pg8::cvt_pk_bf16(s0.z, s0.w); go.z = pg8::cvt_pk_bf16(s1.x, s1.y); go.w = pg8::cvt_pk_bf16(s1.z, s1.w);
          *(pg8::u32x4*)(XG + (size_t)t * 1024 + c) = go;
          sq += ((n0.x * n0.x + n0.y * n0.y) + (n0.z * n0.z + n0.w * n0.w)) + ((n1.x * n1.x + n1.y * n1.y) + (n1.z * n1.z + n1.w * n1.w));
        }
        sq += __shfl_xor(sq, 16); sq += __shfl_xor(sq, 32);
        if (fq == 0) SSQ[(size_t)t * 16 + u.pn * 4 + wc] = sq;
      }
  }
};
struct EpiQ {
  static constexpr bool PERM = true, AFTER_DRAIN = false;
  bf16_t* SC8; const float* SSQ; const float* C2;
  __device__ __forceinline__ void operator()(const f32x4 (&acc)[2][2][4][2], const pg8::Unit& u, int wr, int wc, int fr, int fq) const {
    const int row0 = u.pm * 256 + wr * 64 + fr, col0 = u.pn * 256 + wc * 32 + 8 * fq, b = (u.pm * 256) >> 13;
    f32x4 cc[2][2];
#pragma unroll
    for (int bj = 0; bj < 2; ++bj) { cc[bj][0] = *(const f32x4*)(C2 + b * 2048 + col0 + bj * 128); cc[bj][1] = *(const f32x4*)(C2 + b * 2048 + col0 + bj * 128 + 4); }
#pragma unroll
    for (int ai = 0; ai < 2; ++ai)
#pragma unroll
      for (int m = 0; m < 4; ++m) {
        const int t = row0 + ai * 128 + m * 16;
        const float rstd = rsqrtf(ssq_total(SSQ, t) * (1.f / 1024.f) + EPS_);
#pragma unroll
        for (int bj = 0; bj < 2; ++bj) {
          const f32x4 v0 = acc[ai][bj][m][0] * rstd + cc[bj][0], v1 = acc[ai][bj][m][1] * rstd + cc[bj][1];
          pg8::u32x4 w; w.x = pg8::cvt_pk_bf16(v0[0], v0[1]); w.y = pg8::cvt_pk_bf16(v0[2], v0[3]); w.z = pg8::cvt_pk_bf16(v1[0], v1[1]); w.w = pg8::cvt_pk_bf16(v1[2], v1[3]);
          *(pg8::u32x4*)(SC8 + ((size_t)((col0 + bj * 128) >> 3) * T_ + t) * 8) = w;
        }
      }
  }
};

__device__ void gemm_proj_phase(const Params& p, int l, unsigned char* smem) {
  const CParamsP pp = launder_kargs();
  GAS unsigned char* const ws = launder_ptr(pp->ws);
  pg8::Gemm g; g.A = (const bf16_t*)(ws + WS_ABUF); g.Bt = (const bf16_t*)(ws + WS_WIN) + (size_t)l * INCP * 1024; g.M = T_; g.N = INCP; g.K = 1024;
  pg8::StaticOrder S; S.init(T_, INCP, gridDim.x, blockIdx.x);
  EpiProj E; E.PROJ = (bf16_t*)(ws + WS_PROJ); E.VTA = (bf16_t*)(ws + WS_VTA); E.VTR = (bf16_t*)(ws + WS_VTR);
  pg8::gemm_phase<EpiProj, pg8::StaticOrder>((PG8_LAS unsigned char*)smem, g, S, E);
}
__device__ void gemm_out_phase(const Params& p, int l, unsigned char* smem) {
  const CParamsP pp = launder_kargs();
  GAS unsigned char* const ws = launder_ptr(pp->ws);
  pg8::Gemm g; g.A = (const bf16_t*)(ws + WS_ABUF); g.Bt = (const bf16_t*)(ws + WS_WOUT) + (size_t)l * 1024 * 1024; g.M = T_; g.N = 1024; g.K = 1024;
  pg8::StaticOrder S; S.init(T_, 1024, gridDim.x, blockIdx.x);
  EpiOut E; E.xin = gin(pp->in[I_X]); E.first = (l == 0) ? 1 : 0; E.X = (bf16_t*)(ws + WS_X); E.g1 = (const float*)(ws + WS_MOD) + (size_t)l * 2 * 6144 + 2048;
  E.nf = gin(pp->in[I_NFFN]) + (size_t)l * 1024; E.sc2 = (const float*)(ws + WS_MOD) + (size_t)l * 2 * 6144 + 4096; E.XG = (bf16_t*)(ws + WS_XG); E.SSQ = (float*)(ws + WS_SSQ);
  pg8::gemm_phase<EpiOut, pg8::StaticOrder>((PG8_LAS unsigned char*)smem, g, S, E);
}
__device__ void gemm_q_phase(const Params& p, int l, unsigned char* smem) {
  const CParamsP pp = launder_kargs();
  GAS unsigned char* const ws = launder_ptr(pp->ws);
  pg8::Gemm g; g.A = (const bf16_t*)(ws + WS_XG); g.Bt = (const bf16_t*)(ws + WS_WQ) + (size_t)l * 2048 * 1024; g.M = T_; g.N = 2048; g.K = 1024;
  pg8::StaticOrder S; S.init(T_, 2048, gridDim.x, blockIdx.x);
  EpiQ E; E.SC8 = (bf16_t*)(ws + WS_SC); E.SSQ = (const float*)(ws + WS_SSQ); E.C2 = (const float*)(ws + WS_C2) + (size_t)l * 2 * 2048;
  pg8::gemm_phase<EpiQ, pg8::StaticOrder>((PG8_LAS unsigned char*)smem, g, S, E);
}

__device__ __forceinline__ int attn_fk(int r) { return ((r >> 3) & 3) | (((r >> 1) & 1) << 2); }
__device__ __forceinline__ int attn_fv(int r) { return (r >> 1) & 7; }
__device__ void attn_phase(const Params& p, int l, unsigned char* smem) {
  const CParamsP pp = launder_kargs();
  GAS unsigned char* const ws = launder_ptr(pp->ws); const int tidx = launder_tid();
  const bf16_t* PROJ = (const bf16_t*)(ws + WS_PROJ); const bf16_t* VTA = (const bf16_t*)(ws + WS_VTA);
  bf16_t* ATT = (bf16_t*)(ws + WS_ATT);
  const int lane = tidx & 63, wid = tidx >> 6, fr = lane & 15, fq = lane >> 4;
  float* ext = (float*)smem;
  unsigned char* stg = smem + 15360;
  constexpr float LOG2E = 1.4426950408889634f;
  __syncthreads();
  for (int idx = tidx; idx < 6 * 640; idx += NT) {
    const int h = idx / 640, e = idx - h * 640; int d = e - 63; d = d > 256 ? 256 : d;
    ext[idx] = gin(pp->in[I_RELB])[((size_t)l * 6 + h) * 513 + d + 256] * LOG2E;
  }
  const int hh = wid >> 2, qb = wid & 3, iq = qb * 16 + fr;
  const int srow = tidx >> 3, sch = tidx & 7;
  for (int it_ = blockIdx.x; it_ < 256; it_ += gridDim.x) {
    const int item = ((it_ & 7) << 5) | (it_ >> 3);
    const int b = item >> 7, n = item & 127, t0 = b * 8192 + n * 64;
    const int jc0 = n >= 8 ? 0 : 8 - n, nch = 9 - jc0, nst = 3 * nch;
    uint4 sa0, sa1, sa2, sa3, sb0, sb1, sb2, sb3;
#define ATTN_LOAD(S, st) do { const int _rd = (st) / nch, _jc = jc0 + (st) - _rd * nch, _m = n - 8 + _jc; \
      S##0 = *(const uint4*)(PROJ + (size_t)(b * 8192 + _m * 64 + srow) * INCP + C_KA + (2 * _rd) * 64 + sch * 8); \
      S##1 = *(const uint4*)(PROJ + (size_t)(b * 8192 + _m * 64 + srow) * INCP + C_KA + (2 * _rd + 1) * 64 + sch * 8); \
      S##2 = *(const uint4*)(VTA + ((size_t)b * 384 + (2 * _rd) * 64 + srow) * 8192 + _m * 64 + sch * 8); \
      S##3 = *(const uint4*)(VTA + ((size_t)b * 384 + (2 * _rd + 1) * 64 + srow) * 8192 + _m * 64 + sch * 8); } while (0)
#define ATTN_WRITE(S, buf) do { unsigned char* _bp = stg + (buf) * 32768; \
      *(uint4*)(_bp + srow * 128 + ((sch ^ attn_fk(srow)) << 4)) = S##0; \
      *(uint4*)(_bp + 8192 + srow * 128 + ((sch ^ attn_fk(srow)) << 4)) = S##1; \
      *(uint4*)(_bp + 16384 + srow * 128 + ((sch ^ attn_fv(srow)) << 4)) = S##2; \
      *(uint4*)(_bp + 24576 + srow * 128 + ((sch ^ attn_fv(srow)) << 4)) = S##3; } while (0)
    __syncthreads();
    ATTN_LOAD(sa, 0);
    ATTN_WRITE(sa, 0);
    if (1 < nst) ATTN_LOAD(sb, 1);
    __syncthreads();
    bf16x8 qf[2];
    f32x4 o[4];
    float mrun = -1e30f, lrun = 0.f;
    const float* exth = ext;
    auto attn_compute = [&](const int st) {
      const int rd = st / nch, jc = jc0 + st - rd * nch, h = 2 * rd + hh;
      if (jc == jc0) {
#pragma unroll
        for (int ds = 0; ds < 2; ++ds) qf[ds] = *(const bf16x8*)(PROJ + (size_t)(t0 + iq) * INCP + C_QA + h * 64 + ds * 32 + fq * 8);
#pragma unroll
        for (int et = 0; et < 4; ++et) o[et] = (f32x4){0.f, 0.f, 0.f, 0.f};
        mrun = -1e30f; lrun = 0.f;
        exth = ext + h * 640 + 63 + 512 + iq - 8 * fq;
      }
      const unsigned char* kb = stg + (st & 1) * 32768 + hh * 8192;
      const unsigned char* vb = stg + (st & 1) * 32768 + (2 + hh) * 8192;
      float sc[2][2][4];
      bf16x8 kfr[2][2][2], vfr[2][4]; float bia[2][2][4];
#pragma unroll
      for (int g = 0; g < 2; ++g)
#pragma unroll
        for (int tt = 0; tt < 2; ++tt) {
          const int key = 32 * g + 8 * (fr >> 2) + (fr & 3) + 4 * tt, fk = attn_fk(key);
          kfr[g][tt][0] = *(const bf16x8*)(kb + key * 128 + ((fq ^ fk) << 4));
          kfr[g][tt][1] = *(const bf16x8*)(kb + key * 128 + (((4 + fq) ^ fk) << 4));
        }
#pragma unroll
      for (int g = 0; g < 2; ++g)
#pragma unroll
        for (int tt = 0; tt < 2; ++tt)
#pragma unroll
          for (int j = 0; j < 4; ++j) bia[g][tt][j] = exth[-(64 * jc + 32 * g + 4 * tt + j)];
#pragma unroll
      for (int g = 0; g < 2; ++g)
#pragma unroll
        for (int et = 0; et < 4; ++et) { const int er = 16 * et + fr; vfr[g][et] = *(const bf16x8*)(vb + er * 128 + (((4 * g + fq) ^ attn_fv(er)) << 4)); }
      __builtin_amdgcn_sched_barrier(0);
#pragma unroll
      for (int g = 0; g < 2; ++g)
#pragma unroll
        for (int tt = 0; tt < 2; ++tt) {
          f32x4 s4 = __builtin_amdgcn_mfma_f32_16x16x32_bf16(kfr[g][tt][0], qf[0], (f32x4){0.f, 0.f, 0.f, 0.f}, 0, 0, 0);
          s4 = __builtin_amdgcn_mfma_f32_16x16x32_bf16(kfr[g][tt][1], qf[1], s4, 0, 0, 0);
#pragma unroll
          for (int j = 0; j < 4; ++j) sc[g][tt][j] = s4[j] * (0.125f * LOG2E) + bia[g][tt][j];
        }
      float mloc = -1e30f;
#pragma unroll
      for (int g = 0; g < 2; ++g)
#pragma unroll
        for (int tt = 0; tt < 2; ++tt)
#pragma unroll
          for (int j = 0; j < 4; ++j) mloc = fmaxf(mloc, sc[g][tt][j]);
      mloc = fmaxf(mloc, __shfl_xor(mloc, 16)); mloc = fmaxf(mloc, __shfl_xor(mloc, 32));
      const float mnew = fmaxf(mrun, mloc), alpha = __builtin_amdgcn_exp2f(mrun - mnew);
      mrun = mnew;
      float ls = 0.f;
#pragma unroll
      for (int g = 0; g < 2; ++g)
#pragma unroll
        for (int tt = 0; tt < 2; ++tt)
#pragma unroll
          for (int j = 0; j < 4; ++j) { const float e = __builtin_amdgcn_exp2f(sc[g][tt][j] - mnew); sc[g][tt][j] = e; ls += e; }
      lrun = lrun * alpha + ls;
#pragma unroll
      for (int et = 0; et < 4; ++et) { o[et].x *= alpha; o[et].y *= alpha; o[et].z *= alpha; o[et].w *= alpha; }
#pragma unroll
      for (int g = 0; g < 2; ++g) {
        union { bf16x8 v; unsigned u[4]; } pf;
        pf.u[0] = pk2(sc[g][0][0], sc[g][0][1]); pf.u[1] = pk2(sc[g][0][2], sc[g][0][3]);
        pf.u[2] = pk2(sc[g][1][0], sc[g][1][1]); pf.u[3] = pk2(sc[g][1][2], sc[g][1][3]);
#pragma unroll
        for (int et = 0; et < 4; ++et) o[et] = __builtin_amdgcn_mfma_f32_16x16x32_bf16(vfr[g][et], pf.v, o[et], 0, 0, 0);
      }
      if (jc == 8) {
        float lt = lrun + __shfl_xor(lrun, 16); lt += __shfl_xor(lt, 32);
        const float inv = 1.f / lt;
#pragma unroll
        for (int et = 0; et < 4; ++et) {
          f32x4 v = o[et]; v.x *= inv; v.y *= inv; v.z *= inv; v.w *= inv;
          { uint2 ov; ov.x = pk2(v.x, v.y); ov.y = pk2(v.z, v.w); *(uint2*)(ATT + (size_t)(t0 + iq) * 384 + h * 64 + et * 16 + fq * 4) = ov; }
        }
      }
    };
#pragma unroll 1
    for (int st0 = 0; st0 < nst; st0 += 2) {
      { const int st = st0;
        if (st + 2 < nst) ATTN_LOAD(sa, st + 2);
        attn_compute(st);
        if (st + 1 < nst) ATTN_WRITE(sb, (st + 1) & 1);
        __syncthreads(); }
      if (st0 + 1 < nst) { const int st = st0 + 1;
        if (st + 2 < nst) ATTN_LOAD(sb, st + 2);
        attn_compute(st);
        if (st + 1 < nst) ATTN_WRITE(sa, (st + 1) & 1);
        __syncthreads(); }
    }
#undef ATTN_LOAD
#undef ATTN_WRITE
  }
  __syncthreads();
}

__device__ __forceinline__ void ssm_bu32(const bf16_t* __restrict__ bbh_g, const bf16_t* __restrict__ urow, int lane,
                                         f32x16& lo_re, f32x16& hi_re, f32x16& lo_im, f32x16& hi_im) {
  const int hf = lane >> 5;
  const bf16x8 ub = *(const bf16x8*)(urow + 8 * hf);
  f32x16 z;
#pragma unroll
  for (int r = 0; r < 16; ++r) z[r] = 0.f;
  const bf16x8 a0r = *(const bf16x8*)(bbh_g + (size_t)(0 * 64 + lane) * 8), a1r = *(const bf16x8*)(bbh_g + (size_t)(1 * 64 + lane) * 8);
  const bf16x8 a0i = *(const bf16x8*)(bbh_g + (size_t)(2 * 64 + lane) * 8), a1i = *(const bf16x8*)(bbh_g + (size_t)(3 * 64 + lane) * 8);
  lo_re = __builtin_amdgcn_mfma_f32_32x32x16_bf16(ub, a0r, z, 0, 0, 0); hi_re = __builtin_amdgcn_mfma_f32_32x32x16_bf16(ub, a1r, z, 0, 0, 0);
  lo_im = __builtin_amdgcn_mfma_f32_32x32x16_bf16(ub, a0i, z, 0, 0, 0); hi_im = __builtin_amdgcn_mfma_f32_32x32x16_bf16(ub, a1i, z, 0, 0, 0);
#pragma unroll
  for (int r = 0; r < 16; ++r) {
    const auto s1 = __builtin_amdgcn_permlane32_swap(__float_as_uint(lo_re[r]), __float_as_uint(hi_re[r]), false, false);
    lo_re[r] = __uint_as_float(s1[0]); hi_re[r] = __uint_as_float(s1[1]);
    const auto s2 = __builtin_amdgcn_permlane32_swap(__float_as_uint(lo_im[r]), __float_as_uint(hi_im[r]), false, false);
    lo_im[r] = __uint_as_float(s2[0]); hi_im[r] = __uint_as_float(s2[1]);
  }
}
__device__ __forceinline__ void rotary_frag(const bf16x8 x0, const bf16x8 x1, const float* RC, const float* RS, int pos, int fq, float scale, bf16x8& o0, bf16x8& o1) {
  const f32x4 c0 = *(const f32x4*)(RC + pos * 32 + 8 * fq), c1 = *(const f32x4*)(RC + pos * 32 + 8 * fq + 4);
  const f32x4 s0 = *(const f32x4*)(RS + pos * 32 + 8 * fq), s1 = *(const f32x4*)(RS + pos * 32 + 8 * fq + 4);
  const float cc[8] = {c0.x, c0.y, c0.z, c0.w, c1.x, c1.y, c1.z, c1.w}, sn[8] = {s0.x, s0.y, s0.z, s0.w, s1.x, s1.y, s1.z, s1.w};
  union { bf16x8 v; unsigned u[4]; } r0, r1;
#pragma unroll
  for (int q = 0; q < 4; ++q) {
    const float a0 = bf2f((bf16_t)x0[2 * q]) * scale, a1 = bf2f((bf16_t)x0[2 * q + 1]) * scale, b0 = bf2f((bf16_t)x1[2 * q]) * scale, b1 = bf2f((bf16_t)x1[2 * q + 1]) * scale;
    r0.u[q] = pk2(a0 * cc[2 * q] - b0 * sn[2 * q], a1 * cc[2 * q + 1] - b1 * sn[2 * q + 1]);
    r1.u[q] = pk2(a0 * sn[2 * q] + b0 * cc[2 * q], a1 * sn[2 * q + 1] + b1 * cc[2 * q + 1]);
  }
  o0 = r0.v; o1 = r1.v;
}
__device__ void mix_local_phase(const Params& p, int l, unsigned char* smem) {
  const CParamsP pp = launder_kargs();
  GAS unsigned char* const ws = launder_ptr(pp->ws); const int tidx = launder_tid();
  const bf16_t* PROJ = (const bf16_t*)(ws + WS_PROJ); const bf16_t* VTR = (const bf16_t*)(ws + WS_VTR);
  const float* RC = (const float*)(ws + WS_ROTC); const float* RS = (const float*)(ws + WS_ROTS);
  bf16_t* YINT = (bf16_t*)(ws + WS_YINT); float* UPDT = (float*)(ws + WS_UPD);
  const float* SA = (const float*)(ws + WS_SA) + (size_t)l * 16 * 64 * 2; const bf16_t* BBH = (const bf16_t*)(ws + WS_BBH) + (size_t)l * 16 * 2 * 64 * 16;
  float* SEND = (float*)(ws + WS_SEND);
  const int tid = tidx, lane = tid & 63, wid = tid >> 6, fr = lane & 15, fq = lane >> 4;
  bf16_t* KT = (bf16_t*)smem;
  float* rcL = (float*)(smem + 55296); float* rsL = rcL + 2048;
  for (int it_ = blockIdx.x; it_ < 256; it_ += gridDim.x) {
    const int item = ((it_ & 7) << 5) | (it_ >> 3);
    const int b = item >> 7, n = item & 127, t0 = b * 8192 + n * 64;
    __syncthreads();
#pragma unroll
    for (int i = 0; i < 4; ++i) { rcL[tid + NT * i] = RC[n * 2048 + tid + NT * i]; rsL[tid + NT * i] = RS[n * 2048 + tid + NT * i]; }
    __syncthreads();
#pragma unroll 1
    for (int k3 = 0; k3 < 3; ++k3) {
      const int task = wid * 3 + k3, h = task >> 2, tb = task & 3;
      const int i = 16 * tb + fr;
      const float lg2 = log2f(1.f - exp2f(-5.f - (float)h));
      bf16x8 qraw[2], kraw[2][2][2], vraw[2][4];
      {
        const bf16_t* qp = PROJ + (size_t)(t0 + i) * INCP + C_QR + h * 64 + 8 * fq;
        qraw[0] = *(const bf16x8*)qp; qraw[1] = *(const bf16x8*)(qp + 32);
#pragma unroll
        for (int g = 0; g < 2; ++g) {
#pragma unroll
          for (int tt = 0; tt < 2; ++tt) {
            const int key = 32 * g + 8 * (fr >> 2) + (fr & 3) + 4 * tt;
            const bf16_t* kp = PROJ + (size_t)(t0 + key) * INCP + C_KR + h * 64 + 8 * fq;
            kraw[g][tt][0] = *(const bf16x8*)kp; kraw[g][tt][1] = *(const bf16x8*)(kp + 32);
          }
#pragma unroll
          for (int et = 0; et < 4; ++et) vraw[g][et] = *(const bf16x8*)(VTR + ((size_t)b * 384 + h * 64 + et * 16 + fr) * 8192 + n * 64 + 32 * g + 8 * fq);
        }
      }
      __builtin_amdgcn_sched_barrier(0);
      bf16x8 qf0, qf1;
      rotary_frag(qraw[0], qraw[1], rcL, rsL, i, fq, 1.f, qf0, qf1);
      f32x4 o[4];
#pragma unroll
      for (int et = 0; et < 4; ++et) o[et] = (f32x4){0.f, 0.f, 0.f, 0.f};
#pragma unroll
      for (int g = 0; g < 2; ++g) {
        float st[2][4];
#pragma unroll
        for (int tt = 0; tt < 2; ++tt) {
          const int key = 32 * g + 8 * (fr >> 2) + (fr & 3) + 4 * tt;
          bf16x8 kf0, kf1;
          rotary_frag(kraw[g][tt][0], kraw[g][tt][1], rcL, rsL, key, fq, 0.125f, kf0, kf1);
          f32x4 s4 = __builtin_amdgcn_mfma_f32_16x16x32_bf16(kf0, qf0, (f32x4){0.f, 0.f, 0.f, 0.f}, 0, 0, 0);
          s4 = __builtin_amdgcn_mfma_f32_16x16x32_bf16(kf1, qf1, s4, 0, 0, 0);
#pragma unroll
          for (int j = 0; j < 4; ++j) {
            const int kk = 32 * g + 8 * fq + 4 * tt + j;
            const int dij = i > kk ? i - kk : kk - i;
            st[tt][j] = s4[j] * exp2f(lg2 * (float)dij);
          }
          if (tb == 0) {
            const float kd = exp2f(lg2 * (float)(63 - key));
#pragma unroll
            for (int jj = 0; jj < 8; ++jj) {
              KT[(h * 64 + 8 * fq + jj) * 72 + key] = f2bf(bf2f((bf16_t)kf0[jj]) * kd);
              KT[(h * 64 + 32 + 8 * fq + jj) * 72 + key] = f2bf(bf2f((bf16_t)kf1[jj]) * kd);
            }
          }
        }
        union { bf16x8 v; unsigned u[4]; } pf;
        pf.u[0] = pk2(st[0][0], st[0][1]); pf.u[1] = pk2(st[0][2], st[0][3]); pf.u[2] = pk2(st[1][0], st[1][1]); pf.u[3] = pk2(st[1][2], st[1][3]);
#pragma unroll
        for (int et = 0; et < 4; ++et) o[et] = __builtin_amdgcn_mfma_f32_16x16x32_bf16(vraw[g][et], pf.v, o[et], 0, 0, 0);
      }
#pragma unroll
      for (int et = 0; et < 4; ++et) { uint2 ov; ov.x = pk2(o[et].x, o[et].y); ov.y = pk2(o[et].z, o[et].w); *(uint2*)(YINT + (((((size_t)item * 6 + h) * 4 + tb) * 4 + et) * 64 + lane) * 4) = ov; }
    }
    __syncthreads();
#pragma unroll 1
    for (int k3 = 0; k3 < 3; ++k3) {
      const int task = wid * 3 + k3, h = task >> 2, et = task & 3;
      f32x4 acc[4];
#pragma unroll
      for (int dt = 0; dt < 4; ++dt) acc[dt] = (f32x4){0.f, 0.f, 0.f, 0.f};
#pragma unroll
      for (int g = 0; g < 2; ++g) {
        const bf16x8 vf = *(const bf16x8*)(VTR + ((size_t)b * 384 + h * 64 + et * 16 + fr) * 8192 + n * 64 + 32 * g + 8 * fq);
#pragma unroll
        for (int dt = 0; dt < 4; ++dt) {
          const bf16x8 kt = *(const bf16x8*)(KT + (h * 64 + 16 * dt + fr) * 72 + 32 * g + 8 * fq);
          acc[dt] = __builtin_amdgcn_mfma_f32_16x16x32_bf16(kt, vf, acc[dt], 0, 0, 0);
        }
      }
#pragma unroll
      for (int dt = 0; dt < 4; ++dt) *(f32x4*)(UPDT + (((size_t)item * 6 + h) * 64 + 16 * et + fr) * 64 + 16 * dt + 4 * fq) = acc[dt];
    }
#pragma unroll 1
    for (int gi = 0; gi < 2; ++gi) {
      const int g = wid * 2 + gi;
      const float are = SA[(g * 64 + lane) * 2], aim = SA[(g * 64 + lane) * 2 + 1];
      float xr = 0.f, xi = 0.f;
#pragma unroll 1
      for (int blk = 0; blk < 2; ++blk) {
        f32x16 lr, hr, li, hi;
        ssm_bu32(BBH + (size_t)g * 2 * 64 * 16, PROJ + (size_t)(t0 + 32 * blk + (lane & 31)) * INCP + C_US + g * 16, lane, lr, hr, li, hi);
#pragma unroll
        for (int a4 = 0; a4 < 4; ++a4) {
#pragma unroll
          for (int bq = 0; bq < 4; ++bq) { const float nr = are * xr - aim * xi + lr[4 * a4 + bq], ni = are * xi + aim * xr + li[4 * a4 + bq]; xr = nr; xi = ni; }
#pragma unroll
          for (int bq = 0; bq < 4; ++bq) { const float nr = are * xr - aim * xi + hr[4 * a4 + bq], ni = are * xi + aim * xr + hi[4 * a4 + bq]; xr = nr; xi = ni; }
        }
      }
      SEND[(((size_t)item * 16 + g) * 64 + lane) * 2] = xr; SEND[(((size_t)item * 16 + g) * 64 + lane) * 2 + 1] = xi;
    }
  }
}

__device__ void scan_phase(const Params& p, int l) {
  const CParamsP pp = launder_kargs();
  GAS unsigned char* const ws = launder_ptr(pp->ws); const int tidx = launder_tid();
  const float* __restrict__ UPDT = (const float*)(ws + WS_UPD); bf16_t* __restrict__ SPT = (bf16_t*)(ws + WS_SPT);
  const float* __restrict__ SEND = (const float*)(ws + WS_SEND); float* __restrict__ CARRY = (float*)(ws + WS_CARRY);
  const float* SA = (const float*)(ws + WS_SA) + (size_t)l * 16 * 64 * 2;
  const int gtid = blockIdx.x * NT + tidx, gn = gridDim.x * NT;
  for (int idx = gtid; idx < 2 * 6 * 4096 + 2 * 1024; idx += gn) {
    if (idx < 2 * 6 * 4096) {
      const int b = idx / (6 * 4096), r = idx % (6 * 4096), h = r >> 12;
      const float cd = exp2f(64.f * log2f(1.f - exp2f(-5.f - (float)h)));
      const int e_ = (r >> 6) & 63, d_ = r & 63;
      const int spoff = h * 4096 + ((((e_ >> 4) * 2 + (d_ >> 5)) * 64 + ((d_ >> 3) & 3) * 16 + (e_ & 15)) * 8 + (d_ & 7));
      float s = 0.f;
#pragma unroll 1
      for (int nb = 0; nb < NCH; nb += 16) {
        float v[16];
#pragma unroll
        for (int j = 0; j < 16; ++j) v[j] = UPDT[((size_t)(b * NCH + nb + j)) * 6 * 4096 + r];
#pragma unroll
        for (int j = 0; j < 16; ++j) { SPT[((size_t)(b * NCH + nb + j)) * 6 * 4096 + spoff] = f2bf(s); s = cd * s + v[j]; }
      }
    } else {
      const int r2 = idx - 2 * 6 * 4096, b = r2 >> 10, gp = r2 & 1023;
      float ar = SA[gp * 2], ai = SA[gp * 2 + 1];
#pragma unroll
      for (int q = 0; q < 6; ++q) { const float nr = ar * ar - ai * ai, ni = 2.f * ar * ai; ar = nr; ai = ni; }
      float xr = 0.f, xi = 0.f;
#pragma unroll 1
      for (int nb = 0; nb < NCH; nb += 16) {
        float2 v[16];
#pragma unroll
        for (int j = 0; j < 16; ++j) v[j] = *(const float2*)(SEND + (((size_t)(b * NCH + nb + j)) * 1024 + gp) * 2);
#pragma unroll
        for (int j = 0; j < 16; ++j) {
          *(float2*)(CARRY + (((size_t)(b * NCH + nb + j)) * 1024 + gp) * 2) = make_float2(xr, xi);
          const float nr = ar * xr - ai * xi + v[j].x, ni = ar * xi + ai * xr + v[j].y;
          xr = nr; xi = ni;
        }
      }
    }
  }
  if (l + 1 < DEPTH_) convert_tables_fp4(pp, ws, l + 1, gtid, gn);
}

__device__ void mix_final_phase(const Params& p, int l, unsigned char* smem) {
  const CParamsP pp = launder_kargs();
  GAS unsigned char* const ws = launder_ptr(pp->ws); const int tidx = launder_tid();
  const bf16_t* PROJ = (const bf16_t*)(ws + WS_PROJ);
  const float* RC = (const float*)(ws + WS_ROTC); const float* RS = (const float*)(ws + WS_ROTS);
  const bf16_t* YINT = (const bf16_t*)(ws + WS_YINT); const bf16_t* SPT = (const bf16_t*)(ws + WS_SPT);
  const bf16_t* ATT = (const bf16_t*)(ws + WS_ATT);
  const float* SA = (const float*)(ws + WS_SA) + (size_t)l * 16 * 64 * 2; const bf16_t* BBH = (const bf16_t*)(ws + WS_BBH) + (size_t)l * 16 * 2 * 64 * 16;
  const float* CARRY = (const float*)(ws + WS_CARRY);
  const bf16_t* CB = (const bf16_t*)(ws + WS_CB) + (size_t)l * 16 * 16 * 128; const bf16_t* WG = (const bf16_t*)(ws + WS_WGLUT) + (size_t)l * 512 * 256;
  const float* dsk = gin(pp->in[I_SSMD]) + (size_t)l * 256;
  const float* mg = gin(pp->in[I_MGAIN]) + (size_t)l * 1024;
  bf16_t* MRG = (bf16_t*)(ws + WS_ABUF);
  const int tid = tidx, lane = tid & 63, wid = tid >> 6, fr = lane & 15, fq = lane >> 4;
  bf16_t* YS = (bf16_t*)smem;
  float* red = (float*)(smem + 33792);
  bf16_t* XB = (bf16_t*)(smem + 36864 + wid * 8448 + 4096);
  float* rcL = (float*)(smem + 104448); float* rsL = rcL + 2048;
  for (int it_ = blockIdx.x; it_ < 256; it_ += gridDim.x) {
    const int item = ((it_ & 7) << 5) | (it_ >> 3);
    const int b = item >> 7, n = item & 127, t0 = b * 8192 + n * 64;
    __syncthreads();
#pragma unroll
    for (int i = 0; i < 4; ++i) { rcL[tid + NT * i] = RC[n * 2048 + tid + NT * i]; rsL[tid + NT * i] = RS[n * 2048 + tid + NT * i]; }
    __syncthreads();
    {
      float av[8][6], mgl[6];
#pragma unroll
      for (int ii = 0; ii < 8; ++ii)
#pragma unroll
        for (int j = 0; j < 6; ++j) av[ii][j] = bf2f(ATT[(size_t)(t0 + wid * 8 + ii) * 384 + lane + 64 * j]);
#pragma unroll
      for (int j = 0; j < 6; ++j) mgl[j] = mg[lane + 64 * j];
      __builtin_amdgcn_sched_barrier(0);
#pragma unroll
      for (int ii = 0; ii < 8; ++ii) {
        const int t = t0 + wid * 8 + ii;
        float sq = 0.f;
#pragma unroll
        for (int j = 0; j < 6; ++j) sq += av[ii][j] * av[ii][j];
        const float rstd = rsqrtf(wave_sum(sq) * (1.f / 384.f) + EPS_);
#pragma unroll
        for (int j = 0; j < 6; ++j) MRG[(size_t)t * 1024 + lane + 64 * j] = f2bf(av[ii][j] * rstd * mgl[j]);
      }
    }
#pragma unroll 1
    for (int k3 = 0; k3 < 3; ++k3) {
      const int task = wid * 3 + k3, h = task >> 2, tb = task & 3;
      const int i = 16 * tb + fr, t = t0 + i;
      const float lg2 = log2f(1.f - exp2f(-5.f - (float)h));
      bf16x8 qraw[2], spf[4][2]; f32x4 yiv[4], mgq[4]; uint2 grv[4];
      {
        const bf16_t* qp = PROJ + (size_t)t * INCP + C_QR + h * 64 + 8 * fq;
        qraw[0] = *(const bf16x8*)qp; qraw[1] = *(const bf16x8*)(qp + 32);
#pragma unroll
        for (int et = 0; et < 4; ++et) {
          const bf16_t* sp = SPT + ((size_t)item * 6 + h) * 4096 + (size_t)(et * 2) * 512 + lane * 8;
          spf[et][0] = *(const bf16x8*)sp; spf[et][1] = *(const bf16x8*)(sp + 512);
          { const uint2 yr = *(const uint2*)(YINT + (((((size_t)item * 6 + h) * 4 + tb) * 4 + et) * 64 + lane) * 4); yiv[et] = (f32x4){__uint_as_float(yr.x << 16), __uint_as_float(yr.x & 0xffff0000u), __uint_as_float(yr.y << 16), __uint_as_float(yr.y & 0xffff0000u)}; }
          grv[et] = *(const uint2*)(PROJ + (size_t)t * INCP + C_GR + h * 64 + 16 * et + 4 * fq);
          mgq[et] = *(const f32x4*)(mg + 384 + h * 64 + 16 * et + 4 * fq);
        }
      }
      __builtin_amdgcn_sched_barrier(0);
      bf16x8 qf0, qf1;
      rotary_frag(qraw[0], qraw[1], rcL, rsL, i, fq, 1.f, qf0, qf1);
      f32x4 o[4];
#pragma unroll
      for (int et = 0; et < 4; ++et) {
        o[et] = __builtin_amdgcn_mfma_f32_16x16x32_bf16(spf[et][0], qf0, (f32x4){0.f, 0.f, 0.f, 0.f}, 0, 0, 0);
        o[et] = __builtin_amdgcn_mfma_f32_16x16x32_bf16(spf[et][1], qf1, o[et], 0, 0, 0);
      }
      const float qd = exp2f(lg2 * (float)(i + 1));
      float y[16]; float s1 = 0.f;
#pragma unroll
      for (int et = 0; et < 4; ++et) {
        const f32x4 yi = yiv[et];
        y[4 * et] = yi.x + qd * o[et].x; y[4 * et + 1] = yi.y + qd * o[et].y; y[4 * et + 2] = yi.z + qd * o[et].z; y[4 * et + 3] = yi.w + qd * o[et].w;
        s1 += (y[4 * et] + y[4 * et + 1]) + (y[4 * et + 2] + y[4 * et + 3]);
      }
      s1 += __shfl_xor(s1, 16); s1 += __shfl_xor(s1, 32);
      const float mu = s1 * (1.f / 64.f);
      float s2 = 0.f;
#pragma unroll
      for (int q = 0; q < 16; ++q) { y[q] -= mu; s2 += y[q] * y[q]; }
      s2 += __shfl_xor(s2, 16); s2 += __shfl_xor(s2, 32);
      const float rstd = rsqrtf(s2 * (1.f / 64.f) + EPS_);
#pragma unroll
      for (int et = 0; et < 4; ++et) {
        const int c = h * 64 + 16 * et + 4 * fq;
        const uint2 gr = grv[et];
        const float g0 = __uint_as_float(gr.x << 16), g1 = __uint_as_float(gr.x & 0xffff0000u), g2 = __uint_as_float(gr.y << 16), g3 = __uint_as_float(gr.y & 0xffff0000u);
        const f32x4 mgv = mgq[et];
        uint2 ov;
        ov.x = pk2(y[4 * et] * rstd * (g0 * sigmoid_f(g0)) * mgv.x, y[4 * et + 1] * rstd * (g1 * sigmoid_f(g1)) * mgv.y);
        ov.y = pk2(y[4 * et + 2] * rstd * (g2 * sigmoid_f(g2)) * mgv.z, y[4 * et + 3] * rstd * (g3 * sigmoid_f(g3)) * mgv.w);
        *(uint2*)(MRG + (size_t)t * 1024 + 384 + c) = ov;
      }
    }
#pragma unroll 1
    for (int gi = 0; gi < 2; ++gi) {
      const int g = wid * 2 + gi;
      const float are = SA[(g * 64 + lane) * 2], aim = SA[(g * 64 + lane) * 2 + 1];
      float xr = CARRY[(((size_t)item * 16 + g) * 64 + lane) * 2], xi = CARRY[(((size_t)item * 16 + g) * 64 + lane) * 2 + 1];
      bf16x8 cb[4];
#pragma unroll
      for (int ks = 0; ks < 4; ++ks) cb[ks] = *(const bf16x8*)(CB + (((size_t)g * 4 + ks) * 64 + lane) * 8);
      const float dv = dsk[g * 16 + fr];
#pragma unroll 1
      for (int blk = 0; blk < 2; ++blk) {
        f32x16 lr, hr, li, hi;
        bf16_t uraw[2][4];
#pragma unroll
        for (int half = 0; half < 2; ++half)
#pragma unroll
          for (int j = 0; j < 4; ++j) uraw[half][j] = PROJ[(size_t)(t0 + 32 * blk + 16 * half + 4 * fq + j) * INCP + C_US + g * 16 + fr];
        ssm_bu32(BBH + (size_t)g * 2 * 64 * 16, PROJ + (size_t)(t0 + 32 * blk + (lane & 31)) * INCP + C_US + g * 16, lane, lr, hr, li, hi);
#pragma unroll
        for (int half = 0; half < 2; ++half) {
#pragma unroll
          for (int a2 = 0; a2 < 2; ++a2) {
            const int a4 = 2 * half + a2;
#pragma unroll
            for (int bq = 0; bq < 4; ++bq) {
              const float nr = are * xr - aim * xi + lr[4 * a4 + bq], ni = are * xi + aim * xr + li[4 * a4 + bq]; xr = nr; xi = ni;
              XB[(8 * a2 + bq) * 136 + lane] = f2bf(xr); XB[(8 * a2 + bq) * 136 + 64 + lane] = f2bf(xi);
            }
#pragma unroll
            for (int bq = 0; bq < 4; ++bq) {
              const float nr = are * xr - aim * xi + hr[4 * a4 + bq], ni = are * xi + aim * xr + hi[4 * a4 + bq]; xr = nr; xi = ni;
              XB[(8 * a2 + 4 + bq) * 136 + lane] = f2bf(xr); XB[(8 * a2 + 4 + bq) * 136 + 64 + lane] = f2bf(xi);
            }
          }
          f32x4 acc = (f32x4){0.f, 0.f, 0.f, 0.f};
#pragma unroll
          for (int ks = 0; ks < 4; ++ks) {
            const bf16x8 af = *(const bf16x8*)(XB + fr * 136 + 32 * ks + 8 * fq);
            acc = __builtin_amdgcn_mfma_f32_16x16x32_bf16(af, cb[ks], acc, 0, 0, 0);
          }
#pragma unroll
          for (int j = 0; j < 4; ++j) {
            const int i = 32 * blk + 16 * half + 4 * fq + j;
            const float yv = acc[j] + dv * bf2f(uraw[half][j]);
            YS[i * 264 + g * 16 + fr] = f2bf(gelu_tanh(yv));
          }
        }
      }
    }
    __syncthreads();
    {
      const int n0 = 32 * wid;
      f32x4 a1[4][2], a2[4][2];
#pragma unroll
      for (int mt = 0; mt < 4; ++mt)
#pragma unroll
        for (int nt = 0; nt < 2; ++nt) { a1[mt][nt] = (f32x4){0.f, 0.f, 0.f, 0.f}; a2[mt][nt] = (f32x4){0.f, 0.f, 0.f, 0.f}; }
#pragma unroll 1
      for (int kh = 0; kh < 2; ++kh) {
        bf16x8 w1[4][2], w2[4][2];
#pragma unroll
        for (int k4 = 0; k4 < 4; ++k4)
#pragma unroll
          for (int nt = 0; nt < 2; ++nt) {
            w1[k4][nt] = *(const bf16x8*)(WG + ((((size_t)wid * 8 + 4 * kh + k4) * 2 + 0) * 2 + nt) * 512 + lane * 8);
            w2[k4][nt] = *(const bf16x8*)(WG + ((((size_t)wid * 8 + 4 * kh + k4) * 2 + 1) * 2 + nt) * 512 + lane * 8);
          }
        __builtin_amdgcn_sched_barrier(0);
#pragma unroll
        for (int k4 = 0; k4 < 4; ++k4) {
          const int ks = 4 * kh + k4;
          bf16x8 yb[4];
#pragma unroll
          for (int mt = 0; mt < 4; ++mt) yb[mt] = *(const bf16x8*)(YS + (16 * mt + fr) * 264 + 32 * ks + 8 * fq);
#pragma unroll
          for (int mt = 0; mt < 4; ++mt)
#pragma unroll
            for (int nt = 0; nt < 2; ++nt) {
              a1[mt][nt] = __builtin_amdgcn_mfma_f32_16x16x32_bf16(w1[k4][nt], yb[mt], a1[mt][nt], 0, 0, 0);
              a2[mt][nt] = __builtin_amdgcn_mfma_f32_16x16x32_bf16(w2[k4][nt], yb[mt], a2[mt][nt], 0, 0, 0);
            }
        }
      }
#pragma unroll
      for (int mt = 0; mt < 4; ++mt) {
        float sq = 0.f;
#pragma unroll
        for (int nt = 0; nt < 2; ++nt) {
          f32x4 z = a1[mt][nt]; const f32x4 zg = a2[mt][nt];
          z.x *= sigmoid_f(zg.x); z.y *= sigmoid_f(zg.y); z.z *= sigmoid_f(zg.z); z.w *= sigmoid_f(zg.w);
          a1[mt][nt] = z; sq += z.x * z.x + z.y * z.y + z.z * z.z + z.w * z.w;
        }
        sq += __shfl_xor(sq, 16); sq += __shfl_xor(sq, 32);
        if (fq == 0) red[wid * 64 + 16 * mt + fr] = sq;
      }
      __syncthreads();
#pragma unroll
      for (int mt = 0; mt < 4; ++mt) {
        const int i = 16 * mt + fr, t = t0 + i;
        float tot = 0.f;
#pragma unroll
        for (int w8 = 0; w8 < 8; ++w8) tot += red[w8 * 64 + i];
        const float rstd = rsqrtf(tot * (1.f / 256.f) + EPS_);
#pragma unroll
        for (int nt = 0; nt < 2; ++nt) {
          const int c = n0 + 16 * nt + 4 * fq;
          const f32x4 mgv = *(const f32x4*)(mg + 768 + c); const f32x4 z = a1[mt][nt];
          uint2 ov; ov.x = pk2(z.x * rstd * mgv.x, z.y * rstd * mgv.y); ov.y = pk2(z.z * rstd * mgv.z, z.w * rstd * mgv.w);
          *(uint2*)(MRG + (size_t)t * 1024 + 768 + c) = ov;
        }
      }
    }
  }
}

typedef float f32x2 __attribute__((ext_vector_type(2)));
__device__ __forceinline__ float dot16_fp4(const uint2 u, const f32x2 (&hv)[8]) {
  f32x2 d = __builtin_amdgcn_cvt_scalef32_pk_f32_fp4(u.x, 1.0f, 0) * hv[0];
  d += __builtin_amdgcn_cvt_scalef32_pk_f32_fp4(u.x, 1.0f, 1) * hv[1];
  d += __builtin_amdgcn_cvt_scalef32_pk_f32_fp4(u.x, 1.0f, 2) * hv[2];
  d += __builtin_amdgcn_cvt_scalef32_pk_f32_fp4(u.x, 1.0f, 3) * hv[3];
  d += __builtin_amdgcn_cvt_scalef32_pk_f32_fp4(u.y, 1.0f, 0) * hv[4];
  d += __builtin_amdgcn_cvt_scalef32_pk_f32_fp4(u.y, 1.0f, 1) * hv[5];
  d += __builtin_amdgcn_cvt_scalef32_pk_f32_fp4(u.y, 1.0f, 2) * hv[6];
  d += __builtin_amdgcn_cvt_scalef32_pk_f32_fp4(u.y, 1.0f, 3) * hv[7];
  return d.x + d.y;
}
__device__ __forceinline__ void axpy16_fp4(const uint2 v, const float w, f32x2 (&acc)[8]) {
  const f32x2 w2 = (f32x2){w, w};
  acc[0] += w2 * __builtin_amdgcn_cvt_scalef32_pk_f32_fp4(v.x, 1.0f, 0);
  acc[1] += w2 * __builtin_amdgcn_cvt_scalef32_pk_f32_fp4(v.x, 1.0f, 1);
  acc[2] += w2 * __builtin_amdgcn_cvt_scalef32_pk_f32_fp4(v.x, 1.0f, 2);
  acc[3] += w2 * __builtin_amdgcn_cvt_scalef32_pk_f32_fp4(v.x, 1.0f, 3);
  acc[4] += w2 * __builtin_amdgcn_cvt_scalef32_pk_f32_fp4(v.y, 1.0f, 0);
  acc[5] += w2 * __builtin_amdgcn_cvt_scalef32_pk_f32_fp4(v.y, 1.0f, 1);
  acc[6] += w2 * __builtin_amdgcn_cvt_scalef32_pk_f32_fp4(v.y, 1.0f, 2);
  acc[7] += w2 * __builtin_amdgcn_cvt_scalef32_pk_f32_fp4(v.y, 1.0f, 3);
}
__device__ __forceinline__ float vmaxf(float a, float b) { float r; asm("v_max_f32 %0, %1, %2" : "=v"(r) : "v"(a), "v"(b)); return r; }
__device__ __forceinline__ float vminf(float a, float b) { float r; asm("v_min_f32 %0, %1, %2" : "=v"(r) : "v"(a), "v"(b)); return r; }
__device__ __forceinline__ void cx(float& hi, float& lo) { const float a = hi, b = lo; hi = vmaxf(a, b); lo = vminf(a, b); }
__device__ __forceinline__ void cx2(float& kh, int& ph, float& kl, int& pl) {
  const float a = kh, b = kl; const int pa = ph, pb = pl; const bool c = a >= b;
  kh = vmaxf(a, b); kl = vminf(a, b); ph = c ? pa : pb; pl = c ? pb : pa;
}
__device__ __forceinline__ void bitonic_sort16_desc(float (&v)[16]) {
#pragma unroll
  for (int k = 2; k <= 16; k <<= 1)
#pragma unroll
    for (int j = k >> 1; j > 0; j >>= 1)
#pragma unroll
      for (int i = 0; i < 16; ++i) {
        const int l = i ^ j;
        if (l > i) { if ((i & k) == 0) cx(v[i], v[l]); else cx(v[l], v[i]); }
      }
}
__device__ __forceinline__ void bitonic_merge16_desc(float (&v)[16]) {
#pragma unroll
  for (int j = 8; j > 0; j >>= 1)
#pragma unroll
    for (int i = 0; i < 16; ++i) { const int l = i ^ j; if (l > i) cx(v[i], v[l]); }
}
__device__ __forceinline__ void top16_merge(float (&a)[16], const float (&b)[16]) {
#pragma unroll
  for (int i = 0; i < 16; ++i) a[i] = vmaxf(a[i], b[15 - i]);
  bitonic_merge16_desc(a);
}
template <int M> __device__ __forceinline__ void top16_merge_chain(float (&k)[16], int (&q)[16], const float (&xk)[M], const int (&xq)[M]) {
#pragma unroll
  for (int i = 16 - M; i < 16; ++i) { const float a = k[i], b = xk[15 - i]; const bool c = a >= b; k[i] = vmaxf(a, b); q[i] = c ? q[i] : xq[15 - i]; }
#pragma unroll
  for (int j = 8; j > 0; j >>= 1)
#pragma unroll
    for (int i = 0; i < 16; ++i) { const int l = i ^ j; if (l > i) cx2(k[i], q[i], k[l], q[l]); }
}

__device__ void peer_phase(const Params& p, int l, bool last, unsigned char* smem) {
  const CParamsP pp = launder_kargs();
  GAS unsigned char* const ws = launder_ptr(pp->ws); const int tidx = launder_tid();
  bf16_t* HF = (bf16_t*)(ws + WS_ABUF); bf16_t* X = (bf16_t*)(ws + WS_X);
  const bf16_t* SC8 = (const bf16_t*)(ws + WS_SC);
  const uint2* U4 = (const uint2*)(ws + WS_PU8) + (size_t)l * 16384 * 64; const uint2* V4 = (const uint2*)(ws + WS_PV8) + (size_t)l * 16384 * 64;
  const float* g2 = (const float*)(ws + WS_MOD) + (size_t)l * 2 * 6144 + 5120;
  const bf16_t* XG = (const bf16_t*)(ws + WS_XG); const float* SSQ = (const float*)(ws + WS_SSQ); const float* sh2 = (const float*)(ws + WS_MOD) + (size_t)l * 2 * 6144 + 3072;
  const int ln = last ? l : l + 1;
  const float* nsh = (const float*)(ws + WS_MOD) + (size_t)ln * 2 * 6144; const float* nsc = nsh + 1024;
  const float* ngain = gin(pp->in[I_NMIX]) + (size_t)ln * 1024;
  const int lane = tidx & 63, wid = tidx >> 6;
  const int rL = ((lane >> 5) & 1) * 8 + ((lane >> 4) & 1) * 4 + ((lane >> 3) & 1) * 2 + ((lane >> 2) & 1);
  const bool hi5 = (lane & 32) != 0, hi4 = (lane & 16) != 0, hi3 = (lane & 8) != 0, hi2 = (lane & 4) != 0;
  int* idxL = (int*)smem;
  for (int it_ = blockIdx.x; it_ < T_ / 64; it_ += gridDim.x) {
    const int item = ((it_ & 7) << 5) | (it_ >> 3);
    const int t0 = item * 64;
    __syncthreads();
    {
      int lane_o = lane; asm volatile("" : "+v"(lane_o));
      const int tg = wid & 1, hp = wid >> 1, hf = lane_o >> 5, tl = 32 * tg + (lane_o & 31);
      float F[2][16];
#pragma unroll
      for (int sd = 0; sd < 2; ++sd) {
        float Lh[2][16];
#pragma unroll
        for (int hh = 0; hh < 2; ++hh) {
          const int hs = 2 * (2 * hp + hh) + sd;
          float top[16];
          const bf16_t* scp = SC8 + (((size_t)(hs * 16 + 8 * hf)) * T_ + (t0 + tl)) * 8;
          uint4 sv[8];
#pragma unroll
          for (int kq = 0; kq < 8; ++kq) sv[kq] = *(const uint4*)(scp + (size_t)kq * T_ * 8);
          __builtin_amdgcn_sched_barrier(0);
#pragma unroll
          for (int kt = 0; kt < 4; ++kt) {
            float g[16];
#pragma unroll
            for (int kq = 0; kq < 2; ++kq) {
              const uint4 v8 = sv[2 * kt + kq];
              const unsigned wv[4] = {v8.x, v8.y, v8.z, v8.w};
#pragma unroll
              for (int j = 0; j < 4; ++j) {
                const int key = 64 * hf + 16 * kt + 8 * kq + 2 * j;
                g[8 * kq + 2 * j] = __uint_as_float((wv[j] << 16) | (unsigned)key);
                g[8 * kq + 2 * j + 1] = __uint_as_float((wv[j] & 0xffff0000u) | (unsigned)(key + 1));
              }
            }
            bitonic_sort16_desc(g);
            if (kt == 0) {
#pragma unroll
              for (int r = 0; r < 16; ++r) top[r] = g[r];
            } else top16_merge(top, g);
            __builtin_amdgcn_sched_barrier(0);
          }
#pragma unroll
          for (int r = 0; r < 16; ++r) Lh[hh][r] = top[r];
          __builtin_amdgcn_sched_barrier(0);
        }
#pragma unroll
        for (int r = 0; r < 16; ++r) {
          const auto sw = __builtin_amdgcn_permlane32_swap(__float_as_uint(Lh[0][r]), __float_as_uint(Lh[1][r]), false, false);
          Lh[0][r] = __uint_as_float(sw[0]); Lh[1][r] = __uint_as_float(sw[1]);
        }
        top16_merge(Lh[0], Lh[1]);
#pragma unroll
        for (int r = 0; r < 16; ++r) F[sd][r] = Lh[0][r];
        __builtin_amdgcn_sched_barrier(0);
      }
      int ia[16], ib[16];
#pragma unroll
      for (int r = 0; r < 16; ++r) { ia[r] = (int)(__float_as_uint(F[0][r]) & 127u) << 7; ib[r] = (int)(__float_as_uint(F[1][r]) & 127u); }
      float k[16]; int q[16];
#pragma unroll
      for (int j = 0; j < 16; ++j) { k[j] = F[0][0] + F[1][j]; q[j] = ia[0] | ib[j]; }
      { float xk[8]; int xq[8];
#pragma unroll
        for (int j = 0; j < 8; ++j) { xk[j] = F[0][1] + F[1][j]; xq[j] = ia[1] | ib[j]; }
        top16_merge_chain<8>(k, q, xk, xq); }
      { float xk[5]; int xq[5];
#pragma unroll
        for (int j = 0; j < 5; ++j) { xk[j] = F[0][2] + F[1][j]; xq[j] = ia[2] | ib[j]; }
        top16_merge_chain<5>(k, q, xk, xq); }
      { float xk[4]; int xq[4];
#pragma unroll
        for (int j = 0; j < 4; ++j) { xk[j] = F[0][3] + F[1][j]; xq[j] = ia[3] | ib[j]; }
        top16_merge_chain<4>(k, q, xk, xq); }
      { float xk[3]; int xq[3];
#pragma unroll
        for (int j = 0; j < 3; ++j) { xk[j] = F[0][4] + F[1][j]; xq[j] = ia[4] | ib[j]; }
        top16_merge_chain<3>(k, q, xk, xq); }
      { float xk[11]; int xq[11];
#pragma unroll
        for (int i = 0; i < 11; ++i) { xk[i] = F[0][5 + i] + F[1][0]; xq[i] = ia[5 + i] | ib[0]; }
        top16_merge_chain<11>(k, q, xk, xq); }
      { float xk[3]; int xq[3];
#pragma unroll
        for (int i = 0; i < 3; ++i) { xk[i] = F[0][5 + i] + F[1][1]; xq[i] = ia[5 + i] | ib[1]; }
        top16_merge_chain<3>(k, q, xk, xq); }
      float e[16]; float es = 0.f;
#pragma unroll
      for (int i = 0; i < 16; ++i) { e[i] = __expf(k[i] - k[0]); es += e[i]; }
      const float ies = 1.f / es;
      const int h = 2 * hp + hf;
#pragma unroll
      for (int i = 0; i < 16; ++i) idxL[tl * 132 + h * 16 + i] = (int)(((unsigned)f2bf(e[i] * ies) << 16) | (unsigned)q[i]);
    }
    __syncthreads();
    f32x4 sh2v[4];
#pragma unroll
    for (int qq = 0; qq < 4; ++qq) sh2v[qq] = *(const f32x4*)(sh2 + (t0 >> 13) * 6144 + lane * 16 + 4 * qq);
    const float rs_lane = rsqrtf(ssq_total(SSQ, t0 + wid * 8 + (lane & 7)) * (1.f / 1024.f) + EPS_);
    uint4 nh0 = *(const uint4*)(XG + (size_t)(t0 + wid * 8) * 1024 + lane * 16), nh1 = *(const uint4*)(XG + (size_t)(t0 + wid * 8) * 1024 + lane * 16 + 8);
#pragma unroll 1
    for (int ii = 0; ii < 8; ++ii) {
      const int tl = wid * 8 + ii, t = t0 + tl, b = t >> 13;
      const int fr = lane & 15, fq = lane >> 4;
      uint4 hB1[8], hB2[8];
      {
        const uint4 h0 = nh0, h1 = nh1;
        if (ii < 7) { nh0 = *(const uint4*)(XG + (size_t)(t + 1) * 1024 + lane * 16); nh1 = *(const uint4*)(XG + (size_t)(t + 1) * 1024 + lane * 16 + 8); }
        const unsigned hw[8] = {h0.x, h0.y, h0.z, h0.w, h1.x, h1.y, h1.z, h1.w};
        const float rs = __int_as_float(__builtin_amdgcn_readlane(__float_as_int(rs_lane), ii));
        unsigned q1[2] = {0u, 0u}, q2[2] = {0u, 0u};
#pragma unroll
        for (int qq = 0; qq < 4; ++qq) {
          const f32x4 sh = sh2v[qq];
          float hvv[4];
          hvv[0] = __uint_as_float(hw[2 * qq] << 16) * rs + sh.x; hvv[1] = __uint_as_float(hw[2 * qq] & 0xffff0000u) * rs + sh.y;
          hvv[2] = __uint_as_float(hw[2 * qq + 1] << 16) * rs + sh.z; hvv[3] = __uint_as_float(hw[2 * qq + 1] & 0xffff0000u) * rs + sh.w;
#pragma unroll
          for (int pr = 0; pr < 2; ++pr) {
            const int byte_sel = (2 * qq + pr) & 3, wd = (2 * qq + pr) >> 2;
            const float x0 = fminf(fmaxf(hvv[2 * pr], -6.f), 6.f), x1 = fminf(fmaxf(hvv[2 * pr + 1], -6.f), 6.f);
            unsigned t1 = 0u;
            if (byte_sel == 0) t1 = __builtin_amdgcn_cvt_scalef32_pk_fp4_f32(0u, x0, x1, 1.0f, 0);
            else if (byte_sel == 1) t1 = __builtin_amdgcn_cvt_scalef32_pk_fp4_f32(0u, x0, x1, 1.0f, 1);
            else if (byte_sel == 2) t1 = __builtin_amdgcn_cvt_scalef32_pk_fp4_f32(0u, x0, x1, 1.0f, 2);
            else t1 = __builtin_amdgcn_cvt_scalef32_pk_fp4_f32(0u, x0, x1, 1.0f, 3);
            f32x2 back;
            if (byte_sel == 0) back = __builtin_amdgcn_cvt_scalef32_pk_f32_fp4(t1, 1.0f, 0);
            else if (byte_sel == 1) back = __builtin_amdgcn_cvt_scalef32_pk_f32_fp4(t1, 1.0f, 1);
            else if (byte_sel == 2) back = __builtin_amdgcn_cvt_scalef32_pk_f32_fp4(t1, 1.0f, 2);
            else back = __builtin_amdgcn_cvt_scalef32_pk_f32_fp4(t1, 1.0f, 3);
            const float r0 = fminf(fmaxf((hvv[2 * pr] - back.x) * 8.f, -6.f), 6.f), r1 = fminf(fmaxf((hvv[2 * pr + 1] - back.y) * 8.f, -6.f), 6.f);
            unsigned t2 = 0u;
            if (byte_sel == 0) t2 = __builtin_amdgcn_cvt_scalef32_pk_fp4_f32(0u, r0, r1, 1.0f, 0);
            else if (byte_sel == 1) t2 = __builtin_amdgcn_cvt_scalef32_pk_fp4_f32(0u, r0, r1, 1.0f, 1);
            else if (byte_sel == 2) t2 = __builtin_amdgcn_cvt_scalef32_pk_fp4_f32(0u, r0, r1, 1.0f, 2);
            else t2 = __builtin_amdgcn_cvt_scalef32_pk_fp4_f32(0u, r0, r1, 1.0f, 3);
            q1[wd] |= t1; q2[wd] |= t2;
          }
        }
        unsigned char* hq4 = smem + 33792 + wid * 1024;
        *(uint2*)(hq4 + lane * 8) = make_uint2(q1[0], q1[1]);
        *(uint2*)(hq4 + 512 + lane * 8) = make_uint2(q2[0], q2[1]);
#pragma unroll
        for (int kc = 0; kc < 8; ++kc) { hB1[kc] = *(const uint4*)(hq4 + 64 * kc + 16 * fq); hB2[kc] = *(const uint4*)(hq4 + 512 + 64 * kc + 16 * fq); }
      }
      f32x2 acc2[8];
#pragma unroll
      for (int j = 0; j < 8; ++j) acc2[j] = (f32x2){0.f, 0.f};
#pragma unroll 1
      for (int bt = 0; bt < 8; ++bt) {
        const int myidx = idxL[tl * 132 + 16 * bt + fr] & 0xffff;
        unsigned char* ust = smem + 41984 + wid * 8448;
        uint2 ul[16], vr[16];
#pragma unroll
        for (int r = 0; r < 16; ++r) { const unsigned off = (unsigned)__builtin_amdgcn_readlane(myidx, r) * 512u + (unsigned)lane * 8u; ul[r] = *(const uint2*)((const unsigned char*)U4 + off); }
        __builtin_amdgcn_sched_barrier(0);
#pragma unroll
        for (int r = 0; r < 16; ++r) { const unsigned off = (unsigned)__builtin_amdgcn_readlane(myidx, r) * 512u + (unsigned)lane * 8u; vr[r] = *(const uint2*)((const unsigned char*)V4 + off); }
        __builtin_amdgcn_sched_barrier(0);
#pragma unroll
        for (int r = 0; r < 16; ++r) *(uint2*)(ust + r * 528 + lane * 8) = ul[r];
        uint4 ua[8];
#pragma unroll
        for (int kc = 0; kc < 8; ++kc) ua[kc] = *(const uint4*)(ust + fr * 528 + 64 * kc + 16 * fq);
        f32x4 sa[2] = {(f32x4){0.f, 0.f, 0.f, 0.f}, (f32x4){0.f, 0.f, 0.f, 0.f}}, sb[2] = {(f32x4){0.f, 0.f, 0.f, 0.f}, (f32x4){0.f, 0.f, 0.f, 0.f}};
#pragma unroll
        for (int kc = 0; kc < 8; ++kc) {
          const i32x8 av = (i32x8){(int)ua[kc].x, (int)ua[kc].y, (int)ua[kc].z, (int)ua[kc].w, 0, 0, 0, 0};
          const i32x8 b1 = (i32x8){(int)hB1[kc].x, (int)hB1[kc].y, (int)hB1[kc].z, (int)hB1[kc].w, 0, 0, 0, 0};
          const i32x8 b2 = (i32x8){(int)hB2[kc].x, (int)hB2[kc].y, (int)hB2[kc].z, (int)hB2[kc].w, 0, 0, 0, 0};
          sa[kc & 1] = __builtin_amdgcn_mfma_scale_f32_16x16x128_f8f6f4(av, b1, sa[kc & 1], 4  , 4  , 0, 0x7F7F7F7F, 0, 0x7F7F7F7F);
          sb[kc & 1] = __builtin_amdgcn_mfma_scale_f32_16x16x128_f8f6f4(av, b2, sb[kc & 1], 4, 4, 0, 0x7F7F7F7F, 0, 0x7F7F7F7F);
        }
        f32x4 sc4 = (sa[0] + sa[1]) + (sb[0] + sb[1]) * 0.125f;
        const int jsel = lane & 3;
        const float dsel = jsel == 0 ? sc4[0] : (jsel == 1 ? sc4[1] : (jsel == 2 ? sc4[2] : sc4[3]));
        const float gl = __uint_as_float((unsigned)idxL[tl * 132 + 16 * bt + 4 * fq + jsel] & 0xffff0000u);
        const float w = gl * gelu_tanh_fast(dsel * (1.f / 64.f));
#pragma unroll
        for (int r = 0; r < 16; ++r) {
          const float wr = __int_as_float(__builtin_amdgcn_readlane(__float_as_int(w), 16 * (r >> 2) + (r & 3)));
          axpy16_fp4(vr[r], wr, acc2);
          if ((r & 3) == 3) __builtin_amdgcn_sched_barrier(0);
        }
      }
      float acc[16];
#pragma unroll
      for (int j = 0; j < 8; ++j) { acc[2 * j] = acc2[j].x; acc[2 * j + 1] = acc2[j].y; }
      float xn[16]; float ss = 0.f;
      const uint4 xr0 = *(const uint4*)(X + (size_t)t * 1024 + lane * 16), xr1 = *(const uint4*)(X + (size_t)t * 1024 + lane * 16 + 8);
      const unsigned xw[8] = {xr0.x, xr0.y, xr0.z, xr0.w, xr1.x, xr1.y, xr1.z, xr1.w};
#pragma unroll
      for (int qq = 0; qq < 4; ++qq) {
        const int c = lane * 16 + 4 * qq;
        const f32x4 xv = (f32x4){__uint_as_float(xw[2 * qq] << 16), __uint_as_float(xw[2 * qq] & 0xffff0000u), __uint_as_float(xw[2 * qq + 1] << 16), __uint_as_float(xw[2 * qq + 1] & 0xffff0000u)};
        const f32x4 g = *(const f32x4*)(g2 + b * 6144 + c);
        xn[4 * qq] = xv.x + g.x * acc[4 * qq] * 0.25f; xn[4 * qq + 1] = xv.y + g.y * acc[4 * qq + 1] * 0.25f;
        xn[4 * qq + 2] = xv.z + g.z * acc[4 * qq + 2] * 0.25f; xn[4 * qq + 3] = xv.w + g.w * acc[4 * qq + 3] * 0.25f;
        ss += xn[4 * qq] * xn[4 * qq] + xn[4 * qq + 1] * xn[4 * qq + 1] + xn[4 * qq + 2] * xn[4 * qq + 2] + xn[4 * qq + 3] * xn[4 * qq + 3];
      }
      const float rstd = rsqrtf(wave_sum(ss) * (1.f / 1024.f) + EPS_);
      if (!last) {
        unsigned hb[8], xb[8];
#pragma unroll
        for (int qq = 0; qq < 4; ++qq) {
          const int c = lane * 16 + 4 * qq;
          xb[2 * qq] = pk2(xn[4 * qq], xn[4 * qq + 1]); xb[2 * qq + 1] = pk2(xn[4 * qq + 2], xn[4 * qq + 3]);
          const f32x4 gn = *(const f32x4*)(ngain + c), sh = *(const f32x4*)(nsh + b * 6144 + c), sc = *(const f32x4*)(nsc + b * 6144 + c);
          hb[2 * qq] = pk2(xn[4 * qq] * rstd * gn.x * (1.f + sc.x) + sh.x, xn[4 * qq + 1] * rstd * gn.y * (1.f + sc.y) + sh.y);
          hb[2 * qq + 1] = pk2(xn[4 * qq + 2] * rstd * gn.z * (1.f + sc.z) + sh.z, xn[4 * qq + 3] * rstd * gn.w * (1.f + sc.w) + sh.w);
        }
        *(uint4*)(X + (size_t)t * 1024 + lane * 16) = make_uint4(xb[0], xb[1], xb[2], xb[3]);
        *(uint4*)(X + (size_t)t * 1024 + lane * 16 + 8) = make_uint4(xb[4], xb[5], xb[6], xb[7]);
        *(uint4*)(HF + (size_t)t * 1024 + lane * 16) = make_uint4(hb[0], hb[1], hb[2], hb[3]);
        *(uint4*)(HF + (size_t)t * 1024 + lane * 16 + 8) = make_uint4(hb[4], hb[5], hb[6], hb[7]);
      } else {
#pragma unroll
        for (int qq = 0; qq < 4; ++qq) {
          const int c = lane * 16 + 4 * qq;
          const f32x4 fn = *(const f32x4*)(gin(pp->in[I_FNORM]) + c);
          *(f32x4*)((float*)pp->out + (size_t)t * 1024 + c) = (f32x4){xn[4 * qq] * rstd * fn.x, xn[4 * qq + 1] * rstd * fn.y, xn[4 * qq + 2] * rstd * fn.z, xn[4 * qq + 3] * rstd * fn.w};
        }
      }
    }
  }
}

#define XB_TMO      128
#define XB_XCNT(j)  (256  + 64 * (j))
#define XB_XSUB(j)  (1280 + 64 * (j))
#define XB_XGEN(j)  (2304 + 64 * (j))
#define XB_TOP      3328
#define XB_TOPGEN   3392
#define XCD_BAR_WORDS 3456
#define XB_SPIN_CAP (1u << 20)
#define LAS __attribute__((address_space(3)))
__device__ __forceinline__ unsigned xb_ld(unsigned* q)              { return __hip_atomic_load(q, __ATOMIC_RELAXED, __HIP_MEMORY_SCOPE_AGENT); }
__device__ __forceinline__ unsigned xb_add(unsigned* q, unsigned v) { return __hip_atomic_fetch_add(q, v, __ATOMIC_RELAXED, __HIP_MEMORY_SCOPE_AGENT); }
__device__ __forceinline__ unsigned xb_xcc_id() { return (unsigned)__builtin_amdgcn_s_getreg((3 << 11) | 20) & 0xFu; }
#define XB_SPIN(cond, bar) do { unsigned _sp = 0; while (cond) { __builtin_amdgcn_s_sleep(1); \
    if ((++_sp & 255u) == 0u) { if (xb_ld(&(bar)[XB_TMO])) break; if (_sp > XB_SPIN_CAP) { atomicAdd(&(bar)[XB_TMO], 1u); break; } } } } while (0)
struct XcdBarrier { unsigned* bar; unsigned x; volatile LAS unsigned* st; };
__device__ __forceinline__ XcdBarrier xcd_barrier_post(unsigned* bar, volatile LAS unsigned* st) {
    XcdBarrier b; b.bar = bar; b.x = xb_xcc_id(); b.st = st;
    if (threadIdx.x == 0) (void)xb_add(&bar[XB_XCNT(b.x)], 1u);
    return b;
}
__device__ __forceinline__ void xcd_barrier_complete(unsigned* bar, unsigned x, unsigned& nloc, unsigned& nx) {
    const unsigned G = gridDim.x * gridDim.y * gridDim.z;
    unsigned sum, cnt, mine, sp = 0u;
    for (;;) {
        sum = 0u; cnt = 0u; mine = 0u;
#pragma unroll
        for (unsigned j = 0; j < 16; ++j) { const unsigned c = xb_ld(&bar[XB_XCNT(j)]); sum += c; cnt += (c > 0u) ? 1u : 0u; mine = (j == x) ? c : mine; }
        if (sum == G) break;
        __builtin_amdgcn_s_sleep(1);
        if ((++sp & 255u) == 0u) { if (xb_ld(&bar[XB_TMO])) break; if (sp > XB_SPIN_CAP) { atomicAdd(&bar[XB_TMO], 1u); break; } }
    }
    nloc = mine > 0u ? mine : 1u; nx = cnt > 0u ? cnt : 1u;
}
__device__ __forceinline__ void xcd_barrier(const XcdBarrier& b) {
    asm volatile("s_waitcnt vmcnt(0)" ::: "memory");
    __syncthreads();
    if (threadIdx.x == 0) {
        unsigned* bar = b.bar;
        __builtin_amdgcn_s_waitcnt(0);
        unsigned nloc = b.st[0], nx = b.st[1];
        if (nloc == 0u) { xcd_barrier_complete(bar, b.x, nloc, nx); b.st[0] = nloc; b.st[1] = nx; }
        const unsigned old = xb_add(&bar[XB_XSUB(b.x)], 1u);
        const unsigned gen = old / nloc;
        if (old + 1u == (gen + 1u) * nloc) {
            __builtin_amdgcn_fence(__ATOMIC_RELEASE, "agent");
            asm volatile("s_waitcnt vmcnt(0)" ::: "memory");
            const unsigned og = xb_add(&bar[XB_TOP], 1u);
            const unsigned tg = og / nx;
            if (og + 1u == (tg + 1u) * nx) xb_add(&bar[XB_TOPGEN], 1u);
            else XB_SPIN(xb_ld(&bar[XB_TOPGEN]) == tg, bar);
            __builtin_amdgcn_fence(__ATOMIC_ACQUIRE, "agent");
            xb_add(&bar[XB_XGEN(b.x)], 1u);
            asm volatile("s_waitcnt vmcnt(0)" ::: "memory");
        } else {
            XB_SPIN(xb_ld(&bar[XB_XGEN(b.x)]) == gen, bar);
            __builtin_amdgcn_fence(__ATOMIC_ACQUIRE, "agent");
            asm volatile("s_waitcnt vmcnt(0)" ::: "memory");
        }
    }
    __syncthreads();
}

__global__ void __launch_bounds__(NT) fwd_megakernel(Params p) {
  extern __shared__ __attribute__((aligned(16))) unsigned char smem[];
  const CParamsP pp = launder_kargs();
  cg::grid_group grid = cg::this_grid();
  volatile LAS unsigned* xbst = (volatile LAS unsigned*)(smem + LDS_BYTES - 16);
  if (threadIdx.x == 0) { xbst[0] = 0u; xbst[1] = 0u; }
  if (blockIdx.x == 0) { unsigned* bw = (unsigned*)(pp->ws + WS_BAR); for (int i = threadIdx.x; i < XCD_BAR_WORDS; i += NT) bw[i] = 0u; }
  setup_phase(p, smem);
  grid.sync();
  const XcdBarrier xb = xcd_barrier_post((unsigned*)(pp->ws + WS_BAR), xbst);
  const float* MOD = (const float*)(pp->ws + WS_MOD);
  for (int l = 0; l < DEPTH_; ++l) {
    const float* xsrc = (l == 0) ? gin(pp->in[I_X]) : (const float*)(pp->ws + WS_X);
    const float* modl = MOD + (size_t)l * 2 * 6144;
    if (l == 0) {
      norm_mod_phase(xsrc, gin(pp->in[I_NMIX]), modl + 0, modl + 1024, (bf16_t*)(pp->ws + WS_ABUF));
      qbias_phase(p, smem);
      xcd_barrier(xb);
    }
    gemm_proj_phase(p, l, smem);
    xcd_barrier(xb);
    attn_phase(p, l, smem);
    mix_local_phase(p, l, smem);
    xcd_barrier(xb);
    scan_phase(p, l);
    xcd_barrier(xb);
    mix_final_phase(p, l, smem);
    xcd_barrier(xb);
    gemm_out_phase(p, l, smem);
    xcd_barrier(xb);
    gemm_q_phase(p, l, smem);
    xcd_barrier(xb);
    peer_phase(p, l, l == DEPTH_ - 1, smem);
    xcd_barrier(xb);
  }
}

extern "C" void kernel_launch(void* const* d_in, const int* in_sizes, int n_in,
                              void* d_out, int out_size, void* d_ws, size_t ws_size,
                              hipStream_t stream) {
  static int grid_blocks = 0;
  if (grid_blocks == 0) {
    if (n_in != 24 || ws_size < WS_END) { fprintf(stderr, "kernel_launch: unexpected n_in %d / ws_size %zu (need %zu)\n", n_in, ws_size, (size_t)WS_END); grid_blocks = -1; return; }
    int dev = 0, cus = 0, per_cu = 0;
    if (hipGetDevice(&dev) != hipSuccess || hipDeviceGetAttribute(&cus, hipDeviceAttributeMultiprocessorCount, dev) != hipSuccess) { grid_blocks = -1; return; }
    if (hipFuncSetAttribute((const void*)fwd_megakernel, hipFuncAttributeMaxDynamicSharedMemorySize, LDS_BYTES) != hipSuccess) { fprintf(stderr, "hipFuncSetAttribute failed\n"); grid_blocks = -1; return; }
    if (hipOccupancyMaxActiveBlocksPerMultiprocessor(&per_cu, (const void*)fwd_megakernel, NT, LDS_BYTES) != hipSuccess || per_cu < 1) { fprintf(stderr, "occupancy query: %d\n", per_cu); grid_blocks = -1; return; }
    grid_blocks = cus;
  }
  if (grid_blocks < 0) return;
  Params p{};
  for (int i = 0; i < 24; ++i) p.in[i] = (const GAS float*)d_in[i];
  p.out = (GAS float*)d_out; p.ws = (GAS unsigned char*)d_ws;
  void* args[] = {&p};
  hipError_t e = hipLaunchCooperativeKernel((void*)fwd_megakernel, dim3(grid_blocks), dim3(NT), args, LDS_BYTES, stream);
  if (e != hipSuccess) fprintf(stderr, "cooperative launch failed: %s (grid %d)\n", hipGetErrorString(e), grid_blocks);
}
```

```cpp
#include <hip/hip_runtime.h>
#include <hip/hip_cooperative_groups.h>
#include <cstdio>
#include <cstdint>
namespace cg = cooperative_groups;

typedef unsigned short bf16_t;
typedef short bf16x8 __attribute__((ext_vector_type(8)));
typedef float f32x4 __attribute__((ext_vector_type(4)));
typedef float f32x16 __attribute__((ext_vector_type(16)));
typedef int i32x8 __attribute__((ext_vector_type(8)));

constexpr int T_ = 16384, D_ = 1024, L_ = 8192, NBATCH = 2, DEPTH_ = 4;
constexpr int INC = 2944, INCP = 3072;
constexpr int NCH = 128;
constexpr int NT = 512;
constexpr int NW = 8;
constexpr float EPS_ = 1e-6f;
constexpr int C_QA = 0, C_KA = 384, C_VA = 768, C_QR = 1152, C_KR = 1536, C_VR = 1920, C_GR = 2304, C_US = 2688;

constexpr size_t al256(size_t x) { return (x + 255) & ~(size_t)255; }
constexpr size_t WS_MOD   = 0;
constexpr size_t WS_ROTC  = al256(WS_MOD + 4ull * 2 * 6144 * 4);
constexpr size_t WS_ROTS  = al256(WS_ROTC + 8192ull * 32 * 4);
constexpr size_t WS_SA    = al256(WS_ROTS + 8192ull * 32 * 4);
constexpr size_t WS_SBB   = al256(WS_SA + 4ull * 16 * 64 * 2 * 4);
constexpr size_t WS_WIN   = al256(WS_SBB + 4ull * 16 * 64 * 32 * 4);
constexpr size_t WS_WOUT  = al256(WS_WIN + 4ull * INCP * 1024 * 2);
constexpr size_t WS_WQ    = al256(WS_WOUT + 4ull * 1024 * 1024 * 2);
constexpr size_t WS_SUBK  = al256(WS_WQ + 4ull * 2048 * 1024 * 2);
constexpr size_t WS_ABUF  = al256(WS_SUBK + 4ull * 16 * 128 * 128 * 2);
constexpr size_t WS_PROJ  = al256(WS_ABUF + (size_t)T_ * 1024 * 2);
constexpr size_t WS_VTA   = al256(WS_PROJ + (size_t)T_ * INCP * 2);
constexpr size_t WS_ATT   = al256(WS_VTA + 2ull * 6 * 64 * 8192 * 2);
constexpr size_t WS_YINT  = al256(WS_ATT + (size_t)T_ * 384 * 4);
constexpr size_t WS_UPD   = al256(WS_YINT + (size_t)T_ * 384 * 4);
constexpr size_t WS_SPREV = al256(WS_UPD + 256ull * 6 * 4096 * 4);
constexpr size_t WS_SEND  = al256(WS_SPREV + 256ull * 6 * 4096 * 4);
constexpr size_t WS_CARRY = al256(WS_SEND + 256ull * 16 * 64 * 2 * 4);
constexpr size_t WS_X     = al256(WS_CARRY + 256ull * 16 * 64 * 2 * 4);
constexpr size_t WS_Q     = al256(WS_X + (size_t)T_ * 1024 * 4);
constexpr size_t WS_SC    = al256(WS_Q + (size_t)T_ * 2048 * 2);
constexpr size_t WS_EIDX  = al256(WS_SC + (size_t)T_ * 2048 * 4);
constexpr size_t WS_EGATE = al256(WS_EIDX + (size_t)T_ * 128 * 4);
constexpr size_t WS_PU8   = al256(WS_EGATE + (size_t)T_ * 128 * 4);
constexpr size_t WS_PV8   = al256(WS_PU8 + 4ull * 16384 * 1024);
constexpr size_t WS_BAR   = al256(WS_PV8 + 4ull * 16384 * 1024);
constexpr size_t WS_SPT   = al256(WS_BAR + 3456ull * 4);
constexpr size_t WS_CB    = al256(WS_SPT + 256ull * 6 * 4096 * 2);
constexpr size_t WS_WGLUT = al256(WS_CB + 4ull * 16 * 16 * 128 * 2);
constexpr size_t WS_VTR   = al256(WS_WGLUT + 4ull * 512 * 256 * 2);
constexpr size_t WS_XG    = al256(WS_VTR + 2ull * 384 * 8192 * 2);
constexpr size_t WS_SSQ   = al256(WS_XG + (size_t)T_ * 1024 * 2);
constexpr size_t WS_C2    = al256(WS_SSQ + (size_t)T_ * 16 * 4);
constexpr size_t WS_BBH   = al256(WS_C2 + 4ull * 2 * 2048 * 4);
constexpr size_t WS_END   = al256(WS_BBH + 4ull * 16 * 2 * 64 * 16 * 2);

constexpr int LDS_BYTES = 135168;

#define GAS __attribute__((address_space(1)))
struct Params {
  const GAS float* in[24];
  GAS float* out;
  GAS unsigned char* ws;
};
enum { I_X = 0, I_C, I_WADA, I_BADA, I_NMIX, I_NFFN, I_WIN, I_RELB, I_LRE, I_LIM, I_LOGDT, I_BRE, I_BIM, I_CRE, I_CIM, I_SSMD,
       I_WGLU, I_MGAIN, I_WOUT, I_WQ, I_SUBK, I_PU, I_PV, I_FNORM };

__device__ __forceinline__ float bf2f(bf16_t v) { return __uint_as_float(((unsigned)v) << 16); }
__device__ __forceinline__ bf16_t f2bf(float f) { unsigned u = __float_as_uint(f); u += 0x7fffu + ((u >> 16) & 1u); return (bf16_t)(u >> 16); }
__device__ __forceinline__ unsigned pk2(float a, float b) { return (unsigned)f2bf(a) | ((unsigned)f2bf(b) << 16); }
__device__ __forceinline__ float wave_sum(float v) {
#pragma unroll
  for (int o = 32; o > 0; o >>= 1) v += __shfl_xor(v, o);
  return v;
}
__device__ __forceinline__ float wave_max(float v) {
#pragma unroll
  for (int o = 32; o > 0; o >>= 1) v = fmaxf(v, __shfl_xor(v, o));
  return v;
}
__device__ __forceinline__ float gelu_tanh(float x) { const float u = 0.7978845608028654f * (x + 0.044715f * x * x * x); return 0.5f * x * (1.f + tanhf(u)); }
__device__ __forceinline__ float sigmoid_f(float x) { return 1.f / (1.f + __expf(-x)); }
__device__ __forceinline__ float gelu_tanh_fast(float x) {
  const float u2 = 2.f * 0.7978845608028654f * 1.4426950408889634f * (x + 0.044715f * x * x * x);
  const float e = __builtin_amdgcn_exp2f(fminf(u2, 80.f));
  return x - x * __builtin_amdgcn_rcpf(1.f + e);
}
__device__ __forceinline__ GAS unsigned char* launder_ptr(GAS unsigned char* q) { asm volatile("" : "+s"(q)); return q; }
__device__ __forceinline__ const float* gin(const GAS float* q) { return (const float*)q; }
__device__ __forceinline__ const float* launder_cptr(const float* q) { asm volatile("" : "+s"(q)); return q; }
__device__ __forceinline__ int launder_tid() { int t = threadIdx.x; asm volatile("" : "+v"(t)); return t; }
typedef const Params __attribute__((address_space(4)))* CParamsP;
__device__ __forceinline__ CParamsP launder_kargs() { CParamsP q = (CParamsP)__builtin_amdgcn_kernarg_segment_ptr(); asm volatile("" : "+s"(q)); return q; }

__device__ __forceinline__ void convert_tables_fp4(const CParamsP pp, GAS unsigned char* ws, int layer, int gtid, int gn) {
  constexpr size_t NIT = 16384ull * 1024 / 16;
  for (size_t it = gtid; it < 2 * NIT; it += gn) {
    const int tb = it >= NIT ? 1 : 0; const size_t r = (it - (size_t)tb * NIT) + (size_t)layer * NIT;
    const f32x4* src = (const f32x4*)((tb ? gin(pp->in[I_PV]) : gin(pp->in[I_PU])) + r * 16);
    const float sc = tb ? 4.f : 64.f;
    unsigned o[2] = {0u, 0u};
#pragma unroll
    for (int q = 0; q < 4; ++q) {
      const f32x4 a = src[q];
      const float x0 = fminf(fmaxf(a.x * sc, -6.f), 6.f), x1 = fminf(fmaxf(a.y * sc, -6.f), 6.f);
      const float x2 = fminf(fmaxf(a.z * sc, -6.f), 6.f), x3 = fminf(fmaxf(a.w * sc, -6.f), 6.f);
      if (q == 0)      { o[0] = __builtin_amdgcn_cvt_scalef32_pk_fp4_f32(o[0], x0, x1, 1.0f, 0); o[0] = __builtin_amdgcn_cvt_scalef32_pk_fp4_f32(o[0], x2, x3, 1.0f, 1); }
      else if (q == 1) { o[0] = __builtin_amdgcn_cvt_scalef32_pk_fp4_f32(o[0], x0, x1, 1.0f, 2); o[0] = __builtin_amdgcn_cvt_scalef32_pk_fp4_f32(o[0], x2, x3, 1.0f, 3); }
      else if (q == 2) { o[1] = __builtin_amdgcn_cvt_scalef32_pk_fp4_f32(o[1], x0, x1, 1.0f, 0); o[1] = __builtin_amdgcn_cvt_scalef32_pk_fp4_f32(o[1], x2, x3, 1.0f, 1); }
      else             { o[1] = __builtin_amdgcn_cvt_scalef32_pk_fp4_f32(o[1], x0, x1, 1.0f, 2); o[1] = __builtin_amdgcn_cvt_scalef32_pk_fp4_f32(o[1], x2, x3, 1.0f, 3); }
    }
    *(uint2*)(ws + (tb ? WS_PV8 : WS_PU8) + r * 8) = make_uint2(o[0], o[1]);
  }
}

__device__ void setup_phase(const Params& p, unsigned char* smem) {
  const CParamsP pp = launder_kargs();
  GAS unsigned char* const ws = launder_ptr(pp->ws); const int tidx = launder_tid(); (void)ws; (void)tidx;
  const int tid = tidx;
  float* sm = (float*)smem;
  {
    float* cond = sm;
    float* red = sm + 2048;
    float* MOD = (float*)(ws + WS_MOD);
    for (int i = tid; i < 2048; i += NT) { const float c = gin(pp->in[I_C])[i]; cond[i] = c * sigmoid_f(c); }
    __syncthreads();
    for (int item = blockIdx.x; item < 4 * 96; item += gridDim.x) {
      const int l = item / 96, cb = item % 96, kq = tid >> 6, jj = tid & 63, j = cb * 64 + jj;
      const float* w = gin(pp->in[I_WADA]) + (size_t)l * 1024 * 6144 + j;
      float a0 = 0.f, a1 = 0.f;
#pragma unroll 16
      for (int k = kq * 128; k < kq * 128 + 128; ++k) { const float wv = w[(size_t)k * 6144]; a0 += cond[k] * wv; a1 += cond[1024 + k] * wv; }
      red[(kq * 2 + 0) * 64 + jj] = a0; red[(kq * 2 + 1) * 64 + jj] = a1;
      __syncthreads();
      if (tid < 128) {
        const int b = tid >> 6, j2 = tid & 63; float s = 0.f;
        for (int q = 0; q < 8; ++q) s += red[(q * 2 + b) * 64 + j2];
        MOD[((size_t)l * 2 + b) * 6144 + cb * 64 + j2] = s + gin(pp->in[I_BADA])[(size_t)l * 6144 + cb * 64 + j2];
      }
      __syncthreads();
    }
  }
  const int gtid = blockIdx.x * NT + tid, gn = gridDim.x * NT;
  {
    float* RC = (float*)(ws + WS_ROTC); float* RS = (float*)(ws + WS_ROTS);
    for (int idx = gtid; idx < 8192 * 32; idx += gn) {
      const int pos = idx >> 5, i = idx & 31;
      const float inv = powf(10000.0f, -(float)i / 32.0f);
      const float ang = (float)pos * inv;
      float s, c; sincosf(ang, &s, &c);
      RC[idx] = c; RS[idx] = s;
    }
  }
  {
    float* SA = (float*)(ws + WS_SA); float* SBB = (float*)(ws + WS_SBB); bf16_t* BBH = (bf16_t*)(ws + WS_BBH);
    for (int idx = gtid; idx < 4 * 16 * 64; idx += gn) {
      const int l = idx / 1024, g = (idx >> 6) & 15;
      const float dt = expf(gin(pp->in[I_LOGDT])[l * 16 + g]);
      const float lr = gin(pp->in[I_LRE])[idx], li = gin(pp->in[I_LIM])[idx];
      const float mag = expf(lr * dt);
      float sn, cs; sincosf(li * dt, &sn, &cs);
      const float are = mag * cs, aim = mag * sn;
      const float den = lr * lr + li * li, nr = are - 1.f, ni = aim;
      const float fre = (nr * lr + ni * li) / den, fim = (ni * lr - nr * li) / den;
      SA[idx * 2] = are; SA[idx * 2 + 1] = aim;
      for (int c = 0; c < 16; ++c) {
        const float br = gin(pp->in[I_BRE])[(size_t)idx * 16 + c], bi = gin(pp->in[I_BIM])[(size_t)idx * 16 + c];
        SBB[(size_t)idx * 32 + c] = fre * br - fim * bi;
        SBB[(size_t)idx * 32 + 16 + c] = fre * bi + fim * br;
        {
          const int pq = idx & 63; const size_t fb = (size_t)(idx >> 6) * 2;
          BBH[(((fb + 0) * 2 + (pq >> 5)) * 64 + 32 * (c >> 3) + (pq & 31)) * 8 + (c & 7)] = f2bf(fre * br - fim * bi);
          BBH[(((fb + 1) * 2 + (pq >> 5)) * 64 + 32 * (c >> 3) + (pq & 31)) * 8 + (c & 7)] = f2bf(fre * bi + fim * br);
        }
      }
    }
  }
  {
    bf16_t* CB = (bf16_t*)(ws + WS_CB);
    for (int idx = gtid; idx < 4 * 16 * 16 * 128; idx += gn) {
      const int k = idx & 127, lgc = idx >> 7;
      const bf16_t cv = (k < 64) ? f2bf(gin(pp->in[I_CRE])[(size_t)lgc * 64 + k]) : f2bf(-gin(pp->in[I_CIM])[(size_t)lgc * 64 + (k - 64)]);
      const int cc = lgc & 15, lg = lgc >> 4;
      CB[(((size_t)lg * 4 + (k >> 5)) * 64 + ((k >> 3) & 3) * 16 + cc) * 8 + (k & 7)] = cv;
    }
    bf16_t* WG = (bf16_t*)(ws + WS_WGLUT);
    for (int idx = gtid; idx < 4 * 512 * 256; idx += gn) {
      const int k = idx & 255, nn = (idx >> 8) & 511, l2 = idx >> 17;
      {
        const int which = nn >> 8, w8 = (nn >> 5) & 7, nt = (nn >> 4) & 1, frr = nn & 15, ks = k >> 5, fqq = (k >> 3) & 3, j = k & 7;
        WG[(((((size_t)l2 * 8 + w8) * 8 + ks) * 2 + which) * 2 + nt) * 512 + (fqq * 16 + frr) * 8 + j] = f2bf(gin(pp->in[I_WGLU])[((size_t)l2 * 256 + k) * 512 + nn]);
      }
    }
  }
  convert_tables_fp4(pp, ws, 0, gtid, gn);
  {
    __syncthreads();
    const int lane = tid & 63, wid = tid >> 6;
    float* scr = sm + wid * (64 * 33);
    constexpr int IT_IN = 16 * 96, IT_OUT = 16 * 32, IT_L = IT_IN + IT_OUT;
    for (int item = blockIdx.x * NW + wid; item < 4 * IT_L; item += gridDim.x * NW) {
      const int l = item / IT_L; int r = item - l * IT_L;
      const float* W; bf16_t* WT; int N, NP;
      if (r < IT_IN) { W = gin(pp->in[I_WIN]) + (size_t)l * 1024 * INC; WT = (bf16_t*)(ws + WS_WIN) + (size_t)l * INCP * 1024; N = INC; NP = 96; }
      else { r -= IT_IN; W = gin(pp->in[I_WOUT]) + (size_t)l * 1024 * 1024; WT = (bf16_t*)(ws + WS_WOUT) + (size_t)l * 1024 * 1024; N = 1024; NP = 32; }
      const int kb = r / NP, nb = r - kb * NP, k0 = kb * 64, n0 = nb * 32;
      const int nn = n0 + (lane & 31); const bool inb = nn < N;
      float v[32];
#pragma unroll
      for (int i = 0; i < 32; ++i) { const int kk = 2 * i + (lane >> 5); v[i] = inb ? W[(size_t)(k0 + kk) * N + nn] : 0.f; }
#pragma unroll
      for (int i = 0; i < 32; ++i) { const int kk = 2 * i + (lane >> 5); scr[kk * 33 + (lane & 31)] = v[i]; }
      const int c = lane & 7;
#pragma unroll
      for (int j = 0; j < 4; ++j) {
        const int n = (lane >> 3) + 8 * j; const float* sp = scr + (8 * c) * 33 + n;
        uint4 o; o.x = pk2(sp[0], sp[33]); o.y = pk2(sp[2 * 33], sp[3 * 33]); o.z = pk2(sp[4 * 33], sp[5 * 33]); o.w = pk2(sp[6 * 33], sp[7 * 33]);
        *(uint4*)(WT + (size_t)(n0 + n) * 1024 + k0 + 8 * c) = o;
      }
    }
    __syncthreads();
  }
  {
    float* WtT = sm;
    float* SKs = sm + 128 * 65;
    bf16_t* WP = (bf16_t*)(ws + WS_WQ);
    for (int item = blockIdx.x; item < 4 * 16 * 16; item += gridDim.x) {
      const int l = item >> 8, hs = (item >> 4) & 15, kb = item & 15, k0 = kb * 64;
      const float* Wq = gin(pp->in[I_WQ]) + (size_t)l * 1024 * 2048 + hs * 128;
      const float* SKg = gin(pp->in[I_SUBK]) + ((size_t)l * 16 + hs) * 128 * 128;
      __syncthreads();
#pragma unroll
      for (int i = 0; i < 16; ++i) { const int idx = tid + NT * i, kk = idx >> 7, d = idx & 127; WtT[d * 65 + kk] = Wq[(size_t)(k0 + kk) * 2048 + d]; }
#pragma unroll
      for (int i = 0; i < 32; ++i) { const int idx = tid + NT * i, key = idx >> 7, d = idx & 127; SKs[key * 129 + d] = SKg[idx]; }
      __syncthreads();
      const int key = tid & 127, kg = tid >> 7;
      float acc[16];
#pragma unroll
      for (int i = 0; i < 16; ++i) acc[i] = 0.f;
#pragma unroll 4
      for (int d = 0; d < 128; ++d) {
        const float sv = SKs[key * 129 + d];
#pragma unroll
        for (int i = 0; i < 16; ++i) acc[i] += sv * WtT[d * 65 + kg * 16 + i];
      }
      uint4 o0, o1;
      o0.x = pk2(acc[0], acc[1]); o0.y = pk2(acc[2], acc[3]); o0.z = pk2(acc[4], acc[5]); o0.w = pk2(acc[6], acc[7]);
      o1.x = pk2(acc[8], acc[9]); o1.y = pk2(acc[10], acc[11]); o1.z = pk2(acc[12], acc[13]); o1.w = pk2(acc[14], acc[15]);
      bf16_t* dst = WP + ((size_t)l * 2048 + hs * 128 + key) * 1024 + k0 + kg * 16;
      *(uint4*)dst = o0; *(uint4*)(dst + 8) = o1;
    }
    __syncthreads();
  }
}

__device__ void qbias_phase(const Params& p, unsigned char* smem) {
  const CParamsP pp = launder_kargs();
  GAS unsigned char* const ws = launder_ptr(pp->ws); const int tid = launder_tid();
  float* C2 = (float*)(ws + WS_C2); const float* MOD = (const float*)(ws + WS_MOD); const bf16_t* WP = (const bf16_t*)(ws + WS_WQ);
  const int lane = tid & 63, gw = blockIdx.x * NW + (tid >> 6), nw = gridDim.x * NW;
  for (int o = gw; o < 4 * 2048; o += nw) {
    const int l = o >> 11;
    const uint4 w0 = *(const uint4*)(WP + (size_t)o * 1024 + lane * 16), w1 = *(const uint4*)(WP + (size_t)o * 1024 + lane * 16 + 8);
    const unsigned ww[8] = {w0.x, w0.y, w0.z, w0.w, w1.x, w1.y, w1.z, w1.w};
    const float* s0 = MOD + (size_t)l * 2 * 6144 + 3072 + lane * 16; const float* s1 = s0 + 6144;
    float a0 = 0.f, a1 = 0.f;
#pragma unroll
    for (int q = 0; q < 8; ++q) {
      const float wl = __uint_as_float(ww[q] << 16), wh = __uint_as_float(ww[q] & 0xffff0000u);
      a0 += s0[2 * q] * wl + s0[2 * q + 1] * wh; a1 += s1[2 * q] * wl + s1[2 * q + 1] * wh;
    }
    a0 = wave_sum(a0); a1 = wave_sum(a1);
    if (lane == 0) { C2[((size_t)l * 2 + 0) * 2048 + (o & 2047)] = a0; C2[((size_t)l * 2 + 1) * 2048 + (o & 2047)] = a1; }
  }
  (void)smem;
}

__device__ void norm_mod_phase(const float* __restrict__ xsrc, const float* __restrict__ gain, const float* __restrict__ mod_sh, const float* __restrict__ mod_sc,
                               bf16_t* __restrict__ outp) {
  const int tidx = launder_tid();
  const int lane = tidx & 63, gw = blockIdx.x * NW + (tidx >> 6), nw = gridDim.x * NW;
  for (int t = gw; t < T_; t += nw) {
    const int b = t >> 13;
    const f32x4* xr = (const f32x4*)(xsrc + (size_t)t * 1024) + lane;
    f32x4 v[4]; float s = 0.f;
#pragma unroll
    for (int j = 0; j < 4; ++j) { v[j] = xr[64 * j]; s += v[j].x * v[j].x + v[j].y * v[j].y + v[j].z * v[j].z + v[j].w * v[j].w; }
    const float rstd = rsqrtf(wave_sum(s) * (1.f / 1024.f) + EPS_);
#pragma unroll
    for (int j = 0; j < 4; ++j) {
      const int c = lane * 4 + 256 * j;
      const f32x4 g = *(const f32x4*)(gain + c), sh = *(const f32x4*)(mod_sh + b * 6144 + c), sc = *(const f32x4*)(mod_sc + b * 6144 + c);
      const float o0 = v[j].x * rstd * g.x * (1.f + sc.x) + sh.x, o1 = v[j].y * rstd * g.y * (1.f + sc.y) + sh.y;
      const float o2 = v[j].z * rstd * g.z * (1.f + sc.z) + sh.z, o3 = v[j].w * rstd * g.w * (1.f + sc.w) + sh.w;
      uint2 o; o.x = pk2(o0, o1); o.y = pk2(o2, o3);
      *(uint2*)(outp + (size_t)t * 1024 + c) = o;
    }
  }
}


namespace pg8 {
#define PG8_LAS __attribute__((address_space(3)))
typedef unsigned u32x4 __attribute__((ext_vector_type(4)));
constexpr int BM = 256, BK = 64, HALF = 128, HTB = HALF * BK * 2, STAGE_BYTES = 8 * HTB, NXCD = 8, WGM = 8;
__host__ __device__ __forceinline__ int lds_byte(int r, int c) { const int st = (r >> 4) * 2 + (c >> 5), rr = r & 15, cc = c & 31, ob = rr * 64 + cc * 2; return st * 1024 + (ob ^ (((ob >> 9) & 1) << 5)); }
__host__ __device__ __forceinline__ void stage_rc(int b, int& R, int& C) { const int st = b / 1024, sb = b % 1024, swz = sb ^ (((sb >> 9) & 1) << 5); R = (st >> 1) * 16 + swz / 64; C = (st & 1) * 32 + (swz % 64) / 2; }
__host__ __device__ __forceinline__ int perm32(int rho) { const int n = rho >> 4, i = rho & 15; return 8 * (i >> 2) + 4 * n + (i & 3); }
struct Unit { int pm, pn; };
struct Gemm { const bf16_t* A; const bf16_t* Bt; int M, N, K; };
struct StaticOrder {
    int nM, nN, nwg, G, c;
    __host__ __device__ void init(int M, int N, int G_, int c_) { nM = M / BM; nN = N / BM; nwg = nM * nN; G = G_; c = c_; }
    __host__ __device__ bool next(int i, Unit& u) const {
        const long L = (long)i * G + c; if (L >= nwg) return false;
        int wgid = (int)L; { const int q = nwg / NXCD, r = nwg % NXCD, xcd = wgid % NXCD, off = wgid / NXCD; wgid = (xcd < r ? xcd * (q + 1) : r * (q + 1) + (xcd - r) * q) + off; }
        const int nig = WGM * nN, gid = wgid / nig, fm = gid * WGM, gsz = (nM - fm) < WGM ? (nM - fm) : WGM;
        u.pm = fm + ((wgid % nig) % gsz); u.pn = (wgid % nig) / gsz; return true;
    }
    __device__ __forceinline__ void a_ready(const Unit&) const {}
    __device__ __forceinline__ void done(const Unit&) const {}
};
__device__ __forceinline__ unsigned cvt_pk_bf16(float lo, float hi) { unsigned r; asm volatile("v_cvt_pk_bf16_f32 %0, %1, %2" : "=v"(r) : "v"(lo), "v"(hi)); return r; }
template <class Epi, class Sched>
__device__ __forceinline__ void gemm_phase(PG8_LAS unsigned char* lds, const Gemm g, const Sched& S, const Epi& E) {
    const int tid = launder_tid(), wid = __builtin_amdgcn_readfirstlane(tid >> 6), lane = tid & 63, wr = wid >> 2, wc = wid & 3, fr = lane & 15, fq = lane >> 4;
    const int K = g.K, nt = K / BK;
    unsigned voffA[2], voffB[2];
#pragma unroll
    for (int i = 0; i < 2; ++i) { int R, C; stage_rc(tid * 16 + i * 8192, R, C); const int Rb = Epi::PERM ? ((R & ~31) + perm32(R & 31)) : R;
        voffA[i] = (unsigned)(R * K + C) * 2u; voffB[i] = (unsigned)(Rb * K + C) * 2u; }
    const size_t kstep = (size_t)(BK * 2);
    const size_t hstep = (size_t)HALF * K * 2;
    const size_t tstep = 2 * hstep;
    const unsigned ldsw = (unsigned)wid * 1024u;
    const int aoff = lds_byte(wr * 64 + fr, fq * 8), boff = lds_byte(wc * 32 + fr, fq * 8);
#define PG8_SA(b, h) (((b) * 2 + (h)) * HTB)
#define PG8_SB(b, h) ((4 + (b) * 2 + (h)) * HTB)
#define PG8_STAGE(bufoff, gbase, voff) do { _Pragma("unroll") for (int _i = 0; _i < 2; ++_i) \
        __builtin_amdgcn_global_load_lds((const unsigned*)((const char*)(gbase) + (voff)[_i]), (PG8_LAS unsigned*)(lds + (bufoff) + ldsw + _i * 8192), 16, 0, 0); } while (0)
#define PG8_LDA(dst, b, h) do { _Pragma("unroll") for (int m = 0; m < 4; ++m) _Pragma("unroll") for (int k = 0; k < 2; ++k) dst[m][k] = *(const PG8_LAS bf16x8*)(lds + PG8_SA(b, h) + aoff + m * 2048 + k * 1024); } while (0)
#define PG8_LDB(dst, b, h) do { _Pragma("unroll") for (int n = 0; n < 2; ++n) _Pragma("unroll") for (int k = 0; k < 2; ++k) dst[n][k] = *(const PG8_LAS bf16x8*)(lds + PG8_SB(b, h) + boff + n * 2048 + k * 1024); } while (0)
#define PG8_MMA(ai, bj, At, Bt) do { __builtin_amdgcn_s_setprio(1); _Pragma("unroll") for (int m = 0; m < 4; ++m) _Pragma("unroll") for (int n = 0; n < 2; ++n) _Pragma("unroll") for (int k = 0; k < 2; ++k) \
        acc[ai][bj][m][n] = __builtin_amdgcn_mfma_f32_16x16x32_bf16(Bt[n][k], At[m][k], acc[ai][bj][m][n], 0, 0, 0); __builtin_amdgcn_s_setprio(0); } while (0)
#define PG8_WAIT_V(n) asm volatile("s_waitcnt vmcnt(" #n ")" ::: "memory")
#define PG8_WAIT_L(n) asm volatile("s_waitcnt lgkmcnt(" #n ")" ::: "memory")
#define PG8_BAR __builtin_amdgcn_s_barrier()
#define PG8_SCHED __builtin_amdgcn_sched_barrier(0)
    Unit cur, nxt; int ui = 0;
    if (!S.next(0, cur)) return;
    f32x4 acc[2][2][4][2];
#pragma unroll
    for (int a = 0; a < 2; ++a)
#pragma unroll
        for (int b = 0; b < 2; ++b)
#pragma unroll
            for (int m = 0; m < 4; ++m)
#pragma unroll
                for (int n = 0; n < 2; ++n) acc[a][b][m][n] = (f32x4){0.f, 0.f, 0.f, 0.f};
    bf16x8 At[4][2], B0[2][2], B1[2][2];
    const char* cA = (const char*)g.A + (size_t)cur.pm * tstep; const char* cB = (const char*)g.Bt + (size_t)cur.pn * tstep;
    S.a_ready(cur);
    PG8_STAGE(PG8_SB(0, 0), cB, voffB); PG8_STAGE(PG8_SA(0, 0), cA, voffA); PG8_STAGE(PG8_SB(0, 1), cB + hstep, voffB); PG8_STAGE(PG8_SA(0, 1), cA + hstep, voffA);
    if (wr == 1) PG8_BAR;
    PG8_WAIT_V(4); PG8_BAR;
    PG8_STAGE(PG8_SB(1, 0), cB + kstep, voffB); PG8_STAGE(PG8_SA(1, 0), cA + kstep, voffA); PG8_STAGE(PG8_SB(1, 1), cB + hstep + kstep, voffB);
    PG8_WAIT_V(6); PG8_BAR;
    for (;;) {
        const bool has_next = S.next(ui + 1, nxt);
        const char* nA = has_next ? (const char*)g.A + (size_t)nxt.pm * tstep : cA; const char* nB = has_next ? (const char*)g.Bt + (size_t)nxt.pn * tstep : cB;
        for (int t = 0; t < nt; t += 2) {
            const bool last = (t == nt - 2);
            const char* a1 = cA + (size_t)(t + 1) * kstep;
            const char* a2 = last ? nA : cA + (size_t)(t + 2) * kstep; const char* b2 = last ? nB : cB + (size_t)(t + 2) * kstep;
            const char* a3 = a2 + kstep; const char* b3 = b2 + kstep;
            if (last && has_next) S.a_ready(nxt);
            PG8_LDB(B0, 0, 0); PG8_SCHED; PG8_LDA(At, 0, 0); PG8_STAGE(PG8_SA(1, 1), a1 + hstep, voffA);
            PG8_WAIT_L(8); PG8_BAR; PG8_WAIT_L(0); PG8_MMA(0, 0, At, B0); PG8_BAR; PG8_SCHED;
            PG8_LDB(B1, 0, 1); PG8_STAGE(PG8_SB(0, 0), b2, voffB);
            PG8_BAR; PG8_WAIT_L(0); PG8_MMA(0, 1, At, B1); PG8_BAR;
            PG8_LDA(At, 0, 1); PG8_STAGE(PG8_SA(0, 0), a2, voffA);
            PG8_BAR; PG8_WAIT_L(0); PG8_MMA(1, 0, At, B0); PG8_BAR; PG8_SCHED;
            PG8_STAGE(PG8_SB(0, 1), b2 + hstep, voffB);
            PG8_WAIT_V(6); PG8_BAR; PG8_MMA(1, 1, At, B1); PG8_BAR;
            PG8_LDB(B0, 1, 0); PG8_SCHED; PG8_LDA(At, 1, 0); PG8_STAGE(PG8_SA(0, 1), a2 + hstep, voffA);
            PG8_WAIT_L(8); PG8_BAR; PG8_WAIT_L(0); PG8_MMA(0, 0, At, B0); PG8_BAR; PG8_SCHED;
            PG8_LDB(B1, 1, 1); PG8_STAGE(PG8_SB(1, 0), b3, voffB);
            PG8_BAR; PG8_WAIT_L(0); PG8_MMA(0, 1, At, B1); PG8_BAR;
            PG8_LDA(At, 1, 1); PG8_STAGE(PG8_SA(1, 0), a3, voffA);
            PG8_BAR; PG8_WAIT_L(0); PG8_MMA(1, 0, At, B0); PG8_BAR; PG8_SCHED;
            PG8_STAGE(PG8_SB(1, 1), b3 + hstep, voffB);
            PG8_WAIT_V(6); PG8_BAR; PG8_MMA(1, 1, At, B1); PG8_BAR;
        }
        if constexpr (!Epi::AFTER_DRAIN) { E(acc, cur, wr, wc, fr, fq); S.done(cur); }
        if (!has_next) break;
#pragma unroll
        for (int a = 0; a < 2; ++a)
#pragma unroll
            for (int b = 0; b < 2; ++b)
#pragma unroll
                for (int m = 0; m < 4; ++m)
#pragma unroll
                    for (int n = 0; n < 2; ++n) acc[a][b][m][n] = (f32x4){0.f, 0.f, 0.f, 0.f};
        cur = nxt; cA = nA; cB = nB; ++ui;
    }
    PG8_WAIT_V(0);
    if (wr == 0) PG8_BAR;
    PG8_BAR;
    if constexpr (Epi::AFTER_DRAIN) { E.fused(acc, cur, wr, wc, fr, fq, lds, wid, lane); S.done(cur); }
#undef PG8_SA
#undef PG8_SB
#undef PG8_STAGE
#undef PG8_LDA
#undef PG8_LDB
#undef PG8_MMA
#undef PG8_WAIT_V
#undef PG8_WAIT_L
#undef PG8_BAR
#undef PG8_SCHED
}
}

__device__ __forceinline__ float ssq_total(const float* __restrict__ SSQ, int t) {
  const f32x4 a = *(const f32x4*)(SSQ + (size_t)t * 16), b = *(const f32x4*)(SSQ + (size_t)t * 16 + 4), c = *(const f32x4*)(SSQ + (size_t)t * 16 + 8), d = *(const f32x4*)(SSQ + (size_t)t * 16 + 12);
  return (((a.x + a.y) + (a.z + a.w)) + ((b.x + b.y) + (b.z + b.w))) + (((c.x + c.y) + (c.z + c.w)) + ((d.x + d.y) + (d.z + d.w)));
}
struct EpiProj {
  static constexpr bool PERM = true, AFTER_DRAIN = false;
  bf16_t* PROJ; bf16_t* VTA; bf16_t* VTR;
  __device__ __forceinline__ void operator()(const f32x4 (&acc)[2][2][4][2], const pg8::Unit& u, int wr, int wc, int fr, int fq) const {
    const int row0 = u.pm * 256 + wr * 64 + fr, col0 = u.pn * 256 + wc * 32 + 8 * fq;
    asm volatile("s_nop 15\n\ts_nop 15" ::: "memory");
#pragma unroll
    for (int ai = 0; ai < 2; ++ai)
#pragma unroll
      for (int m = 0; m < 4; ++m) {
        const int t = row0 + ai * 128 + m * 16;
#pragma unroll
        for (int bj = 0; bj < 2; ++bj) {
          const int c = col0 + bj * 128;
          const f32x4 v0 = acc[ai][bj][m][0], v1 = acc[ai][bj][m][1];
          pg8::u32x4 w; w.x = pg8::cvt_pk_bf16(v0[0], v0[1]); w.y = pg8::cvt_pk_bf16(v0[2], v0[3]); w.z = pg8::cvt_pk_bf16(v1[0], v1[1]); w.w = pg8::cvt_pk_bf16(v1[2], v1[3]);
          *(pg8::u32x4*)(PROJ + (size_t)t * INCP + c) = w;
          const bool isva = (c >= C_VA && c < C_VA + 384), isvr = (c >= C_VR && c < C_VR + 384);
          if (isva || isvr) {
            bf16_t* vt = (isva ? VTA : VTR) + ((size_t)(t >> 13) * 384 + (c - (isva ? C_VA : C_VR))) * 8192 + (t & 8191);
            vt[0] = (bf16_t)(w.x & 0xffffu); vt[8192] = (bf16_t)(w.x >> 16); vt[2 * 8192] = (bf16_t)(w.y & 0xffffu); vt[3 * 8192] = (bf16_t)(w.y >> 16);
            vt[4 * 8192] = (bf16_t)(w.z & 0xffffu); vt[5 * 8192] = (bf16_t)(w.z >> 16); vt[6 * 8192] = (bf16_t)(w.w & 0xffffu); vt[7 * 8192] = (bf16_t)(w.w >> 16);
          }
        }
      }
  }
};
struct EpiOut {
  static constexpr bool PERM = true, AFTER_DRAIN = false;
  const float* xin; int first; bf16_t* X; const float* g1; const float* nf; const float* sc2; bf16_t* XG; float* SSQ;
  __device__ __forceinline__ void operator()(const f32x4 (&acc)[2][2][4][2], const pg8::Unit& u, int wr, int wc, int fr, int fq) const {
    const int row0 = u.pm * 256 + wr * 64 + fr, col0 = u.pn * 256 + wc * 32 + 8 * fq, b = (u.pm * 256) >> 13;
    f32x4 gg[2][2], gs[2][2];
#pragma unroll
    for (int bj = 0; bj < 2; ++bj)
#pragma unroll
      for (int n = 0; n < 2; ++n) {
        const int c = col0 + bj * 128 + n * 4;
        gg[bj][n] = *(const f32x4*)(g1 + b * 6144 + c);
        const f32x4 gf = *(const f32x4*)(nf + c), sc = *(const f32x4*)(sc2 + b * 6144 + c);
        gs[bj][n] = gf * (sc + 1.f);
      }
#pragma unroll
    for (int ai = 0; ai < 2; ++ai)
#pragma unroll
      for (int m = 0; m < 4; ++m) {
        const int t = row0 + ai * 128 + m * 16;
        float sq = 0.f;
#pragma unroll
        for (int bj = 0; bj < 2; ++bj) {
          const int c = col0 + bj * 128;
          f32x4 x0, x1;
          if (first) { x0 = *(const f32x4*)(xin + (size_t)t * 1024 + c); x1 = *(const f32x4*)(xin + (size_t)t * 1024 + c + 4); }
          else {
            const pg8::u32x4 xr = *(const pg8::u32x4*)(X + (size_t)t * 1024 + c);
            x0 = (f32x4){__uint_as_float(xr.x << 16), __uint_as_float(xr.x & 0xffff0000u), __uint_as_float(xr.y << 16), __uint_as_float(xr.y & 0xffff0000u)};
            x1 = (f32x4){__uint_as_float(xr.z << 16), __uint_as_float(xr.z & 0xffff0000u), __uint_as_float(xr.w << 16), __uint_as_float(xr.w & 0xffff0000u)};
          }
          const f32x4 n0 = x0 + gg[bj][0] * acc[ai][bj][m][0], n1 = x1 + gg[bj][1] * acc[ai][bj][m][1];
          pg8::u32x4 xo; xo.x = pg8::cvt_pk_bf16(n0.x, n0.y); xo.y = pg8::cvt_pk_bf16(n0.z, n0.w); xo.z = pg8::cvt_pk_bf16(n1.x, n1.y); xo.w = pg8::cvt_pk_bf16(n1.z, n1.w);
          *(pg8::u32x4*)(X + (size_t)t * 1024 + c) = xo;
          const f32x4 s0 = n0 * gs[bj][0], s1 = n1 * gs[bj][1];
          pg8::u32x4 go; go.x = pg8::cvt_pk_bf16(s0.x, s0.y); go.y = pg8::cvt_pk_bf16(s0.z, s0.w); go.z = pg8::cvt_pk_bf16(s1.x, s1.y); go.w = pg8::cvt_pk_bf16(s1.z, s1.w);
          *(pg8::u32x4*)(XG + (size_t)t * 1024 + c) = go;
          sq += ((n0.x * n0.x + n0.y * n0.y) + (n0.z * n0.z + n0.w * n0.w)) + ((n1.x * n1.x + n1.y * n1.y) + (n1.z * n1.z + n1.w * n1.w));
        }
        sq += __shfl_xor(sq, 16); sq += __shfl_xor(sq, 32);
        if (fq == 0) SSQ[(size_t)t * 16 + u.pn * 4 + wc] = sq;
      }
  }
};
struct EpiQ {
  static constexpr bool PERM = true, AFTER_DRAIN = false;
  bf16_t* SC8; const float* SSQ; const float* C2;
  __device__ __forceinline__ void operator()(const f32x4 (&acc)[2][2][4][2], const pg8::Unit& u, int wr, int wc, int fr, int fq) const {
    const int row0 = u.pm * 256 + wr * 64 + fr, col0 = u.pn * 256 + wc * 32 + 8 * fq, b = (u.pm * 256) >> 13;
    f32x4 cc[2][2];
#pragma unroll
    for (int bj = 0; bj < 2; ++bj) { cc[bj][0] = *(const f32x4*)(C2 + b * 2048 + col0 + bj * 128); cc[bj][1] = *(const f32x4*)(C2 + b * 2048 + col0 + bj * 128 + 4); }
#pragma unroll
    for (int ai = 0; ai < 2; ++ai)
#pragma unroll
      for (int m = 0; m < 4; ++m) {
        const int t = row0 + ai * 128 + m * 16;
        const float rstd = rsqrtf(ssq_total(SSQ, t) * (1.f / 1024.f) + EPS_);
#pragma unroll
        for (int bj = 0; bj < 2; ++bj) {
          const f32x4 v0 = acc[ai][bj][m][0] * rstd + cc[bj][0], v1 = acc[ai][bj][m][1] * rstd + cc[bj][1];
          pg8::u32x4 w; w.x = pg8::cvt_pk_bf16(v0[0], v0[1]); w.y = pg8::cvt_pk_bf16(v0[2], v0[3]); w.z = pg8::cvt_pk_bf16(v1[0], v1[1]); w.w = pg8::cvt_pk_bf16(v1[2], v1[3]);
          *(pg8::u32x4*)(SC8 + ((size_t)((col0 + bj * 128) >> 3) * T_ + t) * 8) = w;
        }
      }
  }
};

__device__ void gemm_proj_phase(const Params& p, int l, unsigned char* smem) {
  const CParamsP pp = launder_kargs();
  GAS unsigned char* const ws = launder_ptr(pp->ws);
  pg8::Gemm g; g.A = (const bf16_t*)(ws + WS_ABUF); g.Bt = (const bf16_t*)(ws + WS_WIN) + (size_t)l * INCP * 1024; g.M = T_; g.N = INCP; g.K = 1024;
  pg8::StaticOrder S; S.init(T_, INCP, gridDim.x, blockIdx.x);
  EpiProj E; E.PROJ = (bf16_t*)(ws + WS_PROJ); E.VTA = (bf16_t*)(ws + WS_VTA); E.VTR = (bf16_t*)(ws + WS_VTR);
  pg8::gemm_phase<EpiProj, pg8::StaticOrder>((PG8_LAS unsigned char*)smem, g, S, E);
}
__device__ void gemm_out_phase(const Params& p, int l, unsigned char* smem) {
  const CParamsP pp = launder_kargs();
  GAS unsigned char* const ws = launder_ptr(pp->ws);
  pg8::Gemm g; g.A = (const bf16_t*)(ws + WS_ABUF); g.Bt = (const bf16_t*)(ws + WS_WOUT) + (size_t)l * 1024 * 1024; g.M = T_; g.N = 1024; g.K = 1024;
  pg8::StaticOrder S; S.init(T_, 1024, gridDim.x, blockIdx.x);
  EpiOut E; E.xin = gin(pp->in[I_X]); E.first = (l == 0) ? 1 : 0; E.X = (bf16_t*)(ws + WS_X); E.g1 = (const float*)(ws + WS_MOD) + (size_t)l * 2 * 6144 + 2048;
  E.nf = gin(pp->in[I_NFFN]) + (size_t)l * 1024; E.sc2 = (const float*)(ws + WS_MOD) + (size_t)l * 2 * 6144 + 4096; E.XG = (bf16_t*)(ws + WS_XG); E.SSQ = (float*)(ws + WS_SSQ);
  pg8::gemm_phase<EpiOut, pg8::StaticOrder>((PG8_LAS unsigned char*)smem, g, S, E);
}
__device__ void gemm_q_phase(const Params& p, int l, unsigned char* smem) {
  const CParamsP pp = launder_kargs();
  GAS unsigned char* const ws = launder_ptr(pp->ws);
  pg8::Gemm g; g.A = (const bf16_t*)(ws + WS_XG); g.Bt = (const bf16_t*)(ws + WS_WQ) + (size_t)l * 2048 * 1024; g.M = T_; g.N = 2048; g.K = 1024;
  pg8::StaticOrder S; S.init(T_, 2048, gridDim.x, blockIdx.x);
  EpiQ E; E.SC8 = (bf16_t*)(ws + WS_SC); E.SSQ = (const float*)(ws + WS_SSQ); E.C2 = (const float*)(ws + WS_C2) + (size_t)l * 2 * 2048;
  pg8::gemm_phase<EpiQ, pg8::StaticOrder>((PG8_LAS unsigned char*)smem, g, S, E);
}

__device__ __forceinline__ int attn_fk(int r) { return ((r >> 3) & 3) | (((r >> 1) & 1) << 2); }
__device__ __forceinline__ int attn_fv(int r) { return (r >> 1) & 7; }
__device__ void attn_phase(const Params& p, int l, unsigned char* smem) {
  const CParamsP pp = launder_kargs();
  GAS unsigned char* const ws = launder_ptr(pp->ws); const int tidx = launder_tid();
  const bf16_t* PROJ = (const bf16_t*)(ws + WS_PROJ); const bf16_t* VTA = (const bf16_t*)(ws + WS_VTA);
  bf16_t* ATT = (bf16_t*)(ws + WS_ATT);
  const int lane = tidx & 63, wid = tidx >> 6, fr = lane & 15, fq = lane >> 4;
  float* ext = (float*)smem;
  unsigned char* stg = smem + 15360;
  constexpr float LOG2E = 1.4426950408889634f;
  __syncthreads();
  for (int idx = tidx; idx < 6 * 640; idx += NT) {
    const int h = idx / 640, e = idx - h * 640; int d = e - 63; d = d > 256 ? 256 : d;
    ext[idx] = gin(pp->in[I_RELB])[((size_t)l * 6 + h) * 513 + d + 256] * LOG2E;
  }
  const int hh = wid >> 2, qb = wid & 3, iq = qb * 16 + fr;
  const int srow = tidx >> 3, sch = tidx & 7;
  for (int it_ = blockIdx.x; it_ < 256; it_ += gridDim.x) {
    const int item = ((it_ & 7) << 5) | (it_ >> 3);
    const int b = item >> 7, n = item & 127, t0 = b * 8192 + n * 64;
    const int jc0 = n >= 8 ? 0 : 8 - n, nch = 9 - jc0, nst = 3 * nch;
    uint4 sa0, sa1, sa2, sa3, sb0, sb1, sb2, sb3;
#define ATTN_LOAD(S, st) do { const int _rd = (st) / nch, _jc = jc0 + (st) - _rd * nch, _m = n - 8 + _jc; \
      S##0 = *(const uint4*)(PROJ + (size_t)(b * 8192 + _m * 64 + srow) * INCP + C_KA + (2 * _rd) * 64 + sch * 8); \
      S##1 = *(const uint4*)(PROJ + (size_t)(b * 8192 + _m * 64 + srow) * INCP + C_KA + (2 * _rd + 1) * 64 + sch * 8); \
      S##2 = *(const uint4*)(VTA + ((size_t)b * 384 + (2 * _rd) * 64 + srow) * 8192 + _m * 64 + sch * 8); \
      S##3 = *(const uint4*)(VTA + ((size_t)b * 384 + (2 * _rd + 1) * 64 + srow) * 8192 + _m * 64 + sch * 8); } while (0)
#define ATTN_WRITE(S, buf) do { unsigned char* _bp = stg + (buf) * 32768; \
      *(uint4*)(_bp + srow * 128 + ((sch ^ attn_fk(srow)) << 4)) = S##0; \
      *(uint4*)(_bp + 8192 + srow * 128 + ((sch ^ attn_fk(srow)) << 4)) = S##1; \
      *(uint4*)(_bp + 16384 + srow * 128 + ((sch ^ attn_fv(srow)) << 4)) = S##2; \
      *(uint4*)(_bp + 24576 + srow * 128 + ((sch ^ attn_fv(srow)) << 4)) = S##3; } while (0)
    __syncthreads();
    ATTN_LOAD(sa, 0);
    ATTN_WRITE(sa, 0);
    if (1 < nst) ATTN_LOAD(sb, 1);
    __syncthreads();
    bf16x8 qf[2];
    f32x4 o[4];
    float mrun = -1e30f, lrun = 0.f;
    const float* exth = ext;
    auto attn_compute = [&](const int st) {
      const int rd = st / nch, jc = jc0 + st - rd * nch, h = 2 * rd + hh;
      if (jc == jc0) {
#pragma unroll
        for (int ds = 0; ds < 2; ++ds) qf[ds] = *(const bf16x8*)(PROJ + (size_t)(t0 + iq) * INCP + C_QA + h * 64 + ds * 32 + fq * 8);
#pragma unroll
        for (int et = 0; et < 4; ++et) o[et] = (f32x4){0.f, 0.f, 0.f, 0.f};
        mrun = -1e30f; lrun = 0.f;
        exth = ext + h * 640 + 63 + 512 + iq - 8 * fq;
      }
      const unsigned char* kb = stg + (st & 1) * 32768 + hh * 8192;
      const unsigned char* vb = stg + (st & 1) * 32768 + (2 + hh) * 8192;
      float sc[2][2][4];
      bf16x8 kfr[2][2][2], vfr[2][4]; float bia[2][2][4];
#pragma unroll
      for (int g = 0; g < 2; ++g)
#pragma unroll
        for (int tt = 0; tt < 2; ++tt) {
          const int key = 32 * g + 8 * (fr >> 2) + (fr & 3) + 4 * tt, fk = attn_fk(key);
          kfr[g][tt][0] = *(const bf16x8*)(kb + key * 128 + ((fq ^ fk) << 4));
          kfr[g][tt][1] = *(const bf16x8*)(kb + key * 128 + (((4 + fq) ^ fk) << 4));
        }
#pragma unroll
      for (int g = 0; g < 2; ++g)
#pragma unroll
        for (int tt = 0; tt < 2; ++tt)
#pragma unroll
          for (int j = 0; j < 4; ++j) bia[g][tt][j] = exth[-(64 * jc + 32 * g + 4 * tt + j)];
#pragma unroll
      for (int g = 0; g < 2; ++g)
#pragma unroll
        for (int et = 0; et < 4; ++et) { const int er = 16 * et + fr; vfr[g][et] = *(const bf16x8*)(vb + er * 128 + (((4 * g + fq) ^ attn_fv(er)) << 4)); }
      __builtin_amdgcn_sched_barrier(0);
#pragma unroll
      for (int g = 0; g < 2; ++g)
#pragma unroll
        for (int tt = 0; tt < 2; ++tt) {
          f32x4 s4 = __builtin_amdgcn_mfma_f32_16x16x32_bf16(kfr[g][tt][0], qf[0], (f32x4){0.f, 0.f, 0.f, 0.f}, 0, 0, 0);
          s4 = __builtin_amdgcn_mfma_f32_16x16x32_bf16(kfr[g][tt][1], qf[1], s4, 0, 0, 0);
#pragma unroll
          for (int j = 0; j < 4; ++j) sc[g][tt][j] = s4[j] * (0.125f * LOG2E) + bia[g][tt][j];
        }
      float mloc = -1e30f;
#pragma unroll
      for (int g = 0; g < 2; ++g)
#pragma unroll
        for (int tt = 0; tt < 2; ++tt)
#pragma unroll
          for (int j = 0; j < 4; ++j) mloc = fmaxf(mloc, sc[g][tt][j]);
      mloc = fmaxf(mloc, __shfl_xor(mloc, 16)); mloc = fmaxf(mloc, __shfl_xor(mloc, 32));
      const float mnew = fmaxf(mrun, mloc), alpha = __builtin_amdgcn_exp2f(mrun - mnew);
      mrun = mnew;
      float ls = 0.f;
#pragma unroll
      for (int g = 0; g < 2; ++g)
#pragma unroll
        for (int tt = 0; tt < 2; ++tt)
#pragma unroll
          for (int j = 0; j < 4; ++j) { const float e = __builtin_amdgcn_exp2f(sc[g][tt][j] - mnew); sc[g][tt][j] = e; ls += e; }
      lrun = lrun * alpha + ls;
#pragma unroll
      for (int et = 0; et < 4; ++et) { o[et].x *= alpha; o[et].y *= alpha; o[et].z *= alpha; o[et].w *= alpha; }
#pragma unroll
      for (int g = 0; g < 2; ++g) {
        union { bf16x8 v; unsigned u[4]; } pf;
        pf.u[0] = pk2(sc[g][0][0], sc[g][0][1]); pf.u[1] = pk2(sc[g][0][2], sc[g][0][3]);
        pf.u[2] = pk2(sc[g][1][0], sc[g][1][1]); pf.u[3] = pk2(sc[g][1][2], sc[g][1][3]);
#pragma unroll
        for (int et = 0; et < 4; ++et) o[et] = __builtin_amdgcn_mfma_f32_16x16x32_bf16(vfr[g][et], pf.v, o[et], 0, 0, 0);
      }
      if (jc == 8) {
        float lt = lrun + __shfl_xor(lrun, 16); lt += __shfl_xor(lt, 32);
        const float inv = 1.f / lt;
#pragma unroll
        for (int et = 0; et < 4; ++et) {
          f32x4 v = o[et]; v.x *= inv; v.y *= inv; v.z *= inv; v.w *= inv;
          { uint2 ov; ov.x = pk2(v.x, v.y); ov.y = pk2(v.z, v.w); *(uint2*)(ATT + (size_t)(t0 + iq) * 384 + h * 64 + et * 16 + fq * 4) = ov; }
        }
      }
    };
#pragma unroll 1
    for (int st0 = 0; st0 < nst; st0 += 2) {
      { const int st = st0;
        if (st + 2 < nst) ATTN_LOAD(sa, st + 2);
        attn_compute(st);
        if (st + 1 < nst) ATTN_WRITE(sb, (st + 1) & 1);
        __syncthreads(); }
      if (st0 + 1 < nst) { const int st = st0 + 1;
        if (st + 2 < nst) ATTN_LOAD(sb, st + 2);
        attn_compute(st);
        if (st + 1 < nst) ATTN_WRITE(sa, (st + 1) & 1);
        __syncthreads(); }
    }
#undef ATTN_LOAD
#undef ATTN_WRITE
  }
  __syncthreads();
}

__device__ __forceinline__ void ssm_bu32(const bf16_t* __restrict__ bbh_g, const bf16_t* __restrict__ urow, int lane,
                                         f32x16& lo_re, f32x16& hi_re, f32x16& lo_im, f32x16& hi_im) {
  const int hf = lane >> 5;
  const bf16x8 ub = *(const bf16x8*)(urow + 8 * hf);
  f32x16 z;
#pragma unroll
  for (int r = 0; r < 16; ++r) z[r] = 0.f;
  const bf16x8 a0r = *(const bf16x8*)(bbh_g + (size_t)(0 * 64 + lane) * 8), a1r = *(const bf16x8*)(bbh_g + (size_t)(1 * 64 + lane) * 8);
  const bf16x8 a0i = *(const bf16x8*)(bbh_g + (size_t)(2 * 64 + lane) * 8), a1i = *(const bf16x8*)(bbh_g + (size_t)(3 * 64 + lane) * 8);
  lo_re = __builtin_amdgcn_mfma_f32_32x32x16_bf16(ub, a0r, z, 0, 0, 0); hi_re = __builtin_amdgcn_mfma_f32_32x32x16_bf16(ub, a1r, z, 0, 0, 0);
  lo_im = __builtin_amdgcn_mfma_f32_32x32x16_bf16(ub, a0i, z, 0, 0, 0); hi_im = __builtin_amdgcn_mfma_f32_32x32x16_bf16(ub, a1i, z, 0, 0, 0);
#pragma unroll
  for (int r = 0; r < 16; ++r) {
    const auto s1 = __builtin_amdgcn_permlane32_swap(__float_as_uint(lo_re[r]), __float_as_uint(hi_re[r]), false, false);
    lo_re[r] = __uint_as_float(s1[0]); hi_re[r] = __uint_as_float(s1[1]);
    const auto s2 = __builtin_amdgcn_permlane32_swap(__float_as_uint(lo_im[r]), __float_as_uint(hi_im[r]), false, false);
    lo_im[r] = __uint_as_float(s2[0]); hi_im[r] = __uint_as_float(s2[1]);
  }
}
__device__ __forceinline__ void rotary_frag(const bf16x8 x0, const bf16x8 x1, const float* RC, const float* RS, int pos, int fq, float scale, bf16x8& o0, bf16x8& o1) {
  const f32x4 c0 = *(const f32x4*)(RC + pos * 32 + 8 * fq), c1 = *(const f32x4*)(RC + pos * 32 + 8 * fq + 4);
  const f32x4 s0 = *(const f32x4*)(RS + pos * 32 + 8 * fq), s1 = *(const f32x4*)(RS + pos * 32 + 8 * fq + 4);
  const float cc[8] = {c0.x, c0.y, c0.z, c0.w, c1.x, c1.y, c1.z, c1.w}, sn[8] = {s0.x, s0.y, s0.z, s0.w, s1.x, s1.y, s1.z, s1.w};
  union { bf16x8 v; unsigned u[4]; } r0, r1;
#pragma unroll
  for (int q = 0; q < 4; ++q) {
    const float a0 = bf2f((bf16_t)x0[2 * q]) * scale, a1 = bf2f((bf16_t)x0[2 * q + 1]) * scale, b0 = bf2f((bf16_t)x1[2 * q]) * scale, b1 = bf2f((bf16_t)x1[2 * q + 1]) * scale;
    r0.u[q] = pk2(a0 * cc[2 * q] - b0 * sn[2 * q], a1 * cc[2 * q + 1] - b1 * sn[2 * q + 1]);
    r1.u[q] = pk2(a0 * sn[2 * q] + b0 * cc[2 * q], a1 * sn[2 * q + 1] + b1 * cc[2 * q + 1]);
  }
  o0 = r0.v; o1 = r1.v;
}
__device__ void mix_local_phase(const Params& p, int l, unsigned char* smem) {
  const CParamsP pp = launder_kargs();
  GAS unsigned char* const ws = launder_ptr(pp->ws); const int tidx = launder_tid();
  const bf16_t* PROJ = (const bf16_t*)(ws + WS_PROJ); const bf16_t* VTR = (const bf16_t*)(ws + WS_VTR);
  const float* RC = (const float*)(ws + WS_ROTC); const float* RS = (const float*)(ws + WS_ROTS);
  bf16_t* YINT = (bf16_t*)(ws + WS_YINT); float* UPDT = (float*)(ws + WS_UPD);
  const float* SA = (const float*)(ws + WS_SA) + (size_t)l * 16 * 64 * 2; const bf16_t* BBH = (const bf16_t*)(ws + WS_BBH) + (size_t)l * 16 * 2 * 64 * 16;
  float* SEND = (float*)(ws + WS_SEND);
  const int tid = tidx, lane = tid & 63, wid = tid >> 6, fr = lane & 15, fq = lane >> 4;
  bf16_t* KT = (bf16_t*)smem;
  float* rcL = (float*)(smem + 55296); float* rsL = rcL + 2048;
  for (int it_ = blockIdx.x; it_ < 256; it_ += gridDim.x) {
    const int item = ((it_ & 7) << 5) | (it_ >> 3);
    const int b = item >> 7, n = item & 127, t0 = b * 8192 + n * 64;
    __syncthreads();
#pragma unroll
    for (int i = 0; i < 4; ++i) { rcL[tid + NT * i] = RC[n * 2048 + tid + NT * i]; rsL[tid + NT * i] = RS[n * 2048 + tid + NT * i]; }
    __syncthreads();
#pragma unroll 1
    for (int k3 = 0; k3 < 3; ++k3) {
      const int task = wid * 3 + k3, h = task >> 2, tb = task & 3;
      const int i = 16 * tb + fr;
      const float lg2 = log2f(1.f - exp2f(-5.f - (float)h));
      bf16x8 qraw[2], kraw[2][2][2], vraw[2][4];
      {
        const bf16_t* qp = PROJ + (size_t)(t0 + i) * INCP + C_QR + h * 64 + 8 * fq;
        qraw[0] = *(const bf16x8*)qp; qraw[1] = *(const bf16x8*)(qp + 32);
#pragma unroll
        for (int g = 0; g < 2; ++g) {
#pragma unroll
          for (int tt = 0; tt < 2; ++tt) {
            const int key = 32 * g + 8 * (fr >> 2) + (fr & 3) + 4 * tt;
            const bf16_t* kp = PROJ + (size_t)(t0 + key) * INCP + C_KR + h * 64 + 8 * fq;
            kraw[g][tt][0] = *(const bf16x8*)kp; kraw[g][tt][1] = *(const bf16x8*)(kp + 32);
          }
#pragma unroll
          for (int et = 0; et < 4; ++et) vraw[g][et] = *(const bf16x8*)(VTR + ((size_t)b * 384 + h * 64 + et * 16 + fr) * 8192 + n * 64 + 32 * g + 8 * fq);
        }
      }
      __builtin_amdgcn_sched_barrier(0);
      bf16x8 qf0, qf1;
      rotary_frag(qraw[0], qraw[1], rcL, rsL, i, fq, 1.f, qf0, qf1);
      f32x4 o[4];
#pragma unroll
      for (int et = 0; et < 4; ++et) o[et] = (f32x4){0.f, 0.f, 0.f, 0.f};
#pragma unroll
      for (int g = 0; g < 2; ++g) {
        float st[2][4];
#pragma unroll
        for (int tt = 0; tt < 2; ++tt) {
          const int key = 32 * g + 8 * (fr >> 2) + (fr & 3) + 4 * tt;
          bf16x8 kf0, kf1;
          rotary_frag(kraw[g][tt][0], kraw[g][tt][1], rcL, rsL, key, fq, 0.125f, kf0, kf1);
          f32x4 s4 = __builtin_amdgcn_mfma_f32_16x16x32_bf16(kf0, qf0, (f32x4){0.f, 0.f, 0.f, 0.f}, 0, 0, 0);
          s4 = __builtin_amdgcn_mfma_f32_16x16x32_bf16(kf1, qf1, s4, 0, 0, 0);
#pragma unroll
          for (int j = 0; j < 4; ++j) {
            const int kk = 32 * g + 8 * fq + 4 * tt + j;
            const int dij = i > kk ? i - kk : kk - i;
            st[tt][j] = s4[j] * exp2f(lg2 * (float)dij);
          }
          if (tb == 0) {
            const float kd = exp2f(lg2 * (float)(63 - key));
#pragma unroll
            for (int jj = 0; jj < 8; ++jj) {
              KT[(h * 64 + 8 * fq + jj) * 72 + key] = f2bf(bf2f((bf16_t)kf0[jj]) * kd);
              KT[(h * 64 + 32 + 8 * fq + jj) * 72 + key] = f2bf(bf2f((bf16_t)kf1[jj]) * kd);
            }
          }
        }
        union { bf16x8 v; unsigned u[4]; } pf;
        pf.u[0] = pk2(st[0][0], st[0][1]); pf.u[1] = pk2(st[0][2], st[0][3]); pf.u[2] = pk2(st[1][0], st[1][1]); pf.u[3] = pk2(st[1][2], st[1][3]);
#pragma unroll
        for (int et = 0; et < 4; ++et) o[et] = __builtin_amdgcn_mfma_f32_16x16x32_bf16(vraw[g][et], pf.v, o[et], 0, 0, 0);
      }
#pragma unroll
      for (int et = 0; et < 4; ++et) { uint2 ov; ov.x = pk2(o[et].x, o[et].y); ov.y = pk2(o[et].z, o[et].w); *(uint2*)(YINT + (((((size_t)item * 6 + h) * 4 + tb) * 4 + et) * 64 + lane) * 4) = ov; }
    }
    __syncthreads();
#pragma unroll 1
    for (int k3 = 0; k3 < 3; ++k3) {
      const int task = wid * 3 + k3, h = task >> 2, et = task & 3;
      f32x4 acc[4];
#pragma unroll
      for (int dt = 0; dt < 4; ++dt) acc[dt] = (f32x4){0.f, 0.f, 0.f, 0.f};
#pragma unroll
      for (int g = 0; g < 2; ++g) {
        const bf16x8 vf = *(const bf16x8*)(VTR + ((size_t)b * 384 + h * 64 + et * 16 + fr) * 8192 + n * 64 + 32 * g + 8 * fq);
#pragma unroll
        for (int dt = 0; dt < 4; ++dt) {
          const bf16x8 kt = *(const bf16x8*)(KT + (h * 64 + 16 * dt + fr) * 72 + 32 * g + 8 * fq);
          acc[dt] = __builtin_amdgcn_mfma_f32_16x16x32_bf16(kt, vf, acc[dt], 0, 0, 0);
        }
      }
#pragma unroll
      for (int dt = 0; dt < 4; ++dt) *(f32x4*)(UPDT + (((size_t)item * 6 + h) * 64 + 16 * et + fr) * 64 + 16 * dt + 4 * fq) = acc[dt];
    }
#pragma unroll 1
    for (int gi = 0; gi < 2; ++gi) {
      const int g = wid * 2 + gi;
      const float are = SA[(g * 64 + lane) * 2], aim = SA[(g * 64 + lane) * 2 + 1];
      float xr = 0.f, xi = 0.f;
#pragma unroll 1
      for (int blk = 0; blk < 2; ++blk) {
        f32x16 lr, hr, li, hi;
        ssm_bu32(BBH + (size_t)g * 2 * 64 * 16, PROJ + (size_t)(t0 + 32 * blk + (lane & 31)) * INCP + C_US + g * 16, lane, lr, hr, li, hi);
#pragma unroll
        for (int a4 = 0; a4 < 4; ++a4) {
#pragma unroll
          for (int bq = 0; bq < 4; ++bq) { const float nr = are * xr - aim * xi + lr[4 * a4 + bq], ni = are * xi + aim * xr + li[4 * a4 + bq]; xr = nr; xi = ni; }
#pragma unroll
          for (int bq = 0; bq < 4; ++bq) { const float nr = are * xr - aim * xi + hr[4 * a4 + bq], ni = are * xi + aim * xr + hi[4 * a4 + bq]; xr = nr; xi = ni; }
        }
      }
      SEND[(((size_t)item * 16 + g) * 64 + lane) * 2] = xr; SEND[(((size_t)item * 16 + g) * 64 + lane) * 2 + 1] = xi;
    }
  }
}

__device__ void scan_phase(const Params& p, int l) {
  const CParamsP pp = launder_kargs();
  GAS unsigned char* const ws = launder_ptr(pp->ws); const int tidx = launder_tid();
  const float* __restrict__ UPDT = (const float*)(ws + WS_UPD); bf16_t* __restrict__ SPT = (bf16_t*)(ws + WS_SPT);
  const float* __restrict__ SEND = (const float*)(ws + WS_SEND); float* __restrict__ CARRY = (float*)(ws + WS_CARRY);
  const float* SA = (const float*)(ws + WS_SA) + (size_t)l * 16 * 64 * 2;
  const int gtid = blockIdx.x * NT + tidx, gn = gridDim.x * NT;
  for (int idx = gtid; idx < 2 * 6 * 4096 + 2 * 1024; idx += gn) {
    if (idx < 2 * 6 * 4096) {
      const int b = idx / (6 * 4096), r = idx % (6 * 4096), h = r >> 12;
      const float cd = exp2f(64.f * log2f(1.f - exp2f(-5.f - (float)h)));
      const int e_ = (r >> 6) & 63, d_ = r & 63;
      const int spoff = h * 4096 + ((((e_ >> 4) * 2 + (d_ >> 5)) * 64 + ((d_ >> 3) & 3) * 16 + (e_ & 15)) * 8 + (d_ & 7));
      float s = 0.f;
#pragma unroll 1
      for (int nb = 0; nb < NCH; nb += 16) {
        float v[16];
#pragma unroll
        for (int j = 0; j < 16; ++j) v[j] = UPDT[((size_t)(b * NCH + nb + j)) * 6 * 4096 + r];
#pragma unroll
        for (int j = 0; j < 16; ++j) { SPT[((size_t)(b * NCH + nb + j)) * 6 * 4096 + spoff] = f2bf(s); s = cd * s + v[j]; }
      }
    } else {
      const int r2 = idx - 2 * 6 * 4096, b = r2 >> 10, gp = r2 & 1023;
      float ar = SA[gp * 2], ai = SA[gp * 2 + 1];
#pragma unroll
      for (int q = 0; q < 6; ++q) { const float nr = ar * ar - ai * ai, ni = 2.f * ar * ai; ar = nr; ai = ni; }
      float xr = 0.f, xi = 0.f;
#pragma unroll 1
      for (int nb = 0; nb < NCH; nb += 16) {
        float2 v[16];
#pragma unroll
        for (int j = 0; j < 16; ++j) v[j] = *(const float2*)(SEND + (((size_t)(b * NCH + nb + j)) * 1024 + gp) * 2);
#pragma unroll
        for (int j = 0; j < 16; ++j) {
          *(float2*)(CARRY + (((size_t)(b * NCH + nb + j)) * 1024 + gp) * 2) = make_float2(xr, xi);
          const float nr = ar * xr - ai * xi + v[j].x, ni = ar * xi + ai * xr + v[j].y;
          xr = nr; xi = ni;
        }
      }
    }
  }
  if (l + 1 < DEPTH_) convert_tables_fp4(pp, ws, l + 1, gtid, gn);
}

__device__ void mix_final_phase(const Params& p, int l, unsigned char* smem) {
  const CParamsP pp = launder_kargs();
  GAS unsigned char* const ws = launder_ptr(pp->ws); const int tidx = launder_tid();
  const bf16_t* PROJ = (const bf16_t*)(ws + WS_PROJ);
  const float* RC = (const float*)(ws + WS_ROTC); const float* RS = (const float*)(ws + WS_ROTS);
  const bf16_t* YINT = (const bf16_t*)(ws + WS_YINT); const bf16_t* SPT = (const bf16_t*)(ws + WS_SPT);
  const bf16_t* ATT = (const bf16_t*)(ws + WS_ATT);
  const float* SA = (const float*)(ws + WS_SA) + (size_t)l * 16 * 64 * 2; const bf16_t* BBH = (const bf16_t*)(ws + WS_BBH) + (size_t)l * 16 * 2 * 64 * 16;
  const float* CARRY = (const float*)(ws + WS_CARRY);
  const bf16_t* CB = (const bf16_t*)(ws + WS_CB) + (size_t)l * 16 * 16 * 128; const bf16_t* WG = (const bf16_t*)(ws + WS_WGLUT) + (size_t)l * 512 * 256;
  const float* dsk = gin(pp->in[I_SSMD]) + (size_t)l * 256;
  const float* mg = gin(pp->in[I_MGAIN]) + (size_t)l * 1024;
  bf16_t* MRG = (bf16_t*)(ws + WS_ABUF);
  const int tid = tidx, lane = tid & 63, wid = tid >> 6, fr = lane & 15, fq = lane >> 4;
  bf16_t* YS = (bf16_t*)smem;
  float* red = (float*)(smem + 33792);
  bf16_t* XB = (bf16_t*)(smem + 36864 + wid * 8448 + 4096);
  float* rcL = (float*)(smem + 104448); float* rsL = rcL + 2048;
  for (int it_ = blockIdx.x; it_ < 256; it_ += gridDim.x) {
    const int item = ((it_ & 7) << 5) | (it_ >> 3);
    const int b = item >> 7, n = item & 127, t0 = b * 8192 + n * 64;
    __syncthreads();
#pragma unroll
    for (int i = 0; i < 4; ++i) { rcL[tid + NT * i] = RC[n * 2048 + tid + NT * i]; rsL[tid + NT * i] = RS[n * 2048 + tid + NT * i]; }
    __syncthreads();
    {
      float av[8][6], mgl[6];
#pragma unroll
      for (int ii = 0; ii < 8; ++ii)
#pragma unroll
        for (int j = 0; j < 6; ++j) av[ii][j] = bf2f(ATT[(size_t)(t0 + wid * 8 + ii) * 384 + lane + 64 * j]);
#pragma unroll
      for (int j = 0; j < 6; ++j) mgl[j] = mg[lane + 64 * j];
      __builtin_amdgcn_sched_barrier(0);
#pragma unroll
      for (int ii = 0; ii < 8; ++ii) {
        const int t = t0 + wid * 8 + ii;
        float sq = 0.f;
#pragma unroll
        for (int j = 0; j < 6; ++j) sq += av[ii][j] * av[ii][j];
        const float rstd = rsqrtf(wave_sum(sq) * (1.f / 384.f) + EPS_);
#pragma unroll
        for (int j = 0; j < 6; ++j) MRG[(size_t)t * 1024 + lane + 64 * j] = f2bf(av[ii][j] * rstd * mgl[j]);
      }
    }
#pragma unroll 1
    for (int k3 = 0; k3 < 3; ++k3) {
      const int task = wid * 3 + k3, h = task >> 2, tb = task & 3;
      const int i = 16 * tb + fr, t = t0 + i;
      const float lg2 = log2f(1.f - exp2f(-5.f - (float)h));
      bf16x8 qraw[2], spf[4][2]; f32x4 yiv[4], mgq[4]; uint2 grv[4];
      {
        const bf16_t* qp = PROJ + (size_t)t * INCP + C_QR + h * 64 + 8 * fq;
        qraw[0] = *(const bf16x8*)qp; qraw[1] = *(const bf16x8*)(qp + 32);
#pragma unroll
        for (int et = 0; et < 4; ++et) {
          const bf16_t* sp = SPT + ((size_t)item * 6 + h) * 4096 + (size_t)(et * 2) * 512 + lane * 8;
          spf[et][0] = *(const bf16x8*)sp; spf[et][1] = *(const bf16x8*)(sp + 512);
          { const uint2 yr = *(const uint2*)(YINT + (((((size_t)item * 6 + h) * 4 + tb) * 4 + et) * 64 + lane) * 4); yiv[et] = (f32x4){__uint_as_float(yr.x << 16), __uint_as_float(yr.x & 0xffff0000u), __uint_as_float(yr.y << 16), __uint_as_float(yr.y & 0xffff0000u)}; }
          grv[et] = *(const uint2*)(PROJ + (size_t)t * INCP + C_GR + h * 64 + 16 * et + 4 * fq);
          mgq[et] = *(const f32x4*)(mg + 384 + h * 64 + 16 * et + 4 * fq);
        }
      }
      __builtin_amdgcn_sched_barrier(0);
      bf16x8 qf0, qf1;
      rotary_frag(qraw[0], qraw[1], rcL, rsL, i, fq, 1.f, qf0, qf1);
      f32x4 o[4];
#pragma unroll
      for (int et = 0; et < 4; ++et) {
        o[et] = __builtin_amdgcn_mfma_f32_16x16x32_bf16(spf[et][0], qf0, (f32x4){0.f, 0.f, 0.f, 0.f}, 0, 0, 0);
        o[et] = __builtin_amdgcn_mfma_f32_16x16x32_bf16(spf[et][1], qf1, o[et], 0, 0, 0);
      }
      const float qd = exp2f(lg2 * (float)(i + 1));
      float y[16]; float s1 = 0.f;
#pragma unroll
      for (int et = 0; et < 4; ++et) {
        const f32x4 yi = yiv[et];
        y[4 * et] = yi.x + qd * o[et].x; y[4 * et + 1] = yi.y + qd * o[et].y; y[4 * et + 2] = yi.z + qd * o[et].z; y[4 * et + 3] = yi.w + qd * o[et].w;
        s1 += (y[4 * et] + y[4 * et + 1]) + (y[4 * et + 2] + y[4 * et + 3]);
      }
      s1 += __shfl_xor(s1, 16); s1 += __shfl_xor(s1, 32);
      const float mu = s1 * (1.f / 64.f);
      float s2 = 0.f;
#pragma unroll
      for (int q = 0; q < 16; ++q) { y[q] -= mu; s2 += y[q] * y[q]; }
      s2 += __shfl_xor(s2, 16); s2 += __shfl_xor(s2, 32);
      const float rstd = rsqrtf(s2 * (1.f / 64.f) + EPS_);
#pragma unroll
      for (int et = 0; et < 4; ++et) {
        const int c = h * 64 + 16 * et + 4 * fq;
        const uint2 gr = grv[et];
        const float g0 = __uint_as_float(gr.x << 16), g1 = __uint_as_float(gr.x & 0xffff0000u), g2 = __uint_as_float(gr.y << 16), g3 = __uint_as_float(gr.y & 0xffff0000u);
        const f32x4 mgv = mgq[et];
        uint2 ov;
        ov.x = pk2(y[4 * et] * rstd * (g0 * sigmoid_f(g0)) * mgv.x, y[4 * et + 1] * rstd * (g1 * sigmoid_f(g1)) * mgv.y);
        ov.y = pk2(y[4 * et + 2] * rstd * (g2 * sigmoid_f(g2)) * mgv.z, y[4 * et + 3] * rstd * (g3 * sigmoid_f(g3)) * mgv.w);
        *(uint2*)(MRG + (size_t)t * 1024 + 384 + c) = ov;
      }
    }
#pragma unroll 1
    for (int gi = 0; gi < 2; ++gi) {
      const int g = wid * 2 + gi;
      const float are = SA[(g * 64 + lane) * 2], aim = SA[(g * 64 + lane) * 2 + 1];
      float xr = CARRY[(((size_t)item * 16 + g) * 64 + lane) * 2], xi = CARRY[(((size_t)item * 16 + g) * 64 + lane) * 2 + 1];
      bf16x8 cb[4];
#pragma unroll
      for (int ks = 0; ks < 4; ++ks) cb[ks] = *(const bf16x8*)(CB + (((size_t)g * 4 + ks) * 64 + lane) * 8);
      const float dv = dsk[g * 16 + fr];
#pragma unroll 1
      for (int blk = 0; blk < 2; ++blk) {
        f32x16 lr, hr, li, hi;
        bf16_t uraw[2][4];
#pragma unroll
        for (int half = 0; half < 2; ++half)
#pragma unroll
          for (int j = 0; j < 4; ++j) uraw[half][j] = PROJ[(size_t)(t0 + 32 * blk + 16 * half + 4 * fq + j) * INCP + C_US + g * 16 + fr];
        ssm_bu32(BBH + (size_t)g * 2 * 64 * 16, PROJ + (size_t)(t0 + 32 * blk + (lane & 31)) * INCP + C_US + g * 16, lane, lr, hr, li, hi);
#pragma unroll
        for (int half = 0; half < 2; ++half) {
#pragma unroll
          for (int a2 = 0; a2 < 2; ++a2) {
            const int a4 = 2 * half + a2;
#pragma unroll
            for (int bq = 0; bq < 4; ++bq) {
              const float nr = are * xr - aim * xi + lr[4 * a4 + bq], ni = are * xi + aim * xr + li[4 * a4 + bq]; xr = nr; xi = ni;
              XB[(8 * a2 + bq) * 136 + lane] = f2bf(xr); XB[(8 * a2 + bq) * 136 + 64 + lane] = f2bf(xi);
            }
#pragma unroll
            for (int bq = 0; bq < 4; ++bq) {
              const float nr = are * xr - aim * xi + hr[4 * a4 + bq], ni = are * xi + aim * xr + hi[4 * a4 + bq]; xr = nr; xi = ni;
              XB[(8 * a2 + 4 + bq) * 136 + lane] = f2bf(xr); XB[(8 * a2 + 4 + bq) * 136 + 64 + lane] = f2bf(xi);
            }
          }
          f32x4 acc = (f32x4){0.f, 0.f, 0.f, 0.f};
#pragma unroll
          for (int ks = 0; ks < 4; ++ks) {
            const bf16x8 af = *(const bf16x8*)(XB + fr * 136 + 32 * ks + 8 * fq);
            acc = __builtin_amdgcn_mfma_f32_16x16x32_bf16(af, cb[ks], acc, 0, 0, 0);
          }
#pragma unroll
          for (int j = 0; j < 4; ++j) {
            const int i = 32 * blk + 16 * half + 4 * fq + j;
            const float yv = acc[j] + dv * bf2f(uraw[half][j]);
            YS[i * 264 + g * 16 + fr] = f2bf(gelu_tanh(yv));
          }
        }
      }
    }
    __syncthreads();
    {
      const int n0 = 32 * wid;
      f32x4 a1[4][2], a2[4][2];
#pragma unroll
      for (int mt = 0; mt < 4; ++mt)
#pragma unroll
        for (int nt = 0; nt < 2; ++nt) { a1[mt][nt] = (f32x4){0.f, 0.f, 0.f, 0.f}; a2[mt][nt] = (f32x4){0.f, 0.f, 0.f, 0.f}; }
#pragma unroll 1
      for (int kh = 0; kh < 2; ++kh) {
        bf16x8 w1[4][2], w2[4][2];
#pragma unroll
        for (int k4 = 0; k4 < 4; ++k4)
#pragma unroll
          for (int nt = 0; nt < 2; ++nt) {
            w1[k4][nt] = *(const bf16x8*)(WG + ((((size_t)wid * 8 + 4 * kh + k4) * 2 + 0) * 2 + nt) * 512 + lane * 8);
            w2[k4][nt] = *(const bf16x8*)(WG + ((((size_t)wid * 8 + 4 * kh + k4) * 2 + 1) * 2 + nt) * 512 + lane * 8);
          }
        __builtin_amdgcn_sched_barrier(0);
#pragma unroll
        for (int k4 = 0; k4 < 4; ++k4) {
          const int ks = 4 * kh + k4;
          bf16x8 yb[4];
#pragma unroll
          for (int mt = 0; mt < 4; ++mt) yb[mt] = *(const bf16x8*)(YS + (16 * mt + fr) * 264 + 32 * ks + 8 * fq);
#pragma unroll
          for (int mt = 0; mt < 4; ++mt)
#pragma unroll
            for (int nt = 0; nt < 2; ++nt) {
              a1[mt][nt] = __builtin_amdgcn_mfma_f32_16x16x32_bf16(w1[k4][nt], yb[mt], a1[mt][nt], 0, 0, 0);
              a2[mt][nt] = __builtin_amdgcn_mfma_f32_16x16x32_bf16(w2[k4][nt], yb[mt], a2[mt][nt], 0, 0, 0);
            }
        }
      }
#pragma unroll
      for (int mt = 0; mt < 4; ++mt) {
        float sq = 0.f;
#pragma unroll
        for (int nt = 0; nt < 2; ++nt) {
          f32x4 z = a1[mt][nt]; const f32x4 zg = a2[mt][nt];
          z.x *= sigmoid_f(zg.x); z.y *= sigmoid_f(zg.y); z.z *= sigmoid_f(zg.z); z.w *= sigmoid_f(zg.w);
          a1[mt][nt] = z; sq += z.x * z.x + z.y * z.y + z.z * z.z + z.w * z.w;
        }
        sq += __shfl_xor(sq, 16); sq += __shfl_xor(sq, 32);
        if (fq == 0) red[wid * 64 + 16 * mt + fr] = sq;
      }
      __syncthreads();
#pragma unroll
      for (int mt = 0; mt < 4; ++mt) {
        const int i = 16 * mt + fr, t = t0 + i;
        float tot = 0.f;
#pragma unroll
        for (int w8 = 0; w8 < 8; ++w8) tot += red[w8 * 64 + i];
        const float rstd = rsqrtf(tot * (1.f / 256.f) + EPS_);
#pragma unroll
        for (int nt = 0; nt < 2; ++nt) {
          const int c = n0 + 16 * nt + 4 * fq;
          const f32x4 mgv = *(const f32x4*)(mg + 768 + c); const f32x4 z = a1[mt][nt];
          uint2 ov; ov.x = pk2(z.x * rstd * mgv.x, z.y * rstd * mgv.y); ov.y = pk2(z.z * rstd * mgv.z, z.w * rstd * mgv.w);
          *(uint2*)(MRG + (size_t)t * 1024 + 768 + c) = ov;
        }
      }
    }
  }
}

typedef float f32x2 __attribute__((ext_vector_type(2)));
__device__ __forceinline__ float dot16_fp4(const uint2 u, const f32x2 (&hv)[8]) {
  f32x2 d = __builtin_amdgcn_cvt_scalef32_pk_f32_fp4(u.x, 1.0f, 0) * hv[0];
  d += __builtin_amdgcn_cvt_scalef32_pk_f32_fp4(u.x, 1.0f, 1) * hv[1];
  d += __builtin_amdgcn_cvt_scalef32_pk_f32_fp4(u.x, 1.0f, 2) * hv[2];
  d += __builtin_amdgcn_cvt_scalef32_pk_f32_fp4(u.x, 1.0f, 3) * hv[3];
  d += __builtin_amdgcn_cvt_scalef32_pk_f32_fp4(u.y, 1.0f, 0) * hv[4];
  d += __builtin_amdgcn_cvt_scalef32_pk_f32_fp4(u.y, 1.0f, 1) * hv[5];
  d += __builtin_amdgcn_cvt_scalef32_pk_f32_fp4(u.y, 1.0f, 2) * hv[6];
  d += __builtin_amdgcn_cvt_scalef32_pk_f32_fp4(u.y, 1.0f, 3) * hv[7];
  return d.x + d.y;
}
__device__ __forceinline__ void axpy16_fp4(const uint2 v, const float w, f32x2 (&acc)[8]) {
  const f32x2 w2 = (f32x2){w, w};
  acc[0] += w2 * __builtin_amdgcn_cvt_scalef32_pk_f32_fp4(v.x, 1.0f, 0);
  acc[1] += w2 * __builtin_amdgcn_cvt_scalef32_pk_f32_fp4(v.x, 1.0f, 1);
  acc[2] += w2 * __builtin_amdgcn_cvt_scalef32_pk_f32_fp4(v.x, 1.0f, 2);
  acc[3] += w2 * __builtin_amdgcn_cvt_scalef32_pk_f32_fp4(v.x, 1.0f, 3);
  acc[4] += w2 * __builtin_amdgcn_cvt_scalef32_pk_f32_fp4(v.y, 1.0f, 0);
  acc[5] += w2 * __builtin_amdgcn_cvt_scalef32_pk_f32_fp4(v.y, 1.0f, 1);
  acc[6] += w2 * __builtin_amdgcn_cvt_scalef32_pk_f32_fp4(v.y, 1.0f, 2);
  acc[7] += w2 * __builtin_amdgcn_cvt_scalef32_pk_f32_fp4(v.y, 1.0f, 3);
}
__device__ __forceinline__ float vmaxf(float a, float b) { float r; asm("v_max_f32 %0, %1, %2" : "=v"(r) : "v"(a), "v"(b)); return r; }
__device__ __forceinline__ float vminf(float a, float b) { float r; asm("v_min_f32 %0, %1, %2" : "=v"(r) : "v"(a), "v"(b)); return r; }
__device__ __forceinline__ void cx(float& hi, float& lo) { const float a = hi, b = lo; hi = vmaxf(a, b); lo = vminf(a, b); }
__device__ __forceinline__ void cx2(float& kh, int& ph, float& kl, int& pl) {
  const float a = kh, b = kl; const int pa = ph, pb = pl; const bool c = a >= b;
  kh = vmaxf(a, b); kl = vminf(a, b); ph = c ? pa : pb; pl = c ? pb : pa;
}
__device__ __forceinline__ void bitonic_sort16_desc(float (&v)[16]) {
#pragma unroll
  for (int k = 2; k <= 16; k <<= 1)
#pragma unroll
    for (int j = k >> 1; j > 0; j >>= 1)
#pragma unroll
      for (int i = 0; i < 16; ++i) {
        const int l = i ^ j;
        if (l > i) { if ((i & k) == 0) cx(v[i], v[l]); else cx(v[l], v[i]); }
      }
}
__device__ __forceinline__ void bitonic_merge16_desc(float (&v)[16]) {
#pragma unroll
  for (int j = 8; j > 0; j >>= 1)
#pragma unroll
    for (int i = 0; i < 16; ++i) { const int l = i ^ j; if (l > i) cx(v[i], v[l]); }
}
__device__ __forceinline__ void top16_merge(float (&a)[16], const float (&b)[16]) {
#pragma unroll
  for (int i = 0; i < 16; ++i) a[i] = vmaxf(a[i], b[15 - i]);
  bitonic_merge16_desc(a);
}
template <int M> __device__ __forceinline__ void top16_merge_chain(float (&k)[16], int (&q)[16], const float (&xk)[M], const int (&xq)[M]) {
#pragma unroll
  for (int i = 16 - M; i < 16; ++i) { const float a = k[i], b = xk[15 - i]; const bool c = a >= b; k[i] = vmaxf(a, b); q[i] = c ? q[i] : xq[15 - i]; }
#pragma unroll
  for (int j = 8; j > 0; j >>= 1)
#pragma unroll
    for (int i = 0; i < 16; ++i) { const int l = i ^ j; if (l > i) cx2(k[i], q[i], k[l], q[l]); }
}

__device__ void peer_phase(const Params& p, int l, bool last, unsigned char* smem) {
  const CParamsP pp = launder_kargs();
  GAS unsigned char* const ws = launder_ptr(pp->ws); const int tidx = launder_tid();
  bf16_t* HF = (bf16_t*)(ws + WS_ABUF); bf16_t* X = (bf16_t*)(ws + WS_X);
  const bf16_t* SC8 = (const bf16_t*)(ws + WS_SC);
  const uint2* U4 = (const uint2*)(ws + WS_PU8) + (size_t)l * 16384 * 64; const uint2* V4 = (const uint2*)(ws + WS_PV8) + (size_t)l * 16384 * 64;
  const float* g2 = (const float*)(ws + WS_MOD) + (size_t)l * 2 * 6144 + 5120;
  const bf16_t* XG = (const bf16_t*)(ws + WS_XG); const float* SSQ = (const float*)(ws + WS_SSQ); const float* sh2 = (const float*)(ws + WS_MOD) + (size_t)l * 2 * 6144 + 3072;
  const int ln = last ? l : l + 1;
  const float* nsh = (const float*)(ws + WS_MOD) + (size_t)ln * 2 * 6144; const float* nsc = nsh + 1024;
  const float* ngain = gin(pp->in[I_NMIX]) + (size_t)ln * 1024;
  const int lane = tidx & 63, wid = tidx >> 6;
  const int rL = ((lane >> 5) & 1) * 8 + ((lane >> 4) & 1) * 4 + ((lane >> 3) & 1) * 2 + ((lane >> 2) & 1);
  const bool hi5 = (lane & 32) != 0, hi4 = (lane & 16) != 0, hi3 = (lane & 8) != 0, hi2 = (lane & 4) != 0;
  int* idxL = (int*)smem;
  for (int it_ = blockIdx.x; it_ < T_ / 64; it_ += gridDim.x) {
    const int item = ((it_ & 7) << 5) | (it_ >> 3);
    const int t0 = item * 64;
    __syncthreads();
    {
      int lane_o = lane; asm volatile("" : "+v"(lane_o));
      const int tg = wid & 1, hp = wid >> 1, hf = lane_o >> 5, tl = 32 * tg + (lane_o & 31);
      float F[2][16];
#pragma unroll
      for (int sd = 0; sd < 2; ++sd) {
        float Lh[2][16];
#pragma unroll
        for (int hh = 0; hh < 2; ++hh) {
          const int hs = 2 * (2 * hp + hh) + sd;
          float top[16];
          const bf16_t* scp = SC8 + (((size_t)(hs * 16 + 8 * hf)) * T_ + (t0 + tl)) * 8;
          uint4 sv[8];
#pragma unroll
          for (int kq = 0; kq < 8; ++kq) sv[kq] = *(const uint4*)(scp + (size_t)kq * T_ * 8);
          __builtin_amdgcn_sched_barrier(0);
#pragma unroll
          for (int kt = 0; kt < 4; ++kt) {
            float g[16];
#pragma unroll
            for (int kq = 0; kq < 2; ++kq) {
              const uint4 v8 = sv[2 * kt + kq];
              const unsigned wv[4] = {v8.x, v8.y, v8.z, v8.w};
#pragma unroll
              for (int j = 0; j < 4; ++j) {
                const int key = 64 * hf + 16 * kt + 8 * kq + 2 * j;
                g[8 * kq + 2 * j] = __uint_as_float((wv[j] << 16) | (unsigned)key);
                g[8 * kq + 2 * j + 1] = __uint_as_float((wv[j] & 0xffff0000u) | (unsigned)(key + 1));
              }
            }
            bitonic_sort16_desc(g);
            if (kt == 0) {
#pragma unroll
              for (int r = 0; r < 16; ++r) top[r] = g[r];
            } else top16_merge(top, g);
            __builtin_amdgcn_sched_barrier(0);
          }
#pragma unroll
          for (int r = 0; r < 16; ++r) Lh[hh][r] = top[r];
          __builtin_amdgcn_sched_barrier(0);
        }
#pragma unroll
        for (int r = 0; r < 16; ++r) {
          const auto sw = __builtin_amdgcn_permlane32_swap(__float_as_uint(Lh[0][r]), __float_as_uint(Lh[1][r]), false, false);
          Lh[0][r] = __uint_as_float(sw[0]); Lh[1][r] = __uint_as_float(sw[1]);
        }
        top16_merge(Lh[0], Lh[1]);
#pragma unroll
        for (int r = 0; r < 16; ++r) F[sd][r] = Lh[0][r];
        __builtin_amdgcn_sched_barrier(0);
      }
      int ia[16], ib[16];
#pragma unroll
      for (int r = 0; r < 16; ++r) { ia[r] = (int)(__float_as_uint(F[0][r]) & 127u) << 7; ib[r] = (int)(__float_as_uint(F[1][r]) & 127u); }
      float k[16]; int q[16];
#pragma unroll
      for (int j = 0; j < 16; ++j) { k[j] = F[0][0] + F[1][j]; q[j] = ia[0] | ib[j]; }
      { float xk[8]; int xq[8];
#pragma unroll
        for (int j = 0; j < 8; ++j) { xk[j] = F[0][1] + F[1][j]; xq[j] = ia[1] | ib[j]; }
        top16_merge_chain<8>(k, q, xk, xq); }
      { float xk[5]; int xq[5];
#pragma unroll
        for (int j = 0; j < 5; ++j) { xk[j] = F[0][2] + F[1][j]; xq[j] = ia[2] | ib[j]; }
        top16_merge_chain<5>(k, q, xk, xq); }
      { float xk[4]; int xq[4];
#pragma unroll
        for (int j = 0; j < 4; ++j) { xk[j] = F[0][3] + F[1][j]; xq[j] = ia[3] | ib[j]; }
        top16_merge_chain<4>(k, q, xk, xq); }
      { float xk[3]; int xq[3];
#pragma unroll
        for (int j = 0; j < 3; ++j) { xk[j] = F[0][4] + F[1][j]; xq[j] = ia[4] | ib[j]; }
        top16_merge_chain<3>(k, q, xk, xq); }
      { float xk[11]; int xq[11];
#pragma unroll
        for (int i = 0; i < 11; ++i) { xk[i] = F[0][5 + i] + F[1][0]; xq[i] = ia[5 + i] | ib[0]; }
        top16_merge_chain<11>(k, q, xk, xq); }
      { float xk[3]; int xq[3];
#pragma unroll
        for (int i = 0; i < 3; ++i) { xk[i] = F[0][5 + i] + F[1][1]; xq[i] = ia[5 + i] | ib[1]; }
        top16_merge_chain<3>(k, q, xk, xq); }
      float e[16]; float es = 0.f;
#pragma unroll
      for (int i = 0; i < 16; ++i) { e[i] = __expf(k[i] - k[0]); es += e[i]; }
      const float ies = 1.f / es;
      const int h = 2 * hp + hf;
#pragma unroll
      for (int i = 0; i < 16; ++i) idxL[tl * 132 + h * 16 + i] = (int)(((unsigned)f2bf(e[i] * ies) << 16) | (unsigned)q[i]);
    }
    __syncthreads();
    f32x4 sh2v[4];
#pragma unroll
    for (int qq = 0; qq < 4; ++qq) sh2v[qq] = *(const f32x4*)(sh2 + (t0 >> 13) * 6144 + lane * 16 + 4 * qq);
    const float rs_lane = rsqrtf(ssq_total(SSQ, t0 + wid * 8 + (lane & 7)) * (1.f / 1024.f) + EPS_);
    uint4 nh0 = *(const uint4*)(XG + (size_t)(t0 + wid * 8) * 1024 + lane * 16), nh1 = *(const uint4*)(XG + (size_t)(t0 + wid * 8) * 1024 + lane * 16 + 8);
#pragma unroll 1
    for (int ii = 0; ii < 8; ++ii) {
      const int tl = wid * 8 + ii, t = t0 + tl, b = t >> 13;
      const int fr = lane & 15, fq = lane >> 4;
      uint4 hB1[8], hB2[8];
      {
        const uint4 h0 = nh0, h1 = nh1;
        if (ii < 7) { nh0 = *(const uint4*)(XG + (size_t)(t + 1) * 1024 + lane * 16); nh1 = *(const uint4*)(XG + (size_t)(t + 1) * 1024 + lane * 16 + 8); }
        const unsigned hw[8] = {h0.x, h0.y, h0.z, h0.w, h1.x, h1.y, h1.z, h1.w};
        const float rs = __int_as_float(__builtin_amdgcn_readlane(__float_as_int(rs_lane), ii));
        unsigned q1[2] = {0u, 0u}, q2[2] = {0u, 0u};
#pragma unroll
        for (int qq = 0; qq < 4; ++qq) {
          const f32x4 sh = sh2v[qq];
          float hvv[4];
          hvv[0] = __uint_as_float(hw[2 * qq] << 16) * rs + sh.x; hvv[1] = __uint_as_float(hw[2 * qq] & 0xffff0000u) * rs + sh.y;
          hvv[2] = __uint_as_float(hw[2 * qq + 1] << 16) * rs + sh.z; hvv[3] = __uint_as_float(hw[2 * qq + 1] & 0xffff0000u) * rs + sh.w;
#pragma unroll
          for (int pr = 0; pr < 2; ++pr) {
            const int byte_sel = (2 * qq + pr) & 3, wd = (2 * qq + pr) >> 2;
            const float x0 = fminf(fmaxf(hvv[2 * pr], -6.f), 6.f), x1 = fminf(fmaxf(hvv[2 * pr + 1], -6.f), 6.f);
            unsigned t1 = 0u;
            if (byte_sel == 0) t1 = __builtin_amdgcn_cvt_scalef32_pk_fp4_f32(0u, x0, x1, 1.0f, 0);
            else if (byte_sel == 1) t1 = __builtin_amdgcn_cvt_scalef32_pk_fp4_f32(0u, x0, x1, 1.0f, 1);
            else if (byte_sel == 2) t1 = __builtin_amdgcn_cvt_scalef32_pk_fp4_f32(0u, x0, x1, 1.0f, 2);
            else t1 = __builtin_amdgcn_cvt_scalef32_pk_fp4_f32(0u, x0, x1, 1.0f, 3);
            f32x2 back;
            if (byte_sel == 0) back = __builtin_amdgcn_cvt_scalef32_pk_f32_fp4(t1, 1.0f, 0);
            else if (byte_sel == 1) back = __builtin_amdgcn_cvt_scalef32_pk_f32_fp4(t1, 1.0f, 1);
            else if (byte_sel == 2) back = __builtin_amdgcn_cvt_scalef32_pk_f32_fp4(t1, 1.0f, 2);
            else back = __builtin_amdgcn_cvt_scalef32_pk_f32_fp4(t1, 1.0f, 3);
            const float r0 = fminf(fmaxf((hvv[2 * pr] - back.x) * 8.f, -6.f), 6.f), r1 = fminf(fmaxf((hvv[2 * pr + 1] - back.y) * 8.f, -6.f), 6.f);
            unsigned t2 = 0u;
            if (byte_sel == 0) t2 = __builtin_amdgcn_cvt_scalef32_pk_fp4_f32(0u, r0, r1, 1.0f, 0);
            else if (byte_sel == 1) t2 = __builtin_amdgcn_cvt_scalef32_pk_fp4_f32(0u, r0, r1, 1.0f, 1);
            else if (byte_sel == 2) t2 = __builtin_amdgcn_cvt_scalef32_pk_fp4_f32(0u, r0, r1, 1.0f, 2);
            else t2 = __builtin_amdgcn_cvt_scalef32_pk_fp4_f32(0u, r0, r1, 1.0f, 3);
            q1[wd] |= t1; q2[wd] |= t2;
          }
        }
        unsigned char* hq4 = smem + 33792 + wid * 1024;
        *(uint2*)(hq4 + lane * 8) = make_uint2(q1[0], q1[1]);
        *(uint2*)(hq4 + 512 + lane * 8) = make_uint2(q2[0], q2[1]);
#pragma unroll
        for (int kc = 0; kc < 8; ++kc) { hB1[kc] = *(const uint4*)(hq4 + 64 * kc + 16 * fq); hB2[kc] = *(const uint4*)(hq4 + 512 + 64 * kc + 16 * fq); }
      }
      f32x2 acc2[8];
#pragma unroll
      for (int j = 0; j < 8; ++j) acc2[j] = (f32x2){0.f, 0.f};
#pragma unroll 1
      for (int bt = 0; bt < 8; ++bt) {
        const int myidx = idxL[tl * 132 + 16 * bt + fr] & 0xffff;
        unsigned char* ust = smem + 41984 + wid * 8448;
        uint2 ul[16], vr[16];
#pragma unroll
        for (int r = 0; r < 16; ++r) { const unsigned off = (unsigned)__builtin_amdgcn_readlane(myidx, r) * 512u + (unsigned)lane * 8u; ul[r] = *(const uint2*)((const unsigned char*)U4 + off); }
        __builtin_amdgcn_sched_barrier(0);
#pragma unroll
        for (int r = 0; r < 16; ++r) { const unsigned off = (unsigned)__builtin_amdgcn_readlane(myidx, r) * 512u + (unsigned)lane * 8u; vr[r] = *(const uint2*)((const unsigned char*)V4 + off); }
        __builtin_amdgcn_sched_barrier(0);
#pragma unroll
        for (int r = 0; r < 16; ++r) *(uint2*)(ust + r * 528 + lane * 8) = ul[r];
        uint4 ua[8];
#pragma unroll
        for (int kc = 0; kc < 8; ++kc) ua[kc] = *(const uint4*)(ust + fr * 528 + 64 * kc + 16 * fq);
        f32x4 sa[2] = {(f32x4){0.f, 0.f, 0.f, 0.f}, (f32x4){0.f, 0.f, 0.f, 0.f}}, sb[2] = {(f32x4){0.f, 0.f, 0.f, 0.f}, (f32x4){0.f, 0.f, 0.f, 0.f}};
#pragma unroll
        for (int kc = 0; kc < 8; ++kc) {
          const i32x8 av = (i32x8){(int)ua[kc].x, (int)ua[kc].y, (int)ua[kc].z, (int)ua[kc].w, 0, 0, 0, 0};
          const i32x8 b1 = (i32x8){(int)hB1[kc].x, (int)hB1[kc].y, (int)hB1[kc].z, (int)hB1[kc].w, 0, 0, 0, 0};
          const i32x8 b2 = (i32x8){(int)hB2[kc].x, (int)hB2[kc].y, (int)hB2[kc].z, (int)hB2[kc].w, 0, 0, 0, 0};
          sa[kc & 1] = __builtin_amdgcn_mfma_scale_f32_16x16x128_f8f6f4(av, b1, sa[kc & 1], 4  , 4  , 0, 0x7F7F7F7F, 0, 0x7F7F7F7F);
          sb[kc & 1] = __builtin_amdgcn_mfma_scale_f32_16x16x128_f8f6f4(av, b2, sb[kc & 1], 4, 4, 0, 0x7F7F7F7F, 0, 0x7F7F7F7F);
        }
        f32x4 sc4 = (sa[0] + sa[1]) + (sb[0] + sb[1]) * 0.125f;
        const int jsel = lane & 3;
        const float dsel = jsel == 0 ? sc4[0] : (jsel == 1 ? sc4[1] : (jsel == 2 ? sc4[2] : sc4[3]));
        const float gl = __uint_as_float((unsigned)idxL[tl * 132 + 16 * bt + 4 * fq + jsel] & 0xffff0000u);
        const float w = gl * gelu_tanh_fast(dsel * (1.f / 64.f));
#pragma unroll
        for (int r = 0; r < 16; ++r) {
          const float wr = __int_as_float(__builtin_amdgcn_readlane(__float_as_int(w), 16 * (r >> 2) + (r & 3)));
          axpy16_fp4(vr[r], wr, acc2);
          if ((r & 3) == 3) __builtin_amdgcn_sched_barrier(0);
        }
      }
      float acc[16];
#pragma unroll
      for (int j = 0; j < 8; ++j) { acc[2 * j] = acc2[j].x; acc[2 * j + 1] = acc2[j].y; }
      float xn[16]; float ss = 0.f;
      const uint4 xr0 = *(const uint4*)(X + (size_t)t * 1024 + lane * 16), xr1 = *(const uint4*)(X + (size_t)t * 1024 + lane * 16 + 8);
      const unsigned xw[8] = {xr0.x, xr0.y, xr0.z, xr0.w, xr1.x, xr1.y, xr1.z, xr1.w};
#pragma unroll
      for (int qq = 0; qq < 4; ++qq) {
        const int c = lane * 16 + 4 * qq;
        const f32x4 xv = (f32x4){__uint_as_float(xw[2 * qq] << 16), __uint_as_float(xw[2 * qq] & 0xffff0000u), __uint_as_float(xw[2 * qq + 1] << 16), __uint_as_float(xw[2 * qq + 1] & 0xffff0000u)};
        const f32x4 g = *(const f32x4*)(g2 + b * 6144 + c);
        xn[4 * qq] = xv.x + g.x * acc[4 * qq] * 0.25f; xn[4 * qq + 1] = xv.y + g.y * acc[4 * qq + 1] * 0.25f;
        xn[4 * qq + 2] = xv.z + g.z * acc[4 * qq + 2] * 0.25f; xn[4 * qq + 3] = xv.w + g.w * acc[4 * qq + 3] * 0.25f;
        ss += xn[4 * qq] * xn[4 * qq] + xn[4 * qq + 1] * xn[4 * qq + 1] + xn[4 * qq + 2] * xn[4 * qq + 2] + xn[4 * qq + 3] * xn[4 * qq + 3];
      }
      const float rstd = rsqrtf(wave_sum(ss) * (1.f / 1024.f) + EPS_);
      if (!last) {
        unsigned hb[8], xb[8];
#pragma unroll
        for (int qq = 0; qq < 4; ++qq) {
          const int c = lane * 16 + 4 * qq;
          xb[2 * qq] = pk2(xn[4 * qq], xn[4 * qq + 1]); xb[2 * qq + 1] = pk2(xn[4 * qq + 2], xn[4 * qq + 3]);
          const f32x4 gn = *(const f32x4*)(ngain + c), sh = *(const f32x4*)(nsh + b * 6144 + c), sc = *(const f32x4*)(nsc + b * 6144 + c);
          hb[2 * qq] = pk2(xn[4 * qq] * rstd * gn.x * (1.f + sc.x) + sh.x, xn[4 * qq + 1] * rstd * gn.y * (1.f + sc.y) + sh.y);
          hb[2 * qq + 1] = pk2(xn[4 * qq + 2] * rstd * gn.z * (1.f + sc.z) + sh.z, xn[4 * qq + 3] * rstd * gn.w * (1.f + sc.w) + sh.w);
        }
        *(uint4*)(X + (size_t)t * 1024 + lane * 16) = make_uint4(xb[0], xb[1], xb[2], xb[3]);
        *(uint4*)(X + (size_t)t * 1024 + lane * 16 + 8) = make_uint4(xb[4], xb[5], xb[6], xb[7]);
        *(uint4*)(HF + (size_t)t * 1024 + lane * 16) = make_uint4(hb[0], hb[1], hb[2], hb[3]);
        *(uint4*)(HF + (size_t)t * 1024 + lane * 16 + 8) = make_uint4(hb[4], hb[5], hb[6], hb[7]);
      } else {
#pragma unroll
        for (int qq = 0; qq < 4; ++qq) {
          const int c = lane * 16 + 4 * qq;
          const f32x4 fn = *(const f32x4*)(gin(pp->in[I_FNORM]) + c);
          *(f32x4*)((float*)pp->out + (size_t)t * 1024 + c) = (f32x4){xn[4 * qq] * rstd * fn.x, xn[4 * qq + 1] * rstd * fn.y, xn[4 * qq + 2] * rstd * fn.z, xn[4 * qq + 3] * rstd * fn.w};
        }
      }
    }
  }
}

#define XB_TMO      128
#define XB_XCNT(j)  (256  + 64 * (j))
#define XB_XSUB(j)  (1280 + 64 * (j))
#define XB_XGEN(j)  (2304 + 64 * (j))
#define XB_TOP      3328
#define XB_TOPGEN   3392
#define XCD_BAR_WORDS 3456
#define XB_SPIN_CAP (1u << 20)
#define LAS __attribute__((address_space(3)))
__device__ __forceinline__ unsigned xb_ld(unsigned* q)              { return __hip_atomic_load(q, __ATOMIC_RELAXED, __HIP_MEMORY_SCOPE_AGENT); }
__device__ __forceinline__ unsigned xb_add(unsigned* q, unsigned v) { return __hip_atomic_fetch_add(q, v, __ATOMIC_RELAXED, __HIP_MEMORY_SCOPE_AGENT); }
__device__ __forceinline__ unsigned xb_xcc_id() { return (unsigned)__builtin_amdgcn_s_getreg((3 << 11) | 20) & 0xFu; }
#define XB_SPIN(cond, bar) do { unsigned _sp = 0; while (cond) { __builtin_amdgcn_s_sleep(1); \
    if ((++_sp & 255u) == 0u) { if (xb_ld(&(bar)[XB_TMO])) break; if (_sp > XB_SPIN_CAP) { atomicAdd(&(bar)[XB_TMO], 1u); break; } } } } while (0)
struct XcdBarrier { unsigned* bar; unsigned x; volatile LAS unsigned* st; };
__device__ __forceinline__ XcdBarrier xcd_barrier_post(unsigned* bar, volatile LAS unsigned* st) {
    XcdBarrier b; b.bar = bar; b.x = xb_xcc_id(); b.st = st;
    if (threadIdx.x == 0) (void)xb_add(&bar[XB_XCNT(b.x)], 1u);
    return b;
}
__device__ __forceinline__ void xcd_barrier_complete(unsigned* bar, unsigned x, unsigned& nloc, unsigned& nx) {
    const unsigned G = gridDim.x * gridDim.y * gridDim.z;
    unsigned sum, cnt, mine, sp = 0u;
    for (;;) {
        sum = 0u; cnt = 0u; mine = 0u;
#pragma unroll
        for (unsigned j = 0; j < 16; ++j) { const unsigned c = xb_ld(&bar[XB_XCNT(j)]); sum += c; cnt += (c > 0u) ? 1u : 0u; mine = (j == x) ? c : mine; }
        if (sum == G) break;
        __builtin_amdgcn_s_sleep(1);
        if ((++sp & 255u) == 0u) { if (xb_ld(&bar[XB_TMO])) break; if (sp > XB_SPIN_CAP) { atomicAdd(&bar[XB_TMO], 1u); break; } }
    }
    nloc = mine > 0u ? mine : 1u; nx = cnt > 0u ? cnt : 1u;
}
__device__ __forceinline__ void xcd_barrier(const XcdBarrier& b) {
    asm volatile("s_waitcnt vmcnt(0)" ::: "memory");
    __syncthreads();
    if (threadIdx.x == 0) {
        unsigned* bar = b.bar;
        __builtin_amdgcn_s_waitcnt(0);
        unsigned nloc = b.st[0], nx = b.st[1];
        if (nloc == 0u) { xcd_barrier_complete(bar, b.x, nloc, nx); b.st[0] = nloc; b.st[1] = nx; }
        const unsigned old = xb_add(&bar[XB_XSUB(b.x)], 1u);
        const unsigned gen = old / nloc;
        if (old + 1u == (gen + 1u) * nloc) {
            __builtin_amdgcn_fence(__ATOMIC_RELEASE, "agent");
            asm volatile("s_waitcnt vmcnt(0)" ::: "memory");
            const unsigned og = xb_add(&bar[XB_TOP], 1u);
            const unsigned tg = og / nx;
            if (og + 1u == (tg + 1u) * nx) xb_add(&bar[XB_TOPGEN], 1u);
            else XB_SPIN(xb_ld(&bar[XB_TOPGEN]) == tg, bar);
            __builtin_amdgcn_fence(__ATOMIC_ACQUIRE, "agent");
            xb_add(&bar[XB_XGEN(b.x)], 1u);
            asm volatile("s_waitcnt vmcnt(0)" ::: "memory");
        } else {
            XB_SPIN(xb_ld(&bar[XB_XGEN(b.x)]) == gen, bar);
            __builtin_amdgcn_fence(__ATOMIC_ACQUIRE, "agent");
            asm volatile("s_waitcnt vmcnt(0)" ::: "memory");
        }
    }
    __syncthreads();
}

__global__ void __launch_bounds__(NT) fwd_megakernel(Params p) {
  extern __shared__ __attribute__((aligned(16))) unsigned char smem[];
  const CParamsP pp = launder_kargs();
  cg::grid_group grid = cg::this_grid();
  volatile LAS unsigned* xbst = (volatile LAS unsigned*)(smem + LDS_BYTES - 16);
  if (threadIdx.x == 0) { xbst[0] = 0u; xbst[1] = 0u; }
  if (blockIdx.x == 0) { unsigned* bw = (unsigned*)(pp->ws + WS_BAR); for (int i = threadIdx.x; i < XCD_BAR_WORDS; i += NT) bw[i] = 0u; }
  setup_phase(p, smem);
  grid.sync();
  const XcdBarrier xb = xcd_barrier_post((unsigned*)(pp->ws + WS_BAR), xbst);
  const float* MOD = (const float*)(pp->ws + WS_MOD);
  for (int l = 0; l < DEPTH_; ++l) {
    const float* xsrc = (l == 0) ? gin(pp->in[I_X]) : (const float*)(pp->ws + WS_X);
    const float* modl = MOD + (size_t)l * 2 * 6144;
    if (l == 0) {
      norm_mod_phase(xsrc, gin(pp->in[I_NMIX]), modl + 0, modl + 1024, (bf16_t*)(pp->ws + WS_ABUF));
      qbias_phase(p, smem);
      xcd_barrier(xb);
    }
    gemm_proj_phase(p, l, smem);
    xcd_barrier(xb);
    attn_phase(p, l, smem);
    mix_local_phase(p, l, smem);
    xcd_barrier(xb);
    scan_phase(p, l);
    xcd_barrier(xb);
    mix_final_phase(p, l, smem);
    xcd_barrier(xb);
    gemm_out_phase(p, l, smem);
    xcd_barrier(xb);
    gemm_q_phase(p, l, smem);
    xcd_barrier(xb);
    peer_phase(p, l, l == DEPTH_ - 1, smem);
    xcd_barrier(xb);
  }
}

extern "C" void kernel_launch(void* const* d_in, const int* in_sizes, int n_in,
                              void* d_out, int out_size, void* d_ws, size_t ws_size,
                              hipStream_t stream) {
  static int grid_blocks = 0;
  if (grid_blocks == 0) {
    if (n_in != 24 || ws_size < WS_END) { fprintf(stderr, "kernel_launch: unexpected n_in %d / ws_size %zu (need %zu)\n", n_in, ws_size, (size_t)WS_END); grid_blocks = -1; return; }
    int dev = 0, cus = 0, per_cu = 0;
    if (hipGetDevice(&dev) != hipSuccess || hipDeviceGetAttribute(&cus, hipDeviceAttributeMultiprocessorCount, dev) != hipSuccess) { grid_blocks = -1; return; }
    if (hipFuncSetAttribute((const void*)fwd_megakernel, hipFuncAttributeMaxDynamicSharedMemorySize, LDS_BYTES) != hipSuccess) { fprintf(stderr, "hipFuncSetAttribute failed\n"); grid_blocks = -1; return; }
    if (hipOccupancyMaxActiveBlocksPerMultiprocessor(&per_cu, (const void*)fwd_megakernel, NT, LDS_BYTES) != hipSuccess || per_cu < 1) { fprintf(stderr, "occupancy query: %d\n", per_cu); grid_blocks = -1; return; }
    grid_blocks = cus;
  }
  if (grid_blocks < 0) return;
  Params p{};
  for (int i = 0; i < 24; ++i) p.in[i] = (const GAS float*)d_in[i];
  p.out = (GAS float*)d_out; p.ws = (GAS unsigned char*)d_ws;
  void* args[] = {&p};
  hipError_t e = hipLaunchCooperativeKernel((void*)fwd_megakernel, dim3(grid_blocks), dim3(NT), args, LDS_BYTES, stream);
  if (e != hipSuccess) fprintf(stderr, "cooperative launch failed: %s (grid %d)\n", hipGetErrorString(e), grid_blocks);
}
```

```cpp
#include <hip/hip_runtime.h>
#include <hip/hip_cooperative_groups.h>
#include <cstdio>
#include <cstdint>
namespace cg = cooperative_groups;

typedef unsigned short bf16_t;
typedef short bf16x8 __attribute__((ext_vector_type(8)));
typedef float f32x4 __attribute__((ext_vector_type(4)));
typedef float f32x16 __attribute__((ext_vector_type(16)));
typedef int i32x8 __attribute__((ext_vector_type(8)));

constexpr int T_ = 16384, D_ = 1024, L_ = 8192, NBATCH = 2, DEPTH_ = 4;
constexpr int INC = 2944, INCP = 3072;
constexpr int NCH = 128;
constexpr int NT = 512;
constexpr int NW = 8;
constexpr float EPS_ = 1e-6f;
constexpr int C_QA = 0, C_KA = 384, C_VA = 768, C_QR = 1152, C_KR = 1536, C_VR = 1920, C_GR = 2304, C_US = 2688;

constexpr size_t al256(size_t x) { return (x + 255) & ~(size_t)255; }
constexpr size_t WS_MOD   = 0;
constexpr size_t WS_ROTC  = al256(WS_MOD + 4ull * 2 * 6144 * 4);
constexpr size_t WS_ROTS  = al256(WS_ROTC + 8192ull * 32 * 4);
constexpr size_t WS_SA    = al256(WS_ROTS + 8192ull * 32 * 4);
constexpr size_t WS_SBB   = al256(WS_SA + 4ull * 16 * 64 * 2 * 4);
constexpr size_t WS_WIN   = al256(WS_SBB + 4ull * 16 * 64 * 32 * 4);
constexpr size_t WS_WOUT  = al256(WS_WIN + 4ull * INCP * 1024 * 2);
constexpr size_t WS_WQ    = al256(WS_WOUT + 4ull * 1024 * 1024 * 2);
constexpr size_t WS_SUBK  = al256(WS_WQ + 4ull * 2048 * 1024 * 2);
constexpr size_t WS_ABUF  = al256(WS_SUBK + 4ull * 16 * 128 * 128 * 2);
constexpr size_t WS_PROJ  = al256(WS_ABUF + (size_t)T_ * 1024 * 2);
constexpr size_t WS_VTA   = al256(WS_PROJ + (size_t)T_ * INCP * 2);
constexpr size_t WS_ATT   = al256(WS_VTA + 2ull * 6 * 64 * 8192 * 2);
constexpr size_t WS_YINT  = al256(WS_ATT + (size_t)T_ * 384 * 4);
constexpr size_t WS_UPD   = al256(WS_YINT + (size_t)T_ * 384 * 4);
constexpr size_t WS_SPREV = al256(WS_UPD + 256ull * 6 * 4096 * 4);
constexpr size_t WS_SEND  = al256(WS_SPREV + 256ull * 6 * 4096 * 4);
constexpr size_t WS_CARRY = al256(WS_SEND + 256ull * 16 * 64 * 2 * 4);
constexpr size_t WS_X     = al256(WS_CARRY + 256ull * 16 * 64 * 2 * 4);
constexpr size_t WS_Q     = al256(WS_X + (size_t)T_ * 1024 * 4);
constexpr size_t WS_SC    = al256(WS_Q + (size_t)T_ * 2048 * 2);
constexpr size_t WS_EIDX  = al256(WS_SC + (size_t)T_ * 2048 * 4);
constexpr size_t WS_EGATE = al256(WS_EIDX + (size_t)T_ * 128 * 4);
constexpr size_t WS_PU8   = al256(WS_EGATE + (size_t)T_ * 128 * 4);
constexpr size_t WS_PV8   = al256(WS_PU8 + 4ull * 16384 * 1024);
constexpr size_t WS_BAR   = al256(WS_PV8 + 4ull * 16384 * 1024);
constexpr size_t WS_SPT   = al256(WS_BAR + 3456ull * 4);
constexpr size_t WS_CB    = al256(WS_SPT + 256ull * 6 * 4096 * 2);
constexpr size_t WS_WGLUT = al256(WS_CB + 4ull * 16 * 16 * 128 * 2);
constexpr size_t WS_VTR   = al256(WS_WGLUT + 4ull * 512 * 256 * 2);
constexpr size_t WS_XG    = al256(WS_VTR + 2ull * 384 * 8192 * 2);
constexpr size_t WS_SSQ   = al256(WS_XG + (size_t)T_ * 1024 * 2);
constexpr size_t WS_C2    = al256(WS_SSQ + (size_t)T_ * 16 * 4);
constexpr size_t WS_BBH   = al256(WS_C2 + 4ull * 2 * 2048 * 4);
constexpr size_t WS_END   = al256(WS_BBH + 4ull * 16 * 2 * 64 * 16 * 2);

constexpr int LDS_BYTES = 135168;

#define GAS __attribute__((address_space(1)))
struct Params {
  const GAS float* in[24];
  GAS float* out;
  GAS unsigned char* ws;
};
enum { I_X = 0, I_C, I_WADA, I_BADA, I_NMIX, I_NFFN, I_WIN, I_RELB, I_LRE, I_LIM, I_LOGDT, I_BRE, I_BIM, I_CRE, I_CIM, I_SSMD,
       I_WGLU, I_MGAIN, I_WOUT, I_WQ, I_SUBK, I_PU, I_PV, I_FNORM };

__device__ __forceinline__ float bf2f(bf16_t v) { return __uint_as_float(((unsigned)v) << 16); }
__device__ __forceinline__ bf16_t f2bf(float f) { unsigned u = __float_as_uint(f); u += 0x7fffu + ((u >> 16) & 1u); return (bf16_t)(u >> 16); }
__device__ __forceinline__ unsigned pk2(float a, float b) { return (unsigned)f2bf(a) | ((unsigned)f2bf(b) << 16); }
__device__ __forceinline__ float wave_sum(float v) {
#pragma unroll
  for (int o = 32; o > 0; o >>= 1) v += __shfl_xor(v, o);
  return v;
}
__device__ __forceinline__ float wave_max(float v) {
#pragma unroll
  for (int o = 32; o > 0; o >>= 1) v = fmaxf(v, __shfl_xor(v, o));
  return v;
}
__device__ __forceinline__ float gelu_tanh(float x) { const float u = 0.7978845608028654f * (x + 0.044715f * x * x * x); return 0.5f * x * (1.f + tanhf(u)); }
__device__ __forceinline__ float sigmoid_f(float x) { return 1.f / (1.f + __expf(-x)); }
__device__ __forceinline__ float gelu_tanh_fast(float x) {
  const float u2 = 2.f * 0.7978845608028654f * 1.4426950408889634f * (x + 0.044715f * x * x * x);
  const float e = __builtin_amdgcn_exp2f(fminf(u2, 80.f));
  return x - x * __builtin_amdgcn_rcpf(1.f + e);
}
__device__ __forceinline__ GAS unsigned char* launder_ptr(GAS unsigned char* q) { asm volatile("" : "+s"(q)); return q; }
__device__ __forceinline__ const float* gin(const GAS float* q) { return (const float*)q; }
__device__ __forceinline__ const float* launder_cptr(const float* q) { asm volatile("" : "+s"(q)); return q; }
__device__ __forceinline__ int launder_tid() { int t = threadIdx.x; asm volatile("" : "+v"(t)); return t; }
typedef const Params __attribute__((address_space(4)))* CParamsP;
__device__ __forceinline__ CParamsP launder_kargs() { CParamsP q = (CParamsP)__builtin_amdgcn_kernarg_segment_ptr(); asm volatile("" : "+s"(q)); return q; }

__device__ __forceinline__ void convert_tables_fp4(const CParamsP pp, GAS unsigned char* ws, int layer, int gtid, int gn) {
  constexpr size_t NIT = 16384ull * 1024 / 16;
  for (size_t it = gtid; it < 2 * NIT; it += gn) {
    const int tb = it >= NIT ? 1 : 0; const size_t r = (it - (size_t)tb * NIT) + (size_t)layer * NIT;
    const f32x4* src = (const f32x4*)((tb ? gin(pp->in[I_PV]) : gin(pp->in[I_PU])) + r * 16);
    const float sc = tb ? 4.f : 64.f;
    unsigned o[2] = {0u, 0u};
#pragma unroll
    for (int q = 0; q < 4; ++q) {
      const f32x4 a = src[q];
      const float x0 = fminf(fmaxf(a.x * sc, -6.f), 6.f), x1 = fminf(fmaxf(a.y * sc, -6.f), 6.f);
      const float x2 = fminf(fmaxf(a.z * sc, -6.f), 6.f), x3 = fminf(fmaxf(a.w * sc, -6.f), 6.f);
      if (q == 0)      { o[0] = __builtin_amdgcn_cvt_scalef32_pk_fp4_f32(o[0], x0, x1, 1.0f, 0); o[0] = __builtin_amdgcn_cvt_scalef32_pk_fp4_f32(o[0], x2, x3, 1.0f, 1); }
      else if (q == 1) { o[0] = __builtin_amdgcn_cvt_scalef32_pk_fp4_f32(o[0], x0, x1, 1.0f, 2); o[0] = __builtin_amdgcn_cvt_scalef32_pk_fp4_f32(o[0], x2, x3, 1.0f, 3); }
      else if (q == 2) { o[1] = __builtin_amdgcn_cvt_scalef32_pk_fp4_f32(o[1], x0, x1, 1.0f, 0); o[1] = __builtin_amdgcn_cvt_scalef32_pk_fp4_f32(o[1], x2, x3, 1.0f, 1); }
      else             { o[1] = __builtin_amdgcn_cvt_scalef32_pk_fp4_f32(o[1], x0, x1, 1.0f, 2); o[1] = __builtin_amdgcn_cvt_scalef32_pk_fp4_f32(o[1], x2, x3, 1.0f, 3); }
    }
    *(uint2*)(ws + (tb ? WS_PV8 : WS_PU8) + r * 8) = make_uint2(o[0], o[1]);
  }
}

__device__ void setup_phase(const Params& p, unsigned char* smem) {
  const CParamsP pp = launder_kargs();
  GAS unsigned char* const ws = launder_ptr(pp->ws); const int tidx = launder_tid(); (void)ws; (void)tidx;
  const int tid = tidx;
  float* sm = (float*)smem;
  {
    float* cond = sm;
    float* red = sm + 2048;
    float* MOD = (float*)(ws + WS_MOD);
    for (int i = tid; i < 2048; i += NT) { const float c = gin(pp->in[I_C])[i]; cond[i] = c * sigmoid_f(c); }
    __syncthreads();
    for (int item = blockIdx.x; item < 4 * 96; item += gridDim.x) {
      const int l = item / 96, cb = item % 96, kq = tid >> 6, jj = tid & 63, j = cb * 64 + jj;
      const float* w = gin(pp->in[I_WADA]) + (size_t)l * 1024 * 6144 + j;
      float a0 = 0.f, a1 = 0.f;
#pragma unroll 16
      for (int k = kq * 128; k < kq * 128 + 128; ++k) { const float wv = w[(size_t)k * 6144]; a0 += cond[k] * wv; a1 += cond[1024 + k] * wv; }
      red[(kq * 2 + 0) * 64 + jj] = a0; red[(kq * 2 + 1) * 64 + jj] = a1;
      __syncthreads();
      if (tid < 128) {
        const int b = tid >> 6, j2 = tid & 63; float s = 0.f;
        for (int q = 0; q < 8; ++q) s += red[(q * 2 + b) * 64 + j2];
        MOD[((size_t)l * 2 + b) * 6144 + cb * 64 + j2] = s + gin(pp->in[I_BADA])[(size_t)l * 6144 + cb * 64 + j2];
      }
      __syncthreads();
    }
  }
  const int gtid = blockIdx.x * NT + tid, gn = gridDim.x * NT;
  {
    float* RC = (float*)(ws + WS_ROTC); float* RS = (float*)(ws + WS_ROTS);
    for (int idx = gtid; idx < 8192 * 32; idx += gn) {
      const int pos = idx >> 5, i = idx & 31;
      const float inv = powf(10000.0f, -(float)i / 32.0f);
      const float ang = (float)pos * inv;
      float s, c; sincosf(ang, &s, &c);
      RC[idx] = c; RS[idx] = s;
    }
  }
  {
    float* SA = (float*)(ws + WS_SA); float* SBB = (float*)(ws + WS_SBB); bf16_t* BBH = (bf16_t*)(ws + WS_BBH);
    for (int idx = gtid; idx < 4 * 16 * 64; idx += gn) {
      const int l = idx / 1024, g = (idx >> 6) & 15;
      const float dt = expf(gin(pp->in[I_LOGDT])[l * 16 + g]);
      const float lr = gin(pp->in[I_LRE])[idx], li = gin(pp->in[I_LIM])[idx];
      const float mag = expf(lr * dt);
      float sn, cs; sincosf(li * dt, &sn, &cs);
      const float are = mag * cs, aim = mag * sn;
      const float den = lr * lr + li * li, nr = are - 1.f, ni = aim;
      const float fre = (nr * lr + ni * li) / den, fim = (ni * lr - nr * li) / den;
      SA[idx * 2] = are; SA[idx * 2 + 1] = aim;
      for (int c = 0; c < 16; ++c) {
        const float br = gin(pp->in[I_BRE])[(size_t)idx * 16 + c], bi = gin(pp->in[I_BIM])[(size_t)idx * 16 + c];
        SBB[(size_t)idx * 32 + c] = fre * br - fim * bi;
        SBB[(size_t)idx * 32 + 16 + c] = fre * bi + fim * br;
        {
          const int pq = idx & 63; const size_t fb = (size_t)(idx >> 6) * 2;
          BBH[(((fb + 0) * 2 + (pq >> 5)) * 64 + 32 * (c >> 3) + (pq & 31)) * 8 + (c & 7)] = f2bf(fre * br - fim * bi);
          BBH[(((fb + 1) * 2 + (pq >> 5)) * 64 + 32 * (c >> 3) + (pq & 31)) * 8 + (c & 7)] = f2bf(fre * bi + fim * br);
        }
      }
    }
  }
  {
    bf16_t* CB = (bf16_t*)(ws + WS_CB);
    for (int idx = gtid; idx < 4 * 16 * 16 * 128; idx += gn) {
      const int k = idx & 127, lgc = idx >> 7;
      const bf16_t cv = (k < 64) ? f2bf(gin(pp->in[I_CRE])[(size_t)lgc * 64 + k]) : f2bf(-gin(pp->in[I_CIM])[(size_t)lgc * 64 + (k - 64)]);
      const int cc = lgc & 15, lg = lgc >> 4;
      CB[(((size_t)lg * 4 + (k >> 5)) * 64 + ((k >> 3) & 3) * 16 + cc) * 8 + (k & 7)] = cv;
    }
    bf16_t* WG = (bf16_t*)(ws + WS_WGLUT);
    for (int idx = gtid; idx < 4 * 512 * 256; idx += gn) {
      const int k = idx & 255, nn = (idx >> 8) & 511, l2 = idx >> 17;
      {
        const int which = nn >> 8, w8 = (nn >> 5) & 7, nt = (nn >> 4) & 1, frr = nn & 15, ks = k >> 5, fqq = (k >> 3) & 3, j = k & 7;
        WG[(((((size_t)l2 * 8 + w8) * 8 + ks) * 2 + which) * 2 + nt) * 512 + (fqq * 16 + frr) * 8 + j] = f2bf(gin(pp->in[I_WGLU])[((size_t)l2 * 256 + k) * 512 + nn]);
      }
    }
  }
  convert_tables_fp4(pp, ws, 0, gtid, gn);
  {
    __syncthreads();
    const int lane = tid & 63, wid = tid >> 6;
    float* scr = sm + wid * (64 * 33);
    constexpr int IT_IN = 16 * 96, IT_OUT = 16 * 32, IT_L = IT_IN + IT_OUT;
    for (int item = blockIdx.x * NW + wid; item < 4 * IT_L; item += gridDim.x * NW) {
      const int l = item / IT_L; int r = item - l * IT_L;
      const float* W; bf16_t* WT; int N, NP;
      if (r < IT_IN) { W = gin(pp->in[I_WIN]) + (size_t)l * 1024 * INC; WT = (bf16_t*)(ws + WS_WIN) + (size_t)l * INCP * 1024; N = INC; NP = 96; }
      else { r -= IT_IN; W = gin(pp->in[I_WOUT]) + (size_t)l * 1024 * 1024; WT = (bf16_t*)(ws + WS_WOUT) + (size_t)l * 1024 * 1024; N = 1024; NP = 32; }
      const int kb = r / NP, nb = r - kb * NP, k0 = kb * 64, n0 = nb * 32;
      const int nn = n0 + (lane & 31); const bool inb = nn < N;
      float v[32];
#pragma unroll
      for (int i = 0; i < 32; ++i) { const int kk = 2 * i + (lane >> 5); v[i] = inb ? W[(size_t)(k0 + kk) * N + nn] : 0.f; }
#pragma unroll
      for (int i = 0; i < 32; ++i) { const int kk = 2 * i + (lane >> 5); scr[kk * 33 + (lane & 31)] = v[i]; }
      const int c = lane & 7;
#pragma unroll
      for (int j = 0; j < 4; ++j) {
        const int n = (lane >> 3) + 8 * j; const float* sp = scr + (8 * c) * 33 + n;
        uint4 o; o.x = pk2(sp[0], sp[33]); o.y = pk2(sp[2 * 33], sp[3 * 33]); o.z = pk2(sp[4 * 33], sp[5 * 33]); o.w = pk2(sp[6 * 33], sp[7 * 33]);
        *(uint4*)(WT + (size_t)(n0 + n) * 1024 + k0 + 8 * c) = o;
      }
    }
    __syncthreads();
  }
  {
    float* WtT = sm;
    float* SKs = sm + 128 * 65;
    bf16_t* WP = (bf16_t*)(ws + WS_WQ);
    for (int item = blockIdx.x; item < 4 * 16 * 16; item += gridDim.x) {
      const int l = item >> 8, hs = (item >> 4) & 15, kb = item & 15, k0 = kb * 64;
      const float* Wq = gin(pp->in[I_WQ]) + (size_t)l * 1024 * 2048 + hs * 128;
      const float* SKg = gin(pp->in[I_SUBK]) + ((size_t)l * 16 + hs) * 128 * 128;
      __syncthreads();
#pragma unroll
      for (int i = 0; i < 16; ++i) { const int idx = tid + NT * i, kk = idx >> 7, d = idx & 127; WtT[d * 65 + kk] = Wq[(size_t)(k0 + kk) * 2048 + d]; }
#pragma unroll
      for (int i = 0; i < 32; ++i) { const int idx = tid + NT * i, key = idx >> 7, d = idx & 127; SKs[key * 129 + d] = SKg[idx]; }
      __syncthreads();
      const int key = tid & 127, kg = tid >> 7;
      float acc[16];
#pragma unroll
      for (int i = 0; i < 16; ++i) acc[i] = 0.f;
#pragma unroll 4
      for (int d = 0; d < 128; ++d) {
        const float sv = SKs[key * 129 + d];
#pragma unroll
        for (int i = 0; i < 16; ++i) acc[i] += sv * WtT[d * 65 + kg * 16 + i];
      }
      uint4 o0, o1;
      o0.x = pk2(acc[0], acc[1]); o0.y = pk2(acc[2], acc[3]); o0.z = pk2(acc[4], acc[5]); o0.w = pk2(acc[6], acc[7]);
      o1.x = pk2(acc[8], acc[9]); o1.y = pk2(acc[10], acc[11]); o1.z = pk2(acc[12], acc[13]); o1.w = pk2(acc[14], acc[15]);
      bf16_t* dst = WP + ((size_t)l * 2048 + hs * 128 + key) * 1024 + k0 + kg * 16;
      *(uint4*)dst = o0; *(uint4*)(dst + 8) = o1;
    }
    __syncthreads();
  }
}

__device__ void qbias_phase(const Params& p, unsigned char* smem) {
  const CParamsP pp = launder_kargs();
  GAS unsigned char* const ws = launder_ptr(pp->ws); const int tid = launder_tid();
  float* C2 = (float*)(ws + WS_C2); const float* MOD = (const float*)(ws + WS_MOD); const bf16_t* WP = (const bf16_t*)(ws + WS_WQ);
  const int lane = tid & 63, gw = blockIdx.x * NW + (tid >> 6), nw = gridDim.x * NW;
  for (int o = gw; o < 4 * 2048; o += nw) {
    const int l = o >> 11;
    const uint4 w0 = *(const uint4*)(WP + (size_t)o * 1024 + lane * 16), w1 = *(const uint4*)(WP + (size_t)o * 1024 + lane * 16 + 8);
    const unsigned ww[8] = {w0.x, w0.y, w0.z, w0.w, w1.x, w1.y, w1.z, w1.w};
    const float* s0 = MOD + (size_t)l * 2 * 6144 + 3072 + lane * 16; const float* s1 = s0 + 6144;
    float a0 = 0.f, a1 = 0.f;
#pragma unroll
    for (int q = 0; q < 8; ++q) {
      const float wl = __uint_as_float(ww[q] << 16), wh = __uint_as_float(ww[q] & 0xffff0000u);
      a0 += s0[2 * q] * wl + s0[2 * q + 1] * wh; a1 += s1[2 * q] * wl + s1[2 * q + 1] * wh;
    }
    a0 = wave_sum(a0); a1 = wave_sum(a1);
    if (lane == 0) { C2[((size_t)l * 2 + 0) * 2048 + (o & 2047)] = a0; C2[((size_t)l * 2 + 1) * 2048 + (o & 2047)] = a1; }
  }
  (void)smem;
}

__device__ void norm_mod_phase(const float* __restrict__ xsrc, const float* __restrict__ gain, const float* __restrict__ mod_sh, const float* __restrict__ mod_sc,
                               bf16_t* __restrict__ outp) {
  const int tidx = launder_tid();
  const int lane = tidx & 63, gw = blockIdx.x * NW + (tidx >> 6), nw = gridDim.x * NW;
  for (int t = gw; t < T_; t += nw) {
    const int b = t >> 13;
    const f32x4* xr = (const f32x4*)(xsrc + (size_t)t * 1024) + lane;
    f32x4 v[4]; float s = 0.f;
#pragma unroll
    for (int j = 0; j < 4; ++j) { v[j] = xr[64 * j]; s += v[j].x * v[j].x + v[j].y * v[j].y + v[j].z * v[j].z + v[j].w * v[j].w; }
    const float rstd = rsqrtf(wave_sum(s) * (1.f / 1024.f) + EPS_);
#pragma unroll
    for (int j = 0; j < 4; ++j) {
      const int c = lane * 4 + 256 * j;
      const f32x4 g = *(const f32x4*)(gain + c), sh = *(const f32x4*)(mod_sh + b * 6144 + c), sc = *(const f32x4*)(mod_sc + b * 6144 + c);
      const float o0 = v[j].x * rstd * g.x * (1.f + sc.x) + sh.x, o1 = v[j].y * rstd * g.y * (1.f + sc.y) + sh.y;
      const float o2 = v[j].z * rstd * g.z * (1.f + sc.z) + sh.z, o3 = v[j].w * rstd * g.w * (1.f + sc.w) + sh.w;
      uint2 o; o.x = pk2(o0, o1); o.y = pk2(o2, o3);
      *(uint2*)(outp + (size_t)t * 1024 + c) = o;
    }
  }
}


namespace pg8 {
#define PG8_LAS __attribute__((address_space(3)))
typedef unsigned u32x4 __attribute__((ext_vector_type(4)));
constexpr int BM = 256, BK = 64, HALF = 128, HTB = HALF * BK * 2, STAGE_BYTES = 8 * HTB, NXCD = 8, WGM = 8;
__host__ __device__ __forceinline__ int lds_byte(int r, int c) { const int st = (r >> 4) * 2 + (c >> 5), rr = r & 15, cc = c & 31, ob = rr * 64 + cc * 2; return st * 1024 + (ob ^ (((ob >> 9) & 1) << 5)); }
__host__ __device__ __forceinline__ void stage_rc(int b, int& R, int& C) { const int st = b / 1024, sb = b % 1024, swz = sb ^ (((sb >> 9) & 1) << 5); R = (st >> 1) * 16 + swz / 64; C = (st & 1) * 32 + (swz % 64) / 2; }
__host__ __device__ __forceinline__ int perm32(int rho) { const int n = rho >> 4, i = rho & 15; return 8 * (i >> 2) + 4 * n + (i & 3); }
struct Unit { int pm, pn; };
struct Gemm { const bf16_t* A; const bf16_t* Bt; int M, N, K; };
struct StaticOrder {
    int nM, nN, nwg, G, c;
    __host__ __device__ void init(int M, int N, int G_, int c_) { nM = M / BM; nN = N / BM; nwg = nM * nN; G = G_; c = c_; }
    __host__ __device__ bool next(int i, Unit& u) const {
        const long L = (long)i * G + c; if (L >= nwg) return false;
        int wgid = (int)L; { const int q = nwg / NXCD, r = nwg % NXCD, xcd = wgid % NXCD, off = wgid / NXCD; wgid = (xcd < r ? xcd * (q + 1) : r * (q + 1) + (xcd - r) * q) + off; }
        const int nig = WGM * nN, gid = wgid / nig, fm = gid * WGM, gsz = (nM - fm) < WGM ? (nM - fm) : WGM;
        u.pm = fm + ((wgid % nig) % gsz); u.pn = (wgid % nig) / gsz; return true;
    }
    __device__ __forceinline__ void a_ready(const Unit&) const {}
    __device__ __forceinline__ void done(const Unit&) const {}
};
__device__ __forceinline__ unsigned cvt_pk_bf16(float lo, float hi) { unsigned r; asm volatile("v_cvt_pk_bf16_f32 %0, %1, %2" : "=v"(r) : "v"(lo), "v"(hi)); return r; }
template <class Epi, class Sched>
__device__ __forceinline__ void gemm_phase(PG8_LAS unsigned char* lds, const Gemm g, const Sched& S, const Epi& E) {
    const int tid = launder_tid(), wid = __builtin_amdgcn_readfirstlane(tid >> 6), lane = tid & 63, wr = wid >> 2, wc = wid & 3, fr = lane & 15, fq = lane >> 4;
    const int K = g.K, nt = K / BK;
    unsigned voffA[2], voffB[2];
#pragma unroll
    for (int i = 0; i < 2; ++i) { int R, C; stage_rc(tid * 16 + i * 8192, R, C); const int Rb = Epi::PERM ? ((R & ~31) + perm32(R & 31)) : R;
        voffA[i] = (unsigned)(R * K + C) * 2u; voffB[i] = (unsigned)(Rb * K + C) * 2u; }
    const size_t kstep = (size_t)(BK * 2);
    const size_t hstep = (size_t)HALF * K * 2;
    const size_t tstep = 2 * hstep;
    const unsigned ldsw = (unsigned)wid * 1024u;
    const int aoff = lds_byte(wr * 64 + fr, fq * 8), boff = lds_byte(wc * 32 + fr, fq * 8);
#define PG8_SA(b, h) (((b) * 2 + (h)) * HTB)
#define PG8_SB(b, h) ((4 + (b) * 2 + (h)) * HTB)
#define PG8_STAGE(bufoff, gbase, voff) do { _Pragma("unroll") for (int _i = 0; _i < 2; ++_i) \
        __builtin_amdgcn_global_load_lds((const unsigned*)((const char*)(gbase) + (voff)[_i]), (PG8_LAS unsigned*)(lds + (bufoff) + ldsw + _i * 8192), 16, 0, 0); } while (0)
#define PG8_LDA(dst, b, h) do { _Pragma("unroll") for (int m = 0; m < 4; ++m) _Pragma("unroll") for (int k = 0; k < 2; ++k) dst[m][k] = *(const PG8_LAS bf16x8*)(lds + PG8_SA(b, h) + aoff + m * 2048 + k * 1024); } while (0)
#define PG8_LDB(dst, b, h) do { _Pragma("unroll") for (int n = 0; n < 2; ++n) _Pragma("unroll") for (int k = 0; k < 2; ++k) dst[n][k] = *(const PG8_LAS bf16x8*)(lds + PG8_SB(b, h) + boff + n * 2048 + k * 1024); } while (0)
#define PG8_MMA(ai, bj, At, Bt) do { __builtin_amdgcn_s_setprio(1); _Pragma("unroll") for (int m = 0; m < 4; ++m) _Pragma("unroll") for (int n = 0; n < 2; ++n) _Pragma("unroll") for (int k = 0; k < 2; ++k) \
        acc[ai][bj][m][n] = __builtin_amdgcn_mfma_f32_16x16x32_bf16(Bt[n][k], At[m][k], acc[ai][bj][m][n], 0, 0, 0); __builtin_amdgcn_s_setprio(0); } while (0)
#define PG8_WAIT_V(n) asm volatile("s_waitcnt vmcnt(" #n ")" ::: "memory")
#define PG8_WAIT_L(n) asm volatile("s_waitcnt lgkmcnt(" #n ")" ::: "memory")
#define PG8_BAR __builtin_amdgcn_s_barrier()
#define PG8_SCHED __builtin_amdgcn_sched_barrier(0)
    Unit cur, nxt; int ui = 0;
    if (!S.next(0, cur)) return;
    f32x4 acc[2][2][4][2];
#pragma unroll
    for (int a = 0; a < 2; ++a)
#pragma unroll
        for (int b = 0; b < 2; ++b)
#pragma unroll
            for (int m = 0; m < 4; ++m)
#pragma unroll
                for (int n = 0; n < 2; ++n) acc[a][b][m][n] = (f32x4){0.f, 0.f, 0.f, 0.f};
    bf16x8 At[4][2], B0[2][2], B1[2][2];
    const char* cA = (const char*)g.A + (size_t)cur.pm * tstep; const char* cB = (const char*)g.Bt + (size_t)cur.pn * tstep;
    S.a_ready(cur);
    PG8_STAGE(PG8_SB(0, 0), cB, voffB); PG8_STAGE(PG8_SA(0, 0), cA, voffA); PG8_STAGE(PG8_SB(0, 1), cB + hstep, voffB); PG8_STAGE(PG8_SA(0, 1), cA + hstep, voffA);
    if (wr == 1) PG8_BAR;
    PG8_WAIT_V(4); PG8_BAR;
    PG8_STAGE(PG8_SB(1, 0), cB + kstep, voffB); PG8_STAGE(PG8_SA(1, 0), cA + kstep, voffA); PG8_STAGE(PG8_SB(1, 1), cB + hstep + kstep, voffB);
    PG8_WAIT_V(6); PG8_BAR;
    for (;;) {
        const bool has_next = S.next(ui + 1, nxt);
        const char* nA = has_next ? (const char*)g.A + (size_t)nxt.pm * tstep : cA; const char* nB = has_next ? (const char*)g.Bt + (size_t)nxt.pn * tstep : cB;
        for (int t = 0; t < nt; t += 2) {
            const bool last = (t == nt - 2);
            const char* a1 = cA + (size_t)(t + 1) * kstep;
            const char* a2 = last ? nA : cA + (size_t)(t + 2) * kstep; const char* b2 = last ? nB : cB + (size_t)(t + 2) * kstep;
            const char* a3 = a2 + kstep; const char* b3 = b2 + kstep;
            if (last && has_next) S.a_ready(nxt);
            PG8_LDB(B0, 0, 0); PG8_SCHED; PG8_LDA(At, 0, 0); PG8_STAGE(PG8_SA(1, 1), a1 + hstep, voffA);
            PG8_WAIT_L(8); PG8_BAR; PG8_WAIT_L(0); PG8_MMA(0, 0, At, B0); PG8_BAR; PG8_SCHED;
            PG8_LDB(B1, 0, 1); PG8_STAGE(PG8_SB(0, 0), b2, voffB);
            PG8_BAR; PG8_WAIT_L(0); PG8_MMA(0, 1, At, B1); PG8_BAR;
            PG8_LDA(At, 0, 1); PG8_STAGE(PG8_SA(0, 0), a2, voffA);
            PG8_BAR; PG8_WAIT_L(0); PG8_MMA(1, 0, At, B0); PG8_BAR; PG8_SCHED;
            PG8_STAGE(PG8_SB(0, 1), b2 + hstep, voffB);
            PG8_WAIT_V(6); PG8_BAR; PG8_MMA(1, 1, At, B1); PG8_BAR;
            PG8_LDB(B0, 1, 0); PG8_SCHED; PG8_LDA(At, 1, 0); PG8_STAGE(PG8_SA(0, 1), a2 + hstep, voffA);
            PG8_WAIT_L(8); PG8_BAR; PG8_WAIT_L(0); PG8_MMA(0, 0, At, B0); PG8_BAR; PG8_SCHED;
            PG8_LDB(B1, 1, 1); PG8_STAGE(PG8_SB(1, 0), b3, voffB);
            PG8_BAR; PG8_WAIT_L(0); PG8_MMA(0, 1, At, B1); PG8_BAR;
            PG8_LDA(At, 1, 1); PG8_STAGE(PG8_SA(1, 0), a3, voffA);
            PG8_BAR; PG8_WAIT_L(0); PG8_MMA(1, 0, At, B0); PG8_BAR; PG8_SCHED;
            PG8_STAGE(PG8_SB(1, 1), b3 + hstep, voffB);
            PG8_WAIT_V(6); PG8_BAR; PG8_MMA(1, 1, At, B1); PG8_BAR;
        }
        if constexpr (!Epi::AFTER_DRAIN) { E(acc, cur, wr, wc, fr, fq); S.done(cur); }
        if (!has_next) break;
#pragma unroll
        for (int a = 0; a < 2; ++a)
#pragma unroll
            for (int b = 0; b < 2; ++b)
#pragma unroll
                for (int m = 0; m < 4; ++m)
#pragma unroll
                    for (int n = 0; n < 2; ++n) acc[a][b][m][n] = (f32x4){0.f, 0.f, 0.f, 0.f};
        cur = nxt; cA = nA; cB = nB; ++ui;
    }
    PG8_WAIT_V(0);
    if (wr == 0) PG8_BAR;
    PG8_BAR;
    if constexpr (Epi::AFTER_DRAIN) { E.fused(acc, cur, wr, wc, fr, fq, lds, wid, lane); S.done(cur); }
#undef PG8_SA
#undef PG8_SB
#undef PG8_STAGE
#undef PG8_LDA
#undef PG8_LDB
#undef PG8_MMA
#undef PG8_WAIT_V
#undef PG8_WAIT_L
#undef PG8_BAR
#undef PG8_SCHED
}
}

__device__ __forceinline__ float ssq_total(const float* __restrict__ SSQ, int t) {
  const f32x4 a = *(const f32x4*)(SSQ + (size_t)t * 16), b = *(const f32x4*)(SSQ + (size_t)t * 16 + 4), c = *(const f32x4*)(SSQ + (size_t)t * 16 + 8), d = *(const f32x4*)(SSQ + (size_t)t * 16 + 12);
  return (((a.x + a.y) + (a.z + a.w)) + ((b.x + b.y) + (b.z + b.w))) + (((c.x + c.y) + (c.z + c.w)) + ((d.x + d.y) + (d.z + d.w)));
}
struct EpiProj {
  static constexpr bool PERM = true, AFTER_DRAIN = false;
  bf16_t* PROJ; bf16_t* VTA; bf16_t* VTR;
  __device__ __forceinline__ void operator()(const f32x4 (&acc)[2][2][4][2], const pg8::Unit& u, int wr, int wc, int fr, int fq) const {
    const int row0 = u.pm * 256 + wr * 64 + fr, col0 = u.pn * 256 + wc * 32 + 8 * fq;
    asm volatile("s_nop 15\n\ts_nop 15" ::: "memory");
#pragma unroll
    for (int ai = 0; ai < 2; ++ai)
#pragma unroll
      for (int m = 0; m < 4; ++m) {
        const int t = row0 + ai * 128 + m * 16;
#pragma unroll
        for (int bj = 0; bj < 2; ++bj) {
          const int c = col0 + bj * 128;
          const f32x4 v0 = acc[ai][bj][m][0], v1 = acc[ai][bj][m][1];
          pg8::u32x4 w; w.x = pg8::cvt_pk_bf16(v0[0], v0[1]); w.y = pg8::cvt_pk_bf16(v0[2], v0[3]); w.z = pg8::cvt_pk_bf16(v1[0], v1[1]); w.w = pg8::cvt_pk_bf16(v1[2], v1[3]);
          *(pg8::u32x4*)(PROJ + (size_t)t * INCP + c) = w;
          const bool isva = (c >= C_VA && c < C_VA + 384), isvr = (c >= C_VR && c < C_VR + 384);
          if (isva || isvr) {
            bf16_t* vt = (isva ? VTA : VTR) + ((size_t)(t >> 13) * 384 + (c - (isva ? C_VA : C_VR))) * 8192 + (t & 8191);
            vt[0] = (bf16_t)(w.x & 0xffffu); vt[8192] = (bf16_t)(w.x >> 16); vt[2 * 8192] = (bf16_t)(w.y & 0xffffu); vt[3 * 8192] = (bf16_t)(w.y >> 16);
            vt[4 * 8192] = (bf16_t)(w.z & 0xffffu); vt[5 * 8192] = (bf16_t)(w.z >> 16); vt[6 * 8192] = (bf16_t)(w.w & 0xffffu); vt[7 * 8192] = (bf16_t)(w.w >> 16);
          }
        }
      }
  }
};
struct EpiOut {
  static constexpr bool PERM = true, AFTER_DRAIN = false;
  const float* xin; int first; bf16_t* X; const float* g1; const float* nf; const float* sc2; bf16_t* XG; float* SSQ;
  __device__ __forceinline__ void operator()(const f32x4 (&acc)[2][2][4][2], const pg8::Unit& u, int wr, int wc, int fr, int fq) const {
    const int row0 = u.pm * 256 + wr * 64 + fr, col0 = u.pn * 256 + wc * 32 + 8 * fq, b = (u.pm * 256) >> 13;
    f32x4 gg[2][2], gs[2][2];
#pragma unroll
    for (int bj = 0; bj < 2; ++bj)
#pragma unroll
      for (int n = 0; n < 2; ++n) {
        const int c = col0 + bj * 128 + n * 4;
        gg[bj][n] = *(const f32x4*)(g1 + b * 6144 + c);
        const f32x4 gf = *(const f32x4*)(nf + c), sc = *(const f32x4*)(sc2 + b * 6144 + c);
        gs[bj][n] = gf * (sc + 1.f);
      }
#pragma unroll
    for (int ai = 0; ai < 2; ++ai)
#pragma unroll
      for (int m = 0; m < 4; ++m) {
        const int t = row0 + ai * 128 + m * 16;
        float sq = 0.f;
#pragma unroll
        for (int bj = 0; bj < 2; ++bj) {
          const int c = col0 + bj * 128;
          f32x4 x0, x1;
          if (first) { x0 = *(const f32x4*)(xin + (size_t)t * 1024 + c); x1 = *(const f32x4*)(xin + (size_t)t * 1024 + c + 4); }
          else {
            const pg8::u32x4 xr = *(const pg8::u32x4*)(X + (size_t)t * 1024 + c);
            x0 = (f32x4){__uint_as_float(xr.x << 16), __uint_as_float(xr.x & 0xffff0000u), __uint_as_float(xr.y << 16), __uint_as_float(xr.y & 0xffff0000u)};
            x1 = (f32x4){__uint_as_float(xr.z << 16), __uint_as_float(xr.z & 0xffff0000u), __uint_as_float(xr.w << 16), __uint_as_float(xr.w & 0xffff0000u)};
          }
          const f32x4 n0 = x0 + gg[bj][0] * acc[ai][bj][m][0], n1 = x1 + gg[bj][1] * acc[ai][bj][m][1];
          pg8::u32x4 xo; xo.x = pg8::cvt_pk_bf16(n0.x, n0.y); xo.y = pg8::cvt_pk_bf16(n0.z, n0.w); xo.z = pg8::cvt_pk_bf16(n1.x, n1.y); xo.w = pg8::cvt_pk_bf16(n1.z, n1.w);
          *(pg8::u32x4*)(X + (size_t)t * 1024 + c) = xo;
          const f32x4 s0 = n0 * gs[bj][0], s1 = n1 * gs[bj][1];
          pg8::u32x4 go; go.x = pg8::cvt_pk_bf16(s0.x, s0.y); go.y = pg8::cvt_pk_bf16(s0.z, s0.w); go.z = pg8::cvt_pk_bf16(s1.x, s1.y); go.w = pg8::cvt_pk_bf16(s1.z, s1.w);
          *(pg8::u32x4*)(XG + (size_t)t * 1024 + c) = go;
          sq += ((n0.x * n0.x + n0.y * n0.y) + (n0.z * n0.z + n0.w * n0.w)) + ((n1.x * n1.x + n1.y * n1.y) + (n1.z * n1.z + n1.w * n1.w));
        }
        sq += __shfl_xor(sq, 16); sq += __shfl_xor(sq, 32);
        if (fq == 0) SSQ[(size_t)t * 16 + u.pn * 4 + wc] = sq;
      }
  }
};
struct EpiQ {
  static constexpr bool PERM = true, AFTER_DRAIN = false;
  bf16_t* SC8; const float* SSQ; const float* C2;
  __device__ __forceinline__ void operator()(const f32x4 (&acc)[2][2][4][2], const pg8::Unit& u, int wr, int wc, int fr, int fq) const {
    const int row0 = u.pm * 256 + wr * 64 + fr, col0 = u.pn * 256 + wc * 32 + 8 * fq, b = (u.pm * 256) >> 13;
    f32x4 cc[2][2];
#pragma unroll
    for (int bj = 0; bj < 2; ++bj) { cc[bj][0] = *(const f32x4*)(C2 + b * 2048 + col0 + bj * 128); cc[bj][1] = *(const f32x4*)(C2 + b * 2048 + col0 + bj * 128 + 4); }
#pragma unroll
    for (int ai = 0; ai < 2; ++ai)
#pragma unroll
      for (int m = 0; m < 4; ++m) {
        const int t = row0 + ai * 128 + m * 16;
        const float rstd = rsqrtf(ssq_total(SSQ, t) * (1.f / 1024.f) + EPS_);
#pragma unroll
        for (int bj = 0; bj < 2; ++bj) {
          const f32x4 v0 = acc[ai][bj][m][0] * rstd + cc[bj][0], v1 = acc[ai][bj][m][1] * rstd + cc[bj][1];
          pg8::u32x4 w; w.x = pg8::cvt_pk_bf16(v0[0], v0[1]); w.y = pg8::cvt_pk_bf16(v0[2], v0[3]); w.z = pg8::cvt_pk_bf16(v1[0], v1[1]); w.w = pg8::cvt_pk_bf16(v1[2], v1[3]);
          *(pg8::u32x4*)(SC8 + ((size_t)((col0 + bj * 128) >> 3) * T_ + t) * 8) = w;
        }
      }
  }
};

__device__ void gemm_proj_phase(const Params& p, int l, unsigned char* smem) {
  const CParamsP pp = launder_kargs();
  GAS unsigned char* const ws = launder_ptr(pp->ws);
  pg8::Gemm g; g.A = (const bf16_t*)(ws + WS_ABUF); g.Bt = (const bf16_t*)(ws + WS_WIN) + (size_t)l * INCP * 1024; g.M = T_; g.N = INCP; g.K = 1024;
  pg8::StaticOrder S; S.init(T_, INCP, gridDim.x, blockIdx.x);
  EpiProj E; E.PROJ = (bf16_t*)(ws + WS_PROJ); E.VTA = (bf16_t*)(ws + WS_VTA); E.VTR = (bf16_t*)(ws + WS_VTR);
  pg8::gemm_phase<EpiProj, pg8::StaticOrder>((PG8_LAS unsigned char*)smem, g, S, E);
}
__device__ void gemm_out_phase(const Params& p, int l, unsigned char* smem) {
  const CParamsP pp = launder_kargs();
  GAS unsigned char* const ws = launder_ptr(pp->ws);
  pg8::Gemm g; g.A = (const bf16_t*)(ws + WS_ABUF); g.Bt = (const bf16_t*)(ws + WS_WOUT) + (size_t)l * 1024 * 1024; g.M = T_; g.N = 1024; g.K = 1024;
  pg8::StaticOrder S; S.init(T_, 1024, gridDim.x, blockIdx.x);
  EpiOut E; E.xin = gin(pp->in[I_X]); E.first = (l == 0) ? 1 : 0; E.X = (bf16_t*)(ws + WS_X); E.g1 = (const float*)(ws + WS_MOD) + (size_t)l * 2 * 6144 + 2048;
  E.nf = gin(pp->in[I_NFFN]) + (size_t)l * 1024; E.sc2 = (const float*)(ws + WS_MOD) + (size_t)l * 2 * 6144 + 4096; E.XG = (bf16_t*)(ws + WS_XG); E.SSQ = (float*)(ws + WS_SSQ);
  pg8::gemm_phase<EpiOut, pg8::StaticOrder>((PG8_LAS unsigned char*)smem, g, S, E);
}
__device__ void gemm_q_phase(const Params& p, int l, unsigned char* smem) {
  const CParamsP pp = launder_kargs();
  GAS unsigned char* const ws = launder_ptr(pp->ws);
  pg8::Gemm g; g.A = (const bf16_t*)(ws + WS_XG); g.Bt = (const bf16_t*)(ws + WS_WQ) + (size_t)l * 2048 * 1024; g.M = T_; g.N = 2048; g.K = 1024;
  pg8::StaticOrder S; S.init(T_, 2048, gridDim.x, blockIdx.x);
  EpiQ E; E.SC8 = (bf16_t*)(ws + WS_SC); E.SSQ = (const float*)(ws + WS_SSQ); E.C2 = (const float*)(ws + WS_C2) + (size_t)l * 2 * 2048;
  pg8::gemm_phase<EpiQ, pg8::StaticOrder>((PG8_LAS unsigned char*)smem, g, S, E);
}

__device__ __forceinline__ int attn_fk(int r) { return ((r >> 3) & 3) | (((r >> 1) & 1) << 2); }
__device__ __forceinline__ int attn_fv(int r) { return (r >> 1) & 7; }
__device__ void attn_phase(const Params& p, int l, unsigned char* smem) {
  const CParamsP pp = launder_kargs();
  GAS unsigned char* const ws = launder_ptr(pp->ws); const int tidx = launder_tid();
  const bf16_t* PROJ = (const bf16_t*)(ws + WS_PROJ); const bf16_t* VTA = (const bf16_t*)(ws + WS_VTA);
  bf16_t* ATT = (bf16_t*)(ws + WS_ATT);
  const int lane = tidx & 63, wid = tidx >> 6, fr = lane & 15, fq = lane >> 4;
  float* ext = (float*)smem;
  unsigned char* stg = smem + 15360;
  constexpr float LOG2E = 1.4426950408889634f;
  __syncthreads();
  for (int idx = tidx; idx < 6 * 640; idx += NT) {
    const int h = idx / 640, e = idx - h * 640; int d = e - 63; d = d > 256 ? 256 : d;
    ext[idx] = gin(pp->in[I_RELB])[((size_t)l * 6 + h) * 513 + d + 256] * LOG2E;
  }
  const int hh = wid >> 2, qb = wid & 3, iq = qb * 16 + fr;
  const int srow = tidx >> 3, sch = tidx & 7;
  for (int it_ = blockIdx.x; it_ < 256; it_ += gridDim.x) {
    const int item = ((it_ & 7) << 5) | (it_ >> 3);
    const int b = item >> 7, n = item & 127, t0 = b * 8192 + n * 64;
    const int jc0 = n >= 8 ? 0 : 8 - n, nch = 9 - jc0, nst = 3 * nch;
    uint4 sa0, sa1, sa2, sa3, sb0, sb1, sb2, sb3;
#define ATTN_LOAD(S, st) do { const int _rd = (st) / nch, _jc = jc0 + (st) - _rd * nch, _m = n - 8 + _jc; \
      S##0 = *(const uint4*)(PROJ + (size_t)(b * 8192 + _m * 64 + srow) * INCP + C_KA + (2 * _rd) * 64 + sch * 8); \
      S##1 = *(const uint4*)(PROJ + (size_t)(b * 8192 + _m * 64 + srow) * INCP + C_KA + (2 * _rd + 1) * 64 + sch * 8); \
      S##2 = *(const uint4*)(VTA + ((size_t)b * 384 + (2 * _rd) * 64 + srow) * 8192 + _m * 64 + sch * 8); \
      S##3 = *(const uint4*)(VTA + ((size_t)b * 384 + (2 * _rd + 1) * 64 + srow) * 8192 + _m * 64 + sch * 8); } while (0)
#define ATTN_WRITE(S, buf) do { unsigned char* _bp = stg + (buf) * 32768; \
      *(uint4*)(_bp + srow * 128 + ((sch ^ attn_fk(srow)) << 4)) = S##0; \
      *(uint4*)(_bp + 8192 + srow * 128 + ((sch ^ attn_fk(srow)) << 4)) = S##1; \
      *(uint4*)(_bp + 16384 + srow * 128 + ((sch ^ attn_fv(srow)) << 4)) = S##2; \
      *(uint4*)(_bp + 24576 + srow * 128 + ((sch ^ attn_fv(srow)) << 4)) = S##3; } while (0)
    __syncthreads();
    ATTN_LOAD(sa, 0);
    ATTN_WRITE(sa, 0);
    if (1 < nst) ATTN_LOAD(sb, 1);
    __syncthreads();
    bf16x8 qf[2];
    f32x4 o[4];
    float mrun = -1e30f, lrun = 0.f;
    const float* exth = ext;
    auto attn_compute = [&](const int st) {
      const int rd = st / nch, jc = jc0 + st - rd * nch, h = 2 * rd + hh;
      if (jc == jc0) {
#pragma unroll
        for (int ds = 0; ds < 2; ++ds) qf[ds] = *(const bf16x8*)(PROJ + (size_t)(t0 + iq) * INCP + C_QA + h * 64 + ds * 32 + fq * 8);
#pragma unroll
        for (int et = 0; et < 4; ++et) o[et] = (f32x4){0.f, 0.f, 0.f, 0.f};
        mrun = -1e30f; lrun = 0.f;
        exth = ext + h * 640 + 63 + 512 + iq - 8 * fq;
      }
      const unsigned char* kb = stg + (st & 1) * 32768 + hh * 8192;
      const unsigned char* vb = stg + (st & 1) * 32768 + (2 + hh) * 8192;
      float sc[2][2][4];
      bf16x8 kfr[2][2][2], vfr[2][4]; float bia[2][2][4];
#pragma unroll
      for (int g = 0; g < 2; ++g)
#pragma unroll
        for (int tt = 0; tt < 2; ++tt) {
          const int key = 32 * g + 8 * (fr >> 2) + (fr & 3) + 4 * tt, fk = attn_fk(key);
          kfr[g][tt][0] = *(const bf16x8*)(kb + key * 128 + ((fq ^ fk) << 4));
          kfr[g][tt][1] = *(const bf16x8*)(kb + key * 128 + (((4 + fq) ^ fk) << 4));
        }
#pragma unroll
      for (int g = 0; g < 2; ++g)
#pragma unroll
        for (int tt = 0; tt < 2; ++tt)
#pragma unroll
          for (int j = 0; j < 4; ++j) bia[g][tt][j] = exth[-(64 * jc + 32 * g + 4 * tt + j)];
#pragma unroll
      for (int g = 0; g < 2; ++g)
#pragma unroll
        for (int et = 0; et < 4; ++et) { const int er = 16 * et + fr; vfr[g][et] = *(const bf16x8*)(vb + er * 128 + (((4 * g + fq) ^ attn_fv(er)) << 4)); }
      __builtin_amdgcn_sched_barrier(0);
#pragma unroll
      for (int g = 0; g < 2; ++g)
#pragma unroll
        for (int tt = 0; tt < 2; ++tt) {
          f32x4 s4 = __builtin_amdgcn_mfma_f32_16x16x32_bf16(kfr[g][tt][0], qf[0], (f32x4){0.f, 0.f, 0.f, 0.f}, 0, 0, 0);
          s4 = __builtin_amdgcn_mfma_f32_16x16x32_bf16(kfr[g][tt][1], qf[1], s4, 0, 0, 0);
#pragma unroll
          for (int j = 0; j < 4; ++j) sc[g][tt][j] = s4[j] * (0.125f * LOG2E) + bia[g][tt][j];
        }
      float mloc = -1e30f;
#pragma unroll
      for (int g = 0; g < 2; ++g)
#pragma unroll
        for (int tt = 0; tt < 2; ++tt)
#pragma unroll
          for (int j = 0; j < 4; ++j) mloc = fmaxf(mloc, sc[g][tt][j]);
      mloc = fmaxf(mloc, __shfl_xor(mloc, 16)); mloc = fmaxf(mloc, __shfl_xor(mloc, 32));
      const float mnew = fmaxf(mrun, mloc), alpha = __builtin_amdgcn_exp2f(mrun - mnew);
      mrun = mnew;
      float ls = 0.f;
#pragma unroll
      for (int g = 0; g < 2; ++g)
#pragma unroll
        for (int tt = 0; tt < 2; ++tt)
#pragma unroll
          for (int j = 0; j < 4; ++j) { const float e = __builtin_amdgcn_exp2f(sc[g][tt][j] - mnew); sc[g][tt][j] = e; ls += e; }
      lrun = lrun * alpha + ls;
#pragma unroll
      for (int et = 0; et < 4; ++et) { o[et].x *= alpha; o[et].y *= alpha; o[et].z *= alpha; o[et].w *= alpha; }
#pragma unroll
      for (int g = 0; g < 2; ++g) {
        union { bf16x8 v; unsigned u[4]; } pf;
        pf.u[0] = pk2(sc[g][0][0], sc[g][0][1]); pf.u[1] = pk2(sc[g][0][2], sc[g][0][3]);
        pf.u[2] = pk2(sc[g][1][0], sc[g][1][1]); pf.u[3] = pk2(sc[g][1][2], sc[g][1][3]);
#pragma unroll
        for (int et = 0; et < 4; ++et) o[et] = __builtin_amdgcn_mfma_f32_16x16x32_bf16(vfr[g][et], pf.v, o[et], 0, 0, 0);
      }
      if (jc == 8) {
        float lt = lrun + __shfl_xor(lrun, 16); lt += __shfl_xor(lt, 32);
        const float inv = 1.f / lt;
#pragma unroll
        for (int et = 0; et < 4; ++et) {
          f32x4 v = o[et]; v.x *= inv; v.y *= inv; v.z *= inv; v.w *= inv;
          { uint2 ov; ov.x = pk2(v.x, v.y); ov.y = pk2(v.z, v.w); *(uint2*)(ATT + (size_t)(t0 + iq) * 384 + h * 64 + et * 16 + fq * 4) = ov; }
        }
      }
    };
#pragma unroll 1
    for (int st0 = 0; st0 < nst; st0 += 2) {
      { const int st = st0;
        if (st + 2 < nst) ATTN_LOAD(sa, st + 2);
        attn_compute(st);
        if (st + 1 < nst) ATTN_WRITE(sb, (st + 1) & 1);
        __syncthreads(); }
      if (st0 + 1 < nst) { const int st = st0 + 1;
        if (st + 2 < nst) ATTN_LOAD(sb, st + 2);
        attn_compute(st);
        if (st + 1 < nst) ATTN_WRITE(sa, (st + 1) & 1);
        __syncthreads(); }
    }
#undef ATTN_LOAD
#undef ATTN_WRITE
  }
  __syncthreads();
}

__device__ __forceinline__ void ssm_bu32(const bf16_t* __restrict__ bbh_g, const bf16_t* __restrict__ urow, int lane,
                                         f32x16& lo_re, f32x16& hi_re, f32x16& lo_im, f32x16& hi_im) {
  const int hf = lane >> 5;
  const bf16x8 ub = *(const bf16x8*)(urow + 8 * hf);
  f32x16 z;
#pragma unroll
  for (int r = 0; r < 16; ++r) z[r] = 0.f;
  const bf16x8 a0r = *(const bf16x8*)(bbh_g + (size_t)(0 * 64 + lane) * 8), a1r = *(const bf16x8*)(bbh_g + (size_t)(1 * 64 + lane) * 8);
  const bf16x8 a0i = *(const bf16x8*)(bbh_g + (size_t)(2 * 64 + lane) * 8), a1i = *(const bf16x8*)(bbh_g + (size_t)(3 * 64 + lane) * 8);
  lo_re = __builtin_amdgcn_mfma_f32_32x32x16_bf16(ub, a0r, z, 0, 0, 0); hi_re = __builtin_amdgcn_mfma_f32_32x32x16_bf16(ub, a1r, z, 0, 0, 0);
  lo_im = __builtin_amdgcn_mfma_f32_32x32x16_bf16(ub, a0i, z, 0, 0, 0); hi_im = __builtin_amdgcn_mfma_f32_32x32x16_bf16(ub, a1i, z, 0, 0, 0);
#pragma unroll
  for (int r = 0; r < 16; ++r) {
    const auto s1 = __builtin_amdgcn_permlane32_swap(__float_as_uint(lo_re[r]), __float_as_uint(hi_re[r]), false, false);
    lo_re[r] = __uint_as_float(s1[0]); hi_re[r] = __uint_as_float(s1[1]);
    const auto s2 = __builtin_amdgcn_permlane32_swap(__float_as_uint(lo_im[r]), __float_as_uint(hi_im[r]), false, false);
    lo_im[r] = __uint_as_float(s2[0]); hi_im[r] = __uint_as_float(s2[1]);
  }
}
__device__ __forceinline__ void rotary_frag(const bf16x8 x0, const bf16x8 x1, const float* RC, const float* RS, int pos, int fq, float scale, bf16x8& o0, bf16x8& o1) {
  const f32x4 c0 = *(const f32x4*)(RC + pos * 32 + 8 * fq), c1 = *(const f32x4*)(RC + pos * 32 + 8 * fq + 4);
  const f32x4 s0 = *(const f32x4*)(RS + pos * 32 + 8 * fq), s1 = *(const f32x4*)(RS + pos * 32 + 8 * fq + 4);
  const float cc[8] = {c0.x, c0.y, c0.z, c0.w, c1.x, c1.y, c1.z, c1.w}, sn[8] = {s0.x, s0.y, s0.z, s0.w, s1.x, s1.y, s1.z, s1.w};
  union { bf16x8 v; unsigned u[4]; } r0, r1;
#pragma unroll
  for (int q = 0; q < 4; ++q) {
    const float a0 = bf2f((bf16_t)x0[2 * q]) * scale, a1 = bf2f((bf16_t)x0[2 * q + 1]) * scale, b0 = bf2f((bf16_t)x1[2 * q]) * scale, b1 = bf2f((bf16_t)x1[2 * q + 1]) * scale;
    r0.u[q] = pk2(a0 * cc[2 * q] - b0 * sn[2 * q], a1 * cc[2 * q + 1] - b1 * sn[2 * q + 1]);
    r1.u[q] = pk2(a0 * sn[2 * q] + b0 * cc[2 * q], a1 * sn[2 * q + 1] + b1 * cc[2 * q + 1]);
  }
  o0 = r0.v; o1 = r1.v;
}
__device__ void mix_local_phase(const Params& p, int l, unsigned char* smem) {
  const CParamsP pp = launder_kargs();
  GAS unsigned char* const ws = launder_ptr(pp->ws); const int tidx = launder_tid();
  const bf16_t* PROJ = (const bf16_t*)(ws + WS_PROJ); const bf16_t* VTR = (const bf16_t*)(ws + WS_VTR);
  const float* RC = (const float*)(ws + WS_ROTC); const float* RS = (const float*)(ws + WS_ROTS);
  bf16_t* YINT = (bf16_t*)(ws + WS_YINT); float* UPDT = (float*)(ws + WS_UPD);
  const float* SA = (const float*)(ws + WS_SA) + (size_t)l * 16 * 64 * 2; const bf16_t* BBH = (const bf16_t*)(ws + WS_BBH) + (size_t)l * 16 * 2 * 64 * 16;
  float* SEND = (float*)(ws + WS_SEND);
  const int tid = tidx, lane = tid & 63, wid = tid >> 6, fr = lane & 15, fq = lane >> 4;
  bf16_t* KT = (bf16_t*)smem;
  float* rcL = (float*)(smem + 55296); float* rsL = rcL + 2048;
  for (int it_ = blockIdx.x; it_ < 256; it_ += gridDim.x) {
    const int item = ((it_ & 7) << 5) | (it_ >> 3);
    const int b = item >> 7, n = item & 127, t0 = b * 8192 + n * 64;
    __syncthreads();
#pragma unroll
    for (int i = 0; i < 4; ++i) { rcL[tid + NT * i] = RC[n * 2048 + tid + NT * i]; rsL[tid + NT * i] = RS[n * 2048 + tid + NT * i]; }
    __syncthreads();
#pragma unroll 1
    for (int k3 = 0; k3 < 3; ++k3) {
      const int task = wid * 3 + k3, h = task >> 2, tb = task & 3;
      const int i = 16 * tb + fr;
      const float lg2 = log2f(1.f - exp2f(-5.f - (float)h));
      bf16x8 qraw[2], kraw[2][2][2], vraw[2][4];
      {
        const bf16_t* qp = PROJ + (size_t)(t0 + i) * INCP + C_QR + h * 64 + 8 * fq;
        qraw[0] = *(const bf16x8*)qp; qraw[1] = *(const bf16x8*)(qp + 32);
#pragma unroll
        for (int g = 0; g < 2; ++g) {
#pragma unroll
          for (int tt = 0; tt < 2; ++tt) {
            const int key = 32 * g + 8 * (fr >> 2) + (fr & 3) + 4 * tt;
            const bf16_t* kp = PROJ + (size_t)(t0 + key) * INCP + C_KR + h * 64 + 8 * fq;
            kraw[g][tt][0] = *(const bf16x8*)kp; kraw[g][tt][1] = *(const bf16x8*)(kp + 32);
          }
#pragma unroll
          for (int et = 0; et < 4; ++et) vraw[g][et] = *(const bf16x8*)(VTR + ((size_t)b * 384 + h * 64 + et * 16 + fr) * 8192 + n * 64 + 32 * g + 8 * fq);
        }
      }
      __builtin_amdgcn_sched_barrier(0);
      bf16x8 qf0, qf1;
      rotary_frag(qraw[0], qraw[1], rcL, rsL, i, fq, 1.f, qf0, qf1);
      f32x4 o[4];
#pragma unroll
      for (int et = 0; et < 4; ++et) o[et] = (f32x4){0.f, 0.f, 0.f, 0.f};
#pragma unroll
      for (int g = 0; g < 2; ++g) {
        float st[2][4];
#pragma unroll
        for (int tt = 0; tt < 2; ++tt) {
          const int key = 32 * g + 8 * (fr >> 2) + (fr & 3) + 4 * tt;
          bf16x8 kf0, kf1;
          rotary_frag(kraw[g][tt][0], kraw[g][tt][1], rcL, rsL, key, fq, 0.125f, kf0, kf1);
          f32x4 s4 = __builtin_amdgcn_mfma_f32_16x16x32_bf16(kf0, qf0, (f32x4){0.f, 0.f, 0.f, 0.f}, 0, 0, 0);
          s4 = __builtin_amdgcn_mfma_f32_16x16x32_bf16(kf1, qf1, s4, 0, 0, 0);
#pragma unroll
          for (int j = 0; j < 4; ++j) {
            const int kk = 32 * g + 8 * fq + 4 * tt + j;
            const int dij = i > kk ? i - kk : kk - i;
            st[tt][j] = s4[j] * exp2f(lg2 * (float)dij);
          }
          if (tb == 0) {
            const float kd = exp2f(lg2 * (float)(63 - key));
#pragma unroll
            for (int jj = 0; jj < 8; ++jj) {
              KT[(h * 64 + 8 * fq + jj) * 72 + key] = f2bf(bf2f((bf16_t)kf0[jj]) * kd);
              KT[(h * 64 + 32 + 8 * fq + jj) * 72 + key] = f2bf(bf2f((bf16_t)kf1[jj]) * kd);
            }
          }
        }
        union { bf16x8 v; unsigned u[4]; } pf;
        pf.u[0] = pk2(st[0][0], st[0][1]); pf.u[1] = pk2(st[0][2], st[0][3]); pf.u[2] = pk2(st[1][0], st[1][1]); pf.u[3] = pk2(st[1][2], st[1][3]);
#pragma unroll
        for (int et = 0; et < 4; ++et) o[et] = __builtin_amdgcn_mfma_f32_16x16x32_bf16(vraw[g][et], pf.v, o[et], 0, 0, 0);
      }
#pragma unroll
      for (int et = 0; et < 4; ++et) { uint2 ov; ov.x = pk2(o[et].x, o[et].y); ov.y = pk2(o[et].z, o[et].w); *(uint2*)(YINT + (((((size_t)item * 6 + h) * 4 + tb) * 4 + et) * 64 + lane) * 4) = ov; }
    }
    __syncthreads();
#pragma unroll 1
    for (int k3 = 0; k3 < 3; ++k3) {
      const int task = wid * 3 + k3, h = task >> 2, et = task & 3;
      f32x4 acc[4];
#pragma unroll
      for (int dt = 0; dt < 4; ++dt) acc[dt] = (f32x4){0.f, 0.f, 0.f, 0.f};
#pragma unroll
      for (int g = 0; g < 2; ++g) {
        const bf16x8 vf = *(const bf16x8*)(VTR + ((size_t)b * 384 + h * 64 + et * 16 + fr) * 8192 + n * 64 + 32 * g + 8 * fq);
#pragma unroll
        for (int dt = 0; dt < 4; ++dt) {
          const bf16x8 kt = *(const bf16x8*)(KT + (h * 64 + 16 * dt + fr) * 72 + 32 * g + 8 * fq);
          acc[dt] = __builtin_amdgcn_mfma_f32_16x16x32_bf16(kt, vf, acc[dt], 0, 0, 0);
        }
      }
#pragma unroll
      for (int dt = 0; dt < 4; ++dt) *(f32x4*)(UPDT + (((size_t)item * 6 + h) * 64 + 16 * et + fr) * 64 + 16 * dt + 4 * fq) = acc[dt];
    }
#pragma unroll 1
    for (int gi = 0; gi < 2; ++gi) {
      const int g = wid * 2 + gi;
      const float are = SA[(g * 64 + lane) * 2], aim = SA[(g * 64 + lane) * 2 + 1];
      float xr = 0.f, xi = 0.f;
#pragma unroll 1
      for (int blk = 0; blk < 2; ++blk) {
        f32x16 lr, hr, li, hi;
        ssm_bu32(BBH + (size_t)g * 2 * 64 * 16, PROJ + (size_t)(t0 + 32 * blk + (lane & 31)) * INCP + C_US + g * 16, lane, lr, hr, li, hi);
#pragma unroll
        for (int a4 = 0; a4 < 4; ++a4) {
#pragma unroll
          for (int bq = 0; bq < 4; ++bq) { const float nr = are * xr - aim * xi + lr[4 * a4 + bq], ni = are * xi + aim * xr + li[4 * a4 + bq]; xr = nr; xi = ni; }
#pragma unroll
          for (int bq = 0; bq < 4; ++bq) { const float nr = are * xr - aim * xi + hr[4 * a4 + bq], ni = are * xi + aim * xr + hi[4 * a4 + bq]; xr = nr; xi = ni; }
        }
      }
      SEND[(((size_t)item * 16 + g) * 64 + lane) * 2] = xr; SEND[(((size_t)item * 16 + g) * 64 + lane) * 2 + 1] = xi;
    }
  }
}

__device__ void scan_phase(const Params& p, int l) {
  const CParamsP pp = launder_kargs();
  GAS unsigned char* const ws = launder_ptr(pp->ws); const int tidx = launder_tid();
  const float* __restrict__ UPDT = (const float*)(ws + WS_UPD); bf16_t* __restrict__ SPT = (bf16_t*)(ws + WS_SPT);
  const float* __restrict__ SEND = (const float*)(ws + WS_SEND); float* __restrict__ CARRY = (float*)(ws + WS_CARRY);
  const float* SA = (const float*)(ws + WS_SA) + (size_t)l * 16 * 64 * 2;
  const int gtid = blockIdx.x * NT + tidx, gn = gridDim.x * NT;
  for (int idx = gtid; idx < 2 * 6 * 4096 + 2 * 1024; idx += gn) {
    if (idx < 2 * 6 * 4096) {
      const int b = idx / (6 * 4096), r = idx % (6 * 4096), h = r >> 12;
      const float cd = exp2f(64.f * log2f(1.f - exp2f(-5.f - (float)h)));
      const int e_ = (r >> 6) & 63, d_ = r & 63;
      const int spoff = h * 4096 + ((((e_ >> 4) * 2 + (d_ >> 5)) * 64 + ((d_ >> 3) & 3) * 16 + (e_ & 15)) * 8 + (d_ & 7));
      float s = 0.f;
#pragma unroll 1
      for (int nb = 0; nb < NCH; nb += 16) {
        float v[16];
#pragma unroll
        for (int j = 0; j < 16; ++j) v[j] = UPDT[((size_t)(b * NCH + nb + j)) * 6 * 4096 + r];
#pragma unroll
        for (int j = 0; j < 16; ++j) { SPT[((size_t)(b * NCH + nb + j)) * 6 * 4096 + spoff] = f2bf(s); s = cd * s + v[j]; }
      }
    } else {
      const int r2 = idx - 2 * 6 * 4096, b = r2 >> 10, gp = r2 & 1023;
      float ar = SA[gp * 2], ai = SA[gp * 2 + 1];
#pragma unroll
      for (int q = 0; q < 6; ++q) { const float nr = ar * ar - ai * ai, ni = 2.f * ar * ai; ar = nr; ai = ni; }
      float xr = 0.f, xi = 0.f;
#pragma unroll 1
      for (int nb = 0; nb < NCH; nb += 16) {
        float2 v[16];
#pragma unroll
        for (int j = 0; j < 16; ++j) v[j] = *(const float2*)(SEND + (((size_t)(b * NCH + nb + j)) * 1024 + gp) * 2);
#pragma unroll
        for (int j = 0; j < 16; ++j) {
          *(float2*)(CARRY + (((size_t)(b * NCH + nb + j)) * 1024 + gp) * 2) = make_float2(xr, xi);
          const float nr = ar * xr - ai * xi + v[j].x, ni = ar * xi + ai * xr + v[j].y;
          xr = nr; xi = ni;
        }
      }
    }
  }
  if (l + 1 < DEPTH_) convert_tables_fp4(pp, ws, l + 1, gtid, gn);
}

__device__ void mix_final_phase(const Params& p, int l, unsigned char* smem) {
  const CParamsP pp = launder_kargs();
  GAS unsigned char* const ws = launder_ptr(pp->ws); const int tidx = launder_tid();
  const bf16_t* PROJ = (const bf16_t*)(ws + WS_PROJ);
  const float* RC = (const float*)(ws + WS_ROTC); const float* RS = (const float*)(ws + WS_ROTS);
  const bf16_t* YINT = (const bf16_t*)(ws + WS_YINT); const bf16_t* SPT = (const bf16_t*)(ws + WS_SPT);
  const bf16_t* ATT = (const bf16_t*)(ws + WS_ATT);
  const float* SA = (const float*)(ws + WS_SA) + (size_t)l * 16 * 64 * 2; const bf16_t* BBH = (const bf16_t*)(ws + WS_BBH) + (size_t)l * 16 * 2 * 64 * 16;
  const float* CARRY = (const float*)(ws + WS_CARRY);
  const bf16_t* CB = (const bf16_t*)(ws + WS_CB) + (size_t)l * 16 * 16 * 128; const bf16_t* WG = (const bf16_t*)(ws + WS_WGLUT) + (size_t)l * 512 * 256;
  const float* dsk = gin(pp->in[I_SSMD]) + (size_t)l * 256;
  const float* mg = gin(pp->in[I_MGAIN]) + (size_t)l * 1024;
  bf16_t* MRG = (bf16_t*)(ws + WS_ABUF);
  const int tid = tidx, lane = tid & 63, wid = tid >> 6, fr = lane & 15, fq = lane >> 4;
  bf16_t* YS = (bf16_t*)smem;
  float* red = (float*)(smem + 33792);
  bf16_t* XB = (bf16_t*)(smem + 36864 + wid * 8448 + 4096);
  float* rcL = (float*)(smem + 104448); float* rsL = rcL + 2048;
  for (int it_ = blockIdx.x; it_ < 256; it_ += gridDim.x) {
    const int item = ((it_ & 7) << 5) | (it_ >> 3);
    const int b = item >> 7, n = item & 127, t0 = b * 8192 + n * 64;
    __syncthreads();
#pragma unroll
    for (int i = 0; i < 4; ++i) { rcL[tid + NT * i] = RC[n * 2048 + tid + NT * i]; rsL[tid + NT * i] = RS[n * 2048 + tid + NT * i]; }
    __syncthreads();
    {
      float av[8][6], mgl[6];
#pragma unroll
      for (int ii = 0; ii < 8; ++ii)
#pragma unroll
        for (int j = 0; j < 6; ++j) av[ii][j] = bf2f(ATT[(size_t)(t0 + wid * 8 + ii) * 384 + lane + 64 * j]);
#pragma unroll
      for (int j = 0; j < 6; ++j) mgl[j] = mg[lane + 64 * j];
      __builtin_amdgcn_sched_barrier(0);
#pragma unroll
      for (int ii = 0; ii < 8; ++ii) {
        const int t = t0 + wid * 8 + ii;
        float sq = 0.f;
#pragma unroll
        for (int j = 0; j < 6; ++j) sq += av[ii][j] * av[ii][j];
        const float rstd = rsqrtf(wave_sum(sq) * (1.f / 384.f) + EPS_);
#pragma unroll
        for (int j = 0; j < 6; ++j) MRG[(size_t)t * 1024 + lane + 64 * j] = f2bf(av[ii][j] * rstd * mgl[j]);
      }
    }
#pragma unroll 1
    for (int k3 = 0; k3 < 3; ++k3) {
      const int task = wid * 3 + k3, h = task >> 2, tb = task & 3;
      const int i = 16 * tb + fr, t = t0 + i;
      const float lg2 = log2f(1.f - exp2f(-5.f - (float)h));
      bf16x8 qraw[2], spf[4][2]; f32x4 yiv[4], mgq[4]; uint2 grv[4];
      {
        const bf16_t* qp = PROJ + (size_t)t * INCP + C_QR + h * 64 + 8 * fq;
        qraw[0] = *(const bf16x8*)qp; qraw[1] = *(const bf16x8*)(qp + 32);
#pragma unroll
        for (int et = 0; et < 4; ++et) {
          const bf16_t* sp = SPT + ((size_t)item * 6 + h) * 4096 + (size_t)(et * 2) * 512 + lane * 8;
          spf[et][0] = *(const bf16x8*)sp; spf[et][1] = *(const bf16x8*)(sp + 512);
          { const uint2 yr = *(const uint2*)(YINT + (((((size_t)item * 6 + h) * 4 + tb) * 4 + et) * 64 + lane) * 4); yiv[et] = (f32x4){__uint_as_float(yr.x << 16), __uint_as_float(yr.x & 0xffff0000u), __uint_as_float(yr.y << 16), __uint_as_float(yr.y & 0xffff0000u)}; }
          grv[et] = *(const uint2*)(PROJ + (size_t)t * INCP + C_GR + h * 64 + 16 * et + 4 * fq);
          mgq[et] = *(const f32x4*)(mg + 384 + h * 64 + 16 * et + 4 * fq);
        }
      }
      __builtin_amdgcn_sched_barrier(0);
      bf16x8 qf0, qf1;
      rotary_frag(qraw[0], qraw[1], rcL, rsL, i, fq, 1.f, qf0, qf1);
      f32x4 o[4];
#pragma unroll
      for (int et = 0; et < 4; ++et) {
        o[et] = __builtin_amdgcn_mfma_f32_16x16x32_bf16(spf[et][0], qf0, (f32x4){0.f, 0.f, 0.f, 0.f}, 0, 0, 0);
        o[et] = __builtin_amdgcn_mfma_f32_16x16x32_bf16(spf[et][1], qf1, o[et], 0, 0, 0);
      }
      const float qd = exp2f(lg2 * (float)(i + 1));
      float y[16]; float s1 = 0.f;
#pragma unroll
      for (int et = 0; et < 4; ++et) {
        const f32x4 yi = yiv[et];
        y[4 * et] = yi.x + qd * o[et].x; y[4 * et + 1] = yi.y + qd * o[et].y; y[4 * et + 2] = yi.z + qd * o[et].z; y[4 * et + 3] = yi.w + qd * o[et].w;
        s1 += (y[4 * et] + y[4 * et + 1]) + (y[4 * et + 2] + y[4 * et + 3]);
      }
      s1 += __shfl_xor(s1, 16); s1 += __shfl_xor(s1, 32);
      const float mu = s1 * (1.f / 64.f);
      float s2 = 0.f;
#pragma unroll
      for (int q = 0; q < 16; ++q) { y[q] -= mu; s2 += y[q] * y[q]; }
      s2 += __shfl_xor(s2, 16); s2 += __shfl_xor(s2, 32);
      const float rstd = rsqrtf(s2 * (1.f / 64.f) + EPS_);
#pragma unroll
      for (int et = 0; et < 4; ++et) {
        const int c = h * 64 + 16 * et + 4 * fq;
        const uint2 gr = grv[et];
        const float g0 = __uint_as_float(gr.x << 16), g1 = __uint_as_float(gr.x & 0xffff0000u), g2 = __uint_as_float(gr.y << 16), g3 = __uint_as_float(gr.y & 0xffff0000u);
        const f32x4 mgv = mgq[et];
        uint2 ov;
        ov.x = pk2(y[4 * et] * rstd * (g0 * sigmoid_f(g0)) * mgv.x, y[4 * et + 1] * rstd * (g1 * sigmoid_f(g1)) * mgv.y);
        ov.y = pk2(y[4 * et + 2] * rstd * (g2 * sigmoid_f(g2)) * mgv.z, y[4 * et + 3] * rstd * (g3 * sigmoid_f(g3)) * mgv.w);
        *(uint2*)(MRG + (size_t)t * 1024 + 384 + c) = ov;
      }
    }
#pragma unroll 1
    for (int gi = 0; gi < 2; ++gi) {
      const int g = wid * 2 + gi;
      const float are = SA[(g * 64 + lane) * 2], aim = SA[(g * 64 + lane) * 2 + 1];
      float xr = CARRY[(((size_t)item * 16 + g) * 64 + lane) * 2], xi = CARRY[(((size_t)item * 16 + g) * 64 + lane) * 2 + 1];
      bf16x8 cb[4];
#pragma unroll
      for (int ks = 0; ks < 4; ++ks) cb[ks] = *(const bf16x8*)(CB + (((size_t)g * 4 + ks) * 64 + lane) * 8);
      const float dv = dsk[g * 16 + fr];
#pragma unroll 1
      for (int blk = 0; blk < 2; ++blk) {
        f32x16 lr, hr, li, hi;
        bf16_t uraw[2][4];
#pragma unroll
        for (int half = 0; half < 2; ++half)
#pragma unroll
          for (int j = 0; j < 4; ++j) uraw[half][j] = PROJ[(size_t)(t0 + 32 * blk + 16 * half + 4 * fq + j) * INCP + C_US + g * 16 + fr];
        ssm_bu32(BBH + (size_t)g * 2 * 64 * 16, PROJ + (size_t)(t0 + 32 * blk + (lane & 31)) * INCP + C_US + g * 16, lane, lr, hr, li, hi);
#pragma unroll
        for (int half = 0; half < 2; ++half) {
#pragma unroll
          for (int a2 = 0; a2 < 2; ++a2) {
            const int a4 = 2 * half + a2;
#pragma unroll
            for (int bq = 0; bq < 4; ++bq) {
              const float nr = are * xr - aim * xi + lr[4 * a4 + bq], ni = are * xi + aim * xr + li[4 * a4 + bq]; xr = nr; xi = ni;
              XB[(8 * a2 + bq) * 136 + lane] = f2bf(xr); XB[(8 * a2 + bq) * 136 + 64 + lane] = f2bf(xi);
            }
#pragma unroll
            for (int bq = 0; bq < 4; ++bq) {
              const float nr = are * xr - aim * xi + hr[4 * a4 + bq], ni = are * xi + aim * xr + hi[4 * a4 + bq]; xr = nr; xi = ni;
              XB[(8 * a2 + 4 + bq) * 136 + lane] = f2bf(xr); XB[(8 * a2 + 4 + bq) * 136 + 64 + lane] = f2bf(xi);
            }
          }
          f32x4 acc = (f32x4){0.f, 0.f, 0.f, 0.f};
#pragma unroll
          for (int ks = 0; ks < 4; ++ks) {
            const bf16x8 af = *(const bf16x8*)(XB + fr * 136 + 32 * ks + 8 * fq);
            acc = __builtin_amdgcn_mfma_f32_16x16x32_bf16(af, cb[ks], acc, 0, 0, 0);
          }
#pragma unroll
          for (int j = 0; j < 4; ++j) {
            const int i = 32 * blk + 16 * half + 4 * fq + j;
            const float yv = acc[j] + dv * bf2f(uraw[half][j]);
            YS[i * 264 + g * 16 + fr] = f2bf(gelu_tanh(yv));
          }
        }
      }
    }
    __syncthreads();
    {
      const int n0 = 32 * wid;
      f32x4 a1[4][2], a2[4][2];
#pragma unroll
      for (int mt = 0; mt < 4; ++mt)
#pragma unroll
        for (int nt = 0; nt < 2; ++nt) { a1[mt][nt] = (f32x4){0.f, 0.f, 0.f, 0.f}; a2[mt][nt] = (f32x4){0.f, 0.f, 0.f, 0.f}; }
#pragma unroll 1
      for (int kh = 0; kh < 2; ++kh) {
        bf16x8 w1[4][2], w2[4][2];
#pragma unroll
        for (int k4 = 0; k4 < 4; ++k4)
#pragma unroll
          for (int nt = 0; nt < 2; ++nt) {
            w1[k4][nt] = *(const bf16x8*)(WG + ((((size_t)wid * 8 + 4 * kh + k4) * 2 + 0) * 2 + nt) * 512 + lane * 8);
            w2[k4][nt] = *(const bf16x8*)(WG + ((((size_t)wid * 8 + 4 * kh + k4) * 2 + 1) * 2 + nt) * 512 + lane * 8);
          }
        __builtin_amdgcn_sched_barrier(0);
#pragma unroll
        for (int k4 = 0; k4 < 4; ++k4) {
          const int ks = 4 * kh + k4;
          bf16x8 yb[4];
#pragma unroll
          for (int mt = 0; mt < 4; ++mt) yb[mt] = *(const bf16x8*)(YS + (16 * mt + fr) * 264 + 32 * ks + 8 * fq);
#pragma unroll
          for (int mt = 0; mt < 4; ++mt)
#pragma unroll
            for (int nt = 0; nt < 2; ++nt) {
              a1[mt][nt] = __builtin_amdgcn_mfma_f32_16x16x32_bf16(w1[k4][nt], yb[mt], a1[mt][nt], 0, 0, 0);
              a2[mt][nt] = __builtin_amdgcn_mfma_f32_16x16x32_bf16(w2[k4][nt], yb[mt], a2[mt][nt], 0, 0, 0);
            }
        }
      }
#pragma unroll
      for (int mt = 0; mt < 4; ++mt) {
        float sq = 0.f;
#pragma unroll
        for (int nt = 0; nt < 2; ++nt) {
          f32x4 z = a1[mt][nt]; const f32x4 zg = a2[mt][nt];
          z.x *= sigmoid_f(zg.x); z.y *= sigmoid_f(zg.y); z.z *= sigmoid_f(zg.z); z.w *= sigmoid_f(zg.w);
          a1[mt][nt] = z; sq += z.x * z.x + z.y * z.y + z.z * z.z + z.w * z.w;
        }
        sq += __shfl_xor(sq, 16); sq += __shfl_xor(sq, 32);
        if (fq == 0) red[wid * 64 + 16 * mt + fr] = sq;
      }
      __syncthreads();
#pragma unroll
      for (int mt = 0; mt < 4; ++mt) {
        const int i = 16 * mt + fr, t = t0 + i;
        float tot = 0.f;
#pragma unroll
        for (int w8 = 0; w8 < 8; ++w8) tot += red[w8 * 64 + i];
        const float rstd = rsqrtf(tot * (1.f / 256.f) + EPS_);
#pragma unroll
        for (int nt = 0; nt < 2; ++nt) {
          const int c = n0 + 16 * nt + 4 * fq;
          const f32x4 mgv = *(const f32x4*)(mg + 768 + c); const f32x4 z = a1[mt][nt];
          uint2 ov; ov.x = pk2(z.x * rstd * mgv.x, z.y * rstd * mgv.y); ov.y = pk2(z.z * rstd * mgv.z, z.w * rstd * mgv.w);
          *(uint2*)(MRG + (size_t)t * 1024 + 768 + c) = ov;
        }
      }
    }
  }
}

typedef float f32x2 __attribute__((ext_vector_type(2)));
__device__ __forceinline__ float dot16_fp4(const uint2 u, const f32x2 (&hv)[8]) {
  f32x2 d = __builtin_amdgcn_cvt_scalef32_pk_f32_fp4(u.x, 1.0f, 0) * hv[0];
  d += __builtin_amdgcn_cvt_scalef32_pk_f32_fp4(u.x, 1.0f, 1) * hv[1];
  d += __builtin_amdgcn_cvt_scalef32_pk_f32_fp4(u.x, 1.0f, 2) * hv[2];
  d += __builtin_amdgcn_cvt_scalef32_pk_f32_fp4(u.x, 1.0f, 3) * hv[3];
  d += __builtin_amdgcn_cvt_scalef32_pk_f32_fp4(u.y, 1.0f, 0) * hv[4];
  d += __builtin_amdgcn_cvt_scalef32_pk_f32_fp4(u.y, 1.0f, 1) * hv[5];
  d += __builtin_amdgcn_cvt_scalef32_pk_f32_fp4(u.y, 1.0f, 2) * hv[6];
  d += __builtin_amdgcn_cvt_scalef32_pk_f32_fp4(u.y, 1.0f, 3) * hv[7];
  return d.x + d.y;
}
__device__ __forceinline__ void axpy16_fp4(const uint2 v, const float w, f32x2 (&acc)[8]) {
  const f32x2 w2 = (f32x2){w, w};
  acc[0] += w2 * __builtin_amdgcn_cvt_scalef32_pk_f32_fp4(v.x, 1.0f, 0);
  acc[1] += w2 * __builtin_amdgcn_cvt_scalef32_pk_f32_fp4(v.x, 1.0f, 1);
  acc[2] += w2 * __builtin_amdgcn_cvt_scalef32_pk_f32_fp4(v.x, 1.0f, 2);
  acc[3] += w2 * __builtin_amdgcn_cvt_scalef32_pk_f32_fp4(v.x, 1.0f, 3);
  acc[4] += w2 * __builtin_amdgcn_cvt_scalef32_pk_f32_fp4(v.y, 1.0f, 0);
  acc[5] += w2 * __builtin_amdgcn_cvt_scalef32_pk_f32_fp4(v.y, 1.0f, 1);
  acc[6] += w2 * __builtin_amdgcn_cvt_scalef32_pk_f32_fp4(v.y, 1.0f, 2);
  acc[7] += w2 * __builtin_amdgcn_cvt_scalef32_pk_f32_fp4(v.y, 1.0f, 3);
}
__device__ __forceinline__ float vmaxf(float a, float b) { float r; asm("v_max_f32 %0, %1, %2" : "=v"(r) : "v"(a), "v"(b)); return r; }
__device__ __forceinline__ float vminf(float a, float b) { float r; asm("v_min_f32 %0, %1, %2" : "=v"(r) : "v"(a), "v"(b)); return r; }
__device__ __forceinline__ void cx(float& hi, float& lo) { const float a = hi, b = lo; hi = vmaxf(a, b); lo = vminf(a, b); }
__device__ __forceinline__ void cx2(float& kh, int& ph, float& kl, int& pl) {
  const float a = kh, b = kl; const int pa = ph, pb = pl; const bool c = a >= b;
  kh = vmaxf(a, b); kl = vminf(a, b); ph = c ? pa : pb; pl = c ? pb : pa;
}
__device__ __forceinline__ void bitonic_sort16_desc(float (&v)[16]) {
#pragma unroll
  for (int k = 2; k <= 16; k <<= 1)
#pragma unroll
    for (int j = k >> 1; j > 0; j >>= 1)
#pragma unroll
      for (int i = 0; i < 16; ++i) {
        const int l = i ^ j;
        if (l > i) { if ((i & k) == 0) cx(v[i], v[l]); else cx(v[l], v[i]); }
      }
}
__device__ __forceinline__ void bitonic_merge16_desc(float (&v)[16]) {
#pragma unroll
  for (int j = 8; j > 0; j >>= 1)
#pragma unroll
    for (int i = 0; i < 16; ++i) { const int l = i ^ j; if (l > i) cx(v[i], v[l]); }
}
__device__ __forceinline__ void top16_merge(float (&a)[16], const float (&b)[16]) {
#pragma unroll
  for (int i = 0; i < 16; ++i) a[i] = vmaxf(a[i], b[15 - i]);
  bitonic_merge16_desc(a);
}
template <int M> __device__ __forceinline__ void top16_merge_chain(float (&k)[16], int (&q)[16], const float (&xk)[M], const int (&xq)[M]) {
#pragma unroll
  for (int i = 16 - M; i < 16; ++i) { const float a = k[i], b = xk[15 - i]; const bool c = a >= b; k[i] = vmaxf(a, b); q[i] = c ? q[i] : xq[15 - i]; }
#pragma unroll
  for (int j = 8; j > 0; j >>= 1)
#pragma unroll
    for (int i = 0; i < 16; ++i) { const int l = i ^ j; if (l > i) cx2(k[i], q[i], k[l], q[l]); }
}

__device__ void peer_phase(const Params& p, int l, bool last, unsigned char* smem) {
  const CParamsP pp = launder_kargs();
  GAS unsigned char* const ws = launder_ptr(pp->ws); const int tidx = launder_tid();
  bf16_t* HF = (bf16_t*)(ws + WS_ABUF); bf16_t* X = (bf16_t*)(ws + WS_X);
  const bf16_t* SC8 = (const bf16_t*)(ws + WS_SC);
  const uint2* U4 = (const uint2*)(ws + WS_PU8) + (size_t)l * 16384 * 64; const uint2* V4 = (const uint2*)(ws + WS_PV8) + (size_t)l * 16384 * 64;
  const float* g2 = (const float*)(ws + WS_MOD) + (size_t)l * 2 * 6144 + 5120;
  const bf16_t* XG = (const bf16_t*)(ws + WS_XG); const float* SSQ = (const float*)(ws + WS_SSQ); const float* sh2 = (const float*)(ws + WS_MOD) + (size_t)l * 2 * 6144 + 3072;
  const int ln = last ? l : l + 1;
  const float* nsh = (const float*)(ws + WS_MOD) + (size_t)ln * 2 * 6144; const float* nsc = nsh + 1024;
  const float* ngain = gin(pp->in[I_NMIX]) + (size_t)ln * 1024;
  const int lane = tidx & 63, wid = tidx >> 6;
  const int rL = ((lane >> 5) & 1) * 8 + ((lane >> 4) & 1) * 4 + ((lane >> 3) & 1) * 2 + ((lane >> 2) & 1);
  const bool hi5 = (lane & 32) != 0, hi4 = (lane & 16) != 0, hi3 = (lane & 8) != 0, hi2 = (lane & 4) != 0;
  int* idxL = (int*)smem;
  float* cst = (float*)(smem + 109568);
  for (int it_ = blockIdx.x; it_ < T_ / 64; it_ += gridDim.x) {
    const int item = ((it_ & 7) << 5) | (it_ >> 3);
    const int t0 = item * 64;
    __syncthreads();
    {
      const int bb = t0 >> 13;
      for (int c = tidx; c < 1024; c += NT) {
        const int o = ((c >> 2) & 3) * 256 + (c >> 4) * 4 + (c & 3);
        cst[o] = g2[bb * 6144 + c] * 0.25f;
        cst[1024 + o] = last ? gin(pp->in[I_FNORM])[c] : ngain[c] * (1.f + nsc[bb * 6144 + c]);
        cst[2048 + o] = last ? 0.f : nsh[bb * 6144 + c];
        cst[3072 + o] = sh2[bb * 6144 + c];
      }
    }
    {
      int lane_o = lane; asm volatile("" : "+v"(lane_o));
      const int tg = wid & 1, hp = wid >> 1, hf = lane_o >> 5, tl = 32 * tg + (lane_o & 31);
      float F[2][16];
#pragma unroll
      for (int sd = 0; sd < 2; ++sd) {
        float Lh[2][16];
#pragma unroll
        for (int hh = 0; hh < 2; ++hh) {
          const int hs = 2 * (2 * hp + hh) + sd;
          float top[16];
          const bf16_t* scp = SC8 + (((size_t)(hs * 16 + 8 * hf)) * T_ + (t0 + tl)) * 8;
          uint4 sv[8];
#pragma unroll
          for (int kq = 0; kq < 8; ++kq) sv[kq] = *(const uint4*)(scp + (size_t)kq * T_ * 8);
          __builtin_amdgcn_sched_barrier(0);
#pragma unroll
          for (int kt = 0; kt < 4; ++kt) {
            float g[16];
#pragma unroll
            for (int kq = 0; kq < 2; ++kq) {
              const uint4 v8 = sv[2 * kt + kq];
              const unsigned wv[4] = {v8.x, v8.y, v8.z, v8.w};
#pragma unroll
              for (int j = 0; j < 4; ++j) {
                const int key = 64 * hf + 16 * kt + 8 * kq + 2 * j;
                g[8 * kq + 2 * j] = __uint_as_float((wv[j] << 16) | (unsigned)key);
                g[8 * kq + 2 * j + 1] = __uint_as_float((wv[j] & 0xffff0000u) | (unsigned)(key + 1));
              }
            }
            bitonic_sort16_desc(g);
            if (kt == 0) {
#pragma unroll
              for (int r = 0; r < 16; ++r) top[r] = g[r];
            } else top16_merge(top, g);
            __builtin_amdgcn_sched_barrier(0);
          }
#pragma unroll
          for (int r = 0; r < 16; ++r) Lh[hh][r] = top[r];
          __builtin_amdgcn_sched_barrier(0);
        }
#pragma unroll
        for (int r = 0; r < 16; ++r) {
          const auto sw = __builtin_amdgcn_permlane32_swap(__float_as_uint(Lh[0][r]), __float_as_uint(Lh[1][r]), false, false);
          Lh[0][r] = __uint_as_float(sw[0]); Lh[1][r] = __uint_as_float(sw[1]);
        }
        top16_merge(Lh[0], Lh[1]);
#pragma unroll
        for (int r = 0; r < 16; ++r) F[sd][r] = Lh[0][r];
        __builtin_amdgcn_sched_barrier(0);
      }
      int ia[16], ib[16];
#pragma unroll
      for (int r = 0; r < 16; ++r) { ia[r] = (int)(__float_as_uint(F[0][r]) & 127u) << 7; ib[r] = (int)(__float_as_uint(F[1][r]) & 127u); }
      float k[16]; int q[16];
#pragma unroll
      for (int j = 0; j < 16; ++j) { k[j] = F[0][0] + F[1][j]; q[j] = ia[0] | ib[j]; }
      { float xk[8]; int xq[8];
#pragma unroll
        for (int j = 0; j < 8; ++j) { xk[j] = F[0][1] + F[1][j]; xq[j] = ia[1] | ib[j]; }
        top16_merge_chain<8>(k, q, xk, xq); }
      { float xk[5]; int xq[5];
#pragma unroll
        for (int j = 0; j < 5; ++j) { xk[j] = F[0][2] + F[1][j]; xq[j] = ia[2] | ib[j]; }
        top16_merge_chain<5>(k, q, xk, xq); }
      { float xk[4]; int xq[4];
#pragma unroll
        for (int j = 0; j < 4; ++j) { xk[j] = F[0][3] + F[1][j]; xq[j] = ia[3] | ib[j]; }
        top16_merge_chain<4>(k, q, xk, xq); }
      { float xk[3]; int xq[3];
#pragma unroll
        for (int j = 0; j < 3; ++j) { xk[j] = F[0][4] + F[1][j]; xq[j] = ia[4] | ib[j]; }
        top16_merge_chain<3>(k, q, xk, xq); }
      { float xk[11]; int xq[11];
#pragma unroll
        for (int i = 0; i < 11; ++i) { xk[i] = F[0][5 + i] + F[1][0]; xq[i] = ia[5 + i] | ib[0]; }
        top16_merge_chain<11>(k, q, xk, xq); }
      { float xk[3]; int xq[3];
#pragma unroll
        for (int i = 0; i < 3; ++i) { xk[i] = F[0][5 + i] + F[1][1]; xq[i] = ia[5 + i] | ib[1]; }
        top16_merge_chain<3>(k, q, xk, xq); }
      float e[16]; float es = 0.f;
#pragma unroll
      for (int i = 0; i < 16; ++i) { e[i] = __expf(k[i] - k[0]); es += e[i]; }
      const float ies = 1.f / es;
      const int h = 2 * hp + hf;
#pragma unroll
      for (int i = 0; i < 16; ++i) idxL[tl * 132 + h * 16 + i] = (int)(((unsigned)f2bf(e[i] * ies) << 16) | (unsigned)q[i]);
    }
    __syncthreads();
    {
      const int fr = lane & 15, fq = lane >> 4, jsel = lane & 3, tlb = wid * 8;
      unsigned char* hq4 = smem + 33792 + wid * 1024;
      unsigned char* ust = smem + 41984 + wid * 8448;
      const unsigned lane8 = (unsigned)lane * 8u;
      uint2 ra[16], rb[16];
#define PEER_REQ_IDX(sn_) (idxL[(tlb + ((min((sn_), 127) & 63) >> 3)) * 132 + 16 * (min((sn_), 127) & 7) + fr] & 0xffff)
#define PEER_REQ_TAB(sn_) ((const unsigned char*)((sn_) < 64 ? U4 : V4))
      {
        const int e0 = PEER_REQ_IDX(0), e1 = PEER_REQ_IDX(1);
#pragma unroll
        for (int r = 0; r < 16; ++r) { const unsigned off = (unsigned)__builtin_amdgcn_readlane(e0, r) * 512u + lane8; ra[r] = *(const uint2*)((const unsigned char*)U4 + off); }
        __builtin_amdgcn_sched_barrier(0);
#pragma unroll
        for (int r = 0; r < 16; ++r) { const unsigned off = (unsigned)__builtin_amdgcn_readlane(e1, r) * 512u + lane8; rb[r] = *(const uint2*)((const unsigned char*)U4 + off); }
        __builtin_amdgcn_sched_barrier(0);
      }
      {
        const float rs_lane = rsqrtf(ssq_total(SSQ, t0 + tlb + (lane & 7)) * (1.f / 1024.f) + EPS_);
        uint4 nh0 = *(const uint4*)(XG + (size_t)(t0 + tlb) * 1024 + lane * 16), nh1 = *(const uint4*)(XG + (size_t)(t0 + tlb) * 1024 + lane * 16 + 8);
#pragma unroll 1
        for (int ii = 0; ii < 8; ++ii) {
          const int tl = tlb + ii, t = t0 + tl;
          uint4 hB1[8], hB2[8];
          {
            const unsigned hw[8] = {nh0.x, nh0.y, nh0.z, nh0.w, nh1.x, nh1.y, nh1.z, nh1.w};
            const float rs = __int_as_float(__builtin_amdgcn_readlane(__float_as_int(rs_lane), ii));
            unsigned q1[2] = {0u, 0u}, q2[2] = {0u, 0u};
#pragma unroll
            for (int qq = 0; qq < 4; ++qq) {
              const f32x4 sh = *(const f32x4*)(cst + 3072 + qq * 256 + lane * 4);
              float hvv[4];
              hvv[0] = __uint_as_float(hw[2 * qq] << 16) * rs + sh.x; hvv[1] = __uint_as_float(hw[2 * qq] & 0xffff0000u) * rs + sh.y;
              hvv[2] = __uint_as_float(hw[2 * qq + 1] << 16) * rs + sh.z; hvv[3] = __uint_as_float(hw[2 * qq + 1] & 0xffff0000u) * rs + sh.w;
#pragma unroll
              for (int pr = 0; pr < 2; ++pr) {
                const int byte_sel = (2 * qq + pr) & 3, wd = (2 * qq + pr) >> 2;
                const float x0 = fminf(fmaxf(hvv[2 * pr], -6.f), 6.f), x1 = fminf(fmaxf(hvv[2 * pr + 1], -6.f), 6.f);
                unsigned t1 = 0u;
                if (byte_sel == 0) t1 = __builtin_amdgcn_cvt_scalef32_pk_fp4_f32(0u, x0, x1, 1.0f, 0);
                else if (byte_sel == 1) t1 = __builtin_amdgcn_cvt_scalef32_pk_fp4_f32(0u, x0, x1, 1.0f, 1);
                else if (byte_sel == 2) t1 = __builtin_amdgcn_cvt_scalef32_pk_fp4_f32(0u, x0, x1, 1.0f, 2);
                else t1 = __builtin_amdgcn_cvt_scalef32_pk_fp4_f32(0u, x0, x1, 1.0f, 3);
                f32x2 back;
                if (byte_sel == 0) back = __builtin_amdgcn_cvt_scalef32_pk_f32_fp4(t1, 1.0f, 0);
                else if (byte_sel == 1) back = __builtin_amdgcn_cvt_scalef32_pk_f32_fp4(t1, 1.0f, 1);
                else if (byte_sel == 2) back = __builtin_amdgcn_cvt_scalef32_pk_f32_fp4(t1, 1.0f, 2);
                else back = __builtin_amdgcn_cvt_scalef32_pk_f32_fp4(t1, 1.0f, 3);
                const float r0 = fminf(fmaxf((hvv[2 * pr] - back.x) * 8.f, -6.f), 6.f), r1 = fminf(fmaxf((hvv[2 * pr + 1] - back.y) * 8.f, -6.f), 6.f);
                unsigned t2 = 0u;
                if (byte_sel == 0) t2 = __builtin_amdgcn_cvt_scalef32_pk_fp4_f32(0u, r0, r1, 1.0f, 0);
                else if (byte_sel == 1) t2 = __builtin_amdgcn_cvt_scalef32_pk_fp4_f32(0u, r0, r1, 1.0f, 1);
                else if (byte_sel == 2) t2 = __builtin_amdgcn_cvt_scalef32_pk_fp4_f32(0u, r0, r1, 1.0f, 2);
                else t2 = __builtin_amdgcn_cvt_scalef32_pk_fp4_f32(0u, r0, r1, 1.0f, 3);
                q1[wd] |= t1; q2[wd] |= t2;
              }
            }
            *(uint2*)(hq4 + lane * 8) = make_uint2(q1[0], q1[1]);
            *(uint2*)(hq4 + 512 + lane * 8) = make_uint2(q2[0], q2[1]);
#pragma unroll
            for (int kc = 0; kc < 8; ++kc) { hB1[kc] = *(const uint4*)(hq4 + 64 * kc + 16 * fq); hB2[kc] = *(const uint4*)(hq4 + 512 + 64 * kc + 16 * fq); }
          }
          { const int tn = t + (ii < 7 ? 1 : 0);
            nh0 = *(const uint4*)(XG + (size_t)tn * 1024 + lane * 16); nh1 = *(const uint4*)(XG + (size_t)tn * 1024 + lane * 16 + 8); }
          __builtin_amdgcn_sched_barrier(0);
#define PEER_U_STEP(R, bt_) do { const int _bt = (bt_), _sn = ii * 8 + _bt + 2; \
            _Pragma("unroll") for (int r = 0; r < 16; ++r) *(uint2*)(ust + r * 528 + lane * 8) = R[r];        \
            { const int _en = PEER_REQ_IDX(_sn); const unsigned char* _tab = PEER_REQ_TAB(_sn); \
              _Pragma("unroll") for (int r = 0; r < 16; ++r) { const unsigned off = (unsigned)__builtin_amdgcn_readlane(_en, r) * 512u + lane8; R[r] = *(const uint2*)(_tab + off); } } \
            __builtin_amdgcn_sched_barrier(0); \
            uint4 ua[8]; \
            _Pragma("unroll") for (int kc = 0; kc < 8; ++kc) ua[kc] = *(const uint4*)(ust + fr * 528 + 64 * kc + 16 * fq);      \
            f32x4 sa[2] = {(f32x4){0.f, 0.f, 0.f, 0.f}, (f32x4){0.f, 0.f, 0.f, 0.f}}, sb[2] = {(f32x4){0.f, 0.f, 0.f, 0.f}, (f32x4){0.f, 0.f, 0.f, 0.f}};     \
            _Pragma("unroll") for (int kc = 0; kc < 8; ++kc) { \
              const i32x8 av = (i32x8){(int)ua[kc].x, (int)ua[kc].y, (int)ua[kc].z, (int)ua[kc].w, 0, 0, 0, 0}; \
              const i32x8 b1 = (i32x8){(int)hB1[kc].x, (int)hB1[kc].y, (int)hB1[kc].z, (int)hB1[kc].w, 0, 0, 0, 0}; \
              const i32x8 b2 = (i32x8){(int)hB2[kc].x, (int)hB2[kc].y, (int)hB2[kc].z, (int)hB2[kc].w, 0, 0, 0, 0}; \
              sa[kc & 1] = __builtin_amdgcn_mfma_scale_f32_16x16x128_f8f6f4(av, b1, sa[kc & 1], 4  , 4  , 0, 0x7F7F7F7F, 0, 0x7F7F7F7F); \
              sb[kc & 1] = __builtin_amdgcn_mfma_scale_f32_16x16x128_f8f6f4(av, b2, sb[kc & 1], 4, 4, 0, 0x7F7F7F7F, 0, 0x7F7F7F7F); } \
            const f32x4 sc4 = (sa[0] + sa[1]) + (sb[0] + sb[1]) * 0.125f; \
              \
            const float dsel = jsel == 0 ? sc4[0] : (jsel == 1 ? sc4[1] : (jsel == 2 ? sc4[2] : sc4[3])); \
            const int _eo = tl * 132 + 16 * _bt + 4 * fq + jsel; const unsigned _pe = (unsigned)idxL[_eo]; \
            const float _w = __uint_as_float(_pe & 0xffff0000u) * gelu_tanh_fast(dsel * (1.f / 64.f));            \
            if (fr < 4) idxL[_eo] = (int)(((unsigned)f2bf(_w) << 16) | (_pe & 0xffffu)); \
          } while (0)
#pragma unroll 1
          for (int b2 = 0; b2 < 8; b2 += 2) { PEER_U_STEP(ra, b2); PEER_U_STEP(rb, b2 + 1); }
#undef PEER_U_STEP
        }
      }
      {
        f32x2 acc2[8];
#pragma unroll
        for (int j = 0; j < 8; ++j) acc2[j] = (f32x2){0.f, 0.f};
#pragma unroll 1
        for (int ii = 0; ii < 8; ++ii) {
          const int tl = tlb + ii, t = t0 + tl;
          const uint4 xr0 = *(const uint4*)(X + (size_t)t * 1024 + lane * 16), xr1 = *(const uint4*)(X + (size_t)t * 1024 + lane * 16 + 8);
          __builtin_amdgcn_sched_barrier(0);
#define PEER_V_STEP(R, bt_) do { const int _bt = (bt_), _sn = 64 + ii * 8 + _bt + 2; \
            const int _wv = (int)((unsigned)idxL[tl * 132 + 16 * _bt + fr] & 0xffff0000u);          \
            const int _en = PEER_REQ_IDX(_sn); \
            _Pragma("unroll") for (int r = 0; r < 16; ++r) { \
              const float wr = __int_as_float(__builtin_amdgcn_readlane(_wv, r)); \
              axpy16_fp4(R[r], wr, acc2); \
              { const unsigned off = (unsigned)__builtin_amdgcn_readlane(_en, r) * 512u + lane8; R[r] = *(const uint2*)((const unsigned char*)V4 + off); } \
              __builtin_amdgcn_sched_barrier(0); } \
          } while (0)
#pragma unroll 1
          for (int b2 = 0; b2 < 8; b2 += 2) { PEER_V_STEP(ra, b2); PEER_V_STEP(rb, b2 + 1); }
#undef PEER_V_STEP
          float xn[16]; float ss = 0.f;
          const unsigned xw[8] = {xr0.x, xr0.y, xr0.z, xr0.w, xr1.x, xr1.y, xr1.z, xr1.w};
#pragma unroll
          for (int qq = 0; qq < 4; ++qq) {
            const f32x4 xv = (f32x4){__uint_as_float(xw[2 * qq] << 16), __uint_as_float(xw[2 * qq] & 0xffff0000u), __uint_as_float(xw[2 * qq + 1] << 16), __uint_as_float(xw[2 * qq + 1] & 0xffff0000u)};
            const f32x4 g = *(const f32x4*)(cst + qq * 256 + lane * 4);
            xn[4 * qq] = xv.x + g.x * acc2[2 * qq].x; xn[4 * qq + 1] = xv.y + g.y * acc2[2 * qq].y;
            xn[4 * qq + 2] = xv.z + g.z * acc2[2 * qq + 1].x; xn[4 * qq + 3] = xv.w + g.w * acc2[2 * qq + 1].y;
            ss += xn[4 * qq] * xn[4 * qq] + xn[4 * qq + 1] * xn[4 * qq + 1] + xn[4 * qq + 2] * xn[4 * qq + 2] + xn[4 * qq + 3] * xn[4 * qq + 3];
          }
#pragma unroll
          for (int j = 0; j < 8; ++j) acc2[j] = (f32x2){0.f, 0.f};
          const float rstd = rsqrtf(wave_sum(ss) * (1.f / 1024.f) + EPS_);
          if (!last) {
            unsigned hb[8], xb[8];
#pragma unroll
            for (int qq = 0; qq < 4; ++qq) {
              xb[2 * qq] = pk2(xn[4 * qq], xn[4 * qq + 1]); xb[2 * qq + 1] = pk2(xn[4 * qq + 2], xn[4 * qq + 3]);
              const f32x4 ga = *(const f32x4*)(cst + 1024 + qq * 256 + lane * 4), sh = *(const f32x4*)(cst + 2048 + qq * 256 + lane * 4);
              hb[2 * qq] = pk2(xn[4 * qq] * rstd * ga.x + sh.x, xn[4 * qq + 1] * rstd * ga.y + sh.y);
              hb[2 * qq + 1] = pk2(xn[4 * qq + 2] * rstd * ga.z + sh.z, xn[4 * qq + 3] * rstd * ga.w + sh.w);
            }
            *(uint4*)(X + (size_t)t * 1024 + lane * 16) = make_uint4(xb[0], xb[1], xb[2], xb[3]);
            *(uint4*)(X + (size_t)t * 1024 + lane * 16 + 8) = make_uint4(xb[4], xb[5], xb[6], xb[7]);
            *(uint4*)(HF + (size_t)t * 1024 + lane * 16) = make_uint4(hb[0], hb[1], hb[2], hb[3]);
            *(uint4*)(HF + (size_t)t * 1024 + lane * 16 + 8) = make_uint4(hb[4], hb[5], hb[6], hb[7]);
          } else {
#pragma unroll
            for (int qq = 0; qq < 4; ++qq) {
              const f32x4 fn = *(const f32x4*)(cst + 1024 + qq * 256 + lane * 4);
              *(f32x4*)((float*)pp->out + (size_t)t * 1024 + lane * 16 + 4 * qq) = (f32x4){xn[4 * qq] * rstd * fn.x, xn[4 * qq + 1] * rstd * fn.y, xn[4 * qq + 2] * rstd * fn.z, xn[4 * qq + 3] * rstd * fn.w};
            }
          }
        }
      }
#undef PEER_REQ_IDX
#undef PEER_REQ_TAB
    }
  }
}

#define XB_TMO      128
#define XB_XCNT(j)  (256  + 64 * (j))
#define XB_XSUB(j)  (1280 + 64 * (j))
#define XB_XGEN(j)  (2304 + 64 * (j))
#define XB_TOP      3328
#define XB_TOPGEN   3392
#define XCD_BAR_WORDS 3456
#define XB_SPIN_CAP (1u << 20)
#define LAS __attribute__((address_space(3)))
__device__ __forceinline__ unsigned xb_ld(unsigned* q)              { return __hip_atomic_load(q, __ATOMIC_RELAXED, __HIP_MEMORY_SCOPE_AGENT); }
__device__ __forceinline__ unsigned xb_add(unsigned* q, unsigned v) { return __hip_atomic_fetch_add(q, v, __ATOMIC_RELAXED, __HIP_MEMORY_SCOPE_AGENT); }
__device__ __forceinline__ unsigned xb_xcc_id() { return (unsigned)__builtin_amdgcn_s_getreg((3 << 11) | 20) & 0xFu; }
#define XB_SPIN(cond, bar) do { unsigned _sp = 0; while (cond) { __builtin_amdgcn_s_sleep(1); \
    if ((++_sp & 255u) == 0u) { if (xb_ld(&(bar)[XB_TMO])) break; if (_sp > XB_SPIN_CAP) { atomicAdd(&(bar)[XB_TMO], 1u); break; } } } } while (0)
struct XcdBarrier { unsigned* bar; unsigned x; volatile LAS unsigned* st; };
__device__ __forceinline__ XcdBarrier xcd_barrier_post(unsigned* bar, volatile LAS unsigned* st) {
    XcdBarrier b; b.bar = bar; b.x = xb_xcc_id(); b.st = st;
    if (threadIdx.x == 0) (void)xb_add(&bar[XB_XCNT(b.x)], 1u);
    return b;
}
__device__ __forceinline__ void xcd_barrier_complete(unsigned* bar, unsigned x, unsigned& nloc, unsigned& nx) {
    const unsigned G = gridDim.x * gridDim.y * gridDim.z;
    unsigned sum, cnt, mine, sp = 0u;
    for (;;) {
        sum = 0u; cnt = 0u; mine = 0u;
#pragma unroll
        for (unsigned j = 0; j < 16; ++j) { const unsigned c = xb_ld(&bar[XB_XCNT(j)]); sum += c; cnt += (c > 0u) ? 1u : 0u; mine = (j == x) ? c : mine; }
        if (sum == G) break;
        __builtin_amdgcn_s_sleep(1);
        if ((++sp & 255u) == 0u) { if (xb_ld(&bar[XB_TMO])) break; if (sp > XB_SPIN_CAP) { atomicAdd(&bar[XB_TMO], 1u); break; } }
    }
    nloc = mine > 0u ? mine : 1u; nx = cnt > 0u ? cnt : 1u;
}
__device__ __forceinline__ void xcd_barrier(const XcdBarrier& b) {
    asm volatile("s_waitcnt vmcnt(0)" ::: "memory");
    __syncthreads();
    if (threadIdx.x == 0) {
        unsigned* bar = b.bar;
        __builtin_amdgcn_s_waitcnt(0);
        unsigned nloc = b.st[0], nx = b.st[1];
        if (nloc == 0u) { xcd_barrier_complete(bar, b.x, nloc, nx); b.st[0] = nloc; b.st[1] = nx; }
        const unsigned old = xb_add(&bar[XB_XSUB(b.x)], 1u);
        const unsigned gen = old / nloc;
        if (old + 1u == (gen + 1u) * nloc) {
            __builtin_amdgcn_fence(__ATOMIC_RELEASE, "agent");
            asm volatile("s_waitcnt vmcnt(0)" ::: "memory");
            const unsigned og = xb_add(&bar[XB_TOP], 1u);
            const unsigned tg = og / nx;
            if (og + 1u == (tg + 1u) * nx) xb_add(&bar[XB_TOPGEN], 1u);
            else XB_SPIN(xb_ld(&bar[XB_TOPGEN]) == tg, bar);
            __builtin_amdgcn_fence(__ATOMIC_ACQUIRE, "agent");
            xb_add(&bar[XB_XGEN(b.x)], 1u);
            asm volatile("s_waitcnt vmcnt(0)" ::: "memory");
        } else {
            XB_SPIN(xb_ld(&bar[XB_XGEN(b.x)]) == gen, bar);
            __builtin_amdgcn_fence(__ATOMIC_ACQUIRE, "agent");
            asm volatile("s_waitcnt vmcnt(0)" ::: "memory");
        }
    }
    __syncthreads();
}

__global__ void __launch_bounds__(NT) fwd_megakernel(Params p) {
  extern __shared__ __attribute__((aligned(16))) unsigned char smem[];
  const CParamsP pp = launder_kargs();
  cg::grid_group grid = cg::this_grid();
  volatile LAS unsigned* xbst = (volatile LAS unsigned*)(smem + LDS_BYTES - 16);
  if (threadIdx.x == 0) { xbst[0] = 0u; xbst[1] = 0u; }
  if (blockIdx.x == 0) { unsigned* bw = (unsigned*)(pp->ws + WS_BAR); for (int i = threadIdx.x; i < XCD_BAR_WORDS; i += NT) bw[i] = 0u; }
  setup_phase(p, smem);
  grid.sync();
  const XcdBarrier xb = xcd_barrier_post((unsigned*)(pp->ws + WS_BAR), xbst);
  const float* MOD = (const float*)(pp->ws + WS_MOD);
  for (int l = 0; l < DEPTH_; ++l) {
    const float* xsrc = (l == 0) ? gin(pp->in[I_X]) : (const float*)(pp->ws + WS_X);
    const float* modl = MOD + (size_t)l * 2 * 6144;
    if (l == 0) {
      norm_mod_phase(xsrc, gin(pp->in[I_NMIX]), modl + 0, modl + 1024, (bf16_t*)(pp->ws + WS_ABUF));
      qbias_phase(p, smem);
      xcd_barrier(xb);
    }
    gemm_proj_phase(p, l, smem);
    xcd_barrier(xb);
    attn_phase(p, l, smem);
    mix_local_phase(p, l, smem);
    xcd_barrier(xb);
    scan_phase(p, l);
    xcd_barrier(xb);
    mix_final_phase(p, l, smem);
    xcd_barrier(xb);
    gemm_out_phase(p, l, smem);
    xcd_barrier(xb);
    gemm_q_phase(p, l, smem);
    xcd_barrier(xb);
    peer_phase(p, l, l == DEPTH_ - 1, smem);
    xcd_barrier(xb);
  }
}

extern "C" void kernel_launch(void* const* d_in, const int* in_sizes, int n_in,
                              void* d_out, int out_size, void* d_ws, size_t ws_size,
                              hipStream_t stream) {
  static int grid_blocks = 0;
  if (grid_blocks == 0) {
    if (n_in != 24 || ws_size < WS_END) { fprintf(stderr, "kernel_launch: unexpected n_in %d / ws_size %zu (need %zu)\n", n_in, ws_size, (size_t)WS_END); grid_blocks = -1; return; }
    int dev = 0, cus = 0, per_cu = 0;
    if (hipGetDevice(&dev) != hipSuccess || hipDeviceGetAttribute(&cus, hipDeviceAttributeMultiprocessorCount, dev) != hipSuccess) { grid_blocks = -1; return; }
    if (hipFuncSetAttribute((const void*)fwd_megakernel, hipFuncAttributeMaxDynamicSharedMemorySize, LDS_BYTES) != hipSuccess) { fprintf(stderr, "hipFuncSetAttribute failed\n"); grid_blocks = -1; return; }
    if (hipOccupancyMaxActiveBlocksPerMultiprocessor(&per_cu, (const void*)fwd_megakernel, NT, LDS_BYTES) != hipSuccess || per_cu < 1) { fprintf(stderr, "occupancy query: %d\n", per_cu); grid_blocks = -1; return; }
    grid_blocks = cus;
  }
  if (grid_blocks < 0) return;
  Params p{};
  for (int i = 0; i < 24; ++i) p.in[i] = (const GAS float*)d_in[i];
  p.out = (GAS float*)d_out; p.ws = (GAS unsigned char*)d_ws;
  void* args[] = {&p};
  hipError_t e = hipLaunchCooperativeKernel((void*)fwd_megakernel, dim3(grid_blocks), dim3(NT), args, LDS_BYTES, stream);
  if (e != hipSuccess) fprintf(stderr, "cooperative launch failed: %s (grid %d)\n", hipGetErrorString(e), grid_blocks);
}
```

```cpp
#include <hip/hip_runtime.h>
#include <hip/hip_cooperative_groups.h>
#include <cstdio>
#include <cstdint>
namespace cg = cooperative_groups;

typedef unsigned short bf16_t;
typedef short bf16x8 __attribute__((ext_vector_type(8)));
typedef float f32x4 __attribute__((ext_vector_type(4)));
typedef float f32x16 __attribute__((ext_vector_type(16)));
typedef int i32x8 __attribute__((ext_vector_type(8)));

constexpr int T_ = 16384, D_ = 1024, L_ = 8192, NBATCH = 2, DEPTH_ = 4;
constexpr int INC = 2944, INCP = 3072;
constexpr int NCH = 128;
constexpr int NT = 512;
constexpr int NW = 8;
constexpr float EPS_ = 1e-6f;
constexpr int C_QA = 0, C_KA = 384, C_VA = 768, C_QR = 1152, C_KR = 1536, C_VR = 1920, C_GR = 2304, C_US = 2688;

constexpr size_t al256(size_t x) { return (x + 255) & ~(size_t)255; }
constexpr size_t WS_MOD   = 0;
constexpr size_t WS_ROTC  = al256(WS_MOD + 4ull * 2 * 6144 * 4);
constexpr size_t WS_ROTS  = al256(WS_ROTC + 8192ull * 32 * 4);
constexpr size_t WS_SA    = al256(WS_ROTS + 8192ull * 32 * 4);
constexpr size_t WS_SBB   = al256(WS_SA + 4ull * 16 * 64 * 2 * 4);
constexpr size_t WS_WIN   = al256(WS_SBB + 4ull * 16 * 64 * 32 * 4);
constexpr size_t WS_WOUT  = al256(WS_WIN + 4ull * INCP * 1024 * 2);
constexpr size_t WS_WQ    = al256(WS_WOUT + 4ull * 1024 * 1024 * 2);
constexpr size_t WS_SUBK  = al256(WS_WQ + 4ull * 2048 * 1024 * 2);
constexpr size_t WS_ABUF  = al256(WS_SUBK + 4ull * 16 * 128 * 128 * 2);
constexpr size_t WS_PROJ  = al256(WS_ABUF + (size_t)T_ * 1024 * 2);
constexpr size_t WS_VTA   = al256(WS_PROJ + (size_t)T_ * INCP * 2);
constexpr size_t WS_ATT   = al256(WS_VTA + 2ull * 6 * 64 * 8192 * 2);
constexpr size_t WS_YINT  = al256(WS_ATT + (size_t)T_ * 384 * 4);
constexpr size_t WS_UPD   = al256(WS_YINT + (size_t)T_ * 384 * 4);
constexpr size_t WS_SPREV = al256(WS_UPD + 256ull * 6 * 4096 * 4);
constexpr size_t WS_SEND  = al256(WS_SPREV + 256ull * 6 * 4096 * 4);
constexpr size_t WS_CARRY = al256(WS_SEND + 256ull * 16 * 64 * 2 * 4);
constexpr size_t WS_X     = al256(WS_CARRY + 256ull * 16 * 64 * 2 * 4);
constexpr size_t WS_Q     = al256(WS_X + (size_t)T_ * 1024 * 4);
constexpr size_t WS_SC    = al256(WS_Q + (size_t)T_ * 2048 * 2);
constexpr size_t WS_EIDX  = al256(WS_SC + (size_t)T_ * 2048 * 4);
constexpr size_t WS_EGATE = al256(WS_EIDX + (size_t)T_ * 128 * 4);
constexpr size_t WS_PU8   = al256(WS_EGATE + (size_t)T_ * 128 * 4);
constexpr size_t WS_PV8   = al256(WS_PU8 + 4ull * 16384 * 1024);
constexpr size_t WS_BAR   = al256(WS_PV8 + 4ull * 16384 * 1024);
constexpr size_t WS_SPT   = al256(WS_BAR + 3456ull * 4);
constexpr size_t WS_CB    = al256(WS_SPT + 256ull * 6 * 4096 * 2);
constexpr size_t WS_WGLUT = al256(WS_CB + 4ull * 16 * 16 * 128 * 2);
constexpr size_t WS_VTR   = al256(WS_WGLUT + 4ull * 512 * 256 * 2);
constexpr size_t WS_XG    = al256(WS_VTR + 2ull * 384 * 8192 * 2);
constexpr size_t WS_SSQ   = al256(WS_XG + (size_t)T_ * 1024 * 2);
constexpr size_t WS_C2    = al256(WS_SSQ + (size_t)T_ * 16 * 4);
constexpr size_t WS_BBH   = al256(WS_C2 + 4ull * 2 * 2048 * 4);
constexpr size_t WS_END   = al256(WS_BBH + 4ull * 16 * 2 * 64 * 16 * 2);

constexpr int LDS_BYTES = 135168;

#define GAS __attribute__((address_space(1)))
struct Params {
  const GAS float* in[24];
  GAS float* out;
  GAS unsigned char* ws;
};
enum { I_X = 0, I_C, I_WADA, I_BADA, I_NMIX, I_NFFN, I_WIN, I_RELB, I_LRE, I_LIM, I_LOGDT, I_BRE, I_BIM, I_CRE, I_CIM, I_SSMD,
       I_WGLU, I_MGAIN, I_WOUT, I_WQ, I_SUBK, I_PU, I_PV, I_FNORM };

__device__ __forceinline__ float bf2f(bf16_t v) { return __uint_as_float(((unsigned)v) << 16); }
__device__ __forceinline__ bf16_t f2bf(float f) { unsigned u = __float_as_uint(f); u += 0x7fffu + ((u >> 16) & 1u); return (bf16_t)(u >> 16); }
__device__ __forceinline__ unsigned pk2(float a, float b) { return (unsigned)f2bf(a) | ((unsigned)f2bf(b) << 16); }
__device__ __forceinline__ float wave_sum(float v) {
#pragma unroll
  for (int o = 32; o > 0; o >>= 1) v += __shfl_xor(v, o);
  return v;
}
__device__ __forceinline__ float wave_max(float v) {
#pragma unroll
  for (int o = 32; o > 0; o >>= 1) v = fmaxf(v, __shfl_xor(v, o));
  return v;
}
__device__ __forceinline__ float gelu_tanh(float x) { const float u = 0.7978845608028654f * (x + 0.044715f * x * x * x); return 0.5f * x * (1.f + tanhf(u)); }
__device__ __forceinline__ float sigmoid_f(float x) { return 1.f / (1.f + __expf(-x)); }
__device__ __forceinline__ float gelu_tanh_fast(float x) {
  const float u2 = 2.f * 0.7978845608028654f * 1.4426950408889634f * (x + 0.044715f * x * x * x);
  const float e = __builtin_amdgcn_exp2f(fminf(u2, 80.f));
  return x - x * __builtin_amdgcn_rcpf(1.f + e);
}
__device__ __forceinline__ GAS unsigned char* launder_ptr(GAS unsigned char* q) { asm volatile("" : "+s"(q)); return q; }
__device__ __forceinline__ const float* gin(const GAS float* q) { return (const float*)q; }
__device__ __forceinline__ const float* launder_cptr(const float* q) { asm volatile("" : "+s"(q)); return q; }
__device__ __forceinline__ int launder_tid() { int t = threadIdx.x; asm volatile("" : "+v"(t)); return t; }
typedef const Params __attribute__((address_space(4)))* CParamsP;
__device__ __forceinline__ CParamsP launder_kargs() { CParamsP q = (CParamsP)__builtin_amdgcn_kernarg_segment_ptr(); asm volatile("" : "+s"(q)); return q; }

__device__ __forceinline__ void convert_tables_fp4(const CParamsP pp, GAS unsigned char* ws, int layer, int gtid, int gn) {
  constexpr size_t NIT = 16384ull * 1024 / 16;
  for (size_t it = gtid; it < 2 * NIT; it += gn) {
    const int tb = it >= NIT ? 1 : 0; const size_t r = (it - (size_t)tb * NIT) + (size_t)layer * NIT;
    const f32x4* src = (const f32x4*)((tb ? gin(pp->in[I_PV]) : gin(pp->in[I_PU])) + r * 16);
    const float sc = tb ? 4.f : 64.f;
    unsigned o[2] = {0u, 0u};
#pragma unroll
    for (int q = 0; q < 4; ++q) {
      const f32x4 a = src[q];
      const float x0 = fminf(fmaxf(a.x * sc, -6.f), 6.f), x1 = fminf(fmaxf(a.y * sc, -6.f), 6.f);
      const float x2 = fminf(fmaxf(a.z * sc, -6.f), 6.f), x3 = fminf(fmaxf(a.w * sc, -6.f), 6.f);
      if (q == 0)      { o[0] = __builtin_amdgcn_cvt_scalef32_pk_fp4_f32(o[0], x0, x1, 1.0f, 0); o[0] = __builtin_amdgcn_cvt_scalef32_pk_fp4_f32(o[0], x2, x3, 1.0f, 1); }
      else if (q == 1) { o[0] = __builtin_amdgcn_cvt_scalef32_pk_fp4_f32(o[0], x0, x1, 1.0f, 2); o[0] = __builtin_amdgcn_cvt_scalef32_pk_fp4_f32(o[0], x2, x3, 1.0f, 3); }
      else if (q == 2) { o[1] = __builtin_amdgcn_cvt_scalef32_pk_fp4_f32(o[1], x0, x1, 1.0f, 0); o[1] = __builtin_amdgcn_cvt_scalef32_pk_fp4_f32(o[1], x2, x3, 1.0f, 1); }
      else             { o[1] = __builtin_amdgcn_cvt_scalef32_pk_fp4_f32(o[1], x0, x1, 1.0f, 2); o[1] = __builtin_amdgcn_cvt_scalef32_pk_fp4_f32(o[1], x2, x3, 1.0f, 3); }
    }
    *(uint2*)(ws + (tb ? WS_PV8 : WS_PU8) + r * 8) = make_uint2(o[0], o[1]);
  }
}

__device__ void setup_phase(const Params& p, unsigned char* smem) {
  const CParamsP pp = launder_kargs();
  GAS unsigned char* const ws = launder_ptr(pp->ws); const int tidx = launder_tid(); (void)ws; (void)tidx;
  const int tid = tidx;
  float* sm = (float*)smem;
  {
    float* cond = sm;
    float* red = sm + 2048;
    float* MOD = (float*)(ws + WS_MOD);
    for (int i = tid; i < 2048; i += NT) { const float c = gin(pp->in[I_C])[i]; cond[i] = c * sigmoid_f(c); }
    __syncthreads();
    for (int item = blockIdx.x; item < 4 * 192; item += gridDim.x) {
      const int l = item / 192, cb = item % 192, kq = tid >> 6, jj = tid & 31, kp = (tid >> 5) & 1, j = cb * 32 + jj;
      const float* w = gin(pp->in[I_WADA]) + (size_t)l * 1024 * 6144 + j;
      float a0 = 0.f, a1 = 0.f;
#pragma unroll 32
      for (int k = kq * 128 + kp; k < kq * 128 + 128; k += 2) { const float wv = w[(size_t)k * 6144]; a0 += cond[k] * wv; a1 += cond[1024 + k] * wv; }
      red[((kq * 2 + kp) * 2 + 0) * 32 + jj] = a0; red[((kq * 2 + kp) * 2 + 1) * 32 + jj] = a1;
      __syncthreads();
      if (tid < 64) {
        const int b = tid >> 5, j2 = tid & 31; float s = 0.f;
        for (int q = 0; q < 16; ++q) s += red[(q * 2 + b) * 32 + j2];
        MOD[((size_t)l * 2 + b) * 6144 + cb * 32 + j2] = s + gin(pp->in[I_BADA])[(size_t)l * 6144 + cb * 32 + j2];
      }
      __syncthreads();
    }
  }
  const int gtid = blockIdx.x * NT + tid, gn = gridDim.x * NT;
  {
    float* RC = (float*)(ws + WS_ROTC); float* RS = (float*)(ws + WS_ROTS);
    for (int idx = gtid; idx < 8192 * 32; idx += gn) {
      const int pos = idx >> 5, i = idx & 31;
      const float inv = powf(10000.0f, -(float)i / 32.0f);
      const float ang = (float)pos * inv;
      float s, c; sincosf(ang, &s, &c);
      RC[idx] = c; RS[idx] = s;
    }
  }
  {
    float* SA = (float*)(ws + WS_SA); float* SBB = (float*)(ws + WS_SBB); bf16_t* BBH = (bf16_t*)(ws + WS_BBH);
    for (int idx = gtid; idx < 4 * 16 * 64; idx += gn) {
      const int l = idx / 1024, g = (idx >> 6) & 15;
      const float dt = expf(gin(pp->in[I_LOGDT])[l * 16 + g]);
      const float lr = gin(pp->in[I_LRE])[idx], li = gin(pp->in[I_LIM])[idx];
      const float mag = expf(lr * dt);
      float sn, cs; sincosf(li * dt, &sn, &cs);
      const float are = mag * cs, aim = mag * sn;
      const float den = lr * lr + li * li, nr = are - 1.f, ni = aim;
      const float fre = (nr * lr + ni * li) / den, fim = (ni * lr - nr * li) / den;
      SA[idx * 2] = are; SA[idx * 2 + 1] = aim;
      for (int c = 0; c < 16; ++c) {
        const float br = gin(pp->in[I_BRE])[(size_t)idx * 16 + c], bi = gin(pp->in[I_BIM])[(size_t)idx * 16 + c];
        SBB[(size_t)idx * 32 + c] = fre * br - fim * bi;
        SBB[(size_t)idx * 32 + 16 + c] = fre * bi + fim * br;
        {
          const int pq = idx & 63; const size_t fb = (size_t)(idx >> 6) * 2;
          BBH[(((fb + 0) * 2 + (pq >> 5)) * 64 + 32 * (c >> 3) + (pq & 31)) * 8 + (c & 7)] = f2bf(fre * br - fim * bi);
          BBH[(((fb + 1) * 2 + (pq >> 5)) * 64 + 32 * (c >> 3) + (pq & 31)) * 8 + (c & 7)] = f2bf(fre * bi + fim * br);
        }
      }
    }
  }
  {
    bf16_t* CB = (bf16_t*)(ws + WS_CB);
    for (int idx = gtid; idx < 4 * 16 * 16 * 128; idx += gn) {
      const int k = idx & 127, lgc = idx >> 7;
      const bf16_t cv = (k < 64) ? f2bf(gin(pp->in[I_CRE])[(size_t)lgc * 64 + k]) : f2bf(-gin(pp->in[I_CIM])[(size_t)lgc * 64 + (k - 64)]);
      const int cc = lgc & 15, lg = lgc >> 4;
      CB[(((size_t)lg * 4 + (k >> 5)) * 64 + ((k >> 3) & 3) * 16 + cc) * 8 + (k & 7)] = cv;
    }
    bf16_t* WG = (bf16_t*)(ws + WS_WGLUT);
    for (int idx = gtid; idx < 4 * 512 * 256; idx += gn) {
      const int k = idx & 255, nn = (idx >> 8) & 511, l2 = idx >> 17;
      {
        const int which = nn >> 8, w8 = (nn >> 5) & 7, nt = (nn >> 4) & 1, frr = nn & 15, ks = k >> 5, fqq = (k >> 3) & 3, j = k & 7;
        WG[(((((size_t)l2 * 8 + w8) * 8 + ks) * 2 + which) * 2 + nt) * 512 + (fqq * 16 + frr) * 8 + j] = f2bf(gin(pp->in[I_WGLU])[((size_t)l2 * 256 + k) * 512 + nn]);
      }
    }
  }
  convert_tables_fp4(pp, ws, 0, gtid, gn);
  {
    __syncthreads();
    const int lane = tid & 63, wid = tid >> 6;
    float* scr = sm + wid * (64 * 33);
    constexpr int IT_IN = 16 * 96, IT_OUT = 16 * 32, IT_L = IT_IN + IT_OUT;
    for (int item = blockIdx.x * NW + wid; item < 4 * IT_L; item += gridDim.x * NW) {
      const int l = item / IT_L; int r = item - l * IT_L;
      const float* W; bf16_t* WT; int N, NP;
      if (r < IT_IN) { W = gin(pp->in[I_WIN]) + (size_t)l * 1024 * INC; WT = (bf16_t*)(ws + WS_WIN) + (size_t)l * INCP * 1024; N = INC; NP = 96; }
      else { r -= IT_IN; W = gin(pp->in[I_WOUT]) + (size_t)l * 1024 * 1024; WT = (bf16_t*)(ws + WS_WOUT) + (size_t)l * 1024 * 1024; N = 1024; NP = 32; }
      const int kb = r / NP, nb = r - kb * NP, k0 = kb * 64, n0 = nb * 32;
      const int nn = n0 + (lane & 31); const bool inb = nn < N;
      float v[32];
#pragma unroll
      for (int i = 0; i < 32; ++i) { const int kk = 2 * i + (lane >> 5); v[i] = inb ? W[(size_t)(k0 + kk) * N + nn] : 0.f; }
#pragma unroll
      for (int i = 0; i < 32; ++i) { const int kk = 2 * i + (lane >> 5); scr[kk * 33 + (lane & 31)] = v[i]; }
      const int c = lane & 7;
#pragma unroll
      for (int j = 0; j < 4; ++j) {
        const int n = (lane >> 3) + 8 * j; const float* sp = scr + (8 * c) * 33 + n;
        uint4 o; o.x = pk2(sp[0], sp[33]); o.y = pk2(sp[2 * 33], sp[3 * 33]); o.z = pk2(sp[4 * 33], sp[5 * 33]); o.w = pk2(sp[6 * 33], sp[7 * 33]);
        *(uint4*)(WT + (size_t)(n0 + n) * 1024 + k0 + 8 * c) = o;
      }
    }
    __syncthreads();
  }
  {
    bf16_t* WP = (bf16_t*)(ws + WS_WQ);
    const int lane = tid & 63, wid = tid >> 6, fr = lane & 15, fq = lane >> 4;
    for (int item = blockIdx.x; item < 4 * 16 * 8; item += gridDim.x) {
      const int l = item >> 7, hs = (item >> 3) & 15, kb = item & 7;
      const float* Wq = gin(pp->in[I_WQ]) + ((size_t)l * 1024 + kb * 128 + wid * 16 + fr) * 2048 + hs * 128 + 8 * fq;
      const float* SKg = gin(pp->in[I_SUBK]) + ((size_t)l * 16 + hs) * 128 * 128 + (size_t)fr * 128 + 8 * fq;
      bf16x8 ah[4], al[4];
#pragma unroll
      for (int ks = 0; ks < 4; ++ks) {
        const f32x4 x0 = *(const f32x4*)(Wq + 32 * ks), x1 = *(const f32x4*)(Wq + 32 * ks + 4);
        const float xv[8] = {x0.x, x0.y, x0.z, x0.w, x1.x, x1.y, x1.z, x1.w};
#pragma unroll
        for (int j = 0; j < 8; ++j) { const bf16_t h = f2bf(xv[j]); ah[ks][j] = (short)h; al[ks][j] = (short)f2bf(xv[j] - bf2f(h)); }
      }
      f32x4 acc[8];
#pragma unroll
      for (int ct = 0; ct < 8; ++ct) acc[ct] = (f32x4){0.f, 0.f, 0.f, 0.f};
#pragma unroll 2
      for (int ct = 0; ct < 8; ++ct) {
        f32x4 y[8];
#pragma unroll
        for (int ks = 0; ks < 4; ++ks) { y[2 * ks] = *(const f32x4*)(SKg + (size_t)ct * 16 * 128 + 32 * ks); y[2 * ks + 1] = *(const f32x4*)(SKg + (size_t)ct * 16 * 128 + 32 * ks + 4); }
#pragma unroll
        for (int ks = 0; ks < 4; ++ks) {
          const float yv[8] = {y[2 * ks].x, y[2 * ks].y, y[2 * ks].z, y[2 * ks].w, y[2 * ks + 1].x, y[2 * ks + 1].y, y[2 * ks + 1].z, y[2 * ks + 1].w};
          bf16x8 bh, bl;
#pragma unroll
          for (int j = 0; j < 8; ++j) { const bf16_t h = f2bf(yv[j]); bh[j] = (short)h; bl[j] = (short)f2bf(yv[j] - bf2f(h)); }
          acc[ct] = __builtin_amdgcn_mfma_f32_16x16x32_bf16(ah[ks], bh, acc[ct], 0, 0, 0);
          acc[ct] = __builtin_amdgcn_mfma_f32_16x16x32_bf16(al[ks], bh, acc[ct], 0, 0, 0);
          acc[ct] = __builtin_amdgcn_mfma_f32_16x16x32_bf16(ah[ks], bl, acc[ct], 0, 0, 0);
        }
      }
#pragma unroll
      for (int ct = 0; ct < 8; ++ct)
        *(uint2*)(WP + ((size_t)l * 2048 + hs * 128 + 16 * ct + fr) * 1024 + kb * 128 + wid * 16 + 4 * fq) = make_uint2(pk2(acc[ct][0], acc[ct][1]), pk2(acc[ct][2], acc[ct][3]));
    }
  }
}

__device__ void qbias_phase(const Params& p, unsigned char* smem) {
  const CParamsP pp = launder_kargs();
  GAS unsigned char* const ws = launder_ptr(pp->ws); const int tid = launder_tid();
  float* C2 = (float*)(ws + WS_C2); const float* MOD = (const float*)(ws + WS_MOD); const bf16_t* WP = (const bf16_t*)(ws + WS_WQ);
  const int lane = tid & 63, gw = blockIdx.x * NW + (tid >> 6), nw = gridDim.x * NW;
  for (int o = gw; o < 4 * 2048; o += nw) {
    const int l = o >> 11;
    const uint4 w0 = *(const uint4*)(WP + (size_t)o * 1024 + lane * 16), w1 = *(const uint4*)(WP + (size_t)o * 1024 + lane * 16 + 8);
    const unsigned ww[8] = {w0.x, w0.y, w0.z, w0.w, w1.x, w1.y, w1.z, w1.w};
    const float* s0 = MOD + (size_t)l * 2 * 6144 + 3072 + lane * 16; const float* s1 = s0 + 6144;
    float a0 = 0.f, a1 = 0.f;
#pragma unroll
    for (int q = 0; q < 8; ++q) {
      const float wl = __uint_as_float(ww[q] << 16), wh = __uint_as_float(ww[q] & 0xffff0000u);
      a0 += s0[2 * q] * wl + s0[2 * q + 1] * wh; a1 += s1[2 * q] * wl + s1[2 * q + 1] * wh;
    }
    a0 = wave_sum(a0); a1 = wave_sum(a1);
    if (lane == 0) { C2[((size_t)l * 2 + 0) * 2048 + (o & 2047)] = a0; C2[((size_t)l * 2 + 1) * 2048 + (o & 2047)] = a1; }
  }
  (void)smem;
}

__device__ void norm_mod_phase(const float* __restrict__ xsrc, const float* __restrict__ gain, const float* __restrict__ mod_sh, const float* __restrict__ mod_sc,
                               bf16_t* __restrict__ outp) {
  const int tidx = launder_tid();
  const int lane = tidx & 63, gw = blockIdx.x * NW + (tidx >> 6), nw = gridDim.x * NW;
  for (int t = gw; t < T_; t += nw) {
    const int b = t >> 13;
    const f32x4* xr = (const f32x4*)(xsrc + (size_t)t * 1024) + lane;
    f32x4 v[4]; float s = 0.f;
#pragma unroll
    for (int j = 0; j < 4; ++j) { v[j] = xr[64 * j]; s += v[j].x * v[j].x + v[j].y * v[j].y + v[j].z * v[j].z + v[j].w * v[j].w; }
    const float rstd = rsqrtf(wave_sum(s) * (1.f / 1024.f) + EPS_);
#pragma unroll
    for (int j = 0; j < 4; ++j) {
      const int c = lane * 4 + 256 * j;
      const f32x4 g = *(const f32x4*)(gain + c), sh = *(const f32x4*)(mod_sh + b * 6144 + c), sc = *(const f32x4*)(mod_sc + b * 6144 + c);
      const float o0 = v[j].x * rstd * g.x * (1.f + sc.x) + sh.x, o1 = v[j].y * rstd * g.y * (1.f + sc.y) + sh.y;
      const float o2 = v[j].z * rstd * g.z * (1.f + sc.z) + sh.z, o3 = v[j].w * rstd * g.w * (1.f + sc.w) + sh.w;
      uint2 o; o.x = pk2(o0, o1); o.y = pk2(o2, o3);
      *(uint2*)(outp + (size_t)t * 1024 + c) = o;
    }
  }
}


namespace pg8 {
#define PG8_LAS __attribute__((address_space(3)))
typedef unsigned u32x4 __attribute__((ext_vector_type(4)));
constexpr int BM = 256, BK = 64, HALF = 128, HTB = HALF * BK * 2, STAGE_BYTES = 8 * HTB, NXCD = 8, WGM = 8;
__host__ __device__ __forceinline__ int lds_byte(int r, int c) { const int st = (r >> 4) * 2 + (c >> 5), rr = r & 15, cc = c & 31, ob = rr * 64 + cc * 2; return st * 1024 + (ob ^ (((ob >> 9) & 1) << 5)); }
__host__ __device__ __forceinline__ void stage_rc(int b, int& R, int& C) { const int st = b / 1024, sb = b % 1024, swz = sb ^ (((sb >> 9) & 1) << 5); R = (st >> 1) * 16 + swz / 64; C = (st & 1) * 32 + (swz % 64) / 2; }
__host__ __device__ __forceinline__ int perm32(int rho) { const int n = rho >> 4, i = rho & 15; return 8 * (i >> 2) + 4 * n + (i & 3); }
struct Unit { int pm, pn; };
struct Gemm { const bf16_t* A; const bf16_t* Bt; int M, N, K; };
struct StaticOrder {
    int nM, nN, nwg, G, c;
    __host__ __device__ void init(int M, int N, int G_, int c_) { nM = M / BM; nN = N / BM; nwg = nM * nN; G = G_; c = c_; }
    __host__ __device__ bool next(int i, Unit& u) const {
        const long L = (long)i * G + c; if (L >= nwg) return false;
        int wgid = (int)L; { const int q = nwg / NXCD, r = nwg % NXCD, xcd = wgid % NXCD, off = wgid / NXCD; wgid = (xcd < r ? xcd * (q + 1) : r * (q + 1) + (xcd - r) * q) + off; }
        const int nig = WGM * nN, gid = wgid / nig, fm = gid * WGM, gsz = (nM - fm) < WGM ? (nM - fm) : WGM;
        u.pm = fm + ((wgid % nig) % gsz); u.pn = (wgid % nig) / gsz; return true;
    }
    __device__ __forceinline__ void a_ready(const Unit&) const {}
    __device__ __forceinline__ void done(const Unit&) const {}
};
__device__ __forceinline__ unsigned cvt_pk_bf16(float lo, float hi) { unsigned r; asm volatile("v_cvt_pk_bf16_f32 %0, %1, %2" : "=v"(r) : "v"(lo), "v"(hi)); return r; }
template <class Epi, class Sched>
__device__ __forceinline__ void gemm_phase(PG8_LAS unsigned char* lds, const Gemm g, const Sched& S, const Epi& E) {
    const int tid = launder_tid(), wid = __builtin_amdgcn_readfirstlane(tid >> 6), lane = tid & 63, wr = wid >> 2, wc = wid & 3, fr = lane & 15, fq = lane >> 4;
    const int K = g.K, nt = K / BK;
    unsigned voffA[2], voffB[2];
#pragma unroll
    for (int i = 0; i < 2; ++i) { int R, C; stage_rc(tid * 16 + i * 8192, R, C); const int Rb = Epi::PERM ? ((R & ~31) + perm32(R & 31)) : R;
        voffA[i] = (unsigned)(R * K + C) * 2u; voffB[i] = (unsigned)(Rb * K + C) * 2u; }
    const size_t kstep = (size_t)(BK * 2);
    const size_t hstep = (size_t)HALF * K * 2;
    const size_t tstep = 2 * hstep;
    const unsigned ldsw = (unsigned)wid * 1024u;
    const int aoff = lds_byte(wr * 64 + fr, fq * 8), boff = lds_byte(wc * 32 + fr, fq * 8);
#define PG8_SA(b, h) (((b) * 2 + (h)) * HTB)
#define PG8_SB(b, h) ((4 + (b) * 2 + (h)) * HTB)
#define PG8_STAGE(bufoff, gbase, voff) do { _Pragma("unroll") for (int _i = 0; _i < 2; ++_i) \
        __builtin_amdgcn_global_load_lds((const unsigned*)((const char*)(gbase) + (voff)[_i]), (PG8_LAS unsigned*)(lds + (bufoff) + ldsw + _i * 8192), 16, 0, 0); } while (0)
#define PG8_LDA(dst, b, h) do { _Pragma("unroll") for (int m = 0; m < 4; ++m) _Pragma("unroll") for (int k = 0; k < 2; ++k) dst[m][k] = *(const PG8_LAS bf16x8*)(lds + PG8_SA(b, h) + aoff + m * 2048 + k * 1024); } while (0)
#define PG8_LDB(dst, b, h) do { _Pragma("unroll") for (int n = 0; n < 2; ++n) _Pragma("unroll") for (int k = 0; k < 2; ++k) dst[n][k] = *(const PG8_LAS bf16x8*)(lds + PG8_SB(b, h) + boff + n * 2048 + k * 1024); } while (0)
#define PG8_MMA(ai, bj, At, Bt) do { __builtin_amdgcn_s_setprio(1); _Pragma("unroll") for (int m = 0; m < 4; ++m) _Pragma("unroll") for (int n = 0; n < 2; ++n) _Pragma("unroll") for (int k = 0; k < 2; ++k) \
        acc[ai][bj][m][n] = __builtin_amdgcn_mfma_f32_16x16x32_bf16(Bt[n][k], At[m][k], acc[ai][bj][m][n], 0, 0, 0); __builtin_amdgcn_s_setprio(0); } while (0)
#define PG8_WAIT_V(n) asm volatile("s_waitcnt vmcnt(" #n ")" ::: "memory")
#define PG8_WAIT_L(n) asm volatile("s_waitcnt lgkmcnt(" #n ")" ::: "memory")
#define PG8_BAR __builtin_amdgcn_s_barrier()
#define PG8_SCHED __builtin_amdgcn_sched_barrier(0)
    Unit cur, nxt; int ui = 0;
    if (!S.next(0, cur)) return;
    f32x4 acc[2][2][4][2];
#pragma unroll
    for (int a = 0; a < 2; ++a)
#pragma unroll
        for (int b = 0; b < 2; ++b)
#pragma unroll
            for (int m = 0; m < 4; ++m)
#pragma unroll
                for (int n = 0; n < 2; ++n) acc[a][b][m][n] = (f32x4){0.f, 0.f, 0.f, 0.f};
    bf16x8 At[4][2], B0[2][2], B1[2][2];
    const char* cA = (const char*)g.A + (size_t)cur.pm * tstep; const char* cB = (const char*)g.Bt + (size_t)cur.pn * tstep;
    S.a_ready(cur);
    PG8_STAGE(PG8_SB(0, 0), cB, voffB); PG8_STAGE(PG8_SA(0, 0), cA, voffA); PG8_STAGE(PG8_SB(0, 1), cB + hstep, voffB); PG8_STAGE(PG8_SA(0, 1), cA + hstep, voffA);
    if (wr == 1) PG8_BAR;
    PG8_WAIT_V(4); PG8_BAR;
    PG8_STAGE(PG8_SB(1, 0), cB + kstep, voffB); PG8_STAGE(PG8_SA(1, 0), cA + kstep, voffA); PG8_STAGE(PG8_SB(1, 1), cB + hstep + kstep, voffB);
    PG8_WAIT_V(6); PG8_BAR;
    for (;;) {
        const bool has_next = S.next(ui + 1, nxt);
        const char* nA = has_next ? (const char*)g.A + (size_t)nxt.pm * tstep : cA; const char* nB = has_next ? (const char*)g.Bt + (size_t)nxt.pn * tstep : cB;
        for (int t = 0; t < nt; t += 2) {
            const bool last = (t == nt - 2);
            const char* a1 = cA + (size_t)(t + 1) * kstep;
            const char* a2 = last ? nA : cA + (size_t)(t + 2) * kstep; const char* b2 = last ? nB : cB + (size_t)(t + 2) * kstep;
            const char* a3 = a2 + kstep; const char* b3 = b2 + kstep;
            if (last && has_next) S.a_ready(nxt);
            PG8_LDB(B0, 0, 0); PG8_SCHED; PG8_LDA(At, 0, 0); PG8_STAGE(PG8_SA(1, 1), a1 + hstep, voffA);
            PG8_WAIT_L(8); PG8_BAR; PG8_WAIT_L(0); PG8_MMA(0, 0, At, B0); PG8_BAR; PG8_SCHED;
            PG8_LDB(B1, 0, 1); PG8_STAGE(PG8_SB(0, 0), b2, voffB);
            PG8_BAR; PG8_WAIT_L(0); PG8_MMA(0, 1, At, B1); PG8_BAR;
            PG8_LDA(At, 0, 1); PG8_STAGE(PG8_SA(0, 0), a2, voffA);
            PG8_BAR; PG8_WAIT_L(0); PG8_MMA(1, 0, At, B0); PG8_BAR; PG8_SCHED;
            PG8_STAGE(PG8_SB(0, 1), b2 + hstep, voffB);
            PG8_WAIT_V(6); PG8_BAR; PG8_MMA(1, 1, At, B1); PG8_BAR;
            PG8_LDB(B0, 1, 0); PG8_SCHED; PG8_LDA(At, 1, 0); PG8_STAGE(PG8_SA(0, 1), a2 + hstep, voffA);
            PG8_WAIT_L(8); PG8_BAR; PG8_WAIT_L(0); PG8_MMA(0, 0, At, B0); PG8_BAR; PG8_SCHED;
            PG8_LDB(B1, 1, 1); PG8_STAGE(PG8_SB(1, 0), b3, voffB);
            PG8_BAR; PG8_WAIT_L(0); PG8_MMA(0, 1, At, B1); PG8_BAR;
            PG8_LDA(At, 1, 1); PG8_STAGE(PG8_SA(1, 0), a3, voffA);
            PG8_BAR; PG8_WAIT_L(0); PG8_MMA(1, 0, At, B0); PG8_BAR; PG8_SCHED;
            PG8_STAGE(PG8_SB(1, 1), b3 + hstep, voffB);
            PG8_WAIT_V(6); PG8_BAR; PG8_MMA(1, 1, At, B1); PG8_BAR;
        }
        if constexpr (!Epi::AFTER_DRAIN) { E(acc, cur, wr, wc, fr, fq); S.done(cur); }
        if (!has_next) break;
#pragma unroll
        for (int a = 0; a < 2; ++a)
#pragma unroll
            for (int b = 0; b < 2; ++b)
#pragma unroll
                for (int m = 0; m < 4; ++m)
#pragma unroll
                    for (int n = 0; n < 2; ++n) acc[a][b][m][n] = (f32x4){0.f, 0.f, 0.f, 0.f};
        cur = nxt; cA = nA; cB = nB; ++ui;
    }
    PG8_WAIT_V(0);
    if (wr == 0) PG8_BAR;
    PG8_BAR;
    if constexpr (Epi::AFTER_DRAIN) { E.fused(acc, cur, wr, wc, fr, fq, lds, wid, lane); S.done(cur); }
#undef PG8_SA
#undef PG8_SB
#undef PG8_STAGE
#undef PG8_LDA
#undef PG8_LDB
#undef PG8_MMA
#undef PG8_WAIT_V
#undef PG8_WAIT_L
#undef PG8_BAR
#undef PG8_SCHED
}
}

__device__ __forceinline__ float ssq_total(const float* __restrict__ SSQ, int t) {
  const f32x4 a = *(const f32x4*)(SSQ + (size_t)t * 16), b = *(const f32x4*)(SSQ + (size_t)t * 16 + 4), c = *(const f32x4*)(SSQ + (size_t)t * 16 + 8), d = *(const f32x4*)(SSQ + (size_t)t * 16 + 12);
  return (((a.x + a.y) + (a.z + a.w)) + ((b.x + b.y) + (b.z + b.w))) + (((c.x + c.y) + (c.z + c.w)) + ((d.x + d.y) + (d.z + d.w)));
}
struct EpiProj {
  static constexpr bool PERM = true, AFTER_DRAIN = false;
  bf16_t* PROJ; bf16_t* VTA; bf16_t* VTR;
  __device__ __forceinline__ void operator()(const f32x4 (&acc)[2][2][4][2], const pg8::Unit& u, int wr, int wc, int fr, int fq) const {
    const int row0 = u.pm * 256 + wr * 64 + fr, col0 = u.pn * 256 + wc * 32 + 8 * fq;
    asm volatile("s_nop 15\n\ts_nop 15" ::: "memory");
#pragma unroll
    for (int ai = 0; ai < 2; ++ai)
#pragma unroll
      for (int m = 0; m < 4; ++m) {
        const int t = row0 + ai * 128 + m * 16;
#pragma unroll
        for (int bj = 0; bj < 2; ++bj) {
          const int c = col0 + bj * 128;
          const f32x4 v0 = acc[ai][bj][m][0], v1 = acc[ai][bj][m][1];
          pg8::u32x4 w; w.x = pg8::cvt_pk_bf16(v0[0], v0[1]); w.y = pg8::cvt_pk_bf16(v0[2], v0[3]); w.z = pg8::cvt_pk_bf16(v1[0], v1[1]); w.w = pg8::cvt_pk_bf16(v1[2], v1[3]);
          *(pg8::u32x4*)(PROJ + (size_t)t * INCP + c) = w;
          const bool isva = (c >= C_VA && c < C_VA + 384), isvr = (c >= C_VR && c < C_VR + 384);
          if (isva || isvr) {
            bf16_t* vt = (isva ? VTA : VTR) + ((size_t)(t >> 13) * 384 + (c - (isva ? C_VA : C_VR))) * 8192 + (t & 8191);
            vt[0] = (bf16_t)(w.x & 0xffffu); vt[8192] = (bf16_t)(w.x >> 16); vt[2 * 8192] = (bf16_t)(w.y & 0xffffu); vt[3 * 8192] = (bf16_t)(w.y >> 16);
            vt[4 * 8192] = (bf16_t)(w.z & 0xffffu); vt[5 * 8192] = (bf16_t)(w.z >> 16); vt[6 * 8192] = (bf16_t)(w.w & 0xffffu); vt[7 * 8192] = (bf16_t)(w.w >> 16);
          }
        }
      }
  }
};
struct EpiOut {
  static constexpr bool PERM = true, AFTER_DRAIN = false;
  const float* xin; int first; bf16_t* X; const float* g1; const float* nf; const float* sc2; bf16_t* XG; float* SSQ;
  __device__ __forceinline__ void operator()(const f32x4 (&acc)[2][2][4][2], const pg8::Unit& u, int wr, int wc, int fr, int fq) const {
    const int row0 = u.pm * 256 + wr * 64 + fr, col0 = u.pn * 256 + wc * 32 + 8 * fq, b = (u.pm * 256) >> 13;
    f32x4 gg[2][2], gs[2][2];
#pragma unroll
    for (int bj = 0; bj < 2; ++bj)
#pragma unroll
      for (int n = 0; n < 2; ++n) {
        const int c = col0 + bj * 128 + n * 4;
        gg[bj][n] = *(const f32x4*)(g1 + b * 6144 + c);
        const f32x4 gf = *(const f32x4*)(nf + c), sc = *(const f32x4*)(sc2 + b * 6144 + c);
        gs[bj][n] = gf * (sc + 1.f);
      }
#pragma unroll
    for (int ai = 0; ai < 2; ++ai)
#pragma unroll
      for (int m = 0; m < 4; ++m) {
        const int t = row0 + ai * 128 + m * 16;
        float sq = 0.f;
#pragma unroll
        for (int bj = 0; bj < 2; ++bj) {
          const int c = col0 + bj * 128;
          f32x4 x0, x1;
          if (first) { x0 = *(const f32x4*)(xin + (size_t)t * 1024 + c); x1 = *(const f32x4*)(xin + (size_t)t * 1024 + c + 4); }
          else {
            const pg8::u32x4 xr = *(const pg8::u32x4*)(X + (size_t)t * 1024 + c);
            x0 = (f32x4){__uint_as_float(xr.x << 16), __uint_as_float(xr.x & 0xffff0000u), __uint_as_float(xr.y << 16), __uint_as_float(xr.y & 0xffff0000u)};
            x1 = (f32x4){__uint_as_float(xr.z << 16), __uint_as_float(xr.z & 0xffff0000u), __uint_as_float(xr.w << 16), __uint_as_float(xr.w & 0xffff0000u)};
          }
          const f32x4 n0 = x0 + gg[bj][0] * acc[ai][bj][m][0], n1 = x1 + gg[bj][1] * acc[ai][bj][m][1];
          pg8::u32x4 xo; xo.x = pg8::cvt_pk_bf16(n0.x, n0.y); xo.y = pg8::cvt_pk_bf16(n0.z, n0.w); xo.z = pg8::cvt_pk_bf16(n1.x, n1.y); xo.w = pg8::cvt_pk_bf16(n1.z, n1.w);
          *(pg8::u32x4*)(X + (size_t)t * 1024 + c) = xo;
          const f32x4 s0 = n0 * gs[bj][0], s1 = n1 * gs[bj][1];
          pg8::u32x4 go; go.x = pg8::cvt_pk_bf16(s0.x, s0.y); go.y = pg8::cvt_pk_bf16(s0.z, s0.w); go.z = pg8::cvt_pk_bf16(s1.x, s1.y); go.w = pg8::cvt_pk_bf16(s1.z, s1.w);
          *(pg8::u32x4*)(XG + (size_t)t * 1024 + c) = go;
          sq += ((n0.x * n0.x + n0.y * n0.y) + (n0.z * n0.z + n0.w * n0.w)) + ((n1.x * n1.x + n1.y * n1.y) + (n1.z * n1.z + n1.w * n1.w));
        }
        sq += __shfl_xor(sq, 16); sq += __shfl_xor(sq, 32);
        if (fq == 0) SSQ[(size_t)t * 16 + u.pn * 4 + wc] = sq;
      }
  }
};
struct EpiQ {
  static constexpr bool PERM = true, AFTER_DRAIN = false;
  bf16_t* SC8; const float* SSQ; const float* C2;
  __device__ __forceinline__ void operator()(const f32x4 (&acc)[2][2][4][2], const pg8::Unit& u, int wr, int wc, int fr, int fq) const {
    const int row0 = u.pm * 256 + wr * 64 + fr, col0 = u.pn * 256 + wc * 32 + 8 * fq, b = (u.pm * 256) >> 13;
    f32x4 cc[2][2];
#pragma unroll
    for (int bj = 0; bj < 2; ++bj) { cc[bj][0] = *(const f32x4*)(C2 + b * 2048 + col0 + bj * 128); cc[bj][1] = *(const f32x4*)(C2 + b * 2048 + col0 + bj * 128 + 4); }
#pragma unroll
    for (int ai = 0; ai < 2; ++ai)
#pragma unroll
      for (int m = 0; m < 4; ++m) {
        const int t = row0 + ai * 128 + m * 16;
        const float rstd = rsqrtf(ssq_total(SSQ, t) * (1.f / 1024.f) + EPS_);
#pragma unroll
        for (int bj = 0; bj < 2; ++bj) {
          const f32x4 v0 = acc[ai][bj][m][0] * rstd + cc[bj][0], v1 = acc[ai][bj][m][1] * rstd + cc[bj][1];
          pg8::u32x4 w; w.x = pg8::cvt_pk_bf16(v0[0], v0[1]); w.y = pg8::cvt_pk_bf16(v0[2], v0[3]); w.z = pg8::cvt_pk_bf16(v1[0], v1[1]); w.w = pg8::cvt_pk_bf16(v1[2], v1[3]);
          *(pg8::u32x4*)(SC8 + ((size_t)((col0 + bj * 128) >> 3) * T_ + t) * 8) = w;
        }
      }
  }
};

__device__ void gemm_proj_phase(const Params& p, int l, unsigned char* smem) {
  const CParamsP pp = launder_kargs();
  GAS unsigned char* const ws = launder_ptr(pp->ws);
  pg8::Gemm g; g.A = (const bf16_t*)(ws + WS_ABUF); g.Bt = (const bf16_t*)(ws + WS_WIN) + (size_t)l * INCP * 1024; g.M = T_; g.N = INCP; g.K = 1024;
  pg8::StaticOrder S; S.init(T_, INCP, gridDim.x, blockIdx.x);
  EpiProj E; E.PROJ = (bf16_t*)(ws + WS_PROJ); E.VTA = (bf16_t*)(ws + WS_VTA); E.VTR = (bf16_t*)(ws + WS_VTR);
  pg8::gemm_phase<EpiProj, pg8::StaticOrder>((PG8_LAS unsigned char*)smem, g, S, E);
}
__device__ void gemm_out_phase(const Params& p, int l, unsigned char* smem) {
  const CParamsP pp = launder_kargs();
  GAS unsigned char* const ws = launder_ptr(pp->ws);
  pg8::Gemm g; g.A = (const bf16_t*)(ws + WS_ABUF); g.Bt = (const bf16_t*)(ws + WS_WOUT) + (size_t)l * 1024 * 1024; g.M = T_; g.N = 1024; g.K = 1024;
  pg8::StaticOrder S; S.init(T_, 1024, gridDim.x, blockIdx.x);
  EpiOut E; E.xin = gin(pp->in[I_X]); E.first = (l == 0) ? 1 : 0; E.X = (bf16_t*)(ws + WS_X); E.g1 = (const float*)(ws + WS_MOD) + (size_t)l * 2 * 6144 + 2048;
  E.nf = gin(pp->in[I_NFFN]) + (size_t)l * 1024; E.sc2 = (const float*)(ws + WS_MOD) + (size_t)l * 2 * 6144 + 4096; E.XG = (bf16_t*)(ws + WS_XG); E.SSQ = (float*)(ws + WS_SSQ);
  pg8::gemm_phase<EpiOut, pg8::StaticOrder>((PG8_LAS unsigned char*)smem, g, S, E);
}
__device__ void gemm_q_phase(const Params& p, int l, unsigned char* smem) {
  const CParamsP pp = launder_kargs();
  GAS unsigned char* const ws = launder_ptr(pp->ws);
  pg8::Gemm g; g.A = (const bf16_t*)(ws + WS_XG); g.Bt = (const bf16_t*)(ws + WS_WQ) + (size_t)l * 2048 * 1024; g.M = T_; g.N = 2048; g.K = 1024;
  pg8::StaticOrder S; S.init(T_, 2048, gridDim.x, blockIdx.x);
  EpiQ E; E.SC8 = (bf16_t*)(ws + WS_SC); E.SSQ = (const float*)(ws + WS_SSQ); E.C2 = (const float*)(ws + WS_C2) + (size_t)l * 2 * 2048;
  pg8::gemm_phase<EpiQ, pg8::StaticOrder>((PG8_LAS unsigned char*)smem, g, S, E);
}

__device__ __forceinline__ int attn_fk(int r) { return ((r >> 3) & 3) | (((r >> 1) & 1) << 2); }
__device__ __forceinline__ int attn_fv(int r) { return (r >> 1) & 7; }
__device__ void attn_phase(const Params& p, int l, unsigned char* smem) {
  const CParamsP pp = launder_kargs();
  GAS unsigned char* const ws = launder_ptr(pp->ws); const int tidx = launder_tid();
  const bf16_t* PROJ = (const bf16_t*)(ws + WS_PROJ); const bf16_t* VTA = (const bf16_t*)(ws + WS_VTA);
  bf16_t* ATT = (bf16_t*)(ws + WS_ATT);
  const int lane = tidx & 63, wid = tidx >> 6, fr = lane & 15, fq = lane >> 4;
  float* ext = (float*)smem;
  unsigned char* stg = smem + 15360;
  constexpr float LOG2E = 1.4426950408889634f;
  __syncthreads();
  for (int idx = tidx; idx < 6 * 640; idx += NT) {
    const int h = idx / 640, e = idx - h * 640; int d = e - 63; d = d > 256 ? 256 : d;
    ext[idx] = gin(pp->in[I_RELB])[((size_t)l * 6 + h) * 513 + d + 256] * LOG2E;
  }
  const int hh = wid >> 2, qb = wid & 3, iq = qb * 16 + fr;
  const int srow = tidx >> 3, sch = tidx & 7;
  for (int it_ = blockIdx.x; it_ < 256; it_ += gridDim.x) {
    const int item = ((it_ & 7) << 5) | (it_ >> 3);
    const int b = item >> 7, n = item & 127, t0 = b * 8192 + n * 64;
    const int jc0 = n >= 8 ? 0 : 8 - n, nch = 9 - jc0, nst = 3 * nch;
    uint4 sa0, sa1, sa2, sa3, sb0, sb1, sb2, sb3;
#define ATTN_LOAD(S, st) do { const int _rd = (st) / nch, _jc = jc0 + (st) - _rd * nch, _m = n - 8 + _jc; \
      S##0 = *(const uint4*)(PROJ + (size_t)(b * 8192 + _m * 64 + srow) * INCP + C_KA + (2 * _rd) * 64 + sch * 8); \
      S##1 = *(const uint4*)(PROJ + (size_t)(b * 8192 + _m * 64 + srow) * INCP + C_KA + (2 * _rd + 1) * 64 + sch * 8); \
      S##2 = *(const uint4*)(VTA + ((size_t)b * 384 + (2 * _rd) * 64 + srow) * 8192 + _m * 64 + sch * 8); \
      S##3 = *(const uint4*)(VTA + ((size_t)b * 384 + (2 * _rd + 1) * 64 + srow) * 8192 + _m * 64 + sch * 8); } while (0)
#define ATTN_WRITE(S, buf) do { unsigned char* _bp = stg + (buf) * 32768; \
      *(uint4*)(_bp + srow * 128 + ((sch ^ attn_fk(srow)) << 4)) = S##0; \
      *(uint4*)(_bp + 8192 + srow * 128 + ((sch ^ attn_fk(srow)) << 4)) = S##1; \
      *(uint4*)(_bp + 16384 + srow * 128 + ((sch ^ attn_fv(srow)) << 4)) = S##2; \
      *(uint4*)(_bp + 24576 + srow * 128 + ((sch ^ attn_fv(srow)) << 4)) = S##3; } while (0)
    __syncthreads();
    ATTN_LOAD(sa, 0);
    ATTN_WRITE(sa, 0);
    if (1 < nst) ATTN_LOAD(sb, 1);
    __syncthreads();
    bf16x8 qf[2];
    f32x4 o[4];
    float mrun = -1e30f, lrun = 0.f;
    const float* exth = ext;
    auto attn_compute = [&](const int st) {
      const int rd = st / nch, jc = jc0 + st - rd * nch, h = 2 * rd + hh;
      if (jc == jc0) {
#pragma unroll
        for (int ds = 0; ds < 2; ++ds) qf[ds] = *(const bf16x8*)(PROJ + (size_t)(t0 + iq) * INCP + C_QA + h * 64 + ds * 32 + fq * 8);
#pragma unroll
        for (int et = 0; et < 4; ++et) o[et] = (f32x4){0.f, 0.f, 0.f, 0.f};
        mrun = -1e30f; lrun = 0.f;
        exth = ext + h * 640 + 63 + 512 + iq - 8 * fq;
      }
      const unsigned char* kb = stg + (st & 1) * 32768 + hh * 8192;
      const unsigned char* vb = stg + (st & 1) * 32768 + (2 + hh) * 8192;
      float sc[2][2][4];
      bf16x8 kfr[2][2][2], vfr[2][4]; float bia[2][2][4];
#pragma unroll
      for (int g = 0; g < 2; ++g)
#pragma unroll
        for (int tt = 0; tt < 2; ++tt) {
          const int key = 32 * g + 8 * (fr >> 2) + (fr & 3) + 4 * tt, fk = attn_fk(key);
          kfr[g][tt][0] = *(const bf16x8*)(kb + key * 128 + ((fq ^ fk) << 4));
          kfr[g][tt][1] = *(const bf16x8*)(kb + key * 128 + (((4 + fq) ^ fk) << 4));
        }
#pragma unroll
      for (int g = 0; g < 2; ++g)
#pragma unroll
        for (int tt = 0; tt < 2; ++tt)
#pragma unroll
          for (int j = 0; j < 4; ++j) bia[g][tt][j] = exth[-(64 * jc + 32 * g + 4 * tt + j)];
#pragma unroll
      for (int g = 0; g < 2; ++g)
#pragma unroll
        for (int et = 0; et < 4; ++et) { const int er = 16 * et + fr; vfr[g][et] = *(const bf16x8*)(vb + er * 128 + (((4 * g + fq) ^ attn_fv(er)) << 4)); }
      __builtin_amdgcn_sched_barrier(0);
#pragma unroll
      for (int g = 0; g < 2; ++g)
#pragma unroll
        for (int tt = 0; tt < 2; ++tt) {
          f32x4 s4 = __builtin_amdgcn_mfma_f32_16x16x32_bf16(kfr[g][tt][0], qf[0], (f32x4){0.f, 0.f, 0.f, 0.f}, 0, 0, 0);
          s4 = __builtin_amdgcn_mfma_f32_16x16x32_bf16(kfr[g][tt][1], qf[1], s4, 0, 0, 0);
#pragma unroll
          for (int j = 0; j < 4; ++j) sc[g][tt][j] = s4[j] * (0.125f * LOG2E) + bia[g][tt][j];
        }
      float mloc = -1e30f;
#pragma unroll
      for (int g = 0; g < 2; ++g)
#pragma unroll
        for (int tt = 0; tt < 2; ++tt)
#pragma unroll
          for (int j = 0; j < 4; ++j) mloc = fmaxf(mloc, sc[g][tt][j]);
      mloc = fmaxf(mloc, __shfl_xor(mloc, 16)); mloc = fmaxf(mloc, __shfl_xor(mloc, 32));
      const float mnew = fmaxf(mrun, mloc), alpha = __builtin_amdgcn_exp2f(mrun - mnew);
      mrun = mnew;
      float ls = 0.f;
#pragma unroll
      for (int g = 0; g < 2; ++g)
#pragma unroll
        for (int tt = 0; tt < 2; ++tt)
#pragma unroll
          for (int j = 0; j < 4; ++j) { const float e = __builtin_amdgcn_exp2f(sc[g][tt][j] - mnew); sc[g][tt][j] = e; ls += e; }
      lrun = lrun * alpha + ls;
#pragma unroll
      for (int et = 0; et < 4; ++et) { o[et].x *= alpha; o[et].y *= alpha; o[et].z *= alpha; o[et].w *= alpha; }
#pragma unroll
      for (int g = 0; g < 2; ++g) {
        union { bf16x8 v; unsigned u[4]; } pf;
        pf.u[0] = pk2(sc[g][0][0], sc[g][0][1]); pf.u[1] = pk2(sc[g][0][2], sc[g][0][3]);
        pf.u[2] = pk2(sc[g][1][0], sc[g][1][1]); pf.u[3] = pk2(sc[g][1][2], sc[g][1][3]);
#pragma unroll
        for (int et = 0; et < 4; ++et) o[et] = __builtin_amdgcn_mfma_f32_16x16x32_bf16(vfr[g][et], pf.v, o[et], 0, 0, 0);
      }
      if (jc == 8) {
        float lt = lrun + __shfl_xor(lrun, 16); lt += __shfl_xor(lt, 32);
        const float inv = 1.f / lt;
#pragma unroll
        for (int et = 0; et < 4; ++et) {
          f32x4 v = o[et]; v.x *= inv; v.y *= inv; v.z *= inv; v.w *= inv;
          { uint2 ov; ov.x = pk2(v.x, v.y); ov.y = pk2(v.z, v.w); *(uint2*)(ATT + (size_t)(t0 + iq) * 384 + h * 64 + et * 16 + fq * 4) = ov; }
        }
      }
    };
#pragma unroll 1
    for (int st0 = 0; st0 < nst; st0 += 2) {
      { const int st = st0;
        if (st + 2 < nst) ATTN_LOAD(sa, st + 2);
        attn_compute(st);
        if (st + 1 < nst) ATTN_WRITE(sb, (st + 1) & 1);
        __syncthreads(); }
      if (st0 + 1 < nst) { const int st = st0 + 1;
        if (st + 2 < nst) ATTN_LOAD(sb, st + 2);
        attn_compute(st);
        if (st + 1 < nst) ATTN_WRITE(sa, (st + 1) & 1);
        __syncthreads(); }
    }
#undef ATTN_LOAD
#undef ATTN_WRITE
  }
  __syncthreads();
}

__device__ __forceinline__ void ssm_bu32(const bf16_t* __restrict__ bbh_g, const bf16_t* __restrict__ urow, int lane,
                                         f32x16& lo_re, f32x16& hi_re, f32x16& lo_im, f32x16& hi_im) {
  const int hf = lane >> 5;
  const bf16x8 ub = *(const bf16x8*)(urow + 8 * hf);
  f32x16 z;
#pragma unroll
  for (int r = 0; r < 16; ++r) z[r] = 0.f;
  const bf16x8 a0r = *(const bf16x8*)(bbh_g + (size_t)(0 * 64 + lane) * 8), a1r = *(const bf16x8*)(bbh_g + (size_t)(1 * 64 + lane) * 8);
  const bf16x8 a0i = *(const bf16x8*)(bbh_g + (size_t)(2 * 64 + lane) * 8), a1i = *(const bf16x8*)(bbh_g + (size_t)(3 * 64 + lane) * 8);
  lo_re = __builtin_amdgcn_mfma_f32_32x32x16_bf16(ub, a0r, z, 0, 0, 0); hi_re = __builtin_amdgcn_mfma_f32_32x32x16_bf16(ub, a1r, z, 0, 0, 0);
  lo_im = __builtin_amdgcn_mfma_f32_32x32x16_bf16(ub, a0i, z, 0, 0, 0); hi_im = __builtin_amdgcn_mfma_f32_32x32x16_bf16(ub, a1i, z, 0, 0, 0);
#pragma unroll
  for (int r = 0; r < 16; ++r) {
    const auto s1 = __builtin_amdgcn_permlane32_swap(__float_as_uint(lo_re[r]), __float_as_uint(hi_re[r]), false, false);
    lo_re[r] = __uint_as_float(s1[0]); hi_re[r] = __uint_as_float(s1[1]);
    const auto s2 = __builtin_amdgcn_permlane32_swap(__float_as_uint(lo_im[r]), __float_as_uint(hi_im[r]), false, false);
    lo_im[r] = __uint_as_float(s2[0]); hi_im[r] = __uint_as_float(s2[1]);
  }
}
__device__ __forceinline__ void rotary_frag(const bf16x8 x0, const bf16x8 x1, const float* RC, const float* RS, int pos, int fq, float scale, bf16x8& o0, bf16x8& o1) {
  const f32x4 c0 = *(const f32x4*)(RC + pos * 32 + 8 * fq), c1 = *(const f32x4*)(RC + pos * 32 + 8 * fq + 4);
  const f32x4 s0 = *(const f32x4*)(RS + pos * 32 + 8 * fq), s1 = *(const f32x4*)(RS + pos * 32 + 8 * fq + 4);
  const float cc[8] = {c0.x, c0.y, c0.z, c0.w, c1.x, c1.y, c1.z, c1.w}, sn[8] = {s0.x, s0.y, s0.z, s0.w, s1.x, s1.y, s1.z, s1.w};
  union { bf16x8 v; unsigned u[4]; } r0, r1;
#pragma unroll
  for (int q = 0; q < 4; ++q) {
    const float a0 = bf2f((bf16_t)x0[2 * q]) * scale, a1 = bf2f((bf16_t)x0[2 * q + 1]) * scale, b0 = bf2f((bf16_t)x1[2 * q]) * scale, b1 = bf2f((bf16_t)x1[2 * q + 1]) * scale;
    r0.u[q] = pk2(a0 * cc[2 * q] - b0 * sn[2 * q], a1 * cc[2 * q + 1] - b1 * sn[2 * q + 1]);
    r1.u[q] = pk2(a0 * sn[2 * q] + b0 * cc[2 * q], a1 * sn[2 * q + 1] + b1 * cc[2 * q + 1]);
  }
  o0 = r0.v; o1 = r1.v;
}
__device__ void mix_local_phase(const Params& p, int l, unsigned char* smem) {
  const CParamsP pp = launder_kargs();
  GAS unsigned char* const ws = launder_ptr(pp->ws); const int tidx = launder_tid();
  const bf16_t* PROJ = (const bf16_t*)(ws + WS_PROJ); const bf16_t* VTR = (const bf16_t*)(ws + WS_VTR);
  const float* RC = (const float*)(ws + WS_ROTC); const float* RS = (const float*)(ws + WS_ROTS);
  bf16_t* YINT = (bf16_t*)(ws + WS_YINT); float* UPDT = (float*)(ws + WS_UPD);
  const float* SA = (const float*)(ws + WS_SA) + (size_t)l * 16 * 64 * 2; const bf16_t* BBH = (const bf16_t*)(ws + WS_BBH) + (size_t)l * 16 * 2 * 64 * 16;
  float* SEND = (float*)(ws + WS_SEND);
  const int tid = tidx, lane = tid & 63, wid = tid >> 6, fr = lane & 15, fq = lane >> 4;
  bf16_t* KT = (bf16_t*)smem;
  float* rcL = (float*)(smem + 55296); float* rsL = rcL + 2048;
  for (int it_ = blockIdx.x; it_ < 256; it_ += gridDim.x) {
    const int item = ((it_ & 7) << 5) | (it_ >> 3);
    const int b = item >> 7, n = item & 127, t0 = b * 8192 + n * 64;
    __syncthreads();
#pragma unroll
    for (int i = 0; i < 4; ++i) { rcL[tid + NT * i] = RC[n * 2048 + tid + NT * i]; rsL[tid + NT * i] = RS[n * 2048 + tid + NT * i]; }
    __syncthreads();
#pragma unroll 1
    for (int k3 = 0; k3 < 3; ++k3) {
      const int task = wid * 3 + k3, h = task >> 2, tb = task & 3;
      const int i = 16 * tb + fr;
      const float lg2 = log2f(1.f - exp2f(-5.f - (float)h));
      bf16x8 qraw[2], kraw[2][2][2], vraw[2][4];
      {
        const bf16_t* qp = PROJ + (size_t)(t0 + i) * INCP + C_QR + h * 64 + 8 * fq;
        qraw[0] = *(const bf16x8*)qp; qraw[1] = *(const bf16x8*)(qp + 32);
#pragma unroll
        for (int g = 0; g < 2; ++g) {
#pragma unroll
          for (int tt = 0; tt < 2; ++tt) {
            const int key = 32 * g + 8 * (fr >> 2) + (fr & 3) + 4 * tt;
            const bf16_t* kp = PROJ + (size_t)(t0 + key) * INCP + C_KR + h * 64 + 8 * fq;
            kraw[g][tt][0] = *(const bf16x8*)kp; kraw[g][tt][1] = *(const bf16x8*)(kp + 32);
          }
#pragma unroll
          for (int et = 0; et < 4; ++et) vraw[g][et] = *(const bf16x8*)(VTR + ((size_t)b * 384 + h * 64 + et * 16 + fr) * 8192 + n * 64 + 32 * g + 8 * fq);
        }
      }
      __builtin_amdgcn_sched_barrier(0);
      bf16x8 qf0, qf1;
      rotary_frag(qraw[0], qraw[1], rcL, rsL, i, fq, 1.f, qf0, qf1);
      f32x4 o[4];
#pragma unroll
      for (int et = 0; et < 4; ++et) o[et] = (f32x4){0.f, 0.f, 0.f, 0.f};
#pragma unroll
      for (int g = 0; g < 2; ++g) {
        float st[2][4];
#pragma unroll
        for (int tt = 0; tt < 2; ++tt) {
          const int key = 32 * g + 8 * (fr >> 2) + (fr & 3) + 4 * tt;
          bf16x8 kf0, kf1;
          rotary_frag(kraw[g][tt][0], kraw[g][tt][1], rcL, rsL, key, fq, 0.125f, kf0, kf1);
          f32x4 s4 = __builtin_amdgcn_mfma_f32_16x16x32_bf16(kf0, qf0, (f32x4){0.f, 0.f, 0.f, 0.f}, 0, 0, 0);
          s4 = __builtin_amdgcn_mfma_f32_16x16x32_bf16(kf1, qf1, s4, 0, 0, 0);
#pragma unroll
          for (int j = 0; j < 4; ++j) {
            const int kk = 32 * g + 8 * fq + 4 * tt + j;
            const int dij = i > kk ? i - kk : kk - i;
            st[tt][j] = s4[j] * exp2f(lg2 * (float)dij);
          }
          if (tb == 0) {
            const float kd = exp2f(lg2 * (float)(63 - key));
#pragma unroll
            for (int jj = 0; jj < 8; ++jj) {
              KT[(h * 64 + 8 * fq + jj) * 72 + key] = f2bf(bf2f((bf16_t)kf0[jj]) * kd);
              KT[(h * 64 + 32 + 8 * fq + jj) * 72 + key] = f2bf(bf2f((bf16_t)kf1[jj]) * kd);
            }
          }
        }
        union { bf16x8 v; unsigned u[4]; } pf;
        pf.u[0] = pk2(st[0][0], st[0][1]); pf.u[1] = pk2(st[0][2], st[0][3]); pf.u[2] = pk2(st[1][0], st[1][1]); pf.u[3] = pk2(st[1][2], st[1][3]);
#pragma unroll
        for (int et = 0; et < 4; ++et) o[et] = __builtin_amdgcn_mfma_f32_16x16x32_bf16(vraw[g][et], pf.v, o[et], 0, 0, 0);
      }
#pragma unroll
      for (int et = 0; et < 4; ++et) { uint2 ov; ov.x = pk2(o[et].x, o[et].y); ov.y = pk2(o[et].z, o[et].w); *(uint2*)(YINT + (((((size_t)item * 6 + h) * 4 + tb) * 4 + et) * 64 + lane) * 4) = ov; }
    }
    __syncthreads();
#pragma unroll 1
    for (int k3 = 0; k3 < 3; ++k3) {
      const int task = wid * 3 + k3, h = task >> 2, et = task & 3;
      f32x4 acc[4];
#pragma unroll
      for (int dt = 0; dt < 4; ++dt) acc[dt] = (f32x4){0.f, 0.f, 0.f, 0.f};
#pragma unroll
      for (int g = 0; g < 2; ++g) {
        const bf16x8 vf = *(const bf16x8*)(VTR + ((size_t)b * 384 + h * 64 + et * 16 + fr) * 8192 + n * 64 + 32 * g + 8 * fq);
#pragma unroll
        for (int dt = 0; dt < 4; ++dt) {
          const bf16x8 kt = *(const bf16x8*)(KT + (h * 64 + 16 * dt + fr) * 72 + 32 * g + 8 * fq);
          acc[dt] = __builtin_amdgcn_mfma_f32_16x16x32_bf16(kt, vf, acc[dt], 0, 0, 0);
        }
      }
#pragma unroll
      for (int dt = 0; dt < 4; ++dt) *(f32x4*)(UPDT + (((size_t)item * 6 + h) * 64 + 16 * et + fr) * 64 + 16 * dt + 4 * fq) = acc[dt];
    }
#pragma unroll 1
    for (int gi = 0; gi < 2; ++gi) {
      const int g = wid * 2 + gi;
      const float are = SA[(g * 64 + lane) * 2], aim = SA[(g * 64 + lane) * 2 + 1];
      float xr = 0.f, xi = 0.f;
#pragma unroll 1
      for (int blk = 0; blk < 2; ++blk) {
        f32x16 lr, hr, li, hi;
        ssm_bu32(BBH + (size_t)g * 2 * 64 * 16, PROJ + (size_t)(t0 + 32 * blk + (lane & 31)) * INCP + C_US + g * 16, lane, lr, hr, li, hi);
#pragma unroll
        for (int a4 = 0; a4 < 4; ++a4) {
#pragma unroll
          for (int bq = 0; bq < 4; ++bq) { const float nr = are * xr - aim * xi + lr[4 * a4 + bq], ni = are * xi + aim * xr + li[4 * a4 + bq]; xr = nr; xi = ni; }
#pragma unroll
          for (int bq = 0; bq < 4; ++bq) { const float nr = are * xr - aim * xi + hr[4 * a4 + bq], ni = are * xi + aim * xr + hi[4 * a4 + bq]; xr = nr; xi = ni; }
        }
      }
      SEND[(((size_t)item * 16 + g) * 64 + lane) * 2] = xr; SEND[(((size_t)item * 16 + g) * 64 + lane) * 2 + 1] = xi;
    }
  }
}

__device__ void scan_phase(const Params& p, int l) {
  const CParamsP pp = launder_kargs();
  GAS unsigned char* const ws = launder_ptr(pp->ws); const int tidx = launder_tid();
  const float* __restrict__ UPDT = (const float*)(ws + WS_UPD); bf16_t* __restrict__ SPT = (bf16_t*)(ws + WS_SPT);
  const float* __restrict__ SEND = (const float*)(ws + WS_SEND); float* __restrict__ CARRY = (float*)(ws + WS_CARRY);
  const float* SA = (const float*)(ws + WS_SA) + (size_t)l * 16 * 64 * 2;
  const int gtid = blockIdx.x * NT + tidx, gn = gridDim.x * NT;
  for (int idx = gtid; idx < 2 * 6 * 4096 + 2 * 1024; idx += gn) {
    if (idx < 2 * 6 * 4096) {
      const int b = idx / (6 * 4096), r = idx % (6 * 4096), h = r >> 12;
      const float cd = exp2f(64.f * log2f(1.f - exp2f(-5.f - (float)h)));
      const int e_ = (r >> 6) & 63, d_ = r & 63;
      const int spoff = h * 4096 + ((((e_ >> 4) * 2 + (d_ >> 5)) * 64 + ((d_ >> 3) & 3) * 16 + (e_ & 15)) * 8 + (d_ & 7));
      float s = 0.f;
#pragma unroll 1
      for (int nb = 0; nb < NCH; nb += 16) {
        float v[16];
#pragma unroll
        for (int j = 0; j < 16; ++j) v[j] = UPDT[((size_t)(b * NCH + nb + j)) * 6 * 4096 + r];
#pragma unroll
        for (int j = 0; j < 16; ++j) { SPT[((size_t)(b * NCH + nb + j)) * 6 * 4096 + spoff] = f2bf(s); s = cd * s + v[j]; }
      }
    } else {
      const int r2 = idx - 2 * 6 * 4096, b = r2 >> 10, gp = r2 & 1023;
      float ar = SA[gp * 2], ai = SA[gp * 2 + 1];
#pragma unroll
      for (int q = 0; q < 6; ++q) { const float nr = ar * ar - ai * ai, ni = 2.f * ar * ai; ar = nr; ai = ni; }
      float xr = 0.f, xi = 0.f;
#pragma unroll 1
      for (int nb = 0; nb < NCH; nb += 16) {
        float2 v[16];
#pragma unroll
        for (int j = 0; j < 16; ++j) v[j] = *(const float2*)(SEND + (((size_t)(b * NCH + nb + j)) * 1024 + gp) * 2);
#pragma unroll
        for (int j = 0; j < 16; ++j) {
          *(float2*)(CARRY + (((size_t)(b * NCH + nb + j)) * 1024 + gp) * 2) = make_float2(xr, xi);
          const float nr = ar * xr - ai * xi + v[j].x, ni = ar * xi + ai * xr + v[j].y;
          xr = nr; xi = ni;
        }
      }
    }
  }
  if (l + 1 < DEPTH_) convert_tables_fp4(pp, ws, l + 1, gtid, gn);
}

__device__ void mix_final_phase(const Params& p, int l, unsigned char* smem) {
  const CParamsP pp = launder_kargs();
  GAS unsigned char* const ws = launder_ptr(pp->ws); const int tidx = launder_tid();
  const bf16_t* PROJ = (const bf16_t*)(ws + WS_PROJ);
  const float* RC = (const float*)(ws + WS_ROTC); const float* RS = (const float*)(ws + WS_ROTS);
  const bf16_t* YINT = (const bf16_t*)(ws + WS_YINT); const bf16_t* SPT = (const bf16_t*)(ws + WS_SPT);
  const bf16_t* ATT = (const bf16_t*)(ws + WS_ATT);
  const float* SA = (const float*)(ws + WS_SA) + (size_t)l * 16 * 64 * 2; const bf16_t* BBH = (const bf16_t*)(ws + WS_BBH) + (size_t)l * 16 * 2 * 64 * 16;
  const float* CARRY = (const float*)(ws + WS_CARRY);
  const bf16_t* CB = (const bf16_t*)(ws + WS_CB) + (size_t)l * 16 * 16 * 128; const bf16_t* WG = (const bf16_t*)(ws + WS_WGLUT) + (size_t)l * 512 * 256;
  const float* dsk = gin(pp->in[I_SSMD]) + (size_t)l * 256;
  const float* mg = gin(pp->in[I_MGAIN]) + (size_t)l * 1024;
  bf16_t* MRG = (bf16_t*)(ws + WS_ABUF);
  const int tid = tidx, lane = tid & 63, wid = tid >> 6, fr = lane & 15, fq = lane >> 4;
  bf16_t* YS = (bf16_t*)smem;
  float* red = (float*)(smem + 33792);
  bf16_t* XB = (bf16_t*)(smem + 36864 + wid * 8448 + 4096);
  float* rcL = (float*)(smem + 104448); float* rsL = rcL + 2048;
  for (int it_ = blockIdx.x; it_ < 256; it_ += gridDim.x) {
    const int item = ((it_ & 7) << 5) | (it_ >> 3);
    const int b = item >> 7, n = item & 127, t0 = b * 8192 + n * 64;
    __syncthreads();
#pragma unroll
    for (int i = 0; i < 4; ++i) { rcL[tid + NT * i] = RC[n * 2048 + tid + NT * i]; rsL[tid + NT * i] = RS[n * 2048 + tid + NT * i]; }
    __syncthreads();
    {
      float av[8][6], mgl[6];
#pragma unroll
      for (int ii = 0; ii < 8; ++ii)
#pragma unroll
        for (int j = 0; j < 6; ++j) av[ii][j] = bf2f(ATT[(size_t)(t0 + wid * 8 + ii) * 384 + lane + 64 * j]);
#pragma unroll
      for (int j = 0; j < 6; ++j) mgl[j] = mg[lane + 64 * j];
      __builtin_amdgcn_sched_barrier(0);
#pragma unroll
      for (int ii = 0; ii < 8; ++ii) {
        const int t = t0 + wid * 8 + ii;
        float sq = 0.f;
#pragma unroll
        for (int j = 0; j < 6; ++j) sq += av[ii][j] * av[ii][j];
        const float rstd = rsqrtf(wave_sum(sq) * (1.f / 384.f) + EPS_);
#pragma unroll
        for (int j = 0; j < 6; ++j) MRG[(size_t)t * 1024 + lane + 64 * j] = f2bf(av[ii][j] * rstd * mgl[j]);
      }
    }
#pragma unroll 1
    for (int k3 = 0; k3 < 3; ++k3) {
      const int task = wid * 3 + k3, h = task >> 2, tb = task & 3;
      const int i = 16 * tb + fr, t = t0 + i;
      const float lg2 = log2f(1.f - exp2f(-5.f - (float)h));
      bf16x8 qraw[2], spf[4][2]; f32x4 yiv[4], mgq[4]; uint2 grv[4];
      {
        const bf16_t* qp = PROJ + (size_t)t * INCP + C_QR + h * 64 + 8 * fq;
        qraw[0] = *(const bf16x8*)qp; qraw[1] = *(const bf16x8*)(qp + 32);
#pragma unroll
        for (int et = 0; et < 4; ++et) {
          const bf16_t* sp = SPT + ((size_t)item * 6 + h) * 4096 + (size_t)(et * 2) * 512 + lane * 8;
          spf[et][0] = *(const bf16x8*)sp; spf[et][1] = *(const bf16x8*)(sp + 512);
          { const uint2 yr = *(const uint2*)(YINT + (((((size_t)item * 6 + h) * 4 + tb) * 4 + et) * 64 + lane) * 4); yiv[et] = (f32x4){__uint_as_float(yr.x << 16), __uint_as_float(yr.x & 0xffff0000u), __uint_as_float(yr.y << 16), __uint_as_float(yr.y & 0xffff0000u)}; }
          grv[et] = *(const uint2*)(PROJ + (size_t)t * INCP + C_GR + h * 64 + 16 * et + 4 * fq);
          mgq[et] = *(const f32x4*)(mg + 384 + h * 64 + 16 * et + 4 * fq);
        }
      }
      __builtin_amdgcn_sched_barrier(0);
      bf16x8 qf0, qf1;
      rotary_frag(qraw[0], qraw[1], rcL, rsL, i, fq, 1.f, qf0, qf1);
      f32x4 o[4];
#pragma unroll
      for (int et = 0; et < 4; ++et) {
        o[et] = __builtin_amdgcn_mfma_f32_16x16x32_bf16(spf[et][0], qf0, (f32x4){0.f, 0.f, 0.f, 0.f}, 0, 0, 0);
        o[et] = __builtin_amdgcn_mfma_f32_16x16x32_bf16(spf[et][1], qf1, o[et], 0, 0, 0);
      }
      const float qd = exp2f(lg2 * (float)(i + 1));
      float y[16]; float s1 = 0.f;
#pragma unroll
      for (int et = 0; et < 4; ++et) {
        const f32x4 yi = yiv[et];
        y[4 * et] = yi.x + qd * o[et].x; y[4 * et + 1] = yi.y + qd * o[et].y; y[4 * et + 2] = yi.z + qd * o[et].z; y[4 * et + 3] = yi.w + qd * o[et].w;
        s1 += (y[4 * et] + y[4 * et + 1]) + (y[4 * et + 2] + y[4 * et + 3]);
      }
      s1 += __shfl_xor(s1, 16); s1 += __shfl_xor(s1, 32);
      const float mu = s1 * (1.f / 64.f);
      float s2 = 0.f;
#pragma unroll
      for (int q = 0; q < 16; ++q) { y[q] -= mu; s2 += y[q] * y[q]; }
      s2 += __shfl_xor(s2, 16); s2 += __shfl_xor(s2, 32);
      const float rstd = rsqrtf(s2 * (1.f / 64.f) + EPS_);
#pragma unroll
      for (int et = 0; et < 4; ++et) {
        const int c = h * 64 + 16 * et + 4 * fq;
        const uint2 gr = grv[et];
        const float g0 = __uint_as_float(gr.x << 16), g1 = __uint_as_float(gr.x & 0xffff0000u), g2 = __uint_as_float(gr.y << 16), g3 = __uint_as_float(gr.y & 0xffff0000u);
        const f32x4 mgv = mgq[et];
        uint2 ov;
        ov.x = pk2(y[4 * et] * rstd * (g0 * sigmoid_f(g0)) * mgv.x, y[4 * et + 1] * rstd * (g1 * sigmoid_f(g1)) * mgv.y);
        ov.y = pk2(y[4 * et + 2] * rstd * (g2 * sigmoid_f(g2)) * mgv.z, y[4 * et + 3] * rstd * (g3 * sigmoid_f(g3)) * mgv.w);
        *(uint2*)(MRG + (size_t)t * 1024 + 384 + c) = ov;
      }
    }
#pragma unroll 1
    for (int gi = 0; gi < 2; ++gi) {
      const int g = wid * 2 + gi;
      const float are = SA[(g * 64 + lane) * 2], aim = SA[(g * 64 + lane) * 2 + 1];
      float xr = CARRY[(((size_t)item * 16 + g) * 64 + lane) * 2], xi = CARRY[(((size_t)item * 16 + g) * 64 + lane) * 2 + 1];
      bf16x8 cb[4];
#pragma unroll
      for (int ks = 0; ks < 4; ++ks) cb[ks] = *(const bf16x8*)(CB + (((size_t)g * 4 + ks) * 64 + lane) * 8);
      const float dv = dsk[g * 16 + fr];
#pragma unroll 1
      for (int blk = 0; blk < 2; ++blk) {
        f32x16 lr, hr, li, hi;
        bf16_t uraw[2][4];
#pragma unroll
        for (int half = 0; half < 2; ++half)
#pragma unroll
          for (int j = 0; j < 4; ++j) uraw[half][j] = PROJ[(size_t)(t0 + 32 * blk + 16 * half + 4 * fq + j) * INCP + C_US + g * 16 + fr];
        ssm_bu32(BBH + (size_t)g * 2 * 64 * 16, PROJ + (size_t)(t0 + 32 * blk + (lane & 31)) * INCP + C_US + g * 16, lane, lr, hr, li, hi);
#pragma unroll
        for (int half = 0; half < 2; ++half) {
#pragma unroll
          for (int a2 = 0; a2 < 2; ++a2) {
            const int a4 = 2 * half + a2;
#pragma unroll
            for (int bq = 0; bq < 4; ++bq) {
              const float nr = are * xr - aim * xi + lr[4 * a4 + bq], ni = are * xi + aim * xr + li[4 * a4 + bq]; xr = nr; xi = ni;
              XB[(8 * a2 + bq) * 136 + lane] = f2bf(xr); XB[(8 * a2 + bq) * 136 + 64 + lane] = f2bf(xi);
            }
#pragma unroll
            for (int bq = 0; bq < 4; ++bq) {
              const float nr = are * xr - aim * xi + hr[4 * a4 + bq], ni = are * xi + aim * xr + hi[4 * a4 + bq]; xr = nr; xi = ni;
              XB[(8 * a2 + 4 + bq) * 136 + lane] = f2bf(xr); XB[(8 * a2 + 4 + bq) * 136 + 64 + lane] = f2bf(xi);
            }
          }
          f32x4 acc = (f32x4){0.f, 0.f, 0.f, 0.f};
#pragma unroll
          for (int ks = 0; ks < 4; ++ks) {
            const bf16x8 af = *(const bf16x8*)(XB + fr * 136 + 32 * ks + 8 * fq);
            acc = __builtin_amdgcn_mfma_f32_16x16x32_bf16(af, cb[ks], acc, 0, 0, 0);
          }
#pragma unroll
          for (int j = 0; j < 4; ++j) {
            const int i = 32 * blk + 16 * half + 4 * fq + j;
            const float yv = acc[j] + dv * bf2f(uraw[half][j]);
            YS[i * 264 + g * 16 + fr] = f2bf(gelu_tanh(yv));
          }
        }
      }
    }
    __syncthreads();
    {
      const int n0 = 32 * wid;
      f32x4 a1[4][2], a2[4][2];
#pragma unroll
      for (int mt = 0; mt < 4; ++mt)
#pragma unroll
        for (int nt = 0; nt < 2; ++nt) { a1[mt][nt] = (f32x4){0.f, 0.f, 0.f, 0.f}; a2[mt][nt] = (f32x4){0.f, 0.f, 0.f, 0.f}; }
#pragma unroll 1
      for (int kh = 0; kh < 2; ++kh) {
        bf16x8 w1[4][2], w2[4][2];
#pragma unroll
        for (int k4 = 0; k4 < 4; ++k4)
#pragma unroll
          for (int nt = 0; nt < 2; ++nt) {
            w1[k4][nt] = *(const bf16x8*)(WG + ((((size_t)wid * 8 + 4 * kh + k4) * 2 + 0) * 2 + nt) * 512 + lane * 8);
            w2[k4][nt] = *(const bf16x8*)(WG + ((((size_t)wid * 8 + 4 * kh + k4) * 2 + 1) * 2 + nt) * 512 + lane * 8);
          }
        __builtin_amdgcn_sched_barrier(0);
#pragma unroll
        for (int k4 = 0; k4 < 4; ++k4) {
          const int ks = 4 * kh + k4;
          bf16x8 yb[4];
#pragma unroll
          for (int mt = 0; mt < 4; ++mt) yb[mt] = *(const bf16x8*)(YS + (16 * mt + fr) * 264 + 32 * ks + 8 * fq);
#pragma unroll
          for (int mt = 0; mt < 4; ++mt)
#pragma unroll
            for (int nt = 0; nt < 2; ++nt) {
              a1[mt][nt] = __builtin_amdgcn_mfma_f32_16x16x32_bf16(w1[k4][nt], yb[mt], a1[mt][nt], 0, 0, 0);
              a2[mt][nt] = __builtin_amdgcn_mfma_f32_16x16x32_bf16(w2[k4][nt], yb[mt], a2[mt][nt], 0, 0, 0);
            }
        }
      }
#pragma unroll
      for (int mt = 0; mt < 4; ++mt) {
        float sq = 0.f;
#pragma unroll
        for (int nt = 0; nt < 2; ++nt) {
          f32x4 z = a1[mt][nt]; const f32x4 zg = a2[mt][nt];
          z.x *= sigmoid_f(zg.x); z.y *= sigmoid_f(zg.y); z.z *= sigmoid_f(zg.z); z.w *= sigmoid_f(zg.w);
          a1[mt][nt] = z; sq += z.x * z.x + z.y * z.y + z.z * z.z + z.w * z.w;
        }
        sq += __shfl_xor(sq, 16); sq += __shfl_xor(sq, 32);
        if (fq == 0) red[wid * 64 + 16 * mt + fr] = sq;
      }
      __syncthreads();
#pragma unroll
      for (int mt = 0; mt < 4; ++mt) {
        const int i = 16 * mt + fr, t = t0 + i;
        float tot = 0.f;
#pragma unroll
        for (int w8 = 0; w8 < 8; ++w8) tot += red[w8 * 64 + i];
        const float rstd = rsqrtf(tot * (1.f / 256.f) + EPS_);
#pragma unroll
        for (int nt = 0; nt < 2; ++nt) {
          const int c = n0 + 16 * nt + 4 * fq;
          const f32x4 mgv = *(const f32x4*)(mg + 768 + c); const f32x4 z = a1[mt][nt];
          uint2 ov; ov.x = pk2(z.x * rstd * mgv.x, z.y * rstd * mgv.y); ov.y = pk2(z.z * rstd * mgv.z, z.w * rstd * mgv.w);
          *(uint2*)(MRG + (size_t)t * 1024 + 768 + c) = ov;
        }
      }
    }
  }
}

typedef float f32x2 __attribute__((ext_vector_type(2)));
__device__ __forceinline__ float dot16_fp4(const uint2 u, const f32x2 (&hv)[8]) {
  f32x2 d = __builtin_amdgcn_cvt_scalef32_pk_f32_fp4(u.x, 1.0f, 0) * hv[0];
  d += __builtin_amdgcn_cvt_scalef32_pk_f32_fp4(u.x, 1.0f, 1) * hv[1];
  d += __builtin_amdgcn_cvt_scalef32_pk_f32_fp4(u.x, 1.0f, 2) * hv[2];
  d += __builtin_amdgcn_cvt_scalef32_pk_f32_fp4(u.x, 1.0f, 3) * hv[3];
  d += __builtin_amdgcn_cvt_scalef32_pk_f32_fp4(u.y, 1.0f, 0) * hv[4];
  d += __builtin_amdgcn_cvt_scalef32_pk_f32_fp4(u.y, 1.0f, 1) * hv[5];
  d += __builtin_amdgcn_cvt_scalef32_pk_f32_fp4(u.y, 1.0f, 2) * hv[6];
  d += __builtin_amdgcn_cvt_scalef32_pk_f32_fp4(u.y, 1.0f, 3) * hv[7];
  return d.x + d.y;
}
__device__ __forceinline__ void axpy16_fp4(const uint2 v, const float w, f32x2 (&acc)[8]) {
  const f32x2 w2 = (f32x2){w, w};
  acc[0] += w2 * __builtin_amdgcn_cvt_scalef32_pk_f32_fp4(v.x, 1.0f, 0);
  acc[1] += w2 * __builtin_amdgcn_cvt_scalef32_pk_f32_fp4(v.x, 1.0f, 1);
  acc[2] += w2 * __builtin_amdgcn_cvt_scalef32_pk_f32_fp4(v.x, 1.0f, 2);
  acc[3] += w2 * __builtin_amdgcn_cvt_scalef32_pk_f32_fp4(v.x, 1.0f, 3);
  acc[4] += w2 * __builtin_amdgcn_cvt_scalef32_pk_f32_fp4(v.y, 1.0f, 0);
  acc[5] += w2 * __builtin_amdgcn_cvt_scalef32_pk_f32_fp4(v.y, 1.0f, 1);
  acc[6] += w2 * __builtin_amdgcn_cvt_scalef32_pk_f32_fp4(v.y, 1.0f, 2);
  acc[7] += w2 * __builtin_amdgcn_cvt_scalef32_pk_f32_fp4(v.y, 1.0f, 3);
}
__device__ __forceinline__ float vmaxf(float a, float b) { float r; asm("v_max_f32 %0, %1, %2" : "=v"(r) : "v"(a), "v"(b)); return r; }
__device__ __forceinline__ float vminf(float a, float b) { float r; asm("v_min_f32 %0, %1, %2" : "=v"(r) : "v"(a), "v"(b)); return r; }
__device__ __forceinline__ void cx(float& hi, float& lo) { const float a = hi, b = lo; hi = vmaxf(a, b); lo = vminf(a, b); }
__device__ __forceinline__ void cx2(float& kh, int& ph, float& kl, int& pl) {
  const float a = kh, b = kl; const int pa = ph, pb = pl; const bool c = a >= b;
  kh = vmaxf(a, b); kl = vminf(a, b); ph = c ? pa : pb; pl = c ? pb : pa;
}
__device__ __forceinline__ void bitonic_sort16_desc(float (&v)[16]) {
#pragma unroll
  for (int k = 2; k <= 16; k <<= 1)
#pragma unroll
    for (int j = k >> 1; j > 0; j >>= 1)
#pragma unroll
      for (int i = 0; i < 16; ++i) {
        const int l = i ^ j;
        if (l > i) { if ((i & k) == 0) cx(v[i], v[l]); else cx(v[l], v[i]); }
      }
}
__device__ __forceinline__ void bitonic_merge16_desc(float (&v)[16]) {
#pragma unroll
  for (int j = 8; j > 0; j >>= 1)
#pragma unroll
    for (int i = 0; i < 16; ++i) { const int l = i ^ j; if (l > i) cx(v[i], v[l]); }
}
__device__ __forceinline__ void top16_merge(float (&a)[16], const float (&b)[16]) {
#pragma unroll
  for (int i = 0; i < 16; ++i) a[i] = vmaxf(a[i], b[15 - i]);
  bitonic_merge16_desc(a);
}
template <int M> __device__ __forceinline__ void top16_merge_chain(float (&k)[16], int (&q)[16], const float (&xk)[M], const int (&xq)[M]) {
#pragma unroll
  for (int i = 16 - M; i < 16; ++i) { const float a = k[i], b = xk[15 - i]; const bool c = a >= b; k[i] = vmaxf(a, b); q[i] = c ? q[i] : xq[15 - i]; }
#pragma unroll
  for (int j = 8; j > 0; j >>= 1)
#pragma unroll
    for (int i = 0; i < 16; ++i) { const int l = i ^ j; if (l > i) cx2(k[i], q[i], k[l], q[l]); }
}

__device__ void peer_phase(const Params& p, int l, bool last, unsigned char* smem) {
  const CParamsP pp = launder_kargs();
  GAS unsigned char* const ws = launder_ptr(pp->ws); const int tidx = launder_tid();
  bf16_t* HF = (bf16_t*)(ws + WS_ABUF); bf16_t* X = (bf16_t*)(ws + WS_X);
  const bf16_t* SC8 = (const bf16_t*)(ws + WS_SC);
  const uint2* U4 = (const uint2*)(ws + WS_PU8) + (size_t)l * 16384 * 64; const uint2* V4 = (const uint2*)(ws + WS_PV8) + (size_t)l * 16384 * 64;
  const float* g2 = (const float*)(ws + WS_MOD) + (size_t)l * 2 * 6144 + 5120;
  const bf16_t* XG = (const bf16_t*)(ws + WS_XG); const float* SSQ = (const float*)(ws + WS_SSQ); const float* sh2 = (const float*)(ws + WS_MOD) + (size_t)l * 2 * 6144 + 3072;
  const int ln = last ? l : l + 1;
  const float* nsh = (const float*)(ws + WS_MOD) + (size_t)ln * 2 * 6144; const float* nsc = nsh + 1024;
  const float* ngain = gin(pp->in[I_NMIX]) + (size_t)ln * 1024;
  const int lane = tidx & 63, wid = tidx >> 6;
  const int rL = ((lane >> 5) & 1) * 8 + ((lane >> 4) & 1) * 4 + ((lane >> 3) & 1) * 2 + ((lane >> 2) & 1);
  const bool hi5 = (lane & 32) != 0, hi4 = (lane & 16) != 0, hi3 = (lane & 8) != 0, hi2 = (lane & 4) != 0;
  int* idxL = (int*)smem;
  float* cst = (float*)(smem + 109568);
  for (int it_ = blockIdx.x; it_ < T_ / 64; it_ += gridDim.x) {
    const int item = ((it_ & 7) << 5) | (it_ >> 3);
    const int t0 = item * 64;
    __syncthreads();
    {
      const int bb = t0 >> 13;
      for (int c = tidx; c < 1024; c += NT) {
        const int o = ((c >> 2) & 3) * 256 + (c >> 4) * 4 + (c & 3);
        cst[o] = g2[bb * 6144 + c] * 0.25f;
        cst[1024 + o] = last ? gin(pp->in[I_FNORM])[c] : ngain[c] * (1.f + nsc[bb * 6144 + c]);
        cst[2048 + o] = last ? 0.f : nsh[bb * 6144 + c];
        cst[3072 + o] = sh2[bb * 6144 + c];
      }
    }
    {
      int lane_o = lane; asm volatile("" : "+v"(lane_o));
      const int tg = wid & 1, hp = wid >> 1, hf = lane_o >> 5, tl = 32 * tg + (lane_o & 31);
      float F[2][16];
#pragma unroll
      for (int sd = 0; sd < 2; ++sd) {
        float Lh[2][16];
#pragma unroll
        for (int hh = 0; hh < 2; ++hh) {
          const int hs = 2 * (2 * hp + hh) + sd;
          float top[16];
          const bf16_t* scp = SC8 + (((size_t)(hs * 16 + 8 * hf)) * T_ + (t0 + tl)) * 8;
          uint4 sv[8];
#pragma unroll
          for (int kq = 0; kq < 8; ++kq) sv[kq] = *(const uint4*)(scp + (size_t)kq * T_ * 8);
          __builtin_amdgcn_sched_barrier(0);
#pragma unroll
          for (int kt = 0; kt < 4; ++kt) {
            float g[16];
#pragma unroll
            for (int kq = 0; kq < 2; ++kq) {
              const uint4 v8 = sv[2 * kt + kq];
              const unsigned wv[4] = {v8.x, v8.y, v8.z, v8.w};
#pragma unroll
              for (int j = 0; j < 4; ++j) {
                const int key = 64 * hf + 16 * kt + 8 * kq + 2 * j;
                g[8 * kq + 2 * j] = __uint_as_float((wv[j] << 16) | (unsigned)key);
                g[8 * kq + 2 * j + 1] = __uint_as_float((wv[j] & 0xffff0000u) | (unsigned)(key + 1));
              }
            }
            bitonic_sort16_desc(g);
            if (kt == 0) {
#pragma unroll
              for (int r = 0; r < 16; ++r) top[r] = g[r];
            } else top16_merge(top, g);
            __builtin_amdgcn_sched_barrier(0);
          }
#pragma unroll
          for (int r = 0; r < 16; ++r) Lh[hh][r] = top[r];
          __builtin_amdgcn_sched_barrier(0);
        }
#pragma unroll
        for (int r = 0; r < 16; ++r) {
          const auto sw = __builtin_amdgcn_permlane32_swap(__float_as_uint(Lh[0][r]), __float_as_uint(Lh[1][r]), false, false);
          Lh[0][r] = __uint_as_float(sw[0]); Lh[1][r] = __uint_as_float(sw[1]);
        }
        top16_merge(Lh[0], Lh[1]);
#pragma unroll
        for (int r = 0; r < 16; ++r) F[sd][r] = Lh[0][r];
        __builtin_amdgcn_sched_barrier(0);
      }
      int ia[16], ib[16];
#pragma unroll
      for (int r = 0; r < 16; ++r) { ia[r] = (int)(__float_as_uint(F[0][r]) & 127u) << 7; ib[r] = (int)(__float_as_uint(F[1][r]) & 127u); }
      float k[16]; int q[16];
#pragma unroll
      for (int j = 0; j < 16; ++j) { k[j] = F[0][0] + F[1][j]; q[j] = ia[0] | ib[j]; }
      { float xk[8]; int xq[8];
#pragma unroll
        for (int j = 0; j < 8; ++j) { xk[j] = F[0][1] + F[1][j]; xq[j] = ia[1] | ib[j]; }
        top16_merge_chain<8>(k, q, xk, xq); }
      { float xk[5]; int xq[5];
#pragma unroll
        for (int j = 0; j < 5; ++j) { xk[j] = F[0][2] + F[1][j]; xq[j] = ia[2] | ib[j]; }
        top16_merge_chain<5>(k, q, xk, xq); }
      { float xk[4]; int xq[4];
#pragma unroll
        for (int j = 0; j < 4; ++j) { xk[j] = F[0][3] + F[1][j]; xq[j] = ia[3] | ib[j]; }
        top16_merge_chain<4>(k, q, xk, xq); }
      { float xk[3]; int xq[3];
#pragma unroll
        for (int j = 0; j < 3; ++j) { xk[j] = F[0][4] + F[1][j]; xq[j] = ia[4] | ib[j]; }
        top16_merge_chain<3>(k, q, xk, xq); }
      { float xk[11]; int xq[11];
#pragma unroll
        for (int i = 0; i < 11; ++i) { xk[i] = F[0][5 + i] + F[1][0]; xq[i] = ia[5 + i] | ib[0]; }
        top16_merge_chain<11>(k, q, xk, xq); }
      { float xk[3]; int xq[3];
#pragma unroll
        for (int i = 0; i < 3; ++i) { xk[i] = F[0][5 + i] + F[1][1]; xq[i] = ia[5 + i] | ib[1]; }
        top16_merge_chain<3>(k, q, xk, xq); }
      float e[16]; float es = 0.f;
#pragma unroll
      for (int i = 0; i < 16; ++i) { e[i] = __expf(k[i] - k[0]); es += e[i]; }
      const float ies = 1.f / es;
      const int h = 2 * hp + hf;
#pragma unroll
      for (int i = 0; i < 16; ++i) idxL[tl * 132 + h * 16 + i] = (int)(((unsigned)f2bf(e[i] * ies) << 16) | (unsigned)q[i]);
    }
    __syncthreads();
    {
      const int fr = lane & 15, fq = lane >> 4, jsel = lane & 3, tlb = wid * 8;
      unsigned char* hq4 = smem + 33792 + wid * 1024;
      unsigned char* ust = smem + 41984 + wid * 8448;
      const unsigned lane8 = (unsigned)lane * 8u;
      uint2 ra[16], rb[16];
#define PEER_REQ_IDX(sn_) (idxL[(tlb + ((min((sn_), 127) & 63) >> 3)) * 132 + 16 * (min((sn_), 127) & 7) + fr] & 0xffff)
#define PEER_REQ_TAB(sn_) ((const unsigned char*)((sn_) < 64 ? U4 : V4))
      {
        const int e0 = PEER_REQ_IDX(0), e1 = PEER_REQ_IDX(1);
#pragma unroll
        for (int r = 0; r < 16; ++r) { const unsigned off = (unsigned)__builtin_amdgcn_readlane(e0, r) * 512u + lane8; ra[r] = *(const uint2*)((const unsigned char*)U4 + off); }
        __builtin_amdgcn_sched_barrier(0);
#pragma unroll
        for (int r = 0; r < 16; ++r) { const unsigned off = (unsigned)__builtin_amdgcn_readlane(e1, r) * 512u + lane8; rb[r] = *(const uint2*)((const unsigned char*)U4 + off); }
        __builtin_amdgcn_sched_barrier(0);
      }
      {
        const float rs_lane = rsqrtf(ssq_total(SSQ, t0 + tlb + (lane & 7)) * (1.f / 1024.f) + EPS_);
        uint4 nh0 = *(const uint4*)(XG + (size_t)(t0 + tlb) * 1024 + lane * 16), nh1 = *(const uint4*)(XG + (size_t)(t0 + tlb) * 1024 + lane * 16 + 8);
#pragma unroll 1
        for (int ii = 0; ii < 8; ++ii) {
          const int tl = tlb + ii, t = t0 + tl;
          uint4 hB1[8], hB2[8];
          {
            const unsigned hw[8] = {nh0.x, nh0.y, nh0.z, nh0.w, nh1.x, nh1.y, nh1.z, nh1.w};
            const float rs = __int_as_float(__builtin_amdgcn_readlane(__float_as_int(rs_lane), ii));
            unsigned q1[2] = {0u, 0u}, q2[2] = {0u, 0u};
#pragma unroll
            for (int qq = 0; qq < 4; ++qq) {
              const f32x4 sh = *(const f32x4*)(cst + 3072 + qq * 256 + lane * 4);
              float hvv[4];
              hvv[0] = __uint_as_float(hw[2 * qq] << 16) * rs + sh.x; hvv[1] = __uint_as_float(hw[2 * qq] & 0xffff0000u) * rs + sh.y;
              hvv[2] = __uint_as_float(hw[2 * qq + 1] << 16) * rs + sh.z; hvv[3] = __uint_as_float(hw[2 * qq + 1] & 0xffff0000u) * rs + sh.w;
#pragma unroll
              for (int pr = 0; pr < 2; ++pr) {
                const int byte_sel = (2 * qq + pr) & 3, wd = (2 * qq + pr) >> 2;
                const float x0 = fminf(fmaxf(hvv[2 * pr], -6.f), 6.f), x1 = fminf(fmaxf(hvv[2 * pr + 1], -6.f), 6.f);
                unsigned t1 = 0u;
                if (byte_sel == 0) t1 = __builtin_amdgcn_cvt_scalef32_pk_fp4_f32(0u, x0, x1, 1.0f, 0);
                else if (byte_sel == 1) t1 = __builtin_amdgcn_cvt_scalef32_pk_fp4_f32(0u, x0, x1, 1.0f, 1);
                else if (byte_sel == 2) t1 = __builtin_amdgcn_cvt_scalef32_pk_fp4_f32(0u, x0, x1, 1.0f, 2);
                else t1 = __builtin_amdgcn_cvt_scalef32_pk_fp4_f32(0u, x0, x1, 1.0f, 3);
                f32x2 back;
                if (byte_sel == 0) back = __builtin_amdgcn_cvt_scalef32_pk_f32_fp4(t1, 1.0f, 0);
                else if (byte_sel == 1) back = __builtin_amdgcn_cvt_scalef32_pk_f32_fp4(t1, 1.0f, 1);
                else if (byte_sel == 2) back = __builtin_amdgcn_cvt_scalef32_pk_f32_fp4(t1, 1.0f, 2);
                else back = __builtin_amdgcn_cvt_scalef32_pk_f32_fp4(t1, 1.0f, 3);
                const float r0 = fminf(fmaxf((hvv[2 * pr] - back.x) * 8.f, -6.f), 6.f), r1 = fminf(fmaxf((hvv[2 * pr + 1] - back.y) * 8.f, -6.f), 6.f);
                unsigned t2 = 0u;
                if (byte_sel == 0) t2 = __builtin_amdgcn_cvt_scalef32_pk_fp4_f32(0u, r0, r1, 1.0f, 0);
                else if (byte_sel == 1) t2 = __builtin_amdgcn_cvt_scalef32_pk_fp4_f32(0u, r0, r1, 1.0f, 1);
                else if (byte_sel == 2) t2 = __builtin_amdgcn_cvt_scalef32_pk_fp4_f32(0u, r0, r1, 1.0f, 2);
                else t2 = __builtin_amdgcn_cvt_scalef32_pk_fp4_f32(0u, r0, r1, 1.0f, 3);
                q1[wd] |= t1; q2[wd] |= t2;
              }
            }
            *(uint2*)(hq4 + lane * 8) = make_uint2(q1[0], q1[1]);
            *(uint2*)(hq4 + 512 + lane * 8) = make_uint2(q2[0], q2[1]);
#pragma unroll
            for (int kc = 0; kc < 8; ++kc) { hB1[kc] = *(const uint4*)(hq4 + 64 * kc + 16 * fq); hB2[kc] = *(const uint4*)(hq4 + 512 + 64 * kc + 16 * fq); }
          }
          { const int tn = t + (ii < 7 ? 1 : 0);
            nh0 = *(const uint4*)(XG + (size_t)tn * 1024 + lane * 16); nh1 = *(const uint4*)(XG + (size_t)tn * 1024 + lane * 16 + 8); }
          __builtin_amdgcn_sched_barrier(0);
#define PEER_U_STEP(R, bt_) do { const int _bt = (bt_), _sn = ii * 8 + _bt + 2; \
            _Pragma("unroll") for (int r = 0; r < 16; ++r) *(uint2*)(ust + r * 528 + lane * 8) = R[r];        \
            { const int _en = PEER_REQ_IDX(_sn); const unsigned char* _tab = PEER_REQ_TAB(_sn); \
              _Pragma("unroll") for (int r = 0; r < 16; ++r) { const unsigned off = (unsigned)__builtin_amdgcn_readlane(_en, r) * 512u + lane8; R[r] = *(const uint2*)(_tab + off); } } \
            __builtin_amdgcn_sched_barrier(0); \
            uint4 ua[8]; \
            _Pragma("unroll") for (int kc = 0; kc < 8; ++kc) ua[kc] = *(const uint4*)(ust + fr * 528 + 64 * kc + 16 * fq);      \
            f32x4 sa[2] = {(f32x4){0.f, 0.f, 0.f, 0.f}, (f32x4){0.f, 0.f, 0.f, 0.f}}, sb[2] = {(f32x4){0.f, 0.f, 0.f, 0.f}, (f32x4){0.f, 0.f, 0.f, 0.f}};     \
            _Pragma("unroll") for (int kc = 0; kc < 8; ++kc) { \
              const i32x8 av = (i32x8){(int)ua[kc].x, (int)ua[kc].y, (int)ua[kc].z, (int)ua[kc].w, 0, 0, 0, 0}; \
              const i32x8 b1 = (i32x8){(int)hB1[kc].x, (int)hB1[kc].y, (int)hB1[kc].z, (int)hB1[kc].w, 0, 0, 0, 0}; \
              const i32x8 b2 = (i32x8){(int)hB2[kc].x, (int)hB2[kc].y, (int)hB2[kc].z, (int)hB2[kc].w, 0, 0, 0, 0}; \
              sa[kc & 1] = __builtin_amdgcn_mfma_scale_f32_16x16x128_f8f6f4(av, b1, sa[kc & 1], 4  , 4  , 0, 0x7F7F7F7F, 0, 0x7F7F7F7F); \
              sb[kc & 1] = __builtin_amdgcn_mfma_scale_f32_16x16x128_f8f6f4(av, b2, sb[kc & 1], 4, 4, 0, 0x7F7F7F7F, 0, 0x7F7F7F7F); } \
            const f32x4 sc4 = (sa[0] + sa[1]) + (sb[0] + sb[1]) * 0.125f; \
              \
            const float dsel = jsel == 0 ? sc4[0] : (jsel == 1 ? sc4[1] : (jsel == 2 ? sc4[2] : sc4[3])); \
            const int _eo = tl * 132 + 16 * _bt + 4 * fq + jsel; const unsigned _pe = (unsigned)idxL[_eo]; \
            const float _w = __uint_as_float(_pe & 0xffff0000u) * gelu_tanh_fast(dsel * (1.f / 64.f));            \
            if (fr < 4) idxL[_eo] = (int)(((unsigned)f2bf(_w) << 16) | (_pe & 0xffffu)); \
          } while (0)
#pragma unroll 1
          for (int b2 = 0; b2 < 8; b2 += 2) { PEER_U_STEP(ra, b2); PEER_U_STEP(rb, b2 + 1); }
#undef PEER_U_STEP
        }
      }
      {
        f32x2 acc2[8];
#pragma unroll
        for (int j = 0; j < 8; ++j) acc2[j] = (f32x2){0.f, 0.f};
#pragma unroll 1
        for (int ii = 0; ii < 8; ++ii) {
          const int tl = tlb + ii, t = t0 + tl;
          const uint4 xr0 = *(const uint4*)(X + (size_t)t * 1024 + lane * 16), xr1 = *(const uint4*)(X + (size_t)t * 1024 + lane * 16 + 8);
          __builtin_amdgcn_sched_barrier(0);
#define PEER_V_STEP(R, bt_) do { const int _bt = (bt_), _sn = 64 + ii * 8 + _bt + 2; \
            const int _wv = (int)((unsigned)idxL[tl * 132 + 16 * _bt + fr] & 0xffff0000u);          \
            const int _en = PEER_REQ_IDX(_sn); \
            _Pragma("unroll") for (int r = 0; r < 16; ++r) { \
              const float wr = __int_as_float(__builtin_amdgcn_readlane(_wv, r)); \
              axpy16_fp4(R[r], wr, acc2); \
              { const unsigned off = (unsigned)__builtin_amdgcn_readlane(_en, r) * 512u + lane8; R[r] = *(const uint2*)((const unsigned char*)V4 + off); } \
              __builtin_amdgcn_sched_barrier(0); } \
          } while (0)
#pragma unroll 1
          for (int b2 = 0; b2 < 8; b2 += 2) { PEER_V_STEP(ra, b2); PEER_V_STEP(rb, b2 + 1); }
#undef PEER_V_STEP
          float xn[16]; float ss = 0.f;
          const unsigned xw[8] = {xr0.x, xr0.y, xr0.z, xr0.w, xr1.x, xr1.y, xr1.z, xr1.w};
#pragma unroll
          for (int qq = 0; qq < 4; ++qq) {
            const f32x4 xv = (f32x4){__uint_as_float(xw[2 * qq] << 16), __uint_as_float(xw[2 * qq] & 0xffff0000u), __uint_as_float(xw[2 * qq + 1] << 16), __uint_as_float(xw[2 * qq + 1] & 0xffff0000u)};
            const f32x4 g = *(const f32x4*)(cst + qq * 256 + lane * 4);
            xn[4 * qq] = xv.x + g.x * acc2[2 * qq].x; xn[4 * qq + 1] = xv.y + g.y * acc2[2 * qq].y;
            xn[4 * qq + 2] = xv.z + g.z * acc2[2 * qq + 1].x; xn[4 * qq + 3] = xv.w + g.w * acc2[2 * qq + 1].y;
            ss += xn[4 * qq] * xn[4 * qq] + xn[4 * qq + 1] * xn[4 * qq + 1] + xn[4 * qq + 2] * xn[4 * qq + 2] + xn[4 * qq + 3] * xn[4 * qq + 3];
          }
#pragma unroll
          for (int j = 0; j < 8; ++j) acc2[j] = (f32x2){0.f, 0.f};
          const float rstd = rsqrtf(wave_sum(ss) * (1.f / 1024.f) + EPS_);
          if (!last) {
            unsigned hb[8], xb[8];
#pragma unroll
            for (int qq = 0; qq < 4; ++qq) {
              xb[2 * qq] = pk2(xn[4 * qq], xn[4 * qq + 1]); xb[2 * qq + 1] = pk2(xn[4 * qq + 2], xn[4 * qq + 3]);
              const f32x4 ga = *(const f32x4*)(cst + 1024 + qq * 256 + lane * 4), sh = *(const f32x4*)(cst + 2048 + qq * 256 + lane * 4);
              hb[2 * qq] = pk2(xn[4 * qq] * rstd * ga.x + sh.x, xn[4 * qq + 1] * rstd * ga.y + sh.y);
              hb[2 * qq + 1] = pk2(xn[4 * qq + 2] * rstd * ga.z + sh.z, xn[4 * qq + 3] * rstd * ga.w + sh.w);
            }
            *(uint4*)(X + (size_t)t * 1024 + lane * 16) = make_uint4(xb[0], xb[1], xb[2], xb[3]);
            *(uint4*)(X + (size_t)t * 1024 + lane * 16 + 8) = make_uint4(xb[4], xb[5], xb[6], xb[7]);
            *(uint4*)(HF + (size_t)t * 1024 + lane * 16) = make_uint4(hb[0], hb[1], hb[2], hb[3]);
            *(uint4*)(HF + (size_t)t * 1024 + lane * 16 + 8) = make_uint4(hb[4], hb[5], hb[6], hb[7]);
          } else {
#pragma unroll
            for (int qq = 0; qq < 4; ++qq) {
              const f32x4 fn = *(const f32x4*)(cst + 1024 + qq * 256 + lane * 4);
              *(f32x4*)((float*)pp->out + (size_t)t * 1024 + lane * 16 + 4 * qq) = (f32x4){xn[4 * qq] * rstd * fn.x, xn[4 * qq + 1] * rstd * fn.y, xn[4 * qq + 2] * rstd * fn.z, xn[4 * qq + 3] * rstd * fn.w};
            }
          }
        }
      }
#undef PEER_REQ_IDX
#undef PEER_REQ_TAB
    }
  }
}

#define XB_TMO      128
#define XB_XCNT(j)  (256  + 64 * (j))
#define XB_XSUB(j)  (1280 + 64 * (j))
#define XB_XGEN(j)  (2304 + 64 * (j))
#define XB_TOP      3328
#define XB_TOPGEN   3392
#define XCD_BAR_WORDS 3456
#define XB_SPIN_CAP (1u << 20)
#define LAS __attribute__((address_space(3)))
__device__ __forceinline__ unsigned xb_ld(unsigned* q)              { return __hip_atomic_load(q, __ATOMIC_RELAXED, __HIP_MEMORY_SCOPE_AGENT); }
__device__ __forceinline__ unsigned xb_add(unsigned* q, unsigned v) { return __hip_atomic_fetch_add(q, v, __ATOMIC_RELAXED, __HIP_MEMORY_SCOPE_AGENT); }
__device__ __forceinline__ unsigned xb_xcc_id() { return (unsigned)__builtin_amdgcn_s_getreg((3 << 11) | 20) & 0xFu; }
#define XB_SPIN(cond, bar) do { unsigned _sp = 0; while (cond) { __builtin_amdgcn_s_sleep(1); \
    if ((++_sp & 255u) == 0u) { if (xb_ld(&(bar)[XB_TMO])) break; if (_sp > XB_SPIN_CAP) { atomicAdd(&(bar)[XB_TMO], 1u); break; } } } } while (0)
struct XcdBarrier { unsigned* bar; unsigned x; volatile LAS unsigned* st; };
__device__ __forceinline__ XcdBarrier xcd_barrier_post(unsigned* bar, volatile LAS unsigned* st) {
    XcdBarrier b; b.bar = bar; b.x = xb_xcc_id(); b.st = st;
    if (threadIdx.x == 0) (void)xb_add(&bar[XB_XCNT(b.x)], 1u);
    return b;
}
__device__ __forceinline__ void xcd_barrier_complete(unsigned* bar, unsigned x, unsigned& nloc, unsigned& nx) {
    const unsigned G = gridDim.x * gridDim.y * gridDim.z;
    unsigned sum, cnt, mine, sp = 0u;
    for (;;) {
        sum = 0u; cnt = 0u; mine = 0u;
#pragma unroll
        for (unsigned j = 0; j < 16; ++j) { const unsigned c = xb_ld(&bar[XB_XCNT(j)]); sum += c; cnt += (c > 0u) ? 1u : 0u; mine = (j == x) ? c : mine; }
        if (sum == G) break;
        __builtin_amdgcn_s_sleep(1);
        if ((++sp & 255u) == 0u) { if (xb_ld(&bar[XB_TMO])) break; if (sp > XB_SPIN_CAP) { atomicAdd(&bar[XB_TMO], 1u); break; } }
    }
    nloc = mine > 0u ? mine : 1u; nx = cnt > 0u ? cnt : 1u;
}
__device__ __forceinline__ void xcd_barrier(const XcdBarrier& b) {
    asm volatile("s_waitcnt vmcnt(0)" ::: "memory");
    __syncthreads();
    if (threadIdx.x == 0) {
        unsigned* bar = b.bar;
        __builtin_amdgcn_s_waitcnt(0);
        unsigned nloc = b.st[0], nx = b.st[1];
        if (nloc == 0u) { xcd_barrier_complete(bar, b.x, nloc, nx); b.st[0] = nloc; b.st[1] = nx; }
        const unsigned old = xb_add(&bar[XB_XSUB(b.x)], 1u);
        const unsigned gen = old / nloc;
        if (old + 1u == (gen + 1u) * nloc) {
            __builtin_amdgcn_fence(__ATOMIC_RELEASE, "agent");
            asm volatile("s_waitcnt vmcnt(0)" ::: "memory");
            const unsigned og = xb_add(&bar[XB_TOP], 1u);
            const unsigned tg = og / nx;
            if (og + 1u == (tg + 1u) * nx) xb_add(&bar[XB_TOPGEN], 1u);
            else XB_SPIN(xb_ld(&bar[XB_TOPGEN]) == tg, bar);
            __builtin_amdgcn_fence(__ATOMIC_ACQUIRE, "agent");
            xb_add(&bar[XB_XGEN(b.x)], 1u);
            asm volatile("s_waitcnt vmcnt(0)" ::: "memory");
        } else {
            XB_SPIN(xb_ld(&bar[XB_XGEN(b.x)]) == gen, bar);
            __builtin_amdgcn_fence(__ATOMIC_ACQUIRE, "agent");
            asm volatile("s_waitcnt vmcnt(0)" ::: "memory");
        }
    }
    __syncthreads();
}

__global__ void __launch_bounds__(NT) fwd_megakernel(Params p) {
  extern __shared__ __attribute__((aligned(16))) unsigned char smem[];
  const CParamsP pp = launder_kargs();
  cg::grid_group grid = cg::this_grid();
  volatile LAS unsigned* xbst = (volatile LAS unsigned*)(smem + LDS_BYTES - 16);
  if (threadIdx.x == 0) { xbst[0] = 0u; xbst[1] = 0u; }
  if (blockIdx.x == 0) { unsigned* bw = (unsigned*)(pp->ws + WS_BAR); for (int i = threadIdx.x; i < XCD_BAR_WORDS; i += NT) bw[i] = 0u; }
  setup_phase(p, smem);
  grid.sync();
  const XcdBarrier xb = xcd_barrier_post((unsigned*)(pp->ws + WS_BAR), xbst);
  const float* MOD = (const float*)(pp->ws + WS_MOD);
  for (int l = 0; l < DEPTH_; ++l) {
    const float* xsrc = (l == 0) ? gin(pp->in[I_X]) : (const float*)(pp->ws + WS_X);
    const float* modl = MOD + (size_t)l * 2 * 6144;
    if (l == 0) {
      norm_mod_phase(xsrc, gin(pp->in[I_NMIX]), modl + 0, modl + 1024, (bf16_t*)(pp->ws + WS_ABUF));
      qbias_phase(p, smem);
      xcd_barrier(xb);
    }
    gemm_proj_phase(p, l, smem);
    xcd_barrier(xb);
    attn_phase(p, l, smem);
    mix_local_phase(p, l, smem);
    xcd_barrier(xb);
    scan_phase(p, l);
    xcd_barrier(xb);
    mix_final_phase(p, l, smem);
    xcd_barrier(xb);
    gemm_out_phase(p, l, smem);
    xcd_barrier(xb);
    gemm_q_phase(p, l, smem);
    xcd_barrier(xb);
    peer_phase(p, l, l == DEPTH_ - 1, smem);
    xcd_barrier(xb);
  }
}

extern "C" void kernel_launch(void* const* d_in, const int* in_sizes, int n_in,
                              void* d_out, int out_size, void* d_ws, size_t ws_size,
                              hipStream_t stream) {
  static int grid_blocks = 0;
  if (grid_blocks == 0) {
    if (n_in != 24 || ws_size < WS_END) { fprintf(stderr, "kernel_launch: unexpected n_in %d / ws_size %zu (need %zu)\n", n_in, ws_size, (size_t)WS_END); grid_blocks = -1; return; }
    int dev = 0, cus = 0, per_cu = 0;
    if (hipGetDevice(&dev) != hipSuccess || hipDeviceGetAttribute(&cus, hipDeviceAttributeMultiprocessorCount, dev) != hipSuccess) { grid_blocks = -1; return; }
    if (hipFuncSetAttribute((const void*)fwd_megakernel, hipFuncAttributeMaxDynamicSharedMemorySize, LDS_BYTES) != hipSuccess) { fprintf(stderr, "hipFuncSetAttribute failed\n"); grid_blocks = -1; return; }
    if (hipOccupancyMaxActiveBlocksPerMultiprocessor(&per_cu, (const void*)fwd_megakernel, NT, LDS_BYTES) != hipSuccess || per_cu < 1) { fprintf(stderr, "occupancy query: %d\n", per_cu); grid_blocks = -1; return; }
    grid_blocks = cus;
  }
  if (grid_blocks < 0) return;
  Params p{};
  for (int i = 0; i < 24; ++i) p.in[i] = (const GAS float*)d_in[i];
  p.out = (GAS float*)d_out; p.ws = (GAS unsigned char*)d_ws;
  void* args[] = {&p};
  hipError_t e = hipLaunchCooperativeKernel((void*)fwd_megakernel, dim3(grid_blocks), dim3(NT), args, LDS_BYTES, stream);
  if (e != hipSuccess) fprintf(stderr, "cooperative launch failed: %s (grid %d)\n", hipGetErrorString(e), grid_blocks);
}
```

```cpp
#include <hip/hip_runtime.h>
#include <hip/hip_cooperative_groups.h>
#include <cstdio>
#include <cstdint>
namespace cg = cooperative_groups;

typedef unsigned short bf16_t;
typedef short bf16x8 __attribute__((ext_vector_type(8)));
typedef float f32x4 __attribute__((ext_vector_type(4)));
typedef float f32x16 __attribute__((ext_vector_type(16)));
typedef int i32x8 __attribute__((ext_vector_type(8)));

constexpr int T_ = 16384, D_ = 1024, L_ = 8192, NBATCH = 2, DEPTH_ = 4;
constexpr int INC = 2944, INCP = 3072;
constexpr int NCH = 128;
constexpr int NT = 512;
constexpr int NW = 8;
constexpr float EPS_ = 1e-6f;
constexpr int C_QA = 0, C_KA = 384, C_VA = 768, C_QR = 1152, C_KR = 1536, C_VR = 1920, C_GR = 2304, C_US = 2688;

constexpr size_t al256(size_t x) { return (x + 255) & ~(size_t)255; }
constexpr size_t WS_MOD   = 0;
constexpr size_t WS_ROTC  = al256(WS_MOD + 4ull * 2 * 6144 * 4);
constexpr size_t WS_ROTS  = al256(WS_ROTC + 8192ull * 32 * 4);
constexpr size_t WS_SA    = al256(WS_ROTS + 8192ull * 32 * 4);
constexpr size_t WS_SBB   = al256(WS_SA + 4ull * 16 * 64 * 2 * 4);
constexpr size_t WS_WIN   = al256(WS_SBB + 4ull * 16 * 64 * 32 * 4);
constexpr size_t WS_WOUT  = al256(WS_WIN + 4ull * INCP * 1024 * 2);
constexpr size_t WS_WQ    = al256(WS_WOUT + 4ull * 1024 * 1024 * 2);
constexpr size_t WS_SUBK  = al256(WS_WQ + 4ull * 2048 * 1024 * 2);
constexpr size_t WS_ABUF  = al256(WS_SUBK + 4ull * 16 * 128 * 128 * 2);
constexpr size_t WS_PROJ  = al256(WS_ABUF + (size_t)T_ * 1024 * 2);
constexpr size_t WS_VTA   = al256(WS_PROJ + (size_t)T_ * INCP * 2);
constexpr size_t WS_ATT   = al256(WS_VTA + 2ull * 6 * 64 * 8192 * 2);
constexpr size_t WS_YINT  = al256(WS_ATT + (size_t)T_ * 384 * 4);
constexpr size_t WS_UPD   = al256(WS_YINT + (size_t)T_ * 384 * 4);
constexpr size_t WS_SPREV = al256(WS_UPD + 256ull * 6 * 4096 * 4);
constexpr size_t WS_SEND  = al256(WS_SPREV + 256ull * 6 * 4096 * 4);
constexpr size_t WS_CARRY = al256(WS_SEND + 256ull * 16 * 64 * 2 * 4);
constexpr size_t WS_X     = al256(WS_CARRY + 256ull * 16 * 64 * 2 * 4);
constexpr size_t WS_Q     = al256(WS_X + (size_t)T_ * 1024 * 4);
constexpr size_t WS_SC    = al256(WS_Q + (size_t)T_ * 2048 * 2);
constexpr size_t WS_EIDX  = al256(WS_SC + (size_t)T_ * 2048 * 4);
constexpr size_t WS_EGATE = al256(WS_EIDX + (size_t)T_ * 128 * 4);
constexpr size_t WS_PU8   = al256(WS_EGATE + (size_t)T_ * 128 * 4);
constexpr size_t WS_PV8   = al256(WS_PU8 + 4ull * 16384 * 1024);
constexpr size_t WS_BAR   = al256(WS_PV8 + 4ull * 16384 * 1024);
constexpr size_t WS_SPT   = al256(WS_BAR + 3456ull * 4);
constexpr size_t WS_CB    = al256(WS_SPT + 256ull * 6 * 4096 * 2);
constexpr size_t WS_WGLUT = al256(WS_CB + 4ull * 16 * 16 * 128 * 2);
constexpr size_t WS_VTR   = al256(WS_WGLUT + 4ull * 512 * 256 * 2);
constexpr size_t WS_XG    = al256(WS_VTR + 2ull * 384 * 8192 * 2);
constexpr size_t WS_SSQ   = al256(WS_XG + (size_t)T_ * 1024 * 2);
constexpr size_t WS_C2    = al256(WS_SSQ + (size_t)T_ * 16 * 4);
constexpr size_t WS_BBH   = al256(WS_C2 + 4ull * 2 * 2048 * 4);
constexpr size_t WS_END   = al256(WS_BBH + 4ull * 16 * 2 * 64 * 16 * 2);

constexpr int LDS_BYTES = 135168;

#define GAS __attribute__((address_space(1)))
struct Params {
  const GAS float* in[24];
  GAS float* out;
  GAS unsigned char* ws;
};
enum { I_X = 0, I_C, I_WADA, I_BADA, I_NMIX, I_NFFN, I_WIN, I_RELB, I_LRE, I_LIM, I_LOGDT, I_BRE, I_BIM, I_CRE, I_CIM, I_SSMD,
       I_WGLU, I_MGAIN, I_WOUT, I_WQ, I_SUBK, I_PU, I_PV, I_FNORM };

__device__ __forceinline__ float bf2f(bf16_t v) { return __uint_as_float(((unsigned)v) << 16); }
__device__ __forceinline__ bf16_t f2bf(float f) { unsigned u = __float_as_uint(f); u += 0x7fffu + ((u >> 16) & 1u); return (bf16_t)(u >> 16); }
__device__ __forceinline__ unsigned pk2(float a, float b) { return (unsigned)f2bf(a) | ((unsigned)f2bf(b) << 16); }
__device__ __forceinline__ float wave_sum(float v) {
#pragma unroll
  for (int o = 32; o > 0; o >>= 1) v += __shfl_xor(v, o);
  return v;
}
__device__ __forceinline__ float wave_max(float v) {
#pragma unroll
  for (int o = 32; o > 0; o >>= 1) v = fmaxf(v, __shfl_xor(v, o));
  return v;
}
__device__ __forceinline__ float gelu_tanh(float x) { const float u = 0.7978845608028654f * (x + 0.044715f * x * x * x); return 0.5f * x * (1.f + tanhf(u)); }
__device__ __forceinline__ float sigmoid_f(float x) { return 1.f / (1.f + __expf(-x)); }
__device__ __forceinline__ float gelu_tanh_fast(float x) {
  const float u2 = 2.f * 0.7978845608028654f * 1.4426950408889634f * (x + 0.044715f * x * x * x);
  const float e = __builtin_amdgcn_exp2f(fminf(u2, 80.f));
  return x - x * __builtin_amdgcn_rcpf(1.f + e);
}
__device__ __forceinline__ GAS unsigned char* launder_ptr(GAS unsigned char* q) { asm volatile("" : "+s"(q)); return q; }
__device__ __forceinline__ const float* gin(const GAS float* q) { return (const float*)q; }
__device__ __forceinline__ const float* launder_cptr(const float* q) { asm volatile("" : "+s"(q)); return q; }
__device__ __forceinline__ int launder_tid() { int t = threadIdx.x; asm volatile("" : "+v"(t)); return t; }
typedef const Params __attribute__((address_space(4)))* CParamsP;
__device__ __forceinline__ CParamsP launder_kargs() { CParamsP q = (CParamsP)__builtin_amdgcn_kernarg_segment_ptr(); asm volatile("" : "+s"(q)); return q; }

__device__ __forceinline__ void convert_tables_fp4(const CParamsP pp, GAS unsigned char* ws, int layer, int gtid, int gn) {
  constexpr size_t NIT = 16384ull * 1024 / 16;
  for (size_t it = gtid; it < 2 * NIT; it += gn) {
    const int tb = it >= NIT ? 1 : 0; const size_t r = (it - (size_t)tb * NIT) + (size_t)layer * NIT;
    const f32x4* src = (const f32x4*)((tb ? gin(pp->in[I_PV]) : gin(pp->in[I_PU])) + r * 16);
    const float sc = tb ? 4.f : 64.f;
    unsigned o[2] = {0u, 0u};
#pragma unroll
    for (int q = 0; q < 4; ++q) {
      const f32x4 a = src[q];
      const float x0 = fminf(fmaxf(a.x * sc, -6.f), 6.f), x1 = fminf(fmaxf(a.y * sc, -6.f), 6.f);
      const float x2 = fminf(fmaxf(a.z * sc, -6.f), 6.f), x3 = fminf(fmaxf(a.w * sc, -6.f), 6.f);
      if (q == 0)      { o[0] = __builtin_amdgcn_cvt_scalef32_pk_fp4_f32(o[0], x0, x1, 1.0f, 0); o[0] = __builtin_amdgcn_cvt_scalef32_pk_fp4_f32(o[0], x2, x3, 1.0f, 1); }
      else if (q == 1) { o[0] = __builtin_amdgcn_cvt_scalef32_pk_fp4_f32(o[0], x0, x1, 1.0f, 2); o[0] = __builtin_amdgcn_cvt_scalef32_pk_fp4_f32(o[0], x2, x3, 1.0f, 3); }
      else if (q == 2) { o[1] = __builtin_amdgcn_cvt_scalef32_pk_fp4_f32(o[1], x0, x1, 1.0f, 0); o[1] = __builtin_amdgcn_cvt_scalef32_pk_fp4_f32(o[1], x2, x3, 1.0f, 1); }
      else             { o[1] = __builtin_amdgcn_cvt_scalef32_pk_fp4_f32(o[1], x0, x1, 1.0f, 2); o[1] = __builtin_amdgcn_cvt_scalef32_pk_fp4_f32(o[1], x2, x3, 1.0f, 3); }
    }
    *(uint2*)(ws + (tb ? WS_PV8 : WS_PU8) + r * 8) = make_uint2(o[0], o[1]);
  }
}

__device__ void setup_phase(const Params& p, unsigned char* smem) {
  const CParamsP pp = launder_kargs();
  GAS unsigned char* const ws = launder_ptr(pp->ws); const int tidx = launder_tid(); (void)ws; (void)tidx;
  const int tid = tidx;
  float* sm = (float*)smem;
  {
    float* cond = sm;
    float* red = sm + 2048;
    float* MOD = (float*)(ws + WS_MOD);
    for (int i = tid; i < 2048; i += NT) { const float c = gin(pp->in[I_C])[i]; cond[i] = c * sigmoid_f(c); }
    __syncthreads();
    for (int item = blockIdx.x; item < 4 * 192; item += gridDim.x) {
      const int l = item / 192, cb = item % 192, kq = tid >> 6, jj = tid & 31, kp = (tid >> 5) & 1, j = cb * 32 + jj;
      const float* w = gin(pp->in[I_WADA]) + (size_t)l * 1024 * 6144 + j;
      float a0 = 0.f, a1 = 0.f;
#pragma unroll 32
      for (int k = kq * 128 + kp; k < kq * 128 + 128; k += 2) { const float wv = w[(size_t)k * 6144]; a0 += cond[k] * wv; a1 += cond[1024 + k] * wv; }
      red[((kq * 2 + kp) * 2 + 0) * 32 + jj] = a0; red[((kq * 2 + kp) * 2 + 1) * 32 + jj] = a1;
      __syncthreads();
      if (tid < 64) {
        const int b = tid >> 5, j2 = tid & 31; float s = 0.f;
        for (int q = 0; q < 16; ++q) s += red[(q * 2 + b) * 32 + j2];
        MOD[((size_t)l * 2 + b) * 6144 + cb * 32 + j2] = s + gin(pp->in[I_BADA])[(size_t)l * 6144 + cb * 32 + j2];
      }
      __syncthreads();
    }
  }
  const int gtid = blockIdx.x * NT + tid, gn = gridDim.x * NT;
  {
    float* RC = (float*)(ws + WS_ROTC); float* RS = (float*)(ws + WS_ROTS);
    for (int idx = gtid; idx < 8192 * 32; idx += gn) {
      const int pos = idx >> 5, i = idx & 31;
      const float inv = powf(10000.0f, -(float)i / 32.0f);
      const float ang = (float)pos * inv;
      float s, c; sincosf(ang, &s, &c);
      RC[idx] = c; RS[idx] = s;
    }
  }
  {
    float* SA = (float*)(ws + WS_SA); float* SBB = (float*)(ws + WS_SBB); bf16_t* BBH = (bf16_t*)(ws + WS_BBH);
    for (int idx = gtid; idx < 4 * 16 * 64; idx += gn) {
      const int l = idx / 1024, g = (idx >> 6) & 15;
      const float dt = expf(gin(pp->in[I_LOGDT])[l * 16 + g]);
      const float lr = gin(pp->in[I_LRE])[idx], li = gin(pp->in[I_LIM])[idx];
      const float mag = expf(lr * dt);
      float sn, cs; sincosf(li * dt, &sn, &cs);
      const float are = mag * cs, aim = mag * sn;
      const float den = lr * lr + li * li, nr = are - 1.f, ni = aim;
      const float fre = (nr * lr + ni * li) / den, fim = (ni * lr - nr * li) / den;
      SA[idx * 2] = are; SA[idx * 2 + 1] = aim;
      for (int c = 0; c < 16; ++c) {
        const float br = gin(pp->in[I_BRE])[(size_t)idx * 16 + c], bi = gin(pp->in[I_BIM])[(size_t)idx * 16 + c];
        SBB[(size_t)idx * 32 + c] = fre * br - fim * bi;
        SBB[(size_t)idx * 32 + 16 + c] = fre * bi + fim * br;
        {
          const int pq = idx & 63; const size_t fb = (size_t)(idx >> 6) * 2;
          BBH[(((fb + 0) * 2 + (pq >> 5)) * 64 + 32 * (c >> 3) + (pq & 31)) * 8 + (c & 7)] = f2bf(fre * br - fim * bi);
          BBH[(((fb + 1) * 2 + (pq >> 5)) * 64 + 32 * (c >> 3) + (pq & 31)) * 8 + (c & 7)] = f2bf(fre * bi + fim * br);
        }
      }
    }
  }
  {
    bf16_t* CB = (bf16_t*)(ws + WS_CB);
    for (int idx = gtid; idx < 4 * 16 * 16 * 128; idx += gn) {
      const int k = idx & 127, lgc = idx >> 7;
      const bf16_t cv = (k < 64) ? f2bf(gin(pp->in[I_CRE])[(size_t)lgc * 64 + k]) : f2bf(-gin(pp->in[I_CIM])[(size_t)lgc * 64 + (k - 64)]);
      const int cc = lgc & 15, lg = lgc >> 4;
      CB[(((size_t)lg * 4 + (k >> 5)) * 64 + ((k >> 3) & 3) * 16 + cc) * 8 + (k & 7)] = cv;
    }
    bf16_t* WG = (bf16_t*)(ws + WS_WGLUT);
    for (int idx = gtid; idx < 4 * 512 * 256; idx += gn) {
      const int k = idx & 255, nn = (idx >> 8) & 511, l2 = idx >> 17;
      {
        const int which = nn >> 8, w8 = (nn >> 5) & 7, nt = (nn >> 4) & 1, frr = nn & 15, ks = k >> 5, fqq = (k >> 3) & 3, j = k & 7;
        WG[(((((size_t)l2 * 8 + w8) * 8 + ks) * 2 + which) * 2 + nt) * 512 + (fqq * 16 + frr) * 8 + j] = f2bf(gin(pp->in[I_WGLU])[((size_t)l2 * 256 + k) * 512 + nn]);
      }
    }
  }
  convert_tables_fp4(pp, ws, 0, gtid, gn);
  {
    __syncthreads();
    const int lane = tid & 63, wid = tid >> 6;
    float* scr = sm + wid * (64 * 33);
    constexpr int IT_IN = 16 * 96, IT_OUT = 16 * 32, IT_L = IT_IN + IT_OUT;
    for (int item = blockIdx.x * NW + wid; item < 4 * IT_L; item += gridDim.x * NW) {
      const int l = item / IT_L; int r = item - l * IT_L;
      const float* W; bf16_t* WT; int N, NP;
      if (r < IT_IN) { W = gin(pp->in[I_WIN]) + (size_t)l * 1024 * INC; WT = (bf16_t*)(ws + WS_WIN) + (size_t)l * INCP * 1024; N = INC; NP = 96; }
      else { r -= IT_IN; W = gin(pp->in[I_WOUT]) + (size_t)l * 1024 * 1024; WT = (bf16_t*)(ws + WS_WOUT) + (size_t)l * 1024 * 1024; N = 1024; NP = 32; }
      const int kb = r / NP, nb = r - kb * NP, k0 = kb * 64, n0 = nb * 32;
      const int nn = n0 + (lane & 31); const bool inb = nn < N;
      float v[32];
#pragma unroll
      for (int i = 0; i < 32; ++i) { const int kk = 2 * i + (lane >> 5); v[i] = inb ? W[(size_t)(k0 + kk) * N + nn] : 0.f; }
#pragma unroll
      for (int i = 0; i < 32; ++i) { const int kk = 2 * i + (lane >> 5); scr[kk * 33 + (lane & 31)] = v[i]; }
      const int c = lane & 7;
#pragma unroll
      for (int j = 0; j < 4; ++j) {
        const int n = (lane >> 3) + 8 * j; const float* sp = scr + (8 * c) * 33 + n;
        uint4 o; o.x = pk2(sp[0], sp[33]); o.y = pk2(sp[2 * 33], sp[3 * 33]); o.z = pk2(sp[4 * 33], sp[5 * 33]); o.w = pk2(sp[6 * 33], sp[7 * 33]);
        *(uint4*)(WT + (size_t)(n0 + n) * 1024 + k0 + 8 * c) = o;
      }
    }
    __syncthreads();
  }
  {
    bf16_t* WP = (bf16_t*)(ws + WS_WQ);
    const int lane = tid & 63, wid = tid >> 6, fr = lane & 15, fq = lane >> 4;
    for (int item = blockIdx.x; item < 4 * 16 * 8; item += gridDim.x) {
      const int l = item >> 7, hs = (item >> 3) & 15, kb = item & 7;
      const float* Wq = gin(pp->in[I_WQ]) + ((size_t)l * 1024 + kb * 128 + wid * 16 + fr) * 2048 + hs * 128 + 8 * fq;
      const float* SKg = gin(pp->in[I_SUBK]) + ((size_t)l * 16 + hs) * 128 * 128 + (size_t)fr * 128 + 8 * fq;
      bf16x8 ah[4], al[4];
#pragma unroll
      for (int ks = 0; ks < 4; ++ks) {
        const f32x4 x0 = *(const f32x4*)(Wq + 32 * ks), x1 = *(const f32x4*)(Wq + 32 * ks + 4);
        const float xv[8] = {x0.x, x0.y, x0.z, x0.w, x1.x, x1.y, x1.z, x1.w};
#pragma unroll
        for (int j = 0; j < 8; ++j) { const bf16_t h = f2bf(xv[j]); ah[ks][j] = (short)h; al[ks][j] = (short)f2bf(xv[j] - bf2f(h)); }
      }
      f32x4 acc[8];
#pragma unroll
      for (int ct = 0; ct < 8; ++ct) acc[ct] = (f32x4){0.f, 0.f, 0.f, 0.f};
#pragma unroll 2
      for (int ct = 0; ct < 8; ++ct) {
        f32x4 y[8];
#pragma unroll
        for (int ks = 0; ks < 4; ++ks) { y[2 * ks] = *(const f32x4*)(SKg + (size_t)ct * 16 * 128 + 32 * ks); y[2 * ks + 1] = *(const f32x4*)(SKg + (size_t)ct * 16 * 128 + 32 * ks + 4); }
#pragma unroll
        for (int ks = 0; ks < 4; ++ks) {
          const float yv[8] = {y[2 * ks].x, y[2 * ks].y, y[2 * ks].z, y[2 * ks].w, y[2 * ks + 1].x, y[2 * ks + 1].y, y[2 * ks + 1].z, y[2 * ks + 1].w};
          bf16x8 bh, bl;
#pragma unroll
          for (int j = 0; j < 8; ++j) { const bf16_t h = f2bf(yv[j]); bh[j] = (short)h; bl[j] = (short)f2bf(yv[j] - bf2f(h)); }
          acc[ct] = __builtin_amdgcn_mfma_f32_16x16x32_bf16(ah[ks], bh, acc[ct], 0, 0, 0);
          acc[ct] = __builtin_amdgcn_mfma_f32_16x16x32_bf16(al[ks], bh, acc[ct], 0, 0, 0);
          acc[ct] = __builtin_amdgcn_mfma_f32_16x16x32_bf16(ah[ks], bl, acc[ct], 0, 0, 0);
        }
      }
#pragma unroll
      for (int ct = 0; ct < 8; ++ct)
        *(uint2*)(WP + ((size_t)l * 2048 + hs * 128 + 16 * ct + fr) * 1024 + kb * 128 + wid * 16 + 4 * fq) = make_uint2(pk2(acc[ct][0], acc[ct][1]), pk2(acc[ct][2], acc[ct][3]));
    }
  }
}

__device__ void qbias_phase(const Params& p, unsigned char* smem) {
  const CParamsP pp = launder_kargs();
  GAS unsigned char* const ws = launder_ptr(pp->ws); const int tid = launder_tid();
  float* C2 = (float*)(ws + WS_C2); const float* MOD = (const float*)(ws + WS_MOD); const bf16_t* WP = (const bf16_t*)(ws + WS_WQ);
  const int lane = tid & 63, gw = blockIdx.x * NW + (tid >> 6), nw = gridDim.x * NW;
  for (int o = gw; o < 4 * 2048; o += nw) {
    const int l = o >> 11;
    const uint4 w0 = *(const uint4*)(WP + (size_t)o * 1024 + lane * 16), w1 = *(const uint4*)(WP + (size_t)o * 1024 + lane * 16 + 8);
    const unsigned ww[8] = {w0.x, w0.y, w0.z, w0.w, w1.x, w1.y, w1.z, w1.w};
    const float* s0 = MOD + (size_t)l * 2 * 6144 + 3072 + lane * 16; const float* s1 = s0 + 6144;
    float a0 = 0.f, a1 = 0.f;
#pragma unroll
    for (int q = 0; q < 8; ++q) {
      const float wl = __uint_as_float(ww[q] << 16), wh = __uint_as_float(ww[q] & 0xffff0000u);
      a0 += s0[2 * q] * wl + s0[2 * q + 1] * wh; a1 += s1[2 * q] * wl + s1[2 * q + 1] * wh;
    }
    a0 = wave_sum(a0); a1 = wave_sum(a1);
    if (lane == 0) { C2[((size_t)l * 2 + 0) * 2048 + (o & 2047)] = a0; C2[((size_t)l * 2 + 1) * 2048 + (o & 2047)] = a1; }
  }
  (void)smem;
}

__device__ void norm_mod_phase(const float* __restrict__ xsrc, const float* __restrict__ gain, const float* __restrict__ mod_sh, const float* __restrict__ mod_sc,
                               bf16_t* __restrict__ outp) {
  const int tidx = launder_tid();
  const int lane = tidx & 63, gw = blockIdx.x * NW + (tidx >> 6), nw = gridDim.x * NW;
  for (int t = gw; t < T_; t += nw) {
    const int b = t >> 13;
    const f32x4* xr = (const f32x4*)(xsrc + (size_t)t * 1024) + lane;
    f32x4 v[4]; float s = 0.f;
#pragma unroll
    for (int j = 0; j < 4; ++j) { v[j] = xr[64 * j]; s += v[j].x * v[j].x + v[j].y * v[j].y + v[j].z * v[j].z + v[j].w * v[j].w; }
    const float rstd = rsqrtf(wave_sum(s) * (1.f / 1024.f) + EPS_);
#pragma unroll
    for (int j = 0; j < 4; ++j) {
      const int c = lane * 4 + 256 * j;
      const f32x4 g = *(const f32x4*)(gain + c), sh = *(const f32x4*)(mod_sh + b * 6144 + c), sc = *(const f32x4*)(mod_sc + b * 6144 + c);
      const float o0 = v[j].x * rstd * g.x * (1.f + sc.x) + sh.x, o1 = v[j].y * rstd * g.y * (1.f + sc.y) + sh.y;
      const float o2 = v[j].z * rstd * g.z * (1.f + sc.z) + sh.z, o3 = v[j].w * rstd * g.w * (1.f + sc.w) + sh.w;
      uint2 o; o.x = pk2(o0, o1); o.y = pk2(o2, o3);
      *(uint2*)(outp + (size_t)t * 1024 + c) = o;
    }
  }
}


namespace pg8 {
#define PG8_LAS __attribute__((address_space(3)))
typedef unsigned u32x4 __attribute__((ext_vector_type(4)));
constexpr int BM = 256, BK = 64, HALF = 128, HTB = HALF * BK * 2, STAGE_BYTES = 8 * HTB, NXCD = 8, WGM = 8;
__host__ __device__ __forceinline__ int lds_byte(int r, int c) { const int st = (r >> 4) * 2 + (c >> 5), rr = r & 15, cc = c & 31, ob = rr * 64 + cc * 2; return st * 1024 + (ob ^ (((ob >> 9) & 1) << 5)); }
__host__ __device__ __forceinline__ void stage_rc(int b, int& R, int& C) { const int st = b / 1024, sb = b % 1024, swz = sb ^ (((sb >> 9) & 1) << 5); R = (st >> 1) * 16 + swz / 64; C = (st & 1) * 32 + (swz % 64) / 2; }
__host__ __device__ __forceinline__ int perm32(int rho) { const int n = rho >> 4, i = rho & 15; return 8 * (i >> 2) + 4 * n + (i & 3); }
struct Unit { int pm, pn; };
struct Gemm { const bf16_t* A; const bf16_t* Bt; int M, N, K; };
struct StaticOrder {
    int nM, nN, nwg, G, c;
    __host__ __device__ void init(int M, int N, int G_, int c_) { nM = M / BM; nN = N / BM; nwg = nM * nN; G = G_; c = c_; }
    __host__ __device__ bool next(int i, Unit& u) const {
        const long L = (long)i * G + c; if (L >= nwg) return false;
        int wgid = (int)L; { const int q = nwg / NXCD, r = nwg % NXCD, xcd = wgid % NXCD, off = wgid / NXCD; wgid = (xcd < r ? xcd * (q + 1) : r * (q + 1) + (xcd - r) * q) + off; }
        const int nig = WGM * nN, gid = wgid / nig, fm = gid * WGM, gsz = (nM - fm) < WGM ? (nM - fm) : WGM;
        u.pm = fm + ((wgid % nig) % gsz); u.pn = (wgid % nig) / gsz; return true;
    }
    __device__ __forceinline__ void a_ready(const Unit&) const {}
    __device__ __forceinline__ void done(const Unit&) const {}
};
__device__ __forceinline__ unsigned cvt_pk_bf16(float lo, float hi) { unsigned r; asm volatile("v_cvt_pk_bf16_f32 %0, %1, %2" : "=v"(r) : "v"(lo), "v"(hi)); return r; }
template <class Epi, class Sched>
__device__ __forceinline__ void gemm_phase(PG8_LAS unsigned char* lds, const Gemm g, const Sched& S, const Epi& E) {
    const int tid = launder_tid(), wid = __builtin_amdgcn_readfirstlane(tid >> 6), lane = tid & 63, wr = wid >> 2, wc = wid & 3, fr = lane & 15, fq = lane >> 4;
    const int K = g.K, nt = K / BK;
    unsigned voffA[2], voffB[2];
#pragma unroll
    for (int i = 0; i < 2; ++i) { int R, C; stage_rc(tid * 16 + i * 8192, R, C); const int Rb = Epi::PERM ? ((R & ~31) + perm32(R & 31)) : R;
        voffA[i] = (unsigned)(R * K + C) * 2u; voffB[i] = (unsigned)(Rb * K + C) * 2u; }
    const size_t kstep = (size_t)(BK * 2);
    const size_t hstep = (size_t)HALF * K * 2;
    const size_t tstep = 2 * hstep;
    const unsigned ldsw = (unsigned)wid * 1024u;
    const int aoff = lds_byte(wr * 64 + fr, fq * 8), boff = lds_byte(wc * 32 + fr, fq * 8);
#define PG8_SA(b, h) (((b) * 2 + (h)) * HTB)
#define PG8_SB(b, h) ((4 + (b) * 2 + (h)) * HTB)
#define PG8_STAGE(bufoff, gbase, voff) do { _Pragma("unroll") for (int _i = 0; _i < 2; ++_i) \
        __builtin_amdgcn_global_load_lds((const unsigned*)((const char*)(gbase) + (voff)[_i]), (PG8_LAS unsigned*)(lds + (bufoff) + ldsw + _i * 8192), 16, 0, 0); } while (0)
#define PG8_LDA(dst, b, h) do { _Pragma("unroll") for (int m = 0; m < 4; ++m) _Pragma("unroll") for (int k = 0; k < 2; ++k) dst[m][k] = *(const PG8_LAS bf16x8*)(lds + PG8_SA(b, h) + aoff + m * 2048 + k * 1024); } while (0)
#define PG8_LDB(dst, b, h) do { _Pragma("unroll") for (int n = 0; n < 2; ++n) _Pragma("unroll") for (int k = 0; k < 2; ++k) dst[n][k] = *(const PG8_LAS bf16x8*)(lds + PG8_SB(b, h) + boff + n * 2048 + k * 1024); } while (0)
#define PG8_MMA(ai, bj, At, Bt) do { __builtin_amdgcn_s_setprio(1); _Pragma("unroll") for (int m = 0; m < 4; ++m) _Pragma("unroll") for (int n = 0; n < 2; ++n) _Pragma("unroll") for (int k = 0; k < 2; ++k) \
        acc[ai][bj][m][n] = __builtin_amdgcn_mfma_f32_16x16x32_bf16(Bt[n][k], At[m][k], acc[ai][bj][m][n], 0, 0, 0); __builtin_amdgcn_s_setprio(0); } while (0)
#define PG8_WAIT_V(n) asm volatile("s_waitcnt vmcnt(" #n ")" ::: "memory")
#define PG8_WAIT_L(n) asm volatile("s_waitcnt lgkmcnt(" #n ")" ::: "memory")
#define PG8_BAR __builtin_amdgcn_s_barrier()
#define PG8_SCHED __builtin_amdgcn_sched_barrier(0)
    Unit cur, nxt; int ui = 0;
    if (!S.next(0, cur)) return;
    f32x4 acc[2][2][4][2];
#pragma unroll
    for (int a = 0; a < 2; ++a)
#pragma unroll
        for (int b = 0; b < 2; ++b)
#pragma unroll
            for (int m = 0; m < 4; ++m)
#pragma unroll
                for (int n = 0; n < 2; ++n) acc[a][b][m][n] = (f32x4){0.f, 0.f, 0.f, 0.f};
    bf16x8 At[4][2], B0[2][2], B1[2][2];
    const char* cA = (const char*)g.A + (size_t)cur.pm * tstep; const char* cB = (const char*)g.Bt + (size_t)cur.pn * tstep;
    S.a_ready(cur);
    PG8_STAGE(PG8_SB(0, 0), cB, voffB); PG8_STAGE(PG8_SA(0, 0), cA, voffA); PG8_STAGE(PG8_SB(0, 1), cB + hstep, voffB); PG8_STAGE(PG8_SA(0, 1), cA + hstep, voffA);
    if (wr == 1) PG8_BAR;
    PG8_WAIT_V(4); PG8_BAR;
    PG8_STAGE(PG8_SB(1, 0), cB + kstep, voffB); PG8_STAGE(PG8_SA(1, 0), cA + kstep, voffA); PG8_STAGE(PG8_SB(1, 1), cB + hstep + kstep, voffB);
    PG8_WAIT_V(6); PG8_BAR;
    for (;;) {
        const bool has_next = S.next(ui + 1, nxt);
        const char* nA = has_next ? (const char*)g.A + (size_t)nxt.pm * tstep : cA; const char* nB = has_next ? (const char*)g.Bt + (size_t)nxt.pn * tstep : cB;
        for (int t = 0; t < nt; t += 2) {
            const bool last = (t == nt - 2);
            const char* a1 = cA + (size_t)(t + 1) * kstep;
            const char* a2 = last ? nA : cA + (size_t)(t + 2) * kstep; const char* b2 = last ? nB : cB + (size_t)(t + 2) * kstep;
            const char* a3 = a2 + kstep; const char* b3 = b2 + kstep;
            if (last && has_next) S.a_ready(nxt);
            PG8_LDB(B0, 0, 0); PG8_SCHED; PG8_LDA(At, 0, 0); PG8_STAGE(PG8_SA(1, 1), a1 + hstep, voffA);
            PG8_WAIT_L(8); PG8_BAR; PG8_WAIT_L(0); PG8_MMA(0, 0, At, B0); PG8_BAR; PG8_SCHED;
            PG8_LDB(B1, 0, 1); PG8_STAGE(PG8_SB(0, 0), b2, voffB);
            PG8_BAR; PG8_WAIT_L(0); PG8_MMA(0, 1, At, B1); PG8_BAR;
            PG8_LDA(At, 0, 1); PG8_STAGE(PG8_SA(0, 0), a2, voffA);
            PG8_BAR; PG8_WAIT_L(0); PG8_MMA(1, 0, At, B0); PG8_BAR; PG8_SCHED;
            PG8_STAGE(PG8_SB(0, 1), b2 + hstep, voffB);
            PG8_WAIT_V(6); PG8_BAR; PG8_MMA(1, 1, At, B1); PG8_BAR;
            PG8_LDB(B0, 1, 0); PG8_SCHED; PG8_LDA(At, 1, 0); PG8_STAGE(PG8_SA(0, 1), a2 + hstep, voffA);
            PG8_WAIT_L(8); PG8_BAR; PG8_WAIT_L(0); PG8_MMA(0, 0, At, B0); PG8_BAR; PG8_SCHED;
            PG8_LDB(B1, 1, 1); PG8_STAGE(PG8_SB(1, 0), b3, voffB);
            PG8_BAR; PG8_WAIT_L(0); PG8_MMA(0, 1, At, B1); PG8_BAR;
            PG8_LDA(At, 1, 1); PG8_STAGE(PG8_SA(1, 0), a3, voffA);
            PG8_BAR; PG8_WAIT_L(0); PG8_MMA(1, 0, At, B0); PG8_BAR; PG8_SCHED;
            PG8_STAGE(PG8_SB(1, 1), b3 + hstep, voffB);
            PG8_WAIT_V(6); PG8_BAR; PG8_MMA(1, 1, At, B1); PG8_BAR;
        }
        if constexpr (!Epi::AFTER_DRAIN) { E(acc, cur, wr, wc, fr, fq); S.done(cur); }
        if (!has_next) break;
#pragma unroll
        for (int a = 0; a < 2; ++a)
#pragma unroll
            for (int b = 0; b < 2; ++b)
#pragma unroll
                for (int m = 0; m < 4; ++m)
#pragma unroll
                    for (int n = 0; n < 2; ++n) acc[a][b][m][n] = (f32x4){0.f, 0.f, 0.f, 0.f};
        cur = nxt; cA = nA; cB = nB; ++ui;
    }
    PG8_WAIT_V(0);
    if (wr == 0) PG8_BAR;
    PG8_BAR;
    if constexpr (Epi::AFTER_DRAIN) { E.fused(acc, cur, wr, wc, fr, fq, lds, wid, lane); S.done(cur); }
#undef PG8_SA
#undef PG8_SB
#undef PG8_STAGE
#undef PG8_LDA
#undef PG8_LDB
#undef PG8_MMA
#undef PG8_WAIT_V
#undef PG8_WAIT_L
#undef PG8_BAR
#undef PG8_SCHED
}
}

__device__ __forceinline__ float ssq_total(const float* __restrict__ SSQ, int t) {
  const f32x4 a = *(const f32x4*)(SSQ + (size_t)t * 16), b = *(const f32x4*)(SSQ + (size_t)t * 16 + 4), c = *(const f32x4*)(SSQ + (size_t)t * 16 + 8), d = *(const f32x4*)(SSQ + (size_t)t * 16 + 12);
  return (((a.x + a.y) + (a.z + a.w)) + ((b.x + b.y) + (b.z + b.w))) + (((c.x + c.y) + (c.z + c.w)) + ((d.x + d.y) + (d.z + d.w)));
}
struct EpiProj {
  static constexpr bool PERM = true, AFTER_DRAIN = false;
  bf16_t* PROJ; bf16_t* VTA; bf16_t* VTR;
  __device__ __forceinline__ void operator()(const f32x4 (&acc)[2][2][4][2], const pg8::Unit& u, int wr, int wc, int fr, int fq) const {
    const int row0 = u.pm * 256 + wr * 64 + fr, col0 = u.pn * 256 + wc * 32 + 8 * fq;
    asm volatile("s_nop 15\n\ts_nop 15" ::: "memory");
#pragma unroll
    for (int ai = 0; ai < 2; ++ai)
#pragma unroll
      for (int m = 0; m < 4; ++m) {
        const int t = row0 + ai * 128 + m * 16;
#pragma unroll
        for (int bj = 0; bj < 2; ++bj) {
          const int c = col0 + bj * 128;
          const f32x4 v0 = acc[ai][bj][m][0], v1 = acc[ai][bj][m][1];
          pg8::u32x4 w; w.x = pg8::cvt_pk_bf16(v0[0], v0[1]); w.y = pg8::cvt_pk_bf16(v0[2], v0[3]); w.z = pg8::cvt_pk_bf16(v1[0], v1[1]); w.w = pg8::cvt_pk_bf16(v1[2], v1[3]);
          *(pg8::u32x4*)(PROJ + (size_t)t * INCP + c) = w;
          const bool isva = (c >= C_VA && c < C_VA + 384), isvr = (c >= C_VR && c < C_VR + 384);
          if (isva || isvr) {
            bf16_t* vt = (isva ? VTA : VTR) + ((size_t)(t >> 13) * 384 + (c - (isva ? C_VA : C_VR))) * 8192 + (t & 8191);
            vt[0] = (bf16_t)(w.x & 0xffffu); vt[8192] = (bf16_t)(w.x >> 16); vt[2 * 8192] = (bf16_t)(w.y & 0xffffu); vt[3 * 8192] = (bf16_t)(w.y >> 16);
            vt[4 * 8192] = (bf16_t)(w.z & 0xffffu); vt[5 * 8192] = (bf16_t)(w.z >> 16); vt[6 * 8192] = (bf16_t)(w.w & 0xffffu); vt[7 * 8192] = (bf16_t)(w.w >> 16);
          }
        }
      }
  }
};
struct EpiOut {
  static constexpr bool PERM = true, AFTER_DRAIN = false;
  const float* xin; int first; bf16_t* X; const float* g1; const float* nf; const float* sc2; bf16_t* XG; float* SSQ;
  __device__ __forceinline__ void operator()(const f32x4 (&acc)[2][2][4][2], const pg8::Unit& u, int wr, int wc, int fr, int fq) const {
    const int row0 = u.pm * 256 + wr * 64 + fr, col0 = u.pn * 256 + wc * 32 + 8 * fq, b = (u.pm * 256) >> 13;
    f32x4 gg[2][2], gs[2][2];
#pragma unroll
    for (int bj = 0; bj < 2; ++bj)
#pragma unroll
      for (int n = 0; n < 2; ++n) {
        const int c = col0 + bj * 128 + n * 4;
        gg[bj][n] = *(const f32x4*)(g1 + b * 6144 + c);
        const f32x4 gf = *(const f32x4*)(nf + c), sc = *(const f32x4*)(sc2 + b * 6144 + c);
        gs[bj][n] = gf * (sc + 1.f);
      }
#pragma unroll
    for (int ai = 0; ai < 2; ++ai)
#pragma unroll
      for (int m = 0; m < 4; ++m) {
        const int t = row0 + ai * 128 + m * 16;
        float sq = 0.f;
#pragma unroll
        for (int bj = 0; bj < 2; ++bj) {
          const int c = col0 + bj * 128;
          f32x4 x0, x1;
          if (first) { x0 = *(const f32x4*)(xin + (size_t)t * 1024 + c); x1 = *(const f32x4*)(xin + (size_t)t * 1024 + c + 4); }
          else {
            const pg8::u32x4 xr = *(const pg8::u32x4*)(X + (size_t)t * 1024 + c);
            x0 = (f32x4){__uint_as_float(xr.x << 16), __uint_as_float(xr.x & 0xffff0000u), __uint_as_float(xr.y << 16), __uint_as_float(xr.y & 0xffff0000u)};
            x1 = (f32x4){__uint_as_float(xr.z << 16), __uint_as_float(xr.z & 0xffff0000u), __uint_as_float(xr.w << 16), __uint_as_float(xr.w & 0xffff0000u)};
          }
          const f32x4 n0 = x0 + gg[bj][0] * acc[ai][bj][m][0], n1 = x1 + gg[bj][1] * acc[ai][bj][m][1];
          pg8::u32x4 xo; xo.x = pg8::cvt_pk_bf16(n0.x, n0.y); xo.y = pg8::cvt_pk_bf16(n0.z, n0.w); xo.z = pg8::cvt_pk_bf16(n1.x, n1.y); xo.w = pg8::cvt_pk_bf16(n1.z, n1.w);
          *(pg8::u32x4*)(X + (size_t)t * 1024 + c) = xo;
          const f32x4 s0 = n0 * gs[bj][0], s1 = n1 * gs[bj][1];
          pg8::u32x4 go; go.x = pg8::cvt_pk_bf16(s0.x, s0.y); go.y = pg8::cvt_pk_bf16(s0.z, s0.w); go.z = pg8::cvt_pk_bf16(s1.x, s1.y); go.w = pg8::cvt_pk_bf16(s1.z, s1.w);
          *(pg8::u32x4*)(XG + (size_t)t * 1024 + c) = go;
          sq += ((n0.x * n0.x + n0.y * n0.y) + (n0.z * n0.z + n0.w * n0.w)) + ((n1.x * n1.x + n1.y * n1.y) + (n1.z * n1.z + n1.w * n1.w));
        }
        sq += __shfl_xor(sq, 16); sq += __shfl_xor(sq, 32);
        if (fq == 0) SSQ[(size_t)t * 16 + u.pn * 4 + wc] = sq;
      }
  }
};
struct EpiQ {
  static constexpr bool PERM = true, AFTER_DRAIN = false;
  bf16_t* SC8; const float* SSQ; const float* C2;
  __device__ __forceinline__ void operator()(const f32x4 (&acc)[2][2][4][2], const pg8::Unit& u, int wr, int wc, int fr, int fq) const {
    const int row0 = u.pm * 256 + wr * 64 + fr, col0 = u.pn * 256 + wc * 32 + 8 * fq, b = (u.pm * 256) >> 13;
    f32x4 cc[2][2];
#pragma unroll
    for (int bj = 0; bj < 2; ++bj) { cc[bj][0] = *(const f32x4*)(C2 + b * 2048 + col0 + bj * 128); cc[bj][1] = *(const f32x4*)(C2 + b * 2048 + col0 + bj * 128 + 4); }
#pragma unroll
    for (int ai = 0; ai < 2; ++ai)
#pragma unroll
      for (int m = 0; m < 4; ++m) {
        const int t = row0 + ai * 128 + m * 16;
        const float rstd = rsqrtf(ssq_total(SSQ, t) * (1.f / 1024.f) + EPS_);
#pragma unroll
        for (int bj = 0; bj < 2; ++bj) {
          const f32x4 v0 = acc[ai][bj][m][0] * rstd + cc[bj][0], v1 = acc[ai][bj][m][1] * rstd + cc[bj][1];
          pg8::u32x4 w; w.x = pg8::cvt_pk_bf16(v0[0], v0[1]); w.y = pg8::cvt_pk_bf16(v0[2], v0[3]); w.z = pg8::cvt_pk_bf16(v1[0], v1[1]); w.w = pg8::cvt_pk_bf16(v1[2], v1[3]);
          *(pg8::u32x4*)(SC8 + ((size_t)((col0 + bj * 128) >> 3) * T_ + t) * 8) = w;
        }
      }
  }
};

__device__ void gemm_proj_phase(const Params& p, int l, unsigned char* smem) {
  const CParamsP pp = launder_kargs();
  GAS unsigned char* const ws = launder_ptr(pp->ws);
  pg8::Gemm g; g.A = (const bf16_t*)(ws + WS_ABUF); g.Bt = (const bf16_t*)(ws + WS_WIN) + (size_t)l * INCP * 1024; g.M = T_; g.N = INCP; g.K = 1024;
  pg8::StaticOrder S; S.init(T_, INCP, gridDim.x, blockIdx.x);
  EpiProj E; E.PROJ = (bf16_t*)(ws + WS_PROJ); E.VTA = (bf16_t*)(ws + WS_VTA); E.VTR = (bf16_t*)(ws + WS_VTR);
  pg8::gemm_phase<EpiProj, pg8::StaticOrder>((PG8_LAS unsigned char*)smem, g, S, E);
}
__device__ void gemm_out_phase(const Params& p, int l, unsigned char* smem) {
  const CParamsP pp = launder_kargs();
  GAS unsigned char* const ws = launder_ptr(pp->ws);
  pg8::Gemm g; g.A = (const bf16_t*)(ws + WS_ABUF); g.Bt = (const bf16_t*)(ws + WS_WOUT) + (size_t)l * 1024 * 1024; g.M = T_; g.N = 1024; g.K = 1024;
  pg8::StaticOrder S; S.init(T_, 1024, gridDim.x, blockIdx.x);
  EpiOut E; E.xin = gin(pp->in[I_X]); E.first = (l == 0) ? 1 : 0; E.X = (bf16_t*)(ws + WS_X); E.g1 = (const float*)(ws + WS_MOD) + (size_t)l * 2 * 6144 + 2048;
  E.nf = gin(pp->in[I_NFFN]) + (size_t)l * 1024; E.sc2 = (const float*)(ws + WS_MOD) + (size_t)l * 2 * 6144 + 4096; E.XG = (bf16_t*)(ws + WS_XG); E.SSQ = (float*)(ws + WS_SSQ);
  pg8::gemm_phase<EpiOut, pg8::StaticOrder>((PG8_LAS unsigned char*)smem, g, S, E);
}
__device__ void gemm_q_phase(const Params& p, int l, unsigned char* smem) {
  const CParamsP pp = launder_kargs();
  GAS unsigned char* const ws = launder_ptr(pp->ws);
  pg8::Gemm g; g.A = (const bf16_t*)(ws + WS_XG); g.Bt = (const bf16_t*)(ws + WS_WQ) + (size_t)l * 2048 * 1024; g.M = T_; g.N = 2048; g.K = 1024;
  pg8::StaticOrder S; S.init(T_, 2048, gridDim.x, blockIdx.x);
  EpiQ E; E.SC8 = (bf16_t*)(ws + WS_SC); E.SSQ = (const float*)(ws + WS_SSQ); E.C2 = (const float*)(ws + WS_C2) + (size_t)l * 2 * 2048;
  pg8::gemm_phase<EpiQ, pg8::StaticOrder>((PG8_LAS unsigned char*)smem, g, S, E);
}

__device__ __forceinline__ int attn_fk(int r) { return ((r >> 3) & 3) | (((r >> 1) & 1) << 2); }
__device__ __forceinline__ int attn_fv(int r) { return (r >> 1) & 7; }
__device__ void attn_phase(const Params& p, int l, unsigned char* smem) {
  const CParamsP pp = launder_kargs();
  GAS unsigned char* const ws = launder_ptr(pp->ws); const int tidx = launder_tid();
  const bf16_t* PROJ = (const bf16_t*)(ws + WS_PROJ); const bf16_t* VTA = (const bf16_t*)(ws + WS_VTA);
  bf16_t* ATT = (bf16_t*)(ws + WS_ATT);
  const int lane = tidx & 63, wid = tidx >> 6, fr = lane & 15, fq = lane >> 4;
  float* ext = (float*)smem;
  unsigned char* stg = smem + 15360;
  constexpr float LOG2E = 1.4426950408889634f;
  __syncthreads();
  for (int idx = tidx; idx < 6 * 640; idx += NT) {
    const int h = idx / 640, e = idx - h * 640; int d = e - 63; d = d > 256 ? 256 : d;
    ext[idx] = gin(pp->in[I_RELB])[((size_t)l * 6 + h) * 513 + d + 256] * LOG2E;
  }
  const int hh = wid >> 2, qb = wid & 3, iq = qb * 16 + fr;
  const int srow = tidx >> 3, sch = tidx & 7;
  for (int it_ = blockIdx.x; it_ < 256; it_ += gridDim.x) {
    const int item = ((it_ & 7) << 5) | (it_ >> 3);
    const int b = item >> 7, n = item & 127, t0 = b * 8192 + n * 64;
    const int jc0 = n >= 8 ? 0 : 8 - n, nch = 9 - jc0, nst = 3 * nch;
    uint4 sa0, sa1, sa2, sa3, sb0, sb1, sb2, sb3;
#define ATTN_LOAD(S, st) do { const int _rd = (st) / nch, _jc = jc0 + (st) - _rd * nch, _m = n - 8 + _jc; \
      S##0 = *(const uint4*)(PROJ + (size_t)(b * 8192 + _m * 64 + srow) * INCP + C_KA + (2 * _rd) * 64 + sch * 8); \
      S##1 = *(const uint4*)(PROJ + (size_t)(b * 8192 + _m * 64 + srow) * INCP + C_KA + (2 * _rd + 1) * 64 + sch * 8); \
      S##2 = *(const uint4*)(VTA + ((size_t)b * 384 + (2 * _rd) * 64 + srow) * 8192 + _m * 64 + sch * 8); \
      S##3 = *(const uint4*)(VTA + ((size_t)b * 384 + (2 * _rd + 1) * 64 + srow) * 8192 + _m * 64 + sch * 8); } while (0)
#define ATTN_WRITE(S, buf) do { unsigned char* _bp = stg + (buf) * 32768; \
      *(uint4*)(_bp + srow * 128 + ((sch ^ attn_fk(srow)) << 4)) = S##0; \
      *(uint4*)(_bp + 8192 + srow * 128 + ((sch ^ attn_fk(srow)) << 4)) = S##1; \
      *(uint4*)(_bp + 16384 + srow * 128 + ((sch ^ attn_fv(srow)) << 4)) = S##2; \
      *(uint4*)(_bp + 24576 + srow * 128 + ((sch ^ attn_fv(srow)) << 4)) = S##3; } while (0)
    __syncthreads();
    ATTN_LOAD(sa, 0);
    ATTN_WRITE(sa, 0);
    if (1 < nst) ATTN_LOAD(sb, 1);
    __syncthreads();
    bf16x8 qf[2];
    f32x4 o[4];
    float mrun = -1e30f, lrun = 0.f;
    const float* exth = ext;
    auto attn_compute = [&](const int st) {
      const int rd = st / nch, jc = jc0 + st - rd * nch, h = 2 * rd + hh;
      if (jc == jc0) {
#pragma unroll
        for (int ds = 0; ds < 2; ++ds) qf[ds] = *(const bf16x8*)(PROJ + (size_t)(t0 + iq) * INCP + C_QA + h * 64 + ds * 32 + fq * 8);
#pragma unroll
        for (int et = 0; et < 4; ++et) o[et] = (f32x4){0.f, 0.f, 0.f, 0.f};
        mrun = -1e30f; lrun = 0.f;
        exth = ext + h * 640 + 63 + 512 + iq - 8 * fq;
      }
      const unsigned char* kb = stg + (st & 1) * 32768 + hh * 8192;
      const unsigned char* vb = stg + (st & 1) * 32768 + (2 + hh) * 8192;
      float sc[2][2][4];
      bf16x8 kfr[2][2][2], vfr[2][4]; float bia[2][2][4];
#pragma unroll
      for (int g = 0; g < 2; ++g)
#pragma unroll
        for (int tt = 0; tt < 2; ++tt) {
          const int key = 32 * g + 8 * (fr >> 2) + (fr & 3) + 4 * tt, fk = attn_fk(key);
          kfr[g][tt][0] = *(const bf16x8*)(kb + key * 128 + ((fq ^ fk) << 4));
          kfr[g][tt][1] = *(const bf16x8*)(kb + key * 128 + (((4 + fq) ^ fk) << 4));
        }
#pragma unroll
      for (int g = 0; g < 2; ++g)
#pragma unroll
        for (int tt = 0; tt < 2; ++tt)
#pragma unroll
          for (int j = 0; j < 4; ++j) bia[g][tt][j] = exth[-(64 * jc + 32 * g + 4 * tt + j)];
#pragma unroll
      for (int g = 0; g < 2; ++g)
#pragma unroll
        for (int et = 0; et < 4; ++et) { const int er = 16 * et + fr; vfr[g][et] = *(const bf16x8*)(vb + er * 128 + (((4 * g + fq) ^ attn_fv(er)) << 4)); }
      __builtin_amdgcn_sched_barrier(0);
#pragma unroll
      for (int g = 0; g < 2; ++g)
#pragma unroll
        for (int tt = 0; tt < 2; ++tt) {
          f32x4 s4 = __builtin_amdgcn_mfma_f32_16x16x32_bf16(kfr[g][tt][0], qf[0], (f32x4){0.f, 0.f, 0.f, 0.f}, 0, 0, 0);
          s4 = __builtin_amdgcn_mfma_f32_16x16x32_bf16(kfr[g][tt][1], qf[1], s4, 0, 0, 0);
#pragma unroll
          for (int j = 0; j < 4; ++j) sc[g][tt][j] = s4[j] * (0.125f * LOG2E) + bia[g][tt][j];
        }
      float mloc = -1e30f;
#pragma unroll
      for (int g = 0; g < 2; ++g)
#pragma unroll
        for (int tt = 0; tt < 2; ++tt)
#pragma unroll
          for (int j = 0; j < 4; ++j) mloc = fmaxf(mloc, sc[g][tt][j]);
      mloc = fmaxf(mloc, __shfl_xor(mloc, 16)); mloc = fmaxf(mloc, __shfl_xor(mloc, 32));
      const float mnew = fmaxf(mrun, mloc), alpha = __builtin_amdgcn_exp2f(mrun - mnew);
      mrun = mnew;
      float ls = 0.f;
#pragma unroll
      for (int g = 0; g < 2; ++g)
#pragma unroll
        for (int tt = 0; tt < 2; ++tt)
#pragma unroll
          for (int j = 0; j < 4; ++j) { const float e = __builtin_amdgcn_exp2f(sc[g][tt][j] - mnew); sc[g][tt][j] = e; ls += e; }
      lrun = lrun * alpha + ls;
#pragma unroll
      for (int et = 0; et < 4; ++et) { o[et].x *= alpha; o[et].y *= alpha; o[et].z *= alpha; o[et].w *= alpha; }
#pragma unroll
      for (int g = 0; g < 2; ++g) {
        union { bf16x8 v; unsigned u[4]; } pf;
        pf.u[0] = pk2(sc[g][0][0], sc[g][0][1]); pf.u[1] = pk2(sc[g][0][2], sc[g][0][3]);
        pf.u[2] = pk2(sc[g][1][0], sc[g][1][1]); pf.u[3] = pk2(sc[g][1][2], sc[g][1][3]);
#pragma unroll
        for (int et = 0; et < 4; ++et) o[et] = __builtin_amdgcn_mfma_f32_16x16x32_bf16(vfr[g][et], pf.v, o[et], 0, 0, 0);
      }
      if (jc == 8) {
        float lt = lrun + __shfl_xor(lrun, 16); lt += __shfl_xor(lt, 32);
        const float inv = 1.f / lt;
#pragma unroll
        for (int et = 0; et < 4; ++et) {
          f32x4 v = o[et]; v.x *= inv; v.y *= inv; v.z *= inv; v.w *= inv;
          { uint2 ov; ov.x = pk2(v.x, v.y); ov.y = pk2(v.z, v.w); *(uint2*)(ATT + (size_t)(t0 + iq) * 384 + h * 64 + et * 16 + fq * 4) = ov; }
        }
      }
    };
#pragma unroll 1
    for (int st0 = 0; st0 < nst; st0 += 2) {
      { const int st = st0;
        if (st + 2 < nst) ATTN_LOAD(sa, st + 2);
        attn_compute(st);
        if (st + 1 < nst) ATTN_WRITE(sb, (st + 1) & 1);
        __syncthreads(); }
      if (st0 + 1 < nst) { const int st = st0 + 1;
        if (st + 2 < nst) ATTN_LOAD(sb, st + 2);
        attn_compute(st);
        if (st + 1 < nst) ATTN_WRITE(sa, (st + 1) & 1);
        __syncthreads(); }
    }
#undef ATTN_LOAD
#undef ATTN_WRITE
  }
  __syncthreads();
}

__device__ __forceinline__ void ssm_bu32(const bf16_t* __restrict__ bbh_g, const bf16_t* __restrict__ urow, int lane,
                                         f32x16& lo_re, f32x16& hi_re, f32x16& lo_im, f32x16& hi_im) {
  const int hf = lane >> 5;
  const bf16x8 ub = *(const bf16x8*)(urow + 8 * hf);
  f32x16 z;
#pragma unroll
  for (int r = 0; r < 16; ++r) z[r] = 0.f;
  const bf16x8 a0r = *(const bf16x8*)(bbh_g + (size_t)(0 * 64 + lane) * 8), a1r = *(const bf16x8*)(bbh_g + (size_t)(1 * 64 + lane) * 8);
  const bf16x8 a0i = *(const bf16x8*)(bbh_g + (size_t)(2 * 64 + lane) * 8), a1i = *(const bf16x8*)(bbh_g + (size_t)(3 * 64 + lane) * 8);
  lo_re = __builtin_amdgcn_mfma_f32_32x32x16_bf16(ub, a0r, z, 0, 0, 0); hi_re = __builtin_amdgcn_mfma_f32_32x32x16_bf16(ub, a1r, z, 0, 0, 0);
  lo_im = __builtin_amdgcn_mfma_f32_32x32x16_bf16(ub, a0i, z, 0, 0, 0); hi_im = __builtin_amdgcn_mfma_f32_32x32x16_bf16(ub, a1i, z, 0, 0, 0);
#pragma unroll
  for (int r = 0; r < 16; ++r) {
    const auto s1 = __builtin_amdgcn_permlane32_swap(__float_as_uint(lo_re[r]), __float_as_uint(hi_re[r]), false, false);
    lo_re[r] = __uint_as_float(s1[0]); hi_re[r] = __uint_as_float(s1[1]);
    const auto s2 = __builtin_amdgcn_permlane32_swap(__float_as_uint(lo_im[r]), __float_as_uint(hi_im[r]), false, false);
    lo_im[r] = __uint_as_float(s2[0]); hi_im[r] = __uint_as_float(s2[1]);
  }
}
__device__ __forceinline__ void rotary_frag(const bf16x8 x0, const bf16x8 x1, const float* RC, const float* RS, int pos, int fq, float scale, bf16x8& o0, bf16x8& o1) {
  const f32x4 c0 = *(const f32x4*)(RC + pos * 32 + 8 * fq), c1 = *(const f32x4*)(RC + pos * 32 + 8 * fq + 4);
  const f32x4 s0 = *(const f32x4*)(RS + pos * 32 + 8 * fq), s1 = *(const f32x4*)(RS + pos * 32 + 8 * fq + 4);
  const float cc[8] = {c0.x, c0.y, c0.z, c0.w, c1.x, c1.y, c1.z, c1.w}, sn[8] = {s0.x, s0.y, s0.z, s0.w, s1.x, s1.y, s1.z, s1.w};
  union { bf16x8 v; unsigned u[4]; } r0, r1;
#pragma unroll
  for (int q = 0; q < 4; ++q) {
    const float a0 = bf2f((bf16_t)x0[2 * q]) * scale, a1 = bf2f((bf16_t)x0[2 * q + 1]) * scale, b0 = bf2f((bf16_t)x1[2 * q]) * scale, b1 = bf2f((bf16_t)x1[2 * q + 1]) * scale;
    r0.u[q] = pk2(a0 * cc[2 * q] - b0 * sn[2 * q], a1 * cc[2 * q + 1] - b1 * sn[2 * q + 1]);
    r1.u[q] = pk2(a0 * sn[2 * q] + b0 * cc[2 * q], a1 * sn[2 * q + 1] + b1 * cc[2 * q + 1]);
  }
  o0 = r0.v; o1 = r1.v;
}
__device__ void mix_local_phase(const Params& p, int l, unsigned char* smem) {
  const CParamsP pp = launder_kargs();
  GAS unsigned char* const ws = launder_ptr(pp->ws); const int tidx = launder_tid();
  const bf16_t* PROJ = (const bf16_t*)(ws + WS_PROJ); const bf16_t* VTR = (const bf16_t*)(ws + WS_VTR);
  const float* RC = (const float*)(ws + WS_ROTC); const float* RS = (const float*)(ws + WS_ROTS);
  bf16_t* YINT = (bf16_t*)(ws + WS_YINT); float* UPDT = (float*)(ws + WS_UPD);
  const float* SA = (const float*)(ws + WS_SA) + (size_t)l * 16 * 64 * 2; const bf16_t* BBH = (const bf16_t*)(ws + WS_BBH) + (size_t)l * 16 * 2 * 64 * 16;
  float* SEND = (float*)(ws + WS_SEND);
  const int tid = tidx, lane = tid & 63, wid = tid >> 6, fr = lane & 15, fq = lane >> 4;
  bf16_t* KT = (bf16_t*)smem;
  float* rcL = (float*)(smem + 55296); float* rsL = rcL + 2048;
  for (int it_ = blockIdx.x; it_ < 256; it_ += gridDim.x) {
    const int item = ((it_ & 7) << 5) | (it_ >> 3);
    const int b = item >> 7, n = item & 127, t0 = b * 8192 + n * 64;
    __syncthreads();
#pragma unroll
    for (int i = 0; i < 4; ++i) { rcL[tid + NT * i] = RC[n * 2048 + tid + NT * i]; rsL[tid + NT * i] = RS[n * 2048 + tid + NT * i]; }
    __syncthreads();
#pragma unroll 1
    for (int k3 = 0; k3 < 3; ++k3) {
      const int task = wid * 3 + k3, h = task >> 2, tb = task & 3;
      const int i = 16 * tb + fr;
      const float lg2 = log2f(1.f - exp2f(-5.f - (float)h));
      bf16x8 qraw[2], kraw[2][2][2], vraw[2][4];
      {
        const bf16_t* qp = PROJ + (size_t)(t0 + i) * INCP + C_QR + h * 64 + 8 * fq;
        qraw[0] = *(const bf16x8*)qp; qraw[1] = *(const bf16x8*)(qp + 32);
#pragma unroll
        for (int g = 0; g < 2; ++g) {
#pragma unroll
          for (int tt = 0; tt < 2; ++tt) {
            const int key = 32 * g + 8 * (fr >> 2) + (fr & 3) + 4 * tt;
            const bf16_t* kp = PROJ + (size_t)(t0 + key) * INCP + C_KR + h * 64 + 8 * fq;
            kraw[g][tt][0] = *(const bf16x8*)kp; kraw[g][tt][1] = *(const bf16x8*)(kp + 32);
          }
#pragma unroll
          for (int et = 0; et < 4; ++et) vraw[g][et] = *(const bf16x8*)(VTR + ((size_t)b * 384 + h * 64 + et * 16 + fr) * 8192 + n * 64 + 32 * g + 8 * fq);
        }
      }
      __builtin_amdgcn_sched_barrier(0);
      bf16x8 qf0, qf1;
      rotary_frag(qraw[0], qraw[1], rcL, rsL, i, fq, 1.f, qf0, qf1);
      f32x4 o[4];
#pragma unroll
      for (int et = 0; et < 4; ++et) o[et] = (f32x4){0.f, 0.f, 0.f, 0.f};
#pragma unroll
      for (int g = 0; g < 2; ++g) {
        float st[2][4];
#pragma unroll
        for (int tt = 0; tt < 2; ++tt) {
          const int key = 32 * g + 8 * (fr >> 2) + (fr & 3) + 4 * tt;
          bf16x8 kf0, kf1;
          rotary_frag(kraw[g][tt][0], kraw[g][tt][1], rcL, rsL, key, fq, 0.125f, kf0, kf1);
          f32x4 s4 = __builtin_amdgcn_mfma_f32_16x16x32_bf16(kf0, qf0, (f32x4){0.f, 0.f, 0.f, 0.f}, 0, 0, 0);
          s4 = __builtin_amdgcn_mfma_f32_16x16x32_bf16(kf1, qf1, s4, 0, 0, 0);
#pragma unroll
          for (int j = 0; j < 4; ++j) {
            const int kk = 32 * g + 8 * fq + 4 * tt + j;
            const int dij = i > kk ? i - kk : kk - i;
            st[tt][j] = s4[j] * exp2f(lg2 * (float)dij);
          }
          if (tb == 0) {
            const float kd = exp2f(lg2 * (float)(63 - key));
#pragma unroll
            for (int jj = 0; jj < 8; ++jj) {
              KT[(h * 64 + 8 * fq + jj) * 72 + key] = f2bf(bf2f((bf16_t)kf0[jj]) * kd);
              KT[(h * 64 + 32 + 8 * fq + jj) * 72 + key] = f2bf(bf2f((bf16_t)kf1[jj]) * kd);
            }
          }
        }
        union { bf16x8 v; unsigned u[4]; } pf;
        pf.u[0] = pk2(st[0][0], st[0][1]); pf.u[1] = pk2(st[0][2], st[0][3]); pf.u[2] = pk2(st[1][0], st[1][1]); pf.u[3] = pk2(st[1][2], st[1][3]);
#pragma unroll
        for (int et = 0; et < 4; ++et) o[et] = __builtin_amdgcn_mfma_f32_16x16x32_bf16(vraw[g][et], pf.v, o[et], 0, 0, 0);
      }
#pragma unroll
      for (int et = 0; et < 4; ++et) { uint2 ov; ov.x = pk2(o[et].x, o[et].y); ov.y = pk2(o[et].z, o[et].w); *(uint2*)(YINT + (((((size_t)item * 6 + h) * 4 + tb) * 4 + et) * 64 + lane) * 4) = ov; }
    }
    __syncthreads();
#pragma unroll 1
    for (int k3 = 0; k3 < 3; ++k3) {
      const int task = wid * 3 + k3, h = task >> 2, et = task & 3;
      f32x4 acc[4];
#pragma unroll
      for (int dt = 0; dt < 4; ++dt) acc[dt] = (f32x4){0.f, 0.f, 0.f, 0.f};
#pragma unroll
      for (int g = 0; g < 2; ++g) {
        const bf16x8 vf = *(const bf16x8*)(VTR + ((size_t)b * 384 + h * 64 + et * 16 + fr) * 8192 + n * 64 + 32 * g + 8 * fq);
#pragma unroll
        for (int dt = 0; dt < 4; ++dt) {
          const bf16x8 kt = *(const bf16x8*)(KT + (h * 64 + 16 * dt + fr) * 72 + 32 * g + 8 * fq);
          acc[dt] = __builtin_amdgcn_mfma_f32_16x16x32_bf16(kt, vf, acc[dt], 0, 0, 0);
        }
      }
#pragma unroll
      for (int dt = 0; dt < 4; ++dt) *(f32x4*)(UPDT + (((size_t)item * 6 + h) * 64 + 16 * et + fr) * 64 + 16 * dt + 4 * fq) = acc[dt];
    }
#pragma unroll 1
    for (int gi = 0; gi < 2; ++gi) {
      const int g = wid * 2 + gi;
      const float are = SA[(g * 64 + lane) * 2], aim = SA[(g * 64 + lane) * 2 + 1];
      float xr = 0.f, xi = 0.f;
#pragma unroll 1
      for (int blk = 0; blk < 2; ++blk) {
        f32x16 lr, hr, li, hi;
        ssm_bu32(BBH + (size_t)g * 2 * 64 * 16, PROJ + (size_t)(t0 + 32 * blk + (lane & 31)) * INCP + C_US + g * 16, lane, lr, hr, li, hi);
#pragma unroll
        for (int a4 = 0; a4 < 4; ++a4) {
#pragma unroll
          for (int bq = 0; bq < 4; ++bq) { const float nr = are * xr - aim * xi + lr[4 * a4 + bq], ni = are * xi + aim * xr + li[4 * a4 + bq]; xr = nr; xi = ni; }
#pragma unroll
          for (int bq = 0; bq < 4; ++bq) { const float nr = are * xr - aim * xi + hr[4 * a4 + bq], ni = are * xi + aim * xr + hi[4 * a4 + bq]; xr = nr; xi = ni; }
        }
      }
      SEND[(((size_t)item * 16 + g) * 64 + lane) * 2] = xr; SEND[(((size_t)item * 16 + g) * 64 + lane) * 2 + 1] = xi;
    }
  }
}

__device__ void scan_phase(const Params& p, int l) {
  const CParamsP pp = launder_kargs();
  GAS unsigned char* const ws = launder_ptr(pp->ws); const int tidx = launder_tid();
  const float* __restrict__ UPDT = (const float*)(ws + WS_UPD); bf16_t* __restrict__ SPT = (bf16_t*)(ws + WS_SPT);
  const float* __restrict__ SEND = (const float*)(ws + WS_SEND); float* __restrict__ CARRY = (float*)(ws + WS_CARRY);
  const float* SA = (const float*)(ws + WS_SA) + (size_t)l * 16 * 64 * 2;
  const int gtid = blockIdx.x * NT + tidx, gn = gridDim.x * NT;
  for (int idx = gtid; idx < 2 * 6 * 4096 + 2 * 1024; idx += gn) {
    if (idx < 2 * 6 * 4096) {
      const int b = idx / (6 * 4096), r = idx % (6 * 4096), h = r >> 12;
      const float cd = exp2f(64.f * log2f(1.f - exp2f(-5.f - (float)h)));
      const int e_ = (r >> 6) & 63, d_ = r & 63;
      const int spoff = h * 4096 + ((((e_ >> 4) * 2 + (d_ >> 5)) * 64 + ((d_ >> 3) & 3) * 16 + (e_ & 15)) * 8 + (d_ & 7));
      float s = 0.f;
#pragma unroll 1
      for (int nb = 0; nb < NCH; nb += 16) {
        float v[16];
#pragma unroll
        for (int j = 0; j < 16; ++j) v[j] = UPDT[((size_t)(b * NCH + nb + j)) * 6 * 4096 + r];
#pragma unroll
        for (int j = 0; j < 16; ++j) { SPT[((size_t)(b * NCH + nb + j)) * 6 * 4096 + spoff] = f2bf(s); s = cd * s + v[j]; }
      }
    } else {
      const int r2 = idx - 2 * 6 * 4096, b = r2 >> 10, gp = r2 & 1023;
      float ar = SA[gp * 2], ai = SA[gp * 2 + 1];
#pragma unroll
      for (int q = 0; q < 6; ++q) { const float nr = ar * ar - ai * ai, ni = 2.f * ar * ai; ar = nr; ai = ni; }
      float xr = 0.f, xi = 0.f;
#pragma unroll 1
      for (int nb = 0; nb < NCH; nb += 16) {
        float2 v[16];
#pragma unroll
        for (int j = 0; j < 16; ++j) v[j] = *(const float2*)(SEND + (((size_t)(b * NCH + nb + j)) * 1024 + gp) * 2);
#pragma unroll
        for (int j = 0; j < 16; ++j) {
          *(float2*)(CARRY + (((size_t)(b * NCH + nb + j)) * 1024 + gp) * 2) = make_float2(xr, xi);
          const float nr = ar * xr - ai * xi + v[j].x, ni = ar * xi + ai * xr + v[j].y;
          xr = nr; xi = ni;
        }
      }
    }
  }
  if (l + 1 < DEPTH_) convert_tables_fp4(pp, ws, l + 1, gtid, gn);
}

__device__ void mix_final_phase(const Params& p, int l, unsigned char* smem) {
  const CParamsP pp = launder_kargs();
  GAS unsigned char* const ws = launder_ptr(pp->ws); const int tidx = launder_tid();
  const bf16_t* PROJ = (const bf16_t*)(ws + WS_PROJ);
  const float* RC = (const float*)(ws + WS_ROTC); const float* RS = (const float*)(ws + WS_ROTS);
  const bf16_t* YINT = (const bf16_t*)(ws + WS_YINT); const bf16_t* SPT = (const bf16_t*)(ws + WS_SPT);
  const bf16_t* ATT = (const bf16_t*)(ws + WS_ATT);
  const float* SA = (const float*)(ws + WS_SA) + (size_t)l * 16 * 64 * 2; const bf16_t* BBH = (const bf16_t*)(ws + WS_BBH) + (size_t)l * 16 * 2 * 64 * 16;
  const float* CARRY = (const float*)(ws + WS_CARRY);
  const bf16_t* CB = (const bf16_t*)(ws + WS_CB) + (size_t)l * 16 * 16 * 128; const bf16_t* WG = (const bf16_t*)(ws + WS_WGLUT) + (size_t)l * 512 * 256;
  const float* dsk = gin(pp->in[I_SSMD]) + (size_t)l * 256;
  const float* mg = gin(pp->in[I_MGAIN]) + (size_t)l * 1024;
  bf16_t* MRG = (bf16_t*)(ws + WS_ABUF);
  const int tid = tidx, lane = tid & 63, wid = tid >> 6, fr = lane & 15, fq = lane >> 4;
  bf16_t* YS = (bf16_t*)smem;
  float* red = (float*)(smem + 33792);
  bf16_t* XB = (bf16_t*)(smem + 36864 + wid * 8448 + 4096);
  float* rcL = (float*)(smem + 104448); float* rsL = rcL + 2048;
  for (int it_ = blockIdx.x; it_ < 256; it_ += gridDim.x) {
    const int item = ((it_ & 7) << 5) | (it_ >> 3);
    const int b = item >> 7, n = item & 127, t0 = b * 8192 + n * 64;
    __syncthreads();
#pragma unroll
    for (int i = 0; i < 4; ++i) { rcL[tid + NT * i] = RC[n * 2048 + tid + NT * i]; rsL[tid + NT * i] = RS[n * 2048 + tid + NT * i]; }
    __syncthreads();
    {
      float av[8][6], mgl[6];
#pragma unroll
      for (int ii = 0; ii < 8; ++ii)
#pragma unroll
        for (int j = 0; j < 6; ++j) av[ii][j] = bf2f(ATT[(size_t)(t0 + wid * 8 + ii) * 384 + lane + 64 * j]);
#pragma unroll
      for (int j = 0; j < 6; ++j) mgl[j] = mg[lane + 64 * j];
      __builtin_amdgcn_sched_barrier(0);
#pragma unroll
      for (int ii = 0; ii < 8; ++ii) {
        const int t = t0 + wid * 8 + ii;
        float sq = 0.f;
#pragma unroll
        for (int j = 0; j < 6; ++j) sq += av[ii][j] * av[ii][j];
        const float rstd = rsqrtf(wave_sum(sq) * (1.f / 384.f) + EPS_);
#pragma unroll
        for (int j = 0; j < 6; ++j) MRG[(size_t)t * 1024 + lane + 64 * j] = f2bf(av[ii][j] * rstd * mgl[j]);
      }
    }
#pragma unroll 1
    for (int k3 = 0; k3 < 3; ++k3) {
      const int task = wid * 3 + k3, h = task >> 2, tb = task & 3;
      const int i = 16 * tb + fr, t = t0 + i;
      const float lg2 = log2f(1.f - exp2f(-5.f - (float)h));
      bf16x8 qraw[2], spf[4][2]; f32x4 yiv[4], mgq[4]; uint2 grv[4];
      {
        const bf16_t* qp = PROJ + (size_t)t * INCP + C_QR + h * 64 + 8 * fq;
        qraw[0] = *(const bf16x8*)qp; qraw[1] = *(const bf16x8*)(qp + 32);
#pragma unroll
        for (int et = 0; et < 4; ++et) {
          const bf16_t* sp = SPT + ((size_t)item * 6 + h) * 4096 + (size_t)(et * 2) * 512 + lane * 8;
          spf[et][0] = *(const bf16x8*)sp; spf[et][1] = *(const bf16x8*)(sp + 512);
          { const uint2 yr = *(const uint2*)(YINT + (((((size_t)item * 6 + h) * 4 + tb) * 4 + et) * 64 + lane) * 4); yiv[et] = (f32x4){__uint_as_float(yr.x << 16), __uint_as_float(yr.x & 0xffff0000u), __uint_as_float(yr.y << 16), __uint_as_float(yr.y & 0xffff0000u)}; }
          grv[et] = *(const uint2*)(PROJ + (size_t)t * INCP + C_GR + h * 64 + 16 * et + 4 * fq);
          mgq[et] = *(const f32x4*)(mg + 384 + h * 64 + 16 * et + 4 * fq);
        }
      }
      __builtin_amdgcn_sched_barrier(0);
      bf16x8 qf0, qf1;
      rotary_frag(qraw[0], qraw[1], rcL, rsL, i, fq, 1.f, qf0, qf1);
      f32x4 o[4];
#pragma unroll
      for (int et = 0; et < 4; ++et) {
        o[et] = __builtin_amdgcn_mfma_f32_16x16x32_bf16(spf[et][0], qf0, (f32x4){0.f, 0.f, 0.f, 0.f}, 0, 0, 0);
        o[et] = __builtin_amdgcn_mfma_f32_16x16x32_bf16(spf[et][1], qf1, o[et], 0, 0, 0);
      }
      const float qd = exp2f(lg2 * (float)(i + 1));
      float y[16]; float s1 = 0.f;
#pragma unroll
      for (int et = 0; et < 4; ++et) {
        const f32x4 yi = yiv[et];
        y[4 * et] = yi.x + qd * o[et].x; y[4 * et + 1] = yi.y + qd * o[et].y; y[4 * et + 2] = yi.z + qd * o[et].z; y[4 * et + 3] = yi.w + qd * o[et].w;
        s1 += (y[4 * et] + y[4 * et + 1]) + (y[4 * et + 2] + y[4 * et + 3]);
      }
      s1 += __shfl_xor(s1, 16); s1 += __shfl_xor(s1, 32);
      const float mu = s1 * (1.f / 64.f);
      float s2 = 0.f;
#pragma unroll
      for (int q = 0; q < 16; ++q) { y[q] -= mu; s2 += y[q] * y[q]; }
      s2 += __shfl_xor(s2, 16); s2 += __shfl_xor(s2, 32);
      const float rstd = rsqrtf(s2 * (1.f / 64.f) + EPS_);
#pragma unroll
      for (int et = 0; et < 4; ++et) {
        const int c = h * 64 + 16 * et + 4 * fq;
        const uint2 gr = grv[et];
        const float g0 = __uint_as_float(gr.x << 16), g1 = __uint_as_float(gr.x & 0xffff0000u), g2 = __uint_as_float(gr.y << 16), g3 = __uint_as_float(gr.y & 0xffff0000u);
        const f32x4 mgv = mgq[et];
        uint2 ov;
        ov.x = pk2(y[4 * et] * rstd * (g0 * sigmoid_f(g0)) * mgv.x, y[4 * et + 1] * rstd * (g1 * sigmoid_f(g1)) * mgv.y);
        ov.y = pk2(y[4 * et + 2] * rstd * (g2 * sigmoid_f(g2)) * mgv.z, y[4 * et + 3] * rstd * (g3 * sigmoid_f(g3)) * mgv.w);
        *(uint2*)(MRG + (size_t)t * 1024 + 384 + c) = ov;
      }
    }
#pragma unroll 1
    for (int gi = 0; gi < 2; ++gi) {
      const int g = wid * 2 + gi;
      const float are = SA[(g * 64 + lane) * 2], aim = SA[(g * 64 + lane) * 2 + 1];
      float xr = CARRY[(((size_t)item * 16 + g) * 64 + lane) * 2], xi = CARRY[(((size_t)item * 16 + g) * 64 + lane) * 2 + 1];
      bf16x8 cb[4];
#pragma unroll
      for (int ks = 0; ks < 4; ++ks) cb[ks] = *(const bf16x8*)(CB + (((size_t)g * 4 + ks) * 64 + lane) * 8);
      const float dv = dsk[g * 16 + fr];
#pragma unroll 1
      for (int blk = 0; blk < 2; ++blk) {
        f32x16 lr, hr, li, hi;
        bf16_t uraw[2][4];
#pragma unroll
        for (int half = 0; half < 2; ++half)
#pragma unroll
          for (int j = 0; j < 4; ++j) uraw[half][j] = PROJ[(size_t)(t0 + 32 * blk + 16 * half + 4 * fq + j) * INCP + C_US + g * 16 + fr];
        ssm_bu32(BBH + (size_t)g * 2 * 64 * 16, PROJ + (size_t)(t0 + 32 * blk + (lane & 31)) * INCP + C_US + g * 16, lane, lr, hr, li, hi);
#pragma unroll
        for (int half = 0; half < 2; ++half) {
#pragma unroll
          for (int a2 = 0; a2 < 2; ++a2) {
            const int a4 = 2 * half + a2;
#pragma unroll
            for (int bq = 0; bq < 4; ++bq) {
              const float nr = are * xr - aim * xi + lr[4 * a4 + bq], ni = are * xi + aim * xr + li[4 * a4 + bq]; xr = nr; xi = ni;
              XB[(8 * a2 + bq) * 136 + lane] = f2bf(xr); XB[(8 * a2 + bq) * 136 + 64 + lane] = f2bf(xi);
            }
#pragma unroll
            for (int bq = 0; bq < 4; ++bq) {
              const float nr = are * xr - aim * xi + hr[4 * a4 + bq], ni = are * xi + aim * xr + hi[4 * a4 + bq]; xr = nr; xi = ni;
              XB[(8 * a2 + 4 + bq) * 136 + lane] = f2bf(xr); XB[(8 * a2 + 4 + bq) * 136 + 64 + lane] = f2bf(xi);
            }
          }
          f32x4 acc = (f32x4){0.f, 0.f, 0.f, 0.f};
#pragma unroll
          for (int ks = 0; ks < 4; ++ks) {
            const bf16x8 af = *(const bf16x8*)(XB + fr * 136 + 32 * ks + 8 * fq);
            acc = __builtin_amdgcn_mfma_f32_16x16x32_bf16(af, cb[ks], acc, 0, 0, 0);
          }
#pragma unroll
          for (int j = 0; j < 4; ++j) {
            const int i = 32 * blk + 16 * half + 4 * fq + j;
            const float yv = acc[j] + dv * bf2f(uraw[half][j]);
            YS[i * 264 + g * 16 + fr] = f2bf(gelu_tanh(yv));
          }
        }
      }
    }
    __syncthreads();
    {
      const int n0 = 32 * wid;
      f32x4 a1[4][2], a2[4][2];
#pragma unroll
      for (int mt = 0; mt < 4; ++mt)
#pragma unroll
        for (int nt = 0; nt < 2; ++nt) { a1[mt][nt] = (f32x4){0.f, 0.f, 0.f, 0.f}; a2[mt][nt] = (f32x4){0.f, 0.f, 0.f, 0.f}; }
#pragma unroll 1
      for (int kh = 0; kh < 2; ++kh) {
        bf16x8 w1[4][2], w2[4][2];
#pragma unroll
        for (int k4 = 0; k4 < 4; ++k4)
#pragma unroll
          for (int nt = 0; nt < 2; ++nt) {
            w1[k4][nt] = *(const bf16x8*)(WG + ((((size_t)wid * 8 + 4 * kh + k4) * 2 + 0) * 2 + nt) * 512 + lane * 8);
            w2[k4][nt] = *(const bf16x8*)(WG + ((((size_t)wid * 8 + 4 * kh + k4) * 2 + 1) * 2 + nt) * 512 + lane * 8);
          }
        __builtin_amdgcn_sched_barrier(0);
#pragma unroll
        for (int k4 = 0; k4 < 4; ++k4) {
          const int ks = 4 * kh + k4;
          bf16x8 yb[4];
#pragma unroll
          for (int mt = 0; mt < 4; ++mt) yb[mt] = *(const bf16x8*)(YS + (16 * mt + fr) * 264 + 32 * ks + 8 * fq);
#pragma unroll
          for (int mt = 0; mt < 4; ++mt)
#pragma unroll
            for (int nt = 0; nt < 2; ++nt) {
              a1[mt][nt] = __builtin_amdgcn_mfma_f32_16x16x32_bf16(w1[k4][nt], yb[mt], a1[mt][nt], 0, 0, 0);
              a2[mt][nt] = __builtin_amdgcn_mfma_f32_16x16x32_bf16(w2[k4][nt], yb[mt], a2[mt][nt], 0, 0, 0);
            }
        }
      }
#pragma unroll
      for (int mt = 0; mt < 4; ++mt) {
        float sq = 0.f;
#pragma unroll
        for (int nt = 0; nt < 2; ++nt) {
          f32x4 z = a1[mt][nt]; const f32x4 zg = a2[mt][nt];
          z.x *= sigmoid_f(zg.x); z.y *= sigmoid_f(zg.y); z.z *= sigmoid_f(zg.z); z.w *= sigmoid_f(zg.w);
          a1[mt][nt] = z; sq += z.x * z.x + z.y * z.y + z.z * z.z + z.w * z.w;
        }
        sq += __shfl_xor(sq, 16); sq += __shfl_xor(sq, 32);
        if (fq == 0) red[wid * 64 + 16 * mt + fr] = sq;
      }
      __syncthreads();
#pragma unroll
      for (int mt = 0; mt < 4; ++mt) {
        const int i = 16 * mt + fr, t = t0 + i;
        float tot = 0.f;
#pragma unroll
        for (int w8 = 0; w8 < 8; ++w8) tot += red[w8 * 64 + i];
        const float rstd = rsqrtf(tot * (1.f / 256.f) + EPS_);
#pragma unroll
        for (int nt = 0; nt < 2; ++nt) {
          const int c = n0 + 16 * nt + 4 * fq;
          const f32x4 mgv = *(const f32x4*)(mg + 768 + c); const f32x4 z = a1[mt][nt];
          uint2 ov; ov.x = pk2(z.x * rstd * mgv.x, z.y * rstd * mgv.y); ov.y = pk2(z.z * rstd * mgv.z, z.w * rstd * mgv.w);
          *(uint2*)(MRG + (size_t)t * 1024 + 768 + c) = ov;
        }
      }
    }
  }
}

typedef float f32x2 __attribute__((ext_vector_type(2)));
__device__ __forceinline__ float dot16_fp4(const uint2 u, const f32x2 (&hv)[8]) {
  f32x2 d = __builtin_amdgcn_cvt_scalef32_pk_f32_fp4(u.x, 1.0f, 0) * hv[0];
  d += __builtin_amdgcn_cvt_scalef32_pk_f32_fp4(u.x, 1.0f, 1) * hv[1];
  d += __builtin_amdgcn_cvt_scalef32_pk_f32_fp4(u.x, 1.0f, 2) * hv[2];
  d += __builtin_amdgcn_cvt_scalef32_pk_f32_fp4(u.x, 1.0f, 3) * hv[3];
  d += __builtin_amdgcn_cvt_scalef32_pk_f32_fp4(u.y, 1.0f, 0) * hv[4];
  d += __builtin_amdgcn_cvt_scalef32_pk_f32_fp4(u.y, 1.0f, 1) * hv[5];
  d += __builtin_amdgcn_cvt_scalef32_pk_f32_fp4(u.y, 1.0f, 2) * hv[6];
  d += __builtin_amdgcn_cvt_scalef32_pk_f32_fp4(u.y, 1.0f, 3) * hv[7];
  return d.x + d.y;
}
__device__ __forceinline__ void axpy16_fp4(const uint2 v, const float w, f32x2 (&acc)[8]) {
  const f32x2 w2 = (f32x2){w, w};
  acc[0] += w2 * __builtin_amdgcn_cvt_scalef32_pk_f32_fp4(v.x, 1.0f, 0);
  acc[1] += w2 * __builtin_amdgcn_cvt_scalef32_pk_f32_fp4(v.x, 1.0f, 1);
  acc[2] += w2 * __builtin_amdgcn_cvt_scalef32_pk_f32_fp4(v.x, 1.0f, 2);
  acc[3] += w2 * __builtin_amdgcn_cvt_scalef32_pk_f32_fp4(v.x, 1.0f, 3);
  acc[4] += w2 * __builtin_amdgcn_cvt_scalef32_pk_f32_fp4(v.y, 1.0f, 0);
  acc[5] += w2 * __builtin_amdgcn_cvt_scalef32_pk_f32_fp4(v.y, 1.0f, 1);
  acc[6] += w2 * __builtin_amdgcn_cvt_scalef32_pk_f32_fp4(v.y, 1.0f, 2);
  acc[7] += w2 * __builtin_amdgcn_cvt_scalef32_pk_f32_fp4(v.y, 1.0f, 3);
}
__device__ __forceinline__ float vmaxf(float a, float b) { float r; asm("v_max_f32 %0, %1, %2" : "=v"(r) : "v"(a), "v"(b)); return r; }
__device__ __forceinline__ float vminf(float a, float b) { float r; asm("v_min_f32 %0, %1, %2" : "=v"(r) : "v"(a), "v"(b)); return r; }
__device__ __forceinline__ void cx(float& hi, float& lo) { const float a = hi, b = lo; hi = vmaxf(a, b); lo = vminf(a, b); }
__device__ __forceinline__ void cx2(float& kh, int& ph, float& kl, int& pl) {
  const float a = kh, b = kl; const int pa = ph, pb = pl; const bool c = a >= b;
  kh = vmaxf(a, b); kl = vminf(a, b); ph = c ? pa : pb; pl = c ? pb : pa;
}
__device__ __forceinline__ void bitonic_sort16_desc(float (&v)[16]) {
#pragma unroll
  for (int k = 2; k <= 16; k <<= 1)
#pragma unroll
    for (int j = k >> 1; j > 0; j >>= 1)
#pragma unroll
      for (int i = 0; i < 16; ++i) {
        const int l = i ^ j;
        if (l > i) { if ((i & k) == 0) cx(v[i], v[l]); else cx(v[l], v[i]); }
      }
}
__device__ __forceinline__ void bitonic_merge16_desc(float (&v)[16]) {
#pragma unroll
  for (int j = 8; j > 0; j >>= 1)
#pragma unroll
    for (int i = 0; i < 16; ++i) { const int l = i ^ j; if (l > i) cx(v[i], v[l]); }
}
__device__ __forceinline__ void top16_merge(float (&a)[16], const float (&b)[16]) {
#pragma unroll
  for (int i = 0; i < 16; ++i) a[i] = vmaxf(a[i], b[15 - i]);
  bitonic_merge16_desc(a);
}
template <int M> __device__ __forceinline__ void top16_merge_chain(float (&k)[16], int (&q)[16], const float (&xk)[M], const int (&xq)[M]) {
#pragma unroll
  for (int i = 16 - M; i < 16; ++i) { const float a = k[i], b = xk[15 - i]; const bool c = a >= b; k[i] = vmaxf(a, b); q[i] = c ? q[i] : xq[15 - i]; }
#pragma unroll
  for (int j = 8; j > 0; j >>= 1)
#pragma unroll
    for (int i = 0; i < 16; ++i) { const int l = i ^ j; if (l > i) cx2(k[i], q[i], k[l], q[l]); }
}

typedef unsigned u32x4v __attribute__((ext_vector_type(4)));
__device__ __forceinline__ void peer_req_rows16(u32x4v (&Q)[8], const unsigned char* tab, int e, int hi5, unsigned lane16) {
#pragma unroll
  for (int r = 0; r < 8; ++r) {
    const int ea = __builtin_amdgcn_readlane(e, 2 * r), eb = __builtin_amdgcn_readlane(e, 2 * r + 1);
    const unsigned off = (unsigned)(hi5 ? eb : ea) * 512u + lane16;
    Q[r] = *(const u32x4v*)(tab + off);
  }
}
__device__ __forceinline__ void peer_req_rows8(u32x4v (&Q)[8], const unsigned char* tab, int e, unsigned lane8) {
#pragma unroll
  for (int r = 0; r < 16; ++r) {
    const unsigned off = (unsigned)__builtin_amdgcn_readlane(e, r) * 512u + lane8;
    const uint2 t = *(const uint2*)(tab + off);
    Q[r >> 1][2 * (r & 1)] = t.x; Q[r >> 1][2 * (r & 1) + 1] = t.y;
  }
}
__device__ void peer_phase(const Params& p, int l, bool last, unsigned char* smem) {
  const CParamsP pp = launder_kargs();
  GAS unsigned char* const ws = launder_ptr(pp->ws); const int tidx = launder_tid();
  bf16_t* HF = (bf16_t*)(ws + WS_ABUF); bf16_t* X = (bf16_t*)(ws + WS_X);
  const bf16_t* SC8 = (const bf16_t*)(ws + WS_SC);
  const uint2* U4 = (const uint2*)(ws + WS_PU8) + (size_t)l * 16384 * 64; const uint2* V4 = (const uint2*)(ws + WS_PV8) + (size_t)l * 16384 * 64;
  const float* g2 = (const float*)(ws + WS_MOD) + (size_t)l * 2 * 6144 + 5120;
  const bf16_t* XG = (const bf16_t*)(ws + WS_XG); const float* SSQ = (const float*)(ws + WS_SSQ); const float* sh2 = (const float*)(ws + WS_MOD) + (size_t)l * 2 * 6144 + 3072;
  const int ln = last ? l : l + 1;
  const float* nsh = (const float*)(ws + WS_MOD) + (size_t)ln * 2 * 6144; const float* nsc = nsh + 1024;
  const float* ngain = gin(pp->in[I_NMIX]) + (size_t)ln * 1024;
  const int lane = tidx & 63, wid = tidx >> 6;
  const int rL = ((lane >> 5) & 1) * 8 + ((lane >> 4) & 1) * 4 + ((lane >> 3) & 1) * 2 + ((lane >> 2) & 1);
  const bool hi5 = (lane & 32) != 0, hi4 = (lane & 16) != 0, hi3 = (lane & 8) != 0, hi2 = (lane & 4) != 0;
  int* idxL = (int*)smem;
  float* cst = (float*)(smem + 109568);
  for (int it_ = blockIdx.x; it_ < T_ / 64; it_ += gridDim.x) {
    const int item = ((it_ & 7) << 5) | (it_ >> 3);
    const int t0 = item * 64;
    __syncthreads();
    {
      const int bb = t0 >> 13;
      for (int c = tidx; c < 1024; c += NT) {
        const int o = ((c >> 2) & 3) * 256 + (c >> 4) * 4 + (c & 3);
        cst[o] = g2[bb * 6144 + c] * 0.25f;
        cst[1024 + o] = last ? gin(pp->in[I_FNORM])[c] : ngain[c] * (1.f + nsc[bb * 6144 + c]);
        cst[2048 + o] = last ? 0.f : nsh[bb * 6144 + c];
        cst[3072 + o] = sh2[bb * 6144 + c];
      }
    }
    {
      int lane_o = lane; asm volatile("" : "+v"(lane_o));
      const int tg = wid & 1, hp = wid >> 1, hf = lane_o >> 5, tl = 32 * tg + (lane_o & 31);
      float F[2][16];
#pragma unroll
      for (int sd = 0; sd < 2; ++sd) {
        float Lh[2][16];
#pragma unroll
        for (int hh = 0; hh < 2; ++hh) {
          const int hs = 2 * (2 * hp + hh) + sd;
          float top[16];
          const bf16_t* scp = SC8 + (((size_t)(hs * 16 + 8 * hf)) * T_ + (t0 + tl)) * 8;
          uint4 sv[8];
#pragma unroll
          for (int kq = 0; kq < 8; ++kq) sv[kq] = *(const uint4*)(scp + (size_t)kq * T_ * 8);
          __builtin_amdgcn_sched_barrier(0);
#pragma unroll
          for (int kt = 0; kt < 4; ++kt) {
            float g[16];
#pragma unroll
            for (int kq = 0; kq < 2; ++kq) {
              const uint4 v8 = sv[2 * kt + kq];
              const unsigned wv[4] = {v8.x, v8.y, v8.z, v8.w};
#pragma unroll
              for (int j = 0; j < 4; ++j) {
                const int key = 64 * hf + 16 * kt + 8 * kq + 2 * j;
                g[8 * kq + 2 * j] = __uint_as_float((wv[j] << 16) | (unsigned)key);
                g[8 * kq + 2 * j + 1] = __uint_as_float((wv[j] & 0xffff0000u) | (unsigned)(key + 1));
              }
            }
            bitonic_sort16_desc(g);
            if (kt == 0) {
#pragma unroll
              for (int r = 0; r < 16; ++r) top[r] = g[r];
            } else top16_merge(top, g);
            __builtin_amdgcn_sched_barrier(0);
          }
#pragma unroll
          for (int r = 0; r < 16; ++r) Lh[hh][r] = top[r];
          __builtin_amdgcn_sched_barrier(0);
        }
#pragma unroll
        for (int r = 0; r < 16; ++r) {
          const auto sw = __builtin_amdgcn_permlane32_swap(__float_as_uint(Lh[0][r]), __float_as_uint(Lh[1][r]), false, false);
          Lh[0][r] = __uint_as_float(sw[0]); Lh[1][r] = __uint_as_float(sw[1]);
        }
        top16_merge(Lh[0], Lh[1]);
#pragma unroll
        for (int r = 0; r < 16; ++r) F[sd][r] = Lh[0][r];
        __builtin_amdgcn_sched_barrier(0);
      }
      int ia[16], ib[16];
#pragma unroll
      for (int r = 0; r < 16; ++r) { ia[r] = (int)(__float_as_uint(F[0][r]) & 127u) << 7; ib[r] = (int)(__float_as_uint(F[1][r]) & 127u); }
      float k[16]; int q[16];
#pragma unroll
      for (int j = 0; j < 16; ++j) { k[j] = F[0][0] + F[1][j]; q[j] = ia[0] | ib[j]; }
      { float xk[8]; int xq[8];
#pragma unroll
        for (int j = 0; j < 8; ++j) { xk[j] = F[0][1] + F[1][j]; xq[j] = ia[1] | ib[j]; }
        top16_merge_chain<8>(k, q, xk, xq); }
      { float xk[5]; int xq[5];
#pragma unroll
        for (int j = 0; j < 5; ++j) { xk[j] = F[0][2] + F[1][j]; xq[j] = ia[2] | ib[j]; }
        top16_merge_chain<5>(k, q, xk, xq); }
      { float xk[4]; int xq[4];
#pragma unroll
        for (int j = 0; j < 4; ++j) { xk[j] = F[0][3] + F[1][j]; xq[j] = ia[3] | ib[j]; }
        top16_merge_chain<4>(k, q, xk, xq); }
      { float xk[3]; int xq[3];
#pragma unroll
        for (int j = 0; j < 3; ++j) { xk[j] = F[0][4] + F[1][j]; xq[j] = ia[4] | ib[j]; }
        top16_merge_chain<3>(k, q, xk, xq); }
      { float xk[11]; int xq[11];
#pragma unroll
        for (int i = 0; i < 11; ++i) { xk[i] = F[0][5 + i] + F[1][0]; xq[i] = ia[5 + i] | ib[0]; }
        top16_merge_chain<11>(k, q, xk, xq); }
      { float xk[3]; int xq[3];
#pragma unroll
        for (int i = 0; i < 3; ++i) { xk[i] = F[0][5 + i] + F[1][1]; xq[i] = ia[5 + i] | ib[1]; }
        top16_merge_chain<3>(k, q, xk, xq); }
      float e[16]; float es = 0.f;
#pragma unroll
      for (int i = 0; i < 16; ++i) { e[i] = __expf(k[i] - k[0]); es += e[i]; }
      const float ies = 1.f / es;
      const int h = 2 * hp + hf;
#pragma unroll
      for (int i = 0; i < 16; ++i) idxL[tl * 132 + h * 16 + i] = (int)(((unsigned)f2bf(e[i] * ies) << 16) | (unsigned)q[i]);
    }
    __syncthreads();
    {
      const int fr = lane & 15, fq = lane >> 4, jsel = lane & 3, tlb = wid * 8;
      unsigned char* hq4 = smem + 33792 + wid * 1024;
      unsigned char* ust = smem + 41984 + wid * 8448;
      const unsigned lane8 = (unsigned)lane * 8u;
      const int hi5 = lane >> 5; const unsigned lane16 = (unsigned)(lane & 31) * 16u;
#define PEER_REQ_IDX(sn_) (idxL[(tlb + ((min((sn_), 127) & 63) >> 3)) * 132 + 16 * (min((sn_), 127) & 7) + fr] & 0xffff)
#define PEER_REQ_U(Q, e_) peer_req_rows16(Q, (const unsigned char*)U4, (e_), hi5, lane16)
      u32x4v qa[8], qb[8];
      {
        const int e0 = PEER_REQ_IDX(0), e1 = PEER_REQ_IDX(1);
        PEER_REQ_U(qa, e0);
        __builtin_amdgcn_sched_barrier(0);
        PEER_REQ_U(qb, e1);
        __builtin_amdgcn_sched_barrier(0);
      }
      {
        const float rs_lane = rsqrtf(ssq_total(SSQ, t0 + tlb + (lane & 7)) * (1.f / 1024.f) + EPS_);
        uint4 nh0 = *(const uint4*)(XG + (size_t)(t0 + tlb) * 1024 + lane * 16), nh1 = *(const uint4*)(XG + (size_t)(t0 + tlb) * 1024 + lane * 16 + 8);
#pragma unroll 1
        for (int ii = 0; ii < 8; ++ii) {
          const int tl = tlb + ii, t = t0 + tl;
          uint4 hB1[8], hB2[8];
          {
            const unsigned hw[8] = {nh0.x, nh0.y, nh0.z, nh0.w, nh1.x, nh1.y, nh1.z, nh1.w};
            const float rs = __int_as_float(__builtin_amdgcn_readlane(__float_as_int(rs_lane), ii));
            unsigned q1[2] = {0u, 0u}, q2[2] = {0u, 0u};
#pragma unroll
            for (int qq = 0; qq < 4; ++qq) {
              const f32x4 sh = *(const f32x4*)(cst + 3072 + qq * 256 + lane * 4);
              float hvv[4];
              hvv[0] = __uint_as_float(hw[2 * qq] << 16) * rs + sh.x; hvv[1] = __uint_as_float(hw[2 * qq] & 0xffff0000u) * rs + sh.y;
              hvv[2] = __uint_as_float(hw[2 * qq + 1] << 16) * rs + sh.z; hvv[3] = __uint_as_float(hw[2 * qq + 1] & 0xffff0000u) * rs + sh.w;
#pragma unroll
              for (int pr = 0; pr < 2; ++pr) {
                const int byte_sel = (2 * qq + pr) & 3, wd = (2 * qq + pr) >> 2;
                const float x0 = fminf(fmaxf(hvv[2 * pr], -6.f), 6.f), x1 = fminf(fmaxf(hvv[2 * pr + 1], -6.f), 6.f);
                unsigned t1 = 0u;
                if (byte_sel == 0) t1 = __builtin_amdgcn_cvt_scalef32_pk_fp4_f32(0u, x0, x1, 1.0f, 0);
                else if (byte_sel == 1) t1 = __builtin_amdgcn_cvt_scalef32_pk_fp4_f32(0u, x0, x1, 1.0f, 1);
                else if (byte_sel == 2) t1 = __builtin_amdgcn_cvt_scalef32_pk_fp4_f32(0u, x0, x1, 1.0f, 2);
                else t1 = __builtin_amdgcn_cvt_scalef32_pk_fp4_f32(0u, x0, x1, 1.0f, 3);
                f32x2 back;
                if (byte_sel == 0) back = __builtin_amdgcn_cvt_scalef32_pk_f32_fp4(t1, 1.0f, 0);
                else if (byte_sel == 1) back = __builtin_amdgcn_cvt_scalef32_pk_f32_fp4(t1, 1.0f, 1);
                else if (byte_sel == 2) back = __builtin_amdgcn_cvt_scalef32_pk_f32_fp4(t1, 1.0f, 2);
                else back = __builtin_amdgcn_cvt_scalef32_pk_f32_fp4(t1, 1.0f, 3);
                const float r0 = fminf(fmaxf((hvv[2 * pr] - back.x) * 8.f, -6.f), 6.f), r1 = fminf(fmaxf((hvv[2 * pr + 1] - back.y) * 8.f, -6.f), 6.f);
                unsigned t2 = 0u;
                if (byte_sel == 0) t2 = __builtin_amdgcn_cvt_scalef32_pk_fp4_f32(0u, r0, r1, 1.0f, 0);
                else if (byte_sel == 1) t2 = __builtin_amdgcn_cvt_scalef32_pk_fp4_f32(0u, r0, r1, 1.0f, 1);
                else if (byte_sel == 2) t2 = __builtin_amdgcn_cvt_scalef32_pk_fp4_f32(0u, r0, r1, 1.0f, 2);
                else t2 = __builtin_amdgcn_cvt_scalef32_pk_fp4_f32(0u, r0, r1, 1.0f, 3);
                q1[wd] |= t1; q2[wd] |= t2;
              }
            }
            *(uint2*)(hq4 + lane * 8) = make_uint2(q1[0], q1[1]);
            *(uint2*)(hq4 + 512 + lane * 8) = make_uint2(q2[0], q2[1]);
#pragma unroll
            for (int kc = 0; kc < 8; ++kc) { hB1[kc] = *(const uint4*)(hq4 + 64 * kc + 16 * fq); hB2[kc] = *(const uint4*)(hq4 + 512 + 64 * kc + 16 * fq); }
          }
          { const int tn = t + (ii < 7 ? 1 : 0);
            nh0 = *(const uint4*)(XG + (size_t)tn * 1024 + lane * 16); nh1 = *(const uint4*)(XG + (size_t)tn * 1024 + lane * 16 + 8); }
          __builtin_amdgcn_sched_barrier(0);
#define PEER_U_STEP(R, bt_) do { const int _bt = (bt_), _sn = ii * 8 + _bt + 2; \
            _Pragma("unroll") for (int r = 0; r < 8; ++r) *(u32x4v*)(ust + (2 * r + hi5) * 528 + lane16) = R[r];        \
            if (_sn < 64) { const int _en = PEER_REQ_IDX(_sn); PEER_REQ_U(R, _en); } else { const int _en = PEER_REQ_IDX(_sn); peer_req_rows8(R, (const unsigned char*)V4, _en, lane8); }        \
            __builtin_amdgcn_sched_barrier(0); \
            uint4 ua[8]; \
            _Pragma("unroll") for (int kc = 0; kc < 8; ++kc) ua[kc] = *(const uint4*)(ust + fr * 528 + 64 * kc + 16 * fq);      \
            f32x4 sa[2] = {(f32x4){0.f, 0.f, 0.f, 0.f}, (f32x4){0.f, 0.f, 0.f, 0.f}}, sb[2] = {(f32x4){0.f, 0.f, 0.f, 0.f}, (f32x4){0.f, 0.f, 0.f, 0.f}};     \
            _Pragma("unroll") for (int kc = 0; kc < 8; ++kc) { \
              const i32x8 av = (i32x8){(int)ua[kc].x, (int)ua[kc].y, (int)ua[kc].z, (int)ua[kc].w, 0, 0, 0, 0}; \
              const i32x8 b1 = (i32x8){(int)hB1[kc].x, (int)hB1[kc].y, (int)hB1[kc].z, (int)hB1[kc].w, 0, 0, 0, 0}; \
              const i32x8 b2 = (i32x8){(int)hB2[kc].x, (int)hB2[kc].y, (int)hB2[kc].z, (int)hB2[kc].w, 0, 0, 0, 0}; \
              sa[kc & 1] = __builtin_amdgcn_mfma_scale_f32_16x16x128_f8f6f4(av, b1, sa[kc & 1], 4  , 4  , 0, 0x7F7F7F7F, 0, 0x7F7F7F7F); \
              sb[kc & 1] = __builtin_amdgcn_mfma_scale_f32_16x16x128_f8f6f4(av, b2, sb[kc & 1], 4, 4, 0, 0x7F7F7F7F, 0, 0x7F7F7F7F); } \
            const f32x4 sc4 = (sa[0] + sa[1]) + (sb[0] + sb[1]) * 0.125f; \
              \
            const float dsel = jsel == 0 ? sc4[0] : (jsel == 1 ? sc4[1] : (jsel == 2 ? sc4[2] : sc4[3])); \
            const int _eo = tl * 132 + 16 * _bt + 4 * fq + jsel; const unsigned _pe = (unsigned)idxL[_eo]; \
            const float _w = __uint_as_float(_pe & 0xffff0000u) * gelu_tanh_fast(dsel * (1.f / 64.f));            \
            if (fr < 4) idxL[_eo] = (int)(((unsigned)f2bf(_w) << 16) | (_pe & 0xffffu)); \
          } while (0)
#pragma unroll 1
          for (int b2 = 0; b2 < 8; b2 += 2) { PEER_U_STEP(qa, b2); PEER_U_STEP(qb, b2 + 1); }
#undef PEER_U_STEP
        }
      }
      {
        f32x2 acc2[8];
#pragma unroll
        for (int j = 0; j < 8; ++j) acc2[j] = (f32x2){0.f, 0.f};
#pragma unroll 1
        for (int ii = 0; ii < 8; ++ii) {
          const int tl = tlb + ii, t = t0 + tl;
          const uint4 xr0 = *(const uint4*)(X + (size_t)t * 1024 + lane * 16), xr1 = *(const uint4*)(X + (size_t)t * 1024 + lane * 16 + 8);
          __builtin_amdgcn_sched_barrier(0);
#define PEER_V_STEP(R, bt_) do { const int _bt = (bt_), _sn = 64 + ii * 8 + _bt + 2; \
            const int _wv = (int)((unsigned)idxL[tl * 132 + 16 * _bt + fr] & 0xffff0000u);          \
            const int _en = PEER_REQ_IDX(_sn); \
            _Pragma("unroll") for (int r = 0; r < 16; ++r) { \
              const float wr = __int_as_float(__builtin_amdgcn_readlane(_wv, r)); \
              axpy16_fp4(make_uint2(R[r >> 1][2 * (r & 1)], R[r >> 1][2 * (r & 1) + 1]), wr, acc2); \
              { const unsigned off = (unsigned)__builtin_amdgcn_readlane(_en, r) * 512u + lane8; const uint2 _t = *(const uint2*)((const unsigned char*)V4 + off); \
                R[r >> 1][2 * (r & 1)] = _t.x; R[r >> 1][2 * (r & 1) + 1] = _t.y; } \
              __builtin_amdgcn_sched_barrier(0); } \
          } while (0)
#pragma unroll 1
          for (int b2 = 0; b2 < 8; b2 += 2) { PEER_V_STEP(qa, b2); PEER_V_STEP(qb, b2 + 1); }
#undef PEER_V_STEP
          float xn[16]; float ss = 0.f;
          const unsigned xw[8] = {xr0.x, xr0.y, xr0.z, xr0.w, xr1.x, xr1.y, xr1.z, xr1.w};
#pragma unroll
          for (int qq = 0; qq < 4; ++qq) {
            const f32x4 xv = (f32x4){__uint_as_float(xw[2 * qq] << 16), __uint_as_float(xw[2 * qq] & 0xffff0000u), __uint_as_float(xw[2 * qq + 1] << 16), __uint_as_float(xw[2 * qq + 1] & 0xffff0000u)};
            const f32x4 g = *(const f32x4*)(cst + qq * 256 + lane * 4);
            xn[4 * qq] = xv.x + g.x * acc2[2 * qq].x; xn[4 * qq + 1] = xv.y + g.y * acc2[2 * qq].y;
            xn[4 * qq + 2] = xv.z + g.z * acc2[2 * qq + 1].x; xn[4 * qq + 3] = xv.w + g.w * acc2[2 * qq + 1].y;
            ss += xn[4 * qq] * xn[4 * qq] + xn[4 * qq + 1] * xn[4 * qq + 1] + xn[4 * qq + 2] * xn[4 * qq + 2] + xn[4 * qq + 3] * xn[4 * qq + 3];
          }
#pragma unroll
          for (int j = 0; j < 8; ++j) acc2[j] = (f32x2){0.f, 0.f};
          const float rstd = rsqrtf(wave_sum(ss) * (1.f / 1024.f) + EPS_);
          if (!last) {
            unsigned hb[8], xb[8];
#pragma unroll
            for (int qq = 0; qq < 4; ++qq) {
              xb[2 * qq] = pk2(xn[4 * qq], xn[4 * qq + 1]); xb[2 * qq + 1] = pk2(xn[4 * qq + 2], xn[4 * qq + 3]);
              const f32x4 ga = *(const f32x4*)(cst + 1024 + qq * 256 + lane * 4), sh = *(const f32x4*)(cst + 2048 + qq * 256 + lane * 4);
              hb[2 * qq] = pk2(xn[4 * qq] * rstd * ga.x + sh.x, xn[4 * qq + 1] * rstd * ga.y + sh.y);
              hb[2 * qq + 1] = pk2(xn[4 * qq + 2] * rstd * ga.z + sh.z, xn[4 * qq + 3] * rstd * ga.w + sh.w);
            }
            *(uint4*)(X + (size_t)t * 1024 + lane * 16) = make_uint4(xb[0], xb[1], xb[2], xb[3]);
            *(uint4*)(X + (size_t)t * 1024 + lane * 16 + 8) = make_uint4(xb[4], xb[5], xb[6], xb[7]);
            *(uint4*)(HF + (size_t)t * 1024 + lane * 16) = make_uint4(hb[0], hb[1], hb[2], hb[3]);
            *(uint4*)(HF + (size_t)t * 1024 + lane * 16 + 8) = make_uint4(hb[4], hb[5], hb[6], hb[7]);
          } else {
#pragma unroll
            for (int qq = 0; qq < 4; ++qq) {
              const f32x4 fn = *(const f32x4*)(cst + 1024 + qq * 256 + lane * 4);
              *(f32x4*)((float*)pp->out + (size_t)t * 1024 + lane * 16 + 4 * qq) = (f32x4){xn[4 * qq] * rstd * fn.x, xn[4 * qq + 1] * rstd * fn.y, xn[4 * qq + 2] * rstd * fn.z, xn[4 * qq + 3] * rstd * fn.w};
            }
          }
        }
      }
#undef PEER_REQ_IDX
#undef PEER_REQ_U
    }
  }
}

#define XB_TMO      128
#define XB_XCNT(j)  (256  + 64 * (j))
#define XB_XSUB(j)  (1280 + 64 * (j))
#define XB_XGEN(j)  (2304 + 64 * (j))
#define XB_TOP      3328
#define XB_TOPGEN   3392
#define XCD_BAR_WORDS 3456
#define XB_SPIN_CAP (1u << 20)
#define LAS __attribute__((address_space(3)))
__device__ __forceinline__ unsigned xb_ld(unsigned* q)              { return __hip_atomic_load(q, __ATOMIC_RELAXED, __HIP_MEMORY_SCOPE_AGENT); }
__device__ __forceinline__ unsigned xb_add(unsigned* q, unsigned v) { return __hip_atomic_fetch_add(q, v, __ATOMIC_RELAXED, __HIP_MEMORY_SCOPE_AGENT); }
__device__ __forceinline__ unsigned xb_xcc_id() { return (unsigned)__builtin_amdgcn_s_getreg((3 << 11) | 20) & 0xFu; }
#define XB_SPIN(cond, bar) do { unsigned _sp = 0; while (cond) { __builtin_amdgcn_s_sleep(1); \
    if ((++_sp & 255u) == 0u) { if (xb_ld(&(bar)[XB_TMO])) break; if (_sp > XB_SPIN_CAP) { atomicAdd(&(bar)[XB_TMO], 1u); break; } } } } while (0)
struct XcdBarrier { unsigned* bar; unsigned x; volatile LAS unsigned* st; };
__device__ __forceinline__ XcdBarrier xcd_barrier_post(unsigned* bar, volatile LAS unsigned* st) {
    XcdBarrier b; b.bar = bar; b.x = xb_xcc_id(); b.st = st;
    if (threadIdx.x == 0) (void)xb_add(&bar[XB_XCNT(b.x)], 1u);
    return b;
}
__device__ __forceinline__ void xcd_barrier_complete(unsigned* bar, unsigned x, unsigned& nloc, unsigned& nx) {
    const unsigned G = gridDim.x * gridDim.y * gridDim.z;
    unsigned sum, cnt, mine, sp = 0u;
    for (;;) {
        sum = 0u; cnt = 0u; mine = 0u;
#pragma unroll
        for (unsigned j = 0; j < 16; ++j) { const unsigned c = xb_ld(&bar[XB_XCNT(j)]); sum += c; cnt += (c > 0u) ? 1u : 0u; mine = (j == x) ? c : mine; }
        if (sum == G) break;
        __builtin_amdgcn_s_sleep(1);
        if ((++sp & 255u) == 0u) { if (xb_ld(&bar[XB_TMO])) break; if (sp > XB_SPIN_CAP) { atomicAdd(&bar[XB_TMO], 1u); break; } }
    }
    nloc = mine > 0u ? mine : 1u; nx = cnt > 0u ? cnt : 1u;
}
__device__ __forceinline__ void xcd_barrier(const XcdBarrier& b) {
    asm volatile("s_waitcnt vmcnt(0)" ::: "memory");
    __syncthreads();
    if (threadIdx.x == 0) {
        unsigned* bar = b.bar;
        __builtin_amdgcn_s_waitcnt(0);
        unsigned nloc = b.st[0], nx = b.st[1];
        if (nloc == 0u) { xcd_barrier_complete(bar, b.x, nloc, nx); b.st[0] = nloc; b.st[1] = nx; }
        const unsigned old = xb_add(&bar[XB_XSUB(b.x)], 1u);
        const unsigned gen = old / nloc;
        if (old + 1u == (gen + 1u) * nloc) {
            __builtin_amdgcn_fence(__ATOMIC_RELEASE, "agent");
            asm volatile("s_waitcnt vmcnt(0)" ::: "memory");
            const unsigned og = xb_add(&bar[XB_TOP], 1u);
            const unsigned tg = og / nx;
            if (og + 1u == (tg + 1u) * nx) xb_add(&bar[XB_TOPGEN], 1u);
            else XB_SPIN(xb_ld(&bar[XB_TOPGEN]) == tg, bar);
            __builtin_amdgcn_fence(__ATOMIC_ACQUIRE, "agent");
            xb_add(&bar[XB_XGEN(b.x)], 1u);
            asm volatile("s_waitcnt vmcnt(0)" ::: "memory");
        } else {
            XB_SPIN(xb_ld(&bar[XB_XGEN(b.x)]) == gen, bar);
            __builtin_amdgcn_fence(__ATOMIC_ACQUIRE, "agent");
            asm volatile("s_waitcnt vmcnt(0)" ::: "memory");
        }
    }
    __syncthreads();
}

__global__ void __launch_bounds__(NT) fwd_megakernel(Params p) {
  extern __shared__ __attribute__((aligned(16))) unsigned char smem[];
  const CParamsP pp = launder_kargs();
  cg::grid_group grid = cg::this_grid();
  volatile LAS unsigned* xbst = (volatile LAS unsigned*)(smem + LDS_BYTES - 16);
  if (threadIdx.x == 0) { xbst[0] = 0u; xbst[1] = 0u; }
  if (blockIdx.x == 0) { unsigned* bw = (unsigned*)(pp->ws + WS_BAR); for (int i = threadIdx.x; i < XCD_BAR_WORDS; i += NT) bw[i] = 0u; }
  setup_phase(p, smem);
  grid.sync();
  const XcdBarrier xb = xcd_barrier_post((unsigned*)(pp->ws + WS_BAR), xbst);
  const float* MOD = (const float*)(pp->ws + WS_MOD);
  for (int l = 0; l < DEPTH_; ++l) {
    const float* xsrc = (l == 0) ? gin(pp->in[I_X]) : (const float*)(pp->ws + WS_X);
    const float* modl = MOD + (size_t)l * 2 * 6144;
    if (l == 0) {
      norm_mod_phase(xsrc, gin(pp->in[I_NMIX]), modl + 0, modl + 1024, (bf16_t*)(pp->ws + WS_ABUF));
      qbias_phase(p, smem);
      xcd_barrier(xb);
    }
    gemm_proj_phase(p, l, smem);
    xcd_barrier(xb);
    attn_phase(p, l, smem);
    mix_local_phase(p, l, smem);
    xcd_barrier(xb);
    scan_phase(p, l);
    xcd_barrier(xb);
    mix_final_phase(p, l, smem);
    xcd_barrier(xb);
    gemm_out_phase(p, l, smem);
    xcd_barrier(xb);
    gemm_q_phase(p, l, smem);
    xcd_barrier(xb);
    peer_phase(p, l, l == DEPTH_ - 1, smem);
    xcd_barrier(xb);
  }
}

extern "C" void kernel_launch(void* const* d_in, const int* in_sizes, int n_in,
                              void* d_out, int out_size, void* d_ws, size_t ws_size,
                              hipStream_t stream) {
  static int grid_blocks = 0;
  if (grid_blocks == 0) {
    if (n_in != 24 || ws_size < WS_END) { fprintf(stderr, "kernel_launch: unexpected n_in %d / ws_size %zu (need %zu)\n", n_in, ws_size, (size_t)WS_END); grid_blocks = -1; return; }
    int dev = 0, cus = 0, per_cu = 0;
    if (hipGetDevice(&dev) != hipSuccess || hipDeviceGetAttribute(&cus, hipDeviceAttributeMultiprocessorCount, dev) != hipSuccess) { grid_blocks = -1; return; }
    if (hipFuncSetAttribute((const void*)fwd_megakernel, hipFuncAttributeMaxDynamicSharedMemorySize, LDS_BYTES) != hipSuccess) { fprintf(stderr, "hipFuncSetAttribute failed\n"); grid_blocks = -1; return; }
    if (hipOccupancyMaxActiveBlocksPerMultiprocessor(&per_cu, (const void*)fwd_megakernel, NT, LDS_BYTES) != hipSuccess || per_cu < 1) { fprintf(stderr, "occupancy query: %d\n", per_cu); grid_blocks = -1; return; }
    grid_blocks = cus;
  }
  if (grid_blocks < 0) return;
  Params p{};
  for (int i = 0; i < 24; ++i) p.in[i] = (const GAS float*)d_in[i];
  p.out = (GAS float*)d_out; p.ws = (GAS unsigned char*)d_ws;
  void* args[] = {&p};
  hipError_t e = hipLaunchCooperativeKernel((void*)fwd_megakernel, dim3(grid_blocks), dim3(NT), args, LDS_BYTES, stream);
  if (e != hipSuccess) fprintf(stderr, "cooperative launch failed: %s (grid %d)\n", hipGetErrorString(e), grid_blocks);
}
```

```cpp
#include <hip/hip_runtime.h>
#include <hip/hip_cooperative_groups.h>
#include <cstdio>
#include <cstdint>
namespace cg = cooperative_groups;

typedef unsigned short bf16_t;
typedef short bf16x8 __attribute__((ext_vector_type(8)));
typedef float f32x4 __attribute__((ext_vector_type(4)));
typedef float f32x16 __attribute__((ext_vector_type(16)));
typedef int i32x8 __attribute__((ext_vector_type(8)));

constexpr int T_ = 16384, D_ = 1024, L_ = 8192, NBATCH = 2, DEPTH_ = 4;
constexpr int INC = 2944, INCP = 3072;
constexpr int NCH = 128;
constexpr int NT = 512;
constexpr int NW = 8;
constexpr float EPS_ = 1e-6f;
constexpr int C_QA = 0, C_KA = 384, C_VA = 768, C_QR = 1152, C_KR = 1536, C_VR = 1920, C_GR = 2304, C_US = 2688;

constexpr size_t al256(size_t x) { return (x + 255) & ~(size_t)255; }
constexpr size_t WS_MOD   = 0;
constexpr size_t WS_ROTC  = al256(WS_MOD + 4ull * 2 * 6144 * 4);
constexpr size_t WS_ROTS  = al256(WS_ROTC + 8192ull * 32 * 4);
constexpr size_t WS_SA    = al256(WS_ROTS + 8192ull * 32 * 4);
constexpr size_t WS_SBB   = al256(WS_SA + 4ull * 16 * 64 * 2 * 4);
constexpr size_t WS_WIN   = al256(WS_SBB + 4ull * 16 * 64 * 32 * 4);
constexpr size_t WS_WOUT  = al256(WS_WIN + 4ull * INCP * 1024 * 2);
constexpr size_t WS_WQ    = al256(WS_WOUT + 4ull * 1024 * 1024 * 2);
constexpr size_t WS_SUBK  = al256(WS_WQ + 4ull * 2048 * 1024 * 2);
constexpr size_t WS_ABUF  = al256(WS_SUBK + 4ull * 16 * 128 * 128 * 2);
constexpr size_t WS_PROJ  = al256(WS_ABUF + (size_t)T_ * 1024 * 2);
constexpr size_t WS_VTA   = al256(WS_PROJ + (size_t)T_ * INCP * 2);
constexpr size_t WS_ATT   = al256(WS_VTA + 2ull * 6 * 64 * 8192 * 2);
constexpr size_t WS_YINT  = al256(WS_ATT + (size_t)T_ * 384 * 4);
constexpr size_t WS_UPD   = al256(WS_YINT + (size_t)T_ * 384 * 4);
constexpr size_t WS_SPREV = al256(WS_UPD + 256ull * 6 * 4096 * 4);
constexpr size_t WS_SEND  = al256(WS_SPREV + 256ull * 6 * 4096 * 4);
constexpr size_t WS_CARRY = al256(WS_SEND + 256ull * 16 * 64 * 2 * 4);
constexpr size_t WS_X     = al256(WS_CARRY + 256ull * 16 * 64 * 2 * 4);
constexpr size_t WS_Q     = al256(WS_X + (size_t)T_ * 1024 * 4);
constexpr size_t WS_SC    = al256(WS_Q + (size_t)T_ * 2048 * 2);
constexpr size_t WS_EIDX  = al256(WS_SC + (size_t)T_ * 2048 * 4);
constexpr size_t WS_EGATE = al256(WS_EIDX + (size_t)T_ * 128 * 4);
constexpr size_t WS_PU8   = al256(WS_EGATE + (size_t)T_ * 128 * 4);
constexpr size_t WS_PV8   = al256(WS_PU8 + 4ull * 16384 * 1024);
constexpr size_t WS_BAR   = al256(WS_PV8 + 4ull * 16384 * 1024);
constexpr size_t WS_SPT   = al256(WS_BAR + 3456ull * 4);
constexpr size_t WS_CB    = al256(WS_SPT + 256ull * 6 * 4096 * 2);
constexpr size_t WS_WGLUT = al256(WS_CB + 4ull * 16 * 16 * 128 * 2);
constexpr size_t WS_VTR   = al256(WS_WGLUT + 4ull * 512 * 256 * 2);
constexpr size_t WS_XG    = al256(WS_VTR + 2ull * 384 * 8192 * 2);
constexpr size_t WS_SSQ   = al256(WS_XG + (size_t)T_ * 1024 * 2);
constexpr size_t WS_C2    = al256(WS_SSQ + (size_t)T_ * 16 * 4);
constexpr size_t WS_BBH   = al256(WS_C2 + 4ull * 2 * 2048 * 4);
constexpr size_t WS_END   = al256(WS_BBH + 4ull * 16 * 2 * 64 * 16 * 2);

constexpr int LDS_BYTES = 135168;

#define GAS __attribute__((address_space(1)))
struct Params {
  const GAS float* in[24];
  GAS float* out;
  GAS unsigned char* ws;
};
enum { I_X = 0, I_C, I_WADA, I_BADA, I_NMIX, I_NFFN, I_WIN, I_RELB, I_LRE, I_LIM, I_LOGDT, I_BRE, I_BIM, I_CRE, I_CIM, I_SSMD,
       I_WGLU, I_MGAIN, I_WOUT, I_WQ, I_SUBK, I_PU, I_PV, I_FNORM };

__device__ __forceinline__ float bf2f(bf16_t v) { return __uint_as_float(((unsigned)v) << 16); }
__device__ __forceinline__ bf16_t f2bf(float f) { unsigned u = __float_as_uint(f); u += 0x7fffu + ((u >> 16) & 1u); return (bf16_t)(u >> 16); }
__device__ __forceinline__ unsigned pk2(float a, float b) { return (unsigned)f2bf(a) | ((unsigned)f2bf(b) << 16); }
__device__ __forceinline__ float wave_sum(float v) {
#pragma unroll
  for (int o = 32; o > 0; o >>= 1) v += __shfl_xor(v, o);
  return v;
}
__device__ __forceinline__ float wave_max(float v) {
#pragma unroll
  for (int o = 32; o > 0; o >>= 1) v = fmaxf(v, __shfl_xor(v, o));
  return v;
}
__device__ __forceinline__ float gelu_tanh(float x) { const float u = 0.7978845608028654f * (x + 0.044715f * x * x * x); return 0.5f * x * (1.f + tanhf(u)); }
__device__ __forceinline__ float sigmoid_f(float x) { return 1.f / (1.f + __expf(-x)); }
__device__ __forceinline__ float gelu_tanh_fast(float x) {
  const float u2 = 2.f * 0.7978845608028654f * 1.4426950408889634f * (x + 0.044715f * x * x * x);
  const float e = __builtin_amdgcn_exp2f(fminf(u2, 80.f));
  return x - x * __builtin_amdgcn_rcpf(1.f + e);
}
__device__ __forceinline__ GAS unsigned char* launder_ptr(GAS unsigned char* q) { asm volatile("" : "+s"(q)); return q; }
__device__ __forceinline__ const float* gin(const GAS float* q) { return (const float*)q; }
__device__ __forceinline__ const float* launder_cptr(const float* q) { asm volatile("" : "+s"(q)); return q; }
__device__ __forceinline__ int launder_tid() { int t = threadIdx.x; asm volatile("" : "+v"(t)); return t; }
typedef const Params __attribute__((address_space(4)))* CParamsP;
__device__ __forceinline__ CParamsP launder_kargs() { CParamsP q = (CParamsP)__builtin_amdgcn_kernarg_segment_ptr(); asm volatile("" : "+s"(q)); return q; }

__device__ __forceinline__ void convert_tables_fp4(const CParamsP pp, GAS unsigned char* ws, int layer, int gtid, int gn) {
  constexpr int NSPAN = 16384;
  const int lane = gtid & 63, gw = gtid >> 6, nw = gn >> 6;
  for (int sp0 = gw; sp0 < 2 * NSPAN; sp0 += 2 * nw) {
    f32x4 a[2][4];
#pragma unroll
    for (int h = 0; h < 2; ++h) {
      const int sp = sp0 + h * nw, tb = sp >= NSPAN ? 1 : 0;
      const float* src = (tb ? gin(pp->in[I_PV]) : gin(pp->in[I_PU])) + ((size_t)layer * NSPAN + (sp - tb * NSPAN)) * 1024 + lane * 4;
#pragma unroll
      for (int q = 0; q < 4; ++q) a[h][q] = (sp < 2 * NSPAN) ? *(const f32x4*)(src + q * 256) : (f32x4){0.f, 0.f, 0.f, 0.f};
    }
#pragma unroll
    for (int h = 0; h < 2; ++h) {
      const int sp = sp0 + h * nw, tb = sp >= NSPAN ? 1 : 0;
      if (sp < 2 * NSPAN) {
        const float sc = tb ? 4.f : 64.f;
        unsigned short* dst = (unsigned short*)(ws + (tb ? WS_PV8 : WS_PU8) + ((size_t)layer * NSPAN + (sp - tb * NSPAN)) * 512) + lane;
#pragma unroll
        for (int q = 0; q < 4; ++q) {
          const f32x4 v = a[h][q];
          const float x0 = fminf(fmaxf(v.x * sc, -6.f), 6.f), x1 = fminf(fmaxf(v.y * sc, -6.f), 6.f);
          const float x2 = fminf(fmaxf(v.z * sc, -6.f), 6.f), x3 = fminf(fmaxf(v.w * sc, -6.f), 6.f);
          unsigned o = __builtin_amdgcn_cvt_scalef32_pk_fp4_f32(0u, x0, x1, 1.0f, 0);
          o = __builtin_amdgcn_cvt_scalef32_pk_fp4_f32(o, x2, x3, 1.0f, 1);
          dst[q * 64] = (unsigned short)o;
        }
      }
    }
  }
}

__device__ void setup_phase(const Params& p, unsigned char* smem) {
  const CParamsP pp = launder_kargs();
  GAS unsigned char* const ws = launder_ptr(pp->ws); const int tidx = launder_tid(); (void)ws; (void)tidx;
  const int tid = tidx;
  float* sm = (float*)smem;
  {
    float* cond = sm;
    float* red = sm + 2048;
    float* MOD = (float*)(ws + WS_MOD);
    for (int i = tid; i < 2048; i += NT) { const float c = gin(pp->in[I_C])[i]; cond[i] = c * sigmoid_f(c); }
    __syncthreads();
    for (int item = blockIdx.x; item < 4 * 192; item += gridDim.x) {
      const int l = item / 192, cb = item % 192, kq = tid >> 6, jj = tid & 31, kp = (tid >> 5) & 1, j = cb * 32 + jj;
      const float* w = gin(pp->in[I_WADA]) + (size_t)l * 1024 * 6144 + j;
      float a0 = 0.f, a1 = 0.f;
#pragma unroll 32
      for (int k = kq * 128 + kp; k < kq * 128 + 128; k += 2) { const float wv = w[(size_t)k * 6144]; a0 += cond[k] * wv; a1 += cond[1024 + k] * wv; }
      red[((kq * 2 + kp) * 2 + 0) * 32 + jj] = a0; red[((kq * 2 + kp) * 2 + 1) * 32 + jj] = a1;
      __syncthreads();
      if (tid < 64) {
        const int b = tid >> 5, j2 = tid & 31; float s = 0.f;
        for (int q = 0; q < 16; ++q) s += red[(q * 2 + b) * 32 + j2];
        MOD[((size_t)l * 2 + b) * 6144 + cb * 32 + j2] = s + gin(pp->in[I_BADA])[(size_t)l * 6144 + cb * 32 + j2];
      }
      __syncthreads();
    }
  }
  const int gtid = blockIdx.x * NT + tid, gn = gridDim.x * NT;
  {
    float* RC = (float*)(ws + WS_ROTC); float* RS = (float*)(ws + WS_ROTS);
    for (int idx = gtid; idx < 8192 * 32; idx += gn) {
      const int pos = idx >> 5, i = idx & 31;
      const float inv = powf(10000.0f, -(float)i / 32.0f);
      const float ang = (float)pos * inv;
      float s, c; sincosf(ang, &s, &c);
      RC[idx] = c; RS[idx] = s;
    }
  }
  {
    float* SA = (float*)(ws + WS_SA); float* SBB = (float*)(ws + WS_SBB); bf16_t* BBH = (bf16_t*)(ws + WS_BBH);
    for (int idx = gtid; idx < 4 * 16 * 64; idx += gn) {
      const int l = idx / 1024, g = (idx >> 6) & 15;
      const float dt = expf(gin(pp->in[I_LOGDT])[l * 16 + g]);
      const float lr = gin(pp->in[I_LRE])[idx], li = gin(pp->in[I_LIM])[idx];
      const float mag = expf(lr * dt);
      float sn, cs; sincosf(li * dt, &sn, &cs);
      const float are = mag * cs, aim = mag * sn;
      const float den = lr * lr + li * li, nr = are - 1.f, ni = aim;
      const float fre = (nr * lr + ni * li) / den, fim = (ni * lr - nr * li) / den;
      SA[idx * 2] = are; SA[idx * 2 + 1] = aim;
      for (int c = 0; c < 16; ++c) {
        const float br = gin(pp->in[I_BRE])[(size_t)idx * 16 + c], bi = gin(pp->in[I_BIM])[(size_t)idx * 16 + c];
        SBB[(size_t)idx * 32 + c] = fre * br - fim * bi;
        SBB[(size_t)idx * 32 + 16 + c] = fre * bi + fim * br;
        {
          const int pq = idx & 63; const size_t fb = (size_t)(idx >> 6) * 2;
          BBH[(((fb + 0) * 2 + (pq >> 5)) * 64 + 32 * (c >> 3) + (pq & 31)) * 8 + (c & 7)] = f2bf(fre * br - fim * bi);
          BBH[(((fb + 1) * 2 + (pq >> 5)) * 64 + 32 * (c >> 3) + (pq & 31)) * 8 + (c & 7)] = f2bf(fre * bi + fim * br);
        }
      }
    }
  }
  {
    bf16_t* CB = (bf16_t*)(ws + WS_CB);
    for (int idx = gtid; idx < 4 * 16 * 16 * 128; idx += gn) {
      const int k = idx & 127, lgc = idx >> 7;
      const bf16_t cv = (k < 64) ? f2bf(gin(pp->in[I_CRE])[(size_t)lgc * 64 + k]) : f2bf(-gin(pp->in[I_CIM])[(size_t)lgc * 64 + (k - 64)]);
      const int cc = lgc & 15, lg = lgc >> 4;
      CB[(((size_t)lg * 4 + (k >> 5)) * 64 + ((k >> 3) & 3) * 16 + cc) * 8 + (k & 7)] = cv;
    }
    bf16_t* WG = (bf16_t*)(ws + WS_WGLUT);
    for (int idx = gtid; idx < 4 * 512 * 256; idx += gn) {
      const int k = idx & 255, nn = (idx >> 8) & 511, l2 = idx >> 17;
      {
        const int which = nn >> 8, w8 = (nn >> 5) & 7, nt = (nn >> 4) & 1, frr = nn & 15, ks = k >> 5, fqq = (k >> 3) & 3, j = k & 7;
        WG[(((((size_t)l2 * 8 + w8) * 8 + ks) * 2 + which) * 2 + nt) * 512 + (fqq * 16 + frr) * 8 + j] = f2bf(gin(pp->in[I_WGLU])[((size_t)l2 * 256 + k) * 512 + nn]);
      }
    }
  }
  convert_tables_fp4(pp, ws, 0, gtid, gn);
  {
    __syncthreads();
    const int lane = tid & 63, wid = tid >> 6;
    float* scr = sm + wid * (64 * 33);
    constexpr int IT_IN = 16 * 96, IT_OUT = 16 * 32, IT_L = IT_IN + IT_OUT;
    for (int item = blockIdx.x * NW + wid; item < 4 * IT_L; item += gridDim.x * NW) {
      const int l = item / IT_L; int r = item - l * IT_L;
      const float* W; bf16_t* WT; int N, NP;
      if (r < IT_IN) { W = gin(pp->in[I_WIN]) + (size_t)l * 1024 * INC; WT = (bf16_t*)(ws + WS_WIN) + (size_t)l * INCP * 1024; N = INC; NP = 96; }
      else { r -= IT_IN; W = gin(pp->in[I_WOUT]) + (size_t)l * 1024 * 1024; WT = (bf16_t*)(ws + WS_WOUT) + (size_t)l * 1024 * 1024; N = 1024; NP = 32; }
      const int kb = r / NP, nb = r - kb * NP, k0 = kb * 64, n0 = nb * 32;
      const int nn = n0 + (lane & 31); const bool inb = nn < N;
      float v[32];
#pragma unroll
      for (int i = 0; i < 32; ++i) { const int kk = 2 * i + (lane >> 5); v[i] = inb ? W[(size_t)(k0 + kk) * N + nn] : 0.f; }
#pragma unroll
      for (int i = 0; i < 32; ++i) { const int kk = 2 * i + (lane >> 5); scr[kk * 33 + (lane & 31)] = v[i]; }
      const int c = lane & 7;
#pragma unroll
      for (int j = 0; j < 4; ++j) {
        const int n = (lane >> 3) + 8 * j; const float* sp = scr + (8 * c) * 33 + n;
        uint4 o; o.x = pk2(sp[0], sp[33]); o.y = pk2(sp[2 * 33], sp[3 * 33]); o.z = pk2(sp[4 * 33], sp[5 * 33]); o.w = pk2(sp[6 * 33], sp[7 * 33]);
        *(uint4*)(WT + (size_t)(n0 + n) * 1024 + k0 + 8 * c) = o;
      }
    }
    __syncthreads();
  }
  {
    bf16_t* WP = (bf16_t*)(ws + WS_WQ);
    const int lane = tid & 63, wid = tid >> 6, fr = lane & 15, fq = lane >> 4;
    for (int item = blockIdx.x; item < 4 * 16 * 8; item += gridDim.x) {
      const int l = item >> 7, hs = (item >> 3) & 15, kb = item & 7;
      const float* Wq = gin(pp->in[I_WQ]) + ((size_t)l * 1024 + kb * 128 + wid * 16 + fr) * 2048 + hs * 128 + 8 * fq;
      const float* SKg = gin(pp->in[I_SUBK]) + ((size_t)l * 16 + hs) * 128 * 128 + (size_t)fr * 128 + 8 * fq;
      bf16x8 ah[4], al[4];
#pragma unroll
      for (int ks = 0; ks < 4; ++ks) {
        const f32x4 x0 = *(const f32x4*)(Wq + 32 * ks), x1 = *(const f32x4*)(Wq + 32 * ks + 4);
        const float xv[8] = {x0.x, x0.y, x0.z, x0.w, x1.x, x1.y, x1.z, x1.w};
#pragma unroll
        for (int j = 0; j < 8; ++j) { const bf16_t h = f2bf(xv[j]); ah[ks][j] = (short)h; al[ks][j] = (short)f2bf(xv[j] - bf2f(h)); }
      }
      f32x4 acc[8];
#pragma unroll
      for (int ct = 0; ct < 8; ++ct) acc[ct] = (f32x4){0.f, 0.f, 0.f, 0.f};
#pragma unroll 2
      for (int ct = 0; ct < 8; ++ct) {
        f32x4 y[8];
#pragma unroll
        for (int ks = 0; ks < 4; ++ks) { y[2 * ks] = *(const f32x4*)(SKg + (size_t)ct * 16 * 128 + 32 * ks); y[2 * ks + 1] = *(const f32x4*)(SKg + (size_t)ct * 16 * 128 + 32 * ks + 4); }
#pragma unroll
        for (int ks = 0; ks < 4; ++ks) {
          const float yv[8] = {y[2 * ks].x, y[2 * ks].y, y[2 * ks].z, y[2 * ks].w, y[2 * ks + 1].x, y[2 * ks + 1].y, y[2 * ks + 1].z, y[2 * ks + 1].w};
          bf16x8 bh, bl;
#pragma unroll
          for (int j = 0; j < 8; ++j) { const bf16_t h = f2bf(yv[j]); bh[j] = (short)h; bl[j] = (short)f2bf(yv[j] - bf2f(h)); }
          acc[ct] = __builtin_amdgcn_mfma_f32_16x16x32_bf16(ah[ks], bh, acc[ct], 0, 0, 0);
          acc[ct] = __builtin_amdgcn_mfma_f32_16x16x32_bf16(al[ks], bh, acc[ct], 0, 0, 0);
          acc[ct] = __builtin_amdgcn_mfma_f32_16x16x32_bf16(ah[ks], bl, acc[ct], 0, 0, 0);
        }
      }
#pragma unroll
      for (int ct = 0; ct < 8; ++ct)
        *(uint2*)(WP + ((size_t)l * 2048 + hs * 128 + 16 * ct + fr) * 1024 + kb * 128 + wid * 16 + 4 * fq) = make_uint2(pk2(acc[ct][0], acc[ct][1]), pk2(acc[ct][2], acc[ct][3]));
    }
  }
}

__device__ void qbias_phase(const Params& p, unsigned char* smem) {
  const CParamsP pp = launder_kargs();
  GAS unsigned char* const ws = launder_ptr(pp->ws); const int tid = launder_tid();
  float* C2 = (float*)(ws + WS_C2); const float* MOD = (const float*)(ws + WS_MOD); const bf16_t* WP = (const bf16_t*)(ws + WS_WQ);
  const int lane = tid & 63, gw = blockIdx.x * NW + (tid >> 6), nw = gridDim.x * NW;
  for (int o = gw; o < 4 * 2048; o += nw) {
    const int l = o >> 11;
    const uint4 w0 = *(const uint4*)(WP + (size_t)o * 1024 + lane * 16), w1 = *(const uint4*)(WP + (size_t)o * 1024 + lane * 16 + 8);
    const unsigned ww[8] = {w0.x, w0.y, w0.z, w0.w, w1.x, w1.y, w1.z, w1.w};
    const float* s0 = MOD + (size_t)l * 2 * 6144 + 3072 + lane * 16; const float* s1 = s0 + 6144;
    float a0 = 0.f, a1 = 0.f;
#pragma unroll
    for (int q = 0; q < 8; ++q) {
      const float wl = __uint_as_float(ww[q] << 16), wh = __uint_as_float(ww[q] & 0xffff0000u);
      a0 += s0[2 * q] * wl + s0[2 * q + 1] * wh; a1 += s1[2 * q] * wl + s1[2 * q + 1] * wh;
    }
    a0 = wave_sum(a0); a1 = wave_sum(a1);
    if (lane == 0) { C2[((size_t)l * 2 + 0) * 2048 + (o & 2047)] = a0; C2[((size_t)l * 2 + 1) * 2048 + (o & 2047)] = a1; }
  }
  (void)smem;
}

__device__ void norm_mod_phase(const float* __restrict__ xsrc, const float* __restrict__ gain, const float* __restrict__ mod_sh, const float* __restrict__ mod_sc,
                               bf16_t* __restrict__ outp) {
  const int tidx = launder_tid();
  const int lane = tidx & 63, gw = blockIdx.x * NW + (tidx >> 6), nw = gridDim.x * NW;
  for (int t = gw; t < T_; t += nw) {
    const int b = t >> 13;
    const f32x4* xr = (const f32x4*)(xsrc + (size_t)t * 1024) + lane;
    f32x4 v[4]; float s = 0.f;
#pragma unroll
    for (int j = 0; j < 4; ++j) { v[j] = xr[64 * j]; s += v[j].x * v[j].x + v[j].y * v[j].y + v[j].z * v[j].z + v[j].w * v[j].w; }
    const float rstd = rsqrtf(wave_sum(s) * (1.f / 1024.f) + EPS_);
#pragma unroll
    for (int j = 0; j < 4; ++j) {
      const int c = lane * 4 + 256 * j;
      const f32x4 g = *(const f32x4*)(gain + c), sh = *(const f32x4*)(mod_sh + b * 6144 + c), sc = *(const f32x4*)(mod_sc + b * 6144 + c);
      const float o0 = v[j].x * rstd * g.x * (1.f + sc.x) + sh.x, o1 = v[j].y * rstd * g.y * (1.f + sc.y) + sh.y;
      const float o2 = v[j].z * rstd * g.z * (1.f + sc.z) + sh.z, o3 = v[j].w * rstd * g.w * (1.f + sc.w) + sh.w;
      uint2 o; o.x = pk2(o0, o1); o.y = pk2(o2, o3);
      *(uint2*)(outp + (size_t)t * 1024 + c) = o;
    }
  }
}


namespace pg8 {
#define PG8_LAS __attribute__((address_space(3)))
typedef unsigned u32x4 __attribute__((ext_vector_type(4)));
constexpr int BM = 256, BK = 64, HALF = 128, HTB = HALF * BK * 2, STAGE_BYTES = 8 * HTB, NXCD = 8, WGM = 8;
__host__ __device__ __forceinline__ int lds_byte(int r, int c) { const int st = (r >> 4) * 2 + (c >> 5), rr = r & 15, cc = c & 31, ob = rr * 64 + cc * 2; return st * 1024 + (ob ^ (((ob >> 9) & 1) << 5)); }
__host__ __device__ __forceinline__ void stage_rc(int b, int& R, int& C) { const int st = b / 1024, sb = b % 1024, swz = sb ^ (((sb >> 9) & 1) << 5); R = (st >> 1) * 16 + swz / 64; C = (st & 1) * 32 + (swz % 64) / 2; }
__host__ __device__ __forceinline__ int perm32(int rho) { const int n = rho >> 4, i = rho & 15; return 8 * (i >> 2) + 4 * n + (i & 3); }
struct Unit { int pm, pn; };
struct Gemm { const bf16_t* A; const bf16_t* Bt; int M, N, K; };
struct StaticOrder {
    int nM, nN, nwg, G, c;
    __host__ __device__ void init(int M, int N, int G_, int c_) { nM = M / BM; nN = N / BM; nwg = nM * nN; G = G_; c = c_; }
    __host__ __device__ bool next(int i, Unit& u) const {
        const long L = (long)i * G + c; if (L >= nwg) return false;
        int wgid = (int)L; { const int q = nwg / NXCD, r = nwg % NXCD, xcd = wgid % NXCD, off = wgid / NXCD; wgid = (xcd < r ? xcd * (q + 1) : r * (q + 1) + (xcd - r) * q) + off; }
        const int nig = WGM * nN, gid = wgid / nig, fm = gid * WGM, gsz = (nM - fm) < WGM ? (nM - fm) : WGM;
        u.pm = fm + ((wgid % nig) % gsz); u.pn = (wgid % nig) / gsz; return true;
    }
    __device__ __forceinline__ void a_ready(const Unit&) const {}
    __device__ __forceinline__ void done(const Unit&) const {}
};
__device__ __forceinline__ unsigned cvt_pk_bf16(float lo, float hi) { unsigned r; asm volatile("v_cvt_pk_bf16_f32 %0, %1, %2" : "=v"(r) : "v"(lo), "v"(hi)); return r; }
template <class Epi, class Sched>
__device__ __forceinline__ void gemm_phase(PG8_LAS unsigned char* lds, const Gemm g, const Sched& S, const Epi& E) {
    const int tid = launder_tid(), wid = __builtin_amdgcn_readfirstlane(tid >> 6), lane = tid & 63, wr = wid >> 2, wc = wid & 3, fr = lane & 15, fq = lane >> 4;
    const int K = g.K, nt = K / BK;
    unsigned voffA[2], voffB[2];
#pragma unroll
    for (int i = 0; i < 2; ++i) { int R, C; stage_rc(tid * 16 + i * 8192, R, C); const int Rb = Epi::PERM ? ((R & ~31) + perm32(R & 31)) : R;
        voffA[i] = (unsigned)(R * K + C) * 2u; voffB[i] = (unsigned)(Rb * K + C) * 2u; }
    const size_t kstep = (size_t)(BK * 2);
    const size_t hstep = (size_t)HALF * K * 2;
    const size_t tstep = 2 * hstep;
    const unsigned ldsw = (unsigned)wid * 1024u;
    const int aoff = lds_byte(wr * 64 + fr, fq * 8), boff = lds_byte(wc * 32 + fr, fq * 8);
#define PG8_SA(b, h) (((b) * 2 + (h)) * HTB)
#define PG8_SB(b, h) ((4 + (b) * 2 + (h)) * HTB)
#define PG8_STAGE(bufoff, gbase, voff) do { _Pragma("unroll") for (int _i = 0; _i < 2; ++_i) \
        __builtin_amdgcn_global_load_lds((const unsigned*)((const char*)(gbase) + (voff)[_i]), (PG8_LAS unsigned*)(lds + (bufoff) + ldsw + _i * 8192), 16, 0, 0); } while (0)
#define PG8_LDA(dst, b, h) do { _Pragma("unroll") for (int m = 0; m < 4; ++m) _Pragma("unroll") for (int k = 0; k < 2; ++k) dst[m][k] = *(const PG8_LAS bf16x8*)(lds + PG8_SA(b, h) + aoff + m * 2048 + k * 1024); } while (0)
#define PG8_LDB(dst, b, h) do { _Pragma("unroll") for (int n = 0; n < 2; ++n) _Pragma("unroll") for (int k = 0; k < 2; ++k) dst[n][k] = *(const PG8_LAS bf16x8*)(lds + PG8_SB(b, h) + boff + n * 2048 + k * 1024); } while (0)
#define PG8_MMA(ai, bj, At, Bt) do { __builtin_amdgcn_s_setprio(1); _Pragma("unroll") for (int m = 0; m < 4; ++m) _Pragma("unroll") for (int n = 0; n < 2; ++n) _Pragma("unroll") for (int k = 0; k < 2; ++k) \
        acc[ai][bj][m][n] = __builtin_amdgcn_mfma_f32_16x16x32_bf16(Bt[n][k], At[m][k], acc[ai][bj][m][n], 0, 0, 0); __builtin_amdgcn_s_setprio(0); } while (0)
#define PG8_WAIT_V(n) asm volatile("s_waitcnt vmcnt(" #n ")" ::: "memory")
#define PG8_WAIT_L(n) asm volatile("s_waitcnt lgkmcnt(" #n ")" ::: "memory")
#define PG8_BAR __builtin_amdgcn_s_barrier()
#define PG8_SCHED __builtin_amdgcn_sched_barrier(0)
    Unit cur, nxt; int ui = 0;
    if (!S.next(0, cur)) return;
    f32x4 acc[2][2][4][2];
#pragma unroll
    for (int a = 0; a < 2; ++a)
#pragma unroll
        for (int b = 0; b < 2; ++b)
#pragma unroll
            for (int m = 0; m < 4; ++m)
#pragma unroll
                for (int n = 0; n < 2; ++n) acc[a][b][m][n] = (f32x4){0.f, 0.f, 0.f, 0.f};
    bf16x8 At[4][2], B0[2][2], B1[2][2];
    const char* cA = (const char*)g.A + (size_t)cur.pm * tstep; const char* cB = (const char*)g.Bt + (size_t)cur.pn * tstep;
    S.a_ready(cur);
    PG8_STAGE(PG8_SB(0, 0), cB, voffB); PG8_STAGE(PG8_SA(0, 0), cA, voffA); PG8_STAGE(PG8_SB(0, 1), cB + hstep, voffB); PG8_STAGE(PG8_SA(0, 1), cA + hstep, voffA);
    if (wr == 1) PG8_BAR;
    PG8_WAIT_V(4); PG8_BAR;
    PG8_STAGE(PG8_SB(1, 0), cB + kstep, voffB); PG8_STAGE(PG8_SA(1, 0), cA + kstep, voffA); PG8_STAGE(PG8_SB(1, 1), cB + hstep + kstep, voffB);
    PG8_WAIT_V(6); PG8_BAR;
    for (;;) {
        const bool has_next = S.next(ui + 1, nxt);
        const char* nA = has_next ? (const char*)g.A + (size_t)nxt.pm * tstep : cA; const char* nB = has_next ? (const char*)g.Bt + (size_t)nxt.pn * tstep : cB;
        for (int t = 0; t < nt; t += 2) {
            const bool last = (t == nt - 2);
            const char* a1 = cA + (size_t)(t + 1) * kstep;
            const char* a2 = last ? nA : cA + (size_t)(t + 2) * kstep; const char* b2 = last ? nB : cB + (size_t)(t + 2) * kstep;
            const char* a3 = a2 + kstep; const char* b3 = b2 + kstep;
            if (last && has_next) S.a_ready(nxt);
            PG8_LDB(B0, 0, 0); PG8_SCHED; PG8_LDA(At, 0, 0); PG8_STAGE(PG8_SA(1, 1), a1 + hstep, voffA);
            PG8_WAIT_L(8); PG8_BAR; PG8_WAIT_L(0); PG8_MMA(0, 0, At, B0); PG8_BAR; PG8_SCHED;
            PG8_LDB(B1, 0, 1); PG8_STAGE(PG8_SB(0, 0), b2, voffB);
            PG8_BAR; PG8_WAIT_L(0); PG8_MMA(0, 1, At, B1); PG8_BAR;
            PG8_LDA(At, 0, 1); PG8_STAGE(PG8_SA(0, 0), a2, voffA);
            PG8_BAR; PG8_WAIT_L(0); PG8_MMA(1, 0, At, B0); PG8_BAR; PG8_SCHED;
            PG8_STAGE(PG8_SB(0, 1), b2 + hstep, voffB);
            PG8_WAIT_V(6); PG8_BAR; PG8_MMA(1, 1, At, B1); PG8_BAR;
            PG8_LDB(B0, 1, 0); PG8_SCHED; PG8_LDA(At, 1, 0); PG8_STAGE(PG8_SA(0, 1), a2 + hstep, voffA);
            PG8_WAIT_L(8); PG8_BAR; PG8_WAIT_L(0); PG8_MMA(0, 0, At, B0); PG8_BAR; PG8_SCHED;
            PG8_LDB(B1, 1, 1); PG8_STAGE(PG8_SB(1, 0), b3, voffB);
            PG8_BAR; PG8_WAIT_L(0); PG8_MMA(0, 1, At, B1); PG8_BAR;
            PG8_LDA(At, 1, 1); PG8_STAGE(PG8_SA(1, 0), a3, voffA);
            PG8_BAR; PG8_WAIT_L(0); PG8_MMA(1, 0, At, B0); PG8_BAR; PG8_SCHED;
            PG8_STAGE(PG8_SB(1, 1), b3 + hstep, voffB);
            PG8_WAIT_V(6); PG8_BAR; PG8_MMA(1, 1, At, B1); PG8_BAR;
        }
        if constexpr (!Epi::AFTER_DRAIN) { E(acc, cur, wr, wc, fr, fq); S.done(cur); }
        if (!has_next) break;
#pragma unroll
        for (int a = 0; a < 2; ++a)
#pragma unroll
            for (int b = 0; b < 2; ++b)
#pragma unroll
                for (int m = 0; m < 4; ++m)
#pragma unroll
                    for (int n = 0; n < 2; ++n) acc[a][b][m][n] = (f32x4){0.f, 0.f, 0.f, 0.f};
        cur = nxt; cA = nA; cB = nB; ++ui;
    }
    PG8_WAIT_V(0);
    if (wr == 0) PG8_BAR;
    PG8_BAR;
    if constexpr (Epi::AFTER_DRAIN) { E.fused(acc, cur, wr, wc, fr, fq, lds, wid, lane); S.done(cur); }
#undef PG8_SA
#undef PG8_SB
#undef PG8_STAGE
#undef PG8_LDA
#undef PG8_LDB
#undef PG8_MMA
#undef PG8_WAIT_V
#undef PG8_WAIT_L
#undef PG8_BAR
#undef PG8_SCHED
}
}

__device__ __forceinline__ float ssq_total(const float* __restrict__ SSQ, int t) {
  const f32x4 a = *(const f32x4*)(SSQ + (size_t)t * 16), b = *(const f32x4*)(SSQ + (size_t)t * 16 + 4), c = *(const f32x4*)(SSQ + (size_t)t * 16 + 8), d = *(const f32x4*)(SSQ + (size_t)t * 16 + 12);
  return (((a.x + a.y) + (a.z + a.w)) + ((b.x + b.y) + (b.z + b.w))) + (((c.x + c.y) + (c.z + c.w)) + ((d.x + d.y) + (d.z + d.w)));
}
struct EpiProj {
  static constexpr bool PERM = true, AFTER_DRAIN = false;
  bf16_t* PROJ; bf16_t* VTA; bf16_t* VTR;
  __device__ __forceinline__ void operator()(const f32x4 (&acc)[2][2][4][2], const pg8::Unit& u, int wr, int wc, int fr, int fq) const {
    const int row0 = u.pm * 256 + wr * 64 + fr, col0 = u.pn * 256 + wc * 32 + 8 * fq;
    asm volatile("s_nop 15\n\ts_nop 15" ::: "memory");
#pragma unroll
    for (int ai = 0; ai < 2; ++ai)
#pragma unroll
      for (int m = 0; m < 4; ++m) {
        const int t = row0 + ai * 128 + m * 16;
#pragma unroll
        for (int bj = 0; bj < 2; ++bj) {
          const int c = col0 + bj * 128;
          const f32x4 v0 = acc[ai][bj][m][0], v1 = acc[ai][bj][m][1];
          pg8::u32x4 w; w.x = pg8::cvt_pk_bf16(v0[0], v0[1]); w.y = pg8::cvt_pk_bf16(v0[2], v0[3]); w.z = pg8::cvt_pk_bf16(v1[0], v1[1]); w.w = pg8::cvt_pk_bf16(v1[2], v1[3]);
          *(pg8::u32x4*)(PROJ + (size_t)t * INCP + c) = w;
          const bool isva = (c >= C_VA && c < C_VA + 384), isvr = (c >= C_VR && c < C_VR + 384);
          if (isva || isvr) {
            bf16_t* vt = (isva ? VTA : VTR) + ((size_t)(t >> 13) * 384 + (c - (isva ? C_VA : C_VR))) * 8192 + (t & 8191);
            vt[0] = (bf16_t)(w.x & 0xffffu); vt[8192] = (bf16_t)(w.x >> 16); vt[2 * 8192] = (bf16_t)(w.y & 0xffffu); vt[3 * 8192] = (bf16_t)(w.y >> 16);
            vt[4 * 8192] = (bf16_t)(w.z & 0xffffu); vt[5 * 8192] = (bf16_t)(w.z >> 16); vt[6 * 8192] = (bf16_t)(w.w & 0xffffu); vt[7 * 8192] = (bf16_t)(w.w >> 16);
          }
        }
      }
  }
};
struct EpiOut {
  static constexpr bool PERM = true, AFTER_DRAIN = false;
  const float* xin; int first; bf16_t* X; const float* g1; const float* nf; const float* sc2; bf16_t* XG; float* SSQ;
  __device__ __forceinline__ void operator()(const f32x4 (&acc)[2][2][4][2], const pg8::Unit& u, int wr, int wc, int fr, int fq) const {
    const int row0 = u.pm * 256 + wr * 64 + fr, col0 = u.pn * 256 + wc * 32 + 8 * fq, b = (u.pm * 256) >> 13;
    f32x4 gg[2][2], gs[2][2];
#pragma unroll
    for (int bj = 0; bj < 2; ++bj)
#pragma unroll
      for (int n = 0; n < 2; ++n) {
        const int c = col0 + bj * 128 + n * 4;
        gg[bj][n] = *(const f32x4*)(g1 + b * 6144 + c);
        const f32x4 gf = *(const f32x4*)(nf + c), sc = *(const f32x4*)(sc2 + b * 6144 + c);
        gs[bj][n] = gf * (sc + 1.f);
      }
#pragma unroll
    for (int ai = 0; ai < 2; ++ai)
#pragma unroll
      for (int m = 0; m < 4; ++m) {
        const int t = row0 + ai * 128 + m * 16;
        float sq = 0.f;
#pragma unroll
        for (int bj = 0; bj < 2; ++bj) {
          const int c = col0 + bj * 128;
          f32x4 x0, x1;
          if (first) { x0 = *(const f32x4*)(xin + (size_t)t * 1024 + c); x1 = *(const f32x4*)(xin + (size_t)t * 1024 + c + 4); }
          else {
            const pg8::u32x4 xr = *(const pg8::u32x4*)(X + (size_t)t * 1024 + c);
            x0 = (f32x4){__uint_as_float(xr.x << 16), __uint_as_float(xr.x & 0xffff0000u), __uint_as_float(xr.y << 16), __uint_as_float(xr.y & 0xffff0000u)};
            x1 = (f32x4){__uint_as_float(xr.z << 16), __uint_as_float(xr.z & 0xffff0000u), __uint_as_float(xr.w << 16), __uint_as_float(xr.w & 0xffff0000u)};
          }
          const f32x4 n0 = x0 + gg[bj][0] * acc[ai][bj][m][0], n1 = x1 + gg[bj][1] * acc[ai][bj][m][1];
          pg8::u32x4 xo; xo.x = pg8::cvt_pk_bf16(n0.x, n0.y); xo.y = pg8::cvt_pk_bf16(n0.z, n0.w); xo.z = pg8::cvt_pk_bf16(n1.x, n1.y); xo.w = pg8::cvt_pk_bf16(n1.z, n1.w);
          *(pg8::u32x4*)(X + (size_t)t * 1024 + c) = xo;
          const f32x4 s0 = n0 * gs[bj][0], s1 = n1 * gs[bj][1];
          pg8::u32x4 go; go.x = pg8::cvt_pk_bf16(s0.x, s0.y); go.y = pg8::cvt_pk_bf16(s0.z, s0.w); go.z = pg8::cvt_pk_bf16(s1.x, s1.y); go.w = pg8::cvt_pk_bf16(s1.z, s1.w);
          *(pg8::u32x4*)(XG + (size_t)t * 1024 + c) = go;
          sq += ((n0.x * n0.x + n0.y * n0.y) + (n0.z * n0.z + n0.w * n0.w)) + ((n1.x * n1.x + n1.y * n1.y) + (n1.z * n1.z + n1.w * n1.w));
        }
        sq += __shfl_xor(sq, 16); sq += __shfl_xor(sq, 32);
        if (fq == 0) SSQ[(size_t)t * 16 + u.pn * 4 + wc] = sq;
      }
  }
};
struct EpiQ {
  static constexpr bool PERM = true, AFTER_DRAIN = false;
  bf16_t* SC8; const float* SSQ; const float* C2;
  __device__ __forceinline__ void operator()(const f32x4 (&acc)[2][2][4][2], const pg8::Unit& u, int wr, int wc, int fr, int fq) const {
    const int row0 = u.pm * 256 + wr * 64 + fr, col0 = u.pn * 256 + wc * 32 + 8 * fq, b = (u.pm * 256) >> 13;
    f32x4 cc[2][2];
#pragma unroll
    for (int bj = 0; bj < 2; ++bj) { cc[bj][0] = *(const f32x4*)(C2 + b * 2048 + col0 + bj * 128); cc[bj][1] = *(const f32x4*)(C2 + b * 2048 + col0 + bj * 128 + 4); }
#pragma unroll
    for (int ai = 0; ai < 2; ++ai)
#pragma unroll
      for (int m = 0; m < 4; ++m) {
        const int t = row0 + ai * 128 + m * 16;
        const float rstd = rsqrtf(ssq_total(SSQ, t) * (1.f / 1024.f) + EPS_);
#pragma unroll
        for (int bj = 0; bj < 2; ++bj) {
          const f32x4 v0 = acc[ai][bj][m][0] * rstd + cc[bj][0], v1 = acc[ai][bj][m][1] * rstd + cc[bj][1];
          pg8::u32x4 w; w.x = pg8::cvt_pk_bf16(v0[0], v0[1]); w.y = pg8::cvt_pk_bf16(v0[2], v0[3]); w.z = pg8::cvt_pk_bf16(v1[0], v1[1]); w.w = pg8::cvt_pk_bf16(v1[2], v1[3]);
          *(pg8::u32x4*)(SC8 + ((size_t)((col0 + bj * 128) >> 3) * T_ + t) * 8) = w;
        }
      }
  }
};

__device__ void gemm_proj_phase(const Params& p, int l, unsigned char* smem) {
  const CParamsP pp = launder_kargs();
  GAS unsigned char* const ws = launder_ptr(pp->ws);
  pg8::Gemm g; g.A = (const bf16_t*)(ws + WS_ABUF); g.Bt = (const bf16_t*)(ws + WS_WIN) + (size_t)l * INCP * 1024; g.M = T_; g.N = INCP; g.K = 1024;
  pg8::StaticOrder S; S.init(T_, INCP, gridDim.x, blockIdx.x);
  EpiProj E; E.PROJ = (bf16_t*)(ws + WS_PROJ); E.VTA = (bf16_t*)(ws + WS_VTA); E.VTR = (bf16_t*)(ws + WS_VTR);
  pg8::gemm_phase<EpiProj, pg8::StaticOrder>((PG8_LAS unsigned char*)smem, g, S, E);
}
__device__ void gemm_out_phase(const Params& p, int l, unsigned char* smem) {
  const CParamsP pp = launder_kargs();
  GAS unsigned char* const ws = launder_ptr(pp->ws);
  pg8::Gemm g; g.A = (const bf16_t*)(ws + WS_ABUF); g.Bt = (const bf16_t*)(ws + WS_WOUT) + (size_t)l * 1024 * 1024; g.M = T_; g.N = 1024; g.K = 1024;
  pg8::StaticOrder S; S.init(T_, 1024, gridDim.x, blockIdx.x);
  EpiOut E; E.xin = gin(pp->in[I_X]); E.first = (l == 0) ? 1 : 0; E.X = (bf16_t*)(ws + WS_X); E.g1 = (const float*)(ws + WS_MOD) + (size_t)l * 2 * 6144 + 2048;
  E.nf = gin(pp->in[I_NFFN]) + (size_t)l * 1024; E.sc2 = (const float*)(ws + WS_MOD) + (size_t)l * 2 * 6144 + 4096; E.XG = (bf16_t*)(ws + WS_XG); E.SSQ = (float*)(ws + WS_SSQ);
  pg8::gemm_phase<EpiOut, pg8::StaticOrder>((PG8_LAS unsigned char*)smem, g, S, E);
}
__device__ void gemm_q_phase(const Params& p, int l, unsigned char* smem) {
  const CParamsP pp = launder_kargs();
  GAS unsigned char* const ws = launder_ptr(pp->ws);
  pg8::Gemm g; g.A = (const bf16_t*)(ws + WS_XG); g.Bt = (const bf16_t*)(ws + WS_WQ) + (size_t)l * 2048 * 1024; g.M = T_; g.N = 2048; g.K = 1024;
  pg8::StaticOrder S; S.init(T_, 2048, gridDim.x, blockIdx.x);
  EpiQ E; E.SC8 = (bf16_t*)(ws + WS_SC); E.SSQ = (const float*)(ws + WS_SSQ); E.C2 = (const float*)(ws + WS_C2) + (size_t)l * 2 * 2048;
  pg8::gemm_phase<EpiQ, pg8::StaticOrder>((PG8_LAS unsigned char*)smem, g, S, E);
}

__device__ __forceinline__ int attn_fk(int r) { return ((r >> 3) & 3) | (((r >> 1) & 1) << 2); }
__device__ __forceinline__ int attn_fv(int r) { return (r >> 1) & 7; }
__device__ void attn_phase(const Params& p, int l, unsigned char* smem) {
  const CParamsP pp = launder_kargs();
  GAS unsigned char* const ws = launder_ptr(pp->ws); const int tidx = launder_tid();
  const bf16_t* PROJ = (const bf16_t*)(ws + WS_PROJ); const bf16_t* VTA = (const bf16_t*)(ws + WS_VTA);
  bf16_t* ATT = (bf16_t*)(ws + WS_ATT);
  const int lane = tidx & 63, wid = tidx >> 6, fr = lane & 15, fq = lane >> 4;
  float* ext = (float*)smem;
  unsigned char* stg = smem + 15360;
  constexpr float LOG2E = 1.4426950408889634f;
  __syncthreads();
  for (int idx = tidx; idx < 6 * 640; idx += NT) {
    const int h = idx / 640, e = idx - h * 640; int d = e - 63; d = d > 256 ? 256 : d;
    ext[idx] = gin(pp->in[I_RELB])[((size_t)l * 6 + h) * 513 + d + 256] * LOG2E;
  }
  const int hh = wid >> 2, qb = wid & 3, iq = qb * 16 + fr;
  const int srow = tidx >> 3, sch = tidx & 7;
  for (int it_ = blockIdx.x; it_ < 256; it_ += gridDim.x) {
    const int item = ((it_ & 7) << 5) | (it_ >> 3);
    const int b = item >> 7, n = item & 127, t0 = b * 8192 + n * 64;
    const int jc0 = n >= 8 ? 0 : 8 - n, nch = 9 - jc0, nst = 3 * nch;
    uint4 sa0, sa1, sa2, sa3, sb0, sb1, sb2, sb3;
#define ATTN_LOAD(S, st) do { const int _rd = (st) / nch, _jc = jc0 + (st) - _rd * nch, _m = n - 8 + _jc; \
      S##0 = *(const uint4*)(PROJ + (size_t)(b * 8192 + _m * 64 + srow) * INCP + C_KA + (2 * _rd) * 64 + sch * 8); \
      S##1 = *(const uint4*)(PROJ + (size_t)(b * 8192 + _m * 64 + srow) * INCP + C_KA + (2 * _rd + 1) * 64 + sch * 8); \
      S##2 = *(const uint4*)(VTA + ((size_t)b * 384 + (2 * _rd) * 64 + srow) * 8192 + _m * 64 + sch * 8); \
      S##3 = *(const uint4*)(VTA + ((size_t)b * 384 + (2 * _rd + 1) * 64 + srow) * 8192 + _m * 64 + sch * 8); } while (0)
#define ATTN_WRITE(S, buf) do { unsigned char* _bp = stg + (buf) * 32768; \
      *(uint4*)(_bp + srow * 128 + ((sch ^ attn_fk(srow)) << 4)) = S##0; \
      *(uint4*)(_bp + 8192 + srow * 128 + ((sch ^ attn_fk(srow)) << 4)) = S##1; \
      *(uint4*)(_bp + 16384 + srow * 128 + ((sch ^ attn_fv(srow)) << 4)) = S##2; \
      *(uint4*)(_bp + 24576 + srow * 128 + ((sch ^ attn_fv(srow)) << 4)) = S##3; } while (0)
    __syncthreads();
    ATTN_LOAD(sa, 0);
    ATTN_WRITE(sa, 0);
    if (1 < nst) ATTN_LOAD(sb, 1);
    __syncthreads();
    bf16x8 qf[2];
    f32x4 o[4];
    float mrun = -1e30f, lrun = 0.f;
    const float* exth = ext;
    auto attn_compute = [&](const int st) {
      const int rd = st / nch, jc = jc0 + st - rd * nch, h = 2 * rd + hh;
      if (jc == jc0) {
#pragma unroll
        for (int ds = 0; ds < 2; ++ds) qf[ds] = *(const bf16x8*)(PROJ + (size_t)(t0 + iq) * INCP + C_QA + h * 64 + ds * 32 + fq * 8);
#pragma unroll
        for (int et = 0; et < 4; ++et) o[et] = (f32x4){0.f, 0.f, 0.f, 0.f};
        mrun = -1e30f; lrun = 0.f;
        exth = ext + h * 640 + 63 + 512 + iq - 8 * fq;
      }
      const unsigned char* kb = stg + (st & 1) * 32768 + hh * 8192;
      const unsigned char* vb = stg + (st & 1) * 32768 + (2 + hh) * 8192;
      float sc[2][2][4];
      bf16x8 kfr[2][2][2], vfr[2][4]; float bia[2][2][4];
#pragma unroll
      for (int g = 0; g < 2; ++g)
#pragma unroll
        for (int tt = 0; tt < 2; ++tt) {
          const int key = 32 * g + 8 * (fr >> 2) + (fr & 3) + 4 * tt, fk = attn_fk(key);
          kfr[g][tt][0] = *(const bf16x8*)(kb + key * 128 + ((fq ^ fk) << 4));
          kfr[g][tt][1] = *(const bf16x8*)(kb + key * 128 + (((4 + fq) ^ fk) << 4));
        }
#pragma unroll
      for (int g = 0; g < 2; ++g)
#pragma unroll
        for (int tt = 0; tt < 2; ++tt)
#pragma unroll
          for (int j = 0; j < 4; ++j) bia[g][tt][j] = exth[-(64 * jc + 32 * g + 4 * tt + j)];
#pragma unroll
      for (int g = 0; g < 2; ++g)
#pragma unroll
        for (int et = 0; et < 4; ++et) { const int er = 16 * et + fr; vfr[g][et] = *(const bf16x8*)(vb + er * 128 + (((4 * g + fq) ^ attn_fv(er)) << 4)); }
      __builtin_amdgcn_sched_barrier(0);
#pragma unroll
      for (int g = 0; g < 2; ++g)
#pragma unroll
        for (int tt = 0; tt < 2; ++tt) {
          f32x4 s4 = __builtin_amdgcn_mfma_f32_16x16x32_bf16(kfr[g][tt][0], qf[0], (f32x4){0.f, 0.f, 0.f, 0.f}, 0, 0, 0);
          s4 = __builtin_amdgcn_mfma_f32_16x16x32_bf16(kfr[g][tt][1], qf[1], s4, 0, 0, 0);
#pragma unroll
          for (int j = 0; j < 4; ++j) sc[g][tt][j] = s4[j] * (0.125f * LOG2E) + bia[g][tt][j];
        }
      float mloc = -1e30f;
#pragma unroll
      for (int g = 0; g < 2; ++g)
#pragma unroll
        for (int tt = 0; tt < 2; ++tt)
#pragma unroll
          for (int j = 0; j < 4; ++j) mloc = fmaxf(mloc, sc[g][tt][j]);
      mloc = fmaxf(mloc, __shfl_xor(mloc, 16)); mloc = fmaxf(mloc, __shfl_xor(mloc, 32));
      const float mnew = fmaxf(mrun, mloc), alpha = __builtin_amdgcn_exp2f(mrun - mnew);
      mrun = mnew;
      float ls = 0.f;
#pragma unroll
      for (int g = 0; g < 2; ++g)
#pragma unroll
        for (int tt = 0; tt < 2; ++tt)
#pragma unroll
          for (int j = 0; j < 4; ++j) { const float e = __builtin_amdgcn_exp2f(sc[g][tt][j] - mnew); sc[g][tt][j] = e; ls += e; }
      lrun = lrun * alpha + ls;
#pragma unroll
      for (int et = 0; et < 4; ++et) { o[et].x *= alpha; o[et].y *= alpha; o[et].z *= alpha; o[et].w *= alpha; }
#pragma unroll
      for (int g = 0; g < 2; ++g) {
        union { bf16x8 v; unsigned u[4]; } pf;
        pf.u[0] = pk2(sc[g][0][0], sc[g][0][1]); pf.u[1] = pk2(sc[g][0][2], sc[g][0][3]);
        pf.u[2] = pk2(sc[g][1][0], sc[g][1][1]); pf.u[3] = pk2(sc[g][1][2], sc[g][1][3]);
#pragma unroll
        for (int et = 0; et < 4; ++et) o[et] = __builtin_amdgcn_mfma_f32_16x16x32_bf16(vfr[g][et], pf.v, o[et], 0, 0, 0);
      }
      if (jc == 8) {
        float lt = lrun + __shfl_xor(lrun, 16); lt += __shfl_xor(lt, 32);
        const float inv = 1.f / lt;
#pragma unroll
        for (int et = 0; et < 4; ++et) {
          f32x4 v = o[et]; v.x *= inv; v.y *= inv; v.z *= inv; v.w *= inv;
          { uint2 ov; ov.x = pk2(v.x, v.y); ov.y = pk2(v.z, v.w); *(uint2*)(ATT + (size_t)(t0 + iq) * 384 + h * 64 + et * 16 + fq * 4) = ov; }
        }
      }
    };
#pragma unroll 1
    for (int st0 = 0; st0 < nst; st0 += 2) {
      { const int st = st0;
        if (st + 2 < nst) ATTN_LOAD(sa, st + 2);
        attn_compute(st);
        if (st + 1 < nst) ATTN_WRITE(sb, (st + 1) & 1);
        __syncthreads(); }
      if (st0 + 1 < nst) { const int st = st0 + 1;
        if (st + 2 < nst) ATTN_LOAD(sb, st + 2);
        attn_compute(st);
        if (st + 1 < nst) ATTN_WRITE(sa, (st + 1) & 1);
        __syncthreads(); }
    }
#undef ATTN_LOAD
#undef ATTN_WRITE
  }
  __syncthreads();
}

__device__ __forceinline__ void ssm_bu32(const bf16_t* __restrict__ bbh_g, const bf16_t* __restrict__ urow, int lane,
                                         f32x16& lo_re, f32x16& hi_re, f32x16& lo_im, f32x16& hi_im) {
  const int hf = lane >> 5;
  const bf16x8 ub = *(const bf16x8*)(urow + 8 * hf);
  f32x16 z;
#pragma unroll
  for (int r = 0; r < 16; ++r) z[r] = 0.f;
  const bf16x8 a0r = *(const bf16x8*)(bbh_g + (size_t)(0 * 64 + lane) * 8), a1r = *(const bf16x8*)(bbh_g + (size_t)(1 * 64 + lane) * 8);
  const bf16x8 a0i = *(const bf16x8*)(bbh_g + (size_t)(2 * 64 + lane) * 8), a1i = *(const bf16x8*)(bbh_g + (size_t)(3 * 64 + lane) * 8);
  lo_re = __builtin_amdgcn_mfma_f32_32x32x16_bf16(ub, a0r, z, 0, 0, 0); hi_re = __builtin_amdgcn_mfma_f32_32x32x16_bf16(ub, a1r, z, 0, 0, 0);
  lo_im = __builtin_amdgcn_mfma_f32_32x32x16_bf16(ub, a0i, z, 0, 0, 0); hi_im = __builtin_amdgcn_mfma_f32_32x32x16_bf16(ub, a1i, z, 0, 0, 0);
#pragma unroll
  for (int r = 0; r < 16; ++r) {
    const auto s1 = __builtin_amdgcn_permlane32_swap(__float_as_uint(lo_re[r]), __float_as_uint(hi_re[r]), false, false);
    lo_re[r] = __uint_as_float(s1[0]); hi_re[r] = __uint_as_float(s1[1]);
    const auto s2 = __builtin_amdgcn_permlane32_swap(__float_as_uint(lo_im[r]), __float_as_uint(hi_im[r]), false, false);
    lo_im[r] = __uint_as_float(s2[0]); hi_im[r] = __uint_as_float(s2[1]);
  }
}
__device__ __forceinline__ void rotary_frag(const bf16x8 x0, const bf16x8 x1, const float* RC, const float* RS, int pos, int fq, float scale, bf16x8& o0, bf16x8& o1) {
  const f32x4 c0 = *(const f32x4*)(RC + pos * 32 + 8 * fq), c1 = *(const f32x4*)(RC + pos * 32 + 8 * fq + 4);
  const f32x4 s0 = *(const f32x4*)(RS + pos * 32 + 8 * fq), s1 = *(const f32x4*)(RS + pos * 32 + 8 * fq + 4);
  const float cc[8] = {c0.x, c0.y, c0.z, c0.w, c1.x, c1.y, c1.z, c1.w}, sn[8] = {s0.x, s0.y, s0.z, s0.w, s1.x, s1.y, s1.z, s1.w};
  union { bf16x8 v; unsigned u[4]; } r0, r1;
#pragma unroll
  for (int q = 0; q < 4; ++q) {
    const float a0 = bf2f((bf16_t)x0[2 * q]) * scale, a1 = bf2f((bf16_t)x0[2 * q + 1]) * scale, b0 = bf2f((bf16_t)x1[2 * q]) * scale, b1 = bf2f((bf16_t)x1[2 * q + 1]) * scale;
    r0.u[q] = pk2(a0 * cc[2 * q] - b0 * sn[2 * q], a1 * cc[2 * q + 1] - b1 * sn[2 * q + 1]);
    r1.u[q] = pk2(a0 * sn[2 * q] + b0 * cc[2 * q], a1 * sn[2 * q + 1] + b1 * cc[2 * q + 1]);
  }
  o0 = r0.v; o1 = r1.v;
}
__device__ void mix_local_phase(const Params& p, int l, unsigned char* smem) {
  const CParamsP pp = launder_kargs();
  GAS unsigned char* const ws = launder_ptr(pp->ws); const int tidx = launder_tid();
  const bf16_t* PROJ = (const bf16_t*)(ws + WS_PROJ); const bf16_t* VTR = (const bf16_t*)(ws + WS_VTR);
  const float* RC = (const float*)(ws + WS_ROTC); const float* RS = (const float*)(ws + WS_ROTS);
  bf16_t* YINT = (bf16_t*)(ws + WS_YINT); float* UPDT = (float*)(ws + WS_UPD);
  const float* SA = (const float*)(ws + WS_SA) + (size_t)l * 16 * 64 * 2; const bf16_t* BBH = (const bf16_t*)(ws + WS_BBH) + (size_t)l * 16 * 2 * 64 * 16;
  float* SEND = (float*)(ws + WS_SEND);
  const int tid = tidx, lane = tid & 63, wid = tid >> 6, fr = lane & 15, fq = lane >> 4;
  bf16_t* KT = (bf16_t*)smem;
  float* rcL = (float*)(smem + 55296); float* rsL = rcL + 2048;
  for (int it_ = blockIdx.x; it_ < 256; it_ += gridDim.x) {
    const int item = ((it_ & 7) << 5) | (it_ >> 3);
    const int b = item >> 7, n = item & 127, t0 = b * 8192 + n * 64;
    __syncthreads();
#pragma unroll
    for (int i = 0; i < 4; ++i) { rcL[tid + NT * i] = RC[n * 2048 + tid + NT * i]; rsL[tid + NT * i] = RS[n * 2048 + tid + NT * i]; }
    __syncthreads();
#pragma unroll 1
    for (int k3 = 0; k3 < 3; ++k3) {
      const int task = wid * 3 + k3, h = task >> 2, tb = task & 3;
      const int i = 16 * tb + fr;
      const float lg2 = log2f(1.f - exp2f(-5.f - (float)h));
      bf16x8 qraw[2], kraw[2][2][2], vraw[2][4];
      {
        const bf16_t* qp = PROJ + (size_t)(t0 + i) * INCP + C_QR + h * 64 + 8 * fq;
        qraw[0] = *(const bf16x8*)qp; qraw[1] = *(const bf16x8*)(qp + 32);
#pragma unroll
        for (int g = 0; g < 2; ++g) {
#pragma unroll
          for (int tt = 0; tt < 2; ++tt) {
            const int key = 32 * g + 8 * (fr >> 2) + (fr & 3) + 4 * tt;
            const bf16_t* kp = PROJ + (size_t)(t0 + key) * INCP + C_KR + h * 64 + 8 * fq;
            kraw[g][tt][0] = *(const bf16x8*)kp; kraw[g][tt][1] = *(const bf16x8*)(kp + 32);
          }
#pragma unroll
          for (int et = 0; et < 4; ++et) vraw[g][et] = *(const bf16x8*)(VTR + ((size_t)b * 384 + h * 64 + et * 16 + fr) * 8192 + n * 64 + 32 * g + 8 * fq);
        }
      }
      __builtin_amdgcn_sched_barrier(0);
      bf16x8 qf0, qf1;
      rotary_frag(qraw[0], qraw[1], rcL, rsL, i, fq, 1.f, qf0, qf1);
      f32x4 o[4];
#pragma unroll
      for (int et = 0; et < 4; ++et) o[et] = (f32x4){0.f, 0.f, 0.f, 0.f};
#pragma unroll
      for (int g = 0; g < 2; ++g) {
        float st[2][4];
#pragma unroll
        for (int tt = 0; tt < 2; ++tt) {
          const int key = 32 * g + 8 * (fr >> 2) + (fr & 3) + 4 * tt;
          bf16x8 kf0, kf1;
          rotary_frag(kraw[g][tt][0], kraw[g][tt][1], rcL, rsL, key, fq, 0.125f, kf0, kf1);
          f32x4 s4 = __builtin_amdgcn_mfma_f32_16x16x32_bf16(kf0, qf0, (f32x4){0.f, 0.f, 0.f, 0.f}, 0, 0, 0);
          s4 = __builtin_amdgcn_mfma_f32_16x16x32_bf16(kf1, qf1, s4, 0, 0, 0);
#pragma unroll
          for (int j = 0; j < 4; ++j) {
            const int kk = 32 * g + 8 * fq + 4 * tt + j;
            const int dij = i > kk ? i - kk : kk - i;
            st[tt][j] = s4[j] * exp2f(lg2 * (float)dij);
          }
          if (tb == 0) {
            const float kd = exp2f(lg2 * (float)(63 - key));
#pragma unroll
            for (int jj = 0; jj < 8; ++jj) {
              KT[(h * 64 + 8 * fq + jj) * 72 + key] = f2bf(bf2f((bf16_t)kf0[jj]) * kd);
              KT[(h * 64 + 32 + 8 * fq + jj) * 72 + key] = f2bf(bf2f((bf16_t)kf1[jj]) * kd);
            }
          }
        }
        union { bf16x8 v; unsigned u[4]; } pf;
        pf.u[0] = pk2(st[0][0], st[0][1]); pf.u[1] = pk2(st[0][2], st[0][3]); pf.u[2] = pk2(st[1][0], st[1][1]); pf.u[3] = pk2(st[1][2], st[1][3]);
#pragma unroll
        for (int et = 0; et < 4; ++et) o[et] = __builtin_amdgcn_mfma_f32_16x16x32_bf16(vraw[g][et], pf.v, o[et], 0, 0, 0);
      }
#pragma unroll
      for (int et = 0; et < 4; ++et) { uint2 ov; ov.x = pk2(o[et].x, o[et].y); ov.y = pk2(o[et].z, o[et].w); *(uint2*)(YINT + (((((size_t)item * 6 + h) * 4 + tb) * 4 + et) * 64 + lane) * 4) = ov; }
    }
    __syncthreads();
#pragma unroll 1
    for (int k3 = 0; k3 < 3; ++k3) {
      const int task = wid * 3 + k3, h = task >> 2, et = task & 3;
      f32x4 acc[4];
#pragma unroll
      for (int dt = 0; dt < 4; ++dt) acc[dt] = (f32x4){0.f, 0.f, 0.f, 0.f};
#pragma unroll
      for (int g = 0; g < 2; ++g) {
        const bf16x8 vf = *(const bf16x8*)(VTR + ((size_t)b * 384 + h * 64 + et * 16 + fr) * 8192 + n * 64 + 32 * g + 8 * fq);
#pragma unroll
        for (int dt = 0; dt < 4; ++dt) {
          const bf16x8 kt = *(const bf16x8*)(KT + (h * 64 + 16 * dt + fr) * 72 + 32 * g + 8 * fq);
          acc[dt] = __builtin_amdgcn_mfma_f32_16x16x32_bf16(kt, vf, acc[dt], 0, 0, 0);
        }
      }
#pragma unroll
      for (int dt = 0; dt < 4; ++dt) *(f32x4*)(UPDT + (((size_t)item * 6 + h) * 64 + 16 * et + fr) * 64 + 16 * dt + 4 * fq) = acc[dt];
    }
#pragma unroll 1
    for (int gi = 0; gi < 2; ++gi) {
      const int g = wid * 2 + gi;
      const float are = SA[(g * 64 + lane) * 2], aim = SA[(g * 64 + lane) * 2 + 1];
      float xr = 0.f, xi = 0.f;
#pragma unroll 1
      for (int blk = 0; blk < 2; ++blk) {
        f32x16 lr, hr, li, hi;
        ssm_bu32(BBH + (size_t)g * 2 * 64 * 16, PROJ + (size_t)(t0 + 32 * blk + (lane & 31)) * INCP + C_US + g * 16, lane, lr, hr, li, hi);
#pragma unroll
        for (int a4 = 0; a4 < 4; ++a4) {
#pragma unroll
          for (int bq = 0; bq < 4; ++bq) { const float nr = are * xr - aim * xi + lr[4 * a4 + bq], ni = are * xi + aim * xr + li[4 * a4 + bq]; xr = nr; xi = ni; }
#pragma unroll
          for (int bq = 0; bq < 4; ++bq) { const float nr = are * xr - aim * xi + hr[4 * a4 + bq], ni = are * xi + aim * xr + hi[4 * a4 + bq]; xr = nr; xi = ni; }
        }
      }
      SEND[(((size_t)item * 16 + g) * 64 + lane) * 2] = xr; SEND[(((size_t)item * 16 + g) * 64 + lane) * 2 + 1] = xi;
    }
  }
}

__device__ void scan_phase(const Params& p, int l) {
  const CParamsP pp = launder_kargs();
  GAS unsigned char* const ws = launder_ptr(pp->ws); const int tidx = launder_tid();
  const float* __restrict__ UPDT = (const float*)(ws + WS_UPD); bf16_t* __restrict__ SPT = (bf16_t*)(ws + WS_SPT);
  const float* __restrict__ SEND = (const float*)(ws + WS_SEND); float* __restrict__ CARRY = (float*)(ws + WS_CARRY);
  const float* SA = (const float*)(ws + WS_SA) + (size_t)l * 16 * 64 * 2;
  const int gtid = blockIdx.x * NT + tidx, gn = gridDim.x * NT;
  for (int idx = gtid; idx < 2 * 6 * 4096 + 2 * 1024; idx += gn) {
    if (idx < 2 * 6 * 4096) {
      const int b = idx / (6 * 4096), r = idx % (6 * 4096), h = r >> 12;
      const float cd = exp2f(64.f * log2f(1.f - exp2f(-5.f - (float)h)));
      const int e_ = (r >> 6) & 63, d_ = r & 63;
      const int spoff = h * 4096 + ((((e_ >> 4) * 2 + (d_ >> 5)) * 64 + ((d_ >> 3) & 3) * 16 + (e_ & 15)) * 8 + (d_ & 7));
      float s = 0.f;
#pragma unroll 1
      for (int nb = 0; nb < NCH; nb += 16) {
        float v[16];
#pragma unroll
        for (int j = 0; j < 16; ++j) v[j] = UPDT[((size_t)(b * NCH + nb + j)) * 6 * 4096 + r];
#pragma unroll
        for (int j = 0; j < 16; ++j) { SPT[((size_t)(b * NCH + nb + j)) * 6 * 4096 + spoff] = f2bf(s); s = cd * s + v[j]; }
      }
    } else {
      const int r2 = idx - 2 * 6 * 4096, b = r2 >> 10, gp = r2 & 1023;
      float ar = SA[gp * 2], ai = SA[gp * 2 + 1];
#pragma unroll
      for (int q = 0; q < 6; ++q) { const float nr = ar * ar - ai * ai, ni = 2.f * ar * ai; ar = nr; ai = ni; }
      float xr = 0.f, xi = 0.f;
#pragma unroll 1
      for (int nb = 0; nb < NCH; nb += 16) {
        float2 v[16];
#pragma unroll
        for (int j = 0; j < 16; ++j) v[j] = *(const float2*)(SEND + (((size_t)(b * NCH + nb + j)) * 1024 + gp) * 2);
#pragma unroll
        for (int j = 0; j < 16; ++j) {
          *(float2*)(CARRY + (((size_t)(b * NCH + nb + j)) * 1024 + gp) * 2) = make_float2(xr, xi);
          const float nr = ar * xr - ai * xi + v[j].x, ni = ar * xi + ai * xr + v[j].y;
          xr = nr; xi = ni;
        }
      }
    }
  }
  if (l + 1 < DEPTH_) convert_tables_fp4(pp, ws, l + 1, gtid, gn);
}

__device__ void mix_final_phase(const Params& p, int l, unsigned char* smem) {
  const CParamsP pp = launder_kargs();
  GAS unsigned char* const ws = launder_ptr(pp->ws); const int tidx = launder_tid();
  const bf16_t* PROJ = (const bf16_t*)(ws + WS_PROJ);
  const float* RC = (const float*)(ws + WS_ROTC); const float* RS = (const float*)(ws + WS_ROTS);
  const bf16_t* YINT = (const bf16_t*)(ws + WS_YINT); const bf16_t* SPT = (const bf16_t*)(ws + WS_SPT);
  const bf16_t* ATT = (const bf16_t*)(ws + WS_ATT);
  const float* SA = (const float*)(ws + WS_SA) + (size_t)l * 16 * 64 * 2; const bf16_t* BBH = (const bf16_t*)(ws + WS_BBH) + (size_t)l * 16 * 2 * 64 * 16;
  const float* CARRY = (const float*)(ws + WS_CARRY);
  const bf16_t* CB = (const bf16_t*)(ws + WS_CB) + (size_t)l * 16 * 16 * 128; const bf16_t* WG = (const bf16_t*)(ws + WS_WGLUT) + (size_t)l * 512 * 256;
  const float* dsk = gin(pp->in[I_SSMD]) + (size_t)l * 256;
  const float* mg = gin(pp->in[I_MGAIN]) + (size_t)l * 1024;
  bf16_t* MRG = (bf16_t*)(ws + WS_ABUF);
  const int tid = tidx, lane = tid & 63, wid = tid >> 6, fr = lane & 15, fq = lane >> 4;
  bf16_t* YS = (bf16_t*)smem;
  float* red = (float*)(smem + 33792);
  bf16_t* XB = (bf16_t*)(smem + 36864 + wid * 8448 + 4096);
  float* rcL = (float*)(smem + 104448); float* rsL = rcL + 2048;
  for (int it_ = blockIdx.x; it_ < 256; it_ += gridDim.x) {
    const int item = ((it_ & 7) << 5) | (it_ >> 3);
    const int b = item >> 7, n = item & 127, t0 = b * 8192 + n * 64;
    __syncthreads();
#pragma unroll
    for (int i = 0; i < 4; ++i) { rcL[tid + NT * i] = RC[n * 2048 + tid + NT * i]; rsL[tid + NT * i] = RS[n * 2048 + tid + NT * i]; }
    __syncthreads();
    {
      float av[8][6], mgl[6];
#pragma unroll
      for (int ii = 0; ii < 8; ++ii)
#pragma unroll
        for (int j = 0; j < 6; ++j) av[ii][j] = bf2f(ATT[(size_t)(t0 + wid * 8 + ii) * 384 + lane + 64 * j]);
#pragma unroll
      for (int j = 0; j < 6; ++j) mgl[j] = mg[lane + 64 * j];
      __builtin_amdgcn_sched_barrier(0);
#pragma unroll
      for (int ii = 0; ii < 8; ++ii) {
        const int t = t0 + wid * 8 + ii;
        float sq = 0.f;
#pragma unroll
        for (int j = 0; j < 6; ++j) sq += av[ii][j] * av[ii][j];
        const float rstd = rsqrtf(wave_sum(sq) * (1.f / 384.f) + EPS_);
#pragma unroll
        for (int j = 0; j < 6; ++j) MRG[(size_t)t * 1024 + lane + 64 * j] = f2bf(av[ii][j] * rstd * mgl[j]);
      }
    }
#pragma unroll 1
    for (int k3 = 0; k3 < 3; ++k3) {
      const int task = wid * 3 + k3, h = task >> 2, tb = task & 3;
      const int i = 16 * tb + fr, t = t0 + i;
      const float lg2 = log2f(1.f - exp2f(-5.f - (float)h));
      bf16x8 qraw[2], spf[4][2]; f32x4 yiv[4], mgq[4]; uint2 grv[4];
      {
        const bf16_t* qp = PROJ + (size_t)t * INCP + C_QR + h * 64 + 8 * fq;
        qraw[0] = *(const bf16x8*)qp; qraw[1] = *(const bf16x8*)(qp + 32);
#pragma unroll
        for (int et = 0; et < 4; ++et) {
          const bf16_t* sp = SPT + ((size_t)item * 6 + h) * 4096 + (size_t)(et * 2) * 512 + lane * 8;
          spf[et][0] = *(const bf16x8*)sp; spf[et][1] = *(const bf16x8*)(sp + 512);
          { const uint2 yr = *(const uint2*)(YINT + (((((size_t)item * 6 + h) * 4 + tb) * 4 + et) * 64 + lane) * 4); yiv[et] = (f32x4){__uint_as_float(yr.x << 16), __uint_as_float(yr.x & 0xffff0000u), __uint_as_float(yr.y << 16), __uint_as_float(yr.y & 0xffff0000u)}; }
          grv[et] = *(const uint2*)(PROJ + (size_t)t * INCP + C_GR + h * 64 + 16 * et + 4 * fq);
          mgq[et] = *(const f32x4*)(mg + 384 + h * 64 + 16 * et + 4 * fq);
        }
      }
      __builtin_amdgcn_sched_barrier(0);
      bf16x8 qf0, qf1;
      rotary_frag(qraw[0], qraw[1], rcL, rsL, i, fq, 1.f, qf0, qf1);
      f32x4 o[4];
#pragma unroll
      for (int et = 0; et < 4; ++et) {
        o[et] = __builtin_amdgcn_mfma_f32_16x16x32_bf16(spf[et][0], qf0, (f32x4){0.f, 0.f, 0.f, 0.f}, 0, 0, 0);
        o[et] = __builtin_amdgcn_mfma_f32_16x16x32_bf16(spf[et][1], qf1, o[et], 0, 0, 0);
      }
      const float qd = exp2f(lg2 * (float)(i + 1));
      float y[16]; float s1 = 0.f;
#pragma unroll
      for (int et = 0; et < 4; ++et) {
        const f32x4 yi = yiv[et];
        y[4 * et] = yi.x + qd * o[et].x; y[4 * et + 1] = yi.y + qd * o[et].y; y[4 * et + 2] = yi.z + qd * o[et].z; y[4 * et + 3] = yi.w + qd * o[et].w;
        s1 += (y[4 * et] + y[4 * et + 1]) + (y[4 * et + 2] + y[4 * et + 3]);
      }
      s1 += __shfl_xor(s1, 16); s1 += __shfl_xor(s1, 32);
      const float mu = s1 * (1.f / 64.f);
      float s2 = 0.f;
#pragma unroll
      for (int q = 0; q < 16; ++q) { y[q] -= mu; s2 += y[q] * y[q]; }
      s2 += __shfl_xor(s2, 16); s2 += __shfl_xor(s2, 32);
      const float rstd = rsqrtf(s2 * (1.f / 64.f) + EPS_);
#pragma unroll
      for (int et = 0; et < 4; ++et) {
        const int c = h * 64 + 16 * et + 4 * fq;
        const uint2 gr = grv[et];
        const float g0 = __uint_as_float(gr.x << 16), g1 = __uint_as_float(gr.x & 0xffff0000u), g2 = __uint_as_float(gr.y << 16), g3 = __uint_as_float(gr.y & 0xffff0000u);
        const f32x4 mgv = mgq[et];
        uint2 ov;
        ov.x = pk2(y[4 * et] * rstd * (g0 * sigmoid_f(g0)) * mgv.x, y[4 * et + 1] * rstd * (g1 * sigmoid_f(g1)) * mgv.y);
        ov.y = pk2(y[4 * et + 2] * rstd * (g2 * sigmoid_f(g2)) * mgv.z, y[4 * et + 3] * rstd * (g3 * sigmoid_f(g3)) * mgv.w);
        *(uint2*)(MRG + (size_t)t * 1024 + 384 + c) = ov;
      }
    }
#pragma unroll 1
    for (int gi = 0; gi < 2; ++gi) {
      const int g = wid * 2 + gi;
      const float are = SA[(g * 64 + lane) * 2], aim = SA[(g * 64 + lane) * 2 + 1];
      float xr = CARRY[(((size_t)item * 16 + g) * 64 + lane) * 2], xi = CARRY[(((size_t)item * 16 + g) * 64 + lane) * 2 + 1];
      bf16x8 cb[4];
#pragma unroll
      for (int ks = 0; ks < 4; ++ks) cb[ks] = *(const bf16x8*)(CB + (((size_t)g * 4 + ks) * 64 + lane) * 8);
      const float dv = dsk[g * 16 + fr];
#pragma unroll 1
      for (int blk = 0; blk < 2; ++blk) {
        f32x16 lr, hr, li, hi;
        bf16_t uraw[2][4];
#pragma unroll
        for (int half = 0; half < 2; ++half)
#pragma unroll
          for (int j = 0; j < 4; ++j) uraw[half][j] = PROJ[(size_t)(t0 + 32 * blk + 16 * half + 4 * fq + j) * INCP + C_US + g * 16 + fr];
        ssm_bu32(BBH + (size_t)g * 2 * 64 * 16, PROJ + (size_t)(t0 + 32 * blk + (lane & 31)) * INCP + C_US + g * 16, lane, lr, hr, li, hi);
#pragma unroll
        for (int half = 0; half < 2; ++half) {
#pragma unroll
          for (int a2 = 0; a2 < 2; ++a2) {
            const int a4 = 2 * half + a2;
#pragma unroll
            for (int bq = 0; bq < 4; ++bq) {
              const float nr = are * xr - aim * xi + lr[4 * a4 + bq], ni = are * xi + aim * xr + li[4 * a4 + bq]; xr = nr; xi = ni;
              XB[(8 * a2 + bq) * 136 + lane] = f2bf(xr); XB[(8 * a2 + bq) * 136 + 64 + lane] = f2bf(xi);
            }
#pragma unroll
            for (int bq = 0; bq < 4; ++bq) {
              const float nr = are * xr - aim * xi + hr[4 * a4 + bq], ni = are * xi + aim * xr + hi[4 * a4 + bq]; xr = nr; xi = ni;
              XB[(8 * a2 + 4 + bq) * 136 + lane] = f2bf(xr); XB[(8 * a2 + 4 + bq) * 136 + 64 + lane] = f2bf(xi);
            }
          }
          f32x4 acc = (f32x4){0.f, 0.f, 0.f, 0.f};
#pragma unroll
          for (int ks = 0; ks < 4; ++ks) {
            const bf16x8 af = *(const bf16x8*)(XB + fr * 136 + 32 * ks + 8 * fq);
            acc = __builtin_amdgcn_mfma_f32_16x16x32_bf16(af, cb[ks], acc, 0, 0, 0);
          }
#pragma unroll
          for (int j = 0; j < 4; ++j) {
            const int i = 32 * blk + 16 * half + 4 * fq + j;
            const float yv = acc[j] + dv * bf2f(uraw[half][j]);
            YS[i * 264 + g * 16 + fr] = f2bf(gelu_tanh(yv));
          }
        }
      }
    }
    __syncthreads();
    {
      const int n0 = 32 * wid;
      f32x4 a1[4][2], a2[4][2];
#pragma unroll
      for (int mt = 0; mt < 4; ++mt)
#pragma unroll
        for (int nt = 0; nt < 2; ++nt) { a1[mt][nt] = (f32x4){0.f, 0.f, 0.f, 0.f}; a2[mt][nt] = (f32x4){0.f, 0.f, 0.f, 0.f}; }
#pragma unroll 1
      for (int kh = 0; kh < 2; ++kh) {
        bf16x8 w1[4][2], w2[4][2];
#pragma unroll
        for (int k4 = 0; k4 < 4; ++k4)
#pragma unroll
          for (int nt = 0; nt < 2; ++nt) {
            w1[k4][nt] = *(const bf16x8*)(WG + ((((size_t)wid * 8 + 4 * kh + k4) * 2 + 0) * 2 + nt) * 512 + lane * 8);
            w2[k4][nt] = *(const bf16x8*)(WG + ((((size_t)wid * 8 + 4 * kh + k4) * 2 + 1) * 2 + nt) * 512 + lane * 8);
          }
        __builtin_amdgcn_sched_barrier(0);
#pragma unroll
        for (int k4 = 0; k4 < 4; ++k4) {
          const int ks = 4 * kh + k4;
          bf16x8 yb[4];
#pragma unroll
          for (int mt = 0; mt < 4; ++mt) yb[mt] = *(const bf16x8*)(YS + (16 * mt + fr) * 264 + 32 * ks + 8 * fq);
#pragma unroll
          for (int mt = 0; mt < 4; ++mt)
#pragma unroll
            for (int nt = 0; nt < 2; ++nt) {
              a1[mt][nt] = __builtin_amdgcn_mfma_f32_16x16x32_bf16(w1[k4][nt], yb[mt], a1[mt][nt], 0, 0, 0);
              a2[mt][nt] = __builtin_amdgcn_mfma_f32_16x16x32_bf16(w2[k4][nt], yb[mt], a2[mt][nt], 0, 0, 0);
            }
        }
      }
#pragma unroll
      for (int mt = 0; mt < 4; ++mt) {
        float sq = 0.f;
#pragma unroll
        for (int nt = 0; nt < 2; ++nt) {
          f32x4 z = a1[mt][nt]; const f32x4 zg = a2[mt][nt];
          z.x *= sigmoid_f(zg.x); z.y *= sigmoid_f(zg.y); z.z *= sigmoid_f(zg.z); z.w *= sigmoid_f(zg.w);
          a1[mt][nt] = z; sq += z.x * z.x + z.y * z.y + z.z * z.z + z.w * z.w;
        }
        sq += __shfl_xor(sq, 16); sq += __shfl_xor(sq, 32);
        if (fq == 0) red[wid * 64 + 16 * mt + fr] = sq;
      }
      __syncthreads();
#pragma unroll
      for (int mt = 0; mt < 4; ++mt) {
        const int i = 16 * mt + fr, t = t0 + i;
        float tot = 0.f;
#pragma unroll
        for (int w8 = 0; w8 < 8; ++w8) tot += red[w8 * 64 + i];
        const float rstd = rsqrtf(tot * (1.f / 256.f) + EPS_);
#pragma unroll
        for (int nt = 0; nt < 2; ++nt) {
          const int c = n0 + 16 * nt + 4 * fq;
          const f32x4 mgv = *(const f32x4*)(mg + 768 + c); const f32x4 z = a1[mt][nt];
          uint2 ov; ov.x = pk2(z.x * rstd * mgv.x, z.y * rstd * mgv.y); ov.y = pk2(z.z * rstd * mgv.z, z.w * rstd * mgv.w);
          *(uint2*)(MRG + (size_t)t * 1024 + 768 + c) = ov;
        }
      }
    }
  }
}

typedef float f32x2 __attribute__((ext_vector_type(2)));
__device__ __forceinline__ float dot16_fp4(const uint2 u, const f32x2 (&hv)[8]) {
  f32x2 d = __builtin_amdgcn_cvt_scalef32_pk_f32_fp4(u.x, 1.0f, 0) * hv[0];
  d += __builtin_amdgcn_cvt_scalef32_pk_f32_fp4(u.x, 1.0f, 1) * hv[1];
  d += __builtin_amdgcn_cvt_scalef32_pk_f32_fp4(u.x, 1.0f, 2) * hv[2];
  d += __builtin_amdgcn_cvt_scalef32_pk_f32_fp4(u.x, 1.0f, 3) * hv[3];
  d += __builtin_amdgcn_cvt_scalef32_pk_f32_fp4(u.y, 1.0f, 0) * hv[4];
  d += __builtin_amdgcn_cvt_scalef32_pk_f32_fp4(u.y, 1.0f, 1) * hv[5];
  d += __builtin_amdgcn_cvt_scalef32_pk_f32_fp4(u.y, 1.0f, 2) * hv[6];
  d += __builtin_amdgcn_cvt_scalef32_pk_f32_fp4(u.y, 1.0f, 3) * hv[7];
  return d.x + d.y;
}
__device__ __forceinline__ void axpy16_fp4(const uint2 v, const float w, f32x2 (&acc)[8]) {
  const f32x2 w2 = (f32x2){w, w};
  acc[0] += w2 * __builtin_amdgcn_cvt_scalef32_pk_f32_fp4(v.x, 1.0f, 0);
  acc[1] += w2 * __builtin_amdgcn_cvt_scalef32_pk_f32_fp4(v.x, 1.0f, 1);
  acc[2] += w2 * __builtin_amdgcn_cvt_scalef32_pk_f32_fp4(v.x, 1.0f, 2);
  acc[3] += w2 * __builtin_amdgcn_cvt_scalef32_pk_f32_fp4(v.x, 1.0f, 3);
  acc[4] += w2 * __builtin_amdgcn_cvt_scalef32_pk_f32_fp4(v.y, 1.0f, 0);
  acc[5] += w2 * __builtin_amdgcn_cvt_scalef32_pk_f32_fp4(v.y, 1.0f, 1);
  acc[6] += w2 * __builtin_amdgcn_cvt_scalef32_pk_f32_fp4(v.y, 1.0f, 2);
  acc[7] += w2 * __builtin_amdgcn_cvt_scalef32_pk_f32_fp4(v.y, 1.0f, 3);
}
__device__ __forceinline__ float vmaxf(float a, float b) { float r; asm("v_max_f32 %0, %1, %2" : "=v"(r) : "v"(a), "v"(b)); return r; }
__device__ __forceinline__ float vminf(float a, float b) { float r; asm("v_min_f32 %0, %1, %2" : "=v"(r) : "v"(a), "v"(b)); return r; }
__device__ __forceinline__ void cx(float& hi, float& lo) { const float a = hi, b = lo; hi = vmaxf(a, b); lo = vminf(a, b); }
__device__ __forceinline__ void cx2(float& kh, int& ph, float& kl, int& pl) {
  const float a = kh, b = kl; const int pa = ph, pb = pl; const bool c = a >= b;
  kh = vmaxf(a, b); kl = vminf(a, b); ph = c ? pa : pb; pl = c ? pb : pa;
}
__device__ __forceinline__ void bitonic_sort16_desc(float (&v)[16]) {
#pragma unroll
  for (int k = 2; k <= 16; k <<= 1)
#pragma unroll
    for (int j = k >> 1; j > 0; j >>= 1)
#pragma unroll
      for (int i = 0; i < 16; ++i) {
        const int l = i ^ j;
        if (l > i) { if ((i & k) == 0) cx(v[i], v[l]); else cx(v[l], v[i]); }
      }
}
__device__ __forceinline__ void bitonic_merge16_desc(float (&v)[16]) {
#pragma unroll
  for (int j = 8; j > 0; j >>= 1)
#pragma unroll
    for (int i = 0; i < 16; ++i) { const int l = i ^ j; if (l > i) cx(v[i], v[l]); }
}
__device__ __forceinline__ void top16_merge(float (&a)[16], const float (&b)[16]) {
#pragma unroll
  for (int i = 0; i < 16; ++i) a[i] = vmaxf(a[i], b[15 - i]);
  bitonic_merge16_desc(a);
}
template <int M> __device__ __forceinline__ void top16_merge_chain(float (&k)[16], int (&q)[16], const float (&xk)[M], const int (&xq)[M]) {
#pragma unroll
  for (int i = 16 - M; i < 16; ++i) { const float a = k[i], b = xk[15 - i]; const bool c = a >= b; k[i] = vmaxf(a, b); q[i] = c ? q[i] : xq[15 - i]; }
#pragma unroll
  for (int j = 8; j > 0; j >>= 1)
#pragma unroll
    for (int i = 0; i < 16; ++i) { const int l = i ^ j; if (l > i) cx2(k[i], q[i], k[l], q[l]); }
}

typedef unsigned u32x4v __attribute__((ext_vector_type(4)));
__device__ __forceinline__ void peer_req_rows16(u32x4v (&Q)[8], const unsigned char* tab, int e, int hi5, unsigned lane16) {
#pragma unroll
  for (int r = 0; r < 8; ++r) {
    const int ea = __builtin_amdgcn_readlane(e, 2 * r), eb = __builtin_amdgcn_readlane(e, 2 * r + 1);
    const unsigned off = (unsigned)(hi5 ? eb : ea) * 512u + lane16;
    Q[r] = *(const u32x4v*)(tab + off);
  }
}
__device__ __forceinline__ void peer_req_rows8(u32x4v (&Q)[8], const unsigned char* tab, int e, unsigned lane8) {
#pragma unroll
  for (int r = 0; r < 16; ++r) {
    const unsigned off = (unsigned)__builtin_amdgcn_readlane(e, r) * 512u + lane8;
    const uint2 t = *(const uint2*)(tab + off);
    Q[r >> 1][2 * (r & 1)] = t.x; Q[r >> 1][2 * (r & 1) + 1] = t.y;
  }
}
__device__ void peer_phase(const Params& p, int l, bool last, unsigned char* smem) {
  const CParamsP pp = launder_kargs();
  GAS unsigned char* const ws = launder_ptr(pp->ws); const int tidx = launder_tid();
  bf16_t* HF = (bf16_t*)(ws + WS_ABUF); bf16_t* X = (bf16_t*)(ws + WS_X);
  const bf16_t* SC8 = (const bf16_t*)(ws + WS_SC);
  const uint2* U4 = (const uint2*)(ws + WS_PU8) + (size_t)l * 16384 * 64; const uint2* V4 = (const uint2*)(ws + WS_PV8) + (size_t)l * 16384 * 64;
  const float* g2 = (const float*)(ws + WS_MOD) + (size_t)l * 2 * 6144 + 5120;
  const bf16_t* XG = (const bf16_t*)(ws + WS_XG); const float* SSQ = (const float*)(ws + WS_SSQ); const float* sh2 = (const float*)(ws + WS_MOD) + (size_t)l * 2 * 6144 + 3072;
  const int ln = last ? l : l + 1;
  const float* nsh = (const float*)(ws + WS_MOD) + (size_t)ln * 2 * 6144; const float* nsc = nsh + 1024;
  const float* ngain = gin(pp->in[I_NMIX]) + (size_t)ln * 1024;
  const int lane = tidx & 63, wid = tidx >> 6;
  const int rL = ((lane >> 5) & 1) * 8 + ((lane >> 4) & 1) * 4 + ((lane >> 3) & 1) * 2 + ((lane >> 2) & 1);
  const bool hi5 = (lane & 32) != 0, hi4 = (lane & 16) != 0, hi3 = (lane & 8) != 0, hi2 = (lane & 4) != 0;
  int* idxL = (int*)smem;
  float* cst = (float*)(smem + 109568);
  for (int it_ = blockIdx.x; it_ < T_ / 64; it_ += gridDim.x) {
    const int item = ((it_ & 7) << 5) | (it_ >> 3);
    const int t0 = item * 64;
    __syncthreads();
    {
      const int bb = t0 >> 13;
      for (int c = tidx; c < 1024; c += NT) {
        const int o = ((c >> 2) & 3) * 256 + (c >> 4) * 4 + (c & 3);
        cst[o] = g2[bb * 6144 + c] * 0.25f;
        cst[1024 + o] = last ? gin(pp->in[I_FNORM])[c] : ngain[c] * (1.f + nsc[bb * 6144 + c]);
        cst[2048 + o] = last ? 0.f : nsh[bb * 6144 + c];
        cst[3072 + o] = sh2[bb * 6144 + c];
      }
    }
    {
      int lane_o = lane; asm volatile("" : "+v"(lane_o));
      const int tg = wid & 1, hp = wid >> 1, hf = lane_o >> 5, tl = 32 * tg + (lane_o & 31);
      float F[2][16];
#pragma unroll
      for (int sd = 0; sd < 2; ++sd) {
        float Lh[2][16];
#pragma unroll
        for (int hh = 0; hh < 2; ++hh) {
          const int hs = 2 * (2 * hp + hh) + sd;
          float top[16];
          const bf16_t* scp = SC8 + (((size_t)(hs * 16 + 8 * hf)) * T_ + (t0 + tl)) * 8;
          uint4 sv[8];
#pragma unroll
          for (int kq = 0; kq < 8; ++kq) sv[kq] = *(const uint4*)(scp + (size_t)kq * T_ * 8);
          __builtin_amdgcn_sched_barrier(0);
#pragma unroll
          for (int kt = 0; kt < 4; ++kt) {
            float g[16];
#pragma unroll
            for (int kq = 0; kq < 2; ++kq) {
              const uint4 v8 = sv[2 * kt + kq];
              const unsigned wv[4] = {v8.x, v8.y, v8.z, v8.w};
#pragma unroll
              for (int j = 0; j < 4; ++j) {
                const int key = 64 * hf + 16 * kt + 8 * kq + 2 * j;
                g[8 * kq + 2 * j] = __uint_as_float((wv[j] << 16) | (unsigned)key);
                g[8 * kq + 2 * j + 1] = __uint_as_float((wv[j] & 0xffff0000u) | (unsigned)(key + 1));
              }
            }
            bitonic_sort16_desc(g);
            if (kt == 0) {
#pragma unroll
              for (int r = 0; r < 16; ++r) top[r] = g[r];
            } else top16_merge(top, g);
            __builtin_amdgcn_sched_barrier(0);
          }
#pragma unroll
          for (int r = 0; r < 16; ++r) Lh[hh][r] = top[r];
          __builtin_amdgcn_sched_barrier(0);
        }
#pragma unroll
        for (int r = 0; r < 16; ++r) {
          const auto sw = __builtin_amdgcn_permlane32_swap(__float_as_uint(Lh[0][r]), __float_as_uint(Lh[1][r]), false, false);
          Lh[0][r] = __uint_as_float(sw[0]); Lh[1][r] = __uint_as_float(sw[1]);
        }
        top16_merge(Lh[0], Lh[1]);
#pragma unroll
        for (int r = 0; r < 16; ++r) F[sd][r] = Lh[0][r];
        __builtin_amdgcn_sched_barrier(0);
      }
      int ia[16], ib[16];
#pragma unroll
      for (int r = 0; r < 16; ++r) { ia[r] = (int)(__float_as_uint(F[0][r]) & 127u) << 7; ib[r] = (int)(__float_as_uint(F[1][r]) & 127u); }
      float k[16]; int q[16];
#pragma unroll
      for (int j = 0; j < 16; ++j) { k[j] = F[0][0] + F[1][j]; q[j] = ia[0] | ib[j]; }
      { float xk[8]; int xq[8];
#pragma unroll
        for (int j = 0; j < 8; ++j) { xk[j] = F[0][1] + F[1][j]; xq[j] = ia[1] | ib[j]; }
        top16_merge_chain<8>(k, q, xk, xq); }
      { float xk[5]; int xq[5];
#pragma unroll
        for (int j = 0; j < 5; ++j) { xk[j] = F[0][2] + F[1][j]; xq[j] = ia[2] | ib[j]; }
        top16_merge_chain<5>(k, q, xk, xq); }
      { float xk[4]; int xq[4];
#pragma unroll
        for (int j = 0; j < 4; ++j) { xk[j] = F[0][3] + F[1][j]; xq[j] = ia[3] | ib[j]; }
        top16_merge_chain<4>(k, q, xk, xq); }
      { float xk[3]; int xq[3];
#pragma unroll
        for (int j = 0; j < 3; ++j) { xk[j] = F[0][4] + F[1][j]; xq[j] = ia[4] | ib[j]; }
        top16_merge_chain<3>(k, q, xk, xq); }
      { float xk[11]; int xq[11];
#pragma unroll
        for (int i = 0; i < 11; ++i) { xk[i] = F[0][5 + i] + F[1][0]; xq[i] = ia[5 + i] | ib[0]; }
        top16_merge_chain<11>(k, q, xk, xq); }
      { float xk[3]; int xq[3];
#pragma unroll
        for (int i = 0; i < 3; ++i) { xk[i] = F[0][5 + i] + F[1][1]; xq[i] = ia[5 + i] | ib[1]; }
        top16_merge_chain<3>(k, q, xk, xq); }
      float e[16]; float es = 0.f;
#pragma unroll
      for (int i = 0; i < 16; ++i) { e[i] = __expf(k[i] - k[0]); es += e[i]; }
      const float ies = 1.f / es;
      const int h = 2 * hp + hf;
#pragma unroll
      for (int i = 0; i < 16; ++i) idxL[tl * 132 + h * 16 + i] = (int)(((unsigned)f2bf(e[i] * ies) << 16) | (unsigned)q[i]);
    }
    __syncthreads();
    {
      const int fr = lane & 15, fq = lane >> 4, jsel = lane & 3, tlb = wid * 8;
      unsigned char* hq4 = smem + 33792 + wid * 1024;
      unsigned char* ust = smem + 41984 + wid * 8448;
      const unsigned lane8 = (unsigned)lane * 8u;
      const int hi5 = lane >> 5; const unsigned lane16 = (unsigned)(lane & 31) * 16u;
#define PEER_REQ_IDX(sn_) (idxL[(tlb + ((min((sn_), 127) & 63) >> 3)) * 132 + 16 * (min((sn_), 127) & 7) + fr] & 0xffff)
#define PEER_REQ_U(Q, e_) peer_req_rows16(Q, (const unsigned char*)U4, (e_), hi5, lane16)
      u32x4v qa[8], qb[8];
      {
        const int e0 = PEER_REQ_IDX(0), e1 = PEER_REQ_IDX(1);
        PEER_REQ_U(qa, e0);
        __builtin_amdgcn_sched_barrier(0);
        PEER_REQ_U(qb, e1);
        __builtin_amdgcn_sched_barrier(0);
      }
      {
        const float rs_lane = rsqrtf(ssq_total(SSQ, t0 + tlb + (lane & 7)) * (1.f / 1024.f) + EPS_);
        uint4 nh0 = *(const uint4*)(XG + (size_t)(t0 + tlb) * 1024 + lane * 16), nh1 = *(const uint4*)(XG + (size_t)(t0 + tlb) * 1024 + lane * 16 + 8);
#pragma unroll 1
        for (int ii = 0; ii < 8; ++ii) {
          const int tl = tlb + ii, t = t0 + tl;
          uint4 hB1[8], hB2[8];
          {
            const unsigned hw[8] = {nh0.x, nh0.y, nh0.z, nh0.w, nh1.x, nh1.y, nh1.z, nh1.w};
            const float rs = __int_as_float(__builtin_amdgcn_readlane(__float_as_int(rs_lane), ii));
            unsigned q1[2] = {0u, 0u}, q2[2] = {0u, 0u};
#pragma unroll
            for (int qq = 0; qq < 4; ++qq) {
              const f32x4 sh = *(const f32x4*)(cst + 3072 + qq * 256 + lane * 4);
              float hvv[4];
              hvv[0] = __uint_as_float(hw[2 * qq] << 16) * rs + sh.x; hvv[1] = __uint_as_float(hw[2 * qq] & 0xffff0000u) * rs + sh.y;
              hvv[2] = __uint_as_float(hw[2 * qq + 1] << 16) * rs + sh.z; hvv[3] = __uint_as_float(hw[2 * qq + 1] & 0xffff0000u) * rs + sh.w;
#pragma unroll
              for (int pr = 0; pr < 2; ++pr) {
                const int byte_sel = (2 * qq + pr) & 3, wd = (2 * qq + pr) >> 2;
                const float x0 = fminf(fmaxf(hvv[2 * pr], -6.f), 6.f), x1 = fminf(fmaxf(hvv[2 * pr + 1], -6.f), 6.f);
                unsigned t1 = 0u;
                if (byte_sel == 0) t1 = __builtin_amdgcn_cvt_scalef32_pk_fp4_f32(0u, x0, x1, 1.0f, 0);
                else if (byte_sel == 1) t1 = __builtin_amdgcn_cvt_scalef32_pk_fp4_f32(0u, x0, x1, 1.0f, 1);
                else if (byte_sel == 2) t1 = __builtin_amdgcn_cvt_scalef32_pk_fp4_f32(0u, x0, x1, 1.0f, 2);
                else t1 = __builtin_amdgcn_cvt_scalef32_pk_fp4_f32(0u, x0, x1, 1.0f, 3);
                f32x2 back;
                if (byte_sel == 0) back = __builtin_amdgcn_cvt_scalef32_pk_f32_fp4(t1, 1.0f, 0);
                else if (byte_sel == 1) back = __builtin_amdgcn_cvt_scalef32_pk_f32_fp4(t1, 1.0f, 1);
                else if (byte_sel == 2) back = __builtin_amdgcn_cvt_scalef32_pk_f32_fp4(t1, 1.0f, 2);
                else back = __builtin_amdgcn_cvt_scalef32_pk_f32_fp4(t1, 1.0f, 3);
                const float r0 = fminf(fmaxf((hvv[2 * pr] - back.x) * 8.f, -6.f), 6.f), r1 = fminf(fmaxf((hvv[2 * pr + 1] - back.y) * 8.f, -6.f), 6.f);
                unsigned t2 = 0u;
                if (byte_sel == 0) t2 = __builtin_amdgcn_cvt_scalef32_pk_fp4_f32(0u, r0, r1, 1.0f, 0);
                else if (byte_sel == 1) t2 = __builtin_amdgcn_cvt_scalef32_pk_fp4_f32(0u, r0, r1, 1.0f, 1);
                else if (byte_sel == 2) t2 = __builtin_amdgcn_cvt_scalef32_pk_fp4_f32(0u, r0, r1, 1.0f, 2);
                else t2 = __builtin_amdgcn_cvt_scalef32_pk_fp4_f32(0u, r0, r1, 1.0f, 3);
                q1[wd] |= t1; q2[wd] |= t2;
              }
            }
            *(uint2*)(hq4 + lane * 8) = make_uint2(q1[0], q1[1]);
            *(uint2*)(hq4 + 512 + lane * 8) = make_uint2(q2[0], q2[1]);
#pragma unroll
            for (int kc = 0; kc < 8; ++kc) { hB1[kc] = *(const uint4*)(hq4 + 64 * kc + 16 * fq); hB2[kc] = *(const uint4*)(hq4 + 512 + 64 * kc + 16 * fq); }
          }
          { const int tn = t + (ii < 7 ? 1 : 0);
            nh0 = *(const uint4*)(XG + (size_t)tn * 1024 + lane * 16); nh1 = *(const uint4*)(XG + (size_t)tn * 1024 + lane * 16 + 8); }
          __builtin_amdgcn_sched_barrier(0);
#define PEER_U_STEP(R, bt_) do { const int _bt = (bt_), _sn = ii * 8 + _bt + 2; \
            _Pragma("unroll") for (int r = 0; r < 8; ++r) *(u32x4v*)(ust + (2 * r + hi5) * 528 + lane16) = R[r];        \
            if (_sn < 64) { const int _en = PEER_REQ_IDX(_sn); PEER_REQ_U(R, _en); } else { const int _en = PEER_REQ_IDX(_sn); peer_req_rows8(R, (const unsigned char*)V4, _en, lane8); }        \
            __builtin_amdgcn_sched_barrier(0); \
            uint4 ua[8]; \
            _Pragma("unroll") for (int kc = 0; kc < 8; ++kc) ua[kc] = *(const uint4*)(ust + fr * 528 + 64 * kc + 16 * fq);      \
            f32x4 sa[2] = {(f32x4){0.f, 0.f, 0.f, 0.f}, (f32x4){0.f, 0.f, 0.f, 0.f}}, sb[2] = {(f32x4){0.f, 0.f, 0.f, 0.f}, (f32x4){0.f, 0.f, 0.f, 0.f}};     \
            _Pragma("unroll") for (int kc = 0; kc < 8; ++kc) { \
              const i32x8 av = (i32x8){(int)ua[kc].x, (int)ua[kc].y, (int)ua[kc].z, (int)ua[kc].w, 0, 0, 0, 0}; \
              const i32x8 b1 = (i32x8){(int)hB1[kc].x, (int)hB1[kc].y, (int)hB1[kc].z, (int)hB1[kc].w, 0, 0, 0, 0}; \
              const i32x8 b2 = (i32x8){(int)hB2[kc].x, (int)hB2[kc].y, (int)hB2[kc].z, (int)hB2[kc].w, 0, 0, 0, 0}; \
              sa[kc & 1] = __builtin_amdgcn_mfma_scale_f32_16x16x128_f8f6f4(av, b1, sa[kc & 1], 4  , 4  , 0, 0x7F7F7F7F, 0, 0x7F7F7F7F); \
              sb[kc & 1] = __builtin_amdgcn_mfma_scale_f32_16x16x128_f8f6f4(av, b2, sb[kc & 1], 4, 4, 0, 0x7F7F7F7F, 0, 0x7F7F7F7F); } \
            const f32x4 sc4 = (sa[0] + sa[1]) + (sb[0] + sb[1]) * 0.125f; \
              \
            const float dsel = jsel == 0 ? sc4[0] : (jsel == 1 ? sc4[1] : (jsel == 2 ? sc4[2] : sc4[3])); \
            const int _eo = tl * 132 + 16 * _bt + 4 * fq + jsel; const unsigned _pe = (unsigned)idxL[_eo]; \
            const float _w = __uint_as_float(_pe & 0xffff0000u) * gelu_tanh_fast(dsel * (1.f / 64.f));            \
            if (fr < 4) idxL[_eo] = (int)(((unsigned)f2bf(_w) << 16) | (_pe & 0xffffu)); \
          } while (0)
#pragma unroll 1
          for (int b2 = 0; b2 < 8; b2 += 2) { PEER_U_STEP(qa, b2); PEER_U_STEP(qb, b2 + 1); }
#undef PEER_U_STEP
        }
      }
      {
        f32x2 acc2[8];
#pragma unroll
        for (int j = 0; j < 8; ++j) acc2[j] = (f32x2){0.f, 0.f};
#pragma unroll 1
        for (int ii = 0; ii < 8; ++ii) {
          const int tl = tlb + ii, t = t0 + tl;
          const uint4 xr0 = *(const uint4*)(X + (size_t)t * 1024 + lane * 16), xr1 = *(const uint4*)(X + (size_t)t * 1024 + lane * 16 + 8);
          __builtin_amdgcn_sched_barrier(0);
#define PEER_V_STEP(R, bt_) do { const int _bt = (bt_), _sn = 64 + ii * 8 + _bt + 2; \
            const int _wv = (int)((unsigned)idxL[tl * 132 + 16 * _bt + fr] & 0xffff0000u);          \
            const int _en = PEER_REQ_IDX(_sn); \
            _Pragma("unroll") for (int r = 0; r < 16; ++r) { \
              const float wr = __int_as_float(__builtin_amdgcn_readlane(_wv, r)); \
              axpy16_fp4(make_uint2(R[r >> 1][2 * (r & 1)], R[r >> 1][2 * (r & 1) + 1]), wr, acc2); \
              { const unsigned off = (unsigned)__builtin_amdgcn_readlane(_en, r) * 512u + lane8; const uint2 _t = *(const uint2*)((const unsigned char*)V4 + off); \
                R[r >> 1][2 * (r & 1)] = _t.x; R[r >> 1][2 * (r & 1) + 1] = _t.y; } \
              __builtin_amdgcn_sched_barrier(0); } \
          } while (0)
#pragma unroll 1
          for (int b2 = 0; b2 < 8; b2 += 2) { PEER_V_STEP(qa, b2); PEER_V_STEP(qb, b2 + 1); }
#undef PEER_V_STEP
          float xn[16]; float ss = 0.f;
          const unsigned xw[8] = {xr0.x, xr0.y, xr0.z, xr0.w, xr1.x, xr1.y, xr1.z, xr1.w};
#pragma unroll
          for (int qq = 0; qq < 4; ++qq) {
            const f32x4 xv = (f32x4){__uint_as_float(xw[2 * qq] << 16), __uint_as_float(xw[2 * qq] & 0xffff0000u), __uint_as_float(xw[2 * qq + 1] << 16), __uint_as_float(xw[2 * qq + 1] & 0xffff0000u)};
            const f32x4 g = *(const f32x4*)(cst + qq * 256 + lane * 4);
            xn[4 * qq] = xv.x + g.x * acc2[2 * qq].x; xn[4 * qq + 1] = xv.y + g.y * acc2[2 * qq].y;
            xn[4 * qq + 2] = xv.z + g.z * acc2[2 * qq + 1].x; xn[4 * qq + 3] = xv.w + g.w * acc2[2 * qq + 1].y;
            ss += xn[4 * qq] * xn[4 * qq] + xn[4 * qq + 1] * xn[4 * qq + 1] + xn[4 * qq + 2] * xn[4 * qq + 2] + xn[4 * qq + 3] * xn[4 * qq + 3];
          }
#pragma unroll
          for (int j = 0; j < 8; ++j) acc2[j] = (f32x2){0.f, 0.f};
          const float rstd = rsqrtf(wave_sum(ss) * (1.f / 1024.f) + EPS_);
          if (!last) {
            unsigned hb[8], xb[8];
#pragma unroll
            for (int qq = 0; qq < 4; ++qq) {
              xb[2 * qq] = pk2(xn[4 * qq], xn[4 * qq + 1]); xb[2 * qq + 1] = pk2(xn[4 * qq + 2], xn[4 * qq + 3]);
              const f32x4 ga = *(const f32x4*)(cst + 1024 + qq * 256 + lane * 4), sh = *(const f32x4*)(cst + 2048 + qq * 256 + lane * 4);
              hb[2 * qq] = pk2(xn[4 * qq] * rstd * ga.x + sh.x, xn[4 * qq + 1] * rstd * ga.y + sh.y);
              hb[2 * qq + 1] = pk2(xn[4 * qq + 2] * rstd * ga.z + sh.z, xn[4 * qq + 3] * rstd * ga.w + sh.w);
            }
            *(uint4*)(X + (size_t)t * 1024 + lane * 16) = make_uint4(xb[0], xb[1], xb[2], xb[3]);
            *(uint4*)(X + (size_t)t * 1024 + lane * 16 + 8) = make_uint4(xb[4], xb[5], xb[6], xb[7]);
            *(uint4*)(HF + (size_t)t * 1024 + lane * 16) = make_uint4(hb[0], hb[1], hb[2], hb[3]);
            *(uint4*)(HF + (size_t)t * 1024 + lane * 16 + 8) = make_uint4(hb[4], hb[5], hb[6], hb[7]);
          } else {
#pragma unroll
            for (int qq = 0; qq < 4; ++qq) {
              const f32x4 fn = *(const f32x4*)(cst + 1024 + qq * 256 + lane * 4);
              *(f32x4*)((float*)pp->out + (size_t)t * 1024 + lane * 16 + 4 * qq) = (f32x4){xn[4 * qq] * rstd * fn.x, xn[4 * qq + 1] * rstd * fn.y, xn[4 * qq + 2] * rstd * fn.z, xn[4 * qq + 3] * rstd * fn.w};
            }
          }
        }
      }
#undef PEER_REQ_IDX
#undef PEER_REQ_U
    }
  }
}

#define XB_TMO      128
#define XB_XCNT(j)  (256  + 64 * (j))
#define XB_XSUB(j)  (1280 + 64 * (j))
#define XB_XGEN(j)  (2304 + 64 * (j))
#define XB_TOP      3328
#define XB_TOPGEN   3392
#define XCD_BAR_WORDS 3456
#define XB_SPIN_CAP (1u << 20)
#define LAS __attribute__((address_space(3)))
__device__ __forceinline__ unsigned xb_ld(unsigned* q)              { return __hip_atomic_load(q, __ATOMIC_RELAXED, __HIP_MEMORY_SCOPE_AGENT); }
__device__ __forceinline__ unsigned xb_add(unsigned* q, unsigned v) { return __hip_atomic_fetch_add(q, v, __ATOMIC_RELAXED, __HIP_MEMORY_SCOPE_AGENT); }
__device__ __forceinline__ unsigned xb_xcc_id() { return (unsigned)__builtin_amdgcn_s_getreg((3 << 11) | 20) & 0xFu; }
#define XB_SPIN(cond, bar) do { unsigned _sp = 0; while (cond) { __builtin_amdgcn_s_sleep(1); \
    if ((++_sp & 255u) == 0u) { if (xb_ld(&(bar)[XB_TMO])) break; if (_sp > XB_SPIN_CAP) { atomicAdd(&(bar)[XB_TMO], 1u); break; } } } } while (0)
struct XcdBarrier { unsigned* bar; unsigned x; volatile LAS unsigned* st; };
__device__ __forceinline__ XcdBarrier xcd_barrier_post(unsigned* bar, volatile LAS unsigned* st) {
    XcdBarrier b; b.bar = bar; b.x = xb_xcc_id(); b.st = st;
    if (threadIdx.x == 0) (void)xb_add(&bar[XB_XCNT(b.x)], 1u);
    return b;
}
__device__ __forceinline__ void xcd_barrier_complete(unsigned* bar, unsigned x, unsigned& nloc, unsigned& nx) {
    const unsigned G = gridDim.x * gridDim.y * gridDim.z;
    unsigned sum, cnt, mine, sp = 0u;
    for (;;) {
        sum = 0u; cnt = 0u; mine = 0u;
#pragma unroll
        for (unsigned j = 0; j < 16; ++j) { const unsigned c = xb_ld(&bar[XB_XCNT(j)]); sum += c; cnt += (c > 0u) ? 1u : 0u; mine = (j == x) ? c : mine; }
        if (sum == G) break;
        __builtin_amdgcn_s_sleep(1);
        if ((++sp & 255u) == 0u) { if (xb_ld(&bar[XB_TMO])) break; if (sp > XB_SPIN_CAP) { atomicAdd(&bar[XB_TMO], 1u); break; } }
    }
    nloc = mine > 0u ? mine : 1u; nx = cnt > 0u ? cnt : 1u;
}
__device__ __forceinline__ void xcd_barrier(const XcdBarrier& b) {
    asm volatile("s_waitcnt vmcnt(0)" ::: "memory");
    __syncthreads();
    if (threadIdx.x == 0) {
        unsigned* bar = b.bar;
        __builtin_amdgcn_s_waitcnt(0);
        unsigned nloc = b.st[0], nx = b.st[1];
        if (nloc == 0u) { xcd_barrier_complete(bar, b.x, nloc, nx); b.st[0] = nloc; b.st[1] = nx; }
        const unsigned old = xb_add(&bar[XB_XSUB(b.x)], 1u);
        const unsigned gen = old / nloc;
        if (old + 1u == (gen + 1u) * nloc) {
            __builtin_amdgcn_fence(__ATOMIC_RELEASE, "agent");
            asm volatile("s_waitcnt vmcnt(0)" ::: "memory");
            const unsigned og = xb_add(&bar[XB_TOP], 1u);
            const unsigned tg = og / nx;
            if (og + 1u == (tg + 1u) * nx) xb_add(&bar[XB_TOPGEN], 1u);
            else XB_SPIN(xb_ld(&bar[XB_TOPGEN]) == tg, bar);
            __builtin_amdgcn_fence(__ATOMIC_ACQUIRE, "agent");
            xb_add(&bar[XB_XGEN(b.x)], 1u);
            asm volatile("s_waitcnt vmcnt(0)" ::: "memory");
        } else {
            XB_SPIN(xb_ld(&bar[XB_XGEN(b.x)]) == gen, bar);
            __builtin_amdgcn_fence(__ATOMIC_ACQUIRE, "agent");
            asm volatile("s_waitcnt vmcnt(0)" ::: "memory");
        }
    }
    __syncthreads();
}

__global__ void __launch_bounds__(NT) fwd_megakernel(Params p) {
  extern __shared__ __attribute__((aligned(16))) unsigned char smem[];
  const CParamsP pp = launder_kargs();
  cg::grid_group grid = cg::this_grid();
  volatile LAS unsigned* xbst = (volatile LAS unsigned*)(smem + LDS_BYTES - 16);
  if (threadIdx.x == 0) { xbst[0] = 0u; xbst[1] = 0u; }
  if (blockIdx.x == 0) { unsigned* bw = (unsigned*)(pp->ws + WS_BAR); for (int i = threadIdx.x; i < XCD_BAR_WORDS; i += NT) bw[i] = 0u; }
  setup_phase(p, smem);
  grid.sync();
  const XcdBarrier xb = xcd_barrier_post((unsigned*)(pp->ws + WS_BAR), xbst);
  const float* MOD = (const float*)(pp->ws + WS_MOD);
  for (int l = 0; l < DEPTH_; ++l) {
    const float* xsrc = (l == 0) ? gin(pp->in[I_X]) : (const float*)(pp->ws + WS_X);
    const float* modl = MOD + (size_t)l * 2 * 6144;
    if (l == 0) {
      norm_mod_phase(xsrc, gin(pp->in[I_NMIX]), modl + 0, modl + 1024, (bf16_t*)(pp->ws + WS_ABUF));
      qbias_phase(p, smem);
      xcd_barrier(xb);
    }
    gemm_proj_phase(p, l, smem);
    xcd_barrier(xb);
    attn_phase(p, l, smem);
    mix_local_phase(p, l, smem);
    xcd_barrier(xb);
    scan_phase(p, l);
    xcd_barrier(xb);
    mix_final_phase(p, l, smem);
    xcd_barrier(xb);
    gemm_out_phase(p, l, smem);
    xcd_barrier(xb);
    gemm_q_phase(p, l, smem);
    xcd_barrier(xb);
    peer_phase(p, l, l == DEPTH_ - 1, smem);
    xcd_barrier(xb);
  }
}

extern "C" void kernel_launch(void* const* d_in, const int* in_sizes, int n_in,
                              void* d_out, int out_size, void* d_ws, size_t ws_size,
                              hipStream_t stream) {
  static int grid_blocks = 0;
  if (grid_blocks == 0) {
    if (n_in != 24 || ws_size < WS_END) { fprintf(stderr, "kernel_launch: unexpected n_in %d / ws_size %zu (need %zu)\n", n_in, ws_size, (size_t)WS_END); grid_blocks = -1; return; }
    int dev = 0, cus = 0, per_cu = 0;
    if (hipGetDevice(&dev) != hipSuccess || hipDeviceGetAttribute(&cus, hipDeviceAttributeMultiprocessorCount, dev) != hipSuccess) { grid_blocks = -1; return; }
    if (hipFuncSetAttribute((const void*)fwd_megakernel, hipFuncAttributeMaxDynamicSharedMemorySize, LDS_BYTES) != hipSuccess) { fprintf(stderr, "hipFuncSetAttribute failed\n"); grid_blocks = -1; return; }
    if (hipOccupancyMaxActiveBlocksPerMultiprocessor(&per_cu, (const void*)fwd_megakernel, NT, LDS_BYTES) != hipSuccess || per_cu < 1) { fprintf(stderr, "occupancy query: %d\n", per_cu); grid_blocks = -1; return; }
    grid_blocks = cus;
  }
  if (grid_blocks < 0) return;
  Params p{};
  for (int i = 0; i < 24; ++i) p.in[i] = (const GAS float*)d_in[i];
  p.out = (GAS float*)d_out; p.ws = (GAS unsigned char*)d_ws;
  void* args[] = {&p};
  hipError_t e = hipLaunchCooperativeKernel((void*)fwd_megakernel, dim3(grid_blocks), dim3(NT), args, LDS_BYTES, stream);
  if (e != hipSuccess) fprintf(stderr, "cooperative launch failed: %s (grid %d)\n", hipGetErrorString(e), grid_blocks);
}
```

```cpp
#include <hip/hip_runtime.h>
#include <hip/hip_cooperative_groups.h>
#include <cstdio>
#include <cstdint>
namespace cg = cooperative_groups;

typedef unsigned short bf16_t;
typedef short bf16x8 __attribute__((ext_vector_type(8)));
typedef float f32x4 __attribute__((ext_vector_type(4)));
typedef float f32x16 __attribute__((ext_vector_type(16)));
typedef int i32x8 __attribute__((ext_vector_type(8)));

constexpr int T_ = 16384, D_ = 1024, L_ = 8192, NBATCH = 2, DEPTH_ = 4;
constexpr int INC = 2944, INCP = 3072;
constexpr int NCH = 128;
constexpr int NT = 512;
constexpr int NW = 8;
constexpr float EPS_ = 1e-6f;
constexpr int C_QA = 0, C_KA = 384, C_VA = 768, C_QR = 1152, C_KR = 1536, C_VR = 1920, C_GR = 2304, C_US = 2688;

constexpr size_t al256(size_t x) { return (x + 255) & ~(size_t)255; }
constexpr size_t WS_MOD   = 0;
constexpr size_t WS_ROTC  = al256(WS_MOD + 4ull * 2 * 6144 * 4);
constexpr size_t WS_ROTS  = al256(WS_ROTC + 8192ull * 32 * 4);
constexpr size_t WS_SA    = al256(WS_ROTS + 8192ull * 32 * 4);
constexpr size_t WS_SBB   = al256(WS_SA + 4ull * 16 * 64 * 2 * 4);
constexpr size_t WS_WIN   = al256(WS_SBB + 4ull * 16 * 64 * 32 * 4);
constexpr size_t WS_WOUT  = al256(WS_WIN + 4ull * INCP * 1024 * 2);
constexpr size_t WS_WQ    = al256(WS_WOUT + 4ull * 1024 * 1024 * 2);
constexpr size_t WS_SUBK  = al256(WS_WQ + 4ull * 2048 * 1024 * 2);
constexpr size_t WS_ABUF  = al256(WS_SUBK + 4ull * 16 * 128 * 128 * 2);
constexpr size_t WS_PROJ  = al256(WS_ABUF + (size_t)T_ * 1024 * 2);
constexpr size_t WS_VTA   = al256(WS_PROJ + (size_t)T_ * INCP * 2);
constexpr size_t WS_ATT   = al256(WS_VTA + 2ull * 6 * 64 * 8192 * 2);
constexpr size_t WS_YINT  = al256(WS_ATT + (size_t)T_ * 384 * 4);
constexpr size_t WS_UPD   = al256(WS_YINT + (size_t)T_ * 384 * 4);
constexpr size_t WS_SPREV = al256(WS_UPD + 256ull * 6 * 4096 * 4);
constexpr size_t WS_SEND  = al256(WS_SPREV + 256ull * 6 * 4096 * 4);
constexpr size_t WS_CARRY = al256(WS_SEND + 256ull * 16 * 64 * 2 * 4);
constexpr size_t WS_X     = al256(WS_CARRY + 256ull * 16 * 64 * 2 * 4);
constexpr size_t WS_Q     = al256(WS_X + (size_t)T_ * 1024 * 4);
constexpr size_t WS_SC    = al256(WS_Q + (size_t)T_ * 2048 * 2);
constexpr size_t WS_EIDX  = al256(WS_SC + (size_t)T_ * 2048 * 4);
constexpr size_t WS_EGATE = al256(WS_EIDX + (size_t)T_ * 128 * 4);
constexpr size_t WS_PU8   = al256(WS_EGATE + (size_t)T_ * 128 * 4);
constexpr size_t WS_PV8   = al256(WS_PU8 + 4ull * 16384 * 1024);
constexpr size_t WS_BAR   = al256(WS_PV8 + 4ull * 16384 * 1024);
constexpr size_t WS_SPT   = al256(WS_BAR + 3456ull * 4);
constexpr size_t WS_CB    = al256(WS_SPT + 256ull * 6 * 4096 * 2);
constexpr size_t WS_WGLUT = al256(WS_CB + 4ull * 16 * 16 * 128 * 2);
constexpr size_t WS_VTR   = al256(WS_WGLUT + 4ull * 512 * 256 * 2);
constexpr size_t WS_XG    = al256(WS_VTR + 2ull * 384 * 8192 * 2);
constexpr size_t WS_SSQ   = al256(WS_XG + (size_t)T_ * 1024 * 2);
constexpr size_t WS_C2    = al256(WS_SSQ + (size_t)T_ * 16 * 4);
constexpr size_t WS_BBH   = al256(WS_C2 + 4ull * 2 * 2048 * 4);
constexpr size_t WS_END   = al256(WS_BBH + 4ull * 16 * 2 * 64 * 16 * 2);

constexpr int LDS_BYTES = 135168;

#define GAS __attribute__((address_space(1)))
struct Params {
  const GAS float* in[24];
  GAS float* out;
  GAS unsigned char* ws;
};
enum { I_X = 0, I_C, I_WADA, I_BADA, I_NMIX, I_NFFN, I_WIN, I_RELB, I_LRE, I_LIM, I_LOGDT, I_BRE, I_BIM, I_CRE, I_CIM, I_SSMD,
       I_WGLU, I_MGAIN, I_WOUT, I_WQ, I_SUBK, I_PU, I_PV, I_FNORM };

__device__ __forceinline__ float bf2f(bf16_t v) { return __uint_as_float(((unsigned)v) << 16); }
typedef __bf16 hwbf16x2 __attribute__((ext_vector_type(2)));
__device__ __forceinline__ bf16_t f2bf(float f) { return __builtin_bit_cast(unsigned short, (__bf16)f); }
__device__ __forceinline__ unsigned pk2(float a, float b) { const hwbf16x2 v = {(__bf16)a, (__bf16)b}; return __builtin_bit_cast(unsigned, v); }
__device__ __forceinline__ float wave_sum(float v) {
#pragma unroll
  for (int o = 32; o > 0; o >>= 1) v += __shfl_xor(v, o);
  return v;
}
__device__ __forceinline__ float wave_max(float v) {
#pragma unroll
  for (int o = 32; o > 0; o >>= 1) v = fmaxf(v, __shfl_xor(v, o));
  return v;
}
__device__ __forceinline__ float gelu_tanh(float x) { const float u = 0.7978845608028654f * (x + 0.044715f * x * x * x); return 0.5f * x * (1.f + tanhf(u)); }
__device__ __forceinline__ float sigmoid_f(float x) { return 1.f / (1.f + __expf(-x)); }
__device__ __forceinline__ float gelu_tanh_fast(float x) {
  const float u2 = 2.f * 0.7978845608028654f * 1.4426950408889634f * (x + 0.044715f * x * x * x);
  const float e = __builtin_amdgcn_exp2f(fminf(u2, 80.f));
  return x - x * __builtin_amdgcn_rcpf(1.f + e);
}
__device__ __forceinline__ GAS unsigned char* launder_ptr(GAS unsigned char* q) { asm volatile("" : "+s"(q)); return q; }
__device__ __forceinline__ const float* gin(const GAS float* q) { return (const float*)q; }
__device__ __forceinline__ const float* launder_cptr(const float* q) { asm volatile("" : "+s"(q)); return q; }
__device__ __forceinline__ int launder_tid() { int t = threadIdx.x; asm volatile("" : "+v"(t)); return t; }
typedef const Params __attribute__((address_space(4)))* CParamsP;
__device__ __forceinline__ CParamsP launder_kargs() { CParamsP q = (CParamsP)__builtin_amdgcn_kernarg_segment_ptr(); asm volatile("" : "+s"(q)); return q; }

__device__ __forceinline__ void convert_tables_fp4(const CParamsP pp, GAS unsigned char* ws, int layer, int gtid, int gn) {
  constexpr int NSPAN = 16384;
  const int lane = gtid & 63, gw = gtid >> 6, nw = gn >> 6;
  for (int sp0 = gw; sp0 < 2 * NSPAN; sp0 += 2 * nw) {
    f32x4 a[2][4];
#pragma unroll
    for (int h = 0; h < 2; ++h) {
      const int sp = sp0 + h * nw, tb = sp >= NSPAN ? 1 : 0;
      const float* src = (tb ? gin(pp->in[I_PV]) : gin(pp->in[I_PU])) + ((size_t)layer * NSPAN + (sp - tb * NSPAN)) * 1024 + lane * 4;
#pragma unroll
      for (int q = 0; q < 4; ++q) a[h][q] = (sp < 2 * NSPAN) ? *(const f32x4*)(src + q * 256) : (f32x4){0.f, 0.f, 0.f, 0.f};
    }
#pragma unroll
    for (int h = 0; h < 2; ++h) {
      const int sp = sp0 + h * nw, tb = sp >= NSPAN ? 1 : 0;
      if (sp < 2 * NSPAN) {
        const float sc = tb ? 4.f : 64.f;
        unsigned short* dst = (unsigned short*)(ws + (tb ? WS_PV8 : WS_PU8) + ((size_t)layer * NSPAN + (sp - tb * NSPAN)) * 512) + lane;
#pragma unroll
        for (int q = 0; q < 4; ++q) {
          const f32x4 v = a[h][q];
          const float x0 = fminf(fmaxf(v.x * sc, -6.f), 6.f), x1 = fminf(fmaxf(v.y * sc, -6.f), 6.f);
          const float x2 = fminf(fmaxf(v.z * sc, -6.f), 6.f), x3 = fminf(fmaxf(v.w * sc, -6.f), 6.f);
          unsigned o = __builtin_amdgcn_cvt_scalef32_pk_fp4_f32(0u, x0, x1, 1.0f, 0);
          o = __builtin_amdgcn_cvt_scalef32_pk_fp4_f32(o, x2, x3, 1.0f, 1);
          dst[q * 64] = (unsigned short)o;
        }
      }
    }
  }
}

__device__ void setup_phase(const Params& p, unsigned char* smem) {
  const CParamsP pp = launder_kargs();
  GAS unsigned char* const ws = launder_ptr(pp->ws); const int tidx = launder_tid(); (void)ws; (void)tidx;
  const int tid = tidx;
  float* sm = (float*)smem;
  {
    float* cond = sm;
    float* red = sm + 2048;
    float* MOD = (float*)(ws + WS_MOD);
    for (int i = tid; i < 2048; i += NT) { const float c = gin(pp->in[I_C])[i]; cond[i] = c * sigmoid_f(c); }
    __syncthreads();
    for (int item = blockIdx.x; item < 4 * 192; item += gridDim.x) {
      const int l = item / 192, cb = item % 192, kq = tid >> 6, jj = tid & 31, kp = (tid >> 5) & 1, j = cb * 32 + jj;
      const float* w = gin(pp->in[I_WADA]) + (size_t)l * 1024 * 6144 + j;
      float a0 = 0.f, a1 = 0.f;
#pragma unroll 32
      for (int k = kq * 128 + kp; k < kq * 128 + 128; k += 2) { const float wv = w[(size_t)k * 6144]; a0 += cond[k] * wv; a1 += cond[1024 + k] * wv; }
      red[((kq * 2 + kp) * 2 + 0) * 32 + jj] = a0; red[((kq * 2 + kp) * 2 + 1) * 32 + jj] = a1;
      __syncthreads();
      if (tid < 64) {
        const int b = tid >> 5, j2 = tid & 31; float s = 0.f;
        for (int q = 0; q < 16; ++q) s += red[(q * 2 + b) * 32 + j2];
        MOD[((size_t)l * 2 + b) * 6144 + cb * 32 + j2] = s + gin(pp->in[I_BADA])[(size_t)l * 6144 + cb * 32 + j2];
      }
      __syncthreads();
    }
  }
  const int gtid = blockIdx.x * NT + tid, gn = gridDim.x * NT;
  {
    float* RC = (float*)(ws + WS_ROTC); float* RS = (float*)(ws + WS_ROTS);
    for (int idx = gtid; idx < 8192 * 32; idx += gn) {
      const int pos = idx >> 5, i = idx & 31;
      const float inv = powf(10000.0f, -(float)i / 32.0f);
      const float ang = (float)pos * inv;
      float s, c; sincosf(ang, &s, &c);
      RC[idx] = c; RS[idx] = s;
    }
  }
  {
    float* SA = (float*)(ws + WS_SA); float* SBB = (float*)(ws + WS_SBB); bf16_t* BBH = (bf16_t*)(ws + WS_BBH);
    for (int idx = gtid; idx < 4 * 16 * 64; idx += gn) {
      const int l = idx / 1024, g = (idx >> 6) & 15;
      const float dt = expf(gin(pp->in[I_LOGDT])[l * 16 + g]);
      const float lr = gin(pp->in[I_LRE])[idx], li = gin(pp->in[I_LIM])[idx];
      const float mag = expf(lr * dt);
      float sn, cs; sincosf(li * dt, &sn, &cs);
      const float are = mag * cs, aim = mag * sn;
      const float den = lr * lr + li * li, nr = are - 1.f, ni = aim;
      const float fre = (nr * lr + ni * li) / den, fim = (ni * lr - nr * li) / den;
      SA[idx * 2] = are; SA[idx * 2 + 1] = aim;
      for (int c = 0; c < 16; ++c) {
        const float br = gin(pp->in[I_BRE])[(size_t)idx * 16 + c], bi = gin(pp->in[I_BIM])[(size_t)idx * 16 + c];
        SBB[(size_t)idx * 32 + c] = fre * br - fim * bi;
        SBB[(size_t)idx * 32 + 16 + c] = fre * bi + fim * br;
        {
          const int pq = idx & 63; const size_t fb = (size_t)(idx >> 6) * 2;
          BBH[(((fb + 0) * 2 + (pq >> 5)) * 64 + 32 * (c >> 3) + (pq & 31)) * 8 + (c & 7)] = f2bf(fre * br - fim * bi);
          BBH[(((fb + 1) * 2 + (pq >> 5)) * 64 + 32 * (c >> 3) + (pq & 31)) * 8 + (c & 7)] = f2bf(fre * bi + fim * br);
        }
      }
    }
  }
  {
    bf16_t* CB = (bf16_t*)(ws + WS_CB);
    for (int idx = gtid; idx < 4 * 16 * 16 * 128; idx += gn) {
      const int k = idx & 127, lgc = idx >> 7;
      const bf16_t cv = (k < 64) ? f2bf(gin(pp->in[I_CRE])[(size_t)lgc * 64 + k]) : f2bf(-gin(pp->in[I_CIM])[(size_t)lgc * 64 + (k - 64)]);
      const int cc = lgc & 15, lg = lgc >> 4;
      CB[(((size_t)lg * 4 + (k >> 5)) * 64 + ((k >> 3) & 3) * 16 + cc) * 8 + (k & 7)] = cv;
    }
    bf16_t* WG = (bf16_t*)(ws + WS_WGLUT);
    for (int idx = gtid; idx < 4 * 512 * 256; idx += gn) {
      const int k = idx & 255, nn = (idx >> 8) & 511, l2 = idx >> 17;
      {
        const int which = nn >> 8, w8 = (nn >> 5) & 7, nt = (nn >> 4) & 1, frr = nn & 15, ks = k >> 5, fqq = (k >> 3) & 3, j = k & 7;
        WG[(((((size_t)l2 * 8 + w8) * 8 + ks) * 2 + which) * 2 + nt) * 512 + (fqq * 16 + frr) * 8 + j] = f2bf(gin(pp->in[I_WGLU])[((size_t)l2 * 256 + k) * 512 + nn]);
      }
    }
  }
  convert_tables_fp4(pp, ws, 0, gtid, gn);
  {
    __syncthreads();
    const int lane = tid & 63, wid = tid >> 6;
    float* scr = sm + wid * (64 * 33);
    constexpr int IT_IN = 16 * 96, IT_OUT = 16 * 32, IT_L = IT_IN + IT_OUT;
    for (int item = blockIdx.x * NW + wid; item < 4 * IT_L; item += gridDim.x * NW) {
      const int l = item / IT_L; int r = item - l * IT_L;
      const float* W; bf16_t* WT; int N, NP;
      if (r < IT_IN) { W = gin(pp->in[I_WIN]) + (size_t)l * 1024 * INC; WT = (bf16_t*)(ws + WS_WIN) + (size_t)l * INCP * 1024; N = INC; NP = 96; }
      else { r -= IT_IN; W = gin(pp->in[I_WOUT]) + (size_t)l * 1024 * 1024; WT = (bf16_t*)(ws + WS_WOUT) + (size_t)l * 1024 * 1024; N = 1024; NP = 32; }
      const int kb = r / NP, nb = r - kb * NP, k0 = kb * 64, n0 = nb * 32;
      const int nn = n0 + (lane & 31); const bool inb = nn < N;
      float v[32];
#pragma unroll
      for (int i = 0; i < 32; ++i) { const int kk = 2 * i + (lane >> 5); v[i] = inb ? W[(size_t)(k0 + kk) * N + nn] : 0.f; }
#pragma unroll
      for (int i = 0; i < 32; ++i) { const int kk = 2 * i + (lane >> 5); scr[kk * 33 + (lane & 31)] = v[i]; }
      const int c = lane & 7;
#pragma unroll
      for (int j = 0; j < 4; ++j) {
        const int n = (lane >> 3) + 8 * j; const float* sp = scr + (8 * c) * 33 + n;
        uint4 o; o.x = pk2(sp[0], sp[33]); o.y = pk2(sp[2 * 33], sp[3 * 33]); o.z = pk2(sp[4 * 33], sp[5 * 33]); o.w = pk2(sp[6 * 33], sp[7 * 33]);
        *(uint4*)(WT + (size_t)(n0 + n) * 1024 + k0 + 8 * c) = o;
      }
    }
    __syncthreads();
  }
  {
    bf16_t* WP = (bf16_t*)(ws + WS_WQ);
    const int lane = tid & 63, wid = tid >> 6, fr = lane & 15, fq = lane >> 4;
    for (int item = blockIdx.x; item < 4 * 16 * 8; item += gridDim.x) {
      const int l = item >> 7, hs = (item >> 3) & 15, kb = item & 7;
      const float* Wq = gin(pp->in[I_WQ]) + ((size_t)l * 1024 + kb * 128 + wid * 16 + fr) * 2048 + hs * 128 + 8 * fq;
      const float* SKg = gin(pp->in[I_SUBK]) + ((size_t)l * 16 + hs) * 128 * 128 + (size_t)fr * 128 + 8 * fq;
      bf16x8 ah[4], al[4];
#pragma unroll
      for (int ks = 0; ks < 4; ++ks) {
        const f32x4 x0 = *(const f32x4*)(Wq + 32 * ks), x1 = *(const f32x4*)(Wq + 32 * ks + 4);
        const float xv[8] = {x0.x, x0.y, x0.z, x0.w, x1.x, x1.y, x1.z, x1.w};
#pragma unroll
        for (int j = 0; j < 8; ++j) { const bf16_t h = f2bf(xv[j]); ah[ks][j] = (short)h; al[ks][j] = (short)f2bf(xv[j] - bf2f(h)); }
      }
      f32x4 acc[8];
#pragma unroll
      for (int ct = 0; ct < 8; ++ct) acc[ct] = (f32x4){0.f, 0.f, 0.f, 0.f};
#pragma unroll 2
      for (int ct = 0; ct < 8; ++ct) {
        f32x4 y[8];
#pragma unroll
        for (int ks = 0; ks < 4; ++ks) { y[2 * ks] = *(const f32x4*)(SKg + (size_t)ct * 16 * 128 + 32 * ks); y[2 * ks + 1] = *(const f32x4*)(SKg + (size_t)ct * 16 * 128 + 32 * ks + 4); }
#pragma unroll
        for (int ks = 0; ks < 4; ++ks) {
          const float yv[8] = {y[2 * ks].x, y[2 * ks].y, y[2 * ks].z, y[2 * ks].w, y[2 * ks + 1].x, y[2 * ks + 1].y, y[2 * ks + 1].z, y[2 * ks + 1].w};
          bf16x8 bh, bl;
#pragma unroll
          for (int j = 0; j < 8; ++j) { const bf16_t h = f2bf(yv[j]); bh[j] = (short)h; bl[j] = (short)f2bf(yv[j] - bf2f(h)); }
          acc[ct] = __builtin_amdgcn_mfma_f32_16x16x32_bf16(ah[ks], bh, acc[ct], 0, 0, 0);
          acc[ct] = __builtin_amdgcn_mfma_f32_16x16x32_bf16(al[ks], bh, acc[ct], 0, 0, 0);
          acc[ct] = __builtin_amdgcn_mfma_f32_16x16x32_bf16(ah[ks], bl, acc[ct], 0, 0, 0);
        }
      }
#pragma unroll
      for (int ct = 0; ct < 8; ++ct)
        *(uint2*)(WP + ((size_t)l * 2048 + hs * 128 + 16 * ct + fr) * 1024 + kb * 128 + wid * 16 + 4 * fq) = make_uint2(pk2(acc[ct][0], acc[ct][1]), pk2(acc[ct][2], acc[ct][3]));
    }
  }
}

__device__ void qbias_phase(const Params& p, unsigned char* smem) {
  const CParamsP pp = launder_kargs();
  GAS unsigned char* const ws = launder_ptr(pp->ws); const int tid = launder_tid();
  float* C2 = (float*)(ws + WS_C2); const float* MOD = (const float*)(ws + WS_MOD); const bf16_t* WP = (const bf16_t*)(ws + WS_WQ);
  const int lane = tid & 63, gw = blockIdx.x * NW + (tid >> 6), nw = gridDim.x * NW;
  for (int o = gw; o < 4 * 2048; o += nw) {
    const int l = o >> 11;
    const uint4 w0 = *(const uint4*)(WP + (size_t)o * 1024 + lane * 16), w1 = *(const uint4*)(WP + (size_t)o * 1024 + lane * 16 + 8);
    const unsigned ww[8] = {w0.x, w0.y, w0.z, w0.w, w1.x, w1.y, w1.z, w1.w};
    const float* s0 = MOD + (size_t)l * 2 * 6144 + 3072 + lane * 16; const float* s1 = s0 + 6144;
    float a0 = 0.f, a1 = 0.f;
#pragma unroll
    for (int q = 0; q < 8; ++q) {
      const float wl = __uint_as_float(ww[q] << 16), wh = __uint_as_float(ww[q] & 0xffff0000u);
      a0 += s0[2 * q] * wl + s0[2 * q + 1] * wh; a1 += s1[2 * q] * wl + s1[2 * q + 1] * wh;
    }
    a0 = wave_sum(a0); a1 = wave_sum(a1);
    if (lane == 0) { C2[((size_t)l * 2 + 0) * 2048 + (o & 2047)] = a0; C2[((size_t)l * 2 + 1) * 2048 + (o & 2047)] = a1; }
  }
  (void)smem;
}

__device__ void norm_mod_phase(const float* __restrict__ xsrc, const float* __restrict__ gain, const float* __restrict__ mod_sh, const float* __restrict__ mod_sc,
                               bf16_t* __restrict__ outp) {
  const int tidx = launder_tid();
  const int lane = tidx & 63, gw = blockIdx.x * NW + (tidx >> 6), nw = gridDim.x * NW;
  for (int t = gw; t < T_; t += nw) {
    const int b = t >> 13;
    const f32x4* xr = (const f32x4*)(xsrc + (size_t)t * 1024) + lane;
    f32x4 v[4]; float s = 0.f;
#pragma unroll
    for (int j = 0; j < 4; ++j) { v[j] = xr[64 * j]; s += v[j].x * v[j].x + v[j].y * v[j].y + v[j].z * v[j].z + v[j].w * v[j].w; }
    const float rstd = rsqrtf(wave_sum(s) * (1.f / 1024.f) + EPS_);
#pragma unroll
    for (int j = 0; j < 4; ++j) {
      const int c = lane * 4 + 256 * j;
      const f32x4 g = *(const f32x4*)(gain + c), sh = *(const f32x4*)(mod_sh + b * 6144 + c), sc = *(const f32x4*)(mod_sc + b * 6144 + c);
      const float o0 = v[j].x * rstd * g.x * (1.f + sc.x) + sh.x, o1 = v[j].y * rstd * g.y * (1.f + sc.y) + sh.y;
      const float o2 = v[j].z * rstd * g.z * (1.f + sc.z) + sh.z, o3 = v[j].w * rstd * g.w * (1.f + sc.w) + sh.w;
      uint2 o; o.x = pk2(o0, o1); o.y = pk2(o2, o3);
      *(uint2*)(outp + (size_t)t * 1024 + c) = o;
    }
  }
}


namespace pg8 {
#define PG8_LAS __attribute__((address_space(3)))
typedef unsigned u32x4 __attribute__((ext_vector_type(4)));
constexpr int BM = 256, BK = 64, HALF = 128, HTB = HALF * BK * 2, STAGE_BYTES = 8 * HTB, NXCD = 8, WGM = 8;
__host__ __device__ __forceinline__ int lds_byte(int r, int c) { const int st = (r >> 4) * 2 + (c >> 5), rr = r & 15, cc = c & 31, ob = rr * 64 + cc * 2; return st * 1024 + (ob ^ (((ob >> 9) & 1) << 5)); }
__host__ __device__ __forceinline__ void stage_rc(int b, int& R, int& C) { const int st = b / 1024, sb = b % 1024, swz = sb ^ (((sb >> 9) & 1) << 5); R = (st >> 1) * 16 + swz / 64; C = (st & 1) * 32 + (swz % 64) / 2; }
__host__ __device__ __forceinline__ int perm32(int rho) { const int n = rho >> 4, i = rho & 15; return 8 * (i >> 2) + 4 * n + (i & 3); }
struct Unit { int pm, pn; };
struct Gemm { const bf16_t* A; const bf16_t* Bt; int M, N, K; };
struct StaticOrder {
    int nM, nN, nwg, G, c;
    __host__ __device__ void init(int M, int N, int G_, int c_) { nM = M / BM; nN = N / BM; nwg = nM * nN; G = G_; c = c_; }
    __host__ __device__ bool next(int i, Unit& u) const {
        const long L = (long)i * G + c; if (L >= nwg) return false;
        int wgid = (int)L; { const int q = nwg / NXCD, r = nwg % NXCD, xcd = wgid % NXCD, off = wgid / NXCD; wgid = (xcd < r ? xcd * (q + 1) : r * (q + 1) + (xcd - r) * q) + off; }
        const int nig = WGM * nN, gid = wgid / nig, fm = gid * WGM, gsz = (nM - fm) < WGM ? (nM - fm) : WGM;
        u.pm = fm + ((wgid % nig) % gsz); u.pn = (wgid % nig) / gsz; return true;
    }
    __device__ __forceinline__ void a_ready(const Unit&) const {}
    __device__ __forceinline__ void done(const Unit&) const {}
};
__device__ __forceinline__ unsigned cvt_pk_bf16(float lo, float hi) { unsigned r; asm volatile("v_cvt_pk_bf16_f32 %0, %1, %2" : "=v"(r) : "v"(lo), "v"(hi)); return r; }
template <class Epi, class Sched>
__device__ __forceinline__ void gemm_phase(PG8_LAS unsigned char* lds, const Gemm g, const Sched& S, const Epi& E) {
    const int tid = launder_tid(), wid = __builtin_amdgcn_readfirstlane(tid >> 6), lane = tid & 63, wr = wid >> 2, wc = wid & 3, fr = lane & 15, fq = lane >> 4;
    const int K = g.K, nt = K / BK;
    unsigned voffA[2], voffB[2];
#pragma unroll
    for (int i = 0; i < 2; ++i) { int R, C; stage_rc(tid * 16 + i * 8192, R, C); const int Rb = Epi::PERM ? ((R & ~31) + perm32(R & 31)) : R;
        voffA[i] = (unsigned)(R * K + C) * 2u; voffB[i] = (unsigned)(Rb * K + C) * 2u; }
    const size_t kstep = (size_t)(BK * 2);
    const size_t hstep = (size_t)HALF * K * 2;
    const size_t tstep = 2 * hstep;
    const unsigned ldsw = (unsigned)wid * 1024u;
    const int aoff = lds_byte(wr * 64 + fr, fq * 8), boff = lds_byte(wc * 32 + fr, fq * 8);
#define PG8_SA(b, h) (((b) * 2 + (h)) * HTB)
#define PG8_SB(b, h) ((4 + (b) * 2 + (h)) * HTB)
#define PG8_STAGE(bufoff, gbase, voff) do { _Pragma("unroll") for (int _i = 0; _i < 2; ++_i) \
        __builtin_amdgcn_global_load_lds((const unsigned*)((const char*)(gbase) + (voff)[_i]), (PG8_LAS unsigned*)(lds + (bufoff) + ldsw + _i * 8192), 16, 0, 0); } while (0)
#define PG8_LDA(dst, b, h) do { _Pragma("unroll") for (int m = 0; m < 4; ++m) _Pragma("unroll") for (int k = 0; k < 2; ++k) dst[m][k] = *(const PG8_LAS bf16x8*)(lds + PG8_SA(b, h) + aoff + m * 2048 + k * 1024); } while (0)
#define PG8_LDB(dst, b, h) do { _Pragma("unroll") for (int n = 0; n < 2; ++n) _Pragma("unroll") for (int k = 0; k < 2; ++k) dst[n][k] = *(const PG8_LAS bf16x8*)(lds + PG8_SB(b, h) + boff + n * 2048 + k * 1024); } while (0)
#define PG8_MMA(ai, bj, At, Bt) do { __builtin_amdgcn_s_setprio(1); _Pragma("unroll") for (int m = 0; m < 4; ++m) _Pragma("unroll") for (int n = 0; n < 2; ++n) _Pragma("unroll") for (int k = 0; k < 2; ++k) \
        acc[ai][bj][m][n] = __builtin_amdgcn_mfma_f32_16x16x32_bf16(Bt[n][k], At[m][k], acc[ai][bj][m][n], 0, 0, 0); __builtin_amdgcn_s_setprio(0); } while (0)
#define PG8_WAIT_V(n) asm volatile("s_waitcnt vmcnt(" #n ")" ::: "memory")
#define PG8_WAIT_L(n) asm volatile("s_waitcnt lgkmcnt(" #n ")" ::: "memory")
#define PG8_BAR __builtin_amdgcn_s_barrier()
#define PG8_SCHED __builtin_amdgcn_sched_barrier(0)
    Unit cur, nxt; int ui = 0;
    if (!S.next(0, cur)) return;
    f32x4 acc[2][2][4][2];
#pragma unroll
    for (int a = 0; a < 2; ++a)
#pragma unroll
        for (int b = 0; b < 2; ++b)
#pragma unroll
            for (int m = 0; m < 4; ++m)
#pragma unroll
                for (int n = 0; n < 2; ++n) acc[a][b][m][n] = (f32x4){0.f, 0.f, 0.f, 0.f};
    bf16x8 At[4][2], B0[2][2], B1[2][2];
    const char* cA = (const char*)g.A + (size_t)cur.pm * tstep; const char* cB = (const char*)g.Bt + (size_t)cur.pn * tstep;
    S.a_ready(cur);
    PG8_STAGE(PG8_SB(0, 0), cB, voffB); PG8_STAGE(PG8_SA(0, 0), cA, voffA); PG8_STAGE(PG8_SB(0, 1), cB + hstep, voffB); PG8_STAGE(PG8_SA(0, 1), cA + hstep, voffA);
    if (wr == 1) PG8_BAR;
    PG8_WAIT_V(4); PG8_BAR;
    PG8_STAGE(PG8_SB(1, 0), cB + kstep, voffB); PG8_STAGE(PG8_SA(1, 0), cA + kstep, voffA); PG8_STAGE(PG8_SB(1, 1), cB + hstep + kstep, voffB);
    PG8_WAIT_V(6); PG8_BAR;
    for (;;) {
        const bool has_next = S.next(ui + 1, nxt);
        const char* nA = has_next ? (const char*)g.A + (size_t)nxt.pm * tstep : cA; const char* nB = has_next ? (const char*)g.Bt + (size_t)nxt.pn * tstep : cB;
        for (int t = 0; t < nt; t += 2) {
            const bool last = (t == nt - 2);
            const char* a1 = cA + (size_t)(t + 1) * kstep;
            const char* a2 = last ? nA : cA + (size_t)(t + 2) * kstep; const char* b2 = last ? nB : cB + (size_t)(t + 2) * kstep;
            const char* a3 = a2 + kstep; const char* b3 = b2 + kstep;
            if (last && has_next) S.a_ready(nxt);
            PG8_LDB(B0, 0, 0); PG8_SCHED; PG8_LDA(At, 0, 0); PG8_STAGE(PG8_SA(1, 1), a1 + hstep, voffA);
            PG8_WAIT_L(8); PG8_BAR; PG8_WAIT_L(0); PG8_MMA(0, 0, At, B0); PG8_BAR; PG8_SCHED;
            PG8_LDB(B1, 0, 1); PG8_STAGE(PG8_SB(0, 0), b2, voffB);
            PG8_BAR; PG8_WAIT_L(0); PG8_MMA(0, 1, At, B1); PG8_BAR;
            PG8_LDA(At, 0, 1); PG8_STAGE(PG8_SA(0, 0), a2, voffA);
            PG8_BAR; PG8_WAIT_L(0); PG8_MMA(1, 0, At, B0); PG8_BAR; PG8_SCHED;
            PG8_STAGE(PG8_SB(0, 1), b2 + hstep, voffB);
            PG8_WAIT_V(6); PG8_BAR; PG8_MMA(1, 1, At, B1); PG8_BAR;
            PG8_LDB(B0, 1, 0); PG8_SCHED; PG8_LDA(At, 1, 0); PG8_STAGE(PG8_SA(0, 1), a2 + hstep, voffA);
            PG8_WAIT_L(8); PG8_BAR; PG8_WAIT_L(0); PG8_MMA(0, 0, At, B0); PG8_BAR; PG8_SCHED;
            PG8_LDB(B1, 1, 1); PG8_STAGE(PG8_SB(1, 0), b3, voffB);
            PG8_BAR; PG8_WAIT_L(0); PG8_MMA(0, 1, At, B1); PG8_BAR;
            PG8_LDA(At, 1, 1); PG8_STAGE(PG8_SA(1, 0), a3, voffA);
            PG8_BAR; PG8_WAIT_L(0); PG8_MMA(1, 0, At, B0); PG8_BAR; PG8_SCHED;
            PG8_STAGE(PG8_SB(1, 1), b3 + hstep, voffB);
            PG8_WAIT_V(6); PG8_BAR; PG8_MMA(1, 1, At, B1); PG8_BAR;
        }
        if constexpr (!Epi::AFTER_DRAIN) { E(acc, cur, wr, wc, fr, fq); S.done(cur); }
        if (!has_next) break;
#pragma unroll
        for (int a = 0; a < 2; ++a)
#pragma unroll
            for (int b = 0; b < 2; ++b)
#pragma unroll
                for (int m = 0; m < 4; ++m)
#pragma unroll
                    for (int n = 0; n < 2; ++n) acc[a][b][m][n] = (f32x4){0.f, 0.f, 0.f, 0.f};
        cur = nxt; cA = nA; cB = nB; ++ui;
    }
    PG8_WAIT_V(0);
    if (wr == 0) PG8_BAR;
    PG8_BAR;
    if constexpr (Epi::AFTER_DRAIN) { E.fused(acc, cur, wr, wc, fr, fq, lds, wid, lane); S.done(cur); }
#undef PG8_SA
#undef PG8_SB
#undef PG8_STAGE
#undef PG8_LDA
#undef PG8_LDB
#undef PG8_MMA
#undef PG8_WAIT_V
#undef PG8_WAIT_L
#undef PG8_BAR
#undef PG8_SCHED
}
}

__device__ __forceinline__ float ssq_total(const float* __restrict__ SSQ, int t) {
  const f32x4 a = *(const f32x4*)(SSQ + (size_t)t * 16), b = *(const f32x4*)(SSQ + (size_t)t * 16 + 4), c = *(const f32x4*)(SSQ + (size_t)t * 16 + 8), d = *(const f32x4*)(SSQ + (size_t)t * 16 + 12);
  return (((a.x + a.y) + (a.z + a.w)) + ((b.x + b.y) + (b.z + b.w))) + (((c.x + c.y) + (c.z + c.w)) + ((d.x + d.y) + (d.z + d.w)));
}
struct EpiProj {
  static constexpr bool PERM = true, AFTER_DRAIN = false;
  bf16_t* PROJ; bf16_t* VTA; bf16_t* VTR;
  __device__ __forceinline__ void operator()(const f32x4 (&acc)[2][2][4][2], const pg8::Unit& u, int wr, int wc, int fr, int fq) const {
    const int row0 = u.pm * 256 + wr * 64 + fr, col0 = u.pn * 256 + wc * 32 + 8 * fq;
    asm volatile("s_nop 15\n\ts_nop 15" ::: "memory");
#pragma unroll
    for (int ai = 0; ai < 2; ++ai)
#pragma unroll
      for (int m = 0; m < 4; ++m) {
        const int t = row0 + ai * 128 + m * 16;
#pragma unroll
        for (int bj = 0; bj < 2; ++bj) {
          const int c = col0 + bj * 128;
          const f32x4 v0 = acc[ai][bj][m][0], v1 = acc[ai][bj][m][1];
          pg8::u32x4 w; w.x = pg8::cvt_pk_bf16(v0[0], v0[1]); w.y = pg8::cvt_pk_bf16(v0[2], v0[3]); w.z = pg8::cvt_pk_bf16(v1[0], v1[1]); w.w = pg8::cvt_pk_bf16(v1[2], v1[3]);
          *(pg8::u32x4*)(PROJ + (size_t)t * INCP + c) = w;
          const bool isva = (c >= C_VA && c < C_VA + 384), isvr = (c >= C_VR && c < C_VR + 384);
          if (isva || isvr) {
            bf16_t* vt = (isva ? VTA : VTR) + ((size_t)(t >> 13) * 384 + (c - (isva ? C_VA : C_VR))) * 8192 + (t & 8191);
            vt[0] = (bf16_t)(w.x & 0xffffu); vt[8192] = (bf16_t)(w.x >> 16); vt[2 * 8192] = (bf16_t)(w.y & 0xffffu); vt[3 * 8192] = (bf16_t)(w.y >> 16);
            vt[4 * 8192] = (bf16_t)(w.z & 0xffffu); vt[5 * 8192] = (bf16_t)(w.z >> 16); vt[6 * 8192] = (bf16_t)(w.w & 0xffffu); vt[7 * 8192] = (bf16_t)(w.w >> 16);
          }
        }
      }
  }
};
struct EpiOut {
  static constexpr bool PERM = true, AFTER_DRAIN = false;
  const float* xin; int first; bf16_t* X; const float* g1; const float* nf; const float* sc2; bf16_t* XG; float* SSQ;
  __device__ __forceinline__ void operator()(const f32x4 (&acc)[2][2][4][2], const pg8::Unit& u, int wr, int wc, int fr, int fq) const {
    const int row0 = u.pm * 256 + wr * 64 + fr, col0 = u.pn * 256 + wc * 32 + 8 * fq, b = (u.pm * 256) >> 13;
    f32x4 gg[2][2], gs[2][2];
#pragma unroll
    for (int bj = 0; bj < 2; ++bj)
#pragma unroll
      for (int n = 0; n < 2; ++n) {
        const int c = col0 + bj * 128 + n * 4;
        gg[bj][n] = *(const f32x4*)(g1 + b * 6144 + c);
        const f32x4 gf = *(const f32x4*)(nf + c), sc = *(const f32x4*)(sc2 + b * 6144 + c);
        gs[bj][n] = gf * (sc + 1.f);
      }
#pragma unroll
    for (int ai = 0; ai < 2; ++ai)
#pragma unroll
      for (int m = 0; m < 4; ++m) {
        const int t = row0 + ai * 128 + m * 16;
        float sq = 0.f;
#pragma unroll
        for (int bj = 0; bj < 2; ++bj) {
          const int c = col0 + bj * 128;
          f32x4 x0, x1;
          if (first) { x0 = *(const f32x4*)(xin + (size_t)t * 1024 + c); x1 = *(const f32x4*)(xin + (size_t)t * 1024 + c + 4); }
          else {
            const pg8::u32x4 xr = *(const pg8::u32x4*)(X + (size_t)t * 1024 + c);
            x0 = (f32x4){__uint_as_float(xr.x << 16), __uint_as_float(xr.x & 0xffff0000u), __uint_as_float(xr.y << 16), __uint_as_float(xr.y & 0xffff0000u)};
            x1 = (f32x4){__uint_as_float(xr.z << 16), __uint_as_float(xr.z & 0xffff0000u), __uint_as_float(xr.w << 16), __uint_as_float(xr.w & 0xffff0000u)};
          }
          const f32x4 n0 = x0 + gg[bj][0] * acc[ai][bj][m][0], n1 = x1 + gg[bj][1] * acc[ai][bj][m][1];
          pg8::u32x4 xo; xo.x = pg8::cvt_pk_bf16(n0.x, n0.y); xo.y = pg8::cvt_pk_bf16(n0.z, n0.w); xo.z = pg8::cvt_pk_bf16(n1.x, n1.y); xo.w = pg8::cvt_pk_bf16(n1.z, n1.w);
          *(pg8::u32x4*)(X + (size_t)t * 1024 + c) = xo;
          const f32x4 s0 = n0 * gs[bj][0], s1 = n1 * gs[bj][1];
          pg8::u32x4 go; go.x = pg8::cvt_pk_bf16(s0.x, s0.y); go.y = pg8::cvt_pk_bf16(s0.z, s0.w); go.z = pg8::cvt_pk_bf16(s1.x, s1.y); go.w = pg8::cvt_pk_bf16(s1.z, s1.w);
          *(pg8::u32x4*)(XG + (size_t)t * 1024 + c) = go;
          sq += ((n0.x * n0.x + n0.y * n0.y) + (n0.z * n0.z + n0.w * n0.w)) + ((n1.x * n1.x + n1.y * n1.y) + (n1.z * n1.z + n1.w * n1.w));
        }
        sq += __shfl_xor(sq, 16); sq += __shfl_xor(sq, 32);
        if (fq == 0) SSQ[(size_t)t * 16 + u.pn * 4 + wc] = sq;
      }
  }
};
struct EpiQ {
  static constexpr bool PERM = true, AFTER_DRAIN = false;
  bf16_t* SC8; const float* SSQ; const float* C2;
  __device__ __forceinline__ void operator()(const f32x4 (&acc)[2][2][4][2], const pg8::Unit& u, int wr, int wc, int fr, int fq) const {
    const int row0 = u.pm * 256 + wr * 64 + fr, col0 = u.pn * 256 + wc * 32 + 8 * fq, b = (u.pm * 256) >> 13;
    f32x4 cc[2][2];
#pragma unroll
    for (int bj = 0; bj < 2; ++bj) { cc[bj][0] = *(const f32x4*)(C2 + b * 2048 + col0 + bj * 128); cc[bj][1] = *(const f32x4*)(C2 + b * 2048 + col0 + bj * 128 + 4); }
#pragma unroll
    for (int ai = 0; ai < 2; ++ai)
#pragma unroll
      for (int m = 0; m < 4; ++m) {
        const int t = row0 + ai * 128 + m * 16;
        const float rstd = rsqrtf(ssq_total(SSQ, t) * (1.f / 1024.f) + EPS_);
#pragma unroll
        for (int bj = 0; bj < 2; ++bj) {
          const f32x4 v0 = acc[ai][bj][m][0] * rstd + cc[bj][0], v1 = acc[ai][bj][m][1] * rstd + cc[bj][1];
          pg8::u32x4 w; w.x = pg8::cvt_pk_bf16(v0[0], v0[1]); w.y = pg8::cvt_pk_bf16(v0[2], v0[3]); w.z = pg8::cvt_pk_bf16(v1[0], v1[1]); w.w = pg8::cvt_pk_bf16(v1[2], v1[3]);
          *(pg8::u32x4*)(SC8 + ((size_t)((col0 + bj * 128) >> 3) * T_ + t) * 8) = w;
        }
      }
  }
};

__device__ void gemm_proj_phase(const Params& p, int l, unsigned char* smem) {
  const CParamsP pp = launder_kargs();
  GAS unsigned char* const ws = launder_ptr(pp->ws);
  pg8::Gemm g; g.A = (const bf16_t*)(ws + WS_ABUF); g.Bt = (const bf16_t*)(ws + WS_WIN) + (size_t)l * INCP * 1024; g.M = T_; g.N = INCP; g.K = 1024;
  pg8::StaticOrder S; S.init(T_, INCP, gridDim.x, blockIdx.x);
  EpiProj E; E.PROJ = (bf16_t*)(ws + WS_PROJ); E.VTA = (bf16_t*)(ws + WS_VTA); E.VTR = (bf16_t*)(ws + WS_VTR);
  pg8::gemm_phase<EpiProj, pg8::StaticOrder>((PG8_LAS unsigned char*)smem, g, S, E);
}
__device__ void gemm_out_phase(const Params& p, int l, unsigned char* smem) {
  const CParamsP pp = launder_kargs();
  GAS unsigned char* const ws = launder_ptr(pp->ws);
  pg8::Gemm g; g.A = (const bf16_t*)(ws + WS_ABUF); g.Bt = (const bf16_t*)(ws + WS_WOUT) + (size_t)l * 1024 * 1024; g.M = T_; g.N = 1024; g.K = 1024;
  pg8::StaticOrder S; S.init(T_, 1024, gridDim.x, blockIdx.x);
  EpiOut E; E.xin = gin(pp->in[I_X]); E.first = (l == 0) ? 1 : 0; E.X = (bf16_t*)(ws + WS_X); E.g1 = (const float*)(ws + WS_MOD) + (size_t)l * 2 * 6144 + 2048;
  E.nf = gin(pp->in[I_NFFN]) + (size_t)l * 1024; E.sc2 = (const float*)(ws + WS_MOD) + (size_t)l * 2 * 6144 + 4096; E.XG = (bf16_t*)(ws + WS_XG); E.SSQ = (float*)(ws + WS_SSQ);
  pg8::gemm_phase<EpiOut, pg8::StaticOrder>((PG8_LAS unsigned char*)smem, g, S, E);
}
__device__ void gemm_q_phase(const Params& p, int l, unsigned char* smem) {
  const CParamsP pp = launder_kargs();
  GAS unsigned char* const ws = launder_ptr(pp->ws);
  pg8::Gemm g; g.A = (const bf16_t*)(ws + WS_XG); g.Bt = (const bf16_t*)(ws + WS_WQ) + (size_t)l * 2048 * 1024; g.M = T_; g.N = 2048; g.K = 1024;
  pg8::StaticOrder S; S.init(T_, 2048, gridDim.x, blockIdx.x);
  EpiQ E; E.SC8 = (bf16_t*)(ws + WS_SC); E.SSQ = (const float*)(ws + WS_SSQ); E.C2 = (const float*)(ws + WS_C2) + (size_t)l * 2 * 2048;
  pg8::gemm_phase<EpiQ, pg8::StaticOrder>((PG8_LAS unsigned char*)smem, g, S, E);
}

__device__ __forceinline__ int attn_fk(int r) { return ((r >> 3) & 3) | (((r >> 1) & 1) << 2); }
__device__ __forceinline__ int attn_fv(int r) { return (r >> 1) & 7; }
__device__ void attn_phase(const Params& p, int l, unsigned char* smem) {
  const CParamsP pp = launder_kargs();
  GAS unsigned char* const ws = launder_ptr(pp->ws); const int tidx = launder_tid();
  const bf16_t* PROJ = (const bf16_t*)(ws + WS_PROJ); const bf16_t* VTA = (const bf16_t*)(ws + WS_VTA);
  bf16_t* ATT = (bf16_t*)(ws + WS_ATT);
  const int lane = tidx & 63, wid = tidx >> 6, fr = lane & 15, fq = lane >> 4;
  float* ext = (float*)smem;
  unsigned char* stg = smem + 15360;
  constexpr float LOG2E = 1.4426950408889634f;
  __syncthreads();
  for (int idx = tidx; idx < 6 * 640; idx += NT) {
    const int h = idx / 640, e = idx - h * 640; int d = e - 63; d = d > 256 ? 256 : d;
    ext[idx] = gin(pp->in[I_RELB])[((size_t)l * 6 + h) * 513 + d + 256] * LOG2E;
  }
  const int hh = wid >> 2, qb = wid & 3, iq = qb * 16 + fr;
  const int srow = tidx >> 3, sch = tidx & 7;
  for (int it_ = blockIdx.x; it_ < 256; it_ += gridDim.x) {
    const int item = ((it_ & 7) << 5) | (it_ >> 3);
    const int b = item >> 7, n = item & 127, t0 = b * 8192 + n * 64;
    const int jc0 = n >= 8 ? 0 : 8 - n, nch = 9 - jc0, nst = 3 * nch;
    uint4 sa0, sa1, sa2, sa3, sb0, sb1, sb2, sb3;
#define ATTN_LOAD(S, st) do { const int _rd = (st) / nch, _jc = jc0 + (st) - _rd * nch, _m = n - 8 + _jc; \
      S##0 = *(const uint4*)(PROJ + (size_t)(b * 8192 + _m * 64 + srow) * INCP + C_KA + (2 * _rd) * 64 + sch * 8); \
      S##1 = *(const uint4*)(PROJ + (size_t)(b * 8192 + _m * 64 + srow) * INCP + C_KA + (2 * _rd + 1) * 64 + sch * 8); \
      S##2 = *(const uint4*)(VTA + ((size_t)b * 384 + (2 * _rd) * 64 + srow) * 8192 + _m * 64 + sch * 8); \
      S##3 = *(const uint4*)(VTA + ((size_t)b * 384 + (2 * _rd + 1) * 64 + srow) * 8192 + _m * 64 + sch * 8); } while (0)
#define ATTN_WRITE(S, buf) do { unsigned char* _bp = stg + (buf) * 32768; \
      *(uint4*)(_bp + srow * 128 + ((sch ^ attn_fk(srow)) << 4)) = S##0; \
      *(uint4*)(_bp + 8192 + srow * 128 + ((sch ^ attn_fk(srow)) << 4)) = S##1; \
      *(uint4*)(_bp + 16384 + srow * 128 + ((sch ^ attn_fv(srow)) << 4)) = S##2; \
      *(uint4*)(_bp + 24576 + srow * 128 + ((sch ^ attn_fv(srow)) << 4)) = S##3; } while (0)
    __syncthreads();
    ATTN_LOAD(sa, 0);
    ATTN_WRITE(sa, 0);
    if (1 < nst) ATTN_LOAD(sb, 1);
    __syncthreads();
    bf16x8 qf[2];
    f32x4 o[4];
    float mrun = -1e30f, lrun = 0.f;
    const float* exth = ext;
    auto attn_compute = [&](const int st) {
      const int rd = st / nch, jc = jc0 + st - rd * nch, h = 2 * rd + hh;
      if (jc == jc0) {
#pragma unroll
        for (int ds = 0; ds < 2; ++ds) qf[ds] = *(const bf16x8*)(PROJ + (size_t)(t0 + iq) * INCP + C_QA + h * 64 + ds * 32 + fq * 8);
#pragma unroll
        for (int et = 0; et < 4; ++et) o[et] = (f32x4){0.f, 0.f, 0.f, 0.f};
        mrun = -1e30f; lrun = 0.f;
        exth = ext + h * 640 + 63 + 512 + iq - 8 * fq;
      }
      const unsigned char* kb = stg + (st & 1) * 32768 + hh * 8192;
      const unsigned char* vb = stg + (st & 1) * 32768 + (2 + hh) * 8192;
      float sc[2][2][4];
      bf16x8 kfr[2][2][2], vfr[2][4]; float bia[2][2][4];
#pragma unroll
      for (int g = 0; g < 2; ++g)
#pragma unroll
        for (int tt = 0; tt < 2; ++tt) {
          const int key = 32 * g + 8 * (fr >> 2) + (fr & 3) + 4 * tt, fk = attn_fk(key);
          kfr[g][tt][0] = *(const bf16x8*)(kb + key * 128 + ((fq ^ fk) << 4));
          kfr[g][tt][1] = *(const bf16x8*)(kb + key * 128 + (((4 + fq) ^ fk) << 4));
        }
#pragma unroll
      for (int g = 0; g < 2; ++g)
#pragma unroll
        for (int tt = 0; tt < 2; ++tt)
#pragma unroll
          for (int j = 0; j < 4; ++j) bia[g][tt][j] = exth[-(64 * jc + 32 * g + 4 * tt + j)];
#pragma unroll
      for (int g = 0; g < 2; ++g)
#pragma unroll
        for (int et = 0; et < 4; ++et) { const int er = 16 * et + fr; vfr[g][et] = *(const bf16x8*)(vb + er * 128 + (((4 * g + fq) ^ attn_fv(er)) << 4)); }
      __builtin_amdgcn_sched_barrier(0);
#pragma unroll
      for (int g = 0; g < 2; ++g)
#pragma unroll
        for (int tt = 0; tt < 2; ++tt) {
          f32x4 s4 = __builtin_amdgcn_mfma_f32_16x16x32_bf16(kfr[g][tt][0], qf[0], (f32x4){0.f, 0.f, 0.f, 0.f}, 0, 0, 0);
          s4 = __builtin_amdgcn_mfma_f32_16x16x32_bf16(kfr[g][tt][1], qf[1], s4, 0, 0, 0);
#pragma unroll
          for (int j = 0; j < 4; ++j) sc[g][tt][j] = s4[j] * (0.125f * LOG2E) + bia[g][tt][j];
        }
      float mloc = -1e30f;
#pragma unroll
      for (int g = 0; g < 2; ++g)
#pragma unroll
        for (int tt = 0; tt < 2; ++tt)
#pragma unroll
          for (int j = 0; j < 4; ++j) mloc = fmaxf(mloc, sc[g][tt][j]);
      mloc = fmaxf(mloc, __shfl_xor(mloc, 16)); mloc = fmaxf(mloc, __shfl_xor(mloc, 32));
      const float mnew = fmaxf(mrun, mloc), alpha = __builtin_amdgcn_exp2f(mrun - mnew);
      mrun = mnew;
      float ls = 0.f;
#pragma unroll
      for (int g = 0; g < 2; ++g)
#pragma unroll
        for (int tt = 0; tt < 2; ++tt)
#pragma unroll
          for (int j = 0; j < 4; ++j) { const float e = __builtin_amdgcn_exp2f(sc[g][tt][j] - mnew); sc[g][tt][j] = e; ls += e; }
      lrun = lrun * alpha + ls;
#pragma unroll
      for (int et = 0; et < 4; ++et) { o[et].x *= alpha; o[et].y *= alpha; o[et].z *= alpha; o[et].w *= alpha; }
#pragma unroll
      for (int g = 0; g < 2; ++g) {
        union { bf16x8 v; unsigned u[4]; } pf;
        pf.u[0] = pk2(sc[g][0][0], sc[g][0][1]); pf.u[1] = pk2(sc[g][0][2], sc[g][0][3]);
        pf.u[2] = pk2(sc[g][1][0], sc[g][1][1]); pf.u[3] = pk2(sc[g][1][2], sc[g][1][3]);
#pragma unroll
        for (int et = 0; et < 4; ++et) o[et] = __builtin_amdgcn_mfma_f32_16x16x32_bf16(vfr[g][et], pf.v, o[et], 0, 0, 0);
      }
      if (jc == 8) {
        float lt = lrun + __shfl_xor(lrun, 16); lt += __shfl_xor(lt, 32);
        const float inv = 1.f / lt;
#pragma unroll
        for (int et = 0; et < 4; ++et) {
          f32x4 v = o[et]; v.x *= inv; v.y *= inv; v.z *= inv; v.w *= inv;
          { uint2 ov; ov.x = pk2(v.x, v.y); ov.y = pk2(v.z, v.w); *(uint2*)(ATT + (size_t)(t0 + iq) * 384 + h * 64 + et * 16 + fq * 4) = ov; }
        }
      }
    };
#pragma unroll 1
    for (int st0 = 0; st0 < nst; st0 += 2) {
      { const int st = st0;
        if (st + 2 < nst) ATTN_LOAD(sa, st + 2);
        attn_compute(st);
        if (st + 1 < nst) ATTN_WRITE(sb, (st + 1) & 1);
        __syncthreads(); }
      if (st0 + 1 < nst) { const int st = st0 + 1;
        if (st + 2 < nst) ATTN_LOAD(sb, st + 2);
        attn_compute(st);
        if (st + 1 < nst) ATTN_WRITE(sa, (st + 1) & 1);
        __syncthreads(); }
    }
#undef ATTN_LOAD
#undef ATTN_WRITE
  }
  __syncthreads();
}

__device__ __forceinline__ void ssm_bu32(const bf16_t* __restrict__ bbh_g, const bf16_t* __restrict__ urow, int lane,
                                         f32x16& lo_re, f32x16& hi_re, f32x16& lo_im, f32x16& hi_im) {
  const int hf = lane >> 5;
  const bf16x8 ub = *(const bf16x8*)(urow + 8 * hf);
  f32x16 z;
#pragma unroll
  for (int r = 0; r < 16; ++r) z[r] = 0.f;
  const bf16x8 a0r = *(const bf16x8*)(bbh_g + (size_t)(0 * 64 + lane) * 8), a1r = *(const bf16x8*)(bbh_g + (size_t)(1 * 64 + lane) * 8);
  const bf16x8 a0i = *(const bf16x8*)(bbh_g + (size_t)(2 * 64 + lane) * 8), a1i = *(const bf16x8*)(bbh_g + (size_t)(3 * 64 + lane) * 8);
  lo_re = __builtin_amdgcn_mfma_f32_32x32x16_bf16(ub, a0r, z, 0, 0, 0); hi_re = __builtin_amdgcn_mfma_f32_32x32x16_bf16(ub, a1r, z, 0, 0, 0);
  lo_im = __builtin_amdgcn_mfma_f32_32x32x16_bf16(ub, a0i, z, 0, 0, 0); hi_im = __builtin_amdgcn_mfma_f32_32x32x16_bf16(ub, a1i, z, 0, 0, 0);
#pragma unroll
  for (int r = 0; r < 16; ++r) {
    const auto s1 = __builtin_amdgcn_permlane32_swap(__float_as_uint(lo_re[r]), __float_as_uint(hi_re[r]), false, false);
    lo_re[r] = __uint_as_float(s1[0]); hi_re[r] = __uint_as_float(s1[1]);
    const auto s2 = __builtin_amdgcn_permlane32_swap(__float_as_uint(lo_im[r]), __float_as_uint(hi_im[r]), false, false);
    lo_im[r] = __uint_as_float(s2[0]); hi_im[r] = __uint_as_float(s2[1]);
  }
}
__device__ __forceinline__ void rotary_frag(const bf16x8 x0, const bf16x8 x1, const float* RC, const float* RS, int pos, int fq, float scale, bf16x8& o0, bf16x8& o1) {
  const f32x4 c0 = *(const f32x4*)(RC + pos * 32 + 8 * fq), c1 = *(const f32x4*)(RC + pos * 32 + 8 * fq + 4);
  const f32x4 s0 = *(const f32x4*)(RS + pos * 32 + 8 * fq), s1 = *(const f32x4*)(RS + pos * 32 + 8 * fq + 4);
  const float cc[8] = {c0.x, c0.y, c0.z, c0.w, c1.x, c1.y, c1.z, c1.w}, sn[8] = {s0.x, s0.y, s0.z, s0.w, s1.x, s1.y, s1.z, s1.w};
  union { bf16x8 v; unsigned u[4]; } r0, r1;
#pragma unroll
  for (int q = 0; q < 4; ++q) {
    const float a0 = bf2f((bf16_t)x0[2 * q]) * scale, a1 = bf2f((bf16_t)x0[2 * q + 1]) * scale, b0 = bf2f((bf16_t)x1[2 * q]) * scale, b1 = bf2f((bf16_t)x1[2 * q + 1]) * scale;
    r0.u[q] = pk2(a0 * cc[2 * q] - b0 * sn[2 * q], a1 * cc[2 * q + 1] - b1 * sn[2 * q + 1]);
    r1.u[q] = pk2(a0 * sn[2 * q] + b0 * cc[2 * q], a1 * sn[2 * q + 1] + b1 * cc[2 * q + 1]);
  }
  o0 = r0.v; o1 = r1.v;
}
__device__ void mix_local_phase(const Params& p, int l, unsigned char* smem) {
  const CParamsP pp = launder_kargs();
  GAS unsigned char* const ws = launder_ptr(pp->ws); const int tidx = launder_tid();
  const bf16_t* PROJ = (const bf16_t*)(ws + WS_PROJ); const bf16_t* VTR = (const bf16_t*)(ws + WS_VTR);
  const float* RC = (const float*)(ws + WS_ROTC); const float* RS = (const float*)(ws + WS_ROTS);
  bf16_t* YINT = (bf16_t*)(ws + WS_YINT); float* UPDT = (float*)(ws + WS_UPD);
  const float* SA = (const float*)(ws + WS_SA) + (size_t)l * 16 * 64 * 2; const bf16_t* BBH = (const bf16_t*)(ws + WS_BBH) + (size_t)l * 16 * 2 * 64 * 16;
  float* SEND = (float*)(ws + WS_SEND);
  const int tid = tidx, lane = tid & 63, wid = tid >> 6, fr = lane & 15, fq = lane >> 4;
  bf16_t* KT = (bf16_t*)smem;
  float* rcL = (float*)(smem + 55296); float* rsL = rcL + 2048;
  for (int it_ = blockIdx.x; it_ < 256; it_ += gridDim.x) {
    const int item = ((it_ & 7) << 5) | (it_ >> 3);
    const int b = item >> 7, n = item & 127, t0 = b * 8192 + n * 64;
    __syncthreads();
#pragma unroll
    for (int i = 0; i < 4; ++i) { rcL[tid + NT * i] = RC[n * 2048 + tid + NT * i]; rsL[tid + NT * i] = RS[n * 2048 + tid + NT * i]; }
    __syncthreads();
#pragma unroll 1
    for (int k3 = 0; k3 < 3; ++k3) {
      const int task = wid * 3 + k3, h = task >> 2, tb = task & 3;
      const int i = 16 * tb + fr;
      const float lg2 = log2f(1.f - exp2f(-5.f - (float)h));
      bf16x8 qraw[2], kraw[2][2][2], vraw[2][4];
      {
        const bf16_t* qp = PROJ + (size_t)(t0 + i) * INCP + C_QR + h * 64 + 8 * fq;
        qraw[0] = *(const bf16x8*)qp; qraw[1] = *(const bf16x8*)(qp + 32);
#pragma unroll
        for (int g = 0; g < 2; ++g) {
#pragma unroll
          for (int tt = 0; tt < 2; ++tt) {
            const int key = 32 * g + 8 * (fr >> 2) + (fr & 3) + 4 * tt;
            const bf16_t* kp = PROJ + (size_t)(t0 + key) * INCP + C_KR + h * 64 + 8 * fq;
            kraw[g][tt][0] = *(const bf16x8*)kp; kraw[g][tt][1] = *(const bf16x8*)(kp + 32);
          }
#pragma unroll
          for (int et = 0; et < 4; ++et) vraw[g][et] = *(const bf16x8*)(VTR + ((size_t)b * 384 + h * 64 + et * 16 + fr) * 8192 + n * 64 + 32 * g + 8 * fq);
        }
      }
      __builtin_amdgcn_sched_barrier(0);
      bf16x8 qf0, qf1;
      rotary_frag(qraw[0], qraw[1], rcL, rsL, i, fq, 1.f, qf0, qf1);
      f32x4 o[4];
#pragma unroll
      for (int et = 0; et < 4; ++et) o[et] = (f32x4){0.f, 0.f, 0.f, 0.f};
#pragma unroll
      for (int g = 0; g < 2; ++g) {
        float st[2][4];
#pragma unroll
        for (int tt = 0; tt < 2; ++tt) {
          const int key = 32 * g + 8 * (fr >> 2) + (fr & 3) + 4 * tt;
          bf16x8 kf0, kf1;
          rotary_frag(kraw[g][tt][0], kraw[g][tt][1], rcL, rsL, key, fq, 0.125f, kf0, kf1);
          f32x4 s4 = __builtin_amdgcn_mfma_f32_16x16x32_bf16(kf0, qf0, (f32x4){0.f, 0.f, 0.f, 0.f}, 0, 0, 0);
          s4 = __builtin_amdgcn_mfma_f32_16x16x32_bf16(kf1, qf1, s4, 0, 0, 0);
#pragma unroll
          for (int j = 0; j < 4; ++j) {
            const int kk = 32 * g + 8 * fq + 4 * tt + j;
            const int dij = i > kk ? i - kk : kk - i;
            st[tt][j] = s4[j] * exp2f(lg2 * (float)dij);
          }
          if (tb == 0) {
            const float kd = exp2f(lg2 * (float)(63 - key));
#pragma unroll
            for (int jj = 0; jj < 8; ++jj) {
              KT[(h * 64 + 8 * fq + jj) * 72 + key] = f2bf(bf2f((bf16_t)kf0[jj]) * kd);
              KT[(h * 64 + 32 + 8 * fq + jj) * 72 + key] = f2bf(bf2f((bf16_t)kf1[jj]) * kd);
            }
          }
        }
        union { bf16x8 v; unsigned u[4]; } pf;
        pf.u[0] = pk2(st[0][0], st[0][1]); pf.u[1] = pk2(st[0][2], st[0][3]); pf.u[2] = pk2(st[1][0], st[1][1]); pf.u[3] = pk2(st[1][2], st[1][3]);
#pragma unroll
        for (int et = 0; et < 4; ++et) o[et] = __builtin_amdgcn_mfma_f32_16x16x32_bf16(vraw[g][et], pf.v, o[et], 0, 0, 0);
      }
#pragma unroll
      for (int et = 0; et < 4; ++et) { uint2 ov; ov.x = pk2(o[et].x, o[et].y); ov.y = pk2(o[et].z, o[et].w); *(uint2*)(YINT + (((((size_t)item * 6 + h) * 4 + tb) * 4 + et) * 64 + lane) * 4) = ov; }
    }
    __syncthreads();
#pragma unroll 1
    for (int k3 = 0; k3 < 3; ++k3) {
      const int task = wid * 3 + k3, h = task >> 2, et = task & 3;
      f32x4 acc[4];
#pragma unroll
      for (int dt = 0; dt < 4; ++dt) acc[dt] = (f32x4){0.f, 0.f, 0.f, 0.f};
#pragma unroll
      for (int g = 0; g < 2; ++g) {
        const bf16x8 vf = *(const bf16x8*)(VTR + ((size_t)b * 384 + h * 64 + et * 16 + fr) * 8192 + n * 64 + 32 * g + 8 * fq);
#pragma unroll
        for (int dt = 0; dt < 4; ++dt) {
          const bf16x8 kt = *(const bf16x8*)(KT + (h * 64 + 16 * dt + fr) * 72 + 32 * g + 8 * fq);
          acc[dt] = __builtin_amdgcn_mfma_f32_16x16x32_bf16(kt, vf, acc[dt], 0, 0, 0);
        }
      }
#pragma unroll
      for (int dt = 0; dt < 4; ++dt) *(f32x4*)(UPDT + (((size_t)item * 6 + h) * 64 + 16 * et + fr) * 64 + 16 * dt + 4 * fq) = acc[dt];
    }
#pragma unroll 1
    for (int gi = 0; gi < 2; ++gi) {
      const int g = wid * 2 + gi;
      const float are = SA[(g * 64 + lane) * 2], aim = SA[(g * 64 + lane) * 2 + 1];
      float xr = 0.f, xi = 0.f;
#pragma unroll 1
      for (int blk = 0; blk < 2; ++blk) {
        f32x16 lr, hr, li, hi;
        ssm_bu32(BBH + (size_t)g * 2 * 64 * 16, PROJ + (size_t)(t0 + 32 * blk + (lane & 31)) * INCP + C_US + g * 16, lane, lr, hr, li, hi);
#pragma unroll
        for (int a4 = 0; a4 < 4; ++a4) {
#pragma unroll
          for (int bq = 0; bq < 4; ++bq) { const float nr = are * xr - aim * xi + lr[4 * a4 + bq], ni = are * xi + aim * xr + li[4 * a4 + bq]; xr = nr; xi = ni; }
#pragma unroll
          for (int bq = 0; bq < 4; ++bq) { const float nr = are * xr - aim * xi + hr[4 * a4 + bq], ni = are * xi + aim * xr + hi[4 * a4 + bq]; xr = nr; xi = ni; }
        }
      }
      SEND[(((size_t)item * 16 + g) * 64 + lane) * 2] = xr; SEND[(((size_t)item * 16 + g) * 64 + lane) * 2 + 1] = xi;
    }
  }
}

__device__ void scan_phase(const Params& p, int l) {
  const CParamsP pp = launder_kargs();
  GAS unsigned char* const ws = launder_ptr(pp->ws); const int tidx = launder_tid();
  const float* __restrict__ UPDT = (const float*)(ws + WS_UPD); bf16_t* __restrict__ SPT = (bf16_t*)(ws + WS_SPT);
  const float* __restrict__ SEND = (const float*)(ws + WS_SEND); float* __restrict__ CARRY = (float*)(ws + WS_CARRY);
  const float* SA = (const float*)(ws + WS_SA) + (size_t)l * 16 * 64 * 2;
  const int gtid = blockIdx.x * NT + tidx, gn = gridDim.x * NT;
  for (int idx = gtid; idx < 2 * 6 * 4096 + 2 * 1024; idx += gn) {
    if (idx < 2 * 6 * 4096) {
      const int b = idx / (6 * 4096), r = idx % (6 * 4096), h = r >> 12;
      const float cd = exp2f(64.f * log2f(1.f - exp2f(-5.f - (float)h)));
      const int e_ = (r >> 6) & 63, d_ = r & 63;
      const int spoff = h * 4096 + ((((e_ >> 4) * 2 + (d_ >> 5)) * 64 + ((d_ >> 3) & 3) * 16 + (e_ & 15)) * 8 + (d_ & 7));
      float s = 0.f;
#pragma unroll 1
      for (int nb = 0; nb < NCH; nb += 16) {
        float v[16];
#pragma unroll
        for (int j = 0; j < 16; ++j) v[j] = UPDT[((size_t)(b * NCH + nb + j)) * 6 * 4096 + r];
#pragma unroll
        for (int j = 0; j < 16; ++j) { SPT[((size_t)(b * NCH + nb + j)) * 6 * 4096 + spoff] = f2bf(s); s = cd * s + v[j]; }
      }
    } else {
      const int r2 = idx - 2 * 6 * 4096, b = r2 >> 10, gp = r2 & 1023;
      float ar = SA[gp * 2], ai = SA[gp * 2 + 1];
#pragma unroll
      for (int q = 0; q < 6; ++q) { const float nr = ar * ar - ai * ai, ni = 2.f * ar * ai; ar = nr; ai = ni; }
      float xr = 0.f, xi = 0.f;
#pragma unroll 1
      for (int nb = 0; nb < NCH; nb += 16) {
        float2 v[16];
#pragma unroll
        for (int j = 0; j < 16; ++j) v[j] = *(const float2*)(SEND + (((size_t)(b * NCH + nb + j)) * 1024 + gp) * 2);
#pragma unroll
        for (int j = 0; j < 16; ++j) {
          *(float2*)(CARRY + (((size_t)(b * NCH + nb + j)) * 1024 + gp) * 2) = make_float2(xr, xi);
          const float nr = ar * xr - ai * xi + v[j].x, ni = ar * xi + ai * xr + v[j].y;
          xr = nr; xi = ni;
        }
      }
    }
  }
  if (l + 1 < DEPTH_) convert_tables_fp4(pp, ws, l + 1, gtid, gn);
}

__device__ void mix_final_phase(const Params& p, int l, unsigned char* smem) {
  const CParamsP pp = launder_kargs();
  GAS unsigned char* const ws = launder_ptr(pp->ws); const int tidx = launder_tid();
  const bf16_t* PROJ = (const bf16_t*)(ws + WS_PROJ);
  const float* RC = (const float*)(ws + WS_ROTC); const float* RS = (const float*)(ws + WS_ROTS);
  const bf16_t* YINT = (const bf16_t*)(ws + WS_YINT); const bf16_t* SPT = (const bf16_t*)(ws + WS_SPT);
  const bf16_t* ATT = (const bf16_t*)(ws + WS_ATT);
  const float* SA = (const float*)(ws + WS_SA) + (size_t)l * 16 * 64 * 2; const bf16_t* BBH = (const bf16_t*)(ws + WS_BBH) + (size_t)l * 16 * 2 * 64 * 16;
  const float* CARRY = (const float*)(ws + WS_CARRY);
  const bf16_t* CB = (const bf16_t*)(ws + WS_CB) + (size_t)l * 16 * 16 * 128; const bf16_t* WG = (const bf16_t*)(ws + WS_WGLUT) + (size_t)l * 512 * 256;
  const float* dsk = gin(pp->in[I_SSMD]) + (size_t)l * 256;
  const float* mg = gin(pp->in[I_MGAIN]) + (size_t)l * 1024;
  bf16_t* MRG = (bf16_t*)(ws + WS_ABUF);
  const int tid = tidx, lane = tid & 63, wid = tid >> 6, fr = lane & 15, fq = lane >> 4;
  bf16_t* YS = (bf16_t*)smem;
  float* red = (float*)(smem + 33792);
  bf16_t* XB = (bf16_t*)(smem + 36864 + wid * 8448 + 4096);
  float* rcL = (float*)(smem + 104448); float* rsL = rcL + 2048;
  for (int it_ = blockIdx.x; it_ < 256; it_ += gridDim.x) {
    const int item = ((it_ & 7) << 5) | (it_ >> 3);
    const int b = item >> 7, n = item & 127, t0 = b * 8192 + n * 64;
    __syncthreads();
#pragma unroll
    for (int i = 0; i < 4; ++i) { rcL[tid + NT * i] = RC[n * 2048 + tid + NT * i]; rsL[tid + NT * i] = RS[n * 2048 + tid + NT * i]; }
    __syncthreads();
    {
      float av[8][6], mgl[6];
#pragma unroll
      for (int ii = 0; ii < 8; ++ii)
#pragma unroll
        for (int j = 0; j < 6; ++j) av[ii][j] = bf2f(ATT[(size_t)(t0 + wid * 8 + ii) * 384 + lane + 64 * j]);
#pragma unroll
      for (int j = 0; j < 6; ++j) mgl[j] = mg[lane + 64 * j];
      __builtin_amdgcn_sched_barrier(0);
#pragma unroll
      for (int ii = 0; ii < 8; ++ii) {
        const int t = t0 + wid * 8 + ii;
        float sq = 0.f;
#pragma unroll
        for (int j = 0; j < 6; ++j) sq += av[ii][j] * av[ii][j];
        const float rstd = rsqrtf(wave_sum(sq) * (1.f / 384.f) + EPS_);
#pragma unroll
        for (int j = 0; j < 6; ++j) MRG[(size_t)t * 1024 + lane + 64 * j] = f2bf(av[ii][j] * rstd * mgl[j]);
      }
    }
#pragma unroll 1
    for (int k3 = 0; k3 < 3; ++k3) {
      const int task = wid * 3 + k3, h = task >> 2, tb = task & 3;
      const int i = 16 * tb + fr, t = t0 + i;
      const float lg2 = log2f(1.f - exp2f(-5.f - (float)h));
      bf16x8 qraw[2], spf[4][2]; f32x4 yiv[4], mgq[4]; uint2 grv[4];
      {
        const bf16_t* qp = PROJ + (size_t)t * INCP + C_QR + h * 64 + 8 * fq;
        qraw[0] = *(const bf16x8*)qp; qraw[1] = *(const bf16x8*)(qp + 32);
#pragma unroll
        for (int et = 0; et < 4; ++et) {
          const bf16_t* sp = SPT + ((size_t)item * 6 + h) * 4096 + (size_t)(et * 2) * 512 + lane * 8;
          spf[et][0] = *(const bf16x8*)sp; spf[et][1] = *(const bf16x8*)(sp + 512);
          { const uint2 yr = *(const uint2*)(YINT + (((((size_t)item * 6 + h) * 4 + tb) * 4 + et) * 64 + lane) * 4); yiv[et] = (f32x4){__uint_as_float(yr.x << 16), __uint_as_float(yr.x & 0xffff0000u), __uint_as_float(yr.y << 16), __uint_as_float(yr.y & 0xffff0000u)}; }
          grv[et] = *(const uint2*)(PROJ + (size_t)t * INCP + C_GR + h * 64 + 16 * et + 4 * fq);
          mgq[et] = *(const f32x4*)(mg + 384 + h * 64 + 16 * et + 4 * fq);
        }
      }
      __builtin_amdgcn_sched_barrier(0);
      bf16x8 qf0, qf1;
      rotary_frag(qraw[0], qraw[1], rcL, rsL, i, fq, 1.f, qf0, qf1);
      f32x4 o[4];
#pragma unroll
      for (int et = 0; et < 4; ++et) {
        o[et] = __builtin_amdgcn_mfma_f32_16x16x32_bf16(spf[et][0], qf0, (f32x4){0.f, 0.f, 0.f, 0.f}, 0, 0, 0);
        o[et] = __builtin_amdgcn_mfma_f32_16x16x32_bf16(spf[et][1], qf1, o[et], 0, 0, 0);
      }
      const float qd = exp2f(lg2 * (float)(i + 1));
      float y[16]; float s1 = 0.f;
#pragma unroll
      for (int et = 0; et < 4; ++et) {
        const f32x4 yi = yiv[et];
        y[4 * et] = yi.x + qd * o[et].x; y[4 * et + 1] = yi.y + qd * o[et].y; y[4 * et + 2] = yi.z + qd * o[et].z; y[4 * et + 3] = yi.w + qd * o[et].w;
        s1 += (y[4 * et] + y[4 * et + 1]) + (y[4 * et + 2] + y[4 * et + 3]);
      }
      s1 += __shfl_xor(s1, 16); s1 += __shfl_xor(s1, 32);
      const float mu = s1 * (1.f / 64.f);
      float s2 = 0.f;
#pragma unroll
      for (int q = 0; q < 16; ++q) { y[q] -= mu; s2 += y[q] * y[q]; }
      s2 += __shfl_xor(s2, 16); s2 += __shfl_xor(s2, 32);
      const float rstd = rsqrtf(s2 * (1.f / 64.f) + EPS_);
#pragma unroll
      for (int et = 0; et < 4; ++et) {
        const int c = h * 64 + 16 * et + 4 * fq;
        const uint2 gr = grv[et];
        const float g0 = __uint_as_float(gr.x << 16), g1 = __uint_as_float(gr.x & 0xffff0000u), g2 = __uint_as_float(gr.y << 16), g3 = __uint_as_float(gr.y & 0xffff0000u);
        const f32x4 mgv = mgq[et];
        uint2 ov;
        ov.x = pk2(y[4 * et] * rstd * (g0 * sigmoid_f(g0)) * mgv.x, y[4 * et + 1] * rstd * (g1 * sigmoid_f(g1)) * mgv.y);
        ov.y = pk2(y[4 * et + 2] * rstd * (g2 * sigmoid_f(g2)) * mgv.z, y[4 * et + 3] * rstd * (g3 * sigmoid_f(g3)) * mgv.w);
        *(uint2*)(MRG + (size_t)t * 1024 + 384 + c) = ov;
      }
    }
#pragma unroll 1
    for (int gi = 0; gi < 2; ++gi) {
      const int g = wid * 2 + gi;
      const float are = SA[(g * 64 + lane) * 2], aim = SA[(g * 64 + lane) * 2 + 1];
      float xr = CARRY[(((size_t)item * 16 + g) * 64 + lane) * 2], xi = CARRY[(((size_t)item * 16 + g) * 64 + lane) * 2 + 1];
      bf16x8 cb[4];
#pragma unroll
      for (int ks = 0; ks < 4; ++ks) cb[ks] = *(const bf16x8*)(CB + (((size_t)g * 4 + ks) * 64 + lane) * 8);
      const float dv = dsk[g * 16 + fr];
#pragma unroll 1
      for (int blk = 0; blk < 2; ++blk) {
        f32x16 lr, hr, li, hi;
        bf16_t uraw[2][4];
#pragma unroll
        for (int half = 0; half < 2; ++half)
#pragma unroll
          for (int j = 0; j < 4; ++j) uraw[half][j] = PROJ[(size_t)(t0 + 32 * blk + 16 * half + 4 * fq + j) * INCP + C_US + g * 16 + fr];
        ssm_bu32(BBH + (size_t)g * 2 * 64 * 16, PROJ + (size_t)(t0 + 32 * blk + (lane & 31)) * INCP + C_US + g * 16, lane, lr, hr, li, hi);
#pragma unroll
        for (int half = 0; half < 2; ++half) {
#pragma unroll
          for (int a2 = 0; a2 < 2; ++a2) {
            const int a4 = 2 * half + a2;
#pragma unroll
            for (int bq = 0; bq < 4; ++bq) {
              const float nr = are * xr - aim * xi + lr[4 * a4 + bq], ni = are * xi + aim * xr + li[4 * a4 + bq]; xr = nr; xi = ni;
              XB[(8 * a2 + bq) * 136 + lane] = f2bf(xr); XB[(8 * a2 + bq) * 136 + 64 + lane] = f2bf(xi);
            }
#pragma unroll
            for (int bq = 0; bq < 4; ++bq) {
              const float nr = are * xr - aim * xi + hr[4 * a4 + bq], ni = are * xi + aim * xr + hi[4 * a4 + bq]; xr = nr; xi = ni;
              XB[(8 * a2 + 4 + bq) * 136 + lane] = f2bf(xr); XB[(8 * a2 + 4 + bq) * 136 + 64 + lane] = f2bf(xi);
            }
          }
          f32x4 acc = (f32x4){0.f, 0.f, 0.f, 0.f};
#pragma unroll
          for (int ks = 0; ks < 4; ++ks) {
            const bf16x8 af = *(const bf16x8*)(XB + fr * 136 + 32 * ks + 8 * fq);
            acc = __builtin_amdgcn_mfma_f32_16x16x32_bf16(af, cb[ks], acc, 0, 0, 0);
          }
#pragma unroll
          for (int j = 0; j < 4; ++j) {
            const int i = 32 * blk + 16 * half + 4 * fq + j;
            const float yv = acc[j] + dv * bf2f(uraw[half][j]);
            YS[i * 264 + g * 16 + fr] = f2bf(gelu_tanh(yv));
          }
        }
      }
    }
    __syncthreads();
    {
      const int n0 = 32 * wid;
      f32x4 a1[4][2], a2[4][2];
#pragma unroll
      for (int mt = 0; mt < 4; ++mt)
#pragma unroll
        for (int nt = 0; nt < 2; ++nt) { a1[mt][nt] = (f32x4){0.f, 0.f, 0.f, 0.f}; a2[mt][nt] = (f32x4){0.f, 0.f, 0.f, 0.f}; }
#pragma unroll 1
      for (int kh = 0; kh < 2; ++kh) {
        bf16x8 w1[4][2], w2[4][2];
#pragma unroll
        for (int k4 = 0; k4 < 4; ++k4)
#pragma unroll
          for (int nt = 0; nt < 2; ++nt) {
            w1[k4][nt] = *(const bf16x8*)(WG + ((((size_t)wid * 8 + 4 * kh + k4) * 2 + 0) * 2 + nt) * 512 + lane * 8);
            w2[k4][nt] = *(const bf16x8*)(WG + ((((size_t)wid * 8 + 4 * kh + k4) * 2 + 1) * 2 + nt) * 512 + lane * 8);
          }
        __builtin_amdgcn_sched_barrier(0);
#pragma unroll
        for (int k4 = 0; k4 < 4; ++k4) {
          const int ks = 4 * kh + k4;
          bf16x8 yb[4];
#pragma unroll
          for (int mt = 0; mt < 4; ++mt) yb[mt] = *(const bf16x8*)(YS + (16 * mt + fr) * 264 + 32 * ks + 8 * fq);
#pragma unroll
          for (int mt = 0; mt < 4; ++mt)
#pragma unroll
            for (int nt = 0; nt < 2; ++nt) {
              a1[mt][nt] = __builtin_amdgcn_mfma_f32_16x16x32_bf16(w1[k4][nt], yb[mt], a1[mt][nt], 0, 0, 0);
              a2[mt][nt] = __builtin_amdgcn_mfma_f32_16x16x32_bf16(w2[k4][nt], yb[mt], a2[mt][nt], 0, 0, 0);
            }
        }
      }
#pragma unroll
      for (int mt = 0; mt < 4; ++mt) {
        float sq = 0.f;
#pragma unroll
        for (int nt = 0; nt < 2; ++nt) {
          f32x4 z = a1[mt][nt]; const f32x4 zg = a2[mt][nt];
          z.x *= sigmoid_f(zg.x); z.y *= sigmoid_f(zg.y); z.z *= sigmoid_f(zg.z); z.w *= sigmoid_f(zg.w);
          a1[mt][nt] = z; sq += z.x * z.x + z.y * z.y + z.z * z.z + z.w * z.w;
        }
        sq += __shfl_xor(sq, 16); sq += __shfl_xor(sq, 32);
        if (fq == 0) red[wid * 64 + 16 * mt + fr] = sq;
      }
      __syncthreads();
#pragma unroll
      for (int mt = 0; mt < 4; ++mt) {
        const int i = 16 * mt + fr, t = t0 + i;
        float tot = 0.f;
#pragma unroll
        for (int w8 = 0; w8 < 8; ++w8) tot += red[w8 * 64 + i];
        const float rstd = rsqrtf(tot * (1.f / 256.f) + EPS_);
#pragma unroll
        for (int nt = 0; nt < 2; ++nt) {
          const int c = n0 + 16 * nt + 4 * fq;
          const f32x4 mgv = *(const f32x4*)(mg + 768 + c); const f32x4 z = a1[mt][nt];
          uint2 ov; ov.x = pk2(z.x * rstd * mgv.x, z.y * rstd * mgv.y); ov.y = pk2(z.z * rstd * mgv.z, z.w * rstd * mgv.w);
          *(uint2*)(MRG + (size_t)t * 1024 + 768 + c) = ov;
        }
      }
    }
  }
}

typedef float f32x2 __attribute__((ext_vector_type(2)));
__device__ __forceinline__ float dot16_fp4(const uint2 u, const f32x2 (&hv)[8]) {
  f32x2 d = __builtin_amdgcn_cvt_scalef32_pk_f32_fp4(u.x, 1.0f, 0) * hv[0];
  d += __builtin_amdgcn_cvt_scalef32_pk_f32_fp4(u.x, 1.0f, 1) * hv[1];
  d += __builtin_amdgcn_cvt_scalef32_pk_f32_fp4(u.x, 1.0f, 2) * hv[2];
  d += __builtin_amdgcn_cvt_scalef32_pk_f32_fp4(u.x, 1.0f, 3) * hv[3];
  d += __builtin_amdgcn_cvt_scalef32_pk_f32_fp4(u.y, 1.0f, 0) * hv[4];
  d += __builtin_amdgcn_cvt_scalef32_pk_f32_fp4(u.y, 1.0f, 1) * hv[5];
  d += __builtin_amdgcn_cvt_scalef32_pk_f32_fp4(u.y, 1.0f, 2) * hv[6];
  d += __builtin_amdgcn_cvt_scalef32_pk_f32_fp4(u.y, 1.0f, 3) * hv[7];
  return d.x + d.y;
}
__device__ __forceinline__ void axpy16_fp4(const uint2 v, const float w, f32x2 (&acc)[8]) {
  const f32x2 w2 = (f32x2){w, w};
  acc[0] += w2 * __builtin_amdgcn_cvt_scalef32_pk_f32_fp4(v.x, 1.0f, 0);
  acc[1] += w2 * __builtin_amdgcn_cvt_scalef32_pk_f32_fp4(v.x, 1.0f, 1);
  acc[2] += w2 * __builtin_amdgcn_cvt_scalef32_pk_f32_fp4(v.x, 1.0f, 2);
  acc[3] += w2 * __builtin_amdgcn_cvt_scalef32_pk_f32_fp4(v.x, 1.0f, 3);
  acc[4] += w2 * __builtin_amdgcn_cvt_scalef32_pk_f32_fp4(v.y, 1.0f, 0);
  acc[5] += w2 * __builtin_amdgcn_cvt_scalef32_pk_f32_fp4(v.y, 1.0f, 1);
  acc[6] += w2 * __builtin_amdgcn_cvt_scalef32_pk_f32_fp4(v.y, 1.0f, 2);
  acc[7] += w2 * __builtin_amdgcn_cvt_scalef32_pk_f32_fp4(v.y, 1.0f, 3);
}
__device__ __forceinline__ float vmaxf(float a, float b) { float r; asm("v_max_f32 %0, %1, %2" : "=v"(r) : "v"(a), "v"(b)); return r; }
__device__ __forceinline__ float vminf(float a, float b) { float r; asm("v_min_f32 %0, %1, %2" : "=v"(r) : "v"(a), "v"(b)); return r; }
__device__ __forceinline__ void cx(float& hi, float& lo) { const float a = hi, b = lo; hi = vmaxf(a, b); lo = vminf(a, b); }
__device__ __forceinline__ void cx2(float& kh, int& ph, float& kl, int& pl) {
  const float a = kh, b = kl; const int pa = ph, pb = pl; const bool c = a >= b;
  kh = vmaxf(a, b); kl = vminf(a, b); ph = c ? pa : pb; pl = c ? pb : pa;
}
__device__ __forceinline__ void bitonic_sort16_desc(float (&v)[16]) {
#pragma unroll
  for (int k = 2; k <= 16; k <<= 1)
#pragma unroll
    for (int j = k >> 1; j > 0; j >>= 1)
#pragma unroll
      for (int i = 0; i < 16; ++i) {
        const int l = i ^ j;
        if (l > i) { if ((i & k) == 0) cx(v[i], v[l]); else cx(v[l], v[i]); }
      }
}
__device__ __forceinline__ void bitonic_merge16_desc(float (&v)[16]) {
#pragma unroll
  for (int j = 8; j > 0; j >>= 1)
#pragma unroll
    for (int i = 0; i < 16; ++i) { const int l = i ^ j; if (l > i) cx(v[i], v[l]); }
}
__device__ __forceinline__ void top16_merge(float (&a)[16], const float (&b)[16]) {
#pragma unroll
  for (int i = 0; i < 16; ++i) a[i] = vmaxf(a[i], b[15 - i]);
  bitonic_merge16_desc(a);
}
template <int M> __device__ __forceinline__ void top16_merge_chain(float (&k)[16], int (&q)[16], const float (&xk)[M], const int (&xq)[M]) {
#pragma unroll
  for (int i = 16 - M; i < 16; ++i) { const float a = k[i], b = xk[15 - i]; const bool c = a >= b; k[i] = vmaxf(a, b); q[i] = c ? q[i] : xq[15 - i]; }
#pragma unroll
  for (int j = 8; j > 0; j >>= 1)
#pragma unroll
    for (int i = 0; i < 16; ++i) { const int l = i ^ j; if (l > i) cx2(k[i], q[i], k[l], q[l]); }
}

typedef unsigned u32x4v __attribute__((ext_vector_type(4)));
__device__ __forceinline__ void peer_req_rows16(u32x4v (&Q)[8], const unsigned char* tab, int e, int hi5, unsigned lane16) {
#pragma unroll
  for (int r = 0; r < 8; ++r) {
    const int ea = __builtin_amdgcn_readlane(e, 2 * r), eb = __builtin_amdgcn_readlane(e, 2 * r + 1);
    const unsigned off = (unsigned)(hi5 ? eb : ea) * 512u + lane16;
    Q[r] = *(const u32x4v*)(tab + off);
  }
}
__device__ __forceinline__ void peer_req_rows8(u32x4v (&Q)[8], const unsigned char* tab, int e, unsigned lane8) {
#pragma unroll
  for (int r = 0; r < 16; ++r) {
    const unsigned off = (unsigned)__builtin_amdgcn_readlane(e, r) * 512u + lane8;
    const uint2 t = *(const uint2*)(tab + off);
    Q[r >> 1][2 * (r & 1)] = t.x; Q[r >> 1][2 * (r & 1) + 1] = t.y;
  }
}
__device__ void peer_phase(const Params& p, int l, bool last, unsigned char* smem) {
  const CParamsP pp = launder_kargs();
  GAS unsigned char* const ws = launder_ptr(pp->ws); const int tidx = launder_tid();
  bf16_t* HF = (bf16_t*)(ws + WS_ABUF); bf16_t* X = (bf16_t*)(ws + WS_X);
  const bf16_t* SC8 = (const bf16_t*)(ws + WS_SC);
  const uint2* U4 = (const uint2*)(ws + WS_PU8) + (size_t)l * 16384 * 64; const uint2* V4 = (const uint2*)(ws + WS_PV8) + (size_t)l * 16384 * 64;
  const float* g2 = (const float*)(ws + WS_MOD) + (size_t)l * 2 * 6144 + 5120;
  const bf16_t* XG = (const bf16_t*)(ws + WS_XG); const float* SSQ = (const float*)(ws + WS_SSQ); const float* sh2 = (const float*)(ws + WS_MOD) + (size_t)l * 2 * 6144 + 3072;
  const int ln = last ? l : l + 1;
  const float* nsh = (const float*)(ws + WS_MOD) + (size_t)ln * 2 * 6144; const float* nsc = nsh + 1024;
  const float* ngain = gin(pp->in[I_NMIX]) + (size_t)ln * 1024;
  const int lane = tidx & 63, wid = tidx >> 6;
  const int rL = ((lane >> 5) & 1) * 8 + ((lane >> 4) & 1) * 4 + ((lane >> 3) & 1) * 2 + ((lane >> 2) & 1);
  const bool hi5 = (lane & 32) != 0, hi4 = (lane & 16) != 0, hi3 = (lane & 8) != 0, hi2 = (lane & 4) != 0;
  int* idxL = (int*)smem;
  float* cst = (float*)(smem + 109568);
  for (int it_ = blockIdx.x; it_ < T_ / 64; it_ += gridDim.x) {
    const int item = ((it_ & 7) << 5) | (it_ >> 3);
    const int t0 = item * 64;
    __syncthreads();
    {
      const int bb = t0 >> 13;
      for (int c = tidx; c < 1024; c += NT) {
        const int o = ((c >> 2) & 3) * 256 + (c >> 4) * 4 + (c & 3);
        cst[o] = g2[bb * 6144 + c] * 0.25f;
        cst[1024 + o] = last ? gin(pp->in[I_FNORM])[c] : ngain[c] * (1.f + nsc[bb * 6144 + c]);
        cst[2048 + o] = last ? 0.f : nsh[bb * 6144 + c];
        cst[3072 + o] = sh2[bb * 6144 + c];
      }
    }
    {
      int lane_o = lane; asm volatile("" : "+v"(lane_o));
      const int tg = wid & 1, hp = wid >> 1, hf = lane_o >> 5, tl = 32 * tg + (lane_o & 31);
      float F[2][16];
#pragma unroll
      for (int sd = 0; sd < 2; ++sd) {
        float Lh[2][16];
#pragma unroll
        for (int hh = 0; hh < 2; ++hh) {
          const int hs = 2 * (2 * hp + hh) + sd;
          float top[16];
          const bf16_t* scp = SC8 + (((size_t)(hs * 16 + 8 * hf)) * T_ + (t0 + tl)) * 8;
          uint4 sv[8];
#pragma unroll
          for (int kq = 0; kq < 8; ++kq) sv[kq] = *(const uint4*)(scp + (size_t)kq * T_ * 8);
          __builtin_amdgcn_sched_barrier(0);
#pragma unroll
          for (int kt = 0; kt < 4; ++kt) {
            float g[16];
#pragma unroll
            for (int kq = 0; kq < 2; ++kq) {
              const uint4 v8 = sv[2 * kt + kq];
              const unsigned wv[4] = {v8.x, v8.y, v8.z, v8.w};
#pragma unroll
              for (int j = 0; j < 4; ++j) {
                const int key = 64 * hf + 16 * kt + 8 * kq + 2 * j;
                g[8 * kq + 2 * j] = __uint_as_float((wv[j] << 16) | (unsigned)key);
                g[8 * kq + 2 * j + 1] = __uint_as_float((wv[j] & 0xffff0000u) | (unsigned)(key + 1));
              }
            }
            bitonic_sort16_desc(g);
            if (kt == 0) {
#pragma unroll
              for (int r = 0; r < 16; ++r) top[r] = g[r];
            } else top16_merge(top, g);
            __builtin_amdgcn_sched_barrier(0);
          }
#pragma unroll
          for (int r = 0; r < 16; ++r) Lh[hh][r] = top[r];
          __builtin_amdgcn_sched_barrier(0);
        }
#pragma unroll
        for (int r = 0; r < 16; ++r) {
          const auto sw = __builtin_amdgcn_permlane32_swap(__float_as_uint(Lh[0][r]), __float_as_uint(Lh[1][r]), false, false);
          Lh[0][r] = __uint_as_float(sw[0]); Lh[1][r] = __uint_as_float(sw[1]);
        }
        top16_merge(Lh[0], Lh[1]);
#pragma unroll
        for (int r = 0; r < 16; ++r) F[sd][r] = Lh[0][r];
        __builtin_amdgcn_sched_barrier(0);
      }
      int ia[16], ib[16];
#pragma unroll
      for (int r = 0; r < 16; ++r) { ia[r] = (int)(__float_as_uint(F[0][r]) & 127u) << 7; ib[r] = (int)(__float_as_uint(F[1][r]) & 127u); }
      float k[16]; int q[16];
#pragma unroll
      for (int j = 0; j < 16; ++j) { k[j] = F[0][0] + F[1][j]; q[j] = ia[0] | ib[j]; }
      { float xk[8]; int xq[8];
#pragma unroll
        for (int j = 0; j < 8; ++j) { xk[j] = F[0][1] + F[1][j]; xq[j] = ia[1] | ib[j]; }
        top16_merge_chain<8>(k, q, xk, xq); }
      { float xk[5]; int xq[5];
#pragma unroll
        for (int j = 0; j < 5; ++j) { xk[j] = F[0][2] + F[1][j]; xq[j] = ia[2] | ib[j]; }
        top16_merge_chain<5>(k, q, xk, xq); }
      { float xk[4]; int xq[4];
#pragma unroll
        for (int j = 0; j < 4; ++j) { xk[j] = F[0][3] + F[1][j]; xq[j] = ia[3] | ib[j]; }
        top16_merge_chain<4>(k, q, xk, xq); }
      { float xk[3]; int xq[3];
#pragma unroll
        for (int j = 0; j < 3; ++j) { xk[j] = F[0][4] + F[1][j]; xq[j] = ia[4] | ib[j]; }
        top16_merge_chain<3>(k, q, xk, xq); }
      { float xk[11]; int xq[11];
#pragma unroll
        for (int i = 0; i < 11; ++i) { xk[i] = F[0][5 + i] + F[1][0]; xq[i] = ia[5 + i] | ib[0]; }
        top16_merge_chain<11>(k, q, xk, xq); }
      { float xk[3]; int xq[3];
#pragma unroll
        for (int i = 0; i < 3; ++i) { xk[i] = F[0][5 + i] + F[1][1]; xq[i] = ia[5 + i] | ib[1]; }
        top16_merge_chain<3>(k, q, xk, xq); }
      float e[16]; float es = 0.f;
#pragma unroll
      for (int i = 0; i < 16; ++i) { e[i] = __expf(k[i] - k[0]); es += e[i]; }
      const float ies = 1.f / es;
      const int h = 2 * hp + hf;
#pragma unroll
      for (int i = 0; i < 16; ++i) idxL[tl * 132 + h * 16 + i] = (int)(((unsigned)f2bf(e[i] * ies) << 16) | (unsigned)q[i]);
    }
    __syncthreads();
    {
      const int fr = lane & 15, fq = lane >> 4, jsel = lane & 3, tlb = wid * 8;
      unsigned char* hq4 = smem + 33792 + wid * 1024;
      unsigned char* ust = smem + 41984 + wid * 8448;
      const unsigned lane8 = (unsigned)lane * 8u;
      const int hi5 = lane >> 5; const unsigned lane16 = (unsigned)(lane & 31) * 16u;
#define PEER_REQ_IDX(sn_) (idxL[(tlb + ((min((sn_), 127) & 63) >> 3)) * 132 + 16 * (min((sn_), 127) & 7) + fr] & 0xffff)
#define PEER_REQ_U(Q, e_) peer_req_rows16(Q, (const unsigned char*)U4, (e_), hi5, lane16)
      u32x4v qa[8], qb[8];
      {
        const int e0 = PEER_REQ_IDX(0), e1 = PEER_REQ_IDX(1);
        PEER_REQ_U(qa, e0);
        __builtin_amdgcn_sched_barrier(0);
        PEER_REQ_U(qb, e1);
        __builtin_amdgcn_sched_barrier(0);
      }
      {
        const float rs_lane = rsqrtf(ssq_total(SSQ, t0 + tlb + (lane & 7)) * (1.f / 1024.f) + EPS_);
        uint4 nh0 = *(const uint4*)(XG + (size_t)(t0 + tlb) * 1024 + lane * 16), nh1 = *(const uint4*)(XG + (size_t)(t0 + tlb) * 1024 + lane * 16 + 8);
#pragma unroll 1
        for (int ii = 0; ii < 8; ++ii) {
          const int tl = tlb + ii, t = t0 + tl;
          uint4 hB1[8], hB2[8];
          {
            const unsigned hw[8] = {nh0.x, nh0.y, nh0.z, nh0.w, nh1.x, nh1.y, nh1.z, nh1.w};
            const float rs = __int_as_float(__builtin_amdgcn_readlane(__float_as_int(rs_lane), ii));
            unsigned q1[2] = {0u, 0u}, q2[2] = {0u, 0u};
#pragma unroll
            for (int qq = 0; qq < 4; ++qq) {
              const f32x4 sh = *(const f32x4*)(cst + 3072 + qq * 256 + lane * 4);
              float hvv[4];
              hvv[0] = __uint_as_float(hw[2 * qq] << 16) * rs + sh.x; hvv[1] = __uint_as_float(hw[2 * qq] & 0xffff0000u) * rs + sh.y;
              hvv[2] = __uint_as_float(hw[2 * qq + 1] << 16) * rs + sh.z; hvv[3] = __uint_as_float(hw[2 * qq + 1] & 0xffff0000u) * rs + sh.w;
#pragma unroll
              for (int pr = 0; pr < 2; ++pr) {
                const int byte_sel = (2 * qq + pr) & 3, wd = (2 * qq + pr) >> 2;
                const float x0 = fminf(fmaxf(hvv[2 * pr], -6.f), 6.f), x1 = fminf(fmaxf(hvv[2 * pr + 1], -6.f), 6.f);
                unsigned t1 = 0u;
                if (byte_sel == 0) t1 = __builtin_amdgcn_cvt_scalef32_pk_fp4_f32(0u, x0, x1, 1.0f, 0);
                else if (byte_sel == 1) t1 = __builtin_amdgcn_cvt_scalef32_pk_fp4_f32(0u, x0, x1, 1.0f, 1);
                else if (byte_sel == 2) t1 = __builtin_amdgcn_cvt_scalef32_pk_fp4_f32(0u, x0, x1, 1.0f, 2);
                else t1 = __builtin_amdgcn_cvt_scalef32_pk_fp4_f32(0u, x0, x1, 1.0f, 3);
                f32x2 back;
                if (byte_sel == 0) back = __builtin_amdgcn_cvt_scalef32_pk_f32_fp4(t1, 1.0f, 0);
                else if (byte_sel == 1) back = __builtin_amdgcn_cvt_scalef32_pk_f32_fp4(t1, 1.0f, 1);
                else if (byte_sel == 2) back = __builtin_amdgcn_cvt_scalef32_pk_f32_fp4(t1, 1.0f, 2);
                else back = __builtin_amdgcn_cvt_scalef32_pk_f32_fp4(t1, 1.0f, 3);
                const float r0 = fminf(fmaxf((hvv[2 * pr] - back.x) * 8.f, -6.f), 6.f), r1 = fminf(fmaxf((hvv[2 * pr + 1] - back.y) * 8.f, -6.f), 6.f);
                unsigned t2 = 0u;
                if (byte_sel == 0) t2 = __builtin_amdgcn_cvt_scalef32_pk_fp4_f32(0u, r0, r1, 1.0f, 0);
                else if (byte_sel == 1) t2 = __builtin_amdgcn_cvt_scalef32_pk_fp4_f32(0u, r0, r1, 1.0f, 1);
                else if (byte_sel == 2) t2 = __builtin_amdgcn_cvt_scalef32_pk_fp4_f32(0u, r0, r1, 1.0f, 2);
                else t2 = __builtin_amdgcn_cvt_scalef32_pk_fp4_f32(0u, r0, r1, 1.0f, 3);
                q1[wd] |= t1; q2[wd] |= t2;
              }
            }
            *(uint2*)(hq4 + lane * 8) = make_uint2(q1[0], q1[1]);
            *(uint2*)(hq4 + 512 + lane * 8) = make_uint2(q2[0], q2[1]);
#pragma unroll
            for (int kc = 0; kc < 8; ++kc) { hB1[kc] = *(const uint4*)(hq4 + 64 * kc + 16 * fq); hB2[kc] = *(const uint4*)(hq4 + 512 + 64 * kc + 16 * fq); }
          }
          { const int tn = t + (ii < 7 ? 1 : 0);
            nh0 = *(const uint4*)(XG + (size_t)tn * 1024 + lane * 16); nh1 = *(const uint4*)(XG + (size_t)tn * 1024 + lane * 16 + 8); }
          __builtin_amdgcn_sched_barrier(0);
#define PEER_U_STEP(R, bt_) do { const int _bt = (bt_), _sn = ii * 8 + _bt + 2; \
            _Pragma("unroll") for (int r = 0; r < 8; ++r) *(u32x4v*)(ust + (2 * r + hi5) * 528 + lane16) = R[r];        \
            if (_sn < 64) { const int _en = PEER_REQ_IDX(_sn); PEER_REQ_U(R, _en); } else { const int _en = PEER_REQ_IDX(_sn); peer_req_rows8(R, (const unsigned char*)V4, _en, lane8); }        \
            __builtin_amdgcn_sched_barrier(0); \
            uint4 ua[8]; \
            _Pragma("unroll") for (int kc = 0; kc < 8; ++kc) ua[kc] = *(const uint4*)(ust + fr * 528 + 64 * kc + 16 * fq);      \
            f32x4 sa[2] = {(f32x4){0.f, 0.f, 0.f, 0.f}, (f32x4){0.f, 0.f, 0.f, 0.f}}, sb[2] = {(f32x4){0.f, 0.f, 0.f, 0.f}, (f32x4){0.f, 0.f, 0.f, 0.f}};     \
            _Pragma("unroll") for (int kc = 0; kc < 8; ++kc) { \
              const i32x8 av = (i32x8){(int)ua[kc].x, (int)ua[kc].y, (int)ua[kc].z, (int)ua[kc].w, 0, 0, 0, 0}; \
              const i32x8 b1 = (i32x8){(int)hB1[kc].x, (int)hB1[kc].y, (int)hB1[kc].z, (int)hB1[kc].w, 0, 0, 0, 0}; \
              const i32x8 b2 = (i32x8){(int)hB2[kc].x, (int)hB2[kc].y, (int)hB2[kc].z, (int)hB2[kc].w, 0, 0, 0, 0}; \
              sa[kc & 1] = __builtin_amdgcn_mfma_scale_f32_16x16x128_f8f6f4(av, b1, sa[kc & 1], 4  , 4  , 0, 0x7F7F7F7F, 0, 0x7F7F7F7F); \
              sb[kc & 1] = __builtin_amdgcn_mfma_scale_f32_16x16x128_f8f6f4(av, b2, sb[kc & 1], 4, 4, 0, 0x7F7F7F7F, 0, 0x7F7F7F7F); } \
            const f32x4 sc4 = (sa[0] + sa[1]) + (sb[0] + sb[1]) * 0.125f; \
              \
            const float dsel = jsel == 0 ? sc4[0] : (jsel == 1 ? sc4[1] : (jsel == 2 ? sc4[2] : sc4[3])); \
            const int _eo = tl * 132 + 16 * _bt + 4 * fq + jsel; const unsigned _pe = (unsigned)idxL[_eo]; \
            const float _w = __uint_as_float(_pe & 0xffff0000u) * gelu_tanh_fast(dsel * (1.f / 64.f));            \
            if (fr < 4) idxL[_eo] = (int)(((unsigned)f2bf(_w) << 16) | (_pe & 0xffffu)); \
          } while (0)
#pragma unroll 1
          for (int b2 = 0; b2 < 8; b2 += 2) { PEER_U_STEP(qa, b2); PEER_U_STEP(qb, b2 + 1); }
#undef PEER_U_STEP
        }
      }
      {
        f32x2 acc2[8];
#pragma unroll
        for (int j = 0; j < 8; ++j) acc2[j] = (f32x2){0.f, 0.f};
#pragma unroll 1
        for (int ii = 0; ii < 8; ++ii) {
          const int tl = tlb + ii, t = t0 + tl;
          const uint4 xr0 = *(const uint4*)(X + (size_t)t * 1024 + lane * 16), xr1 = *(const uint4*)(X + (size_t)t * 1024 + lane * 16 + 8);
          __builtin_amdgcn_sched_barrier(0);
#define PEER_V_STEP(R, bt_) do { const int _bt = (bt_), _sn = 64 + ii * 8 + _bt + 2; \
            const int _wv = (int)((unsigned)idxL[tl * 132 + 16 * _bt + fr] & 0xffff0000u);          \
            const int _en = PEER_REQ_IDX(_sn); \
            _Pragma("unroll") for (int r = 0; r < 16; ++r) { \
              const float wr = __int_as_float(__builtin_amdgcn_readlane(_wv, r)); \
              axpy16_fp4(make_uint2(R[r >> 1][2 * (r & 1)], R[r >> 1][2 * (r & 1) + 1]), wr, acc2); \
              { const unsigned off = (unsigned)__builtin_amdgcn_readlane(_en, r) * 512u + lane8; const uint2 _t = *(const uint2*)((const unsigned char*)V4 + off); \
                R[r >> 1][2 * (r & 1)] = _t.x; R[r >> 1][2 * (r & 1) + 1] = _t.y; } \
              __builtin_amdgcn_sched_barrier(0); } \
          } while (0)
#pragma unroll 1
          for (int b2 = 0; b2 < 8; b2 += 2) { PEER_V_STEP(qa, b2); PEER_V_STEP(qb, b2 + 1); }
#undef PEER_V_STEP
          float xn[16]; float ss = 0.f;
          const unsigned xw[8] = {xr0.x, xr0.y, xr0.z, xr0.w, xr1.x, xr1.y, xr1.z, xr1.w};
#pragma unroll
          for (int qq = 0; qq < 4; ++qq) {
            const f32x4 xv = (f32x4){__uint_as_float(xw[2 * qq] << 16), __uint_as_float(xw[2 * qq] & 0xffff0000u), __uint_as_float(xw[2 * qq + 1] << 16), __uint_as_float(xw[2 * qq + 1] & 0xffff0000u)};
            const f32x4 g = *(const f32x4*)(cst + qq * 256 + lane * 4);
            xn[4 * qq] = xv.x + g.x * acc2[2 * qq].x; xn[4 * qq + 1] = xv.y + g.y * acc2[2 * qq].y;
            xn[4 * qq + 2] = xv.z + g.z * acc2[2 * qq + 1].x; xn[4 * qq + 3] = xv.w + g.w * acc2[2 * qq + 1].y;
            ss += xn[4 * qq] * xn[4 * qq] + xn[4 * qq + 1] * xn[4 * qq + 1] + xn[4 * qq + 2] * xn[4 * qq + 2] + xn[4 * qq + 3] * xn[4 * qq + 3];
          }
#pragma unroll
          for (int j = 0; j < 8; ++j) acc2[j] = (f32x2){0.f, 0.f};
          const float rstd = rsqrtf(wave_sum(ss) * (1.f / 1024.f) + EPS_);
          if (!last) {
            unsigned hb[8], xb[8];
#pragma unroll
            for (int qq = 0; qq < 4; ++qq) {
              xb[2 * qq] = pk2(xn[4 * qq], xn[4 * qq + 1]); xb[2 * qq + 1] = pk2(xn[4 * qq + 2], xn[4 * qq + 3]);
              const f32x4 ga = *(const f32x4*)(cst + 1024 + qq * 256 + lane * 4), sh = *(const f32x4*)(cst + 2048 + qq * 256 + lane * 4);
              hb[2 * qq] = pk2(xn[4 * qq] * rstd * ga.x + sh.x, xn[4 * qq + 1] * rstd * ga.y + sh.y);
              hb[2 * qq + 1] = pk2(xn[4 * qq + 2] * rstd * ga.z + sh.z, xn[4 * qq + 3] * rstd * ga.w + sh.w);
            }
            *(uint4*)(X + (size_t)t * 1024 + lane * 16) = make_uint4(xb[0], xb[1], xb[2], xb[3]);
            *(uint4*)(X + (size_t)t * 1024 + lane * 16 + 8) = make_uint4(xb[4], xb[5], xb[6], xb[7]);
            *(uint4*)(HF + (size_t)t * 1024 + lane * 16) = make_uint4(hb[0], hb[1], hb[2], hb[3]);
            *(uint4*)(HF + (size_t)t * 1024 + lane * 16 + 8) = make_uint4(hb[4], hb[5], hb[6], hb[7]);
          } else {
#pragma unroll
            for (int qq = 0; qq < 4; ++qq) {
              const f32x4 fn = *(const f32x4*)(cst + 1024 + qq * 256 + lane * 4);
              *(f32x4*)((float*)pp->out + (size_t)t * 1024 + lane * 16 + 4 * qq) = (f32x4){xn[4 * qq] * rstd * fn.x, xn[4 * qq + 1] * rstd * fn.y, xn[4 * qq + 2] * rstd * fn.z, xn[4 * qq + 3] * rstd * fn.w};
            }
          }
        }
      }
#undef PEER_REQ_IDX
#undef PEER_REQ_U
    }
  }
}

#define XB_TMO      128
#define XB_XCNT(j)  (256  + 64 * (j))
#define XB_XSUB(j)  (1280 + 64 * (j))
#define XB_XGEN(j)  (2304 + 64 * (j))
#define XB_TOP      3328
#define XB_TOPGEN   3392
#define XCD_BAR_WORDS 3456
#define XB_SPIN_CAP (1u << 20)
#define LAS __attribute__((address_space(3)))
__device__ __forceinline__ unsigned xb_ld(unsigned* q)              { return __hip_atomic_load(q, __ATOMIC_RELAXED, __HIP_MEMORY_SCOPE_AGENT); }
__device__ __forceinline__ unsigned xb_add(unsigned* q, unsigned v) { return __hip_atomic_fetch_add(q, v, __ATOMIC_RELAXED, __HIP_MEMORY_SCOPE_AGENT); }
__device__ __forceinline__ unsigned xb_xcc_id() { return (unsigned)__builtin_amdgcn_s_getreg((3 << 11) | 20) & 0xFu; }
#define XB_SPIN(cond, bar) do { unsigned _sp = 0; while (cond) { __builtin_amdgcn_s_sleep(1); \
    if ((++_sp & 255u) == 0u) { if (xb_ld(&(bar)[XB_TMO])) break; if (_sp > XB_SPIN_CAP) { atomicAdd(&(bar)[XB_TMO], 1u); break; } } } } while (0)
struct XcdBarrier { unsigned* bar; unsigned x; volatile LAS unsigned* st; };
__device__ __forceinline__ XcdBarrier xcd_barrier_post(unsigned* bar, volatile LAS unsigned* st) {
    XcdBarrier b; b.bar = bar; b.x = xb_xcc_id(); b.st = st;
    if (threadIdx.x == 0) (void)xb_add(&bar[XB_XCNT(b.x)], 1u);
    return b;
}
__device__ __forceinline__ void xcd_barrier_complete(unsigned* bar, unsigned x, unsigned& nloc, unsigned& nx) {
    const unsigned G = gridDim.x * gridDim.y * gridDim.z;
    unsigned sum, cnt, mine, sp = 0u;
    for (;;) {
        sum = 0u; cnt = 0u; mine = 0u;
#pragma unroll
        for (unsigned j = 0; j < 16; ++j) { const unsigned c = xb_ld(&bar[XB_XCNT(j)]); sum += c; cnt += (c > 0u) ? 1u : 0u; mine = (j == x) ? c : mine; }
        if (sum == G) break;
        __builtin_amdgcn_s_sleep(1);
        if ((++sp & 255u) == 0u) { if (xb_ld(&bar[XB_TMO])) break; if (sp > XB_SPIN_CAP) { atomicAdd(&bar[XB_TMO], 1u); break; } }
    }
    nloc = mine > 0u ? mine : 1u; nx = cnt > 0u ? cnt : 1u;
}
__device__ __forceinline__ void xcd_barrier(const XcdBarrier& b) {
    asm volatile("s_waitcnt vmcnt(0)" ::: "memory");
    __syncthreads();
    if (threadIdx.x == 0) {
        unsigned* bar = b.bar;
        __builtin_amdgcn_s_waitcnt(0);
        unsigned nloc = b.st[0], nx = b.st[1];
        if (nloc == 0u) { xcd_barrier_complete(bar, b.x, nloc, nx); b.st[0] = nloc; b.st[1] = nx; }
        const unsigned old = xb_add(&bar[XB_XSUB(b.x)], 1u);
        const unsigned gen = old / nloc;
        if (old + 1u == (gen + 1u) * nloc) {
            __builtin_amdgcn_fence(__ATOMIC_RELEASE, "agent");
            asm volatile("s_waitcnt vmcnt(0)" ::: "memory");
            const unsigned og = xb_add(&bar[XB_TOP], 1u);
            const unsigned tg = og / nx;
            if (og + 1u == (tg + 1u) * nx) xb_add(&bar[XB_TOPGEN], 1u);
            else XB_SPIN(xb_ld(&bar[XB_TOPGEN]) == tg, bar);
            __builtin_amdgcn_fence(__ATOMIC_ACQUIRE, "agent");
            xb_add(&bar[XB_XGEN(b.x)], 1u);
            asm volatile("s_waitcnt vmcnt(0)" ::: "memory");
        } else {
            XB_SPIN(xb_ld(&bar[XB_XGEN(b.x)]) == gen, bar);
            __builtin_amdgcn_fence(__ATOMIC_ACQUIRE, "agent");
            asm volatile("s_waitcnt vmcnt(0)" ::: "memory");
        }
    }
    __syncthreads();
}

__global__ void __launch_bounds__(NT) fwd_megakernel(Params p) {
  extern __shared__ __attribute__((aligned(16))) unsigned char smem[];
  const CParamsP pp = launder_kargs();
  cg::grid_group grid = cg::this_grid();
  volatile LAS unsigned* xbst = (volatile LAS unsigned*)(smem + LDS_BYTES - 16);
  if (threadIdx.x == 0) { xbst[0] = 0u; xbst[1] = 0u; }
  if (blockIdx.x == 0) { unsigned* bw = (unsigned*)(pp->ws + WS_BAR); for (int i = threadIdx.x; i < XCD_BAR_WORDS; i += NT) bw[i] = 0u; }
  setup_phase(p, smem);
  grid.sync();
  const XcdBarrier xb = xcd_barrier_post((unsigned*)(pp->ws + WS_BAR), xbst);
  const float* MOD = (const float*)(pp->ws + WS_MOD);
  for (int l = 0; l < DEPTH_; ++l) {
    const float* xsrc = (l == 0) ? gin(pp->in[I_X]) : (const float*)(pp->ws + WS_X);
    const float* modl = MOD + (size_t)l * 2 * 6144;
    if (l == 0) {
      norm_mod_phase(xsrc, gin(pp->in[I_NMIX]), modl + 0, modl + 1024, (bf16_t*)(pp->ws + WS_ABUF));
      qbias_phase(p, smem);
      xcd_barrier(xb);
    }
    gemm_proj_phase(p, l, smem);
    xcd_barrier(xb);
    attn_phase(p, l, smem);
    mix_local_phase(p, l, smem);
    xcd_barrier(xb);
    scan_phase(p, l);
    xcd_barrier(xb);
    mix_final_phase(p, l, smem);
    xcd_barrier(xb);
    gemm_out_phase(p, l, smem);
    xcd_barrier(xb);
    gemm_q_phase(p, l, smem);
    xcd_barrier(xb);
    peer_phase(p, l, l == DEPTH_ - 1, smem);
    xcd_barrier(xb);
  }
}

extern "C" void kernel_launch(void* const* d_in, const int* in_sizes, int n_in,
                              void* d_out, int out_size, void* d_ws, size_t ws_size,
                              hipStream_t stream) {
  static int grid_blocks = 0;
  if (grid_blocks == 0) {
    if (n_in != 24 || ws_size < WS_END) { fprintf(stderr, "kernel_launch: unexpected n_in %d / ws_size %zu (need %zu)\n", n_in, ws_size, (size_t)WS_END); grid_blocks = -1; return; }
    int dev = 0, cus = 0, per_cu = 0;
    if (hipGetDevice(&dev) != hipSuccess || hipDeviceGetAttribute(&cus, hipDeviceAttributeMultiprocessorCount, dev) != hipSuccess) { grid_blocks = -1; return; }
    if (hipFuncSetAttribute((const void*)fwd_megakernel, hipFuncAttributeMaxDynamicSharedMemorySize, LDS_BYTES) != hipSuccess) { fprintf(stderr, "hipFuncSetAttribute failed\n"); grid_blocks = -1; return; }
    if (hipOccupancyMaxActiveBlocksPerMultiprocessor(&per_cu, (const void*)fwd_megakernel, NT, LDS_BYTES) != hipSuccess || per_cu < 1) { fprintf(stderr, "occupancy query: %d\n", per_cu); grid_blocks = -1; return; }
    grid_blocks = cus;
  }
  if (grid_blocks < 0) return;
  Params p{};
  for (int i = 0; i < 24; ++i) p.in[i] = (const GAS float*)d_in[i];
  p.out = (GAS float*)d_out; p.ws = (GAS unsigned char*)d_ws;
  void* args[] = {&p};
  hipError_t e = hipLaunchCooperativeKernel((void*)fwd_megakernel, dim3(grid_blocks), dim3(NT), args, LDS_BYTES, stream);
  if (e != hipSuccess) fprintf(stderr, "cooperative launch failed: %s (grid %d)\n", hipGetErrorString(e), grid_blocks);
}
```

```cpp
#include <hip/hip_runtime.h>
#include <hip/hip_cooperative_groups.h>
#include <cstdio>
#include <cstdint>
namespace cg = cooperative_groups;

typedef unsigned short bf16_t;
typedef short bf16x8 __attribute__((ext_vector_type(8)));
typedef float f32x4 __attribute__((ext_vector_type(4)));
typedef float f32x16 __attribute__((ext_vector_type(16)));
typedef int i32x8 __attribute__((ext_vector_type(8)));

constexpr int T_ = 16384, D_ = 1024, L_ = 8192, NBATCH = 2, DEPTH_ = 4;
constexpr int INC = 2944, INCP = 3072;
constexpr int NCH = 128;
constexpr int NT = 512;
constexpr int NW = 8;
constexpr float EPS_ = 1e-6f;
constexpr int C_QA = 0, C_KA = 384, C_VA = 768, C_QR = 1152, C_KR = 1536, C_VR = 1920, C_GR = 2304, C_US = 2688;

constexpr size_t al256(size_t x) { return (x + 255) & ~(size_t)255; }
constexpr size_t WS_MOD   = 0;
constexpr size_t WS_ROTC  = al256(WS_MOD + 4ull * 2 * 6144 * 4);
constexpr size_t WS_ROTS  = al256(WS_ROTC + 8192ull * 32 * 4);
constexpr size_t WS_SA    = al256(WS_ROTS + 8192ull * 32 * 4);
constexpr size_t WS_SBB   = al256(WS_SA + 4ull * 16 * 64 * 2 * 4);
constexpr size_t WS_WIN   = al256(WS_SBB + 4ull * 16 * 64 * 32 * 4);
constexpr size_t WS_WOUT  = al256(WS_WIN + 4ull * INCP * 1024 * 2);
constexpr size_t WS_WQ    = al256(WS_WOUT + 4ull * 1024 * 1024 * 2);
constexpr size_t WS_SUBK  = al256(WS_WQ + 4ull * 2048 * 1024 * 2);
constexpr size_t WS_ABUF  = al256(WS_SUBK + 4ull * 16 * 128 * 128 * 2);
constexpr size_t WS_PROJ  = al256(WS_ABUF + (size_t)T_ * 1024 * 2);
constexpr size_t WS_VTA   = al256(WS_PROJ + (size_t)T_ * INCP * 2);
constexpr size_t WS_ATT   = al256(WS_VTA + 2ull * 6 * 64 * 8192 * 2);
constexpr size_t WS_YINT  = al256(WS_ATT + (size_t)T_ * 384 * 4);
constexpr size_t WS_UPD   = al256(WS_YINT + (size_t)T_ * 384 * 4);
constexpr size_t WS_SPREV = al256(WS_UPD + 256ull * 6 * 4096 * 4);
constexpr size_t WS_SEND  = al256(WS_SPREV + 256ull * 6 * 4096 * 4);
constexpr size_t WS_CARRY = al256(WS_SEND + 256ull * 16 * 64 * 2 * 4);
constexpr size_t WS_X     = al256(WS_CARRY + 256ull * 16 * 64 * 2 * 4);
constexpr size_t WS_Q     = al256(WS_X + (size_t)T_ * 1024 * 4);
constexpr size_t WS_SC    = al256(WS_Q + (size_t)T_ * 2048 * 2);
constexpr size_t WS_EIDX  = al256(WS_SC + (size_t)T_ * 2048 * 4);
constexpr size_t WS_EGATE = al256(WS_EIDX + (size_t)T_ * 128 * 4);
constexpr size_t WS_PU8   = al256(WS_EGATE + (size_t)T_ * 128 * 4);
constexpr size_t WS_PV8   = al256(WS_PU8 + 4ull * 16384 * 1024);
constexpr size_t WS_BAR   = al256(WS_PV8 + 4ull * 16384 * 1024);
constexpr size_t WS_SPT   = al256(WS_BAR + 3456ull * 4);
constexpr size_t WS_CB    = al256(WS_SPT + 256ull * 6 * 4096 * 2);
constexpr size_t WS_WGLUT = al256(WS_CB + 4ull * 16 * 16 * 128 * 2);
constexpr size_t WS_VTR   = al256(WS_WGLUT + 4ull * 512 * 256 * 2);
constexpr size_t WS_XG    = al256(WS_VTR + 2ull * 384 * 8192 * 2);
constexpr size_t WS_SSQ   = al256(WS_XG + (size_t)T_ * 1024 * 2);
constexpr size_t WS_C2    = al256(WS_SSQ + (size_t)T_ * 16 * 4);
constexpr size_t WS_BBH   = al256(WS_C2 + 4ull * 2 * 2048 * 4);
constexpr size_t WS_END   = al256(WS_BBH + 4ull * 16 * 2 * 64 * 16 * 2);

constexpr int LDS_BYTES = 135168;

#define GAS __attribute__((address_space(1)))
struct Params {
  const GAS float* in[24];
  GAS float* out;
  GAS unsigned char* ws;
};
enum { I_X = 0, I_C, I_WADA, I_BADA, I_NMIX, I_NFFN, I_WIN, I_RELB, I_LRE, I_LIM, I_LOGDT, I_BRE, I_BIM, I_CRE, I_CIM, I_SSMD,
       I_WGLU, I_MGAIN, I_WOUT, I_WQ, I_SUBK, I_PU, I_PV, I_FNORM };

__device__ __forceinline__ float bf2f(bf16_t v) { return __uint_as_float(((unsigned)v) << 16); }
typedef __bf16 hwbf16x2 __attribute__((ext_vector_type(2)));
typedef unsigned u32x4v __attribute__((ext_vector_type(4)));
__device__ __forceinline__ bf16_t f2bf(float f) { return __builtin_bit_cast(unsigned short, (__bf16)f); }
__device__ __forceinline__ unsigned pk2(float a, float b) { const hwbf16x2 v = {(__bf16)a, (__bf16)b}; return __builtin_bit_cast(unsigned, v); }
__device__ __forceinline__ float wave_sum(float v) {
#pragma unroll
  for (int o = 32; o > 0; o >>= 1) v += __shfl_xor(v, o);
  return v;
}
__device__ __forceinline__ float wave_max(float v) {
#pragma unroll
  for (int o = 32; o > 0; o >>= 1) v = fmaxf(v, __shfl_xor(v, o));
  return v;
}
__device__ __forceinline__ float gelu_tanh(float x) { const float u = 0.7978845608028654f * (x + 0.044715f * x * x * x); return 0.5f * x * (1.f + tanhf(u)); }
__device__ __forceinline__ float sigmoid_f(float x) { return 1.f / (1.f + __expf(-x)); }
__device__ __forceinline__ float gelu_tanh_fast(float x) {
  const float u2 = 2.f * 0.7978845608028654f * 1.4426950408889634f * (x + 0.044715f * x * x * x);
  const float e = __builtin_amdgcn_exp2f(fminf(u2, 80.f));
  return x - x * __builtin_amdgcn_rcpf(1.f + e);
}
__device__ __forceinline__ GAS unsigned char* launder_ptr(GAS unsigned char* q) { asm volatile("" : "+s"(q)); return q; }
__device__ __forceinline__ const float* gin(const GAS float* q) { return (const float*)q; }
__device__ __forceinline__ const float* launder_cptr(const float* q) { asm volatile("" : "+s"(q)); return q; }
__device__ __forceinline__ int launder_tid() { int t = threadIdx.x; asm volatile("" : "+v"(t)); return t; }
typedef const Params __attribute__((address_space(4)))* CParamsP;
__device__ __forceinline__ CParamsP launder_kargs() { CParamsP q = (CParamsP)__builtin_amdgcn_kernarg_segment_ptr(); asm volatile("" : "+s"(q)); return q; }

__device__ __forceinline__ void convert_tables_fp4(const CParamsP pp, GAS unsigned char* ws, int layer, int gtid, int gn) {
  constexpr int NSPAN = 16384;
  const int lane = gtid & 63, gw = gtid >> 6, nw = gn >> 6;
  for (int sp0 = gw; sp0 < 2 * NSPAN; sp0 += 2 * nw) {
    f32x4 a[2][4];
#pragma unroll
    for (int h = 0; h < 2; ++h) {
      const int sp = sp0 + h * nw, tb = sp >= NSPAN ? 1 : 0;
      const float* src = (tb ? gin(pp->in[I_PV]) : gin(pp->in[I_PU])) + ((size_t)layer * NSPAN + (sp - tb * NSPAN)) * 1024 + lane * 4;
#pragma unroll
      for (int q = 0; q < 4; ++q) a[h][q] = (sp < 2 * NSPAN) ? *(const f32x4*)(src + q * 256) : (f32x4){0.f, 0.f, 0.f, 0.f};
    }
#pragma unroll
    for (int h = 0; h < 2; ++h) {
      const int sp = sp0 + h * nw, tb = sp >= NSPAN ? 1 : 0;
      if (sp < 2 * NSPAN) {
        const float sc = tb ? 4.f : 64.f;
        unsigned short* dst = (unsigned short*)(ws + (tb ? WS_PV8 : WS_PU8) + ((size_t)layer * NSPAN + (sp - tb * NSPAN)) * 512) + lane;
#pragma unroll
        for (int q = 0; q < 4; ++q) {
          const f32x4 v = a[h][q];
          const float x0 = fminf(fmaxf(v.x * sc, -6.f), 6.f), x1 = fminf(fmaxf(v.y * sc, -6.f), 6.f);
          const float x2 = fminf(fmaxf(v.z * sc, -6.f), 6.f), x3 = fminf(fmaxf(v.w * sc, -6.f), 6.f);
          unsigned o = __builtin_amdgcn_cvt_scalef32_pk_fp4_f32(0u, x0, x1, 1.0f, 0);
          o = __builtin_amdgcn_cvt_scalef32_pk_fp4_f32(o, x2, x3, 1.0f, 1);
          dst[q * 64] = (unsigned short)o;
        }
      }
    }
  }
}

__device__ void setup_phase(const Params& p, unsigned char* smem) {
  const CParamsP pp = launder_kargs();
  GAS unsigned char* const ws = launder_ptr(pp->ws); const int tidx = launder_tid(); (void)ws; (void)tidx;
  const int tid = tidx;
  float* sm = (float*)smem;
  {
    float* cond = sm;
    float* red = sm + 2048;
    float* MOD = (float*)(ws + WS_MOD);
    for (int i = tid; i < 2048; i += NT) { const float c = gin(pp->in[I_C])[i]; cond[i] = c * sigmoid_f(c); }
    __syncthreads();
    for (int item = blockIdx.x; item < 4 * 192; item += gridDim.x) {
      const int l = item / 192, cb = item % 192, kq = tid >> 6, jj = tid & 31, kp = (tid >> 5) & 1, j = cb * 32 + jj;
      const float* w = gin(pp->in[I_WADA]) + (size_t)l * 1024 * 6144 + j;
      float a0 = 0.f, a1 = 0.f;
#pragma unroll 32
      for (int k = kq * 128 + kp; k < kq * 128 + 128; k += 2) { const float wv = w[(size_t)k * 6144]; a0 += cond[k] * wv; a1 += cond[1024 + k] * wv; }
      red[((kq * 2 + kp) * 2 + 0) * 32 + jj] = a0; red[((kq * 2 + kp) * 2 + 1) * 32 + jj] = a1;
      __syncthreads();
      if (tid < 64) {
        const int b = tid >> 5, j2 = tid & 31; float s = 0.f;
        for (int q = 0; q < 16; ++q) s += red[(q * 2 + b) * 32 + j2];
        MOD[((size_t)l * 2 + b) * 6144 + cb * 32 + j2] = s + gin(pp->in[I_BADA])[(size_t)l * 6144 + cb * 32 + j2];
      }
      __syncthreads();
    }
  }
  const int gtid = blockIdx.x * NT + tid, gn = gridDim.x * NT;
  {
    float* RC = (float*)(ws + WS_ROTC); float* RS = (float*)(ws + WS_ROTS);
    for (int idx = gtid; idx < 8192 * 32; idx += gn) {
      const int pos = idx >> 5, i = idx & 31;
      const float inv = powf(10000.0f, -(float)i / 32.0f);
      const float ang = (float)pos * inv;
      float s, c; sincosf(ang, &s, &c);
      RC[idx] = c; RS[idx] = s;
    }
  }
  {
    float* SA = (float*)(ws + WS_SA); float* SBB = (float*)(ws + WS_SBB); bf16_t* BBH = (bf16_t*)(ws + WS_BBH);
    for (int idx = gtid; idx < 4 * 16 * 64; idx += gn) {
      const int l = idx / 1024, g = (idx >> 6) & 15;
      const float dt = expf(gin(pp->in[I_LOGDT])[l * 16 + g]);
      const float lr = gin(pp->in[I_LRE])[idx], li = gin(pp->in[I_LIM])[idx];
      const float mag = expf(lr * dt);
      float sn, cs; sincosf(li * dt, &sn, &cs);
      const float are = mag * cs, aim = mag * sn;
      const float den = lr * lr + li * li, nr = are - 1.f, ni = aim;
      const float fre = (nr * lr + ni * li) / den, fim = (ni * lr - nr * li) / den;
      SA[idx * 2] = are; SA[idx * 2 + 1] = aim;
      for (int c = 0; c < 16; ++c) {
        const float br = gin(pp->in[I_BRE])[(size_t)idx * 16 + c], bi = gin(pp->in[I_BIM])[(size_t)idx * 16 + c];
        SBB[(size_t)idx * 32 + c] = fre * br - fim * bi;
        SBB[(size_t)idx * 32 + 16 + c] = fre * bi + fim * br;
        {
          const int pq = idx & 63; const size_t fb = (size_t)(idx >> 6) * 2;
          BBH[(((fb + 0) * 2 + (pq >> 5)) * 64 + 32 * (c >> 3) + (pq & 31)) * 8 + (c & 7)] = f2bf(fre * br - fim * bi);
          BBH[(((fb + 1) * 2 + (pq >> 5)) * 64 + 32 * (c >> 3) + (pq & 31)) * 8 + (c & 7)] = f2bf(fre * bi + fim * br);
        }
      }
    }
  }
  {
    bf16_t* CB = (bf16_t*)(ws + WS_CB);
    for (int idx = gtid; idx < 4 * 16 * 16 * 128; idx += gn) {
      const int k = idx & 127, lgc = idx >> 7;
      const bf16_t cv = (k < 64) ? f2bf(gin(pp->in[I_CRE])[(size_t)lgc * 64 + k]) : f2bf(-gin(pp->in[I_CIM])[(size_t)lgc * 64 + (k - 64)]);
      const int cc = lgc & 15, lg = lgc >> 4;
      CB[(((size_t)lg * 4 + (k >> 5)) * 64 + ((k >> 3) & 3) * 16 + cc) * 8 + (k & 7)] = cv;
    }
    bf16_t* WG = (bf16_t*)(ws + WS_WGLUT);
    for (int idx = gtid; idx < 4 * 512 * 256; idx += gn) {
      const int k = idx & 255, nn = (idx >> 8) & 511, l2 = idx >> 17;
      {
        const int which = nn >> 8, w8 = (nn >> 5) & 7, nt = (nn >> 4) & 1, frr = nn & 15, ks = k >> 5, fqq = (k >> 3) & 3, j = k & 7;
        WG[(((((size_t)l2 * 8 + w8) * 8 + ks) * 2 + which) * 2 + nt) * 512 + (fqq * 16 + frr) * 8 + j] = f2bf(gin(pp->in[I_WGLU])[((size_t)l2 * 256 + k) * 512 + nn]);
      }
    }
  }
  convert_tables_fp4(pp, ws, 0, gtid, gn);
  {
    __syncthreads();
    const int lane = tid & 63, wid = tid >> 6;
    float* scr = sm + wid * (64 * 33);
    constexpr int IT_IN = 16 * 96, IT_OUT = 16 * 32, IT_L = IT_IN + IT_OUT;
    for (int item = blockIdx.x * NW + wid; item < 4 * IT_L; item += gridDim.x * NW) {
      const int l = item / IT_L; int r = item - l * IT_L;
      const float* W; bf16_t* WT; int N, NP;
      if (r < IT_IN) { W = gin(pp->in[I_WIN]) + (size_t)l * 1024 * INC; WT = (bf16_t*)(ws + WS_WIN) + (size_t)l * INCP * 1024; N = INC; NP = 96; }
      else { r -= IT_IN; W = gin(pp->in[I_WOUT]) + (size_t)l * 1024 * 1024; WT = (bf16_t*)(ws + WS_WOUT) + (size_t)l * 1024 * 1024; N = 1024; NP = 32; }
      const int kb = r / NP, nb = r - kb * NP, k0 = kb * 64, n0 = nb * 32;
      const int nn = n0 + (lane & 31); const bool inb = nn < N;
      float v[32];
#pragma unroll
      for (int i = 0; i < 32; ++i) { const int kk = 2 * i + (lane >> 5); v[i] = inb ? W[(size_t)(k0 + kk) * N + nn] : 0.f; }
#pragma unroll
      for (int i = 0; i < 32; ++i) { const int kk = 2 * i + (lane >> 5); scr[kk * 33 + (lane & 31)] = v[i]; }
      const int c = lane & 7;
#pragma unroll
      for (int j = 0; j < 4; ++j) {
        const int n = (lane >> 3) + 8 * j; const float* sp = scr + (8 * c) * 33 + n;
        uint4 o; o.x = pk2(sp[0], sp[33]); o.y = pk2(sp[2 * 33], sp[3 * 33]); o.z = pk2(sp[4 * 33], sp[5 * 33]); o.w = pk2(sp[6 * 33], sp[7 * 33]);
        *(uint4*)(WT + (size_t)(n0 + n) * 1024 + k0 + 8 * c) = o;
      }
    }
    __syncthreads();
  }
  {
    bf16_t* WP = (bf16_t*)(ws + WS_WQ);
    const int lane = tid & 63, wid = tid >> 6, fr = lane & 15, fq = lane >> 4;
    for (int item = blockIdx.x; item < 4 * 16 * 8; item += gridDim.x) {
      const int l = item >> 7, hs = (item >> 3) & 15, kb = item & 7;
      const float* Wq = gin(pp->in[I_WQ]) + ((size_t)l * 1024 + kb * 128 + wid * 16 + fr) * 2048 + hs * 128 + 8 * fq;
      const float* SKg = gin(pp->in[I_SUBK]) + ((size_t)l * 16 + hs) * 128 * 128 + (size_t)fr * 128 + 8 * fq;
      bf16x8 ah[4], al[4];
#pragma unroll
      for (int ks = 0; ks < 4; ++ks) {
        const f32x4 x0 = *(const f32x4*)(Wq + 32 * ks), x1 = *(const f32x4*)(Wq + 32 * ks + 4);
        const float xv[8] = {x0.x, x0.y, x0.z, x0.w, x1.x, x1.y, x1.z, x1.w};
#pragma unroll
        for (int j = 0; j < 8; ++j) { const bf16_t h = f2bf(xv[j]); ah[ks][j] = (short)h; al[ks][j] = (short)f2bf(xv[j] - bf2f(h)); }
      }
      f32x4 acc[8];
#pragma unroll
      for (int ct = 0; ct < 8; ++ct) acc[ct] = (f32x4){0.f, 0.f, 0.f, 0.f};
#pragma unroll 2
      for (int ct = 0; ct < 8; ++ct) {
        f32x4 y[8];
#pragma unroll
        for (int ks = 0; ks < 4; ++ks) { y[2 * ks] = *(const f32x4*)(SKg + (size_t)ct * 16 * 128 + 32 * ks); y[2 * ks + 1] = *(const f32x4*)(SKg + (size_t)ct * 16 * 128 + 32 * ks + 4); }
#pragma unroll
        for (int ks = 0; ks < 4; ++ks) {
          const float yv[8] = {y[2 * ks].x, y[2 * ks].y, y[2 * ks].z, y[2 * ks].w, y[2 * ks + 1].x, y[2 * ks + 1].y, y[2 * ks + 1].z, y[2 * ks + 1].w};
          bf16x8 bh, bl;
#pragma unroll
          for (int j = 0; j < 8; ++j) { const bf16_t h = f2bf(yv[j]); bh[j] = (short)h; bl[j] = (short)f2bf(yv[j] - bf2f(h)); }
          acc[ct] = __builtin_amdgcn_mfma_f32_16x16x32_bf16(ah[ks], bh, acc[ct], 0, 0, 0);
          acc[ct] = __builtin_amdgcn_mfma_f32_16x16x32_bf16(al[ks], bh, acc[ct], 0, 0, 0);
          acc[ct] = __builtin_amdgcn_mfma_f32_16x16x32_bf16(ah[ks], bl, acc[ct], 0, 0, 0);
        }
      }
#pragma unroll
      for (int ct = 0; ct < 8; ++ct)
        *(uint2*)(WP + ((size_t)l * 2048 + hs * 128 + 16 * ct + fr) * 1024 + kb * 128 + wid * 16 + 4 * fq) = make_uint2(pk2(acc[ct][0], acc[ct][1]), pk2(acc[ct][2], acc[ct][3]));
    }
  }
}

__device__ void qbias_phase(const Params& p, unsigned char* smem) {
  const CParamsP pp = launder_kargs();
  GAS unsigned char* const ws = launder_ptr(pp->ws); const int tid = launder_tid();
  float* C2 = (float*)(ws + WS_C2); const float* MOD = (const float*)(ws + WS_MOD); const bf16_t* WP = (const bf16_t*)(ws + WS_WQ);
  const int lane = tid & 63, gw = blockIdx.x * NW + (tid >> 6), nw = gridDim.x * NW;
  for (int o = gw; o < 4 * 2048; o += nw) {
    const int l = o >> 11;
    const uint4 w0 = *(const uint4*)(WP + (size_t)o * 1024 + lane * 16), w1 = *(const uint4*)(WP + (size_t)o * 1024 + lane * 16 + 8);
    const unsigned ww[8] = {w0.x, w0.y, w0.z, w0.w, w1.x, w1.y, w1.z, w1.w};
    const float* s0 = MOD + (size_t)l * 2 * 6144 + 3072 + lane * 16; const float* s1 = s0 + 6144;
    float a0 = 0.f, a1 = 0.f;
#pragma unroll
    for (int q = 0; q < 8; ++q) {
      const float wl = __uint_as_float(ww[q] << 16), wh = __uint_as_float(ww[q] & 0xffff0000u);
      a0 += s0[2 * q] * wl + s0[2 * q + 1] * wh; a1 += s1[2 * q] * wl + s1[2 * q + 1] * wh;
    }
    a0 = wave_sum(a0); a1 = wave_sum(a1);
    if (lane == 0) { C2[((size_t)l * 2 + 0) * 2048 + (o & 2047)] = a0; C2[((size_t)l * 2 + 1) * 2048 + (o & 2047)] = a1; }
  }
  (void)smem;
}

__device__ void norm_mod_phase(const float* __restrict__ xsrc, const float* __restrict__ gain, const float* __restrict__ mod_sh, const float* __restrict__ mod_sc,
                               bf16_t* __restrict__ outp) {
  const int tidx = launder_tid();
  const int lane = tidx & 63, gw = blockIdx.x * NW + (tidx >> 6), nw = gridDim.x * NW;
  for (int t = gw; t < T_; t += nw) {
    const int b = t >> 13;
    const f32x4* xr = (const f32x4*)(xsrc + (size_t)t * 1024) + lane;
    f32x4 v[4]; float s = 0.f;
#pragma unroll
    for (int j = 0; j < 4; ++j) { v[j] = xr[64 * j]; s += v[j].x * v[j].x + v[j].y * v[j].y + v[j].z * v[j].z + v[j].w * v[j].w; }
    const float rstd = rsqrtf(wave_sum(s) * (1.f / 1024.f) + EPS_);
#pragma unroll
    for (int j = 0; j < 4; ++j) {
      const int c = lane * 4 + 256 * j;
      const f32x4 g = *(const f32x4*)(gain + c), sh = *(const f32x4*)(mod_sh + b * 6144 + c), sc = *(const f32x4*)(mod_sc + b * 6144 + c);
      const float o0 = v[j].x * rstd * g.x * (1.f + sc.x) + sh.x, o1 = v[j].y * rstd * g.y * (1.f + sc.y) + sh.y;
      const float o2 = v[j].z * rstd * g.z * (1.f + sc.z) + sh.z, o3 = v[j].w * rstd * g.w * (1.f + sc.w) + sh.w;
      uint2 o; o.x = pk2(o0, o1); o.y = pk2(o2, o3);
      *(uint2*)(outp + (size_t)t * 1024 + c) = o;
    }
  }
}


namespace pg8 {
#define PG8_LAS __attribute__((address_space(3)))
typedef unsigned u32x4 __attribute__((ext_vector_type(4)));
constexpr int BM = 256, BK = 64, HALF = 128, HTB = HALF * BK * 2, STAGE_BYTES = 8 * HTB, NXCD = 8, WGM = 8;
__host__ __device__ __forceinline__ int lds_byte(int r, int c) { const int st = (r >> 4) * 2 + (c >> 5), rr = r & 15, cc = c & 31, ob = rr * 64 + cc * 2; return st * 1024 + (ob ^ (((ob >> 9) & 1) << 5)); }
__host__ __device__ __forceinline__ void stage_rc(int b, int& R, int& C) { const int st = b / 1024, sb = b % 1024, swz = sb ^ (((sb >> 9) & 1) << 5); R = (st >> 1) * 16 + swz / 64; C = (st & 1) * 32 + (swz % 64) / 2; }
__host__ __device__ __forceinline__ int perm32(int rho) { const int n = rho >> 4, i = rho & 15; return 8 * (i >> 2) + 4 * n + (i & 3); }
struct Unit { int pm, pn; };
struct Gemm { const bf16_t* A; const bf16_t* Bt; int M, N, K; };
struct StaticOrder {
    int nM, nN, nwg, G, c;
    __host__ __device__ void init(int M, int N, int G_, int c_) { nM = M / BM; nN = N / BM; nwg = nM * nN; G = G_; c = c_; }
    __host__ __device__ bool next(int i, Unit& u) const {
        const long L = (long)i * G + c; if (L >= nwg) return false;
        int wgid = (int)L; { const int q = nwg / NXCD, r = nwg % NXCD, xcd = wgid % NXCD, off = wgid / NXCD; wgid = (xcd < r ? xcd * (q + 1) : r * (q + 1) + (xcd - r) * q) + off; }
        const int nig = WGM * nN, gid = wgid / nig, fm = gid * WGM, gsz = (nM - fm) < WGM ? (nM - fm) : WGM;
        u.pm = fm + ((wgid % nig) % gsz); u.pn = (wgid % nig) / gsz; return true;
    }
    __device__ __forceinline__ void a_ready(const Unit&) const {}
    __device__ __forceinline__ void done(const Unit&) const {}
};
__device__ __forceinline__ unsigned cvt_pk_bf16(float lo, float hi) { unsigned r; asm volatile("v_cvt_pk_bf16_f32 %0, %1, %2" : "=v"(r) : "v"(lo), "v"(hi)); return r; }
template <class Epi, class Sched>
__device__ __forceinline__ void gemm_phase(PG8_LAS unsigned char* lds, const Gemm g, const Sched& S, const Epi& E) {
    const int tid = launder_tid(), wid = __builtin_amdgcn_readfirstlane(tid >> 6), lane = tid & 63, wr = wid >> 2, wc = wid & 3, fr = lane & 15, fq = lane >> 4;
    const int K = g.K, nt = K / BK;
    unsigned voffA[2], voffB[2];
#pragma unroll
    for (int i = 0; i < 2; ++i) { int R, C; stage_rc(tid * 16 + i * 8192, R, C); const int Rb = Epi::PERM ? ((R & ~31) + perm32(R & 31)) : R;
        voffA[i] = (unsigned)(R * K + C) * 2u; voffB[i] = (unsigned)(Rb * K + C) * 2u; }
    const size_t kstep = (size_t)(BK * 2);
    const size_t hstep = (size_t)HALF * K * 2;
    const size_t tstep = 2 * hstep;
    const unsigned ldsw = (unsigned)wid * 1024u;
    const int aoff = lds_byte(wr * 64 + fr, fq * 8), boff = lds_byte(wc * 32 + fr, fq * 8);
#define PG8_SA(b, h) (((b) * 2 + (h)) * HTB)
#define PG8_SB(b, h) ((4 + (b) * 2 + (h)) * HTB)
#define PG8_STAGE(bufoff, gbase, voff) do { _Pragma("unroll") for (int _i = 0; _i < 2; ++_i) \
        __builtin_amdgcn_global_load_lds((const unsigned*)((const char*)(gbase) + (voff)[_i]), (PG8_LAS unsigned*)(lds + (bufoff) + ldsw + _i * 8192), 16, 0, 0); } while (0)
#define PG8_LDA(dst, b, h) do { _Pragma("unroll") for (int m = 0; m < 4; ++m) _Pragma("unroll") for (int k = 0; k < 2; ++k) dst[m][k] = *(const PG8_LAS bf16x8*)(lds + PG8_SA(b, h) + aoff + m * 2048 + k * 1024); } while (0)
#define PG8_LDB(dst, b, h) do { _Pragma("unroll") for (int n = 0; n < 2; ++n) _Pragma("unroll") for (int k = 0; k < 2; ++k) dst[n][k] = *(const PG8_LAS bf16x8*)(lds + PG8_SB(b, h) + boff + n * 2048 + k * 1024); } while (0)
#define PG8_MMA(ai, bj, At, Bt) do { __builtin_amdgcn_s_setprio(1); _Pragma("unroll") for (int m = 0; m < 4; ++m) _Pragma("unroll") for (int n = 0; n < 2; ++n) _Pragma("unroll") for (int k = 0; k < 2; ++k) \
        acc[ai][bj][m][n] = __builtin_amdgcn_mfma_f32_16x16x32_bf16(Bt[n][k], At[m][k], acc[ai][bj][m][n], 0, 0, 0); __builtin_amdgcn_s_setprio(0); } while (0)
#define PG8_WAIT_V(n) asm volatile("s_waitcnt vmcnt(" #n ")" ::: "memory")
#define PG8_WAIT_L(n) asm volatile("s_waitcnt lgkmcnt(" #n ")" ::: "memory")
#define PG8_BAR __builtin_amdgcn_s_barrier()
#define PG8_SCHED __builtin_amdgcn_sched_barrier(0)
    Unit cur, nxt; int ui = 0;
    if (!S.next(0, cur)) return;
    f32x4 acc[2][2][4][2];
#pragma unroll
    for (int a = 0; a < 2; ++a)
#pragma unroll
        for (int b = 0; b < 2; ++b)
#pragma unroll
            for (int m = 0; m < 4; ++m)
#pragma unroll
                for (int n = 0; n < 2; ++n) acc[a][b][m][n] = (f32x4){0.f, 0.f, 0.f, 0.f};
    bf16x8 At[4][2], B0[2][2], B1[2][2];
    const char* cA = (const char*)g.A + (size_t)cur.pm * tstep; const char* cB = (const char*)g.Bt + (size_t)cur.pn * tstep;
    S.a_ready(cur);
    PG8_STAGE(PG8_SB(0, 0), cB, voffB); PG8_STAGE(PG8_SA(0, 0), cA, voffA); PG8_STAGE(PG8_SB(0, 1), cB + hstep, voffB); PG8_STAGE(PG8_SA(0, 1), cA + hstep, voffA);
    if (wr == 1) PG8_BAR;
    PG8_WAIT_V(4); PG8_BAR;
    PG8_STAGE(PG8_SB(1, 0), cB + kstep, voffB); PG8_STAGE(PG8_SA(1, 0), cA + kstep, voffA); PG8_STAGE(PG8_SB(1, 1), cB + hstep + kstep, voffB);
    PG8_WAIT_V(6); PG8_BAR;
    for (;;) {
        const bool has_next = S.next(ui + 1, nxt);
        const char* nA = has_next ? (const char*)g.A + (size_t)nxt.pm * tstep : cA; const char* nB = has_next ? (const char*)g.Bt + (size_t)nxt.pn * tstep : cB;
        for (int t = 0; t < nt; t += 2) {
            const bool last = (t == nt - 2);
            const char* a1 = cA + (size_t)(t + 1) * kstep;
            const char* a2 = last ? nA : cA + (size_t)(t + 2) * kstep; const char* b2 = last ? nB : cB + (size_t)(t + 2) * kstep;
            const char* a3 = a2 + kstep; const char* b3 = b2 + kstep;
            if (last && has_next) S.a_ready(nxt);
            PG8_LDB(B0, 0, 0); PG8_SCHED; PG8_LDA(At, 0, 0); PG8_STAGE(PG8_SA(1, 1), a1 + hstep, voffA);
            PG8_WAIT_L(8); PG8_BAR; PG8_WAIT_L(0); PG8_MMA(0, 0, At, B0); PG8_BAR; PG8_SCHED;
            PG8_LDB(B1, 0, 1); PG8_STAGE(PG8_SB(0, 0), b2, voffB);
            PG8_BAR; PG8_WAIT_L(0); PG8_MMA(0, 1, At, B1); PG8_BAR;
            PG8_LDA(At, 0, 1); PG8_STAGE(PG8_SA(0, 0), a2, voffA);
            PG8_BAR; PG8_WAIT_L(0); PG8_MMA(1, 0, At, B0); PG8_BAR; PG8_SCHED;
            PG8_STAGE(PG8_SB(0, 1), b2 + hstep, voffB);
            PG8_WAIT_V(6); PG8_BAR; PG8_MMA(1, 1, At, B1); PG8_BAR;
            PG8_LDB(B0, 1, 0); PG8_SCHED; PG8_LDA(At, 1, 0); PG8_STAGE(PG8_SA(0, 1), a2 + hstep, voffA);
            PG8_WAIT_L(8); PG8_BAR; PG8_WAIT_L(0); PG8_MMA(0, 0, At, B0); PG8_BAR; PG8_SCHED;
            PG8_LDB(B1, 1, 1); PG8_STAGE(PG8_SB(1, 0), b3, voffB);
            PG8_BAR; PG8_WAIT_L(0); PG8_MMA(0, 1, At, B1); PG8_BAR;
            PG8_LDA(At, 1, 1); PG8_STAGE(PG8_SA(1, 0), a3, voffA);
            PG8_BAR; PG8_WAIT_L(0); PG8_MMA(1, 0, At, B0); PG8_BAR; PG8_SCHED;
            PG8_STAGE(PG8_SB(1, 1), b3 + hstep, voffB);
            PG8_WAIT_V(6); PG8_BAR; PG8_MMA(1, 1, At, B1); PG8_BAR;
        }
        if constexpr (!Epi::AFTER_DRAIN) { E(acc, cur, wr, wc, fr, fq); S.done(cur); }
        if (!has_next) break;
#pragma unroll
        for (int a = 0; a < 2; ++a)
#pragma unroll
            for (int b = 0; b < 2; ++b)
#pragma unroll
                for (int m = 0; m < 4; ++m)
#pragma unroll
                    for (int n = 0; n < 2; ++n) acc[a][b][m][n] = (f32x4){0.f, 0.f, 0.f, 0.f};
        cur = nxt; cA = nA; cB = nB; ++ui;
    }
    PG8_WAIT_V(0);
    if (wr == 0) PG8_BAR;
    PG8_BAR;
    if constexpr (Epi::AFTER_DRAIN) { E.fused(acc, cur, wr, wc, fr, fq, lds, wid, lane); S.done(cur); }
#undef PG8_SA
#undef PG8_SB
#undef PG8_STAGE
#undef PG8_LDA
#undef PG8_LDB
#undef PG8_MMA
#undef PG8_WAIT_V
#undef PG8_WAIT_L
#undef PG8_BAR
#undef PG8_SCHED
}
}

__device__ __forceinline__ float ssq_total(const float* __restrict__ SSQ, int t) {
  const f32x4 a = *(const f32x4*)(SSQ + (size_t)t * 16), b = *(const f32x4*)(SSQ + (size_t)t * 16 + 4), c = *(const f32x4*)(SSQ + (size_t)t * 16 + 8), d = *(const f32x4*)(SSQ + (size_t)t * 16 + 12);
  return (((a.x + a.y) + (a.z + a.w)) + ((b.x + b.y) + (b.z + b.w))) + (((c.x + c.y) + (c.z + c.w)) + ((d.x + d.y) + (d.z + d.w)));
}
struct EpiProj {
  static constexpr bool PERM = true, AFTER_DRAIN = false;
  bf16_t* PROJ; bf16_t* VTA; bf16_t* VTR;
  __device__ __forceinline__ void operator()(const f32x4 (&acc)[2][2][4][2], const pg8::Unit& u, int wr, int wc, int fr, int fq) const {
    const int row0 = u.pm * 256 + wr * 64 + fr, col0 = u.pn * 256 + wc * 32 + 8 * fq;
    asm volatile("s_nop 15\n\ts_nop 15" ::: "memory");
#pragma unroll
    for (int ai = 0; ai < 2; ++ai)
#pragma unroll
      for (int m = 0; m < 4; ++m) {
        const int t = row0 + ai * 128 + m * 16;
#pragma unroll
        for (int bj = 0; bj < 2; ++bj) {
          const int c = col0 + bj * 128;
          const f32x4 v0 = acc[ai][bj][m][0], v1 = acc[ai][bj][m][1];
          pg8::u32x4 w; w.x = pg8::cvt_pk_bf16(v0[0], v0[1]); w.y = pg8::cvt_pk_bf16(v0[2], v0[3]); w.z = pg8::cvt_pk_bf16(v1[0], v1[1]); w.w = pg8::cvt_pk_bf16(v1[2], v1[3]);
          *(pg8::u32x4*)(PROJ + (size_t)t * INCP + c) = w;
          const bool isva = (c >= C_VA && c < C_VA + 384), isvr = (c >= C_VR && c < C_VR + 384);
          if (isva || isvr) {
            bf16_t* vt = (isva ? VTA : VTR) + ((size_t)(t >> 13) * 384 + (c - (isva ? C_VA : C_VR))) * 8192 + (t & 8191);
            vt[0] = (bf16_t)(w.x & 0xffffu); vt[8192] = (bf16_t)(w.x >> 16); vt[2 * 8192] = (bf16_t)(w.y & 0xffffu); vt[3 * 8192] = (bf16_t)(w.y >> 16);
            vt[4 * 8192] = (bf16_t)(w.z & 0xffffu); vt[5 * 8192] = (bf16_t)(w.z >> 16); vt[6 * 8192] = (bf16_t)(w.w & 0xffffu); vt[7 * 8192] = (bf16_t)(w.w >> 16);
          }
        }
      }
  }
};
struct EpiOut {
  static constexpr bool PERM = true, AFTER_DRAIN = false;
  const float* xin; int first; bf16_t* X; const float* g1; const float* nf; const float* sc2; bf16_t* XG; float* SSQ;
  __device__ __forceinline__ void operator()(const f32x4 (&acc)[2][2][4][2], const pg8::Unit& u, int wr, int wc, int fr, int fq) const {
    const int row0 = u.pm * 256 + wr * 64 + fr, col0 = u.pn * 256 + wc * 32 + 8 * fq, b = (u.pm * 256) >> 13;
    f32x4 gg[2][2], gs[2][2];
#pragma unroll
    for (int bj = 0; bj < 2; ++bj)
#pragma unroll
      for (int n = 0; n < 2; ++n) {
        const int c = col0 + bj * 128 + n * 4;
        gg[bj][n] = *(const f32x4*)(g1 + b * 6144 + c);
        const f32x4 gf = *(const f32x4*)(nf + c), sc = *(const f32x4*)(sc2 + b * 6144 + c);
        gs[bj][n] = gf * (sc + 1.f);
      }
#pragma unroll
    for (int ai = 0; ai < 2; ++ai)
#pragma unroll
      for (int m = 0; m < 4; ++m) {
        const int t = row0 + ai * 128 + m * 16;
        float sq = 0.f;
#pragma unroll
        for (int bj = 0; bj < 2; ++bj) {
          const int c = col0 + bj * 128;
          f32x4 x0, x1;
          if (first) { x0 = *(const f32x4*)(xin + (size_t)t * 1024 + c); x1 = *(const f32x4*)(xin + (size_t)t * 1024 + c + 4); }
          else {
            const pg8::u32x4 xr = *(const pg8::u32x4*)(X + (size_t)t * 1024 + c);
            x0 = (f32x4){__uint_as_float(xr.x << 16), __uint_as_float(xr.x & 0xffff0000u), __uint_as_float(xr.y << 16), __uint_as_float(xr.y & 0xffff0000u)};
            x1 = (f32x4){__uint_as_float(xr.z << 16), __uint_as_float(xr.z & 0xffff0000u), __uint_as_float(xr.w << 16), __uint_as_float(xr.w & 0xffff0000u)};
          }
          const f32x4 n0 = x0 + gg[bj][0] * acc[ai][bj][m][0], n1 = x1 + gg[bj][1] * acc[ai][bj][m][1];
          pg8::u32x4 xo; xo.x = pg8::cvt_pk_bf16(n0.x, n0.y); xo.y = pg8::cvt_pk_bf16(n0.z, n0.w); xo.z = pg8::cvt_pk_bf16(n1.x, n1.y); xo.w = pg8::cvt_pk_bf16(n1.z, n1.w);
          *(pg8::u32x4*)(X + (size_t)t * 1024 + c) = xo;
          const f32x4 s0 = n0 * gs[bj][0], s1 = n1 * gs[bj][1];
          pg8::u32x4 go; go.x = pg8::cvt_pk_bf16(s0.x, s0.y); go.y = pg8::cvt_pk_bf16(s0.z, s0.w); go.z = pg8::cvt_pk_bf16(s1.x, s1.y); go.w = pg8::cvt_pk_bf16(s1.z, s1.w);
          *(pg8::u32x4*)(XG + (size_t)t * 1024 + c) = go;
          sq += ((n0.x * n0.x + n0.y * n0.y) + (n0.z * n0.z + n0.w * n0.w)) + ((n1.x * n1.x + n1.y * n1.y) + (n1.z * n1.z + n1.w * n1.w));
        }
        sq += __shfl_xor(sq, 16); sq += __shfl_xor(sq, 32);
        if (fq == 0) SSQ[(size_t)t * 16 + u.pn * 4 + wc] = sq;
      }
  }
};
struct EpiQ {
  static constexpr bool PERM = true, AFTER_DRAIN = false;
  bf16_t* SC8; const float* SSQ; const float* C2;
  __device__ __forceinline__ void operator()(const f32x4 (&acc)[2][2][4][2], const pg8::Unit& u, int wr, int wc, int fr, int fq) const {
    const int row0 = u.pm * 256 + wr * 64 + fr, col0 = u.pn * 256 + wc * 32 + 8 * fq, b = (u.pm * 256) >> 13;
    f32x4 cc[2][2];
#pragma unroll
    for (int bj = 0; bj < 2; ++bj) { cc[bj][0] = *(const f32x4*)(C2 + b * 2048 + col0 + bj * 128); cc[bj][1] = *(const f32x4*)(C2 + b * 2048 + col0 + bj * 128 + 4); }
#pragma unroll
    for (int ai = 0; ai < 2; ++ai)
#pragma unroll
      for (int m = 0; m < 4; ++m) {
        const int t = row0 + ai * 128 + m * 16;
        const float rstd = rsqrtf(ssq_total(SSQ, t) * (1.f / 1024.f) + EPS_);
#pragma unroll
        for (int bj = 0; bj < 2; ++bj) {
          const f32x4 v0 = acc[ai][bj][m][0] * rstd + cc[bj][0], v1 = acc[ai][bj][m][1] * rstd + cc[bj][1];
          pg8::u32x4 w; w.x = pg8::cvt_pk_bf16(v0[0], v0[1]); w.y = pg8::cvt_pk_bf16(v0[2], v0[3]); w.z = pg8::cvt_pk_bf16(v1[0], v1[1]); w.w = pg8::cvt_pk_bf16(v1[2], v1[3]);
          *(pg8::u32x4*)(SC8 + ((size_t)((col0 + bj * 128) >> 3) * T_ + t) * 8) = w;
        }
      }
  }
};

__device__ void gemm_proj_phase(const Params& p, int l, unsigned char* smem) {
  const CParamsP pp = launder_kargs();
  GAS unsigned char* const ws = launder_ptr(pp->ws);
  pg8::Gemm g; g.A = (const bf16_t*)(ws + WS_ABUF); g.Bt = (const bf16_t*)(ws + WS_WIN) + (size_t)l * INCP * 1024; g.M = T_; g.N = INCP; g.K = 1024;
  pg8::StaticOrder S; S.init(T_, INCP, gridDim.x, blockIdx.x);
  EpiProj E; E.PROJ = (bf16_t*)(ws + WS_PROJ); E.VTA = (bf16_t*)(ws + WS_VTA); E.VTR = (bf16_t*)(ws + WS_VTR);
  pg8::gemm_phase<EpiProj, pg8::StaticOrder>((PG8_LAS unsigned char*)smem, g, S, E);
}
__device__ void gemm_out_phase(const Params& p, int l, unsigned char* smem) {
  const CParamsP pp = launder_kargs();
  GAS unsigned char* const ws = launder_ptr(pp->ws);
  pg8::Gemm g; g.A = (const bf16_t*)(ws + WS_ABUF); g.Bt = (const bf16_t*)(ws + WS_WOUT) + (size_t)l * 1024 * 1024; g.M = T_; g.N = 1024; g.K = 1024;
  pg8::StaticOrder S; S.init(T_, 1024, gridDim.x, blockIdx.x);
  EpiOut E; E.xin = gin(pp->in[I_X]); E.first = (l == 0) ? 1 : 0; E.X = (bf16_t*)(ws + WS_X); E.g1 = (const float*)(ws + WS_MOD) + (size_t)l * 2 * 6144 + 2048;
  E.nf = gin(pp->in[I_NFFN]) + (size_t)l * 1024; E.sc2 = (const float*)(ws + WS_MOD) + (size_t)l * 2 * 6144 + 4096; E.XG = (bf16_t*)(ws + WS_XG); E.SSQ = (float*)(ws + WS_SSQ);
  pg8::gemm_phase<EpiOut, pg8::StaticOrder>((PG8_LAS unsigned char*)smem, g, S, E);
}
__device__ void gemm_q_phase(const Params& p, int l, unsigned char* smem) {
  const CParamsP pp = launder_kargs();
  GAS unsigned char* const ws = launder_ptr(pp->ws);
  pg8::Gemm g; g.A = (const bf16_t*)(ws + WS_XG); g.Bt = (const bf16_t*)(ws + WS_WQ) + (size_t)l * 2048 * 1024; g.M = T_; g.N = 2048; g.K = 1024;
  pg8::StaticOrder S; S.init(T_, 2048, gridDim.x, blockIdx.x);
  EpiQ E; E.SC8 = (bf16_t*)(ws + WS_SC); E.SSQ = (const float*)(ws + WS_SSQ); E.C2 = (const float*)(ws + WS_C2) + (size_t)l * 2 * 2048;
  pg8::gemm_phase<EpiQ, pg8::StaticOrder>((PG8_LAS unsigned char*)smem, g, S, E);
}

__device__ __forceinline__ int attn_fk(int r) { return ((r >> 3) & 3) | (((r >> 1) & 1) << 2); }
__device__ __forceinline__ int attn_fv(int r) { return (r >> 1) & 7; }
__device__ void attn_phase(const Params& p, int l, unsigned char* smem) {
  const CParamsP pp = launder_kargs();
  GAS unsigned char* const ws = launder_ptr(pp->ws); const int tidx = launder_tid();
  const bf16_t* PROJ = (const bf16_t*)(ws + WS_PROJ); const bf16_t* VTA = (const bf16_t*)(ws + WS_VTA);
  bf16_t* ATT = (bf16_t*)(ws + WS_ATT);
  const int lane = tidx & 63, wid = tidx >> 6, fr = lane & 15, fq = lane >> 4;
  float* ext = (float*)smem;
  unsigned char* stg = smem + 15360;
  constexpr float LOG2E = 1.4426950408889634f;
  __syncthreads();
  for (int idx = tidx; idx < 6 * 640; idx += NT) {
    const int h = idx / 640, e = idx - h * 640; int d = e - 63; d = d > 256 ? 256 : d;
    ext[idx] = gin(pp->in[I_RELB])[((size_t)l * 6 + h) * 513 + d + 256] * LOG2E;
  }
  const int hh = wid >> 2, qb = wid & 3, iq = qb * 16 + fr;
  const int srow = tidx >> 3, sch = tidx & 7;
  const int fk_l = attn_fk(8 * (fr >> 2) + (fr & 3)), fv_l = attn_fv(fr);
  const unsigned char* const kb0 = stg + hh * 8192 + (8 * (fr >> 2) + (fr & 3)) * 128 + ((fq ^ fk_l) << 4);
  const unsigned char* const kb1 = stg + hh * 8192 + (8 * (fr >> 2) + (fr & 3)) * 128 + (((4 + fq) ^ fk_l) << 4);
  const unsigned char* const vb0 = stg + 49152 + hh * 8192 + fr * 128 + ((fq ^ fv_l) << 4);
  const unsigned char* const vb1 = stg + 49152 + hh * 8192 + fr * 128 + (((4 + fq) ^ fv_l) << 4);
  const float* const exb = ext + hh * 640 + 63 + 512 + iq - 8 * fq;
  for (int it_ = blockIdx.x; it_ < 256; it_ += gridDim.x) {
    const int item = ((it_ & 7) << 5) | (it_ >> 3);
    const int b = item >> 7, n = item & 127, t0 = b * 8192 + n * 64;
    const int jc0 = n >= 8 ? 0 : 8 - n;
    u32x4v sk[6], sv[6];
#define ATTN_LOAD(jc_) do { const int _m = n - 8 + (jc_); \
      _Pragma("unroll") for (int h = 0; h < 6; ++h) { \
        sk[h] = *(const u32x4v*)(PROJ + (size_t)(b * 8192 + _m * 64 + srow) * INCP + C_KA + h * 64 + sch * 8); \
        sv[h] = *(const u32x4v*)(VTA + ((size_t)b * 384 + h * 64 + srow) * 8192 + _m * 64 + sch * 8); } } while (0)
#define ATTN_WRITE() do { \
      _Pragma("unroll") for (int h = 0; h < 6; ++h) { \
        *(u32x4v*)(stg + h * 8192 + srow * 128 + ((sch ^ attn_fk(srow)) << 4)) = sk[h]; \
        *(u32x4v*)(stg + (6 + h) * 8192 + srow * 128 + ((sch ^ attn_fv(srow)) << 4)) = sv[h]; } } while (0)
    __syncthreads();
    ATTN_LOAD(jc0);
    bf16x8 qf[3][2];
    f32x4 o[3][4];
    float mrun[3], lrun[3];
#pragma unroll
    for (int r = 0; r < 3; ++r) {
#pragma unroll
      for (int ds = 0; ds < 2; ++ds) qf[r][ds] = *(const bf16x8*)(PROJ + (size_t)(t0 + iq) * INCP + C_QA + (2 * r + hh) * 64 + ds * 32 + fq * 8);
#pragma unroll
      for (int et = 0; et < 4; ++et) o[r][et] = (f32x4){0.f, 0.f, 0.f, 0.f};
      mrun[r] = -1e30f; lrun[r] = 0.f;
    }
    ATTN_WRITE();
    __syncthreads();
    auto attn_task = [&](bf16x8 (&qfr)[2], f32x4 (&orr)[4], float& mr, float& lr, const int koff  , const int boff  , const int hcol  , const int jc) {
      float sc[2][2][4];
      bf16x8 kfr[2][2][2], vfr[2][4]; float bia[2][2][4];
#pragma unroll
      for (int g = 0; g < 2; ++g)
#pragma unroll
        for (int tt = 0; tt < 2; ++tt) {
          kfr[g][tt][0] = *(const bf16x8*)(kb0 + koff + 4096 * g + 512 * tt);
          kfr[g][tt][1] = *(const bf16x8*)(kb1 + koff + 4096 * g + 512 * tt);
        }
      const float* exj = exb + boff - 64 * jc;
#pragma unroll
      for (int g = 0; g < 2; ++g)
#pragma unroll
        for (int tt = 0; tt < 2; ++tt)
#pragma unroll
          for (int j = 0; j < 4; ++j) bia[g][tt][j] = exj[-(32 * g + 4 * tt + j)];
      __builtin_amdgcn_sched_barrier(0);
#pragma unroll
      for (int g = 0; g < 2; ++g)
#pragma unroll
        for (int tt = 0; tt < 2; ++tt) {
          f32x4 s4 = __builtin_amdgcn_mfma_f32_16x16x32_bf16(kfr[g][tt][0], qfr[0], (f32x4){0.f, 0.f, 0.f, 0.f}, 0, 0, 0);
          s4 = __builtin_amdgcn_mfma_f32_16x16x32_bf16(kfr[g][tt][1], qfr[1], s4, 0, 0, 0);
#pragma unroll
          for (int j = 0; j < 4; ++j) sc[g][tt][j] = s4[j] * (0.125f * LOG2E) + bia[g][tt][j];
        }
#pragma unroll
      for (int et = 0; et < 4; ++et) { vfr[0][et] = *(const bf16x8*)(vb0 + koff + 2048 * et); vfr[1][et] = *(const bf16x8*)(vb1 + koff + 2048 * et); }
      __builtin_amdgcn_sched_barrier(0);
      float mloc = -1e30f;
#pragma unroll
      for (int g = 0; g < 2; ++g)
#pragma unroll
        for (int tt = 0; tt < 2; ++tt)
#pragma unroll
          for (int j = 0; j < 4; ++j) mloc = fmaxf(mloc, sc[g][tt][j]);
      mloc = fmaxf(mloc, __shfl_xor(mloc, 16)); mloc = fmaxf(mloc, __shfl_xor(mloc, 32));
      const float mnew = fmaxf(mr, mloc), alpha = __builtin_amdgcn_exp2f(mr - mnew);
      mr = mnew;
      float ls = 0.f;
#pragma unroll
      for (int g = 0; g < 2; ++g)
#pragma unroll
        for (int tt = 0; tt < 2; ++tt)
#pragma unroll
          for (int j = 0; j < 4; ++j) { const float e = __builtin_amdgcn_exp2f(sc[g][tt][j] - mnew); sc[g][tt][j] = e; ls += e; }
      lr = lr * alpha + ls;
#pragma unroll
      for (int et = 0; et < 4; ++et) { orr[et].x *= alpha; orr[et].y *= alpha; orr[et].z *= alpha; orr[et].w *= alpha; }
#pragma unroll
      for (int g = 0; g < 2; ++g) {
        union { bf16x8 v; unsigned u[4]; } pf;
        pf.u[0] = pk2(sc[g][0][0], sc[g][0][1]); pf.u[1] = pk2(sc[g][0][2], sc[g][0][3]);
        pf.u[2] = pk2(sc[g][1][0], sc[g][1][1]); pf.u[3] = pk2(sc[g][1][2], sc[g][1][3]);
#pragma unroll
        for (int et = 0; et < 4; ++et) orr[et] = __builtin_amdgcn_mfma_f32_16x16x32_bf16(vfr[g][et], pf.v, orr[et], 0, 0, 0);
      }
      if (jc == 8) {
        float lt = lr + __shfl_xor(lr, 16); lt += __shfl_xor(lt, 32);
        const float inv = 1.f / lt;
#pragma unroll
        for (int et = 0; et < 4; ++et) {
          f32x4 v = orr[et]; v.x *= inv; v.y *= inv; v.z *= inv; v.w *= inv;
          { uint2 ov; ov.x = pk2(v.x, v.y); ov.y = pk2(v.z, v.w); *(uint2*)(ATT + (size_t)(t0 + iq) * 384 + hcol + et * 16 + fq * 4) = ov; }
        }
      }
    };
#pragma unroll 1
    for (int jc = jc0; jc < 9; ++jc) {
      if (jc < 8) ATTN_LOAD(jc + 1);
      attn_task(qf[0], o[0], mrun[0], lrun[0], 0, 0, hh * 64, jc);
      attn_task(qf[1], o[1], mrun[1], lrun[1], 16384, 1280, (2 + hh) * 64, jc);
      attn_task(qf[2], o[2], mrun[2], lrun[2], 32768, 2560, (4 + hh) * 64, jc);
      if (jc < 8) {
        __syncthreads();
        ATTN_WRITE();
        __syncthreads();
      }
    }
#undef ATTN_LOAD
#undef ATTN_WRITE
  }
  __syncthreads();
}

__device__ __forceinline__ void ssm_bu32(const bf16_t* __restrict__ bbh_g, const bf16_t* __restrict__ urow, int lane,
                                         f32x16& lo_re, f32x16& hi_re, f32x16& lo_im, f32x16& hi_im) {
  const int hf = lane >> 5;
  const bf16x8 ub = *(const bf16x8*)(urow + 8 * hf);
  f32x16 z;
#pragma unroll
  for (int r = 0; r < 16; ++r) z[r] = 0.f;
  const bf16x8 a0r = *(const bf16x8*)(bbh_g + (size_t)(0 * 64 + lane) * 8), a1r = *(const bf16x8*)(bbh_g + (size_t)(1 * 64 + lane) * 8);
  const bf16x8 a0i = *(const bf16x8*)(bbh_g + (size_t)(2 * 64 + lane) * 8), a1i = *(const bf16x8*)(bbh_g + (size_t)(3 * 64 + lane) * 8);
  lo_re = __builtin_amdgcn_mfma_f32_32x32x16_bf16(ub, a0r, z, 0, 0, 0); hi_re = __builtin_amdgcn_mfma_f32_32x32x16_bf16(ub, a1r, z, 0, 0, 0);
  lo_im = __builtin_amdgcn_mfma_f32_32x32x16_bf16(ub, a0i, z, 0, 0, 0); hi_im = __builtin_amdgcn_mfma_f32_32x32x16_bf16(ub, a1i, z, 0, 0, 0);
#pragma unroll
  for (int r = 0; r < 16; ++r) {
    const auto s1 = __builtin_amdgcn_permlane32_swap(__float_as_uint(lo_re[r]), __float_as_uint(hi_re[r]), false, false);
    lo_re[r] = __uint_as_float(s1[0]); hi_re[r] = __uint_as_float(s1[1]);
    const auto s2 = __builtin_amdgcn_permlane32_swap(__float_as_uint(lo_im[r]), __float_as_uint(hi_im[r]), false, false);
    lo_im[r] = __uint_as_float(s2[0]); hi_im[r] = __uint_as_float(s2[1]);
  }
}
__device__ __forceinline__ void rotary_frag(const bf16x8 x0, const bf16x8 x1, const float* RC, const float* RS, int pos, int fq, float scale, bf16x8& o0, bf16x8& o1) {
  const f32x4 c0 = *(const f32x4*)(RC + pos * 32 + 8 * fq), c1 = *(const f32x4*)(RC + pos * 32 + 8 * fq + 4);
  const f32x4 s0 = *(const f32x4*)(RS + pos * 32 + 8 * fq), s1 = *(const f32x4*)(RS + pos * 32 + 8 * fq + 4);
  const float cc[8] = {c0.x, c0.y, c0.z, c0.w, c1.x, c1.y, c1.z, c1.w}, sn[8] = {s0.x, s0.y, s0.z, s0.w, s1.x, s1.y, s1.z, s1.w};
  union { bf16x8 v; unsigned u[4]; } r0, r1;
#pragma unroll
  for (int q = 0; q < 4; ++q) {
    const float a0 = bf2f((bf16_t)x0[2 * q]) * scale, a1 = bf2f((bf16_t)x0[2 * q + 1]) * scale, b0 = bf2f((bf16_t)x1[2 * q]) * scale, b1 = bf2f((bf16_t)x1[2 * q + 1]) * scale;
    r0.u[q] = pk2(a0 * cc[2 * q] - b0 * sn[2 * q], a1 * cc[2 * q + 1] - b1 * sn[2 * q + 1]);
    r1.u[q] = pk2(a0 * sn[2 * q] + b0 * cc[2 * q], a1 * sn[2 * q + 1] + b1 * cc[2 * q + 1]);
  }
  o0 = r0.v; o1 = r1.v;
}
__device__ void mix_local_phase(const Params& p, int l, unsigned char* smem) {
  const CParamsP pp = launder_kargs();
  GAS unsigned char* const ws = launder_ptr(pp->ws); const int tidx = launder_tid();
  const bf16_t* PROJ = (const bf16_t*)(ws + WS_PROJ); const bf16_t* VTR = (const bf16_t*)(ws + WS_VTR);
  const float* RC = (const float*)(ws + WS_ROTC); const float* RS = (const float*)(ws + WS_ROTS);
  bf16_t* YINT = (bf16_t*)(ws + WS_YINT); float* UPDT = (float*)(ws + WS_UPD);
  const float* SA = (const float*)(ws + WS_SA) + (size_t)l * 16 * 64 * 2; const bf16_t* BBH = (const bf16_t*)(ws + WS_BBH) + (size_t)l * 16 * 2 * 64 * 16;
  float* SEND = (float*)(ws + WS_SEND);
  const int tid = tidx, lane = tid & 63, wid = tid >> 6, fr = lane & 15, fq = lane >> 4;
  bf16_t* KT = (bf16_t*)smem;
  float* rcL = (float*)(smem + 55296); float* rsL = rcL + 2048;
  for (int it_ = blockIdx.x; it_ < 256; it_ += gridDim.x) {
    const int item = ((it_ & 7) << 5) | (it_ >> 3);
    const int b = item >> 7, n = item & 127, t0 = b * 8192 + n * 64;
    __syncthreads();
#pragma unroll
    for (int i = 0; i < 4; ++i) { rcL[tid + NT * i] = RC[n * 2048 + tid + NT * i]; rsL[tid + NT * i] = RS[n * 2048 + tid + NT * i]; }
    __syncthreads();
#pragma unroll 1
    for (int k3 = 0; k3 < 3; ++k3) {
      const int task = wid * 3 + k3, h = task >> 2, tb = task & 3;
      const int i = 16 * tb + fr;
      const float lg2 = log2f(1.f - exp2f(-5.f - (float)h));
      bf16x8 qraw[2], kraw[2][2][2], vraw[2][4];
      {
        const bf16_t* qp = PROJ + (size_t)(t0 + i) * INCP + C_QR + h * 64 + 8 * fq;
        qraw[0] = *(const bf16x8*)qp; qraw[1] = *(const bf16x8*)(qp + 32);
#pragma unroll
        for (int g = 0; g < 2; ++g) {
#pragma unroll
          for (int tt = 0; tt < 2; ++tt) {
            const int key = 32 * g + 8 * (fr >> 2) + (fr & 3) + 4 * tt;
            const bf16_t* kp = PROJ + (size_t)(t0 + key) * INCP + C_KR + h * 64 + 8 * fq;
            kraw[g][tt][0] = *(const bf16x8*)kp; kraw[g][tt][1] = *(const bf16x8*)(kp + 32);
          }
#pragma unroll
          for (int et = 0; et < 4; ++et) vraw[g][et] = *(const bf16x8*)(VTR + ((size_t)b * 384 + h * 64 + et * 16 + fr) * 8192 + n * 64 + 32 * g + 8 * fq);
        }
      }
      __builtin_amdgcn_sched_barrier(0);
      bf16x8 qf0, qf1;
      rotary_frag(qraw[0], qraw[1], rcL, rsL, i, fq, 1.f, qf0, qf1);
      f32x4 o[4];
#pragma unroll
      for (int et = 0; et < 4; ++et) o[et] = (f32x4){0.f, 0.f, 0.f, 0.f};
#pragma unroll
      for (int g = 0; g < 2; ++g) {
        float st[2][4];
#pragma unroll
        for (int tt = 0; tt < 2; ++tt) {
          const int key = 32 * g + 8 * (fr >> 2) + (fr & 3) + 4 * tt;
          bf16x8 kf0, kf1;
          rotary_frag(kraw[g][tt][0], kraw[g][tt][1], rcL, rsL, key, fq, 0.125f, kf0, kf1);
          f32x4 s4 = __builtin_amdgcn_mfma_f32_16x16x32_bf16(kf0, qf0, (f32x4){0.f, 0.f, 0.f, 0.f}, 0, 0, 0);
          s4 = __builtin_amdgcn_mfma_f32_16x16x32_bf16(kf1, qf1, s4, 0, 0, 0);
#pragma unroll
          for (int j = 0; j < 4; ++j) {
            const int kk = 32 * g + 8 * fq + 4 * tt + j;
            const int dij = i > kk ? i - kk : kk - i;
            st[tt][j] = s4[j] * exp2f(lg2 * (float)dij);
          }
          if (tb == 0) {
            const float kd = exp2f(lg2 * (float)(63 - key));
#pragma unroll
            for (int jj = 0; jj < 8; ++jj) {
              KT[(h * 64 + 8 * fq + jj) * 72 + key] = f2bf(bf2f((bf16_t)kf0[jj]) * kd);
              KT[(h * 64 + 32 + 8 * fq + jj) * 72 + key] = f2bf(bf2f((bf16_t)kf1[jj]) * kd);
            }
          }
        }
        union { bf16x8 v; unsigned u[4]; } pf;
        pf.u[0] = pk2(st[0][0], st[0][1]); pf.u[1] = pk2(st[0][2], st[0][3]); pf.u[2] = pk2(st[1][0], st[1][1]); pf.u[3] = pk2(st[1][2], st[1][3]);
#pragma unroll
        for (int et = 0; et < 4; ++et) o[et] = __builtin_amdgcn_mfma_f32_16x16x32_bf16(vraw[g][et], pf.v, o[et], 0, 0, 0);
      }
#pragma unroll
      for (int et = 0; et < 4; ++et) { uint2 ov; ov.x = pk2(o[et].x, o[et].y); ov.y = pk2(o[et].z, o[et].w); *(uint2*)(YINT + (((((size_t)item * 6 + h) * 4 + tb) * 4 + et) * 64 + lane) * 4) = ov; }
    }
    __syncthreads();
#pragma unroll 1
    for (int k3 = 0; k3 < 3; ++k3) {
      const int task = wid * 3 + k3, h = task >> 2, et = task & 3;
      f32x4 acc[4];
#pragma unroll
      for (int dt = 0; dt < 4; ++dt) acc[dt] = (f32x4){0.f, 0.f, 0.f, 0.f};
#pragma unroll
      for (int g = 0; g < 2; ++g) {
        const bf16x8 vf = *(const bf16x8*)(VTR + ((size_t)b * 384 + h * 64 + et * 16 + fr) * 8192 + n * 64 + 32 * g + 8 * fq);
#pragma unroll
        for (int dt = 0; dt < 4; ++dt) {
          const bf16x8 kt = *(const bf16x8*)(KT + (h * 64 + 16 * dt + fr) * 72 + 32 * g + 8 * fq);
          acc[dt] = __builtin_amdgcn_mfma_f32_16x16x32_bf16(kt, vf, acc[dt], 0, 0, 0);
        }
      }
#pragma unroll
      for (int dt = 0; dt < 4; ++dt) *(f32x4*)(UPDT + (((size_t)item * 6 + h) * 64 + 16 * et + fr) * 64 + 16 * dt + 4 * fq) = acc[dt];
    }
#pragma unroll 1
    for (int gi = 0; gi < 2; ++gi) {
      const int g = wid * 2 + gi;
      const float are = SA[(g * 64 + lane) * 2], aim = SA[(g * 64 + lane) * 2 + 1];
      float xr = 0.f, xi = 0.f;
#pragma unroll 1
      for (int blk = 0; blk < 2; ++blk) {
        f32x16 lr, hr, li, hi;
        ssm_bu32(BBH + (size_t)g * 2 * 64 * 16, PROJ + (size_t)(t0 + 32 * blk + (lane & 31)) * INCP + C_US + g * 16, lane, lr, hr, li, hi);
#pragma unroll
        for (int a4 = 0; a4 < 4; ++a4) {
#pragma unroll
          for (int bq = 0; bq < 4; ++bq) { const float nr = are * xr - aim * xi + lr[4 * a4 + bq], ni = are * xi + aim * xr + li[4 * a4 + bq]; xr = nr; xi = ni; }
#pragma unroll
          for (int bq = 0; bq < 4; ++bq) { const float nr = are * xr - aim * xi + hr[4 * a4 + bq], ni = are * xi + aim * xr + hi[4 * a4 + bq]; xr = nr; xi = ni; }
        }
      }
      SEND[(((size_t)item * 16 + g) * 64 + lane) * 2] = xr; SEND[(((size_t)item * 16 + g) * 64 + lane) * 2 + 1] = xi;
    }
  }
}

__device__ void scan_phase(const Params& p, int l) {
  const CParamsP pp = launder_kargs();
  GAS unsigned char* const ws = launder_ptr(pp->ws); const int tidx = launder_tid();
  const float* __restrict__ UPDT = (const float*)(ws + WS_UPD); bf16_t* __restrict__ SPT = (bf16_t*)(ws + WS_SPT);
  const float* __restrict__ SEND = (const float*)(ws + WS_SEND); float* __restrict__ CARRY = (float*)(ws + WS_CARRY);
  const float* SA = (const float*)(ws + WS_SA) + (size_t)l * 16 * 64 * 2;
  const int gtid = blockIdx.x * NT + tidx, gn = gridDim.x * NT;
  for (int idx = gtid; idx < 2 * 6 * 4096 + 2 * 1024; idx += gn) {
    if (idx < 2 * 6 * 4096) {
      const int b = idx / (6 * 4096), r = idx % (6 * 4096), h = r >> 12;
      const float cd = exp2f(64.f * log2f(1.f - exp2f(-5.f - (float)h)));
      const int e_ = (r >> 6) & 63, d_ = r & 63;
      const int spoff = h * 4096 + ((((e_ >> 4) * 2 + (d_ >> 5)) * 64 + ((d_ >> 3) & 3) * 16 + (e_ & 15)) * 8 + (d_ & 7));
      float s = 0.f;
#pragma unroll 1
      for (int nb = 0; nb < NCH; nb += 16) {
        float v[16];
#pragma unroll
        for (int j = 0; j < 16; ++j) v[j] = UPDT[((size_t)(b * NCH + nb + j)) * 6 * 4096 + r];
#pragma unroll
        for (int j = 0; j < 16; ++j) { SPT[((size_t)(b * NCH + nb + j)) * 6 * 4096 + spoff] = f2bf(s); s = cd * s + v[j]; }
      }
    } else {
      const int r2 = idx - 2 * 6 * 4096, b = r2 >> 10, gp = r2 & 1023;
      float ar = SA[gp * 2], ai = SA[gp * 2 + 1];
#pragma unroll
      for (int q = 0; q < 6; ++q) { const float nr = ar * ar - ai * ai, ni = 2.f * ar * ai; ar = nr; ai = ni; }
      float xr = 0.f, xi = 0.f;
#pragma unroll 1
      for (int nb = 0; nb < NCH; nb += 16) {
        float2 v[16];
#pragma unroll
        for (int j = 0; j < 16; ++j) v[j] = *(const float2*)(SEND + (((size_t)(b * NCH + nb + j)) * 1024 + gp) * 2);
#pragma unroll
        for (int j = 0; j < 16; ++j) {
          *(float2*)(CARRY + (((size_t)(b * NCH + nb + j)) * 1024 + gp) * 2) = make_float2(xr, xi);
          const float nr = ar * xr - ai * xi + v[j].x, ni = ar * xi + ai * xr + v[j].y;
          xr = nr; xi = ni;
        }
      }
    }
  }
  if (l + 1 < DEPTH_) convert_tables_fp4(pp, ws, l + 1, gtid, gn);
}

__device__ void mix_final_phase(const Params& p, int l, unsigned char* smem) {
  const CParamsP pp = launder_kargs();
  GAS unsigned char* const ws = launder_ptr(pp->ws); const int tidx = launder_tid();
  const bf16_t* PROJ = (const bf16_t*)(ws + WS_PROJ);
  const float* RC = (const float*)(ws + WS_ROTC); const float* RS = (const float*)(ws + WS_ROTS);
  const bf16_t* YINT = (const bf16_t*)(ws + WS_YINT); const bf16_t* SPT = (const bf16_t*)(ws + WS_SPT);
  const bf16_t* ATT = (const bf16_t*)(ws + WS_ATT);
  const float* SA = (const float*)(ws + WS_SA) + (size_t)l * 16 * 64 * 2; const bf16_t* BBH = (const bf16_t*)(ws + WS_BBH) + (size_t)l * 16 * 2 * 64 * 16;
  const float* CARRY = (const float*)(ws + WS_CARRY);
  const bf16_t* CB = (const bf16_t*)(ws + WS_CB) + (size_t)l * 16 * 16 * 128; const bf16_t* WG = (const bf16_t*)(ws + WS_WGLUT) + (size_t)l * 512 * 256;
  const float* dsk = gin(pp->in[I_SSMD]) + (size_t)l * 256;
  const float* mg = gin(pp->in[I_MGAIN]) + (size_t)l * 1024;
  bf16_t* MRG = (bf16_t*)(ws + WS_ABUF);
  const int tid = tidx, lane = tid & 63, wid = tid >> 6, fr = lane & 15, fq = lane >> 4;
  bf16_t* YS = (bf16_t*)smem;
  float* red = (float*)(smem + 33792);
  bf16_t* XB = (bf16_t*)(smem + 36864 + wid * 8448 + 4096);
  float* rcL = (float*)(smem + 104448); float* rsL = rcL + 2048;
  for (int it_ = blockIdx.x; it_ < 256; it_ += gridDim.x) {
    const int item = ((it_ & 7) << 5) | (it_ >> 3);
    const int b = item >> 7, n = item & 127, t0 = b * 8192 + n * 64;
    __syncthreads();
#pragma unroll
    for (int i = 0; i < 4; ++i) { rcL[tid + NT * i] = RC[n * 2048 + tid + NT * i]; rsL[tid + NT * i] = RS[n * 2048 + tid + NT * i]; }
    __syncthreads();
    {
      float av[8][6], mgl[6];
#pragma unroll
      for (int ii = 0; ii < 8; ++ii)
#pragma unroll
        for (int j = 0; j < 6; ++j) av[ii][j] = bf2f(ATT[(size_t)(t0 + wid * 8 + ii) * 384 + lane + 64 * j]);
#pragma unroll
      for (int j = 0; j < 6; ++j) mgl[j] = mg[lane + 64 * j];
      __builtin_amdgcn_sched_barrier(0);
#pragma unroll
      for (int ii = 0; ii < 8; ++ii) {
        const int t = t0 + wid * 8 + ii;
        float sq = 0.f;
#pragma unroll
        for (int j = 0; j < 6; ++j) sq += av[ii][j] * av[ii][j];
        const float rstd = rsqrtf(wave_sum(sq) * (1.f / 384.f) + EPS_);
#pragma unroll
        for (int j = 0; j < 6; ++j) MRG[(size_t)t * 1024 + lane + 64 * j] = f2bf(av[ii][j] * rstd * mgl[j]);
      }
    }
#pragma unroll 1
    for (int k3 = 0; k3 < 3; ++k3) {
      const int task = wid * 3 + k3, h = task >> 2, tb = task & 3;
      const int i = 16 * tb + fr, t = t0 + i;
      const float lg2 = log2f(1.f - exp2f(-5.f - (float)h));
      bf16x8 qraw[2], spf[4][2]; f32x4 yiv[4], mgq[4]; uint2 grv[4];
      {
        const bf16_t* qp = PROJ + (size_t)t * INCP + C_QR + h * 64 + 8 * fq;
        qraw[0] = *(const bf16x8*)qp; qraw[1] = *(const bf16x8*)(qp + 32);
#pragma unroll
        for (int et = 0; et < 4; ++et) {
          const bf16_t* sp = SPT + ((size_t)item * 6 + h) * 4096 + (size_t)(et * 2) * 512 + lane * 8;
          spf[et][0] = *(const bf16x8*)sp; spf[et][1] = *(const bf16x8*)(sp + 512);
          { const uint2 yr = *(const uint2*)(YINT + (((((size_t)item * 6 + h) * 4 + tb) * 4 + et) * 64 + lane) * 4); yiv[et] = (f32x4){__uint_as_float(yr.x << 16), __uint_as_float(yr.x & 0xffff0000u), __uint_as_float(yr.y << 16), __uint_as_float(yr.y & 0xffff0000u)}; }
          grv[et] = *(const uint2*)(PROJ + (size_t)t * INCP + C_GR + h * 64 + 16 * et + 4 * fq);
          mgq[et] = *(const f32x4*)(mg + 384 + h * 64 + 16 * et + 4 * fq);
        }
      }
      __builtin_amdgcn_sched_barrier(0);
      bf16x8 qf0, qf1;
      rotary_frag(qraw[0], qraw[1], rcL, rsL, i, fq, 1.f, qf0, qf1);
      f32x4 o[4];
#pragma unroll
      for (int et = 0; et < 4; ++et) {
        o[et] = __builtin_amdgcn_mfma_f32_16x16x32_bf16(spf[et][0], qf0, (f32x4){0.f, 0.f, 0.f, 0.f}, 0, 0, 0);
        o[et] = __builtin_amdgcn_mfma_f32_16x16x32_bf16(spf[et][1], qf1, o[et], 0, 0, 0);
      }
      const float qd = exp2f(lg2 * (float)(i + 1));
      float y[16]; float s1 = 0.f;
#pragma unroll
      for (int et = 0; et < 4; ++et) {
        const f32x4 yi = yiv[et];
        y[4 * et] = yi.x + qd * o[et].x; y[4 * et + 1] = yi.y + qd * o[et].y; y[4 * et + 2] = yi.z + qd * o[et].z; y[4 * et + 3] = yi.w + qd * o[et].w;
        s1 += (y[4 * et] + y[4 * et + 1]) + (y[4 * et + 2] + y[4 * et + 3]);
      }
      s1 += __shfl_xor(s1, 16); s1 += __shfl_xor(s1, 32);
      const float mu = s1 * (1.f / 64.f);
      float s2 = 0.f;
#pragma unroll
      for (int q = 0; q < 16; ++q) { y[q] -= mu; s2 += y[q] * y[q]; }
      s2 += __shfl_xor(s2, 16); s2 += __shfl_xor(s2, 32);
      const float rstd = rsqrtf(s2 * (1.f / 64.f) + EPS_);
#pragma unroll
      for (int et = 0; et < 4; ++et) {
        const int c = h * 64 + 16 * et + 4 * fq;
        const uint2 gr = grv[et];
        const float g0 = __uint_as_float(gr.x << 16), g1 = __uint_as_float(gr.x & 0xffff0000u), g2 = __uint_as_float(gr.y << 16), g3 = __uint_as_float(gr.y & 0xffff0000u);
        const f32x4 mgv = mgq[et];
        uint2 ov;
        ov.x = pk2(y[4 * et] * rstd * (g0 * sigmoid_f(g0)) * mgv.x, y[4 * et + 1] * rstd * (g1 * sigmoid_f(g1)) * mgv.y);
        ov.y = pk2(y[4 * et + 2] * rstd * (g2 * sigmoid_f(g2)) * mgv.z, y[4 * et + 3] * rstd * (g3 * sigmoid_f(g3)) * mgv.w);
        *(uint2*)(MRG + (size_t)t * 1024 + 384 + c) = ov;
      }
    }
#pragma unroll 1
    for (int gi = 0; gi < 2; ++gi) {
      const int g = wid * 2 + gi;
      const float are = SA[(g * 64 + lane) * 2], aim = SA[(g * 64 + lane) * 2 + 1];
      float xr = CARRY[(((size_t)item * 16 + g) * 64 + lane) * 2], xi = CARRY[(((size_t)item * 16 + g) * 64 + lane) * 2 + 1];
      bf16x8 cb[4];
#pragma unroll
      for (int ks = 0; ks < 4; ++ks) cb[ks] = *(const bf16x8*)(CB + (((size_t)g * 4 + ks) * 64 + lane) * 8);
      const float dv = dsk[g * 16 + fr];
#pragma unroll 1
      for (int blk = 0; blk < 2; ++blk) {
        f32x16 lr, hr, li, hi;
        bf16_t uraw[2][4];
#pragma unroll
        for (int half = 0; half < 2; ++half)
#pragma unroll
          for (int j = 0; j < 4; ++j) uraw[half][j] = PROJ[(size_t)(t0 + 32 * blk + 16 * half + 4 * fq + j) * INCP + C_US + g * 16 + fr];
        ssm_bu32(BBH + (size_t)g * 2 * 64 * 16, PROJ + (size_t)(t0 + 32 * blk + (lane & 31)) * INCP + C_US + g * 16, lane, lr, hr, li, hi);
#pragma unroll
        for (int half = 0; half < 2; ++half) {
#pragma unroll
          for (int a2 = 0; a2 < 2; ++a2) {
            const int a4 = 2 * half + a2;
#pragma unroll
            for (int bq = 0; bq < 4; ++bq) {
              const float nr = are * xr - aim * xi + lr[4 * a4 + bq], ni = are * xi + aim * xr + li[4 * a4 + bq]; xr = nr; xi = ni;
              XB[(8 * a2 + bq) * 136 + lane] = f2bf(xr); XB[(8 * a2 + bq) * 136 + 64 + lane] = f2bf(xi);
            }
#pragma unroll
            for (int bq = 0; bq < 4; ++bq) {
              const float nr = are * xr - aim * xi + hr[4 * a4 + bq], ni = are * xi + aim * xr + hi[4 * a4 + bq]; xr = nr; xi = ni;
              XB[(8 * a2 + 4 + bq) * 136 + lane] = f2bf(xr); XB[(8 * a2 + 4 + bq) * 136 + 64 + lane] = f2bf(xi);
            }
          }
          f32x4 acc = (f32x4){0.f, 0.f, 0.f, 0.f};
#pragma unroll
          for (int ks = 0; ks < 4; ++ks) {
            const bf16x8 af = *(const bf16x8*)(XB + fr * 136 + 32 * ks + 8 * fq);
            acc = __builtin_amdgcn_mfma_f32_16x16x32_bf16(af, cb[ks], acc, 0, 0, 0);
          }
#pragma unroll
          for (int j = 0; j < 4; ++j) {
            const int i = 32 * blk + 16 * half + 4 * fq + j;
            const float yv = acc[j] + dv * bf2f(uraw[half][j]);
            YS[i * 264 + g * 16 + fr] = f2bf(gelu_tanh(yv));
          }
        }
      }
    }
    __syncthreads();
    {
      const int n0 = 32 * wid;
      f32x4 a1[4][2], a2[4][2];
#pragma unroll
      for (int mt = 0; mt < 4; ++mt)
#pragma unroll
        for (int nt = 0; nt < 2; ++nt) { a1[mt][nt] = (f32x4){0.f, 0.f, 0.f, 0.f}; a2[mt][nt] = (f32x4){0.f, 0.f, 0.f, 0.f}; }
#pragma unroll 1
      for (int kh = 0; kh < 2; ++kh) {
        bf16x8 w1[4][2], w2[4][2];
#pragma unroll
        for (int k4 = 0; k4 < 4; ++k4)
#pragma unroll
          for (int nt = 0; nt < 2; ++nt) {
            w1[k4][nt] = *(const bf16x8*)(WG + ((((size_t)wid * 8 + 4 * kh + k4) * 2 + 0) * 2 + nt) * 512 + lane * 8);
            w2[k4][nt] = *(const bf16x8*)(WG + ((((size_t)wid * 8 + 4 * kh + k4) * 2 + 1) * 2 + nt) * 512 + lane * 8);
          }
        __builtin_amdgcn_sched_barrier(0);
#pragma unroll
        for (int k4 = 0; k4 < 4; ++k4) {
          const int ks = 4 * kh + k4;
          bf16x8 yb[4];
#pragma unroll
          for (int mt = 0; mt < 4; ++mt) yb[mt] = *(const bf16x8*)(YS + (16 * mt + fr) * 264 + 32 * ks + 8 * fq);
#pragma unroll
          for (int mt = 0; mt < 4; ++mt)
#pragma unroll
            for (int nt = 0; nt < 2; ++nt) {
              a1[mt][nt] = __builtin_amdgcn_mfma_f32_16x16x32_bf16(w1[k4][nt], yb[mt], a1[mt][nt], 0, 0, 0);
              a2[mt][nt] = __builtin_amdgcn_mfma_f32_16x16x32_bf16(w2[k4][nt], yb[mt], a2[mt][nt], 0, 0, 0);
            }
        }
      }
#pragma unroll
      for (int mt = 0; mt < 4; ++mt) {
        float sq = 0.f;
#pragma unroll
        for (int nt = 0; nt < 2; ++nt) {
          f32x4 z = a1[mt][nt]; const f32x4 zg = a2[mt][nt];
          z.x *= sigmoid_f(zg.x); z.y *= sigmoid_f(zg.y); z.z *= sigmoid_f(zg.z); z.w *= sigmoid_f(zg.w);
          a1[mt][nt] = z; sq += z.x * z.x + z.y * z.y + z.z * z.z + z.w * z.w;
        }
        sq += __shfl_xor(sq, 16); sq += __shfl_xor(sq, 32);
        if (fq == 0) red[wid * 64 + 16 * mt + fr] = sq;
      }
      __syncthreads();
#pragma unroll
      for (int mt = 0; mt < 4; ++mt) {
        const int i = 16 * mt + fr, t = t0 + i;
        float tot = 0.f;
#pragma unroll
        for (int w8 = 0; w8 < 8; ++w8) tot += red[w8 * 64 + i];
        const float rstd = rsqrtf(tot * (1.f / 256.f) + EPS_);
#pragma unroll
        for (int nt = 0; nt < 2; ++nt) {
          const int c = n0 + 16 * nt + 4 * fq;
          const f32x4 mgv = *(const f32x4*)(mg + 768 + c); const f32x4 z = a1[mt][nt];
          uint2 ov; ov.x = pk2(z.x * rstd * mgv.x, z.y * rstd * mgv.y); ov.y = pk2(z.z * rstd * mgv.z, z.w * rstd * mgv.w);
          *(uint2*)(MRG + (size_t)t * 1024 + 768 + c) = ov;
        }
      }
    }
  }
}

typedef float f32x2 __attribute__((ext_vector_type(2)));
__device__ __forceinline__ float dot16_fp4(const uint2 u, const f32x2 (&hv)[8]) {
  f32x2 d = __builtin_amdgcn_cvt_scalef32_pk_f32_fp4(u.x, 1.0f, 0) * hv[0];
  d += __builtin_amdgcn_cvt_scalef32_pk_f32_fp4(u.x, 1.0f, 1) * hv[1];
  d += __builtin_amdgcn_cvt_scalef32_pk_f32_fp4(u.x, 1.0f, 2) * hv[2];
  d += __builtin_amdgcn_cvt_scalef32_pk_f32_fp4(u.x, 1.0f, 3) * hv[3];
  d += __builtin_amdgcn_cvt_scalef32_pk_f32_fp4(u.y, 1.0f, 0) * hv[4];
  d += __builtin_amdgcn_cvt_scalef32_pk_f32_fp4(u.y, 1.0f, 1) * hv[5];
  d += __builtin_amdgcn_cvt_scalef32_pk_f32_fp4(u.y, 1.0f, 2) * hv[6];
  d += __builtin_amdgcn_cvt_scalef32_pk_f32_fp4(u.y, 1.0f, 3) * hv[7];
  return d.x + d.y;
}
__device__ __forceinline__ void axpy16_fp4(const uint2 v, const float w, f32x2 (&acc)[8]) {
  const f32x2 w2 = (f32x2){w, w};
  acc[0] += w2 * __builtin_amdgcn_cvt_scalef32_pk_f32_fp4(v.x, 1.0f, 0);
  acc[1] += w2 * __builtin_amdgcn_cvt_scalef32_pk_f32_fp4(v.x, 1.0f, 1);
  acc[2] += w2 * __builtin_amdgcn_cvt_scalef32_pk_f32_fp4(v.x, 1.0f, 2);
  acc[3] += w2 * __builtin_amdgcn_cvt_scalef32_pk_f32_fp4(v.x, 1.0f, 3);
  acc[4] += w2 * __builtin_amdgcn_cvt_scalef32_pk_f32_fp4(v.y, 1.0f, 0);
  acc[5] += w2 * __builtin_amdgcn_cvt_scalef32_pk_f32_fp4(v.y, 1.0f, 1);
  acc[6] += w2 * __builtin_amdgcn_cvt_scalef32_pk_f32_fp4(v.y, 1.0f, 2);
  acc[7] += w2 * __builtin_amdgcn_cvt_scalef32_pk_f32_fp4(v.y, 1.0f, 3);
}
__device__ __forceinline__ float vmaxf(float a, float b) { float r; asm("v_max_f32 %0, %1, %2" : "=v"(r) : "v"(a), "v"(b)); return r; }
__device__ __forceinline__ float vminf(float a, float b) { float r; asm("v_min_f32 %0, %1, %2" : "=v"(r) : "v"(a), "v"(b)); return r; }
__device__ __forceinline__ void cx(float& hi, float& lo) { const float a = hi, b = lo; hi = vmaxf(a, b); lo = vminf(a, b); }
__device__ __forceinline__ void cx2(float& kh, int& ph, float& kl, int& pl) {
  const float a = kh, b = kl; const int pa = ph, pb = pl; const bool c = a >= b;
  kh = vmaxf(a, b); kl = vminf(a, b); ph = c ? pa : pb; pl = c ? pb : pa;
}
__device__ __forceinline__ void bitonic_sort16_desc(float (&v)[16]) {
#pragma unroll
  for (int k = 2; k <= 16; k <<= 1)
#pragma unroll
    for (int j = k >> 1; j > 0; j >>= 1)
#pragma unroll
      for (int i = 0; i < 16; ++i) {
        const int l = i ^ j;
        if (l > i) { if ((i & k) == 0) cx(v[i], v[l]); else cx(v[l], v[i]); }
      }
}
__device__ __forceinline__ void bitonic_merge16_desc(float (&v)[16]) {
#pragma unroll
  for (int j = 8; j > 0; j >>= 1)
#pragma unroll
    for (int i = 0; i < 16; ++i) { const int l = i ^ j; if (l > i) cx(v[i], v[l]); }
}
__device__ __forceinline__ void top16_merge(float (&a)[16], const float (&b)[16]) {
#pragma unroll
  for (int i = 0; i < 16; ++i) a[i] = vmaxf(a[i], b[15 - i]);
  bitonic_merge16_desc(a);
}
template <int M> __device__ __forceinline__ void top16_merge_chain(float (&k)[16], int (&q)[16], const float (&xk)[M], const int (&xq)[M]) {
#pragma unroll
  for (int i = 16 - M; i < 16; ++i) { const float a = k[i], b = xk[15 - i]; const bool c = a >= b; k[i] = vmaxf(a, b); q[i] = c ? q[i] : xq[15 - i]; }
#pragma unroll
  for (int j = 8; j > 0; j >>= 1)
#pragma unroll
    for (int i = 0; i < 16; ++i) { const int l = i ^ j; if (l > i) cx2(k[i], q[i], k[l], q[l]); }
}

__device__ __forceinline__ void peer_req_rows16(u32x4v (&Q)[8], const unsigned char* tab, int e, int hi5, unsigned lane16) {
#pragma unroll
  for (int r = 0; r < 8; ++r) {
    const int ea = __builtin_amdgcn_readlane(e, 2 * r), eb = __builtin_amdgcn_readlane(e, 2 * r + 1);
    const unsigned off = (unsigned)(hi5 ? eb : ea) * 512u + lane16;
    Q[r] = *(const u32x4v*)(tab + off);
  }
}
__device__ __forceinline__ void peer_req_rows8(u32x4v (&Q)[8], const unsigned char* tab, int e, unsigned lane8) {
#pragma unroll
  for (int r = 0; r < 16; ++r) {
    const unsigned off = (unsigned)__builtin_amdgcn_readlane(e, r) * 512u + lane8;
    const uint2 t = *(const uint2*)(tab + off);
    Q[r >> 1][2 * (r & 1)] = t.x; Q[r >> 1][2 * (r & 1) + 1] = t.y;
  }
}
__device__ void peer_phase(const Params& p, int l, bool last, unsigned char* smem) {
  const CParamsP pp = launder_kargs();
  GAS unsigned char* const ws = launder_ptr(pp->ws); const int tidx = launder_tid();
  bf16_t* HF = (bf16_t*)(ws + WS_ABUF); bf16_t* X = (bf16_t*)(ws + WS_X);
  const bf16_t* SC8 = (const bf16_t*)(ws + WS_SC);
  const uint2* U4 = (const uint2*)(ws + WS_PU8) + (size_t)l * 16384 * 64; const uint2* V4 = (const uint2*)(ws + WS_PV8) + (size_t)l * 16384 * 64;
  const float* g2 = (const float*)(ws + WS_MOD) + (size_t)l * 2 * 6144 + 5120;
  const bf16_t* XG = (const bf16_t*)(ws + WS_XG); const float* SSQ = (const float*)(ws + WS_SSQ); const float* sh2 = (const float*)(ws + WS_MOD) + (size_t)l * 2 * 6144 + 3072;
  const int ln = last ? l : l + 1;
  const float* nsh = (const float*)(ws + WS_MOD) + (size_t)ln * 2 * 6144; const float* nsc = nsh + 1024;
  const float* ngain = gin(pp->in[I_NMIX]) + (size_t)ln * 1024;
  const int lane = tidx & 63, wid = tidx >> 6;
  const int rL = ((lane >> 5) & 1) * 8 + ((lane >> 4) & 1) * 4 + ((lane >> 3) & 1) * 2 + ((lane >> 2) & 1);
  const bool hi5 = (lane & 32) != 0, hi4 = (lane & 16) != 0, hi3 = (lane & 8) != 0, hi2 = (lane & 4) != 0;
  int* idxL = (int*)smem;
  float* cst = (float*)(smem + 109568);
  for (int it_ = blockIdx.x; it_ < T_ / 64; it_ += gridDim.x) {
    const int item = ((it_ & 7) << 5) | (it_ >> 3);
    const int t0 = item * 64;
    __syncthreads();
    {
      const int bb = t0 >> 13;
      for (int c = tidx; c < 1024; c += NT) {
        const int o = ((c >> 2) & 3) * 256 + (c >> 4) * 4 + (c & 3);
        cst[o] = g2[bb * 6144 + c] * 0.25f;
        cst[1024 + o] = last ? gin(pp->in[I_FNORM])[c] : ngain[c] * (1.f + nsc[bb * 6144 + c]);
        cst[2048 + o] = last ? 0.f : nsh[bb * 6144 + c];
        cst[3072 + o] = sh2[bb * 6144 + c];
      }
    }
    {
      int lane_o = lane; asm volatile("" : "+v"(lane_o));
      const int tg = wid & 1, hp = wid >> 1, hf = lane_o >> 5, tl = 32 * tg + (lane_o & 31);
      float F[2][16];
#pragma unroll
      for (int sd = 0; sd < 2; ++sd) {
        float Lh[2][16];
#pragma unroll
        for (int hh = 0; hh < 2; ++hh) {
          const int hs = 2 * (2 * hp + hh) + sd;
          float top[16];
          const bf16_t* scp = SC8 + (((size_t)(hs * 16 + 8 * hf)) * T_ + (t0 + tl)) * 8;
          uint4 sv[8];
#pragma unroll
          for (int kq = 0; kq < 8; ++kq) sv[kq] = *(const uint4*)(scp + (size_t)kq * T_ * 8);
          __builtin_amdgcn_sched_barrier(0);
#pragma unroll
          for (int kt = 0; kt < 4; ++kt) {
            float g[16];
#pragma unroll
            for (int kq = 0; kq < 2; ++kq) {
              const uint4 v8 = sv[2 * kt + kq];
              const unsigned wv[4] = {v8.x, v8.y, v8.z, v8.w};
#pragma unroll
              for (int j = 0; j < 4; ++j) {
                const int key = 64 * hf + 16 * kt + 8 * kq + 2 * j;
                g[8 * kq + 2 * j] = __uint_as_float((wv[j] << 16) | (unsigned)key);
                g[8 * kq + 2 * j + 1] = __uint_as_float((wv[j] & 0xffff0000u) | (unsigned)(key + 1));
              }
            }
            bitonic_sort16_desc(g);
            if (kt == 0) {
#pragma unroll
              for (int r = 0; r < 16; ++r) top[r] = g[r];
            } else top16_merge(top, g);
            __builtin_amdgcn_sched_barrier(0);
          }
#pragma unroll
          for (int r = 0; r < 16; ++r) Lh[hh][r] = top[r];
          __builtin_amdgcn_sched_barrier(0);
        }
#pragma unroll
        for (int r = 0; r < 16; ++r) {
          const auto sw = __builtin_amdgcn_permlane32_swap(__float_as_uint(Lh[0][r]), __float_as_uint(Lh[1][r]), false, false);
          Lh[0][r] = __uint_as_float(sw[0]); Lh[1][r] = __uint_as_float(sw[1]);
        }
        top16_merge(Lh[0], Lh[1]);
#pragma unroll
        for (int r = 0; r < 16; ++r) F[sd][r] = Lh[0][r];
        __builtin_amdgcn_sched_barrier(0);
      }
      int ia[16], ib[16];
#pragma unroll
      for (int r = 0; r < 16; ++r) { ia[r] = (int)(__float_as_uint(F[0][r]) & 127u) << 7; ib[r] = (int)(__float_as_uint(F[1][r]) & 127u); }
      float k[16]; int q[16];
#pragma unroll
      for (int j = 0; j < 16; ++j) { k[j] = F[0][0] + F[1][j]; q[j] = ia[0] | ib[j]; }
      { float xk[8]; int xq[8];
#pragma unroll
        for (int j = 0; j < 8; ++j) { xk[j] = F[0][1] + F[1][j]; xq[j] = ia[1] | ib[j]; }
        top16_merge_chain<8>(k, q, xk, xq); }
      { float xk[5]; int xq[5];
#pragma unroll
        for (int j = 0; j < 5; ++j) { xk[j] = F[0][2] + F[1][j]; xq[j] = ia[2] | ib[j]; }
        top16_merge_chain<5>(k, q, xk, xq); }
      { float xk[4]; int xq[4];
#pragma unroll
        for (int j = 0; j < 4; ++j) { xk[j] = F[0][3] + F[1][j]; xq[j] = ia[3] | ib[j]; }
        top16_merge_chain<4>(k, q, xk, xq); }
      { float xk[3]; int xq[3];
#pragma unroll
        for (int j = 0; j < 3; ++j) { xk[j] = F[0][4] + F[1][j]; xq[j] = ia[4] | ib[j]; }
        top16_merge_chain<3>(k, q, xk, xq); }
      { float xk[11]; int xq[11];
#pragma unroll
        for (int i = 0; i < 11; ++i) { xk[i] = F[0][5 + i] + F[1][0]; xq[i] = ia[5 + i] | ib[0]; }
        top16_merge_chain<11>(k, q, xk, xq); }
      { float xk[3]; int xq[3];
#pragma unroll
        for (int i = 0; i < 3; ++i) { xk[i] = F[0][5 + i] + F[1][1]; xq[i] = ia[5 + i] | ib[1]; }
        top16_merge_chain<3>(k, q, xk, xq); }
      float e[16]; float es = 0.f;
#pragma unroll
      for (int i = 0; i < 16; ++i) { e[i] = __expf(k[i] - k[0]); es += e[i]; }
      const float ies = 1.f / es;
      const int h = 2 * hp + hf;
#pragma unroll
      for (int i = 0; i < 16; ++i) idxL[tl * 132 + h * 16 + i] = (int)(((unsigned)f2bf(e[i] * ies) << 16) | (unsigned)q[i]);
    }
    __syncthreads();
    {
      const int fr = lane & 15, fq = lane >> 4, jsel = lane & 3, tlb = wid * 8;
      unsigned char* hq4 = smem + 33792 + wid * 1024;
      unsigned char* ust = smem + 41984 + wid * 8448;
      const unsigned lane8 = (unsigned)lane * 8u;
      const int hi5 = lane >> 5; const unsigned lane16 = (unsigned)(lane & 31) * 16u;
#define PEER_REQ_IDX(sn_) (idxL[(tlb + ((min((sn_), 127) & 63) >> 3)) * 132 + 16 * (min((sn_), 127) & 7) + fr] & 0xffff)
#define PEER_REQ_U(Q, e_) peer_req_rows16(Q, (const unsigned char*)U4, (e_), hi5, lane16)
      u32x4v qa[8], qb[8];
      {
        const int e0 = PEER_REQ_IDX(0), e1 = PEER_REQ_IDX(1);
        PEER_REQ_U(qa, e0);
        __builtin_amdgcn_sched_barrier(0);
        PEER_REQ_U(qb, e1);
        __builtin_amdgcn_sched_barrier(0);
      }
      {
        const float rs_lane = rsqrtf(ssq_total(SSQ, t0 + tlb + (lane & 7)) * (1.f / 1024.f) + EPS_);
        uint4 nh0 = *(const uint4*)(XG + (size_t)(t0 + tlb) * 1024 + lane * 16), nh1 = *(const uint4*)(XG + (size_t)(t0 + tlb) * 1024 + lane * 16 + 8);
#pragma unroll 1
        for (int ii = 0; ii < 8; ++ii) {
          const int tl = tlb + ii, t = t0 + tl;
          uint4 hB1[8], hB2[8];
          {
            const unsigned hw[8] = {nh0.x, nh0.y, nh0.z, nh0.w, nh1.x, nh1.y, nh1.z, nh1.w};
            const float rs = __int_as_float(__builtin_amdgcn_readlane(__float_as_int(rs_lane), ii));
            unsigned q1[2] = {0u, 0u}, q2[2] = {0u, 0u};
#pragma unroll
            for (int qq = 0; qq < 4; ++qq) {
              const f32x4 sh = *(const f32x4*)(cst + 3072 + qq * 256 + lane * 4);
              float hvv[4];
              hvv[0] = __uint_as_float(hw[2 * qq] << 16) * rs + sh.x; hvv[1] = __uint_as_float(hw[2 * qq] & 0xffff0000u) * rs + sh.y;
              hvv[2] = __uint_as_float(hw[2 * qq + 1] << 16) * rs + sh.z; hvv[3] = __uint_as_float(hw[2 * qq + 1] & 0xffff0000u) * rs + sh.w;
#pragma unroll
              for (int pr = 0; pr < 2; ++pr) {
                const int byte_sel = (2 * qq + pr) & 3, wd = (2 * qq + pr) >> 2;
                const float x0 = fminf(fmaxf(hvv[2 * pr], -6.f), 6.f), x1 = fminf(fmaxf(hvv[2 * pr + 1], -6.f), 6.f);
                unsigned t1 = 0u;
                if (byte_sel == 0) t1 = __builtin_amdgcn_cvt_scalef32_pk_fp4_f32(0u, x0, x1, 1.0f, 0);
                else if (byte_sel == 1) t1 = __builtin_amdgcn_cvt_scalef32_pk_fp4_f32(0u, x0, x1, 1.0f, 1);
                else if (byte_sel == 2) t1 = __builtin_amdgcn_cvt_scalef32_pk_fp4_f32(0u, x0, x1, 1.0f, 2);
                else t1 = __builtin_amdgcn_cvt_scalef32_pk_fp4_f32(0u, x0, x1, 1.0f, 3);
                f32x2 back;
                if (byte_sel == 0) back = __builtin_amdgcn_cvt_scalef32_pk_f32_fp4(t1, 1.0f, 0);
                else if (byte_sel == 1) back = __builtin_amdgcn_cvt_scalef32_pk_f32_fp4(t1, 1.0f, 1);
                else if (byte_sel == 2) back = __builtin_amdgcn_cvt_scalef32_pk_f32_fp4(t1, 1.0f, 2);
                else back = __builtin_amdgcn_cvt_scalef32_pk_f32_fp4(t1, 1.0f, 3);
                const float r0 = fminf(fmaxf((hvv[2 * pr] - back.x) * 8.f, -6.f), 6.f), r1 = fminf(fmaxf((hvv[2 * pr + 1] - back.y) * 8.f, -6.f), 6.f);
                unsigned t2 = 0u;
                if (byte_sel == 0) t2 = __builtin_amdgcn_cvt_scalef32_pk_fp4_f32(0u, r0, r1, 1.0f, 0);
                else if (byte_sel == 1) t2 = __builtin_amdgcn_cvt_scalef32_pk_fp4_f32(0u, r0, r1, 1.0f, 1);
                else if (byte_sel == 2) t2 = __builtin_amdgcn_cvt_scalef32_pk_fp4_f32(0u, r0, r1, 1.0f, 2);
                else t2 = __builtin_amdgcn_cvt_scalef32_pk_fp4_f32(0u, r0, r1, 1.0f, 3);
                q1[wd] |= t1; q2[wd] |= t2;
              }
            }
            *(uint2*)(hq4 + lane * 8) = make_uint2(q1[0], q1[1]);
            *(uint2*)(hq4 + 512 + lane * 8) = make_uint2(q2[0], q2[1]);
#pragma unroll
            for (int kc = 0; kc < 8; ++kc) { hB1[kc] = *(const uint4*)(hq4 + 64 * kc + 16 * fq); hB2[kc] = *(const uint4*)(hq4 + 512 + 64 * kc + 16 * fq); }
          }
          { const int tn = t + (ii < 7 ? 1 : 0);
            nh0 = *(const uint4*)(XG + (size_t)tn * 1024 + lane * 16); nh1 = *(const uint4*)(XG + (size_t)tn * 1024 + lane * 16 + 8); }
          __builtin_amdgcn_sched_barrier(0);
#define PEER_U_STEP(R, bt_) do { const int _bt = (bt_), _sn = ii * 8 + _bt + 2; \
            _Pragma("unroll") for (int r = 0; r < 8; ++r) *(u32x4v*)(ust + (2 * r + hi5) * 528 + lane16) = R[r];        \
            if (_sn < 64) { const int _en = PEER_REQ_IDX(_sn); PEER_REQ_U(R, _en); } else { const int _en = PEER_REQ_IDX(_sn); peer_req_rows8(R, (const unsigned char*)V4, _en, lane8); }        \
            __builtin_amdgcn_sched_barrier(0); \
            uint4 ua[8]; \
            _Pragma("unroll") for (int kc = 0; kc < 8; ++kc) ua[kc] = *(const uint4*)(ust + fr * 528 + 64 * kc + 16 * fq);      \
            f32x4 sa[2] = {(f32x4){0.f, 0.f, 0.f, 0.f}, (f32x4){0.f, 0.f, 0.f, 0.f}}, sb[2] = {(f32x4){0.f, 0.f, 0.f, 0.f}, (f32x4){0.f, 0.f, 0.f, 0.f}};     \
            _Pragma("unroll") for (int kc = 0; kc < 8; ++kc) { \
              const i32x8 av = (i32x8){(int)ua[kc].x, (int)ua[kc].y, (int)ua[kc].z, (int)ua[kc].w, 0, 0, 0, 0}; \
              const i32x8 b1 = (i32x8){(int)hB1[kc].x, (int)hB1[kc].y, (int)hB1[kc].z, (int)hB1[kc].w, 0, 0, 0, 0}; \
              const i32x8 b2 = (i32x8){(int)hB2[kc].x, (int)hB2[kc].y, (int)hB2[kc].z, (int)hB2[kc].w, 0, 0, 0, 0}; \
              sa[kc & 1] = __builtin_amdgcn_mfma_scale_f32_16x16x128_f8f6f4(av, b1, sa[kc & 1], 4  , 4  , 0, 0x7F7F7F7F, 0, 0x7F7F7F7F); \
              sb[kc & 1] = __builtin_amdgcn_mfma_scale_f32_16x16x128_f8f6f4(av, b2, sb[kc & 1], 4, 4, 0, 0x7F7F7F7F, 0, 0x7F7F7F7F); } \
            const f32x4 sc4 = (sa[0] + sa[1]) + (sb[0] + sb[1]) * 0.125f; \
              \
            const float dsel = jsel == 0 ? sc4[0] : (jsel == 1 ? sc4[1] : (jsel == 2 ? sc4[2] : sc4[3])); \
            const int _eo = tl * 132 + 16 * _bt + 4 * fq + jsel; const unsigned _pe = (unsigned)idxL[_eo]; \
            const float _w = __uint_as_float(_pe & 0xffff0000u) * gelu_tanh_fast(dsel * (1.f / 64.f));            \
            if (fr < 4) idxL[_eo] = (int)(((unsigned)f2bf(_w) << 16) | (_pe & 0xffffu)); \
          } while (0)
#pragma unroll 1
          for (int b2 = 0; b2 < 8; b2 += 2) { PEER_U_STEP(qa, b2); PEER_U_STEP(qb, b2 + 1); }
#undef PEER_U_STEP
        }
      }
      {
        f32x2 acc2[8];
#pragma unroll
        for (int j = 0; j < 8; ++j) acc2[j] = (f32x2){0.f, 0.f};
#pragma unroll 1
        for (int ii = 0; ii < 8; ++ii) {
          const int tl = tlb + ii, t = t0 + tl;
          const uint4 xr0 = *(const uint4*)(X + (size_t)t * 1024 + lane * 16), xr1 = *(const uint4*)(X + (size_t)t * 1024 + lane * 16 + 8);
          __builtin_amdgcn_sched_barrier(0);
#define PEER_V_STEP(R, bt_) do { const int _bt = (bt_), _sn = 64 + ii * 8 + _bt + 2; \
            const int _wv = (int)((unsigned)idxL[tl * 132 + 16 * _bt + fr] & 0xffff0000u);          \
            const int _en = PEER_REQ_IDX(_sn); \
            _Pragma("unroll") for (int r = 0; r < 16; ++r) { \
              const float wr = __int_as_float(__builtin_amdgcn_readlane(_wv, r)); \
              axpy16_fp4(make_uint2(R[r >> 1][2 * (r & 1)], R[r >> 1][2 * (r & 1) + 1]), wr, acc2); \
              { const unsigned off = (unsigned)__builtin_amdgcn_readlane(_en, r) * 512u + lane8; const uint2 _t = *(const uint2*)((const unsigned char*)V4 + off); \
                R[r >> 1][2 * (r & 1)] = _t.x; R[r >> 1][2 * (r & 1) + 1] = _t.y; } \
              __builtin_amdgcn_sched_barrier(0); } \
          } while (0)
#pragma unroll 1
          for (int b2 = 0; b2 < 8; b2 += 2) { PEER_V_STEP(qa, b2); PEER_V_STEP(qb, b2 + 1); }
#undef PEER_V_STEP
          float xn[16]; float ss = 0.f;
          const unsigned xw[8] = {xr0.x, xr0.y, xr0.z, xr0.w, xr1.x, xr1.y, xr1.z, xr1.w};
#pragma unroll
          for (int qq = 0; qq < 4; ++qq) {
            const f32x4 xv = (f32x4){__uint_as_float(xw[2 * qq] << 16), __uint_as_float(xw[2 * qq] & 0xffff0000u), __uint_as_float(xw[2 * qq + 1] << 16), __uint_as_float(xw[2 * qq + 1] & 0xffff0000u)};
            const f32x4 g = *(const f32x4*)(cst + qq * 256 + lane * 4);
            xn[4 * qq] = xv.x + g.x * acc2[2 * qq].x; xn[4 * qq + 1] = xv.y + g.y * acc2[2 * qq].y;
            xn[4 * qq + 2] = xv.z + g.z * acc2[2 * qq + 1].x; xn[4 * qq + 3] = xv.w + g.w * acc2[2 * qq + 1].y;
            ss += xn[4 * qq] * xn[4 * qq] + xn[4 * qq + 1] * xn[4 * qq + 1] + xn[4 * qq + 2] * xn[4 * qq + 2] + xn[4 * qq + 3] * xn[4 * qq + 3];
          }
#pragma unroll
          for (int j = 0; j < 8; ++j) acc2[j] = (f32x2){0.f, 0.f};
          const float rstd = rsqrtf(wave_sum(ss) * (1.f / 1024.f) + EPS_);
          if (!last) {
            unsigned hb[8], xb[8];
#pragma unroll
            for (int qq = 0; qq < 4; ++qq) {
              xb[2 * qq] = pk2(xn[4 * qq], xn[4 * qq + 1]); xb[2 * qq + 1] = pk2(xn[4 * qq + 2], xn[4 * qq + 3]);
              const f32x4 ga = *(const f32x4*)(cst + 1024 + qq * 256 + lane * 4), sh = *(const f32x4*)(cst + 2048 + qq * 256 + lane * 4);
              hb[2 * qq] = pk2(xn[4 * qq] * rstd * ga.x + sh.x, xn[4 * qq + 1] * rstd * ga.y + sh.y);
              hb[2 * qq + 1] = pk2(xn[4 * qq + 2] * rstd * ga.z + sh.z, xn[4 * qq + 3] * rstd * ga.w + sh.w);
            }
            *(uint4*)(X + (size_t)t * 1024 + lane * 16) = make_uint4(xb[0], xb[1], xb[2], xb[3]);
            *(uint4*)(X + (size_t)t * 1024 + lane * 16 + 8) = make_uint4(xb[4], xb[5], xb[6], xb[7]);
            *(uint4*)(HF + (size_t)t * 1024 + lane * 16) = make_uint4(hb[0], hb[1], hb[2], hb[3]);
            *(uint4*)(HF + (size_t)t * 1024 + lane * 16 + 8) = make_uint4(hb[4], hb[5], hb[6], hb[7]);
          } else {
#pragma unroll
            for (int qq = 0; qq < 4; ++qq) {
              const f32x4 fn = *(const f32x4*)(cst + 1024 + qq * 256 + lane * 4);
              *(f32x4*)((float*)pp->out + (size_t)t * 1024 + lane * 16 + 4 * qq) = (f32x4){xn[4 * qq] * rstd * fn.x, xn[4 * qq + 1] * rstd * fn.y, xn[4 * qq + 2] * rstd * fn.z, xn[4 * qq + 3] * rstd * fn.w};
            }
          }
        }
      }
#undef PEER_REQ_IDX
#undef PEER_REQ_U
    }
  }
}

#define XB_TMO      128
#define XB_XCNT(j)  (256  + 64 * (j))
#define XB_XSUB(j)  (1280 + 64 * (j))
#define XB_XGEN(j)  (2304 + 64 * (j))
#define XB_TOP      3328
#define XB_TOPGEN   3392
#define XCD_BAR_WORDS 3456
#define XB_SPIN_CAP (1u << 20)
#define LAS __attribute__((address_space(3)))
__device__ __forceinline__ unsigned xb_ld(unsigned* q)              { return __hip_atomic_load(q, __ATOMIC_RELAXED, __HIP_MEMORY_SCOPE_AGENT); }
__device__ __forceinline__ unsigned xb_add(unsigned* q, unsigned v) { return __hip_atomic_fetch_add(q, v, __ATOMIC_RELAXED, __HIP_MEMORY_SCOPE_AGENT); }
__device__ __forceinline__ unsigned xb_xcc_id() { return (unsigned)__builtin_amdgcn_s_getreg((3 << 11) | 20) & 0xFu; }
#define XB_SPIN(cond, bar) do { unsigned _sp = 0; while (cond) { __builtin_amdgcn_s_sleep(1); \
    if ((++_sp & 255u) == 0u) { if (xb_ld(&(bar)[XB_TMO])) break; if (_sp > XB_SPIN_CAP) { atomicAdd(&(bar)[XB_TMO], 1u); break; } } } } while (0)
struct XcdBarrier { unsigned* bar; unsigned x; volatile LAS unsigned* st; };
__device__ __forceinline__ XcdBarrier xcd_barrier_post(unsigned* bar, volatile LAS unsigned* st) {
    XcdBarrier b; b.bar = bar; b.x = xb_xcc_id(); b.st = st;
    if (threadIdx.x == 0) (void)xb_add(&bar[XB_XCNT(b.x)], 1u);
    return b;
}
__device__ __forceinline__ void xcd_barrier_complete(unsigned* bar, unsigned x, unsigned& nloc, unsigned& nx) {
    const unsigned G = gridDim.x * gridDim.y * gridDim.z;
    unsigned sum, cnt, mine, sp = 0u;
    for (;;) {
        sum = 0u; cnt = 0u; mine = 0u;
#pragma unroll
        for (unsigned j = 0; j < 16; ++j) { const unsigned c = xb_ld(&bar[XB_XCNT(j)]); sum += c; cnt += (c > 0u) ? 1u : 0u; mine = (j == x) ? c : mine; }
        if (sum == G) break;
        __builtin_amdgcn_s_sleep(1);
        if ((++sp & 255u) == 0u) { if (xb_ld(&bar[XB_TMO])) break; if (sp > XB_SPIN_CAP) { atomicAdd(&bar[XB_TMO], 1u); break; } }
    }
    nloc = mine > 0u ? mine : 1u; nx = cnt > 0u ? cnt : 1u;
}
__device__ __forceinline__ void xcd_barrier(const XcdBarrier& b) {
    asm volatile("s_waitcnt vmcnt(0)" ::: "memory");
    __syncthreads();
    if (threadIdx.x == 0) {
        unsigned* bar = b.bar;
        __builtin_amdgcn_s_waitcnt(0);
        unsigned nloc = b.st[0], nx = b.st[1];
        if (nloc == 0u) { xcd_barrier_complete(bar, b.x, nloc, nx); b.st[0] = nloc; b.st[1] = nx; }
        const unsigned old = xb_add(&bar[XB_XSUB(b.x)], 1u);
        const unsigned gen = old / nloc;
        if (old + 1u == (gen + 1u) * nloc) {
            __builtin_amdgcn_fence(__ATOMIC_RELEASE, "agent");
            asm volatile("s_waitcnt vmcnt(0)" ::: "memory");
            const unsigned og = xb_add(&bar[XB_TOP], 1u);
            const unsigned tg = og / nx;
            if (og + 1u == (tg + 1u) * nx) xb_add(&bar[XB_TOPGEN], 1u);
            else XB_SPIN(xb_ld(&bar[XB_TOPGEN]) == tg, bar);
            __builtin_amdgcn_fence(__ATOMIC_ACQUIRE, "agent");
            xb_add(&bar[XB_XGEN(b.x)], 1u);
            asm volatile("s_waitcnt vmcnt(0)" ::: "memory");
        } else {
            XB_SPIN(xb_ld(&bar[XB_XGEN(b.x)]) == gen, bar);
            __builtin_amdgcn_fence(__ATOMIC_ACQUIRE, "agent");
            asm volatile("s_waitcnt vmcnt(0)" ::: "memory");
        }
    }
    __syncthreads();
}

__global__ void __launch_bounds__(NT) fwd_megakernel(Params p) {
  extern __shared__ __attribute__((aligned(16))) unsigned char smem[];
  const CParamsP pp = launder_kargs();
  cg::grid_group grid = cg::this_grid();
  volatile LAS unsigned* xbst = (volatile LAS unsigned*)(smem + LDS_BYTES - 16);
  if (threadIdx.x == 0) { xbst[0] = 0u; xbst[1] = 0u; }
  if (blockIdx.x == 0) { unsigned* bw = (unsigned*)(pp->ws + WS_BAR); for (int i = threadIdx.x; i < XCD_BAR_WORDS; i += NT) bw[i] = 0u; }
  setup_phase(p, smem);
  grid.sync();
  const XcdBarrier xb = xcd_barrier_post((unsigned*)(pp->ws + WS_BAR), xbst);
  const float* MOD = (const float*)(pp->ws + WS_MOD);
  for (int l = 0; l < DEPTH_; ++l) {
    const float* xsrc = (l == 0) ? gin(pp->in[I_X]) : (const float*)(pp->ws + WS_X);
    const float* modl = MOD + (size_t)l * 2 * 6144;
    if (l == 0) {
      norm_mod_phase(xsrc, gin(pp->in[I_NMIX]), modl + 0, modl + 1024, (bf16_t*)(pp->ws + WS_ABUF));
      qbias_phase(p, smem);
      xcd_barrier(xb);
    }
    gemm_proj_phase(p, l, smem);
    xcd_barrier(xb);
    attn_phase(p, l, smem);
    mix_local_phase(p, l, smem);
    xcd_barrier(xb);
    scan_phase(p, l);
    xcd_barrier(xb);
    mix_final_phase(p, l, smem);
    xcd_barrier(xb);
    gemm_out_phase(p, l, smem);
    xcd_barrier(xb);
    gemm_q_phase(p, l, smem);
    xcd_barrier(xb);
    peer_phase(p, l, l == DEPTH_ - 1, smem);
    xcd_barrier(xb);
  }
}

extern "C" void kernel_launch(void* const* d_in, const int* in_sizes, int n_in,
                              void* d_out, int out_size, void* d_ws, size_t ws_size,
                              hipStream_t stream) {
  static int grid_blocks = 0;
  if (grid_blocks == 0) {
    if (n_in != 24 || ws_size < WS_END) { fprintf(stderr, "kernel_launch: unexpected n_in %d / ws_size %zu (need %zu)\n", n_in, ws_size, (size_t)WS_END); grid_blocks = -1; return; }
    int dev = 0, cus = 0, per_cu = 0;
    if (hipGetDevice(&dev) != hipSuccess || hipDeviceGetAttribute(&cus, hipDeviceAttributeMultiprocessorCount, dev) != hipSuccess) { grid_blocks = -1; return; }
    if (hipFuncSetAttribute((const void*)fwd_megakernel, hipFuncAttributeMaxDynamicSharedMemorySize, LDS_BYTES) != hipSuccess) { fprintf(stderr, "hipFuncSetAttribute failed\n"); grid_blocks = -1; return; }
    if (hipOccupancyMaxActiveBlocksPerMultiprocessor(&per_cu, (const void*)fwd_megakernel, NT, LDS_BYTES) != hipSuccess || per_cu < 1) { fprintf(stderr, "occupancy query: %d\n", per_cu); grid_blocks = -1; return; }
    grid_blocks = cus;
  }
  if (grid_blocks < 0) return;
  Params p{};
  for (int i = 0; i < 24; ++i) p.in[i] = (const GAS float*)d_in[i];
  p.out = (GAS float*)d_out; p.ws = (GAS unsigned char*)d_ws;
  void* args[] = {&p};
  hipError_t e = hipLaunchCooperativeKernel((void*)fwd_megakernel, dim3(grid_blocks), dim3(NT), args, LDS_BYTES, stream);
  if (e != hipSuccess) fprintf(stderr, "cooperative launch failed: %s (grid %d)\n", hipGetErrorString(e), grid_blocks);
}
```

```cpp
#include <hip/hip_runtime.h>
#include <hip/hip_cooperative_groups.h>
#include <cstdio>
#include <cstdint>
namespace cg = cooperative_groups;

typedef unsigned short bf16_t;
typedef short bf16x8 __attribute__((ext_vector_type(8)));
typedef float f32x4 __attribute__((ext_vector_type(4)));
typedef float f32x16 __attribute__((ext_vector_type(16)));
typedef int i32x8 __attribute__((ext_vector_type(8)));

constexpr int T_ = 16384, D_ = 1024, L_ = 8192, NBATCH = 2, DEPTH_ = 4;
constexpr int INC = 2944, INCP = 3072;
constexpr int NCH = 128;
constexpr int NT = 512;
constexpr int NW = 8;
constexpr float EPS_ = 1e-6f;
constexpr int C_QA = 0, C_KA = 384, C_VA = 768, C_QR = 1152, C_KR = 1536, C_VR = 1920, C_GR = 2304, C_US = 2688;

constexpr size_t al256(size_t x) { return (x + 255) & ~(size_t)255; }
constexpr size_t WS_MOD   = 0;
constexpr size_t WS_ROTC  = al256(WS_MOD + 4ull * 2 * 6144 * 4);
constexpr size_t WS_ROTS  = al256(WS_ROTC + 8192ull * 32 * 4);
constexpr size_t WS_SA    = al256(WS_ROTS + 8192ull * 32 * 4);
constexpr size_t WS_SBB   = al256(WS_SA + 4ull * 16 * 64 * 2 * 4);
constexpr size_t WS_WIN   = al256(WS_SBB + 4ull * 16 * 64 * 32 * 4);
constexpr size_t WS_WOUT  = al256(WS_WIN + 4ull * INCP * 1024 * 2);
constexpr size_t WS_WQ    = al256(WS_WOUT + 4ull * 1024 * 1024 * 2);
constexpr size_t WS_SUBK  = al256(WS_WQ + 4ull * 2048 * 1024 * 2);
constexpr size_t WS_ABUF  = al256(WS_SUBK + 4ull * 16 * 128 * 128 * 2);
constexpr size_t WS_PROJ  = al256(WS_ABUF + (size_t)T_ * 1024 * 2);
constexpr size_t WS_VTA   = al256(WS_PROJ + (size_t)T_ * INCP * 2);
constexpr size_t WS_ATT   = al256(WS_VTA + 2ull * 6 * 64 * 8192 * 2);
constexpr size_t WS_YINT  = al256(WS_ATT + (size_t)T_ * 384 * 4);
constexpr size_t WS_UPD   = al256(WS_YINT + (size_t)T_ * 384 * 4);
constexpr size_t WS_SPREV = al256(WS_UPD + 256ull * 6 * 4096 * 4);
constexpr size_t WS_SEND  = al256(WS_SPREV + 256ull * 6 * 4096 * 4);
constexpr size_t WS_CARRY = al256(WS_SEND + 256ull * 16 * 64 * 2 * 4);
constexpr size_t WS_X     = al256(WS_CARRY + 256ull * 16 * 64 * 2 * 4);
constexpr size_t WS_Q     = al256(WS_X + (size_t)T_ * 1024 * 4);
constexpr size_t WS_SC    = al256(WS_Q + (size_t)T_ * 2048 * 2);
constexpr size_t WS_EIDX  = al256(WS_SC + (size_t)T_ * 2048 * 4);
constexpr size_t WS_EGATE = al256(WS_EIDX + (size_t)T_ * 128 * 4);
constexpr size_t WS_PU8   = al256(WS_EGATE + (size_t)T_ * 128 * 4);
constexpr size_t WS_PV8   = al256(WS_PU8 + 4ull * 16384 * 1024);
constexpr size_t WS_BAR   = al256(WS_PV8 + 4ull * 16384 * 1024);
constexpr size_t WS_SPT   = al256(WS_BAR + 3456ull * 4);
constexpr size_t WS_CB    = al256(WS_SPT + 256ull * 6 * 4096 * 2);
constexpr size_t WS_WGLUT = al256(WS_CB + 4ull * 16 * 16 * 128 * 2);
constexpr size_t WS_VTR   = al256(WS_WGLUT + 4ull * 512 * 256 * 2);
constexpr size_t WS_XG    = al256(WS_VTR + 2ull * 384 * 8192 * 2);
constexpr size_t WS_SSQ   = al256(WS_XG + (size_t)T_ * 1024 * 2);
constexpr size_t WS_C2    = al256(WS_SSQ + (size_t)T_ * 16 * 4);
constexpr size_t WS_BBH   = al256(WS_C2 + 4ull * 2 * 2048 * 4);
constexpr size_t WS_END   = al256(WS_BBH + 4ull * 16 * 2 * 64 * 16 * 2);

constexpr int LDS_BYTES = 135168;

#define GAS __attribute__((address_space(1)))
struct Params {
  const GAS float* in[24];
  GAS float* out;
  GAS unsigned char* ws;
};
enum { I_X = 0, I_C, I_WADA, I_BADA, I_NMIX, I_NFFN, I_WIN, I_RELB, I_LRE, I_LIM, I_LOGDT, I_BRE, I_BIM, I_CRE, I_CIM, I_SSMD,
       I_WGLU, I_MGAIN, I_WOUT, I_WQ, I_SUBK, I_PU, I_PV, I_FNORM };

__device__ __forceinline__ float bf2f(bf16_t v) { return __uint_as_float(((unsigned)v) << 16); }
typedef __bf16 hwbf16x2 __attribute__((ext_vector_type(2)));
typedef unsigned u32x4v __attribute__((ext_vector_type(4)));
typedef float f32x2 __attribute__((ext_vector_type(2)));
__device__ __forceinline__ bf16_t f2bf(float f) { return __builtin_bit_cast(unsigned short, (__bf16)f); }
__device__ __forceinline__ unsigned pk2(float a, float b) { const hwbf16x2 v = {(__bf16)a, (__bf16)b}; return __builtin_bit_cast(unsigned, v); }
__device__ __forceinline__ float wave_sum(float v) {
#pragma unroll
  for (int o = 32; o > 0; o >>= 1) v += __shfl_xor(v, o);
  return v;
}
__device__ __forceinline__ float wave_max(float v) {
#pragma unroll
  for (int o = 32; o > 0; o >>= 1) v = fmaxf(v, __shfl_xor(v, o));
  return v;
}
__device__ __forceinline__ float gelu_tanh(float x) { const float u = 0.7978845608028654f * (x + 0.044715f * x * x * x); return 0.5f * x * (1.f + tanhf(u)); }
__device__ __forceinline__ float sigmoid_f(float x) { return 1.f / (1.f + __expf(-x)); }
__device__ __forceinline__ float gelu_tanh_fast(float x) {
  const float u2 = 2.f * 0.7978845608028654f * 1.4426950408889634f * (x + 0.044715f * x * x * x);
  const float e = __builtin_amdgcn_exp2f(fminf(u2, 80.f));
  return x - x * __builtin_amdgcn_rcpf(1.f + e);
}
__device__ __forceinline__ GAS unsigned char* launder_ptr(GAS unsigned char* q) { asm volatile("" : "+s"(q)); return q; }
__device__ __forceinline__ const float* gin(const GAS float* q) { return (const float*)q; }
__device__ __forceinline__ const float* launder_cptr(const float* q) { asm volatile("" : "+s"(q)); return q; }
__device__ __forceinline__ int launder_tid() { int t = threadIdx.x; asm volatile("" : "+v"(t)); return t; }
typedef const Params __attribute__((address_space(4)))* CParamsP;
__device__ __forceinline__ CParamsP launder_kargs() { CParamsP q = (CParamsP)__builtin_amdgcn_kernarg_segment_ptr(); asm volatile("" : "+s"(q)); return q; }

__device__ __forceinline__ void convert_tables_fp4(const CParamsP pp, GAS unsigned char* ws, int layer, int gtid, int gn) {
  constexpr int NSPAN = 16384;
  const int lane = gtid & 63, gw = gtid >> 6, nw = gn >> 6;
  for (int sp0 = gw; sp0 < 2 * NSPAN; sp0 += 2 * nw) {
    f32x4 a[2][4];
#pragma unroll
    for (int h = 0; h < 2; ++h) {
      const int sp = sp0 + h * nw, tb = sp >= NSPAN ? 1 : 0;
      const float* src = (tb ? gin(pp->in[I_PV]) : gin(pp->in[I_PU])) + ((size_t)layer * NSPAN + (sp - tb * NSPAN)) * 1024 + lane * 4;
#pragma unroll
      for (int q = 0; q < 4; ++q) a[h][q] = (sp < 2 * NSPAN) ? *(const f32x4*)(src + q * 256) : (f32x4){0.f, 0.f, 0.f, 0.f};
    }
#pragma unroll
    for (int h = 0; h < 2; ++h) {
      const int sp = sp0 + h * nw, tb = sp >= NSPAN ? 1 : 0;
      if (sp < 2 * NSPAN) {
        const float sc = tb ? 4.f : 64.f;
        unsigned short* dst = (unsigned short*)(ws + (tb ? WS_PV8 : WS_PU8) + ((size_t)layer * NSPAN + (sp - tb * NSPAN)) * 512) + lane;
#pragma unroll
        for (int q = 0; q < 4; ++q) {
          const f32x4 v = a[h][q];
          const float x0 = fminf(fmaxf(v.x * sc, -6.f), 6.f), x1 = fminf(fmaxf(v.y * sc, -6.f), 6.f);
          const float x2 = fminf(fmaxf(v.z * sc, -6.f), 6.f), x3 = fminf(fmaxf(v.w * sc, -6.f), 6.f);
          unsigned o = __builtin_amdgcn_cvt_scalef32_pk_fp4_f32(0u, x0, x1, 1.0f, 0);
          o = __builtin_amdgcn_cvt_scalef32_pk_fp4_f32(o, x2, x3, 1.0f, 1);
          dst[q * 64] = (unsigned short)o;
        }
      }
    }
  }
}

__device__ void setup_phase(const Params& p, unsigned char* smem) {
  const CParamsP pp = launder_kargs();
  GAS unsigned char* const ws = launder_ptr(pp->ws); const int tidx = launder_tid(); (void)ws; (void)tidx;
  const int tid = tidx;
  float* sm = (float*)smem;
  {
    float* cond = sm;
    float* red = sm + 2048;
    float* MOD = (float*)(ws + WS_MOD);
    for (int i = tid; i < 2048; i += NT) { const float c = gin(pp->in[I_C])[i]; cond[i] = c * sigmoid_f(c); }
    __syncthreads();
    for (int item = blockIdx.x; item < 4 * 192; item += gridDim.x) {
      const int l = item / 192, cb = item % 192, kq = tid >> 6, jj = tid & 31, kp = (tid >> 5) & 1, j = cb * 32 + jj;
      const float* w = gin(pp->in[I_WADA]) + (size_t)l * 1024 * 6144 + j;
      float a0 = 0.f, a1 = 0.f;
#pragma unroll 32
      for (int k = kq * 128 + kp; k < kq * 128 + 128; k += 2) { const float wv = w[(size_t)k * 6144]; a0 += cond[k] * wv; a1 += cond[1024 + k] * wv; }
      red[((kq * 2 + kp) * 2 + 0) * 32 + jj] = a0; red[((kq * 2 + kp) * 2 + 1) * 32 + jj] = a1;
      __syncthreads();
      if (tid < 64) {
        const int b = tid >> 5, j2 = tid & 31; float s = 0.f;
        for (int q = 0; q < 16; ++q) s += red[(q * 2 + b) * 32 + j2];
        MOD[((size_t)l * 2 + b) * 6144 + cb * 32 + j2] = s + gin(pp->in[I_BADA])[(size_t)l * 6144 + cb * 32 + j2];
      }
      __syncthreads();
    }
  }
  const int gtid = blockIdx.x * NT + tid, gn = gridDim.x * NT;
  {
    float* RC = (float*)(ws + WS_ROTC); float* RS = (float*)(ws + WS_ROTS);
    for (int idx = gtid; idx < 8192 * 32; idx += gn) {
      const int pos = idx >> 5, i = idx & 31;
      const float inv = powf(10000.0f, -(float)i / 32.0f);
      const float ang = (float)pos * inv;
      float s, c; sincosf(ang, &s, &c);
      RC[idx] = c; RS[idx] = s;
    }
  }
  {
    float* SA = (float*)(ws + WS_SA); float* SBB = (float*)(ws + WS_SBB); bf16_t* BBH = (bf16_t*)(ws + WS_BBH);
    for (int idx = gtid; idx < 4 * 16 * 64; idx += gn) {
      const int l = idx / 1024, g = (idx >> 6) & 15;
      const float dt = expf(gin(pp->in[I_LOGDT])[l * 16 + g]);
      const float lr = gin(pp->in[I_LRE])[idx], li = gin(pp->in[I_LIM])[idx];
      const float mag = expf(lr * dt);
      float sn, cs; sincosf(li * dt, &sn, &cs);
      const float are = mag * cs, aim = mag * sn;
      const float den = lr * lr + li * li, nr = are - 1.f, ni = aim;
      const float fre = (nr * lr + ni * li) / den, fim = (ni * lr - nr * li) / den;
      SA[idx * 2] = are; SA[idx * 2 + 1] = aim;
      for (int c = 0; c < 16; ++c) {
        const float br = gin(pp->in[I_BRE])[(size_t)idx * 16 + c], bi = gin(pp->in[I_BIM])[(size_t)idx * 16 + c];
        SBB[(size_t)idx * 32 + c] = fre * br - fim * bi;
        SBB[(size_t)idx * 32 + 16 + c] = fre * bi + fim * br;
        {
          const int pq = idx & 63; const size_t fb = (size_t)(idx >> 6) * 2;
          BBH[(((fb + 0) * 2 + (pq >> 5)) * 64 + 32 * (c >> 3) + (pq & 31)) * 8 + (c & 7)] = f2bf(fre * br - fim * bi);
          BBH[(((fb + 1) * 2 + (pq >> 5)) * 64 + 32 * (c >> 3) + (pq & 31)) * 8 + (c & 7)] = f2bf(fre * bi + fim * br);
        }
      }
    }
  }
  {
    bf16_t* CB = (bf16_t*)(ws + WS_CB);
    for (int idx = gtid; idx < 4 * 16 * 16 * 128; idx += gn) {
      const int k = idx & 127, lgc = idx >> 7;
      const bf16_t cv = (k < 64) ? f2bf(gin(pp->in[I_CRE])[(size_t)lgc * 64 + k]) : f2bf(-gin(pp->in[I_CIM])[(size_t)lgc * 64 + (k - 64)]);
      const int cc = lgc & 15, lg = lgc >> 4;
      CB[(((size_t)lg * 4 + (k >> 5)) * 64 + ((k >> 3) & 3) * 16 + cc) * 8 + (k & 7)] = cv;
    }
    bf16_t* WG = (bf16_t*)(ws + WS_WGLUT);
    for (int idx = gtid; idx < 4 * 512 * 256; idx += gn) {
      const int k = idx & 255, nn = (idx >> 8) & 511, l2 = idx >> 17;
      {
        const int which = nn >> 8, w8 = (nn >> 5) & 7, nt = (nn >> 4) & 1, frr = nn & 15, ks = k >> 5, fqq = (k >> 3) & 3, j = k & 7;
        WG[(((((size_t)l2 * 8 + w8) * 8 + ks) * 2 + which) * 2 + nt) * 512 + (fqq * 16 + frr) * 8 + j] = f2bf(gin(pp->in[I_WGLU])[((size_t)l2 * 256 + k) * 512 + nn]);
      }
    }
  }
  convert_tables_fp4(pp, ws, 0, gtid, gn);
  {
    __syncthreads();
    const int lane = tid & 63, wid = tid >> 6;
    float* scr = sm + wid * (64 * 33);
    constexpr int IT_IN = 16 * 96, IT_OUT = 16 * 32, IT_L = IT_IN + IT_OUT;
    for (int item = blockIdx.x * NW + wid; item < 4 * IT_L; item += gridDim.x * NW) {
      const int l = item / IT_L; int r = item - l * IT_L;
      const float* W; bf16_t* WT; int N, NP;
      if (r < IT_IN) { W = gin(pp->in[I_WIN]) + (size_t)l * 1024 * INC; WT = (bf16_t*)(ws + WS_WIN) + (size_t)l * INCP * 1024; N = INC; NP = 96; }
      else { r -= IT_IN; W = gin(pp->in[I_WOUT]) + (size_t)l * 1024 * 1024; WT = (bf16_t*)(ws + WS_WOUT) + (size_t)l * 1024 * 1024; N = 1024; NP = 32; }
      const int kb = r / NP, nb = r - kb * NP, k0 = kb * 64, n0 = nb * 32;
      const int nn = n0 + (lane & 31); const bool inb = nn < N;
      float v[32];
#pragma unroll
      for (int i = 0; i < 32; ++i) { const int kk = 2 * i + (lane >> 5); v[i] = inb ? W[(size_t)(k0 + kk) * N + nn] : 0.f; }
#pragma unroll
      for (int i = 0; i < 32; ++i) { const int kk = 2 * i + (lane >> 5); scr[kk * 33 + (lane & 31)] = v[i]; }
      const int c = lane & 7;
#pragma unroll
      for (int j = 0; j < 4; ++j) {
        const int n = (lane >> 3) + 8 * j; const float* sp = scr + (8 * c) * 33 + n;
        uint4 o; o.x = pk2(sp[0], sp[33]); o.y = pk2(sp[2 * 33], sp[3 * 33]); o.z = pk2(sp[4 * 33], sp[5 * 33]); o.w = pk2(sp[6 * 33], sp[7 * 33]);
        *(uint4*)(WT + (size_t)(n0 + n) * 1024 + k0 + 8 * c) = o;
      }
    }
    __syncthreads();
  }
  {
    bf16_t* WP = (bf16_t*)(ws + WS_WQ);
    const int lane = tid & 63, wid = tid >> 6, fr = lane & 15, fq = lane >> 4;
    for (int item = blockIdx.x; item < 4 * 16 * 8; item += gridDim.x) {
      const int l = item >> 7, hs = (item >> 3) & 15, kb = item & 7;
      const float* Wq = gin(pp->in[I_WQ]) + ((size_t)l * 1024 + kb * 128 + wid * 16 + fr) * 2048 + hs * 128 + 8 * fq;
      const float* SKg = gin(pp->in[I_SUBK]) + ((size_t)l * 16 + hs) * 128 * 128 + (size_t)fr * 128 + 8 * fq;
      bf16x8 ah[4], al[4];
#pragma unroll
      for (int ks = 0; ks < 4; ++ks) {
        const f32x4 x0 = *(const f32x4*)(Wq + 32 * ks), x1 = *(const f32x4*)(Wq + 32 * ks + 4);
        const float xv[8] = {x0.x, x0.y, x0.z, x0.w, x1.x, x1.y, x1.z, x1.w};
#pragma unroll
        for (int j = 0; j < 8; ++j) { const bf16_t h = f2bf(xv[j]); ah[ks][j] = (short)h; al[ks][j] = (short)f2bf(xv[j] - bf2f(h)); }
      }
      f32x4 acc[8];
#pragma unroll
      for (int ct = 0; ct < 8; ++ct) acc[ct] = (f32x4){0.f, 0.f, 0.f, 0.f};
#pragma unroll 2
      for (int ct = 0; ct < 8; ++ct) {
        f32x4 y[8];
#pragma unroll
        for (int ks = 0; ks < 4; ++ks) { y[2 * ks] = *(const f32x4*)(SKg + (size_t)ct * 16 * 128 + 32 * ks); y[2 * ks + 1] = *(const f32x4*)(SKg + (size_t)ct * 16 * 128 + 32 * ks + 4); }
#pragma unroll
        for (int ks = 0; ks < 4; ++ks) {
          const float yv[8] = {y[2 * ks].x, y[2 * ks].y, y[2 * ks].z, y[2 * ks].w, y[2 * ks + 1].x, y[2 * ks + 1].y, y[2 * ks + 1].z, y[2 * ks + 1].w};
          bf16x8 bh, bl;
#pragma unroll
          for (int j = 0; j < 8; ++j) { const bf16_t h = f2bf(yv[j]); bh[j] = (short)h; bl[j] = (short)f2bf(yv[j] - bf2f(h)); }
          acc[ct] = __builtin_amdgcn_mfma_f32_16x16x32_bf16(ah[ks], bh, acc[ct], 0, 0, 0);
          acc[ct] = __builtin_amdgcn_mfma_f32_16x16x32_bf16(al[ks], bh, acc[ct], 0, 0, 0);
          acc[ct] = __builtin_amdgcn_mfma_f32_16x16x32_bf16(ah[ks], bl, acc[ct], 0, 0, 0);
        }
      }
#pragma unroll
      for (int ct = 0; ct < 8; ++ct)
        *(uint2*)(WP + ((size_t)l * 2048 + hs * 128 + 16 * ct + fr) * 1024 + kb * 128 + wid * 16 + 4 * fq) = make_uint2(pk2(acc[ct][0], acc[ct][1]), pk2(acc[ct][2], acc[ct][3]));
    }
  }
}

__device__ void qbias_phase(const Params& p, unsigned char* smem) {
  const CParamsP pp = launder_kargs();
  GAS unsigned char* const ws = launder_ptr(pp->ws); const int tid = launder_tid();
  float* C2 = (float*)(ws + WS_C2); const float* MOD = (const float*)(ws + WS_MOD); const bf16_t* WP = (const bf16_t*)(ws + WS_WQ);
  const int lane = tid & 63, gw = blockIdx.x * NW + (tid >> 6), nw = gridDim.x * NW;
  for (int o = gw; o < 4 * 2048; o += nw) {
    const int l = o >> 11;
    const uint4 w0 = *(const uint4*)(WP + (size_t)o * 1024 + lane * 16), w1 = *(const uint4*)(WP + (size_t)o * 1024 + lane * 16 + 8);
    const unsigned ww[8] = {w0.x, w0.y, w0.z, w0.w, w1.x, w1.y, w1.z, w1.w};
    const float* s0 = MOD + (size_t)l * 2 * 6144 + 3072 + lane * 16; const float* s1 = s0 + 6144;
    float a0 = 0.f, a1 = 0.f;
#pragma unroll
    for (int q = 0; q < 8; ++q) {
      const float wl = __uint_as_float(ww[q] << 16), wh = __uint_as_float(ww[q] & 0xffff0000u);
      a0 += s0[2 * q] * wl + s0[2 * q + 1] * wh; a1 += s1[2 * q] * wl + s1[2 * q + 1] * wh;
    }
    a0 = wave_sum(a0); a1 = wave_sum(a1);
    if (lane == 0) { C2[((size_t)l * 2 + 0) * 2048 + (o & 2047)] = a0; C2[((size_t)l * 2 + 1) * 2048 + (o & 2047)] = a1; }
  }
  (void)smem;
}

__device__ void norm_mod_phase(const float* __restrict__ xsrc, const float* __restrict__ gain, const float* __restrict__ mod_sh, const float* __restrict__ mod_sc,
                               bf16_t* __restrict__ outp) {
  const int tidx = launder_tid();
  const int lane = tidx & 63, gw = blockIdx.x * NW + (tidx >> 6), nw = gridDim.x * NW;
  for (int t = gw; t < T_; t += nw) {
    const int b = t >> 13;
    const f32x4* xr = (const f32x4*)(xsrc + (size_t)t * 1024) + lane;
    f32x4 v[4]; float s = 0.f;
#pragma unroll
    for (int j = 0; j < 4; ++j) { v[j] = xr[64 * j]; s += v[j].x * v[j].x + v[j].y * v[j].y + v[j].z * v[j].z + v[j].w * v[j].w; }
    const float rstd = rsqrtf(wave_sum(s) * (1.f / 1024.f) + EPS_);
#pragma unroll
    for (int j = 0; j < 4; ++j) {
      const int c = lane * 4 + 256 * j;
      const f32x4 g = *(const f32x4*)(gain + c), sh = *(const f32x4*)(mod_sh + b * 6144 + c), sc = *(const f32x4*)(mod_sc + b * 6144 + c);
      const float o0 = v[j].x * rstd * g.x * (1.f + sc.x) + sh.x, o1 = v[j].y * rstd * g.y * (1.f + sc.y) + sh.y;
      const float o2 = v[j].z * rstd * g.z * (1.f + sc.z) + sh.z, o3 = v[j].w * rstd * g.w * (1.f + sc.w) + sh.w;
      uint2 o; o.x = pk2(o0, o1); o.y = pk2(o2, o3);
      *(uint2*)(outp + (size_t)t * 1024 + c) = o;
    }
  }
}


namespace pg8 {
#define PG8_LAS __attribute__((address_space(3)))
typedef unsigned u32x4 __attribute__((ext_vector_type(4)));
constexpr int BM = 256, BK = 64, HALF = 128, HTB = HALF * BK * 2, STAGE_BYTES = 8 * HTB, NXCD = 8, WGM = 8;
__host__ __device__ __forceinline__ int lds_byte(int r, int c) { const int st = (r >> 4) * 2 + (c >> 5), rr = r & 15, cc = c & 31, ob = rr * 64 + cc * 2; return st * 1024 + (ob ^ (((ob >> 9) & 1) << 5)); }
__host__ __device__ __forceinline__ void stage_rc(int b, int& R, int& C) { const int st = b / 1024, sb = b % 1024, swz = sb ^ (((sb >> 9) & 1) << 5); R = (st >> 1) * 16 + swz / 64; C = (st & 1) * 32 + (swz % 64) / 2; }
__host__ __device__ __forceinline__ int perm32(int rho) { const int n = rho >> 4, i = rho & 15; return 8 * (i >> 2) + 4 * n + (i & 3); }
struct Unit { int pm, pn; };
struct Gemm { const bf16_t* A; const bf16_t* Bt; int M, N, K; };
struct StaticOrder {
    int nM, nN, nwg, G, c;
    __host__ __device__ void init(int M, int N, int G_, int c_) { nM = M / BM; nN = N / BM; nwg = nM * nN; G = G_; c = c_; }
    __host__ __device__ bool next(int i, Unit& u) const {
        const long L = (long)i * G + c; if (L >= nwg) return false;
        int wgid = (int)L; { const int q = nwg / NXCD, r = nwg % NXCD, xcd = wgid % NXCD, off = wgid / NXCD; wgid = (xcd < r ? xcd * (q + 1) : r * (q + 1) + (xcd - r) * q) + off; }
        const int nig = WGM * nN, gid = wgid / nig, fm = gid * WGM, gsz = (nM - fm) < WGM ? (nM - fm) : WGM;
        u.pm = fm + ((wgid % nig) % gsz); u.pn = (wgid % nig) / gsz; return true;
    }
    __device__ __forceinline__ void a_ready(const Unit&) const {}
    __device__ __forceinline__ void done(const Unit&) const {}
};
__device__ __forceinline__ unsigned cvt_pk_bf16(float lo, float hi) { unsigned r; asm volatile("v_cvt_pk_bf16_f32 %0, %1, %2" : "=v"(r) : "v"(lo), "v"(hi)); return r; }
template <class Epi, class Sched>
__device__ __forceinline__ void gemm_phase(PG8_LAS unsigned char* lds, const Gemm g, const Sched& S, const Epi& E) {
    const int tid = launder_tid(), wid = __builtin_amdgcn_readfirstlane(tid >> 6), lane = tid & 63, wr = wid >> 2, wc = wid & 3, fr = lane & 15, fq = lane >> 4;
    const int K = g.K, nt = K / BK;
    unsigned voffA[2], voffB[2];
#pragma unroll
    for (int i = 0; i < 2; ++i) { int R, C; stage_rc(tid * 16 + i * 8192, R, C); const int Rb = Epi::PERM ? ((R & ~31) + perm32(R & 31)) : R;
        voffA[i] = (unsigned)(R * K + C) * 2u; voffB[i] = (unsigned)(Rb * K + C) * 2u; }
    const size_t kstep = (size_t)(BK * 2);
    const size_t hstep = (size_t)HALF * K * 2;
    const size_t tstep = 2 * hstep;
    const unsigned ldsw = (unsigned)wid * 1024u;
    const int aoff = lds_byte(wr * 64 + fr, fq * 8), boff = lds_byte(wc * 32 + fr, fq * 8);
#define PG8_SA(b, h) (((b) * 2 + (h)) * HTB)
#define PG8_SB(b, h) ((4 + (b) * 2 + (h)) * HTB)
#define PG8_STAGE(bufoff, gbase, voff) do { _Pragma("unroll") for (int _i = 0; _i < 2; ++_i) \
        __builtin_amdgcn_global_load_lds((const unsigned*)((const char*)(gbase) + (voff)[_i]), (PG8_LAS unsigned*)(lds + (bufoff) + ldsw + _i * 8192), 16, 0, 0); } while (0)
#define PG8_LDA(dst, b, h) do { _Pragma("unroll") for (int m = 0; m < 4; ++m) _Pragma("unroll") for (int k = 0; k < 2; ++k) dst[m][k] = *(const PG8_LAS bf16x8*)(lds + PG8_SA(b, h) + aoff + m * 2048 + k * 1024); } while (0)
#define PG8_LDB(dst, b, h) do { _Pragma("unroll") for (int n = 0; n < 2; ++n) _Pragma("unroll") for (int k = 0; k < 2; ++k) dst[n][k] = *(const PG8_LAS bf16x8*)(lds + PG8_SB(b, h) + boff + n * 2048 + k * 1024); } while (0)
#define PG8_MMA(ai, bj, At, Bt) do { __builtin_amdgcn_s_setprio(1); _Pragma("unroll") for (int m = 0; m < 4; ++m) _Pragma("unroll") for (int n = 0; n < 2; ++n) _Pragma("unroll") for (int k = 0; k < 2; ++k) \
        acc[ai][bj][m][n] = __builtin_amdgcn_mfma_f32_16x16x32_bf16(Bt[n][k], At[m][k], acc[ai][bj][m][n], 0, 0, 0); __builtin_amdgcn_s_setprio(0); } while (0)
#define PG8_WAIT_V(n) asm volatile("s_waitcnt vmcnt(" #n ")" ::: "memory")
#define PG8_WAIT_L(n) asm volatile("s_waitcnt lgkmcnt(" #n ")" ::: "memory")
#define PG8_BAR __builtin_amdgcn_s_barrier()
#define PG8_SCHED __builtin_amdgcn_sched_barrier(0)
    Unit cur, nxt; int ui = 0;
    if (!S.next(0, cur)) return;
    f32x4 acc[2][2][4][2];
#pragma unroll
    for (int a = 0; a < 2; ++a)
#pragma unroll
        for (int b = 0; b < 2; ++b)
#pragma unroll
            for (int m = 0; m < 4; ++m)
#pragma unroll
                for (int n = 0; n < 2; ++n) acc[a][b][m][n] = (f32x4){0.f, 0.f, 0.f, 0.f};
    bf16x8 At[4][2], B0[2][2], B1[2][2];
    const char* cA = (const char*)g.A + (size_t)cur.pm * tstep; const char* cB = (const char*)g.Bt + (size_t)cur.pn * tstep;
    S.a_ready(cur);
    PG8_STAGE(PG8_SB(0, 0), cB, voffB); PG8_STAGE(PG8_SA(0, 0), cA, voffA); PG8_STAGE(PG8_SB(0, 1), cB + hstep, voffB); PG8_STAGE(PG8_SA(0, 1), cA + hstep, voffA);
    if (wr == 1) PG8_BAR;
    PG8_WAIT_V(4); PG8_BAR;
    PG8_STAGE(PG8_SB(1, 0), cB + kstep, voffB); PG8_STAGE(PG8_SA(1, 0), cA + kstep, voffA); PG8_STAGE(PG8_SB(1, 1), cB + hstep + kstep, voffB);
    PG8_WAIT_V(6); PG8_BAR;
    for (;;) {
        const bool has_next = S.next(ui + 1, nxt);
        const char* nA = has_next ? (const char*)g.A + (size_t)nxt.pm * tstep : cA; const char* nB = has_next ? (const char*)g.Bt + (size_t)nxt.pn * tstep : cB;
        for (int t = 0; t < nt; t += 2) {
            const bool last = (t == nt - 2);
            const char* a1 = cA + (size_t)(t + 1) * kstep;
            const char* a2 = last ? nA : cA + (size_t)(t + 2) * kstep; const char* b2 = last ? nB : cB + (size_t)(t + 2) * kstep;
            const char* a3 = a2 + kstep; const char* b3 = b2 + kstep;
            if (last && has_next) S.a_ready(nxt);
            PG8_LDB(B0, 0, 0); PG8_SCHED; PG8_LDA(At, 0, 0); PG8_STAGE(PG8_SA(1, 1), a1 + hstep, voffA);
            PG8_WAIT_L(8); PG8_BAR; PG8_WAIT_L(0); PG8_MMA(0, 0, At, B0); PG8_BAR; PG8_SCHED;
            PG8_LDB(B1, 0, 1); PG8_STAGE(PG8_SB(0, 0), b2, voffB);
            PG8_BAR; PG8_WAIT_L(0); PG8_MMA(0, 1, At, B1); PG8_BAR;
            PG8_LDA(At, 0, 1); PG8_STAGE(PG8_SA(0, 0), a2, voffA);
            PG8_BAR; PG8_WAIT_L(0); PG8_MMA(1, 0, At, B0); PG8_BAR; PG8_SCHED;
            PG8_STAGE(PG8_SB(0, 1), b2 + hstep, voffB);
            PG8_WAIT_V(6); PG8_BAR; PG8_MMA(1, 1, At, B1); PG8_BAR;
            PG8_LDB(B0, 1, 0); PG8_SCHED; PG8_LDA(At, 1, 0); PG8_STAGE(PG8_SA(0, 1), a2 + hstep, voffA);
            PG8_WAIT_L(8); PG8_BAR; PG8_WAIT_L(0); PG8_MMA(0, 0, At, B0); PG8_BAR; PG8_SCHED;
            PG8_LDB(B1, 1, 1); PG8_STAGE(PG8_SB(1, 0), b3, voffB);
            PG8_BAR; PG8_WAIT_L(0); PG8_MMA(0, 1, At, B1); PG8_BAR;
            PG8_LDA(At, 1, 1); PG8_STAGE(PG8_SA(1, 0), a3, voffA);
            PG8_BAR; PG8_WAIT_L(0); PG8_MMA(1, 0, At, B0); PG8_BAR; PG8_SCHED;
            PG8_STAGE(PG8_SB(1, 1), b3 + hstep, voffB);
            PG8_WAIT_V(6); PG8_BAR; PG8_MMA(1, 1, At, B1); PG8_BAR;
        }
        if constexpr (!Epi::AFTER_DRAIN) { E(acc, cur, wr, wc, fr, fq); S.done(cur); }
        if (!has_next) break;
#pragma unroll
        for (int a = 0; a < 2; ++a)
#pragma unroll
            for (int b = 0; b < 2; ++b)
#pragma unroll
                for (int m = 0; m < 4; ++m)
#pragma unroll
                    for (int n = 0; n < 2; ++n) acc[a][b][m][n] = (f32x4){0.f, 0.f, 0.f, 0.f};
        cur = nxt; cA = nA; cB = nB; ++ui;
    }
    PG8_WAIT_V(0);
    if (wr == 0) PG8_BAR;
    PG8_BAR;
    if constexpr (Epi::AFTER_DRAIN) { E.fused(acc, cur, wr, wc, fr, fq, lds, wid, lane); S.done(cur); }
#undef PG8_SA
#undef PG8_SB
#undef PG8_STAGE
#undef PG8_LDA
#undef PG8_LDB
#undef PG8_MMA
#undef PG8_WAIT_V
#undef PG8_WAIT_L
#undef PG8_BAR
#undef PG8_SCHED
}
}

__device__ __forceinline__ float ssq_total(const float* __restrict__ SSQ, int t) {
  const f32x4 a = *(const f32x4*)(SSQ + (size_t)t * 16), b = *(const f32x4*)(SSQ + (size_t)t * 16 + 4), c = *(const f32x4*)(SSQ + (size_t)t * 16 + 8), d = *(const f32x4*)(SSQ + (size_t)t * 16 + 12);
  return (((a.x + a.y) + (a.z + a.w)) + ((b.x + b.y) + (b.z + b.w))) + (((c.x + c.y) + (c.z + c.w)) + ((d.x + d.y) + (d.z + d.w)));
}
struct EpiProj {
  static constexpr bool PERM = true, AFTER_DRAIN = false;
  bf16_t* PROJ; bf16_t* VTA; bf16_t* VTR;
  __device__ __forceinline__ void operator()(const f32x4 (&acc)[2][2][4][2], const pg8::Unit& u, int wr, int wc, int fr, int fq) const {
    const int row0 = u.pm * 256 + wr * 64 + fr, col0 = u.pn * 256 + wc * 32 + 8 * fq;
    asm volatile("s_nop 15\n\ts_nop 15" ::: "memory");
#pragma unroll
    for (int ai = 0; ai < 2; ++ai)
#pragma unroll
      for (int m = 0; m < 4; ++m) {
        const int t = row0 + ai * 128 + m * 16;
#pragma unroll
        for (int bj = 0; bj < 2; ++bj) {
          const int c = col0 + bj * 128;
          const f32x4 v0 = acc[ai][bj][m][0], v1 = acc[ai][bj][m][1];
          pg8::u32x4 w; w.x = pg8::cvt_pk_bf16(v0[0], v0[1]); w.y = pg8::cvt_pk_bf16(v0[2], v0[3]); w.z = pg8::cvt_pk_bf16(v1[0], v1[1]); w.w = pg8::cvt_pk_bf16(v1[2], v1[3]);
          *(pg8::u32x4*)(PROJ + (size_t)t * INCP + c) = w;
          const bool isva = (c >= C_VA && c < C_VA + 384), isvr = (c >= C_VR && c < C_VR + 384);
          if (isva || isvr) {
            bf16_t* vt = (isva ? VTA : VTR) + ((size_t)(t >> 13) * 384 + (c - (isva ? C_VA : C_VR))) * 8192 + (t & 8191);
            vt[0] = (bf16_t)(w.x & 0xffffu); vt[8192] = (bf16_t)(w.x >> 16); vt[2 * 8192] = (bf16_t)(w.y & 0xffffu); vt[3 * 8192] = (bf16_t)(w.y >> 16);
            vt[4 * 8192] = (bf16_t)(w.z & 0xffffu); vt[5 * 8192] = (bf16_t)(w.z >> 16); vt[6 * 8192] = (bf16_t)(w.w & 0xffffu); vt[7 * 8192] = (bf16_t)(w.w >> 16);
          }
        }
      }
  }
};
struct EpiOut {
  static constexpr bool PERM = true, AFTER_DRAIN = false;
  const float* xin; int first; bf16_t* X; const float* g1; const float* nf; const float* sc2; bf16_t* XG; float* SSQ;
  __device__ __forceinline__ void operator()(const f32x4 (&acc)[2][2][4][2], const pg8::Unit& u, int wr, int wc, int fr, int fq) const {
    const int row0 = u.pm * 256 + wr * 64 + fr, col0 = u.pn * 256 + wc * 32 + 8 * fq, b = (u.pm * 256) >> 13;
    f32x4 gg[2][2], gs[2][2];
#pragma unroll
    for (int bj = 0; bj < 2; ++bj)
#pragma unroll
      for (int n = 0; n < 2; ++n) {
        const int c = col0 + bj * 128 + n * 4;
        gg[bj][n] = *(const f32x4*)(g1 + b * 6144 + c);
        const f32x4 gf = *(const f32x4*)(nf + c), sc = *(const f32x4*)(sc2 + b * 6144 + c);
        gs[bj][n] = gf * (sc + 1.f);
      }
#pragma unroll
    for (int ai = 0; ai < 2; ++ai)
#pragma unroll
      for (int m = 0; m < 4; ++m) {
        const int t = row0 + ai * 128 + m * 16;
        float sq = 0.f;
#pragma unroll
        for (int bj = 0; bj < 2; ++bj) {
          const int c = col0 + bj * 128;
          f32x4 x0, x1;
          if (first) { x0 = *(const f32x4*)(xin + (size_t)t * 1024 + c); x1 = *(const f32x4*)(xin + (size_t)t * 1024 + c + 4); }
          else {
            const pg8::u32x4 xr = *(const pg8::u32x4*)(X + (size_t)t * 1024 + c);
            x0 = (f32x4){__uint_as_float(xr.x << 16), __uint_as_float(xr.x & 0xffff0000u), __uint_as_float(xr.y << 16), __uint_as_float(xr.y & 0xffff0000u)};
            x1 = (f32x4){__uint_as_float(xr.z << 16), __uint_as_float(xr.z & 0xffff0000u), __uint_as_float(xr.w << 16), __uint_as_float(xr.w & 0xffff0000u)};
          }
          const f32x4 n0 = x0 + gg[bj][0] * acc[ai][bj][m][0], n1 = x1 + gg[bj][1] * acc[ai][bj][m][1];
          pg8::u32x4 xo; xo.x = pg8::cvt_pk_bf16(n0.x, n0.y); xo.y = pg8::cvt_pk_bf16(n0.z, n0.w); xo.z = pg8::cvt_pk_bf16(n1.x, n1.y); xo.w = pg8::cvt_pk_bf16(n1.z, n1.w);
          *(pg8::u32x4*)(X + (size_t)t * 1024 + c) = xo;
          const f32x4 s0 = n0 * gs[bj][0], s1 = n1 * gs[bj][1];
          pg8::u32x4 go; go.x = pg8::cvt_pk_bf16(s0.x, s0.y); go.y = pg8::cvt_pk_bf16(s0.z, s0.w); go.z = pg8::cvt_pk_bf16(s1.x, s1.y); go.w = pg8::cvt_pk_bf16(s1.z, s1.w);
          *(pg8::u32x4*)(XG + (size_t)t * 1024 + c) = go;
          sq += ((n0.x * n0.x + n0.y * n0.y) + (n0.z * n0.z + n0.w * n0.w)) + ((n1.x * n1.x + n1.y * n1.y) + (n1.z * n1.z + n1.w * n1.w));
        }
        sq += __shfl_xor(sq, 16); sq += __shfl_xor(sq, 32);
        if (fq == 0) SSQ[(size_t)t * 16 + u.pn * 4 + wc] = sq;
      }
  }
};
struct EpiQ {
  static constexpr bool PERM = true, AFTER_DRAIN = false;
  bf16_t* SC8; const float* SSQ; const float* C2;
  __device__ __forceinline__ void operator()(const f32x4 (&acc)[2][2][4][2], const pg8::Unit& u, int wr, int wc, int fr, int fq) const {
    const int row0 = u.pm * 256 + wr * 64 + fr, col0 = u.pn * 256 + wc * 32 + 8 * fq, b = (u.pm * 256) >> 13;
    f32x4 cc[2][2];
#pragma unroll
    for (int bj = 0; bj < 2; ++bj) { cc[bj][0] = *(const f32x4*)(C2 + b * 2048 + col0 + bj * 128); cc[bj][1] = *(const f32x4*)(C2 + b * 2048 + col0 + bj * 128 + 4); }
#pragma unroll
    for (int ai = 0; ai < 2; ++ai)
#pragma unroll
      for (int m = 0; m < 4; ++m) {
        const int t = row0 + ai * 128 + m * 16;
        const float rstd = rsqrtf(ssq_total(SSQ, t) * (1.f / 1024.f) + EPS_);
#pragma unroll
        for (int bj = 0; bj < 2; ++bj) {
          const f32x4 v0 = acc[ai][bj][m][0] * rstd + cc[bj][0], v1 = acc[ai][bj][m][1] * rstd + cc[bj][1];
          pg8::u32x4 w; w.x = pg8::cvt_pk_bf16(v0[0], v0[1]); w.y = pg8::cvt_pk_bf16(v0[2], v0[3]); w.z = pg8::cvt_pk_bf16(v1[0], v1[1]); w.w = pg8::cvt_pk_bf16(v1[2], v1[3]);
          *(pg8::u32x4*)(SC8 + ((size_t)((col0 + bj * 128) >> 3) * T_ + t) * 8) = w;
        }
      }
  }
};

__device__ void gemm_proj_phase(const Params& p, int l, unsigned char* smem) {
  const CParamsP pp = launder_kargs();
  GAS unsigned char* const ws = launder_ptr(pp->ws);
  pg8::Gemm g; g.A = (const bf16_t*)(ws + WS_ABUF); g.Bt = (const bf16_t*)(ws + WS_WIN) + (size_t)l * INCP * 1024; g.M = T_; g.N = INCP; g.K = 1024;
  pg8::StaticOrder S; S.init(T_, INCP, gridDim.x, blockIdx.x);
  EpiProj E; E.PROJ = (bf16_t*)(ws + WS_PROJ); E.VTA = (bf16_t*)(ws + WS_VTA); E.VTR = (bf16_t*)(ws + WS_VTR);
  pg8::gemm_phase<EpiProj, pg8::StaticOrder>((PG8_LAS unsigned char*)smem, g, S, E);
}
__device__ void gemm_out_phase(const Params& p, int l, unsigned char* smem) {
  const CParamsP pp = launder_kargs();
  GAS unsigned char* const ws = launder_ptr(pp->ws);
  pg8::Gemm g; g.A = (const bf16_t*)(ws + WS_ABUF); g.Bt = (const bf16_t*)(ws + WS_WOUT) + (size_t)l * 1024 * 1024; g.M = T_; g.N = 1024; g.K = 1024;
  pg8::StaticOrder S; S.init(T_, 1024, gridDim.x, blockIdx.x);
  EpiOut E; E.xin = gin(pp->in[I_X]); E.first = (l == 0) ? 1 : 0; E.X = (bf16_t*)(ws + WS_X); E.g1 = (const float*)(ws + WS_MOD) + (size_t)l * 2 * 6144 + 2048;
  E.nf = gin(pp->in[I_NFFN]) + (size_t)l * 1024; E.sc2 = (const float*)(ws + WS_MOD) + (size_t)l * 2 * 6144 + 4096; E.XG = (bf16_t*)(ws + WS_XG); E.SSQ = (float*)(ws + WS_SSQ);
  pg8::gemm_phase<EpiOut, pg8::StaticOrder>((PG8_LAS unsigned char*)smem, g, S, E);
}
__device__ void gemm_q_phase(const Params& p, int l, unsigned char* smem) {
  const CParamsP pp = launder_kargs();
  GAS unsigned char* const ws = launder_ptr(pp->ws);
  pg8::Gemm g; g.A = (const bf16_t*)(ws + WS_XG); g.Bt = (const bf16_t*)(ws + WS_WQ) + (size_t)l * 2048 * 1024; g.M = T_; g.N = 2048; g.K = 1024;
  pg8::StaticOrder S; S.init(T_, 2048, gridDim.x, blockIdx.x);
  EpiQ E; E.SC8 = (bf16_t*)(ws + WS_SC); E.SSQ = (const float*)(ws + WS_SSQ); E.C2 = (const float*)(ws + WS_C2) + (size_t)l * 2 * 2048;
  pg8::gemm_phase<EpiQ, pg8::StaticOrder>((PG8_LAS unsigned char*)smem, g, S, E);
}

__device__ __forceinline__ int attn_fk(int r) { return ((r >> 3) & 3) | (((r >> 1) & 1) << 2); }
__device__ __forceinline__ int attn_fv(int r) { return (r >> 1) & 7; }
__device__ void attn_phase(const Params& p, int l, unsigned char* smem) {
  const CParamsP pp = launder_kargs();
  GAS unsigned char* const ws = launder_ptr(pp->ws); const int tidx = launder_tid();
  const bf16_t* PROJ = (const bf16_t*)(ws + WS_PROJ); const bf16_t* VTA = (const bf16_t*)(ws + WS_VTA);
  bf16_t* ATT = (bf16_t*)(ws + WS_ATT);
  const int lane = tidx & 63, wid = tidx >> 6, fr = lane & 15, fq = lane >> 4;
  float* ext = (float*)smem;
  unsigned char* stg = smem + 15360;
  constexpr float LOG2E = 1.4426950408889634f;
  __syncthreads();
  for (int idx = tidx; idx < 6 * 640; idx += NT) {
    const int h = idx / 640, e = idx - h * 640; int d = e - 63; d = d > 256 ? 256 : d;
    ext[idx] = gin(pp->in[I_RELB])[((size_t)l * 6 + h) * 513 + d + 256] * LOG2E;
  }
  const int hh = wid >> 2, qb = wid & 3, iq = qb * 16 + fr;
  const int srow = tidx >> 3, sch = tidx & 7;
  const int fk_l = attn_fk(8 * (fr >> 2) + (fr & 3)), fv_l = attn_fv(fr);
  const unsigned char* const kb0 = stg + hh * 8192 + (8 * (fr >> 2) + (fr & 3)) * 128 + ((fq ^ fk_l) << 4);
  const unsigned char* const kb1 = stg + hh * 8192 + (8 * (fr >> 2) + (fr & 3)) * 128 + (((4 + fq) ^ fk_l) << 4);
  const unsigned char* const vb0 = stg + 49152 + hh * 8192 + fr * 128 + ((fq ^ fv_l) << 4);
  const unsigned char* const vb1 = stg + 49152 + hh * 8192 + fr * 128 + (((4 + fq) ^ fv_l) << 4);
  const float* const exb = ext + hh * 640 + 63 + 512 + iq - 8 * fq;
  for (int it_ = blockIdx.x; it_ < 256; it_ += gridDim.x) {
    const int item = ((it_ & 7) << 5) | (it_ >> 3);
    const int b = item >> 7, n = item & 127, t0 = b * 8192 + n * 64;
    const int jc0 = n >= 8 ? 0 : 8 - n;
    u32x4v sk[6], sv[6];
#define ATTN_LOAD(jc_) do { const int _m = n - 8 + (jc_); \
      _Pragma("unroll") for (int h = 0; h < 6; ++h) { \
        sk[h] = *(const u32x4v*)(PROJ + (size_t)(b * 8192 + _m * 64 + srow) * INCP + C_KA + h * 64 + sch * 8); \
        sv[h] = *(const u32x4v*)(VTA + ((size_t)b * 384 + h * 64 + srow) * 8192 + _m * 64 + sch * 8); } } while (0)
#define ATTN_WRITE() do { \
      _Pragma("unroll") for (int h = 0; h < 6; ++h) { \
        *(u32x4v*)(stg + h * 8192 + srow * 128 + ((sch ^ attn_fk(srow)) << 4)) = sk[h]; \
        *(u32x4v*)(stg + (6 + h) * 8192 + srow * 128 + ((sch ^ attn_fv(srow)) << 4)) = sv[h]; } } while (0)
    __syncthreads();
    ATTN_LOAD(jc0);
    bf16x8 qf[3][2];
    f32x4 o[3][4];
    float mrun[3], lrun[3];
#pragma unroll
    for (int r = 0; r < 3; ++r) {
#pragma unroll
      for (int ds = 0; ds < 2; ++ds) qf[r][ds] = *(const bf16x8*)(PROJ + (size_t)(t0 + iq) * INCP + C_QA + (2 * r + hh) * 64 + ds * 32 + fq * 8);
#pragma unroll
      for (int et = 0; et < 4; ++et) o[r][et] = (f32x4){0.f, 0.f, 0.f, 0.f};
      mrun[r] = -1e30f; lrun[r] = 0.f;
    }
    ATTN_WRITE();
    __syncthreads();
    auto attn_task = [&](bf16x8 (&qfr)[2], f32x4 (&orr)[4], float& mr, float& lr, const int koff  , const int boff  , const int hcol  , const int jc) {
      float sc[2][2][4];
      bf16x8 kfr[2][2][2], vfr[2][4]; float bia[2][2][4];
#pragma unroll
      for (int g = 0; g < 2; ++g)
#pragma unroll
        for (int tt = 0; tt < 2; ++tt) {
          kfr[g][tt][0] = *(const bf16x8*)(kb0 + koff + 4096 * g + 512 * tt);
          kfr[g][tt][1] = *(const bf16x8*)(kb1 + koff + 4096 * g + 512 * tt);
        }
      const float* exj = exb + boff - 64 * jc;
#pragma unroll
      for (int g = 0; g < 2; ++g)
#pragma unroll
        for (int tt = 0; tt < 2; ++tt)
#pragma unroll
          for (int j = 0; j < 4; ++j) bia[g][tt][j] = exj[-(32 * g + 4 * tt + j)];
      __builtin_amdgcn_sched_barrier(0);
#pragma unroll
      for (int g = 0; g < 2; ++g)
#pragma unroll
        for (int tt = 0; tt < 2; ++tt) {
          f32x4 s4 = __builtin_amdgcn_mfma_f32_16x16x32_bf16(kfr[g][tt][0], qfr[0], (f32x4){0.f, 0.f, 0.f, 0.f}, 0, 0, 0);
          s4 = __builtin_amdgcn_mfma_f32_16x16x32_bf16(kfr[g][tt][1], qfr[1], s4, 0, 0, 0);
#pragma unroll
          for (int j = 0; j < 4; ++j) sc[g][tt][j] = s4[j] * (0.125f * LOG2E) + bia[g][tt][j];
        }
#pragma unroll
      for (int et = 0; et < 4; ++et) { vfr[0][et] = *(const bf16x8*)(vb0 + koff + 2048 * et); vfr[1][et] = *(const bf16x8*)(vb1 + koff + 2048 * et); }
      __builtin_amdgcn_sched_barrier(0);
      float mloc = -1e30f;
#pragma unroll
      for (int g = 0; g < 2; ++g)
#pragma unroll
        for (int tt = 0; tt < 2; ++tt)
#pragma unroll
          for (int j = 0; j < 4; ++j) mloc = fmaxf(mloc, sc[g][tt][j]);
      mloc = fmaxf(mloc, __shfl_xor(mloc, 16)); mloc = fmaxf(mloc, __shfl_xor(mloc, 32));
      const float mnew = fmaxf(mr, mloc), alpha = __builtin_amdgcn_exp2f(mr - mnew);
      mr = mnew;
      float ls = 0.f;
#pragma unroll
      for (int g = 0; g < 2; ++g)
#pragma unroll
        for (int tt = 0; tt < 2; ++tt)
#pragma unroll
          for (int j = 0; j < 4; ++j) { const float e = __builtin_amdgcn_exp2f(sc[g][tt][j] - mnew); sc[g][tt][j] = e; ls += e; }
      lr = lr * alpha + ls;
#pragma unroll
      for (int et = 0; et < 4; ++et) { orr[et].x *= alpha; orr[et].y *= alpha; orr[et].z *= alpha; orr[et].w *= alpha; }
#pragma unroll
      for (int g = 0; g < 2; ++g) {
        union { bf16x8 v; unsigned u[4]; } pf;
        pf.u[0] = pk2(sc[g][0][0], sc[g][0][1]); pf.u[1] = pk2(sc[g][0][2], sc[g][0][3]);
        pf.u[2] = pk2(sc[g][1][0], sc[g][1][1]); pf.u[3] = pk2(sc[g][1][2], sc[g][1][3]);
#pragma unroll
        for (int et = 0; et < 4; ++et) orr[et] = __builtin_amdgcn_mfma_f32_16x16x32_bf16(vfr[g][et], pf.v, orr[et], 0, 0, 0);
      }
      if (jc == 8) {
        float lt = lr + __shfl_xor(lr, 16); lt += __shfl_xor(lt, 32);
        const float inv = 1.f / lt;
#pragma unroll
        for (int et = 0; et < 4; ++et) {
          f32x4 v = orr[et]; v.x *= inv; v.y *= inv; v.z *= inv; v.w *= inv;
          { uint2 ov; ov.x = pk2(v.x, v.y); ov.y = pk2(v.z, v.w); *(uint2*)(ATT + (size_t)(t0 + iq) * 384 + hcol + et * 16 + fq * 4) = ov; }
        }
      }
    };
#pragma unroll 1
    for (int jc = jc0; jc < 9; ++jc) {
      if (jc < 8) ATTN_LOAD(jc + 1);
      attn_task(qf[0], o[0], mrun[0], lrun[0], 0, 0, hh * 64, jc);
      attn_task(qf[1], o[1], mrun[1], lrun[1], 16384, 1280, (2 + hh) * 64, jc);
      attn_task(qf[2], o[2], mrun[2], lrun[2], 32768, 2560, (4 + hh) * 64, jc);
      if (jc < 8) {
        __syncthreads();
        ATTN_WRITE();
        __syncthreads();
      }
    }
#undef ATTN_LOAD
#undef ATTN_WRITE
  }
  __syncthreads();
}

__device__ __forceinline__ void ssm_bu32(const bf16_t* __restrict__ bbh_g, const bf16_t* __restrict__ urow, int lane,
                                         f32x16& lo_re, f32x16& hi_re, f32x16& lo_im, f32x16& hi_im) {
  const int hf = lane >> 5;
  const bf16x8 ub = *(const bf16x8*)(urow + 8 * hf);
  f32x16 z;
#pragma unroll
  for (int r = 0; r < 16; ++r) z[r] = 0.f;
  const bf16x8 a0r = *(const bf16x8*)(bbh_g + (size_t)(0 * 64 + lane) * 8), a1r = *(const bf16x8*)(bbh_g + (size_t)(1 * 64 + lane) * 8);
  const bf16x8 a0i = *(const bf16x8*)(bbh_g + (size_t)(2 * 64 + lane) * 8), a1i = *(const bf16x8*)(bbh_g + (size_t)(3 * 64 + lane) * 8);
  lo_re = __builtin_amdgcn_mfma_f32_32x32x16_bf16(ub, a0r, z, 0, 0, 0); hi_re = __builtin_amdgcn_mfma_f32_32x32x16_bf16(ub, a1r, z, 0, 0, 0);
  lo_im = __builtin_amdgcn_mfma_f32_32x32x16_bf16(ub, a0i, z, 0, 0, 0); hi_im = __builtin_amdgcn_mfma_f32_32x32x16_bf16(ub, a1i, z, 0, 0, 0);
#pragma unroll
  for (int r = 0; r < 16; ++r) {
    const auto s1 = __builtin_amdgcn_permlane32_swap(__float_as_uint(lo_re[r]), __float_as_uint(hi_re[r]), false, false);
    lo_re[r] = __uint_as_float(s1[0]); hi_re[r] = __uint_as_float(s1[1]);
    const auto s2 = __builtin_amdgcn_permlane32_swap(__float_as_uint(lo_im[r]), __float_as_uint(hi_im[r]), false, false);
    lo_im[r] = __uint_as_float(s2[0]); hi_im[r] = __uint_as_float(s2[1]);
  }
}
__device__ __forceinline__ void rotary_frag(const bf16x8 x0, const bf16x8 x1, const float* RC, const float* RS, int pos, int fq, float scale, bf16x8& o0, bf16x8& o1) {
  const f32x4 c0 = *(const f32x4*)(RC + pos * 32 + 8 * fq), c1 = *(const f32x4*)(RC + pos * 32 + 8 * fq + 4);
  const f32x4 s0 = *(const f32x4*)(RS + pos * 32 + 8 * fq), s1 = *(const f32x4*)(RS + pos * 32 + 8 * fq + 4);
  const float cc[8] = {c0.x, c0.y, c0.z, c0.w, c1.x, c1.y, c1.z, c1.w}, sn[8] = {s0.x, s0.y, s0.z, s0.w, s1.x, s1.y, s1.z, s1.w};
  union { bf16x8 v; unsigned u[4]; } r0, r1;
#pragma unroll
  for (int q = 0; q < 4; ++q) {
    const float a0 = bf2f((bf16_t)x0[2 * q]) * scale, a1 = bf2f((bf16_t)x0[2 * q + 1]) * scale, b0 = bf2f((bf16_t)x1[2 * q]) * scale, b1 = bf2f((bf16_t)x1[2 * q + 1]) * scale;
    r0.u[q] = pk2(a0 * cc[2 * q] - b0 * sn[2 * q], a1 * cc[2 * q + 1] - b1 * sn[2 * q + 1]);
    r1.u[q] = pk2(a0 * sn[2 * q] + b0 * cc[2 * q], a1 * sn[2 * q + 1] + b1 * cc[2 * q + 1]);
  }
  o0 = r0.v; o1 = r1.v;
}
__device__ void mix_local_phase(const Params& p, int l, unsigned char* smem) {
  const CParamsP pp = launder_kargs();
  GAS unsigned char* const ws = launder_ptr(pp->ws); const int tidx = launder_tid();
  const bf16_t* PROJ = (const bf16_t*)(ws + WS_PROJ); const bf16_t* VTR = (const bf16_t*)(ws + WS_VTR);
  const float* RC = (const float*)(ws + WS_ROTC); const float* RS = (const float*)(ws + WS_ROTS);
  bf16_t* YINT = (bf16_t*)(ws + WS_YINT); float* UPDT = (float*)(ws + WS_UPD);
  const float* SA = (const float*)(ws + WS_SA) + (size_t)l * 16 * 64 * 2; const bf16_t* BBH = (const bf16_t*)(ws + WS_BBH) + (size_t)l * 16 * 2 * 64 * 16;
  float* SEND = (float*)(ws + WS_SEND);
  const int tid = tidx, lane = tid & 63, wid = tid >> 6, fr = lane & 15, fq = lane >> 4;
  bf16_t* KT = (bf16_t*)smem;
  float* rcL = (float*)(smem + 55296); float* rsL = rcL + 2048;
  for (int it_ = blockIdx.x; it_ < 256; it_ += gridDim.x) {
    const int item = ((it_ & 7) << 5) | (it_ >> 3);
    const int b = item >> 7, n = item & 127, t0 = b * 8192 + n * 64;
    __syncthreads();
#pragma unroll
    for (int i = 0; i < 4; ++i) { rcL[tid + NT * i] = RC[n * 2048 + tid + NT * i]; rsL[tid + NT * i] = RS[n * 2048 + tid + NT * i]; }
    __syncthreads();
#pragma unroll 1
    for (int k3 = 0; k3 < 3; ++k3) {
      const int task = wid * 3 + k3, h = task >> 2, tb = task & 3;
      const int i = 16 * tb + fr;
      const float lg2 = log2f(1.f - exp2f(-5.f - (float)h));
      bf16x8 qraw[2], kraw[2][2][2], vraw[2][4];
      {
        const bf16_t* qp = PROJ + (size_t)(t0 + i) * INCP + C_QR + h * 64 + 8 * fq;
        qraw[0] = *(const bf16x8*)qp; qraw[1] = *(const bf16x8*)(qp + 32);
#pragma unroll
        for (int g = 0; g < 2; ++g) {
#pragma unroll
          for (int tt = 0; tt < 2; ++tt) {
            const int key = 32 * g + 8 * (fr >> 2) + (fr & 3) + 4 * tt;
            const bf16_t* kp = PROJ + (size_t)(t0 + key) * INCP + C_KR + h * 64 + 8 * fq;
            kraw[g][tt][0] = *(const bf16x8*)kp; kraw[g][tt][1] = *(const bf16x8*)(kp + 32);
          }
#pragma unroll
          for (int et = 0; et < 4; ++et) vraw[g][et] = *(const bf16x8*)(VTR + ((size_t)b * 384 + h * 64 + et * 16 + fr) * 8192 + n * 64 + 32 * g + 8 * fq);
        }
      }
      __builtin_amdgcn_sched_barrier(0);
      bf16x8 qf0, qf1;
      rotary_frag(qraw[0], qraw[1], rcL, rsL, i, fq, 1.f, qf0, qf1);
      f32x4 o[4];
#pragma unroll
      for (int et = 0; et < 4; ++et) o[et] = (f32x4){0.f, 0.f, 0.f, 0.f};
#pragma unroll
      for (int g = 0; g < 2; ++g) {
        float st[2][4];
#pragma unroll
        for (int tt = 0; tt < 2; ++tt) {
          const int key = 32 * g + 8 * (fr >> 2) + (fr & 3) + 4 * tt;
          bf16x8 kf0, kf1;
          rotary_frag(kraw[g][tt][0], kraw[g][tt][1], rcL, rsL, key, fq, 0.125f, kf0, kf1);
          f32x4 s4 = __builtin_amdgcn_mfma_f32_16x16x32_bf16(kf0, qf0, (f32x4){0.f, 0.f, 0.f, 0.f}, 0, 0, 0);
          s4 = __builtin_amdgcn_mfma_f32_16x16x32_bf16(kf1, qf1, s4, 0, 0, 0);
#pragma unroll
          for (int j = 0; j < 4; ++j) {
            const int kk = 32 * g + 8 * fq + 4 * tt + j;
            const int dij = i > kk ? i - kk : kk - i;
            st[tt][j] = s4[j] * exp2f(lg2 * (float)dij);
          }
          if (tb == 0) {
            const float kd = exp2f(lg2 * (float)(63 - key));
#pragma unroll
            for (int jj = 0; jj < 8; ++jj) {
              KT[(h * 64 + 8 * fq + jj) * 72 + key] = f2bf(bf2f((bf16_t)kf0[jj]) * kd);
              KT[(h * 64 + 32 + 8 * fq + jj) * 72 + key] = f2bf(bf2f((bf16_t)kf1[jj]) * kd);
            }
          }
        }
        union { bf16x8 v; unsigned u[4]; } pf;
        pf.u[0] = pk2(st[0][0], st[0][1]); pf.u[1] = pk2(st[0][2], st[0][3]); pf.u[2] = pk2(st[1][0], st[1][1]); pf.u[3] = pk2(st[1][2], st[1][3]);
#pragma unroll
        for (int et = 0; et < 4; ++et) o[et] = __builtin_amdgcn_mfma_f32_16x16x32_bf16(vraw[g][et], pf.v, o[et], 0, 0, 0);
      }
#pragma unroll
      for (int et = 0; et < 4; ++et) { uint2 ov; ov.x = pk2(o[et].x, o[et].y); ov.y = pk2(o[et].z, o[et].w); *(uint2*)(YINT + (((((size_t)item * 6 + h) * 4 + tb) * 4 + et) * 64 + lane) * 4) = ov; }
    }
    __syncthreads();
#pragma unroll 1
    for (int k3 = 0; k3 < 3; ++k3) {
      const int task = wid * 3 + k3, h = task >> 2, et = task & 3;
      f32x4 acc[4];
#pragma unroll
      for (int dt = 0; dt < 4; ++dt) acc[dt] = (f32x4){0.f, 0.f, 0.f, 0.f};
#pragma unroll
      for (int g = 0; g < 2; ++g) {
        const bf16x8 vf = *(const bf16x8*)(VTR + ((size_t)b * 384 + h * 64 + et * 16 + fr) * 8192 + n * 64 + 32 * g + 8 * fq);
#pragma unroll
        for (int dt = 0; dt < 4; ++dt) {
          const bf16x8 kt = *(const bf16x8*)(KT + (h * 64 + 16 * dt + fr) * 72 + 32 * g + 8 * fq);
          acc[dt] = __builtin_amdgcn_mfma_f32_16x16x32_bf16(kt, vf, acc[dt], 0, 0, 0);
        }
      }
#pragma unroll
      for (int dt = 0; dt < 4; ++dt) *(f32x4*)(UPDT + (((size_t)item * 6 + h) * 64 + 16 * et + fr) * 64 + 16 * dt + 4 * fq) = acc[dt];
    }
#pragma unroll 1
    for (int gi = 0; gi < 2; ++gi) {
      const int g = wid * 2 + gi;
      const float are = SA[(g * 64 + lane) * 2], aim = SA[(g * 64 + lane) * 2 + 1];
      float xr = 0.f, xi = 0.f;
#pragma unroll 1
      for (int blk = 0; blk < 2; ++blk) {
        f32x16 lr, hr, li, hi;
        ssm_bu32(BBH + (size_t)g * 2 * 64 * 16, PROJ + (size_t)(t0 + 32 * blk + (lane & 31)) * INCP + C_US + g * 16, lane, lr, hr, li, hi);
#pragma unroll
        for (int a4 = 0; a4 < 4; ++a4) {
#pragma unroll
          for (int bq = 0; bq < 4; ++bq) { const float nr = are * xr - aim * xi + lr[4 * a4 + bq], ni = are * xi + aim * xr + li[4 * a4 + bq]; xr = nr; xi = ni; }
#pragma unroll
          for (int bq = 0; bq < 4; ++bq) { const float nr = are * xr - aim * xi + hr[4 * a4 + bq], ni = are * xi + aim * xr + hi[4 * a4 + bq]; xr = nr; xi = ni; }
        }
      }
      SEND[(((size_t)item * 16 + g) * 64 + lane) * 2] = xr; SEND[(((size_t)item * 16 + g) * 64 + lane) * 2 + 1] = xi;
    }
  }
}

__device__ void scan_phase(const Params& p, int l) {
  const CParamsP pp = launder_kargs();
  GAS unsigned char* const ws = launder_ptr(pp->ws); const int tidx = launder_tid();
  const float* __restrict__ UPDT = (const float*)(ws + WS_UPD); bf16_t* __restrict__ SPT = (bf16_t*)(ws + WS_SPT);
  const float* __restrict__ SEND = (const float*)(ws + WS_SEND); float* __restrict__ CARRY = (float*)(ws + WS_CARRY);
  const float* SA = (const float*)(ws + WS_SA) + (size_t)l * 16 * 64 * 2;
  const int gtid = blockIdx.x * NT + tidx, gn = gridDim.x * NT;
  for (int idx = gtid; idx < 2 * 6 * 4096 + 2 * 1024; idx += gn) {
    if (idx < 2 * 6 * 4096) {
      const int b = idx / (6 * 4096), r = idx % (6 * 4096), h = r >> 12;
      const float cd = exp2f(64.f * log2f(1.f - exp2f(-5.f - (float)h)));
      const int e_ = (r >> 6) & 63, d_ = r & 63;
      const int spoff = h * 4096 + ((((e_ >> 4) * 2 + (d_ >> 5)) * 64 + ((d_ >> 3) & 3) * 16 + (e_ & 15)) * 8 + (d_ & 7));
      float s = 0.f;
      float v[16], vn[16];
#pragma unroll
      for (int j = 0; j < 16; ++j) v[j] = UPDT[((size_t)(b * NCH + j)) * 6 * 4096 + r];
#pragma unroll 1
      for (int nb = 0; nb < NCH; nb += 16) {
        const int nbn = nb + 16 < NCH ? nb + 16 : nb;
#pragma unroll
        for (int j = 0; j < 16; ++j) vn[j] = UPDT[((size_t)(b * NCH + nbn + j)) * 6 * 4096 + r];
        __builtin_amdgcn_sched_barrier(0);
#pragma unroll
        for (int j = 0; j < 16; ++j) { SPT[((size_t)(b * NCH + nb + j)) * 6 * 4096 + spoff] = f2bf(s); s = cd * s + v[j]; }
#pragma unroll
        for (int j = 0; j < 16; ++j) v[j] = vn[j];
      }
    } else {
      const int r2 = idx - 2 * 6 * 4096, b = r2 >> 10, gp = r2 & 1023;
      float ar = SA[gp * 2], ai = SA[gp * 2 + 1];
#pragma unroll
      for (int q = 0; q < 6; ++q) { const float nr = ar * ar - ai * ai, ni = 2.f * ar * ai; ar = nr; ai = ni; }
      float xr = 0.f, xi = 0.f;
      f32x2 v[16], vn[16];
#pragma unroll
      for (int j = 0; j < 16; ++j) v[j] = *(const f32x2*)(SEND + (((size_t)(b * NCH + j)) * 1024 + gp) * 2);
#pragma unroll 1
      for (int nb = 0; nb < NCH; nb += 16) {
        const int nbn = nb + 16 < NCH ? nb + 16 : nb;
#pragma unroll
        for (int j = 0; j < 16; ++j) vn[j] = *(const f32x2*)(SEND + (((size_t)(b * NCH + nbn + j)) * 1024 + gp) * 2);
        __builtin_amdgcn_sched_barrier(0);
#pragma unroll
        for (int j = 0; j < 16; ++j) {
          *(f32x2*)(CARRY + (((size_t)(b * NCH + nb + j)) * 1024 + gp) * 2) = (f32x2){xr, xi};
          const float nr = ar * xr - ai * xi + v[j].x, ni = ar * xi + ai * xr + v[j].y;
          xr = nr; xi = ni;
        }
#pragma unroll
        for (int j = 0; j < 16; ++j) v[j] = vn[j];
      }
    }
  }
  if (l + 1 < DEPTH_) convert_tables_fp4(pp, ws, l + 1, gtid, gn);
}

__device__ void mix_final_phase(const Params& p, int l, unsigned char* smem) {
  const CParamsP pp = launder_kargs();
  GAS unsigned char* const ws = launder_ptr(pp->ws); const int tidx = launder_tid();
  const bf16_t* PROJ = (const bf16_t*)(ws + WS_PROJ);
  const float* RC = (const float*)(ws + WS_ROTC); const float* RS = (const float*)(ws + WS_ROTS);
  const bf16_t* YINT = (const bf16_t*)(ws + WS_YINT); const bf16_t* SPT = (const bf16_t*)(ws + WS_SPT);
  const bf16_t* ATT = (const bf16_t*)(ws + WS_ATT);
  const float* SA = (const float*)(ws + WS_SA) + (size_t)l * 16 * 64 * 2; const bf16_t* BBH = (const bf16_t*)(ws + WS_BBH) + (size_t)l * 16 * 2 * 64 * 16;
  const float* CARRY = (const float*)(ws + WS_CARRY);
  const bf16_t* CB = (const bf16_t*)(ws + WS_CB) + (size_t)l * 16 * 16 * 128; const bf16_t* WG = (const bf16_t*)(ws + WS_WGLUT) + (size_t)l * 512 * 256;
  const float* dsk = gin(pp->in[I_SSMD]) + (size_t)l * 256;
  const float* mg = gin(pp->in[I_MGAIN]) + (size_t)l * 1024;
  bf16_t* MRG = (bf16_t*)(ws + WS_ABUF);
  const int tid = tidx, lane = tid & 63, wid = tid >> 6, fr = lane & 15, fq = lane >> 4;
  bf16_t* YS = (bf16_t*)smem;
  float* red = (float*)(smem + 33792);
  bf16_t* XB = (bf16_t*)(smem + 36864 + wid * 8448 + 4096);
  float* rcL = (float*)(smem + 104448); float* rsL = rcL + 2048;
  for (int it_ = blockIdx.x; it_ < 256; it_ += gridDim.x) {
    const int item = ((it_ & 7) << 5) | (it_ >> 3);
    const int b = item >> 7, n = item & 127, t0 = b * 8192 + n * 64;
    __syncthreads();
#pragma unroll
    for (int i = 0; i < 4; ++i) { rcL[tid + NT * i] = RC[n * 2048 + tid + NT * i]; rsL[tid + NT * i] = RS[n * 2048 + tid + NT * i]; }
    __syncthreads();
    {
      float av[8][6], mgl[6];
#pragma unroll
      for (int ii = 0; ii < 8; ++ii)
#pragma unroll
        for (int j = 0; j < 6; ++j) av[ii][j] = bf2f(ATT[(size_t)(t0 + wid * 8 + ii) * 384 + lane + 64 * j]);
#pragma unroll
      for (int j = 0; j < 6; ++j) mgl[j] = mg[lane + 64 * j];
      __builtin_amdgcn_sched_barrier(0);
#pragma unroll
      for (int ii = 0; ii < 8; ++ii) {
        const int t = t0 + wid * 8 + ii;
        float sq = 0.f;
#pragma unroll
        for (int j = 0; j < 6; ++j) sq += av[ii][j] * av[ii][j];
        const float rstd = rsqrtf(wave_sum(sq) * (1.f / 384.f) + EPS_);
#pragma unroll
        for (int j = 0; j < 6; ++j) MRG[(size_t)t * 1024 + lane + 64 * j] = f2bf(av[ii][j] * rstd * mgl[j]);
      }
    }
#pragma unroll 1
    for (int k3 = 0; k3 < 3; ++k3) {
      const int task = wid * 3 + k3, h = task >> 2, tb = task & 3;
      const int i = 16 * tb + fr, t = t0 + i;
      const float lg2 = log2f(1.f - exp2f(-5.f - (float)h));
      bf16x8 qraw[2], spf[4][2]; f32x4 yiv[4], mgq[4]; uint2 grv[4];
      {
        const bf16_t* qp = PROJ + (size_t)t * INCP + C_QR + h * 64 + 8 * fq;
        qraw[0] = *(const bf16x8*)qp; qraw[1] = *(const bf16x8*)(qp + 32);
#pragma unroll
        for (int et = 0; et < 4; ++et) {
          const bf16_t* sp = SPT + ((size_t)item * 6 + h) * 4096 + (size_t)(et * 2) * 512 + lane * 8;
          spf[et][0] = *(const bf16x8*)sp; spf[et][1] = *(const bf16x8*)(sp + 512);
          { const uint2 yr = *(const uint2*)(YINT + (((((size_t)item * 6 + h) * 4 + tb) * 4 + et) * 64 + lane) * 4); yiv[et] = (f32x4){__uint_as_float(yr.x << 16), __uint_as_float(yr.x & 0xffff0000u), __uint_as_float(yr.y << 16), __uint_as_float(yr.y & 0xffff0000u)}; }
          grv[et] = *(const uint2*)(PROJ + (size_t)t * INCP + C_GR + h * 64 + 16 * et + 4 * fq);
          mgq[et] = *(const f32x4*)(mg + 384 + h * 64 + 16 * et + 4 * fq);
        }
      }
      __builtin_amdgcn_sched_barrier(0);
      bf16x8 qf0, qf1;
      rotary_frag(qraw[0], qraw[1], rcL, rsL, i, fq, 1.f, qf0, qf1);
      f32x4 o[4];
#pragma unroll
      for (int et = 0; et < 4; ++et) {
        o[et] = __builtin_amdgcn_mfma_f32_16x16x32_bf16(spf[et][0], qf0, (f32x4){0.f, 0.f, 0.f, 0.f}, 0, 0, 0);
        o[et] = __builtin_amdgcn_mfma_f32_16x16x32_bf16(spf[et][1], qf1, o[et], 0, 0, 0);
      }
      const float qd = exp2f(lg2 * (float)(i + 1));
      float y[16]; float s1 = 0.f;
#pragma unroll
      for (int et = 0; et < 4; ++et) {
        const f32x4 yi = yiv[et];
        y[4 * et] = yi.x + qd * o[et].x; y[4 * et + 1] = yi.y + qd * o[et].y; y[4 * et + 2] = yi.z + qd * o[et].z; y[4 * et + 3] = yi.w + qd * o[et].w;
        s1 += (y[4 * et] + y[4 * et + 1]) + (y[4 * et + 2] + y[4 * et + 3]);
      }
      s1 += __shfl_xor(s1, 16); s1 += __shfl_xor(s1, 32);
      const float mu = s1 * (1.f / 64.f);
      float s2 = 0.f;
#pragma unroll
      for (int q = 0; q < 16; ++q) { y[q] -= mu; s2 += y[q] * y[q]; }
      s2 += __shfl_xor(s2, 16); s2 += __shfl_xor(s2, 32);
      const float rstd = rsqrtf(s2 * (1.f / 64.f) + EPS_);
#pragma unroll
      for (int et = 0; et < 4; ++et) {
        const int c = h * 64 + 16 * et + 4 * fq;
        const uint2 gr = grv[et];
        const float g0 = __uint_as_float(gr.x << 16), g1 = __uint_as_float(gr.x & 0xffff0000u), g2 = __uint_as_float(gr.y << 16), g3 = __uint_as_float(gr.y & 0xffff0000u);
        const f32x4 mgv = mgq[et];
        uint2 ov;
        ov.x = pk2(y[4 * et] * rstd * (g0 * sigmoid_f(g0)) * mgv.x, y[4 * et + 1] * rstd * (g1 * sigmoid_f(g1)) * mgv.y);
        ov.y = pk2(y[4 * et + 2] * rstd * (g2 * sigmoid_f(g2)) * mgv.z, y[4 * et + 3] * rstd * (g3 * sigmoid_f(g3)) * mgv.w);
        *(uint2*)(MRG + (size_t)t * 1024 + 384 + c) = ov;
      }
    }
#pragma unroll 1
    for (int gi = 0; gi < 2; ++gi) {
      const int g = wid * 2 + gi;
      const float are = SA[(g * 64 + lane) * 2], aim = SA[(g * 64 + lane) * 2 + 1];
      float xr = CARRY[(((size_t)item * 16 + g) * 64 + lane) * 2], xi = CARRY[(((size_t)item * 16 + g) * 64 + lane) * 2 + 1];
      bf16x8 cb[4];
#pragma unroll
      for (int ks = 0; ks < 4; ++ks) cb[ks] = *(const bf16x8*)(CB + (((size_t)g * 4 + ks) * 64 + lane) * 8);
      const float dv = dsk[g * 16 + fr];
#pragma unroll 1
      for (int blk = 0; blk < 2; ++blk) {
        f32x16 lr, hr, li, hi;
        bf16_t uraw[2][4];
#pragma unroll
        for (int half = 0; half < 2; ++half)
#pragma unroll
          for (int j = 0; j < 4; ++j) uraw[half][j] = PROJ[(size_t)(t0 + 32 * blk + 16 * half + 4 * fq + j) * INCP + C_US + g * 16 + fr];
        ssm_bu32(BBH + (size_t)g * 2 * 64 * 16, PROJ + (size_t)(t0 + 32 * blk + (lane & 31)) * INCP + C_US + g * 16, lane, lr, hr, li, hi);
#pragma unroll
        for (int half = 0; half < 2; ++half) {
#pragma unroll
          for (int a2 = 0; a2 < 2; ++a2) {
            const int a4 = 2 * half + a2;
#pragma unroll
            for (int bq = 0; bq < 4; ++bq) {
              const float nr = are * xr - aim * xi + lr[4 * a4 + bq], ni = are * xi + aim * xr + li[4 * a4 + bq]; xr = nr; xi = ni;
              XB[(8 * a2 + bq) * 136 + lane] = f2bf(xr); XB[(8 * a2 + bq) * 136 + 64 + lane] = f2bf(xi);
            }
#pragma unroll
            for (int bq = 0; bq < 4; ++bq) {
              const float nr = are * xr - aim * xi + hr[4 * a4 + bq], ni = are * xi + aim * xr + hi[4 * a4 + bq]; xr = nr; xi = ni;
              XB[(8 * a2 + 4 + bq) * 136 + lane] = f2bf(xr); XB[(8 * a2 + 4 + bq) * 136 + 64 + lane] = f2bf(xi);
            }
          }
          f32x4 acc = (f32x4){0.f, 0.f, 0.f, 0.f};
#pragma unroll
          for (int ks = 0; ks < 4; ++ks) {
            const bf16x8 af = *(const bf16x8*)(XB + fr * 136 + 32 * ks + 8 * fq);
            acc = __builtin_amdgcn_mfma_f32_16x16x32_bf16(af, cb[ks], acc, 0, 0, 0);
          }
#pragma unroll
          for (int j = 0; j < 4; ++j) {
            const int i = 32 * blk + 16 * half + 4 * fq + j;
            const float yv = acc[j] + dv * bf2f(uraw[half][j]);
            YS[i * 264 + g * 16 + fr] = f2bf(gelu_tanh(yv));
          }
        }
      }
    }
    __syncthreads();
    {
      const int n0 = 32 * wid;
      f32x4 a1[4][2], a2[4][2];
#pragma unroll
      for (int mt = 0; mt < 4; ++mt)
#pragma unroll
        for (int nt = 0; nt < 2; ++nt) { a1[mt][nt] = (f32x4){0.f, 0.f, 0.f, 0.f}; a2[mt][nt] = (f32x4){0.f, 0.f, 0.f, 0.f}; }
#pragma unroll 1
      for (int kh = 0; kh < 2; ++kh) {
        bf16x8 w1[4][2], w2[4][2];
#pragma unroll
        for (int k4 = 0; k4 < 4; ++k4)
#pragma unroll
          for (int nt = 0; nt < 2; ++nt) {
            w1[k4][nt] = *(const bf16x8*)(WG + ((((size_t)wid * 8 + 4 * kh + k4) * 2 + 0) * 2 + nt) * 512 + lane * 8);
            w2[k4][nt] = *(const bf16x8*)(WG + ((((size_t)wid * 8 + 4 * kh + k4) * 2 + 1) * 2 + nt) * 512 + lane * 8);
          }
        __builtin_amdgcn_sched_barrier(0);
#pragma unroll
        for (int k4 = 0; k4 < 4; ++k4) {
          const int ks = 4 * kh + k4;
          bf16x8 yb[4];
#pragma unroll
          for (int mt = 0; mt < 4; ++mt) yb[mt] = *(const bf16x8*)(YS + (16 * mt + fr) * 264 + 32 * ks + 8 * fq);
#pragma unroll
          for (int mt = 0; mt < 4; ++mt)
#pragma unroll
            for (int nt = 0; nt < 2; ++nt) {
              a1[mt][nt] = __builtin_amdgcn_mfma_f32_16x16x32_bf16(w1[k4][nt], yb[mt], a1[mt][nt], 0, 0, 0);
              a2[mt][nt] = __builtin_amdgcn_mfma_f32_16x16x32_bf16(w2[k4][nt], yb[mt], a2[mt][nt], 0, 0, 0);
            }
        }
      }
#pragma unroll
      for (int mt = 0; mt < 4; ++mt) {
        float sq = 0.f;
#pragma unroll
        for (int nt = 0; nt < 2; ++nt) {
          f32x4 z = a1[mt][nt]; const f32x4 zg = a2[mt][nt];
          z.x *= sigmoid_f(zg.x); z.y *= sigmoid_f(zg.y); z.z *= sigmoid_f(zg.z); z.w *= sigmoid_f(zg.w);
          a1[mt][nt] = z; sq += z.x * z.x + z.y * z.y + z.z * z.z + z.w * z.w;
        }
        sq += __shfl_xor(sq, 16); sq += __shfl_xor(sq, 32);
        if (fq == 0) red[wid * 64 + 16 * mt + fr] = sq;
      }
      __syncthreads();
#pragma unroll
      for (int mt = 0; mt < 4; ++mt) {
        const int i = 16 * mt + fr, t = t0 + i;
        float tot = 0.f;
#pragma unroll
        for (int w8 = 0; w8 < 8; ++w8) tot += red[w8 * 64 + i];
        const float rstd = rsqrtf(tot * (1.f / 256.f) + EPS_);
#pragma unroll
        for (int nt = 0; nt < 2; ++nt) {
          const int c = n0 + 16 * nt + 4 * fq;
          const f32x4 mgv = *(const f32x4*)(mg + 768 + c); const f32x4 z = a1[mt][nt];
          uint2 ov; ov.x = pk2(z.x * rstd * mgv.x, z.y * rstd * mgv.y); ov.y = pk2(z.z * rstd * mgv.z, z.w * rstd * mgv.w);
          *(uint2*)(MRG + (size_t)t * 1024 + 768 + c) = ov;
        }
      }
    }
  }
}

__device__ __forceinline__ float dot16_fp4(const uint2 u, const f32x2 (&hv)[8]) {
  f32x2 d = __builtin_amdgcn_cvt_scalef32_pk_f32_fp4(u.x, 1.0f, 0) * hv[0];
  d += __builtin_amdgcn_cvt_scalef32_pk_f32_fp4(u.x, 1.0f, 1) * hv[1];
  d += __builtin_amdgcn_cvt_scalef32_pk_f32_fp4(u.x, 1.0f, 2) * hv[2];
  d += __builtin_amdgcn_cvt_scalef32_pk_f32_fp4(u.x, 1.0f, 3) * hv[3];
  d += __builtin_amdgcn_cvt_scalef32_pk_f32_fp4(u.y, 1.0f, 0) * hv[4];
  d += __builtin_amdgcn_cvt_scalef32_pk_f32_fp4(u.y, 1.0f, 1) * hv[5];
  d += __builtin_amdgcn_cvt_scalef32_pk_f32_fp4(u.y, 1.0f, 2) * hv[6];
  d += __builtin_amdgcn_cvt_scalef32_pk_f32_fp4(u.y, 1.0f, 3) * hv[7];
  return d.x + d.y;
}
__device__ __forceinline__ void axpy16_fp4(const uint2 v, const float w, f32x2 (&acc)[8]) {
  const f32x2 w2 = (f32x2){w, w};
  acc[0] += w2 * __builtin_amdgcn_cvt_scalef32_pk_f32_fp4(v.x, 1.0f, 0);
  acc[1] += w2 * __builtin_amdgcn_cvt_scalef32_pk_f32_fp4(v.x, 1.0f, 1);
  acc[2] += w2 * __builtin_amdgcn_cvt_scalef32_pk_f32_fp4(v.x, 1.0f, 2);
  acc[3] += w2 * __builtin_amdgcn_cvt_scalef32_pk_f32_fp4(v.x, 1.0f, 3);
  acc[4] += w2 * __builtin_amdgcn_cvt_scalef32_pk_f32_fp4(v.y, 1.0f, 0);
  acc[5] += w2 * __builtin_amdgcn_cvt_scalef32_pk_f32_fp4(v.y, 1.0f, 1);
  acc[6] += w2 * __builtin_amdgcn_cvt_scalef32_pk_f32_fp4(v.y, 1.0f, 2);
  acc[7] += w2 * __builtin_amdgcn_cvt_scalef32_pk_f32_fp4(v.y, 1.0f, 3);
}
__device__ __forceinline__ float vmaxf(float a, float b) { float r; asm("v_max_f32 %0, %1, %2" : "=v"(r) : "v"(a), "v"(b)); return r; }
__device__ __forceinline__ float vminf(float a, float b) { float r; asm("v_min_f32 %0, %1, %2" : "=v"(r) : "v"(a), "v"(b)); return r; }
__device__ __forceinline__ void cx(float& hi, float& lo) { const float a = hi, b = lo; hi = vmaxf(a, b); lo = vminf(a, b); }
__device__ __forceinline__ void cx2(float& kh, int& ph, float& kl, int& pl) {
  const float a = kh, b = kl; const int pa = ph, pb = pl; const bool c = a >= b;
  kh = vmaxf(a, b); kl = vminf(a, b); ph = c ? pa : pb; pl = c ? pb : pa;
}
__device__ __forceinline__ void bitonic_sort16_desc(float (&v)[16]) {
#pragma unroll
  for (int k = 2; k <= 16; k <<= 1)
#pragma unroll
    for (int j = k >> 1; j > 0; j >>= 1)
#pragma unroll
      for (int i = 0; i < 16; ++i) {
        const int l = i ^ j;
        if (l > i) { if ((i & k) == 0) cx(v[i], v[l]); else cx(v[l], v[i]); }
      }
}
__device__ __forceinline__ void bitonic_merge16_desc(float (&v)[16]) {
#pragma unroll
  for (int j = 8; j > 0; j >>= 1)
#pragma unroll
    for (int i = 0; i < 16; ++i) { const int l = i ^ j; if (l > i) cx(v[i], v[l]); }
}
__device__ __forceinline__ void top16_merge(float (&a)[16], const float (&b)[16]) {
#pragma unroll
  for (int i = 0; i < 16; ++i) a[i] = vmaxf(a[i], b[15 - i]);
  bitonic_merge16_desc(a);
}
template <int M> __device__ __forceinline__ void top16_merge_chain(float (&k)[16], int (&q)[16], const float (&xk)[M], const int (&xq)[M]) {
#pragma unroll
  for (int i = 16 - M; i < 16; ++i) { const float a = k[i], b = xk[15 - i]; const bool c = a >= b; k[i] = vmaxf(a, b); q[i] = c ? q[i] : xq[15 - i]; }
#pragma unroll
  for (int j = 8; j > 0; j >>= 1)
#pragma unroll
    for (int i = 0; i < 16; ++i) { const int l = i ^ j; if (l > i) cx2(k[i], q[i], k[l], q[l]); }
}

__device__ __forceinline__ void peer_req_rows16(u32x4v (&Q)[8], const unsigned char* tab, int e, int hi5, unsigned lane16) {
#pragma unroll
  for (int r = 0; r < 8; ++r) {
    const int ea = __builtin_amdgcn_readlane(e, 2 * r), eb = __builtin_amdgcn_readlane(e, 2 * r + 1);
    const unsigned off = (unsigned)(hi5 ? eb : ea) * 512u + lane16;
    Q[r] = *(const u32x4v*)(tab + off);
  }
}
__device__ __forceinline__ void peer_req_rows8(u32x4v (&Q)[8], const unsigned char* tab, int e, unsigned lane8) {
#pragma unroll
  for (int r = 0; r < 16; ++r) {
    const unsigned off = (unsigned)__builtin_amdgcn_readlane(e, r) * 512u + lane8;
    const uint2 t = *(const uint2*)(tab + off);
    Q[r >> 1][2 * (r & 1)] = t.x; Q[r >> 1][2 * (r & 1) + 1] = t.y;
  }
}
__device__ void peer_phase(const Params& p, int l, bool last, unsigned char* smem) {
  const CParamsP pp = launder_kargs();
  GAS unsigned char* const ws = launder_ptr(pp->ws); const int tidx = launder_tid();
  bf16_t* HF = (bf16_t*)(ws + WS_ABUF); bf16_t* X = (bf16_t*)(ws + WS_X);
  const bf16_t* SC8 = (const bf16_t*)(ws + WS_SC);
  const uint2* U4 = (const uint2*)(ws + WS_PU8) + (size_t)l * 16384 * 64; const uint2* V4 = (const uint2*)(ws + WS_PV8) + (size_t)l * 16384 * 64;
  const float* g2 = (const float*)(ws + WS_MOD) + (size_t)l * 2 * 6144 + 5120;
  const bf16_t* XG = (const bf16_t*)(ws + WS_XG); const float* SSQ = (const float*)(ws + WS_SSQ); const float* sh2 = (const float*)(ws + WS_MOD) + (size_t)l * 2 * 6144 + 3072;
  const int ln = last ? l : l + 1;
  const float* nsh = (const float*)(ws + WS_MOD) + (size_t)ln * 2 * 6144; const float* nsc = nsh + 1024;
  const float* ngain = gin(pp->in[I_NMIX]) + (size_t)ln * 1024;
  const int lane = tidx & 63, wid = tidx >> 6;
  const int rL = ((lane >> 5) & 1) * 8 + ((lane >> 4) & 1) * 4 + ((lane >> 3) & 1) * 2 + ((lane >> 2) & 1);
  const bool hi5 = (lane & 32) != 0, hi4 = (lane & 16) != 0, hi3 = (lane & 8) != 0, hi2 = (lane & 4) != 0;
  int* idxL = (int*)smem;
  float* cst = (float*)(smem + 109568);
  for (int it_ = blockIdx.x; it_ < T_ / 64; it_ += gridDim.x) {
    const int item = ((it_ & 7) << 5) | (it_ >> 3);
    const int t0 = item * 64;
    __syncthreads();
    {
      const int bb = t0 >> 13;
      for (int c = tidx; c < 1024; c += NT) {
        const int o = ((c >> 2) & 3) * 256 + (c >> 4) * 4 + (c & 3);
        cst[o] = g2[bb * 6144 + c] * 0.25f;
        cst[1024 + o] = last ? gin(pp->in[I_FNORM])[c] : ngain[c] * (1.f + nsc[bb * 6144 + c]);
        cst[2048 + o] = last ? 0.f : nsh[bb * 6144 + c];
        cst[3072 + o] = sh2[bb * 6144 + c];
      }
    }
    {
      int lane_o = lane; asm volatile("" : "+v"(lane_o));
      const int tg = wid & 1, hp = wid >> 1, hf = lane_o >> 5, tl = 32 * tg + (lane_o & 31);
      float F[2][16];
#pragma unroll
      for (int sd = 0; sd < 2; ++sd) {
        float Lh[2][16];
#pragma unroll
        for (int hh = 0; hh < 2; ++hh) {
          const int hs = 2 * (2 * hp + hh) + sd;
          float top[16];
          const bf16_t* scp = SC8 + (((size_t)(hs * 16 + 8 * hf)) * T_ + (t0 + tl)) * 8;
          uint4 sv[8];
#pragma unroll
          for (int kq = 0; kq < 8; ++kq) sv[kq] = *(const uint4*)(scp + (size_t)kq * T_ * 8);
          __builtin_amdgcn_sched_barrier(0);
#pragma unroll
          for (int kt = 0; kt < 4; ++kt) {
            float g[16];
#pragma unroll
            for (int kq = 0; kq < 2; ++kq) {
              const uint4 v8 = sv[2 * kt + kq];
              const unsigned wv[4] = {v8.x, v8.y, v8.z, v8.w};
#pragma unroll
              for (int j = 0; j < 4; ++j) {
                const int key = 64 * hf + 16 * kt + 8 * kq + 2 * j;
                g[8 * kq + 2 * j] = __uint_as_float((wv[j] << 16) | (unsigned)key);
                g[8 * kq + 2 * j + 1] = __uint_as_float((wv[j] & 0xffff0000u) | (unsigned)(key + 1));
              }
            }
            bitonic_sort16_desc(g);
            if (kt == 0) {
#pragma unroll
              for (int r = 0; r < 16; ++r) top[r] = g[r];
            } else top16_merge(top, g);
            __builtin_amdgcn_sched_barrier(0);
          }
#pragma unroll
          for (int r = 0; r < 16; ++r) Lh[hh][r] = top[r];
          __builtin_amdgcn_sched_barrier(0);
        }
#pragma unroll
        for (int r = 0; r < 16; ++r) {
          const auto sw = __builtin_amdgcn_permlane32_swap(__float_as_uint(Lh[0][r]), __float_as_uint(Lh[1][r]), false, false);
          Lh[0][r] = __uint_as_float(sw[0]); Lh[1][r] = __uint_as_float(sw[1]);
        }
        top16_merge(Lh[0], Lh[1]);
#pragma unroll
        for (int r = 0; r < 16; ++r) F[sd][r] = Lh[0][r];
        __builtin_amdgcn_sched_barrier(0);
      }
      int ia[16], ib[16];
#pragma unroll
      for (int r = 0; r < 16; ++r) { ia[r] = (int)(__float_as_uint(F[0][r]) & 127u) << 7; ib[r] = (int)(__float_as_uint(F[1][r]) & 127u); }
      float k[16]; int q[16];
#pragma unroll
      for (int j = 0; j < 16; ++j) { k[j] = F[0][0] + F[1][j]; q[j] = ia[0] | ib[j]; }
      { float xk[8]; int xq[8];
#pragma unroll
        for (int j = 0; j < 8; ++j) { xk[j] = F[0][1] + F[1][j]; xq[j] = ia[1] | ib[j]; }
        top16_merge_chain<8>(k, q, xk, xq); }
      { float xk[5]; int xq[5];
#pragma unroll
        for (int j = 0; j < 5; ++j) { xk[j] = F[0][2] + F[1][j]; xq[j] = ia[2] | ib[j]; }
        top16_merge_chain<5>(k, q, xk, xq); }
      { float xk[4]; int xq[4];
#pragma unroll
        for (int j = 0; j < 4; ++j) { xk[j] = F[0][3] + F[1][j]; xq[j] = ia[3] | ib[j]; }
        top16_merge_chain<4>(k, q, xk, xq); }
      { float xk[3]; int xq[3];
#pragma unroll
        for (int j = 0; j < 3; ++j) { xk[j] = F[0][4] + F[1][j]; xq[j] = ia[4] | ib[j]; }
        top16_merge_chain<3>(k, q, xk, xq); }
      { float xk[11]; int xq[11];
#pragma unroll
        for (int i = 0; i < 11; ++i) { xk[i] = F[0][5 + i] + F[1][0]; xq[i] = ia[5 + i] | ib[0]; }
        top16_merge_chain<11>(k, q, xk, xq); }
      { float xk[3]; int xq[3];
#pragma unroll
        for (int i = 0; i < 3; ++i) { xk[i] = F[0][5 + i] + F[1][1]; xq[i] = ia[5 + i] | ib[1]; }
        top16_merge_chain<3>(k, q, xk, xq); }
      float e[16]; float es = 0.f;
#pragma unroll
      for (int i = 0; i < 16; ++i) { e[i] = __expf(k[i] - k[0]); es += e[i]; }
      const float ies = 1.f / es;
      const int h = 2 * hp + hf;
#pragma unroll
      for (int i = 0; i < 16; ++i) idxL[tl * 132 + h * 16 + i] = (int)(((unsigned)f2bf(e[i] * ies) << 16) | (unsigned)q[i]);
    }
    __syncthreads();
    {
      const int fr = lane & 15, fq = lane >> 4, jsel = lane & 3, tlb = wid * 8;
      unsigned char* hq4 = smem + 33792 + wid * 1024;
      unsigned char* ust = smem + 41984 + wid * 8448;
      const unsigned lane8 = (unsigned)lane * 8u;
      const int hi5 = lane >> 5; const unsigned lane16 = (unsigned)(lane & 31) * 16u;
#define PEER_REQ_IDX(sn_) (idxL[(tlb + ((min((sn_), 127) & 63) >> 3)) * 132 + 16 * (min((sn_), 127) & 7) + fr] & 0xffff)
#define PEER_REQ_U(Q, e_) peer_req_rows16(Q, (const unsigned char*)U4, (e_), hi5, lane16)
      u32x4v qa[8], qb[8];
      {
        const int e0 = PEER_REQ_IDX(0), e1 = PEER_REQ_IDX(1);
        PEER_REQ_U(qa, e0);
        __builtin_amdgcn_sched_barrier(0);
        PEER_REQ_U(qb, e1);
        __builtin_amdgcn_sched_barrier(0);
      }
      {
        const float rs_lane = rsqrtf(ssq_total(SSQ, t0 + tlb + (lane & 7)) * (1.f / 1024.f) + EPS_);
        uint4 nh0 = *(const uint4*)(XG + (size_t)(t0 + tlb) * 1024 + lane * 16), nh1 = *(const uint4*)(XG + (size_t)(t0 + tlb) * 1024 + lane * 16 + 8);
#pragma unroll 1
        for (int ii = 0; ii < 8; ++ii) {
          const int tl = tlb + ii, t = t0 + tl;
          uint4 hB1[8], hB2[8];
          {
            const unsigned hw[8] = {nh0.x, nh0.y, nh0.z, nh0.w, nh1.x, nh1.y, nh1.z, nh1.w};
            const float rs = __int_as_float(__builtin_amdgcn_readlane(__float_as_int(rs_lane), ii));
            unsigned q1[2] = {0u, 0u}, q2[2] = {0u, 0u};
#pragma unroll
            for (int qq = 0; qq < 4; ++qq) {
              const f32x4 sh = *(const f32x4*)(cst + 3072 + qq * 256 + lane * 4);
              float hvv[4];
              hvv[0] = __uint_as_float(hw[2 * qq] << 16) * rs + sh.x; hvv[1] = __uint_as_float(hw[2 * qq] & 0xffff0000u) * rs + sh.y;
              hvv[2] = __uint_as_float(hw[2 * qq + 1] << 16) * rs + sh.z; hvv[3] = __uint_as_float(hw[2 * qq + 1] & 0xffff0000u) * rs + sh.w;
#pragma unroll
              for (int pr = 0; pr < 2; ++pr) {
                const int byte_sel = (2 * qq + pr) & 3, wd = (2 * qq + pr) >> 2;
                const float x0 = fminf(fmaxf(hvv[2 * pr], -6.f), 6.f), x1 = fminf(fmaxf(hvv[2 * pr + 1], -6.f), 6.f);
                unsigned t1 = 0u;
                if (byte_sel == 0) t1 = __builtin_amdgcn_cvt_scalef32_pk_fp4_f32(0u, x0, x1, 1.0f, 0);
                else if (byte_sel == 1) t1 = __builtin_amdgcn_cvt_scalef32_pk_fp4_f32(0u, x0, x1, 1.0f, 1);
                else if (byte_sel == 2) t1 = __builtin_amdgcn_cvt_scalef32_pk_fp4_f32(0u, x0, x1, 1.0f, 2);
                else t1 = __builtin_amdgcn_cvt_scalef32_pk_fp4_f32(0u, x0, x1, 1.0f, 3);
                f32x2 back;
                if (byte_sel == 0) back = __builtin_amdgcn_cvt_scalef32_pk_f32_fp4(t1, 1.0f, 0);
                else if (byte_sel == 1) back = __builtin_amdgcn_cvt_scalef32_pk_f32_fp4(t1, 1.0f, 1);
                else if (byte_sel == 2) back = __builtin_amdgcn_cvt_scalef32_pk_f32_fp4(t1, 1.0f, 2);
                else back = __builtin_amdgcn_cvt_scalef32_pk_f32_fp4(t1, 1.0f, 3);
                const float r0 = fminf(fmaxf((hvv[2 * pr] - back.x) * 8.f, -6.f), 6.f), r1 = fminf(fmaxf((hvv[2 * pr + 1] - back.y) * 8.f, -6.f), 6.f);
                unsigned t2 = 0u;
                if (byte_sel == 0) t2 = __builtin_amdgcn_cvt_scalef32_pk_fp4_f32(0u, r0, r1, 1.0f, 0);
                else if (byte_sel == 1) t2 = __builtin_amdgcn_cvt_scalef32_pk_fp4_f32(0u, r0, r1, 1.0f, 1);
                else if (byte_sel == 2) t2 = __builtin_amdgcn_cvt_scalef32_pk_fp4_f32(0u, r0, r1, 1.0f, 2);
                else t2 = __builtin_amdgcn_cvt_scalef32_pk_fp4_f32(0u, r0, r1, 1.0f, 3);
                q1[wd] |= t1; q2[wd] |= t2;
              }
            }
            *(uint2*)(hq4 + lane * 8) = make_uint2(q1[0], q1[1]);
            *(uint2*)(hq4 + 512 + lane * 8) = make_uint2(q2[0], q2[1]);
#pragma unroll
            for (int kc = 0; kc < 8; ++kc) { hB1[kc] = *(const uint4*)(hq4 + 64 * kc + 16 * fq); hB2[kc] = *(const uint4*)(hq4 + 512 + 64 * kc + 16 * fq); }
          }
          { const int tn = t + (ii < 7 ? 1 : 0);
            nh0 = *(const uint4*)(XG + (size_t)tn * 1024 + lane * 16); nh1 = *(const uint4*)(XG + (size_t)tn * 1024 + lane * 16 + 8); }
          __builtin_amdgcn_sched_barrier(0);
#define PEER_U_STEP(R, bt_) do { const int _bt = (bt_), _sn = ii * 8 + _bt + 2; \
            _Pragma("unroll") for (int r = 0; r < 8; ++r) *(u32x4v*)(ust + (2 * r + hi5) * 528 + lane16) = R[r];        \
            if (_sn < 64) { const int _en = PEER_REQ_IDX(_sn); PEER_REQ_U(R, _en); } else { const int _en = PEER_REQ_IDX(_sn); peer_req_rows8(R, (const unsigned char*)V4, _en, lane8); }        \
            __builtin_amdgcn_sched_barrier(0); \
            uint4 ua[8]; \
            _Pragma("unroll") for (int kc = 0; kc < 8; ++kc) ua[kc] = *(const uint4*)(ust + fr * 528 + 64 * kc + 16 * fq);      \
            f32x4 sa[2] = {(f32x4){0.f, 0.f, 0.f, 0.f}, (f32x4){0.f, 0.f, 0.f, 0.f}}, sb[2] = {(f32x4){0.f, 0.f, 0.f, 0.f}, (f32x4){0.f, 0.f, 0.f, 0.f}};     \
            _Pragma("unroll") for (int kc = 0; kc < 8; ++kc) { \
              const i32x8 av = (i32x8){(int)ua[kc].x, (int)ua[kc].y, (int)ua[kc].z, (int)ua[kc].w, 0, 0, 0, 0}; \
              const i32x8 b1 = (i32x8){(int)hB1[kc].x, (int)hB1[kc].y, (int)hB1[kc].z, (int)hB1[kc].w, 0, 0, 0, 0}; \
              const i32x8 b2 = (i32x8){(int)hB2[kc].x, (int)hB2[kc].y, (int)hB2[kc].z, (int)hB2[kc].w, 0, 0, 0, 0}; \
              sa[kc & 1] = __builtin_amdgcn_mfma_scale_f32_16x16x128_f8f6f4(av, b1, sa[kc & 1], 4  , 4  , 0, 0x7F7F7F7F, 0, 0x7F7F7F7F); \
              sb[kc & 1] = __builtin_amdgcn_mfma_scale_f32_16x16x128_f8f6f4(av, b2, sb[kc & 1], 4, 4, 0, 0x7F7F7F7F, 0, 0x7F7F7F7F); } \
            const f32x4 sc4 = (sa[0] + sa[1]) + (sb[0] + sb[1]) * 0.125f; \
              \
            const float dsel = jsel == 0 ? sc4[0] : (jsel == 1 ? sc4[1] : (jsel == 2 ? sc4[2] : sc4[3])); \
            const int _eo = tl * 132 + 16 * _bt + 4 * fq + jsel; const unsigned _pe = (unsigned)idxL[_eo]; \
            const float _w = __uint_as_float(_pe & 0xffff0000u) * gelu_tanh_fast(dsel * (1.f / 64.f));            \
            if (fr < 4) idxL[_eo] = (int)(((unsigned)f2bf(_w) << 16) | (_pe & 0xffffu)); \
          } while (0)
#pragma unroll 1
          for (int b2 = 0; b2 < 8; b2 += 2) { PEER_U_STEP(qa, b2); PEER_U_STEP(qb, b2 + 1); }
#undef PEER_U_STEP
        }
      }
      {
        f32x2 acc2[8];
#pragma unroll
        for (int j = 0; j < 8; ++j) acc2[j] = (f32x2){0.f, 0.f};
#pragma unroll 1
        for (int ii = 0; ii < 8; ++ii) {
          const int tl = tlb + ii, t = t0 + tl;
          const uint4 xr0 = *(const uint4*)(X + (size_t)t * 1024 + lane * 16), xr1 = *(const uint4*)(X + (size_t)t * 1024 + lane * 16 + 8);
          __builtin_amdgcn_sched_barrier(0);
#define PEER_V_STEP(R, bt_) do { const int _bt = (bt_), _sn = 64 + ii * 8 + _bt + 2; \
            const int _wv = (int)((unsigned)idxL[tl * 132 + 16 * _bt + fr] & 0xffff0000u);          \
            const int _en = PEER_REQ_IDX(_sn); \
            _Pragma("unroll") for (int r = 0; r < 16; ++r) { \
              const float wr = __int_as_float(__builtin_amdgcn_readlane(_wv, r)); \
              axpy16_fp4(make_uint2(R[r >> 1][2 * (r & 1)], R[r >> 1][2 * (r & 1) + 1]), wr, acc2); \
              { const unsigned off = (unsigned)__builtin_amdgcn_readlane(_en, r) * 512u + lane8; const uint2 _t = *(const uint2*)((const unsigned char*)V4 + off); \
                R[r >> 1][2 * (r & 1)] = _t.x; R[r >> 1][2 * (r & 1) + 1] = _t.y; } \
              __builtin_amdgcn_sched_barrier(0); } \
          } while (0)
#pragma unroll 1
          for (int b2 = 0; b2 < 8; b2 += 2) { PEER_V_STEP(qa, b2); PEER_V_STEP(qb, b2 + 1); }
#undef PEER_V_STEP
          float xn[16]; float ss = 0.f;
          const unsigned xw[8] = {xr0.x, xr0.y, xr0.z, xr0.w, xr1.x, xr1.y, xr1.z, xr1.w};
#pragma unroll
          for (int qq = 0; qq < 4; ++qq) {
            const f32x4 xv = (f32x4){__uint_as_float(xw[2 * qq] << 16), __uint_as_float(xw[2 * qq] & 0xffff0000u), __uint_as_float(xw[2 * qq + 1] << 16), __uint_as_float(xw[2 * qq + 1] & 0xffff0000u)};
            const f32x4 g = *(const f32x4*)(cst + qq * 256 + lane * 4);
            xn[4 * qq] = xv.x + g.x * acc2[2 * qq].x; xn[4 * qq + 1] = xv.y + g.y * acc2[2 * qq].y;
            xn[4 * qq + 2] = xv.z + g.z * acc2[2 * qq + 1].x; xn[4 * qq + 3] = xv.w + g.w * acc2[2 * qq + 1].y;
            ss += xn[4 * qq] * xn[4 * qq] + xn[4 * qq + 1] * xn[4 * qq + 1] + xn[4 * qq + 2] * xn[4 * qq + 2] + xn[4 * qq + 3] * xn[4 * qq + 3];
          }
#pragma unroll
          for (int j = 0; j < 8; ++j) acc2[j] = (f32x2){0.f, 0.f};
          const float rstd = rsqrtf(wave_sum(ss) * (1.f / 1024.f) + EPS_);
          if (!last) {
            unsigned hb[8], xb[8];
#pragma unroll
            for (int qq = 0; qq < 4; ++qq) {
              xb[2 * qq] = pk2(xn[4 * qq], xn[4 * qq + 1]); xb[2 * qq + 1] = pk2(xn[4 * qq + 2], xn[4 * qq + 3]);
              const f32x4 ga = *(const f32x4*)(cst + 1024 + qq * 256 + lane * 4), sh = *(const f32x4*)(cst + 2048 + qq * 256 + lane * 4);
              hb[2 * qq] = pk2(xn[4 * qq] * rstd * ga.x + sh.x, xn[4 * qq + 1] * rstd * ga.y + sh.y);
              hb[2 * qq + 1] = pk2(xn[4 * qq + 2] * rstd * ga.z + sh.z, xn[4 * qq + 3] * rstd * ga.w + sh.w);
            }
            *(uint4*)(X + (size_t)t * 1024 + lane * 16) = make_uint4(xb[0], xb[1], xb[2], xb[3]);
            *(uint4*)(X + (size_t)t * 1024 + lane * 16 + 8) = make_uint4(xb[4], xb[5], xb[6], xb[7]);
            *(uint4*)(HF + (size_t)t * 1024 + lane * 16) = make_uint4(hb[0], hb[1], hb[2], hb[3]);
            *(uint4*)(HF + (size_t)t * 1024 + lane * 16 + 8) = make_uint4(hb[4], hb[5], hb[6], hb[7]);
          } else {
#pragma unroll
            for (int qq = 0; qq < 4; ++qq) {
              const f32x4 fn = *(const f32x4*)(cst + 1024 + qq * 256 + lane * 4);
              *(f32x4*)((float*)pp->out + (size_t)t * 1024 + lane * 16 + 4 * qq) = (f32x4){xn[4 * qq] * rstd * fn.x, xn[4 * qq + 1] * rstd * fn.y, xn[4 * qq + 2] * rstd * fn.z, xn[4 * qq + 3] * rstd * fn.w};
            }
          }
        }
      }
#undef PEER_REQ_IDX
#undef PEER_REQ_U
    }
  }
}

#define XB_TMO      128
#define XB_XCNT(j)  (256  + 64 * (j))
#define XB_XSUB(j)  (1280 + 64 * (j))
#define XB_XGEN(j)  (2304 + 64 * (j))
#define XB_TOP      3328
#define XB_TOPGEN   3392
#define XCD_BAR_WORDS 3456
#define XB_SPIN_CAP (1u << 20)
#define LAS __attribute__((address_space(3)))
__device__ __forceinline__ unsigned xb_ld(unsigned* q)              { return __hip_atomic_load(q, __ATOMIC_RELAXED, __HIP_MEMORY_SCOPE_AGENT); }
__device__ __forceinline__ unsigned xb_add(unsigned* q, unsigned v) { return __hip_atomic_fetch_add(q, v, __ATOMIC_RELAXED, __HIP_MEMORY_SCOPE_AGENT); }
__device__ __forceinline__ unsigned xb_xcc_id() { return (unsigned)__builtin_amdgcn_s_getreg((3 << 11) | 20) & 0xFu; }
#define XB_SPIN(cond, bar) do { unsigned _sp = 0; while (cond) { __builtin_amdgcn_s_sleep(1); \
    if ((++_sp & 255u) == 0u) { if (xb_ld(&(bar)[XB_TMO])) break; if (_sp > XB_SPIN_CAP) { atomicAdd(&(bar)[XB_TMO], 1u); break; } } } } while (0)
struct XcdBarrier { unsigned* bar; unsigned x; volatile LAS unsigned* st; };
__device__ __forceinline__ XcdBarrier xcd_barrier_post(unsigned* bar, volatile LAS unsigned* st) {
    XcdBarrier b; b.bar = bar; b.x = xb_xcc_id(); b.st = st;
    if (threadIdx.x == 0) (void)xb_add(&bar[XB_XCNT(b.x)], 1u);
    return b;
}
__device__ __forceinline__ void xcd_barrier_complete(unsigned* bar, unsigned x, unsigned& nloc, unsigned& nx) {
    const unsigned G = gridDim.x * gridDim.y * gridDim.z;
    unsigned sum, cnt, mine, sp = 0u;
    for (;;) {
        sum = 0u; cnt = 0u; mine = 0u;
#pragma unroll
        for (unsigned j = 0; j < 16; ++j) { const unsigned c = xb_ld(&bar[XB_XCNT(j)]); sum += c; cnt += (c > 0u) ? 1u : 0u; mine = (j == x) ? c : mine; }
        if (sum == G) break;
        __builtin_amdgcn_s_sleep(1);
        if ((++sp & 255u) == 0u) { if (xb_ld(&bar[XB_TMO])) break; if (sp > XB_SPIN_CAP) { atomicAdd(&bar[XB_TMO], 1u); break; } }
    }
    nloc = mine > 0u ? mine : 1u; nx = cnt > 0u ? cnt : 1u;
}
__device__ __forceinline__ void xcd_barrier(const XcdBarrier& b) {
    asm volatile("s_waitcnt vmcnt(0)" ::: "memory");
    __syncthreads();
    if (threadIdx.x == 0) {
        unsigned* bar = b.bar;
        __builtin_amdgcn_s_waitcnt(0);
        unsigned nloc = b.st[0], nx = b.st[1];
        if (nloc == 0u) { xcd_barrier_complete(bar, b.x, nloc, nx); b.st[0] = nloc; b.st[1] = nx; }
        const unsigned old = xb_add(&bar[XB_XSUB(b.x)], 1u);
        const unsigned gen = old / nloc;
        if (old + 1u == (gen + 1u) * nloc) {
            __builtin_amdgcn_fence(__ATOMIC_RELEASE, "agent");
            asm volatile("s_waitcnt vmcnt(0)" ::: "memory");
            const unsigned og = xb_add(&bar[XB_TOP], 1u);
            const unsigned tg = og / nx;
            if (og + 1u == (tg + 1u) * nx) xb_add(&bar[XB_TOPGEN], 1u);
            else XB_SPIN(xb_ld(&bar[XB_TOPGEN]) == tg, bar);
            __builtin_amdgcn_fence(__ATOMIC_ACQUIRE, "agent");
            xb_add(&bar[XB_XGEN(b.x)], 1u);
            asm volatile("s_waitcnt vmcnt(0)" ::: "memory");
        } else {
            XB_SPIN(xb_ld(&bar[XB_XGEN(b.x)]) == gen, bar);
            __builtin_amdgcn_fence(__ATOMIC_ACQUIRE, "agent");
            asm volatile("s_waitcnt vmcnt(0)" ::: "memory");
        }
    }
    __syncthreads();
}

__global__ void __launch_bounds__(NT) fwd_megakernel(Params p) {
  extern __shared__ __attribute__((aligned(16))) unsigned char smem[];
  const CParamsP pp = launder_kargs();
  cg::grid_group grid = cg::this_grid();
  volatile LAS unsigned* xbst = (volatile LAS unsigned*)(smem + LDS_BYTES - 16);
  if (threadIdx.x == 0) { xbst[0] = 0u; xbst[1] = 0u; }
  if (blockIdx.x == 0) { unsigned* bw = (unsigned*)(pp->ws + WS_BAR); for (int i = threadIdx.x; i < XCD_BAR_WORDS; i += NT) bw[i] = 0u; }
  setup_phase(p, smem);
  grid.sync();
  const XcdBarrier xb = xcd_barrier_post((unsigned*)(pp->ws + WS_BAR), xbst);
  const float* MOD = (const float*)(pp->ws + WS_MOD);
  for (int l = 0; l < DEPTH_; ++l) {
    const float* xsrc = (l == 0) ? gin(pp->in[I_X]) : (const float*)(pp->ws + WS_X);
    const float* modl = MOD + (size_t)l * 2 * 6144;
    if (l == 0) {
      norm_mod_phase(xsrc, gin(pp->in[I_NMIX]), modl + 0, modl + 1024, (bf16_t*)(pp->ws + WS_ABUF));
      qbias_phase(p, smem);
      xcd_barrier(xb);
    }
    gemm_proj_phase(p, l, smem);
    xcd_barrier(xb);
    attn_phase(p, l, smem);
    mix_local_phase(p, l, smem);
    xcd_barrier(xb);
    scan_phase(p, l);
    xcd_barrier(xb);
    mix_final_phase(p, l, smem);
    xcd_barrier(xb);
    gemm_out_phase(p, l, smem);
    xcd_barrier(xb);
    gemm_q_phase(p, l, smem);
    xcd_barrier(xb);
    peer_phase(p, l, l == DEPTH_ - 1, smem);
    xcd_barrier(xb);
  }
}

extern "C" void kernel_launch(void* const* d_in, const int* in_sizes, int n_in,
                              void* d_out, int out_size, void* d_ws, size_t ws_size,
                              hipStream_t stream) {
  static int grid_blocks = 0;
  if (grid_blocks == 0) {
    if (n_in != 24 || ws_size < WS_END) { fprintf(stderr, "kernel_launch: unexpected n_in %d / ws_size %zu (need %zu)\n", n_in, ws_size, (size_t)WS_END); grid_blocks = -1; return; }
    int dev = 0, cus = 0, per_cu = 0;
    if (hipGetDevice(&dev) != hipSuccess || hipDeviceGetAttribute(&cus, hipDeviceAttributeMultiprocessorCount, dev) != hipSuccess) { grid_blocks = -1; return; }
    if (hipFuncSetAttribute((const void*)fwd_megakernel, hipFuncAttributeMaxDynamicSharedMemorySize, LDS_BYTES) != hipSuccess) { fprintf(stderr, "hipFuncSetAttribute failed\n"); grid_blocks = -1; return; }
    if (hipOccupancyMaxActiveBlocksPerMultiprocessor(&per_cu, (const void*)fwd_megakernel, NT, LDS_BYTES) != hipSuccess || per_cu < 1) { fprintf(stderr, "occupancy query: %d\n", per_cu); grid_blocks = -1; return; }
    grid_blocks = cus;
  }
  if (grid_blocks < 0) return;
  Params p{};
  for (int i = 0; i < 24; ++i) p.in[i] = (const GAS float*)d_in[i];
  p.out = (GAS float*)d_out; p.ws = (GAS unsigned char*)d_ws;
  void* args[] = {&p};
  hipError_t e = hipLaunchCooperativeKernel((void*)fwd_megakernel, dim3(grid_blocks), dim3(NT), args, LDS_BYTES, stream);
  if (e != hipSuccess) fprintf(stderr, "cooperative launch failed: %s (grid %d)\n", hipGetErrorString(e), grid_blocks);
}
```

```cpp
#include <hip/hip_runtime.h>
#include <hip/hip_cooperative_groups.h>
#include <cstdio>
#include <cstdint>
namespace cg = cooperative_groups;

typedef unsigned short bf16_t;
typedef short bf16x8 __attribute__((ext_vector_type(8)));
typedef float f32x4 __attribute__((ext_vector_type(4)));
typedef float f32x16 __attribute__((ext_vector_type(16)));
typedef int i32x8 __attribute__((ext_vector_type(8)));

constexpr int T_ = 16384, D_ = 1024, L_ = 8192, NBATCH = 2, DEPTH_ = 4;
constexpr int INC = 2944, INCP = 3072;
constexpr int NCH = 128;
constexpr int NT = 512;
constexpr int NW = 8;
constexpr float EPS_ = 1e-6f;
constexpr int C_QA = 0, C_KA = 384, C_VA = 768, C_QR = 1152, C_KR = 1536, C_VR = 1920, C_GR = 2304, C_US = 2688;

constexpr size_t al256(size_t x) { return (x + 255) & ~(size_t)255; }
constexpr size_t WS_MOD   = 0;
constexpr size_t WS_ROTC  = al256(WS_MOD + 4ull * 2 * 6144 * 4);
constexpr size_t WS_ROTS  = al256(WS_ROTC + 8192ull * 32 * 4);
constexpr size_t WS_SA    = al256(WS_ROTS + 8192ull * 32 * 4);
constexpr size_t WS_SBB   = al256(WS_SA + 4ull * 16 * 64 * 2 * 4);
constexpr size_t WS_WIN   = al256(WS_SBB + 4ull * 16 * 64 * 32 * 4);
constexpr size_t WS_WOUT  = al256(WS_WIN + 4ull * INCP * 1024 * 2);
constexpr size_t WS_WQ    = al256(WS_WOUT + 4ull * 1024 * 1024 * 2);
constexpr size_t WS_SUBK  = al256(WS_WQ + 4ull * 2048 * 1024 * 2);
constexpr size_t WS_ABUF  = al256(WS_SUBK + 4ull * 16 * 128 * 128 * 2);
constexpr size_t WS_PROJ  = al256(WS_ABUF + (size_t)T_ * 1024 * 2);
constexpr size_t WS_VTA   = al256(WS_PROJ + (size_t)T_ * INCP * 2);
constexpr size_t WS_ATT   = al256(WS_VTA + 2ull * 6 * 64 * 8192 * 2);
constexpr size_t WS_YINT  = al256(WS_ATT + (size_t)T_ * 384 * 4);
constexpr size_t WS_UPD   = al256(WS_YINT + (size_t)T_ * 384 * 4);
constexpr size_t WS_SPREV = al256(WS_UPD + 256ull * 6 * 4096 * 4);
constexpr size_t WS_SEND  = al256(WS_SPREV + 256ull * 6 * 4096 * 4);
constexpr size_t WS_CARRY = al256(WS_SEND + 256ull * 16 * 64 * 2 * 4);
constexpr size_t WS_X     = al256(WS_CARRY + 256ull * 16 * 64 * 2 * 4);
constexpr size_t WS_Q     = al256(WS_X + (size_t)T_ * 1024 * 4);
constexpr size_t WS_SC    = al256(WS_Q + (size_t)T_ * 2048 * 2);
constexpr size_t WS_EIDX  = al256(WS_SC + (size_t)T_ * 2048 * 4);
constexpr size_t WS_EGATE = al256(WS_EIDX + (size_t)T_ * 128 * 4);
constexpr size_t WS_PU8   = al256(WS_EGATE + (size_t)T_ * 128 * 4);
constexpr size_t WS_PV8   = al256(WS_PU8 + 4ull * 16384 * 1024);
constexpr size_t WS_BAR   = al256(WS_PV8 + 4ull * 16384 * 1024);
constexpr size_t WS_SPT   = al256(WS_BAR + 3456ull * 4);
constexpr size_t WS_CB    = al256(WS_SPT + 256ull * 6 * 4096 * 2);
constexpr size_t WS_WGLUT = al256(WS_CB + 4ull * 16 * 16 * 128 * 2);
constexpr size_t WS_VTR   = al256(WS_WGLUT + 4ull * 512 * 256 * 2);
constexpr size_t WS_XG    = al256(WS_VTR + 2ull * 384 * 8192 * 2);
constexpr size_t WS_SSQ   = al256(WS_XG + (size_t)T_ * 1024 * 2);
constexpr size_t WS_C2    = al256(WS_SSQ + (size_t)T_ * 16 * 4);
constexpr size_t WS_BBH   = al256(WS_C2 + 4ull * 2 * 2048 * 4);
constexpr size_t WS_END   = al256(WS_BBH + 4ull * 16 * 2 * 64 * 16 * 2);

constexpr int LDS_BYTES = 135168;

#define GAS __attribute__((address_space(1)))
struct Params {
  const GAS float* in[24];
  GAS float* out;
  GAS unsigned char* ws;
};
enum { I_X = 0, I_C, I_WADA, I_BADA, I_NMIX, I_NFFN, I_WIN, I_RELB, I_LRE, I_LIM, I_LOGDT, I_BRE, I_BIM, I_CRE, I_CIM, I_SSMD,
       I_WGLU, I_MGAIN, I_WOUT, I_WQ, I_SUBK, I_PU, I_PV, I_FNORM };

__device__ __forceinline__ float bf2f(bf16_t v) { return __uint_as_float(((unsigned)v) << 16); }
typedef __bf16 hwbf16x2 __attribute__((ext_vector_type(2)));
typedef unsigned u32x4v __attribute__((ext_vector_type(4)));
typedef float f32x2 __attribute__((ext_vector_type(2)));
__device__ __forceinline__ bf16_t f2bf(float f) { return __builtin_bit_cast(unsigned short, (__bf16)f); }
__device__ __forceinline__ unsigned pk2(float a, float b) { const hwbf16x2 v = {(__bf16)a, (__bf16)b}; return __builtin_bit_cast(unsigned, v); }
#define WAVE_ROR(v_, c_) __int_as_float(__builtin_amdgcn_update_dpp(0, __float_as_int(v_), (c_), 0xf, 0xf, false))
__device__ __forceinline__ float wave_sum(float v) {
  v += WAVE_ROR(v, 0x128  ); v += WAVE_ROR(v, 0x124  ); v += WAVE_ROR(v, 0x122  ); v += WAVE_ROR(v, 0x121  );
  return (__int_as_float(__builtin_amdgcn_readlane(__float_as_int(v), 0)) + __int_as_float(__builtin_amdgcn_readlane(__float_as_int(v), 16))) +
         (__int_as_float(__builtin_amdgcn_readlane(__float_as_int(v), 32)) + __int_as_float(__builtin_amdgcn_readlane(__float_as_int(v), 48)));
}
__device__ __forceinline__ float xsum_16_32(float v) {
  const auto a = __builtin_amdgcn_permlane16_swap(__float_as_uint(v), __float_as_uint(v), false, false); v = __uint_as_float(a[0]) + __uint_as_float(a[1]);
  const auto b = __builtin_amdgcn_permlane32_swap(__float_as_uint(v), __float_as_uint(v), false, false); return __uint_as_float(b[0]) + __uint_as_float(b[1]);
}
__device__ __forceinline__ float xmax_16_32(float v) {
  const auto a = __builtin_amdgcn_permlane16_swap(__float_as_uint(v), __float_as_uint(v), false, false); v = fmaxf(__uint_as_float(a[0]), __uint_as_float(a[1]));
  const auto b = __builtin_amdgcn_permlane32_swap(__float_as_uint(v), __float_as_uint(v), false, false); return fmaxf(__uint_as_float(b[0]), __uint_as_float(b[1]));
}
__device__ __forceinline__ float wave_max(float v) {
#pragma unroll
  for (int o = 32; o > 0; o >>= 1) v = fmaxf(v, __shfl_xor(v, o));
  return v;
}
__device__ __forceinline__ float gelu_tanh(float x) { const float u = 0.7978845608028654f * (x + 0.044715f * x * x * x); return 0.5f * x * (1.f + tanhf(u)); }
__device__ __forceinline__ float sigmoid_f(float x) { return 1.f / (1.f + __expf(-x)); }
__device__ __forceinline__ float gelu_tanh_fast(float x) {
  const float u2 = 2.f * 0.7978845608028654f * 1.4426950408889634f * (x + 0.044715f * x * x * x);
  const float e = __builtin_amdgcn_exp2f(fminf(u2, 80.f));
  return x - x * __builtin_amdgcn_rcpf(1.f + e);
}
__device__ __forceinline__ GAS unsigned char* launder_ptr(GAS unsigned char* q) { asm volatile("" : "+s"(q)); return q; }
__device__ __forceinline__ const float* gin(const GAS float* q) { return (const float*)q; }
__device__ __forceinline__ const float* launder_cptr(const float* q) { asm volatile("" : "+s"(q)); return q; }
__device__ __forceinline__ int launder_tid() { int t = threadIdx.x; asm volatile("" : "+v"(t)); return t; }
typedef const Params __attribute__((address_space(4)))* CParamsP;
__device__ __forceinline__ CParamsP launder_kargs() { CParamsP q = (CParamsP)__builtin_amdgcn_kernarg_segment_ptr(); asm volatile("" : "+s"(q)); return q; }

__device__ __forceinline__ void convert_tables_fp4(const CParamsP pp, GAS unsigned char* ws, int layer, int gtid, int gn, int sp_begin = 0, int sp_end = 2 * 16384) {
  constexpr int NSPAN = 16384;
  const int lane = gtid & 63, gw = gtid >> 6, nw = gn >> 6;
  for (int sp0 = sp_begin + gw; sp0 < sp_end; sp0 += 4 * nw) {
    f32x4 a[4][4];
#pragma unroll
    for (int h = 0; h < 4; ++h) {
      const int sp = sp0 + h * nw, tb = sp >= NSPAN ? 1 : 0;
      const float* src = (tb ? gin(pp->in[I_PV]) : gin(pp->in[I_PU])) + ((size_t)layer * NSPAN + (sp - tb * NSPAN)) * 1024 + lane * 4;
#pragma unroll
      for (int q = 0; q < 4; ++q) a[h][q] = (sp < sp_end) ? *(const f32x4*)(src + q * 256) : (f32x4){0.f, 0.f, 0.f, 0.f};
    }
#pragma unroll
    for (int h = 0; h < 4; ++h) {
      const int sp = sp0 + h * nw, tb = sp >= NSPAN ? 1 : 0;
      if (sp < sp_end) {
        const float sc = tb ? 4.f : 64.f;
        unsigned short* dst = (unsigned short*)(ws + (tb ? WS_PV8 : WS_PU8) + ((size_t)layer * NSPAN + (sp - tb * NSPAN)) * 512) + lane;
#pragma unroll
        for (int q = 0; q < 4; ++q) {
          const f32x4 v = a[h][q];
          const float x0 = fminf(fmaxf(v.x * sc, -6.f), 6.f), x1 = fminf(fmaxf(v.y * sc, -6.f), 6.f);
          const float x2 = fminf(fmaxf(v.z * sc, -6.f), 6.f), x3 = fminf(fmaxf(v.w * sc, -6.f), 6.f);
          unsigned o = __builtin_amdgcn_cvt_scalef32_pk_fp4_f32(0u, x0, x1, 1.0f, 0);
          o = __builtin_amdgcn_cvt_scalef32_pk_fp4_f32(o, x2, x3, 1.0f, 1);
          dst[q * 64] = (unsigned short)o;
        }
      }
    }
  }
}

__device__ void setup_phase(const Params& p, unsigned char* smem) {
  const CParamsP pp = launder_kargs();
  GAS unsigned char* const ws = launder_ptr(pp->ws); const int tidx = launder_tid(); (void)ws; (void)tidx;
  const int tid = tidx;
  float* sm = (float*)smem;
  {
    float* cond = sm;
    float* red = sm + 2048;
    float* MOD = (float*)(ws + WS_MOD);
    for (int i = tid; i < 2048; i += NT) { const float c = gin(pp->in[I_C])[i]; cond[i] = c * sigmoid_f(c); }
    __syncthreads();
    for (int item = blockIdx.x; item < 4 * 192; item += gridDim.x) {
      const int l = item / 192, cb = item % 192, kq = tid >> 6, jj = tid & 31, kp = (tid >> 5) & 1, j = cb * 32 + jj;
      const float* w = gin(pp->in[I_WADA]) + (size_t)l * 1024 * 6144 + j;
      float a0 = 0.f, a1 = 0.f;
#pragma unroll 32
      for (int k = kq * 128 + kp; k < kq * 128 + 128; k += 2) { const float wv = w[(size_t)k * 6144]; a0 += cond[k] * wv; a1 += cond[1024 + k] * wv; }
      red[((kq * 2 + kp) * 2 + 0) * 32 + jj] = a0; red[((kq * 2 + kp) * 2 + 1) * 32 + jj] = a1;
      __syncthreads();
      if (tid < 64) {
        const int b = tid >> 5, j2 = tid & 31; float s = 0.f;
        for (int q = 0; q < 16; ++q) s += red[(q * 2 + b) * 32 + j2];
        MOD[((size_t)l * 2 + b) * 6144 + cb * 32 + j2] = s + gin(pp->in[I_BADA])[(size_t)l * 6144 + cb * 32 + j2];
      }
      __syncthreads();
    }
  }
  const int gtid = blockIdx.x * NT + tid, gn = gridDim.x * NT;
  {
    float* RC = (float*)(ws + WS_ROTC); float* RS = (float*)(ws + WS_ROTS);
    for (int idx = gtid; idx < 8192 * 32; idx += gn) {
      const int pos = idx >> 5, i = idx & 31;
      const float inv = powf(10000.0f, -(float)i / 32.0f);
      const float ang = (float)pos * inv;
      float s, c; sincosf(ang, &s, &c);
      RC[idx] = c; RS[idx] = s;
    }
  }
  {
    float* SA = (float*)(ws + WS_SA); float* SBB = (float*)(ws + WS_SBB); bf16_t* BBH = (bf16_t*)(ws + WS_BBH);
    for (int idx = gtid; idx < 4 * 16 * 64; idx += gn) {
      const int l = idx / 1024, g = (idx >> 6) & 15;
      const float dt = expf(gin(pp->in[I_LOGDT])[l * 16 + g]);
      const float lr = gin(pp->in[I_LRE])[idx], li = gin(pp->in[I_LIM])[idx];
      const float mag = expf(lr * dt);
      float sn, cs; sincosf(li * dt, &sn, &cs);
      const float are = mag * cs, aim = mag * sn;
      const float den = lr * lr + li * li, nr = are - 1.f, ni = aim;
      const float fre = (nr * lr + ni * li) / den, fim = (ni * lr - nr * li) / den;
      SA[idx * 2] = are; SA[idx * 2 + 1] = aim;
      for (int c = 0; c < 16; ++c) {
        const float br = gin(pp->in[I_BRE])[(size_t)idx * 16 + c], bi = gin(pp->in[I_BIM])[(size_t)idx * 16 + c];
        SBB[(size_t)idx * 32 + c] = fre * br - fim * bi;
        SBB[(size_t)idx * 32 + 16 + c] = fre * bi + fim * br;
        {
          const int pq = idx & 63; const size_t fb = (size_t)(idx >> 6) * 2;
          BBH[(((fb + 0) * 2 + (pq >> 5)) * 64 + 32 * (c >> 3) + (pq & 31)) * 8 + (c & 7)] = f2bf(fre * br - fim * bi);
          BBH[(((fb + 1) * 2 + (pq >> 5)) * 64 + 32 * (c >> 3) + (pq & 31)) * 8 + (c & 7)] = f2bf(fre * bi + fim * br);
        }
      }
    }
  }
  {
    bf16_t* CB = (bf16_t*)(ws + WS_CB);
    for (int idx = gtid; idx < 4 * 16 * 16 * 128; idx += gn) {
      const int k = idx & 127, lgc = idx >> 7;
      const bf16_t cv = (k < 64) ? f2bf(gin(pp->in[I_CRE])[(size_t)lgc * 64 + k]) : f2bf(-gin(pp->in[I_CIM])[(size_t)lgc * 64 + (k - 64)]);
      const int cc = lgc & 15, lg = lgc >> 4;
      CB[(((size_t)lg * 4 + (k >> 5)) * 64 + ((k >> 3) & 3) * 16 + cc) * 8 + (k & 7)] = cv;
    }
    bf16_t* WG = (bf16_t*)(ws + WS_WGLUT);
    for (int idx = gtid; idx < 4 * 512 * 256; idx += gn) {
      const int k = idx & 255, nn = (idx >> 8) & 511, l2 = idx >> 17;
      {
        const int which = nn >> 8, w8 = (nn >> 5) & 7, nt = (nn >> 4) & 1, frr = nn & 15, ks = k >> 5, fqq = (k >> 3) & 3, j = k & 7;
        WG[(((((size_t)l2 * 8 + w8) * 8 + ks) * 2 + which) * 2 + nt) * 512 + (fqq * 16 + frr) * 8 + j] = f2bf(gin(pp->in[I_WGLU])[((size_t)l2 * 256 + k) * 512 + nn]);
      }
    }
  }
  convert_tables_fp4(pp, ws, 0, gtid, gn);
  {
    __syncthreads();
    const int lane = tid & 63, wid = tid >> 6;
    float* scr = sm + wid * (64 * 33);
    constexpr int IT_IN = 16 * 96, IT_OUT = 16 * 32, IT_L = IT_IN + IT_OUT;
    for (int item = blockIdx.x * NW + wid; item < 4 * IT_L; item += gridDim.x * NW) {
      const int l = item / IT_L; int r = item - l * IT_L;
      const float* W; bf16_t* WT; int N, NP;
      if (r < IT_IN) { W = gin(pp->in[I_WIN]) + (size_t)l * 1024 * INC; WT = (bf16_t*)(ws + WS_WIN) + (size_t)l * INCP * 1024; N = INC; NP = 96; }
      else { r -= IT_IN; W = gin(pp->in[I_WOUT]) + (size_t)l * 1024 * 1024; WT = (bf16_t*)(ws + WS_WOUT) + (size_t)l * 1024 * 1024; N = 1024; NP = 32; }
      const int kb = r / NP, nb = r - kb * NP, k0 = kb * 64, n0 = nb * 32;
      const int nn = n0 + (lane & 31); const bool inb = nn < N;
      float v[32];
#pragma unroll
      for (int i = 0; i < 32; ++i) { const int kk = 2 * i + (lane >> 5); v[i] = inb ? W[(size_t)(k0 + kk) * N + nn] : 0.f; }
#pragma unroll
      for (int i = 0; i < 32; ++i) { const int kk = 2 * i + (lane >> 5); scr[kk * 33 + (lane & 31)] = v[i]; }
      const int c = lane & 7;
#pragma unroll
      for (int j = 0; j < 4; ++j) {
        const int n = (lane >> 3) + 8 * j; const float* sp = scr + (8 * c) * 33 + n;
        uint4 o; o.x = pk2(sp[0], sp[33]); o.y = pk2(sp[2 * 33], sp[3 * 33]); o.z = pk2(sp[4 * 33], sp[5 * 33]); o.w = pk2(sp[6 * 33], sp[7 * 33]);
        *(uint4*)(WT + (size_t)(n0 + n) * 1024 + k0 + 8 * c) = o;
      }
    }
    __syncthreads();
  }
  {
    bf16_t* WP = (bf16_t*)(ws + WS_WQ);
    const int lane = tid & 63, wid = tid >> 6, fr = lane & 15, fq = lane >> 4;
    unsigned char* skl = smem;
    for (int unit = blockIdx.x; unit < 4 * 16 * 4; unit += gridDim.x) {
      const int lhs = unit >> 2, l = lhs >> 4, hs = lhs & 15, kq = unit & 3;
      __syncthreads();
      {
        const float* SKb = gin(pp->in[I_SUBK]) + (size_t)lhs * 128 * 128;
#pragma unroll
        for (int i = 0; i < 4; ++i) {
          const int g = tid + NT * i, fl = g & 63, cs = g >> 6, ct = cs >> 2, ks = cs & 3;
          const float* sp = SKb + (size_t)(16 * ct + (fl & 15)) * 128 + 32 * ks + 8 * (fl >> 4);
          const f32x4 y0 = *(const f32x4*)sp, y1 = *(const f32x4*)(sp + 4);
          const float yv[8] = {y0.x, y0.y, y0.z, y0.w, y1.x, y1.y, y1.z, y1.w};
          bf16x8 bh, bl;
#pragma unroll
          for (int j = 0; j < 8; ++j) { const bf16_t h = f2bf(yv[j]); bh[j] = (short)h; bl[j] = (short)f2bf(yv[j] - bf2f(h)); }
          *(bf16x8*)(skl + (cs * 2 + 0) * 1024 + fl * 16) = bh;
          *(bf16x8*)(skl + (cs * 2 + 1) * 1024 + fl * 16) = bl;
        }
      }
      __syncthreads();
#pragma unroll 1
      for (int kk = 0; kk < 2; ++kk) {
        const int kb = 2 * kq + kk;
        const float* Wq = gin(pp->in[I_WQ]) + ((size_t)l * 1024 + kb * 128 + wid * 16 + fr) * 2048 + hs * 128 + 8 * fq;
        bf16x8 ah[4], al[4];
#pragma unroll
        for (int ks = 0; ks < 4; ++ks) {
          const f32x4 x0 = *(const f32x4*)(Wq + 32 * ks), x1 = *(const f32x4*)(Wq + 32 * ks + 4);
          const float xv[8] = {x0.x, x0.y, x0.z, x0.w, x1.x, x1.y, x1.z, x1.w};
#pragma unroll
          for (int j = 0; j < 8; ++j) { const bf16_t h = f2bf(xv[j]); ah[ks][j] = (short)h; al[ks][j] = (short)f2bf(xv[j] - bf2f(h)); }
        }
        f32x4 acc[8];
#pragma unroll
        for (int ct = 0; ct < 8; ++ct) acc[ct] = (f32x4){0.f, 0.f, 0.f, 0.f};
#pragma unroll
        for (int ct = 0; ct < 8; ++ct) {
#pragma unroll
          for (int ks = 0; ks < 4; ++ks) {
            const bf16x8 bh = *(const bf16x8*)(skl + ((ct * 4 + ks) * 2 + 0) * 1024 + lane * 16), bl = *(const bf16x8*)(skl + ((ct * 4 + ks) * 2 + 1) * 1024 + lane * 16);
            acc[ct] = __builtin_amdgcn_mfma_f32_16x16x32_bf16(ah[ks], bh, acc[ct], 0, 0, 0);
            acc[ct] = __builtin_amdgcn_mfma_f32_16x16x32_bf16(al[ks], bh, acc[ct], 0, 0, 0);
            acc[ct] = __builtin_amdgcn_mfma_f32_16x16x32_bf16(ah[ks], bl, acc[ct], 0, 0, 0);
          }
          __builtin_amdgcn_sched_barrier(0);
        }
#pragma unroll
        for (int ct = 0; ct < 8; ++ct)
          *(uint2*)(WP + ((size_t)l * 2048 + hs * 128 + 16 * ct + fr) * 1024 + kb * 128 + wid * 16 + 4 * fq) = make_uint2(pk2(acc[ct][0], acc[ct][1]), pk2(acc[ct][2], acc[ct][3]));
      }
    }
    __syncthreads();
  }
}

__device__ void qbias_phase(const Params& p, unsigned char* smem) {
  const CParamsP pp = launder_kargs();
  GAS unsigned char* const ws = launder_ptr(pp->ws); const int tid = launder_tid();
  float* C2 = (float*)(ws + WS_C2); const float* MOD = (const float*)(ws + WS_MOD); const bf16_t* WP = (const bf16_t*)(ws + WS_WQ);
  const int lane = tid & 63, gw = blockIdx.x * NW + (tid >> 6), nw = gridDim.x * NW;
  for (int o = gw; o < 4 * 2048; o += nw) {
    const int l = o >> 11;
    const uint4 w0 = *(const uint4*)(WP + (size_t)o * 1024 + lane * 16), w1 = *(const uint4*)(WP + (size_t)o * 1024 + lane * 16 + 8);
    const unsigned ww[8] = {w0.x, w0.y, w0.z, w0.w, w1.x, w1.y, w1.z, w1.w};
    const float* s0 = MOD + (size_t)l * 2 * 6144 + 3072 + lane * 16; const float* s1 = s0 + 6144;
    float a0 = 0.f, a1 = 0.f;
#pragma unroll
    for (int q = 0; q < 8; ++q) {
      const float wl = __uint_as_float(ww[q] << 16), wh = __uint_as_float(ww[q] & 0xffff0000u);
      a0 += s0[2 * q] * wl + s0[2 * q + 1] * wh; a1 += s1[2 * q] * wl + s1[2 * q + 1] * wh;
    }
    a0 = wave_sum(a0); a1 = wave_sum(a1);
    if (lane == 0) { C2[((size_t)l * 2 + 0) * 2048 + (o & 2047)] = a0; C2[((size_t)l * 2 + 1) * 2048 + (o & 2047)] = a1; }
  }
  (void)smem;
}

__device__ void norm_mod_phase(const float* __restrict__ xsrc, const float* __restrict__ gain, const float* __restrict__ mod_sh, const float* __restrict__ mod_sc,
                               bf16_t* __restrict__ outp, bf16_t* __restrict__ xcopy) {
  const int tidx = launder_tid();
  const int lane = tidx & 63, gw = blockIdx.x * NW + (tidx >> 6), nw = gridDim.x * NW;
  for (int t = gw; t < T_; t += nw) {
    const int b = t >> 13;
    const f32x4* xr = (const f32x4*)(xsrc + (size_t)t * 1024) + lane;
    f32x4 v[4]; float s = 0.f;
#pragma unroll
    for (int j = 0; j < 4; ++j) { v[j] = xr[64 * j]; s += v[j].x * v[j].x + v[j].y * v[j].y + v[j].z * v[j].z + v[j].w * v[j].w; }
    const float rstd = rsqrtf(wave_sum(s) * (1.f / 1024.f) + EPS_);
#pragma unroll
    for (int j = 0; j < 4; ++j) {
      const int c = lane * 4 + 256 * j;
      const f32x4 g = *(const f32x4*)(gain + c), sh = *(const f32x4*)(mod_sh + b * 6144 + c), sc = *(const f32x4*)(mod_sc + b * 6144 + c);
      const float o0 = v[j].x * rstd * g.x * (1.f + sc.x) + sh.x, o1 = v[j].y * rstd * g.y * (1.f + sc.y) + sh.y;
      const float o2 = v[j].z * rstd * g.z * (1.f + sc.z) + sh.z, o3 = v[j].w * rstd * g.w * (1.f + sc.w) + sh.w;
      uint2 o; o.x = pk2(o0, o1); o.y = pk2(o2, o3);
      *(uint2*)(outp + (size_t)t * 1024 + c) = o;
      uint2 xc; xc.x = pk2(v[j].x, v[j].y); xc.y = pk2(v[j].z, v[j].w);
      *(uint2*)(xcopy + (size_t)t * 1024 + c) = xc;
    }
  }
}


namespace pg8 {
#define PG8_LAS __attribute__((address_space(3)))
typedef unsigned u32x4 __attribute__((ext_vector_type(4)));
constexpr int BM = 256, BK = 64, HALF = 128, HTB = HALF * BK * 2, STAGE_BYTES = 8 * HTB, NXCD = 8, WGM = 8;
__host__ __device__ __forceinline__ int lds_byte(int r, int c) { const int st = (r >> 4) * 2 + (c >> 5), rr = r & 15, cc = c & 31, ob = rr * 64 + cc * 2; return st * 1024 + (ob ^ (((ob >> 9) & 1) << 5)); }
__host__ __device__ __forceinline__ void stage_rc(int b, int& R, int& C) { const int st = b / 1024, sb = b % 1024, swz = sb ^ (((sb >> 9) & 1) << 5); R = (st >> 1) * 16 + swz / 64; C = (st & 1) * 32 + (swz % 64) / 2; }
__host__ __device__ __forceinline__ int perm32(int rho) { const int n = rho >> 4, i = rho & 15; return 8 * (i >> 2) + 4 * n + (i & 3); }
struct Unit { int pm, pn; };
struct Gemm { const bf16_t* A; const bf16_t* Bt; int M, N, K; };
struct StaticOrder {
    int nM, nN, nwg, G, c;
    __host__ __device__ void init(int M, int N, int G_, int c_) { nM = M / BM; nN = N / BM; nwg = nM * nN; G = G_; c = c_; }
    __host__ __device__ bool next(int i, Unit& u) const {
        const long L = (long)i * G + c; if (L >= nwg) return false;
        int wgid = (int)L; { const int q = nwg / NXCD, r = nwg % NXCD, xcd = wgid % NXCD, off = wgid / NXCD; wgid = (xcd < r ? xcd * (q + 1) : r * (q + 1) + (xcd - r) * q) + off; }
        const int nig = WGM * nN, gid = wgid / nig, fm = gid * WGM, gsz = (nM - fm) < WGM ? (nM - fm) : WGM;
        u.pm = fm + ((wgid % nig) % gsz); u.pn = (wgid % nig) / gsz; return true;
    }
    __device__ __forceinline__ void a_ready(const Unit&) const {}
    __device__ __forceinline__ void done(const Unit&) const {}
};
__device__ __forceinline__ unsigned cvt_pk_bf16(float lo, float hi) { unsigned r; asm volatile("v_cvt_pk_bf16_f32 %0, %1, %2" : "=v"(r) : "v"(lo), "v"(hi)); return r; }
template <class Epi, class Sched>
__device__ __forceinline__ void gemm_phase(PG8_LAS unsigned char* lds, const Gemm g, const Sched& S, const Epi& E) {
    const int tid = launder_tid(), wid = __builtin_amdgcn_readfirstlane(tid >> 6), lane = tid & 63, wr = wid >> 2, wc = wid & 3, fr = lane & 15, fq = lane >> 4;
    const int K = g.K, nt = K / BK;
    unsigned voffA[2], voffB[2];
#pragma unroll
    for (int i = 0; i < 2; ++i) { int R, C; stage_rc(tid * 16 + i * 8192, R, C); const int Rb = Epi::PERM ? ((R & ~31) + perm32(R & 31)) : R;
        voffA[i] = (unsigned)(R * K + C) * 2u; voffB[i] = (unsigned)(Rb * K + C) * 2u; }
    const size_t kstep = (size_t)(BK * 2);
    const size_t hstep = (size_t)HALF * K * 2;
    const size_t tstep = 2 * hstep;
    const unsigned ldsw = (unsigned)wid * 1024u;
    const int aoff = lds_byte(wr * 64 + fr, fq * 8), boff = lds_byte(wc * 32 + fr, fq * 8);
#define PG8_SA(b, h) (((b) * 2 + (h)) * HTB)
#define PG8_SB(b, h) ((4 + (b) * 2 + (h)) * HTB)
#define PG8_STAGE(bufoff, gbase, voff) do { _Pragma("unroll") for (int _i = 0; _i < 2; ++_i) \
        __builtin_amdgcn_global_load_lds((const unsigned*)((const char*)(gbase) + (voff)[_i]), (PG8_LAS unsigned*)(lds + (bufoff) + ldsw + _i * 8192), 16, 0, 0); } while (0)
#define PG8_LDA(dst, b, h) do { _Pragma("unroll") for (int m = 0; m < 4; ++m) _Pragma("unroll") for (int k = 0; k < 2; ++k) dst[m][k] = *(const PG8_LAS bf16x8*)(lds + PG8_SA(b, h) + aoff + m * 2048 + k * 1024); } while (0)
#define PG8_LDB(dst, b, h) do { _Pragma("unroll") for (int n = 0; n < 2; ++n) _Pragma("unroll") for (int k = 0; k < 2; ++k) dst[n][k] = *(const PG8_LAS bf16x8*)(lds + PG8_SB(b, h) + boff + n * 2048 + k * 1024); } while (0)
#define PG8_MMA(ai, bj, At, Bt) do { __builtin_amdgcn_s_setprio(1); _Pragma("unroll") for (int m = 0; m < 4; ++m) _Pragma("unroll") for (int n = 0; n < 2; ++n) _Pragma("unroll") for (int k = 0; k < 2; ++k) \
        acc[ai][bj][m][n] = __builtin_amdgcn_mfma_f32_16x16x32_bf16(Bt[n][k], At[m][k], acc[ai][bj][m][n], 0, 0, 0); __builtin_amdgcn_s_setprio(0); } while (0)
#define PG8_WAIT_V(n) asm volatile("s_waitcnt vmcnt(" #n ")" ::: "memory")
#define PG8_WAIT_L(n) asm volatile("s_waitcnt lgkmcnt(" #n ")" ::: "memory")
#define PG8_BAR __builtin_amdgcn_s_barrier()
#define PG8_SCHED __builtin_amdgcn_sched_barrier(0)
    Unit cur, nxt; int ui = 0;
    if (!S.next(0, cur)) return;
    f32x4 acc[2][2][4][2];
#pragma unroll
    for (int a = 0; a < 2; ++a)
#pragma unroll
        for (int b = 0; b < 2; ++b)
#pragma unroll
            for (int m = 0; m < 4; ++m)
#pragma unroll
                for (int n = 0; n < 2; ++n) acc[a][b][m][n] = (f32x4){0.f, 0.f, 0.f, 0.f};
    bf16x8 At[4][2], B0[2][2], B1[2][2];
    const char* cA = (const char*)g.A + (size_t)cur.pm * tstep; const char* cB = (const char*)g.Bt + (size_t)cur.pn * tstep;
    S.a_ready(cur);
    PG8_STAGE(PG8_SB(0, 0), cB, voffB); PG8_STAGE(PG8_SA(0, 0), cA, voffA); PG8_STAGE(PG8_SB(0, 1), cB + hstep, voffB); PG8_STAGE(PG8_SA(0, 1), cA + hstep, voffA);
    if (wr == 1) PG8_BAR;
    PG8_WAIT_V(4); PG8_BAR;
    PG8_STAGE(PG8_SB(1, 0), cB + kstep, voffB); PG8_STAGE(PG8_SA(1, 0), cA + kstep, voffA); PG8_STAGE(PG8_SB(1, 1), cB + hstep + kstep, voffB);
    PG8_WAIT_V(6); PG8_BAR;
    for (;;) {
        const bool has_next = S.next(ui + 1, nxt);
        const char* nA = has_next ? (const char*)g.A + (size_t)nxt.pm * tstep : cA; const char* nB = has_next ? (const char*)g.Bt + (size_t)nxt.pn * tstep : cB;
        for (int t = 0; t < nt; t += 2) {
            const bool last = (t == nt - 2);
            const char* a1 = cA + (size_t)(t + 1) * kstep;
            const char* a2 = last ? nA : cA + (size_t)(t + 2) * kstep; const char* b2 = last ? nB : cB + (size_t)(t + 2) * kstep;
            const char* a3 = a2 + kstep; const char* b3 = b2 + kstep;
            if (last && has_next) S.a_ready(nxt);
            PG8_LDB(B0, 0, 0); PG8_SCHED; PG8_LDA(At, 0, 0); PG8_STAGE(PG8_SA(1, 1), a1 + hstep, voffA);
            PG8_WAIT_L(8); PG8_BAR; PG8_WAIT_L(0); PG8_MMA(0, 0, At, B0); PG8_BAR; PG8_SCHED;
            PG8_LDB(B1, 0, 1); PG8_STAGE(PG8_SB(0, 0), b2, voffB);
            PG8_BAR; PG8_WAIT_L(0); PG8_MMA(0, 1, At, B1); PG8_BAR;
            PG8_LDA(At, 0, 1); PG8_STAGE(PG8_SA(0, 0), a2, voffA);
            PG8_BAR; PG8_WAIT_L(0); PG8_MMA(1, 0, At, B0); PG8_BAR; PG8_SCHED;
            PG8_STAGE(PG8_SB(0, 1), b2 + hstep, voffB);
            PG8_WAIT_V(6); PG8_BAR; PG8_MMA(1, 1, At, B1); PG8_BAR;
            PG8_LDB(B0, 1, 0); PG8_SCHED; PG8_LDA(At, 1, 0); PG8_STAGE(PG8_SA(0, 1), a2 + hstep, voffA);
            PG8_WAIT_L(8); PG8_BAR; PG8_WAIT_L(0); PG8_MMA(0, 0, At, B0); PG8_BAR; PG8_SCHED;
            PG8_LDB(B1, 1, 1); PG8_STAGE(PG8_SB(1, 0), b3, voffB);
            PG8_BAR; PG8_WAIT_L(0); PG8_MMA(0, 1, At, B1); PG8_BAR;
            PG8_LDA(At, 1, 1); PG8_STAGE(PG8_SA(1, 0), a3, voffA);
            PG8_BAR; PG8_WAIT_L(0); PG8_MMA(1, 0, At, B0); PG8_BAR; PG8_SCHED;
            PG8_STAGE(PG8_SB(1, 1), b3 + hstep, voffB);
            PG8_WAIT_V(6); PG8_BAR; PG8_MMA(1, 1, At, B1); PG8_BAR;
        }
        if constexpr (!Epi::AFTER_DRAIN) { E(acc, cur, wr, wc, fr, fq); S.done(cur); }
        if (!has_next) break;
#pragma unroll
        for (int a = 0; a < 2; ++a)
#pragma unroll
            for (int b = 0; b < 2; ++b)
#pragma unroll
                for (int m = 0; m < 4; ++m)
#pragma unroll
                    for (int n = 0; n < 2; ++n) acc[a][b][m][n] = (f32x4){0.f, 0.f, 0.f, 0.f};
        cur = nxt; cA = nA; cB = nB; ++ui;
    }
    PG8_WAIT_V(0);
    if (wr == 0) PG8_BAR;
    PG8_BAR;
    if constexpr (Epi::AFTER_DRAIN) { E.fused(acc, cur, wr, wc, fr, fq, lds, wid, lane); S.done(cur); }
#undef PG8_SA
#undef PG8_SB
#undef PG8_STAGE
#undef PG8_LDA
#undef PG8_LDB
#undef PG8_MMA
#undef PG8_WAIT_V
#undef PG8_WAIT_L
#undef PG8_BAR
#undef PG8_SCHED
}
}

__device__ __forceinline__ float ssq_total(const float* __restrict__ SSQ, int t) {
  const f32x4 a = *(const f32x4*)(SSQ + (size_t)t * 4), b = *(const f32x4*)(SSQ + ((size_t)T_ + t) * 4), c = *(const f32x4*)(SSQ + ((size_t)2 * T_ + t) * 4), d = *(const f32x4*)(SSQ + ((size_t)3 * T_ + t) * 4);
  return (((a.x + a.y) + (a.z + a.w)) + ((b.x + b.y) + (b.z + b.w))) + (((c.x + c.y) + (c.z + c.w)) + ((d.x + d.y) + (d.z + d.w)));
}
struct EpiProj {
  static constexpr bool PERM = true, AFTER_DRAIN = false;
  bf16_t* PROJ; bf16_t* VTA; bf16_t* VTR;
  __device__ __forceinline__ void operator()(const f32x4 (&acc)[2][2][4][2], const pg8::Unit& u, int wr, int wc, int fr, int fq) const {
    const int row0 = u.pm * 256 + wr * 64 + fr, col0 = u.pn * 256 + wc * 32 + 8 * fq;
    asm volatile("s_nop 15\n\ts_nop 15" ::: "memory");
#pragma unroll
    for (int ai = 0; ai < 2; ++ai)
#pragma unroll
      for (int m = 0; m < 4; ++m) {
        const int t = row0 + ai * 128 + m * 16;
#pragma unroll
        for (int bj = 0; bj < 2; ++bj) {
          const int c = col0 + bj * 128;
          const f32x4 v0 = acc[ai][bj][m][0], v1 = acc[ai][bj][m][1];
          pg8::u32x4 w; w.x = pg8::cvt_pk_bf16(v0[0], v0[1]); w.y = pg8::cvt_pk_bf16(v0[2], v0[3]); w.z = pg8::cvt_pk_bf16(v1[0], v1[1]); w.w = pg8::cvt_pk_bf16(v1[2], v1[3]);
          *(pg8::u32x4*)(PROJ + (size_t)t * INCP + c) = w;
          const bool isva = (c >= C_VA && c < C_VA + 384), isvr = (c >= C_VR && c < C_VR + 384);
          if (isva || isvr) {
            bf16_t* vt = (isva ? VTA : VTR) + ((size_t)(t >> 13) * 384 + (c - (isva ? C_VA : C_VR))) * 8192 + (t & 8191);
            vt[0] = (bf16_t)(w.x & 0xffffu); vt[8192] = (bf16_t)(w.x >> 16); vt[2 * 8192] = (bf16_t)(w.y & 0xffffu); vt[3 * 8192] = (bf16_t)(w.y >> 16);
            vt[4 * 8192] = (bf16_t)(w.z & 0xffffu); vt[5 * 8192] = (bf16_t)(w.z >> 16); vt[6 * 8192] = (bf16_t)(w.w & 0xffffu); vt[7 * 8192] = (bf16_t)(w.w >> 16);
          }
        }
      }
  }
};
struct EpiOut {
  static constexpr bool PERM = true, AFTER_DRAIN = false;
  const float* g1; const float* nf; const float* sc2; GAS unsigned char* Xg; GAS unsigned char* XGg; GAS unsigned char* SSQg;
  __device__ __forceinline__ void operator()(const f32x4 (&acc)[2][2][4][2], const pg8::Unit& u, int wr, int wc, int fr, int fq) const {
    const int row0 = u.pm * 256 + wr * 64 + fr, col0 = u.pn * 256 + wc * 32 + 8 * fq, b = (u.pm * 256) >> 13;
    f32x4 gg[2][2], gs[2][2];
#pragma unroll
    for (int bj = 0; bj < 2; ++bj)
#pragma unroll
      for (int n = 0; n < 2; ++n) {
        const int c = col0 + bj * 128 + n * 4;
        gg[bj][n] = *(const f32x4*)(g1 + b * 6144 + c);
        const f32x4 gf = *(const f32x4*)(nf + c), sc = *(const f32x4*)(sc2 + b * 6144 + c);
        gs[bj][n] = gf * (sc + 1.f);
      }
#pragma unroll
    for (int ai = 0; ai < 2; ++ai) {
      pg8::u32x4 raw[4][2];
#pragma unroll
      for (int m = 0; m < 4; ++m)
#pragma unroll
        for (int bj = 0; bj < 2; ++bj) raw[m][bj] = *(const GAS pg8::u32x4*)(Xg + (unsigned)((row0 + ai * 128 + m * 16) * 1024 + col0 + bj * 128) * 2u);
      __builtin_amdgcn_sched_barrier(0);
#pragma unroll
      for (int m = 0; m < 4; ++m) {
        const int t = row0 + ai * 128 + m * 16;
        float sq = 0.f;
#pragma unroll
        for (int bj = 0; bj < 2; ++bj) {
          const unsigned off = (unsigned)(t * 1024 + col0 + bj * 128) * 2u;
          const pg8::u32x4 xr = raw[m][bj];
          const f32x4 x0 = (f32x4){__uint_as_float(xr.x << 16), __uint_as_float(xr.x & 0xffff0000u), __uint_as_float(xr.y << 16), __uint_as_float(xr.y & 0xffff0000u)};
          const f32x4 x1 = (f32x4){__uint_as_float(xr.z << 16), __uint_as_float(xr.z & 0xffff0000u), __uint_as_float(xr.w << 16), __uint_as_float(xr.w & 0xffff0000u)};
          const f32x4 n0 = x0 + gg[bj][0] * acc[ai][bj][m][0], n1 = x1 + gg[bj][1] * acc[ai][bj][m][1];
          pg8::u32x4 xo; xo.x = pg8::cvt_pk_bf16(n0.x, n0.y); xo.y = pg8::cvt_pk_bf16(n0.z, n0.w); xo.z = pg8::cvt_pk_bf16(n1.x, n1.y); xo.w = pg8::cvt_pk_bf16(n1.z, n1.w);
          *(GAS pg8::u32x4*)(Xg + off) = xo;
          const f32x4 s0 = n0 * gs[bj][0], s1 = n1 * gs[bj][1];
          pg8::u32x4 go; go.x = pg8::cvt_pk_bf16(s0.x, s0.y); go.y = pg8::cvt_pk_bf16(s0.z, s0.w); go.z = pg8::cvt_pk_bf16(s1.x, s1.y); go.w = pg8::cvt_pk_bf16(s1.z, s1.w);
          *(GAS pg8::u32x4*)(XGg + off) = go;
          sq += ((n0.x * n0.x + n0.y * n0.y) + (n0.z * n0.z + n0.w * n0.w)) + ((n1.x * n1.x + n1.y * n1.y) + (n1.z * n1.z + n1.w * n1.w));
        }
        sq = xsum_16_32(sq);
        if (fq == 0) *(GAS float*)(SSQg + (unsigned)((u.pn * T_ + t) * 4 + wc) * 4u) = sq;
      }
      __builtin_amdgcn_sched_barrier(0);
    }
  }
};
struct EpiQ {
  static constexpr bool PERM = true, AFTER_DRAIN = false;
  bf16_t* SC8; const float* SSQ; const float* C2;
  __device__ __forceinline__ void operator()(const f32x4 (&acc)[2][2][4][2], const pg8::Unit& u, int wr, int wc, int fr, int fq) const {
    const int row0 = u.pm * 256 + wr * 64 + fr, col0 = u.pn * 256 + wc * 32 + 8 * fq, b = (u.pm * 256) >> 13;
    f32x4 cc[2][2];
#pragma unroll
    for (int bj = 0; bj < 2; ++bj) { cc[bj][0] = *(const f32x4*)(C2 + b * 2048 + col0 + bj * 128); cc[bj][1] = *(const f32x4*)(C2 + b * 2048 + col0 + bj * 128 + 4); }
    float rs8[8];
    {
      f32x4 pq[8];
#pragma unroll
      for (int am = 0; am < 8; ++am) pq[am] = *(const f32x4*)(SSQ + ((size_t)fq * T_ + (row0 + (am >> 2) * 128 + (am & 3) * 16)) * 4);
#pragma unroll
      for (int am = 0; am < 8; ++am) {
        float sq = (pq[am].x + pq[am].y) + (pq[am].z + pq[am].w);
        sq = xsum_16_32(sq);
        rs8[am] = rsqrtf(sq * (1.f / 1024.f) + EPS_);
      }
    }
#pragma unroll
    for (int ai = 0; ai < 2; ++ai)
#pragma unroll
      for (int m = 0; m < 4; ++m) {
        const int t = row0 + ai * 128 + m * 16;
        const float rstd = rs8[ai * 4 + m];
#pragma unroll
        for (int bj = 0; bj < 2; ++bj) {
          const f32x4 v0 = acc[ai][bj][m][0] * rstd + cc[bj][0], v1 = acc[ai][bj][m][1] * rstd + cc[bj][1];
          pg8::u32x4 w; w.x = pg8::cvt_pk_bf16(v0[0], v0[1]); w.y = pg8::cvt_pk_bf16(v0[2], v0[3]); w.z = pg8::cvt_pk_bf16(v1[0], v1[1]); w.w = pg8::cvt_pk_bf16(v1[2], v1[3]);
          *(pg8::u32x4*)(SC8 + ((size_t)((col0 + bj * 128) >> 3) * T_ + t) * 8) = w;
        }
      }
  }
};

struct ProjOrder : pg8::StaticOrder {
  __device__ bool next(int i, pg8::Unit& u) const { if (!pg8::StaticOrder::next(i, u)) return false; u.pn = (int)((0xBA9652107483ull >> (4 * u.pn)) & 15ull); return true; }
};
__device__ void gemm_proj_phase(const Params& p, int l, unsigned char* smem) {
  const CParamsP pp = launder_kargs();
  GAS unsigned char* const ws = launder_ptr(pp->ws);
  pg8::Gemm g; g.A = (const bf16_t*)(ws + WS_ABUF); g.Bt = (const bf16_t*)(ws + WS_WIN) + (size_t)l * INCP * 1024; g.M = T_; g.N = INCP; g.K = 1024;
  ProjOrder S; S.init(T_, INCP, gridDim.x, blockIdx.x);
  EpiProj E; E.PROJ = (bf16_t*)(ws + WS_PROJ); E.VTA = (bf16_t*)(ws + WS_VTA); E.VTR = (bf16_t*)(ws + WS_VTR);
  pg8::gemm_phase<EpiProj, ProjOrder>((PG8_LAS unsigned char*)smem, g, S, E);
}
__device__ void gemm_out_phase(const Params& p, int l, unsigned char* smem) {
  const CParamsP pp = launder_kargs();
  GAS unsigned char* const ws = launder_ptr(pp->ws);
  pg8::Gemm g; g.A = (const bf16_t*)(ws + WS_ABUF); g.Bt = (const bf16_t*)(ws + WS_WOUT) + (size_t)l * 1024 * 1024; g.M = T_; g.N = 1024; g.K = 1024;
  pg8::StaticOrder S; S.init(T_, 1024, gridDim.x, blockIdx.x);
  EpiOut E; E.g1 = (const float*)(ws + WS_MOD) + (size_t)l * 2 * 6144 + 2048; E.nf = gin(pp->in[I_NFFN]) + (size_t)l * 1024; E.sc2 = (const float*)(ws + WS_MOD) + (size_t)l * 2 * 6144 + 4096;
  E.Xg = ws + WS_X; E.XGg = ws + WS_XG; E.SSQg = ws + WS_SSQ;
  pg8::gemm_phase<EpiOut, pg8::StaticOrder>((PG8_LAS unsigned char*)smem, g, S, E);
}
__device__ void gemm_q_phase(const Params& p, int l, unsigned char* smem) {
  const CParamsP pp = launder_kargs();
  GAS unsigned char* const ws = launder_ptr(pp->ws);
  pg8::Gemm g; g.A = (const bf16_t*)(ws + WS_XG); g.Bt = (const bf16_t*)(ws + WS_WQ) + (size_t)l * 2048 * 1024; g.M = T_; g.N = 2048; g.K = 1024;
  pg8::StaticOrder S; S.init(T_, 2048, gridDim.x, blockIdx.x);
  EpiQ E; E.SC8 = (bf16_t*)(ws + WS_SC); E.SSQ = (const float*)(ws + WS_SSQ); E.C2 = (const float*)(ws + WS_C2) + (size_t)l * 2 * 2048;
  pg8::gemm_phase<EpiQ, pg8::StaticOrder>((PG8_LAS unsigned char*)smem, g, S, E);
}

__device__ __forceinline__ int attn_fk(int r) { return ((r >> 3) & 3) | (((r >> 1) & 1) << 2); }
__device__ __forceinline__ int attn_fv(int r) { return (r >> 1) & 7; }
__device__ void attn_phase(const Params& p, int l, unsigned char* smem) {
  const CParamsP pp = launder_kargs();
  GAS unsigned char* const ws = launder_ptr(pp->ws); const int tidx = launder_tid();
  const bf16_t* PROJ = (const bf16_t*)(ws + WS_PROJ); const bf16_t* VTA = (const bf16_t*)(ws + WS_VTA);
  bf16_t* ATT = (bf16_t*)(ws + WS_ATT);
  const int lane = tidx & 63, wid = tidx >> 6, fr = lane & 15, fq = lane >> 4;
  float* ext = (float*)smem;
  unsigned char* stg = smem + 15360;
  constexpr float LOG2E = 1.4426950408889634f;
  __syncthreads();
  for (int idx = tidx; idx < 6 * 640; idx += NT) {
    const int h = idx / 640, e = idx - h * 640; int d = e - 63; d = d > 256 ? 256 : d;
    ext[idx] = gin(pp->in[I_RELB])[((size_t)l * 6 + h) * 513 + d + 256] * LOG2E;
  }
  const int hh = wid >> 2, qb = wid & 3, iq = qb * 16 + fr;
  const int srow = tidx >> 3, sch = tidx & 7;
  const int fk_l = attn_fk(8 * (fr >> 2) + (fr & 3)), fv_l = attn_fv(fr);
  const unsigned char* const kb0 = stg + hh * 8192 + (8 * (fr >> 2) + (fr & 3)) * 128 + ((fq ^ fk_l) << 4);
  const unsigned char* const kb1 = stg + hh * 8192 + (8 * (fr >> 2) + (fr & 3)) * 128 + (((4 + fq) ^ fk_l) << 4);
  const unsigned char* const vb0 = stg + 49152 + hh * 8192 + fr * 128 + ((fq ^ fv_l) << 4);
  const unsigned char* const vb1 = stg + 49152 + hh * 8192 + fr * 128 + (((4 + fq) ^ fv_l) << 4);
  const float* const exb = ext + hh * 640 + 63 + 512 + iq - 8 * fq;
  for (int it_ = blockIdx.x; it_ < 256; it_ += gridDim.x) {
    const int item = ((it_ & 7) << 5) | (it_ >> 3);
    const int b = item >> 7, n = item & 127, t0 = b * 8192 + n * 64;
    const int jc0 = n >= 8 ? 0 : 8 - n;
    u32x4v sk[6], sv[6];
#define ATTN_LOAD(jc_) do { const int _m = n - 8 + (jc_); \
      _Pragma("unroll") for (int h = 0; h < 6; ++h) { \
        sk[h] = *(const u32x4v*)(PROJ + (size_t)(b * 8192 + _m * 64 + srow) * INCP + C_KA + h * 64 + sch * 8); \
        sv[h] = *(const u32x4v*)(VTA + ((size_t)b * 384 + h * 64 + srow) * 8192 + _m * 64 + sch * 8); } } while (0)
#define ATTN_WRITE() do { \
      _Pragma("unroll") for (int h = 0; h < 6; ++h) { \
        *(u32x4v*)(stg + h * 8192 + srow * 128 + ((sch ^ attn_fk(srow)) << 4)) = sk[h]; \
        *(u32x4v*)(stg + (6 + h) * 8192 + srow * 128 + ((sch ^ attn_fv(srow)) << 4)) = sv[h]; } } while (0)
    __syncthreads();
    ATTN_LOAD(jc0);
    bf16x8 qf[3][2];
    f32x4 o[3][4];
    float mrun[3], lrun[3];
#pragma unroll
    for (int r = 0; r < 3; ++r) {
#pragma unroll
      for (int ds = 0; ds < 2; ++ds) qf[r][ds] = *(const bf16x8*)(PROJ + (size_t)(t0 + iq) * INCP + C_QA + (2 * r + hh) * 64 + ds * 32 + fq * 8);
#pragma unroll
      for (int et = 0; et < 4; ++et) o[r][et] = (f32x4){0.f, 0.f, 0.f, 0.f};
      mrun[r] = -1e30f; lrun[r] = 0.f;
    }
    ATTN_WRITE();
    __syncthreads();
    auto attn_task = [&](bf16x8 (&qfr)[2], f32x4 (&orr)[4], float& mr, float& lr, const int koff  , const int boff  , const int hcol  , const int jc) {
      float sc[2][2][4];
      bf16x8 kfr[2][2][2], vfr[2][4]; float bia[2][2][4];
#pragma unroll
      for (int g = 0; g < 2; ++g)
#pragma unroll
        for (int tt = 0; tt < 2; ++tt) {
          kfr[g][tt][0] = *(const bf16x8*)(kb0 + koff + 4096 * g + 512 * tt);
          kfr[g][tt][1] = *(const bf16x8*)(kb1 + koff + 4096 * g + 512 * tt);
        }
      const float* exj = exb + boff - 64 * jc;
#pragma unroll
      for (int g = 0; g < 2; ++g)
#pragma unroll
        for (int tt = 0; tt < 2; ++tt)
#pragma unroll
          for (int j = 0; j < 4; ++j) bia[g][tt][j] = exj[-(32 * g + 4 * tt + j)];
      __builtin_amdgcn_sched_barrier(0);
#pragma unroll
      for (int g = 0; g < 2; ++g)
#pragma unroll
        for (int tt = 0; tt < 2; ++tt) {
          f32x4 s4 = __builtin_amdgcn_mfma_f32_16x16x32_bf16(kfr[g][tt][0], qfr[0], (f32x4){0.f, 0.f, 0.f, 0.f}, 0, 0, 0);
          s4 = __builtin_amdgcn_mfma_f32_16x16x32_bf16(kfr[g][tt][1], qfr[1], s4, 0, 0, 0);
#pragma unroll
          for (int j = 0; j < 4; ++j) sc[g][tt][j] = s4[j] * (0.125f * LOG2E) + bia[g][tt][j];
        }
#pragma unroll
      for (int et = 0; et < 4; ++et) { vfr[0][et] = *(const bf16x8*)(vb0 + koff + 2048 * et); vfr[1][et] = *(const bf16x8*)(vb1 + koff + 2048 * et); }
      __builtin_amdgcn_sched_barrier(0);
      float mloc = -1e30f;
#pragma unroll
      for (int g = 0; g < 2; ++g)
#pragma unroll
        for (int tt = 0; tt < 2; ++tt)
#pragma unroll
          for (int j = 0; j < 4; ++j) mloc = fmaxf(mloc, sc[g][tt][j]);
      mloc = xmax_16_32(mloc);
      const float mnew = fmaxf(mr, mloc), alpha = __builtin_amdgcn_exp2f(mr - mnew);
      mr = mnew;
      float ls = 0.f;
#pragma unroll
      for (int g = 0; g < 2; ++g)
#pragma unroll
        for (int tt = 0; tt < 2; ++tt)
#pragma unroll
          for (int j = 0; j < 4; ++j) { const float e = __builtin_amdgcn_exp2f(sc[g][tt][j] - mnew); sc[g][tt][j] = e; ls += e; }
      lr = lr * alpha + ls;
#pragma unroll
      for (int et = 0; et < 4; ++et) { orr[et].x *= alpha; orr[et].y *= alpha; orr[et].z *= alpha; orr[et].w *= alpha; }
#pragma unroll
      for (int g = 0; g < 2; ++g) {
        union { bf16x8 v; unsigned u[4]; } pf;
        pf.u[0] = pk2(sc[g][0][0], sc[g][0][1]); pf.u[1] = pk2(sc[g][0][2], sc[g][0][3]);
        pf.u[2] = pk2(sc[g][1][0], sc[g][1][1]); pf.u[3] = pk2(sc[g][1][2], sc[g][1][3]);
#pragma unroll
        for (int et = 0; et < 4; ++et) orr[et] = __builtin_amdgcn_mfma_f32_16x16x32_bf16(vfr[g][et], pf.v, orr[et], 0, 0, 0);
      }
      if (jc == 8) {
        const float lt = xsum_16_32(lr);
        const float inv = 1.f / lt;
#pragma unroll
        for (int et = 0; et < 4; ++et) {
          f32x4 v = orr[et]; v.x *= inv; v.y *= inv; v.z *= inv; v.w *= inv;
          { uint2 ov; ov.x = pk2(v.x, v.y); ov.y = pk2(v.z, v.w); *(uint2*)(ATT + (size_t)(t0 + iq) * 384 + hcol + et * 16 + fq * 4) = ov; }
        }
      }
    };
#pragma unroll 1
    for (int jc = jc0; jc < 9; ++jc) {
      if (jc < 8) ATTN_LOAD(jc + 1);
      attn_task(qf[0], o[0], mrun[0], lrun[0], 0, 0, hh * 64, jc);
      attn_task(qf[1], o[1], mrun[1], lrun[1], 16384, 1280, (2 + hh) * 64, jc);
      attn_task(qf[2], o[2], mrun[2], lrun[2], 32768, 2560, (4 + hh) * 64, jc);
      if (jc < 8) {
        __syncthreads();
        ATTN_WRITE();
        __syncthreads();
      }
    }
#undef ATTN_LOAD
#undef ATTN_WRITE
  }
  __syncthreads();
}

__device__ __forceinline__ void ssm_bu32(const bf16_t* __restrict__ bbh_g, const bf16_t* __restrict__ urow, int lane,
                                         f32x16& lo_re, f32x16& hi_re, f32x16& lo_im, f32x16& hi_im) {
  const int hf = lane >> 5;
  const bf16x8 ub = *(const bf16x8*)(urow + 8 * hf);
  f32x16 z;
#pragma unroll
  for (int r = 0; r < 16; ++r) z[r] = 0.f;
  const bf16x8 a0r = *(const bf16x8*)(bbh_g + (size_t)(0 * 64 + lane) * 8), a1r = *(const bf16x8*)(bbh_g + (size_t)(1 * 64 + lane) * 8);
  const bf16x8 a0i = *(const bf16x8*)(bbh_g + (size_t)(2 * 64 + lane) * 8), a1i = *(const bf16x8*)(bbh_g + (size_t)(3 * 64 + lane) * 8);
  lo_re = __builtin_amdgcn_mfma_f32_32x32x16_bf16(ub, a0r, z, 0, 0, 0); hi_re = __builtin_amdgcn_mfma_f32_32x32x16_bf16(ub, a1r, z, 0, 0, 0);
  lo_im = __builtin_amdgcn_mfma_f32_32x32x16_bf16(ub, a0i, z, 0, 0, 0); hi_im = __builtin_amdgcn_mfma_f32_32x32x16_bf16(ub, a1i, z, 0, 0, 0);
#pragma unroll
  for (int r = 0; r < 16; ++r) {
    const auto s1 = __builtin_amdgcn_permlane32_swap(__float_as_uint(lo_re[r]), __float_as_uint(hi_re[r]), false, false);
    lo_re[r] = __uint_as_float(s1[0]); hi_re[r] = __uint_as_float(s1[1]);
    const auto s2 = __builtin_amdgcn_permlane32_swap(__float_as_uint(lo_im[r]), __float_as_uint(hi_im[r]), false, false);
    lo_im[r] = __uint_as_float(s2[0]); hi_im[r] = __uint_as_float(s2[1]);
  }
}
__device__ __forceinline__ void rotary_frag(const bf16x8 x0, const bf16x8 x1, const float* RC, const float* RS, int pos, int fq, float scale, bf16x8& o0, bf16x8& o1) {
  const f32x4 c0 = *(const f32x4*)(RC + pos * 32 + 8 * fq), c1 = *(const f32x4*)(RC + pos * 32 + 8 * fq + 4);
  const f32x4 s0 = *(const f32x4*)(RS + pos * 32 + 8 * fq), s1 = *(const f32x4*)(RS + pos * 32 + 8 * fq + 4);
  const float cc[8] = {c0.x, c0.y, c0.z, c0.w, c1.x, c1.y, c1.z, c1.w}, sn[8] = {s0.x, s0.y, s0.z, s0.w, s1.x, s1.y, s1.z, s1.w};
  union { bf16x8 v; unsigned u[4]; } r0, r1;
#pragma unroll
  for (int q = 0; q < 4; ++q) {
    const float a0 = bf2f((bf16_t)x0[2 * q]) * scale, a1 = bf2f((bf16_t)x0[2 * q + 1]) * scale, b0 = bf2f((bf16_t)x1[2 * q]) * scale, b1 = bf2f((bf16_t)x1[2 * q + 1]) * scale;
    r0.u[q] = pk2(a0 * cc[2 * q] - b0 * sn[2 * q], a1 * cc[2 * q + 1] - b1 * sn[2 * q + 1]);
    r1.u[q] = pk2(a0 * sn[2 * q] + b0 * cc[2 * q], a1 * sn[2 * q + 1] + b1 * cc[2 * q + 1]);
  }
  o0 = r0.v; o1 = r1.v;
}
__device__ void mix_local_phase(const Params& p, int l, unsigned char* smem) {
  const CParamsP pp = launder_kargs();
  GAS unsigned char* const ws = launder_ptr(pp->ws); const int tidx = launder_tid();
  const bf16_t* PROJ = (const bf16_t*)(ws + WS_PROJ); const bf16_t* VTR = (const bf16_t*)(ws + WS_VTR);
  const float* RC = (const float*)(ws + WS_ROTC); const float* RS = (const float*)(ws + WS_ROTS);
  bf16_t* YINT = (bf16_t*)(ws + WS_YINT); float* UPDT = (float*)(ws + WS_UPD);
  const float* SA = (const float*)(ws + WS_SA) + (size_t)l * 16 * 64 * 2; const bf16_t* BBH = (const bf16_t*)(ws + WS_BBH) + (size_t)l * 16 * 2 * 64 * 16;
  float* SEND = (float*)(ws + WS_SEND);
  const int tid = tidx, lane = tid & 63, wid = tid >> 6, fr = lane & 15, fq = lane >> 4;
  bf16_t* KT = (bf16_t*)smem;
  float* rcL = (float*)(smem + 55296); float* rsL = rcL + 2048;
  for (int it_ = blockIdx.x; it_ < 256; it_ += gridDim.x) {
    const int item = ((it_ & 7) << 5) | (it_ >> 3);
    const int b = item >> 7, n = item & 127, t0 = b * 8192 + n * 64;
    __syncthreads();
#pragma unroll
    for (int i = 0; i < 4; ++i) { rcL[tid + NT * i] = RC[n * 2048 + tid + NT * i]; rsL[tid + NT * i] = RS[n * 2048 + tid + NT * i]; }
    __syncthreads();
#pragma unroll 1
    for (int k3 = 0; k3 < 3; ++k3) {
      const int task = wid * 3 + k3, h = task >> 2, tb = task & 3;
      const int i = 16 * tb + fr;
      const float lg2 = log2f(1.f - exp2f(-5.f - (float)h));
      bf16x8 qraw[2], kraw[2][2][2], vraw[2][4];
      {
        const bf16_t* qp = PROJ + (size_t)(t0 + i) * INCP + C_QR + h * 64 + 8 * fq;
        qraw[0] = *(const bf16x8*)qp; qraw[1] = *(const bf16x8*)(qp + 32);
#pragma unroll
        for (int g = 0; g < 2; ++g) {
#pragma unroll
          for (int tt = 0; tt < 2; ++tt) {
            const int key = 32 * g + 8 * (fr >> 2) + (fr & 3) + 4 * tt;
            const bf16_t* kp = PROJ + (size_t)(t0 + key) * INCP + C_KR + h * 64 + 8 * fq;
            kraw[g][tt][0] = *(const bf16x8*)kp; kraw[g][tt][1] = *(const bf16x8*)(kp + 32);
          }
#pragma unroll
          for (int et = 0; et < 4; ++et) vraw[g][et] = *(const bf16x8*)(VTR + ((size_t)b * 384 + h * 64 + et * 16 + fr) * 8192 + n * 64 + 32 * g + 8 * fq);
        }
      }
      __builtin_amdgcn_sched_barrier(0);
      bf16x8 qf0, qf1;
      rotary_frag(qraw[0], qraw[1], rcL, rsL, i, fq, 1.f, qf0, qf1);
      f32x4 o[4];
#pragma unroll
      for (int et = 0; et < 4; ++et) o[et] = (f32x4){0.f, 0.f, 0.f, 0.f};
#pragma unroll
      for (int g = 0; g < 2; ++g) {
        float st[2][4];
#pragma unroll
        for (int tt = 0; tt < 2; ++tt) {
          const int key = 32 * g + 8 * (fr >> 2) + (fr & 3) + 4 * tt;
          bf16x8 kf0, kf1;
          rotary_frag(kraw[g][tt][0], kraw[g][tt][1], rcL, rsL, key, fq, 0.125f, kf0, kf1);
          f32x4 s4 = __builtin_amdgcn_mfma_f32_16x16x32_bf16(kf0, qf0, (f32x4){0.f, 0.f, 0.f, 0.f}, 0, 0, 0);
          s4 = __builtin_amdgcn_mfma_f32_16x16x32_bf16(kf1, qf1, s4, 0, 0, 0);
#pragma unroll
          for (int j = 0; j < 4; ++j) {
            const int kk = 32 * g + 8 * fq + 4 * tt + j;
            const int dij = i > kk ? i - kk : kk - i;
            st[tt][j] = s4[j] * exp2f(lg2 * (float)dij);
          }
          if (tb == 0) {
            const float kd = exp2f(lg2 * (float)(63 - key));
#pragma unroll
            for (int jj = 0; jj < 8; ++jj) {
              KT[(h * 64 + 8 * fq + jj) * 72 + key] = f2bf(bf2f((bf16_t)kf0[jj]) * kd);
              KT[(h * 64 + 32 + 8 * fq + jj) * 72 + key] = f2bf(bf2f((bf16_t)kf1[jj]) * kd);
            }
          }
        }
        union { bf16x8 v; unsigned u[4]; } pf;
        pf.u[0] = pk2(st[0][0], st[0][1]); pf.u[1] = pk2(st[0][2], st[0][3]); pf.u[2] = pk2(st[1][0], st[1][1]); pf.u[3] = pk2(st[1][2], st[1][3]);
#pragma unroll
        for (int et = 0; et < 4; ++et) o[et] = __builtin_amdgcn_mfma_f32_16x16x32_bf16(vraw[g][et], pf.v, o[et], 0, 0, 0);
      }
#pragma unroll
      for (int et = 0; et < 4; ++et) { uint2 ov; ov.x = pk2(o[et].x, o[et].y); ov.y = pk2(o[et].z, o[et].w); *(uint2*)(YINT + (((((size_t)item * 6 + h) * 4 + tb) * 4 + et) * 64 + lane) * 4) = ov; }
    }
    __syncthreads();
#pragma unroll 1
    for (int k3 = 0; k3 < 3; ++k3) {
      const int task = wid * 3 + k3, h = task >> 2, et = task & 3;
      f32x4 acc[4];
#pragma unroll
      for (int dt = 0; dt < 4; ++dt) acc[dt] = (f32x4){0.f, 0.f, 0.f, 0.f};
#pragma unroll
      for (int g = 0; g < 2; ++g) {
        const bf16x8 vf = *(const bf16x8*)(VTR + ((size_t)b * 384 + h * 64 + et * 16 + fr) * 8192 + n * 64 + 32 * g + 8 * fq);
#pragma unroll
        for (int dt = 0; dt < 4; ++dt) {
          const bf16x8 kt = *(const bf16x8*)(KT + (h * 64 + 16 * dt + fr) * 72 + 32 * g + 8 * fq);
          acc[dt] = __builtin_amdgcn_mfma_f32_16x16x32_bf16(kt, vf, acc[dt], 0, 0, 0);
        }
      }
#pragma unroll
      for (int dt = 0; dt < 4; ++dt) *(f32x4*)(UPDT + (((size_t)item * 6 + h) * 64 + 16 * et + fr) * 64 + 16 * dt + 4 * fq) = acc[dt];
    }
#pragma unroll 1
    for (int gi = 0; gi < 2; ++gi) {
      const int g = wid * 2 + gi;
      const float are = SA[(g * 64 + lane) * 2], aim = SA[(g * 64 + lane) * 2 + 1];
      float xr = 0.f, xi = 0.f;
#pragma unroll 1
      for (int blk = 0; blk < 2; ++blk) {
        f32x16 lr, hr, li, hi;
        ssm_bu32(BBH + (size_t)g * 2 * 64 * 16, PROJ + (size_t)(t0 + 32 * blk + (lane & 31)) * INCP + C_US + g * 16, lane, lr, hr, li, hi);
#pragma unroll
        for (int a4 = 0; a4 < 4; ++a4) {
#pragma unroll
          for (int bq = 0; bq < 4; ++bq) { const float nr = are * xr - aim * xi + lr[4 * a4 + bq], ni = are * xi + aim * xr + li[4 * a4 + bq]; xr = nr; xi = ni; }
#pragma unroll
          for (int bq = 0; bq < 4; ++bq) { const float nr = are * xr - aim * xi + hr[4 * a4 + bq], ni = are * xi + aim * xr + hi[4 * a4 + bq]; xr = nr; xi = ni; }
        }
      }
      SEND[(((size_t)item * 16 + g) * 64 + lane) * 2] = xr; SEND[(((size_t)item * 16 + g) * 64 + lane) * 2 + 1] = xi;
    }
  }
}

__device__ void scan_phase(const Params& p, int l) {
  const CParamsP pp = launder_kargs();
  GAS unsigned char* const ws = launder_ptr(pp->ws); const int tidx = launder_tid();
  const float* __restrict__ UPDT = (const float*)(ws + WS_UPD); bf16_t* __restrict__ SPT = (bf16_t*)(ws + WS_SPT);
  const float* __restrict__ SEND = (const float*)(ws + WS_SEND); float* __restrict__ CARRY = (float*)(ws + WS_CARRY);
  const float* SA = (const float*)(ws + WS_SA) + (size_t)l * 16 * 64 * 2;
  const int gtid = blockIdx.x * NT + tidx, gn = gridDim.x * NT;
  for (int idx = gtid; idx < 2 * 6 * 4096 + 2 * 1024; idx += gn) {
    if (idx < 2 * 6 * 4096) {
      const int b = idx / (6 * 4096), r = idx % (6 * 4096), h = r >> 12;
      const float cd = exp2f(64.f * log2f(1.f - exp2f(-5.f - (float)h)));
      const int e_ = (r >> 6) & 63, d_ = r & 63;
      const int spoff = h * 4096 + ((((e_ >> 4) * 2 + (d_ >> 5)) * 64 + ((d_ >> 3) & 3) * 16 + (e_ & 15)) * 8 + (d_ & 7));
      float s = 0.f;
      float v[16], vn[16];
#pragma unroll
      for (int j = 0; j < 16; ++j) v[j] = UPDT[((size_t)(b * NCH + j)) * 6 * 4096 + r];
#pragma unroll 1
      for (int nb = 0; nb < NCH; nb += 16) {
        const int nbn = nb + 16 < NCH ? nb + 16 : nb;
#pragma unroll
        for (int j = 0; j < 16; ++j) vn[j] = UPDT[((size_t)(b * NCH + nbn + j)) * 6 * 4096 + r];
        __builtin_amdgcn_sched_barrier(0);
#pragma unroll
        for (int j = 0; j < 16; ++j) { SPT[((size_t)(b * NCH + nb + j)) * 6 * 4096 + spoff] = f2bf(s); s = cd * s + v[j]; }
#pragma unroll
        for (int j = 0; j < 16; ++j) v[j] = vn[j];
      }
    } else {
      const int r2 = idx - 2 * 6 * 4096, b = r2 >> 10, gp = r2 & 1023;
      float ar = SA[gp * 2], ai = SA[gp * 2 + 1];
#pragma unroll
      for (int q = 0; q < 6; ++q) { const float nr = ar * ar - ai * ai, ni = 2.f * ar * ai; ar = nr; ai = ni; }
      float xr = 0.f, xi = 0.f;
      f32x2 v[16], vn[16];
#pragma unroll
      for (int j = 0; j < 16; ++j) v[j] = *(const f32x2*)(SEND + (((size_t)(b * NCH + j)) * 1024 + gp) * 2);
#pragma unroll 1
      for (int nb = 0; nb < NCH; nb += 16) {
        const int nbn = nb + 16 < NCH ? nb + 16 : nb;
#pragma unroll
        for (int j = 0; j < 16; ++j) vn[j] = *(const f32x2*)(SEND + (((size_t)(b * NCH + nbn + j)) * 1024 + gp) * 2);
        __builtin_amdgcn_sched_barrier(0);
#pragma unroll
        for (int j = 0; j < 16; ++j) {
          *(f32x2*)(CARRY + (((size_t)(b * NCH + nb + j)) * 1024 + gp) * 2) = (f32x2){xr, xi};
          const float nr = ar * xr - ai * xi + v[j].x, ni = ar * xi + ai * xr + v[j].y;
          xr = nr; xi = ni;
        }
#pragma unroll
        for (int j = 0; j < 16; ++j) v[j] = vn[j];
      }
    }
  }
}
constexpr int G1_SLICE_SPANS = 8192;
__device__ void g1_convert_slice(const Params& p, int l) {
  const CParamsP pp = launder_kargs();
  GAS unsigned char* const ws = launder_ptr(pp->ws); const int tidx = launder_tid();
  if (l + 1 < DEPTH_) convert_tables_fp4(pp, ws, l + 1, blockIdx.x * NT + tidx, gridDim.x * NT, 0, G1_SLICE_SPANS);
}
__device__ void scan_convert_phase(const Params& p, int l, int sp_first) {
  const CParamsP pp = launder_kargs();
  GAS unsigned char* const ws = launder_ptr(pp->ws); const int tidx = launder_tid();
  const int gtid = blockIdx.x * NT + tidx, gn = gridDim.x * NT;
  if (l + 1 < DEPTH_) {
    constexpr int NCHAIN_WG = (2 * 6 * 4096 + 2 * 1024 + NT - 1) / NT;
    if ((int)gridDim.x >= 2 * NCHAIN_WG) { if ((int)blockIdx.x >= NCHAIN_WG) convert_tables_fp4(pp, ws, l + 1, gtid - NCHAIN_WG * NT, gn - NCHAIN_WG * NT, sp_first); }
    else convert_tables_fp4(pp, ws, l + 1, gtid, gn, sp_first);
  }
}

__device__ void mix_final_att_phase(const Params& p, int l) {
  const CParamsP pp = launder_kargs();
  GAS unsigned char* const ws = launder_ptr(pp->ws); const int tidx = launder_tid();
  const bf16_t* ATT = (const bf16_t*)(ws + WS_ATT);
  const float* mg = gin(pp->in[I_MGAIN]) + (size_t)l * 1024;
  bf16_t* MRG = (bf16_t*)(ws + WS_ABUF);
  const int lane = tidx & 63, wid = tidx >> 6;
  for (int it_ = blockIdx.x; it_ < 256; it_ += gridDim.x) {
    const int item = ((it_ & 7) << 5) | (it_ >> 3);
    const int b = item >> 7, n = item & 127, t0 = b * 8192 + n * 64;
    {
      float av[8][6], mgl[6];
#pragma unroll
      for (int ii = 0; ii < 8; ++ii)
#pragma unroll
        for (int j = 0; j < 6; ++j) av[ii][j] = bf2f(ATT[(size_t)(t0 + wid * 8 + ii) * 384 + lane + 64 * j]);
#pragma unroll
      for (int j = 0; j < 6; ++j) mgl[j] = mg[lane + 64 * j];
      __builtin_amdgcn_sched_barrier(0);
#pragma unroll
      for (int ii = 0; ii < 8; ++ii) {
        const int t = t0 + wid * 8 + ii;
        float sq = 0.f;
#pragma unroll
        for (int j = 0; j < 6; ++j) sq += av[ii][j] * av[ii][j];
        const float rstd = rsqrtf(wave_sum(sq) * (1.f / 384.f) + EPS_);
#pragma unroll
        for (int j = 0; j < 6; ++j) MRG[(size_t)t * 1024 + lane + 64 * j] = f2bf(av[ii][j] * rstd * mgl[j]);
      }
    }
  }
}

__device__ void mix_final_phase(const Params& p, int l, unsigned char* smem) {
  const CParamsP pp = launder_kargs();
  GAS unsigned char* const ws = launder_ptr(pp->ws); const int tidx = launder_tid();
  const bf16_t* PROJ = (const bf16_t*)(ws + WS_PROJ);
  const float* RC = (const float*)(ws + WS_ROTC); const float* RS = (const float*)(ws + WS_ROTS);
  const bf16_t* YINT = (const bf16_t*)(ws + WS_YINT); const bf16_t* SPT = (const bf16_t*)(ws + WS_SPT);
  const bf16_t* ATT = (const bf16_t*)(ws + WS_ATT);
  const float* SA = (const float*)(ws + WS_SA) + (size_t)l * 16 * 64 * 2; const bf16_t* BBH = (const bf16_t*)(ws + WS_BBH) + (size_t)l * 16 * 2 * 64 * 16;
  const float* CARRY = (const float*)(ws + WS_CARRY);
  const bf16_t* CB = (const bf16_t*)(ws + WS_CB) + (size_t)l * 16 * 16 * 128; const bf16_t* WG = (const bf16_t*)(ws + WS_WGLUT) + (size_t)l * 512 * 256;
  const float* dsk = gin(pp->in[I_SSMD]) + (size_t)l * 256;
  const float* mg = gin(pp->in[I_MGAIN]) + (size_t)l * 1024;
  bf16_t* MRG = (bf16_t*)(ws + WS_ABUF);
  const int tid = tidx, lane = tid & 63, wid = tid >> 6, fr = lane & 15, fq = lane >> 4;
  bf16_t* YS = (bf16_t*)smem;
  float* red = (float*)(smem + 33792);
  bf16_t* XB = (bf16_t*)(smem + 36864 + wid * 8448 + 4096);
  float* rcL = (float*)(smem + 104448); float* rsL = rcL + 2048;
  for (int it_ = blockIdx.x; it_ < 256; it_ += gridDim.x) {
    const int item = ((it_ & 7) << 5) | (it_ >> 3);
    const int b = item >> 7, n = item & 127, t0 = b * 8192 + n * 64;
    __syncthreads();
#pragma unroll
    for (int i = 0; i < 4; ++i) { rcL[tid + NT * i] = RC[n * 2048 + tid + NT * i]; rsL[tid + NT * i] = RS[n * 2048 + tid + NT * i]; }
    __syncthreads();
#pragma unroll 1
    for (int k3 = 0; k3 < 3; ++k3) {
      const int task = wid * 3 + k3, h = task >> 2, tb = task & 3;
      const int i = 16 * tb + fr, t = t0 + i;
      const float lg2 = log2f(1.f - exp2f(-5.f - (float)h));
      bf16x8 qraw[2], spf[4][2]; f32x4 yiv[4], mgq[4]; uint2 grv[4];
      {
        const bf16_t* qp = PROJ + (size_t)t * INCP + C_QR + h * 64 + 8 * fq;
        qraw[0] = *(const bf16x8*)qp; qraw[1] = *(const bf16x8*)(qp + 32);
#pragma unroll
        for (int et = 0; et < 4; ++et) {
          const bf16_t* sp = SPT + ((size_t)item * 6 + h) * 4096 + (size_t)(et * 2) * 512 + lane * 8;
          spf[et][0] = *(const bf16x8*)sp; spf[et][1] = *(const bf16x8*)(sp + 512);
          { const uint2 yr = *(const uint2*)(YINT + (((((size_t)item * 6 + h) * 4 + tb) * 4 + et) * 64 + lane) * 4); yiv[et] = (f32x4){__uint_as_float(yr.x << 16), __uint_as_float(yr.x & 0xffff0000u), __uint_as_float(yr.y << 16), __uint_as_float(yr.y & 0xffff0000u)}; }
          grv[et] = *(const uint2*)(PROJ + (size_t)t * INCP + C_GR + h * 64 + 16 * et + 4 * fq);
          mgq[et] = *(const f32x4*)(mg + 384 + h * 64 + 16 * et + 4 * fq);
        }
      }
      __builtin_amdgcn_sched_barrier(0);
      bf16x8 qf0, qf1;
      rotary_frag(qraw[0], qraw[1], rcL, rsL, i, fq, 1.f, qf0, qf1);
      f32x4 o[4];
#pragma unroll
      for (int et = 0; et < 4; ++et) {
        o[et] = __builtin_amdgcn_mfma_f32_16x16x32_bf16(spf[et][0], qf0, (f32x4){0.f, 0.f, 0.f, 0.f}, 0, 0, 0);
        o[et] = __builtin_amdgcn_mfma_f32_16x16x32_bf16(spf[et][1], qf1, o[et], 0, 0, 0);
      }
      const float qd = exp2f(lg2 * (float)(i + 1));
      float y[16]; float s1 = 0.f;
#pragma unroll
      for (int et = 0; et < 4; ++et) {
        const f32x4 yi = yiv[et];
        y[4 * et] = yi.x + qd * o[et].x; y[4 * et + 1] = yi.y + qd * o[et].y; y[4 * et + 2] = yi.z + qd * o[et].z; y[4 * et + 3] = yi.w + qd * o[et].w;
        s1 += (y[4 * et] + y[4 * et + 1]) + (y[4 * et + 2] + y[4 * et + 3]);
      }
      s1 = xsum_16_32(s1);
      const float mu = s1 * (1.f / 64.f);
      float s2 = 0.f;
#pragma unroll
      for (int q = 0; q < 16; ++q) { y[q] -= mu; s2 += y[q] * y[q]; }
      s2 = xsum_16_32(s2);
      const float rstd = rsqrtf(s2 * (1.f / 64.f) + EPS_);
#pragma unroll
      for (int et = 0; et < 4; ++et) {
        const int c = h * 64 + 16 * et + 4 * fq;
        const uint2 gr = grv[et];
        const float g0 = __uint_as_float(gr.x << 16), g1 = __uint_as_float(gr.x & 0xffff0000u), g2 = __uint_as_float(gr.y << 16), g3 = __uint_as_float(gr.y & 0xffff0000u);
        const f32x4 mgv = mgq[et];
        uint2 ov;
        ov.x = pk2(y[4 * et] * rstd * (g0 * sigmoid_f(g0)) * mgv.x, y[4 * et + 1] * rstd * (g1 * sigmoid_f(g1)) * mgv.y);
        ov.y = pk2(y[4 * et + 2] * rstd * (g2 * sigmoid_f(g2)) * mgv.z, y[4 * et + 3] * rstd * (g3 * sigmoid_f(g3)) * mgv.w);
        *(uint2*)(MRG + (size_t)t * 1024 + 384 + c) = ov;
      }
    }
#pragma unroll 1
    for (int gi = 0; gi < 2; ++gi) {
      const int g = wid * 2 + gi;
      const float are = SA[(g * 64 + lane) * 2], aim = SA[(g * 64 + lane) * 2 + 1];
      float xr = CARRY[(((size_t)item * 16 + g) * 64 + lane) * 2], xi = CARRY[(((size_t)item * 16 + g) * 64 + lane) * 2 + 1];
      bf16x8 cb[4];
#pragma unroll
      for (int ks = 0; ks < 4; ++ks) cb[ks] = *(const bf16x8*)(CB + (((size_t)g * 4 + ks) * 64 + lane) * 8);
      const float dv = dsk[g * 16 + fr];
#pragma unroll 1
      for (int blk = 0; blk < 2; ++blk) {
        f32x16 lr, hr, li, hi;
        bf16_t uraw[2][4];
#pragma unroll
        for (int half = 0; half < 2; ++half)
#pragma unroll
          for (int j = 0; j < 4; ++j) uraw[half][j] = PROJ[(size_t)(t0 + 32 * blk + 16 * half + 4 * fq + j) * INCP + C_US + g * 16 + fr];
        ssm_bu32(BBH + (size_t)g * 2 * 64 * 16, PROJ + (size_t)(t0 + 32 * blk + (lane & 31)) * INCP + C_US + g * 16, lane, lr, hr, li, hi);
#pragma unroll
        for (int half = 0; half < 2; ++half) {
#pragma unroll
          for (int a2 = 0; a2 < 2; ++a2) {
            const int a4 = 2 * half + a2;
#pragma unroll
            for (int bq = 0; bq < 4; ++bq) {
              const float nr = are * xr - aim * xi + lr[4 * a4 + bq], ni = are * xi + aim * xr + li[4 * a4 + bq]; xr = nr; xi = ni;
              XB[(8 * a2 + bq) * 136 + lane] = f2bf(xr); XB[(8 * a2 + bq) * 136 + 64 + lane] = f2bf(xi);
            }
#pragma unroll
            for (int bq = 0; bq < 4; ++bq) {
              const float nr = are * xr - aim * xi + hr[4 * a4 + bq], ni = are * xi + aim * xr + hi[4 * a4 + bq]; xr = nr; xi = ni;
              XB[(8 * a2 + 4 + bq) * 136 + lane] = f2bf(xr); XB[(8 * a2 + 4 + bq) * 136 + 64 + lane] = f2bf(xi);
            }
          }
          f32x4 acc = (f32x4){0.f, 0.f, 0.f, 0.f};
#pragma unroll
          for (int ks = 0; ks < 4; ++ks) {
            const bf16x8 af = *(const bf16x8*)(XB + fr * 136 + 32 * ks + 8 * fq);
            acc = __builtin_amdgcn_mfma_f32_16x16x32_bf16(af, cb[ks], acc, 0, 0, 0);
          }
#pragma unroll
          for (int j = 0; j < 4; ++j) {
            const int i = 32 * blk + 16 * half + 4 * fq + j;
            const float yv = acc[j] + dv * bf2f(uraw[half][j]);
            YS[i * 264 + g * 16 + fr] = f2bf(gelu_tanh(yv));
          }
        }
      }
    }
    __syncthreads();
    {
      const int n0 = 32 * wid;
      f32x4 a1[4][2], a2[4][2];
#pragma unroll
      for (int mt = 0; mt < 4; ++mt)
#pragma unroll
        for (int nt = 0; nt < 2; ++nt) { a1[mt][nt] = (f32x4){0.f, 0.f, 0.f, 0.f}; a2[mt][nt] = (f32x4){0.f, 0.f, 0.f, 0.f}; }
#pragma unroll 1
      for (int kh = 0; kh < 2; ++kh) {
        bf16x8 w1[4][2], w2[4][2];
#pragma unroll
        for (int k4 = 0; k4 < 4; ++k4)
#pragma unroll
          for (int nt = 0; nt < 2; ++nt) {
            w1[k4][nt] = *(const bf16x8*)(WG + ((((size_t)wid * 8 + 4 * kh + k4) * 2 + 0) * 2 + nt) * 512 + lane * 8);
            w2[k4][nt] = *(const bf16x8*)(WG + ((((size_t)wid * 8 + 4 * kh + k4) * 2 + 1) * 2 + nt) * 512 + lane * 8);
          }
        __builtin_amdgcn_sched_barrier(0);
#pragma unroll
        for (int k4 = 0; k4 < 4; ++k4) {
          const int ks = 4 * kh + k4;
          bf16x8 yb[4];
#pragma unroll
          for (int mt = 0; mt < 4; ++mt) yb[mt] = *(const bf16x8*)(YS + (16 * mt + fr) * 264 + 32 * ks + 8 * fq);
#pragma unroll
          for (int mt = 0; mt < 4; ++mt)
#pragma unroll
            for (int nt = 0; nt < 2; ++nt) {
              a1[mt][nt] = __builtin_amdgcn_mfma_f32_16x16x32_bf16(w1[k4][nt], yb[mt], a1[mt][nt], 0, 0, 0);
              a2[mt][nt] = __builtin_amdgcn_mfma_f32_16x16x32_bf16(w2[k4][nt], yb[mt], a2[mt][nt], 0, 0, 0);
            }
        }
      }
#pragma unroll
      for (int mt = 0; mt < 4; ++mt) {
        float sq = 0.f;
#pragma unroll
        for (int nt = 0; nt < 2; ++nt) {
          f32x4 z = a1[mt][nt]; const f32x4 zg = a2[mt][nt];
          z.x *= sigmoid_f(zg.x); z.y *= sigmoid_f(zg.y); z.z *= sigmoid_f(zg.z); z.w *= sigmoid_f(zg.w);
          a1[mt][nt] = z; sq += z.x * z.x + z.y * z.y + z.z * z.z + z.w * z.w;
        }
        sq = xsum_16_32(sq);
        if (fq == 0) red[wid * 64 + 16 * mt + fr] = sq;
      }
      __syncthreads();
#pragma unroll
      for (int mt = 0; mt < 4; ++mt) {
        const int i = 16 * mt + fr, t = t0 + i;
        float tot = 0.f;
#pragma unroll
        for (int w8 = 0; w8 < 8; ++w8) tot += red[w8 * 64 + i];
        const float rstd = rsqrtf(tot * (1.f / 256.f) + EPS_);
#pragma unroll
        for (int nt = 0; nt < 2; ++nt) {
          const int c = n0 + 16 * nt + 4 * fq;
          const f32x4 mgv = *(const f32x4*)(mg + 768 + c); const f32x4 z = a1[mt][nt];
          uint2 ov; ov.x = pk2(z.x * rstd * mgv.x, z.y * rstd * mgv.y); ov.y = pk2(z.z * rstd * mgv.z, z.w * rstd * mgv.w);
          *(uint2*)(MRG + (size_t)t * 1024 + 768 + c) = ov;
        }
      }
    }
  }
}

__device__ __forceinline__ float dot16_fp4(const uint2 u, const f32x2 (&hv)[8]) {
  f32x2 d = __builtin_amdgcn_cvt_scalef32_pk_f32_fp4(u.x, 1.0f, 0) * hv[0];
  d += __builtin_amdgcn_cvt_scalef32_pk_f32_fp4(u.x, 1.0f, 1) * hv[1];
  d += __builtin_amdgcn_cvt_scalef32_pk_f32_fp4(u.x, 1.0f, 2) * hv[2];
  d += __builtin_amdgcn_cvt_scalef32_pk_f32_fp4(u.x, 1.0f, 3) * hv[3];
  d += __builtin_amdgcn_cvt_scalef32_pk_f32_fp4(u.y, 1.0f, 0) * hv[4];
  d += __builtin_amdgcn_cvt_scalef32_pk_f32_fp4(u.y, 1.0f, 1) * hv[5];
  d += __builtin_amdgcn_cvt_scalef32_pk_f32_fp4(u.y, 1.0f, 2) * hv[6];
  d += __builtin_amdgcn_cvt_scalef32_pk_f32_fp4(u.y, 1.0f, 3) * hv[7];
  return d.x + d.y;
}
__device__ __forceinline__ void axpy16_fp4(const uint2 v, const float w, f32x2 (&acc)[8]) {
  const f32x2 w2 = (f32x2){w, w};
  acc[0] += w2 * __builtin_amdgcn_cvt_scalef32_pk_f32_fp4(v.x, 1.0f, 0);
  acc[1] += w2 * __builtin_amdgcn_cvt_scalef32_pk_f32_fp4(v.x, 1.0f, 1);
  acc[2] += w2 * __builtin_amdgcn_cvt_scalef32_pk_f32_fp4(v.x, 1.0f, 2);
  acc[3] += w2 * __builtin_amdgcn_cvt_scalef32_pk_f32_fp4(v.x, 1.0f, 3);
  acc[4] += w2 * __builtin_amdgcn_cvt_scalef32_pk_f32_fp4(v.y, 1.0f, 0);
  acc[5] += w2 * __builtin_amdgcn_cvt_scalef32_pk_f32_fp4(v.y, 1.0f, 1);
  acc[6] += w2 * __builtin_amdgcn_cvt_scalef32_pk_f32_fp4(v.y, 1.0f, 2);
  acc[7] += w2 * __builtin_amdgcn_cvt_scalef32_pk_f32_fp4(v.y, 1.0f, 3);
}
__device__ __forceinline__ float vmaxf(float a, float b) { float r; asm("v_max_f32 %0, %1, %2" : "=v"(r) : "v"(a), "v"(b)); return r; }
__device__ __forceinline__ float vminf(float a, float b) { float r; asm("v_min_f32 %0, %1, %2" : "=v"(r) : "v"(a), "v"(b)); return r; }
__device__ __forceinline__ void cx(float& hi, float& lo) { const float a = hi, b = lo; hi = vmaxf(a, b); lo = vminf(a, b); }
__device__ __forceinline__ void cx2(float& kh, int& ph, float& kl, int& pl) {
  const float a = kh, b = kl; const int pa = ph, pb = pl; const bool c = a >= b;
  kh = vmaxf(a, b); kl = vminf(a, b); ph = c ? pa : pb; pl = c ? pb : pa;
}
__device__ __forceinline__ void bitonic_sort16_desc(float (&v)[16]) {
#define SN_CX(i, j) cx(v[i], v[j]);
  SN_CX(0,13) SN_CX(1,12) SN_CX(2,15) SN_CX(3,14) SN_CX(4,8) SN_CX(5,6) SN_CX(7,11) SN_CX(9,10)
  SN_CX(0,5) SN_CX(1,7) SN_CX(2,9) SN_CX(3,4) SN_CX(6,13) SN_CX(8,14) SN_CX(10,15) SN_CX(11,12)
  SN_CX(0,1) SN_CX(2,3) SN_CX(4,5) SN_CX(6,8) SN_CX(7,9) SN_CX(10,11) SN_CX(12,13) SN_CX(14,15)
  SN_CX(0,2) SN_CX(1,3) SN_CX(4,10) SN_CX(5,11) SN_CX(6,7) SN_CX(8,9) SN_CX(12,14) SN_CX(13,15)
  SN_CX(1,2) SN_CX(3,12) SN_CX(4,6) SN_CX(5,7) SN_CX(8,10) SN_CX(9,11) SN_CX(13,14)
  SN_CX(1,4) SN_CX(2,6) SN_CX(5,8) SN_CX(7,10) SN_CX(9,13) SN_CX(11,14)
  SN_CX(2,4) SN_CX(3,6) SN_CX(9,12) SN_CX(11,13)
  SN_CX(3,5) SN_CX(6,8) SN_CX(7,9) SN_CX(10,12)
  SN_CX(3,4) SN_CX(5,6) SN_CX(7,8) SN_CX(9,10) SN_CX(11,12)
  SN_CX(6,7) SN_CX(8,9)
#undef SN_CX
}
__device__ __forceinline__ void bitonic_merge16_desc(float (&v)[16]) {
#pragma unroll
  for (int j = 8; j > 0; j >>= 1)
#pragma unroll
    for (int i = 0; i < 16; ++i) { const int l = i ^ j; if (l > i) cx(v[i], v[l]); }
}
__device__ __forceinline__ void top16_merge(float (&a)[16], const float (&b)[16]) {
#pragma unroll
  for (int i = 0; i < 16; ++i) a[i] = vmaxf(a[i], b[15 - i]);
  bitonic_merge16_desc(a);
}
template <int M> __device__ __forceinline__ void top16_merge_chain(float (&k)[16], int (&q)[16], const float (&xk)[M], const int (&xq)[M]) {
#pragma unroll
  for (int i = 16 - M; i < 16; ++i) { const float a = k[i], b = xk[15 - i]; const bool c = a >= b; k[i] = vmaxf(a, b); q[i] = c ? q[i] : xq[15 - i]; }
#pragma unroll
  for (int j = 8; j > 0; j >>= 1)
#pragma unroll
    for (int i = 0; i < 16; ++i) { const int l = i ^ j; if (l > i) cx2(k[i], q[i], k[l], q[l]); }
}

__device__ __forceinline__ void peer_req_rows16(u32x4v (&Q)[8], const unsigned char* tab, int e, int hi5, unsigned lane16) {
#pragma unroll
  for (int r = 0; r < 8; ++r) {
    const int ea = __builtin_amdgcn_readlane(e, 2 * r), eb = __builtin_amdgcn_readlane(e, 2 * r + 1);
    const unsigned off = (unsigned)(hi5 ? eb : ea) * 512u + lane16;
    Q[r] = *(const u32x4v*)(tab + off);
  }
}
__device__ __forceinline__ void peer_req_rows8(u32x4v (&Q)[8], const unsigned char* tab, int e, unsigned lane8) {
#pragma unroll
  for (int r = 0; r < 16; ++r) {
    const unsigned off = (unsigned)__builtin_amdgcn_readlane(e, r) * 512u + lane8;
    const uint2 t = *(const uint2*)(tab + off);
    Q[r >> 1][2 * (r & 1)] = t.x; Q[r >> 1][2 * (r & 1) + 1] = t.y;
  }
}
__device__ void peer_phase(const Params& p, int l, bool last, unsigned char* smem) {
  const CParamsP pp = launder_kargs();
  GAS unsigned char* const ws = launder_ptr(pp->ws); const int tidx = launder_tid();
  bf16_t* HF = (bf16_t*)(ws + WS_ABUF); bf16_t* X = (bf16_t*)(ws + WS_X);
  const bf16_t* SC8 = (const bf16_t*)(ws + WS_SC);
  const uint2* U4 = (const uint2*)(ws + WS_PU8) + (size_t)l * 16384 * 64; const uint2* V4 = (const uint2*)(ws + WS_PV8) + (size_t)l * 16384 * 64;
  const float* g2 = (const float*)(ws + WS_MOD) + (size_t)l * 2 * 6144 + 5120;
  const bf16_t* XG = (const bf16_t*)(ws + WS_XG); const float* SSQ = (const float*)(ws + WS_SSQ); const float* sh2 = (const float*)(ws + WS_MOD) + (size_t)l * 2 * 6144 + 3072;
  const int ln = last ? l : l + 1;
  const float* nsh = (const float*)(ws + WS_MOD) + (size_t)ln * 2 * 6144; const float* nsc = nsh + 1024;
  const float* ngain = gin(pp->in[I_NMIX]) + (size_t)ln * 1024;
  const int lane = tidx & 63, wid = tidx >> 6;
  const int rL = ((lane >> 5) & 1) * 8 + ((lane >> 4) & 1) * 4 + ((lane >> 3) & 1) * 2 + ((lane >> 2) & 1);
  const bool hi5 = (lane & 32) != 0, hi4 = (lane & 16) != 0, hi3 = (lane & 8) != 0, hi2 = (lane & 4) != 0;
  int* idxL = (int*)smem;
  float* cst = (float*)(smem + 115712);
  for (int it_ = blockIdx.x; it_ < T_ / 64; it_ += gridDim.x) {
    const int item = ((it_ & 7) << 5) | (it_ >> 3);
    const int t0 = item * 64;
    __syncthreads();
    {
      const int bb = t0 >> 13;
      for (int c = tidx; c < 1024; c += NT) {
        const int o = ((c >> 2) & 3) * 256 + (c >> 4) * 4 + (c & 3);
        cst[o] = g2[bb * 6144 + c] * 0.25f;
        cst[1024 + o] = last ? gin(pp->in[I_FNORM])[c] : ngain[c] * (1.f + nsc[bb * 6144 + c]);
        cst[2048 + o] = last ? 0.f : nsh[bb * 6144 + c];
        cst[3072 + o] = sh2[bb * 6144 + c];
      }
    }
    {
      int lane_o = lane; asm volatile("" : "+v"(lane_o));
      const int tg = wid & 1, hp = wid >> 1, hf = lane_o >> 5, tl = 32 * tg + (lane_o & 31);
      float F[2][16];
#pragma unroll
      for (int sd = 0; sd < 2; ++sd) {
        float Lh[2][16];
#pragma unroll
        for (int hh = 0; hh < 2; ++hh) {
          const int hs = 2 * (2 * hp + hh) + sd;
          float top[16];
          const bf16_t* scp = SC8 + (((size_t)(hs * 16 + 8 * hf)) * T_ + (t0 + tl)) * 8;
          uint4 sv[8];
#pragma unroll
          for (int kq = 0; kq < 8; ++kq) sv[kq] = *(const uint4*)(scp + (size_t)kq * T_ * 8);
          __builtin_amdgcn_sched_barrier(0);
#pragma unroll
          for (int kt = 0; kt < 4; ++kt) {
            float g[16];
#pragma unroll
            for (int kq = 0; kq < 2; ++kq) {
              const uint4 v8 = sv[2 * kt + kq];
              const unsigned wv[4] = {v8.x, v8.y, v8.z, v8.w};
#pragma unroll
              for (int j = 0; j < 4; ++j) {
                const int key = 64 * hf + 16 * kt + 8 * kq + 2 * j;
                g[8 * kq + 2 * j] = __uint_as_float((wv[j] << 16) | (unsigned)key);
                g[8 * kq + 2 * j + 1] = __uint_as_float((wv[j] & 0xffff0000u) | (unsigned)(key + 1));
              }
            }
            bitonic_sort16_desc(g);
            if (kt == 0) {
#pragma unroll
              for (int r = 0; r < 16; ++r) top[r] = g[r];
            } else top16_merge(top, g);
            __builtin_amdgcn_sched_barrier(0);
          }
#pragma unroll
          for (int r = 0; r < 16; ++r) Lh[hh][r] = top[r];
          __builtin_amdgcn_sched_barrier(0);
        }
#pragma unroll
        for (int r = 0; r < 16; ++r) {
          const auto sw = __builtin_amdgcn_permlane32_swap(__float_as_uint(Lh[0][r]), __float_as_uint(Lh[1][r]), false, false);
          Lh[0][r] = __uint_as_float(sw[0]); Lh[1][r] = __uint_as_float(sw[1]);
        }
        top16_merge(Lh[0], Lh[1]);
#pragma unroll
        for (int r = 0; r < 16; ++r) F[sd][r] = Lh[0][r];
        __builtin_amdgcn_sched_barrier(0);
      }
      int ia[16], ib[16];
#pragma unroll
      for (int r = 0; r < 16; ++r) { ia[r] = (int)(__float_as_uint(F[0][r]) & 127u) << 7; ib[r] = (int)(__float_as_uint(F[1][r]) & 127u); }
      float k[16]; int q[16];
#pragma unroll
      for (int j = 0; j < 16; ++j) { k[j] = F[0][0] + F[1][j]; q[j] = ia[0] | ib[j]; }
      { float xk[8]; int xq[8];
#pragma unroll
        for (int j = 0; j < 8; ++j) { xk[j] = F[0][1] + F[1][j]; xq[j] = ia[1] | ib[j]; }
        top16_merge_chain<8>(k, q, xk, xq); }
      { float xk[5]; int xq[5];
#pragma unroll
        for (int j = 0; j < 5; ++j) { xk[j] = F[0][2] + F[1][j]; xq[j] = ia[2] | ib[j]; }
        top16_merge_chain<5>(k, q, xk, xq); }
      { float xk[4]; int xq[4];
#pragma unroll
        for (int j = 0; j < 4; ++j) { xk[j] = F[0][3] + F[1][j]; xq[j] = ia[3] | ib[j]; }
        top16_merge_chain<4>(k, q, xk, xq); }
      { float xk[3]; int xq[3];
#pragma unroll
        for (int j = 0; j < 3; ++j) { xk[j] = F[0][4] + F[1][j]; xq[j] = ia[4] | ib[j]; }
        top16_merge_chain<3>(k, q, xk, xq); }
      { float xk[11]; int xq[11];
#pragma unroll
        for (int i = 0; i < 11; ++i) { xk[i] = F[0][5 + i] + F[1][0]; xq[i] = ia[5 + i] | ib[0]; }
        top16_merge_chain<11>(k, q, xk, xq); }
      { float xk[3]; int xq[3];
#pragma unroll
        for (int i = 0; i < 3; ++i) { xk[i] = F[0][5 + i] + F[1][1]; xq[i] = ia[5 + i] | ib[1]; }
        top16_merge_chain<3>(k, q, xk, xq); }
      float e[16]; float es = 0.f;
#pragma unroll
      for (int i = 0; i < 16; ++i) { e[i] = __expf(k[i] - k[0]); es += e[i]; }
      const float ies = 1.f / es;
      const int h = 2 * hp + hf;
#pragma unroll
      for (int i = 0; i < 16; ++i) idxL[tl * 132 + h * 16 + i] = (int)(((unsigned)f2bf(e[i] * ies) << 16) | (unsigned)q[i]);
    }
    __syncthreads();
    {
      const int fr = lane & 15, fq = lane >> 4, jsel = lane & 3, tlb = wid * 8;
      unsigned char* hq4 = smem + 33792 + wid * 1024;
      unsigned char* ust = smem + 41984 + wid * 9216;
      const unsigned lane8 = (unsigned)lane * 8u;
      const int hi5 = lane >> 5; const unsigned lane16 = (unsigned)(lane & 31) * 16u;
#define PEER_REQ_IDX(sn_) (idxL[(tlb + ((min((sn_), 127) & 63) >> 3)) * 132 + 16 * (min((sn_), 127) & 7) + fr] & 0xffff)
#define PEER_REQ_U(Q, sn_) do { const int _s = (sn_); const int* _ir = idxL + (tlb + (_s >> 3)) * 132 + 16 * (_s & 7) + hi5; \
        _Pragma("unroll") for (int r = 0; r < 8; ++r) { const unsigned _e = (unsigned)_ir[2 * r] & 0xffffu; Q[r] = *(const u32x4v*)((const unsigned char*)U4 + (_e * 512u + lane16)); } } while (0)
#define PEER_REQ_V(Q, vs_) do { const int _v = min((vs_), 63); const int* _ir = idxL + (tlb + (_v >> 3)) * 132 + 64 * ((_v >> 2) & 1) + (lane >> 3); \
        const unsigned _po = (unsigned)(_v & 3) * 128u + (unsigned)(lane & 7) * 16u; \
        _Pragma("unroll") for (int r = 0; r < 8; ++r) { const unsigned _e = (unsigned)_ir[8 * r] & 0xffffu; Q[r] = *(const u32x4v*)((const unsigned char*)V4 + (_e * 512u + _po)); } } while (0)
      u32x4v qa[8], qb[8];
      {
        PEER_REQ_U(qa, 0);
        __builtin_amdgcn_sched_barrier(0);
        PEER_REQ_U(qb, 1);
        __builtin_amdgcn_sched_barrier(0);
      }
      {
        const float rs_lane = rsqrtf(ssq_total(SSQ, t0 + tlb + (lane & 7)) * (1.f / 1024.f) + EPS_);
        uint4 nh0 = *(const uint4*)(XG + (size_t)(t0 + tlb) * 1024 + lane * 16), nh1 = *(const uint4*)(XG + (size_t)(t0 + tlb) * 1024 + lane * 16 + 8);
#pragma unroll 1
        for (int ii = 0; ii < 8; ++ii) {
          const int tl = tlb + ii, t = t0 + tl;
          uint4 hB[8];
          {
            const unsigned hw[8] = {nh0.x, nh0.y, nh0.z, nh0.w, nh1.x, nh1.y, nh1.z, nh1.w};
            const float rs = __int_as_float(__builtin_amdgcn_readlane(__float_as_int(rs_lane), ii));
            unsigned q1[2] = {0u, 0u}, q2[2] = {0u, 0u};
#pragma unroll
            for (int qq = 0; qq < 4; ++qq) {
              const f32x4 sh = *(const f32x4*)(cst + 3072 + qq * 256 + lane * 4);
              float hvv[4];
              hvv[0] = __uint_as_float(hw[2 * qq] << 16) * rs + sh.x; hvv[1] = __uint_as_float(hw[2 * qq] & 0xffff0000u) * rs + sh.y;
              hvv[2] = __uint_as_float(hw[2 * qq + 1] << 16) * rs + sh.z; hvv[3] = __uint_as_float(hw[2 * qq + 1] & 0xffff0000u) * rs + sh.w;
#pragma unroll
              for (int pr = 0; pr < 2; ++pr) {
                const int byte_sel = (2 * qq + pr) & 3, wd = (2 * qq + pr) >> 2;
                const float x0 = fminf(fmaxf(hvv[2 * pr], -6.f), 6.f), x1 = fminf(fmaxf(hvv[2 * pr + 1], -6.f), 6.f);
                unsigned t1 = 0u;
                if (byte_sel == 0) t1 = __builtin_amdgcn_cvt_scalef32_pk_fp4_f32(0u, x0, x1, 1.0f, 0);
                else if (byte_sel == 1) t1 = __builtin_amdgcn_cvt_scalef32_pk_fp4_f32(0u, x0, x1, 1.0f, 1);
                else if (byte_sel == 2) t1 = __builtin_amdgcn_cvt_scalef32_pk_fp4_f32(0u, x0, x1, 1.0f, 2);
                else t1 = __builtin_amdgcn_cvt_scalef32_pk_fp4_f32(0u, x0, x1, 1.0f, 3);
                f32x2 back;
                if (byte_sel == 0) back = __builtin_amdgcn_cvt_scalef32_pk_f32_fp4(t1, 1.0f, 0);
                else if (byte_sel == 1) back = __builtin_amdgcn_cvt_scalef32_pk_f32_fp4(t1, 1.0f, 1);
                else if (byte_sel == 2) back = __builtin_amdgcn_cvt_scalef32_pk_f32_fp4(t1, 1.0f, 2);
                else back = __builtin_amdgcn_cvt_scalef32_pk_f32_fp4(t1, 1.0f, 3);
                const float r0 = fminf(fmaxf((hvv[2 * pr] - back.x) * 8.f, -6.f), 6.f), r1 = fminf(fmaxf((hvv[2 * pr + 1] - back.y) * 8.f, -6.f), 6.f);
                unsigned t2 = 0u;
                if (byte_sel == 0) t2 = __builtin_amdgcn_cvt_scalef32_pk_fp4_f32(0u, r0, r1, 1.0f, 0);
                else if (byte_sel == 1) t2 = __builtin_amdgcn_cvt_scalef32_pk_fp4_f32(0u, r0, r1, 1.0f, 1);
                else if (byte_sel == 2) t2 = __builtin_amdgcn_cvt_scalef32_pk_fp4_f32(0u, r0, r1, 1.0f, 2);
                else t2 = __builtin_amdgcn_cvt_scalef32_pk_fp4_f32(0u, r0, r1, 1.0f, 3);
                q1[wd] |= t1; q2[wd] |= t2;
              }
            }
            *(uint2*)(hq4 + lane * 8) = make_uint2(q1[0], q1[1]);
            *(uint2*)(hq4 + 512 + lane * 8) = make_uint2(q2[0], q2[1]);
#pragma unroll
            for (int kc = 0; kc < 8; ++kc) hB[kc] = *(const uint4*)(hq4 + ((fr & 8) ? 512 : 0) + 64 * kc + 16 * fq);
          }
          { const int tn = t + (ii < 7 ? 1 : 0);
            nh0 = *(const uint4*)(XG + (size_t)tn * 1024 + lane * 16); nh1 = *(const uint4*)(XG + (size_t)tn * 1024 + lane * 16 + 8); }
          __builtin_amdgcn_sched_barrier(0);
#define PEER_U_STEP(R, bt_) do { const int _bt = (bt_), _sn = ii * 8 + _bt + 2; \
            _Pragma("unroll") for (int r = 0; r < 8; ++r) *(u32x4v*)(ust + (2 * r + hi5) * 528 + lane16) = R[r];        \
            if (_sn < 64) { PEER_REQ_U(R, _sn); } else { PEER_REQ_V(R, _sn - 64); }        \
            __builtin_amdgcn_sched_barrier(0); \
            uint4 ua[8]; \
            _Pragma("unroll") for (int kc = 0; kc < 8; ++kc) ua[kc] = *(const uint4*)(ust + fr * 528 + 64 * kc + 16 * fq);      \
            f32x4 sa[4] = {(f32x4){0.f, 0.f, 0.f, 0.f}, (f32x4){0.f, 0.f, 0.f, 0.f}, (f32x4){0.f, 0.f, 0.f, 0.f}, (f32x4){0.f, 0.f, 0.f, 0.f}};     \
            _Pragma("unroll") for (int kc = 0; kc < 8; ++kc) { \
              const i32x8 av = (i32x8){(int)ua[kc].x, (int)ua[kc].y, (int)ua[kc].z, (int)ua[kc].w, 0, 0, 0, 0}; \
              const i32x8 bv = (i32x8){(int)hB[kc].x, (int)hB[kc].y, (int)hB[kc].z, (int)hB[kc].w, 0, 0, 0, 0}; \
              sa[kc & 3] = __builtin_amdgcn_mfma_scale_f32_16x16x128_f8f6f4(av, bv, sa[kc & 3], 4  , 4  , 0, 0, 0, 0); } \
            const f32x4 sc4 = (sa[0] + sa[1]) + (sa[2] + sa[3]); \
              \
            const float down = jsel == 0 ? sc4[0] : (jsel == 1 ? sc4[1] : (jsel == 2 ? sc4[2] : sc4[3])); \
            const float doth = __int_as_float(__builtin_amdgcn_update_dpp(0, __float_as_int(down), 0x128  , 0xf, 0xf, false)); \
            const float dsel = (fr & 8) ? (doth + 0.125f * down) : (down + 0.125f * doth); \
            const int _eo = tl * 132 + 16 * _bt + 4 * fq + jsel; const unsigned _pe = (unsigned)idxL[_eo]; \
            const float _w = __uint_as_float(_pe & 0xffff0000u) * gelu_tanh_fast(dsel * (1.f / 64.f));            \
            if (fr < 4) idxL[_eo] = (int)(((unsigned)f2bf(_w) << 16) | (_pe & 0xffffu)); \
          } while (0)
#pragma unroll 1
          for (int b2 = 0; b2 < 8; b2 += 2) { PEER_U_STEP(qa, b2); PEER_U_STEP(qb, b2 + 1); }
#undef PEER_U_STEP
        }
      }
      {
        typedef int i32x2t __attribute__((ext_vector_type(2)));
#define PEER_TR4(p_) __builtin_amdgcn_ds_read_tr4_b64_v2i32((__attribute__((address_space(3))) i32x2t*)(p_))
        const int grp = lane >> 4, li = lane & 15;
        const unsigned char* trb = ust + ((grp >> 1) * 32 + li) * 144 + (grp & 1) * 8;
        unsigned char* wst = ust + (lane >> 3) * 144 + (lane & 7) * 16;
        unsigned char* wb = hq4;
        float oacc[4][8];
        unsigned ro[8];
        { const int* _ir = idxL + tlb * 132 + (lane >> 3);
#pragma unroll
          for (int r = 0; r < 8; ++r) ro[r] = ((unsigned)_ir[8 * r] & 0xffffu) * 512u + (unsigned)(lane & 7) * 16u; }
#pragma unroll 1
        for (int ii = 0; ii < 8; ++ii) {
          const int tl = tlb + ii, t = t0 + tl;
          const uint4 xr0 = *(const uint4*)(X + (size_t)t * 1024 + lane * 16), xr1 = *(const uint4*)(X + (size_t)t * 1024 + lane * 16 + 8);
#pragma unroll
          for (int s4 = 0; s4 < 4; ++s4)
#pragma unroll
            for (int nb = 0; nb < 8; ++nb) oacc[s4][nb] = 0.f;
          __builtin_amdgcn_sched_barrier(0);
#define PEER_V_STEP(R, vs_) do { constexpr int _vs = (vs_); \
            if ((_vs & 3) == 0) {          \
              const float _w = __uint_as_float((unsigned)idxL[tl * 132 + 64 * (_vs >> 2) + lane] & 0xffff0000u); \
              float _wm = fabsf(_w); \
              _wm = fmaxf(_wm, __int_as_float(__builtin_amdgcn_update_dpp(0, __float_as_int(_wm), 0x128  , 0xf, 0xf, false))); \
              _wm = fmaxf(_wm, __int_as_float(__builtin_amdgcn_update_dpp(0, __float_as_int(_wm), 0x124  , 0xf, 0xf, false))); \
              _wm = fmaxf(_wm, __int_as_float(__builtin_amdgcn_update_dpp(0, __float_as_int(_wm), 0x122  , 0xf, 0xf, false))); \
              _wm = fmaxf(_wm, __int_as_float(__builtin_amdgcn_update_dpp(0, __float_as_int(_wm), 0x121  , 0xf, 0xf, false))); \
              _wm = fmaxf(fmaxf(__int_as_float(__builtin_amdgcn_readlane(__float_as_int(_wm), 0)), __int_as_float(__builtin_amdgcn_readlane(__float_as_int(_wm), 16))), \
                          fmaxf(__int_as_float(__builtin_amdgcn_readlane(__float_as_int(_wm), 32)), __int_as_float(__builtin_amdgcn_readlane(__float_as_int(_wm), 48)))); \
              _wm = fmaxf(_wm, 1e-30f); invS = _wm * 0.25f; \
              float _r = _w * (4.f / _wm); unsigned _code = 0u; \
              _Pragma("unroll") for (int t_ = 0; t_ < 4; ++t_) { const unsigned _c = __builtin_amdgcn_cvt_scalef32_pk_fp4_f32(0u, _r, 0.f, 1.0f, 0) & 0xfu; \
                const f32x2 _bk = __builtin_amdgcn_cvt_scalef32_pk_f32_fp4(_c, 1.0f, 0); _code |= _c << (4 * t_); _r = (_r - _bk.x) * 4.f; } \
              *(uint2*)(wb + lane * 8) = make_uint2(_code, 0u); \
              const i32x2t _a0 = PEER_TR4(wb + ((lane >> 5) * 32 + li) * 8), _a1 = PEER_TR4(wb + ((lane >> 5) * 32 + 16 + li) * 8); \
              av = (i32x8){_a0.x, _a0.y, _a1.x, _a1.y, 0, 0, 0, 0}; } \
            _Pragma("unroll") for (int r = 0; r < 8; ++r) *(u32x4v*)(wst + r * (8 * 144)) = R[r];        \
            { constexpr int _nv = (_vs + 2) & 7;            \
              if ((_nv & 3) == 0) { const int _v = min(ii * 8 + _vs + 2, 63); const int* _ir = idxL + (tlb + (_v >> 3)) * 132 + 64 * ((_v >> 2) & 1) + (lane >> 3); \
                _Pragma("unroll") for (int r = 0; r < 8; ++r) ro[r] = ((unsigned)_ir[8 * r] & 0xffffu) * 512u + (unsigned)(lane & 7) * 16u; } \
              _Pragma("unroll") for (int r = 0; r < 8; ++r) R[r] = *(const u32x4v*)((const unsigned char*)V4 + (ro[r] + (unsigned)(_nv & 3) * 128u)); } \
            __builtin_amdgcn_sched_barrier(0); \
            {            \
              i32x2t _bf[16]; \
              _Pragma("unroll") for (int nb = 0; nb < 8; ++nb) { _bf[2 * nb] = PEER_TR4(trb + 16 * nb); _bf[2 * nb + 1] = PEER_TR4(trb + 16 * 144 + 16 * nb); } \
              const f32x16 zero16 = {0.f, 0.f, 0.f, 0.f, 0.f, 0.f, 0.f, 0.f, 0.f, 0.f, 0.f, 0.f, 0.f, 0.f, 0.f, 0.f}; \
              f32x16 _d[8]; \
              _Pragma("unroll") for (int nb = 0; nb < 8; ++nb) { \
                const i32x8 bv = (i32x8){_bf[2 * nb].x, _bf[2 * nb].y, _bf[2 * nb + 1].x, _bf[2 * nb + 1].y, 0, 0, 0, 0}; \
                _d[nb] = __builtin_amdgcn_mfma_scale_f32_32x32x64_f8f6f4(av, bv, zero16, 4  , 4  , 0, 0, 0, 0); } \
              _Pragma("unroll") for (int nb = 0; nb < 8; ++nb) oacc[_vs & 3][nb] += ((_d[nb][0] + 0.25f * _d[nb][1]) + (0.0625f * _d[nb][2] + 0.015625f * _d[nb][3])) * invS; \
              asm volatile("" : "+v"(oacc[_vs & 3][0]), "+v"(oacc[_vs & 3][1]), "+v"(oacc[_vs & 3][2]), "+v"(oacc[_vs & 3][3]), "+v"(oacc[_vs & 3][4]), "+v"(oacc[_vs & 3][5]), "+v"(oacc[_vs & 3][6]), "+v"(oacc[_vs & 3][7]));     \
              __builtin_amdgcn_sched_barrier(0); } \
          } while (0)
          {
            i32x8 av = (i32x8){0, 0, 0, 0, 0, 0, 0, 0}; float invS = 0.f;
            PEER_V_STEP(qa, 0); PEER_V_STEP(qb, 1); PEER_V_STEP(qa, 2); PEER_V_STEP(qb, 3);
            PEER_V_STEP(qa, 4); PEER_V_STEP(qb, 5); PEER_V_STEP(qa, 6); PEER_V_STEP(qb, 7);
          }
#undef PEER_V_STEP
          f32x2 acc2[8];
          {
            float* ob = (float*)ust;
            if (lane < 32) {
#pragma unroll
              for (int s4 = 0; s4 < 4; ++s4)
#pragma unroll
                for (int nb = 0; nb < 8; ++nb) ob[256 * s4 + 32 * nb + lane] = oacc[s4][nb];
            }
#pragma unroll
            for (int qq = 0; qq < 4; ++qq) { const f32x4 o4 = *(const f32x4*)(ob + lane * 16 + 4 * qq); acc2[2 * qq] = (f32x2){o4.x, o4.y}; acc2[2 * qq + 1] = (f32x2){o4.z, o4.w}; }
          }
          float xn[16]; float ss = 0.f;
          const unsigned xw[8] = {xr0.x, xr0.y, xr0.z, xr0.w, xr1.x, xr1.y, xr1.z, xr1.w};
#pragma unroll
          for (int qq = 0; qq < 4; ++qq) {
            const f32x4 xv = (f32x4){__uint_as_float(xw[2 * qq] << 16), __uint_as_float(xw[2 * qq] & 0xffff0000u), __uint_as_float(xw[2 * qq + 1] << 16), __uint_as_float(xw[2 * qq + 1] & 0xffff0000u)};
            const f32x4 g = *(const f32x4*)(cst + qq * 256 + lane * 4);
            xn[4 * qq] = xv.x + g.x * acc2[2 * qq].x; xn[4 * qq + 1] = xv.y + g.y * acc2[2 * qq].y;
            xn[4 * qq + 2] = xv.z + g.z * acc2[2 * qq + 1].x; xn[4 * qq + 3] = xv.w + g.w * acc2[2 * qq + 1].y;
            ss += xn[4 * qq] * xn[4 * qq] + xn[4 * qq + 1] * xn[4 * qq + 1] + xn[4 * qq + 2] * xn[4 * qq + 2] + xn[4 * qq + 3] * xn[4 * qq + 3];
          }
          const float rstd = rsqrtf(wave_sum(ss) * (1.f / 1024.f) + EPS_);
          if (!last) {
            unsigned hb[8], xb[8];
#pragma unroll
            for (int qq = 0; qq < 4; ++qq) {
              xb[2 * qq] = pk2(xn[4 * qq], xn[4 * qq + 1]); xb[2 * qq + 1] = pk2(xn[4 * qq + 2], xn[4 * qq + 3]);
              const f32x4 ga = *(const f32x4*)(cst + 1024 + qq * 256 + lane * 4), sh = *(const f32x4*)(cst + 2048 + qq * 256 + lane * 4);
              hb[2 * qq] = pk2(xn[4 * qq] * rstd * ga.x + sh.x, xn[4 * qq + 1] * rstd * ga.y + sh.y);
              hb[2 * qq + 1] = pk2(xn[4 * qq + 2] * rstd * ga.z + sh.z, xn[4 * qq + 3] * rstd * ga.w + sh.w);
            }
            *(uint4*)(X + (size_t)t * 1024 + lane * 16) = make_uint4(xb[0], xb[1], xb[2], xb[3]);
            *(uint4*)(X + (size_t)t * 1024 + lane * 16 + 8) = make_uint4(xb[4], xb[5], xb[6], xb[7]);
            *(uint4*)(HF + (size_t)t * 1024 + lane * 16) = make_uint4(hb[0], hb[1], hb[2], hb[3]);
            *(uint4*)(HF + (size_t)t * 1024 + lane * 16 + 8) = make_uint4(hb[4], hb[5], hb[6], hb[7]);
          } else {
#pragma unroll
            for (int qq = 0; qq < 4; ++qq) {
              const f32x4 fn = *(const f32x4*)(cst + 1024 + qq * 256 + lane * 4);
              *(f32x4*)((float*)pp->out + (size_t)t * 1024 + lane * 16 + 4 * qq) = (f32x4){xn[4 * qq] * rstd * fn.x, xn[4 * qq + 1] * rstd * fn.y, xn[4 * qq + 2] * rstd * fn.z, xn[4 * qq + 3] * rstd * fn.w};
            }
          }
        }
      }
#undef PEER_REQ_IDX
#undef PEER_REQ_U
#undef PEER_REQ_V
    }
  }
}

#define XB_TMO      128
#define XB_MATCH    192
#define XB_XCNT(j)  (256  + 64 * (j))
#define XB_XSUB(j)  (1280 + 64 * (j))
#define XB_XGEN(j)  (2304 + 64 * (j))
#define XB_TOP      3328
#define XB_TOPGEN   3392
#define XCD_BAR_WORDS 3456
#define XB_SPIN_CAP (1u << 20)
#define LAS __attribute__((address_space(3)))
__device__ __forceinline__ unsigned xb_ld(unsigned* q)              { return __hip_atomic_load(q, __ATOMIC_RELAXED, __HIP_MEMORY_SCOPE_AGENT); }
__device__ __forceinline__ unsigned xb_add(unsigned* q, unsigned v) { return __hip_atomic_fetch_add(q, v, __ATOMIC_RELAXED, __HIP_MEMORY_SCOPE_AGENT); }
__device__ __forceinline__ unsigned xb_xcc_id() { return (unsigned)__builtin_amdgcn_s_getreg((3 << 11) | 20) & 0xFu; }
#define XB_SPIN(cond, bar) do { unsigned _sp = 0; while (cond) { __builtin_amdgcn_s_sleep(1); \
    if ((++_sp & 255u) == 0u) { if (xb_ld(&(bar)[XB_TMO])) break; if (_sp > XB_SPIN_CAP) { atomicAdd(&(bar)[XB_TMO], 1u); break; } } } } while (0)
struct XcdBarrier { unsigned* bar; unsigned x; volatile LAS unsigned* st; };
__device__ __forceinline__ XcdBarrier xcd_barrier_post(unsigned* bar, volatile LAS unsigned* st) {
    XcdBarrier b; b.bar = bar; b.x = xb_xcc_id(); b.st = st;
    if (threadIdx.x == 0) {
        (void)__hip_atomic_fetch_or(&bar[XB_MATCH + (blockIdx.x & 7u)], 1u << b.x, __ATOMIC_RELAXED, __HIP_MEMORY_SCOPE_AGENT); asm volatile("s_waitcnt vmcnt(0)" ::: "memory");
        (void)xb_add(&bar[XB_XCNT(b.x)], 1u);
    }
    return b;
}
__device__ __forceinline__ void xcd_barrier_complete(unsigned* bar, unsigned x, unsigned& nloc, unsigned& nx) {
    const unsigned G = gridDim.x * gridDim.y * gridDim.z;
    unsigned sum, cnt, mine, sp = 0u;
    for (;;) {
        sum = 0u; cnt = 0u; mine = 0u;
#pragma unroll
        for (unsigned j = 0; j < 16; ++j) { const unsigned c = xb_ld(&bar[XB_XCNT(j)]); sum += c; cnt += (c > 0u) ? 1u : 0u; mine = (j == x) ? c : mine; }
        if (sum == G) break;
        __builtin_amdgcn_s_sleep(1);
        if ((++sp & 255u) == 0u) { if (xb_ld(&bar[XB_TMO])) break; if (sp > XB_SPIN_CAP) { atomicAdd(&bar[XB_TMO], 1u); break; } }
    }
    nloc = mine > 0u ? mine : 1u; nx = cnt > 0u ? cnt : 1u;
}
__device__ __forceinline__ void xcd_barrier(const XcdBarrier& b_) {
    (void)b_;
    extern __shared__ __attribute__((aligned(16))) unsigned char xb_smem_[];
    XcdBarrier b; b.bar = (unsigned*)(launder_kargs()->ws + WS_BAR); b.x = xb_xcc_id(); b.st = (volatile LAS unsigned*)(xb_smem_ + LDS_BYTES - 16);
    asm volatile("s_waitcnt vmcnt(0)" ::: "memory");
    __syncthreads();
    if (threadIdx.x == 0) {
        unsigned* bar = b.bar;
        __builtin_amdgcn_s_waitcnt(0);
        unsigned nloc = b.st[0], nx = b.st[1];
        if (nloc == 0u) { xcd_barrier_complete(bar, b.x, nloc, nx); b.st[0] = nloc; b.st[1] = nx;
            unsigned all_ = 0u, ones_ = 0u;
#pragma unroll
            for (unsigned c = 0; c < 8; ++c) { const unsigned m = xb_ld(&bar[XB_MATCH + c]); all_ |= m; ones_ += (__popc(m) == 1) ? 1u : 0u; }
            b.st[2] = (ones_ == 8u && __popc(all_) == 8 && nloc * 8u == gridDim.x && nx == 8u) ? 1u : 0u; }
        const unsigned old = xb_add(&bar[XB_XSUB(b.x)], 1u);
        const unsigned gen = old / nloc;
        if (old + 1u == (gen + 1u) * nloc) {
            __builtin_amdgcn_fence(__ATOMIC_RELEASE, "agent");
            asm volatile("s_waitcnt vmcnt(0)" ::: "memory");
            const unsigned og = xb_add(&bar[XB_TOP], 1u);
            const unsigned tg = og / nx;
            if (og + 1u == (tg + 1u) * nx) xb_add(&bar[XB_TOPGEN], 1u);
            else XB_SPIN(xb_ld(&bar[XB_TOPGEN]) == tg, bar);
            __builtin_amdgcn_fence(__ATOMIC_ACQUIRE, "agent");
            asm volatile("s_waitcnt vmcnt(0)" ::: "memory");
        } else {
            XB_SPIN(xb_ld(&bar[XB_TOPGEN]) == gen, bar);
            __builtin_amdgcn_fence(__ATOMIC_ACQUIRE, "agent");
            asm volatile("s_waitcnt vmcnt(0)" ::: "memory");
        }
    }
    __syncthreads();
}

__device__ __forceinline__ void xcd_barrier_local(const XcdBarrier& b_, const bool acquire) {
    extern __shared__ __attribute__((aligned(16))) unsigned char xb_smem_[];
    volatile LAS unsigned* st = (volatile LAS unsigned*)(xb_smem_ + LDS_BYTES - 16);
    asm volatile("s_waitcnt vmcnt(0)" ::: "memory");
    __syncthreads();
    const unsigned fastmode = st[2];
    if (!fastmode) { xcd_barrier(b_); return; }
    if (threadIdx.x == 0) {
        unsigned* bar = (unsigned*)(launder_kargs()->ws + WS_BAR); const unsigned x = xb_xcc_id();
        __builtin_amdgcn_s_waitcnt(0);
        const unsigned nloc = st[0];
        const unsigned old = xb_add(&bar[XB_XSUB(x) + 32], 1u);
        const unsigned gen = old / nloc;
        if (old + 1u == (gen + 1u) * nloc) xb_add(&bar[XB_XGEN(x) + 32], 1u);
        else XB_SPIN(xb_ld(&bar[XB_XGEN(x) + 32]) == gen, bar);
        if (acquire) __builtin_amdgcn_fence(__ATOMIC_ACQUIRE, "agent");
        asm volatile("s_waitcnt vmcnt(0)" ::: "memory");
    }
    __syncthreads();
}

__device__ __forceinline__ void xcd_barrier_arrive(const XcdBarrier& b_) {
    (void)b_;
    extern __shared__ __attribute__((aligned(16))) unsigned char xb_smem_[];
    volatile LAS unsigned* st = (volatile LAS unsigned*)(xb_smem_ + LDS_BYTES - 16);
    asm volatile("s_waitcnt vmcnt(0)" ::: "memory");
    __syncthreads();
    if (threadIdx.x == 0) {
        unsigned* bar = (unsigned*)(launder_kargs()->ws + WS_BAR); const unsigned x = xb_xcc_id();
        __builtin_amdgcn_s_waitcnt(0);
        const unsigned nloc = st[0], nx = st[1];
        const unsigned old = xb_add(&bar[XB_XSUB(x)], 1u);
        const unsigned gen = old / nloc;
        st[3] = gen;
        if (old + 1u == (gen + 1u) * nloc) {
            __builtin_amdgcn_fence(__ATOMIC_RELEASE, "agent");
            asm volatile("s_waitcnt vmcnt(0)" ::: "memory");
            const unsigned og = xb_add(&bar[XB_TOP], 1u);
            const unsigned tg = og / nx;
            if (og + 1u == (tg + 1u) * nx) xb_add(&bar[XB_TOPGEN], 1u);
        }
    }
}
__device__ __forceinline__ void xcd_barrier_wait(const XcdBarrier& b_) {
    (void)b_;
    extern __shared__ __attribute__((aligned(16))) unsigned char xb_smem_[];
    volatile LAS unsigned* st = (volatile LAS unsigned*)(xb_smem_ + LDS_BYTES - 16);
    if (threadIdx.x == 0) {
        unsigned* bar = (unsigned*)(launder_kargs()->ws + WS_BAR);
        const unsigned gen = st[3];
        XB_SPIN(xb_ld(&bar[XB_TOPGEN]) == gen, bar);
        __builtin_amdgcn_fence(__ATOMIC_ACQUIRE, "agent");
        asm volatile("s_waitcnt vmcnt(0)" ::: "memory");
    }
    __syncthreads();
}

__global__ void __launch_bounds__(NT) fwd_megakernel(Params p) {
  extern __shared__ __attribute__((aligned(16))) unsigned char smem[];
  const CParamsP pp = launder_kargs();
  if (pp->ws == nullptr) cg::this_grid().sync();
  volatile LAS unsigned* xbst = (volatile LAS unsigned*)(smem + LDS_BYTES - 16);
  if (threadIdx.x == 0) { xbst[0] = 0u; xbst[1] = 0u; xbst[2] = 0u; }
  setup_phase(p, smem);
  const XcdBarrier xb = xcd_barrier_post((unsigned*)(pp->ws + WS_BAR), xbst);
  xcd_barrier(xb);
  const float* MOD = (const float*)(pp->ws + WS_MOD);
  for (int l = 0; l < DEPTH_; ++l) {
    const float* xsrc = (l == 0) ? gin(pp->in[I_X]) : (const float*)(pp->ws + WS_X);
    const float* modl = MOD + (size_t)l * 2 * 6144;
    if (l == 0) {
      norm_mod_phase(xsrc, gin(pp->in[I_NMIX]), modl + 0, modl + 1024, (bf16_t*)(pp->ws + WS_ABUF), (bf16_t*)(pp->ws + WS_X));
      qbias_phase(p, smem);
      xcd_barrier(xb);
    }
    gemm_proj_phase(p, l, smem);
    const bool split = xbst[2] != 0u;
    if (split) { xcd_barrier_arrive(xb); g1_convert_slice(p, l); xcd_barrier_wait(xb); } else xcd_barrier(xb);
    attn_phase(p, l, smem);
    mix_local_phase(p, l, smem);
    if (split) xcd_barrier_arrive(xb); else xcd_barrier(xb);
    scan_convert_phase(p, l, split ? G1_SLICE_SPANS : 0);
    if (split) xcd_barrier_wait(xb);
    scan_phase(p, l);
    if (split) xcd_barrier_arrive(xb); else xcd_barrier(xb);
    mix_final_att_phase(p, l);
    if (split) xcd_barrier_wait(xb);
    mix_final_phase(p, l, smem);
    xcd_barrier_local(xb, false);
    gemm_out_phase(p, l, smem);
    xcd_barrier_local(xb, false);
    gemm_q_phase(p, l, smem);
    xcd_barrier_local(xb, false);
    peer_phase(p, l, l == DEPTH_ - 1, smem);
    if (l + 1 < DEPTH_) xcd_barrier_local(xb, true);
  }
}

extern "C" void kernel_launch(void* const* d_in, const int* in_sizes, int n_in,
                              void* d_out, int out_size, void* d_ws, size_t ws_size,
                              hipStream_t stream) {
  static int grid_blocks = 0;
  if (grid_blocks == 0) {
    if (n_in != 24 || ws_size < WS_END) { fprintf(stderr, "kernel_launch: unexpected n_in %d / ws_size %zu (need %zu)\n", n_in, ws_size, (size_t)WS_END); grid_blocks = -1; return; }
    int dev = 0, cus = 0, per_cu = 0;
    if (hipGetDevice(&dev) != hipSuccess || hipDeviceGetAttribute(&cus, hipDeviceAttributeMultiprocessorCount, dev) != hipSuccess) { grid_blocks = -1; return; }
    if (hipFuncSetAttribute((const void*)fwd_megakernel, hipFuncAttributeMaxDynamicSharedMemorySize, LDS_BYTES) != hipSuccess) { fprintf(stderr, "hipFuncSetAttribute failed\n"); grid_blocks = -1; return; }
    if (hipOccupancyMaxActiveBlocksPerMultiprocessor(&per_cu, (const void*)fwd_megakernel, NT, LDS_BYTES) != hipSuccess || per_cu < 1) { fprintf(stderr, "occupancy query: %d\n", per_cu); grid_blocks = -1; return; }
    grid_blocks = cus;
  }
  if (grid_blocks < 0) return;
  Params p{};
  for (int i = 0; i < 24; ++i) p.in[i] = (const GAS float*)d_in[i];
  p.out = (GAS float*)d_out; p.ws = (GAS unsigned char*)d_ws;
  void* args[] = {&p};
  if (hipMemsetAsync((unsigned char*)d_ws + WS_BAR, 0, (size_t)XCD_BAR_WORDS * 4, stream) != hipSuccess) { fprintf(stderr, "barrier memset failed\n"); return; }
  hipError_t e = hipLaunchCooperativeKernel((void*)fwd_megakernel, dim3(grid_blocks), dim3(NT), args, LDS_BYTES, stream);
  if (e != hipSuccess) fprintf(stderr, "cooperative launch failed: %s (grid %d)\n", hipGetErrorString(e), grid_blocks);
}
```
